# Optimizing an MI355X kernel written in HIP

```python
import math
import jax, jax.numpy as jnp
from jax import lax
import numpy as np

D_MODEL = 1024
BATCH = 8
SEQ = 4096
DEPTH = 2
DEC_BATCH = 16
DEC_SEQ = 16
PAST_LEN = 4096

CHUNK = 64
N_EVEN = (DEPTH + 1) // 2
N_ODD = DEPTH // 2
EPS = 1e-6
CONV_W = 4
NEG_INF = -1e30
LRU_WIDTH = D_MODEL // 2
LRU_HEADS = 8
LRU_BLOCK = LRU_WIDTH // LRU_HEADS
LRU_C = 8.0
HEAD_DIM = 64
ATT_HEADS = (D_MODEL // 2) // HEAD_DIM
ATT_KV_HEADS = 2
ATT_GROUP = ATT_HEADS // ATT_KV_HEADS
WINDOW = 128
ROT_DIM = HEAD_DIM // 4
ROPE_THETA = 500000.0
ATT_WIDTH = ATT_HEADS * HEAD_DIM
KV_WIDTH = ATT_KV_HEADS * HEAD_DIM
EVEN_IN = 2 * LRU_WIDTH + ATT_WIDTH + 2 * KV_WIDTH + ATT_WIDTH
EVEN_MIX = LRU_WIDTH + ATT_WIDTH
EVEN_SPLITS = (LRU_WIDTH, 2 * LRU_WIDTH, 2 * LRU_WIDTH + ATT_WIDTH,
               2 * LRU_WIDTH + ATT_WIDTH + KV_WIDTH, 2 * LRU_WIDTH + ATT_WIDTH + 2 * KV_WIDTH)
GDN_DK = 128
GDN_DV = 128
GDN_HEADS = D_MODEL // GDN_DV
GDN_KW = GDN_HEADS * GDN_DK
GDN_VW = GDN_HEADS * GDN_DV
GDN_CONV_CH = 2 * GDN_KW + GDN_VW
ODD_IN = GDN_CONV_CH + GDN_VW + 2 * GDN_HEADS
ODD_SPLITS = (GDN_CONV_CH, GDN_CONV_CH + GDN_VW, GDN_CONV_CH + GDN_VW + GDN_HEADS)

kernel_name = "hybrid_streaming_encoder_step"


def rms_norm(x, g):
    xf = x.astype(jnp.float32)
    y = xf * lax.rsqrt(jnp.mean(xf * xf, axis=-1, keepdims=True) + EPS)
    return (y * g.astype(jnp.float32)).astype(x.dtype)


def l2_normalize(x):
    return x * lax.rsqrt(jnp.sum(x * x, axis=-1, keepdims=True) + EPS)


def modulate(c, mod_w, mod_b):
    mod = jnp.dot(jax.nn.silu(c), mod_w) + mod_b
    shift, scale, gate = jnp.split(mod, 3, axis=-1)
    return shift[:, None], scale[:, None], gate[:, None]


def causal_dwconv(u, buf, w):
    t = u.shape[1]
    ext = jnp.concatenate([buf.astype(u.dtype), u], axis=1)
    y = ext[:, 0:t] * w[0]
    for j in range(1, CONV_W):
        y = y + ext[:, j:j + t] * w[j]
    return y, ext[:, t:]


def partial_rope(x, pos):
    half = ROT_DIM // 2
    inv = ROPE_THETA ** (-(jnp.arange(half, dtype=jnp.float32) * 2.0 / ROT_DIM))
    ang = pos.astype(jnp.float32)[:, None] * inv[None, :]
    cos = jnp.cos(ang)[None, :, None, :]
    sin = jnp.sin(ang)[None, :, None, :]
    xf = x.astype(jnp.float32)
    x1 = xf[..., :half]
    x2 = xf[..., half:ROT_DIM]
    out = jnp.concatenate([x1 * cos - x2 * sin, x2 * cos + x1 * sin, xf[..., ROT_DIM:]], axis=-1)
    return out.astype(x.dtype)


def rg_lru(x, h0, w_a, b_a, w_x, b_x, lam):
    bsz, t, _ = x.shape
    xf = x.astype(jnp.float32)
    xb = xf.reshape(bsz, t, LRU_HEADS, LRU_BLOCK)
    r = jax.nn.sigmoid(jnp.einsum('bthi,hij->bthj', xb, w_a.astype(jnp.float32)).reshape(bsz, t, LRU_WIDTH) + b_a)
    i = jax.nn.sigmoid(jnp.einsum('bthi,hij->bthj', xb, w_x.astype(jnp.float32)).reshape(bsz, t, LRU_WIDTH) + b_x)
    log_a = -LRU_C * r * jax.nn.softplus(-lam.astype(jnp.float32))
    a = jnp.exp(log_a)
    gated_x = jnp.sqrt(-jnp.expm1(2.0 * log_a)) * (i * xf)

    def combine(lhs, rhs):
        a_l, b_l = lhs
        a_r, b_r = rhs
        return a_l * a_r, a_r * b_l + b_r

    a_cum, h_zero = lax.associative_scan(combine, (a, gated_x), axis=1)
    h = h_zero + a_cum * h0.astype(jnp.float32)[:, None]
    return h.astype(x.dtype), h[:, -1].astype(x.dtype)


def sink_window_attention(q, k, v, k_past, v_past, n_past_valid, sinks):
    bsz, t = q.shape[:2]
    cb = min(CHUNK, t)
    nb = t // cb
    m = WINDOW + cb
    k_ext = jnp.concatenate([k_past.astype(k.dtype), k], axis=1)
    v_ext = jnp.concatenate([v_past.astype(v.dtype), v], axis=1)
    idx = jnp.arange(nb)[:, None] * cb + jnp.arange(m)[None, :]
    kb = jnp.take(k_ext, idx, axis=1)
    vb = jnp.take(v_ext, idx, axis=1)
    qb = q.reshape(bsz, nb, cb, ATT_KV_HEADS, ATT_GROUP, HEAD_DIM)
    s = jnp.einsum('bnqhgd,bnmhd->bnhgqm', qb, kb,
                   preferred_element_type=jnp.float32) * (HEAD_DIM ** -0.5)
    valid = idx >= (WINDOW - n_past_valid)
    s = jnp.where(valid[None, :, None, None, None, :], s, NEG_INF)
    sink = sinks.astype(jnp.float32).reshape(ATT_KV_HEADS, ATT_GROUP)[None, None, :, :, None, None]
    mx = jnp.maximum(jnp.max(s, axis=-1, keepdims=True), sink)
    p = jnp.exp(s - mx)
    p = p / (jnp.sum(p, axis=-1, keepdims=True) + jnp.exp(sink - mx))
    o = jnp.einsum('bnhgqm,bnmhd->bnqhgd', p.astype(v.dtype), vb)
    return o.reshape(bsz, t, ATT_WIDTH)


def unit_lower_inverse(a, n):
    t = jnp.broadcast_to(jnp.eye(n, dtype=a.dtype), a.shape)
    p = -a
    n_steps = (n - 1).bit_length()
    for step in range(n_steps):
        t = t + jnp.matmul(t, p)
        if step + 1 < n_steps:
            p = jnp.matmul(p, p)
    return t


def gated_delta_rule(q, k, v, g, beta, s0):
    bsz, t, h, _ = q.shape
    dv = v.shape[-1]
    cb = min(CHUNK, t)
    nc = t // cb

    def chunks(a):
        a = a.reshape(bsz, nc, cb, h, -1)
        return jnp.transpose(a, (1, 0, 3, 2, 4))

    qc, kc, vc = chunks(q), chunks(k), chunks(v)
    gc = chunks(g[..., None])[..., 0]
    bc = chunks(beta[..., None])[..., 0]
    gcum = jnp.cumsum(gc, axis=-1)
    strict = jnp.tril(jnp.ones((cb, cb), dtype=bool), -1)
    incl = jnp.tril(jnp.ones((cb, cb), dtype=bool))
    diff = gcum[..., :, None] - gcum[..., None, :]
    decay_strict = jnp.where(strict, jnp.exp(jnp.where(strict, diff, 0.0)), 0.0)
    decay_incl = jnp.where(incl, jnp.exp(jnp.where(incl, diff, 0.0)), 0.0)
    k_beta = kc * bc[..., None]
    a_mat = jnp.einsum('nbhid,nbhjd->nbhij', k_beta, kc) * decay_strict
    t_mat = unit_lower_inverse(a_mat, cb)
    w = jnp.matmul(t_mat, k_beta * jnp.exp(gcum)[..., None])
    u = jnp.matmul(t_mat, vc * bc[..., None])
    qk = jnp.einsum('nbhid,nbhjd->nbhij', qc, kc) * decay_incl

    def step(state, inp):
        q_i, k_i, w_i, u_i, qk_i, g_i = inp
        v_new = u_i - jnp.einsum('bhck,bhkv->bhcv', w_i, state)
        o_i = (jnp.einsum('bhck,bhkv->bhcv', q_i * jnp.exp(g_i)[..., None], state)
               + jnp.einsum('bhcj,bhjv->bhcv', qk_i, v_new))
        g_last = g_i[..., -1:]
        k_dec = k_i * jnp.exp(g_last - g_i)[..., None]
        state = state * jnp.exp(g_last)[..., None] + jnp.einsum('bhck,bhcv->bhkv', k_dec, v_new)
        return state, o_i

    s_final, o = lax.scan(step, s0, (qc, kc, w, u, qk, gcum))
    o = jnp.transpose(o, (1, 0, 3, 2, 4)).reshape(bsz, t, h, dv)
    return o, s_final


def even_layer(x, c, conv_buf, h0, k_past, v_past, n_past_valid, pos0,
               mod_w, mod_b, norm_pre, norm_post, w_in, conv_w, conv_b,
               w_a, b_a, w_x, b_x, lam, sinks, w_out):
    bsz, t, _ = x.shape
    shift, scale, gate = modulate(c, mod_w, mod_b)
    hmod = rms_norm(x, norm_pre) * (1.0 + scale) + shift
    u = jnp.dot(hmod, w_in)
    x_a, g_a, q, k, v, g_b = jnp.split(u, EVEN_SPLITS, axis=-1)
    xc, new_buf = causal_dwconv(x_a, conv_buf, conv_w)
    h, h_last = rg_lru(xc + conv_b, h0, w_a, b_a, w_x, b_x, lam)
    y_a = h * jax.nn.silu(g_a)
    pos = pos0 + jnp.arange(t, dtype=jnp.int32)
    q = partial_rope(q.reshape(bsz, t, ATT_HEADS, HEAD_DIM), pos)
    k = partial_rope(k.reshape(bsz, t, ATT_KV_HEADS, HEAD_DIM), pos)
    v = v.reshape(bsz, t, ATT_KV_HEADS, HEAD_DIM)
    y_b = sink_window_attention(q, k, v, k_past, v_past, n_past_valid, sinks) * jax.nn.silu(g_b)
    y = jnp.dot(jnp.concatenate([y_a, y_b], axis=-1), w_out)
    x = x + gate * rms_norm(y, norm_post)
    return x, new_buf, h_last, k, v


def odd_layer(x, c, conv_buf, s0, mod_w, mod_b, norm_pre, norm_post, w_in,
              conv_w, a_log, dt_bias, head_norm, w_out):
    bsz, t, _ = x.shape
    shift, scale, gate = modulate(c, mod_w, mod_b)
    hmod = rms_norm(x, norm_pre) * (1.0 + scale) + shift
    u = jnp.dot(hmod, w_in)
    qkv, z, b, a = jnp.split(u, ODD_SPLITS, axis=-1)
    qkv_c, new_buf = causal_dwconv(qkv, conv_buf, conv_w)
    qkv_c = jax.nn.silu(qkv_c).astype(jnp.float32)
    q, k, v = jnp.split(qkv_c, (GDN_KW, 2 * GDN_KW), axis=-1)
    q = l2_normalize(q.reshape(bsz, t, GDN_HEADS, GDN_DK)) * (GDN_DK ** -0.5)
    k = l2_normalize(k.reshape(bsz, t, GDN_HEADS, GDN_DK))
    v = v.reshape(bsz, t, GDN_HEADS, GDN_DV)
    beta = jax.nn.sigmoid(b.astype(jnp.float32))
    g = -jnp.exp(a_log.astype(jnp.float32)) * jax.nn.softplus(a.astype(jnp.float32) + dt_bias)
    o, s_new = gated_delta_rule(q, k, v, g, beta, s0.astype(jnp.float32))
    o = rms_norm(o, head_norm) * jax.nn.silu(z.reshape(bsz, t, GDN_HEADS, GDN_DV).astype(jnp.float32))
    y = jnp.dot(o.reshape(bsz, t, GDN_VW).astype(x.dtype), w_out)
    x = x + gate * rms_norm(y, norm_post)
    return x, new_buf, s_new.astype(x.dtype)


def setup_inputs(seed: int = 0) -> dict:
    key = jax.random.key(seed)
    ks = iter(jax.random.split(key, 48))
    f32 = jnp.float32

    def nrm(shape, scale):
        return jax.random.normal(next(ks), shape, f32) * scale

    x_prompt = nrm((BATCH, SEQ, D_MODEL), 1.0)
    x_sample = nrm((DEC_BATCH, DEC_SEQ, D_MODEL), 1.0)
    state_lru_conv = nrm((N_EVEN, DEC_BATCH, CONV_W - 1, LRU_WIDTH), 1.0)
    state_lru_h = nrm((N_EVEN, DEC_BATCH, LRU_WIDTH), 0.5)
    cache_swa_k = nrm((N_EVEN, DEC_BATCH, WINDOW, ATT_KV_HEADS, HEAD_DIM), 1.0)
    cache_swa_v = nrm((N_EVEN, DEC_BATCH, WINDOW, ATT_KV_HEADS, HEAD_DIM), 1.0)
    state_gdn_conv = nrm((N_ODD, DEC_BATCH, CONV_W - 1, GDN_CONV_CH), 1.0)
    state_gdn_s = nrm((N_ODD, DEC_BATCH, GDN_HEADS, GDN_DK, GDN_DV), GDN_DK ** -0.5)
    c_prompt = nrm((BATCH, D_MODEL), 1.0)
    c_sample = nrm((DEC_BATCH, D_MODEL), 1.0)
    ev_mod_w = nrm((N_EVEN, D_MODEL, 3 * D_MODEL), 0.2 * D_MODEL ** -0.5)
    ev_mod_b = nrm((N_EVEN, 3 * D_MODEL), 0.02)
    ev_norm_pre = 1.0 + nrm((N_EVEN, D_MODEL), 0.02)
    ev_norm_post = 1.0 + nrm((N_EVEN, D_MODEL), 0.02)
    ev_w_in = nrm((N_EVEN, D_MODEL, EVEN_IN), D_MODEL ** -0.5)
    lru_conv_w = nrm((N_EVEN, CONV_W, LRU_WIDTH), CONV_W ** -0.5)
    lru_conv_b = nrm((N_EVEN, LRU_WIDTH), 0.02)
    lru_w_a = nrm((N_EVEN, LRU_HEADS, LRU_BLOCK, LRU_BLOCK), LRU_BLOCK ** -0.5)
    lru_b_a = nrm((N_EVEN, LRU_WIDTH), 0.02)
    lru_w_x = nrm((N_EVEN, LRU_HEADS, LRU_BLOCK, LRU_BLOCK), LRU_BLOCK ** -0.5)
    lru_b_x = nrm((N_EVEN, LRU_WIDTH), 0.02)
    u_lam = jax.random.uniform(next(ks), (N_EVEN, LRU_WIDTH), f32, 0.9, 0.999)
    lru_lambda = jnp.log(u_lam) - jnp.log1p(-u_lam)
    swa_sinks = nrm((N_EVEN, ATT_HEADS), 1.0)
    ev_w_out = nrm((N_EVEN, EVEN_MIX, D_MODEL), EVEN_MIX ** -0.5)
    od_mod_w = nrm((N_ODD, D_MODEL, 3 * D_MODEL), 0.2 * D_MODEL ** -0.5)
    od_mod_b = nrm((N_ODD, 3 * D_MODEL), 0.02)
    od_norm_pre = 1.0 + nrm((N_ODD, D_MODEL), 0.02)
    od_norm_post = 1.0 + nrm((N_ODD, D_MODEL), 0.02)
    od_w_in = nrm((N_ODD, D_MODEL, ODD_IN), D_MODEL ** -0.5)
    gdn_conv_w = nrm((N_ODD, CONV_W, GDN_CONV_CH), CONV_W ** -0.5)
    gdn_a_log = jnp.log(jax.random.uniform(next(ks), (N_ODD, GDN_HEADS), f32, 1.0, 16.0))
    dt = jnp.exp(jax.random.uniform(next(ks), (N_ODD, GDN_HEADS), f32, math.log(1e-3), math.log(1e-1)))
    gdn_dt_bias = dt + jnp.log(-jnp.expm1(-dt))
    gdn_head_norm = 1.0 + nrm((N_ODD, GDN_DV), 0.02)
    od_w_out = nrm((N_ODD, GDN_VW, D_MODEL), GDN_VW ** -0.5)
    return {
        'x_prompt': x_prompt, 'x_sample': x_sample,
        'state_lru_conv': state_lru_conv, 'state_lru_h': state_lru_h,
        'cache_swa_k': cache_swa_k, 'cache_swa_v': cache_swa_v,
        'state_gdn_conv': state_gdn_conv, 'state_gdn_s': state_gdn_s,
        'c_prompt': c_prompt, 'c_sample': c_sample,
        'ev_mod_w': ev_mod_w, 'ev_mod_b': ev_mod_b, 'ev_norm_pre': ev_norm_pre, 'ev_norm_post': ev_norm_post,
        'ev_w_in': ev_w_in, 'lru_conv_w': lru_conv_w, 'lru_conv_b': lru_conv_b,
        'lru_w_a': lru_w_a, 'lru_b_a': lru_b_a, 'lru_w_x': lru_w_x, 'lru_b_x': lru_b_x,
        'lru_lambda': lru_lambda, 'swa_sinks': swa_sinks, 'ev_w_out': ev_w_out,
        'od_mod_w': od_mod_w, 'od_mod_b': od_mod_b, 'od_norm_pre': od_norm_pre, 'od_norm_post': od_norm_post,
        'od_w_in': od_w_in, 'gdn_conv_w': gdn_conv_w, 'gdn_a_log': gdn_a_log, 'gdn_dt_bias': gdn_dt_bias,
        'gdn_head_norm': gdn_head_norm, 'od_w_out': od_w_out,
    }


def reference(x_prompt, x_sample, state_lru_conv, state_lru_h, cache_swa_k, cache_swa_v,
              state_gdn_conv, state_gdn_s, c_prompt, c_sample,
              ev_mod_w, ev_mod_b, ev_norm_pre, ev_norm_post, ev_w_in, lru_conv_w, lru_conv_b,
              lru_w_a, lru_b_a, lru_w_x, lru_b_x, lru_lambda, swa_sinks, ev_w_out,
              od_mod_w, od_mod_b, od_norm_pre, od_norm_post, od_w_in, gdn_conv_w, gdn_a_log,
              gdn_dt_bias, gdn_head_norm, od_w_out):
    xp, xs = x_prompt, x_sample
    bp = xp.shape[0]
    lru_conv_p, lru_conv_s, lru_h_p, lru_h_s = [], [], [], []
    swa_k_p, swa_k_s, swa_v_p, swa_v_s = [], [], [], []
    gdn_conv_p, gdn_conv_s, gdn_s_p, gdn_s_s = [], [], [], []
    for layer in range(DEPTH):
        if layer % 2 == 0:
            e = layer // 2
            ew = (ev_mod_w[e], ev_mod_b[e], ev_norm_pre[e], ev_norm_post[e], ev_w_in[e],
                  lru_conv_w[e], lru_conv_b[e], lru_w_a[e], lru_b_a[e], lru_w_x[e], lru_b_x[e],
                  lru_lambda[e], swa_sinks[e], ev_w_out[e])
            zero_buf = jnp.zeros((bp, CONV_W - 1, LRU_WIDTH), xp.dtype)
            zero_h = jnp.zeros((bp, LRU_WIDTH), xp.dtype)
            zero_kv = jnp.zeros((bp, WINDOW, ATT_KV_HEADS, HEAD_DIM), xp.dtype)
            xp, buf_p, h_p, k_p, v_p = even_layer(xp, c_prompt, zero_buf, zero_h, zero_kv, zero_kv, 0, 0, *ew)
            xs, buf_s, h_s, k_s, v_s = even_layer(xs, c_sample, state_lru_conv[e], state_lru_h[e],
                                                  cache_swa_k[e], cache_swa_v[e], WINDOW, PAST_LEN, *ew)
            lru_conv_p.append(buf_p)
            lru_conv_s.append(buf_s)
            lru_h_p.append(h_p)
            lru_h_s.append(h_s)
            swa_k_p.append(k_p[:, -WINDOW:])
            swa_v_p.append(v_p[:, -WINDOW:])
            swa_k_s.append(k_s)
            swa_v_s.append(v_s)
        else:
            o = layer // 2
            ow = (od_mod_w[o], od_mod_b[o], od_norm_pre[o], od_norm_post[o], od_w_in[o],
                  gdn_conv_w[o], gdn_a_log[o], gdn_dt_bias[o], gdn_head_norm[o], od_w_out[o])
            zero_buf = jnp.zeros((bp, CONV_W - 1, GDN_CONV_CH), xp.dtype)
            zero_s = jnp.zeros((bp, GDN_HEADS, GDN_DK, GDN_DV), jnp.float32)
            xp, buf_p, st_p = odd_layer(xp, c_prompt, zero_buf, zero_s, *ow)
            xs, buf_s, st_s = odd_layer(xs, c_sample, state_gdn_conv[o], state_gdn_s[o], *ow)
            gdn_conv_p.append(buf_p)
            gdn_conv_s.append(buf_s)
            gdn_s_p.append(st_p)
            gdn_s_s.append(st_s)
    return (xp, xs,
            jnp.stack(lru_conv_p), jnp.stack(lru_conv_s),
            jnp.stack(lru_h_p), jnp.stack(lru_h_s),
            jnp.stack(swa_k_p), jnp.stack(swa_k_s),
            jnp.stack(swa_v_p), jnp.stack(swa_v_s),
            jnp.stack(gdn_conv_p), jnp.stack(gdn_conv_s),
            jnp.stack(gdn_s_p), jnp.stack(gdn_s_s))
```

```cpp
#include <hip/hip_runtime.h>
#include <hip/hip_cooperative_groups.h>
namespace cg = cooperative_groups;

#define LAS __attribute__((address_space(3)))
typedef unsigned short bf16_t;
typedef short bf16x8 __attribute__((ext_vector_type(8)));
typedef float f32x4 __attribute__((ext_vector_type(4)));
typedef float f32x2 __attribute__((ext_vector_type(2)));
typedef unsigned u32x4 __attribute__((ext_vector_type(4)));
typedef unsigned u32x2 __attribute__((ext_vector_type(2)));

constexpr int D = 1024, BP = 8, TP = 4096, BS = 16, TS = 16;
constexpr int MP = BP * TP, MS = BS * TS, MT = MP + MS;
constexpr int NSEQ = BP + BS;
constexpr int EV_IN = 2304, OD_IN = 4112, OD_MAIN = 4096;
constexpr int C_XA = 0, C_GA = 512, C_Q = 1024, C_K = 1536, C_V = 1664, C_GB = 1792;
constexpr float EPS = 1e-6f;
constexpr size_t O_Y = 0, O_LCP = 33816576, O_LCS = 33828864, O_LHP = 33853440, O_LHS = 33857536, O_KP = 33865728, O_KS = 33996800,
                 O_VP = 34029568, O_VS = 34160640, O_GCP = 34193408, O_GCS = 34267136, O_GSP = 34414592, O_GSS = 35463168, O_END = 37560320;
constexpr size_t MiB = 1u << 20;
constexpr size_t WS_CTL = 0, WS_W1O = 1 * MiB, WS_MOD = 3 * MiB, WS_ROPE = 4 * MiB, WS_BA = 5 * MiB, WS_LAG = 8 * MiB, WS_LGW = 10 * MiB;
constexpr size_t WS_RA = 16 * MiB, RA_BYTES = (size_t)MT * 4096 * 2;
constexpr size_t WS_RB = WS_RA + RA_BYTES;
constexpr size_t ACT_BYTES = (size_t)MT * D * 2;
constexpr size_t RB_XN = 0, RB_Y0 = ACT_BYTES, RB_YO = 2 * ACT_BYTES, RB_W0I = 3 * ACT_BYTES, RB_W0O = RB_W0I + (size_t)EV_IN * D * 2,
                 RB_W1I = RB_W0O + (size_t)D * D * 2, RB_WEND = RB_W1I + (size_t)OD_MAIN * D * 2;
constexpr size_t RB_BYTES = (size_t)4224 * 73728;
constexpr size_t WS_END = WS_RB + RB_BYTES;
static_assert(RB_WEND <= RB_BYTES, "ws map");
static_assert((size_t)MT * 3072 * 2 <= RB_BYTES, "ws map");
constexpr int LDS_BYTES = 147456;

struct Params { const float* in[34]; float* out; unsigned char* ws; };

__device__ __forceinline__ float bf2f(bf16_t b) { return __uint_as_float(((unsigned)b) << 16); }
__device__ __forceinline__ unsigned f2bf(float f) { unsigned u = __float_as_uint(f); return (u + 0x7fffu + ((u >> 16) & 1u)) >> 16; }
__device__ __forceinline__ unsigned pk2(float lo, float hi) { return f2bf(lo) | (f2bf(hi) << 16); }
__device__ __forceinline__ float lo16(unsigned w) { return __uint_as_float(w << 16); }
__device__ __forceinline__ float hi16(unsigned w) { return __uint_as_float(w & 0xffff0000u); }
__device__ __forceinline__ float wave_sum(float v) {
#pragma unroll
    for (int o = 1; o < 64; o <<= 1) v += __shfl_xor(v, o);
    return v;
}
__device__ __forceinline__ float sigmoidf_(float x) { return 1.0f / (1.0f + __expf(-x)); }
__device__ __forceinline__ float siluf_(float x) { return x / (1.0f + __expf(-x)); }
__device__ __forceinline__ float softplusf_(float x) { return x > 20.f ? x : log1pf(__expf(x)); }
__device__ __forceinline__ int seq_base(int s) { return s < BP ? s * TP : MP + (s - BP) * TS; }
__device__ __forceinline__ int seq_len(int s) { return s < BP ? TP : TS; }
__device__ __forceinline__ void tok_info(int m, int& s, int& t) { if (m < MP) { s = m >> 12; t = m & 4095; } else { const int r = m - MP; s = BP + (r >> 4); t = r & 15; } }

namespace pg8 {
constexpr int BM = 256, BK = 64, HALF = 128, HTB = HALF * BK * 2, STAGE_BYTES = 8 * HTB, NXCD = 8, WGM = 8;
__host__ __device__ __forceinline__ int lds_byte(int r, int c) { const int st = (r >> 4) * 2 + (c >> 5), rr = r & 15, cc = c & 31, ob = rr * 64 + cc * 2; return st * 1024 + (ob ^ (((ob >> 9) & 1) << 5)); }
__host__ __device__ __forceinline__ void stage_rc(int b, int& R, int& C) { const int st = b / 1024, sb = b % 1024, swz = sb ^ (((sb >> 9) & 1) << 5); R = (st >> 1) * 16 + swz / 64; C = (st & 1) * 32 + (swz % 64) / 2; }
__host__ __device__ __forceinline__ int perm32(int rho) { const int n = rho >> 4, i = rho & 15; return 8 * (i >> 2) + 4 * n + (i & 3); }
struct Unit { int pm, pn; };
struct Gemm { const bf16_t* A; const bf16_t* Bt; int M, N, K; };
struct StaticOrder {
    int nM, nN, nwg, G, c;
    __device__ void init(int M, int N, int G_, int c_) { nM = M / BM; nN = N / BM; nwg = nM * nN; G = G_; c = c_; }
    __device__ bool next(int i, Unit& u) const {
        const long L = (long)i * G + c; if (L >= nwg) return false;
        int wgid = (int)L; { const int q = nwg / NXCD, r = nwg % NXCD, xcd = wgid % NXCD, off = wgid / NXCD; wgid = (xcd < r ? xcd * (q + 1) : r * (q + 1) + (xcd - r) * q) + off; }
        const int nig = WGM * nN, gid = wgid / nig, fm = gid * WGM, gsz = (nM - fm) < WGM ? (nM - fm) : WGM;
        u.pm = fm + ((wgid % nig) % gsz); u.pn = (wgid % nig) / gsz; return true;
    }
};
__device__ __forceinline__ unsigned cvt_pk_bf16(float lo, float hi) { unsigned r; asm volatile("v_cvt_pk_bf16_f32 %0, %1, %2" : "=v"(r) : "v"(lo), "v"(hi)); return r; }
struct EpiBf16 {
    static constexpr bool PERM = true;
    bf16_t* O0; int ld0; int split; bf16_t* O1; int ld1;
    __device__ __forceinline__ void operator()(const f32x4 (&acc)[2][2][4][2], const Unit& u, int wr, int wc, int fr, int fq) const {
        const int row0 = u.pm * BM + wr * 64 + fr; int colt = u.pn * BM; bf16_t* base = O0; int ld = ld0;
        if (colt >= split) { base = O1; ld = ld1; colt -= split; }
        const int col0 = colt + wc * 32 + 8 * fq;
#pragma unroll
        for (int ai = 0; ai < 2; ++ai)
#pragma unroll
            for (int m = 0; m < 4; ++m) { bf16_t* rowp = base + (size_t)(row0 + ai * HALF + m * 16) * ld + col0;
#pragma unroll
                for (int bj = 0; bj < 2; ++bj) { const f32x4 v0 = acc[ai][bj][m][0], v1 = acc[ai][bj][m][1];
                    u32x4 w; w.x = cvt_pk_bf16(v0[0], v0[1]); w.y = cvt_pk_bf16(v0[2], v0[3]); w.z = cvt_pk_bf16(v1[0], v1[1]); w.w = cvt_pk_bf16(v1[2], v1[3]);
                    *(u32x4*)(rowp + bj * HALF) = w; } }
    }
};
template <class Epi, class Sched>
__device__ __forceinline__ void gemm_phase(LAS unsigned char* lds, const Gemm g, const Sched& S, const Epi& E) {
    const int tid = threadIdx.x, wid = __builtin_amdgcn_readfirstlane(tid >> 6), lane = tid & 63, wr = wid >> 2, wc = wid & 3, fr = lane & 15, fq = lane >> 4;
    const int K = g.K, nt = K / BK;
    unsigned voffA[2], voffB[2];
#pragma unroll
    for (int i = 0; i < 2; ++i) { int R, C; stage_rc(tid * 16 + i * 8192, R, C); const int Rb = Epi::PERM ? ((R & ~31) + perm32(R & 31)) : R;
        voffA[i] = (unsigned)(R * K + C) * 2u; voffB[i] = (unsigned)(Rb * K + C) * 2u; }
    const size_t kstep = (size_t)(BK * 2);
    const size_t hstep = (size_t)HALF * K * 2;
    const size_t tstep = 2 * hstep;
    const unsigned ldsw = (unsigned)wid * 1024u;
    const int aoff = lds_byte(wr * 64 + fr, fq * 8), boff = lds_byte(wc * 32 + fr, fq * 8);
#define PG8_SA(b, h) (((b) * 2 + (h)) * HTB)
#define PG8_SB(b, h) ((4 + (b) * 2 + (h)) * HTB)
#define PG8_STAGE(bufoff, gbase, voff) do { _Pragma("unroll") for (int _i = 0; _i < 2; ++_i) \
        __builtin_amdgcn_global_load_lds((const unsigned*)((const char*)(gbase) + (voff)[_i]), (LAS unsigned*)(lds + (bufoff) + ldsw + _i * 8192), 16, 0, 0); } while (0)
#define PG8_LDA(dst, b, h) do { _Pragma("unroll") for (int m = 0; m < 4; ++m) _Pragma("unroll") for (int k = 0; k < 2; ++k) dst[m][k] = *(const LAS bf16x8*)(lds + PG8_SA(b, h) + aoff + m * 2048 + k * 1024); } while (0)
#define PG8_LDB(dst, b, h) do { _Pragma("unroll") for (int n = 0; n < 2; ++n) _Pragma("unroll") for (int k = 0; k < 2; ++k) dst[n][k] = *(const LAS bf16x8*)(lds + PG8_SB(b, h) + boff + n * 2048 + k * 1024); } while (0)
#define PG8_MMA(ai, bj, At, Bt) do { __builtin_amdgcn_s_setprio(1); _Pragma("unroll") for (int m = 0; m < 4; ++m) _Pragma("unroll") for (int n = 0; n < 2; ++n) _Pragma("unroll") for (int k = 0; k < 2; ++k) \
        acc[ai][bj][m][n] = __builtin_amdgcn_mfma_f32_16x16x32_bf16(Bt[n][k], At[m][k], acc[ai][bj][m][n], 0, 0, 0); __builtin_amdgcn_s_setprio(0); } while (0)
#define PG8_WAIT_V(n) asm volatile("s_waitcnt vmcnt(" #n ")" ::: "memory")
#define PG8_WAIT_L(n) asm volatile("s_waitcnt lgkmcnt(" #n ")" ::: "memory")
#define PG8_BAR __builtin_amdgcn_s_barrier()
#define PG8_SCHED __builtin_amdgcn_sched_barrier(0)
    Unit cur, nxt; int ui = 0;
    if (!S.next(0, cur)) return;
    f32x4 acc[2][2][4][2];
#pragma unroll
    for (int a = 0; a < 2; ++a)
#pragma unroll
        for (int b = 0; b < 2; ++b)
#pragma unroll
            for (int m = 0; m < 4; ++m)
#pragma unroll
                for (int n = 0; n < 2; ++n) acc[a][b][m][n] = (f32x4){0.f, 0.f, 0.f, 0.f};
    bf16x8 At[4][2], B0[2][2], B1[2][2];
    const char* cA = (const char*)g.A + (size_t)cur.pm * tstep; const char* cB = (const char*)g.Bt + (size_t)cur.pn * tstep;
    PG8_STAGE(PG8_SB(0, 0), cB, voffB); PG8_STAGE(PG8_SA(0, 0), cA, voffA); PG8_STAGE(PG8_SB(0, 1), cB + hstep, voffB); PG8_STAGE(PG8_SA(0, 1), cA + hstep, voffA);
    if (wr == 1) PG8_BAR;
    PG8_WAIT_V(4); PG8_BAR;
    PG8_STAGE(PG8_SB(1, 0), cB + kstep, voffB); PG8_STAGE(PG8_SA(1, 0), cA + kstep, voffA); PG8_STAGE(PG8_SB(1, 1), cB + hstep + kstep, voffB);
    PG8_WAIT_V(6); PG8_BAR;
    for (;;) {
        const bool has_next = S.next(ui + 1, nxt);
        const char* nA = has_next ? (const char*)g.A + (size_t)nxt.pm * tstep : cA; const char* nB = has_next ? (const char*)g.Bt + (size_t)nxt.pn * tstep : cB;
        for (int t = 0; t < nt; t += 2) {
            const bool last = (t == nt - 2);
            const char* a1 = cA + (size_t)(t + 1) * kstep;
            const char* a2 = last ? nA : cA + (size_t)(t + 2) * kstep; const char* b2 = last ? nB : cB + (size_t)(t + 2) * kstep;
            const char* a3 = a2 + kstep; const char* b3 = b2 + kstep;
            PG8_LDB(B0, 0, 0); PG8_SCHED; PG8_LDA(At, 0, 0); PG8_STAGE(PG8_SA(1, 1), a1 + hstep, voffA);
            PG8_WAIT_L(8); PG8_BAR; PG8_WAIT_L(0); PG8_MMA(0, 0, At, B0); PG8_BAR; PG8_SCHED;
            PG8_LDB(B1, 0, 1); PG8_STAGE(PG8_SB(0, 0), b2, voffB);
            PG8_BAR; PG8_WAIT_L(0); PG8_MMA(0, 1, At, B1); PG8_BAR;
            PG8_LDA(At, 0, 1); PG8_STAGE(PG8_SA(0, 0), a2, voffA);
            PG8_BAR; PG8_WAIT_L(0); PG8_MMA(1, 0, At, B0); PG8_BAR; PG8_SCHED;
            PG8_STAGE(PG8_SB(0, 1), b2 + hstep, voffB);
            PG8_WAIT_V(6); PG8_BAR; PG8_MMA(1, 1, At, B1); PG8_BAR;
            PG8_LDB(B0, 1, 0); PG8_SCHED; PG8_LDA(At, 1, 0); PG8_STAGE(PG8_SA(0, 1), a2 + hstep, voffA);
            PG8_WAIT_L(8); PG8_BAR; PG8_WAIT_L(0); PG8_MMA(0, 0, At, B0); PG8_BAR; PG8_SCHED;
            PG8_LDB(B1, 1, 1); PG8_STAGE(PG8_SB(1, 0), b3, voffB);
            PG8_BAR; PG8_WAIT_L(0); PG8_MMA(0, 1, At, B1); PG8_BAR;
            PG8_LDA(At, 1, 1); PG8_STAGE(PG8_SA(1, 0), a3, voffA);
            PG8_BAR; PG8_WAIT_L(0); PG8_MMA(1, 0, At, B0); PG8_BAR; PG8_SCHED;
            PG8_STAGE(PG8_SB(1, 1), b3 + hstep, voffB);
            PG8_WAIT_V(6); PG8_BAR; PG8_MMA(1, 1, At, B1); PG8_BAR;
        }
        E(acc, cur, wr, wc, fr, fq);
        if (!has_next) break;
#pragma unroll
        for (int a = 0; a < 2; ++a)
#pragma unroll
            for (int b = 0; b < 2; ++b)
#pragma unroll
                for (int m = 0; m < 4; ++m)
#pragma unroll
                    for (int n = 0; n < 2; ++n) acc[a][b][m][n] = (f32x4){0.f, 0.f, 0.f, 0.f};
        cur = nxt; cA = nA; cB = nB; ++ui;
    }
    PG8_WAIT_V(0);
    if (wr == 0) PG8_BAR;
    PG8_BAR;
#undef PG8_SA
#undef PG8_SB
#undef PG8_STAGE
#undef PG8_LDA
#undef PG8_LDB
#undef PG8_MMA
#undef PG8_WAIT_V
#undef PG8_WAIT_L
#undef PG8_BAR
#undef PG8_SCHED
}
}

struct Frame {
    LAS unsigned char* lds;
    int tid, lane, wave, vcu, G;
    const float* const* in; float* out; unsigned char* ws;
    __device__ __forceinline__ float* MOD() const { return (float*)(ws + WS_MOD); }
    __device__ __forceinline__ float* ROPE() const { return (float*)(ws + WS_ROPE); }
    __device__ __forceinline__ float* BA() const { return (float*)(ws + WS_BA); }
    __device__ __forceinline__ float* LAG() const { return (float*)(ws + WS_LAG); }
    __device__ __forceinline__ bf16_t* W1O() const { return (bf16_t*)(ws + WS_W1O); }
    __device__ __forceinline__ bf16_t* U0() const { return (bf16_t*)(ws + WS_RA); }
    __device__ __forceinline__ bf16_t* QKV1() const { return (bf16_t*)(ws + WS_RA); }
    __device__ __forceinline__ bf16_t* Z1() const { return (bf16_t*)(ws + WS_RA + (size_t)MT * 3072 * 2); }
    __device__ __forceinline__ bf16_t* Y1() const { return (bf16_t*)(ws + WS_RA); }
    __device__ __forceinline__ bf16_t* XN() const { return (bf16_t*)(ws + WS_RB + RB_XN); }
    __device__ __forceinline__ bf16_t* Y0() const { return (bf16_t*)(ws + WS_RB + RB_Y0); }
    __device__ __forceinline__ bf16_t* YO() const { return (bf16_t*)(ws + WS_RB + RB_YO); }
    __device__ __forceinline__ bf16_t* W0I() const { return (bf16_t*)(ws + WS_RB + RB_W0I); }
    __device__ __forceinline__ bf16_t* W0O() const { return (bf16_t*)(ws + WS_RB + RB_W0O); }
    __device__ __forceinline__ bf16_t* W1I() const { return (bf16_t*)(ws + WS_RB + RB_W1I); }
    __device__ __forceinline__ bf16_t* QKVC() const { return (bf16_t*)(ws + WS_RB); }
};

__device__ __forceinline__ void p0_transpose_item(const float* W, int ldw, int nblk, int K, bf16_t* WT, LAS float* scr, int item, int lane) {
    const int kb = item / nblk, nb = item % nblk, k0 = 64 * kb, n0 = 32 * nb;
#pragma unroll 8
    for (int i = 0; i < 32; ++i) { const int kk = 2 * i + (lane >> 5); scr[kk * 33 + (lane & 31)] = W[(size_t)(k0 + kk) * ldw + n0 + (lane & 31)]; }
    asm volatile("s_waitcnt lgkmcnt(0)" ::: "memory");
    const int c = lane & 7;
#pragma unroll
    for (int j = 0; j < 4; ++j) { const int n = (lane >> 3) + 8 * j; const LAS float* s = scr + (8 * c) * 33 + n;
        u32x4 o; o.x = pk2(s[0 * 33], s[1 * 33]); o.y = pk2(s[2 * 33], s[3 * 33]); o.z = pk2(s[4 * 33], s[5 * 33]); o.w = pk2(s[6 * 33], s[7 * 33]);
        *(u32x4*)(WT + (size_t)(n0 + n) * K + k0 + 8 * c) = o; }
    asm volatile("s_waitcnt lgkmcnt(0)" ::: "memory");
}
__device__ __forceinline__ void phase_prologue(Frame& F) {
    const int gw = F.vcu * 8 + F.wave, NGW = F.G * 8;
    {
        LAS float* scr = (LAS float*)(F.lds + F.wave * 16384);
        constexpr int I0 = 16 * (EV_IN / 32), I1 = 16 * 32, I2 = 16 * (OD_MAIN / 32), I3 = 16 * 32;
        for (int it = gw; it < I0 + I1 + I2 + I3; it += NGW) {
            int r = it;
            if (r < I0) { p0_transpose_item(F.in[14], EV_IN, EV_IN / 32, D, F.W0I(), scr, r, F.lane); continue; } r -= I0;
            if (r < I1) { p0_transpose_item(F.in[23], D, 32, D, F.W0O(), scr, r, F.lane); continue; } r -= I1;
            if (r < I2) { p0_transpose_item(F.in[28], OD_IN, OD_MAIN / 32, D, F.W1I(), scr, r, F.lane); continue; } r -= I2;
            p0_transpose_item(F.in[33], D, 32, D, F.W1O(), scr, r, F.lane);
        }
    }
    {
        const double inv[8] = {1.0, 0.19392274474868576, 0.03760603093086393, 0.007292664737217109, 0.001414213562373095, 0.0002742481756762073, 5.318295896944988e-05, 1.031338537721246e-05};
        for (int idx = F.vcu * 512 + F.tid; idx < 4112 * 8; idx += F.G * 512) {
            const int pos = idx >> 3, i = idx & 7;
            double iv = inv[0];
#pragma unroll
            for (int q = 1; q < 8; ++q) iv = (i == q) ? inv[q] : iv;
            const double ang = (double)pos * iv;
            const double n = __builtin_rint(ang * 0.15915494309189535);
            const float r = (float)__builtin_fma(-n, 6.283185307179586, ang);
            F.ROPE()[pos * 16 + i] = __cosf(r); F.ROPE()[pos * 16 + 8 + i] = __sinf(r);
        }
    }
    __syncthreads();
    for (int bt = F.vcu; bt < 96; bt += F.G) {
        LAS float* tab = (LAS float*)F.lds;
        for (int idx = F.tid; idx < 24 * 1024; idx += 512) { const int s = idx >> 10, k = idx & 1023;
            const float c = s < BP ? F.in[8][s * D + k] : F.in[9][(s - BP) * D + k]; tab[k * 24 + s] = siluf_(c); }
        __syncthreads();
        const int L = bt / 48, n0 = (bt % 48) * 64;
        const float* mw = (L == 0 ? F.in[10] : F.in[24]) + n0 + F.lane;
        float acc[24];
#pragma unroll
        for (int r = 0; r < 24; ++r) acc[r] = 0.f;
        for (int k = F.wave * 128; k < F.wave * 128 + 128; ++k) {
            const float w = mw[(size_t)k * 3072];
            const LAS f32x4* tp = (const LAS f32x4*)(tab + k * 24);
#pragma unroll
            for (int q = 0; q < 6; ++q) { const f32x4 t4 = tp[q]; acc[4 * q] += t4[0] * w; acc[4 * q + 1] += t4[1] * w; acc[4 * q + 2] += t4[2] * w; acc[4 * q + 3] += t4[3] * w; }
        }
        __syncthreads();
        LAS float* red = (LAS float*)F.lds;
#pragma unroll
        for (int r = 0; r < 24; ++r) red[(F.wave * 24 + r) * 64 + F.lane] = acc[r];
        __syncthreads();
        const float* mb = (L == 0 ? F.in[11] : F.in[25]);
        for (int idx = F.tid; idx < 24 * 64; idx += 512) { const int r = idx >> 6, l = idx & 63; float s = 0.f;
#pragma unroll
            for (int w = 0; w < 8; ++w) s += red[(w * 24 + r) * 64 + l];
            F.MOD()[((size_t)L * 24 + r) * 3072 + n0 + l] = s + mb[n0 + l]; }
        __syncthreads();
    }
}

__device__ __forceinline__ void phase_prenorm0(Frame& F) {
    const int gw = F.vcu * 8 + F.wave, NGW = F.G * 8;
    for (int m = gw; m < MT; m += NGW) {
        int s, t; tok_info(m, s, t);
        const float* xrow = m < MP ? F.in[0] + (size_t)m * D : F.in[1] + (size_t)(m - MP) * D;
        const float* modr = F.MOD() + (size_t)s * 3072;
        f32x4 v[4]; float ss = 0.f;
#pragma unroll
        for (int j = 0; j < 4; ++j) { v[j] = *(const f32x4*)(xrow + 4 * F.lane + 256 * j); ss += (v[j][0] * v[j][0] + v[j][1] * v[j][1]) + (v[j][2] * v[j][2] + v[j][3] * v[j][3]); }
        const float r = rsqrtf(wave_sum(ss) * (1.f / D) + EPS);
#pragma unroll
        for (int j = 0; j < 4; ++j) { const int c = 4 * F.lane + 256 * j;
            const f32x4 g = *(const f32x4*)(F.in[12] + c), sh = *(const f32x4*)(modr + c), sc = *(const f32x4*)(modr + 1024 + c);
            f32x4 o;
#pragma unroll
            for (int e = 0; e < 4; ++e) o[e] = v[j][e] * r * g[e] * (1.f + sc[e]) + sh[e];
            u32x2 w; w.x = pk2(o[0], o[1]); w.y = pk2(o[2], o[3]); *(u32x2*)(F.XN() + (size_t)m * D + c) = w; }
    }
}

__device__ __forceinline__ void phase_rope(Frame& F) {
    const int gt = F.vcu * 512 + F.tid, NT = F.G * 512;
    for (int idx = gt; idx < MT * 80; idx += NT) {
        const int m = idx / 80, r = idx % 80, slot = r >> 3, i = r & 7;
        int s, t; tok_info(m, s, t);
        const int pos = s < BP ? t : TP + t;
        const int col = slot < 8 ? C_Q + slot * 64 : C_K + (slot - 8) * 64;
        bf16_t* p = F.U0() + (size_t)m * EV_IN + col;
        const float x1 = bf2f(p[i]), x2 = bf2f(p[8 + i]), c = F.ROPE()[pos * 16 + i], sn = F.ROPE()[pos * 16 + 8 + i];
        const float o1 = x1 * c - x2 * sn, o2 = x2 * c + x1 * sn;
        p[i] = (bf16_t)f2bf(o1); p[8 + i] = (bf16_t)f2bf(o2);
        if (slot >= 8) { const int kv = slot - 8;
            if (s >= BP) { float* o = F.out + O_KS + ((size_t)((s - BP) * TS + t) * 2 + kv) * 64; o[i] = o1; o[8 + i] = o2; }
            else if (t >= TP - 128) { float* o = F.out + O_KP + ((size_t)(s * 128 + (t - (TP - 128))) * 2 + kv) * 64; o[i] = o1; o[8 + i] = o2; } }
    }
    for (int idx = gt; idx < 1280 * 224; idx += NT) {
        const int tk = idx / 224, e = idx % 224;
        int s, t, m; if (tk < 1024) { s = tk >> 7; t = TP - 128 + (tk & 127); m = s * TP + t; } else { s = BP + ((tk - 1024) >> 4); t = (tk - 1024) & 15; m = MP + (tk - 1024); }
        const bool isv = e >= 96; const int e2 = isv ? e - 96 : e; const int kv = isv ? (e2 >> 6) : (e2 / 48), d = isv ? (e2 & 63) : 16 + (e2 % 48);
        const float val = bf2f(F.U0()[(size_t)m * EV_IN + (isv ? C_V : C_K) + kv * 64 + d]);
        const size_t ob = s >= BP ? (isv ? O_VS : O_KS) + ((size_t)((s - BP) * TS + t) * 2 + kv) * 64 : (isv ? O_VP : O_KP) + ((size_t)(s * 128 + (t - (TP - 128))) * 2 + kv) * 64;
        F.out[ob + d] = val;
    }
}

__device__ __forceinline__ void phase_lru_naive(Frame& F) {
    const int gw = F.vcu * 8 + F.wave, NGW = F.G * 8;
    for (int task = gw; task < NSEQ * 8; task += NGW) {
        const int s = task >> 3, h = task & 7, ch = h * 64 + F.lane, T = seq_len(s), base = seq_base(s);
        float wa[64], wx[64];
#pragma unroll
        for (int i = 0; i < 64; ++i) { wa[i] = F.in[17][(h * 64 + i) * 64 + F.lane]; wx[i] = F.in[19][(h * 64 + i) * 64 + F.lane]; }
        const float cw0 = F.in[15][ch], cw1 = F.in[15][512 + ch], cw2 = F.in[15][1024 + ch], cw3 = F.in[15][1536 + ch], cb = F.in[16][ch];
        const float ba = F.in[18][ch], bx = F.in[20][ch], sp = softplusf_(-F.in[21][ch]);
        float x3 = 0.f, x2 = 0.f, x1 = 0.f, hh = 0.f;
        if (s >= BP) { const float* cs = F.in[2] + (size_t)(s - BP) * 3 * 512; x3 = cs[ch]; x2 = cs[512 + ch]; x1 = cs[1024 + ch]; hh = F.in[3][(s - BP) * 512 + ch]; }
        for (int t0 = 0; t0 < T; t0 += 16) {
            float xa[16], ga[16];
#pragma unroll
            for (int j = 0; j < 16; ++j) { const bf16_t* p = F.U0() + (size_t)(base + t0 + j) * EV_IN; xa[j] = bf2f(p[C_XA + ch]); ga[j] = bf2f(p[C_GA + ch]); }
#pragma unroll
            for (int j = 0; j < 16; ++j) {
                const float xc = cw0 * x3 + cw1 * x2 + cw2 * x1 + cw3 * xa[j] + cb;
                x3 = x2; x2 = x1; x1 = xa[j];
                float za = ba, zx = bx;
#pragma unroll
                for (int i = 0; i < 64; ++i) { const float xi = __uint_as_float(__builtin_amdgcn_readlane(__float_as_uint(xc), i)); za += xi * wa[i]; zx += xi * wx[i]; }
                const float r = sigmoidf_(za), ig = sigmoidf_(zx), la = -8.0f * r * sp, a = __expf(la);
                const float gx = sqrtf(-expm1f(2.0f * la)) * (ig * xc);
                hh = a * hh + gx;
                F.Y0()[(size_t)(base + t0 + j) * D + ch] = (bf16_t)f2bf(hh * siluf_(ga[j]));
            }
        }
        if (s < BP) { F.out[O_LHP + s * 512 + ch] = hh; float* o = F.out + O_LCP + (size_t)s * 3 * 512; o[ch] = x3; o[512 + ch] = x2; o[1024 + ch] = x1; }
        else { F.out[O_LHS + (s - BP) * 512 + ch] = hh; float* o = F.out + O_LCS + (size_t)(s - BP) * 3 * 512; o[ch] = x3; o[512 + ch] = x2; o[1024 + ch] = x1; }
    }
}

__device__ __forceinline__ void phase_attn_naive(Frame& F) {
    const int gt = F.vcu * 512 + F.tid, NT = F.G * 512;
    for (int idx = gt; idx < MT * 8; idx += NT) {
        const int hq = idx / MT, m = idx % MT, kv = hq >> 2;
        int s, t; tok_info(m, s, t);
        unsigned qp[32]; float o[64];
        { const u32x4* qq = (const u32x4*)(F.U0() + (size_t)m * EV_IN + C_Q + hq * 64);
#pragma unroll
          for (int c = 0; c < 8; ++c) { const u32x4 w = qq[c];
#pragma unroll
              for (int e = 0; e < 4; ++e) qp[c * 4 + e] = pk2(lo16(w[e]) * 0.125f, hi16(w[e]) * 0.125f); } }
#pragma unroll
        for (int d = 0; d < 64; ++d) o[d] = 0.f;
        float mx = F.in[22][hq], l = 1.0f;
        int nkeys, p0 = 0;
        if (s < BP) { const int c0 = (t >> 6) * 64; p0 = c0 - 128 < 0 ? 0 : c0 - 128; nkeys = c0 + 64 - p0; } else nkeys = 128 + TS;
        for (int j = 0; j < nkeys; ++j) {
            float sc = 0.f;
            const bool cached = (s >= BP && j < 128);
            const int mk = s < BP ? s * TP + p0 + j : seq_base(s) + (j - 128);
            const float* kpf = F.in[4] + ((size_t)((s - BP) * 128 + j) * 2 + kv) * 64; const float* vpf = F.in[5] + ((size_t)((s - BP) * 128 + j) * 2 + kv) * 64;
            const bf16_t* kpb = F.U0() + (size_t)mk * EV_IN + C_K + kv * 64; const bf16_t* vpb = F.U0() + (size_t)mk * EV_IN + C_V + kv * 64;
            if (cached) {
#pragma unroll
                for (int c = 0; c < 16; ++c) { const f32x4 a = *(const f32x4*)(kpf + 4 * c); sc += (lo16(qp[2 * c]) * a[0] + hi16(qp[2 * c]) * a[1]) + (lo16(qp[2 * c + 1]) * a[2] + hi16(qp[2 * c + 1]) * a[3]); }
            } else {
#pragma unroll
                for (int c = 0; c < 8; ++c) { const u32x4 a = *(const u32x4*)(kpb + 8 * c);
#pragma unroll
                    for (int e = 0; e < 4; ++e) sc += lo16(qp[c * 4 + e]) * lo16(a[e]) + hi16(qp[c * 4 + e]) * hi16(a[e]); }
            }
            const float mn = fmaxf(mx, sc), alpha = __expf(mx - mn), p = __expf(sc - mn);
            l = l * alpha + p; mx = mn;
            if (cached) {
#pragma unroll
                for (int c = 0; c < 16; ++c) { const f32x4 b = *(const f32x4*)(vpf + 4 * c);
#pragma unroll
                    for (int e = 0; e < 4; ++e) o[4 * c + e] = o[4 * c + e] * alpha + p * b[e]; }
            } else {
#pragma unroll
                for (int c = 0; c < 8; ++c) { const u32x4 b = *(const u32x4*)(vpb + 8 * c);
#pragma unroll
                    for (int e = 0; e < 4; ++e) { o[c * 8 + 2 * e] = o[c * 8 + 2 * e] * alpha + p * lo16(b[e]); o[c * 8 + 2 * e + 1] = o[c * 8 + 2 * e + 1] * alpha + p * hi16(b[e]); } }
            }
        }
        const float il = 1.0f / l;
        const u32x4* gp = (const u32x4*)(F.U0() + (size_t)m * EV_IN + C_GB + hq * 64);
        u32x4* yp = (u32x4*)(F.Y0() + (size_t)m * D + 512 + hq * 64);
#pragma unroll
        for (int c = 0; c < 8; ++c) { const u32x4 g = gp[c]; u32x4 w;
#pragma unroll
            for (int e = 0; e < 4; ++e) w[e] = pk2(o[c * 8 + 2 * e] * il * siluf_(lo16(g[e])), o[c * 8 + 2 * e + 1] * il * siluf_(hi16(g[e])));
            yp[c] = w; }
    }
}

__device__ __forceinline__ void phase_mid_rowwise(Frame& F) {
    LAS float* baw = (LAS float*)F.lds;
    for (int idx = F.tid; idx < 16 * 1024; idx += 512) { const int j = idx & 15, k = idx >> 4; baw[j * 1024 + k] = F.in[28][(size_t)k * OD_IN + OD_MAIN + j]; }
    __syncthreads();
    const int gw = F.vcu * 8 + F.wave, NGW = F.G * 8;
    for (int m = gw; m < MT; m += NGW) {
        int s, t; tok_info(m, s, t);
        const float* xrow = m < MP ? F.in[0] + (size_t)m * D : F.in[1] + (size_t)(m - MP) * D;
        const float* mod0 = F.MOD() + (size_t)s * 3072; const float* mod1 = F.MOD() + (size_t)(24 + s) * 3072;
        f32x4 y[4]; float ss = 0.f;
#pragma unroll
        for (int j = 0; j < 4; ++j) { const u32x2 w = *(const u32x2*)(F.YO() + (size_t)m * D + 4 * F.lane + 256 * j); y[j] = (f32x4){lo16(w.x), hi16(w.x), lo16(w.y), hi16(w.y)};
            ss += (y[j][0] * y[j][0] + y[j][1] * y[j][1]) + (y[j][2] * y[j][2] + y[j][3] * y[j][3]); }
        const float r1 = rsqrtf(wave_sum(ss) * (1.f / D) + EPS);
        f32x4 x1[4]; float s2 = 0.f;
#pragma unroll
        for (int j = 0; j < 4; ++j) { const int c = 4 * F.lane + 256 * j;
            const f32x4 xv = *(const f32x4*)(xrow + c), g = *(const f32x4*)(F.in[13] + c), gt = *(const f32x4*)(mod0 + 2048 + c);
#pragma unroll
            for (int e = 0; e < 4; ++e) x1[j][e] = xv[e] + gt[e] * (y[j][e] * r1 * g[e]);
            *(f32x4*)(F.out + O_Y + (size_t)m * D + c) = x1[j];
            s2 += (x1[j][0] * x1[j][0] + x1[j][1] * x1[j][1]) + (x1[j][2] * x1[j][2] + x1[j][3] * x1[j][3]); }
        const float r2 = rsqrtf(wave_sum(s2) * (1.f / D) + EPS);
        f32x4 hm[4];
#pragma unroll
        for (int j = 0; j < 4; ++j) { const int c = 4 * F.lane + 256 * j;
            const f32x4 g = *(const f32x4*)(F.in[26] + c), sh = *(const f32x4*)(mod1 + c), sc = *(const f32x4*)(mod1 + 1024 + c);
#pragma unroll
            for (int e = 0; e < 4; ++e) hm[j][e] = x1[j][e] * r2 * g[e] * (1.f + sc[e]) + sh[e];
            u32x2 w; w.x = pk2(hm[j][0], hm[j][1]); w.y = pk2(hm[j][2], hm[j][3]); *(u32x2*)(F.XN() + (size_t)m * D + c) = w; }
        float mine = 0.f;
#pragma unroll 1
        for (int q = 0; q < 16; ++q) { float p = 0.f;
#pragma unroll
            for (int j = 0; j < 4; ++j) { const f32x4 w = *(const LAS f32x4*)(baw + q * 1024 + 256 * j + 4 * F.lane); p += (hm[j][0] * w[0] + hm[j][1] * w[1]) + (hm[j][2] * w[2] + hm[j][3] * w[3]); }
            p = wave_sum(p); mine = (F.lane == q) ? p : mine; }
        if (F.lane < 16) F.BA()[(size_t)m * 16 + F.lane] = mine;
    }
}

__device__ __forceinline__ void phase_gdn_prep_naive(Frame& F) {
    const int gw = F.vcu * 8 + F.wave, NGW = F.G * 8;
    for (int idx = gw; idx < MT * 24; idx += NGW) {
        const int m = idx / 24, g = idx % 24, c = g * 128 + 2 * F.lane;
        int s, t; tok_info(m, s, t);
        float u0[4], u1[4];
#pragma unroll
        for (int j = 0; j < 4; ++j) { const int tt = t - 3 + j;
            if (tt >= 0) { const unsigned w = *(const unsigned*)(F.QKV1() + (size_t)(m - 3 + j) * 3072 + c); u0[j] = lo16(w); u1[j] = hi16(w); }
            else if (s >= BP) { const float* cs = F.in[6] + ((size_t)(s - BP) * 3 + (tt + 3)) * 3072 + c; u0[j] = cs[0]; u1[j] = cs[1]; }
            else { u0[j] = 0.f; u1[j] = 0.f; } }
        const float* cw = F.in[29] + c;
        float a0 = cw[0] * u0[0] + cw[3072] * u0[1] + cw[6144] * u0[2] + cw[9216] * u0[3];
        float a1 = cw[1] * u1[0] + cw[3073] * u1[1] + cw[6145] * u1[2] + cw[9217] * u1[3];
        a0 = siluf_(a0); a1 = siluf_(a1);
        if (g < 16) { const float ss = wave_sum(a0 * a0 + a1 * a1); float sc = rsqrtf(ss + EPS); if (g < 8) sc *= 0.08838834764831845f; a0 *= sc; a1 *= sc; }
        *(unsigned*)(F.QKVC() + (size_t)m * 3072 + c) = pk2(a0, a1);
        const int T = seq_len(s);
        if (t >= T - 3) { float* o = s < BP ? F.out + O_GCP + ((size_t)s * 3 + (t - (T - 3))) * 3072 + c : F.out + O_GCS + ((size_t)(s - BP) * 3 + (t - (T - 3))) * 3072 + c; o[0] = u0[3]; o[1] = u1[3]; }
    }
}

__device__ __forceinline__ void phase_gdn_rec_naive(Frame& F) {
    int tid = threadIdx.x; asm volatile("" : "+v"(tid));
    LAS float* kq = (LAS float*)F.lds;
    LAS float* red = kq + 1024;
    LAS float* red2 = red + 512;
    LAS float* misc = red2 + 512;
    const int v = tid & 127, rg = tid >> 7;
    for (int task = F.vcu; task < NSEQ * 8; task += F.G) {
        const int s = task >> 3, h = task & 7, T = seq_len(s), base = seq_base(s);
        float S[32];
        if (s < BP) {
#pragma unroll
            for (int i = 0; i < 32; ++i) S[i] = 0.f;
        } else {
#pragma unroll
            for (int i = 0; i < 32; ++i) S[i] = F.in[7][(((size_t)(s - BP) * 8 + h) * 128 + rg * 32 + i) * 128 + v];
        }
        const float Aexp = __expf(F.in[30][h]), dtb = F.in[31][h], hn = F.in[32][v];
        float nxt = 0.f;
        if (tid < 384) { const int part = tid >> 7; const int col = (part == 0 ? 1024 : part == 1 ? 0 : 2048) + h * 128 + (tid & 127); nxt = bf2f(F.QKVC()[(size_t)base * 3072 + col]); }
        __syncthreads();
        for (int t = 0; t < T; ++t) {
            LAS float* cur = kq + (t & 1) * 384;
            if (tid < 384) cur[tid] = nxt;
            if (tid < 384 && t + 1 < T) { const int part = tid >> 7; const int col = (part == 0 ? 1024 : part == 1 ? 0 : 2048) + h * 128 + (tid & 127); nxt = bf2f(F.QKVC()[(size_t)(base + t + 1) * 3072 + col]); }
            const float bb = F.BA()[(size_t)(base + t) * 16 + h], aa = F.BA()[(size_t)(base + t) * 16 + 8 + h];
            const float zz = bf2f(F.Z1()[(size_t)(base + t) * D + h * 128 + v]);
            const float beta = sigmoidf_(bb), g = -Aexp * softplusf_(aa + dtb), a = __expf(g);
            __syncthreads();
            float part = 0.f;
#pragma unroll
            for (int i = 0; i < 32; ++i) { S[i] *= a; part += cur[rg * 32 + i] * S[i]; }
            red[rg * 128 + v] = part;
            __syncthreads();
            const float kS = (red[v] + red[128 + v]) + (red[256 + v] + red[384 + v]);
            const float dlt = beta * (cur[256 + v] - kS);
            float po = 0.f;
#pragma unroll
            for (int i = 0; i < 32; ++i) { S[i] += cur[rg * 32 + i] * dlt; po += cur[128 + rg * 32 + i] * S[i]; }
            red2[rg * 128 + v] = po;
            __syncthreads();
            if (tid < 128) {
                const float o = (red2[v] + red2[128 + v]) + (red2[256 + v] + red2[384 + v]);
                const float sq = wave_sum(o * o);
                if (F.lane == 0) misc[F.wave] = sq;
                red[v] = o;
            }
            __syncthreads();
            if (tid < 128) {
                const float o = red[v], r = rsqrtf((misc[0] + misc[1]) * (1.f / 128.f) + EPS);
                F.Y1()[(size_t)(base + t) * D + h * 128 + v] = (bf16_t)f2bf(o * r * hn * siluf_(zz));
            }
        }
        float* so = s < BP ? F.out + O_GSP + (((size_t)s * 8 + h) * 128 + rg * 32) * 128 + v : F.out + O_GSS + (((size_t)(s - BP) * 8 + h) * 128 + rg * 32) * 128 + v;
#pragma unroll
        for (int i = 0; i < 32; ++i) so[(size_t)i * 128] = S[i];
        __syncthreads();
    }
}

__device__ __forceinline__ void phase_final_rowwise(Frame& F) {
    const int gw = F.vcu * 8 + F.wave, NGW = F.G * 8;
    for (int m = gw; m < MT; m += NGW) {
        int s, t; tok_info(m, s, t);
        const float* mod1 = F.MOD() + (size_t)(24 + s) * 3072;
        f32x4 y[4]; float ss = 0.f;
#pragma unroll
        for (int j = 0; j < 4; ++j) { const u32x2 w = *(const u32x2*)(F.YO() + (size_t)m * D + 4 * F.lane + 256 * j); y[j] = (f32x4){lo16(w.x), hi16(w.x), lo16(w.y), hi16(w.y)};
            ss += (y[j][0] * y[j][0] + y[j][1] * y[j][1]) + (y[j][2] * y[j][2] + y[j][3] * y[j][3]); }
        const float r1 = rsqrtf(wave_sum(ss) * (1.f / D) + EPS);
#pragma unroll
        for (int j = 0; j < 4; ++j) { const int c = 4 * F.lane + 256 * j;
            float* op = F.out + O_Y + (size_t)m * D + c;
            const f32x4 xv = *(const f32x4*)op, g = *(const f32x4*)(F.in[27] + c), gt = *(const f32x4*)(mod1 + 2048 + c);
            f32x4 o;
#pragma unroll
            for (int e = 0; e < 4; ++e) o[e] = xv[e] + gt[e] * (y[j][e] * r1 * g[e]);
            *(f32x4*)op = o; }
    }
}

__global__ void __launch_bounds__(512, 2) fwd_megakernel(Params P) {
    extern __shared__ __attribute__((aligned(16))) unsigned char lds_raw[];
    cg::grid_group grid = cg::this_grid();
    Frame F;
    F.lds = (LAS unsigned char*)lds_raw;
    F.tid = threadIdx.x; F.lane = F.tid & 63; F.wave = __builtin_amdgcn_readfirstlane(F.tid >> 6);
    F.G = gridDim.x; { const int bx = blockIdx.x; F.vcu = (F.G % 8 == 0) ? (bx % 8) * (F.G / 8) + bx / 8 : bx; }
    F.in = P.in; F.out = P.out; F.ws = P.ws;

    phase_prologue(F);
    grid.sync();
    phase_prenorm0(F);
    grid.sync();
    { pg8::Gemm g{F.XN(), F.W0I(), MT, EV_IN, D}; pg8::StaticOrder S; S.init(MT, EV_IN, F.G, (int)blockIdx.x);
      pg8::EpiBf16 E{F.U0(), EV_IN, 1 << 30, F.U0(), EV_IN}; pg8::gemm_phase(F.lds, g, S, E); }
    grid.sync();
    phase_rope(F);
    phase_lru_naive(F);
    grid.sync();
    phase_attn_naive(F);
    grid.sync();
    { pg8::Gemm g{F.Y0(), F.W0O(), MT, D, D}; pg8::StaticOrder S; S.init(MT, D, F.G, (int)blockIdx.x);
      pg8::EpiBf16 E{F.YO(), D, 1 << 30, F.YO(), D}; pg8::gemm_phase(F.lds, g, S, E); }
    grid.sync();
    phase_mid_rowwise(F);
    grid.sync();
    { pg8::Gemm g{F.XN(), F.W1I(), MT, OD_MAIN, D}; pg8::StaticOrder S; S.init(MT, OD_MAIN, F.G, (int)blockIdx.x);
      pg8::EpiBf16 E{F.QKV1(), 3072, 3072, F.Z1(), D}; pg8::gemm_phase(F.lds, g, S, E); }
    grid.sync();
    phase_gdn_prep_naive(F);
    grid.sync();
    phase_gdn_rec_naive(F);
    grid.sync();
    { pg8::Gemm g{F.Y1(), F.W1O(), MT, D, D}; pg8::StaticOrder S; S.init(MT, D, F.G, (int)blockIdx.x);
      pg8::EpiBf16 E{F.YO(), D, 1 << 30, F.YO(), D}; pg8::gemm_phase(F.lds, g, S, E); }
    grid.sync();
    phase_final_rowwise(F);
}

extern "C" void kernel_launch(void* const* d_in, const int* in_sizes, int n_in, void* d_out, int out_size, void* d_ws, size_t ws_size, hipStream_t stream) {
    static int grid = 0;
    if (grid == 0) {
        if (n_in != 34 || out_size != (int)O_END || ws_size < WS_END) { grid = -1; return; }
        int dev = 0, cus = 0, per_cu = 0;
        if (hipGetDevice(&dev) != hipSuccess || hipDeviceGetAttribute(&cus, hipDeviceAttributeMultiprocessorCount, dev) != hipSuccess) { grid = -1; return; }
        if (hipFuncSetAttribute((const void*)fwd_megakernel, hipFuncAttributeMaxDynamicSharedMemorySize, LDS_BYTES) != hipSuccess) { grid = -1; return; }
        if (hipOccupancyMaxActiveBlocksPerMultiprocessor(&per_cu, (const void*)fwd_megakernel, 512, LDS_BYTES) != hipSuccess || per_cu < 1) { grid = -1; return; }
        grid = cus;
    }
    if (grid < 0) return;
    Params p{};
    for (int i = 0; i < 34; ++i) p.in[i] = (const float*)d_in[i];
    p.out = (float*)d_out; p.ws = (unsigned char*)d_ws;
    void* args[] = {&p};
    (void)hipLaunchCooperativeKernel((const void*)fwd_megakernel, dim3(grid), dim3(512), args, LDS_BYTES, stream);
}
```

```cpp
#include <hip/hip_runtime.h>
#include <hip/hip_cooperative_groups.h>
namespace cg = cooperative_groups;

#define LAS __attribute__((address_space(3)))
typedef unsigned short bf16_t;
typedef short bf16x8 __attribute__((ext_vector_type(8)));
typedef float f32x4 __attribute__((ext_vector_type(4)));
typedef float f32x2 __attribute__((ext_vector_type(2)));
typedef unsigned u32x4 __attribute__((ext_vector_type(4)));
typedef unsigned u32x2 __attribute__((ext_vector_type(2)));

constexpr int D = 1024, BP = 8, TP = 4096, BS = 16, TS = 16;
constexpr int MP = BP * TP, MS = BS * TS, MT = MP + MS;
constexpr int NSEQ = BP + BS;
constexpr int EV_IN = 2304, OD_IN = 4112, OD_MAIN = 4096;
constexpr int C_XA = 0, C_GA = 512, C_Q = 1024, C_K = 1536, C_V = 1664, C_GB = 1792;
constexpr float EPS = 1e-6f;
constexpr size_t O_Y = 0, O_LCP = 33816576, O_LCS = 33828864, O_LHP = 33853440, O_LHS = 33857536, O_KP = 33865728, O_KS = 33996800,
                 O_VP = 34029568, O_VS = 34160640, O_GCP = 34193408, O_GCS = 34267136, O_GSP = 34414592, O_GSS = 35463168, O_END = 37560320;
constexpr size_t MiB = 1u << 20;
constexpr size_t WS_CTL = 0, WS_W1O = 1 * MiB, WS_MOD = 3 * MiB, WS_ROPE = 4 * MiB, WS_BA = 5 * MiB, WS_LAG = 8 * MiB, WS_LGW = 10 * MiB;
constexpr size_t WS_RA = 16 * MiB, RA_BYTES = (size_t)MT * 4096 * 2;
constexpr size_t WS_RB = WS_RA + RA_BYTES;
constexpr size_t ACT_BYTES = (size_t)MT * D * 2;
constexpr size_t RB_XN = 0, RB_Y0 = ACT_BYTES, RB_YO = 2 * ACT_BYTES, RB_W0I = 3 * ACT_BYTES, RB_W0O = RB_W0I + (size_t)EV_IN * D * 2,
                 RB_W1I = RB_W0O + (size_t)D * D * 2, RB_WEND = RB_W1I + (size_t)OD_MAIN * D * 2;
constexpr size_t RB_BYTES = (size_t)4224 * 73728;
constexpr size_t WS_END = WS_RB + RB_BYTES;
static_assert(RB_WEND <= RB_BYTES, "ws map");
static_assert((size_t)MT * 3072 * 2 <= RB_BYTES, "ws map");
constexpr int LDS_BYTES = 155648;

struct Params { const float* in[34]; float* out; unsigned char* ws; };

__device__ __forceinline__ float bf2f(bf16_t b) { return __uint_as_float(((unsigned)b) << 16); }
__device__ __forceinline__ unsigned f2bf(float f) { unsigned u = __float_as_uint(f); return (u + 0x7fffu + ((u >> 16) & 1u)) >> 16; }
__device__ __forceinline__ unsigned pk2(float lo, float hi) { return f2bf(lo) | (f2bf(hi) << 16); }
__device__ __forceinline__ float lo16(unsigned w) { return __uint_as_float(w << 16); }
__device__ __forceinline__ float hi16(unsigned w) { return __uint_as_float(w & 0xffff0000u); }
__device__ __forceinline__ float wave_sum(float v) {
#pragma unroll
    for (int o = 1; o < 64; o <<= 1) v += __shfl_xor(v, o);
    return v;
}
__device__ __forceinline__ float sigmoidf_(float x) { return 1.0f / (1.0f + __expf(-x)); }
__device__ __forceinline__ float siluf_(float x) { return x / (1.0f + __expf(-x)); }
__device__ __forceinline__ float softplusf_(float x) { return x > 20.f ? x : log1pf(__expf(x)); }
__device__ __forceinline__ int seq_base(int s) { return s < BP ? s * TP : MP + (s - BP) * TS; }
__device__ __forceinline__ int seq_len(int s) { return s < BP ? TP : TS; }
__device__ __forceinline__ void tok_info(int m, int& s, int& t) { if (m < MP) { s = m >> 12; t = m & 4095; } else { const int r = m - MP; s = BP + (r >> 4); t = r & 15; } }

namespace pg8 {
constexpr int BM = 256, BK = 64, HALF = 128, HTB = HALF * BK * 2, STAGE_BYTES = 8 * HTB, NXCD = 8, WGM = 8;
__host__ __device__ __forceinline__ int lds_byte(int r, int c) { const int st = (r >> 4) * 2 + (c >> 5), rr = r & 15, cc = c & 31, ob = rr * 64 + cc * 2; return st * 1024 + (ob ^ (((ob >> 9) & 1) << 5)); }
__host__ __device__ __forceinline__ void stage_rc(int b, int& R, int& C) { const int st = b / 1024, sb = b % 1024, swz = sb ^ (((sb >> 9) & 1) << 5); R = (st >> 1) * 16 + swz / 64; C = (st & 1) * 32 + (swz % 64) / 2; }
__host__ __device__ __forceinline__ int perm32(int rho) { const int n = rho >> 4, i = rho & 15; return 8 * (i >> 2) + 4 * n + (i & 3); }
struct Unit { int pm, pn; };
struct Gemm { const bf16_t* A; const bf16_t* Bt; int M, N, K; };
struct StaticOrder {
    int nM, nN, nwg, G, c;
    __device__ void init(int M, int N, int G_, int c_) { nM = M / BM; nN = N / BM; nwg = nM * nN; G = G_; c = c_; }
    __device__ bool next(int i, Unit& u) const {
        const long L = (long)i * G + c; if (L >= nwg) return false;
        int wgid = (int)L; { const int q = nwg / NXCD, r = nwg % NXCD, xcd = wgid % NXCD, off = wgid / NXCD; wgid = (xcd < r ? xcd * (q + 1) : r * (q + 1) + (xcd - r) * q) + off; }
        const int nig = WGM * nN, gid = wgid / nig, fm = gid * WGM, gsz = (nM - fm) < WGM ? (nM - fm) : WGM;
        u.pm = fm + ((wgid % nig) % gsz); u.pn = (wgid % nig) / gsz; return true;
    }
};
__device__ __forceinline__ unsigned cvt_pk_bf16(float lo, float hi) { unsigned r; asm volatile("v_cvt_pk_bf16_f32 %0, %1, %2" : "=v"(r) : "v"(lo), "v"(hi)); return r; }
struct EpiBf16 {
    static constexpr bool PERM = true;
    bf16_t* O0; int ld0; int split; bf16_t* O1; int ld1;
    __device__ __forceinline__ void operator()(const f32x4 (&acc)[2][2][4][2], const Unit& u, int wr, int wc, int fr, int fq) const {
        const int row0 = u.pm * BM + wr * 64 + fr; int colt = u.pn * BM; bf16_t* base = O0; int ld = ld0;
        if (colt >= split) { base = O1; ld = ld1; colt -= split; }
        const int col0 = colt + wc * 32 + 8 * fq;
#pragma unroll
        for (int ai = 0; ai < 2; ++ai)
#pragma unroll
            for (int m = 0; m < 4; ++m) { bf16_t* rowp = base + (size_t)(row0 + ai * HALF + m * 16) * ld + col0;
#pragma unroll
                for (int bj = 0; bj < 2; ++bj) { const f32x4 v0 = acc[ai][bj][m][0], v1 = acc[ai][bj][m][1];
                    u32x4 w; w.x = cvt_pk_bf16(v0[0], v0[1]); w.y = cvt_pk_bf16(v0[2], v0[3]); w.z = cvt_pk_bf16(v1[0], v1[1]); w.w = cvt_pk_bf16(v1[2], v1[3]);
                    *(u32x4*)(rowp + bj * HALF) = w; } }
    }
};
template <class Epi, class Sched>
__device__ __forceinline__ void gemm_phase(LAS unsigned char* lds, const Gemm g, const Sched& S, const Epi& E) {
    int tid = threadIdx.x; asm volatile("" : "+v"(tid));
    const int wid = __builtin_amdgcn_readfirstlane(tid >> 6), lane = tid & 63, wr = wid >> 2, wc = wid & 3, fr = lane & 15, fq = lane >> 4;
    const int K = g.K, nt = K / BK;
    unsigned voffA[2], voffB[2];
#pragma unroll
    for (int i = 0; i < 2; ++i) { int R, C; stage_rc(tid * 16 + i * 8192, R, C); const int Rb = Epi::PERM ? ((R & ~31) + perm32(R & 31)) : R;
        voffA[i] = (unsigned)(R * K + C) * 2u; voffB[i] = (unsigned)(Rb * K + C) * 2u; }
    const size_t kstep = (size_t)(BK * 2);
    const size_t hstep = (size_t)HALF * K * 2;
    const size_t tstep = 2 * hstep;
    const unsigned ldsw = (unsigned)wid * 1024u;
    const int aoff = lds_byte(wr * 64 + fr, fq * 8), boff = lds_byte(wc * 32 + fr, fq * 8);
#define PG8_SA(b, h) (((b) * 2 + (h)) * HTB)
#define PG8_SB(b, h) ((4 + (b) * 2 + (h)) * HTB)
#define PG8_STAGE(bufoff, gbase, voff) do { _Pragma("unroll") for (int _i = 0; _i < 2; ++_i) \
        __builtin_amdgcn_global_load_lds((const unsigned*)((const char*)(gbase) + (voff)[_i]), (LAS unsigned*)(lds + (bufoff) + ldsw + _i * 8192), 16, 0, 0); } while (0)
#define PG8_LDA(dst, b, h) do { _Pragma("unroll") for (int m = 0; m < 4; ++m) _Pragma("unroll") for (int k = 0; k < 2; ++k) dst[m][k] = *(const LAS bf16x8*)(lds + PG8_SA(b, h) + aoff + m * 2048 + k * 1024); } while (0)
#define PG8_LDB(dst, b, h) do { _Pragma("unroll") for (int n = 0; n < 2; ++n) _Pragma("unroll") for (int k = 0; k < 2; ++k) dst[n][k] = *(const LAS bf16x8*)(lds + PG8_SB(b, h) + boff + n * 2048 + k * 1024); } while (0)
#define PG8_MMA(ai, bj, At, Bt) do { __builtin_amdgcn_s_setprio(1); _Pragma("unroll") for (int m = 0; m < 4; ++m) _Pragma("unroll") for (int n = 0; n < 2; ++n) _Pragma("unroll") for (int k = 0; k < 2; ++k) \
        acc[ai][bj][m][n] = __builtin_amdgcn_mfma_f32_16x16x32_bf16(Bt[n][k], At[m][k], acc[ai][bj][m][n], 0, 0, 0); __builtin_amdgcn_s_setprio(0); } while (0)
#define PG8_WAIT_V(n) asm volatile("s_waitcnt vmcnt(" #n ")" ::: "memory")
#define PG8_WAIT_L(n) asm volatile("s_waitcnt lgkmcnt(" #n ")" ::: "memory")
#define PG8_BAR __builtin_amdgcn_s_barrier()
#define PG8_SCHED __builtin_amdgcn_sched_barrier(0)
    Unit cur, nxt; int ui = 0;
    if (!S.next(0, cur)) return;
    f32x4 acc[2][2][4][2];
#pragma unroll
    for (int a = 0; a < 2; ++a)
#pragma unroll
        for (int b = 0; b < 2; ++b)
#pragma unroll
            for (int m = 0; m < 4; ++m)
#pragma unroll
                for (int n = 0; n < 2; ++n) acc[a][b][m][n] = (f32x4){0.f, 0.f, 0.f, 0.f};
    bf16x8 At[4][2], B0[2][2], B1[2][2];
    const char* cA = (const char*)g.A + (size_t)cur.pm * tstep; const char* cB = (const char*)g.Bt + (size_t)cur.pn * tstep;
    PG8_STAGE(PG8_SB(0, 0), cB, voffB); PG8_STAGE(PG8_SA(0, 0), cA, voffA); PG8_STAGE(PG8_SB(0, 1), cB + hstep, voffB); PG8_STAGE(PG8_SA(0, 1), cA + hstep, voffA);
    if (wr == 1) PG8_BAR;
    PG8_WAIT_V(4); PG8_BAR;
    PG8_STAGE(PG8_SB(1, 0), cB + kstep, voffB); PG8_STAGE(PG8_SA(1, 0), cA + kstep, voffA); PG8_STAGE(PG8_SB(1, 1), cB + hstep + kstep, voffB);
    PG8_WAIT_V(6); PG8_BAR;
    for (;;) {
        const bool has_next = S.next(ui + 1, nxt);
        const char* nA = has_next ? (const char*)g.A + (size_t)nxt.pm * tstep : cA; const char* nB = has_next ? (const char*)g.Bt + (size_t)nxt.pn * tstep : cB;
        for (int t = 0; t < nt; t += 2) {
            const bool last = (t == nt - 2);
            const char* a1 = cA + (size_t)(t + 1) * kstep;
            const char* a2 = last ? nA : cA + (size_t)(t + 2) * kstep; const char* b2 = last ? nB : cB + (size_t)(t + 2) * kstep;
            const char* a3 = a2 + kstep; const char* b3 = b2 + kstep;
            PG8_LDB(B0, 0, 0); PG8_SCHED; PG8_LDA(At, 0, 0); PG8_STAGE(PG8_SA(1, 1), a1 + hstep, voffA);
            PG8_WAIT_L(8); PG8_BAR; PG8_WAIT_L(0); PG8_MMA(0, 0, At, B0); PG8_BAR; PG8_SCHED;
            PG8_LDB(B1, 0, 1); PG8_STAGE(PG8_SB(0, 0), b2, voffB);
            PG8_BAR; PG8_WAIT_L(0); PG8_MMA(0, 1, At, B1); PG8_BAR;
            PG8_LDA(At, 0, 1); PG8_STAGE(PG8_SA(0, 0), a2, voffA);
            PG8_BAR; PG8_WAIT_L(0); PG8_MMA(1, 0, At, B0); PG8_BAR; PG8_SCHED;
            PG8_STAGE(PG8_SB(0, 1), b2 + hstep, voffB);
            PG8_WAIT_V(6); PG8_BAR; PG8_MMA(1, 1, At, B1); PG8_BAR;
            PG8_LDB(B0, 1, 0); PG8_SCHED; PG8_LDA(At, 1, 0); PG8_STAGE(PG8_SA(0, 1), a2 + hstep, voffA);
            PG8_WAIT_L(8); PG8_BAR; PG8_WAIT_L(0); PG8_MMA(0, 0, At, B0); PG8_BAR; PG8_SCHED;
            PG8_LDB(B1, 1, 1); PG8_STAGE(PG8_SB(1, 0), b3, voffB);
            PG8_BAR; PG8_WAIT_L(0); PG8_MMA(0, 1, At, B1); PG8_BAR;
            PG8_LDA(At, 1, 1); PG8_STAGE(PG8_SA(1, 0), a3, voffA);
            PG8_BAR; PG8_WAIT_L(0); PG8_MMA(1, 0, At, B0); PG8_BAR; PG8_SCHED;
            PG8_STAGE(PG8_SB(1, 1), b3 + hstep, voffB);
            PG8_WAIT_V(6); PG8_BAR; PG8_MMA(1, 1, At, B1); PG8_BAR;
        }
        E(acc, cur, wr, wc, fr, fq);
        if (!has_next) break;
#pragma unroll
        for (int a = 0; a < 2; ++a)
#pragma unroll
            for (int b = 0; b < 2; ++b)
#pragma unroll
                for (int m = 0; m < 4; ++m)
#pragma unroll
                    for (int n = 0; n < 2; ++n) acc[a][b][m][n] = (f32x4){0.f, 0.f, 0.f, 0.f};
        cur = nxt; cA = nA; cB = nB; ++ui;
    }
    PG8_WAIT_V(0);
    if (wr == 0) PG8_BAR;
    PG8_BAR;
#undef PG8_SA
#undef PG8_SB
#undef PG8_STAGE
#undef PG8_LDA
#undef PG8_LDB
#undef PG8_MMA
#undef PG8_WAIT_V
#undef PG8_WAIT_L
#undef PG8_BAR
#undef PG8_SCHED
}
}

struct Frame {
    LAS unsigned char* lds;
    int tid, lane, wave, vcu, G;
    const float* const* in; float* out; unsigned char* ws;
    __device__ __forceinline__ float* MOD() const { return (float*)(ws + WS_MOD); }
    __device__ __forceinline__ float* ROPE() const { return (float*)(ws + WS_ROPE); }
    __device__ __forceinline__ float* BA() const { return (float*)(ws + WS_BA); }
    __device__ __forceinline__ float* LAG() const { return (float*)(ws + WS_LAG); }
    __device__ __forceinline__ bf16_t* W1O() const { return (bf16_t*)(ws + WS_W1O); }
    __device__ __forceinline__ bf16_t* U0() const { return (bf16_t*)(ws + WS_RA); }
    __device__ __forceinline__ bf16_t* QKV1() const { return (bf16_t*)(ws + WS_RA); }
    __device__ __forceinline__ bf16_t* Z1() const { return (bf16_t*)(ws + WS_RA + (size_t)MT * 3072 * 2); }
    __device__ __forceinline__ bf16_t* Y1() const { return (bf16_t*)(ws + WS_RA); }
    __device__ __forceinline__ bf16_t* XN() const { return (bf16_t*)(ws + WS_RB + RB_XN); }
    __device__ __forceinline__ bf16_t* Y0() const { return (bf16_t*)(ws + WS_RB + RB_Y0); }
    __device__ __forceinline__ bf16_t* YO() const { return (bf16_t*)(ws + WS_RB + RB_YO); }
    __device__ __forceinline__ bf16_t* W0I() const { return (bf16_t*)(ws + WS_RB + RB_W0I); }
    __device__ __forceinline__ bf16_t* W0O() const { return (bf16_t*)(ws + WS_RB + RB_W0O); }
    __device__ __forceinline__ bf16_t* W1I() const { return (bf16_t*)(ws + WS_RB + RB_W1I); }
    __device__ __forceinline__ bf16_t* QKVC() const { return (bf16_t*)(ws + WS_RB); }
};

__device__ __forceinline__ void p0_transpose_item(const float* W, int ldw, int nblk, int K, bf16_t* WT, LAS float* scr, int item, int lane) {
    const int kb = item / nblk, nb = item % nblk, k0 = 64 * kb, n0 = 32 * nb;
#pragma unroll 8
    for (int i = 0; i < 32; ++i) { const int kk = 2 * i + (lane >> 5); scr[kk * 33 + (lane & 31)] = W[(size_t)(k0 + kk) * ldw + n0 + (lane & 31)]; }
    asm volatile("s_waitcnt lgkmcnt(0)" ::: "memory");
    const int c = lane & 7;
#pragma unroll
    for (int j = 0; j < 4; ++j) { const int n = (lane >> 3) + 8 * j; const LAS float* s = scr + (8 * c) * 33 + n;
        u32x4 o; o.x = pk2(s[0 * 33], s[1 * 33]); o.y = pk2(s[2 * 33], s[3 * 33]); o.z = pk2(s[4 * 33], s[5 * 33]); o.w = pk2(s[6 * 33], s[7 * 33]);
        *(u32x4*)(WT + (size_t)(n0 + n) * K + k0 + 8 * c) = o; }
    asm volatile("s_waitcnt lgkmcnt(0)" ::: "memory");
}
__device__ __forceinline__ void phase_prologue(Frame& F) {
    const int gw = F.vcu * 8 + F.wave, NGW = F.G * 8;
    {
        LAS float* scr = (LAS float*)(F.lds + F.wave * 16384);
        constexpr int I0 = 16 * (EV_IN / 32), I1 = 16 * 32, I2 = 16 * (OD_MAIN / 32), I3 = 16 * 32;
        for (int it = gw; it < I0 + I1 + I2 + I3; it += NGW) {
            int r = it;
            if (r < I0) { p0_transpose_item(F.in[14], EV_IN, EV_IN / 32, D, F.W0I(), scr, r, F.lane); continue; } r -= I0;
            if (r < I1) { p0_transpose_item(F.in[23], D, 32, D, F.W0O(), scr, r, F.lane); continue; } r -= I1;
            if (r < I2) { p0_transpose_item(F.in[28], OD_IN, OD_MAIN / 32, D, F.W1I(), scr, r, F.lane); continue; } r -= I2;
            p0_transpose_item(F.in[33], D, 32, D, F.W1O(), scr, r, F.lane);
        }
    }
    {
        const double inv[8] = {1.0, 0.19392274474868576, 0.03760603093086393, 0.007292664737217109, 0.001414213562373095, 0.0002742481756762073, 5.318295896944988e-05, 1.031338537721246e-05};
        for (int idx = F.vcu * 512 + F.tid; idx < 4112 * 8; idx += F.G * 512) {
            const int pos = idx >> 3, i = idx & 7;
            double iv = inv[0];
#pragma unroll
            for (int q = 1; q < 8; ++q) iv = (i == q) ? inv[q] : iv;
            const double ang = (double)pos * iv;
            const double n = __builtin_rint(ang * 0.15915494309189535);
            const float r = (float)__builtin_fma(-n, 6.283185307179586, ang);
            F.ROPE()[pos * 16 + i] = __cosf(r); F.ROPE()[pos * 16 + 8 + i] = __sinf(r);
        }
    }
    __syncthreads();
    for (int bt = F.vcu; bt < 96; bt += F.G) {
        LAS float* tab = (LAS float*)F.lds;
        for (int idx = F.tid; idx < 24 * 1024; idx += 512) { const int s = idx >> 10, k = idx & 1023;
            const float c = s < BP ? F.in[8][s * D + k] : F.in[9][(s - BP) * D + k]; tab[k * 24 + s] = siluf_(c); }
        __syncthreads();
        const int L = bt / 48, n0 = (bt % 48) * 64;
        const float* mw = (L == 0 ? F.in[10] : F.in[24]) + n0 + F.lane;
        float acc[24];
#pragma unroll
        for (int r = 0; r < 24; ++r) acc[r] = 0.f;
        for (int k = F.wave * 128; k < F.wave * 128 + 128; ++k) {
            const float w = mw[(size_t)k * 3072];
            const LAS f32x4* tp = (const LAS f32x4*)(tab + k * 24);
#pragma unroll
            for (int q = 0; q < 6; ++q) { const f32x4 t4 = tp[q]; acc[4 * q] += t4[0] * w; acc[4 * q + 1] += t4[1] * w; acc[4 * q + 2] += t4[2] * w; acc[4 * q + 3] += t4[3] * w; }
        }
        __syncthreads();
        LAS float* red = (LAS float*)F.lds;
#pragma unroll
        for (int r = 0; r < 24; ++r) red[(F.wave * 24 + r) * 64 + F.lane] = acc[r];
        __syncthreads();
        const float* mb = (L == 0 ? F.in[11] : F.in[25]);
        for (int idx = F.tid; idx < 24 * 64; idx += 512) { const int r = idx >> 6, l = idx & 63; float s = 0.f;
#pragma unroll
            for (int w = 0; w < 8; ++w) s += red[(w * 24 + r) * 64 + l];
            F.MOD()[((size_t)L * 24 + r) * 3072 + n0 + l] = s + mb[n0 + l]; }
        __syncthreads();
    }
}

__device__ __forceinline__ void phase_prenorm0(Frame& F) {
    const int gw = F.vcu * 8 + F.wave, NGW = F.G * 8;
    for (int m = gw; m < MT; m += NGW) {
        int s, t; tok_info(m, s, t);
        const float* xrow = m < MP ? F.in[0] + (size_t)m * D : F.in[1] + (size_t)(m - MP) * D;
        const float* modr = F.MOD() + (size_t)s * 3072;
        f32x4 v[4]; float ss = 0.f;
#pragma unroll
        for (int j = 0; j < 4; ++j) { v[j] = *(const f32x4*)(xrow + 4 * F.lane + 256 * j); ss += (v[j][0] * v[j][0] + v[j][1] * v[j][1]) + (v[j][2] * v[j][2] + v[j][3] * v[j][3]); }
        const float r = rsqrtf(wave_sum(ss) * (1.f / D) + EPS);
#pragma unroll
        for (int j = 0; j < 4; ++j) { const int c = 4 * F.lane + 256 * j;
            const f32x4 g = *(const f32x4*)(F.in[12] + c), sh = *(const f32x4*)(modr + c), sc = *(const f32x4*)(modr + 1024 + c);
            f32x4 o;
#pragma unroll
            for (int e = 0; e < 4; ++e) o[e] = v[j][e] * r * g[e] * (1.f + sc[e]) + sh[e];
            u32x2 w; w.x = pk2(o[0], o[1]); w.y = pk2(o[2], o[3]); *(u32x2*)(F.XN() + (size_t)m * D + c) = w; }
    }
}

__device__ __forceinline__ void phase_rope(Frame& F) {
    const int gt = F.vcu * 512 + F.tid, NT = F.G * 512;
    for (int idx = gt; idx < MT * 80; idx += NT) {
        const int m = idx / 80, r = idx % 80, slot = r >> 3, i = r & 7;
        int s, t; tok_info(m, s, t);
        const int pos = s < BP ? t : TP + t;
        const int col = slot < 8 ? C_Q + slot * 64 : C_K + (slot - 8) * 64;
        bf16_t* p = F.U0() + (size_t)m * EV_IN + col;
        const float x1 = bf2f(p[i]), x2 = bf2f(p[8 + i]), c = F.ROPE()[pos * 16 + i], sn = F.ROPE()[pos * 16 + 8 + i];
        const float o1 = x1 * c - x2 * sn, o2 = x2 * c + x1 * sn;
        p[i] = (bf16_t)f2bf(o1); p[8 + i] = (bf16_t)f2bf(o2);
        if (slot >= 8) { const int kv = slot - 8;
            if (s >= BP) { float* o = F.out + O_KS + ((size_t)((s - BP) * TS + t) * 2 + kv) * 64; o[i] = o1; o[8 + i] = o2; }
            else if (t >= TP - 128) { float* o = F.out + O_KP + ((size_t)(s * 128 + (t - (TP - 128))) * 2 + kv) * 64; o[i] = o1; o[8 + i] = o2; } }
    }
    for (int idx = gt; idx < 1280 * 224; idx += NT) {
        const int tk = idx / 224, e = idx % 224;
        int s, t, m; if (tk < 1024) { s = tk >> 7; t = TP - 128 + (tk & 127); m = s * TP + t; } else { s = BP + ((tk - 1024) >> 4); t = (tk - 1024) & 15; m = MP + (tk - 1024); }
        const bool isv = e >= 96; const int e2 = isv ? e - 96 : e; const int kv = isv ? (e2 >> 6) : (e2 / 48), d = isv ? (e2 & 63) : 16 + (e2 % 48);
        const float val = bf2f(F.U0()[(size_t)m * EV_IN + (isv ? C_V : C_K) + kv * 64 + d]);
        const size_t ob = s >= BP ? (isv ? O_VS : O_KS) + ((size_t)((s - BP) * TS + t) * 2 + kv) * 64 : (isv ? O_VP : O_KP) + ((size_t)(s * 128 + (t - (TP - 128))) * 2 + kv) * 64;
        F.out[ob + d] = val;
    }
}

__device__ __forceinline__ void phase_lru_naive(Frame& F) {
    const int gw = F.vcu * 8 + F.wave, NGW = F.G * 8;
    for (int task = gw; task < NSEQ * 8; task += NGW) {
        const int s = task >> 3, h = task & 7, ch = h * 64 + F.lane, T = seq_len(s), base = seq_base(s);
        float wa[64], wx[64];
#pragma unroll
        for (int i = 0; i < 64; ++i) { wa[i] = F.in[17][(h * 64 + i) * 64 + F.lane]; wx[i] = F.in[19][(h * 64 + i) * 64 + F.lane]; }
        const float cw0 = F.in[15][ch], cw1 = F.in[15][512 + ch], cw2 = F.in[15][1024 + ch], cw3 = F.in[15][1536 + ch], cb = F.in[16][ch];
        const float ba = F.in[18][ch], bx = F.in[20][ch], sp = softplusf_(-F.in[21][ch]);
        float x3 = 0.f, x2 = 0.f, x1 = 0.f, hh = 0.f;
        if (s >= BP) { const float* cs = F.in[2] + (size_t)(s - BP) * 3 * 512; x3 = cs[ch]; x2 = cs[512 + ch]; x1 = cs[1024 + ch]; hh = F.in[3][(s - BP) * 512 + ch]; }
        for (int t0 = 0; t0 < T; t0 += 16) {
            float xa[16], ga[16];
#pragma unroll
            for (int j = 0; j < 16; ++j) { const bf16_t* p = F.U0() + (size_t)(base + t0 + j) * EV_IN; xa[j] = bf2f(p[C_XA + ch]); ga[j] = bf2f(p[C_GA + ch]); }
#pragma unroll
            for (int j = 0; j < 16; ++j) {
                const float xc = cw0 * x3 + cw1 * x2 + cw2 * x1 + cw3 * xa[j] + cb;
                x3 = x2; x2 = x1; x1 = xa[j];
                float za = ba, zx = bx;
#pragma unroll
                for (int i = 0; i < 64; ++i) { const float xi = __uint_as_float(__builtin_amdgcn_readlane(__float_as_uint(xc), i)); za += xi * wa[i]; zx += xi * wx[i]; }
                const float r = sigmoidf_(za), ig = sigmoidf_(zx), la = -8.0f * r * sp, a = __expf(la);
                const float gx = sqrtf(-expm1f(2.0f * la)) * (ig * xc);
                hh = a * hh + gx;
                F.Y0()[(size_t)(base + t0 + j) * D + ch] = (bf16_t)f2bf(hh * siluf_(ga[j]));
            }
        }
        if (s < BP) { F.out[O_LHP + s * 512 + ch] = hh; float* o = F.out + O_LCP + (size_t)s * 3 * 512; o[ch] = x3; o[512 + ch] = x2; o[1024 + ch] = x1; }
        else { F.out[O_LHS + (s - BP) * 512 + ch] = hh; float* o = F.out + O_LCS + (size_t)(s - BP) * 3 * 512; o[ch] = x3; o[512 + ch] = x2; o[1024 + ch] = x1; }
    }
}

__device__ __forceinline__ void phase_attn_naive(Frame& F) {
    const int gt = F.vcu * 512 + F.tid, NT = F.G * 512;
    for (int idx = gt; idx < MT * 8; idx += NT) {
        const int hq = idx / MT, m = idx % MT, kv = hq >> 2;
        int s, t; tok_info(m, s, t);
        unsigned qp[32]; float o[64];
        { const u32x4* qq = (const u32x4*)(F.U0() + (size_t)m * EV_IN + C_Q + hq * 64);
#pragma unroll
          for (int c = 0; c < 8; ++c) { const u32x4 w = qq[c];
#pragma unroll
              for (int e = 0; e < 4; ++e) qp[c * 4 + e] = pk2(lo16(w[e]) * 0.125f, hi16(w[e]) * 0.125f); } }
#pragma unroll
        for (int d = 0; d < 64; ++d) o[d] = 0.f;
        float mx = F.in[22][hq], l = 1.0f;
        int nkeys, p0 = 0;
        if (s < BP) { const int c0 = (t >> 6) * 64; p0 = c0 - 128 < 0 ? 0 : c0 - 128; nkeys = c0 + 64 - p0; } else nkeys = 128 + TS;
        for (int j = 0; j < nkeys; ++j) {
            float sc = 0.f;
            const bool cached = (s >= BP && j < 128);
            const int mk = s < BP ? s * TP + p0 + j : seq_base(s) + (j - 128);
            const float* kpf = F.in[4] + ((size_t)((s - BP) * 128 + j) * 2 + kv) * 64; const float* vpf = F.in[5] + ((size_t)((s - BP) * 128 + j) * 2 + kv) * 64;
            const bf16_t* kpb = F.U0() + (size_t)mk * EV_IN + C_K + kv * 64; const bf16_t* vpb = F.U0() + (size_t)mk * EV_IN + C_V + kv * 64;
            if (cached) {
#pragma unroll
                for (int c = 0; c < 16; ++c) { const f32x4 a = *(const f32x4*)(kpf + 4 * c); sc += (lo16(qp[2 * c]) * a[0] + hi16(qp[2 * c]) * a[1]) + (lo16(qp[2 * c + 1]) * a[2] + hi16(qp[2 * c + 1]) * a[3]); }
            } else {
#pragma unroll
                for (int c = 0; c < 8; ++c) { const u32x4 a = *(const u32x4*)(kpb + 8 * c);
#pragma unroll
                    for (int e = 0; e < 4; ++e) sc += lo16(qp[c * 4 + e]) * lo16(a[e]) + hi16(qp[c * 4 + e]) * hi16(a[e]); }
            }
            const float mn = fmaxf(mx, sc), alpha = __expf(mx - mn), p = __expf(sc - mn);
            l = l * alpha + p; mx = mn;
            if (cached) {
#pragma unroll
                for (int c = 0; c < 16; ++c) { const f32x4 b = *(const f32x4*)(vpf + 4 * c);
#pragma unroll
                    for (int e = 0; e < 4; ++e) o[4 * c + e] = o[4 * c + e] * alpha + p * b[e]; }
            } else {
#pragma unroll
                for (int c = 0; c < 8; ++c) { const u32x4 b = *(const u32x4*)(vpb + 8 * c);
#pragma unroll
                    for (int e = 0; e < 4; ++e) { o[c * 8 + 2 * e] = o[c * 8 + 2 * e] * alpha + p * lo16(b[e]); o[c * 8 + 2 * e + 1] = o[c * 8 + 2 * e + 1] * alpha + p * hi16(b[e]); } }
            }
        }
        const float il = 1.0f / l;
        const u32x4* gp = (const u32x4*)(F.U0() + (size_t)m * EV_IN + C_GB + hq * 64);
        u32x4* yp = (u32x4*)(F.Y0() + (size_t)m * D + 512 + hq * 64);
#pragma unroll
        for (int c = 0; c < 8; ++c) { const u32x4 g = gp[c]; u32x4 w;
#pragma unroll
            for (int e = 0; e < 4; ++e) w[e] = pk2(o[c * 8 + 2 * e] * il * siluf_(lo16(g[e])), o[c * 8 + 2 * e + 1] * il * siluf_(hi16(g[e])));
            yp[c] = w; }
    }
}

__device__ __forceinline__ void phase_mid_rowwise(Frame& F) {
    LAS float* baw = (LAS float*)F.lds;
    for (int idx = F.tid; idx < 16 * 1024; idx += 512) { const int j = idx & 15, k = idx >> 4; baw[j * 1024 + k] = F.in[28][(size_t)k * OD_IN + OD_MAIN + j]; }
    __syncthreads();
    const int gw = F.vcu * 8 + F.wave, NGW = F.G * 8;
    for (int m = gw; m < MT; m += NGW) {
        int s, t; tok_info(m, s, t);
        const float* xrow = m < MP ? F.in[0] + (size_t)m * D : F.in[1] + (size_t)(m - MP) * D;
        const float* mod0 = F.MOD() + (size_t)s * 3072; const float* mod1 = F.MOD() + (size_t)(24 + s) * 3072;
        f32x4 y[4]; float ss = 0.f;
#pragma unroll
        for (int j = 0; j < 4; ++j) { const u32x2 w = *(const u32x2*)(F.YO() + (size_t)m * D + 4 * F.lane + 256 * j); y[j] = (f32x4){lo16(w.x), hi16(w.x), lo16(w.y), hi16(w.y)};
            ss += (y[j][0] * y[j][0] + y[j][1] * y[j][1]) + (y[j][2] * y[j][2] + y[j][3] * y[j][3]); }
        const float r1 = rsqrtf(wave_sum(ss) * (1.f / D) + EPS);
        f32x4 x1[4]; float s2 = 0.f;
#pragma unroll
        for (int j = 0; j < 4; ++j) { const int c = 4 * F.lane + 256 * j;
            const f32x4 xv = *(const f32x4*)(xrow + c), g = *(const f32x4*)(F.in[13] + c), gt = *(const f32x4*)(mod0 + 2048 + c);
#pragma unroll
            for (int e = 0; e < 4; ++e) x1[j][e] = xv[e] + gt[e] * (y[j][e] * r1 * g[e]);
            *(f32x4*)(F.out + O_Y + (size_t)m * D + c) = x1[j];
            s2 += (x1[j][0] * x1[j][0] + x1[j][1] * x1[j][1]) + (x1[j][2] * x1[j][2] + x1[j][3] * x1[j][3]); }
        const float r2 = rsqrtf(wave_sum(s2) * (1.f / D) + EPS);
        f32x4 hm[4];
#pragma unroll
        for (int j = 0; j < 4; ++j) { const int c = 4 * F.lane + 256 * j;
            const f32x4 g = *(const f32x4*)(F.in[26] + c), sh = *(const f32x4*)(mod1 + c), sc = *(const f32x4*)(mod1 + 1024 + c);
#pragma unroll
            for (int e = 0; e < 4; ++e) hm[j][e] = x1[j][e] * r2 * g[e] * (1.f + sc[e]) + sh[e];
            u32x2 w; w.x = pk2(hm[j][0], hm[j][1]); w.y = pk2(hm[j][2], hm[j][3]); *(u32x2*)(F.XN() + (size_t)m * D + c) = w; }
        float mine = 0.f;
#pragma unroll 1
        for (int q = 0; q < 16; ++q) { float p = 0.f;
#pragma unroll
            for (int j = 0; j < 4; ++j) { const f32x4 w = *(const LAS f32x4*)(baw + q * 1024 + 256 * j + 4 * F.lane); p += (hm[j][0] * w[0] + hm[j][1] * w[1]) + (hm[j][2] * w[2] + hm[j][3] * w[3]); }
            p = wave_sum(p); mine = (F.lane == q) ? p : mine; }
        if (F.lane < 16) F.BA()[(size_t)m * 16 + F.lane] = mine;
    }
}

__device__ __forceinline__ void phase_gdn_prep_naive(Frame& F) {
    const int gw = F.vcu * 8 + F.wave, NGW = F.G * 8;
    for (int idx = gw; idx < MT * 24; idx += NGW) {
        const int m = idx / 24, g = idx % 24, c = g * 128 + 2 * F.lane;
        int s, t; tok_info(m, s, t);
        float u0[4], u1[4];
#pragma unroll
        for (int j = 0; j < 4; ++j) { const int tt = t - 3 + j;
            if (tt >= 0) { const unsigned w = *(const unsigned*)(F.QKV1() + (size_t)(m - 3 + j) * 3072 + c); u0[j] = lo16(w); u1[j] = hi16(w); }
            else if (s >= BP) { const float* cs = F.in[6] + ((size_t)(s - BP) * 3 + (tt + 3)) * 3072 + c; u0[j] = cs[0]; u1[j] = cs[1]; }
            else { u0[j] = 0.f; u1[j] = 0.f; } }
        const float* cw = F.in[29] + c;
        float a0 = cw[0] * u0[0] + cw[3072] * u0[1] + cw[6144] * u0[2] + cw[9216] * u0[3];
        float a1 = cw[1] * u1[0] + cw[3073] * u1[1] + cw[6145] * u1[2] + cw[9217] * u1[3];
        a0 = siluf_(a0); a1 = siluf_(a1);
        if (g < 16) { const float ss = wave_sum(a0 * a0 + a1 * a1); float sc = rsqrtf(ss + EPS); if (g < 8) sc *= 0.08838834764831845f; a0 *= sc; a1 *= sc; }
        *(unsigned*)(F.QKVC() + (size_t)m * 3072 + c) = pk2(a0, a1);
        const int T = seq_len(s);
        if (t >= T - 3) { float* o = s < BP ? F.out + O_GCP + ((size_t)s * 3 + (t - (T - 3))) * 3072 + c : F.out + O_GCS + ((size_t)(s - BP) * 3 + (t - (T - 3))) * 3072 + c; o[0] = u0[3]; o[1] = u1[3]; }
    }
}

__device__ __forceinline__ void phase_gdn_rec_naive(Frame& F) {
    int tid = threadIdx.x; asm volatile("" : "+v"(tid));
    LAS float* kq = (LAS float*)F.lds;
    LAS float* red = kq + 1024;
    LAS float* red2 = red + 512;
    LAS float* misc = red2 + 512;
    const int v = tid & 127, rg = tid >> 7;
    for (int task = F.vcu; task < NSEQ * 8; task += F.G) {
        const int s = task >> 3, h = task & 7, T = seq_len(s), base = seq_base(s);
        float S[32];
        if (s < BP) {
#pragma unroll
            for (int i = 0; i < 32; ++i) S[i] = 0.f;
        } else {
#pragma unroll
            for (int i = 0; i < 32; ++i) S[i] = F.in[7][(((size_t)(s - BP) * 8 + h) * 128 + rg * 32 + i) * 128 + v];
        }
        const float Aexp = __expf(F.in[30][h]), dtb = F.in[31][h], hn = F.in[32][v];
        float nxt = 0.f;
        if (tid < 384) { const int part = tid >> 7; const int col = (part == 0 ? 1024 : part == 1 ? 0 : 2048) + h * 128 + (tid & 127); nxt = bf2f(F.QKVC()[(size_t)base * 3072 + col]); }
        __syncthreads();
        for (int t = 0; t < T; ++t) {
            LAS float* cur = kq + (t & 1) * 384;
            if (tid < 384) cur[tid] = nxt;
            if (tid < 384 && t + 1 < T) { const int part = tid >> 7; const int col = (part == 0 ? 1024 : part == 1 ? 0 : 2048) + h * 128 + (tid & 127); nxt = bf2f(F.QKVC()[(size_t)(base + t + 1) * 3072 + col]); }
            const float bb = F.BA()[(size_t)(base + t) * 16 + h], aa = F.BA()[(size_t)(base + t) * 16 + 8 + h];
            const float zz = bf2f(F.Z1()[(size_t)(base + t) * D + h * 128 + v]);
            const float beta = sigmoidf_(bb), g = -Aexp * softplusf_(aa + dtb), a = __expf(g);
            __syncthreads();
            float part = 0.f;
#pragma unroll
            for (int i = 0; i < 32; ++i) { S[i] *= a; part += cur[rg * 32 + i] * S[i]; }
            red[rg * 128 + v] = part;
            __syncthreads();
            const float kS = (red[v] + red[128 + v]) + (red[256 + v] + red[384 + v]);
            const float dlt = beta * (cur[256 + v] - kS);
            float po = 0.f;
#pragma unroll
            for (int i = 0; i < 32; ++i) { S[i] += cur[rg * 32 + i] * dlt; po += cur[128 + rg * 32 + i] * S[i]; }
            red2[rg * 128 + v] = po;
            __syncthreads();
            if (tid < 128) {
                const float o = (red2[v] + red2[128 + v]) + (red2[256 + v] + red2[384 + v]);
                const float sq = wave_sum(o * o);
                if (F.lane == 0) misc[F.wave] = sq;
                red[v] = o;
            }
            __syncthreads();
            if (tid < 128) {
                const float o = red[v], r = rsqrtf((misc[0] + misc[1]) * (1.f / 128.f) + EPS);
                F.Y1()[(size_t)(base + t) * D + h * 128 + v] = (bf16_t)f2bf(o * r * hn * siluf_(zz));
            }
        }
        float* so = s < BP ? F.out + O_GSP + (((size_t)s * 8 + h) * 128 + rg * 32) * 128 + v : F.out + O_GSS + (((size_t)(s - BP) * 8 + h) * 128 + rg * 32) * 128 + v;
#pragma unroll
        for (int i = 0; i < 32; ++i) so[(size_t)i * 128] = S[i];
        __syncthreads();
    }
}

typedef float f32x16 __attribute__((ext_vector_type(16)));
typedef __bf16 bf16x2_t __attribute__((ext_vector_type(2)));
constexpr int GS_WF = 0, GS_QF = 16384, GS_KF = 32768, GS_PF = 49152, GS_UF = 57344, GS_BYTES = 73728;
constexpr size_t WS_DEC = 11 * MiB;
__device__ __forceinline__ unsigned cvt2(float a, float b) { f32x2 v = {a, b}; bf16x2_t r = __builtin_convertvector(v, bf16x2_t); return __builtin_bit_cast(unsigned, r); }
__device__ __forceinline__ int krow(int s, int h, int j) { return 16 * s + 8 * (j >> 2) + 4 * h + (j & 3); }
#define MFMA32(a, b, c) __builtin_amdgcn_mfma_f32_32x32x16_bf16((a), (b), (c), 0, 0, 0)

constexpr int G1_QS = 0, G1_KS = 17408, G1_VS = 34816, G1_AS = 52224, G1_PS = 69632, G1_WS = 78848, G1_CW = 96256, G1_VEC = 102400;
__device__ __forceinline__ void phase_gdn_g1(Frame& F) {
    int tid = threadIdx.x; asm volatile("" : "+v"(tid));
    const int lane = tid & 63, wave = __builtin_amdgcn_readfirstlane(tid >> 6);
    LAS unsigned char* L = F.lds;
    LAS float* cw_s = (LAS float*)(L + G1_CW);
    LAS float* beta_s = (LAS float*)(L + G1_VEC); LAS float* gcum_s = beta_s + 64; LAS float* eg_s = beta_s + 128; LAS float* ek_s = beta_s + 192;
    float* DEC = (float*)(F.ws + WS_DEC);
    for (int task = F.vcu; task < 4224; task += F.G) {
        int s, c, h; if (task < 4096) { s = task >> 9; c = (task >> 3) & 63; h = task & 7; } else { s = BP + ((task - 4096) >> 3); c = 0; h = task & 7; }
        const int nvalid = s < BP ? 64 : TS, t0 = c * 64, base = seq_base(s), T = seq_len(s);
        unsigned char* blk = F.ws + WS_RB + (size_t)task * GS_BYTES;
        for (int i = tid; i < 4 * 384; i += 512) { const int jj = i / 384, cc = i % 384; cw_s[i] = F.in[29][(size_t)jj * 3072 + (cc >> 7) * 1024 + h * 128 + (cc & 127)]; }
        if (tid < 64) {
            const bool ok = tid < nvalid; float beta = 0.f, g = 0.f;
            if (ok) { const float* ba = F.BA() + (size_t)(base + t0 + tid) * 16; beta = sigmoidf_(ba[h]); g = -__expf(F.in[30][h]) * softplusf_(ba[8 + h] + F.in[31][h]); }
            float x = g;
#pragma unroll
            for (int o = 1; o < 64; o <<= 1) { const float y = __shfl_up(x, o); if (lane >= o) x += y; }
            const float gl = __shfl(x, 63);
            beta_s[tid] = beta; gcum_s[tid] = x; eg_s[tid] = __expf(x); ek_s[tid] = ok ? __expf(gl - x) : 0.f;
            if (tid == 0) DEC[task] = __expf(gl);
        }
        __syncthreads();
        {
            int t1 = tid; asm volatile("" : "+v"(t1));
            const int r = t1 >> 3, j = t1 & 7, t = t0 + r; const bool ok = r < nvalid;
#pragma unroll 1
            for (int p = 0; p < 3; ++p) {
                float acc[16];
#pragma unroll
                for (int e = 0; e < 16; ++e) acc[e] = 0.f;
                float cur[16];
#pragma unroll
                for (int e = 0; e < 16; ++e) cur[e] = 0.f;
                if (ok) {
                    const int cb = p * 1024 + h * 128 + j * 16;
#pragma unroll
                    for (int jj = 0; jj < 4; ++jj) {
                        const int tt = t - 3 + jj; float x[16];
                        if (tt >= 0) { const u32x4* src = (const u32x4*)(F.QKV1() + (size_t)(base + tt) * 3072 + cb); const u32x4 a = src[0], b = src[1];
#pragma unroll
                            for (int e = 0; e < 4; ++e) { x[2 * e] = lo16(a[e]); x[2 * e + 1] = hi16(a[e]); x[8 + 2 * e] = lo16(b[e]); x[8 + 2 * e + 1] = hi16(b[e]); } }
                        else if (s >= BP) { const f32x4* src = (const f32x4*)(F.in[6] + ((size_t)(s - BP) * 3 + (tt + 3)) * 3072 + cb);
#pragma unroll
                            for (int q = 0; q < 4; ++q) { const f32x4 a = src[q]; x[4 * q] = a[0]; x[4 * q + 1] = a[1]; x[4 * q + 2] = a[2]; x[4 * q + 3] = a[3]; } }
                        else {
#pragma unroll
                            for (int e = 0; e < 16; ++e) x[e] = 0.f; }
                        const LAS f32x4* wp = (const LAS f32x4*)(cw_s + jj * 384 + p * 128 + j * 16);
#pragma unroll
                        for (int q = 0; q < 4; ++q) { const f32x4 w4 = wp[q]; acc[4 * q] += w4[0] * x[4 * q]; acc[4 * q + 1] += w4[1] * x[4 * q + 1]; acc[4 * q + 2] += w4[2] * x[4 * q + 2]; acc[4 * q + 3] += w4[3] * x[4 * q + 3]; }
                        if (jj == 3) {
#pragma unroll
                            for (int e = 0; e < 16; ++e) cur[e] = x[e]; }
                    }
                    if (t >= T - 3) {
                        float* o = (s < BP ? F.out + O_GCP + ((size_t)s * 3 + (t - (T - 3))) * 3072 : F.out + O_GCS + ((size_t)(s - BP) * 3 + (t - (T - 3))) * 3072) + cb;
#pragma unroll
                        for (int q = 0; q < 4; ++q) *(f32x4*)(o + 4 * q) = (f32x4){cur[4 * q], cur[4 * q + 1], cur[4 * q + 2], cur[4 * q + 3]};
                    }
                }
                float ss = 0.f;
#pragma unroll
                for (int e = 0; e < 16; ++e) { acc[e] = siluf_(acc[e]); ss += acc[e] * acc[e]; }
                if (p < 2) { ss += __shfl_xor(ss, 1); ss += __shfl_xor(ss, 2); ss += __shfl_xor(ss, 4);
                    float sc = rsqrtf(ss + EPS); if (p == 0) sc *= 0.08838834764831845f;
#pragma unroll
                    for (int e = 0; e < 16; ++e) acc[e] *= sc; }
                u32x4 w0, w1;
#pragma unroll
                for (int e = 0; e < 4; ++e) { w0[e] = ok ? cvt2(acc[2 * e], acc[2 * e + 1]) : 0u; w1[e] = ok ? cvt2(acc[8 + 2 * e], acc[8 + 2 * e + 1]) : 0u; }
                LAS u32x4* dst = (LAS u32x4*)(L + (p == 0 ? G1_QS : p == 1 ? G1_KS : G1_VS) + r * 272 + j * 32);
                dst[0] = w0; dst[1] = w1;
            }
        }
        __syncthreads();
        {
            int l2 = lane; asm volatile("" : "+v"(l2));
            const int which = wave >> 2, ti = (wave >> 1) & 1, tj = wave & 1, r = l2 & 31, hh = l2 >> 5;
            f32x16 acc;
#pragma unroll
            for (int e = 0; e < 16; ++e) acc[e] = 0.f;
            if (!(ti == 0 && tj == 1)) {
                const LAS unsigned char* ap = L + (which ? G1_QS : G1_KS) + (32 * ti + r) * 272 + hh * 16;
                const LAS unsigned char* bp = L + G1_KS + (32 * tj + r) * 272 + hh * 16;
#pragma unroll
                for (int ks = 0; ks < 8; ++ks) { const bf16x8 a = *(const LAS bf16x8*)(ap + ks * 32), b = *(const LAS bf16x8*)(bp + ks * 32); acc = MFMA32(a, b, acc); }
            }
            const int jc = 32 * tj + r; const float gj = gcum_s[jc];
#pragma unroll
            for (int e = 0; e < 16; ++e) {
                const int i = 32 * ti + (e & 3) + 8 * (e >> 2) + 4 * hh; const float dg = gcum_s[i] - gj;
                if (which == 0) { const float f = (i > jc) ? __expf(dg) * beta_s[i] : 0.f; *(LAS float*)(L + G1_AS + i * 272 + jc * 4) = acc[e] * f; }
                else { const float f = (i >= jc) ? __expf(dg) : 0.f; *(LAS bf16_t*)(L + G1_PS + i * 144 + jc * 2) = (bf16_t)(cvt2(acc[e] * f, 0.f) & 0xffffu); }
            }
        }
        __syncthreads();
        if (tid < 256) {
            int t3 = tid; asm volatile("" : "+v"(t3));
            const bool isw = t3 < 128; const int d = t3 & 127;
            float X[64];
#pragma unroll
            for (int i = 0; i < 64; ++i) { const float raw = bf2f(*(const LAS bf16_t*)(L + (isw ? G1_KS : G1_VS) + i * 272 + d * 2)); X[i] = raw * beta_s[i] * (isw ? eg_s[i] : 1.0f); }
            unsigned abase = (unsigned)(size_t)(L + G1_AS);
#pragma unroll
            for (int i = 1; i < 64; ++i) {
                unsigned ra = abase + i * 272;
                if (i >= 3) asm volatile("" : "+v"(ra) : "v"(X[i - 2]));
                float a = X[i];
#pragma unroll
                for (int j4 = 0; j4 <= (i - 1) / 4; ++j4) { const f32x4 a4 = *(const LAS f32x4*)(ra + j4 * 16);
                    a -= a4[0] * X[4 * j4]; a -= a4[1] * X[4 * j4 + 1]; a -= a4[2] * X[4 * j4 + 2]; a -= a4[3] * X[4 * j4 + 3]; }
                X[i] = a;
            }
            if (isw) {
#pragma unroll
                for (int i = 0; i < 64; ++i) *(LAS bf16_t*)(L + G1_WS + i * 272 + d * 2) = (bf16_t)(cvt2(-X[i], 0.f) & 0xffffu);
            } else {
                const int ws = d >> 5, cc = d & 31;
#pragma unroll
                for (int rt = 0; rt < 2; ++rt)
#pragma unroll
                    for (int hh = 0; hh < 2; ++hh) { u32x4 o0, o1;
#pragma unroll
                        for (int q = 0; q < 2; ++q) { const int i0 = 32 * rt + 8 * q + 4 * hh, i1 = 32 * rt + 8 * (q + 2) + 4 * hh;
                            o0[2 * q] = cvt2(X[i0], X[i0 + 1]); o0[2 * q + 1] = cvt2(X[i0 + 2], X[i0 + 3]); o1[2 * q] = cvt2(X[i1], X[i1 + 1]); o1[2 * q + 1] = cvt2(X[i1 + 2], X[i1 + 3]); }
                        u32x4* dst = (u32x4*)(blk + GS_UF + (size_t)(((ws * 2 + rt) * 64) + cc + 32 * hh) * 32); dst[0] = o0; dst[1] = o1; }
            }
        } else {
            int l3 = lane; asm volatile("" : "+v"(l3));
            const int wv = wave - 4, r = l3 & 31, hh = l3 >> 5;
            {   const int rt4 = wv;
#pragma unroll
                for (int kt2 = 0; kt2 < 2; ++kt2)
#pragma unroll
                    for (int ss = 0; ss < 2; ++ss) { float v[8];
#pragma unroll
                        for (int j = 0; j < 8; ++j) { const int tok = 32 * kt2 + krow(ss, hh, j); v[j] = bf2f(*(const LAS bf16_t*)(L + G1_KS + tok * 272 + (32 * rt4 + r) * 2)) * ek_s[tok]; }
                        u32x4 o; o[0] = cvt2(v[0], v[1]); o[1] = cvt2(v[2], v[3]); o[2] = cvt2(v[4], v[5]); o[3] = cvt2(v[6], v[7]);
                        *(u32x4*)(blk + GS_KF + ((rt4 * 2 + kt2) * 2 + ss) * 1024 + lane * 16) = o; } }
            {   const int kt = wv;
#pragma unroll
                for (int rt = 0; rt < 2; ++rt)
#pragma unroll
                    for (int ss = 0; ss < 2; ++ss) { const int i = 32 * rt + r; const float sc = eg_s[i];
                        const u32x2 lo = *(const LAS u32x2*)(L + G1_QS + i * 272 + (32 * kt + 16 * ss + 4 * hh) * 2), hi = *(const LAS u32x2*)(L + G1_QS + i * 272 + (32 * kt + 16 * ss + 8 + 4 * hh) * 2);
                        u32x4 o; o[0] = cvt2(lo16(lo[0]) * sc, hi16(lo[0]) * sc); o[1] = cvt2(lo16(lo[1]) * sc, hi16(lo[1]) * sc); o[2] = cvt2(lo16(hi[0]) * sc, hi16(hi[0]) * sc); o[3] = cvt2(lo16(hi[1]) * sc, hi16(hi[1]) * sc);
                        *(u32x4*)(blk + GS_QF + ((rt * 4 + kt) * 2 + ss) * 1024 + lane * 16) = o; } }
            {   const int rt = wv >> 1, kt2 = wv & 1;
#pragma unroll
                for (int ss = 0; ss < 2; ++ss) { const int i = 32 * rt + r;
                    const u32x2 lo = *(const LAS u32x2*)(L + G1_PS + i * 144 + (32 * kt2 + 16 * ss + 4 * hh) * 2), hi = *(const LAS u32x2*)(L + G1_PS + i * 144 + (32 * kt2 + 16 * ss + 8 + 4 * hh) * 2);
                    u32x4 o; o[0] = lo[0]; o[1] = lo[1]; o[2] = hi[0]; o[3] = hi[1];
                    *(u32x4*)(blk + GS_PF + ((rt * 2 + kt2) * 2 + ss) * 1024 + lane * 16) = o; } }
        }
        __syncthreads();
        {
            int l4 = lane; asm volatile("" : "+v"(l4));
            const int kt = wave & 3, rt = wave >> 2, r = l4 & 31, hh = l4 >> 5, i = 32 * rt + r;
#pragma unroll
            for (int ss = 0; ss < 2; ++ss) {
                const u32x2 lo = *(const LAS u32x2*)(L + G1_WS + i * 272 + (32 * kt + 16 * ss + 4 * hh) * 2), hi = *(const LAS u32x2*)(L + G1_WS + i * 272 + (32 * kt + 16 * ss + 8 + 4 * hh) * 2);
                u32x4 o; o[0] = lo[0]; o[1] = lo[1]; o[2] = hi[0]; o[3] = hi[1];
                *(u32x4*)(blk + GS_WF + ((rt * 4 + kt) * 2 + ss) * 1024 + lane * 16) = o; }
        }
        __syncthreads();
    }
}

constexpr int G2_FB = 57344, G2_OS = 2 * G2_FB, G2_OSTRIDE = 528;
__device__ __forceinline__ bf16x8 pack8(const f32x16& x, const int s) {
    u32x4 p; p[0] = cvt2(x[8 * s], x[8 * s + 1]); p[1] = cvt2(x[8 * s + 2], x[8 * s + 3]); p[2] = cvt2(x[8 * s + 4], x[8 * s + 5]); p[3] = cvt2(x[8 * s + 6], x[8 * s + 7]);
    return __builtin_bit_cast(bf16x8, p);
}
__device__ __forceinline__ void phase_gdn_g2(Frame& F) {
    int tid = threadIdx.x; asm volatile("" : "+v"(tid));
    const int lane = tid & 63, wave = __builtin_amdgcn_readfirstlane(tid >> 6);
    LAS unsigned char* L = F.lds;
    const float* DEC = (const float*)(F.ws + WS_DEC);
    for (int task = blockIdx.x; task < 192; task += F.G) {
        int s, h, nch, ch0; if (task < 64) { s = task >> 3; h = task & 7; nch = 64; ch0 = s * 512 + h; } else { s = BP + ((task - 64) >> 3); h = task & 7; nch = 1; ch0 = 4096 + (s - BP) * 8 + h; }
        const int cstride = 8;
        const int base = seq_base(s), nvalid = s < BP ? 64 : TS;
        const unsigned char* blk0 = F.ws + WS_RB + (size_t)ch0 * GS_BYTES;
        if (wave < 4) {
            const int ws = wave, cc = lane & 31, hh = lane >> 5;
            f32x16 S0, S1, S2, S3;
            if (s < BP) {
#pragma unroll
                for (int e = 0; e < 16; ++e) { S0[e] = 0.f; S1[e] = 0.f; S2[e] = 0.f; S3[e] = 0.f; }
            } else {
                const float* sp = F.in[7] + ((size_t)(s - BP) * 8 + h) * 16384 + 32 * ws + cc;
#pragma unroll
                for (int e = 0; e < 16; ++e) { const int rr = (e & 3) + 8 * (e >> 2) + 4 * hh; S0[e] = sp[(size_t)rr * 128]; S1[e] = sp[(size_t)(32 + rr) * 128]; S2[e] = sp[(size_t)(64 + rr) * 128]; S3[e] = sp[(size_t)(96 + rr) * 128]; }
            }
            u32x4 un[4];
            { const u32x4* up = (const u32x4*)(blk0 + GS_UF + (size_t)(ws * 2 * 64 + lane) * 32); un[0] = up[0]; un[1] = up[1]; un[2] = up[128]; un[3] = up[129]; }
            __syncthreads();
            for (int c = 0; c < nch; ++c) {
                const LAS unsigned char* B = L + (c & 1) * G2_FB + lane * 16;
                const float dec = DEC[ch0 + c * cstride];
                f32x16 vn0, vn1, o0, o1;
#pragma unroll
                for (int q = 0; q < 4; ++q) { vn0[2 * q] = lo16(un[0][q]); vn0[2 * q + 1] = hi16(un[0][q]); vn0[8 + 2 * q] = lo16(un[1][q]); vn0[8 + 2 * q + 1] = hi16(un[1][q]);
                                              vn1[2 * q] = lo16(un[2][q]); vn1[2 * q + 1] = hi16(un[2][q]); vn1[8 + 2 * q] = lo16(un[3][q]); vn1[8 + 2 * q + 1] = hi16(un[3][q]); }
#pragma unroll
                for (int e = 0; e < 16; ++e) { o0[e] = 0.f; o1[e] = 0.f; }
                if (c + 1 < nch) { const u32x4* up = (const u32x4*)(blk0 + (size_t)(c + 1) * cstride * GS_BYTES + GS_UF + (size_t)(ws * 2 * 64 + lane) * 32); un[0] = up[0]; un[1] = up[1]; un[2] = up[128]; un[3] = up[129]; }
#define G2_WQ(Sx, kt) do { _Pragma("unroll") for (int ss = 0; ss < 2; ++ss) { const bf16x8 sb = pack8(Sx, ss); \
                    const bf16x8 fw0 = *(const LAS bf16x8*)(B + GS_WF + ((0 * 4 + kt) * 2 + ss) * 1024), fw1 = *(const LAS bf16x8*)(B + GS_WF + ((1 * 4 + kt) * 2 + ss) * 1024); \
                    const bf16x8 fq0 = *(const LAS bf16x8*)(B + GS_QF + ((0 * 4 + kt) * 2 + ss) * 1024), fq1 = *(const LAS bf16x8*)(B + GS_QF + ((1 * 4 + kt) * 2 + ss) * 1024); \
                    vn0 = MFMA32(fw0, sb, vn0); vn1 = MFMA32(fw1, sb, vn1); o0 = MFMA32(fq0, sb, o0); o1 = MFMA32(fq1, sb, o1); } } while (0)
                G2_WQ(S0, 0); G2_WQ(S1, 1); G2_WQ(S2, 2); G2_WQ(S3, 3);
#undef G2_WQ
                bf16x8 vb[2][2];
                vb[0][0] = pack8(vn0, 0); vb[0][1] = pack8(vn0, 1); vb[1][0] = pack8(vn1, 0); vb[1][1] = pack8(vn1, 1);
#pragma unroll
                for (int kt2 = 0; kt2 < 2; ++kt2)
#pragma unroll
                    for (int ss = 0; ss < 2; ++ss) {
                        const bf16x8 fp0 = *(const LAS bf16x8*)(B + GS_PF + ((0 * 2 + kt2) * 2 + ss) * 1024), fp1 = *(const LAS bf16x8*)(B + GS_PF + ((1 * 2 + kt2) * 2 + ss) * 1024);
                        o0 = MFMA32(fp0, vb[kt2][ss], o0); o1 = MFMA32(fp1, vb[kt2][ss], o1); }
#define G2_KS(Sx, rt4) do { Sx = Sx * dec; _Pragma("unroll") for (int kt2 = 0; kt2 < 2; ++kt2) _Pragma("unroll") for (int ss = 0; ss < 2; ++ss) { \
                    const bf16x8 fk = *(const LAS bf16x8*)(B + GS_KF + ((rt4 * 2 + kt2) * 2 + ss) * 1024); Sx = MFMA32(fk, vb[kt2][ss], Sx); } } while (0)
                G2_KS(S0, 0); G2_KS(S1, 1); G2_KS(S2, 2); G2_KS(S3, 3);
#undef G2_KS
                __syncthreads();
#pragma unroll
                for (int e = 0; e < 16; ++e) { const int rr = (e & 3) + 8 * (e >> 2) + 4 * hh;
                    *(LAS float*)(L + G2_OS + rr * G2_OSTRIDE + (32 * ws + cc) * 4) = o0[e]; *(LAS float*)(L + G2_OS + (32 + rr) * G2_OSTRIDE + (32 * ws + cc) * 4) = o1[e]; }
                __syncthreads();
            }
            float* so = (s < BP ? F.out + O_GSP + ((size_t)s * 8 + h) * 16384 : F.out + O_GSS + ((size_t)(s - BP) * 8 + h) * 16384) + 32 * ws + cc;
#pragma unroll
            for (int e = 0; e < 16; ++e) { const int rr = (e & 3) + 8 * (e >> 2) + 4 * hh; so[(size_t)rr * 128] = S0[e]; so[(size_t)(32 + rr) * 128] = S1[e]; so[(size_t)(64 + rr) * 128] = S2[e]; so[(size_t)(96 + rr) * 128] = S3[e]; }
        } else {
            const int lt = tid - 256;
            u32x4 pre[14];
            { const u32x4* src = (const u32x4*)blk0;
#pragma unroll
              for (int i = 0; i < 14; ++i) pre[i] = src[i * 256 + lt];
#pragma unroll
              for (int i = 0; i < 14; ++i) *(LAS u32x4*)(L + (size_t)(i * 256 + lt) * 16) = pre[i]; }
            __syncthreads();
            const int row = lt >> 2, seg = lt & 3;
            f32x4 hn[8];
#pragma unroll
            for (int q = 0; q < 8; ++q) hn[q] = *(const f32x4*)(F.in[32] + seg * 32 + 4 * q);
            for (int c = 0; c < nch; ++c) {
                const bool more = c + 1 < nch;
                if (more) { const u32x4* src = (const u32x4*)(blk0 + (size_t)(c + 1) * cstride * GS_BYTES);
#pragma unroll
                    for (int i = 0; i < 14; ++i) pre[i] = src[i * 256 + lt]; }
                const int m = base + c * 64 + row; const bool rok = row < nvalid;
                u32x4 zz[4];
                if (rok) { const u32x4* zp = (const u32x4*)(F.Z1() + (size_t)m * D + h * 128 + seg * 32);
#pragma unroll
                    for (int q = 0; q < 4; ++q) zz[q] = zp[q]; }
                __syncthreads();
                if (more) {
#pragma unroll
                    for (int i = 0; i < 14; ++i) *(LAS u32x4*)(L + ((c + 1) & 1) * G2_FB + (size_t)(i * 256 + lt) * 16) = pre[i]; }
                __syncthreads();
                f32x4 ov[8]; float ss = 0.f;
#pragma unroll
                for (int q = 0; q < 8; ++q) { ov[q] = *(const LAS f32x4*)(L + G2_OS + row * G2_OSTRIDE + (seg * 32 + 4 * q) * 4); ss += (ov[q][0] * ov[q][0] + ov[q][1] * ov[q][1]) + (ov[q][2] * ov[q][2] + ov[q][3] * ov[q][3]); }
                ss += __shfl_xor(ss, 1); ss += __shfl_xor(ss, 2);
                const float rn = rsqrtf(ss * (1.f / 128.f) + EPS);
                if (rok) { u32x4 yo[4];
#pragma unroll
                    for (int q = 0; q < 4; ++q) {
#pragma unroll
                        for (int e = 0; e < 4; ++e) { const int q2 = 2 * q + (e >> 1), e2 = 2 * (e & 1); const float z0 = lo16(zz[q][e]), z1 = hi16(zz[q][e]);
                            yo[q][e] = cvt2(ov[q2][e2] * rn * hn[q2][e2] * siluf_(z0), ov[q2][e2 + 1] * rn * hn[q2][e2 + 1] * siluf_(z1)); } }
                    u32x4* yp = (u32x4*)(F.Y1() + (size_t)m * D + h * 128 + seg * 32);
#pragma unroll
                    for (int q = 0; q < 4; ++q) yp[q] = yo[q]; }
            }
        }
        __syncthreads();
    }
}

__device__ __forceinline__ void phase_final_rowwise(Frame& F) {
    const int gw = F.vcu * 8 + F.wave, NGW = F.G * 8;
    for (int m = gw; m < MT; m += NGW) {
        int s, t; tok_info(m, s, t);
        const float* mod1 = F.MOD() + (size_t)(24 + s) * 3072;
        f32x4 y[4]; float ss = 0.f;
#pragma unroll
        for (int j = 0; j < 4; ++j) { const u32x2 w = *(const u32x2*)(F.YO() + (size_t)m * D + 4 * F.lane + 256 * j); y[j] = (f32x4){lo16(w.x), hi16(w.x), lo16(w.y), hi16(w.y)};
            ss += (y[j][0] * y[j][0] + y[j][1] * y[j][1]) + (y[j][2] * y[j][2] + y[j][3] * y[j][3]); }
        const float r1 = rsqrtf(wave_sum(ss) * (1.f / D) + EPS);
#pragma unroll
        for (int j = 0; j < 4; ++j) { const int c = 4 * F.lane + 256 * j;
            float* op = F.out + O_Y + (size_t)m * D + c;
            const f32x4 xv = *(const f32x4*)op, g = *(const f32x4*)(F.in[27] + c), gt = *(const f32x4*)(mod1 + 2048 + c);
            f32x4 o;
#pragma unroll
            for (int e = 0; e < 4; ++e) o[e] = xv[e] + gt[e] * (y[j][e] * r1 * g[e]);
            *(f32x4*)op = o; }
    }
}

__global__ void __launch_bounds__(512, 2) fwd_megakernel(Params P) {
    extern __shared__ __attribute__((aligned(16))) unsigned char lds_raw[];
    cg::grid_group grid = cg::this_grid();
    Frame F;
    F.lds = (LAS unsigned char*)lds_raw;
    F.tid = threadIdx.x; F.lane = F.tid & 63; F.wave = __builtin_amdgcn_readfirstlane(F.tid >> 6);
    F.G = gridDim.x; { const int bx = blockIdx.x; F.vcu = (F.G % 8 == 0) ? (bx % 8) * (F.G / 8) + bx / 8 : bx; }
    F.in = P.in; F.out = P.out; F.ws = P.ws;

    phase_prologue(F);
    grid.sync();
    phase_prenorm0(F);
    grid.sync();
    { pg8::Gemm g{F.XN(), F.W0I(), MT, EV_IN, D}; pg8::StaticOrder S; S.init(MT, EV_IN, F.G, (int)blockIdx.x);
      pg8::EpiBf16 E{F.U0(), EV_IN, 1 << 30, F.U0(), EV_IN}; pg8::gemm_phase(F.lds, g, S, E); }
    grid.sync();
    phase_rope(F);
    phase_lru_naive(F);
    grid.sync();
    phase_attn_naive(F);
    grid.sync();
    { pg8::Gemm g{F.Y0(), F.W0O(), MT, D, D}; pg8::StaticOrder S; S.init(MT, D, F.G, (int)blockIdx.x);
      pg8::EpiBf16 E{F.YO(), D, 1 << 30, F.YO(), D}; pg8::gemm_phase(F.lds, g, S, E); }
    grid.sync();
    phase_mid_rowwise(F);
    grid.sync();
    { pg8::Gemm g{F.XN(), F.W1I(), MT, OD_MAIN, D}; pg8::StaticOrder S; S.init(MT, OD_MAIN, F.G, (int)blockIdx.x);
      pg8::EpiBf16 E{F.QKV1(), 3072, 3072, F.Z1(), D}; pg8::gemm_phase(F.lds, g, S, E); }
    grid.sync();
    phase_gdn_g1(F);
    grid.sync();
    phase_gdn_g2(F);
    grid.sync();
    { pg8::Gemm g{F.Y1(), F.W1O(), MT, D, D}; pg8::StaticOrder S; S.init(MT, D, F.G, (int)blockIdx.x);
      pg8::EpiBf16 E{F.YO(), D, 1 << 30, F.YO(), D}; pg8::gemm_phase(F.lds, g, S, E); }
    grid.sync();
    phase_final_rowwise(F);
}

extern "C" void kernel_launch(void* const* d_in, const int* in_sizes, int n_in, void* d_out, int out_size, void* d_ws, size_t ws_size, hipStream_t stream) {
    static int grid = 0;
    if (grid == 0) {
        if (n_in != 34 || out_size != (int)O_END || ws_size < WS_END) { grid = -1; return; }
        int dev = 0, cus = 0, per_cu = 0;
        if (hipGetDevice(&dev) != hipSuccess || hipDeviceGetAttribute(&cus, hipDeviceAttributeMultiprocessorCount, dev) != hipSuccess) { grid = -1; return; }
        if (hipFuncSetAttribute((const void*)fwd_megakernel, hipFuncAttributeMaxDynamicSharedMemorySize, LDS_BYTES) != hipSuccess) { grid = -1; return; }
        if (hipOccupancyMaxActiveBlocksPerMultiprocessor(&per_cu, (const void*)fwd_megakernel, 512, LDS_BYTES) != hipSuccess || per_cu < 1) { grid = -1; return; }
        grid = cus;
    }
    if (grid < 0) return;
    Params p{};
    for (int i = 0; i < 34; ++i) p.in[i] = (const float*)d_in[i];
    p.out = (float*)d_out; p.ws = (unsigned char*)d_ws;
    void* args[] = {&p};
    (void)hipLaunchCooperativeKernel((const void*)fwd_megakernel, dim3(grid), dim3(512), args, LDS_BYTES, stream);
}
```

```cpp
#include <hip/hip_runtime.h>
#include <hip/hip_cooperative_groups.h>
namespace cg = cooperative_groups;

#define LAS __attribute__((address_space(3)))
typedef unsigned short bf16_t;
typedef short bf16x8 __attribute__((ext_vector_type(8)));
typedef float f32x4 __attribute__((ext_vector_type(4)));
typedef float f32x2 __attribute__((ext_vector_type(2)));
typedef unsigned u32x4 __attribute__((ext_vector_type(4)));
typedef unsigned u32x2 __attribute__((ext_vector_type(2)));

constexpr int D = 1024, BP = 8, TP = 4096, BS = 16, TS = 16;
constexpr int MP = BP * TP, MS = BS * TS, MT = MP + MS;
constexpr int NSEQ = BP + BS;
constexpr int EV_IN = 2304, OD_IN = 4112, OD_MAIN = 4096;
constexpr int C_XA = 0, C_GA = 512, C_Q = 1024, C_K = 1536, C_V = 1664, C_GB = 1792;
constexpr float EPS = 1e-6f;
constexpr size_t O_Y = 0, O_LCP = 33816576, O_LCS = 33828864, O_LHP = 33853440, O_LHS = 33857536, O_KP = 33865728, O_KS = 33996800,
                 O_VP = 34029568, O_VS = 34160640, O_GCP = 34193408, O_GCS = 34267136, O_GSP = 34414592, O_GSS = 35463168, O_END = 37560320;
constexpr size_t MiB = 1u << 20;
constexpr size_t WS_CTL = 0, WS_W1O = 1 * MiB, WS_MOD = 3 * MiB, WS_ROPE = 4 * MiB, WS_BA = 5 * MiB, WS_LAG = 8 * MiB, WS_LGW = 10 * MiB;
constexpr size_t WS_RA = 16 * MiB, RA_BYTES = (size_t)MT * 4096 * 2;
constexpr size_t WS_RB = WS_RA + RA_BYTES;
constexpr size_t ACT_BYTES = (size_t)MT * D * 2;
constexpr size_t RB_XN = 0, RB_Y0 = ACT_BYTES, RB_YO = 2 * ACT_BYTES, RB_W0I = 3 * ACT_BYTES, RB_W0O = RB_W0I + (size_t)EV_IN * D * 2,
                 RB_W1I = RB_W0O + (size_t)D * D * 2, RB_WEND = RB_W1I + (size_t)OD_MAIN * D * 2;
constexpr size_t RB_BYTES = (size_t)4224 * 73728;
constexpr size_t WS_END = WS_RB + RB_BYTES;
static_assert(RB_WEND <= RB_BYTES, "ws map");
static_assert((size_t)MT * 3072 * 2 <= RB_BYTES, "ws map");
constexpr int LDS_BYTES = 155648;

struct Params { const float* in[34]; float* out; unsigned char* ws; };

__device__ __forceinline__ float bf2f(bf16_t b) { return __uint_as_float(((unsigned)b) << 16); }
__device__ __forceinline__ unsigned f2bf(float f) { unsigned u = __float_as_uint(f); return (u + 0x7fffu + ((u >> 16) & 1u)) >> 16; }
__device__ __forceinline__ unsigned pk2(float lo, float hi) { return f2bf(lo) | (f2bf(hi) << 16); }
__device__ __forceinline__ float lo16(unsigned w) { return __uint_as_float(w << 16); }
__device__ __forceinline__ float hi16(unsigned w) { return __uint_as_float(w & 0xffff0000u); }
__device__ __forceinline__ float wave_sum(float v) {
#pragma unroll
    for (int o = 1; o < 64; o <<= 1) v += __shfl_xor(v, o);
    return v;
}
__device__ __forceinline__ float sigmoidf_(float x) { return 1.0f / (1.0f + __expf(-x)); }
__device__ __forceinline__ float siluf_(float x) { return x / (1.0f + __expf(-x)); }
__device__ __forceinline__ float softplusf_(float x) { return x > 20.f ? x : log1pf(__expf(x)); }
__device__ __forceinline__ int seq_base(int s) { return s < BP ? s * TP : MP + (s - BP) * TS; }
__device__ __forceinline__ int seq_len(int s) { return s < BP ? TP : TS; }
__device__ __forceinline__ void tok_info(int m, int& s, int& t) { if (m < MP) { s = m >> 12; t = m & 4095; } else { const int r = m - MP; s = BP + (r >> 4); t = r & 15; } }

namespace pg8 {
constexpr int BM = 256, BK = 64, HALF = 128, HTB = HALF * BK * 2, STAGE_BYTES = 8 * HTB, NXCD = 8, WGM = 8;
__host__ __device__ __forceinline__ int lds_byte(int r, int c) { const int st = (r >> 4) * 2 + (c >> 5), rr = r & 15, cc = c & 31, ob = rr * 64 + cc * 2; return st * 1024 + (ob ^ (((ob >> 9) & 1) << 5)); }
__host__ __device__ __forceinline__ void stage_rc(int b, int& R, int& C) { const int st = b / 1024, sb = b % 1024, swz = sb ^ (((sb >> 9) & 1) << 5); R = (st >> 1) * 16 + swz / 64; C = (st & 1) * 32 + (swz % 64) / 2; }
__host__ __device__ __forceinline__ int perm32(int rho) { const int n = rho >> 4, i = rho & 15; return 8 * (i >> 2) + 4 * n + (i & 3); }
struct Unit { int pm, pn; };
struct Gemm { const bf16_t* A; const bf16_t* Bt; int M, N, K; };
struct StaticOrder {
    int nM, nN, nwg, G, c;
    __device__ void init(int M, int N, int G_, int c_) { nM = M / BM; nN = N / BM; nwg = nM * nN; G = G_; c = c_; }
    __device__ bool next(int i, Unit& u) const {
        const long L = (long)i * G + c; if (L >= nwg) return false;
        int wgid = (int)L; { const int q = nwg / NXCD, r = nwg % NXCD, xcd = wgid % NXCD, off = wgid / NXCD; wgid = (xcd < r ? xcd * (q + 1) : r * (q + 1) + (xcd - r) * q) + off; }
        const int nig = WGM * nN, gid = wgid / nig, fm = gid * WGM, gsz = (nM - fm) < WGM ? (nM - fm) : WGM;
        u.pm = fm + ((wgid % nig) % gsz); u.pn = (wgid % nig) / gsz; return true;
    }
};
__device__ __forceinline__ unsigned cvt_pk_bf16(float lo, float hi) { unsigned r; asm volatile("v_cvt_pk_bf16_f32 %0, %1, %2" : "=v"(r) : "v"(lo), "v"(hi)); return r; }
struct EpiBf16 {
    static constexpr bool PERM = true;
    bf16_t* O0; int ld0; int split; bf16_t* O1; int ld1;
    __device__ __forceinline__ void operator()(const f32x4 (&acc)[2][2][4][2], const Unit& u, int wr, int wc, int fr, int fq) const {
        const int row0 = u.pm * BM + wr * 64 + fr; int colt = u.pn * BM; bf16_t* base = O0; int ld = ld0;
        if (colt >= split) { base = O1; ld = ld1; colt -= split; }
        const int col0 = colt + wc * 32 + 8 * fq;
#pragma unroll
        for (int ai = 0; ai < 2; ++ai)
#pragma unroll
            for (int m = 0; m < 4; ++m) { bf16_t* rowp = base + (size_t)(row0 + ai * HALF + m * 16) * ld + col0;
#pragma unroll
                for (int bj = 0; bj < 2; ++bj) { const f32x4 v0 = acc[ai][bj][m][0], v1 = acc[ai][bj][m][1];
                    u32x4 w; w.x = cvt_pk_bf16(v0[0], v0[1]); w.y = cvt_pk_bf16(v0[2], v0[3]); w.z = cvt_pk_bf16(v1[0], v1[1]); w.w = cvt_pk_bf16(v1[2], v1[3]);
                    *(u32x4*)(rowp + bj * HALF) = w; } }
    }
};
template <class Epi, class Sched>
__device__ __forceinline__ void gemm_phase(LAS unsigned char* lds, const Gemm g, const Sched& S, const Epi& E) {
    int tid = threadIdx.x; asm volatile("" : "+v"(tid));
    const int wid = __builtin_amdgcn_readfirstlane(tid >> 6), lane = tid & 63, wr = wid >> 2, wc = wid & 3, fr = lane & 15, fq = lane >> 4;
    const int K = g.K, nt = K / BK;
    unsigned voffA[2], voffB[2];
#pragma unroll
    for (int i = 0; i < 2; ++i) { int R, C; stage_rc(tid * 16 + i * 8192, R, C); const int Rb = Epi::PERM ? ((R & ~31) + perm32(R & 31)) : R;
        voffA[i] = (unsigned)(R * K + C) * 2u; voffB[i] = (unsigned)(Rb * K + C) * 2u; }
    const size_t kstep = (size_t)(BK * 2);
    const size_t hstep = (size_t)HALF * K * 2;
    const size_t tstep = 2 * hstep;
    const unsigned ldsw = (unsigned)wid * 1024u;
    const int aoff = lds_byte(wr * 64 + fr, fq * 8), boff = lds_byte(wc * 32 + fr, fq * 8);
#define PG8_SA(b, h) (((b) * 2 + (h)) * HTB)
#define PG8_SB(b, h) ((4 + (b) * 2 + (h)) * HTB)
#define PG8_STAGE(bufoff, gbase, voff) do { _Pragma("unroll") for (int _i = 0; _i < 2; ++_i) \
        __builtin_amdgcn_global_load_lds((const unsigned*)((const char*)(gbase) + (voff)[_i]), (LAS unsigned*)(lds + (bufoff) + ldsw + _i * 8192), 16, 0, 0); } while (0)
#define PG8_LDA(dst, b, h) do { _Pragma("unroll") for (int m = 0; m < 4; ++m) _Pragma("unroll") for (int k = 0; k < 2; ++k) dst[m][k] = *(const LAS bf16x8*)(lds + PG8_SA(b, h) + aoff + m * 2048 + k * 1024); } while (0)
#define PG8_LDB(dst, b, h) do { _Pragma("unroll") for (int n = 0; n < 2; ++n) _Pragma("unroll") for (int k = 0; k < 2; ++k) dst[n][k] = *(const LAS bf16x8*)(lds + PG8_SB(b, h) + boff + n * 2048 + k * 1024); } while (0)
#define PG8_MMA(ai, bj, At, Bt) do { __builtin_amdgcn_s_setprio(1); _Pragma("unroll") for (int m = 0; m < 4; ++m) _Pragma("unroll") for (int n = 0; n < 2; ++n) _Pragma("unroll") for (int k = 0; k < 2; ++k) \
        acc[ai][bj][m][n] = __builtin_amdgcn_mfma_f32_16x16x32_bf16(Bt[n][k], At[m][k], acc[ai][bj][m][n], 0, 0, 0); __builtin_amdgcn_s_setprio(0); } while (0)
#define PG8_WAIT_V(n) asm volatile("s_waitcnt vmcnt(" #n ")" ::: "memory")
#define PG8_WAIT_L(n) asm volatile("s_waitcnt lgkmcnt(" #n ")" ::: "memory")
#define PG8_BAR __builtin_amdgcn_s_barrier()
#define PG8_SCHED __builtin_amdgcn_sched_barrier(0)
    Unit cur, nxt; int ui = 0;
    if (!S.next(0, cur)) return;
    f32x4 acc[2][2][4][2];
#pragma unroll
    for (int a = 0; a < 2; ++a)
#pragma unroll
        for (int b = 0; b < 2; ++b)
#pragma unroll
            for (int m = 0; m < 4; ++m)
#pragma unroll
                for (int n = 0; n < 2; ++n) acc[a][b][m][n] = (f32x4){0.f, 0.f, 0.f, 0.f};
    bf16x8 At[4][2], B0[2][2], B1[2][2];
    const char* cA = (const char*)g.A + (size_t)cur.pm * tstep; const char* cB = (const char*)g.Bt + (size_t)cur.pn * tstep;
    PG8_STAGE(PG8_SB(0, 0), cB, voffB); PG8_STAGE(PG8_SA(0, 0), cA, voffA); PG8_STAGE(PG8_SB(0, 1), cB + hstep, voffB); PG8_STAGE(PG8_SA(0, 1), cA + hstep, voffA);
    if (wr == 1) PG8_BAR;
    PG8_WAIT_V(4); PG8_BAR;
    PG8_STAGE(PG8_SB(1, 0), cB + kstep, voffB); PG8_STAGE(PG8_SA(1, 0), cA + kstep, voffA); PG8_STAGE(PG8_SB(1, 1), cB + hstep + kstep, voffB);
    PG8_WAIT_V(6); PG8_BAR;
    for (;;) {
        const bool has_next = S.next(ui + 1, nxt);
        const char* nA = has_next ? (const char*)g.A + (size_t)nxt.pm * tstep : cA; const char* nB = has_next ? (const char*)g.Bt + (size_t)nxt.pn * tstep : cB;
        for (int t = 0; t < nt; t += 2) {
            const bool last = (t == nt - 2);
            const char* a1 = cA + (size_t)(t + 1) * kstep;
            const char* a2 = last ? nA : cA + (size_t)(t + 2) * kstep; const char* b2 = last ? nB : cB + (size_t)(t + 2) * kstep;
            const char* a3 = a2 + kstep; const char* b3 = b2 + kstep;
            PG8_LDB(B0, 0, 0); PG8_SCHED; PG8_LDA(At, 0, 0); PG8_STAGE(PG8_SA(1, 1), a1 + hstep, voffA);
            PG8_WAIT_L(8); PG8_BAR; PG8_WAIT_L(0); PG8_MMA(0, 0, At, B0); PG8_BAR; PG8_SCHED;
            PG8_LDB(B1, 0, 1); PG8_STAGE(PG8_SB(0, 0), b2, voffB);
            PG8_BAR; PG8_WAIT_L(0); PG8_MMA(0, 1, At, B1); PG8_BAR;
            PG8_LDA(At, 0, 1); PG8_STAGE(PG8_SA(0, 0), a2, voffA);
            PG8_BAR; PG8_WAIT_L(0); PG8_MMA(1, 0, At, B0); PG8_BAR; PG8_SCHED;
            PG8_STAGE(PG8_SB(0, 1), b2 + hstep, voffB);
            PG8_WAIT_V(6); PG8_BAR; PG8_MMA(1, 1, At, B1); PG8_BAR;
            PG8_LDB(B0, 1, 0); PG8_SCHED; PG8_LDA(At, 1, 0); PG8_STAGE(PG8_SA(0, 1), a2 + hstep, voffA);
            PG8_WAIT_L(8); PG8_BAR; PG8_WAIT_L(0); PG8_MMA(0, 0, At, B0); PG8_BAR; PG8_SCHED;
            PG8_LDB(B1, 1, 1); PG8_STAGE(PG8_SB(1, 0), b3, voffB);
            PG8_BAR; PG8_WAIT_L(0); PG8_MMA(0, 1, At, B1); PG8_BAR;
            PG8_LDA(At, 1, 1); PG8_STAGE(PG8_SA(1, 0), a3, voffA);
            PG8_BAR; PG8_WAIT_L(0); PG8_MMA(1, 0, At, B0); PG8_BAR; PG8_SCHED;
            PG8_STAGE(PG8_SB(1, 1), b3 + hstep, voffB);
            PG8_WAIT_V(6); PG8_BAR; PG8_MMA(1, 1, At, B1); PG8_BAR;
        }
        E(acc, cur, wr, wc, fr, fq);
        if (!has_next) break;
#pragma unroll
        for (int a = 0; a < 2; ++a)
#pragma unroll
            for (int b = 0; b < 2; ++b)
#pragma unroll
                for (int m = 0; m < 4; ++m)
#pragma unroll
                    for (int n = 0; n < 2; ++n) acc[a][b][m][n] = (f32x4){0.f, 0.f, 0.f, 0.f};
        cur = nxt; cA = nA; cB = nB; ++ui;
    }
    PG8_WAIT_V(0);
    if (wr == 0) PG8_BAR;
    PG8_BAR;
#undef PG8_SA
#undef PG8_SB
#undef PG8_STAGE
#undef PG8_LDA
#undef PG8_LDB
#undef PG8_MMA
#undef PG8_WAIT_V
#undef PG8_WAIT_L
#undef PG8_BAR
#undef PG8_SCHED
}
}

struct Frame {
    LAS unsigned char* lds;
    int vcu, G;
    const float* const* in; float* out; unsigned char* ws;
    __device__ __forceinline__ float* MOD() const { return (float*)(ws + WS_MOD); }
    __device__ __forceinline__ float* ROPE() const { return (float*)(ws + WS_ROPE); }
    __device__ __forceinline__ float* BA() const { return (float*)(ws + WS_BA); }
    __device__ __forceinline__ float* LAG() const { return (float*)(ws + WS_LAG); }
    __device__ __forceinline__ bf16_t* W1O() const { return (bf16_t*)(ws + WS_W1O); }
    __device__ __forceinline__ bf16_t* U0() const { return (bf16_t*)(ws + WS_RA); }
    __device__ __forceinline__ bf16_t* QKV1() const { return (bf16_t*)(ws + WS_RA); }
    __device__ __forceinline__ bf16_t* Z1() const { return (bf16_t*)(ws + WS_RA + (size_t)MT * 3072 * 2); }
    __device__ __forceinline__ bf16_t* Y1() const { return (bf16_t*)(ws + WS_RA); }
    __device__ __forceinline__ bf16_t* XN() const { return (bf16_t*)(ws + WS_RB + RB_XN); }
    __device__ __forceinline__ bf16_t* Y0() const { return (bf16_t*)(ws + WS_RB + RB_Y0); }
    __device__ __forceinline__ bf16_t* YO() const { return (bf16_t*)(ws + WS_RB + RB_YO); }
    __device__ __forceinline__ bf16_t* W0I() const { return (bf16_t*)(ws + WS_RB + RB_W0I); }
    __device__ __forceinline__ bf16_t* W0O() const { return (bf16_t*)(ws + WS_RB + RB_W0O); }
    __device__ __forceinline__ bf16_t* W1I() const { return (bf16_t*)(ws + WS_RB + RB_W1I); }
    __device__ __forceinline__ bf16_t* QKVC() const { return (bf16_t*)(ws + WS_RB); }
};

#define PHASE_IDS() int tid = threadIdx.x; asm volatile("" : "+v"(tid)); const int lane = tid & 63, wave = __builtin_amdgcn_readfirstlane(tid >> 6); (void)lane; (void)wave
__device__ __forceinline__ void p0_transpose_item(const float* W, int ldw, int nblk, int K, bf16_t* WT, LAS float* scr, int item, int lane) {
    const int kb = item / nblk, nb = item % nblk, k0 = 64 * kb, n0 = 32 * nb;
#pragma unroll 8
    for (int i = 0; i < 32; ++i) { const int kk = 2 * i + (lane >> 5); scr[kk * 33 + (lane & 31)] = W[(size_t)(k0 + kk) * ldw + n0 + (lane & 31)]; }
    asm volatile("s_waitcnt lgkmcnt(0)" ::: "memory");
    const int c = lane & 7;
#pragma unroll
    for (int j = 0; j < 4; ++j) { const int n = (lane >> 3) + 8 * j; const LAS float* s = scr + (8 * c) * 33 + n;
        u32x4 o; o.x = pk2(s[0 * 33], s[1 * 33]); o.y = pk2(s[2 * 33], s[3 * 33]); o.z = pk2(s[4 * 33], s[5 * 33]); o.w = pk2(s[6 * 33], s[7 * 33]);
        *(u32x4*)(WT + (size_t)(n0 + n) * K + k0 + 8 * c) = o; }
    asm volatile("s_waitcnt lgkmcnt(0)" ::: "memory");
}
__device__ __forceinline__ void phase_prologue(Frame& F) {
    PHASE_IDS();
    const int gw = F.vcu * 8 + wave, NGW = F.G * 8;
    {
        LAS float* scr = (LAS float*)(F.lds + wave * 16384);
        constexpr int I0 = 16 * (EV_IN / 32), I1 = 16 * 32, I2 = 16 * (OD_MAIN / 32), I3 = 16 * 32;
        for (int it = gw; it < I0 + I1 + I2 + I3; it += NGW) {
            int r = it;
            if (r < I0) { p0_transpose_item(F.in[14], EV_IN, EV_IN / 32, D, F.W0I(), scr, r, lane); continue; } r -= I0;
            if (r < I1) { p0_transpose_item(F.in[23], D, 32, D, F.W0O(), scr, r, lane); continue; } r -= I1;
            if (r < I2) { p0_transpose_item(F.in[28], OD_IN, OD_MAIN / 32, D, F.W1I(), scr, r, lane); continue; } r -= I2;
            p0_transpose_item(F.in[33], D, 32, D, F.W1O(), scr, r, lane);
        }
    }
    {
        const double inv[8] = {1.0, 0.19392274474868576, 0.03760603093086393, 0.007292664737217109, 0.001414213562373095, 0.0002742481756762073, 5.318295896944988e-05, 1.031338537721246e-05};
        for (int idx = F.vcu * 512 + tid; idx < 4112 * 8; idx += F.G * 512) {
            const int pos = idx >> 3, i = idx & 7;
            double iv = inv[0];
#pragma unroll
            for (int q = 1; q < 8; ++q) iv = (i == q) ? inv[q] : iv;
            const double ang = (double)pos * iv;
            const double n = __builtin_rint(ang * 0.15915494309189535);
            const float r = (float)__builtin_fma(-n, 6.283185307179586, ang);
            F.ROPE()[pos * 16 + i] = __cosf(r); F.ROPE()[pos * 16 + 8 + i] = __sinf(r);
        }
    }
    {
        bf16_t* LGW = (bf16_t*)(F.ws + WS_LGW);
        for (int idx = F.vcu * 512 + tid; idx < 8 * 2 * 64 * 64; idx += F.G * 512) { const int k = idx & 63, n = (idx >> 6) & 63, gate = (idx >> 12) & 1, hh = idx >> 13;
            LGW[idx] = (bf16_t)f2bf((gate ? F.in[19] : F.in[17])[(hh * 64 + k) * 64 + n]); }
    }
    __syncthreads();
    for (int bt = F.vcu; bt < 96; bt += F.G) {
        LAS float* tab = (LAS float*)F.lds;
        for (int idx = tid; idx < 24 * 1024; idx += 512) { const int s = idx >> 10, k = idx & 1023;
            const float c = s < BP ? F.in[8][s * D + k] : F.in[9][(s - BP) * D + k]; tab[k * 24 + s] = siluf_(c); }
        __syncthreads();
        const int L = bt / 48, n0 = (bt % 48) * 64;
        const float* mw = (L == 0 ? F.in[10] : F.in[24]) + n0 + lane;
        float acc[24];
#pragma unroll
        for (int r = 0; r < 24; ++r) acc[r] = 0.f;
        for (int k = wave * 128; k < wave * 128 + 128; ++k) {
            const float w = mw[(size_t)k * 3072];
            const LAS f32x4* tp = (const LAS f32x4*)(tab + k * 24);
#pragma unroll
            for (int q = 0; q < 6; ++q) { const f32x4 t4 = tp[q]; acc[4 * q] += t4[0] * w; acc[4 * q + 1] += t4[1] * w; acc[4 * q + 2] += t4[2] * w; acc[4 * q + 3] += t4[3] * w; }
        }
        __syncthreads();
        LAS float* red = (LAS float*)F.lds;
#pragma unroll
        for (int r = 0; r < 24; ++r) red[(wave * 24 + r) * 64 + lane] = acc[r];
        __syncthreads();
        const float* mb = (L == 0 ? F.in[11] : F.in[25]);
        for (int idx = tid; idx < 24 * 64; idx += 512) { const int r = idx >> 6, l = idx & 63; float s = 0.f;
#pragma unroll
            for (int w = 0; w < 8; ++w) s += red[(w * 24 + r) * 64 + l];
            F.MOD()[((size_t)L * 24 + r) * 3072 + n0 + l] = s + mb[n0 + l]; }
        __syncthreads();
    }
}

__device__ __forceinline__ void phase_prenorm0(Frame& F) {
    PHASE_IDS();
    const int gw = F.vcu * 8 + wave, NGW = F.G * 8;
    for (int m = gw; m < MT; m += NGW) {
        int s, t; tok_info(m, s, t);
        const float* xrow = m < MP ? F.in[0] + (size_t)m * D : F.in[1] + (size_t)(m - MP) * D;
        const float* modr = F.MOD() + (size_t)s * 3072;
        f32x4 v[4]; float ss = 0.f;
#pragma unroll
        for (int j = 0; j < 4; ++j) { v[j] = *(const f32x4*)(xrow + 4 * lane + 256 * j); ss += (v[j][0] * v[j][0] + v[j][1] * v[j][1]) + (v[j][2] * v[j][2] + v[j][3] * v[j][3]); }
        const float r = rsqrtf(wave_sum(ss) * (1.f / D) + EPS);
#pragma unroll
        for (int j = 0; j < 4; ++j) { const int c = 4 * lane + 256 * j;
            const f32x4 g = *(const f32x4*)(F.in[12] + c), sh = *(const f32x4*)(modr + c), sc = *(const f32x4*)(modr + 1024 + c);
            f32x4 o;
#pragma unroll
            for (int e = 0; e < 4; ++e) o[e] = v[j][e] * r * g[e] * (1.f + sc[e]) + sh[e];
            u32x2 w; w.x = pk2(o[0], o[1]); w.y = pk2(o[2], o[3]); *(u32x2*)(F.XN() + (size_t)m * D + c) = w; }
    }
}

__device__ __forceinline__ void phase_rope(Frame& F) {
    PHASE_IDS();
    const int gt = F.vcu * 512 + tid, NT = F.G * 512;
    for (int idx = gt; idx < MT * 80; idx += NT) {
        const int m = idx / 80, r = idx % 80, slot = r >> 3, i = r & 7;
        int s, t; tok_info(m, s, t);
        const int pos = s < BP ? t : TP + t;
        const int col = slot < 8 ? C_Q + slot * 64 : C_K + (slot - 8) * 64;
        bf16_t* p = F.U0() + (size_t)m * EV_IN + col;
        const float x1 = bf2f(p[i]), x2 = bf2f(p[8 + i]), c = F.ROPE()[pos * 16 + i], sn = F.ROPE()[pos * 16 + 8 + i];
        const float o1 = x1 * c - x2 * sn, o2 = x2 * c + x1 * sn;
        p[i] = (bf16_t)f2bf(o1); p[8 + i] = (bf16_t)f2bf(o2);
        if (slot >= 8) { const int kv = slot - 8;
            if (s >= BP) { float* o = F.out + O_KS + ((size_t)((s - BP) * TS + t) * 2 + kv) * 64; o[i] = o1; o[8 + i] = o2; }
            else if (t >= TP - 128) { float* o = F.out + O_KP + ((size_t)(s * 128 + (t - (TP - 128))) * 2 + kv) * 64; o[i] = o1; o[8 + i] = o2; } }
    }
    for (int idx = gt; idx < 1280 * 224; idx += NT) {
        const int tk = idx / 224, e = idx % 224;
        int s, t, m; if (tk < 1024) { s = tk >> 7; t = TP - 128 + (tk & 127); m = s * TP + t; } else { s = BP + ((tk - 1024) >> 4); t = (tk - 1024) & 15; m = MP + (tk - 1024); }
        const bool isv = e >= 96; const int e2 = isv ? e - 96 : e; const int kv = isv ? (e2 >> 6) : (e2 / 48), d = isv ? (e2 & 63) : 16 + (e2 % 48);
        const float val = bf2f(F.U0()[(size_t)m * EV_IN + (isv ? C_V : C_K) + kv * 64 + d]);
        const size_t ob = s >= BP ? (isv ? O_VS : O_KS) + ((size_t)((s - BP) * TS + t) * 2 + kv) * 64 : (isv ? O_VP : O_KP) + ((size_t)(s * 128 + (t - (TP - 128))) * 2 + kv) * 64;
        F.out[ob + d] = val;
    }
}

__device__ __forceinline__ void phase_lru_naive(Frame& F) {
    PHASE_IDS();
    const int gw = F.vcu * 8 + wave, NGW = F.G * 8;
    for (int task = gw; task < NSEQ * 8; task += NGW) {
        const int s = task >> 3, h = task & 7, ch = h * 64 + lane, T = seq_len(s), base = seq_base(s);
        float wa[64], wx[64];
#pragma unroll
        for (int i = 0; i < 64; ++i) { wa[i] = F.in[17][(h * 64 + i) * 64 + lane]; wx[i] = F.in[19][(h * 64 + i) * 64 + lane]; }
        const float cw0 = F.in[15][ch], cw1 = F.in[15][512 + ch], cw2 = F.in[15][1024 + ch], cw3 = F.in[15][1536 + ch], cb = F.in[16][ch];
        const float ba = F.in[18][ch], bx = F.in[20][ch], sp = softplusf_(-F.in[21][ch]);
        float x3 = 0.f, x2 = 0.f, x1 = 0.f, hh = 0.f;
        if (s >= BP) { const float* cs = F.in[2] + (size_t)(s - BP) * 3 * 512; x3 = cs[ch]; x2 = cs[512 + ch]; x1 = cs[1024 + ch]; hh = F.in[3][(s - BP) * 512 + ch]; }
        for (int t0 = 0; t0 < T; t0 += 16) {
            float xa[16], ga[16];
#pragma unroll
            for (int j = 0; j < 16; ++j) { const bf16_t* p = F.U0() + (size_t)(base + t0 + j) * EV_IN; xa[j] = bf2f(p[C_XA + ch]); ga[j] = bf2f(p[C_GA + ch]); }
#pragma unroll
            for (int j = 0; j < 16; ++j) {
                const float xc = cw0 * x3 + cw1 * x2 + cw2 * x1 + cw3 * xa[j] + cb;
                x3 = x2; x2 = x1; x1 = xa[j];
                float za = ba, zx = bx;
#pragma unroll
                for (int i = 0; i < 64; ++i) { const float xi = __uint_as_float(__builtin_amdgcn_readlane(__float_as_uint(xc), i)); za += xi * wa[i]; zx += xi * wx[i]; }
                const float r = sigmoidf_(za), ig = sigmoidf_(zx), la = -8.0f * r * sp, a = __expf(la);
                const float gx = sqrtf(-expm1f(2.0f * la)) * (ig * xc);
                hh = a * hh + gx;
                F.Y0()[(size_t)(base + t0 + j) * D + ch] = (bf16_t)f2bf(hh * siluf_(ga[j]));
            }
        }
        if (s < BP) { F.out[O_LHP + s * 512 + ch] = hh; float* o = F.out + O_LCP + (size_t)s * 3 * 512; o[ch] = x3; o[512 + ch] = x2; o[1024 + ch] = x1; }
        else { F.out[O_LHS + (s - BP) * 512 + ch] = hh; float* o = F.out + O_LCS + (size_t)(s - BP) * 3 * 512; o[ch] = x3; o[512 + ch] = x2; o[1024 + ch] = x1; }
    }
}

__device__ __forceinline__ void phase_attn_naive(Frame& F) {
    PHASE_IDS();
    const int gt = F.vcu * 512 + tid, NT = F.G * 512;
    for (int idx = gt; idx < MT * 8; idx += NT) {
        const int hq = idx / MT, m = idx % MT, kv = hq >> 2;
        int s, t; tok_info(m, s, t);
        unsigned qp[32]; float o[64];
        { const u32x4* qq = (const u32x4*)(F.U0() + (size_t)m * EV_IN + C_Q + hq * 64);
#pragma unroll
          for (int c = 0; c < 8; ++c) { const u32x4 w = qq[c];
#pragma unroll
              for (int e = 0; e < 4; ++e) qp[c * 4 + e] = pk2(lo16(w[e]) * 0.125f, hi16(w[e]) * 0.125f); } }
#pragma unroll
        for (int d = 0; d < 64; ++d) o[d] = 0.f;
        float mx = F.in[22][hq], l = 1.0f;
        int nkeys, p0 = 0;
        if (s < BP) { const int c0 = (t >> 6) * 64; p0 = c0 - 128 < 0 ? 0 : c0 - 128; nkeys = c0 + 64 - p0; } else nkeys = 128 + TS;
        for (int j = 0; j < nkeys; ++j) {
            float sc = 0.f;
            const bool cached = (s >= BP && j < 128);
            const int mk = s < BP ? s * TP + p0 + j : seq_base(s) + (j - 128);
            const float* kpf = F.in[4] + ((size_t)((s - BP) * 128 + j) * 2 + kv) * 64; const float* vpf = F.in[5] + ((size_t)((s - BP) * 128 + j) * 2 + kv) * 64;
            const bf16_t* kpb = F.U0() + (size_t)mk * EV_IN + C_K + kv * 64; const bf16_t* vpb = F.U0() + (size_t)mk * EV_IN + C_V + kv * 64;
            if (cached) {
#pragma unroll
                for (int c = 0; c < 16; ++c) { const f32x4 a = *(const f32x4*)(kpf + 4 * c); sc += (lo16(qp[2 * c]) * a[0] + hi16(qp[2 * c]) * a[1]) + (lo16(qp[2 * c + 1]) * a[2] + hi16(qp[2 * c + 1]) * a[3]); }
            } else {
#pragma unroll
                for (int c = 0; c < 8; ++c) { const u32x4 a = *(const u32x4*)(kpb + 8 * c);
#pragma unroll
                    for (int e = 0; e < 4; ++e) sc += lo16(qp[c * 4 + e]) * lo16(a[e]) + hi16(qp[c * 4 + e]) * hi16(a[e]); }
            }
            const float mn = fmaxf(mx, sc), alpha = __expf(mx - mn), p = __expf(sc - mn);
            l = l * alpha + p; mx = mn;
            if (cached) {
#pragma unroll
                for (int c = 0; c < 16; ++c) { const f32x4 b = *(const f32x4*)(vpf + 4 * c);
#pragma unroll
                    for (int e = 0; e < 4; ++e) o[4 * c + e] = o[4 * c + e] * alpha + p * b[e]; }
            } else {
#pragma unroll
                for (int c = 0; c < 8; ++c) { const u32x4 b = *(const u32x4*)(vpb + 8 * c);
#pragma unroll
                    for (int e = 0; e < 4; ++e) { o[c * 8 + 2 * e] = o[c * 8 + 2 * e] * alpha + p * lo16(b[e]); o[c * 8 + 2 * e + 1] = o[c * 8 + 2 * e + 1] * alpha + p * hi16(b[e]); } }
            }
        }
        const float il = 1.0f / l;
        const u32x4* gp = (const u32x4*)(F.U0() + (size_t)m * EV_IN + C_GB + hq * 64);
        u32x4* yp = (u32x4*)(F.Y0() + (size_t)m * D + 512 + hq * 64);
#pragma unroll
        for (int c = 0; c < 8; ++c) { const u32x4 g = gp[c]; u32x4 w;
#pragma unroll
            for (int e = 0; e < 4; ++e) w[e] = pk2(o[c * 8 + 2 * e] * il * siluf_(lo16(g[e])), o[c * 8 + 2 * e + 1] * il * siluf_(hi16(g[e])));
            yp[c] = w; }
    }
}

__device__ __forceinline__ void phase_mid_rowwise(Frame& F) {
    PHASE_IDS();
    LAS float* baw = (LAS float*)F.lds;
    for (int idx = tid; idx < 16 * 1024; idx += 512) { const int j = idx & 15, k = idx >> 4; baw[j * 1024 + k] = F.in[28][(size_t)k * OD_IN + OD_MAIN + j]; }
    __syncthreads();
    const int gw = F.vcu * 8 + wave, NGW = F.G * 8;
    for (int m = gw; m < MT; m += NGW) {
        int s, t; tok_info(m, s, t);
        const float* xrow = m < MP ? F.in[0] + (size_t)m * D : F.in[1] + (size_t)(m - MP) * D;
        const float* mod0 = F.MOD() + (size_t)s * 3072; const float* mod1 = F.MOD() + (size_t)(24 + s) * 3072;
        f32x4 y[4]; float ss = 0.f;
#pragma unroll
        for (int j = 0; j < 4; ++j) { const u32x2 w = *(const u32x2*)(F.YO() + (size_t)m * D + 4 * lane + 256 * j); y[j] = (f32x4){lo16(w.x), hi16(w.x), lo16(w.y), hi16(w.y)};
            ss += (y[j][0] * y[j][0] + y[j][1] * y[j][1]) + (y[j][2] * y[j][2] + y[j][3] * y[j][3]); }
        const float r1 = rsqrtf(wave_sum(ss) * (1.f / D) + EPS);
        f32x4 x1[4]; float s2 = 0.f;
#pragma unroll
        for (int j = 0; j < 4; ++j) { const int c = 4 * lane + 256 * j;
            const f32x4 xv = *(const f32x4*)(xrow + c), g = *(const f32x4*)(F.in[13] + c), gt = *(const f32x4*)(mod0 + 2048 + c);
#pragma unroll
            for (int e = 0; e < 4; ++e) x1[j][e] = xv[e] + gt[e] * (y[j][e] * r1 * g[e]);
            *(f32x4*)(F.out + O_Y + (size_t)m * D + c) = x1[j];
            s2 += (x1[j][0] * x1[j][0] + x1[j][1] * x1[j][1]) + (x1[j][2] * x1[j][2] + x1[j][3] * x1[j][3]); }
        const float r2 = rsqrtf(wave_sum(s2) * (1.f / D) + EPS);
        f32x4 hm[4];
#pragma unroll
        for (int j = 0; j < 4; ++j) { const int c = 4 * lane + 256 * j;
            const f32x4 g = *(const f32x4*)(F.in[26] + c), sh = *(const f32x4*)(mod1 + c), sc = *(const f32x4*)(mod1 + 1024 + c);
#pragma unroll
            for (int e = 0; e < 4; ++e) hm[j][e] = x1[j][e] * r2 * g[e] * (1.f + sc[e]) + sh[e];
            u32x2 w; w.x = pk2(hm[j][0], hm[j][1]); w.y = pk2(hm[j][2], hm[j][3]); *(u32x2*)(F.XN() + (size_t)m * D + c) = w; }
        float mine = 0.f;
#pragma unroll 1
        for (int q = 0; q < 16; ++q) { float p = 0.f;
#pragma unroll
            for (int j = 0; j < 4; ++j) { const f32x4 w = *(const LAS f32x4*)(baw + q * 1024 + 256 * j + 4 * lane); p += (hm[j][0] * w[0] + hm[j][1] * w[1]) + (hm[j][2] * w[2] + hm[j][3] * w[3]); }
            p = wave_sum(p); mine = (lane == q) ? p : mine; }
        if (lane < 16) F.BA()[(size_t)m * 16 + lane] = mine;
    }
}

__device__ __forceinline__ void phase_gdn_prep_naive(Frame& F) {
    PHASE_IDS();
    const int gw = F.vcu * 8 + wave, NGW = F.G * 8;
    for (int idx = gw; idx < MT * 24; idx += NGW) {
        const int m = idx / 24, g = idx % 24, c = g * 128 + 2 * lane;
        int s, t; tok_info(m, s, t);
        float u0[4], u1[4];
#pragma unroll
        for (int j = 0; j < 4; ++j) { const int tt = t - 3 + j;
            if (tt >= 0) { const unsigned w = *(const unsigned*)(F.QKV1() + (size_t)(m - 3 + j) * 3072 + c); u0[j] = lo16(w); u1[j] = hi16(w); }
            else if (s >= BP) { const float* cs = F.in[6] + ((size_t)(s - BP) * 3 + (tt + 3)) * 3072 + c; u0[j] = cs[0]; u1[j] = cs[1]; }
            else { u0[j] = 0.f; u1[j] = 0.f; } }
        const float* cw = F.in[29] + c;
        float a0 = cw[0] * u0[0] + cw[3072] * u0[1] + cw[6144] * u0[2] + cw[9216] * u0[3];
        float a1 = cw[1] * u1[0] + cw[3073] * u1[1] + cw[6145] * u1[2] + cw[9217] * u1[3];
        a0 = siluf_(a0); a1 = siluf_(a1);
        if (g < 16) { const float ss = wave_sum(a0 * a0 + a1 * a1); float sc = rsqrtf(ss + EPS); if (g < 8) sc *= 0.08838834764831845f; a0 *= sc; a1 *= sc; }
        *(unsigned*)(F.QKVC() + (size_t)m * 3072 + c) = pk2(a0, a1);
        const int T = seq_len(s);
        if (t >= T - 3) { float* o = s < BP ? F.out + O_GCP + ((size_t)s * 3 + (t - (T - 3))) * 3072 + c : F.out + O_GCS + ((size_t)(s - BP) * 3 + (t - (T - 3))) * 3072 + c; o[0] = u0[3]; o[1] = u1[3]; }
    }
}

__device__ __forceinline__ void phase_gdn_rec_naive(Frame& F) {
    int tid = threadIdx.x; asm volatile("" : "+v"(tid));
    LAS float* kq = (LAS float*)F.lds;
    LAS float* red = kq + 1024;
    LAS float* red2 = red + 512;
    LAS float* misc = red2 + 512;
    const int v = tid & 127, rg = tid >> 7;
    for (int task = F.vcu; task < NSEQ * 8; task += F.G) {
        const int s = task >> 3, h = task & 7, T = seq_len(s), base = seq_base(s);
        float S[32];
        if (s < BP) {
#pragma unroll
            for (int i = 0; i < 32; ++i) S[i] = 0.f;
        } else {
#pragma unroll
            for (int i = 0; i < 32; ++i) S[i] = F.in[7][(((size_t)(s - BP) * 8 + h) * 128 + rg * 32 + i) * 128 + v];
        }
        const float Aexp = __expf(F.in[30][h]), dtb = F.in[31][h], hn = F.in[32][v];
        float nxt = 0.f;
        if (tid < 384) { const int part = tid >> 7; const int col = (part == 0 ? 1024 : part == 1 ? 0 : 2048) + h * 128 + (tid & 127); nxt = bf2f(F.QKVC()[(size_t)base * 3072 + col]); }
        __syncthreads();
        for (int t = 0; t < T; ++t) {
            LAS float* cur = kq + (t & 1) * 384;
            if (tid < 384) cur[tid] = nxt;
            if (tid < 384 && t + 1 < T) { const int part = tid >> 7; const int col = (part == 0 ? 1024 : part == 1 ? 0 : 2048) + h * 128 + (tid & 127); nxt = bf2f(F.QKVC()[(size_t)(base + t + 1) * 3072 + col]); }
            const float bb = F.BA()[(size_t)(base + t) * 16 + h], aa = F.BA()[(size_t)(base + t) * 16 + 8 + h];
            const float zz = bf2f(F.Z1()[(size_t)(base + t) * D + h * 128 + v]);
            const float beta = sigmoidf_(bb), g = -Aexp * softplusf_(aa + dtb), a = __expf(g);
            __syncthreads();
            float part = 0.f;
#pragma unroll
            for (int i = 0; i < 32; ++i) { S[i] *= a; part += cur[rg * 32 + i] * S[i]; }
            red[rg * 128 + v] = part;
            __syncthreads();
            const float kS = (red[v] + red[128 + v]) + (red[256 + v] + red[384 + v]);
            const float dlt = beta * (cur[256 + v] - kS);
            float po = 0.f;
#pragma unroll
            for (int i = 0; i < 32; ++i) { S[i] += cur[rg * 32 + i] * dlt; po += cur[128 + rg * 32 + i] * S[i]; }
            red2[rg * 128 + v] = po;
            __syncthreads();
            if (tid < 128) {
                const float o = (red2[v] + red2[128 + v]) + (red2[256 + v] + red2[384 + v]);
                const float sq = wave_sum(o * o);
                if ((tid & 63) == 0) misc[(tid >> 6)] = sq;
                red[v] = o;
            }
            __syncthreads();
            if (tid < 128) {
                const float o = red[v], r = rsqrtf((misc[0] + misc[1]) * (1.f / 128.f) + EPS);
                F.Y1()[(size_t)(base + t) * D + h * 128 + v] = (bf16_t)f2bf(o * r * hn * siluf_(zz));
            }
        }
        float* so = s < BP ? F.out + O_GSP + (((size_t)s * 8 + h) * 128 + rg * 32) * 128 + v : F.out + O_GSS + (((size_t)(s - BP) * 8 + h) * 128 + rg * 32) * 128 + v;
#pragma unroll
        for (int i = 0; i < 32; ++i) so[(size_t)i * 128] = S[i];
        __syncthreads();
    }
}

typedef float f32x16 __attribute__((ext_vector_type(16)));
typedef __bf16 bf16x2_t __attribute__((ext_vector_type(2)));
constexpr int GS_WF = 0, GS_QF = 16384, GS_KF = 32768, GS_PF = 49152, GS_UF = 57344, GS_BYTES = 73728;
constexpr size_t WS_DEC = 11 * MiB;
__device__ __forceinline__ unsigned cvt2(float a, float b) { f32x2 v = {a, b}; bf16x2_t r = __builtin_convertvector(v, bf16x2_t); return __builtin_bit_cast(unsigned, r); }
__device__ __forceinline__ int krow(int s, int h, int j) { return 16 * s + 8 * (j >> 2) + 4 * h + (j & 3); }
#define MFMA32(a, b, c) __builtin_amdgcn_mfma_f32_32x32x16_bf16((a), (b), (c), 0, 0, 0)

constexpr int G1_QS = 0, G1_KS = 17408, G1_VS = 34816, G1_AS = 52224, G1_PS = 69632, G1_WS = 78848, G1_CW = 96256, G1_VEC = 102400;
__device__ __forceinline__ void phase_gdn_g1(Frame& F) {
    int tid = threadIdx.x; asm volatile("" : "+v"(tid));
    const int lane = tid & 63, wave = __builtin_amdgcn_readfirstlane(tid >> 6);
    LAS unsigned char* L = F.lds;
    LAS float* cw_s = (LAS float*)(L + G1_CW);
    LAS float* beta_s = (LAS float*)(L + G1_VEC); LAS float* gcum_s = beta_s + 64; LAS float* eg_s = beta_s + 128; LAS float* ek_s = beta_s + 192;
    float* DEC = (float*)(F.ws + WS_DEC);
    for (int task = F.vcu; task < 4224; task += F.G) {
        int s, c, h; if (task < 4096) { s = task >> 9; c = (task >> 3) & 63; h = task & 7; } else { s = BP + ((task - 4096) >> 3); c = 0; h = task & 7; }
        const int nvalid = s < BP ? 64 : TS, t0 = c * 64, base = seq_base(s), T = seq_len(s);
        unsigned char* blk = F.ws + WS_RB + (size_t)task * GS_BYTES;
        for (int i = tid; i < 4 * 384; i += 512) { const int jj = i / 384, cc = i % 384; cw_s[i] = F.in[29][(size_t)jj * 3072 + (cc >> 7) * 1024 + h * 128 + (cc & 127)]; }
        if (tid < 64) {
            const bool ok = tid < nvalid; float beta = 0.f, g = 0.f;
            if (ok) { const float* ba = F.BA() + (size_t)(base + t0 + tid) * 16; beta = sigmoidf_(ba[h]); g = -__expf(F.in[30][h]) * softplusf_(ba[8 + h] + F.in[31][h]); }
            float x = g;
#pragma unroll
            for (int o = 1; o < 64; o <<= 1) { const float y = __shfl_up(x, o); if (lane >= o) x += y; }
            const float gl = __shfl(x, 63);
            beta_s[tid] = beta; gcum_s[tid] = x; eg_s[tid] = __expf(x); ek_s[tid] = ok ? __expf(gl - x) : 0.f;
            if (tid == 0) DEC[task] = __expf(gl);
        }
        __syncthreads();
        {
            int t1 = tid; asm volatile("" : "+v"(t1));
            const int r = t1 >> 3, j = t1 & 7, t = t0 + r; const bool ok = r < nvalid;
#pragma unroll 1
            for (int p = 0; p < 3; ++p) {
                float acc[16];
#pragma unroll
                for (int e = 0; e < 16; ++e) acc[e] = 0.f;
                float cur[16];
#pragma unroll
                for (int e = 0; e < 16; ++e) cur[e] = 0.f;
                if (ok) {
                    const int cb = p * 1024 + h * 128 + j * 16;
#pragma unroll
                    for (int jj = 0; jj < 4; ++jj) {
                        const int tt = t - 3 + jj; float x[16];
                        if (tt >= 0) { const u32x4* src = (const u32x4*)(F.QKV1() + (size_t)(base + tt) * 3072 + cb); const u32x4 a = src[0], b = src[1];
#pragma unroll
                            for (int e = 0; e < 4; ++e) { x[2 * e] = lo16(a[e]); x[2 * e + 1] = hi16(a[e]); x[8 + 2 * e] = lo16(b[e]); x[8 + 2 * e + 1] = hi16(b[e]); } }
                        else if (s >= BP) { const f32x4* src = (const f32x4*)(F.in[6] + ((size_t)(s - BP) * 3 + (tt + 3)) * 3072 + cb);
#pragma unroll
                            for (int q = 0; q < 4; ++q) { const f32x4 a = src[q]; x[4 * q] = a[0]; x[4 * q + 1] = a[1]; x[4 * q + 2] = a[2]; x[4 * q + 3] = a[3]; } }
                        else {
#pragma unroll
                            for (int e = 0; e < 16; ++e) x[e] = 0.f; }
                        const LAS f32x4* wp = (const LAS f32x4*)(cw_s + jj * 384 + p * 128 + j * 16);
#pragma unroll
                        for (int q = 0; q < 4; ++q) { const f32x4 w4 = wp[q]; acc[4 * q] += w4[0] * x[4 * q]; acc[4 * q + 1] += w4[1] * x[4 * q + 1]; acc[4 * q + 2] += w4[2] * x[4 * q + 2]; acc[4 * q + 3] += w4[3] * x[4 * q + 3]; }
                        if (jj == 3) {
#pragma unroll
                            for (int e = 0; e < 16; ++e) cur[e] = x[e]; }
                    }
                    if (t >= T - 3) {
                        float* o = (s < BP ? F.out + O_GCP + ((size_t)s * 3 + (t - (T - 3))) * 3072 : F.out + O_GCS + ((size_t)(s - BP) * 3 + (t - (T - 3))) * 3072) + cb;
#pragma unroll
                        for (int q = 0; q < 4; ++q) *(f32x4*)(o + 4 * q) = (f32x4){cur[4 * q], cur[4 * q + 1], cur[4 * q + 2], cur[4 * q + 3]};
                    }
                }
                float ss = 0.f;
#pragma unroll
                for (int e = 0; e < 16; ++e) { acc[e] = siluf_(acc[e]); ss += acc[e] * acc[e]; }
                if (p < 2) { ss += __shfl_xor(ss, 1); ss += __shfl_xor(ss, 2); ss += __shfl_xor(ss, 4);
                    float sc = rsqrtf(ss + EPS); if (p == 0) sc *= 0.08838834764831845f;
#pragma unroll
                    for (int e = 0; e < 16; ++e) acc[e] *= sc; }
                u32x4 w0, w1;
#pragma unroll
                for (int e = 0; e < 4; ++e) { w0[e] = ok ? cvt2(acc[2 * e], acc[2 * e + 1]) : 0u; w1[e] = ok ? cvt2(acc[8 + 2 * e], acc[8 + 2 * e + 1]) : 0u; }
                LAS u32x4* dst = (LAS u32x4*)(L + (p == 0 ? G1_QS : p == 1 ? G1_KS : G1_VS) + r * 272 + j * 32);
                dst[0] = w0; dst[1] = w1;
            }
        }
        __syncthreads();
        {
            int l2 = lane; asm volatile("" : "+v"(l2));
            const int which = wave >> 2, ti = (wave >> 1) & 1, tj = wave & 1, r = l2 & 31, hh = l2 >> 5;
            f32x16 acc;
#pragma unroll
            for (int e = 0; e < 16; ++e) acc[e] = 0.f;
            if (!(ti == 0 && tj == 1)) {
                const LAS unsigned char* ap = L + (which ? G1_QS : G1_KS) + (32 * ti + r) * 272 + hh * 16;
                const LAS unsigned char* bp = L + G1_KS + (32 * tj + r) * 272 + hh * 16;
#pragma unroll
                for (int ks = 0; ks < 8; ++ks) { const bf16x8 a = *(const LAS bf16x8*)(ap + ks * 32), b = *(const LAS bf16x8*)(bp + ks * 32); acc = MFMA32(a, b, acc); }
            }
            const int jc = 32 * tj + r; const float gj = gcum_s[jc];
#pragma unroll
            for (int e = 0; e < 16; ++e) {
                const int i = 32 * ti + (e & 3) + 8 * (e >> 2) + 4 * hh; const float dg = gcum_s[i] - gj;
                if (which == 0) { const float f = (i > jc) ? __expf(dg) * beta_s[i] : 0.f; *(LAS float*)(L + G1_AS + i * 272 + jc * 4) = acc[e] * f; }
                else { const float f = (i >= jc) ? __expf(dg) : 0.f; *(LAS bf16_t*)(L + G1_PS + i * 144 + jc * 2) = (bf16_t)(cvt2(acc[e] * f, 0.f) & 0xffffu); }
            }
        }
        __syncthreads();
        if (tid < 256) {
            int t3 = tid; asm volatile("" : "+v"(t3));
            const bool isw = t3 < 128; const int d = t3 & 127;
            float X[64];
#pragma unroll
            for (int i = 0; i < 64; ++i) { const float raw = bf2f(*(const LAS bf16_t*)(L + (isw ? G1_KS : G1_VS) + i * 272 + d * 2)); X[i] = raw * beta_s[i] * (isw ? eg_s[i] : 1.0f); }
            unsigned abase = (unsigned)(size_t)(L + G1_AS);
#pragma unroll
            for (int i = 1; i < 64; ++i) {
                unsigned ra = abase + i * 272;
                if (i >= 3) asm volatile("" : "+v"(ra) : "v"(X[i - 2]));
                float a = X[i];
#pragma unroll
                for (int j4 = 0; j4 <= (i - 1) / 4; ++j4) { const f32x4 a4 = *(const LAS f32x4*)(ra + j4 * 16);
                    a -= a4[0] * X[4 * j4]; a -= a4[1] * X[4 * j4 + 1]; a -= a4[2] * X[4 * j4 + 2]; a -= a4[3] * X[4 * j4 + 3]; }
                X[i] = a;
            }
            if (isw) {
#pragma unroll
                for (int i = 0; i < 64; ++i) *(LAS bf16_t*)(L + G1_WS + i * 272 + d * 2) = (bf16_t)(cvt2(-X[i], 0.f) & 0xffffu);
            } else {
                const int ws = d >> 5, cc = d & 31;
#pragma unroll
                for (int rt = 0; rt < 2; ++rt)
#pragma unroll
                    for (int hh = 0; hh < 2; ++hh) { u32x4 o0, o1;
#pragma unroll
                        for (int q = 0; q < 2; ++q) { const int i0 = 32 * rt + 8 * q + 4 * hh, i1 = 32 * rt + 8 * (q + 2) + 4 * hh;
                            o0[2 * q] = cvt2(X[i0], X[i0 + 1]); o0[2 * q + 1] = cvt2(X[i0 + 2], X[i0 + 3]); o1[2 * q] = cvt2(X[i1], X[i1 + 1]); o1[2 * q + 1] = cvt2(X[i1 + 2], X[i1 + 3]); }
                        u32x4* dst = (u32x4*)(blk + GS_UF + (size_t)(((ws * 2 + rt) * 64) + cc + 32 * hh) * 32); dst[0] = o0; dst[1] = o1; }
            }
        } else {
            int l3 = lane; asm volatile("" : "+v"(l3));
            const int wv = wave - 4, r = l3 & 31, hh = l3 >> 5;
            {   const int rt4 = wv;
#pragma unroll
                for (int kt2 = 0; kt2 < 2; ++kt2)
#pragma unroll
                    for (int ss = 0; ss < 2; ++ss) { float v[8];
#pragma unroll
                        for (int j = 0; j < 8; ++j) { const int tok = 32 * kt2 + krow(ss, hh, j); v[j] = bf2f(*(const LAS bf16_t*)(L + G1_KS + tok * 272 + (32 * rt4 + r) * 2)) * ek_s[tok]; }
                        u32x4 o; o[0] = cvt2(v[0], v[1]); o[1] = cvt2(v[2], v[3]); o[2] = cvt2(v[4], v[5]); o[3] = cvt2(v[6], v[7]);
                        *(u32x4*)(blk + GS_KF + ((rt4 * 2 + kt2) * 2 + ss) * 1024 + lane * 16) = o; } }
            {   const int kt = wv;
#pragma unroll
                for (int rt = 0; rt < 2; ++rt)
#pragma unroll
                    for (int ss = 0; ss < 2; ++ss) { const int i = 32 * rt + r; const float sc = eg_s[i];
                        const u32x2 lo = *(const LAS u32x2*)(L + G1_QS + i * 272 + (32 * kt + 16 * ss + 4 * hh) * 2), hi = *(const LAS u32x2*)(L + G1_QS + i * 272 + (32 * kt + 16 * ss + 8 + 4 * hh) * 2);
                        u32x4 o; o[0] = cvt2(lo16(lo[0]) * sc, hi16(lo[0]) * sc); o[1] = cvt2(lo16(lo[1]) * sc, hi16(lo[1]) * sc); o[2] = cvt2(lo16(hi[0]) * sc, hi16(hi[0]) * sc); o[3] = cvt2(lo16(hi[1]) * sc, hi16(hi[1]) * sc);
                        *(u32x4*)(blk + GS_QF + ((rt * 4 + kt) * 2 + ss) * 1024 + lane * 16) = o; } }
            {   const int rt = wv >> 1, kt2 = wv & 1;
#pragma unroll
                for (int ss = 0; ss < 2; ++ss) { const int i = 32 * rt + r;
                    const u32x2 lo = *(const LAS u32x2*)(L + G1_PS + i * 144 + (32 * kt2 + 16 * ss + 4 * hh) * 2), hi = *(const LAS u32x2*)(L + G1_PS + i * 144 + (32 * kt2 + 16 * ss + 8 + 4 * hh) * 2);
                    u32x4 o; o[0] = lo[0]; o[1] = lo[1]; o[2] = hi[0]; o[3] = hi[1];
                    *(u32x4*)(blk + GS_PF + ((rt * 2 + kt2) * 2 + ss) * 1024 + lane * 16) = o; } }
        }
        __syncthreads();
        {
            int l4 = lane; asm volatile("" : "+v"(l4));
            const int kt = wave & 3, rt = wave >> 2, r = l4 & 31, hh = l4 >> 5, i = 32 * rt + r;
#pragma unroll
            for (int ss = 0; ss < 2; ++ss) {
                const u32x2 lo = *(const LAS u32x2*)(L + G1_WS + i * 272 + (32 * kt + 16 * ss + 4 * hh) * 2), hi = *(const LAS u32x2*)(L + G1_WS + i * 272 + (32 * kt + 16 * ss + 8 + 4 * hh) * 2);
                u32x4 o; o[0] = lo[0]; o[1] = lo[1]; o[2] = hi[0]; o[3] = hi[1];
                *(u32x4*)(blk + GS_WF + ((rt * 4 + kt) * 2 + ss) * 1024 + lane * 16) = o; }
        }
        __syncthreads();
    }
}

constexpr int G2_FB = 57344, G2_OS = 2 * G2_FB, G2_OSTRIDE = 528;
__device__ __forceinline__ bf16x8 pack8(const f32x16& x, const int s) {
    u32x4 p; p[0] = cvt2(x[8 * s], x[8 * s + 1]); p[1] = cvt2(x[8 * s + 2], x[8 * s + 3]); p[2] = cvt2(x[8 * s + 4], x[8 * s + 5]); p[3] = cvt2(x[8 * s + 6], x[8 * s + 7]);
    return __builtin_bit_cast(bf16x8, p);
}
__device__ __forceinline__ void phase_gdn_g2(Frame& F) {
    int tid = threadIdx.x; asm volatile("" : "+v"(tid));
    const int lane = tid & 63, wave = __builtin_amdgcn_readfirstlane(tid >> 6);
    LAS unsigned char* L = F.lds;
    const float* DEC = (const float*)(F.ws + WS_DEC);
    for (int task = blockIdx.x; task < 192; task += F.G) {
        int s, h, nch, ch0; if (task < 64) { s = task >> 3; h = task & 7; nch = 64; ch0 = s * 512 + h; } else { s = BP + ((task - 64) >> 3); h = task & 7; nch = 1; ch0 = 4096 + (s - BP) * 8 + h; }
        const int cstride = 8;
        const int base = seq_base(s), nvalid = s < BP ? 64 : TS;
        const unsigned char* blk0 = F.ws + WS_RB + (size_t)ch0 * GS_BYTES;
        if (wave < 4) {
            const int ws = wave, cc = lane & 31, hh = lane >> 5;
            f32x16 S0, S1, S2, S3;
            if (s < BP) {
#pragma unroll
                for (int e = 0; e < 16; ++e) { S0[e] = 0.f; S1[e] = 0.f; S2[e] = 0.f; S3[e] = 0.f; }
            } else {
                const float* sp = F.in[7] + ((size_t)(s - BP) * 8 + h) * 16384 + 32 * ws + cc;
#pragma unroll
                for (int e = 0; e < 16; ++e) { const int rr = (e & 3) + 8 * (e >> 2) + 4 * hh; S0[e] = sp[(size_t)rr * 128]; S1[e] = sp[(size_t)(32 + rr) * 128]; S2[e] = sp[(size_t)(64 + rr) * 128]; S3[e] = sp[(size_t)(96 + rr) * 128]; }
            }
            u32x4 un[4];
            { const u32x4* up = (const u32x4*)(blk0 + GS_UF + (size_t)(ws * 2 * 64 + lane) * 32); un[0] = up[0]; un[1] = up[1]; un[2] = up[128]; un[3] = up[129]; }
            __syncthreads();
            for (int c = 0; c < nch; ++c) {
                const LAS unsigned char* B = L + (c & 1) * G2_FB + lane * 16;
                const float dec = DEC[ch0 + c * cstride];
                f32x16 vn0, vn1, o0, o1;
#pragma unroll
                for (int q = 0; q < 4; ++q) { vn0[2 * q] = lo16(un[0][q]); vn0[2 * q + 1] = hi16(un[0][q]); vn0[8 + 2 * q] = lo16(un[1][q]); vn0[8 + 2 * q + 1] = hi16(un[1][q]);
                                              vn1[2 * q] = lo16(un[2][q]); vn1[2 * q + 1] = hi16(un[2][q]); vn1[8 + 2 * q] = lo16(un[3][q]); vn1[8 + 2 * q + 1] = hi16(un[3][q]); }
#pragma unroll
                for (int e = 0; e < 16; ++e) { o0[e] = 0.f; o1[e] = 0.f; }
                if (c + 1 < nch) { const u32x4* up = (const u32x4*)(blk0 + (size_t)(c + 1) * cstride * GS_BYTES + GS_UF + (size_t)(ws * 2 * 64 + lane) * 32); un[0] = up[0]; un[1] = up[1]; un[2] = up[128]; un[3] = up[129]; }
#define G2_WQ(Sx, kt) do { _Pragma("unroll") for (int ss = 0; ss < 2; ++ss) { const bf16x8 sb = pack8(Sx, ss); \
                    const bf16x8 fw0 = *(const LAS bf16x8*)(B + GS_WF + ((0 * 4 + kt) * 2 + ss) * 1024), fw1 = *(const LAS bf16x8*)(B + GS_WF + ((1 * 4 + kt) * 2 + ss) * 1024); \
                    const bf16x8 fq0 = *(const LAS bf16x8*)(B + GS_QF + ((0 * 4 + kt) * 2 + ss) * 1024), fq1 = *(const LAS bf16x8*)(B + GS_QF + ((1 * 4 + kt) * 2 + ss) * 1024); \
                    vn0 = MFMA32(fw0, sb, vn0); vn1 = MFMA32(fw1, sb, vn1); o0 = MFMA32(fq0, sb, o0); o1 = MFMA32(fq1, sb, o1); } } while (0)
                G2_WQ(S0, 0); G2_WQ(S1, 1); G2_WQ(S2, 2); G2_WQ(S3, 3);
#undef G2_WQ
                bf16x8 vb[2][2];
                vb[0][0] = pack8(vn0, 0); vb[0][1] = pack8(vn0, 1); vb[1][0] = pack8(vn1, 0); vb[1][1] = pack8(vn1, 1);
#pragma unroll
                for (int kt2 = 0; kt2 < 2; ++kt2)
#pragma unroll
                    for (int ss = 0; ss < 2; ++ss) {
                        const bf16x8 fp0 = *(const LAS bf16x8*)(B + GS_PF + ((0 * 2 + kt2) * 2 + ss) * 1024), fp1 = *(const LAS bf16x8*)(B + GS_PF + ((1 * 2 + kt2) * 2 + ss) * 1024);
                        o0 = MFMA32(fp0, vb[kt2][ss], o0); o1 = MFMA32(fp1, vb[kt2][ss], o1); }
#define G2_KS(Sx, rt4) do { Sx = Sx * dec; _Pragma("unroll") for (int kt2 = 0; kt2 < 2; ++kt2) _Pragma("unroll") for (int ss = 0; ss < 2; ++ss) { \
                    const bf16x8 fk = *(const LAS bf16x8*)(B + GS_KF + ((rt4 * 2 + kt2) * 2 + ss) * 1024); Sx = MFMA32(fk, vb[kt2][ss], Sx); } } while (0)
                G2_KS(S0, 0); G2_KS(S1, 1); G2_KS(S2, 2); G2_KS(S3, 3);
#undef G2_KS
                __syncthreads();
#pragma unroll
                for (int e = 0; e < 16; ++e) { const int rr = (e & 3) + 8 * (e >> 2) + 4 * hh;
                    *(LAS float*)(L + G2_OS + rr * G2_OSTRIDE + (32 * ws + cc) * 4) = o0[e]; *(LAS float*)(L + G2_OS + (32 + rr) * G2_OSTRIDE + (32 * ws + cc) * 4) = o1[e]; }
                __syncthreads();
            }
            float* so = (s < BP ? F.out + O_GSP + ((size_t)s * 8 + h) * 16384 : F.out + O_GSS + ((size_t)(s - BP) * 8 + h) * 16384) + 32 * ws + cc;
#pragma unroll
            for (int e = 0; e < 16; ++e) { const int rr = (e & 3) + 8 * (e >> 2) + 4 * hh; so[(size_t)rr * 128] = S0[e]; so[(size_t)(32 + rr) * 128] = S1[e]; so[(size_t)(64 + rr) * 128] = S2[e]; so[(size_t)(96 + rr) * 128] = S3[e]; }
        } else {
            const int lt = tid - 256;
            u32x4 pre[14];
            { const u32x4* src = (const u32x4*)blk0;
#pragma unroll
              for (int i = 0; i < 14; ++i) pre[i] = src[i * 256 + lt];
#pragma unroll
              for (int i = 0; i < 14; ++i) *(LAS u32x4*)(L + (size_t)(i * 256 + lt) * 16) = pre[i]; }
            __syncthreads();
            const int row = lt >> 2, seg = lt & 3;
            f32x4 hn[8];
#pragma unroll
            for (int q = 0; q < 8; ++q) hn[q] = *(const f32x4*)(F.in[32] + seg * 32 + 4 * q);
            for (int c = 0; c < nch; ++c) {
                const bool more = c + 1 < nch;
                if (more) { const u32x4* src = (const u32x4*)(blk0 + (size_t)(c + 1) * cstride * GS_BYTES);
#pragma unroll
                    for (int i = 0; i < 14; ++i) pre[i] = src[i * 256 + lt]; }
                const int m = base + c * 64 + row; const bool rok = row < nvalid;
                u32x4 zz[4];
                if (rok) { const u32x4* zp = (const u32x4*)(F.Z1() + (size_t)m * D + h * 128 + seg * 32);
#pragma unroll
                    for (int q = 0; q < 4; ++q) zz[q] = zp[q]; }
                __syncthreads();
                if (more) {
#pragma unroll
                    for (int i = 0; i < 14; ++i) *(LAS u32x4*)(L + ((c + 1) & 1) * G2_FB + (size_t)(i * 256 + lt) * 16) = pre[i]; }
                __syncthreads();
                f32x4 ov[8]; float ss = 0.f;
#pragma unroll
                for (int q = 0; q < 8; ++q) { ov[q] = *(const LAS f32x4*)(L + G2_OS + row * G2_OSTRIDE + (seg * 32 + 4 * q) * 4); ss += (ov[q][0] * ov[q][0] + ov[q][1] * ov[q][1]) + (ov[q][2] * ov[q][2] + ov[q][3] * ov[q][3]); }
                ss += __shfl_xor(ss, 1); ss += __shfl_xor(ss, 2);
                const float rn = rsqrtf(ss * (1.f / 128.f) + EPS);
                if (rok) { u32x4 yo[4];
#pragma unroll
                    for (int q = 0; q < 4; ++q) {
#pragma unroll
                        for (int e = 0; e < 4; ++e) { const int q2 = 2 * q + (e >> 1), e2 = 2 * (e & 1); const float z0 = lo16(zz[q][e]), z1 = hi16(zz[q][e]);
                            yo[q][e] = cvt2(ov[q2][e2] * rn * hn[q2][e2] * siluf_(z0), ov[q2][e2 + 1] * rn * hn[q2][e2 + 1] * siluf_(z1)); } }
                    u32x4* yp = (u32x4*)(F.Y1() + (size_t)m * D + h * 128 + seg * 32);
#pragma unroll
                    for (int q = 0; q < 4; ++q) yp[q] = yo[q]; }
            }
        }
        __syncthreads();
    }
}

#define MFMA16(a, b, c) __builtin_amdgcn_mfma_f32_16x16x32_bf16((a), (b), (c), 0, 0, 0)
__device__ __forceinline__ float dpp_shr_f(float idv, float x, const int o) {
    int r;
    switch (o) {
        case 1: r = __builtin_amdgcn_update_dpp(__float_as_int(idv), __float_as_int(x), 0x111, 0xf, 0xf, false); break;
        case 2: r = __builtin_amdgcn_update_dpp(__float_as_int(idv), __float_as_int(x), 0x112, 0xf, 0xf, false); break;
        case 4: r = __builtin_amdgcn_update_dpp(__float_as_int(idv), __float_as_int(x), 0x114, 0xf, 0xf, false); break;
        default: r = __builtin_amdgcn_update_dpp(__float_as_int(idv), __float_as_int(x), 0x118, 0xf, 0xf, false); break;
    }
    return __int_as_float(r);
}
template <int PASS>
__device__ __forceinline__ void phase_lru(Frame& F) {
    int tid = threadIdx.x; asm volatile("" : "+v"(tid));
    const int lane = tid & 63, wave = __builtin_amdgcn_readfirstlane(tid >> 6);
    const int gw = F.vcu * 8 + wave, NGW = F.G * 8, h = gw & 7, g = lane >> 4, l15 = lane & 15;
    LAS unsigned char* xs = F.lds + wave * 9216;
    LAS float* cst = (LAS float*)(F.lds + 73728 + wave * 768);
    const bf16_t* LGW = (const bf16_t*)(F.ws + WS_LGW);
    float* LAG = F.LAG();
    bf16x8 wfa[4][2], wfx[4][2];
#pragma unroll
    for (int nt = 0; nt < 4; ++nt)
#pragma unroll
        for (int ks = 0; ks < 2; ++ks) {
            wfa[nt][ks] = *(const bf16x8*)(LGW + ((size_t)(h * 2 + 0) * 64 + 16 * nt + l15) * 64 + 32 * ks + 8 * g);
            wfx[nt][ks] = *(const bf16x8*)(LGW + ((size_t)(h * 2 + 1) * 64 + 16 * nt + l15) * 64 + 32 * ks + 8 * g); }
    cst[lane] = F.in[18][h * 64 + lane]; cst[64 + lane] = F.in[20][h * 64 + lane]; cst[128 + lane] = softplusf_(-F.in[21][h * 64 + lane]);
    for (int task = gw; task < 4224; task += NGW) {
        int s, c; if (task < 4096) { s = task >> 9; c = (task >> 3) & 63; } else { s = BP + ((task - 4096) >> 3); c = 0; }
        const int T = seq_len(s), base = seq_base(s), t0 = c * 64, ntile = s < BP ? 4 : 1;
        {
            int l1 = lane; asm volatile("" : "+v"(l1));
            const int cg = l1 & 7, tp = l1 >> 3, chb = h * 64 + cg * 8;
            float xr[11][8];
#pragma unroll
            for (int i = 0; i < 11; ++i) {
                const int tt = t0 + tp * 8 - 3 + i;
                if (tt >= 0 && tt < T) { const u32x4 w = *(const u32x4*)(F.U0() + (size_t)(base + tt) * EV_IN + C_XA + chb);
#pragma unroll
                    for (int e = 0; e < 4; ++e) { xr[i][2 * e] = lo16(w[e]); xr[i][2 * e + 1] = hi16(w[e]); } }
                else if (tt < 0 && s >= BP) { const f32x4* sp = (const f32x4*)(F.in[2] + ((size_t)(s - BP) * 3 + (tt + 3)) * 512 + chb); const f32x4 a = sp[0], b = sp[1];
                    xr[i][0] = a[0]; xr[i][1] = a[1]; xr[i][2] = a[2]; xr[i][3] = a[3]; xr[i][4] = b[0]; xr[i][5] = b[1]; xr[i][6] = b[2]; xr[i][7] = b[3]; }
                else {
#pragma unroll
                    for (int e = 0; e < 8; ++e) xr[i][e] = 0.f; }
            }
            float cw[4][8], cb[8];
#pragma unroll
            for (int jj = 0; jj < 4; ++jj) { const f32x4 a = *(const f32x4*)(F.in[15] + jj * 512 + chb), b = *(const f32x4*)(F.in[15] + jj * 512 + chb + 4);
                cw[jj][0] = a[0]; cw[jj][1] = a[1]; cw[jj][2] = a[2]; cw[jj][3] = a[3]; cw[jj][4] = b[0]; cw[jj][5] = b[1]; cw[jj][6] = b[2]; cw[jj][7] = b[3]; }
            { const f32x4 a = *(const f32x4*)(F.in[16] + chb), b = *(const f32x4*)(F.in[16] + chb + 4); cb[0] = a[0]; cb[1] = a[1]; cb[2] = a[2]; cb[3] = a[3]; cb[4] = b[0]; cb[5] = b[1]; cb[6] = b[2]; cb[7] = b[3]; }
#pragma unroll
            for (int i = 0; i < 8; ++i) { float o[8];
#pragma unroll
                for (int e = 0; e < 8; ++e) o[e] = cw[0][e] * xr[i][e] + cw[1][e] * xr[i + 1][e] + cw[2][e] * xr[i + 2][e] + cw[3][e] * xr[i + 3][e] + cb[e];
                u32x4 w; w[0] = cvt2(o[0], o[1]); w[1] = cvt2(o[2], o[3]); w[2] = cvt2(o[4], o[5]); w[3] = cvt2(o[6], o[7]);
                *(LAS u32x4*)(xs + (tp * 8 + i) * 144 + cg * 16) = w; }
            if (PASS == 2 && t0 + 64 >= T && tp == ((T - 1) >> 3) - (t0 >> 3)) {
                float* o = (s < BP ? F.out + O_LCP + (size_t)s * 3 * 512 : F.out + O_LCS + (size_t)(s - BP) * 3 * 512) + chb;
#pragma unroll
                for (int q = 0; q < 3; ++q) { *(f32x4*)(o + q * 512) = (f32x4){xr[8 + q][0], xr[8 + q][1], xr[8 + q][2], xr[8 + q][3]}; *(f32x4*)(o + q * 512 + 4) = (f32x4){xr[8 + q][4], xr[8 + q][5], xr[8 + q][6], xr[8 + q][7]}; }
            }
        }
        float hin[4][4], arun[4][4];
#pragma unroll
        for (int nt = 0; nt < 4; ++nt)
#pragma unroll
            for (int rg = 0; rg < 4; ++rg) { hin[nt][rg] = 0.f; arun[nt][rg] = 1.f; }
        if (PASS == 2) {
            float hf = s >= BP ? F.in[3][(s - BP) * 512 + h * 64 + lane] : 0.f;
            const f32x2* lp = (const f32x2*)LAG + (size_t)(s * 64) * 512 + h * 64 + lane;
            int j = 0;
            for (; j + 8 <= c; j += 8) { f32x2 v[8];
#pragma unroll
                for (int q = 0; q < 8; ++q) v[q] = lp[(size_t)(j + q) * 512];
#pragma unroll
                for (int q = 0; q < 8; ++q) hf = v[q][0] * hf + v[q][1]; }
            for (; j < c; ++j) { const f32x2 v = lp[(size_t)j * 512]; hf = v[0] * hf + v[1]; }
#pragma unroll
            for (int nt = 0; nt < 4; ++nt)
#pragma unroll
                for (int rg = 0; rg < 4; ++rg) hin[nt][rg] = __shfl(hf, 16 * nt + 4 * g + rg);
        }
        asm volatile("s_waitcnt lgkmcnt(0)" ::: "memory");
        for (int tt = 0; tt < ntile; ++tt) {
            const int tok = 16 * tt + l15;
            const bf16x8 b0 = *(const LAS bf16x8*)(xs + tok * 144 + (8 * g) * 2), b1 = *(const LAS bf16x8*)(xs + tok * 144 + (32 + 8 * g) * 2);
            const size_t m = (size_t)base + t0 + tok;
#pragma unroll
            for (int nt = 0; nt < 4; ++nt) {
                f32x4 za = {0.f, 0.f, 0.f, 0.f}, zx = {0.f, 0.f, 0.f, 0.f};
                za = MFMA16(wfa[nt][0], b0, za); za = MFMA16(wfa[nt][1], b1, za);
                zx = MFMA16(wfx[nt][0], b0, zx); zx = MFMA16(wfx[nt][1], b1, zx);
                const int n0 = 16 * nt + 4 * g;
                const u32x2 xw = *(const LAS u32x2*)(xs + tok * 144 + n0 * 2);
                const float xc[4] = {lo16(xw[0]), hi16(xw[0]), lo16(xw[1]), hi16(xw[1])};
                const f32x4 cba = *(const LAS f32x4*)(cst + n0), cbx = *(const LAS f32x4*)(cst + 64 + n0), csp = *(const LAS f32x4*)(cst + 128 + n0);
                float av[4], bv[4];
#pragma unroll
                for (int rg = 0; rg < 4; ++rg) {
                    const float r = sigmoidf_(za[rg] + cba[rg]), ig = sigmoidf_(zx[rg] + cbx[rg]), la = -8.0f * r * csp[rg], a = __expf(la);
                    av[rg] = a; bv[rg] = sqrtf(fmaxf(1.0f - a * a, 0.f)) * (ig * xc[rg]); }
#pragma unroll
                for (int o = 1; o < 16; o <<= 1)
#pragma unroll
                    for (int rg = 0; rg < 4; ++rg) { const float ap = dpp_shr_f(1.0f, av[rg], o), bp = dpp_shr_f(0.0f, bv[rg], o); bv[rg] = av[rg] * bp + bv[rg]; av[rg] = av[rg] * ap; }
                float hv[4];
#pragma unroll
                for (int rg = 0; rg < 4; ++rg) { hv[rg] = bv[rg] + av[rg] * hin[nt][rg]; hin[nt][rg] = __shfl(hv[rg], (lane & 48) | 15); }
                if (PASS == 1) {
#pragma unroll
                    for (int rg = 0; rg < 4; ++rg) arun[nt][rg] *= __shfl(av[rg], (lane & 48) | 15);
                } else {
                    const bool tok_ok = (t0 + tok) < T;
                    if (tok_ok) {
                        const u32x2 gw2 = *(const u32x2*)(F.U0() + m * EV_IN + C_GA + h * 64 + n0);
                        u32x2 yo; yo[0] = cvt2(hv[0] * siluf_(lo16(gw2[0])), hv[1] * siluf_(hi16(gw2[0]))); yo[1] = cvt2(hv[2] * siluf_(lo16(gw2[1])), hv[3] * siluf_(hi16(gw2[1])));
                        *(u32x2*)(F.Y0() + m * D + h * 64 + n0) = yo;
                        if (t0 + tok == T - 1) { float* o = (s < BP ? F.out + O_LHP + s * 512 : F.out + O_LHS + (s - BP) * 512) + h * 64 + n0; *(f32x4*)o = (f32x4){hv[0], hv[1], hv[2], hv[3]}; }
                    }
                }
            }
        }
        if (PASS == 1 && s < BP && l15 == 15) {
            f32x2* lp = (f32x2*)LAG + (size_t)(s * 64 + c) * 512 + h * 64;
#pragma unroll
            for (int nt = 0; nt < 4; ++nt)
#pragma unroll
                for (int rg = 0; rg < 4; ++rg) lp[16 * nt + 4 * g + rg] = (f32x2){arun[nt][rg], hin[nt][rg]};
        }
        asm volatile("s_waitcnt lgkmcnt(0)" ::: "memory");
    }
}

__device__ __forceinline__ void phase_final_rowwise(Frame& F) {
    PHASE_IDS();
    const int gw = F.vcu * 8 + wave, NGW = F.G * 8;
    for (int m = gw; m < MT; m += NGW) {
        int s, t; tok_info(m, s, t);
        const float* mod1 = F.MOD() + (size_t)(24 + s) * 3072;
        f32x4 y[4]; float ss = 0.f;
#pragma unroll
        for (int j = 0; j < 4; ++j) { const u32x2 w = *(const u32x2*)(F.YO() + (size_t)m * D + 4 * lane + 256 * j); y[j] = (f32x4){lo16(w.x), hi16(w.x), lo16(w.y), hi16(w.y)};
            ss += (y[j][0] * y[j][0] + y[j][1] * y[j][1]) + (y[j][2] * y[j][2] + y[j][3] * y[j][3]); }
        const float r1 = rsqrtf(wave_sum(ss) * (1.f / D) + EPS);
#pragma unroll
        for (int j = 0; j < 4; ++j) { const int c = 4 * lane + 256 * j;
            float* op = F.out + O_Y + (size_t)m * D + c;
            const f32x4 xv = *(const f32x4*)op, g = *(const f32x4*)(F.in[27] + c), gt = *(const f32x4*)(mod1 + 2048 + c);
            f32x4 o;
#pragma unroll
            for (int e = 0; e < 4; ++e) o[e] = xv[e] + gt[e] * (y[j][e] * r1 * g[e]);
            *(f32x4*)op = o; }
    }
}

__global__ void __launch_bounds__(512, 2) fwd_megakernel(Params P) {
    extern __shared__ __attribute__((aligned(16))) unsigned char lds_raw[];
    cg::grid_group grid = cg::this_grid();
    Frame F;
    F.lds = (LAS unsigned char*)lds_raw;
    F.G = gridDim.x; { const int bx = blockIdx.x; F.vcu = (F.G % 8 == 0) ? (bx % 8) * (F.G / 8) + bx / 8 : bx; }
    F.in = P.in; F.out = P.out; F.ws = P.ws;

    phase_prologue(F);
    grid.sync();
    phase_prenorm0(F);
    grid.sync();
    { pg8::Gemm g{F.XN(), F.W0I(), MT, EV_IN, D}; pg8::StaticOrder S; S.init(MT, EV_IN, F.G, (int)blockIdx.x);
      pg8::EpiBf16 E{F.U0(), EV_IN, 1 << 30, F.U0(), EV_IN}; pg8::gemm_phase(F.lds, g, S, E); }
    grid.sync();
    phase_rope(F);
    phase_lru<1>(F);
    grid.sync();
    phase_lru<2>(F);
    phase_attn_naive(F);
    grid.sync();
    { pg8::Gemm g{F.Y0(), F.W0O(), MT, D, D}; pg8::StaticOrder S; S.init(MT, D, F.G, (int)blockIdx.x);
      pg8::EpiBf16 E{F.YO(), D, 1 << 30, F.YO(), D}; pg8::gemm_phase(F.lds, g, S, E); }
    grid.sync();
    phase_mid_rowwise(F);
    grid.sync();
    { pg8::Gemm g{F.XN(), F.W1I(), MT, OD_MAIN, D}; pg8::StaticOrder S; S.init(MT, OD_MAIN, F.G, (int)blockIdx.x);
      pg8::EpiBf16 E{F.QKV1(), 3072, 3072, F.Z1(), D}; pg8::gemm_phase(F.lds, g, S, E); }
    grid.sync();
    phase_gdn_g1(F);
    grid.sync();
    phase_gdn_g2(F);
    grid.sync();
    { pg8::Gemm g{F.Y1(), F.W1O(), MT, D, D}; pg8::StaticOrder S; S.init(MT, D, F.G, (int)blockIdx.x);
      pg8::EpiBf16 E{F.YO(), D, 1 << 30, F.YO(), D}; pg8::gemm_phase(F.lds, g, S, E); }
    grid.sync();
    phase_final_rowwise(F);
}

extern "C" void kernel_launch(void* const* d_in, const int* in_sizes, int n_in, void* d_out, int out_size, void* d_ws, size_t ws_size, hipStream_t stream) {
    static int grid = 0;
    if (grid == 0) {
        if (n_in != 34 || out_size != (int)O_END || ws_size < WS_END) { grid = -1; return; }
        int dev = 0, cus = 0, per_cu = 0;
        if (hipGetDevice(&dev) != hipSuccess || hipDeviceGetAttribute(&cus, hipDeviceAttributeMultiprocessorCount, dev) != hipSuccess) { grid = -1; return; }
        if (hipFuncSetAttribute((const void*)fwd_megakernel, hipFuncAttributeMaxDynamicSharedMemorySize, LDS_BYTES) != hipSuccess) { grid = -1; return; }
        if (hipOccupancyMaxActiveBlocksPerMultiprocessor(&per_cu, (const void*)fwd_megakernel, 512, LDS_BYTES) != hipSuccess || per_cu < 1) { grid = -1; return; }
        grid = cus;
    }
    if (grid < 0) return;
    Params p{};
    for (int i = 0; i < 34; ++i) p.in[i] = (const float*)d_in[i];
    p.out = (float*)d_out; p.ws = (unsigned char*)d_ws;
    void* args[] = {&p};
    (void)hipLaunchCooperativeKernel((const void*)fwd_megakernel, dim3(grid), dim3(512), args, LDS_BYTES, stream);
}
```

```cpp
#include <hip/hip_runtime.h>
#include <hip/hip_cooperative_groups.h>
namespace cg = cooperative_groups;

#define LAS __attribute__((address_space(3)))
typedef unsigned short bf16_t;
typedef short bf16x8 __attribute__((ext_vector_type(8)));
typedef float f32x4 __attribute__((ext_vector_type(4)));
typedef float f32x2 __attribute__((ext_vector_type(2)));
typedef unsigned u32x4 __attribute__((ext_vector_type(4)));
typedef unsigned u32x2 __attribute__((ext_vector_type(2)));

constexpr int D = 1024, BP = 8, TP = 4096, BS = 16, TS = 16;
constexpr int MP = BP * TP, MS = BS * TS, MT = MP + MS;
constexpr int NSEQ = BP + BS;
constexpr int EV_IN = 2304, OD_IN = 4112, OD_MAIN = 4096;
constexpr int C_XA = 0, C_GA = 512, C_Q = 1024, C_K = 1536, C_V = 1664, C_GB = 1792;
constexpr float EPS = 1e-6f;
constexpr size_t O_Y = 0, O_LCP = 33816576, O_LCS = 33828864, O_LHP = 33853440, O_LHS = 33857536, O_KP = 33865728, O_KS = 33996800,
                 O_VP = 34029568, O_VS = 34160640, O_GCP = 34193408, O_GCS = 34267136, O_GSP = 34414592, O_GSS = 35463168, O_END = 37560320;
constexpr size_t MiB = 1u << 20;
constexpr size_t WS_CTL = 0, WS_W1O = 1 * MiB, WS_MOD = 3 * MiB, WS_ROPE = 4 * MiB, WS_BA = 5 * MiB, WS_LAG = 8 * MiB, WS_LGW = 10 * MiB;
constexpr size_t WS_RA = 16 * MiB, RA_BYTES = (size_t)MT * 4096 * 2;
constexpr size_t WS_RB = WS_RA + RA_BYTES;
constexpr size_t ACT_BYTES = (size_t)MT * D * 2;
constexpr size_t RB_XN = 0, RB_Y0 = ACT_BYTES, RB_YO = 2 * ACT_BYTES, RB_W0I = 3 * ACT_BYTES, RB_W0O = RB_W0I + (size_t)EV_IN * D * 2,
                 RB_W1I = RB_W0O + (size_t)D * D * 2, RB_WEND = RB_W1I + (size_t)OD_MAIN * D * 2;
constexpr size_t RB_BYTES = (size_t)4224 * 73728;
constexpr size_t WS_END = WS_RB + RB_BYTES;
static_assert(RB_WEND <= RB_BYTES, "ws map");
static_assert((size_t)MT * 3072 * 2 <= RB_BYTES, "ws map");
constexpr int LDS_BYTES = 155648;

struct Params { const float* in[34]; float* out; unsigned char* ws; };

__device__ __forceinline__ float bf2f(bf16_t b) { return __uint_as_float(((unsigned)b) << 16); }
__device__ __forceinline__ unsigned f2bf(float f) { unsigned u = __float_as_uint(f); return (u + 0x7fffu + ((u >> 16) & 1u)) >> 16; }
__device__ __forceinline__ unsigned pk2(float lo, float hi) { return f2bf(lo) | (f2bf(hi) << 16); }
__device__ __forceinline__ float lo16(unsigned w) { return __uint_as_float(w << 16); }
__device__ __forceinline__ float hi16(unsigned w) { return __uint_as_float(w & 0xffff0000u); }
__device__ __forceinline__ float wave_sum(float v) {
#pragma unroll
    for (int o = 1; o < 64; o <<= 1) v += __shfl_xor(v, o);
    return v;
}
__device__ __forceinline__ float sigmoidf_(float x) { return 1.0f / (1.0f + __expf(-x)); }
__device__ __forceinline__ float siluf_(float x) { return x / (1.0f + __expf(-x)); }
__device__ __forceinline__ float softplusf_(float x) { return x > 20.f ? x : log1pf(__expf(x)); }
__device__ __forceinline__ int seq_base(int s) { return s < BP ? s * TP : MP + (s - BP) * TS; }
__device__ __forceinline__ int seq_len(int s) { return s < BP ? TP : TS; }
__device__ __forceinline__ void tok_info(int m, int& s, int& t) { if (m < MP) { s = m >> 12; t = m & 4095; } else { const int r = m - MP; s = BP + (r >> 4); t = r & 15; } }

__device__ __forceinline__ int opaque_tid(int wv) { int l = __builtin_amdgcn_mbcnt_hi(~0u, __builtin_amdgcn_mbcnt_lo(~0u, 0u)); asm volatile("" : "+v"(l)); return wv * 64 + l; }
namespace pg8 {
constexpr int BM = 256, BK = 64, HALF = 128, HTB = HALF * BK * 2, STAGE_BYTES = 8 * HTB, NXCD = 8, WGM = 8;
__host__ __device__ __forceinline__ int lds_byte(int r, int c) { const int st = (r >> 4) * 2 + (c >> 5), rr = r & 15, cc = c & 31, ob = rr * 64 + cc * 2; return st * 1024 + (ob ^ (((ob >> 9) & 1) << 5)); }
__host__ __device__ __forceinline__ void stage_rc(int b, int& R, int& C) { const int st = b / 1024, sb = b % 1024, swz = sb ^ (((sb >> 9) & 1) << 5); R = (st >> 1) * 16 + swz / 64; C = (st & 1) * 32 + (swz % 64) / 2; }
__host__ __device__ __forceinline__ int perm32(int rho) { const int n = rho >> 4, i = rho & 15; return 8 * (i >> 2) + 4 * n + (i & 3); }
struct Unit { int pm, pn; };
struct Gemm { const bf16_t* A; const bf16_t* Bt; int M, N, K; };
struct StaticOrder {
    int nM, nN, nwg, G, c;
    __device__ void init(int M, int N, int G_, int c_) { nM = M / BM; nN = N / BM; nwg = nM * nN; G = G_; c = c_; }
    __device__ bool next(int i, Unit& u) const {
        const long L = (long)i * G + c; if (L >= nwg) return false;
        int wgid = (int)L; { const int q = nwg / NXCD, r = nwg % NXCD, xcd = wgid % NXCD, off = wgid / NXCD; wgid = (xcd < r ? xcd * (q + 1) : r * (q + 1) + (xcd - r) * q) + off; }
        const int nig = WGM * nN, gid = wgid / nig, fm = gid * WGM, gsz = (nM - fm) < WGM ? (nM - fm) : WGM;
        u.pm = fm + ((wgid % nig) % gsz); u.pn = (wgid % nig) / gsz; return true;
    }
};
__device__ __forceinline__ unsigned cvt_pk_bf16(float lo, float hi) { unsigned r; asm volatile("v_cvt_pk_bf16_f32 %0, %1, %2" : "=v"(r) : "v"(lo), "v"(hi)); return r; }
struct EpiBf16 {
    static constexpr bool PERM = true;
    bf16_t* O0; int ld0; int split; bf16_t* O1; int ld1;
    __device__ __forceinline__ void operator()(const f32x4 (&acc)[2][2][4][2], const Unit& u, int wr, int wc, int fr, int fq) const {
        const int row0 = u.pm * BM + wr * 64 + fr; int colt = u.pn * BM; bf16_t* base = O0; int ld = ld0;
        if (colt >= split) { base = O1; ld = ld1; colt -= split; }
        const int col0 = colt + wc * 32 + 8 * fq;
#pragma unroll
        for (int ai = 0; ai < 2; ++ai)
#pragma unroll
            for (int m = 0; m < 4; ++m) { bf16_t* rowp = base + (size_t)(row0 + ai * HALF + m * 16) * ld + col0;
#pragma unroll
                for (int bj = 0; bj < 2; ++bj) { const f32x4 v0 = acc[ai][bj][m][0], v1 = acc[ai][bj][m][1];
                    u32x4 w; w.x = cvt_pk_bf16(v0[0], v0[1]); w.y = cvt_pk_bf16(v0[2], v0[3]); w.z = cvt_pk_bf16(v1[0], v1[1]); w.w = cvt_pk_bf16(v1[2], v1[3]);
                    *(u32x4*)(rowp + bj * HALF) = w; } }
    }
};
template <class Epi, class Sched>
__device__ __forceinline__ void gemm_phase(LAS unsigned char* lds, const Gemm g, const Sched& S, const Epi& E, const int wv0) {
    int tid = opaque_tid(wv0);
    const int wid = __builtin_amdgcn_readfirstlane(tid >> 6), lane = tid & 63, wr = wid >> 2, wc = wid & 3, fr = lane & 15, fq = lane >> 4;
    const int K = g.K, nt = K / BK;
    unsigned voffA[2], voffB[2];
#pragma unroll
    for (int i = 0; i < 2; ++i) { int R, C; stage_rc(tid * 16 + i * 8192, R, C); const int Rb = Epi::PERM ? ((R & ~31) + perm32(R & 31)) : R;
        voffA[i] = (unsigned)(R * K + C) * 2u; voffB[i] = (unsigned)(Rb * K + C) * 2u; }
    const size_t kstep = (size_t)(BK * 2);
    const size_t hstep = (size_t)HALF * K * 2;
    const size_t tstep = 2 * hstep;
    const unsigned ldsw = (unsigned)wid * 1024u;
    const int aoff = lds_byte(wr * 64 + fr, fq * 8), boff = lds_byte(wc * 32 + fr, fq * 8);
#define PG8_SA(b, h) (((b) * 2 + (h)) * HTB)
#define PG8_SB(b, h) ((4 + (b) * 2 + (h)) * HTB)
#define PG8_STAGE(bufoff, gbase, voff) do { _Pragma("unroll") for (int _i = 0; _i < 2; ++_i) \
        __builtin_amdgcn_global_load_lds((const unsigned*)((const char*)(gbase) + (voff)[_i]), (LAS unsigned*)(lds + (bufoff) + ldsw + _i * 8192), 16, 0, 0); } while (0)
#define PG8_LDA(dst, b, h) do { _Pragma("unroll") for (int m = 0; m < 4; ++m) _Pragma("unroll") for (int k = 0; k < 2; ++k) dst[m][k] = *(const LAS bf16x8*)(lds + PG8_SA(b, h) + aoff + m * 2048 + k * 1024); } while (0)
#define PG8_LDB(dst, b, h) do { _Pragma("unroll") for (int n = 0; n < 2; ++n) _Pragma("unroll") for (int k = 0; k < 2; ++k) dst[n][k] = *(const LAS bf16x8*)(lds + PG8_SB(b, h) + boff + n * 2048 + k * 1024); } while (0)
#define PG8_MMA(ai, bj, At, Bt) do { __builtin_amdgcn_s_setprio(1); _Pragma("unroll") for (int m = 0; m < 4; ++m) _Pragma("unroll") for (int n = 0; n < 2; ++n) _Pragma("unroll") for (int k = 0; k < 2; ++k) \
        acc[ai][bj][m][n] = __builtin_amdgcn_mfma_f32_16x16x32_bf16(Bt[n][k], At[m][k], acc[ai][bj][m][n], 0, 0, 0); __builtin_amdgcn_s_setprio(0); } while (0)
#define PG8_WAIT_V(n) asm volatile("s_waitcnt vmcnt(" #n ")" ::: "memory")
#define PG8_WAIT_L(n) asm volatile("s_waitcnt lgkmcnt(" #n ")" ::: "memory")
#define PG8_BAR __builtin_amdgcn_s_barrier()
#define PG8_SCHED __builtin_amdgcn_sched_barrier(0)
    Unit cur, nxt; int ui = 0;
    if (!S.next(0, cur)) return;
    f32x4 acc[2][2][4][2];
#pragma unroll
    for (int a = 0; a < 2; ++a)
#pragma unroll
        for (int b = 0; b < 2; ++b)
#pragma unroll
            for (int m = 0; m < 4; ++m)
#pragma unroll
                for (int n = 0; n < 2; ++n) acc[a][b][m][n] = (f32x4){0.f, 0.f, 0.f, 0.f};
    bf16x8 At[4][2], B0[2][2], B1[2][2];
    const char* cA = (const char*)g.A + (size_t)cur.pm * tstep; const char* cB = (const char*)g.Bt + (size_t)cur.pn * tstep;
    PG8_STAGE(PG8_SB(0, 0), cB, voffB); PG8_STAGE(PG8_SA(0, 0), cA, voffA); PG8_STAGE(PG8_SB(0, 1), cB + hstep, voffB); PG8_STAGE(PG8_SA(0, 1), cA + hstep, voffA);
    if (wr == 1) PG8_BAR;
    PG8_WAIT_V(4); PG8_BAR;
    PG8_STAGE(PG8_SB(1, 0), cB + kstep, voffB); PG8_STAGE(PG8_SA(1, 0), cA + kstep, voffA); PG8_STAGE(PG8_SB(1, 1), cB + hstep + kstep, voffB);
    PG8_WAIT_V(6); PG8_BAR;
    for (;;) {
        const bool has_next = S.next(ui + 1, nxt);
        const char* nA = has_next ? (const char*)g.A + (size_t)nxt.pm * tstep : cA; const char* nB = has_next ? (const char*)g.Bt + (size_t)nxt.pn * tstep : cB;
        for (int t = 0; t < nt; t += 2) {
            const bool last = (t == nt - 2);
            const char* a1 = cA + (size_t)(t + 1) * kstep;
            const char* a2 = last ? nA : cA + (size_t)(t + 2) * kstep; const char* b2 = last ? nB : cB + (size_t)(t + 2) * kstep;
            const char* a3 = a2 + kstep; const char* b3 = b2 + kstep;
            PG8_LDB(B0, 0, 0); PG8_SCHED; PG8_LDA(At, 0, 0); PG8_STAGE(PG8_SA(1, 1), a1 + hstep, voffA);
            PG8_WAIT_L(8); PG8_BAR; PG8_WAIT_L(0); PG8_MMA(0, 0, At, B0); PG8_BAR; PG8_SCHED;
            PG8_LDB(B1, 0, 1); PG8_STAGE(PG8_SB(0, 0), b2, voffB);
            PG8_BAR; PG8_WAIT_L(0); PG8_MMA(0, 1, At, B1); PG8_BAR;
            PG8_LDA(At, 0, 1); PG8_STAGE(PG8_SA(0, 0), a2, voffA);
            PG8_BAR; PG8_WAIT_L(0); PG8_MMA(1, 0, At, B0); PG8_BAR; PG8_SCHED;
            PG8_STAGE(PG8_SB(0, 1), b2 + hstep, voffB);
            PG8_WAIT_V(6); PG8_BAR; PG8_MMA(1, 1, At, B1); PG8_BAR;
            PG8_LDB(B0, 1, 0); PG8_SCHED; PG8_LDA(At, 1, 0); PG8_STAGE(PG8_SA(0, 1), a2 + hstep, voffA);
            PG8_WAIT_L(8); PG8_BAR; PG8_WAIT_L(0); PG8_MMA(0, 0, At, B0); PG8_BAR; PG8_SCHED;
            PG8_LDB(B1, 1, 1); PG8_STAGE(PG8_SB(1, 0), b3, voffB);
            PG8_BAR; PG8_WAIT_L(0); PG8_MMA(0, 1, At, B1); PG8_BAR;
            PG8_LDA(At, 1, 1); PG8_STAGE(PG8_SA(1, 0), a3, voffA);
            PG8_BAR; PG8_WAIT_L(0); PG8_MMA(1, 0, At, B0); PG8_BAR; PG8_SCHED;
            PG8_STAGE(PG8_SB(1, 1), b3 + hstep, voffB);
            PG8_WAIT_V(6); PG8_BAR; PG8_MMA(1, 1, At, B1); PG8_BAR;
        }
        E(acc, cur, wr, wc, fr, fq);
        if (!has_next) break;
#pragma unroll
        for (int a = 0; a < 2; ++a)
#pragma unroll
            for (int b = 0; b < 2; ++b)
#pragma unroll
                for (int m = 0; m < 4; ++m)
#pragma unroll
                    for (int n = 0; n < 2; ++n) acc[a][b][m][n] = (f32x4){0.f, 0.f, 0.f, 0.f};
        cur = nxt; cA = nA; cB = nB; ++ui;
    }
    PG8_WAIT_V(0);
    if (wr == 0) PG8_BAR;
    PG8_BAR;
#undef PG8_SA
#undef PG8_SB
#undef PG8_STAGE
#undef PG8_LDA
#undef PG8_LDB
#undef PG8_MMA
#undef PG8_WAIT_V
#undef PG8_WAIT_L
#undef PG8_BAR
#undef PG8_SCHED
}
}

struct Frame {
    LAS unsigned char* lds;
    int vcu, G, wv;
    const float* const* in; float* out; unsigned char* ws;
    __device__ __forceinline__ float* MOD() const { return (float*)(ws + WS_MOD); }
    __device__ __forceinline__ float* ROPE() const { return (float*)(ws + WS_ROPE); }
    __device__ __forceinline__ float* BA() const { return (float*)(ws + WS_BA); }
    __device__ __forceinline__ float* LAG() const { return (float*)(ws + WS_LAG); }
    __device__ __forceinline__ bf16_t* W1O() const { return (bf16_t*)(ws + WS_W1O); }
    __device__ __forceinline__ bf16_t* U0() const { return (bf16_t*)(ws + WS_RA); }
    __device__ __forceinline__ bf16_t* QKV1() const { return (bf16_t*)(ws + WS_RA); }
    __device__ __forceinline__ bf16_t* Z1() const { return (bf16_t*)(ws + WS_RA + (size_t)MT * 3072 * 2); }
    __device__ __forceinline__ bf16_t* Y1() const { return (bf16_t*)(ws + WS_RA); }
    __device__ __forceinline__ bf16_t* XN() const { return (bf16_t*)(ws + WS_RB + RB_XN); }
    __device__ __forceinline__ bf16_t* Y0() const { return (bf16_t*)(ws + WS_RB + RB_Y0); }
    __device__ __forceinline__ bf16_t* YO() const { return (bf16_t*)(ws + WS_RB + RB_YO); }
    __device__ __forceinline__ bf16_t* W0I() const { return (bf16_t*)(ws + WS_RB + RB_W0I); }
    __device__ __forceinline__ bf16_t* W0O() const { return (bf16_t*)(ws + WS_RB + RB_W0O); }
    __device__ __forceinline__ bf16_t* W1I() const { return (bf16_t*)(ws + WS_RB + RB_W1I); }
    __device__ __forceinline__ bf16_t* QKVC() const { return (bf16_t*)(ws + WS_RB); }
};

#define PHASE_IDS() int tid = opaque_tid(F.wv); const int lane = tid & 63, wave = __builtin_amdgcn_readfirstlane(tid >> 6); (void)lane; (void)wave
__device__ __forceinline__ void p0_transpose_item(const float* W, int ldw, int nblk, int K, bf16_t* WT, LAS float* scr, int item, int lane) {
    const int kb = item / nblk, nb = item % nblk, k0 = 64 * kb, n0 = 32 * nb;
#pragma unroll 8
    for (int i = 0; i < 32; ++i) { const int kk = 2 * i + (lane >> 5); scr[kk * 33 + (lane & 31)] = W[(size_t)(k0 + kk) * ldw + n0 + (lane & 31)]; }
    asm volatile("s_waitcnt lgkmcnt(0)" ::: "memory");
    const int c = lane & 7;
#pragma unroll
    for (int j = 0; j < 4; ++j) { const int n = (lane >> 3) + 8 * j; const LAS float* s = scr + (8 * c) * 33 + n;
        u32x4 o; o.x = pk2(s[0 * 33], s[1 * 33]); o.y = pk2(s[2 * 33], s[3 * 33]); o.z = pk2(s[4 * 33], s[5 * 33]); o.w = pk2(s[6 * 33], s[7 * 33]);
        *(u32x4*)(WT + (size_t)(n0 + n) * K + k0 + 8 * c) = o; }
    asm volatile("s_waitcnt lgkmcnt(0)" ::: "memory");
}
__device__ __forceinline__ void phase_prologue(Frame& F) {
    PHASE_IDS();
    const int gw = F.vcu * 8 + wave, NGW = F.G * 8;
    {
        LAS float* scr = (LAS float*)(F.lds + wave * 16384);
        constexpr int I0 = 16 * (EV_IN / 32), I1 = 16 * 32, I2 = 16 * (OD_MAIN / 32), I3 = 16 * 32;
        for (int it = gw; it < I0 + I1 + I2 + I3; it += NGW) {
            int r = it;
            if (r < I0) { p0_transpose_item(F.in[14], EV_IN, EV_IN / 32, D, F.W0I(), scr, r, lane); continue; } r -= I0;
            if (r < I1) { p0_transpose_item(F.in[23], D, 32, D, F.W0O(), scr, r, lane); continue; } r -= I1;
            if (r < I2) { p0_transpose_item(F.in[28], OD_IN, OD_MAIN / 32, D, F.W1I(), scr, r, lane); continue; } r -= I2;
            p0_transpose_item(F.in[33], D, 32, D, F.W1O(), scr, r, lane);
        }
    }
    {
        const double inv[8] = {1.0, 0.19392274474868576, 0.03760603093086393, 0.007292664737217109, 0.001414213562373095, 0.0002742481756762073, 5.318295896944988e-05, 1.031338537721246e-05};
        for (int idx = F.vcu * 512 + tid; idx < 4112 * 8; idx += F.G * 512) {
            const int pos = idx >> 3, i = idx & 7;
            double iv = inv[0];
#pragma unroll
            for (int q = 1; q < 8; ++q) iv = (i == q) ? inv[q] : iv;
            const double ang = (double)pos * iv;
            const double n = __builtin_rint(ang * 0.15915494309189535);
            const float r = (float)__builtin_fma(-n, 6.283185307179586, ang);
            F.ROPE()[pos * 16 + i] = __cosf(r); F.ROPE()[pos * 16 + 8 + i] = __sinf(r);
        }
    }
    {
        bf16_t* LGW = (bf16_t*)(F.ws + WS_LGW);
        for (int idx = F.vcu * 512 + tid; idx < 8 * 2 * 64 * 64; idx += F.G * 512) { const int k = idx & 63, n = (idx >> 6) & 63, gate = (idx >> 12) & 1, hh = idx >> 13;
            LGW[idx] = (bf16_t)f2bf((gate ? F.in[19] : F.in[17])[(hh * 64 + k) * 64 + n]); }
    }
    __syncthreads();
    for (int bt = F.vcu; bt < 96; bt += F.G) {
        LAS float* tab = (LAS float*)F.lds;
        for (int idx = tid; idx < 24 * 1024; idx += 512) { const int s = idx >> 10, k = idx & 1023;
            const float c = s < BP ? F.in[8][s * D + k] : F.in[9][(s - BP) * D + k]; tab[k * 24 + s] = siluf_(c); }
        __syncthreads();
        const int L = bt / 48, n0 = (bt % 48) * 64;
        const float* mw = (L == 0 ? F.in[10] : F.in[24]) + n0 + lane;
        float acc[24];
#pragma unroll
        for (int r = 0; r < 24; ++r) acc[r] = 0.f;
        for (int k = wave * 128; k < wave * 128 + 128; ++k) {
            const float w = mw[(size_t)k * 3072];
            const LAS f32x4* tp = (const LAS f32x4*)(tab + k * 24);
#pragma unroll
            for (int q = 0; q < 6; ++q) { const f32x4 t4 = tp[q]; acc[4 * q] += t4[0] * w; acc[4 * q + 1] += t4[1] * w; acc[4 * q + 2] += t4[2] * w; acc[4 * q + 3] += t4[3] * w; }
        }
        __syncthreads();
        LAS float* red = (LAS float*)F.lds;
#pragma unroll
        for (int r = 0; r < 24; ++r) red[(wave * 24 + r) * 64 + lane] = acc[r];
        __syncthreads();
        const float* mb = (L == 0 ? F.in[11] : F.in[25]);
        for (int idx = tid; idx < 24 * 64; idx += 512) { const int r = idx >> 6, l = idx & 63; float s = 0.f;
#pragma unroll
            for (int w = 0; w < 8; ++w) s += red[(w * 24 + r) * 64 + l];
            F.MOD()[((size_t)L * 24 + r) * 3072 + n0 + l] = s + mb[n0 + l]; }
        __syncthreads();
    }
}

__device__ __forceinline__ void phase_prenorm0(Frame& F) {
    PHASE_IDS();
    const int gw = F.vcu * 8 + wave, NGW = F.G * 8;
    for (int m = gw; m < MT; m += NGW) {
        int s, t; tok_info(m, s, t);
        const float* xrow = m < MP ? F.in[0] + (size_t)m * D : F.in[1] + (size_t)(m - MP) * D;
        const float* modr = F.MOD() + (size_t)s * 3072;
        f32x4 v[4]; float ss = 0.f;
#pragma unroll
        for (int j = 0; j < 4; ++j) { v[j] = *(const f32x4*)(xrow + 4 * lane + 256 * j); ss += (v[j][0] * v[j][0] + v[j][1] * v[j][1]) + (v[j][2] * v[j][2] + v[j][3] * v[j][3]); }
        const float r = rsqrtf(wave_sum(ss) * (1.f / D) + EPS);
#pragma unroll
        for (int j = 0; j < 4; ++j) { const int c = 4 * lane + 256 * j;
            const f32x4 g = *(const f32x4*)(F.in[12] + c), sh = *(const f32x4*)(modr + c), sc = *(const f32x4*)(modr + 1024 + c);
            f32x4 o;
#pragma unroll
            for (int e = 0; e < 4; ++e) o[e] = v[j][e] * r * g[e] * (1.f + sc[e]) + sh[e];
            u32x2 w; w.x = pk2(o[0], o[1]); w.y = pk2(o[2], o[3]); *(u32x2*)(F.XN() + (size_t)m * D + c) = w; }
    }
}

__device__ __forceinline__ void phase_rope(Frame& F) {
    PHASE_IDS();
    const int gt = F.vcu * 512 + tid, NT = F.G * 512;
    for (int idx = gt; idx < MT * 80; idx += NT) {
        const int m = idx / 80, r = idx % 80, slot = r >> 3, i = r & 7;
        int s, t; tok_info(m, s, t);
        const int pos = s < BP ? t : TP + t;
        const int col = slot < 8 ? C_Q + slot * 64 : C_K + (slot - 8) * 64;
        bf16_t* p = F.U0() + (size_t)m * EV_IN + col;
        const float x1 = bf2f(p[i]), x2 = bf2f(p[8 + i]), c = F.ROPE()[pos * 16 + i], sn = F.ROPE()[pos * 16 + 8 + i];
        const float o1 = x1 * c - x2 * sn, o2 = x2 * c + x1 * sn;
        p[i] = (bf16_t)f2bf(o1); p[8 + i] = (bf16_t)f2bf(o2);
        if (slot >= 8) { const int kv = slot - 8;
            if (s >= BP) { float* o = F.out + O_KS + ((size_t)((s - BP) * TS + t) * 2 + kv) * 64; o[i] = o1; o[8 + i] = o2; }
            else if (t >= TP - 128) { float* o = F.out + O_KP + ((size_t)(s * 128 + (t - (TP - 128))) * 2 + kv) * 64; o[i] = o1; o[8 + i] = o2; } }
    }
    for (int idx = gt; idx < 1280 * 224; idx += NT) {
        const int tk = idx / 224, e = idx % 224;
        int s, t, m; if (tk < 1024) { s = tk >> 7; t = TP - 128 + (tk & 127); m = s * TP + t; } else { s = BP + ((tk - 1024) >> 4); t = (tk - 1024) & 15; m = MP + (tk - 1024); }
        const bool isv = e >= 96; const int e2 = isv ? e - 96 : e; const int kv = isv ? (e2 >> 6) : (e2 / 48), d = isv ? (e2 & 63) : 16 + (e2 % 48);
        const float val = bf2f(F.U0()[(size_t)m * EV_IN + (isv ? C_V : C_K) + kv * 64 + d]);
        const size_t ob = s >= BP ? (isv ? O_VS : O_KS) + ((size_t)((s - BP) * TS + t) * 2 + kv) * 64 : (isv ? O_VP : O_KP) + ((size_t)(s * 128 + (t - (TP - 128))) * 2 + kv) * 64;
        F.out[ob + d] = val;
    }
}

__device__ __forceinline__ void phase_lru_naive(Frame& F) {
    PHASE_IDS();
    const int gw = F.vcu * 8 + wave, NGW = F.G * 8;
    for (int task = gw; task < NSEQ * 8; task += NGW) {
        const int s = task >> 3, h = task & 7, ch = h * 64 + lane, T = seq_len(s), base = seq_base(s);
        float wa[64], wx[64];
#pragma unroll
        for (int i = 0; i < 64; ++i) { wa[i] = F.in[17][(h * 64 + i) * 64 + lane]; wx[i] = F.in[19][(h * 64 + i) * 64 + lane]; }
        const float cw0 = F.in[15][ch], cw1 = F.in[15][512 + ch], cw2 = F.in[15][1024 + ch], cw3 = F.in[15][1536 + ch], cb = F.in[16][ch];
        const float ba = F.in[18][ch], bx = F.in[20][ch], sp = softplusf_(-F.in[21][ch]);
        float x3 = 0.f, x2 = 0.f, x1 = 0.f, hh = 0.f;
        if (s >= BP) { const float* cs = F.in[2] + (size_t)(s - BP) * 3 * 512; x3 = cs[ch]; x2 = cs[512 + ch]; x1 = cs[1024 + ch]; hh = F.in[3][(s - BP) * 512 + ch]; }
        for (int t0 = 0; t0 < T; t0 += 16) {
            float xa[16], ga[16];
#pragma unroll
            for (int j = 0; j < 16; ++j) { const bf16_t* p = F.U0() + (size_t)(base + t0 + j) * EV_IN; xa[j] = bf2f(p[C_XA + ch]); ga[j] = bf2f(p[C_GA + ch]); }
#pragma unroll
            for (int j = 0; j < 16; ++j) {
                const float xc = cw0 * x3 + cw1 * x2 + cw2 * x1 + cw3 * xa[j] + cb;
                x3 = x2; x2 = x1; x1 = xa[j];
                float za = ba, zx = bx;
#pragma unroll
                for (int i = 0; i < 64; ++i) { const float xi = __uint_as_float(__builtin_amdgcn_readlane(__float_as_uint(xc), i)); za += xi * wa[i]; zx += xi * wx[i]; }
                const float r = sigmoidf_(za), ig = sigmoidf_(zx), la = -8.0f * r * sp, a = __expf(la);
                const float gx = sqrtf(-expm1f(2.0f * la)) * (ig * xc);
                hh = a * hh + gx;
                F.Y0()[(size_t)(base + t0 + j) * D + ch] = (bf16_t)f2bf(hh * siluf_(ga[j]));
            }
        }
        if (s < BP) { F.out[O_LHP + s * 512 + ch] = hh; float* o = F.out + O_LCP + (size_t)s * 3 * 512; o[ch] = x3; o[512 + ch] = x2; o[1024 + ch] = x1; }
        else { F.out[O_LHS + (s - BP) * 512 + ch] = hh; float* o = F.out + O_LCS + (size_t)(s - BP) * 3 * 512; o[ch] = x3; o[512 + ch] = x2; o[1024 + ch] = x1; }
    }
}

__device__ __forceinline__ void phase_attn_naive(Frame& F) {
    PHASE_IDS();
    const int gt = F.vcu * 512 + tid, NT = F.G * 512;
    for (int idx = gt; idx < MT * 8; idx += NT) {
        const int hq = idx / MT, m = idx % MT, kv = hq >> 2;
        int s, t; tok_info(m, s, t);
        unsigned qp[32]; float o[64];
        { const u32x4* qq = (const u32x4*)(F.U0() + (size_t)m * EV_IN + C_Q + hq * 64);
#pragma unroll
          for (int c = 0; c < 8; ++c) { const u32x4 w = qq[c];
#pragma unroll
              for (int e = 0; e < 4; ++e) qp[c * 4 + e] = pk2(lo16(w[e]) * 0.125f, hi16(w[e]) * 0.125f); } }
#pragma unroll
        for (int d = 0; d < 64; ++d) o[d] = 0.f;
        float mx = F.in[22][hq], l = 1.0f;
        int nkeys, p0 = 0;
        if (s < BP) { const int c0 = (t >> 6) * 64; p0 = c0 - 128 < 0 ? 0 : c0 - 128; nkeys = c0 + 64 - p0; } else nkeys = 128 + TS;
        for (int j = 0; j < nkeys; ++j) {
            float sc = 0.f;
            const bool cached = (s >= BP && j < 128);
            const int mk = s < BP ? s * TP + p0 + j : seq_base(s) + (j - 128);
            const float* kpf = F.in[4] + ((size_t)((s - BP) * 128 + j) * 2 + kv) * 64; const float* vpf = F.in[5] + ((size_t)((s - BP) * 128 + j) * 2 + kv) * 64;
            const bf16_t* kpb = F.U0() + (size_t)mk * EV_IN + C_K + kv * 64; const bf16_t* vpb = F.U0() + (size_t)mk * EV_IN + C_V + kv * 64;
            if (cached) {
#pragma unroll
                for (int c = 0; c < 16; ++c) { const f32x4 a = *(const f32x4*)(kpf + 4 * c); sc += (lo16(qp[2 * c]) * a[0] + hi16(qp[2 * c]) * a[1]) + (lo16(qp[2 * c + 1]) * a[2] + hi16(qp[2 * c + 1]) * a[3]); }
            } else {
#pragma unroll
                for (int c = 0; c < 8; ++c) { const u32x4 a = *(const u32x4*)(kpb + 8 * c);
#pragma unroll
                    for (int e = 0; e < 4; ++e) sc += lo16(qp[c * 4 + e]) * lo16(a[e]) + hi16(qp[c * 4 + e]) * hi16(a[e]); }
            }
            const float mn = fmaxf(mx, sc), alpha = __expf(mx - mn), p = __expf(sc - mn);
            l = l * alpha + p; mx = mn;
            if (cached) {
#pragma unroll
                for (int c = 0; c < 16; ++c) { const f32x4 b = *(const f32x4*)(vpf + 4 * c);
#pragma unroll
                    for (int e = 0; e < 4; ++e) o[4 * c + e] = o[4 * c + e] * alpha + p * b[e]; }
            } else {
#pragma unroll
                for (int c = 0; c < 8; ++c) { const u32x4 b = *(const u32x4*)(vpb + 8 * c);
#pragma unroll
                    for (int e = 0; e < 4; ++e) { o[c * 8 + 2 * e] = o[c * 8 + 2 * e] * alpha + p * lo16(b[e]); o[c * 8 + 2 * e + 1] = o[c * 8 + 2 * e + 1] * alpha + p * hi16(b[e]); } }
            }
        }
        const float il = 1.0f / l;
        const u32x4* gp = (const u32x4*)(F.U0() + (size_t)m * EV_IN + C_GB + hq * 64);
        u32x4* yp = (u32x4*)(F.Y0() + (size_t)m * D + 512 + hq * 64);
#pragma unroll
        for (int c = 0; c < 8; ++c) { const u32x4 g = gp[c]; u32x4 w;
#pragma unroll
            for (int e = 0; e < 4; ++e) w[e] = pk2(o[c * 8 + 2 * e] * il * siluf_(lo16(g[e])), o[c * 8 + 2 * e + 1] * il * siluf_(hi16(g[e])));
            yp[c] = w; }
    }
}

__device__ __forceinline__ void phase_mid_rowwise(Frame& F) {
    PHASE_IDS();
    LAS float* baw = (LAS float*)F.lds;
    for (int idx = tid; idx < 16 * 1024; idx += 512) { const int j = idx & 15, k = idx >> 4; baw[j * 1024 + k] = F.in[28][(size_t)k * OD_IN + OD_MAIN + j]; }
    __syncthreads();
    const int gw = F.vcu * 8 + wave, NGW = F.G * 8;
    for (int m = gw; m < MT; m += NGW) {
        int s, t; tok_info(m, s, t);
        const float* xrow = m < MP ? F.in[0] + (size_t)m * D : F.in[1] + (size_t)(m - MP) * D;
        const float* mod0 = F.MOD() + (size_t)s * 3072; const float* mod1 = F.MOD() + (size_t)(24 + s) * 3072;
        f32x4 y[4]; float ss = 0.f;
#pragma unroll
        for (int j = 0; j < 4; ++j) { const u32x2 w = *(const u32x2*)(F.YO() + (size_t)m * D + 4 * lane + 256 * j); y[j] = (f32x4){lo16(w.x), hi16(w.x), lo16(w.y), hi16(w.y)};
            ss += (y[j][0] * y[j][0] + y[j][1] * y[j][1]) + (y[j][2] * y[j][2] + y[j][3] * y[j][3]); }
        const float r1 = rsqrtf(wave_sum(ss) * (1.f / D) + EPS);
        f32x4 x1[4]; float s2 = 0.f;
#pragma unroll
        for (int j = 0; j < 4; ++j) { const int c = 4 * lane + 256 * j;
            const f32x4 xv = *(const f32x4*)(xrow + c), g = *(const f32x4*)(F.in[13] + c), gt = *(const f32x4*)(mod0 + 2048 + c);
#pragma unroll
            for (int e = 0; e < 4; ++e) x1[j][e] = xv[e] + gt[e] * (y[j][e] * r1 * g[e]);
            *(f32x4*)(F.out + O_Y + (size_t)m * D + c) = x1[j];
            s2 += (x1[j][0] * x1[j][0] + x1[j][1] * x1[j][1]) + (x1[j][2] * x1[j][2] + x1[j][3] * x1[j][3]); }
        const float r2 = rsqrtf(wave_sum(s2) * (1.f / D) + EPS);
        f32x4 hm[4];
#pragma unroll
        for (int j = 0; j < 4; ++j) { const int c = 4 * lane + 256 * j;
            const f32x4 g = *(const f32x4*)(F.in[26] + c), sh = *(const f32x4*)(mod1 + c), sc = *(const f32x4*)(mod1 + 1024 + c);
#pragma unroll
            for (int e = 0; e < 4; ++e) hm[j][e] = x1[j][e] * r2 * g[e] * (1.f + sc[e]) + sh[e];
            u32x2 w; w.x = pk2(hm[j][0], hm[j][1]); w.y = pk2(hm[j][2], hm[j][3]); *(u32x2*)(F.XN() + (size_t)m * D + c) = w; }
        float mine = 0.f;
#pragma unroll 1
        for (int q = 0; q < 16; ++q) { float p = 0.f;
#pragma unroll
            for (int j = 0; j < 4; ++j) { const f32x4 w = *(const LAS f32x4*)(baw + q * 1024 + 256 * j + 4 * lane); p += (hm[j][0] * w[0] + hm[j][1] * w[1]) + (hm[j][2] * w[2] + hm[j][3] * w[3]); }
            p = wave_sum(p); mine = (lane == q) ? p : mine; }
        if (lane < 16) F.BA()[(size_t)m * 16 + lane] = mine;
    }
}

__device__ __forceinline__ void phase_gdn_prep_naive(Frame& F) {
    PHASE_IDS();
    const int gw = F.vcu * 8 + wave, NGW = F.G * 8;
    for (int idx = gw; idx < MT * 24; idx += NGW) {
        const int m = idx / 24, g = idx % 24, c = g * 128 + 2 * lane;
        int s, t; tok_info(m, s, t);
        float u0[4], u1[4];
#pragma unroll
        for (int j = 0; j < 4; ++j) { const int tt = t - 3 + j;
            if (tt >= 0) { const unsigned w = *(const unsigned*)(F.QKV1() + (size_t)(m - 3 + j) * 3072 + c); u0[j] = lo16(w); u1[j] = hi16(w); }
            else if (s >= BP) { const float* cs = F.in[6] + ((size_t)(s - BP) * 3 + (tt + 3)) * 3072 + c; u0[j] = cs[0]; u1[j] = cs[1]; }
            else { u0[j] = 0.f; u1[j] = 0.f; } }
        const float* cw = F.in[29] + c;
        float a0 = cw[0] * u0[0] + cw[3072] * u0[1] + cw[6144] * u0[2] + cw[9216] * u0[3];
        float a1 = cw[1] * u1[0] + cw[3073] * u1[1] + cw[6145] * u1[2] + cw[9217] * u1[3];
        a0 = siluf_(a0); a1 = siluf_(a1);
        if (g < 16) { const float ss = wave_sum(a0 * a0 + a1 * a1); float sc = rsqrtf(ss + EPS); if (g < 8) sc *= 0.08838834764831845f; a0 *= sc; a1 *= sc; }
        *(unsigned*)(F.QKVC() + (size_t)m * 3072 + c) = pk2(a0, a1);
        const int T = seq_len(s);
        if (t >= T - 3) { float* o = s < BP ? F.out + O_GCP + ((size_t)s * 3 + (t - (T - 3))) * 3072 + c : F.out + O_GCS + ((size_t)(s - BP) * 3 + (t - (T - 3))) * 3072 + c; o[0] = u0[3]; o[1] = u1[3]; }
    }
}

__device__ __forceinline__ void phase_gdn_rec_naive(Frame& F) {
    int tid = opaque_tid(F.wv);
    LAS float* kq = (LAS float*)F.lds;
    LAS float* red = kq + 1024;
    LAS float* red2 = red + 512;
    LAS float* misc = red2 + 512;
    const int v = tid & 127, rg = tid >> 7;
    for (int task = F.vcu; task < NSEQ * 8; task += F.G) {
        const int s = task >> 3, h = task & 7, T = seq_len(s), base = seq_base(s);
        float S[32];
        if (s < BP) {
#pragma unroll
            for (int i = 0; i < 32; ++i) S[i] = 0.f;
        } else {
#pragma unroll
            for (int i = 0; i < 32; ++i) S[i] = F.in[7][(((size_t)(s - BP) * 8 + h) * 128 + rg * 32 + i) * 128 + v];
        }
        const float Aexp = __expf(F.in[30][h]), dtb = F.in[31][h], hn = F.in[32][v];
        float nxt = 0.f;
        if (tid < 384) { const int part = tid >> 7; const int col = (part == 0 ? 1024 : part == 1 ? 0 : 2048) + h * 128 + (tid & 127); nxt = bf2f(F.QKVC()[(size_t)base * 3072 + col]); }
        __syncthreads();
        for (int t = 0; t < T; ++t) {
            LAS float* cur = kq + (t & 1) * 384;
            if (tid < 384) cur[tid] = nxt;
            if (tid < 384 && t + 1 < T) { const int part = tid >> 7; const int col = (part == 0 ? 1024 : part == 1 ? 0 : 2048) + h * 128 + (tid & 127); nxt = bf2f(F.QKVC()[(size_t)(base + t + 1) * 3072 + col]); }
            const float bb = F.BA()[(size_t)(base + t) * 16 + h], aa = F.BA()[(size_t)(base + t) * 16 + 8 + h];
            const float zz = bf2f(F.Z1()[(size_t)(base + t) * D + h * 128 + v]);
            const float beta = sigmoidf_(bb), g = -Aexp * softplusf_(aa + dtb), a = __expf(g);
            __syncthreads();
            float part = 0.f;
#pragma unroll
            for (int i = 0; i < 32; ++i) { S[i] *= a; part += cur[rg * 32 + i] * S[i]; }
            red[rg * 128 + v] = part;
            __syncthreads();
            const float kS = (red[v] + red[128 + v]) + (red[256 + v] + red[384 + v]);
            const float dlt = beta * (cur[256 + v] - kS);
            float po = 0.f;
#pragma unroll
            for (int i = 0; i < 32; ++i) { S[i] += cur[rg * 32 + i] * dlt; po += cur[128 + rg * 32 + i] * S[i]; }
            red2[rg * 128 + v] = po;
            __syncthreads();
            if (tid < 128) {
                const float o = (red2[v] + red2[128 + v]) + (red2[256 + v] + red2[384 + v]);
                const float sq = wave_sum(o * o);
                if ((tid & 63) == 0) misc[(tid >> 6)] = sq;
                red[v] = o;
            }
            __syncthreads();
            if (tid < 128) {
                const float o = red[v], r = rsqrtf((misc[0] + misc[1]) * (1.f / 128.f) + EPS);
                F.Y1()[(size_t)(base + t) * D + h * 128 + v] = (bf16_t)f2bf(o * r * hn * siluf_(zz));
            }
        }
        float* so = s < BP ? F.out + O_GSP + (((size_t)s * 8 + h) * 128 + rg * 32) * 128 + v : F.out + O_GSS + (((size_t)(s - BP) * 8 + h) * 128 + rg * 32) * 128 + v;
#pragma unroll
        for (int i = 0; i < 32; ++i) so[(size_t)i * 128] = S[i];
        __syncthreads();
    }
}

typedef float f32x16 __attribute__((ext_vector_type(16)));
typedef __bf16 bf16x2_t __attribute__((ext_vector_type(2)));
constexpr int GS_WF = 0, GS_QF = 16384, GS_KF = 32768, GS_PF = 49152, GS_UF = 57344, GS_BYTES = 73728;
constexpr size_t WS_DEC = 11 * MiB;
__device__ __forceinline__ unsigned cvt2(float a, float b) { f32x2 v = {a, b}; bf16x2_t r = __builtin_convertvector(v, bf16x2_t); return __builtin_bit_cast(unsigned, r); }
__device__ __forceinline__ int krow(int s, int h, int j) { return 16 * s + 8 * (j >> 2) + 4 * h + (j & 3); }
#define MFMA32(a, b, c) __builtin_amdgcn_mfma_f32_32x32x16_bf16((a), (b), (c), 0, 0, 0)

constexpr int G1_QS = 0, G1_KS = 17408, G1_VS = 34816, G1_AS = 52224, G1_PS = 69632, G1_WS = 78848, G1_CW = 96256, G1_VEC = 102400;
__device__ __forceinline__ void phase_gdn_g1(Frame& F) {
    int tid = opaque_tid(F.wv);
    const int lane = tid & 63, wave = __builtin_amdgcn_readfirstlane(tid >> 6);
    LAS unsigned char* L = F.lds;
    LAS float* cw_s = (LAS float*)(L + G1_CW);
    LAS float* beta_s = (LAS float*)(L + G1_VEC); LAS float* gcum_s = beta_s + 64; LAS float* eg_s = beta_s + 128; LAS float* ek_s = beta_s + 192;
    float* DEC = (float*)(F.ws + WS_DEC);
    for (int task = F.vcu; task < 4224; task += F.G) {
        int s, c, h; if (task < 4096) { s = task >> 9; c = (task >> 3) & 63; h = task & 7; } else { s = BP + ((task - 4096) >> 3); c = 0; h = task & 7; }
        const int nvalid = s < BP ? 64 : TS, t0 = c * 64, base = seq_base(s), T = seq_len(s);
        unsigned char* blk = F.ws + WS_RB + (size_t)task * GS_BYTES;
        for (int i = tid; i < 4 * 384; i += 512) { const int jj = i / 384, cc = i % 384; cw_s[i] = F.in[29][(size_t)jj * 3072 + (cc >> 7) * 1024 + h * 128 + (cc & 127)]; }
        if (tid < 64) {
            const bool ok = tid < nvalid; float beta = 0.f, g = 0.f;
            if (ok) { const float* ba = F.BA() + (size_t)(base + t0 + tid) * 16; beta = sigmoidf_(ba[h]); g = -__expf(F.in[30][h]) * softplusf_(ba[8 + h] + F.in[31][h]); }
            float x = g;
#pragma unroll
            for (int o = 1; o < 64; o <<= 1) { const float y = __shfl_up(x, o); if (lane >= o) x += y; }
            const float gl = __shfl(x, 63);
            beta_s[tid] = beta; gcum_s[tid] = x; eg_s[tid] = __expf(x); ek_s[tid] = ok ? __expf(gl - x) : 0.f;
            if (tid == 0) DEC[task] = __expf(gl);
        }
        __syncthreads();
        {
            int t1 = tid; asm volatile("" : "+v"(t1));
            const int r = t1 >> 3, j = t1 & 7, t = t0 + r; const bool ok = r < nvalid;
#pragma unroll 1
            for (int p = 0; p < 3; ++p) {
                float acc[16];
#pragma unroll
                for (int e = 0; e < 16; ++e) acc[e] = 0.f;
                float cur[16];
#pragma unroll
                for (int e = 0; e < 16; ++e) cur[e] = 0.f;
                if (ok) {
                    const int cb = p * 1024 + h * 128 + j * 16;
#pragma unroll
                    for (int jj = 0; jj < 4; ++jj) {
                        const int tt = t - 3 + jj; float x[16];
                        if (tt >= 0) { const u32x4* src = (const u32x4*)(F.QKV1() + (size_t)(base + tt) * 3072 + cb); const u32x4 a = src[0], b = src[1];
#pragma unroll
                            for (int e = 0; e < 4; ++e) { x[2 * e] = lo16(a[e]); x[2 * e + 1] = hi16(a[e]); x[8 + 2 * e] = lo16(b[e]); x[8 + 2 * e + 1] = hi16(b[e]); } }
                        else if (s >= BP) { const f32x4* src = (const f32x4*)(F.in[6] + ((size_t)(s - BP) * 3 + (tt + 3)) * 3072 + cb);
#pragma unroll
                            for (int q = 0; q < 4; ++q) { const f32x4 a = src[q]; x[4 * q] = a[0]; x[4 * q + 1] = a[1]; x[4 * q + 2] = a[2]; x[4 * q + 3] = a[3]; } }
                        else {
#pragma unroll
                            for (int e = 0; e < 16; ++e) x[e] = 0.f; }
                        const LAS f32x4* wp = (const LAS f32x4*)(cw_s + jj * 384 + p * 128 + j * 16);
#pragma unroll
                        for (int q = 0; q < 4; ++q) { const f32x4 w4 = wp[q]; acc[4 * q] += w4[0] * x[4 * q]; acc[4 * q + 1] += w4[1] * x[4 * q + 1]; acc[4 * q + 2] += w4[2] * x[4 * q + 2]; acc[4 * q + 3] += w4[3] * x[4 * q + 3]; }
                        if (jj == 3) {
#pragma unroll
                            for (int e = 0; e < 16; ++e) cur[e] = x[e]; }
                    }
                    if (t >= T - 3) {
                        float* o = (s < BP ? F.out + O_GCP + ((size_t)s * 3 + (t - (T - 3))) * 3072 : F.out + O_GCS + ((size_t)(s - BP) * 3 + (t - (T - 3))) * 3072) + cb;
#pragma unroll
                        for (int q = 0; q < 4; ++q) *(f32x4*)(o + 4 * q) = (f32x4){cur[4 * q], cur[4 * q + 1], cur[4 * q + 2], cur[4 * q + 3]};
                    }
                }
                float ss = 0.f;
#pragma unroll
                for (int e = 0; e < 16; ++e) { acc[e] = siluf_(acc[e]); ss += acc[e] * acc[e]; }
                if (p < 2) { ss += __shfl_xor(ss, 1); ss += __shfl_xor(ss, 2); ss += __shfl_xor(ss, 4);
                    float sc = rsqrtf(ss + EPS); if (p == 0) sc *= 0.08838834764831845f;
#pragma unroll
                    for (int e = 0; e < 16; ++e) acc[e] *= sc; }
                u32x4 w0, w1;
#pragma unroll
                for (int e = 0; e < 4; ++e) { w0[e] = ok ? cvt2(acc[2 * e], acc[2 * e + 1]) : 0u; w1[e] = ok ? cvt2(acc[8 + 2 * e], acc[8 + 2 * e + 1]) : 0u; }
                LAS u32x4* dst = (LAS u32x4*)(L + (p == 0 ? G1_QS : p == 1 ? G1_KS : G1_VS) + r * 272 + j * 32);
                dst[0] = w0; dst[1] = w1;
            }
        }
        __syncthreads();
        {
            int l2 = lane; asm volatile("" : "+v"(l2));
            const int which = wave >> 2, ti = (wave >> 1) & 1, tj = wave & 1, r = l2 & 31, hh = l2 >> 5;
            f32x16 acc;
#pragma unroll
            for (int e = 0; e < 16; ++e) acc[e] = 0.f;
            if (!(ti == 0 && tj == 1)) {
                const LAS unsigned char* ap = L + (which ? G1_QS : G1_KS) + (32 * ti + r) * 272 + hh * 16;
                const LAS unsigned char* bp = L + G1_KS + (32 * tj + r) * 272 + hh * 16;
#pragma unroll
                for (int ks = 0; ks < 8; ++ks) { const bf16x8 a = *(const LAS bf16x8*)(ap + ks * 32), b = *(const LAS bf16x8*)(bp + ks * 32); acc = MFMA32(a, b, acc); }
            }
            const int jc = 32 * tj + r; const float gj = gcum_s[jc];
#pragma unroll
            for (int e = 0; e < 16; ++e) {
                const int i = 32 * ti + (e & 3) + 8 * (e >> 2) + 4 * hh; const float dg = gcum_s[i] - gj;
                if (which == 0) { const float f = (i > jc) ? __expf(dg) * beta_s[i] : 0.f; *(LAS float*)(L + G1_AS + i * 272 + jc * 4) = acc[e] * f; }
                else { const float f = (i >= jc) ? __expf(dg) : 0.f; *(LAS bf16_t*)(L + G1_PS + i * 144 + jc * 2) = (bf16_t)(cvt2(acc[e] * f, 0.f) & 0xffffu); }
            }
        }
        __syncthreads();
        if (tid < 256) {
            int t3 = tid; asm volatile("" : "+v"(t3));
            const bool isw = t3 < 128; const int d = t3 & 127;
            float X[64];
#pragma unroll
            for (int i = 0; i < 64; ++i) { const float raw = bf2f(*(const LAS bf16_t*)(L + (isw ? G1_KS : G1_VS) + i * 272 + d * 2)); X[i] = raw * beta_s[i] * (isw ? eg_s[i] : 1.0f); }
            unsigned abase = (unsigned)(size_t)(L + G1_AS);
#pragma unroll
            for (int i = 1; i < 64; ++i) {
                unsigned ra = abase + i * 272;
                if (i >= 3) asm volatile("" : "+v"(ra) : "v"(X[i - 2]));
                float a = X[i];
#pragma unroll
                for (int j4 = 0; j4 <= (i - 1) / 4; ++j4) { const f32x4 a4 = *(const LAS f32x4*)(ra + j4 * 16);
                    a -= a4[0] * X[4 * j4]; a -= a4[1] * X[4 * j4 + 1]; a -= a4[2] * X[4 * j4 + 2]; a -= a4[3] * X[4 * j4 + 3]; }
                X[i] = a;
            }
            if (isw) {
#pragma unroll
                for (int i = 0; i < 64; ++i) *(LAS bf16_t*)(L + G1_WS + i * 272 + d * 2) = (bf16_t)(cvt2(-X[i], 0.f) & 0xffffu);
            } else {
                const int ws = d >> 5, cc = d & 31;
#pragma unroll
                for (int rt = 0; rt < 2; ++rt)
#pragma unroll
                    for (int hh = 0; hh < 2; ++hh) { u32x4 o0, o1;
#pragma unroll
                        for (int q = 0; q < 2; ++q) { const int i0 = 32 * rt + 8 * q + 4 * hh, i1 = 32 * rt + 8 * (q + 2) + 4 * hh;
                            o0[2 * q] = cvt2(X[i0], X[i0 + 1]); o0[2 * q + 1] = cvt2(X[i0 + 2], X[i0 + 3]); o1[2 * q] = cvt2(X[i1], X[i1 + 1]); o1[2 * q + 1] = cvt2(X[i1 + 2], X[i1 + 3]); }
                        u32x4* dst = (u32x4*)(blk + GS_UF + (size_t)(((ws * 2 + rt) * 64) + cc + 32 * hh) * 32); dst[0] = o0; dst[1] = o1; }
            }
        } else {
            int l3 = lane; asm volatile("" : "+v"(l3));
            const int wv = wave - 4, r = l3 & 31, hh = l3 >> 5;
            {   const int rt4 = wv;
#pragma unroll
                for (int kt2 = 0; kt2 < 2; ++kt2)
#pragma unroll
                    for (int ss = 0; ss < 2; ++ss) { float v[8];
#pragma unroll
                        for (int j = 0; j < 8; ++j) { const int tok = 32 * kt2 + krow(ss, hh, j); v[j] = bf2f(*(const LAS bf16_t*)(L + G1_KS + tok * 272 + (32 * rt4 + r) * 2)) * ek_s[tok]; }
                        u32x4 o; o[0] = cvt2(v[0], v[1]); o[1] = cvt2(v[2], v[3]); o[2] = cvt2(v[4], v[5]); o[3] = cvt2(v[6], v[7]);
                        *(u32x4*)(blk + GS_KF + ((rt4 * 2 + kt2) * 2 + ss) * 1024 + lane * 16) = o; } }
            {   const int kt = wv;
#pragma unroll
                for (int rt = 0; rt < 2; ++rt)
#pragma unroll
                    for (int ss = 0; ss < 2; ++ss) { const int i = 32 * rt + r; const float sc = eg_s[i];
                        const u32x2 lo = *(const LAS u32x2*)(L + G1_QS + i * 272 + (32 * kt + 16 * ss + 4 * hh) * 2), hi = *(const LAS u32x2*)(L + G1_QS + i * 272 + (32 * kt + 16 * ss + 8 + 4 * hh) * 2);
                        u32x4 o; o[0] = cvt2(lo16(lo[0]) * sc, hi16(lo[0]) * sc); o[1] = cvt2(lo16(lo[1]) * sc, hi16(lo[1]) * sc); o[2] = cvt2(lo16(hi[0]) * sc, hi16(hi[0]) * sc); o[3] = cvt2(lo16(hi[1]) * sc, hi16(hi[1]) * sc);
                        *(u32x4*)(blk + GS_QF + ((rt * 4 + kt) * 2 + ss) * 1024 + lane * 16) = o; } }
            {   const int rt = wv >> 1, kt2 = wv & 1;
#pragma unroll
                for (int ss = 0; ss < 2; ++ss) { const int i = 32 * rt + r;
                    const u32x2 lo = *(const LAS u32x2*)(L + G1_PS + i * 144 + (32 * kt2 + 16 * ss + 4 * hh) * 2), hi = *(const LAS u32x2*)(L + G1_PS + i * 144 + (32 * kt2 + 16 * ss + 8 + 4 * hh) * 2);
                    u32x4 o; o[0] = lo[0]; o[1] = lo[1]; o[2] = hi[0]; o[3] = hi[1];
                    *(u32x4*)(blk + GS_PF + ((rt * 2 + kt2) * 2 + ss) * 1024 + lane * 16) = o; } }
        }
        __syncthreads();
        {
            int l4 = lane; asm volatile("" : "+v"(l4));
            const int kt = wave & 3, rt = wave >> 2, r = l4 & 31, hh = l4 >> 5, i = 32 * rt + r;
#pragma unroll
            for (int ss = 0; ss < 2; ++ss) {
                const u32x2 lo = *(const LAS u32x2*)(L + G1_WS + i * 272 + (32 * kt + 16 * ss + 4 * hh) * 2), hi = *(const LAS u32x2*)(L + G1_WS + i * 272 + (32 * kt + 16 * ss + 8 + 4 * hh) * 2);
                u32x4 o; o[0] = lo[0]; o[1] = lo[1]; o[2] = hi[0]; o[3] = hi[1];
                *(u32x4*)(blk + GS_WF + ((rt * 4 + kt) * 2 + ss) * 1024 + lane * 16) = o; }
        }
        __syncthreads();
    }
}

constexpr int G2_FB = 57344, G2_OS = 2 * G2_FB, G2_OSTRIDE = 528;
__device__ __forceinline__ bf16x8 pack8(const f32x16& x, const int s) {
    u32x4 p; p[0] = cvt2(x[8 * s], x[8 * s + 1]); p[1] = cvt2(x[8 * s + 2], x[8 * s + 3]); p[2] = cvt2(x[8 * s + 4], x[8 * s + 5]); p[3] = cvt2(x[8 * s + 6], x[8 * s + 7]);
    return __builtin_bit_cast(bf16x8, p);
}
__device__ __forceinline__ void phase_gdn_g2(Frame& F) {
    int tid = opaque_tid(F.wv);
    const int lane = tid & 63, wave = __builtin_amdgcn_readfirstlane(tid >> 6);
    LAS unsigned char* L = F.lds;
    const float* DEC = (const float*)(F.ws + WS_DEC);
    for (int task = blockIdx.x; task < 192; task += F.G) {
        int s, h, nch, ch0; if (task < 64) { s = task >> 3; h = task & 7; nch = 64; ch0 = s * 512 + h; } else { s = BP + ((task - 64) >> 3); h = task & 7; nch = 1; ch0 = 4096 + (s - BP) * 8 + h; }
        const int cstride = 8;
        const int base = seq_base(s), nvalid = s < BP ? 64 : TS;
        const unsigned char* blk0 = F.ws + WS_RB + (size_t)ch0 * GS_BYTES;
        if (wave < 4) {
            const int ws = wave, cc = lane & 31, hh = lane >> 5;
            f32x16 S0, S1, S2, S3;
            if (s < BP) {
#pragma unroll
                for (int e = 0; e < 16; ++e) { S0[e] = 0.f; S1[e] = 0.f; S2[e] = 0.f; S3[e] = 0.f; }
            } else {
                const float* sp = F.in[7] + ((size_t)(s - BP) * 8 + h) * 16384 + 32 * ws + cc;
#pragma unroll
                for (int e = 0; e < 16; ++e) { const int rr = (e & 3) + 8 * (e >> 2) + 4 * hh; S0[e] = sp[(size_t)rr * 128]; S1[e] = sp[(size_t)(32 + rr) * 128]; S2[e] = sp[(size_t)(64 + rr) * 128]; S3[e] = sp[(size_t)(96 + rr) * 128]; }
            }
            u32x4 un[4];
            { const u32x4* up = (const u32x4*)(blk0 + GS_UF + (size_t)(ws * 2 * 64 + lane) * 32); un[0] = up[0]; un[1] = up[1]; un[2] = up[128]; un[3] = up[129]; }
            __syncthreads();
            for (int c = 0; c < nch; ++c) {
                const LAS unsigned char* B = L + (c & 1) * G2_FB + lane * 16;
                const float dec = DEC[ch0 + c * cstride];
                f32x16 vn0, vn1, o0, o1;
#pragma unroll
                for (int q = 0; q < 4; ++q) { vn0[2 * q] = lo16(un[0][q]); vn0[2 * q + 1] = hi16(un[0][q]); vn0[8 + 2 * q] = lo16(un[1][q]); vn0[8 + 2 * q + 1] = hi16(un[1][q]);
                                              vn1[2 * q] = lo16(un[2][q]); vn1[2 * q + 1] = hi16(un[2][q]); vn1[8 + 2 * q] = lo16(un[3][q]); vn1[8 + 2 * q + 1] = hi16(un[3][q]); }
#pragma unroll
                for (int e = 0; e < 16; ++e) { o0[e] = 0.f; o1[e] = 0.f; }
                if (c + 1 < nch) { const u32x4* up = (const u32x4*)(blk0 + (size_t)(c + 1) * cstride * GS_BYTES + GS_UF + (size_t)(ws * 2 * 64 + lane) * 32); un[0] = up[0]; un[1] = up[1]; un[2] = up[128]; un[3] = up[129]; }
#define G2_WQ(Sx, kt) do { _Pragma("unroll") for (int ss = 0; ss < 2; ++ss) { const bf16x8 sb = pack8(Sx, ss); \
                    const bf16x8 fw0 = *(const LAS bf16x8*)(B + GS_WF + ((0 * 4 + kt) * 2 + ss) * 1024), fw1 = *(const LAS bf16x8*)(B + GS_WF + ((1 * 4 + kt) * 2 + ss) * 1024); \
                    const bf16x8 fq0 = *(const LAS bf16x8*)(B + GS_QF + ((0 * 4 + kt) * 2 + ss) * 1024), fq1 = *(const LAS bf16x8*)(B + GS_QF + ((1 * 4 + kt) * 2 + ss) * 1024); \
                    vn0 = MFMA32(fw0, sb, vn0); vn1 = MFMA32(fw1, sb, vn1); o0 = MFMA32(fq0, sb, o0); o1 = MFMA32(fq1, sb, o1); } } while (0)
                G2_WQ(S0, 0); G2_WQ(S1, 1); G2_WQ(S2, 2); G2_WQ(S3, 3);
#undef G2_WQ
                bf16x8 vb[2][2];
                vb[0][0] = pack8(vn0, 0); vb[0][1] = pack8(vn0, 1); vb[1][0] = pack8(vn1, 0); vb[1][1] = pack8(vn1, 1);
#pragma unroll
                for (int kt2 = 0; kt2 < 2; ++kt2)
#pragma unroll
                    for (int ss = 0; ss < 2; ++ss) {
                        const bf16x8 fp0 = *(const LAS bf16x8*)(B + GS_PF + ((0 * 2 + kt2) * 2 + ss) * 1024), fp1 = *(const LAS bf16x8*)(B + GS_PF + ((1 * 2 + kt2) * 2 + ss) * 1024);
                        o0 = MFMA32(fp0, vb[kt2][ss], o0); o1 = MFMA32(fp1, vb[kt2][ss], o1); }
#define G2_KS(Sx, rt4) do { Sx = Sx * dec; _Pragma("unroll") for (int kt2 = 0; kt2 < 2; ++kt2) _Pragma("unroll") for (int ss = 0; ss < 2; ++ss) { \
                    const bf16x8 fk = *(const LAS bf16x8*)(B + GS_KF + ((rt4 * 2 + kt2) * 2 + ss) * 1024); Sx = MFMA32(fk, vb[kt2][ss], Sx); } } while (0)
                G2_KS(S0, 0); G2_KS(S1, 1); G2_KS(S2, 2); G2_KS(S3, 3);
#undef G2_KS
                __syncthreads();
#pragma unroll
                for (int e = 0; e < 16; ++e) { const int rr = (e & 3) + 8 * (e >> 2) + 4 * hh;
                    *(LAS float*)(L + G2_OS + rr * G2_OSTRIDE + (32 * ws + cc) * 4) = o0[e]; *(LAS float*)(L + G2_OS + (32 + rr) * G2_OSTRIDE + (32 * ws + cc) * 4) = o1[e]; }
                __syncthreads();
            }
            float* so = (s < BP ? F.out + O_GSP + ((size_t)s * 8 + h) * 16384 : F.out + O_GSS + ((size_t)(s - BP) * 8 + h) * 16384) + 32 * ws + cc;
#pragma unroll
            for (int e = 0; e < 16; ++e) { const int rr = (e & 3) + 8 * (e >> 2) + 4 * hh; so[(size_t)rr * 128] = S0[e]; so[(size_t)(32 + rr) * 128] = S1[e]; so[(size_t)(64 + rr) * 128] = S2[e]; so[(size_t)(96 + rr) * 128] = S3[e]; }
        } else {
            const int lt = tid - 256;
            u32x4 pre[14];
            { const u32x4* src = (const u32x4*)blk0;
#pragma unroll
              for (int i = 0; i < 14; ++i) pre[i] = src[i * 256 + lt];
#pragma unroll
              for (int i = 0; i < 14; ++i) *(LAS u32x4*)(L + (size_t)(i * 256 + lt) * 16) = pre[i]; }
            __syncthreads();
            const int row = lt >> 2, seg = lt & 3;
            f32x4 hn[8];
#pragma unroll
            for (int q = 0; q < 8; ++q) hn[q] = *(const f32x4*)(F.in[32] + seg * 32 + 4 * q);
            for (int c = 0; c < nch; ++c) {
                const bool more = c + 1 < nch;
                if (more) { const u32x4* src = (const u32x4*)(blk0 + (size_t)(c + 1) * cstride * GS_BYTES);
#pragma unroll
                    for (int i = 0; i < 14; ++i) pre[i] = src[i * 256 + lt]; }
                const int m = base + c * 64 + row; const bool rok = row < nvalid;
                u32x4 zz[4];
                if (rok) { const u32x4* zp = (const u32x4*)(F.Z1() + (size_t)m * D + h * 128 + seg * 32);
#pragma unroll
                    for (int q = 0; q < 4; ++q) zz[q] = zp[q]; }
                __syncthreads();
                if (more) {
#pragma unroll
                    for (int i = 0; i < 14; ++i) *(LAS u32x4*)(L + ((c + 1) & 1) * G2_FB + (size_t)(i * 256 + lt) * 16) = pre[i]; }
                __syncthreads();
                f32x4 ov[8]; float ss = 0.f;
#pragma unroll
                for (int q = 0; q < 8; ++q) { ov[q] = *(const LAS f32x4*)(L + G2_OS + row * G2_OSTRIDE + (seg * 32 + 4 * q) * 4); ss += (ov[q][0] * ov[q][0] + ov[q][1] * ov[q][1]) + (ov[q][2] * ov[q][2] + ov[q][3] * ov[q][3]); }
                ss += __shfl_xor(ss, 1); ss += __shfl_xor(ss, 2);
                const float rn = rsqrtf(ss * (1.f / 128.f) + EPS);
                if (rok) { u32x4 yo[4];
#pragma unroll
                    for (int q = 0; q < 4; ++q) {
#pragma unroll
                        for (int e = 0; e < 4; ++e) { const int q2 = 2 * q + (e >> 1), e2 = 2 * (e & 1); const float z0 = lo16(zz[q][e]), z1 = hi16(zz[q][e]);
                            yo[q][e] = cvt2(ov[q2][e2] * rn * hn[q2][e2] * siluf_(z0), ov[q2][e2 + 1] * rn * hn[q2][e2 + 1] * siluf_(z1)); } }
                    u32x4* yp = (u32x4*)(F.Y1() + (size_t)m * D + h * 128 + seg * 32);
#pragma unroll
                    for (int q = 0; q < 4; ++q) yp[q] = yo[q]; }
            }
        }
        __syncthreads();
    }
}

#define MFMA16(a, b, c) __builtin_amdgcn_mfma_f32_16x16x32_bf16((a), (b), (c), 0, 0, 0)
__device__ __forceinline__ float dpp_shr_f(float idv, float x, const int o) {
    int r;
    switch (o) {
        case 1: r = __builtin_amdgcn_update_dpp(__float_as_int(idv), __float_as_int(x), 0x111, 0xf, 0xf, false); break;
        case 2: r = __builtin_amdgcn_update_dpp(__float_as_int(idv), __float_as_int(x), 0x112, 0xf, 0xf, false); break;
        case 4: r = __builtin_amdgcn_update_dpp(__float_as_int(idv), __float_as_int(x), 0x114, 0xf, 0xf, false); break;
        default: r = __builtin_amdgcn_update_dpp(__float_as_int(idv), __float_as_int(x), 0x118, 0xf, 0xf, false); break;
    }
    return __int_as_float(r);
}
template <int PASS>
__device__ __forceinline__ void phase_lru(Frame& F) {
    int tid = opaque_tid(F.wv);
    const int lane = tid & 63, wave = __builtin_amdgcn_readfirstlane(tid >> 6);
    const int gw = F.vcu * 8 + wave, NGW = F.G * 8, h = gw & 7, g = lane >> 4, l15 = lane & 15;
    LAS unsigned char* xs = F.lds + wave * 9216;
    LAS float* cst = (LAS float*)(F.lds + 73728 + wave * 768);
    const bf16_t* LGW = (const bf16_t*)(F.ws + WS_LGW);
    float* LAG = F.LAG();
    bf16x8 wfa[4][2], wfx[4][2];
#pragma unroll
    for (int nt = 0; nt < 4; ++nt)
#pragma unroll
        for (int ks = 0; ks < 2; ++ks) {
            wfa[nt][ks] = *(const bf16x8*)(LGW + ((size_t)(h * 2 + 0) * 64 + 16 * nt + l15) * 64 + 32 * ks + 8 * g);
            wfx[nt][ks] = *(const bf16x8*)(LGW + ((size_t)(h * 2 + 1) * 64 + 16 * nt + l15) * 64 + 32 * ks + 8 * g); }
    cst[lane] = F.in[18][h * 64 + lane]; cst[64 + lane] = F.in[20][h * 64 + lane]; cst[128 + lane] = softplusf_(-F.in[21][h * 64 + lane]);
    for (int task = gw; task < 4224; task += NGW) {
        int s, c; if (task < 4096) { s = task >> 9; c = (task >> 3) & 63; } else { s = BP + ((task - 4096) >> 3); c = 0; }
        const int T = seq_len(s), base = seq_base(s), t0 = c * 64, ntile = s < BP ? 4 : 1;
        {
            int l1 = lane; asm volatile("" : "+v"(l1));
            const int cg = l1 & 7, tp = l1 >> 3, chb = h * 64 + cg * 8;
            float xr[11][8];
#pragma unroll
            for (int i = 0; i < 11; ++i) {
                const int tt = t0 + tp * 8 - 3 + i;
                if (tt >= 0 && tt < T) { const u32x4 w = *(const u32x4*)(F.U0() + (size_t)(base + tt) * EV_IN + C_XA + chb);
#pragma unroll
                    for (int e = 0; e < 4; ++e) { xr[i][2 * e] = lo16(w[e]); xr[i][2 * e + 1] = hi16(w[e]); } }
                else if (tt < 0 && s >= BP) { const f32x4* sp = (const f32x4*)(F.in[2] + ((size_t)(s - BP) * 3 + (tt + 3)) * 512 + chb); const f32x4 a = sp[0], b = sp[1];
                    xr[i][0] = a[0]; xr[i][1] = a[1]; xr[i][2] = a[2]; xr[i][3] = a[3]; xr[i][4] = b[0]; xr[i][5] = b[1]; xr[i][6] = b[2]; xr[i][7] = b[3]; }
                else {
#pragma unroll
                    for (int e = 0; e < 8; ++e) xr[i][e] = 0.f; }
            }
            float cw[4][8], cb[8];
#pragma unroll
            for (int jj = 0; jj < 4; ++jj) { const f32x4 a = *(const f32x4*)(F.in[15] + jj * 512 + chb), b = *(const f32x4*)(F.in[15] + jj * 512 + chb + 4);
                cw[jj][0] = a[0]; cw[jj][1] = a[1]; cw[jj][2] = a[2]; cw[jj][3] = a[3]; cw[jj][4] = b[0]; cw[jj][5] = b[1]; cw[jj][6] = b[2]; cw[jj][7] = b[3]; }
            { const f32x4 a = *(const f32x4*)(F.in[16] + chb), b = *(const f32x4*)(F.in[16] + chb + 4); cb[0] = a[0]; cb[1] = a[1]; cb[2] = a[2]; cb[3] = a[3]; cb[4] = b[0]; cb[5] = b[1]; cb[6] = b[2]; cb[7] = b[3]; }
#pragma unroll
            for (int i = 0; i < 8; ++i) { float o[8];
#pragma unroll
                for (int e = 0; e < 8; ++e) o[e] = cw[0][e] * xr[i][e] + cw[1][e] * xr[i + 1][e] + cw[2][e] * xr[i + 2][e] + cw[3][e] * xr[i + 3][e] + cb[e];
                u32x4 w; w[0] = cvt2(o[0], o[1]); w[1] = cvt2(o[2], o[3]); w[2] = cvt2(o[4], o[5]); w[3] = cvt2(o[6], o[7]);
                *(LAS u32x4*)(xs + (tp * 8 + i) * 144 + cg * 16) = w; }
            if (PASS == 2 && t0 + 64 >= T && tp == ((T - 1) >> 3) - (t0 >> 3)) {
                float* o = (s < BP ? F.out + O_LCP + (size_t)s * 3 * 512 : F.out + O_LCS + (size_t)(s - BP) * 3 * 512) + chb;
#pragma unroll
                for (int q = 0; q < 3; ++q) { *(f32x4*)(o + q * 512) = (f32x4){xr[8 + q][0], xr[8 + q][1], xr[8 + q][2], xr[8 + q][3]}; *(f32x4*)(o + q * 512 + 4) = (f32x4){xr[8 + q][4], xr[8 + q][5], xr[8 + q][6], xr[8 + q][7]}; }
            }
        }
        float hin[4][4], arun[4][4];
#pragma unroll
        for (int nt = 0; nt < 4; ++nt)
#pragma unroll
            for (int rg = 0; rg < 4; ++rg) { hin[nt][rg] = 0.f; arun[nt][rg] = 1.f; }
        if (PASS == 2) {
            float hf = s >= BP ? F.in[3][(s - BP) * 512 + h * 64 + lane] : 0.f;
            const f32x2* lp = (const f32x2*)LAG + (size_t)(s * 64) * 512 + h * 64 + lane;
            int j = 0;
            for (; j + 8 <= c; j += 8) { f32x2 v[8];
#pragma unroll
                for (int q = 0; q < 8; ++q) v[q] = lp[(size_t)(j + q) * 512];
#pragma unroll
                for (int q = 0; q < 8; ++q) hf = v[q][0] * hf + v[q][1]; }
            for (; j < c; ++j) { const f32x2 v = lp[(size_t)j * 512]; hf = v[0] * hf + v[1]; }
#pragma unroll
            for (int nt = 0; nt < 4; ++nt)
#pragma unroll
                for (int rg = 0; rg < 4; ++rg) hin[nt][rg] = __shfl(hf, 16 * nt + 4 * g + rg);
        }
        asm volatile("s_waitcnt lgkmcnt(0)" ::: "memory");
        for (int tt = 0; tt < ntile; ++tt) {
            const int tok = 16 * tt + l15;
            const bf16x8 b0 = *(const LAS bf16x8*)(xs + tok * 144 + (8 * g) * 2), b1 = *(const LAS bf16x8*)(xs + tok * 144 + (32 + 8 * g) * 2);
            const size_t m = (size_t)base + t0 + tok;
#pragma unroll
            for (int nt = 0; nt < 4; ++nt) {
                f32x4 za = {0.f, 0.f, 0.f, 0.f}, zx = {0.f, 0.f, 0.f, 0.f};
                za = MFMA16(wfa[nt][0], b0, za); za = MFMA16(wfa[nt][1], b1, za);
                zx = MFMA16(wfx[nt][0], b0, zx); zx = MFMA16(wfx[nt][1], b1, zx);
                const int n0 = 16 * nt + 4 * g;
                const u32x2 xw = *(const LAS u32x2*)(xs + tok * 144 + n0 * 2);
                const float xc[4] = {lo16(xw[0]), hi16(xw[0]), lo16(xw[1]), hi16(xw[1])};
                const f32x4 cba = *(const LAS f32x4*)(cst + n0), cbx = *(const LAS f32x4*)(cst + 64 + n0), csp = *(const LAS f32x4*)(cst + 128 + n0);
                float av[4], bv[4];
#pragma unroll
                for (int rg = 0; rg < 4; ++rg) {
                    const float r = sigmoidf_(za[rg] + cba[rg]), ig = sigmoidf_(zx[rg] + cbx[rg]), la = -8.0f * r * csp[rg], a = __expf(la);
                    av[rg] = a; bv[rg] = sqrtf(fmaxf(1.0f - a * a, 0.f)) * (ig * xc[rg]); }
#pragma unroll
                for (int o = 1; o < 16; o <<= 1)
#pragma unroll
                    for (int rg = 0; rg < 4; ++rg) { const float ap = dpp_shr_f(1.0f, av[rg], o), bp = dpp_shr_f(0.0f, bv[rg], o); bv[rg] = av[rg] * bp + bv[rg]; av[rg] = av[rg] * ap; }
                float hv[4];
#pragma unroll
                for (int rg = 0; rg < 4; ++rg) { hv[rg] = bv[rg] + av[rg] * hin[nt][rg]; hin[nt][rg] = __shfl(hv[rg], (lane & 48) | 15); }
                if (PASS == 1) {
#pragma unroll
                    for (int rg = 0; rg < 4; ++rg) arun[nt][rg] *= __shfl(av[rg], (lane & 48) | 15);
                } else {
                    const bool tok_ok = (t0 + tok) < T;
                    if (tok_ok) {
                        const u32x2 gw2 = *(const u32x2*)(F.U0() + m * EV_IN + C_GA + h * 64 + n0);
                        u32x2 yo; yo[0] = cvt2(hv[0] * siluf_(lo16(gw2[0])), hv[1] * siluf_(hi16(gw2[0]))); yo[1] = cvt2(hv[2] * siluf_(lo16(gw2[1])), hv[3] * siluf_(hi16(gw2[1])));
                        *(u32x2*)(F.Y0() + m * D + h * 64 + n0) = yo;
                        if (t0 + tok == T - 1) { float* o = (s < BP ? F.out + O_LHP + s * 512 : F.out + O_LHS + (s - BP) * 512) + h * 64 + n0; *(f32x4*)o = (f32x4){hv[0], hv[1], hv[2], hv[3]}; }
                    }
                }
            }
        }
        if (PASS == 1 && s < BP && l15 == 15) {
            f32x2* lp = (f32x2*)LAG + (size_t)(s * 64 + c) * 512 + h * 64;
#pragma unroll
            for (int nt = 0; nt < 4; ++nt)
#pragma unroll
                for (int rg = 0; rg < 4; ++rg) lp[16 * nt + 4 * g + rg] = (f32x2){arun[nt][rg], hin[nt][rg]};
        }
        asm volatile("s_waitcnt lgkmcnt(0)" ::: "memory");
    }
}

constexpr size_t RB_VTP = RB_WEND, RB_VTS = RB_VTP + (size_t)BP * 2 * 64 * TP * 2, RB_VTEND = RB_VTS + (size_t)BS * 2 * 64 * 192 * 2;
static_assert(RB_VTEND <= RB_BYTES, "ws map");
__device__ __forceinline__ void phase_vt_build(Frame& F) {
    PHASE_IDS();
    const int gw = F.vcu * 8 + wave, NGW = F.G * 8;
    LAS unsigned char* xs = F.lds + wave * 9216;
    bf16_t* VTP = (bf16_t*)(F.ws + WS_RB + RB_VTP); bf16_t* VTS = (bf16_t*)(F.ws + WS_RB + RB_VTS);
    for (int task = gw; task < 1024 + 96; task += NGW) {
        int s, kv, kb; if (task < 1024) { s = task >> 7; kv = (task >> 6) & 1; kb = task & 63; } else { const int r = task - 1024; s = BP + r / 6; kv = (r % 6) / 3; kb = r % 3; }
        const int row8 = lane >> 3, ch = lane & 7;
#pragma unroll
        for (int i = 0; i < 8; ++i) {
            const int key = 8 * i + row8, kg = kb * 64 + key; u32x4 w = {0u, 0u, 0u, 0u};
            if (s < BP) w = *(const u32x4*)(F.U0() + (size_t)(s * TP + kg) * EV_IN + C_V + kv * 64 + ch * 8);
            else if (kg < 128) { const f32x4* p = (const f32x4*)(F.in[5] + ((size_t)((s - BP) * 128 + kg) * 2 + kv) * 64 + ch * 8); const f32x4 a = p[0], b = p[1]; w[0] = cvt2(a[0], a[1]); w[1] = cvt2(a[2], a[3]); w[2] = cvt2(b[0], b[1]); w[3] = cvt2(b[2], b[3]); }
            else if (kg < 128 + TS) w = *(const u32x4*)(F.U0() + (size_t)(MP + (s - BP) * TS + (kg - 128)) * EV_IN + C_V + kv * 64 + ch * 8);
            *(LAS u32x4*)(xs + key * 144 + ch * 16) = w;
        }
        asm volatile("s_waitcnt lgkmcnt(0)" ::: "memory");
        bf16_t* dst = s < BP ? VTP + ((size_t)(s * 2 + kv) * 64 + lane) * TP + kb * 64 : VTS + ((size_t)((s - BP) * 2 + kv) * 64 + lane) * 192 + kb * 64;
#pragma unroll
        for (int q = 0; q < 8; ++q) { u32x4 o;
#pragma unroll
            for (int e = 0; e < 4; ++e) { const unsigned lo = *(const LAS bf16_t*)(xs + (8 * q + 2 * e) * 144 + lane * 2), hi = *(const LAS bf16_t*)(xs + (8 * q + 2 * e + 1) * 144 + lane * 2); o[e] = lo | (hi << 16); }
            *(u32x4*)(dst + 8 * q) = o; }
        asm volatile("s_waitcnt lgkmcnt(0)" ::: "memory");
    }
}
constexpr int AT_K = 0, AT_V = 27648;
__device__ __forceinline__ void phase_attn(Frame& F) {
    PHASE_IDS();
    LAS unsigned char* L = F.lds;
    const bf16_t* VTP = (const bf16_t*)(F.ws + WS_RB + RB_VTP); const bf16_t* VTS = (const bf16_t*)(F.ws + WS_RB + RB_VTS);
    for (int task = F.vcu; task < 1024 + 32; task += F.G) {
        int s, c, kv; if (task < 1024) { s = task >> 7; c = (task >> 1) & 63; kv = task & 1; } else { s = BP + ((task - 1024) >> 1); c = 0; kv = task & 1; }
        const int base = seq_base(s), tok0 = c * 64 - 128;
        const int kmin = s < BP ? (tok0 < 0 ? -tok0 : 0) : 0, kmax = s < BP ? 192 : 128 + TS;
        __syncthreads();
#pragma unroll
        for (int i = 0; i < 3; ++i) {
            const int idx = tid + 512 * i, key = idx >> 3, ch = idx & 7; u32x4 w = {0u, 0u, 0u, 0u};
            if (key >= kmin && key < kmax) {
                if (s < BP) w = *(const u32x4*)(F.U0() + (size_t)(base + tok0 + key) * EV_IN + C_K + kv * 64 + ch * 8);
                else if (key < 128) { const f32x4* p = (const f32x4*)(F.in[4] + ((size_t)((s - BP) * 128 + key) * 2 + kv) * 64 + ch * 8); const f32x4 a = p[0], b = p[1]; w[0] = cvt2(a[0], a[1]); w[1] = cvt2(a[2], a[3]); w[2] = cvt2(b[0], b[1]); w[3] = cvt2(b[2], b[3]); }
                else w = *(const u32x4*)(F.U0() + (size_t)(base + key - 128) * EV_IN + C_K + kv * 64 + ch * 8);
            }
            *(LAS u32x4*)(L + AT_K + key * 144 + ch * 16) = w;
        }
#pragma unroll
        for (int i = 0; i < 3; ++i) {
            const int idx = tid + 512 * i, d = idx / 24, ch = idx % 24, key = ch * 8; u32x4 w = {0u, 0u, 0u, 0u};
            if (s < BP) { if (key >= kmin) w = *(const u32x4*)(VTP + ((size_t)(s * 2 + kv) * 64 + d) * TP + tok0 + key); }
            else w = *(const u32x4*)(VTS + ((size_t)((s - BP) * 2 + kv) * 64 + d) * 192 + key);
            *(LAS u32x4*)(L + AT_V + d * 400 + ch * 16) = w;
        }
        const int g = wave >> 1, qh = wave & 1, hq = kv * 4 + g, r = lane & 31, hh = lane >> 5, qi = qh * 32 + r;
        const bool qok = s < BP ? true : qi < TS;
        const size_t m = (size_t)base + c * 64 + (qok ? qi : 0);
        bf16x8 qf[4];
#pragma unroll
        for (int ks = 0; ks < 4; ++ks) { u32x4 w = {0u, 0u, 0u, 0u};
            if (qok) { const u32x4 x = *(const u32x4*)(F.U0() + m * EV_IN + C_Q + hq * 64 + 16 * ks + 8 * hh);
#pragma unroll
                for (int e = 0; e < 4; ++e) w[e] = cvt2(lo16(x[e]) * 0.125f, hi16(x[e]) * 0.125f); }
            qf[ks] = __builtin_bit_cast(bf16x8, w); }
        const float sink = F.in[22][hq];
        __syncthreads();
        f32x16 sc[6];
#pragma unroll
        for (int kt = 0; kt < 6; ++kt) {
#pragma unroll
            for (int e = 0; e < 16; ++e) sc[kt][e] = 0.f;
#pragma unroll
            for (int ks = 0; ks < 4; ++ks) { const bf16x8 kf = *(const LAS bf16x8*)(L + AT_K + (32 * kt + r) * 144 + (16 * ks + 8 * hh) * 2); sc[kt] = MFMA32(kf, qf[ks], sc[kt]); }
        }
        float mx = sink;
#pragma unroll
        for (int kt = 0; kt < 6; ++kt)
#pragma unroll
            for (int e = 0; e < 16; ++e) { const int kidx = 32 * kt + (e & 3) + 8 * (e >> 2) + 4 * hh; const bool ok = kidx >= kmin && kidx < kmax; sc[kt][e] = ok ? sc[kt][e] : -1e30f; mx = fmaxf(mx, sc[kt][e]); }
        mx = fmaxf(mx, __shfl_xor(mx, 32));
        float lsum = 0.f;
#pragma unroll
        for (int kt = 0; kt < 6; ++kt)
#pragma unroll
            for (int e = 0; e < 16; ++e) { const float p = __expf(sc[kt][e] - mx); sc[kt][e] = p; lsum += p; }
        lsum += __shfl_xor(lsum, 32);
        const float il = 1.0f / (lsum + __expf(sink - mx));
        f32x16 o0, o1;
#pragma unroll
        for (int e = 0; e < 16; ++e) { o0[e] = 0.f; o1[e] = 0.f; }
#pragma unroll
        for (int kt = 0; kt < 6; ++kt)
#pragma unroll
            for (int ss = 0; ss < 2; ++ss) {
                const bf16x8 pb = pack8(sc[kt], ss);
                const LAS unsigned char* vp = L + AT_V + r * 400 + (32 * kt + 16 * ss + 4 * hh) * 2;
                const u32x2 a0 = *(const LAS u32x2*)vp, a1 = *(const LAS u32x2*)(vp + 16), b0 = *(const LAS u32x2*)(vp + 32 * 400), b1 = *(const LAS u32x2*)(vp + 32 * 400 + 16);
                const u32x4 va = {a0[0], a0[1], a1[0], a1[1]}, vb = {b0[0], b0[1], b1[0], b1[1]};
                o0 = MFMA32(__builtin_bit_cast(bf16x8, va), pb, o0); o1 = MFMA32(__builtin_bit_cast(bf16x8, vb), pb, o1);
            }
        if (qok) {
#pragma unroll
            for (int qq = 0; qq < 4; ++qq) {
                { const int d = 8 * qq + 4 * hh; const u32x2 gb = *(const u32x2*)(F.U0() + m * EV_IN + C_GB + hq * 64 + d);
                  u32x2 yo; yo[0] = cvt2(o0[4 * qq] * il * siluf_(lo16(gb[0])), o0[4 * qq + 1] * il * siluf_(hi16(gb[0]))); yo[1] = cvt2(o0[4 * qq + 2] * il * siluf_(lo16(gb[1])), o0[4 * qq + 3] * il * siluf_(hi16(gb[1])));
                  *(u32x2*)(F.Y0() + m * D + 512 + hq * 64 + d) = yo; }
                { const int d = 32 + 8 * qq + 4 * hh; const u32x2 gb = *(const u32x2*)(F.U0() + m * EV_IN + C_GB + hq * 64 + d);
                  u32x2 yo; yo[0] = cvt2(o1[4 * qq] * il * siluf_(lo16(gb[0])), o1[4 * qq + 1] * il * siluf_(hi16(gb[0]))); yo[1] = cvt2(o1[4 * qq + 2] * il * siluf_(lo16(gb[1])), o1[4 * qq + 3] * il * siluf_(hi16(gb[1])));
                  *(u32x2*)(F.Y0() + m * D + 512 + hq * 64 + d) = yo; }
            }
        }
    }
    __syncthreads();
}

__device__ __forceinline__ void phase_final_rowwise(Frame& F) {
    PHASE_IDS();
    const int gw = F.vcu * 8 + wave, NGW = F.G * 8;
    for (int m = gw; m < MT; m += NGW) {
        int s, t; tok_info(m, s, t);
        const float* mod1 = F.MOD() + (size_t)(24 + s) * 3072;
        f32x4 y[4]; float ss = 0.f;
#pragma unroll
        for (int j = 0; j < 4; ++j) { const u32x2 w = *(const u32x2*)(F.YO() + (size_t)m * D + 4 * lane + 256 * j); y[j] = (f32x4){lo16(w.x), hi16(w.x), lo16(w.y), hi16(w.y)};
            ss += (y[j][0] * y[j][0] + y[j][1] * y[j][1]) + (y[j][2] * y[j][2] + y[j][3] * y[j][3]); }
        const float r1 = rsqrtf(wave_sum(ss) * (1.f / D) + EPS);
#pragma unroll
        for (int j = 0; j < 4; ++j) { const int c = 4 * lane + 256 * j;
            float* op = F.out + O_Y + (size_t)m * D + c;
            const f32x4 xv = *(const f32x4*)op, g = *(const f32x4*)(F.in[27] + c), gt = *(const f32x4*)(mod1 + 2048 + c);
            f32x4 o;
#pragma unroll
            for (int e = 0; e < 4; ++e) o[e] = xv[e] + gt[e] * (y[j][e] * r1 * g[e]);
            *(f32x4*)op = o; }
    }
}

__global__ void __launch_bounds__(512, 2) fwd_megakernel(Params P) {
    extern __shared__ __attribute__((aligned(16))) unsigned char lds_raw[];
    cg::grid_group grid = cg::this_grid();
    Frame F;
    F.lds = (LAS unsigned char*)lds_raw;
    F.wv = __builtin_amdgcn_readfirstlane(threadIdx.x >> 6);
    F.G = gridDim.x; { const int bx = blockIdx.x; F.vcu = (F.G % 8 == 0) ? (bx % 8) * (F.G / 8) + bx / 8 : bx; }
    F.in = P.in; F.out = P.out; F.ws = P.ws;

    phase_prologue(F);
    grid.sync();
    phase_prenorm0(F);
    grid.sync();
    { pg8::Gemm g{F.XN(), F.W0I(), MT, EV_IN, D}; pg8::StaticOrder S; S.init(MT, EV_IN, F.G, (int)blockIdx.x);
      pg8::EpiBf16 E{F.U0(), EV_IN, 1 << 30, F.U0(), EV_IN}; pg8::gemm_phase(F.lds, g, S, E, F.wv); }
    grid.sync();
    phase_rope(F);
    phase_lru<1>(F);
    phase_vt_build(F);
    grid.sync();
    phase_lru<2>(F);
    phase_attn(F);
    grid.sync();
    { pg8::Gemm g{F.Y0(), F.W0O(), MT, D, D}; pg8::StaticOrder S; S.init(MT, D, F.G, (int)blockIdx.x);
      pg8::EpiBf16 E{F.YO(), D, 1 << 30, F.YO(), D}; pg8::gemm_phase(F.lds, g, S, E, F.wv); }
    grid.sync();
    phase_mid_rowwise(F);
    grid.sync();
    { pg8::Gemm g{F.XN(), F.W1I(), MT, OD_MAIN, D}; pg8::StaticOrder S; S.init(MT, OD_MAIN, F.G, (int)blockIdx.x);
      pg8::EpiBf16 E{F.QKV1(), 3072, 3072, F.Z1(), D}; pg8::gemm_phase(F.lds, g, S, E, F.wv); }
    grid.sync();
    phase_gdn_g1(F);
    grid.sync();
    phase_gdn_g2(F);
    grid.sync();
    { pg8::Gemm g{F.Y1(), F.W1O(), MT, D, D}; pg8::StaticOrder S; S.init(MT, D, F.G, (int)blockIdx.x);
      pg8::EpiBf16 E{F.YO(), D, 1 << 30, F.YO(), D}; pg8::gemm_phase(F.lds, g, S, E, F.wv); }
    grid.sync();
    phase_final_rowwise(F);
}

extern "C" void kernel_launch(void* const* d_in, const int* in_sizes, int n_in, void* d_out, int out_size, void* d_ws, size_t ws_size, hipStream_t stream) {
    static int grid = 0;
    if (grid == 0) {
        if (n_in != 34 || out_size != (int)O_END || ws_size < WS_END) { grid = -1; return; }
        int dev = 0, cus = 0, per_cu = 0;
        if (hipGetDevice(&dev) != hipSuccess || hipDeviceGetAttribute(&cus, hipDeviceAttributeMultiprocessorCount, dev) != hipSuccess) { grid = -1; return; }
        if (hipFuncSetAttribute((const void*)fwd_megakernel, hipFuncAttributeMaxDynamicSharedMemorySize, LDS_BYTES) != hipSuccess) { grid = -1; return; }
        if (hipOccupancyMaxActiveBlocksPerMultiprocessor(&per_cu, (const void*)fwd_megakernel, 512, LDS_BYTES) != hipSuccess || per_cu < 1) { grid = -1; return; }
        grid = cus;
    }
    if (grid < 0) return;
    Params p{};
    for (int i = 0; i < 34; ++i) p.in[i] = (const float*)d_in[i];
    p.out = (float*)d_out; p.ws = (unsigned char*)d_ws;
    void* args[] = {&p};
    (void)hipLaunchCooperativeKernel((const void*)fwd_megakernel, dim3(grid), dim3(512), args, LDS_BYTES, stream);
}
```

```cpp
#include <hip/hip_runtime.h>
#include <hip/hip_cooperative_groups.h>
namespace cg = cooperative_groups;

#define LAS __attribute__((address_space(3)))
typedef unsigned short bf16_t;
typedef short bf16x8 __attribute__((ext_vector_type(8)));
typedef float f32x4 __attribute__((ext_vector_type(4)));
typedef float f32x2 __attribute__((ext_vector_type(2)));
typedef unsigned u32x4 __attribute__((ext_vector_type(4)));
typedef unsigned u32x2 __attribute__((ext_vector_type(2)));

constexpr int D = 1024, BP = 8, TP = 4096, BS = 16, TS = 16;
constexpr int MP = BP * TP, MS = BS * TS, MT = MP + MS;
constexpr int NSEQ = BP + BS;
constexpr int EV_IN = 2304, OD_IN = 4112, OD_MAIN = 4096;
constexpr int C_XA = 0, C_GA = 512, C_Q = 1024, C_K = 1536, C_V = 1664, C_GB = 1792;
constexpr float EPS = 1e-6f;
constexpr size_t O_Y = 0, O_LCP = 33816576, O_LCS = 33828864, O_LHP = 33853440, O_LHS = 33857536, O_KP = 33865728, O_KS = 33996800,
                 O_VP = 34029568, O_VS = 34160640, O_GCP = 34193408, O_GCS = 34267136, O_GSP = 34414592, O_GSS = 35463168, O_END = 37560320;
constexpr size_t MiB = 1u << 20;
constexpr size_t WS_CTL = 0, WS_W1O = 1 * MiB, WS_MOD = 3 * MiB, WS_ROPE = 4 * MiB, WS_BA = 5 * MiB, WS_LAG = 8 * MiB, WS_LGW = 10 * MiB;
constexpr size_t WS_RA = 16 * MiB, RA_BYTES = (size_t)MT * 4096 * 2;
constexpr size_t WS_RB = WS_RA + RA_BYTES;
constexpr size_t ACT_BYTES = (size_t)MT * D * 2;
constexpr size_t RB_XN = 0, RB_Y0 = ACT_BYTES, RB_YO = 2 * ACT_BYTES, RB_W0I = 3 * ACT_BYTES, RB_W0O = RB_W0I + (size_t)EV_IN * D * 2,
                 RB_W1I = RB_W0O + (size_t)D * D * 2, RB_WEND = RB_W1I + (size_t)OD_MAIN * D * 2;
constexpr size_t RB_BYTES = (size_t)4224 * 73728;
constexpr size_t WS_END = WS_RB + RB_BYTES;
static_assert(RB_WEND <= RB_BYTES, "ws map");
static_assert((size_t)MT * 3072 * 2 <= RB_BYTES, "ws map");
constexpr int LDS_BYTES = 155648;

struct Params { const float* in[34]; float* out; unsigned char* ws; };

__device__ __forceinline__ float bf2f(bf16_t b) { return __uint_as_float(((unsigned)b) << 16); }
__device__ __forceinline__ unsigned f2bf(float f) { unsigned u = __float_as_uint(f); return (u + 0x7fffu + ((u >> 16) & 1u)) >> 16; }
__device__ __forceinline__ unsigned pk2(float lo, float hi) { return f2bf(lo) | (f2bf(hi) << 16); }
__device__ __forceinline__ float lo16(unsigned w) { return __uint_as_float(w << 16); }
__device__ __forceinline__ float hi16(unsigned w) { return __uint_as_float(w & 0xffff0000u); }
__device__ __forceinline__ float wave_sum(float v) {
#pragma unroll
    for (int o = 1; o < 64; o <<= 1) v += __shfl_xor(v, o);
    return v;
}
__device__ __forceinline__ float sigmoidf_(float x) { return 1.0f / (1.0f + __expf(-x)); }
__device__ __forceinline__ float siluf_(float x) { return x / (1.0f + __expf(-x)); }
__device__ __forceinline__ float softplusf_(float x) { return x > 20.f ? x : log1pf(__expf(x)); }
__device__ __forceinline__ int seq_base(int s) { return s < BP ? s * TP : MP + (s - BP) * TS; }
__device__ __forceinline__ int seq_len(int s) { return s < BP ? TP : TS; }
__device__ __forceinline__ void tok_info(int m, int& s, int& t) { if (m < MP) { s = m >> 12; t = m & 4095; } else { const int r = m - MP; s = BP + (r >> 4); t = r & 15; } }

__device__ __forceinline__ int opaque_tid(int wv) { int l = __builtin_amdgcn_mbcnt_hi(~0u, __builtin_amdgcn_mbcnt_lo(~0u, 0u)); asm volatile("" : "+v"(l)); return wv * 64 + l; }
namespace pg8 {
constexpr int BM = 256, BK = 64, HALF = 128, HTB = HALF * BK * 2, STAGE_BYTES = 8 * HTB, NXCD = 8, WGM = 8;
__host__ __device__ __forceinline__ int lds_byte(int r, int c) { const int st = (r >> 4) * 2 + (c >> 5), rr = r & 15, cc = c & 31, ob = rr * 64 + cc * 2; return st * 1024 + (ob ^ (((ob >> 9) & 1) << 5)); }
__host__ __device__ __forceinline__ void stage_rc(int b, int& R, int& C) { const int st = b / 1024, sb = b % 1024, swz = sb ^ (((sb >> 9) & 1) << 5); R = (st >> 1) * 16 + swz / 64; C = (st & 1) * 32 + (swz % 64) / 2; }
__host__ __device__ __forceinline__ int perm32(int rho) { const int n = rho >> 4, i = rho & 15; return 8 * (i >> 2) + 4 * n + (i & 3); }
struct Unit { int pm, pn; };
struct Gemm { const bf16_t* A; const bf16_t* Bt; int M, N, K; };
struct StaticOrder {
    int nM, nN, nwg, G, c;
    __device__ void init(int M, int N, int G_, int c_) { nM = M / BM; nN = N / BM; nwg = nM * nN; G = G_; c = c_; }
    __device__ bool next(int i, Unit& u) const {
        const long L = (long)i * G + c; if (L >= nwg) return false;
        int wgid = (int)L; { const int q = nwg / NXCD, r = nwg % NXCD, xcd = wgid % NXCD, off = wgid / NXCD; wgid = (xcd < r ? xcd * (q + 1) : r * (q + 1) + (xcd - r) * q) + off; }
        const int nig = WGM * nN, gid = wgid / nig, fm = gid * WGM, gsz = (nM - fm) < WGM ? (nM - fm) : WGM;
        u.pm = fm + ((wgid % nig) % gsz); u.pn = (wgid % nig) / gsz; return true;
    }
};
__device__ __forceinline__ unsigned cvt_pk_bf16(float lo, float hi) { unsigned r; asm volatile("v_cvt_pk_bf16_f32 %0, %1, %2" : "=v"(r) : "v"(lo), "v"(hi)); return r; }
struct EpiBf16 {
    static constexpr bool PERM = true;
    bf16_t* O0; int ld0; int split; bf16_t* O1; int ld1;
    __device__ __forceinline__ void operator()(const f32x4 (&acc)[2][2][4][2], const Unit& u, int wr, int wc, int fr, int fq) const {
        const int row0 = u.pm * BM + wr * 64 + fr; int colt = u.pn * BM; bf16_t* base = O0; int ld = ld0;
        if (colt >= split) { base = O1; ld = ld1; colt -= split; }
        const int col0 = colt + wc * 32 + 8 * fq;
#pragma unroll
        for (int ai = 0; ai < 2; ++ai)
#pragma unroll
            for (int m = 0; m < 4; ++m) { bf16_t* rowp = base + (size_t)(row0 + ai * HALF + m * 16) * ld + col0;
#pragma unroll
                for (int bj = 0; bj < 2; ++bj) { const f32x4 v0 = acc[ai][bj][m][0], v1 = acc[ai][bj][m][1];
                    u32x4 w; w.x = cvt_pk_bf16(v0[0], v0[1]); w.y = cvt_pk_bf16(v0[2], v0[3]); w.z = cvt_pk_bf16(v1[0], v1[1]); w.w = cvt_pk_bf16(v1[2], v1[3]);
                    *(u32x4*)(rowp + bj * HALF) = w; } }
    }
};
template <class Epi, class Sched>
__device__ __forceinline__ void gemm_phase(LAS unsigned char* lds, const Gemm g, const Sched& S, const Epi& E, const int wv0) {
    int tid = opaque_tid(wv0);
    const int wid = __builtin_amdgcn_readfirstlane(tid >> 6), lane = tid & 63, wr = wid >> 2, wc = wid & 3, fr = lane & 15, fq = lane >> 4;
    const int K = g.K, nt = K / BK;
    unsigned voffA[2], voffB[2];
#pragma unroll
    for (int i = 0; i < 2; ++i) { int R, C; stage_rc(tid * 16 + i * 8192, R, C); const int Rb = Epi::PERM ? ((R & ~31) + perm32(R & 31)) : R;
        voffA[i] = (unsigned)(R * K + C) * 2u; voffB[i] = (unsigned)(Rb * K + C) * 2u; }
    const size_t kstep = (size_t)(BK * 2);
    const size_t hstep = (size_t)HALF * K * 2;
    const size_t tstep = 2 * hstep;
    const unsigned ldsw = (unsigned)wid * 1024u;
    const int aoff = lds_byte(wr * 64 + fr, fq * 8), boff = lds_byte(wc * 32 + fr, fq * 8);
#define PG8_SA(b, h) (((b) * 2 + (h)) * HTB)
#define PG8_SB(b, h) ((4 + (b) * 2 + (h)) * HTB)
#define PG8_STAGE(bufoff, gbase, voff) do { _Pragma("unroll") for (int _i = 0; _i < 2; ++_i) \
        __builtin_amdgcn_global_load_lds((const unsigned*)((const char*)(gbase) + (voff)[_i]), (LAS unsigned*)(lds + (bufoff) + ldsw + _i * 8192), 16, 0, 0); } while (0)
#define PG8_LDA(dst, b, h) do { _Pragma("unroll") for (int m = 0; m < 4; ++m) _Pragma("unroll") for (int k = 0; k < 2; ++k) dst[m][k] = *(const LAS bf16x8*)(lds + PG8_SA(b, h) + aoff + m * 2048 + k * 1024); } while (0)
#define PG8_LDB(dst, b, h) do { _Pragma("unroll") for (int n = 0; n < 2; ++n) _Pragma("unroll") for (int k = 0; k < 2; ++k) dst[n][k] = *(const LAS bf16x8*)(lds + PG8_SB(b, h) + boff + n * 2048 + k * 1024); } while (0)
#define PG8_MMA(ai, bj, At, Bt) do { __builtin_amdgcn_s_setprio(1); _Pragma("unroll") for (int m = 0; m < 4; ++m) _Pragma("unroll") for (int n = 0; n < 2; ++n) _Pragma("unroll") for (int k = 0; k < 2; ++k) \
        acc[ai][bj][m][n] = __builtin_amdgcn_mfma_f32_16x16x32_bf16(Bt[n][k], At[m][k], acc[ai][bj][m][n], 0, 0, 0); __builtin_amdgcn_s_setprio(0); } while (0)
#define PG8_WAIT_V(n) asm volatile("s_waitcnt vmcnt(" #n ")" ::: "memory")
#define PG8_WAIT_L(n) asm volatile("s_waitcnt lgkmcnt(" #n ")" ::: "memory")
#define PG8_BAR __builtin_amdgcn_s_barrier()
#define PG8_SCHED __builtin_amdgcn_sched_barrier(0)
    Unit cur, nxt; int ui = 0;
    if (!S.next(0, cur)) return;
    f32x4 acc[2][2][4][2];
#pragma unroll
    for (int a = 0; a < 2; ++a)
#pragma unroll
        for (int b = 0; b < 2; ++b)
#pragma unroll
            for (int m = 0; m < 4; ++m)
#pragma unroll
                for (int n = 0; n < 2; ++n) acc[a][b][m][n] = (f32x4){0.f, 0.f, 0.f, 0.f};
    bf16x8 At[4][2], B0[2][2], B1[2][2];
    const char* cA = (const char*)g.A + (size_t)cur.pm * tstep; const char* cB = (const char*)g.Bt + (size_t)cur.pn * tstep;
    PG8_STAGE(PG8_SB(0, 0), cB, voffB); PG8_STAGE(PG8_SA(0, 0), cA, voffA); PG8_STAGE(PG8_SB(0, 1), cB + hstep, voffB); PG8_STAGE(PG8_SA(0, 1), cA + hstep, voffA);
    if (wr == 1) PG8_BAR;
    PG8_WAIT_V(4); PG8_BAR;
    PG8_STAGE(PG8_SB(1, 0), cB + kstep, voffB); PG8_STAGE(PG8_SA(1, 0), cA + kstep, voffA); PG8_STAGE(PG8_SB(1, 1), cB + hstep + kstep, voffB);
    PG8_WAIT_V(6); PG8_BAR;
    for (;;) {
        const bool has_next = S.next(ui + 1, nxt);
        const char* nA = has_next ? (const char*)g.A + (size_t)nxt.pm * tstep : cA; const char* nB = has_next ? (const char*)g.Bt + (size_t)nxt.pn * tstep : cB;
        for (int t = 0; t < nt; t += 2) {
            const bool last = (t == nt - 2);
            const char* a1 = cA + (size_t)(t + 1) * kstep;
            const char* a2 = last ? nA : cA + (size_t)(t + 2) * kstep; const char* b2 = last ? nB : cB + (size_t)(t + 2) * kstep;
            const char* a3 = a2 + kstep; const char* b3 = b2 + kstep;
            PG8_LDB(B0, 0, 0); PG8_SCHED; PG8_LDA(At, 0, 0); PG8_STAGE(PG8_SA(1, 1), a1 + hstep, voffA);
            PG8_WAIT_L(8); PG8_BAR; PG8_WAIT_L(0); PG8_MMA(0, 0, At, B0); PG8_BAR; PG8_SCHED;
            PG8_LDB(B1, 0, 1); PG8_STAGE(PG8_SB(0, 0), b2, voffB);
            PG8_BAR; PG8_WAIT_L(0); PG8_MMA(0, 1, At, B1); PG8_BAR;
            PG8_LDA(At, 0, 1); PG8_STAGE(PG8_SA(0, 0), a2, voffA);
            PG8_BAR; PG8_WAIT_L(0); PG8_MMA(1, 0, At, B0); PG8_BAR; PG8_SCHED;
            PG8_STAGE(PG8_SB(0, 1), b2 + hstep, voffB);
            PG8_WAIT_V(6); PG8_BAR; PG8_MMA(1, 1, At, B1); PG8_BAR;
            PG8_LDB(B0, 1, 0); PG8_SCHED; PG8_LDA(At, 1, 0); PG8_STAGE(PG8_SA(0, 1), a2 + hstep, voffA);
            PG8_WAIT_L(8); PG8_BAR; PG8_WAIT_L(0); PG8_MMA(0, 0, At, B0); PG8_BAR; PG8_SCHED;
            PG8_LDB(B1, 1, 1); PG8_STAGE(PG8_SB(1, 0), b3, voffB);
            PG8_BAR; PG8_WAIT_L(0); PG8_MMA(0, 1, At, B1); PG8_BAR;
            PG8_LDA(At, 1, 1); PG8_STAGE(PG8_SA(1, 0), a3, voffA);
            PG8_BAR; PG8_WAIT_L(0); PG8_MMA(1, 0, At, B0); PG8_BAR; PG8_SCHED;
            PG8_STAGE(PG8_SB(1, 1), b3 + hstep, voffB);
            PG8_WAIT_V(6); PG8_BAR; PG8_MMA(1, 1, At, B1); PG8_BAR;
        }
        E(acc, cur, wr, wc, fr, fq);
        if (!has_next) break;
#pragma unroll
        for (int a = 0; a < 2; ++a)
#pragma unroll
            for (int b = 0; b < 2; ++b)
#pragma unroll
                for (int m = 0; m < 4; ++m)
#pragma unroll
                    for (int n = 0; n < 2; ++n) acc[a][b][m][n] = (f32x4){0.f, 0.f, 0.f, 0.f};
        cur = nxt; cA = nA; cB = nB; ++ui;
    }
    PG8_WAIT_V(0);
    if (wr == 0) PG8_BAR;
    PG8_BAR;
#undef PG8_SA
#undef PG8_SB
#undef PG8_STAGE
#undef PG8_LDA
#undef PG8_LDB
#undef PG8_MMA
#undef PG8_WAIT_V
#undef PG8_WAIT_L
#undef PG8_BAR
#undef PG8_SCHED
}
}


#define XB_TMO      128
#define XB_XCNT(j)  (256  + 64 * (j))
#define XB_XSUB(j)  (1280 + 64 * (j))
#define XB_XGEN(j)  (2304 + 64 * (j))
#define XB_TOP      3328
#define XB_TOPGEN   3392
#define XCD_BAR_WORDS 3456
#define XB_SPIN_CAP (1u << 18)
__device__ __forceinline__ unsigned xb_ld(unsigned* p)              { return __hip_atomic_load(p, __ATOMIC_RELAXED, __HIP_MEMORY_SCOPE_AGENT); }
__device__ __forceinline__ unsigned xb_add(unsigned* p, unsigned v) { return __hip_atomic_fetch_add(p, v, __ATOMIC_RELAXED, __HIP_MEMORY_SCOPE_AGENT); }
__device__ __forceinline__ unsigned xb_xcc_id() { return (unsigned)__builtin_amdgcn_s_getreg((3 << 11) | 20) & 0xFu; }
#define XB_SPIN(cond, bar) do { unsigned _sp = 0; while (cond) { __builtin_amdgcn_s_sleep(1); \
    if ((++_sp & 255u) == 0u) { if (xb_ld(&(bar)[XB_TMO])) break; if (_sp > XB_SPIN_CAP) { atomicAdd(&(bar)[XB_TMO], 1u); break; } } } } while (0)
struct XcdBarrier { unsigned* bar; unsigned x; volatile LAS unsigned* st; };
__device__ __forceinline__ XcdBarrier xcd_barrier_post(unsigned* bar, volatile LAS unsigned* st) {
    XcdBarrier b; b.bar = bar; b.x = xb_xcc_id(); b.st = st;
    if (threadIdx.x == 0) (void)xb_add(&bar[XB_XCNT(b.x)], 1u);
    return b;
}
__device__ __forceinline__ void xcd_barrier_complete(unsigned* bar, unsigned x, unsigned& nloc, unsigned& nx) {
    const unsigned G = gridDim.x * gridDim.y * gridDim.z;
    unsigned sum, cnt, mine, sp = 0u;
    for (;;) {
        sum = 0u; cnt = 0u; mine = 0u;
#pragma unroll
        for (unsigned j = 0; j < 16; ++j) { const unsigned c = xb_ld(&bar[XB_XCNT(j)]); sum += c; cnt += (c > 0u) ? 1u : 0u; mine = (j == x) ? c : mine; }
        if (sum == G) break;
        __builtin_amdgcn_s_sleep(1);
        if ((++sp & 255u) == 0u) { if (xb_ld(&bar[XB_TMO])) break; if (sp > XB_SPIN_CAP) { atomicAdd(&bar[XB_TMO], 1u); break; } }
    }
    nloc = mine > 0u ? mine : 1u; nx = cnt > 0u ? cnt : 1u;
}
__device__ __forceinline__ void xcd_barrier(const XcdBarrier& b, const int wv0) {
    asm volatile("s_waitcnt vmcnt(0)" ::: "memory");
    __syncthreads();
    if (opaque_tid(wv0) == 0) {
        unsigned* bar = b.bar;
        __builtin_amdgcn_s_waitcnt(0);
        unsigned nloc = b.st[0], nx = b.st[1];
        if (nloc == 0u) { xcd_barrier_complete(bar, b.x, nloc, nx); b.st[0] = nloc; b.st[1] = nx; }
        const unsigned old = xb_add(&bar[XB_XSUB(b.x)], 1u);
        const unsigned gen = old / nloc;
        if (old + 1u == (gen + 1u) * nloc) {
            __builtin_amdgcn_fence(__ATOMIC_RELEASE, "agent");
            asm volatile("s_waitcnt vmcnt(0)" ::: "memory");
            const unsigned og = xb_add(&bar[XB_TOP], 1u);
            const unsigned tg = og / nx;
            if (og + 1u == (tg + 1u) * nx) xb_add(&bar[XB_TOPGEN], 1u);
            else XB_SPIN(xb_ld(&bar[XB_TOPGEN]) == tg, bar);
            __builtin_amdgcn_fence(__ATOMIC_ACQUIRE, "agent");
            xb_add(&bar[XB_XGEN(b.x)], 1u);
            asm volatile("s_waitcnt vmcnt(0)" ::: "memory");
        } else {
            XB_SPIN(xb_ld(&bar[XB_XGEN(b.x)]) == gen, bar);
            __builtin_amdgcn_fence(__ATOMIC_ACQUIRE, "agent");
            asm volatile("s_waitcnt vmcnt(0)" ::: "memory");
        }
    }
    __syncthreads();
}

struct Frame {
    LAS unsigned char* lds;
    int vcu, G, wv;
    const float* const* in; float* out; unsigned char* ws;
    __device__ __forceinline__ float* MOD() const { return (float*)(ws + WS_MOD); }
    __device__ __forceinline__ float* ROPE() const { return (float*)(ws + WS_ROPE); }
    __device__ __forceinline__ float* BA() const { return (float*)(ws + WS_BA); }
    __device__ __forceinline__ float* LAG() const { return (float*)(ws + WS_LAG); }
    __device__ __forceinline__ bf16_t* W1O() const { return (bf16_t*)(ws + WS_W1O); }
    __device__ __forceinline__ bf16_t* U0() const { return (bf16_t*)(ws + WS_RA); }
    __device__ __forceinline__ bf16_t* QKV1() const { return (bf16_t*)(ws + WS_RA); }
    __device__ __forceinline__ bf16_t* Z1() const { return (bf16_t*)(ws + WS_RA + (size_t)MT * 3072 * 2); }
    __device__ __forceinline__ bf16_t* Y1() const { return (bf16_t*)(ws + WS_RA); }
    __device__ __forceinline__ bf16_t* XN() const { return (bf16_t*)(ws + WS_RB + RB_XN); }
    __device__ __forceinline__ bf16_t* Y0() const { return (bf16_t*)(ws + WS_RB + RB_Y0); }
    __device__ __forceinline__ bf16_t* YO() const { return (bf16_t*)(ws + WS_RB + RB_YO); }
    __device__ __forceinline__ bf16_t* W0I() const { return (bf16_t*)(ws + WS_RB + RB_W0I); }
    __device__ __forceinline__ bf16_t* W0O() const { return (bf16_t*)(ws + WS_RB + RB_W0O); }
    __device__ __forceinline__ bf16_t* W1I() const { return (bf16_t*)(ws + WS_RB + RB_W1I); }
    __device__ __forceinline__ bf16_t* QKVC() const { return (bf16_t*)(ws + WS_RB); }
};

#define PHASE_IDS() int tid = opaque_tid(F.wv); const int lane = tid & 63, wave = __builtin_amdgcn_readfirstlane(tid >> 6); (void)lane; (void)wave
__device__ __forceinline__ void p0_transpose_item(const float* W, int ldw, int nblk, int K, bf16_t* WT, LAS float* scr, int item, int lane) {
    const int kb = item / nblk, nb = item % nblk, k0 = 64 * kb, n0 = 32 * nb;
#pragma unroll 8
    for (int i = 0; i < 32; ++i) { const int kk = 2 * i + (lane >> 5); scr[kk * 33 + (lane & 31)] = W[(size_t)(k0 + kk) * ldw + n0 + (lane & 31)]; }
    asm volatile("s_waitcnt lgkmcnt(0)" ::: "memory");
    const int c = lane & 7;
#pragma unroll
    for (int j = 0; j < 4; ++j) { const int n = (lane >> 3) + 8 * j; const LAS float* s = scr + (8 * c) * 33 + n;
        u32x4 o; o.x = pk2(s[0 * 33], s[1 * 33]); o.y = pk2(s[2 * 33], s[3 * 33]); o.z = pk2(s[4 * 33], s[5 * 33]); o.w = pk2(s[6 * 33], s[7 * 33]);
        *(u32x4*)(WT + (size_t)(n0 + n) * K + k0 + 8 * c) = o; }
    asm volatile("s_waitcnt lgkmcnt(0)" ::: "memory");
}
__device__ __forceinline__ void phase_prologue(Frame& F) {
    PHASE_IDS();
    const int gw = F.vcu * 8 + wave, NGW = F.G * 8;
    {
        LAS float* scr = (LAS float*)(F.lds + wave * 16384);
        constexpr int I0 = 16 * (EV_IN / 32), I1 = 16 * 32, I2 = 16 * (OD_MAIN / 32), I3 = 16 * 32;
        for (int it = gw; it < I0 + I1 + I2 + I3; it += NGW) {
            int r = it;
            if (r < I0) { p0_transpose_item(F.in[14], EV_IN, EV_IN / 32, D, F.W0I(), scr, r, lane); continue; } r -= I0;
            if (r < I1) { p0_transpose_item(F.in[23], D, 32, D, F.W0O(), scr, r, lane); continue; } r -= I1;
            if (r < I2) { p0_transpose_item(F.in[28], OD_IN, OD_MAIN / 32, D, F.W1I(), scr, r, lane); continue; } r -= I2;
            p0_transpose_item(F.in[33], D, 32, D, F.W1O(), scr, r, lane);
        }
    }
    {
        const double inv[8] = {1.0, 0.19392274474868576, 0.03760603093086393, 0.007292664737217109, 0.001414213562373095, 0.0002742481756762073, 5.318295896944988e-05, 1.031338537721246e-05};
        for (int idx = F.vcu * 512 + tid; idx < 4112 * 8; idx += F.G * 512) {
            const int pos = idx >> 3, i = idx & 7;
            double iv = inv[0];
#pragma unroll
            for (int q = 1; q < 8; ++q) iv = (i == q) ? inv[q] : iv;
            const double ang = (double)pos * iv;
            const double n = __builtin_rint(ang * 0.15915494309189535);
            const float r = (float)__builtin_fma(-n, 6.283185307179586, ang);
            F.ROPE()[pos * 16 + i] = __cosf(r); F.ROPE()[pos * 16 + 8 + i] = __sinf(r);
        }
    }
    {
        bf16_t* LGW = (bf16_t*)(F.ws + WS_LGW);
        for (int idx = F.vcu * 512 + tid; idx < 8 * 2 * 64 * 64; idx += F.G * 512) { const int k = idx & 63, n = (idx >> 6) & 63, gate = (idx >> 12) & 1, hh = idx >> 13;
            LGW[idx] = (bf16_t)f2bf((gate ? F.in[19] : F.in[17])[(hh * 64 + k) * 64 + n]); }
    }
    __syncthreads();
    for (int bt = F.vcu; bt < 96; bt += F.G) {
        LAS float* tab = (LAS float*)F.lds;
        for (int idx = tid; idx < 24 * 1024; idx += 512) { const int s = idx >> 10, k = idx & 1023;
            const float c = s < BP ? F.in[8][s * D + k] : F.in[9][(s - BP) * D + k]; tab[k * 24 + s] = siluf_(c); }
        __syncthreads();
        const int L = bt / 48, n0 = (bt % 48) * 64;
        const float* mw = (L == 0 ? F.in[10] : F.in[24]) + n0 + lane;
        float acc[24];
#pragma unroll
        for (int r = 0; r < 24; ++r) acc[r] = 0.f;
        for (int k = wave * 128; k < wave * 128 + 128; ++k) {
            const float w = mw[(size_t)k * 3072];
            const LAS f32x4* tp = (const LAS f32x4*)(tab + k * 24);
#pragma unroll
            for (int q = 0; q < 6; ++q) { const f32x4 t4 = tp[q]; acc[4 * q] += t4[0] * w; acc[4 * q + 1] += t4[1] * w; acc[4 * q + 2] += t4[2] * w; acc[4 * q + 3] += t4[3] * w; }
        }
        __syncthreads();
        LAS float* red = (LAS float*)F.lds;
#pragma unroll
        for (int r = 0; r < 24; ++r) red[(wave * 24 + r) * 64 + lane] = acc[r];
        __syncthreads();
        const float* mb = (L == 0 ? F.in[11] : F.in[25]);
        for (int idx = tid; idx < 24 * 64; idx += 512) { const int r = idx >> 6, l = idx & 63; float s = 0.f;
#pragma unroll
            for (int w = 0; w < 8; ++w) s += red[(w * 24 + r) * 64 + l];
            F.MOD()[((size_t)L * 24 + r) * 3072 + n0 + l] = s + mb[n0 + l]; }
        __syncthreads();
    }
}

__device__ __forceinline__ void phase_prenorm0(Frame& F) {
    PHASE_IDS();
    const int gw = F.vcu * 8 + wave, NGW = F.G * 8;
    for (int m = gw; m < MT; m += NGW) {
        int s, t; tok_info(m, s, t);
        const float* xrow = m < MP ? F.in[0] + (size_t)m * D : F.in[1] + (size_t)(m - MP) * D;
        const float* modr = F.MOD() + (size_t)s * 3072;
        f32x4 v[4]; float ss = 0.f;
#pragma unroll
        for (int j = 0; j < 4; ++j) { v[j] = *(const f32x4*)(xrow + 4 * lane + 256 * j); ss += (v[j][0] * v[j][0] + v[j][1] * v[j][1]) + (v[j][2] * v[j][2] + v[j][3] * v[j][3]); }
        const float r = rsqrtf(wave_sum(ss) * (1.f / D) + EPS);
#pragma unroll
        for (int j = 0; j < 4; ++j) { const int c = 4 * lane + 256 * j;
            const f32x4 g = *(const f32x4*)(F.in[12] + c), sh = *(const f32x4*)(modr + c), sc = *(const f32x4*)(modr + 1024 + c);
            f32x4 o;
#pragma unroll
            for (int e = 0; e < 4; ++e) o[e] = v[j][e] * r * g[e] * (1.f + sc[e]) + sh[e];
            u32x2 w; w.x = pk2(o[0], o[1]); w.y = pk2(o[2], o[3]); *(u32x2*)(F.XN() + (size_t)m * D + c) = w; }
    }
}

__device__ __forceinline__ void phase_rope(Frame& F) {
    PHASE_IDS();
    const int gt = F.vcu * 512 + tid, NT = F.G * 512;
    for (int idx = gt; idx < MT * 80; idx += NT) {
        const int m = idx / 80, r = idx % 80, slot = r >> 3, i = r & 7;
        int s, t; tok_info(m, s, t);
        const int pos = s < BP ? t : TP + t;
        const int col = slot < 8 ? C_Q + slot * 64 : C_K + (slot - 8) * 64;
        bf16_t* p = F.U0() + (size_t)m * EV_IN + col;
        const float x1 = bf2f(p[i]), x2 = bf2f(p[8 + i]), c = F.ROPE()[pos * 16 + i], sn = F.ROPE()[pos * 16 + 8 + i];
        const float o1 = x1 * c - x2 * sn, o2 = x2 * c + x1 * sn;
        p[i] = (bf16_t)f2bf(o1); p[8 + i] = (bf16_t)f2bf(o2);
        if (slot >= 8) { const int kv = slot - 8;
            if (s >= BP) { float* o = F.out + O_KS + ((size_t)((s - BP) * TS + t) * 2 + kv) * 64; o[i] = o1; o[8 + i] = o2; }
            else if (t >= TP - 128) { float* o = F.out + O_KP + ((size_t)(s * 128 + (t - (TP - 128))) * 2 + kv) * 64; o[i] = o1; o[8 + i] = o2; } }
    }
    for (int idx = gt; idx < 1280 * 224; idx += NT) {
        const int tk = idx / 224, e = idx % 224;
        int s, t, m; if (tk < 1024) { s = tk >> 7; t = TP - 128 + (tk & 127); m = s * TP + t; } else { s = BP + ((tk - 1024) >> 4); t = (tk - 1024) & 15; m = MP + (tk - 1024); }
        const bool isv = e >= 96; const int e2 = isv ? e - 96 : e; const int kv = isv ? (e2 >> 6) : (e2 / 48), d = isv ? (e2 & 63) : 16 + (e2 % 48);
        const float val = bf2f(F.U0()[(size_t)m * EV_IN + (isv ? C_V : C_K) + kv * 64 + d]);
        const size_t ob = s >= BP ? (isv ? O_VS : O_KS) + ((size_t)((s - BP) * TS + t) * 2 + kv) * 64 : (isv ? O_VP : O_KP) + ((size_t)(s * 128 + (t - (TP - 128))) * 2 + kv) * 64;
        F.out[ob + d] = val;
    }
}

__device__ __forceinline__ void phase_lru_naive(Frame& F) {
    PHASE_IDS();
    const int gw = F.vcu * 8 + wave, NGW = F.G * 8;
    for (int task = gw; task < NSEQ * 8; task += NGW) {
        const int s = task >> 3, h = task & 7, ch = h * 64 + lane, T = seq_len(s), base = seq_base(s);
        float wa[64], wx[64];
#pragma unroll
        for (int i = 0; i < 64; ++i) { wa[i] = F.in[17][(h * 64 + i) * 64 + lane]; wx[i] = F.in[19][(h * 64 + i) * 64 + lane]; }
        const float cw0 = F.in[15][ch], cw1 = F.in[15][512 + ch], cw2 = F.in[15][1024 + ch], cw3 = F.in[15][1536 + ch], cb = F.in[16][ch];
        const float ba = F.in[18][ch], bx = F.in[20][ch], sp = softplusf_(-F.in[21][ch]);
        float x3 = 0.f, x2 = 0.f, x1 = 0.f, hh = 0.f;
        if (s >= BP) { const float* cs = F.in[2] + (size_t)(s - BP) * 3 * 512; x3 = cs[ch]; x2 = cs[512 + ch]; x1 = cs[1024 + ch]; hh = F.in[3][(s - BP) * 512 + ch]; }
        for (int t0 = 0; t0 < T; t0 += 16) {
            float xa[16], ga[16];
#pragma unroll
            for (int j = 0; j < 16; ++j) { const bf16_t* p = F.U0() + (size_t)(base + t0 + j) * EV_IN; xa[j] = bf2f(p[C_XA + ch]); ga[j] = bf2f(p[C_GA + ch]); }
#pragma unroll
            for (int j = 0; j < 16; ++j) {
                const float xc = cw0 * x3 + cw1 * x2 + cw2 * x1 + cw3 * xa[j] + cb;
                x3 = x2; x2 = x1; x1 = xa[j];
                float za = ba, zx = bx;
#pragma unroll
                for (int i = 0; i < 64; ++i) { const float xi = __uint_as_float(__builtin_amdgcn_readlane(__float_as_uint(xc), i)); za += xi * wa[i]; zx += xi * wx[i]; }
                const float r = sigmoidf_(za), ig = sigmoidf_(zx), la = -8.0f * r * sp, a = __expf(la);
                const float gx = sqrtf(-expm1f(2.0f * la)) * (ig * xc);
                hh = a * hh + gx;
                F.Y0()[(size_t)(base + t0 + j) * D + ch] = (bf16_t)f2bf(hh * siluf_(ga[j]));
            }
        }
        if (s < BP) { F.out[O_LHP + s * 512 + ch] = hh; float* o = F.out + O_LCP + (size_t)s * 3 * 512; o[ch] = x3; o[512 + ch] = x2; o[1024 + ch] = x1; }
        else { F.out[O_LHS + (s - BP) * 512 + ch] = hh; float* o = F.out + O_LCS + (size_t)(s - BP) * 3 * 512; o[ch] = x3; o[512 + ch] = x2; o[1024 + ch] = x1; }
    }
}

__device__ __forceinline__ void phase_attn_naive(Frame& F) {
    PHASE_IDS();
    const int gt = F.vcu * 512 + tid, NT = F.G * 512;
    for (int idx = gt; idx < MT * 8; idx += NT) {
        const int hq = idx / MT, m = idx % MT, kv = hq >> 2;
        int s, t; tok_info(m, s, t);
        unsigned qp[32]; float o[64];
        { const u32x4* qq = (const u32x4*)(F.U0() + (size_t)m * EV_IN + C_Q + hq * 64);
#pragma unroll
          for (int c = 0; c < 8; ++c) { const u32x4 w = qq[c];
#pragma unroll
              for (int e = 0; e < 4; ++e) qp[c * 4 + e] = pk2(lo16(w[e]) * 0.125f, hi16(w[e]) * 0.125f); } }
#pragma unroll
        for (int d = 0; d < 64; ++d) o[d] = 0.f;
        float mx = F.in[22][hq], l = 1.0f;
        int nkeys, p0 = 0;
        if (s < BP) { const int c0 = (t >> 6) * 64; p0 = c0 - 128 < 0 ? 0 : c0 - 128; nkeys = c0 + 64 - p0; } else nkeys = 128 + TS;
        for (int j = 0; j < nkeys; ++j) {
            float sc = 0.f;
            const bool cached = (s >= BP && j < 128);
            const int mk = s < BP ? s * TP + p0 + j : seq_base(s) + (j - 128);
            const float* kpf = F.in[4] + ((size_t)((s - BP) * 128 + j) * 2 + kv) * 64; const float* vpf = F.in[5] + ((size_t)((s - BP) * 128 + j) * 2 + kv) * 64;
            const bf16_t* kpb = F.U0() + (size_t)mk * EV_IN + C_K + kv * 64; const bf16_t* vpb = F.U0() + (size_t)mk * EV_IN + C_V + kv * 64;
            if (cached) {
#pragma unroll
                for (int c = 0; c < 16; ++c) { const f32x4 a = *(const f32x4*)(kpf + 4 * c); sc += (lo16(qp[2 * c]) * a[0] + hi16(qp[2 * c]) * a[1]) + (lo16(qp[2 * c + 1]) * a[2] + hi16(qp[2 * c + 1]) * a[3]); }
            } else {
#pragma unroll
                for (int c = 0; c < 8; ++c) { const u32x4 a = *(const u32x4*)(kpb + 8 * c);
#pragma unroll
                    for (int e = 0; e < 4; ++e) sc += lo16(qp[c * 4 + e]) * lo16(a[e]) + hi16(qp[c * 4 + e]) * hi16(a[e]); }
            }
            const float mn = fmaxf(mx, sc), alpha = __expf(mx - mn), p = __expf(sc - mn);
            l = l * alpha + p; mx = mn;
            if (cached) {
#pragma unroll
                for (int c = 0; c < 16; ++c) { const f32x4 b = *(const f32x4*)(vpf + 4 * c);
#pragma unroll
                    for (int e = 0; e < 4; ++e) o[4 * c + e] = o[4 * c + e] * alpha + p * b[e]; }
            } else {
#pragma unroll
                for (int c = 0; c < 8; ++c) { const u32x4 b = *(const u32x4*)(vpb + 8 * c);
#pragma unroll
                    for (int e = 0; e < 4; ++e) { o[c * 8 + 2 * e] = o[c * 8 + 2 * e] * alpha + p * lo16(b[e]); o[c * 8 + 2 * e + 1] = o[c * 8 + 2 * e + 1] * alpha + p * hi16(b[e]); } }
            }
        }
        const float il = 1.0f / l;
        const u32x4* gp = (const u32x4*)(F.U0() + (size_t)m * EV_IN + C_GB + hq * 64);
        u32x4* yp = (u32x4*)(F.Y0() + (size_t)m * D + 512 + hq * 64);
#pragma unroll
        for (int c = 0; c < 8; ++c) { const u32x4 g = gp[c]; u32x4 w;
#pragma unroll
            for (int e = 0; e < 4; ++e) w[e] = pk2(o[c * 8 + 2 * e] * il * siluf_(lo16(g[e])), o[c * 8 + 2 * e + 1] * il * siluf_(hi16(g[e])));
            yp[c] = w; }
    }
}

__device__ __forceinline__ void phase_mid_rowwise(Frame& F) {
    PHASE_IDS();
    LAS float* baw = (LAS float*)F.lds;
    for (int idx = tid; idx < 16 * 1024; idx += 512) { const int j = idx & 15, k = idx >> 4; baw[j * 1024 + k] = F.in[28][(size_t)k * OD_IN + OD_MAIN + j]; }
    __syncthreads();
    const int gw = F.vcu * 8 + wave, NGW = F.G * 8;
    for (int m = gw; m < MT; m += NGW) {
        int s, t; tok_info(m, s, t);
        const float* xrow = m < MP ? F.in[0] + (size_t)m * D : F.in[1] + (size_t)(m - MP) * D;
        const float* mod0 = F.MOD() + (size_t)s * 3072; const float* mod1 = F.MOD() + (size_t)(24 + s) * 3072;
        f32x4 y[4]; float ss = 0.f;
#pragma unroll
        for (int j = 0; j < 4; ++j) { const u32x2 w = *(const u32x2*)(F.YO() + (size_t)m * D + 4 * lane + 256 * j); y[j] = (f32x4){lo16(w.x), hi16(w.x), lo16(w.y), hi16(w.y)};
            ss += (y[j][0] * y[j][0] + y[j][1] * y[j][1]) + (y[j][2] * y[j][2] + y[j][3] * y[j][3]); }
        const float r1 = rsqrtf(wave_sum(ss) * (1.f / D) + EPS);
        f32x4 x1[4]; float s2 = 0.f;
#pragma unroll
        for (int j = 0; j < 4; ++j) { const int c = 4 * lane + 256 * j;
            const f32x4 xv = *(const f32x4*)(xrow + c), g = *(const f32x4*)(F.in[13] + c), gt = *(const f32x4*)(mod0 + 2048 + c);
#pragma unroll
            for (int e = 0; e < 4; ++e) x1[j][e] = xv[e] + gt[e] * (y[j][e] * r1 * g[e]);
            *(f32x4*)(F.out + O_Y + (size_t)m * D + c) = x1[j];
            s2 += (x1[j][0] * x1[j][0] + x1[j][1] * x1[j][1]) + (x1[j][2] * x1[j][2] + x1[j][3] * x1[j][3]); }
        const float r2 = rsqrtf(wave_sum(s2) * (1.f / D) + EPS);
        f32x4 hm[4];
#pragma unroll
        for (int j = 0; j < 4; ++j) { const int c = 4 * lane + 256 * j;
            const f32x4 g = *(const f32x4*)(F.in[26] + c), sh = *(const f32x4*)(mod1 + c), sc = *(const f32x4*)(mod1 + 1024 + c);
#pragma unroll
            for (int e = 0; e < 4; ++e) hm[j][e] = x1[j][e] * r2 * g[e] * (1.f + sc[e]) + sh[e];
            u32x2 w; w.x = pk2(hm[j][0], hm[j][1]); w.y = pk2(hm[j][2], hm[j][3]); *(u32x2*)(F.XN() + (size_t)m * D + c) = w; }
        float mine = 0.f;
#pragma unroll 1
        for (int q = 0; q < 16; ++q) { float p = 0.f;
#pragma unroll
            for (int j = 0; j < 4; ++j) { const f32x4 w = *(const LAS f32x4*)(baw + q * 1024 + 256 * j + 4 * lane); p += (hm[j][0] * w[0] + hm[j][1] * w[1]) + (hm[j][2] * w[2] + hm[j][3] * w[3]); }
            p = wave_sum(p); mine = (lane == q) ? p : mine; }
        if (lane < 16) F.BA()[(size_t)m * 16 + lane] = mine;
    }
}

__device__ __forceinline__ void phase_gdn_prep_naive(Frame& F) {
    PHASE_IDS();
    const int gw = F.vcu * 8 + wave, NGW = F.G * 8;
    for (int idx = gw; idx < MT * 24; idx += NGW) {
        const int m = idx / 24, g = idx % 24, c = g * 128 + 2 * lane;
        int s, t; tok_info(m, s, t);
        float u0[4], u1[4];
#pragma unroll
        for (int j = 0; j < 4; ++j) { const int tt = t - 3 + j;
            if (tt >= 0) { const unsigned w = *(const unsigned*)(F.QKV1() + (size_t)(m - 3 + j) * 3072 + c); u0[j] = lo16(w); u1[j] = hi16(w); }
            else if (s >= BP) { const float* cs = F.in[6] + ((size_t)(s - BP) * 3 + (tt + 3)) * 3072 + c; u0[j] = cs[0]; u1[j] = cs[1]; }
            else { u0[j] = 0.f; u1[j] = 0.f; } }
        const float* cw = F.in[29] + c;
        float a0 = cw[0] * u0[0] + cw[3072] * u0[1] + cw[6144] * u0[2] + cw[9216] * u0[3];
        float a1 = cw[1] * u1[0] + cw[3073] * u1[1] + cw[6145] * u1[2] + cw[9217] * u1[3];
        a0 = siluf_(a0); a1 = siluf_(a1);
        if (g < 16) { const float ss = wave_sum(a0 * a0 + a1 * a1); float sc = rsqrtf(ss + EPS); if (g < 8) sc *= 0.08838834764831845f; a0 *= sc; a1 *= sc; }
        *(unsigned*)(F.QKVC() + (size_t)m * 3072 + c) = pk2(a0, a1);
        const int T = seq_len(s);
        if (t >= T - 3) { float* o = s < BP ? F.out + O_GCP + ((size_t)s * 3 + (t - (T - 3))) * 3072 + c : F.out + O_GCS + ((size_t)(s - BP) * 3 + (t - (T - 3))) * 3072 + c; o[0] = u0[3]; o[1] = u1[3]; }
    }
}

__device__ __forceinline__ void phase_gdn_rec_naive(Frame& F) {
    int tid = opaque_tid(F.wv);
    LAS float* kq = (LAS float*)F.lds;
    LAS float* red = kq + 1024;
    LAS float* red2 = red + 512;
    LAS float* misc = red2 + 512;
    const int v = tid & 127, rg = tid >> 7;
    for (int task = F.vcu; task < NSEQ * 8; task += F.G) {
        const int s = task >> 3, h = task & 7, T = seq_len(s), base = seq_base(s);
        float S[32];
        if (s < BP) {
#pragma unroll
            for (int i = 0; i < 32; ++i) S[i] = 0.f;
        } else {
#pragma unroll
            for (int i = 0; i < 32; ++i) S[i] = F.in[7][(((size_t)(s - BP) * 8 + h) * 128 + rg * 32 + i) * 128 + v];
        }
        const float Aexp = __expf(F.in[30][h]), dtb = F.in[31][h], hn = F.in[32][v];
        float nxt = 0.f;
        if (tid < 384) { const int part = tid >> 7; const int col = (part == 0 ? 1024 : part == 1 ? 0 : 2048) + h * 128 + (tid & 127); nxt = bf2f(F.QKVC()[(size_t)base * 3072 + col]); }
        __syncthreads();
        for (int t = 0; t < T; ++t) {
            LAS float* cur = kq + (t & 1) * 384;
            if (tid < 384) cur[tid] = nxt;
            if (tid < 384 && t + 1 < T) { const int part = tid >> 7; const int col = (part == 0 ? 1024 : part == 1 ? 0 : 2048) + h * 128 + (tid & 127); nxt = bf2f(F.QKVC()[(size_t)(base + t + 1) * 3072 + col]); }
            const float bb = F.BA()[(size_t)(base + t) * 16 + h], aa = F.BA()[(size_t)(base + t) * 16 + 8 + h];
            const float zz = bf2f(F.Z1()[(size_t)(base + t) * D + h * 128 + v]);
            const float beta = sigmoidf_(bb), g = -Aexp * softplusf_(aa + dtb), a = __expf(g);
            __syncthreads();
            float part = 0.f;
#pragma unroll
            for (int i = 0; i < 32; ++i) { S[i] *= a; part += cur[rg * 32 + i] * S[i]; }
            red[rg * 128 + v] = part;
            __syncthreads();
            const float kS = (red[v] + red[128 + v]) + (red[256 + v] + red[384 + v]);
            const float dlt = beta * (cur[256 + v] - kS);
            float po = 0.f;
#pragma unroll
            for (int i = 0; i < 32; ++i) { S[i] += cur[rg * 32 + i] * dlt; po += cur[128 + rg * 32 + i] * S[i]; }
            red2[rg * 128 + v] = po;
            __syncthreads();
            if (tid < 128) {
                const float o = (red2[v] + red2[128 + v]) + (red2[256 + v] + red2[384 + v]);
                const float sq = wave_sum(o * o);
                if ((tid & 63) == 0) misc[(tid >> 6)] = sq;
                red[v] = o;
            }
            __syncthreads();
            if (tid < 128) {
                const float o = red[v], r = rsqrtf((misc[0] + misc[1]) * (1.f / 128.f) + EPS);
                F.Y1()[(size_t)(base + t) * D + h * 128 + v] = (bf16_t)f2bf(o * r * hn * siluf_(zz));
            }
        }
        float* so = s < BP ? F.out + O_GSP + (((size_t)s * 8 + h) * 128 + rg * 32) * 128 + v : F.out + O_GSS + (((size_t)(s - BP) * 8 + h) * 128 + rg * 32) * 128 + v;
#pragma unroll
        for (int i = 0; i < 32; ++i) so[(size_t)i * 128] = S[i];
        __syncthreads();
    }
}

typedef float f32x16 __attribute__((ext_vector_type(16)));
typedef __bf16 bf16x2_t __attribute__((ext_vector_type(2)));
constexpr int GS_WF = 0, GS_QF = 16384, GS_KF = 32768, GS_PF = 49152, GS_UF = 57344, GS_BYTES = 73728;
constexpr size_t WS_DEC = 11 * MiB;
__device__ __forceinline__ unsigned cvt2(float a, float b) { f32x2 v = {a, b}; bf16x2_t r = __builtin_convertvector(v, bf16x2_t); return __builtin_bit_cast(unsigned, r); }
__device__ __forceinline__ int krow(int s, int h, int j) { return 16 * s + 8 * (j >> 2) + 4 * h + (j & 3); }
#define MFMA32(a, b, c) __builtin_amdgcn_mfma_f32_32x32x16_bf16((a), (b), (c), 0, 0, 0)

constexpr int G1_QS = 0, G1_KS = 17408, G1_VS = 34816, G1_AS = 52224, G1_PS = 69632, G1_WS = 78848, G1_CW = 96256, G1_VEC = 102400;
__device__ __forceinline__ void phase_gdn_g1(Frame& F) {
    int tid = opaque_tid(F.wv);
    const int lane = tid & 63, wave = __builtin_amdgcn_readfirstlane(tid >> 6);
    LAS unsigned char* L = F.lds;
    LAS float* cw_s = (LAS float*)(L + G1_CW);
    LAS float* beta_s = (LAS float*)(L + G1_VEC); LAS float* gcum_s = beta_s + 64; LAS float* eg_s = beta_s + 128; LAS float* ek_s = beta_s + 192;
    float* DEC = (float*)(F.ws + WS_DEC);
    for (int task = F.vcu; task < 4224; task += F.G) {
        int s, c, h; if (task < 4096) { s = task >> 9; c = (task >> 3) & 63; h = task & 7; } else { s = BP + ((task - 4096) >> 3); c = 0; h = task & 7; }
        const int nvalid = s < BP ? 64 : TS, t0 = c * 64, base = seq_base(s), T = seq_len(s);
        unsigned char* blk = F.ws + WS_RB + (size_t)task * GS_BYTES;
        for (int i = tid; i < 4 * 384; i += 512) { const int jj = i / 384, cc = i % 384; cw_s[i] = F.in[29][(size_t)jj * 3072 + (cc >> 7) * 1024 + h * 128 + (cc & 127)]; }
        if (tid < 64) {
            const bool ok = tid < nvalid; float beta = 0.f, g = 0.f;
            if (ok) { const float* ba = F.BA() + (size_t)(base + t0 + tid) * 16; beta = sigmoidf_(ba[h]); g = -__expf(F.in[30][h]) * softplusf_(ba[8 + h] + F.in[31][h]); }
            float x = g;
#pragma unroll
            for (int o = 1; o < 64; o <<= 1) { const float y = __shfl_up(x, o); if (lane >= o) x += y; }
            const float gl = __shfl(x, 63);
            beta_s[tid] = beta; gcum_s[tid] = x; eg_s[tid] = __expf(x); ek_s[tid] = ok ? __expf(gl - x) : 0.f;
            if (tid == 0) DEC[task] = __expf(gl);
        }
        __syncthreads();
        {
            int t1 = tid; asm volatile("" : "+v"(t1));
            const int r = t1 >> 3, j = t1 & 7, t = t0 + r; const bool ok = r < nvalid;
#pragma unroll 1
            for (int p = 0; p < 3; ++p) {
                float acc[16];
#pragma unroll
                for (int e = 0; e < 16; ++e) acc[e] = 0.f;
                float cur[16];
#pragma unroll
                for (int e = 0; e < 16; ++e) cur[e] = 0.f;
                if (ok) {
                    const int cb = p * 1024 + h * 128 + j * 16;
#pragma unroll
                    for (int jj = 0; jj < 4; ++jj) {
                        const int tt = t - 3 + jj; float x[16];
                        if (tt >= 0) { const u32x4* src = (const u32x4*)(F.QKV1() + (size_t)(base + tt) * 3072 + cb); const u32x4 a = src[0], b = src[1];
#pragma unroll
                            for (int e = 0; e < 4; ++e) { x[2 * e] = lo16(a[e]); x[2 * e + 1] = hi16(a[e]); x[8 + 2 * e] = lo16(b[e]); x[8 + 2 * e + 1] = hi16(b[e]); } }
                        else if (s >= BP) { const f32x4* src = (const f32x4*)(F.in[6] + ((size_t)(s - BP) * 3 + (tt + 3)) * 3072 + cb);
#pragma unroll
                            for (int q = 0; q < 4; ++q) { const f32x4 a = src[q]; x[4 * q] = a[0]; x[4 * q + 1] = a[1]; x[4 * q + 2] = a[2]; x[4 * q + 3] = a[3]; } }
                        else {
#pragma unroll
                            for (int e = 0; e < 16; ++e) x[e] = 0.f; }
                        const LAS f32x4* wp = (const LAS f32x4*)(cw_s + jj * 384 + p * 128 + j * 16);
#pragma unroll
                        for (int q = 0; q < 4; ++q) { const f32x4 w4 = wp[q]; acc[4 * q] += w4[0] * x[4 * q]; acc[4 * q + 1] += w4[1] * x[4 * q + 1]; acc[4 * q + 2] += w4[2] * x[4 * q + 2]; acc[4 * q + 3] += w4[3] * x[4 * q + 3]; }
                        if (jj == 3) {
#pragma unroll
                            for (int e = 0; e < 16; ++e) cur[e] = x[e]; }
                    }
                    if (t >= T - 3) {
                        float* o = (s < BP ? F.out + O_GCP + ((size_t)s * 3 + (t - (T - 3))) * 3072 : F.out + O_GCS + ((size_t)(s - BP) * 3 + (t - (T - 3))) * 3072) + cb;
#pragma unroll
                        for (int q = 0; q < 4; ++q) *(f32x4*)(o + 4 * q) = (f32x4){cur[4 * q], cur[4 * q + 1], cur[4 * q + 2], cur[4 * q + 3]};
                    }
                }
                float ss = 0.f;
#pragma unroll
                for (int e = 0; e < 16; ++e) { acc[e] = siluf_(acc[e]); ss += acc[e] * acc[e]; }
                if (p < 2) { ss += __shfl_xor(ss, 1); ss += __shfl_xor(ss, 2); ss += __shfl_xor(ss, 4);
                    float sc = rsqrtf(ss + EPS); if (p == 0) sc *= 0.08838834764831845f;
#pragma unroll
                    for (int e = 0; e < 16; ++e) acc[e] *= sc; }
                u32x4 w0, w1;
#pragma unroll
                for (int e = 0; e < 4; ++e) { w0[e] = ok ? cvt2(acc[2 * e], acc[2 * e + 1]) : 0u; w1[e] = ok ? cvt2(acc[8 + 2 * e], acc[8 + 2 * e + 1]) : 0u; }
                LAS u32x4* dst = (LAS u32x4*)(L + (p == 0 ? G1_QS : p == 1 ? G1_KS : G1_VS) + r * 272 + j * 32);
                dst[0] = w0; dst[1] = w1;
            }
        }
        __syncthreads();
        {
            int l2 = lane; asm volatile("" : "+v"(l2));
            const int which = wave >> 2, ti = (wave >> 1) & 1, tj = wave & 1, r = l2 & 31, hh = l2 >> 5;
            f32x16 acc;
#pragma unroll
            for (int e = 0; e < 16; ++e) acc[e] = 0.f;
            if (!(ti == 0 && tj == 1)) {
                const LAS unsigned char* ap = L + (which ? G1_QS : G1_KS) + (32 * ti + r) * 272 + hh * 16;
                const LAS unsigned char* bp = L + G1_KS + (32 * tj + r) * 272 + hh * 16;
#pragma unroll
                for (int ks = 0; ks < 8; ++ks) { const bf16x8 a = *(const LAS bf16x8*)(ap + ks * 32), b = *(const LAS bf16x8*)(bp + ks * 32); acc = MFMA32(a, b, acc); }
            }
            const int jc = 32 * tj + r; const float gj = gcum_s[jc];
#pragma unroll
            for (int e = 0; e < 16; ++e) {
                const int i = 32 * ti + (e & 3) + 8 * (e >> 2) + 4 * hh; const float dg = gcum_s[i] - gj;
                if (which == 0) { const float f = (i > jc) ? __expf(dg) * beta_s[i] : 0.f; *(LAS float*)(L + G1_AS + i * 272 + jc * 4) = acc[e] * f; }
                else { const float f = (i >= jc) ? __expf(dg) : 0.f; *(LAS bf16_t*)(L + G1_PS + i * 144 + jc * 2) = (bf16_t)(cvt2(acc[e] * f, 0.f) & 0xffffu); }
            }
        }
        __syncthreads();
        if (tid < 256) {
            int t3 = tid; asm volatile("" : "+v"(t3));
            const bool isw = t3 < 128; const int d = t3 & 127;
            float X[64];
#pragma unroll
            for (int i = 0; i < 64; ++i) { const float raw = bf2f(*(const LAS bf16_t*)(L + (isw ? G1_KS : G1_VS) + i * 272 + d * 2)); X[i] = raw * beta_s[i] * (isw ? eg_s[i] : 1.0f); }
            unsigned abase = (unsigned)(size_t)(L + G1_AS);
#pragma unroll
            for (int i = 1; i < 64; ++i) {
                unsigned ra = abase + i * 272;
                if (i >= 3) asm volatile("" : "+v"(ra) : "v"(X[i - 2]));
                float a = X[i];
#pragma unroll
                for (int j4 = 0; j4 <= (i - 1) / 4; ++j4) { const f32x4 a4 = *(const LAS f32x4*)(ra + j4 * 16);
                    a -= a4[0] * X[4 * j4]; a -= a4[1] * X[4 * j4 + 1]; a -= a4[2] * X[4 * j4 + 2]; a -= a4[3] * X[4 * j4 + 3]; }
                X[i] = a;
            }
            if (isw) {
#pragma unroll
                for (int i = 0; i < 64; ++i) *(LAS bf16_t*)(L + G1_WS + i * 272 + d * 2) = (bf16_t)(cvt2(-X[i], 0.f) & 0xffffu);
            } else {
                const int ws = d >> 5, cc = d & 31;
#pragma unroll
                for (int rt = 0; rt < 2; ++rt)
#pragma unroll
                    for (int hh = 0; hh < 2; ++hh) { u32x4 o0, o1;
#pragma unroll
                        for (int q = 0; q < 2; ++q) { const int i0 = 32 * rt + 8 * q + 4 * hh, i1 = 32 * rt + 8 * (q + 2) + 4 * hh;
                            o0[2 * q] = cvt2(X[i0], X[i0 + 1]); o0[2 * q + 1] = cvt2(X[i0 + 2], X[i0 + 3]); o1[2 * q] = cvt2(X[i1], X[i1 + 1]); o1[2 * q + 1] = cvt2(X[i1 + 2], X[i1 + 3]); }
                        u32x4* dst = (u32x4*)(blk + GS_UF + (size_t)(((ws * 2 + rt) * 64) + cc + 32 * hh) * 32); dst[0] = o0; dst[1] = o1; }
            }
        } else {
            int l3 = lane; asm volatile("" : "+v"(l3));
            const int wv = wave - 4, r = l3 & 31, hh = l3 >> 5;
            {   const int rt4 = wv;
#pragma unroll
                for (int kt2 = 0; kt2 < 2; ++kt2)
#pragma unroll
                    for (int ss = 0; ss < 2; ++ss) { float v[8];
#pragma unroll
                        for (int j = 0; j < 8; ++j) { const int tok = 32 * kt2 + krow(ss, hh, j); v[j] = bf2f(*(const LAS bf16_t*)(L + G1_KS + tok * 272 + (32 * rt4 + r) * 2)) * ek_s[tok]; }
                        u32x4 o; o[0] = cvt2(v[0], v[1]); o[1] = cvt2(v[2], v[3]); o[2] = cvt2(v[4], v[5]); o[3] = cvt2(v[6], v[7]);
                        *(u32x4*)(blk + GS_KF + ((rt4 * 2 + kt2) * 2 + ss) * 1024 + lane * 16) = o; } }
            {   const int kt = wv;
#pragma unroll
                for (int rt = 0; rt < 2; ++rt)
#pragma unroll
                    for (int ss = 0; ss < 2; ++ss) { const int i = 32 * rt + r; const float sc = eg_s[i];
                        const u32x2 lo = *(const LAS u32x2*)(L + G1_QS + i * 272 + (32 * kt + 16 * ss + 4 * hh) * 2), hi = *(const LAS u32x2*)(L + G1_QS + i * 272 + (32 * kt + 16 * ss + 8 + 4 * hh) * 2);
                        u32x4 o; o[0] = cvt2(lo16(lo[0]) * sc, hi16(lo[0]) * sc); o[1] = cvt2(lo16(lo[1]) * sc, hi16(lo[1]) * sc); o[2] = cvt2(lo16(hi[0]) * sc, hi16(hi[0]) * sc); o[3] = cvt2(lo16(hi[1]) * sc, hi16(hi[1]) * sc);
                        *(u32x4*)(blk + GS_QF + ((rt * 4 + kt) * 2 + ss) * 1024 + lane * 16) = o; } }
            {   const int rt = wv >> 1, kt2 = wv & 1;
#pragma unroll
                for (int ss = 0; ss < 2; ++ss) { const int i = 32 * rt + r;
                    const u32x2 lo = *(const LAS u32x2*)(L + G1_PS + i * 144 + (32 * kt2 + 16 * ss + 4 * hh) * 2), hi = *(const LAS u32x2*)(L + G1_PS + i * 144 + (32 * kt2 + 16 * ss + 8 + 4 * hh) * 2);
                    u32x4 o; o[0] = lo[0]; o[1] = lo[1]; o[2] = hi[0]; o[3] = hi[1];
                    *(u32x4*)(blk + GS_PF + ((rt * 2 + kt2) * 2 + ss) * 1024 + lane * 16) = o; } }
        }
        __syncthreads();
        {
            int l4 = lane; asm volatile("" : "+v"(l4));
            const int kt = wave & 3, rt = wave >> 2, r = l4 & 31, hh = l4 >> 5, i = 32 * rt + r;
#pragma unroll
            for (int ss = 0; ss < 2; ++ss) {
                const u32x2 lo = *(const LAS u32x2*)(L + G1_WS + i * 272 + (32 * kt + 16 * ss + 4 * hh) * 2), hi = *(const LAS u32x2*)(L + G1_WS + i * 272 + (32 * kt + 16 * ss + 8 + 4 * hh) * 2);
                u32x4 o; o[0] = lo[0]; o[1] = lo[1]; o[2] = hi[0]; o[3] = hi[1];
                *(u32x4*)(blk + GS_WF + ((rt * 4 + kt) * 2 + ss) * 1024 + lane * 16) = o; }
        }
        __syncthreads();
    }
}

constexpr int G2_FB = 57344, G2_OS = 2 * G2_FB, G2_OSTRIDE = 528;
__device__ __forceinline__ bf16x8 pack8(const f32x16& x, const int s) {
    u32x4 p; p[0] = cvt2(x[8 * s], x[8 * s + 1]); p[1] = cvt2(x[8 * s + 2], x[8 * s + 3]); p[2] = cvt2(x[8 * s + 4], x[8 * s + 5]); p[3] = cvt2(x[8 * s + 6], x[8 * s + 7]);
    return __builtin_bit_cast(bf16x8, p);
}
__device__ __forceinline__ void phase_gdn_g2(Frame& F) {
    int tid = opaque_tid(F.wv);
    const int lane = tid & 63, wave = __builtin_amdgcn_readfirstlane(tid >> 6);
    LAS unsigned char* L = F.lds;
    const float* DEC = (const float*)(F.ws + WS_DEC);
    for (int task = blockIdx.x; task < 192; task += F.G) {
        int s, h, nch, ch0; if (task < 64) { s = task >> 3; h = task & 7; nch = 64; ch0 = s * 512 + h; } else { s = BP + ((task - 64) >> 3); h = task & 7; nch = 1; ch0 = 4096 + (s - BP) * 8 + h; }
        const int cstride = 8;
        const int base = seq_base(s), nvalid = s < BP ? 64 : TS;
        const unsigned char* blk0 = F.ws + WS_RB + (size_t)ch0 * GS_BYTES;
        if (wave < 4) {
            const int ws = wave, cc = lane & 31, hh = lane >> 5;
            f32x16 S0, S1, S2, S3;
            if (s < BP) {
#pragma unroll
                for (int e = 0; e < 16; ++e) { S0[e] = 0.f; S1[e] = 0.f; S2[e] = 0.f; S3[e] = 0.f; }
            } else {
                const float* sp = F.in[7] + ((size_t)(s - BP) * 8 + h) * 16384 + 32 * ws + cc;
#pragma unroll
                for (int e = 0; e < 16; ++e) { const int rr = (e & 3) + 8 * (e >> 2) + 4 * hh; S0[e] = sp[(size_t)rr * 128]; S1[e] = sp[(size_t)(32 + rr) * 128]; S2[e] = sp[(size_t)(64 + rr) * 128]; S3[e] = sp[(size_t)(96 + rr) * 128]; }
            }
            u32x4 un[4];
            { const u32x4* up = (const u32x4*)(blk0 + GS_UF + (size_t)(ws * 2 * 64 + lane) * 32); un[0] = up[0]; un[1] = up[1]; un[2] = up[128]; un[3] = up[129]; }
            __syncthreads();
            for (int c = 0; c < nch; ++c) {
                const LAS unsigned char* B = L + (c & 1) * G2_FB + lane * 16;
                const float dec = DEC[ch0 + c * cstride];
                f32x16 vn0, vn1, o0, o1;
#pragma unroll
                for (int q = 0; q < 4; ++q) { vn0[2 * q] = lo16(un[0][q]); vn0[2 * q + 1] = hi16(un[0][q]); vn0[8 + 2 * q] = lo16(un[1][q]); vn0[8 + 2 * q + 1] = hi16(un[1][q]);
                                              vn1[2 * q] = lo16(un[2][q]); vn1[2 * q + 1] = hi16(un[2][q]); vn1[8 + 2 * q] = lo16(un[3][q]); vn1[8 + 2 * q + 1] = hi16(un[3][q]); }
#pragma unroll
                for (int e = 0; e < 16; ++e) { o0[e] = 0.f; o1[e] = 0.f; }
                if (c + 1 < nch) { const u32x4* up = (const u32x4*)(blk0 + (size_t)(c + 1) * cstride * GS_BYTES + GS_UF + (size_t)(ws * 2 * 64 + lane) * 32); un[0] = up[0]; un[1] = up[1]; un[2] = up[128]; un[3] = up[129]; }
#define G2_WQ(Sx, kt) do { _Pragma("unroll") for (int ss = 0; ss < 2; ++ss) { const bf16x8 sb = pack8(Sx, ss); \
                    const bf16x8 fw0 = *(const LAS bf16x8*)(B + GS_WF + ((0 * 4 + kt) * 2 + ss) * 1024), fw1 = *(const LAS bf16x8*)(B + GS_WF + ((1 * 4 + kt) * 2 + ss) * 1024); \
                    const bf16x8 fq0 = *(const LAS bf16x8*)(B + GS_QF + ((0 * 4 + kt) * 2 + ss) * 1024), fq1 = *(const LAS bf16x8*)(B + GS_QF + ((1 * 4 + kt) * 2 + ss) * 1024); \
                    vn0 = MFMA32(fw0, sb, vn0); vn1 = MFMA32(fw1, sb, vn1); o0 = MFMA32(fq0, sb, o0); o1 = MFMA32(fq1, sb, o1); } } while (0)
                G2_WQ(S0, 0); G2_WQ(S1, 1); G2_WQ(S2, 2); G2_WQ(S3, 3);
#undef G2_WQ
                bf16x8 vb[2][2];
                vb[0][0] = pack8(vn0, 0); vb[0][1] = pack8(vn0, 1); vb[1][0] = pack8(vn1, 0); vb[1][1] = pack8(vn1, 1);
#pragma unroll
                for (int kt2 = 0; kt2 < 2; ++kt2)
#pragma unroll
                    for (int ss = 0; ss < 2; ++ss) {
                        const bf16x8 fp0 = *(const LAS bf16x8*)(B + GS_PF + ((0 * 2 + kt2) * 2 + ss) * 1024), fp1 = *(const LAS bf16x8*)(B + GS_PF + ((1 * 2 + kt2) * 2 + ss) * 1024);
                        o0 = MFMA32(fp0, vb[kt2][ss], o0); o1 = MFMA32(fp1, vb[kt2][ss], o1); }
#define G2_KS(Sx, rt4) do { Sx = Sx * dec; _Pragma("unroll") for (int kt2 = 0; kt2 < 2; ++kt2) _Pragma("unroll") for (int ss = 0; ss < 2; ++ss) { \
                    const bf16x8 fk = *(const LAS bf16x8*)(B + GS_KF + ((rt4 * 2 + kt2) * 2 + ss) * 1024); Sx = MFMA32(fk, vb[kt2][ss], Sx); } } while (0)
                G2_KS(S0, 0); G2_KS(S1, 1); G2_KS(S2, 2); G2_KS(S3, 3);
#undef G2_KS
                __syncthreads();
#pragma unroll
                for (int e = 0; e < 16; ++e) { const int rr = (e & 3) + 8 * (e >> 2) + 4 * hh;
                    *(LAS float*)(L + G2_OS + rr * G2_OSTRIDE + (32 * ws + cc) * 4) = o0[e]; *(LAS float*)(L + G2_OS + (32 + rr) * G2_OSTRIDE + (32 * ws + cc) * 4) = o1[e]; }
                __syncthreads();
            }
            float* so = (s < BP ? F.out + O_GSP + ((size_t)s * 8 + h) * 16384 : F.out + O_GSS + ((size_t)(s - BP) * 8 + h) * 16384) + 32 * ws + cc;
#pragma unroll
            for (int e = 0; e < 16; ++e) { const int rr = (e & 3) + 8 * (e >> 2) + 4 * hh; so[(size_t)rr * 128] = S0[e]; so[(size_t)(32 + rr) * 128] = S1[e]; so[(size_t)(64 + rr) * 128] = S2[e]; so[(size_t)(96 + rr) * 128] = S3[e]; }
        } else {
            const int lt = tid - 256;
            u32x4 pre[14];
            { const u32x4* src = (const u32x4*)blk0;
#pragma unroll
              for (int i = 0; i < 14; ++i) pre[i] = src[i * 256 + lt];
#pragma unroll
              for (int i = 0; i < 14; ++i) *(LAS u32x4*)(L + (size_t)(i * 256 + lt) * 16) = pre[i]; }
            __syncthreads();
            const int row = lt >> 2, seg = lt & 3;
            f32x4 hn[8];
#pragma unroll
            for (int q = 0; q < 8; ++q) hn[q] = *(const f32x4*)(F.in[32] + seg * 32 + 4 * q);
            for (int c = 0; c < nch; ++c) {
                const bool more = c + 1 < nch;
                if (more) { const u32x4* src = (const u32x4*)(blk0 + (size_t)(c + 1) * cstride * GS_BYTES);
#pragma unroll
                    for (int i = 0; i < 14; ++i) pre[i] = src[i * 256 + lt]; }
                const int m = base + c * 64 + row; const bool rok = row < nvalid;
                u32x4 zz[4];
                if (rok) { const u32x4* zp = (const u32x4*)(F.Z1() + (size_t)m * D + h * 128 + seg * 32);
#pragma unroll
                    for (int q = 0; q < 4; ++q) zz[q] = zp[q]; }
                __syncthreads();
                if (more) {
#pragma unroll
                    for (int i = 0; i < 14; ++i) *(LAS u32x4*)(L + ((c + 1) & 1) * G2_FB + (size_t)(i * 256 + lt) * 16) = pre[i]; }
                __syncthreads();
                f32x4 ov[8]; float ss = 0.f;
#pragma unroll
                for (int q = 0; q < 8; ++q) { ov[q] = *(const LAS f32x4*)(L + G2_OS + row * G2_OSTRIDE + (seg * 32 + 4 * q) * 4); ss += (ov[q][0] * ov[q][0] + ov[q][1] * ov[q][1]) + (ov[q][2] * ov[q][2] + ov[q][3] * ov[q][3]); }
                ss += __shfl_xor(ss, 1); ss += __shfl_xor(ss, 2);
                const float rn = rsqrtf(ss * (1.f / 128.f) + EPS);
                if (rok) { u32x4 yo[4];
#pragma unroll
                    for (int q = 0; q < 4; ++q) {
#pragma unroll
                        for (int e = 0; e < 4; ++e) { const int q2 = 2 * q + (e >> 1), e2 = 2 * (e & 1); const float z0 = lo16(zz[q][e]), z1 = hi16(zz[q][e]);
                            yo[q][e] = cvt2(ov[q2][e2] * rn * hn[q2][e2] * siluf_(z0), ov[q2][e2 + 1] * rn * hn[q2][e2 + 1] * siluf_(z1)); } }
                    u32x4* yp = (u32x4*)(F.Y1() + (size_t)m * D + h * 128 + seg * 32);
#pragma unroll
                    for (int q = 0; q < 4; ++q) yp[q] = yo[q]; }
            }
        }
        __syncthreads();
    }
}

#define MFMA16(a, b, c) __builtin_amdgcn_mfma_f32_16x16x32_bf16((a), (b), (c), 0, 0, 0)
__device__ __forceinline__ float dpp_shr_f(float idv, float x, const int o) {
    int r;
    switch (o) {
        case 1: r = __builtin_amdgcn_update_dpp(__float_as_int(idv), __float_as_int(x), 0x111, 0xf, 0xf, false); break;
        case 2: r = __builtin_amdgcn_update_dpp(__float_as_int(idv), __float_as_int(x), 0x112, 0xf, 0xf, false); break;
        case 4: r = __builtin_amdgcn_update_dpp(__float_as_int(idv), __float_as_int(x), 0x114, 0xf, 0xf, false); break;
        default: r = __builtin_amdgcn_update_dpp(__float_as_int(idv), __float_as_int(x), 0x118, 0xf, 0xf, false); break;
    }
    return __int_as_float(r);
}
template <int PASS>
__device__ __forceinline__ void phase_lru(Frame& F) {
    int tid = opaque_tid(F.wv);
    const int lane = tid & 63, wave = __builtin_amdgcn_readfirstlane(tid >> 6);
    const int gw = F.vcu * 8 + wave, NGW = F.G * 8, h = gw & 7, g = lane >> 4, l15 = lane & 15;
    LAS unsigned char* xs = F.lds + wave * 9216;
    LAS float* cst = (LAS float*)(F.lds + 73728 + wave * 768);
    const bf16_t* LGW = (const bf16_t*)(F.ws + WS_LGW);
    float* LAG = F.LAG();
    bf16x8 wfa[4][2], wfx[4][2];
#pragma unroll
    for (int nt = 0; nt < 4; ++nt)
#pragma unroll
        for (int ks = 0; ks < 2; ++ks) {
            wfa[nt][ks] = *(const bf16x8*)(LGW + ((size_t)(h * 2 + 0) * 64 + 16 * nt + l15) * 64 + 32 * ks + 8 * g);
            wfx[nt][ks] = *(const bf16x8*)(LGW + ((size_t)(h * 2 + 1) * 64 + 16 * nt + l15) * 64 + 32 * ks + 8 * g); }
    cst[lane] = F.in[18][h * 64 + lane]; cst[64 + lane] = F.in[20][h * 64 + lane]; cst[128 + lane] = softplusf_(-F.in[21][h * 64 + lane]);
    for (int task = gw; task < 4224; task += NGW) {
        int s, c; if (task < 4096) { s = task >> 9; c = (task >> 3) & 63; } else { s = BP + ((task - 4096) >> 3); c = 0; }
        const int T = seq_len(s), base = seq_base(s), t0 = c * 64, ntile = s < BP ? 4 : 1;
        {
            int l1 = lane; asm volatile("" : "+v"(l1));
            const int cg = l1 & 7, tp = l1 >> 3, chb = h * 64 + cg * 8;
            float xr[11][8];
#pragma unroll
            for (int i = 0; i < 11; ++i) {
                const int tt = t0 + tp * 8 - 3 + i;
                if (tt >= 0 && tt < T) { const u32x4 w = *(const u32x4*)(F.U0() + (size_t)(base + tt) * EV_IN + C_XA + chb);
#pragma unroll
                    for (int e = 0; e < 4; ++e) { xr[i][2 * e] = lo16(w[e]); xr[i][2 * e + 1] = hi16(w[e]); } }
                else if (tt < 0 && s >= BP) { const f32x4* sp = (const f32x4*)(F.in[2] + ((size_t)(s - BP) * 3 + (tt + 3)) * 512 + chb); const f32x4 a = sp[0], b = sp[1];
                    xr[i][0] = a[0]; xr[i][1] = a[1]; xr[i][2] = a[2]; xr[i][3] = a[3]; xr[i][4] = b[0]; xr[i][5] = b[1]; xr[i][6] = b[2]; xr[i][7] = b[3]; }
                else {
#pragma unroll
                    for (int e = 0; e < 8; ++e) xr[i][e] = 0.f; }
            }
            float cw[4][8], cb[8];
#pragma unroll
            for (int jj = 0; jj < 4; ++jj) { const f32x4 a = *(const f32x4*)(F.in[15] + jj * 512 + chb), b = *(const f32x4*)(F.in[15] + jj * 512 + chb + 4);
                cw[jj][0] = a[0]; cw[jj][1] = a[1]; cw[jj][2] = a[2]; cw[jj][3] = a[3]; cw[jj][4] = b[0]; cw[jj][5] = b[1]; cw[jj][6] = b[2]; cw[jj][7] = b[3]; }
            { const f32x4 a = *(const f32x4*)(F.in[16] + chb), b = *(const f32x4*)(F.in[16] + chb + 4); cb[0] = a[0]; cb[1] = a[1]; cb[2] = a[2]; cb[3] = a[3]; cb[4] = b[0]; cb[5] = b[1]; cb[6] = b[2]; cb[7] = b[3]; }
#pragma unroll
            for (int i = 0; i < 8; ++i) { float o[8];
#pragma unroll
                for (int e = 0; e < 8; ++e) o[e] = cw[0][e] * xr[i][e] + cw[1][e] * xr[i + 1][e] + cw[2][e] * xr[i + 2][e] + cw[3][e] * xr[i + 3][e] + cb[e];
                u32x4 w; w[0] = cvt2(o[0], o[1]); w[1] = cvt2(o[2], o[3]); w[2] = cvt2(o[4], o[5]); w[3] = cvt2(o[6], o[7]);
                *(LAS u32x4*)(xs + (tp * 8 + i) * 144 + cg * 16) = w; }
            if (PASS == 2 && t0 + 64 >= T && tp == ((T - 1) >> 3) - (t0 >> 3)) {
                float* o = (s < BP ? F.out + O_LCP + (size_t)s * 3 * 512 : F.out + O_LCS + (size_t)(s - BP) * 3 * 512) + chb;
#pragma unroll
                for (int q = 0; q < 3; ++q) { *(f32x4*)(o + q * 512) = (f32x4){xr[8 + q][0], xr[8 + q][1], xr[8 + q][2], xr[8 + q][3]}; *(f32x4*)(o + q * 512 + 4) = (f32x4){xr[8 + q][4], xr[8 + q][5], xr[8 + q][6], xr[8 + q][7]}; }
            }
        }
        float hin[4][4], arun[4][4];
#pragma unroll
        for (int nt = 0; nt < 4; ++nt)
#pragma unroll
            for (int rg = 0; rg < 4; ++rg) { hin[nt][rg] = 0.f; arun[nt][rg] = 1.f; }
        if (PASS == 2) {
            float hf = s >= BP ? F.in[3][(s - BP) * 512 + h * 64 + lane] : 0.f;
            const f32x2* lp = (const f32x2*)LAG + (size_t)(s * 64) * 512 + h * 64 + lane;
            int j = 0;
            for (; j + 8 <= c; j += 8) { f32x2 v[8];
#pragma unroll
                for (int q = 0; q < 8; ++q) v[q] = lp[(size_t)(j + q) * 512];
#pragma unroll
                for (int q = 0; q < 8; ++q) hf = v[q][0] * hf + v[q][1]; }
            for (; j < c; ++j) { const f32x2 v = lp[(size_t)j * 512]; hf = v[0] * hf + v[1]; }
#pragma unroll
            for (int nt = 0; nt < 4; ++nt)
#pragma unroll
                for (int rg = 0; rg < 4; ++rg) hin[nt][rg] = __shfl(hf, 16 * nt + 4 * g + rg);
        }
        asm volatile("s_waitcnt lgkmcnt(0)" ::: "memory");
        for (int tt = 0; tt < ntile; ++tt) {
            const int tok = 16 * tt + l15;
            const bf16x8 b0 = *(const LAS bf16x8*)(xs + tok * 144 + (8 * g) * 2), b1 = *(const LAS bf16x8*)(xs + tok * 144 + (32 + 8 * g) * 2);
            const size_t m = (size_t)base + t0 + tok;
#pragma unroll
            for (int nt = 0; nt < 4; ++nt) {
                f32x4 za = {0.f, 0.f, 0.f, 0.f}, zx = {0.f, 0.f, 0.f, 0.f};
                za = MFMA16(wfa[nt][0], b0, za); za = MFMA16(wfa[nt][1], b1, za);
                zx = MFMA16(wfx[nt][0], b0, zx); zx = MFMA16(wfx[nt][1], b1, zx);
                const int n0 = 16 * nt + 4 * g;
                const u32x2 xw = *(const LAS u32x2*)(xs + tok * 144 + n0 * 2);
                const float xc[4] = {lo16(xw[0]), hi16(xw[0]), lo16(xw[1]), hi16(xw[1])};
                const f32x4 cba = *(const LAS f32x4*)(cst + n0), cbx = *(const LAS f32x4*)(cst + 64 + n0), csp = *(const LAS f32x4*)(cst + 128 + n0);
                float av[4], bv[4];
#pragma unroll
                for (int rg = 0; rg < 4; ++rg) {
                    const float r = sigmoidf_(za[rg] + cba[rg]), ig = sigmoidf_(zx[rg] + cbx[rg]), la = -8.0f * r * csp[rg], a = __expf(la);
                    av[rg] = a; bv[rg] = sqrtf(fmaxf(1.0f - a * a, 0.f)) * (ig * xc[rg]); }
#pragma unroll
                for (int o = 1; o < 16; o <<= 1)
#pragma unroll
                    for (int rg = 0; rg < 4; ++rg) { const float ap = dpp_shr_f(1.0f, av[rg], o), bp = dpp_shr_f(0.0f, bv[rg], o); bv[rg] = av[rg] * bp + bv[rg]; av[rg] = av[rg] * ap; }
                float hv[4];
#pragma unroll
                for (int rg = 0; rg < 4; ++rg) { hv[rg] = bv[rg] + av[rg] * hin[nt][rg]; hin[nt][rg] = __shfl(hv[rg], (lane & 48) | 15); }
                if (PASS == 1) {
#pragma unroll
                    for (int rg = 0; rg < 4; ++rg) arun[nt][rg] *= __shfl(av[rg], (lane & 48) | 15);
                } else {
                    const bool tok_ok = (t0 + tok) < T;
                    if (tok_ok) {
                        const u32x2 gw2 = *(const u32x2*)(F.U0() + m * EV_IN + C_GA + h * 64 + n0);
                        u32x2 yo; yo[0] = cvt2(hv[0] * siluf_(lo16(gw2[0])), hv[1] * siluf_(hi16(gw2[0]))); yo[1] = cvt2(hv[2] * siluf_(lo16(gw2[1])), hv[3] * siluf_(hi16(gw2[1])));
                        *(u32x2*)(F.Y0() + m * D + h * 64 + n0) = yo;
                        if (t0 + tok == T - 1) { float* o = (s < BP ? F.out + O_LHP + s * 512 : F.out + O_LHS + (s - BP) * 512) + h * 64 + n0; *(f32x4*)o = (f32x4){hv[0], hv[1], hv[2], hv[3]}; }
                    }
                }
            }
        }
        if (PASS == 1 && s < BP && l15 == 15) {
            f32x2* lp = (f32x2*)LAG + (size_t)(s * 64 + c) * 512 + h * 64;
#pragma unroll
            for (int nt = 0; nt < 4; ++nt)
#pragma unroll
                for (int rg = 0; rg < 4; ++rg) lp[16 * nt + 4 * g + rg] = (f32x2){arun[nt][rg], hin[nt][rg]};
        }
        asm volatile("s_waitcnt lgkmcnt(0)" ::: "memory");
    }
}

constexpr size_t RB_VTP = RB_WEND, RB_VTS = RB_VTP + (size_t)BP * 2 * 64 * TP * 2, RB_VTEND = RB_VTS + (size_t)BS * 2 * 64 * 192 * 2;
static_assert(RB_VTEND <= RB_BYTES, "ws map");
__device__ __forceinline__ void phase_vt_build(Frame& F) {
    PHASE_IDS();
    const int gw = F.vcu * 8 + wave, NGW = F.G * 8;
    LAS unsigned char* xs = F.lds + wave * 9216;
    bf16_t* VTP = (bf16_t*)(F.ws + WS_RB + RB_VTP); bf16_t* VTS = (bf16_t*)(F.ws + WS_RB + RB_VTS);
    for (int task = gw; task < 1024 + 96; task += NGW) {
        int s, kv, kb; if (task < 1024) { s = task >> 7; kv = (task >> 6) & 1; kb = task & 63; } else { const int r = task - 1024; s = BP + r / 6; kv = (r % 6) / 3; kb = r % 3; }
        const int row8 = lane >> 3, ch = lane & 7;
#pragma unroll
        for (int i = 0; i < 8; ++i) {
            const int key = 8 * i + row8, kg = kb * 64 + key; u32x4 w = {0u, 0u, 0u, 0u};
            if (s < BP) w = *(const u32x4*)(F.U0() + (size_t)(s * TP + kg) * EV_IN + C_V + kv * 64 + ch * 8);
            else if (kg < 128) { const f32x4* p = (const f32x4*)(F.in[5] + ((size_t)((s - BP) * 128 + kg) * 2 + kv) * 64 + ch * 8); const f32x4 a = p[0], b = p[1]; w[0] = cvt2(a[0], a[1]); w[1] = cvt2(a[2], a[3]); w[2] = cvt2(b[0], b[1]); w[3] = cvt2(b[2], b[3]); }
            else if (kg < 128 + TS) w = *(const u32x4*)(F.U0() + (size_t)(MP + (s - BP) * TS + (kg - 128)) * EV_IN + C_V + kv * 64 + ch * 8);
            *(LAS u32x4*)(xs + key * 144 + ch * 16) = w;
        }
        asm volatile("s_waitcnt lgkmcnt(0)" ::: "memory");
        bf16_t* dst = s < BP ? VTP + ((size_t)(s * 2 + kv) * 64 + lane) * TP + kb * 64 : VTS + ((size_t)((s - BP) * 2 + kv) * 64 + lane) * 192 + kb * 64;
#pragma unroll
        for (int q = 0; q < 8; ++q) { u32x4 o;
#pragma unroll
            for (int e = 0; e < 4; ++e) { const unsigned lo = *(const LAS bf16_t*)(xs + (8 * q + 2 * e) * 144 + lane * 2), hi = *(const LAS bf16_t*)(xs + (8 * q + 2 * e + 1) * 144 + lane * 2); o[e] = lo | (hi << 16); }
            *(u32x4*)(dst + 8 * q) = o; }
        asm volatile("s_waitcnt lgkmcnt(0)" ::: "memory");
    }
}
constexpr int AT_K = 0, AT_V = 27648;
__device__ __forceinline__ void phase_attn(Frame& F) {
    PHASE_IDS();
    LAS unsigned char* L = F.lds;
    const bf16_t* VTP = (const bf16_t*)(F.ws + WS_RB + RB_VTP); const bf16_t* VTS = (const bf16_t*)(F.ws + WS_RB + RB_VTS);
    for (int task = F.vcu; task < 1024 + 32; task += F.G) {
        int s, c, kv; if (task < 1024) { s = task >> 7; c = (task >> 1) & 63; kv = task & 1; } else { s = BP + ((task - 1024) >> 1); c = 0; kv = task & 1; }
        const int base = seq_base(s), tok0 = c * 64 - 128;
        const int kmin = s < BP ? (tok0 < 0 ? -tok0 : 0) : 0, kmax = s < BP ? 192 : 128 + TS;
        __syncthreads();
#pragma unroll
        for (int i = 0; i < 3; ++i) {
            const int idx = tid + 512 * i, key = idx >> 3, ch = idx & 7; u32x4 w = {0u, 0u, 0u, 0u};
            if (key >= kmin && key < kmax) {
                if (s < BP) w = *(const u32x4*)(F.U0() + (size_t)(base + tok0 + key) * EV_IN + C_K + kv * 64 + ch * 8);
                else if (key < 128) { const f32x4* p = (const f32x4*)(F.in[4] + ((size_t)((s - BP) * 128 + key) * 2 + kv) * 64 + ch * 8); const f32x4 a = p[0], b = p[1]; w[0] = cvt2(a[0], a[1]); w[1] = cvt2(a[2], a[3]); w[2] = cvt2(b[0], b[1]); w[3] = cvt2(b[2], b[3]); }
                else w = *(const u32x4*)(F.U0() + (size_t)(base + key - 128) * EV_IN + C_K + kv * 64 + ch * 8);
            }
            *(LAS u32x4*)(L + AT_K + key * 144 + ch * 16) = w;
        }
#pragma unroll
        for (int i = 0; i < 3; ++i) {
            const int idx = tid + 512 * i, d = idx / 24, ch = idx % 24, key = ch * 8; u32x4 w = {0u, 0u, 0u, 0u};
            if (s < BP) { if (key >= kmin) w = *(const u32x4*)(VTP + ((size_t)(s * 2 + kv) * 64 + d) * TP + tok0 + key); }
            else w = *(const u32x4*)(VTS + ((size_t)((s - BP) * 2 + kv) * 64 + d) * 192 + key);
            *(LAS u32x4*)(L + AT_V + d * 400 + ch * 16) = w;
        }
        const int g = wave >> 1, qh = wave & 1, hq = kv * 4 + g, r = lane & 31, hh = lane >> 5, qi = qh * 32 + r;
        const bool qok = s < BP ? true : qi < TS;
        const size_t m = (size_t)base + c * 64 + (qok ? qi : 0);
        bf16x8 qf[4];
#pragma unroll
        for (int ks = 0; ks < 4; ++ks) { u32x4 w = {0u, 0u, 0u, 0u};
            if (qok) { const u32x4 x = *(const u32x4*)(F.U0() + m * EV_IN + C_Q + hq * 64 + 16 * ks + 8 * hh);
#pragma unroll
                for (int e = 0; e < 4; ++e) w[e] = cvt2(lo16(x[e]) * 0.125f, hi16(x[e]) * 0.125f); }
            qf[ks] = __builtin_bit_cast(bf16x8, w); }
        const float sink = F.in[22][hq];
        __syncthreads();
        f32x16 sc[6];
#pragma unroll
        for (int kt = 0; kt < 6; ++kt) {
#pragma unroll
            for (int e = 0; e < 16; ++e) sc[kt][e] = 0.f;
#pragma unroll
            for (int ks = 0; ks < 4; ++ks) { const bf16x8 kf = *(const LAS bf16x8*)(L + AT_K + (32 * kt + r) * 144 + (16 * ks + 8 * hh) * 2); sc[kt] = MFMA32(kf, qf[ks], sc[kt]); }
        }
        float mx = sink;
#pragma unroll
        for (int kt = 0; kt < 6; ++kt)
#pragma unroll
            for (int e = 0; e < 16; ++e) { const int kidx = 32 * kt + (e & 3) + 8 * (e >> 2) + 4 * hh; const bool ok = kidx >= kmin && kidx < kmax; sc[kt][e] = ok ? sc[kt][e] : -1e30f; mx = fmaxf(mx, sc[kt][e]); }
        mx = fmaxf(mx, __shfl_xor(mx, 32));
        float lsum = 0.f;
#pragma unroll
        for (int kt = 0; kt < 6; ++kt)
#pragma unroll
            for (int e = 0; e < 16; ++e) { const float p = __expf(sc[kt][e] - mx); sc[kt][e] = p; lsum += p; }
        lsum += __shfl_xor(lsum, 32);
        const float il = 1.0f / (lsum + __expf(sink - mx));
        f32x16 o0, o1;
#pragma unroll
        for (int e = 0; e < 16; ++e) { o0[e] = 0.f; o1[e] = 0.f; }
#pragma unroll
        for (int kt = 0; kt < 6; ++kt)
#pragma unroll
            for (int ss = 0; ss < 2; ++ss) {
                const bf16x8 pb = pack8(sc[kt], ss);
                const LAS unsigned char* vp = L + AT_V + r * 400 + (32 * kt + 16 * ss + 4 * hh) * 2;
                const u32x2 a0 = *(const LAS u32x2*)vp, a1 = *(const LAS u32x2*)(vp + 16), b0 = *(const LAS u32x2*)(vp + 32 * 400), b1 = *(const LAS u32x2*)(vp + 32 * 400 + 16);
                const u32x4 va = {a0[0], a0[1], a1[0], a1[1]}, vb = {b0[0], b0[1], b1[0], b1[1]};
                o0 = MFMA32(__builtin_bit_cast(bf16x8, va), pb, o0); o1 = MFMA32(__builtin_bit_cast(bf16x8, vb), pb, o1);
            }
        if (qok) {
#pragma unroll
            for (int qq = 0; qq < 4; ++qq) {
                { const int d = 8 * qq + 4 * hh; const u32x2 gb = *(const u32x2*)(F.U0() + m * EV_IN + C_GB + hq * 64 + d);
                  u32x2 yo; yo[0] = cvt2(o0[4 * qq] * il * siluf_(lo16(gb[0])), o0[4 * qq + 1] * il * siluf_(hi16(gb[0]))); yo[1] = cvt2(o0[4 * qq + 2] * il * siluf_(lo16(gb[1])), o0[4 * qq + 3] * il * siluf_(hi16(gb[1])));
                  *(u32x2*)(F.Y0() + m * D + 512 + hq * 64 + d) = yo; }
                { const int d = 32 + 8 * qq + 4 * hh; const u32x2 gb = *(const u32x2*)(F.U0() + m * EV_IN + C_GB + hq * 64 + d);
                  u32x2 yo; yo[0] = cvt2(o1[4 * qq] * il * siluf_(lo16(gb[0])), o1[4 * qq + 1] * il * siluf_(hi16(gb[0]))); yo[1] = cvt2(o1[4 * qq + 2] * il * siluf_(lo16(gb[1])), o1[4 * qq + 3] * il * siluf_(hi16(gb[1])));
                  *(u32x2*)(F.Y0() + m * D + 512 + hq * 64 + d) = yo; }
            }
        }
    }
    __syncthreads();
}

__device__ __forceinline__ void phase_final_rowwise(Frame& F) {
    PHASE_IDS();
    const int gw = F.vcu * 8 + wave, NGW = F.G * 8;
    for (int m = gw; m < MT; m += NGW) {
        int s, t; tok_info(m, s, t);
        const float* mod1 = F.MOD() + (size_t)(24 + s) * 3072;
        f32x4 y[4]; float ss = 0.f;
#pragma unroll
        for (int j = 0; j < 4; ++j) { const u32x2 w = *(const u32x2*)(F.YO() + (size_t)m * D + 4 * lane + 256 * j); y[j] = (f32x4){lo16(w.x), hi16(w.x), lo16(w.y), hi16(w.y)};
            ss += (y[j][0] * y[j][0] + y[j][1] * y[j][1]) + (y[j][2] * y[j][2] + y[j][3] * y[j][3]); }
        const float r1 = rsqrtf(wave_sum(ss) * (1.f / D) + EPS);
#pragma unroll
        for (int j = 0; j < 4; ++j) { const int c = 4 * lane + 256 * j;
            float* op = F.out + O_Y + (size_t)m * D + c;
            const f32x4 xv = *(const f32x4*)op, g = *(const f32x4*)(F.in[27] + c), gt = *(const f32x4*)(mod1 + 2048 + c);
            f32x4 o;
#pragma unroll
            for (int e = 0; e < 4; ++e) o[e] = xv[e] + gt[e] * (y[j][e] * r1 * g[e]);
            *(f32x4*)op = o; }
    }
}

__global__ void __launch_bounds__(512, 2) fwd_megakernel(Params P) {
    extern __shared__ __attribute__((aligned(16))) unsigned char lds_raw[];
    cg::grid_group grid = cg::this_grid();
    Frame F;
    F.lds = (LAS unsigned char*)lds_raw;
    F.wv = __builtin_amdgcn_readfirstlane(threadIdx.x >> 6);
    F.G = gridDim.x; { const int bx = blockIdx.x; F.vcu = (F.G % 8 == 0) ? (bx % 8) * (F.G / 8) + bx / 8 : bx; }
    F.in = P.in; F.out = P.out; F.ws = P.ws;

    volatile LAS unsigned* misc = (volatile LAS unsigned*)(F.lds + LDS_BYTES - 64);
    if (threadIdx.x < 16) misc[threadIdx.x] = 0u;
    __syncthreads();
    XcdBarrier xbar = xcd_barrier_post((unsigned*)(P.ws + WS_CTL), misc);
#define GRID_BAR() xcd_barrier(xbar, F.wv)
    phase_prologue(F);
    grid.sync();
    phase_prenorm0(F);
    GRID_BAR();
    { pg8::Gemm g{F.XN(), F.W0I(), MT, EV_IN, D}; pg8::StaticOrder S; S.init(MT, EV_IN, F.G, (int)blockIdx.x);
      pg8::EpiBf16 E{F.U0(), EV_IN, 1 << 30, F.U0(), EV_IN}; pg8::gemm_phase(F.lds, g, S, E, F.wv); }
    GRID_BAR();
    phase_rope(F);
    phase_lru<1>(F);
    phase_vt_build(F);
    GRID_BAR();
    phase_lru<2>(F);
    phase_attn(F);
    GRID_BAR();
    { pg8::Gemm g{F.Y0(), F.W0O(), MT, D, D}; pg8::StaticOrder S; S.init(MT, D, F.G, (int)blockIdx.x);
      pg8::EpiBf16 E{F.YO(), D, 1 << 30, F.YO(), D}; pg8::gemm_phase(F.lds, g, S, E, F.wv); }
    GRID_BAR();
    phase_mid_rowwise(F);
    GRID_BAR();
    { pg8::Gemm g{F.XN(), F.W1I(), MT, OD_MAIN, D}; pg8::StaticOrder S; S.init(MT, OD_MAIN, F.G, (int)blockIdx.x);
      pg8::EpiBf16 E{F.QKV1(), 3072, 3072, F.Z1(), D}; pg8::gemm_phase(F.lds, g, S, E, F.wv); }
    GRID_BAR();
    phase_gdn_g1(F);
    GRID_BAR();
    phase_gdn_g2(F);
    GRID_BAR();
    { pg8::Gemm g{F.Y1(), F.W1O(), MT, D, D}; pg8::StaticOrder S; S.init(MT, D, F.G, (int)blockIdx.x);
      pg8::EpiBf16 E{F.YO(), D, 1 << 30, F.YO(), D}; pg8::gemm_phase(F.lds, g, S, E, F.wv); }
    GRID_BAR();
    phase_final_rowwise(F);
}

extern "C" void kernel_launch(void* const* d_in, const int* in_sizes, int n_in, void* d_out, int out_size, void* d_ws, size_t ws_size, hipStream_t stream) {
    static int grid = 0;
    if (grid == 0) {
        if (n_in != 34 || out_size != (int)O_END || ws_size < WS_END) { grid = -1; return; }
        int dev = 0, cus = 0, per_cu = 0;
        if (hipGetDevice(&dev) != hipSuccess || hipDeviceGetAttribute(&cus, hipDeviceAttributeMultiprocessorCount, dev) != hipSuccess) { grid = -1; return; }
        if (hipFuncSetAttribute((const void*)fwd_megakernel, hipFuncAttributeMaxDynamicSharedMemorySize, LDS_BYTES) != hipSuccess) { grid = -1; return; }
        if (hipOccupancyMaxActiveBlocksPerMultiprocessor(&per_cu, (const void*)fwd_megakernel, 512, LDS_BYTES) != hipSuccess || per_cu < 1) { grid = -1; return; }
        grid = cus;
    }
    if (grid < 0) return;
    if (hipMemsetAsync((char*)d_ws + WS_CTL, 0, 16384, stream) != hipSuccess) return;
    Params p{};
    for (int i = 0; i < 34; ++i) p.in[i] = (const float*)d_in[i];
    p.out = (float*)d_out; p.ws = (unsigned char*)d_ws;
    void* args[] = {&p};
    (void)hipLaunchCooperativeKernel((const void*)fwd_megakernel, dim3(grid), dim3(512), args, LDS_BYTES, stream);
}
```

```cpp
#include <hip/hip_runtime.h>
#include <hip/hip_cooperative_groups.h>
namespace cg = cooperative_groups;

#define LAS __attribute__((address_space(3)))
typedef unsigned short bf16_t;
typedef short bf16x8 __attribute__((ext_vector_type(8)));
typedef float f32x4 __attribute__((ext_vector_type(4)));
typedef float f32x2 __attribute__((ext_vector_type(2)));
typedef unsigned u32x4 __attribute__((ext_vector_type(4)));
typedef unsigned u32x2 __attribute__((ext_vector_type(2)));

constexpr int D = 1024, BP = 8, TP = 4096, BS = 16, TS = 16;
constexpr int MP = BP * TP, MS = BS * TS, MT = MP + MS;
constexpr int NSEQ = BP + BS;
constexpr int EV_IN = 2304, OD_IN = 4112, OD_MAIN = 4096;
constexpr int C_XA = 0, C_GA = 512, C_Q = 1024, C_K = 1536, C_V = 1664, C_GB = 1792;
constexpr float EPS = 1e-6f;
constexpr size_t O_Y = 0, O_LCP = 33816576, O_LCS = 33828864, O_LHP = 33853440, O_LHS = 33857536, O_KP = 33865728, O_KS = 33996800,
                 O_VP = 34029568, O_VS = 34160640, O_GCP = 34193408, O_GCS = 34267136, O_GSP = 34414592, O_GSS = 35463168, O_END = 37560320;
constexpr size_t MiB = 1u << 20;
constexpr size_t WS_CTL = 0, WS_W1O = 1 * MiB, WS_MOD = 3 * MiB, WS_ROPE = 4 * MiB, WS_BA = 5 * MiB, WS_LAG = 8 * MiB, WS_LGW = 10 * MiB;
constexpr size_t WS_RA = 16 * MiB, RA_BYTES = (size_t)MT * 4096 * 2;
constexpr size_t WS_RB = WS_RA + RA_BYTES;
constexpr size_t ACT_BYTES = (size_t)MT * D * 2;
constexpr size_t RB_XN = 0, RB_Y0 = ACT_BYTES, RB_YO = 2 * ACT_BYTES, RB_W0I = 3 * ACT_BYTES, RB_W0O = RB_W0I + (size_t)EV_IN * D * 2,
                 RB_W1I = RB_W0O + (size_t)D * D * 2, RB_WEND = RB_W1I + (size_t)OD_MAIN * D * 2;
constexpr size_t RB_BYTES = (size_t)4224 * 73728;
constexpr size_t WS_END = WS_RB + RB_BYTES;
static_assert(RB_WEND <= RB_BYTES, "ws map");
static_assert((size_t)MT * 3072 * 2 <= RB_BYTES, "ws map");
constexpr int LDS_BYTES = 155648;

struct Params { const float* in[34]; float* out; unsigned char* ws; };

__device__ __forceinline__ float bf2f(bf16_t b) { return __uint_as_float(((unsigned)b) << 16); }
__device__ __forceinline__ unsigned f2bf(float f) { unsigned u = __float_as_uint(f); return (u + 0x7fffu + ((u >> 16) & 1u)) >> 16; }
__device__ __forceinline__ unsigned pk2(float lo, float hi) { return f2bf(lo) | (f2bf(hi) << 16); }
__device__ __forceinline__ float lo16(unsigned w) { return __uint_as_float(w << 16); }
__device__ __forceinline__ float hi16(unsigned w) { return __uint_as_float(w & 0xffff0000u); }
__device__ __forceinline__ float shfl_idx(float x, int src_lane) { return __int_as_float(__builtin_amdgcn_ds_bpermute(src_lane << 2, __float_as_int(x))); }
__device__ __forceinline__ float shfl_xor_l(float x, int o, int lane) { return shfl_idx(x, lane ^ o); }
__device__ __forceinline__ float wave_sum(float v, int lane) {
#pragma unroll
    for (int o = 1; o < 64; o <<= 1) v += shfl_xor_l(v, o, lane);
    return v;
}
__device__ __forceinline__ float sigmoidf_(float x) { return __builtin_amdgcn_rcpf(1.0f + __expf(-x)); }
__device__ __forceinline__ float siluf_(float x) { return x * __builtin_amdgcn_rcpf(1.0f + __expf(-x)); }
__device__ __forceinline__ float softplusf_(float x) { return x > 20.f ? x : log1pf(__expf(x)); }
__device__ __forceinline__ int seq_base(int s) { return s < BP ? s * TP : MP + (s - BP) * TS; }
__device__ __forceinline__ int seq_len(int s) { return s < BP ? TP : TS; }
__device__ __forceinline__ void tok_info(int m, int& s, int& t) { if (m < MP) { s = m >> 12; t = m & 4095; } else { const int r = m - MP; s = BP + (r >> 4); t = r & 15; } }

__device__ __forceinline__ int opaque_tid(int wv) { unsigned z = 0u; asm volatile("" : "+v"(z)); const int l = __builtin_amdgcn_mbcnt_hi(~0u, __builtin_amdgcn_mbcnt_lo(~0u, z)); return wv * 64 + l; }
namespace pg8 {
constexpr int BM = 256, BK = 64, HALF = 128, HTB = HALF * BK * 2, STAGE_BYTES = 8 * HTB, NXCD = 8, WGM = 8;
__host__ __device__ __forceinline__ int lds_byte(int r, int c) { const int st = (r >> 4) * 2 + (c >> 5), rr = r & 15, cc = c & 31, ob = rr * 64 + cc * 2; return st * 1024 + (ob ^ (((ob >> 9) & 1) << 5)); }
__host__ __device__ __forceinline__ void stage_rc(int b, int& R, int& C) { const int st = b / 1024, sb = b % 1024, swz = sb ^ (((sb >> 9) & 1) << 5); R = (st >> 1) * 16 + swz / 64; C = (st & 1) * 32 + (swz % 64) / 2; }
__host__ __device__ __forceinline__ int perm32(int rho) { const int n = rho >> 4, i = rho & 15; return 8 * (i >> 2) + 4 * n + (i & 3); }
struct Unit { int pm, pn; };
struct Gemm { const bf16_t* A; const bf16_t* Bt; int M, N, K; };
struct StaticOrder {
    int nM, nN, nwg, G, c;
    __device__ void init(int M, int N, int G_, int c_) { nM = M / BM; nN = N / BM; nwg = nM * nN; G = G_; c = c_; }
    __device__ bool next(int i, Unit& u) const {
        const long L = (long)i * G + c; if (L >= nwg) return false;
        int wgid = (int)L; { const int q = nwg / NXCD, r = nwg % NXCD, xcd = wgid % NXCD, off = wgid / NXCD; wgid = (xcd < r ? xcd * (q + 1) : r * (q + 1) + (xcd - r) * q) + off; }
        const int nig = WGM * nN, gid = wgid / nig, fm = gid * WGM, gsz = (nM - fm) < WGM ? (nM - fm) : WGM;
        u.pm = fm + ((wgid % nig) % gsz); u.pn = (wgid % nig) / gsz; return true;
    }
};
__device__ __forceinline__ unsigned cvt_pk_bf16(float lo, float hi) { unsigned r; asm volatile("v_cvt_pk_bf16_f32 %0, %1, %2" : "=v"(r) : "v"(lo), "v"(hi)); return r; }
struct EpiBf16 {
    static constexpr bool PERM = true;
    bf16_t* O0; int ld0; int split; bf16_t* O1; int ld1;
    __device__ __forceinline__ void operator()(const f32x4 (&acc)[2][2][4][2], const Unit& u, int wr, int wc, int fr, int fq) const {
        const int row0 = u.pm * BM + wr * 64 + fr; int colt = u.pn * BM; bf16_t* base = O0; int ld = ld0;
        if (colt >= split) { base = O1; ld = ld1; colt -= split; }
        const int col0 = colt + wc * 32 + 8 * fq;
#pragma unroll
        for (int ai = 0; ai < 2; ++ai)
#pragma unroll
            for (int m = 0; m < 4; ++m) { bf16_t* rowp = base + (size_t)(row0 + ai * HALF + m * 16) * ld + col0;
#pragma unroll
                for (int bj = 0; bj < 2; ++bj) { const f32x4 v0 = acc[ai][bj][m][0], v1 = acc[ai][bj][m][1];
                    u32x4 w; w.x = cvt_pk_bf16(v0[0], v0[1]); w.y = cvt_pk_bf16(v0[2], v0[3]); w.z = cvt_pk_bf16(v1[0], v1[1]); w.w = cvt_pk_bf16(v1[2], v1[3]);
                    *(u32x4*)(rowp + bj * HALF) = w; } }
    }
};
template <class Epi, class Sched>
__device__ __forceinline__ void gemm_phase(LAS unsigned char* lds, const Gemm g, const Sched& S, const Epi& E, const int wv0) {
    int tid = opaque_tid(wv0);
    const int wid = __builtin_amdgcn_readfirstlane(tid >> 6), lane = tid & 63, wr = wid >> 2, wc = wid & 3, fr = lane & 15, fq = lane >> 4;
    const int K = g.K, nt = K / BK;
    unsigned voffA[2], voffB[2];
#pragma unroll
    for (int i = 0; i < 2; ++i) { int R, C; stage_rc(tid * 16 + i * 8192, R, C); const int Rb = Epi::PERM ? ((R & ~31) + perm32(R & 31)) : R;
        voffA[i] = (unsigned)(R * K + C) * 2u; voffB[i] = (unsigned)(Rb * K + C) * 2u; }
    const size_t kstep = (size_t)(BK * 2);
    const size_t hstep = (size_t)HALF * K * 2;
    const size_t tstep = 2 * hstep;
    const unsigned ldsw = (unsigned)wid * 1024u;
    const int aoff = lds_byte(wr * 64 + fr, fq * 8), boff = lds_byte(wc * 32 + fr, fq * 8);
#define PG8_SA(b, h) (((b) * 2 + (h)) * HTB)
#define PG8_SB(b, h) ((4 + (b) * 2 + (h)) * HTB)
#define PG8_STAGE(bufoff, gbase, voff) do { _Pragma("unroll") for (int _i = 0; _i < 2; ++_i) \
        __builtin_amdgcn_global_load_lds((const unsigned*)((const char*)(gbase) + (voff)[_i]), (LAS unsigned*)(lds + (bufoff) + ldsw + _i * 8192), 16, 0, 0); } while (0)
#define PG8_LDA(dst, b, h) do { _Pragma("unroll") for (int m = 0; m < 4; ++m) _Pragma("unroll") for (int k = 0; k < 2; ++k) dst[m][k] = *(const LAS bf16x8*)(lds + PG8_SA(b, h) + aoff + m * 2048 + k * 1024); } while (0)
#define PG8_LDB(dst, b, h) do { _Pragma("unroll") for (int n = 0; n < 2; ++n) _Pragma("unroll") for (int k = 0; k < 2; ++k) dst[n][k] = *(const LAS bf16x8*)(lds + PG8_SB(b, h) + boff + n * 2048 + k * 1024); } while (0)
#define PG8_MMA(ai, bj, At, Bt) do { __builtin_amdgcn_s_setprio(1); _Pragma("unroll") for (int m = 0; m < 4; ++m) _Pragma("unroll") for (int n = 0; n < 2; ++n) _Pragma("unroll") for (int k = 0; k < 2; ++k) \
        acc[ai][bj][m][n] = __builtin_amdgcn_mfma_f32_16x16x32_bf16(Bt[n][k], At[m][k], acc[ai][bj][m][n], 0, 0, 0); __builtin_amdgcn_s_setprio(0); } while (0)
#define PG8_WAIT_V(n) asm volatile("s_waitcnt vmcnt(" #n ")" ::: "memory")
#define PG8_WAIT_L(n) asm volatile("s_waitcnt lgkmcnt(" #n ")" ::: "memory")
#define PG8_BAR __builtin_amdgcn_s_barrier()
#define PG8_SCHED __builtin_amdgcn_sched_barrier(0)
    Unit cur, nxt; int ui = 0;
    if (!S.next(0, cur)) return;
    f32x4 acc[2][2][4][2];
#pragma unroll
    for (int a = 0; a < 2; ++a)
#pragma unroll
        for (int b = 0; b < 2; ++b)
#pragma unroll
            for (int m = 0; m < 4; ++m)
#pragma unroll
                for (int n = 0; n < 2; ++n) acc[a][b][m][n] = (f32x4){0.f, 0.f, 0.f, 0.f};
    bf16x8 At[4][2], B0[2][2], B1[2][2];
    const char* cA = (const char*)g.A + (size_t)cur.pm * tstep; const char* cB = (const char*)g.Bt + (size_t)cur.pn * tstep;
    PG8_STAGE(PG8_SB(0, 0), cB, voffB); PG8_STAGE(PG8_SA(0, 0), cA, voffA); PG8_STAGE(PG8_SB(0, 1), cB + hstep, voffB); PG8_STAGE(PG8_SA(0, 1), cA + hstep, voffA);
    if (wr == 1) PG8_BAR;
    PG8_WAIT_V(4); PG8_BAR;
    PG8_STAGE(PG8_SB(1, 0), cB + kstep, voffB); PG8_STAGE(PG8_SA(1, 0), cA + kstep, voffA); PG8_STAGE(PG8_SB(1, 1), cB + hstep + kstep, voffB);
    PG8_WAIT_V(6); PG8_BAR;
    for (;;) {
        const bool has_next = S.next(ui + 1, nxt);
        const char* nA = has_next ? (const char*)g.A + (size_t)nxt.pm * tstep : cA; const char* nB = has_next ? (const char*)g.Bt + (size_t)nxt.pn * tstep : cB;
        for (int t = 0; t < nt; t += 2) {
            const bool last = (t == nt - 2);
            const char* a1 = cA + (size_t)(t + 1) * kstep;
            const char* a2 = last ? nA : cA + (size_t)(t + 2) * kstep; const char* b2 = last ? nB : cB + (size_t)(t + 2) * kstep;
            const char* a3 = a2 + kstep; const char* b3 = b2 + kstep;
            PG8_LDB(B0, 0, 0); PG8_SCHED; PG8_LDA(At, 0, 0); PG8_STAGE(PG8_SA(1, 1), a1 + hstep, voffA);
            PG8_WAIT_L(8); PG8_BAR; PG8_WAIT_L(0); PG8_MMA(0, 0, At, B0); PG8_BAR; PG8_SCHED;
            PG8_LDB(B1, 0, 1); PG8_STAGE(PG8_SB(0, 0), b2, voffB);
            PG8_BAR; PG8_WAIT_L(0); PG8_MMA(0, 1, At, B1); PG8_BAR;
            PG8_LDA(At, 0, 1); PG8_STAGE(PG8_SA(0, 0), a2, voffA);
            PG8_BAR; PG8_WAIT_L(0); PG8_MMA(1, 0, At, B0); PG8_BAR; PG8_SCHED;
            PG8_STAGE(PG8_SB(0, 1), b2 + hstep, voffB);
            PG8_WAIT_V(6); PG8_BAR; PG8_MMA(1, 1, At, B1); PG8_BAR;
            PG8_LDB(B0, 1, 0); PG8_SCHED; PG8_LDA(At, 1, 0); PG8_STAGE(PG8_SA(0, 1), a2 + hstep, voffA);
            PG8_WAIT_L(8); PG8_BAR; PG8_WAIT_L(0); PG8_MMA(0, 0, At, B0); PG8_BAR; PG8_SCHED;
            PG8_LDB(B1, 1, 1); PG8_STAGE(PG8_SB(1, 0), b3, voffB);
            PG8_BAR; PG8_WAIT_L(0); PG8_MMA(0, 1, At, B1); PG8_BAR;
            PG8_LDA(At, 1, 1); PG8_STAGE(PG8_SA(1, 0), a3, voffA);
            PG8_BAR; PG8_WAIT_L(0); PG8_MMA(1, 0, At, B0); PG8_BAR; PG8_SCHED;
            PG8_STAGE(PG8_SB(1, 1), b3 + hstep, voffB);
            PG8_WAIT_V(6); PG8_BAR; PG8_MMA(1, 1, At, B1); PG8_BAR;
        }
        E(acc, cur, wr, wc, fr, fq);
        if (!has_next) break;
#pragma unroll
        for (int a = 0; a < 2; ++a)
#pragma unroll
            for (int b = 0; b < 2; ++b)
#pragma unroll
                for (int m = 0; m < 4; ++m)
#pragma unroll
                    for (int n = 0; n < 2; ++n) acc[a][b][m][n] = (f32x4){0.f, 0.f, 0.f, 0.f};
        cur = nxt; cA = nA; cB = nB; ++ui;
    }
    PG8_WAIT_V(0);
    if (wr == 0) PG8_BAR;
    PG8_BAR;
#undef PG8_SA
#undef PG8_SB
#undef PG8_STAGE
#undef PG8_LDA
#undef PG8_LDB
#undef PG8_MMA
#undef PG8_WAIT_V
#undef PG8_WAIT_L
#undef PG8_BAR
#undef PG8_SCHED
}
}


#define XB_TMO      128
#define XB_XCNT(j)  (256  + 64 * (j))
#define XB_XSUB(j)  (1280 + 64 * (j))
#define XB_XGEN(j)  (2304 + 64 * (j))
#define XB_TOP      3328
#define XB_TOPGEN   3392
#define XCD_BAR_WORDS 3456
#define XB_SPIN_CAP (1u << 18)
__device__ __forceinline__ unsigned xb_ld(unsigned* p)              { return __hip_atomic_load(p, __ATOMIC_RELAXED, __HIP_MEMORY_SCOPE_AGENT); }
__device__ __forceinline__ unsigned xb_add(unsigned* p, unsigned v) { return __hip_atomic_fetch_add(p, v, __ATOMIC_RELAXED, __HIP_MEMORY_SCOPE_AGENT); }
__device__ __forceinline__ unsigned xb_xcc_id() { return (unsigned)__builtin_amdgcn_s_getreg((3 << 11) | 20) & 0xFu; }
#define XB_SPIN(cond, bar) do { unsigned _sp = 0; while (cond) { __builtin_amdgcn_s_sleep(1); \
    if ((++_sp & 255u) == 0u) { if (xb_ld(&(bar)[XB_TMO])) break; if (_sp > XB_SPIN_CAP) { atomicAdd(&(bar)[XB_TMO], 1u); break; } } } } while (0)
struct XcdBarrier { unsigned* bar; unsigned x; volatile LAS unsigned* st; };
__device__ __forceinline__ XcdBarrier xcd_barrier_post(unsigned* bar, volatile LAS unsigned* st) {
    XcdBarrier b; b.bar = bar; b.x = xb_xcc_id(); b.st = st;
    if (threadIdx.x == 0) (void)xb_add(&bar[XB_XCNT(b.x)], 1u);
    return b;
}
__device__ __forceinline__ void xcd_barrier_complete(unsigned* bar, unsigned x, unsigned& nloc, unsigned& nx) {
    const unsigned G = gridDim.x * gridDim.y * gridDim.z;
    unsigned sum, cnt, mine, sp = 0u;
    for (;;) {
        sum = 0u; cnt = 0u; mine = 0u;
#pragma unroll
        for (unsigned j = 0; j < 16; ++j) { const unsigned c = xb_ld(&bar[XB_XCNT(j)]); sum += c; cnt += (c > 0u) ? 1u : 0u; mine = (j == x) ? c : mine; }
        if (sum == G) break;
        __builtin_amdgcn_s_sleep(1);
        if ((++sp & 255u) == 0u) { if (xb_ld(&bar[XB_TMO])) break; if (sp > XB_SPIN_CAP) { atomicAdd(&bar[XB_TMO], 1u); break; } }
    }
    nloc = mine > 0u ? mine : 1u; nx = cnt > 0u ? cnt : 1u;
}
__device__ __forceinline__ void xcd_barrier(const XcdBarrier& b, const int wv0) {
    asm volatile("s_waitcnt vmcnt(0)" ::: "memory");
    __syncthreads();
    if (opaque_tid(wv0) == 0) {
        unsigned* bar = b.bar;
        __builtin_amdgcn_s_waitcnt(0);
        unsigned nloc = b.st[0], nx = b.st[1];
        if (nloc == 0u) { xcd_barrier_complete(bar, b.x, nloc, nx); b.st[0] = nloc; b.st[1] = nx; }
        const unsigned old = xb_add(&bar[XB_XSUB(b.x)], 1u);
        const unsigned gen = old / nloc;
        if (old + 1u == (gen + 1u) * nloc) {
            __builtin_amdgcn_fence(__ATOMIC_RELEASE, "agent");
            asm volatile("s_waitcnt vmcnt(0)" ::: "memory");
            const unsigned og = xb_add(&bar[XB_TOP], 1u);
            const unsigned tg = og / nx;
            if (og + 1u == (tg + 1u) * nx) xb_add(&bar[XB_TOPGEN], 1u);
            else XB_SPIN(xb_ld(&bar[XB_TOPGEN]) == tg, bar);
            __builtin_amdgcn_fence(__ATOMIC_ACQUIRE, "agent");
            xb_add(&bar[XB_XGEN(b.x)], 1u);
            asm volatile("s_waitcnt vmcnt(0)" ::: "memory");
        } else {
            XB_SPIN(xb_ld(&bar[XB_XGEN(b.x)]) == gen, bar);
            __builtin_amdgcn_fence(__ATOMIC_ACQUIRE, "agent");
            asm volatile("s_waitcnt vmcnt(0)" ::: "memory");
        }
    }
    __syncthreads();
}

struct Frame {
    LAS unsigned char* lds;
    int vcu, G, wv;
    const float* const* in; float* out; unsigned char* ws;
    __device__ __forceinline__ float* MOD() const { return (float*)(ws + WS_MOD); }
    __device__ __forceinline__ float* ROPE() const { return (float*)(ws + WS_ROPE); }
    __device__ __forceinline__ float* BA() const { return (float*)(ws + WS_BA); }
    __device__ __forceinline__ float* LAG() const { return (float*)(ws + WS_LAG); }
    __device__ __forceinline__ bf16_t* W1O() const { return (bf16_t*)(ws + WS_W1O); }
    __device__ __forceinline__ bf16_t* U0() const { return (bf16_t*)(ws + WS_RA); }
    __device__ __forceinline__ bf16_t* QKV1() const { return (bf16_t*)(ws + WS_RA); }
    __device__ __forceinline__ bf16_t* Z1() const { return (bf16_t*)(ws + WS_RA + (size_t)MT * 3072 * 2); }
    __device__ __forceinline__ bf16_t* Y1() const { return (bf16_t*)(ws + WS_RA); }
    __device__ __forceinline__ bf16_t* XN() const { return (bf16_t*)(ws + WS_RB + RB_XN); }
    __device__ __forceinline__ bf16_t* Y0() const { return (bf16_t*)(ws + WS_RB + RB_Y0); }
    __device__ __forceinline__ bf16_t* YO() const { return (bf16_t*)(ws + WS_RB + RB_YO); }
    __device__ __forceinline__ bf16_t* W0I() const { return (bf16_t*)(ws + WS_RB + RB_W0I); }
    __device__ __forceinline__ bf16_t* W0O() const { return (bf16_t*)(ws + WS_RB + RB_W0O); }
    __device__ __forceinline__ bf16_t* W1I() const { return (bf16_t*)(ws + WS_RB + RB_W1I); }
    __device__ __forceinline__ bf16_t* QKVC() const { return (bf16_t*)(ws + WS_RB); }
};

#define PHASE_IDS() int tid = opaque_tid(F.wv); const int lane = tid & 63, wave = __builtin_amdgcn_readfirstlane(tid >> 6); (void)lane; (void)wave
__device__ __forceinline__ void p0_transpose_item(const float* W, int ldw, int nblk, int K, bf16_t* WT, LAS float* scr, int item, int lane) {
    const int kb = item / nblk, nb = item % nblk, k0 = 64 * kb, n0 = 32 * nb;
#pragma unroll 8
    for (int i = 0; i < 32; ++i) { const int kk = 2 * i + (lane >> 5); scr[kk * 33 + (lane & 31)] = W[(size_t)(k0 + kk) * ldw + n0 + (lane & 31)]; }
    asm volatile("s_waitcnt lgkmcnt(0)" ::: "memory");
    const int c = lane & 7;
#pragma unroll
    for (int j = 0; j < 4; ++j) { const int n = (lane >> 3) + 8 * j; const LAS float* s = scr + (8 * c) * 33 + n;
        u32x4 o; o.x = pk2(s[0 * 33], s[1 * 33]); o.y = pk2(s[2 * 33], s[3 * 33]); o.z = pk2(s[4 * 33], s[5 * 33]); o.w = pk2(s[6 * 33], s[7 * 33]);
        *(u32x4*)(WT + (size_t)(n0 + n) * K + k0 + 8 * c) = o; }
    asm volatile("s_waitcnt lgkmcnt(0)" ::: "memory");
}
__device__ __forceinline__ void phase_prologue(Frame& F) {
    PHASE_IDS();
    const int gw = F.vcu * 8 + wave, NGW = F.G * 8;
    {
        LAS float* scr = (LAS float*)(F.lds + wave * 16384);
        constexpr int I0 = 16 * (EV_IN / 32), I1 = 16 * 32, I2 = 16 * (OD_MAIN / 32), I3 = 16 * 32;
        for (int it = gw; it < I0 + I1 + I2 + I3; it += NGW) {
            int r = it;
            if (r < I0) { p0_transpose_item(F.in[14], EV_IN, EV_IN / 32, D, F.W0I(), scr, r, lane); continue; } r -= I0;
            if (r < I1) { p0_transpose_item(F.in[23], D, 32, D, F.W0O(), scr, r, lane); continue; } r -= I1;
            if (r < I2) { p0_transpose_item(F.in[28], OD_IN, OD_MAIN / 32, D, F.W1I(), scr, r, lane); continue; } r -= I2;
            p0_transpose_item(F.in[33], D, 32, D, F.W1O(), scr, r, lane);
        }
    }
    {
        const double inv[8] = {1.0, 0.19392274474868576, 0.03760603093086393, 0.007292664737217109, 0.001414213562373095, 0.0002742481756762073, 5.318295896944988e-05, 1.031338537721246e-05};
        for (int idx = F.vcu * 512 + tid; idx < 4112 * 8; idx += F.G * 512) {
            const int pos = idx >> 3, i = idx & 7;
            double iv = inv[0];
#pragma unroll
            for (int q = 1; q < 8; ++q) iv = (i == q) ? inv[q] : iv;
            const double ang = (double)pos * iv;
            const double n = __builtin_rint(ang * 0.15915494309189535);
            const float r = (float)__builtin_fma(-n, 6.283185307179586, ang);
            F.ROPE()[pos * 16 + i] = __cosf(r); F.ROPE()[pos * 16 + 8 + i] = __sinf(r);
        }
    }
    {
        bf16_t* LGW = (bf16_t*)(F.ws + WS_LGW);
        for (int idx = F.vcu * 512 + tid; idx < 8 * 2 * 64 * 64; idx += F.G * 512) { const int k = idx & 63, n = (idx >> 6) & 63, gate = (idx >> 12) & 1, hh = idx >> 13;
            LGW[idx] = (bf16_t)f2bf((gate ? F.in[19] : F.in[17])[(hh * 64 + k) * 64 + n]); }
    }
    __syncthreads();
    for (int bt = F.vcu; bt < 96; bt += F.G) {
        LAS float* tab = (LAS float*)F.lds;
        for (int idx = tid; idx < 24 * 1024; idx += 512) { const int s = idx >> 10, k = idx & 1023;
            const float c = s < BP ? F.in[8][s * D + k] : F.in[9][(s - BP) * D + k]; tab[k * 24 + s] = siluf_(c); }
        __syncthreads();
        const int L = bt / 48, n0 = (bt % 48) * 64;
        const float* mw = (L == 0 ? F.in[10] : F.in[24]) + n0 + lane;
        float acc[24];
#pragma unroll
        for (int r = 0; r < 24; ++r) acc[r] = 0.f;
        for (int k = wave * 128; k < wave * 128 + 128; ++k) {
            const float w = mw[(size_t)k * 3072];
            const LAS f32x4* tp = (const LAS f32x4*)(tab + k * 24);
#pragma unroll
            for (int q = 0; q < 6; ++q) { const f32x4 t4 = tp[q]; acc[4 * q] += t4[0] * w; acc[4 * q + 1] += t4[1] * w; acc[4 * q + 2] += t4[2] * w; acc[4 * q + 3] += t4[3] * w; }
        }
        __syncthreads();
        LAS float* red = (LAS float*)F.lds;
#pragma unroll
        for (int r = 0; r < 24; ++r) red[(wave * 24 + r) * 64 + lane] = acc[r];
        __syncthreads();
        const float* mb = (L == 0 ? F.in[11] : F.in[25]);
        for (int idx = tid; idx < 24 * 64; idx += 512) { const int r = idx >> 6, l = idx & 63; float s = 0.f;
#pragma unroll
            for (int w = 0; w < 8; ++w) s += red[(w * 24 + r) * 64 + l];
            F.MOD()[((size_t)L * 24 + r) * 3072 + n0 + l] = s + mb[n0 + l]; }
        __syncthreads();
    }
}

__device__ __forceinline__ void phase_prenorm0(Frame& F) {
    PHASE_IDS();
    const int gw = F.vcu * 8 + wave, NGW = F.G * 8;
    for (int m = gw; m < MT; m += NGW) {
        int s, t; tok_info(m, s, t);
        const float* xrow = m < MP ? F.in[0] + (size_t)m * D : F.in[1] + (size_t)(m - MP) * D;
        const float* modr = F.MOD() + (size_t)s * 3072;
        f32x4 v[4]; float ss = 0.f;
#pragma unroll
        for (int j = 0; j < 4; ++j) { v[j] = *(const f32x4*)(xrow + 4 * lane + 256 * j); ss += (v[j][0] * v[j][0] + v[j][1] * v[j][1]) + (v[j][2] * v[j][2] + v[j][3] * v[j][3]); }
        const float r = rsqrtf(wave_sum(ss, lane) * (1.f / D) + EPS);
#pragma unroll
        for (int j = 0; j < 4; ++j) { const int c = 4 * lane + 256 * j;
            const f32x4 g = *(const f32x4*)(F.in[12] + c), sh = *(const f32x4*)(modr + c), sc = *(const f32x4*)(modr + 1024 + c);
            f32x4 o;
#pragma unroll
            for (int e = 0; e < 4; ++e) o[e] = v[j][e] * r * g[e] * (1.f + sc[e]) + sh[e];
            u32x2 w; w.x = pk2(o[0], o[1]); w.y = pk2(o[2], o[3]); *(u32x2*)(F.XN() + (size_t)m * D + c) = w; }
    }
}

__device__ __forceinline__ void phase_rope(Frame& F) {
    PHASE_IDS();
    const int gt = F.vcu * 512 + tid, NT = F.G * 512;
    for (int idx = gt; idx < MT * 80; idx += NT) {
        const int m = idx / 80, r = idx % 80, slot = r >> 3, i = r & 7;
        int s, t; tok_info(m, s, t);
        const int pos = s < BP ? t : TP + t;
        const int col = slot < 8 ? C_Q + slot * 64 : C_K + (slot - 8) * 64;
        bf16_t* p = F.U0() + (size_t)m * EV_IN + col;
        const float x1 = bf2f(p[i]), x2 = bf2f(p[8 + i]), c = F.ROPE()[pos * 16 + i], sn = F.ROPE()[pos * 16 + 8 + i];
        const float o1 = x1 * c - x2 * sn, o2 = x2 * c + x1 * sn;
        p[i] = (bf16_t)f2bf(o1); p[8 + i] = (bf16_t)f2bf(o2);
        if (slot >= 8) { const int kv = slot - 8;
            if (s >= BP) { float* o = F.out + O_KS + ((size_t)((s - BP) * TS + t) * 2 + kv) * 64; o[i] = o1; o[8 + i] = o2; }
            else if (t >= TP - 128) { float* o = F.out + O_KP + ((size_t)(s * 128 + (t - (TP - 128))) * 2 + kv) * 64; o[i] = o1; o[8 + i] = o2; } }
    }
    for (int idx = gt; idx < 1280 * 224; idx += NT) {
        const int tk = idx / 224, e = idx % 224;
        int s, t, m; if (tk < 1024) { s = tk >> 7; t = TP - 128 + (tk & 127); m = s * TP + t; } else { s = BP + ((tk - 1024) >> 4); t = (tk - 1024) & 15; m = MP + (tk - 1024); }
        const bool isv = e >= 96; const int e2 = isv ? e - 96 : e; const int kv = isv ? (e2 >> 6) : (e2 / 48), d = isv ? (e2 & 63) : 16 + (e2 % 48);
        const float val = bf2f(F.U0()[(size_t)m * EV_IN + (isv ? C_V : C_K) + kv * 64 + d]);
        const size_t ob = s >= BP ? (isv ? O_VS : O_KS) + ((size_t)((s - BP) * TS + t) * 2 + kv) * 64 : (isv ? O_VP : O_KP) + ((size_t)(s * 128 + (t - (TP - 128))) * 2 + kv) * 64;
        F.out[ob + d] = val;
    }
}


__device__ __forceinline__ void phase_mid_rowwise(Frame& F) {
    PHASE_IDS();
    LAS float* baw = (LAS float*)F.lds;
    for (int idx = tid; idx < 16 * 1024; idx += 512) { const int j = idx & 15, k = idx >> 4; baw[j * 1024 + k] = F.in[28][(size_t)k * OD_IN + OD_MAIN + j]; }
    __syncthreads();
    const int gw = F.vcu * 8 + wave, NGW = F.G * 8;
    for (int m = gw; m < MT; m += NGW) {
        int s, t; tok_info(m, s, t);
        const float* xrow = m < MP ? F.in[0] + (size_t)m * D : F.in[1] + (size_t)(m - MP) * D;
        const float* mod0 = F.MOD() + (size_t)s * 3072; const float* mod1 = F.MOD() + (size_t)(24 + s) * 3072;
        f32x4 y[4]; float ss = 0.f;
#pragma unroll
        for (int j = 0; j < 4; ++j) { const u32x2 w = *(const u32x2*)(F.YO() + (size_t)m * D + 4 * lane + 256 * j); y[j] = (f32x4){lo16(w.x), hi16(w.x), lo16(w.y), hi16(w.y)};
            ss += (y[j][0] * y[j][0] + y[j][1] * y[j][1]) + (y[j][2] * y[j][2] + y[j][3] * y[j][3]); }
        const float r1 = rsqrtf(wave_sum(ss, lane) * (1.f / D) + EPS);
        f32x4 x1[4]; float s2 = 0.f;
#pragma unroll
        for (int j = 0; j < 4; ++j) { const int c = 4 * lane + 256 * j;
            const f32x4 xv = *(const f32x4*)(xrow + c), g = *(const f32x4*)(F.in[13] + c), gt = *(const f32x4*)(mod0 + 2048 + c);
#pragma unroll
            for (int e = 0; e < 4; ++e) x1[j][e] = xv[e] + gt[e] * (y[j][e] * r1 * g[e]);
            *(f32x4*)(F.out + O_Y + (size_t)m * D + c) = x1[j];
            s2 += (x1[j][0] * x1[j][0] + x1[j][1] * x1[j][1]) + (x1[j][2] * x1[j][2] + x1[j][3] * x1[j][3]); }
        const float r2 = rsqrtf(wave_sum(s2, lane) * (1.f / D) + EPS);
        f32x4 hm[4];
#pragma unroll
        for (int j = 0; j < 4; ++j) { const int c = 4 * lane + 256 * j;
            const f32x4 g = *(const f32x4*)(F.in[26] + c), sh = *(const f32x4*)(mod1 + c), sc = *(const f32x4*)(mod1 + 1024 + c);
#pragma unroll
            for (int e = 0; e < 4; ++e) hm[j][e] = x1[j][e] * r2 * g[e] * (1.f + sc[e]) + sh[e];
            u32x2 w; w.x = pk2(hm[j][0], hm[j][1]); w.y = pk2(hm[j][2], hm[j][3]); *(u32x2*)(F.XN() + (size_t)m * D + c) = w; }
        float mine = 0.f;
#pragma unroll 1
        for (int q = 0; q < 16; ++q) { float p = 0.f;
#pragma unroll
            for (int j = 0; j < 4; ++j) { const f32x4 w = *(const LAS f32x4*)(baw + q * 1024 + 256 * j + 4 * lane); p += (hm[j][0] * w[0] + hm[j][1] * w[1]) + (hm[j][2] * w[2] + hm[j][3] * w[3]); }
            p = wave_sum(p, lane); mine = (lane == q) ? p : mine; }
        if (lane < 16) F.BA()[(size_t)m * 16 + lane] = mine;
    }
}


typedef float f32x16 __attribute__((ext_vector_type(16)));
typedef __bf16 bf16x2_t __attribute__((ext_vector_type(2)));
constexpr int GS_WF = 0, GS_QF = 16384, GS_KF = 32768, GS_PF = 49152, GS_UF = 57344, GS_BYTES = 73728;
constexpr size_t WS_DEC = 11 * MiB;
__device__ __forceinline__ unsigned cvt2(float a, float b) { f32x2 v = {a, b}; bf16x2_t r = __builtin_convertvector(v, bf16x2_t); return __builtin_bit_cast(unsigned, r); }
__device__ __forceinline__ int krow(int s, int h, int j) { return 16 * s + 8 * (j >> 2) + 4 * h + (j & 3); }
#define MFMA32(a, b, c) __builtin_amdgcn_mfma_f32_32x32x16_bf16((a), (b), (c), 0, 0, 0)

constexpr int G1_QS = 0, G1_KS = 17408, G1_VS = 34816, G1_AS = 52224, G1_PS = 69632, G1_WS = 78848, G1_CW = 96256, G1_VEC = 102400;
__device__ __forceinline__ void phase_gdn_g1(Frame& F) {
    int tid = opaque_tid(F.wv);
    const int lane = tid & 63, wave = __builtin_amdgcn_readfirstlane(tid >> 6);
    LAS unsigned char* L = F.lds;
    LAS float* cw_s = (LAS float*)(L + G1_CW);
    LAS float* beta_s = (LAS float*)(L + G1_VEC); LAS float* gcum_s = beta_s + 64; LAS float* eg_s = beta_s + 128; LAS float* ek_s = beta_s + 192;
    float* DEC = (float*)(F.ws + WS_DEC);
    for (int task = F.vcu; task < 4224; task += F.G) {
        int s, c, h; if (task < 4096) { s = task >> 9; c = (task >> 3) & 63; h = task & 7; } else { s = BP + ((task - 4096) >> 3); c = 0; h = task & 7; }
        const int nvalid = s < BP ? 64 : TS, t0 = c * 64, base = seq_base(s), T = seq_len(s);
        const int sidx = task < 4096 ? ((s * 8 + h) * 64 + c) : task;
        unsigned char* blk = F.ws + WS_RB + (size_t)sidx * GS_BYTES;
        for (int i = tid; i < 4 * 384; i += 512) { const int jj = i / 384, cc = i % 384; cw_s[i] = F.in[29][(size_t)jj * 3072 + (cc >> 7) * 1024 + h * 128 + (cc & 127)]; }
        if (tid < 64) {
            const bool ok = tid < nvalid; float beta = 0.f, g = 0.f;
            if (ok) { const float* ba = F.BA() + (size_t)(base + t0 + tid) * 16; beta = sigmoidf_(ba[h]); g = -__expf(F.in[30][h]) * softplusf_(ba[8 + h] + F.in[31][h]); }
            float x = g;
#pragma unroll
            for (int o = 1; o < 64; o <<= 1) { const float y = shfl_idx(x, lane >= o ? lane - o : lane); if (lane >= o) x += y; }
            const float gl = shfl_idx(x, 63);
            beta_s[tid] = beta; gcum_s[tid] = x; eg_s[tid] = __expf(x); ek_s[tid] = ok ? __expf(gl - x) : 0.f;
            if (tid == 0) DEC[task < 4096 ? ((s * 8 + h) * 64 + c) : task] = __expf(gl);
        }
        __syncthreads();
        {
            int t1 = tid; asm volatile("" : "+v"(t1));
            const int r = t1 >> 3, j = t1 & 7, t = t0 + r; const bool ok = r < nvalid;
#pragma unroll 1
            for (int p = 0; p < 3; ++p) {
                float acc[16];
#pragma unroll
                for (int e = 0; e < 16; ++e) acc[e] = 0.f;
                float cur[16];
#pragma unroll
                for (int e = 0; e < 16; ++e) cur[e] = 0.f;
                if (ok) {
                    const int cb = p * 1024 + h * 128 + j * 16;
#pragma unroll
                    for (int jj = 0; jj < 4; ++jj) {
                        const int tt = t - 3 + jj; float x[16];
                        if (tt >= 0) { const u32x4* src = (const u32x4*)(F.QKV1() + (size_t)(base + tt) * 3072 + cb); const u32x4 a = src[0], b = src[1];
#pragma unroll
                            for (int e = 0; e < 4; ++e) { x[2 * e] = lo16(a[e]); x[2 * e + 1] = hi16(a[e]); x[8 + 2 * e] = lo16(b[e]); x[8 + 2 * e + 1] = hi16(b[e]); } }
                        else if (s >= BP) { const f32x4* src = (const f32x4*)(F.in[6] + ((size_t)(s - BP) * 3 + (tt + 3)) * 3072 + cb);
#pragma unroll
                            for (int q = 0; q < 4; ++q) { const f32x4 a = src[q]; x[4 * q] = a[0]; x[4 * q + 1] = a[1]; x[4 * q + 2] = a[2]; x[4 * q + 3] = a[3]; } }
                        else {
#pragma unroll
                            for (int e = 0; e < 16; ++e) x[e] = 0.f; }
                        const LAS f32x4* wp = (const LAS f32x4*)(cw_s + jj * 384 + p * 128 + j * 16);
#pragma unroll
                        for (int q = 0; q < 4; ++q) { const f32x4 w4 = wp[q]; acc[4 * q] += w4[0] * x[4 * q]; acc[4 * q + 1] += w4[1] * x[4 * q + 1]; acc[4 * q + 2] += w4[2] * x[4 * q + 2]; acc[4 * q + 3] += w4[3] * x[4 * q + 3]; }
                        if (jj == 3) {
#pragma unroll
                            for (int e = 0; e < 16; ++e) cur[e] = x[e]; }
                    }
                    if (t >= T - 3) {
                        float* o = (s < BP ? F.out + O_GCP + ((size_t)s * 3 + (t - (T - 3))) * 3072 : F.out + O_GCS + ((size_t)(s - BP) * 3 + (t - (T - 3))) * 3072) + cb;
#pragma unroll
                        for (int q = 0; q < 4; ++q) *(f32x4*)(o + 4 * q) = (f32x4){cur[4 * q], cur[4 * q + 1], cur[4 * q + 2], cur[4 * q + 3]};
                    }
                }
                float ss = 0.f;
#pragma unroll
                for (int e = 0; e < 16; ++e) { acc[e] = siluf_(acc[e]); ss += acc[e] * acc[e]; }
                if (p < 2) { ss += shfl_xor_l(ss, 1, lane); ss += shfl_xor_l(ss, 2, lane); ss += shfl_xor_l(ss, 4, lane);
                    float sc = rsqrtf(ss + EPS); if (p == 0) sc *= 0.08838834764831845f;
#pragma unroll
                    for (int e = 0; e < 16; ++e) acc[e] *= sc; }
                u32x4 w0, w1;
#pragma unroll
                for (int e = 0; e < 4; ++e) { w0[e] = ok ? cvt2(acc[2 * e], acc[2 * e + 1]) : 0u; w1[e] = ok ? cvt2(acc[8 + 2 * e], acc[8 + 2 * e + 1]) : 0u; }
                LAS u32x4* dst = (LAS u32x4*)(L + (p == 0 ? G1_QS : p == 1 ? G1_KS : G1_VS) + r * 272 + j * 32);
                dst[0] = w0; dst[1] = w1;
            }
        }
        __syncthreads();
        {
            int l2 = lane; asm volatile("" : "+v"(l2));
            const int which = wave >> 2, ti = (wave >> 1) & 1, tj = wave & 1, r = l2 & 31, hh = l2 >> 5;
            f32x16 acc;
#pragma unroll
            for (int e = 0; e < 16; ++e) acc[e] = 0.f;
            if (!(ti == 0 && tj == 1)) {
                const LAS unsigned char* ap = L + (which ? G1_QS : G1_KS) + (32 * ti + r) * 272 + hh * 16;
                const LAS unsigned char* bp = L + G1_KS + (32 * tj + r) * 272 + hh * 16;
#pragma unroll
                for (int ks = 0; ks < 8; ++ks) { const bf16x8 a = *(const LAS bf16x8*)(ap + ks * 32), b = *(const LAS bf16x8*)(bp + ks * 32); acc = MFMA32(a, b, acc); }
            }
            const int jc = 32 * tj + r; const float gj = gcum_s[jc];
#pragma unroll
            for (int e = 0; e < 16; ++e) {
                const int i = 32 * ti + (e & 3) + 8 * (e >> 2) + 4 * hh; const float dg = gcum_s[i] - gj;
                if (which == 0) { const float f = (i > jc) ? __expf(dg) * beta_s[i] : 0.f; *(LAS float*)(L + G1_AS + i * 272 + jc * 4) = acc[e] * f; }
                else { const float f = (i >= jc) ? __expf(dg) : 0.f; *(LAS bf16_t*)(L + G1_PS + i * 144 + jc * 2) = (bf16_t)(cvt2(acc[e] * f, 0.f) & 0xffffu); }
            }
        }
        __syncthreads();
        if (tid < 256) {
            int t3 = tid; asm volatile("" : "+v"(t3));
            const bool isw = t3 < 128; const int d = t3 & 127;
            float X[64];
#pragma unroll
            for (int i = 0; i < 64; ++i) { const float raw = bf2f(*(const LAS bf16_t*)(L + (isw ? G1_KS : G1_VS) + i * 272 + d * 2)); X[i] = raw * beta_s[i] * (isw ? eg_s[i] : 1.0f); }
            unsigned abase = (unsigned)(size_t)(L + G1_AS);
#pragma unroll
            for (int i = 1; i < 64; ++i) {
                unsigned ra = abase + i * 272;
                if (i >= 3) asm volatile("" : "+v"(ra) : "v"(X[i - 2]));
                float a = X[i];
#pragma unroll
                for (int j4 = 0; j4 <= (i - 1) / 4; ++j4) { const f32x4 a4 = *(const LAS f32x4*)(ra + j4 * 16);
                    a -= a4[0] * X[4 * j4]; a -= a4[1] * X[4 * j4 + 1]; a -= a4[2] * X[4 * j4 + 2]; a -= a4[3] * X[4 * j4 + 3]; }
                X[i] = a;
            }
            if (isw) {
#pragma unroll
                for (int i = 0; i < 64; ++i) *(LAS bf16_t*)(L + G1_WS + i * 272 + d * 2) = (bf16_t)(cvt2(-X[i], 0.f) & 0xffffu);
            } else {
                const int ws = d >> 5, cc = d & 31;
#pragma unroll
                for (int rt = 0; rt < 2; ++rt)
#pragma unroll
                    for (int hh = 0; hh < 2; ++hh) { u32x4 o0, o1;
#pragma unroll
                        for (int q = 0; q < 2; ++q) { const int i0 = 32 * rt + 8 * q + 4 * hh, i1 = 32 * rt + 8 * (q + 2) + 4 * hh;
                            o0[2 * q] = cvt2(X[i0], X[i0 + 1]); o0[2 * q + 1] = cvt2(X[i0 + 2], X[i0 + 3]); o1[2 * q] = cvt2(X[i1], X[i1 + 1]); o1[2 * q + 1] = cvt2(X[i1 + 2], X[i1 + 3]); }
                        u32x4* dst = (u32x4*)(blk + GS_UF + (size_t)(((ws * 2 + rt) * 64) + cc + 32 * hh) * 32); dst[0] = o0; dst[1] = o1; }
            }
        } else {
            int l3 = lane; asm volatile("" : "+v"(l3));
            const int wv = wave - 4, r = l3 & 31, hh = l3 >> 5;
            {   const int rt4 = wv;
#pragma unroll
                for (int kt2 = 0; kt2 < 2; ++kt2)
#pragma unroll
                    for (int ss = 0; ss < 2; ++ss) { float v[8];
#pragma unroll
                        for (int j = 0; j < 8; ++j) { const int tok = 32 * kt2 + krow(ss, hh, j); v[j] = bf2f(*(const LAS bf16_t*)(L + G1_KS + tok * 272 + (32 * rt4 + r) * 2)) * ek_s[tok]; }
                        u32x4 o; o[0] = cvt2(v[0], v[1]); o[1] = cvt2(v[2], v[3]); o[2] = cvt2(v[4], v[5]); o[3] = cvt2(v[6], v[7]);
                        *(u32x4*)(blk + GS_KF + ((rt4 * 2 + kt2) * 2 + ss) * 1024 + lane * 16) = o; } }
            {   const int kt = wv;
#pragma unroll
                for (int rt = 0; rt < 2; ++rt)
#pragma unroll
                    for (int ss = 0; ss < 2; ++ss) { const int i = 32 * rt + r; const float sc = eg_s[i];
                        const u32x2 lo = *(const LAS u32x2*)(L + G1_QS + i * 272 + (32 * kt + 16 * ss + 4 * hh) * 2), hi = *(const LAS u32x2*)(L + G1_QS + i * 272 + (32 * kt + 16 * ss + 8 + 4 * hh) * 2);
                        u32x4 o; o[0] = cvt2(lo16(lo[0]) * sc, hi16(lo[0]) * sc); o[1] = cvt2(lo16(lo[1]) * sc, hi16(lo[1]) * sc); o[2] = cvt2(lo16(hi[0]) * sc, hi16(hi[0]) * sc); o[3] = cvt2(lo16(hi[1]) * sc, hi16(hi[1]) * sc);
                        *(u32x4*)(blk + GS_QF + ((rt * 4 + kt) * 2 + ss) * 1024 + lane * 16) = o; } }
            {   const int rt = wv >> 1, kt2 = wv & 1;
#pragma unroll
                for (int ss = 0; ss < 2; ++ss) { const int i = 32 * rt + r;
                    const u32x2 lo = *(const LAS u32x2*)(L + G1_PS + i * 144 + (32 * kt2 + 16 * ss + 4 * hh) * 2), hi = *(const LAS u32x2*)(L + G1_PS + i * 144 + (32 * kt2 + 16 * ss + 8 + 4 * hh) * 2);
                    u32x4 o; o[0] = lo[0]; o[1] = lo[1]; o[2] = hi[0]; o[3] = hi[1];
                    *(u32x4*)(blk + GS_PF + ((rt * 2 + kt2) * 2 + ss) * 1024 + lane * 16) = o; } }
        }
        __syncthreads();
        {
            int l4 = lane; asm volatile("" : "+v"(l4));
            const int kt = wave & 3, rt = wave >> 2, r = l4 & 31, hh = l4 >> 5, i = 32 * rt + r;
#pragma unroll
            for (int ss = 0; ss < 2; ++ss) {
                const u32x2 lo = *(const LAS u32x2*)(L + G1_WS + i * 272 + (32 * kt + 16 * ss + 4 * hh) * 2), hi = *(const LAS u32x2*)(L + G1_WS + i * 272 + (32 * kt + 16 * ss + 8 + 4 * hh) * 2);
                u32x4 o; o[0] = lo[0]; o[1] = lo[1]; o[2] = hi[0]; o[3] = hi[1];
                *(u32x4*)(blk + GS_WF + ((rt * 4 + kt) * 2 + ss) * 1024 + lane * 16) = o; }
        }
        __syncthreads();
    }
}

constexpr int G2_FB = GS_BYTES, G2_OSTRIDE = 528, G2_HN = 2 * G2_FB, G2_DEC = G2_HN + 512;
__device__ __forceinline__ bf16x8 pack8(const f32x16& x, const int s) {
    u32x4 p; p[0] = cvt2(x[8 * s], x[8 * s + 1]); p[1] = cvt2(x[8 * s + 2], x[8 * s + 3]); p[2] = cvt2(x[8 * s + 4], x[8 * s + 5]); p[3] = cvt2(x[8 * s + 6], x[8 * s + 7]);
    return __builtin_bit_cast(bf16x8, p);
}
#define LDS_BARRIER() do { asm volatile("s_waitcnt lgkmcnt(0)" ::: "memory"); __builtin_amdgcn_s_barrier(); asm volatile("" ::: "memory"); } while (0)
__device__ __forceinline__ void g2_load_set(u32x4 (&pre)[18], const unsigned char* blk, int lt) {
    const u32x4* src = (const u32x4*)blk;
#pragma unroll
    for (int i = 0; i < 18; ++i) pre[i] = src[i * 256 + lt];
}
__device__ __forceinline__ void g2_store_set(const u32x4 (&pre)[18], LAS unsigned char* dst, int lt) {
#pragma unroll
    for (int i = 0; i < 18; ++i) *(LAS u32x4*)(dst + (size_t)(i * 256 + lt) * 16) = pre[i];
}
#define G2_FRAG(off) (*(const LAS bf16x8*)(B + (off)))
#define G2_SCHED() __builtin_amdgcn_sched_barrier(0)
__device__ __forceinline__ void g2_mfma_step(f32x16& S0, f32x16& S1, f32x16& S2, f32x16& S3, LAS unsigned char* Bimg, const float dec, int ws, int lane, int cc, int hh) {
    const LAS unsigned char* B = Bimg + lane * 16;
    f32x16 vn0, vn1, o0, o1;
    { const LAS u32x4* up = (const LAS u32x4*)(Bimg + GS_UF + (size_t)(ws * 2 * 64 + lane) * 32); const u32x4 u0 = up[0], u1 = up[1], u2 = up[128], u3 = up[129];
#pragma unroll
      for (int q = 0; q < 4; ++q) { vn0[2 * q] = lo16(u0[q]); vn0[2 * q + 1] = hi16(u0[q]); vn0[8 + 2 * q] = lo16(u1[q]); vn0[8 + 2 * q + 1] = hi16(u1[q]);
                                    vn1[2 * q] = lo16(u2[q]); vn1[2 * q + 1] = hi16(u2[q]); vn1[8 + 2 * q] = lo16(u3[q]); vn1[8 + 2 * q + 1] = hi16(u3[q]); } }
#pragma unroll
    for (int e = 0; e < 16; ++e) { o0[e] = 0.f; o1[e] = 0.f; }
    bf16x8 fa[8], fb[8];
#define G2_LD_WQ(dst, kt) do { _Pragma("unroll") for (int ss = 0; ss < 2; ++ss) { dst[4 * ss] = G2_FRAG(GS_WF + ((0 * 4 + kt) * 2 + ss) * 1024); dst[4 * ss + 1] = G2_FRAG(GS_WF + ((1 * 4 + kt) * 2 + ss) * 1024); \
        dst[4 * ss + 2] = G2_FRAG(GS_QF + ((0 * 4 + kt) * 2 + ss) * 1024); dst[4 * ss + 3] = G2_FRAG(GS_QF + ((1 * 4 + kt) * 2 + ss) * 1024); } } while (0)
#define G2_MM_WQ(src, Sx) do { _Pragma("unroll") for (int ss = 0; ss < 2; ++ss) { const bf16x8 sb = pack8(Sx, ss); \
        vn0 = MFMA32(src[4 * ss], sb, vn0); vn1 = MFMA32(src[4 * ss + 1], sb, vn1); o0 = MFMA32(src[4 * ss + 2], sb, o0); o1 = MFMA32(src[4 * ss + 3], sb, o1); } } while (0)
    G2_LD_WQ(fa, 0);
    G2_SCHED(); G2_LD_WQ(fb, 1); G2_SCHED(); G2_MM_WQ(fa, S0);
    G2_SCHED(); G2_LD_WQ(fa, 2); G2_SCHED(); G2_MM_WQ(fb, S1);
    G2_SCHED(); G2_LD_WQ(fb, 3); G2_SCHED(); G2_MM_WQ(fa, S2);
    G2_SCHED();
#pragma unroll
    for (int kt2 = 0; kt2 < 2; ++kt2)
#pragma unroll
        for (int ss = 0; ss < 2; ++ss) { fa[(kt2 * 2 + ss) * 2] = G2_FRAG(GS_PF + ((0 * 2 + kt2) * 2 + ss) * 1024); fa[(kt2 * 2 + ss) * 2 + 1] = G2_FRAG(GS_PF + ((1 * 2 + kt2) * 2 + ss) * 1024); }
    G2_SCHED(); G2_MM_WQ(fb, S3);
    G2_SCHED();
#define G2_LD_K(dst, kt2) do { _Pragma("unroll") for (int ss = 0; ss < 2; ++ss) _Pragma("unroll") for (int rt4 = 0; rt4 < 4; ++rt4) dst[ss * 4 + rt4] = G2_FRAG(GS_KF + ((rt4 * 2 + kt2) * 2 + ss) * 1024); } while (0)
    G2_LD_K(fb, 0);
    bf16x8 vb[2][2];
    vb[0][0] = pack8(vn0, 0); vb[0][1] = pack8(vn0, 1); vb[1][0] = pack8(vn1, 0); vb[1][1] = pack8(vn1, 1);
    S0 = S0 * dec; S1 = S1 * dec; S2 = S2 * dec; S3 = S3 * dec;
    G2_SCHED();
#pragma unroll
    for (int kt2 = 0; kt2 < 2; ++kt2)
#pragma unroll
        for (int ss = 0; ss < 2; ++ss) { o0 = MFMA32(fa[(kt2 * 2 + ss) * 2], vb[kt2][ss], o0); o1 = MFMA32(fa[(kt2 * 2 + ss) * 2 + 1], vb[kt2][ss], o1); }
    G2_SCHED(); G2_LD_K(fa, 1); G2_SCHED();
#define G2_MM_K(src, kt2) do { _Pragma("unroll") for (int ss = 0; ss < 2; ++ss) { S0 = MFMA32(src[ss * 4], vb[kt2][ss], S0); S1 = MFMA32(src[ss * 4 + 1], vb[kt2][ss], S1); S2 = MFMA32(src[ss * 4 + 2], vb[kt2][ss], S2); S3 = MFMA32(src[ss * 4 + 3], vb[kt2][ss], S3); } } while (0)
    G2_MM_K(fb, 0);
    G2_SCHED();
    G2_MM_K(fa, 1);
#undef G2_LD_WQ
#undef G2_MM_WQ
#undef G2_LD_K
#undef G2_MM_K
    LDS_BARRIER();
#pragma unroll
    for (int e = 0; e < 16; ++e) { const int rr = (e & 3) + 8 * (e >> 2) + 4 * hh;
        *(LAS float*)(Bimg + rr * G2_OSTRIDE + (32 * ws + cc) * 4) = o0[e]; *(LAS float*)(Bimg + (32 + rr) * G2_OSTRIDE + (32 * ws + cc) * 4) = o1[e]; }
    LDS_BARRIER();
}
__device__ __forceinline__ void g2_epi_step(Frame& F, LAS unsigned char* L, const LAS unsigned char* Oimg, const u32x4 (&zz)[4], int row, int seg, size_t m, int h, bool rok, int lane) {
    float ss = 0.f;
#pragma unroll
    for (int q = 0; q < 8; ++q) { const f32x4 ov = *(const LAS f32x4*)(Oimg + row * G2_OSTRIDE + (seg * 32 + 4 * q) * 4); ss += (ov[0] * ov[0] + ov[1] * ov[1]) + (ov[2] * ov[2] + ov[3] * ov[3]); }
    ss += shfl_xor_l(ss, 1, lane); ss += shfl_xor_l(ss, 2, lane);
    const float rn = rsqrtf(ss * (1.f / 128.f) + EPS);
    if (rok) {
        u32x4* yp = (u32x4*)(F.Y1() + m * D + h * 128 + seg * 32);
        const LAS float* hn_s = (const LAS float*)(L + G2_HN);
#pragma unroll
        for (int q = 0; q < 4; ++q) {
            const f32x4 oa = *(const LAS f32x4*)(Oimg + row * G2_OSTRIDE + (seg * 32 + 8 * q) * 4), ob = *(const LAS f32x4*)(Oimg + row * G2_OSTRIDE + (seg * 32 + 8 * q + 4) * 4);
            const f32x4 ha = *(const LAS f32x4*)(hn_s + seg * 32 + 8 * q), hb = *(const LAS f32x4*)(hn_s + seg * 32 + 8 * q + 4);
            u32x4 yo;
            yo[0] = cvt2(oa[0] * rn * ha[0] * siluf_(lo16(zz[q][0])), oa[1] * rn * ha[1] * siluf_(hi16(zz[q][0])));
            yo[1] = cvt2(oa[2] * rn * ha[2] * siluf_(lo16(zz[q][1])), oa[3] * rn * ha[3] * siluf_(hi16(zz[q][1])));
            yo[2] = cvt2(ob[0] * rn * hb[0] * siluf_(lo16(zz[q][2])), ob[1] * rn * hb[1] * siluf_(hi16(zz[q][2])));
            yo[3] = cvt2(ob[2] * rn * hb[2] * siluf_(lo16(zz[q][3])), ob[3] * rn * hb[3] * siluf_(hi16(zz[q][3])));
            yp[q] = yo; }
    }
}
template <int NCH>
__device__ __forceinline__ void g2_task(Frame& F, LAS unsigned char* L, const float* DEC, int s, int h, int ch0, int tid, int lane, int wave) {
    const size_t cstep = (size_t)GS_BYTES;
    const int base = seq_base(s), nvalid = s < BP ? 64 : TS;
    const unsigned char* blk0 = F.ws + WS_RB + (size_t)ch0 * GS_BYTES;
    constexpr int lastc = NCH - 1;
    if (wave < 4) {
        const int ws = wave, cc = lane & 31, hh = lane >> 5;
        f32x16 S0, S1, S2, S3;
        if (s < BP) {
#pragma unroll
            for (int e = 0; e < 16; ++e) { S0[e] = 0.f; S1[e] = 0.f; S2[e] = 0.f; S3[e] = 0.f; }
        } else {
            const float* sp = F.in[7] + ((size_t)(s - BP) * 8 + h) * 16384 + 32 * ws + cc;
#pragma unroll
            for (int e = 0; e < 16; ++e) { const int rr = (e & 3) + 8 * (e >> 2) + 4 * hh; S0[e] = sp[(size_t)rr * 128]; S1[e] = sp[(size_t)(32 + rr) * 128]; S2[e] = sp[(size_t)(64 + rr) * 128]; S3[e] = sp[(size_t)(96 + rr) * 128]; }
        }
        const LAS float* dec_s = (const LAS float*)(L + G2_DEC);
        LDS_BARRIER();
        if (NCH == 1) g2_mfma_step(S0, S1, S2, S3, L, dec_s[0], ws, lane, cc, hh);
        else for (int c = 0; c < NCH; c += 2) {
            g2_mfma_step(S0, S1, S2, S3, L, dec_s[c], ws, lane, cc, hh);
            g2_mfma_step(S0, S1, S2, S3, L + G2_FB, dec_s[c + 1], ws, lane, cc, hh);
        }
        int l9 = lane; asm volatile("" : "+v"(l9));
        const int cc9 = l9 & 31, hh9 = l9 >> 5;
        float* so = (s < BP ? F.out + O_GSP + ((size_t)s * 8 + h) * 16384 : F.out + O_GSS + ((size_t)(s - BP) * 8 + h) * 16384) + 32 * ws + cc9;
#pragma unroll
        for (int e = 0; e < 16; ++e) { const int rr = (e & 3) + 8 * (e >> 2) + 4 * hh9; so[(size_t)rr * 128] = S0[e]; so[(size_t)(32 + rr) * 128] = S1[e]; so[(size_t)(64 + rr) * 128] = S2[e]; so[(size_t)(96 + rr) * 128] = S3[e]; }
    } else {
        const int lt = tid - 256;
        if (lt < 128) ((LAS float*)(L + G2_HN))[lt] = F.in[32][lt];
        if (lt >= 128 && lt < 128 + NCH) ((LAS float*)(L + G2_DEC))[lt - 128] = DEC[ch0 + (lt - 128)];
        u32x4 preA[18], preB[18];
        g2_load_set(preA, blk0, lt);
        g2_load_set(preB, blk0 + (size_t)(1 < lastc ? 1 : lastc) * cstep, lt);
        g2_store_set(preA, L, lt);
        g2_load_set(preA, blk0 + (size_t)(2 < lastc ? 2 : lastc) * cstep, lt);
        const int row = lt >> 2, seg = lt & 3; const bool rok = row < nvalid;
        u32x4 zz[4];
        LDS_BARRIER();
        if (NCH == 1) {
            const size_t m = (size_t)base + row;
            if (rok) { const u32x4* zp = (const u32x4*)(F.Z1() + m * D + h * 128 + seg * 32);
#pragma unroll
                for (int q = 0; q < 4; ++q) zz[q] = zp[q]; }
            LDS_BARRIER();
            LDS_BARRIER();
            g2_epi_step(F, L, L, zz, row, seg, m, h, rok, lane);
        } else for (int c = 0; c < NCH; c += 2) {
            {
                const size_t m = (size_t)base + c * 64 + row;
                { const u32x4* zp = (const u32x4*)(F.Z1() + m * D + h * 128 + seg * 32);
#pragma unroll
                  for (int q = 0; q < 4; ++q) zz[q] = zp[q]; }
                g2_store_set(preB, L + G2_FB, lt);
                g2_load_set(preB, blk0 + (size_t)(c + 3 < lastc ? c + 3 : lastc) * cstep, lt);
                LDS_BARRIER();
                LDS_BARRIER();
                g2_epi_step(F, L, L, zz, row, seg, m, h, rok, lane);
            }
            {
                const size_t m = (size_t)base + (c + 1) * 64 + row;
                { const u32x4* zp = (const u32x4*)(F.Z1() + m * D + h * 128 + seg * 32);
#pragma unroll
                  for (int q = 0; q < 4; ++q) zz[q] = zp[q]; }
                g2_store_set(preA, L, lt);
                g2_load_set(preA, blk0 + (size_t)(c + 4 < lastc ? c + 4 : lastc) * cstep, lt);
                LDS_BARRIER();
                LDS_BARRIER();
                g2_epi_step(F, L, L + G2_FB, zz, row, seg, m, h, rok, lane);
            }
        }
    }
}
__device__ __forceinline__ void phase_gdn_g2(Frame& F) {
    LAS unsigned char* L = F.lds;
    const float* DEC = (const float*)(F.ws + WS_DEC);
    for (int task = blockIdx.x; task < 192; task += F.G) {
        const int tid = opaque_tid(F.wv);
        const int lane = tid & 63, wave = F.wv;
        if (task < 64) g2_task<64>(F, L, DEC, task >> 3, task & 7, task * 64, tid, lane, wave);
        else g2_task<1>(F, L, DEC, BP + ((task - 64) >> 3), task & 7, 4096 + ((task - 64) >> 3) * 8 + (task & 7), tid, lane, wave);
        __syncthreads();
    }
}

#define MFMA16(a, b, c) __builtin_amdgcn_mfma_f32_16x16x32_bf16((a), (b), (c), 0, 0, 0)
__device__ __forceinline__ float dpp_shr_f(float idv, float x, const int o) {
    int r;
    switch (o) {
        case 1: r = __builtin_amdgcn_update_dpp(__float_as_int(idv), __float_as_int(x), 0x111, 0xf, 0xf, false); break;
        case 2: r = __builtin_amdgcn_update_dpp(__float_as_int(idv), __float_as_int(x), 0x112, 0xf, 0xf, false); break;
        case 4: r = __builtin_amdgcn_update_dpp(__float_as_int(idv), __float_as_int(x), 0x114, 0xf, 0xf, false); break;
        default: r = __builtin_amdgcn_update_dpp(__float_as_int(idv), __float_as_int(x), 0x118, 0xf, 0xf, false); break;
    }
    return __int_as_float(r);
}
template <int PASS>
__device__ __forceinline__ void phase_lru(Frame& F) {
    int tid = opaque_tid(F.wv);
    const int lane = tid & 63, wave = __builtin_amdgcn_readfirstlane(tid >> 6);
    const int gw = F.vcu * 8 + wave, NGW = F.G * 8, h = gw & 7, g = lane >> 4, l15 = lane & 15;
    LAS unsigned char* xs = F.lds + wave * 9216;
    LAS float* cst = (LAS float*)(F.lds + 73728 + wave * 768);
    const bf16_t* LGW = (const bf16_t*)(F.ws + WS_LGW);
    float* LAG = F.LAG();
    bf16x8 wfa[4][2], wfx[4][2];
#pragma unroll
    for (int nt = 0; nt < 4; ++nt)
#pragma unroll
        for (int ks = 0; ks < 2; ++ks) {
            wfa[nt][ks] = *(const bf16x8*)(LGW + ((size_t)(h * 2 + 0) * 64 + 16 * nt + l15) * 64 + 32 * ks + 8 * g);
            wfx[nt][ks] = *(const bf16x8*)(LGW + ((size_t)(h * 2 + 1) * 64 + 16 * nt + l15) * 64 + 32 * ks + 8 * g); }
    cst[lane] = F.in[18][h * 64 + lane]; cst[64 + lane] = F.in[20][h * 64 + lane]; cst[128 + lane] = softplusf_(-F.in[21][h * 64 + lane]);
    for (int task = gw; task < 4224; task += NGW) {
        int s, c; if (task < 4096) { s = task >> 9; c = (task >> 3) & 63; } else { s = BP + ((task - 4096) >> 3); c = 0; }
        const int T = seq_len(s), base = seq_base(s), t0 = c * 64, ntile = s < BP ? 4 : 1;
        {
            int l1 = lane; asm volatile("" : "+v"(l1));
            const int cg = l1 & 7, tp = l1 >> 3;
#pragma unroll 1
            for (int hf2 = 0; hf2 < 2; ++hf2) {
                const int chb = h * 64 + cg * 8 + hf2 * 4;
                float xr[11][4];
#pragma unroll
                for (int i = 0; i < 11; ++i) {
                    const int tt = t0 + tp * 8 - 3 + i;
                    if (tt >= 0 && tt < T) { const u32x2 w = *(const u32x2*)(F.U0() + (size_t)(base + tt) * EV_IN + C_XA + chb);
                        xr[i][0] = lo16(w[0]); xr[i][1] = hi16(w[0]); xr[i][2] = lo16(w[1]); xr[i][3] = hi16(w[1]); }
                    else if (tt < 0 && s >= BP) { const f32x4 a = *(const f32x4*)(F.in[2] + ((size_t)(s - BP) * 3 + (tt + 3)) * 512 + chb); xr[i][0] = a[0]; xr[i][1] = a[1]; xr[i][2] = a[2]; xr[i][3] = a[3]; }
                    else { xr[i][0] = 0.f; xr[i][1] = 0.f; xr[i][2] = 0.f; xr[i][3] = 0.f; }
                }
                const f32x4 c0 = *(const f32x4*)(F.in[15] + chb), c1 = *(const f32x4*)(F.in[15] + 512 + chb), c2 = *(const f32x4*)(F.in[15] + 1024 + chb), c3 = *(const f32x4*)(F.in[15] + 1536 + chb), cb = *(const f32x4*)(F.in[16] + chb);
#pragma unroll
                for (int i = 0; i < 8; ++i) { float o[4];
#pragma unroll
                    for (int e = 0; e < 4; ++e) o[e] = c0[e] * xr[i][e] + c1[e] * xr[i + 1][e] + c2[e] * xr[i + 2][e] + c3[e] * xr[i + 3][e] + cb[e];
                    u32x2 w; w[0] = cvt2(o[0], o[1]); w[1] = cvt2(o[2], o[3]);
                    *(LAS u32x2*)(xs + (tp * 8 + i) * 144 + cg * 16 + hf2 * 8) = w; }
                if (PASS == 2 && t0 + 64 >= T && tp == ((T - 1) >> 3) - (t0 >> 3)) {
                    float* o = (s < BP ? F.out + O_LCP + (size_t)s * 3 * 512 : F.out + O_LCS + (size_t)(s - BP) * 3 * 512) + chb;
#pragma unroll
                    for (int q = 0; q < 3; ++q) *(f32x4*)(o + q * 512) = (f32x4){xr[8 + q][0], xr[8 + q][1], xr[8 + q][2], xr[8 + q][3]};
                }
            }
        }
        float hin[4][4], arun[4][4];
#pragma unroll
        for (int nt = 0; nt < 4; ++nt)
#pragma unroll
            for (int rg = 0; rg < 4; ++rg) { hin[nt][rg] = 0.f; arun[nt][rg] = 1.f; }
        if (PASS == 2) {
            float hf = s >= BP ? F.in[3][(s - BP) * 512 + h * 64 + lane] : 0.f;
            const f32x2* lp = (const f32x2*)LAG + (size_t)(s * 64) * 512 + h * 64 + lane;
            int j = 0;
            for (; j + 8 <= c; j += 8) { f32x2 v[8];
#pragma unroll
                for (int q = 0; q < 8; ++q) v[q] = lp[(size_t)(j + q) * 512];
#pragma unroll
                for (int q = 0; q < 8; ++q) hf = v[q][0] * hf + v[q][1]; }
            for (; j < c; ++j) { const f32x2 v = lp[(size_t)j * 512]; hf = v[0] * hf + v[1]; }
#pragma unroll
            for (int nt = 0; nt < 4; ++nt)
#pragma unroll
                for (int rg = 0; rg < 4; ++rg) hin[nt][rg] = shfl_idx(hf, 16 * nt + 4 * g + rg);
        }
        asm volatile("s_waitcnt lgkmcnt(0)" ::: "memory");
        for (int tt = 0; tt < ntile; ++tt) {
            const int tok = 16 * tt + l15;
            const bf16x8 b0 = *(const LAS bf16x8*)(xs + tok * 144 + (8 * g) * 2), b1 = *(const LAS bf16x8*)(xs + tok * 144 + (32 + 8 * g) * 2);
            const size_t m = (size_t)base + t0 + tok;
#pragma unroll
            for (int nt = 0; nt < 4; ++nt) {
                f32x4 za = {0.f, 0.f, 0.f, 0.f}, zx = {0.f, 0.f, 0.f, 0.f};
                za = MFMA16(wfa[nt][0], b0, za); za = MFMA16(wfa[nt][1], b1, za);
                zx = MFMA16(wfx[nt][0], b0, zx); zx = MFMA16(wfx[nt][1], b1, zx);
                const int n0 = 16 * nt + 4 * g;
                const u32x2 xw = *(const LAS u32x2*)(xs + tok * 144 + n0 * 2);
                const float xc[4] = {lo16(xw[0]), hi16(xw[0]), lo16(xw[1]), hi16(xw[1])};
                const f32x4 cba = *(const LAS f32x4*)(cst + n0), cbx = *(const LAS f32x4*)(cst + 64 + n0), csp = *(const LAS f32x4*)(cst + 128 + n0);
                float av[4], bv[4];
#pragma unroll
                for (int rg = 0; rg < 4; ++rg) {
                    const float r = sigmoidf_(za[rg] + cba[rg]), ig = sigmoidf_(zx[rg] + cbx[rg]), la = -8.0f * r * csp[rg], a = __expf(la);
                    av[rg] = a; bv[rg] = sqrtf(fmaxf(1.0f - a * a, 0.f)) * (ig * xc[rg]); }
#pragma unroll
                for (int o = 1; o < 16; o <<= 1)
#pragma unroll
                    for (int rg = 0; rg < 4; ++rg) { const float ap = dpp_shr_f(1.0f, av[rg], o), bp = dpp_shr_f(0.0f, bv[rg], o); bv[rg] = av[rg] * bp + bv[rg]; av[rg] = av[rg] * ap; }
                float hv[4];
#pragma unroll
                for (int rg = 0; rg < 4; ++rg) { hv[rg] = bv[rg] + av[rg] * hin[nt][rg]; hin[nt][rg] = shfl_idx(hv[rg], (lane & 48) | 15); }
                if (PASS == 1) {
#pragma unroll
                    for (int rg = 0; rg < 4; ++rg) arun[nt][rg] *= shfl_idx(av[rg], (lane & 48) | 15);
                } else {
                    const bool tok_ok = (t0 + tok) < T;
                    if (tok_ok) {
                        const u32x2 gw2 = *(const u32x2*)(F.U0() + m * EV_IN + C_GA + h * 64 + n0);
                        u32x2 yo; yo[0] = cvt2(hv[0] * siluf_(lo16(gw2[0])), hv[1] * siluf_(hi16(gw2[0]))); yo[1] = cvt2(hv[2] * siluf_(lo16(gw2[1])), hv[3] * siluf_(hi16(gw2[1])));
                        *(u32x2*)(F.Y0() + m * D + h * 64 + n0) = yo;
                        if (t0 + tok == T - 1) { float* o = (s < BP ? F.out + O_LHP + s * 512 : F.out + O_LHS + (s - BP) * 512) + h * 64 + n0; *(f32x4*)o = (f32x4){hv[0], hv[1], hv[2], hv[3]}; }
                    }
                }
                if (nt & 1) __builtin_amdgcn_sched_barrier(0);
            }
        }
        if (PASS == 1 && s < BP && l15 == 15) {
            f32x2* lp = (f32x2*)LAG + (size_t)(s * 64 + c) * 512 + h * 64;
#pragma unroll
            for (int nt = 0; nt < 4; ++nt)
#pragma unroll
                for (int rg = 0; rg < 4; ++rg) lp[16 * nt + 4 * g + rg] = (f32x2){arun[nt][rg], hin[nt][rg]};
        }
        asm volatile("s_waitcnt lgkmcnt(0)" ::: "memory");
    }
}

constexpr size_t RB_VTP = RB_WEND, RB_VTS = RB_VTP + (size_t)BP * 2 * 64 * TP * 2, RB_VTEND = RB_VTS + (size_t)BS * 2 * 64 * 192 * 2;
static_assert(RB_VTEND <= RB_BYTES, "ws map");
__device__ __forceinline__ void phase_vt_build(Frame& F) {
    PHASE_IDS();
    const int gw = F.vcu * 8 + wave, NGW = F.G * 8;
    LAS unsigned char* xs = F.lds + wave * 9216;
    bf16_t* VTP = (bf16_t*)(F.ws + WS_RB + RB_VTP); bf16_t* VTS = (bf16_t*)(F.ws + WS_RB + RB_VTS);
    for (int task = gw; task < 1024 + 96; task += NGW) {
        int s, kv, kb; if (task < 1024) { s = task >> 7; kv = (task >> 6) & 1; kb = task & 63; } else { const int r = task - 1024; s = BP + r / 6; kv = (r % 6) / 3; kb = r % 3; }
        const int row8 = lane >> 3, ch = lane & 7;
#pragma unroll
        for (int i = 0; i < 8; ++i) {
            const int key = 8 * i + row8, kg = kb * 64 + key; u32x4 w = {0u, 0u, 0u, 0u};
            if (s < BP) w = *(const u32x4*)(F.U0() + (size_t)(s * TP + kg) * EV_IN + C_V + kv * 64 + ch * 8);
            else if (kg < 128) { const f32x4* p = (const f32x4*)(F.in[5] + ((size_t)((s - BP) * 128 + kg) * 2 + kv) * 64 + ch * 8); const f32x4 a = p[0], b = p[1]; w[0] = cvt2(a[0], a[1]); w[1] = cvt2(a[2], a[3]); w[2] = cvt2(b[0], b[1]); w[3] = cvt2(b[2], b[3]); }
            else if (kg < 128 + TS) w = *(const u32x4*)(F.U0() + (size_t)(MP + (s - BP) * TS + (kg - 128)) * EV_IN + C_V + kv * 64 + ch * 8);
            *(LAS u32x4*)(xs + key * 144 + ch * 16) = w;
        }
        asm volatile("s_waitcnt lgkmcnt(0)" ::: "memory");
        bf16_t* dst = s < BP ? VTP + ((size_t)(s * 2 + kv) * 64 + lane) * TP + kb * 64 : VTS + ((size_t)((s - BP) * 2 + kv) * 64 + lane) * 192 + kb * 64;
#pragma unroll
        for (int q = 0; q < 8; ++q) { u32x4 o;
#pragma unroll
            for (int e = 0; e < 4; ++e) { const unsigned lo = *(const LAS bf16_t*)(xs + (8 * q + 2 * e) * 144 + lane * 2), hi = *(const LAS bf16_t*)(xs + (8 * q + 2 * e + 1) * 144 + lane * 2); o[e] = lo | (hi << 16); }
            *(u32x4*)(dst + 8 * q) = o; }
        asm volatile("s_waitcnt lgkmcnt(0)" ::: "memory");
    }
}
constexpr int AT_K = 0, AT_V = 27648;
__device__ __forceinline__ void phase_attn(Frame& F) {
    PHASE_IDS();
    LAS unsigned char* L = F.lds;
    const bf16_t* VTP = (const bf16_t*)(F.ws + WS_RB + RB_VTP); const bf16_t* VTS = (const bf16_t*)(F.ws + WS_RB + RB_VTS);
    for (int task = F.vcu; task < 1024 + 32; task += F.G) {
        int s, c, kv; if (task < 1024) { s = task >> 7; c = (task >> 1) & 63; kv = task & 1; } else { s = BP + ((task - 1024) >> 1); c = 0; kv = task & 1; }
        const int base = seq_base(s), tok0 = c * 64 - 128;
        const int kmin = s < BP ? (tok0 < 0 ? -tok0 : 0) : 0, kmax = s < BP ? 192 : 128 + TS;
        __syncthreads();
#pragma unroll
        for (int i = 0; i < 3; ++i) {
            const int idx = tid + 512 * i, key = idx >> 3, ch = idx & 7; u32x4 w = {0u, 0u, 0u, 0u};
            if (key >= kmin && key < kmax) {
                if (s < BP) w = *(const u32x4*)(F.U0() + (size_t)(base + tok0 + key) * EV_IN + C_K + kv * 64 + ch * 8);
                else if (key < 128) { const f32x4* p = (const f32x4*)(F.in[4] + ((size_t)((s - BP) * 128 + key) * 2 + kv) * 64 + ch * 8); const f32x4 a = p[0], b = p[1]; w[0] = cvt2(a[0], a[1]); w[1] = cvt2(a[2], a[3]); w[2] = cvt2(b[0], b[1]); w[3] = cvt2(b[2], b[3]); }
                else w = *(const u32x4*)(F.U0() + (size_t)(base + key - 128) * EV_IN + C_K + kv * 64 + ch * 8);
            }
            *(LAS u32x4*)(L + AT_K + key * 144 + ch * 16) = w;
        }
#pragma unroll
        for (int i = 0; i < 3; ++i) {
            const int idx = tid + 512 * i, d = idx / 24, ch = idx % 24, key = ch * 8; u32x4 w = {0u, 0u, 0u, 0u};
            if (s < BP) { if (key >= kmin) w = *(const u32x4*)(VTP + ((size_t)(s * 2 + kv) * 64 + d) * TP + tok0 + key); }
            else w = *(const u32x4*)(VTS + ((size_t)((s - BP) * 2 + kv) * 64 + d) * 192 + key);
            *(LAS u32x4*)(L + AT_V + d * 400 + ch * 16) = w;
        }
        const int g = wave >> 1, qh = wave & 1, hq = kv * 4 + g, r = lane & 31, hh = lane >> 5, qi = qh * 32 + r;
        const bool qok = s < BP ? true : qi < TS;
        const size_t m = (size_t)base + c * 64 + (qok ? qi : 0);
        bf16x8 qf[4];
#pragma unroll
        for (int ks = 0; ks < 4; ++ks) { u32x4 w = {0u, 0u, 0u, 0u};
            if (qok) { const u32x4 x = *(const u32x4*)(F.U0() + m * EV_IN + C_Q + hq * 64 + 16 * ks + 8 * hh);
#pragma unroll
                for (int e = 0; e < 4; ++e) w[e] = cvt2(lo16(x[e]) * 0.125f, hi16(x[e]) * 0.125f); }
            qf[ks] = __builtin_bit_cast(bf16x8, w); }
        const float sink = F.in[22][hq];
        __syncthreads();
        float mrun = sink, lrun = 1.0f;
        f32x16 o0, o1;
#pragma unroll
        for (int e = 0; e < 16; ++e) { o0[e] = 0.f; o1[e] = 0.f; }
#pragma unroll 1
        for (int half = 0; half < 2; ++half) {
            f32x16 sc[3];
#pragma unroll
            for (int k3 = 0; k3 < 3; ++k3) {
                const int kt = 3 * half + k3;
#pragma unroll
                for (int e = 0; e < 16; ++e) sc[k3][e] = 0.f;
#pragma unroll
                for (int ks = 0; ks < 4; ++ks) { const bf16x8 kf = *(const LAS bf16x8*)(L + AT_K + (32 * kt + r) * 144 + (16 * ks + 8 * hh) * 2); sc[k3] = MFMA32(kf, qf[ks], sc[k3]); }
            }
            float mx = -1e30f;
#pragma unroll
            for (int k3 = 0; k3 < 3; ++k3)
#pragma unroll
                for (int e = 0; e < 16; ++e) { const int kidx = 32 * (3 * half + k3) + (e & 3) + 8 * (e >> 2) + 4 * hh; const bool ok = kidx >= kmin && kidx < kmax; sc[k3][e] = ok ? sc[k3][e] : -1e30f; mx = fmaxf(mx, sc[k3][e]); }
            mx = fmaxf(mx, shfl_xor_l(mx, 32, lane));
            const float mnew = fmaxf(mrun, mx), alpha = __expf(mrun - mnew);
            float psum = 0.f;
#pragma unroll
            for (int k3 = 0; k3 < 3; ++k3)
#pragma unroll
                for (int e = 0; e < 16; ++e) { const float p = __expf(sc[k3][e] - mnew); sc[k3][e] = p; psum += p; }
            psum += shfl_xor_l(psum, 32, lane);
            lrun = lrun * alpha + psum; mrun = mnew;
            o0 = o0 * alpha; o1 = o1 * alpha;
#pragma unroll
            for (int k3 = 0; k3 < 3; ++k3)
#pragma unroll
                for (int ss = 0; ss < 2; ++ss) {
                    const int kt = 3 * half + k3;
                    const bf16x8 pb = pack8(sc[k3], ss);
                    const LAS unsigned char* vp = L + AT_V + r * 400 + (32 * kt + 16 * ss + 4 * hh) * 2;
                    const u32x2 a0 = *(const LAS u32x2*)vp, a1 = *(const LAS u32x2*)(vp + 16), b0 = *(const LAS u32x2*)(vp + 32 * 400), b1 = *(const LAS u32x2*)(vp + 32 * 400 + 16);
                    const u32x4 va = {a0[0], a0[1], a1[0], a1[1]}, vb = {b0[0], b0[1], b1[0], b1[1]};
                    o0 = MFMA32(__builtin_bit_cast(bf16x8, va), pb, o0); o1 = MFMA32(__builtin_bit_cast(bf16x8, vb), pb, o1);
                }
        }
        const float il = __builtin_amdgcn_rcpf(lrun);
        if (qok) {
#pragma unroll
            for (int qq = 0; qq < 4; ++qq) {
                { const int d = 8 * qq + 4 * hh; const u32x2 gb = *(const u32x2*)(F.U0() + m * EV_IN + C_GB + hq * 64 + d);
                  u32x2 yo; yo[0] = cvt2(o0[4 * qq] * il * siluf_(lo16(gb[0])), o0[4 * qq + 1] * il * siluf_(hi16(gb[0]))); yo[1] = cvt2(o0[4 * qq + 2] * il * siluf_(lo16(gb[1])), o0[4 * qq + 3] * il * siluf_(hi16(gb[1])));
                  *(u32x2*)(F.Y0() + m * D + 512 + hq * 64 + d) = yo; }
                { const int d = 32 + 8 * qq + 4 * hh; const u32x2 gb = *(const u32x2*)(F.U0() + m * EV_IN + C_GB + hq * 64 + d);
                  u32x2 yo; yo[0] = cvt2(o1[4 * qq] * il * siluf_(lo16(gb[0])), o1[4 * qq + 1] * il * siluf_(hi16(gb[0]))); yo[1] = cvt2(o1[4 * qq + 2] * il * siluf_(lo16(gb[1])), o1[4 * qq + 3] * il * siluf_(hi16(gb[1])));
                  *(u32x2*)(F.Y0() + m * D + 512 + hq * 64 + d) = yo; }
            }
        }
    }
    __syncthreads();
}

__device__ __forceinline__ void phase_final_rowwise(Frame& F) {
    PHASE_IDS();
    const int gw = F.vcu * 8 + wave, NGW = F.G * 8;
    for (int m = gw; m < MT; m += NGW) {
        int s, t; tok_info(m, s, t);
        const float* mod1 = F.MOD() + (size_t)(24 + s) * 3072;
        f32x4 y[4]; float ss = 0.f;
#pragma unroll
        for (int j = 0; j < 4; ++j) { const u32x2 w = *(const u32x2*)(F.YO() + (size_t)m * D + 4 * lane + 256 * j); y[j] = (f32x4){lo16(w.x), hi16(w.x), lo16(w.y), hi16(w.y)};
            ss += (y[j][0] * y[j][0] + y[j][1] * y[j][1]) + (y[j][2] * y[j][2] + y[j][3] * y[j][3]); }
        const float r1 = rsqrtf(wave_sum(ss, lane) * (1.f / D) + EPS);
#pragma unroll
        for (int j = 0; j < 4; ++j) { const int c = 4 * lane + 256 * j;
            float* op = F.out + O_Y + (size_t)m * D + c;
            const f32x4 xv = *(const f32x4*)op, g = *(const f32x4*)(F.in[27] + c), gt = *(const f32x4*)(mod1 + 2048 + c);
            f32x4 o;
#pragma unroll
            for (int e = 0; e < 4; ++e) o[e] = xv[e] + gt[e] * (y[j][e] * r1 * g[e]);
            *(f32x4*)op = o; }
    }
}

__global__ void __launch_bounds__(512, 2) fwd_megakernel(Params P) {
    extern __shared__ __attribute__((aligned(16))) unsigned char lds_raw[];
    cg::grid_group grid = cg::this_grid();
    Frame F;
    F.lds = (LAS unsigned char*)lds_raw;
    F.wv = __builtin_amdgcn_readfirstlane(threadIdx.x >> 6);
    F.G = gridDim.x; { const int bx = blockIdx.x; F.vcu = (F.G % 8 == 0) ? (bx % 8) * (F.G / 8) + bx / 8 : bx; }
    F.in = P.in; F.out = P.out; F.ws = P.ws;

    volatile LAS unsigned* misc = (volatile LAS unsigned*)(F.lds + LDS_BYTES - 64);
    if (threadIdx.x < 16) misc[threadIdx.x] = 0u;
    __syncthreads();
    XcdBarrier xbar = xcd_barrier_post((unsigned*)(P.ws + WS_CTL), misc);
#define GRID_BAR() xcd_barrier(xbar, F.wv)
    phase_prologue(F);
    grid.sync();
    phase_prenorm0(F);
    GRID_BAR();
    { pg8::Gemm g{F.XN(), F.W0I(), MT, EV_IN, D}; pg8::StaticOrder S; S.init(MT, EV_IN, F.G, (int)blockIdx.x);
      pg8::EpiBf16 E{F.U0(), EV_IN, 1 << 30, F.U0(), EV_IN}; pg8::gemm_phase(F.lds, g, S, E, F.wv); }
    GRID_BAR();
    phase_rope(F);
    phase_lru<1>(F);
    phase_vt_build(F);
    GRID_BAR();
    phase_lru<2>(F);
    phase_attn(F);
    GRID_BAR();
    { pg8::Gemm g{F.Y0(), F.W0O(), MT, D, D}; pg8::StaticOrder S; S.init(MT, D, F.G, (int)blockIdx.x);
      pg8::EpiBf16 E{F.YO(), D, 1 << 30, F.YO(), D}; pg8::gemm_phase(F.lds, g, S, E, F.wv); }
    GRID_BAR();
    phase_mid_rowwise(F);
    GRID_BAR();
    { pg8::Gemm g{F.XN(), F.W1I(), MT, OD_MAIN, D}; pg8::StaticOrder S; S.init(MT, OD_MAIN, F.G, (int)blockIdx.x);
      pg8::EpiBf16 E{F.QKV1(), 3072, 3072, F.Z1(), D}; pg8::gemm_phase(F.lds, g, S, E, F.wv); }
    GRID_BAR();
    phase_gdn_g1(F);
    GRID_BAR();
    phase_gdn_g2(F);
    GRID_BAR();
    { pg8::Gemm g{F.Y1(), F.W1O(), MT, D, D}; pg8::StaticOrder S; S.init(MT, D, F.G, (int)blockIdx.x);
      pg8::EpiBf16 E{F.YO(), D, 1 << 30, F.YO(), D}; pg8::gemm_phase(F.lds, g, S, E, F.wv); }
    GRID_BAR();
    phase_final_rowwise(F);
}

extern "C" void kernel_launch(void* const* d_in, const int* in_sizes, int n_in, void* d_out, int out_size, void* d_ws, size_t ws_size, hipStream_t stream) {
    static int grid = 0;
    if (grid == 0) {
        if (n_in != 34 || out_size != (int)O_END || ws_size < WS_END) { grid = -1; return; }
        int dev = 0, cus = 0, per_cu = 0;
        if (hipGetDevice(&dev) != hipSuccess || hipDeviceGetAttribute(&cus, hipDeviceAttributeMultiprocessorCount, dev) != hipSuccess) { grid = -1; return; }
        if (hipFuncSetAttribute((const void*)fwd_megakernel, hipFuncAttributeMaxDynamicSharedMemorySize, LDS_BYTES) != hipSuccess) { grid = -1; return; }
        if (hipOccupancyMaxActiveBlocksPerMultiprocessor(&per_cu, (const void*)fwd_megakernel, 512, LDS_BYTES) != hipSuccess || per_cu < 1) { grid = -1; return; }
        grid = cus;
    }
    if (grid < 0) return;
    if (hipMemsetAsync((char*)d_ws + WS_CTL, 0, 16384, stream) != hipSuccess) return;
    Params p{};
    for (int i = 0; i < 34; ++i) p.in[i] = (const float*)d_in[i];
    p.out = (float*)d_out; p.ws = (unsigned char*)d_ws;
    void* args[] = {&p};
    (void)hipLaunchCooperativeKernel((const void*)fwd_megakernel, dim3(grid), dim3(512), args, LDS_BYTES, stream);
}
```

```cpp
#include <hip/hip_runtime.h>
#include <hip/hip_cooperative_groups.h>
namespace cg = cooperative_groups;

#define LAS __attribute__((address_space(3)))
typedef unsigned short bf16_t;
typedef short bf16x8 __attribute__((ext_vector_type(8)));
typedef float f32x4 __attribute__((ext_vector_type(4)));
typedef float f32x2 __attribute__((ext_vector_type(2)));
typedef unsigned u32x4 __attribute__((ext_vector_type(4)));
typedef unsigned u32x2 __attribute__((ext_vector_type(2)));

constexpr int D = 1024, BP = 8, TP = 4096, BS = 16, TS = 16;
constexpr int MP = BP * TP, MS = BS * TS, MT = MP + MS;
constexpr int NSEQ = BP + BS;
constexpr int EV_IN = 2304, OD_IN = 4112, OD_MAIN = 4096;
constexpr int C_XA = 0, C_GA = 512, C_Q = 1024, C_K = 1536, C_V = 1664, C_GB = 1792;
constexpr float EPS = 1e-6f;
constexpr size_t O_Y = 0, O_LCP = 33816576, O_LCS = 33828864, O_LHP = 33853440, O_LHS = 33857536, O_KP = 33865728, O_KS = 33996800,
                 O_VP = 34029568, O_VS = 34160640, O_GCP = 34193408, O_GCS = 34267136, O_GSP = 34414592, O_GSS = 35463168, O_END = 37560320;
constexpr size_t MiB = 1u << 20;
constexpr size_t WS_CTL = 0, WS_W1O = 1 * MiB, WS_MOD = 3 * MiB, WS_ROPE = 4 * MiB, WS_BA = 5 * MiB, WS_LAG = 8 * MiB, WS_LGW = 10 * MiB;
constexpr size_t WS_RA = 16 * MiB, RA_BYTES = (size_t)MT * 4096 * 2;
constexpr size_t WS_RB = WS_RA + RA_BYTES;
constexpr size_t ACT_BYTES = (size_t)MT * D * 2;
constexpr size_t RB_XN = 0, RB_Y0 = ACT_BYTES, RB_YO = 2 * ACT_BYTES, RB_W0I = 3 * ACT_BYTES, RB_W0O = RB_W0I + (size_t)EV_IN * D * 2,
                 RB_W1I = RB_W0O + (size_t)D * D * 2, RB_WEND = RB_W1I + (size_t)OD_MAIN * D * 2;
constexpr size_t RB_BYTES = (size_t)4224 * 73728;
constexpr size_t WS_END = WS_RB + RB_BYTES;
static_assert(RB_WEND <= RB_BYTES, "ws map");
static_assert((size_t)MT * 3072 * 2 <= RB_BYTES, "ws map");
constexpr int LDS_BYTES = 155648;

struct Params { const float* in[34]; float* out; unsigned char* ws; };

__device__ __forceinline__ float bf2f(bf16_t b) { return __uint_as_float(((unsigned)b) << 16); }
__device__ __forceinline__ unsigned f2bf(float f) { unsigned u = __float_as_uint(f); return (u + 0x7fffu + ((u >> 16) & 1u)) >> 16; }
__device__ __forceinline__ unsigned pk2(float lo, float hi) { return f2bf(lo) | (f2bf(hi) << 16); }
__device__ __forceinline__ float lo16(unsigned w) { return __uint_as_float(w << 16); }
__device__ __forceinline__ float hi16(unsigned w) { return __uint_as_float(w & 0xffff0000u); }
__device__ __forceinline__ float shfl_idx(float x, int src_lane) { return __int_as_float(__builtin_amdgcn_ds_bpermute(src_lane << 2, __float_as_int(x))); }
__device__ __forceinline__ float shfl_xor_l(float x, int o, int lane) { return shfl_idx(x, lane ^ o); }
__device__ __forceinline__ float wave_sum(float v, int lane) {
#pragma unroll
    for (int o = 1; o < 64; o <<= 1) v += shfl_xor_l(v, o, lane);
    return v;
}
__device__ __forceinline__ float sigmoidf_(float x) { return __builtin_amdgcn_rcpf(1.0f + __expf(-x)); }
__device__ __forceinline__ float siluf_(float x) { return x * __builtin_amdgcn_rcpf(1.0f + __expf(-x)); }
__device__ __forceinline__ float softplusf_(float x) { return x > 20.f ? x : log1pf(__expf(x)); }
__device__ __forceinline__ int seq_base(int s) { return s < BP ? s * TP : MP + (s - BP) * TS; }
__device__ __forceinline__ int seq_len(int s) { return s < BP ? TP : TS; }
__device__ __forceinline__ void tok_info(int m, int& s, int& t) { if (m < MP) { s = m >> 12; t = m & 4095; } else { const int r = m - MP; s = BP + (r >> 4); t = r & 15; } }

__device__ __forceinline__ int opaque_tid(int wv) { unsigned z = 0u; asm volatile("" : "+v"(z)); const int l = __builtin_amdgcn_mbcnt_hi(~0u, __builtin_amdgcn_mbcnt_lo(~0u, z)); return wv * 64 + l; }
namespace pg8 {
constexpr int BM = 256, BK = 64, HALF = 128, HTB = HALF * BK * 2, STAGE_BYTES = 8 * HTB, NXCD = 8, WGM = 8;
__host__ __device__ __forceinline__ int lds_byte(int r, int c) { const int st = (r >> 4) * 2 + (c >> 5), rr = r & 15, cc = c & 31, ob = rr * 64 + cc * 2; return st * 1024 + (ob ^ (((ob >> 9) & 1) << 5)); }
__host__ __device__ __forceinline__ void stage_rc(int b, int& R, int& C) { const int st = b / 1024, sb = b % 1024, swz = sb ^ (((sb >> 9) & 1) << 5); R = (st >> 1) * 16 + swz / 64; C = (st & 1) * 32 + (swz % 64) / 2; }
__host__ __device__ __forceinline__ int perm32(int rho) { const int n = rho >> 4, i = rho & 15; return 8 * (i >> 2) + 4 * n + (i & 3); }
struct Unit { int pm, pn; };
struct Gemm { const bf16_t* A; const bf16_t* Bt; int M, N, K; };
struct StaticOrder {
    int nM, nN, nwg, G, c;
    __device__ void init(int M, int N, int G_, int c_) { nM = M / BM; nN = N / BM; nwg = nM * nN; G = G_; c = c_; }
    __device__ bool next(int i, Unit& u) const {
        const long L = (long)i * G + c; if (L >= nwg) return false;
        int wgid = (int)L; { const int q = nwg / NXCD, r = nwg % NXCD, xcd = wgid % NXCD, off = wgid / NXCD; wgid = (xcd < r ? xcd * (q + 1) : r * (q + 1) + (xcd - r) * q) + off; }
        const int nig = WGM * nN, gid = wgid / nig, fm = gid * WGM, gsz = (nM - fm) < WGM ? (nM - fm) : WGM;
        u.pm = fm + ((wgid % nig) % gsz); u.pn = (wgid % nig) / gsz; return true;
    }
};
__device__ __forceinline__ unsigned cvt_pk_bf16(float lo, float hi) { unsigned r; asm volatile("v_cvt_pk_bf16_f32 %0, %1, %2" : "=v"(r) : "v"(lo), "v"(hi)); return r; }
struct EpiBf16 {
    static constexpr bool PERM = true;
    bf16_t* O0; int ld0; int split; bf16_t* O1; int ld1;
    __device__ __forceinline__ void operator()(const f32x4 (&acc)[2][2][4][2], const Unit& u, int wr, int wc, int fr, int fq) const {
        const int row0 = u.pm * BM + wr * 64 + fr; int colt = u.pn * BM; bf16_t* base = O0; int ld = ld0;
        if (colt >= split) { base = O1; ld = ld1; colt -= split; }
        const int col0 = colt + wc * 32 + 8 * fq;
#pragma unroll
        for (int ai = 0; ai < 2; ++ai)
#pragma unroll
            for (int m = 0; m < 4; ++m) { bf16_t* rowp = base + (size_t)(row0 + ai * HALF + m * 16) * ld + col0;
#pragma unroll
                for (int bj = 0; bj < 2; ++bj) { const f32x4 v0 = acc[ai][bj][m][0], v1 = acc[ai][bj][m][1];
                    u32x4 w; w.x = cvt_pk_bf16(v0[0], v0[1]); w.y = cvt_pk_bf16(v0[2], v0[3]); w.z = cvt_pk_bf16(v1[0], v1[1]); w.w = cvt_pk_bf16(v1[2], v1[3]);
                    *(u32x4*)(rowp + bj * HALF) = w; } }
    }
};
template <class Epi, class Sched>
__device__ __forceinline__ void gemm_phase(LAS unsigned char* lds, const Gemm g, const Sched& S, const Epi& E, const int wv0) {
    int tid = opaque_tid(wv0);
    const int wid = __builtin_amdgcn_readfirstlane(tid >> 6), lane = tid & 63, wr = wid >> 2, wc = wid & 3, fr = lane & 15, fq = lane >> 4;
    const int K = g.K, nt = K / BK;
    unsigned voffA[2], voffB[2];
#pragma unroll
    for (int i = 0; i < 2; ++i) { int R, C; stage_rc(tid * 16 + i * 8192, R, C); const int Rb = Epi::PERM ? ((R & ~31) + perm32(R & 31)) : R;
        voffA[i] = (unsigned)(R * K + C) * 2u; voffB[i] = (unsigned)(Rb * K + C) * 2u; }
    const size_t kstep = (size_t)(BK * 2);
    const size_t hstep = (size_t)HALF * K * 2;
    const size_t tstep = 2 * hstep;
    const unsigned ldsw = (unsigned)wid * 1024u;
    const int aoff = lds_byte(wr * 64 + fr, fq * 8), boff = lds_byte(wc * 32 + fr, fq * 8);
#define PG8_SA(b, h) (((b) * 2 + (h)) * HTB)
#define PG8_SB(b, h) ((4 + (b) * 2 + (h)) * HTB)
#define PG8_STAGE(bufoff, gbase, voff) do { _Pragma("unroll") for (int _i = 0; _i < 2; ++_i) \
        __builtin_amdgcn_global_load_lds((const unsigned*)((const char*)(gbase) + (voff)[_i]), (LAS unsigned*)(lds + (bufoff) + ldsw + _i * 8192), 16, 0, 0); } while (0)
#define PG8_LDA(dst, b, h) do { _Pragma("unroll") for (int m = 0; m < 4; ++m) _Pragma("unroll") for (int k = 0; k < 2; ++k) dst[m][k] = *(const LAS bf16x8*)(lds + PG8_SA(b, h) + aoff + m * 2048 + k * 1024); } while (0)
#define PG8_LDB(dst, b, h) do { _Pragma("unroll") for (int n = 0; n < 2; ++n) _Pragma("unroll") for (int k = 0; k < 2; ++k) dst[n][k] = *(const LAS bf16x8*)(lds + PG8_SB(b, h) + boff + n * 2048 + k * 1024); } while (0)
#define PG8_MMA(ai, bj, At, Bt) do { __builtin_amdgcn_s_setprio(1); _Pragma("unroll") for (int m = 0; m < 4; ++m) _Pragma("unroll") for (int n = 0; n < 2; ++n) _Pragma("unroll") for (int k = 0; k < 2; ++k) \
        acc[ai][bj][m][n] = __builtin_amdgcn_mfma_f32_16x16x32_bf16(Bt[n][k], At[m][k], acc[ai][bj][m][n], 0, 0, 0); __builtin_amdgcn_s_setprio(0); } while (0)
#define PG8_WAIT_V(n) asm volatile("s_waitcnt vmcnt(" #n ")" ::: "memory")
#define PG8_WAIT_L(n) asm volatile("s_waitcnt lgkmcnt(" #n ")" ::: "memory")
#define PG8_BAR __builtin_amdgcn_s_barrier()
#define PG8_SCHED __builtin_amdgcn_sched_barrier(0)
    Unit cur, nxt; int ui = 0;
    if (!S.next(0, cur)) return;
    f32x4 acc[2][2][4][2];
#pragma unroll
    for (int a = 0; a < 2; ++a)
#pragma unroll
        for (int b = 0; b < 2; ++b)
#pragma unroll
            for (int m = 0; m < 4; ++m)
#pragma unroll
                for (int n = 0; n < 2; ++n) acc[a][b][m][n] = (f32x4){0.f, 0.f, 0.f, 0.f};
    bf16x8 At[4][2], B0[2][2], B1[2][2];
    const char* cA = (const char*)g.A + (size_t)cur.pm * tstep; const char* cB = (const char*)g.Bt + (size_t)cur.pn * tstep;
    PG8_STAGE(PG8_SB(0, 0), cB, voffB); PG8_STAGE(PG8_SA(0, 0), cA, voffA); PG8_STAGE(PG8_SB(0, 1), cB + hstep, voffB); PG8_STAGE(PG8_SA(0, 1), cA + hstep, voffA);
    if (wr == 1) PG8_BAR;
    PG8_WAIT_V(4); PG8_BAR;
    PG8_STAGE(PG8_SB(1, 0), cB + kstep, voffB); PG8_STAGE(PG8_SA(1, 0), cA + kstep, voffA); PG8_STAGE(PG8_SB(1, 1), cB + hstep + kstep, voffB);
    PG8_WAIT_V(6); PG8_BAR;
    for (;;) {
        const bool has_next = S.next(ui + 1, nxt);
        const char* nA = has_next ? (const char*)g.A + (size_t)nxt.pm * tstep : cA; const char* nB = has_next ? (const char*)g.Bt + (size_t)nxt.pn * tstep : cB;
        for (int t = 0; t < nt; t += 2) {
            const bool last = (t == nt - 2);
            const char* a1 = cA + (size_t)(t + 1) * kstep;
            const char* a2 = last ? nA : cA + (size_t)(t + 2) * kstep; const char* b2 = last ? nB : cB + (size_t)(t + 2) * kstep;
            const char* a3 = a2 + kstep; const char* b3 = b2 + kstep;
            PG8_LDB(B0, 0, 0); PG8_SCHED; PG8_LDA(At, 0, 0); PG8_STAGE(PG8_SA(1, 1), a1 + hstep, voffA);
            PG8_WAIT_L(8); PG8_BAR; PG8_WAIT_L(0); PG8_MMA(0, 0, At, B0); PG8_BAR; PG8_SCHED;
            PG8_LDB(B1, 0, 1); PG8_STAGE(PG8_SB(0, 0), b2, voffB);
            PG8_BAR; PG8_WAIT_L(0); PG8_MMA(0, 1, At, B1); PG8_BAR;
            PG8_LDA(At, 0, 1); PG8_STAGE(PG8_SA(0, 0), a2, voffA);
            PG8_BAR; PG8_WAIT_L(0); PG8_MMA(1, 0, At, B0); PG8_BAR; PG8_SCHED;
            PG8_STAGE(PG8_SB(0, 1), b2 + hstep, voffB);
            PG8_WAIT_V(6); PG8_BAR; PG8_MMA(1, 1, At, B1); PG8_BAR;
            PG8_LDB(B0, 1, 0); PG8_SCHED; PG8_LDA(At, 1, 0); PG8_STAGE(PG8_SA(0, 1), a2 + hstep, voffA);
            PG8_WAIT_L(8); PG8_BAR; PG8_WAIT_L(0); PG8_MMA(0, 0, At, B0); PG8_BAR; PG8_SCHED;
            PG8_LDB(B1, 1, 1); PG8_STAGE(PG8_SB(1, 0), b3, voffB);
            PG8_BAR; PG8_WAIT_L(0); PG8_MMA(0, 1, At, B1); PG8_BAR;
            PG8_LDA(At, 1, 1); PG8_STAGE(PG8_SA(1, 0), a3, voffA);
            PG8_BAR; PG8_WAIT_L(0); PG8_MMA(1, 0, At, B0); PG8_BAR; PG8_SCHED;
            PG8_STAGE(PG8_SB(1, 1), b3 + hstep, voffB);
            PG8_WAIT_V(6); PG8_BAR; PG8_MMA(1, 1, At, B1); PG8_BAR;
        }
        E(acc, cur, wr, wc, fr, fq);
        if (!has_next) break;
#pragma unroll
        for (int a = 0; a < 2; ++a)
#pragma unroll
            for (int b = 0; b < 2; ++b)
#pragma unroll
                for (int m = 0; m < 4; ++m)
#pragma unroll
                    for (int n = 0; n < 2; ++n) acc[a][b][m][n] = (f32x4){0.f, 0.f, 0.f, 0.f};
        cur = nxt; cA = nA; cB = nB; ++ui;
    }
    PG8_WAIT_V(0);
    if (wr == 0) PG8_BAR;
    PG8_BAR;
#undef PG8_SA
#undef PG8_SB
#undef PG8_STAGE
#undef PG8_LDA
#undef PG8_LDB
#undef PG8_MMA
#undef PG8_WAIT_V
#undef PG8_WAIT_L
#undef PG8_BAR
#undef PG8_SCHED
}
}


#define XB_TMO      128
#define XB_XCNT(j)  (256  + 64 * (j))
#define XB_XSUB(j)  (1280 + 64 * (j))
#define XB_XGEN(j)  (2304 + 64 * (j))
#define XB_TOP      3328
#define XB_TOPGEN   3392
#define XCD_BAR_WORDS 3456
#define XB_SPIN_CAP (1u << 18)
__device__ __forceinline__ unsigned xb_ld(unsigned* p)              { return __hip_atomic_load(p, __ATOMIC_RELAXED, __HIP_MEMORY_SCOPE_AGENT); }
__device__ __forceinline__ unsigned xb_add(unsigned* p, unsigned v) { return __hip_atomic_fetch_add(p, v, __ATOMIC_RELAXED, __HIP_MEMORY_SCOPE_AGENT); }
__device__ __forceinline__ unsigned xb_xcc_id() { return (unsigned)__builtin_amdgcn_s_getreg((3 << 11) | 20) & 0xFu; }
#define XB_SPIN(cond, bar) do { unsigned _sp = 0; while (cond) { __builtin_amdgcn_s_sleep(1); \
    if ((++_sp & 255u) == 0u) { if (xb_ld(&(bar)[XB_TMO])) break; if (_sp > XB_SPIN_CAP) { atomicAdd(&(bar)[XB_TMO], 1u); break; } } } } while (0)
struct XcdBarrier { unsigned* bar; unsigned x; volatile LAS unsigned* st; };
__device__ __forceinline__ XcdBarrier xcd_barrier_post(unsigned* bar, volatile LAS unsigned* st) {
    XcdBarrier b; b.bar = bar; b.x = xb_xcc_id(); b.st = st;
    if (threadIdx.x == 0) (void)xb_add(&bar[XB_XCNT(b.x)], 1u);
    return b;
}
__device__ __forceinline__ void xcd_barrier_complete(unsigned* bar, unsigned x, unsigned& nloc, unsigned& nx) {
    const unsigned G = gridDim.x * gridDim.y * gridDim.z;
    unsigned sum, cnt, mine, sp = 0u;
    for (;;) {
        sum = 0u; cnt = 0u; mine = 0u;
#pragma unroll
        for (unsigned j = 0; j < 16; ++j) { const unsigned c = xb_ld(&bar[XB_XCNT(j)]); sum += c; cnt += (c > 0u) ? 1u : 0u; mine = (j == x) ? c : mine; }
        if (sum == G) break;
        __builtin_amdgcn_s_sleep(1);
        if ((++sp & 255u) == 0u) { if (xb_ld(&bar[XB_TMO])) break; if (sp > XB_SPIN_CAP) { atomicAdd(&bar[XB_TMO], 1u); break; } }
    }
    nloc = mine > 0u ? mine : 1u; nx = cnt > 0u ? cnt : 1u;
}
__device__ __forceinline__ void xcd_barrier(const XcdBarrier& b, const int wv0) {
    asm volatile("s_waitcnt vmcnt(0)" ::: "memory");
    __syncthreads();
    if (opaque_tid(wv0) == 0) {
        unsigned* bar = b.bar;
        __builtin_amdgcn_s_waitcnt(0);
        unsigned nloc = b.st[0], nx = b.st[1];
        if (nloc == 0u) { xcd_barrier_complete(bar, b.x, nloc, nx); b.st[0] = nloc; b.st[1] = nx; }
        const unsigned old = xb_add(&bar[XB_XSUB(b.x)], 1u);
        const unsigned gen = old / nloc;
        if (old + 1u == (gen + 1u) * nloc) {
            __builtin_amdgcn_fence(__ATOMIC_RELEASE, "agent");
            asm volatile("s_waitcnt vmcnt(0)" ::: "memory");
            const unsigned og = xb_add(&bar[XB_TOP], 1u);
            const unsigned tg = og / nx;
            if (og + 1u == (tg + 1u) * nx) xb_add(&bar[XB_TOPGEN], 1u);
            else XB_SPIN(xb_ld(&bar[XB_TOPGEN]) == tg, bar);
            __builtin_amdgcn_fence(__ATOMIC_ACQUIRE, "agent");
            xb_add(&bar[XB_XGEN(b.x)], 1u);
            asm volatile("s_waitcnt vmcnt(0)" ::: "memory");
        } else {
            XB_SPIN(xb_ld(&bar[XB_XGEN(b.x)]) == gen, bar);
            __builtin_amdgcn_fence(__ATOMIC_ACQUIRE, "agent");
            asm volatile("s_waitcnt vmcnt(0)" ::: "memory");
        }
    }
    __syncthreads();
}

struct Frame {
    LAS unsigned char* lds;
    int vcu, G, wv;
    const float* const* in; float* out; unsigned char* ws;
    __device__ __forceinline__ float* MOD() const { return (float*)(ws + WS_MOD); }
    __device__ __forceinline__ float* ROPE() const { return (float*)(ws + WS_ROPE); }
    __device__ __forceinline__ float* BA() const { return (float*)(ws + WS_BA); }
    __device__ __forceinline__ float* LAG() const { return (float*)(ws + WS_LAG); }
    __device__ __forceinline__ bf16_t* W1O() const { return (bf16_t*)(ws + WS_W1O); }
    __device__ __forceinline__ bf16_t* U0() const { return (bf16_t*)(ws + WS_RA); }
    __device__ __forceinline__ bf16_t* QKV1() const { return (bf16_t*)(ws + WS_RA); }
    __device__ __forceinline__ bf16_t* Z1() const { return (bf16_t*)(ws + WS_RA + (size_t)MT * 3072 * 2); }
    __device__ __forceinline__ bf16_t* Y1() const { return (bf16_t*)(ws + WS_RA); }
    __device__ __forceinline__ bf16_t* XN() const { return (bf16_t*)(ws + WS_RB + RB_XN); }
    __device__ __forceinline__ bf16_t* Y0() const { return (bf16_t*)(ws + WS_RB + RB_Y0); }
    __device__ __forceinline__ bf16_t* YO() const { return (bf16_t*)(ws + WS_RB + RB_YO); }
    __device__ __forceinline__ bf16_t* W0I() const { return (bf16_t*)(ws + WS_RB + RB_W0I); }
    __device__ __forceinline__ bf16_t* W0O() const { return (bf16_t*)(ws + WS_RB + RB_W0O); }
    __device__ __forceinline__ bf16_t* W1I() const { return (bf16_t*)(ws + WS_RB + RB_W1I); }
    __device__ __forceinline__ bf16_t* QKVC() const { return (bf16_t*)(ws + WS_RB); }
};

#define PHASE_IDS() int tid = opaque_tid(F.wv); const int lane = tid & 63, wave = __builtin_amdgcn_readfirstlane(tid >> 6); (void)lane; (void)wave
__device__ __forceinline__ void p0_transpose_item(const float* W, int ldw, int nblk, int K, bf16_t* WT, LAS float* scr, int item, int lane) {
    const int kb = item / nblk, nb = item % nblk, k0 = 64 * kb, n0 = 32 * nb;
#pragma unroll 8
    for (int i = 0; i < 32; ++i) { const int kk = 2 * i + (lane >> 5); scr[kk * 33 + (lane & 31)] = W[(size_t)(k0 + kk) * ldw + n0 + (lane & 31)]; }
    asm volatile("s_waitcnt lgkmcnt(0)" ::: "memory");
    const int c = lane & 7;
#pragma unroll
    for (int j = 0; j < 4; ++j) { const int n = (lane >> 3) + 8 * j; const LAS float* s = scr + (8 * c) * 33 + n;
        u32x4 o; o.x = pk2(s[0 * 33], s[1 * 33]); o.y = pk2(s[2 * 33], s[3 * 33]); o.z = pk2(s[4 * 33], s[5 * 33]); o.w = pk2(s[6 * 33], s[7 * 33]);
        *(u32x4*)(WT + (size_t)(n0 + n) * K + k0 + 8 * c) = o; }
    asm volatile("s_waitcnt lgkmcnt(0)" ::: "memory");
}
__device__ __forceinline__ void phase_prologue(Frame& F) {
    PHASE_IDS();
    const int gw = F.vcu * 8 + wave, NGW = F.G * 8;
    {
        LAS float* scr = (LAS float*)(F.lds + wave * 16384);
        constexpr int I0 = 16 * (EV_IN / 32), I1 = 16 * 32, I2 = 16 * (OD_MAIN / 32), I3 = 16 * 32;
        for (int it = gw; it < I0 + I1 + I2 + I3; it += NGW) {
            int r = it;
            if (r < I0) { p0_transpose_item(F.in[14], EV_IN, EV_IN / 32, D, F.W0I(), scr, r, lane); continue; } r -= I0;
            if (r < I1) { p0_transpose_item(F.in[23], D, 32, D, F.W0O(), scr, r, lane); continue; } r -= I1;
            if (r < I2) { p0_transpose_item(F.in[28], OD_IN, OD_MAIN / 32, D, F.W1I(), scr, r, lane); continue; } r -= I2;
            p0_transpose_item(F.in[33], D, 32, D, F.W1O(), scr, r, lane);
        }
    }
    {
        const double inv[8] = {1.0, 0.19392274474868576, 0.03760603093086393, 0.007292664737217109, 0.001414213562373095, 0.0002742481756762073, 5.318295896944988e-05, 1.031338537721246e-05};
        for (int idx = F.vcu * 512 + tid; idx < 4112 * 8; idx += F.G * 512) {
            const int pos = idx >> 3, i = idx & 7;
            double iv = inv[0];
#pragma unroll
            for (int q = 1; q < 8; ++q) iv = (i == q) ? inv[q] : iv;
            const double ang = (double)pos * iv;
            const double n = __builtin_rint(ang * 0.15915494309189535);
            const float r = (float)__builtin_fma(-n, 6.283185307179586, ang);
            F.ROPE()[pos * 16 + i] = __cosf(r); F.ROPE()[pos * 16 + 8 + i] = __sinf(r);
        }
    }
    {
        bf16_t* LGW = (bf16_t*)(F.ws + WS_LGW);
        for (int idx = F.vcu * 512 + tid; idx < 8 * 2 * 64 * 64; idx += F.G * 512) { const int k = idx & 63, n = (idx >> 6) & 63, gate = (idx >> 12) & 1, hh = idx >> 13;
            LGW[idx] = (bf16_t)f2bf((gate ? F.in[19] : F.in[17])[(hh * 64 + k) * 64 + n]); }
    }
    __syncthreads();
    for (int bt = F.vcu; bt < 96; bt += F.G) {
        LAS float* tab = (LAS float*)F.lds;
        for (int idx = tid; idx < 24 * 1024; idx += 512) { const int s = idx >> 10, k = idx & 1023;
            const float c = s < BP ? F.in[8][s * D + k] : F.in[9][(s - BP) * D + k]; tab[k * 24 + s] = siluf_(c); }
        __syncthreads();
        const int L = bt / 48, n0 = (bt % 48) * 64;
        const float* mw = (L == 0 ? F.in[10] : F.in[24]) + n0 + lane;
        float acc[24];
#pragma unroll
        for (int r = 0; r < 24; ++r) acc[r] = 0.f;
        for (int k = wave * 128; k < wave * 128 + 128; ++k) {
            const float w = mw[(size_t)k * 3072];
            const LAS f32x4* tp = (const LAS f32x4*)(tab + k * 24);
#pragma unroll
            for (int q = 0; q < 6; ++q) { const f32x4 t4 = tp[q]; acc[4 * q] += t4[0] * w; acc[4 * q + 1] += t4[1] * w; acc[4 * q + 2] += t4[2] * w; acc[4 * q + 3] += t4[3] * w; }
        }
        __syncthreads();
        LAS float* red = (LAS float*)F.lds;
#pragma unroll
        for (int r = 0; r < 24; ++r) red[(wave * 24 + r) * 64 + lane] = acc[r];
        __syncthreads();
        const float* mb = (L == 0 ? F.in[11] : F.in[25]);
        for (int idx = tid; idx < 24 * 64; idx += 512) { const int r = idx >> 6, l = idx & 63; float s = 0.f;
#pragma unroll
            for (int w = 0; w < 8; ++w) s += red[(w * 24 + r) * 64 + l];
            F.MOD()[((size_t)L * 24 + r) * 3072 + n0 + l] = s + mb[n0 + l]; }
        __syncthreads();
    }
}

__device__ __forceinline__ void phase_prenorm0(Frame& F) {
    PHASE_IDS();
    const int gw = F.vcu * 8 + wave, NGW = F.G * 8;
    for (int m = gw; m < MT; m += NGW) {
        int s, t; tok_info(m, s, t);
        const float* xrow = m < MP ? F.in[0] + (size_t)m * D : F.in[1] + (size_t)(m - MP) * D;
        const float* modr = F.MOD() + (size_t)s * 3072;
        f32x4 v[4]; float ss = 0.f;
#pragma unroll
        for (int j = 0; j < 4; ++j) { v[j] = *(const f32x4*)(xrow + 4 * lane + 256 * j); ss += (v[j][0] * v[j][0] + v[j][1] * v[j][1]) + (v[j][2] * v[j][2] + v[j][3] * v[j][3]); }
        const float r = rsqrtf(wave_sum(ss, lane) * (1.f / D) + EPS);
#pragma unroll
        for (int j = 0; j < 4; ++j) { const int c = 4 * lane + 256 * j;
            const f32x4 g = *(const f32x4*)(F.in[12] + c), sh = *(const f32x4*)(modr + c), sc = *(const f32x4*)(modr + 1024 + c);
            f32x4 o;
#pragma unroll
            for (int e = 0; e < 4; ++e) o[e] = v[j][e] * r * g[e] * (1.f + sc[e]) + sh[e];
            u32x2 w; w.x = pk2(o[0], o[1]); w.y = pk2(o[2], o[3]); *(u32x2*)(F.XN() + (size_t)m * D + c) = w; }
    }
}

__device__ __forceinline__ void phase_rope(Frame& F) {
    PHASE_IDS();
    const int gt = F.vcu * 512 + tid, NT = F.G * 512;
    for (int idx = gt; idx < MT * 80; idx += NT) {
        const int m = idx / 80, r = idx % 80, slot = r >> 3, i = r & 7;
        int s, t; tok_info(m, s, t);
        const int pos = s < BP ? t : TP + t;
        const int col = slot < 8 ? C_Q + slot * 64 : C_K + (slot - 8) * 64;
        bf16_t* p = F.U0() + (size_t)m * EV_IN + col;
        const float x1 = bf2f(p[i]), x2 = bf2f(p[8 + i]), c = F.ROPE()[pos * 16 + i], sn = F.ROPE()[pos * 16 + 8 + i];
        const float o1 = x1 * c - x2 * sn, o2 = x2 * c + x1 * sn;
        p[i] = (bf16_t)f2bf(o1); p[8 + i] = (bf16_t)f2bf(o2);
        if (slot >= 8) { const int kv = slot - 8;
            if (s >= BP) { float* o = F.out + O_KS + ((size_t)((s - BP) * TS + t) * 2 + kv) * 64; o[i] = o1; o[8 + i] = o2; }
            else if (t >= TP - 128) { float* o = F.out + O_KP + ((size_t)(s * 128 + (t - (TP - 128))) * 2 + kv) * 64; o[i] = o1; o[8 + i] = o2; } }
    }
    for (int idx = gt; idx < 1280 * 224; idx += NT) {
        const int tk = idx / 224, e = idx % 224;
        int s, t, m; if (tk < 1024) { s = tk >> 7; t = TP - 128 + (tk & 127); m = s * TP + t; } else { s = BP + ((tk - 1024) >> 4); t = (tk - 1024) & 15; m = MP + (tk - 1024); }
        const bool isv = e >= 96; const int e2 = isv ? e - 96 : e; const int kv = isv ? (e2 >> 6) : (e2 / 48), d = isv ? (e2 & 63) : 16 + (e2 % 48);
        const float val = bf2f(F.U0()[(size_t)m * EV_IN + (isv ? C_V : C_K) + kv * 64 + d]);
        const size_t ob = s >= BP ? (isv ? O_VS : O_KS) + ((size_t)((s - BP) * TS + t) * 2 + kv) * 64 : (isv ? O_VP : O_KP) + ((size_t)(s * 128 + (t - (TP - 128))) * 2 + kv) * 64;
        F.out[ob + d] = val;
    }
}


__device__ __forceinline__ void phase_mid_rowwise(Frame& F) {
    PHASE_IDS();
    LAS float* baw = (LAS float*)F.lds;
    for (int idx = tid; idx < 16 * 1024; idx += 512) { const int j = idx & 15, k = idx >> 4; baw[j * 1024 + k] = F.in[28][(size_t)k * OD_IN + OD_MAIN + j]; }
    __syncthreads();
    const int gw = F.vcu * 8 + wave, NGW = F.G * 8;
    for (int m = gw; m < MT; m += NGW) {
        int s, t; tok_info(m, s, t);
        const float* xrow = m < MP ? F.in[0] + (size_t)m * D : F.in[1] + (size_t)(m - MP) * D;
        const float* mod0 = F.MOD() + (size_t)s * 3072; const float* mod1 = F.MOD() + (size_t)(24 + s) * 3072;
        f32x4 y[4]; float ss = 0.f;
#pragma unroll
        for (int j = 0; j < 4; ++j) { const u32x2 w = *(const u32x2*)(F.YO() + (size_t)m * D + 4 * lane + 256 * j); y[j] = (f32x4){lo16(w.x), hi16(w.x), lo16(w.y), hi16(w.y)};
            ss += (y[j][0] * y[j][0] + y[j][1] * y[j][1]) + (y[j][2] * y[j][2] + y[j][3] * y[j][3]); }
        const float r1 = rsqrtf(wave_sum(ss, lane) * (1.f / D) + EPS);
        f32x4 x1[4]; float s2 = 0.f;
#pragma unroll
        for (int j = 0; j < 4; ++j) { const int c = 4 * lane + 256 * j;
            const f32x4 xv = *(const f32x4*)(xrow + c), g = *(const f32x4*)(F.in[13] + c), gt = *(const f32x4*)(mod0 + 2048 + c);
#pragma unroll
            for (int e = 0; e < 4; ++e) x1[j][e] = xv[e] + gt[e] * (y[j][e] * r1 * g[e]);
            *(f32x4*)(F.out + O_Y + (size_t)m * D + c) = x1[j];
            s2 += (x1[j][0] * x1[j][0] + x1[j][1] * x1[j][1]) + (x1[j][2] * x1[j][2] + x1[j][3] * x1[j][3]); }
        const float r2 = rsqrtf(wave_sum(s2, lane) * (1.f / D) + EPS);
        f32x4 hm[4];
#pragma unroll
        for (int j = 0; j < 4; ++j) { const int c = 4 * lane + 256 * j;
            const f32x4 g = *(const f32x4*)(F.in[26] + c), sh = *(const f32x4*)(mod1 + c), sc = *(const f32x4*)(mod1 + 1024 + c);
#pragma unroll
            for (int e = 0; e < 4; ++e) hm[j][e] = x1[j][e] * r2 * g[e] * (1.f + sc[e]) + sh[e];
            u32x2 w; w.x = pk2(hm[j][0], hm[j][1]); w.y = pk2(hm[j][2], hm[j][3]); *(u32x2*)(F.XN() + (size_t)m * D + c) = w; }
        float mine = 0.f;
#pragma unroll 1
        for (int q = 0; q < 16; ++q) { float p = 0.f;
#pragma unroll
            for (int j = 0; j < 4; ++j) { const f32x4 w = *(const LAS f32x4*)(baw + q * 1024 + 256 * j + 4 * lane); p += (hm[j][0] * w[0] + hm[j][1] * w[1]) + (hm[j][2] * w[2] + hm[j][3] * w[3]); }
            p = wave_sum(p, lane); mine = (lane == q) ? p : mine; }
        if (lane < 16) F.BA()[(size_t)m * 16 + lane] = mine;
    }
}


typedef float f32x16 __attribute__((ext_vector_type(16)));
typedef __bf16 bf16x2_t __attribute__((ext_vector_type(2)));
constexpr int GS_WF = 0, GS_QF = 16384, GS_KF = 32768, GS_PF = 49152, GS_UF = 57344, GS_BYTES = 73728;
constexpr size_t WS_DEC = 11 * MiB;
__device__ __forceinline__ unsigned cvt2(float a, float b) { f32x2 v = {a, b}; bf16x2_t r = __builtin_convertvector(v, bf16x2_t); return __builtin_bit_cast(unsigned, r); }
__device__ __forceinline__ int krow(int s, int h, int j) { return 16 * s + 8 * (j >> 2) + 4 * h + (j & 3); }
#define MFMA32(a, b, c) __builtin_amdgcn_mfma_f32_32x32x16_bf16((a), (b), (c), 0, 0, 0)
#define MFMA16(a, b, c) __builtin_amdgcn_mfma_f32_16x16x32_bf16((a), (b), (c), 0, 0, 0)

constexpr int G1_QS = 0, G1_KS = 17408, G1_VS = 34816, G1_AS = 52224, G1_PS = 69632, G1_WS = 78848, G1_CW = 96256, G1_VEC = 102400, G1_ES = 103424;
__device__ __forceinline__ void g1_load_raw(Frame& F, u32x4 (&raw)[24], int s, int c, int h, int t1) {
    const int r = t1 >> 3, j = t1 & 7, t = c * 64 + r;
#pragma unroll
    for (int p = 0; p < 3; ++p)
#pragma unroll
        for (int jj = 0; jj < 4; ++jj) { const int tt = t - 3 + jj, ttc = tt < 0 ? 0 : tt;
            const u32x4* src = (const u32x4*)(F.QKV1() + (size_t)(s * TP + ttc) * 3072 + p * 1024 + h * 128 + j * 16); raw[p * 8 + jj * 2] = src[0]; raw[p * 8 + jj * 2 + 1] = src[1]; }
}
__device__ __forceinline__ bf16x8 g1_pack_b(const f32x4 p, const f32x4 q) { u32x4 w; w[0] = cvt2(p[0], p[1]); w[1] = cvt2(p[2], p[3]); w[2] = cvt2(q[0], q[1]); w[3] = cvt2(q[2], q[3]); return __builtin_bit_cast(bf16x8, w); }
__device__ __forceinline__ void phase_gdn_g1(Frame& F) {
    int tid = opaque_tid(F.wv);
    const int lane = tid & 63, wave = __builtin_amdgcn_readfirstlane(tid >> 6);
    LAS unsigned char* L = F.lds;
    LAS float* cw_s = (LAS float*)(L + G1_CW);
    LAS float* beta_s = (LAS float*)(L + G1_VEC); LAS float* gcum_s = beta_s + 64; LAS float* eg_s = beta_s + 128; LAS float* ek_s = beta_s + 192;
    float* DEC = (float*)(F.ws + WS_DEC);
    u32x4 raw[24];
    if (F.vcu < 4096) g1_load_raw(F, raw, F.vcu >> 9, (F.vcu >> 3) & 63, F.vcu & 7, tid);
    for (int task = F.vcu; task < 4224; task += F.G) {
        const int tid = opaque_tid(F.wv), lane = tid & 63;
        int s, c, h; if (task < 4096) { s = task >> 9; c = (task >> 3) & 63; h = task & 7; } else { s = BP + ((task - 4096) >> 3); c = 0; h = task & 7; }
        const int nvalid = s < BP ? 64 : TS, t0 = c * 64, base = seq_base(s), T = seq_len(s);
        const int sidx = task < 4096 ? ((s * 8 + h) * 64 + c) : task;
        unsigned char* blk = F.ws + WS_RB + (size_t)sidx * GS_BYTES;
        for (int i = tid; i < 4 * 384; i += 512) { const int jj = i / 384, cc = i % 384; cw_s[i] = F.in[29][(size_t)jj * 3072 + (cc >> 7) * 1024 + h * 128 + (cc & 127)]; }
        if (tid < 64) {
            const bool ok = tid < nvalid; float beta = 0.f, g = 0.f;
            if (ok) { const float* ba = F.BA() + (size_t)(base + t0 + tid) * 16; beta = sigmoidf_(ba[h]); g = -__expf(F.in[30][h]) * softplusf_(ba[8 + h] + F.in[31][h]); }
            float x = g;
#pragma unroll
            for (int o = 1; o < 64; o <<= 1) { const float y = shfl_idx(x, lane >= o ? lane - o : lane); if (lane >= o) x += y; }
            const float gl = shfl_idx(x, 63);
            beta_s[tid] = beta; gcum_s[tid] = x; eg_s[tid] = __expf(x); ek_s[tid] = ok ? __expf(gl - x) : 0.f;
            if (tid == 0) DEC[sidx] = __expf(gl);
        }
        __syncthreads();
        {
            int t1 = tid; asm volatile("" : "+v"(t1));
            const int r = t1 >> 3, j = t1 & 7, t = t0 + r; const bool ok = r < nvalid;
#pragma unroll
            for (int p = 0; p < 3; ++p) {
                float acc[16], cur[16];
#pragma unroll
                for (int e = 0; e < 16; ++e) { acc[e] = 0.f; cur[e] = 0.f; }
                const int cb = p * 1024 + h * 128 + j * 16;
#pragma unroll
                for (int jj = 0; jj < 4; ++jj) {
                    const int tt = t - 3 + jj; float x[16];
                    if (s < BP) { const u32x4 a = raw[p * 8 + jj * 2], b = raw[p * 8 + jj * 2 + 1]; const bool v = tt >= 0;
#pragma unroll
                        for (int e = 0; e < 4; ++e) { x[2 * e] = v ? lo16(a[e]) : 0.f; x[2 * e + 1] = v ? hi16(a[e]) : 0.f; x[8 + 2 * e] = v ? lo16(b[e]) : 0.f; x[8 + 2 * e + 1] = v ? hi16(b[e]) : 0.f; } }
                    else if (ok && tt >= 0) { const u32x4* src = (const u32x4*)(F.QKV1() + (size_t)(base + tt) * 3072 + cb); const u32x4 a = src[0], b = src[1];
#pragma unroll
                        for (int e = 0; e < 4; ++e) { x[2 * e] = lo16(a[e]); x[2 * e + 1] = hi16(a[e]); x[8 + 2 * e] = lo16(b[e]); x[8 + 2 * e + 1] = hi16(b[e]); } }
                    else if (ok) { const f32x4* src = (const f32x4*)(F.in[6] + ((size_t)(s - BP) * 3 + (tt + 3)) * 3072 + cb);
#pragma unroll
                        for (int q = 0; q < 4; ++q) { const f32x4 a = src[q]; x[4 * q] = a[0]; x[4 * q + 1] = a[1]; x[4 * q + 2] = a[2]; x[4 * q + 3] = a[3]; } }
                    else {
#pragma unroll
                        for (int e = 0; e < 16; ++e) x[e] = 0.f; }
                    const LAS f32x4* wp = (const LAS f32x4*)(cw_s + jj * 384 + p * 128 + j * 16);
#pragma unroll
                    for (int q = 0; q < 4; ++q) { const f32x4 w4 = wp[q]; acc[4 * q] += w4[0] * x[4 * q]; acc[4 * q + 1] += w4[1] * x[4 * q + 1]; acc[4 * q + 2] += w4[2] * x[4 * q + 2]; acc[4 * q + 3] += w4[3] * x[4 * q + 3]; }
                    if (jj == 3) {
#pragma unroll
                        for (int e = 0; e < 16; ++e) cur[e] = x[e]; }
                }
                if (ok && t >= T - 3) {
                    float* o = (s < BP ? F.out + O_GCP + ((size_t)s * 3 + (t - (T - 3))) * 3072 : F.out + O_GCS + ((size_t)(s - BP) * 3 + (t - (T - 3))) * 3072) + cb;
#pragma unroll
                    for (int q = 0; q < 4; ++q) *(f32x4*)(o + 4 * q) = (f32x4){cur[4 * q], cur[4 * q + 1], cur[4 * q + 2], cur[4 * q + 3]};
                }
                float ss = 0.f;
#pragma unroll
                for (int e = 0; e < 16; ++e) { acc[e] = siluf_(acc[e]); ss += acc[e] * acc[e]; }
                if (p < 2) { ss += shfl_xor_l(ss, 1, lane); ss += shfl_xor_l(ss, 2, lane); ss += shfl_xor_l(ss, 4, lane);
                    float sc = rsqrtf(ss + EPS); if (p == 0) sc *= 0.08838834764831845f;
#pragma unroll
                    for (int e = 0; e < 16; ++e) acc[e] *= sc; }
                u32x4 w0, w1;
#pragma unroll
                for (int e = 0; e < 4; ++e) { w0[e] = ok ? cvt2(acc[2 * e], acc[2 * e + 1]) : 0u; w1[e] = ok ? cvt2(acc[8 + 2 * e], acc[8 + 2 * e + 1]) : 0u; }
                LAS u32x4* dst = (LAS u32x4*)(L + (p == 0 ? G1_QS : p == 1 ? G1_KS : G1_VS) + r * 272 + j * 32);
                dst[0] = w0; dst[1] = w1;
                __builtin_amdgcn_sched_barrier(0);
            }
            { const int ntk = task + F.G < 4095 ? task + F.G : 4095; g1_load_raw(F, raw, ntk >> 9, (ntk >> 3) & 63, ntk & 7, t1); }
        }
        __syncthreads();
        {
            int l2 = lane; asm volatile("" : "+v"(l2));
            const int which = wave >> 2, ti = (wave >> 1) & 1, tj = wave & 1, r = l2 & 31, hh = l2 >> 5;
            f32x16 acc;
#pragma unroll
            for (int e = 0; e < 16; ++e) acc[e] = 0.f;
            if (!(ti == 0 && tj == 1)) {
                const LAS unsigned char* ap = L + (which ? G1_QS : G1_KS) + (32 * ti + r) * 272 + hh * 16;
                const LAS unsigned char* bp = L + G1_KS + (32 * tj + r) * 272 + hh * 16;
#pragma unroll
                for (int ks = 0; ks < 8; ++ks) { const bf16x8 a = *(const LAS bf16x8*)(ap + ks * 32), b = *(const LAS bf16x8*)(bp + ks * 32); acc = MFMA32(a, b, acc); }
            }
            const int jc = 32 * tj + r; const float gj = gcum_s[jc];
#pragma unroll
            for (int e = 0; e < 16; ++e) {
                const int i = 32 * ti + (e & 3) + 8 * (e >> 2) + 4 * hh; const float dg = gcum_s[i] - gj;
                if (which == 0) { const float f = (i > jc) ? __expf(dg) * beta_s[i] : 0.f; *(LAS float*)(L + G1_AS + i * 272 + jc * 4) = acc[e] * f; }
                else { const float f = (i >= jc) ? __expf(dg) : 0.f; *(LAS bf16_t*)(L + G1_PS + i * 144 + jc * 2) = (bf16_t)(cvt2(acc[e] * f, 0.f) & 0xffffu); }
            }
        }
        __syncthreads();
        if (wave == 0) {
            int l3 = lane; asm volatile("" : "+v"(l3));
            const int bk = l3 >> 4, col = l3 & 15;
            float tcol[16];
#pragma unroll
            for (int rr = 0; rr < 16; ++rr) {
                float a = (rr == col) ? 1.0f : 0.f;
#pragma unroll
                for (int j4 = 0; j4 < (rr + 3) / 4; ++j4) { const f32x4 a4 = *(const LAS f32x4*)(L + G1_AS + (16 * bk + rr) * 272 + (16 * bk + 4 * j4) * 4);
#pragma unroll
                    for (int q = 0; q < 4; ++q) if (4 * j4 + q < rr) a -= a4[q] * tcol[4 * j4 + q]; }
                tcol[rr] = a;
                *(LAS float*)(L + G1_ES + ((bk * 16 + rr) * 16 + col) * 4) = a - ((rr == col) ? 1.0f : 0.f);
            }
        } else if (wave >= 4) {
            int l3 = lane; asm volatile("" : "+v"(l3));
            const int wv = wave - 4, r = l3 & 31, hh = l3 >> 5;
            {   const int rt4 = wv;
#pragma unroll
                for (int kt2 = 0; kt2 < 2; ++kt2)
#pragma unroll
                    for (int ss = 0; ss < 2; ++ss) { float v[8];
#pragma unroll
                        for (int j = 0; j < 8; ++j) { const int tok = 32 * kt2 + krow(ss, hh, j); v[j] = bf2f(*(const LAS bf16_t*)(L + G1_KS + tok * 272 + (32 * rt4 + r) * 2)) * ek_s[tok]; }
                        u32x4 o; o[0] = cvt2(v[0], v[1]); o[1] = cvt2(v[2], v[3]); o[2] = cvt2(v[4], v[5]); o[3] = cvt2(v[6], v[7]);
                        *(u32x4*)(blk + GS_KF + ((rt4 * 2 + kt2) * 2 + ss) * 1024 + l3 * 16) = o; } }
            {   const int kt = wv;
#pragma unroll
                for (int rt = 0; rt < 2; ++rt)
#pragma unroll
                    for (int ss = 0; ss < 2; ++ss) { const int i = 32 * rt + r; const float sc = eg_s[i];
                        const u32x2 lo = *(const LAS u32x2*)(L + G1_QS + i * 272 + (32 * kt + 16 * ss + 4 * hh) * 2), hi = *(const LAS u32x2*)(L + G1_QS + i * 272 + (32 * kt + 16 * ss + 8 + 4 * hh) * 2);
                        u32x4 o; o[0] = cvt2(lo16(lo[0]) * sc, hi16(lo[0]) * sc); o[1] = cvt2(lo16(lo[1]) * sc, hi16(lo[1]) * sc); o[2] = cvt2(lo16(hi[0]) * sc, hi16(hi[0]) * sc); o[3] = cvt2(lo16(hi[1]) * sc, hi16(hi[1]) * sc);
                        *(u32x4*)(blk + GS_QF + ((rt * 4 + kt) * 2 + ss) * 1024 + l3 * 16) = o; } }
            {   const int rt = wv >> 1, kt2 = wv & 1;
#pragma unroll
                for (int ss = 0; ss < 2; ++ss) { const int i = 32 * rt + r;
                    const u32x2 lo = *(const LAS u32x2*)(L + G1_PS + i * 144 + (32 * kt2 + 16 * ss + 4 * hh) * 2), hi = *(const LAS u32x2*)(L + G1_PS + i * 144 + (32 * kt2 + 16 * ss + 8 + 4 * hh) * 2);
                    u32x4 o; o[0] = lo[0]; o[1] = lo[1]; o[2] = hi[0]; o[3] = hi[1];
                    *(u32x4*)(blk + GS_PF + ((rt * 2 + kt2) * 2 + ss) * 1024 + l3 * 16) = o; } }
        }
        __syncthreads();
        {
            int l4 = lane; asm volatile("" : "+v"(l4));
            const int c16 = l4 & 15, g = l4 >> 4;
            const f32x4 z4 = {0.f, 0.f, 0.f, 0.f};
            f32x4 a10, a20, a21, a30, a31, a32, e0, e1, e2, e3;
            { const LAS unsigned char* ar = L + G1_AS + c16 * 272 + (4 * g) * 4;
              a10 = *(const LAS f32x4*)(ar + 16 * 272); a20 = *(const LAS f32x4*)(ar + 32 * 272); a21 = *(const LAS f32x4*)(ar + 32 * 272 + 64);
              a30 = *(const LAS f32x4*)(ar + 48 * 272); a31 = *(const LAS f32x4*)(ar + 48 * 272 + 64); a32 = *(const LAS f32x4*)(ar + 48 * 272 + 128);
              const LAS unsigned char* er = L + G1_ES + (c16 * 16 + 4 * g) * 4;
              e0 = *(const LAS f32x4*)er; e1 = *(const LAS f32x4*)(er + 1024); e2 = *(const LAS f32x4*)(er + 2048); e3 = *(const LAS f32x4*)(er + 3072); }
            const bf16x8 fA10 = g1_pack_b(z4 - a10, z4), fA2 = g1_pack_b(z4 - a20, z4 - a21), fA3a = g1_pack_b(z4 - a30, z4 - a31), fA3b = g1_pack_b(z4 - a32, z4);
            const bf16x8 fE0 = g1_pack_b(e0, z4), fE1 = g1_pack_b(e1, z4), fE2 = g1_pack_b(e2, z4), fE3 = g1_pack_b(e3, z4);
            const bool isw = wave < 4; const int cbase = 32 * (wave & 3);
#pragma unroll
            for (int tl = 0; tl < 2; ++tl) {
                const int d = cbase + 16 * tl + c16;
                f32x4 R[4];
#pragma unroll
                for (int i = 0; i < 4; ++i)
#pragma unroll
                    for (int e = 0; e < 4; ++e) { const int row = 16 * i + 4 * g + e; const float raw1 = bf2f(*(const LAS bf16_t*)(L + (isw ? G1_KS : G1_VS) + row * 272 + d * 2)); R[i][e] = raw1 * beta_s[row] * (isw ? eg_s[row] : 1.0f); }
                const f32x4 X0 = MFMA16(fE0, g1_pack_b(R[0], z4), R[0]);
                const f32x4 Y1 = MFMA16(fA10, g1_pack_b(X0, z4), R[1]);
                const f32x4 X1 = MFMA16(fE1, g1_pack_b(Y1, z4), Y1);
                const f32x4 Y2 = MFMA16(fA2, g1_pack_b(X0, X1), R[2]);
                const f32x4 X2 = MFMA16(fE2, g1_pack_b(Y2, z4), Y2);
                f32x4 Y3 = MFMA16(fA3a, g1_pack_b(X0, X1), R[3]);
                Y3 = MFMA16(fA3b, g1_pack_b(X2, z4), Y3);
                const f32x4 X3 = MFMA16(fE3, g1_pack_b(Y3, z4), Y3);
                const f32x4 X[4] = {X0, X1, X2, X3};
                if (isw) {
#pragma unroll
                    for (int i = 0; i < 4; ++i)
#pragma unroll
                        for (int e = 0; e < 4; ++e) *(LAS bf16_t*)(L + G1_WS + (16 * i + 4 * g + e) * 272 + d * 2) = (bf16_t)(cvt2(-X[i][e], 0.f) & 0xffffu);
                } else {
                    const int ws = wave & 3, cc = 16 * tl + c16;
#pragma unroll
                    for (int i = 0; i < 4; ++i) { const int rt = i >> 1, q = 2 * (i & 1) + (g >> 1), hh = g & 1;
                        u32x2 o; o[0] = cvt2(X[i][0], X[i][1]); o[1] = cvt2(X[i][2], X[i][3]);
                        *(u32x2*)(blk + GS_UF + (size_t)(((ws * 2 + rt) * 64) + cc + 32 * hh) * 32 + q * 8) = o; }
                }
            }
        }
        __syncthreads();
        {
            int l5 = lane; asm volatile("" : "+v"(l5));
            const int kt = wave & 3, rt = wave >> 2, r = l5 & 31, hh = l5 >> 5, i = 32 * rt + r;
#pragma unroll
            for (int ss = 0; ss < 2; ++ss) {
                const u32x2 lo = *(const LAS u32x2*)(L + G1_WS + i * 272 + (32 * kt + 16 * ss + 4 * hh) * 2), hi = *(const LAS u32x2*)(L + G1_WS + i * 272 + (32 * kt + 16 * ss + 8 + 4 * hh) * 2);
                u32x4 o; o[0] = lo[0]; o[1] = lo[1]; o[2] = hi[0]; o[3] = hi[1];
                *(u32x4*)(blk + GS_WF + ((rt * 4 + kt) * 2 + ss) * 1024 + l5 * 16) = o; }
        }
        __syncthreads();
    }
}

constexpr int G2_FB = GS_BYTES, G2_OSTRIDE = 528, G2_HN = 2 * G2_FB, G2_DEC = G2_HN + 512;
__device__ __forceinline__ bf16x8 pack8(const f32x16& x, const int s) {
    u32x4 p; p[0] = cvt2(x[8 * s], x[8 * s + 1]); p[1] = cvt2(x[8 * s + 2], x[8 * s + 3]); p[2] = cvt2(x[8 * s + 4], x[8 * s + 5]); p[3] = cvt2(x[8 * s + 6], x[8 * s + 7]);
    return __builtin_bit_cast(bf16x8, p);
}
#define LDS_BARRIER() do { asm volatile("s_waitcnt lgkmcnt(0)" ::: "memory"); __builtin_amdgcn_s_barrier(); asm volatile("" ::: "memory"); } while (0)
__device__ __forceinline__ void g2_load_set(u32x4 (&pre)[18], const unsigned char* blk, int lt) {
    const u32x4* src = (const u32x4*)blk;
#pragma unroll
    for (int i = 0; i < 18; ++i) pre[i] = src[i * 256 + lt];
}
__device__ __forceinline__ void g2_store_set(const u32x4 (&pre)[18], LAS unsigned char* dst, int lt) {
#pragma unroll
    for (int i = 0; i < 18; ++i) *(LAS u32x4*)(dst + (size_t)(i * 256 + lt) * 16) = pre[i];
}
#define G2_FRAG(off) (*(const LAS bf16x8*)(B + (off)))
#define G2_SCHED() __builtin_amdgcn_sched_barrier(0)
__device__ __forceinline__ void g2_mfma_step(f32x16& S0, f32x16& S1, f32x16& S2, f32x16& S3, LAS unsigned char* Bimg, const float dec, int ws, int lane, int cc, int hh) {
    const LAS unsigned char* B = Bimg + lane * 16;
    f32x16 vn0, vn1, o0, o1;
    { const LAS u32x4* up = (const LAS u32x4*)(Bimg + GS_UF + (size_t)(ws * 2 * 64 + lane) * 32); const u32x4 u0 = up[0], u1 = up[1], u2 = up[128], u3 = up[129];
#pragma unroll
      for (int q = 0; q < 4; ++q) { vn0[2 * q] = lo16(u0[q]); vn0[2 * q + 1] = hi16(u0[q]); vn0[8 + 2 * q] = lo16(u1[q]); vn0[8 + 2 * q + 1] = hi16(u1[q]);
                                    vn1[2 * q] = lo16(u2[q]); vn1[2 * q + 1] = hi16(u2[q]); vn1[8 + 2 * q] = lo16(u3[q]); vn1[8 + 2 * q + 1] = hi16(u3[q]); } }
#pragma unroll
    for (int e = 0; e < 16; ++e) { o0[e] = 0.f; o1[e] = 0.f; }
    bf16x8 fa[8], fb[8];
#define G2_LD_WQ(dst, kt) do { _Pragma("unroll") for (int ss = 0; ss < 2; ++ss) { dst[4 * ss] = G2_FRAG(GS_WF + ((0 * 4 + kt) * 2 + ss) * 1024); dst[4 * ss + 1] = G2_FRAG(GS_WF + ((1 * 4 + kt) * 2 + ss) * 1024); \
        dst[4 * ss + 2] = G2_FRAG(GS_QF + ((0 * 4 + kt) * 2 + ss) * 1024); dst[4 * ss + 3] = G2_FRAG(GS_QF + ((1 * 4 + kt) * 2 + ss) * 1024); } } while (0)
#define G2_MM_WQ(src, Sx) do { _Pragma("unroll") for (int ss = 0; ss < 2; ++ss) { const bf16x8 sb = pack8(Sx, ss); \
        vn0 = MFMA32(src[4 * ss], sb, vn0); vn1 = MFMA32(src[4 * ss + 1], sb, vn1); o0 = MFMA32(src[4 * ss + 2], sb, o0); o1 = MFMA32(src[4 * ss + 3], sb, o1); } } while (0)
    G2_LD_WQ(fa, 0);
    G2_SCHED(); G2_LD_WQ(fb, 1); G2_SCHED(); G2_MM_WQ(fa, S0);
    G2_SCHED(); G2_LD_WQ(fa, 2); G2_SCHED(); G2_MM_WQ(fb, S1);
    G2_SCHED(); G2_LD_WQ(fb, 3); G2_SCHED(); G2_MM_WQ(fa, S2);
    G2_SCHED();
#pragma unroll
    for (int kt2 = 0; kt2 < 2; ++kt2)
#pragma unroll
        for (int ss = 0; ss < 2; ++ss) { fa[(kt2 * 2 + ss) * 2] = G2_FRAG(GS_PF + ((0 * 2 + kt2) * 2 + ss) * 1024); fa[(kt2 * 2 + ss) * 2 + 1] = G2_FRAG(GS_PF + ((1 * 2 + kt2) * 2 + ss) * 1024); }
    G2_SCHED(); G2_MM_WQ(fb, S3);
    G2_SCHED();
#define G2_LD_K(dst, kt2) do { _Pragma("unroll") for (int ss = 0; ss < 2; ++ss) _Pragma("unroll") for (int rt4 = 0; rt4 < 4; ++rt4) dst[ss * 4 + rt4] = G2_FRAG(GS_KF + ((rt4 * 2 + kt2) * 2 + ss) * 1024); } while (0)
    G2_LD_K(fb, 0);
    bf16x8 vb[2][2];
    vb[0][0] = pack8(vn0, 0); vb[0][1] = pack8(vn0, 1); vb[1][0] = pack8(vn1, 0); vb[1][1] = pack8(vn1, 1);
    S0 = S0 * dec; S1 = S1 * dec; S2 = S2 * dec; S3 = S3 * dec;
    G2_SCHED();
#pragma unroll
    for (int kt2 = 0; kt2 < 2; ++kt2)
#pragma unroll
        for (int ss = 0; ss < 2; ++ss) { o0 = MFMA32(fa[(kt2 * 2 + ss) * 2], vb[kt2][ss], o0); o1 = MFMA32(fa[(kt2 * 2 + ss) * 2 + 1], vb[kt2][ss], o1); }
    G2_SCHED(); G2_LD_K(fa, 1); G2_SCHED();
#define G2_MM_K(src, kt2) do { _Pragma("unroll") for (int ss = 0; ss < 2; ++ss) { S0 = MFMA32(src[ss * 4], vb[kt2][ss], S0); S1 = MFMA32(src[ss * 4 + 1], vb[kt2][ss], S1); S2 = MFMA32(src[ss * 4 + 2], vb[kt2][ss], S2); S3 = MFMA32(src[ss * 4 + 3], vb[kt2][ss], S3); } } while (0)
    G2_MM_K(fb, 0);
    G2_SCHED();
    G2_MM_K(fa, 1);
#undef G2_LD_WQ
#undef G2_MM_WQ
#undef G2_LD_K
#undef G2_MM_K
    LDS_BARRIER();
#pragma unroll
    for (int e = 0; e < 16; ++e) { const int rr = (e & 3) + 8 * (e >> 2) + 4 * hh;
        *(LAS float*)(Bimg + rr * G2_OSTRIDE + (32 * ws + cc) * 4) = o0[e]; *(LAS float*)(Bimg + (32 + rr) * G2_OSTRIDE + (32 * ws + cc) * 4) = o1[e]; }
    LDS_BARRIER();
}
__device__ __forceinline__ void g2_epi_step(Frame& F, LAS unsigned char* L, const LAS unsigned char* Oimg, const u32x4 (&zz)[4], int row, int seg, size_t m, int h, bool rok, int lane) {
    float ss = 0.f;
#pragma unroll
    for (int q = 0; q < 8; ++q) { const f32x4 ov = *(const LAS f32x4*)(Oimg + row * G2_OSTRIDE + (seg * 32 + 4 * q) * 4); ss += (ov[0] * ov[0] + ov[1] * ov[1]) + (ov[2] * ov[2] + ov[3] * ov[3]); }
    ss += shfl_xor_l(ss, 1, lane); ss += shfl_xor_l(ss, 2, lane);
    const float rn = rsqrtf(ss * (1.f / 128.f) + EPS);
    if (rok) {
        u32x4* yp = (u32x4*)(F.Y1() + m * D + h * 128 + seg * 32);
        const LAS float* hn_s = (const LAS float*)(L + G2_HN);
#pragma unroll
        for (int q = 0; q < 4; ++q) {
            const f32x4 oa = *(const LAS f32x4*)(Oimg + row * G2_OSTRIDE + (seg * 32 + 8 * q) * 4), ob = *(const LAS f32x4*)(Oimg + row * G2_OSTRIDE + (seg * 32 + 8 * q + 4) * 4);
            const f32x4 ha = *(const LAS f32x4*)(hn_s + seg * 32 + 8 * q), hb = *(const LAS f32x4*)(hn_s + seg * 32 + 8 * q + 4);
            u32x4 yo;
            yo[0] = cvt2(oa[0] * rn * ha[0] * siluf_(lo16(zz[q][0])), oa[1] * rn * ha[1] * siluf_(hi16(zz[q][0])));
            yo[1] = cvt2(oa[2] * rn * ha[2] * siluf_(lo16(zz[q][1])), oa[3] * rn * ha[3] * siluf_(hi16(zz[q][1])));
            yo[2] = cvt2(ob[0] * rn * hb[0] * siluf_(lo16(zz[q][2])), ob[1] * rn * hb[1] * siluf_(hi16(zz[q][2])));
            yo[3] = cvt2(ob[2] * rn * hb[2] * siluf_(lo16(zz[q][3])), ob[3] * rn * hb[3] * siluf_(hi16(zz[q][3])));
            yp[q] = yo; }
    }
}
template <int NCH>
__device__ __forceinline__ void g2_task(Frame& F, LAS unsigned char* L, const float* DEC, int s, int h, int ch0, int tid, int lane, int wave) {
    const size_t cstep = (size_t)GS_BYTES;
    const int base = seq_base(s), nvalid = s < BP ? 64 : TS;
    const unsigned char* blk0 = F.ws + WS_RB + (size_t)ch0 * GS_BYTES;
    constexpr int lastc = NCH - 1;
    if (wave < 4) {
        const int ws = wave, cc = lane & 31, hh = lane >> 5;
        f32x16 S0, S1, S2, S3;
        if (s < BP) {
#pragma unroll
            for (int e = 0; e < 16; ++e) { S0[e] = 0.f; S1[e] = 0.f; S2[e] = 0.f; S3[e] = 0.f; }
        } else {
            const float* sp = F.in[7] + ((size_t)(s - BP) * 8 + h) * 16384 + 32 * ws + cc;
#pragma unroll
            for (int e = 0; e < 16; ++e) { const int rr = (e & 3) + 8 * (e >> 2) + 4 * hh; S0[e] = sp[(size_t)rr * 128]; S1[e] = sp[(size_t)(32 + rr) * 128]; S2[e] = sp[(size_t)(64 + rr) * 128]; S3[e] = sp[(size_t)(96 + rr) * 128]; }
        }
        const LAS float* dec_s = (const LAS float*)(L + G2_DEC);
        LDS_BARRIER();
        if (NCH == 1) g2_mfma_step(S0, S1, S2, S3, L, dec_s[0], ws, lane, cc, hh);
        else for (int c = 0; c < NCH; c += 2) {
            g2_mfma_step(S0, S1, S2, S3, L, dec_s[c], ws, lane, cc, hh);
            g2_mfma_step(S0, S1, S2, S3, L + G2_FB, dec_s[c + 1], ws, lane, cc, hh);
        }
        int l9 = lane; asm volatile("" : "+v"(l9));
        const int cc9 = l9 & 31, hh9 = l9 >> 5;
        float* so = (s < BP ? F.out + O_GSP + ((size_t)s * 8 + h) * 16384 : F.out + O_GSS + ((size_t)(s - BP) * 8 + h) * 16384) + 32 * ws + cc9;
#pragma unroll
        for (int e = 0; e < 16; ++e) { const int rr = (e & 3) + 8 * (e >> 2) + 4 * hh9; so[(size_t)rr * 128] = S0[e]; so[(size_t)(32 + rr) * 128] = S1[e]; so[(size_t)(64 + rr) * 128] = S2[e]; so[(size_t)(96 + rr) * 128] = S3[e]; }
    } else {
        const int lt = tid - 256;
        if (lt < 128) ((LAS float*)(L + G2_HN))[lt] = F.in[32][lt];
        if (lt >= 128 && lt < 128 + NCH) ((LAS float*)(L + G2_DEC))[lt - 128] = DEC[ch0 + (lt - 128)];
        u32x4 preA[18], preB[18];
        g2_load_set(preA, blk0, lt);
        g2_load_set(preB, blk0 + (size_t)(1 < lastc ? 1 : lastc) * cstep, lt);
        g2_store_set(preA, L, lt);
        g2_load_set(preA, blk0 + (size_t)(2 < lastc ? 2 : lastc) * cstep, lt);
        const int row = lt >> 2, seg = lt & 3; const bool rok = row < nvalid;
        u32x4 zz[4];
        LDS_BARRIER();
        if (NCH == 1) {
            const size_t m = (size_t)base + row;
            if (rok) { const u32x4* zp = (const u32x4*)(F.Z1() + m * D + h * 128 + seg * 32);
#pragma unroll
                for (int q = 0; q < 4; ++q) zz[q] = zp[q]; }
            LDS_BARRIER();
            LDS_BARRIER();
            g2_epi_step(F, L, L, zz, row, seg, m, h, rok, lane);
        } else for (int c = 0; c < NCH; c += 2) {
            {
                const size_t m = (size_t)base + c * 64 + row;
                { const u32x4* zp = (const u32x4*)(F.Z1() + m * D + h * 128 + seg * 32);
#pragma unroll
                  for (int q = 0; q < 4; ++q) zz[q] = zp[q]; }
                g2_store_set(preB, L + G2_FB, lt);
                g2_load_set(preB, blk0 + (size_t)(c + 3 < lastc ? c + 3 : lastc) * cstep, lt);
                LDS_BARRIER();
                LDS_BARRIER();
                g2_epi_step(F, L, L, zz, row, seg, m, h, rok, lane);
            }
            {
                const size_t m = (size_t)base + (c + 1) * 64 + row;
                { const u32x4* zp = (const u32x4*)(F.Z1() + m * D + h * 128 + seg * 32);
#pragma unroll
                  for (int q = 0; q < 4; ++q) zz[q] = zp[q]; }
                g2_store_set(preA, L, lt);
                g2_load_set(preA, blk0 + (size_t)(c + 4 < lastc ? c + 4 : lastc) * cstep, lt);
                LDS_BARRIER();
                LDS_BARRIER();
                g2_epi_step(F, L, L + G2_FB, zz, row, seg, m, h, rok, lane);
            }
        }
    }
}
__device__ __forceinline__ void phase_gdn_g2(Frame& F) {
    LAS unsigned char* L = F.lds;
    const float* DEC = (const float*)(F.ws + WS_DEC);
    for (int task = blockIdx.x; task < 192; task += F.G) {
        const int tid = opaque_tid(F.wv);
        const int lane = tid & 63, wave = F.wv;
        if (task < 64) g2_task<64>(F, L, DEC, task >> 3, task & 7, task * 64, tid, lane, wave);
        else g2_task<1>(F, L, DEC, BP + ((task - 64) >> 3), task & 7, 4096 + ((task - 64) >> 3) * 8 + (task & 7), tid, lane, wave);
        __syncthreads();
    }
}

__device__ __forceinline__ float dpp_shr_f(float idv, float x, const int o) {
    int r;
    switch (o) {
        case 1: r = __builtin_amdgcn_update_dpp(__float_as_int(idv), __float_as_int(x), 0x111, 0xf, 0xf, false); break;
        case 2: r = __builtin_amdgcn_update_dpp(__float_as_int(idv), __float_as_int(x), 0x112, 0xf, 0xf, false); break;
        case 4: r = __builtin_amdgcn_update_dpp(__float_as_int(idv), __float_as_int(x), 0x114, 0xf, 0xf, false); break;
        default: r = __builtin_amdgcn_update_dpp(__float_as_int(idv), __float_as_int(x), 0x118, 0xf, 0xf, false); break;
    }
    return __int_as_float(r);
}
template <int PASS>
__device__ __forceinline__ void phase_lru(Frame& F) {
    int tid = opaque_tid(F.wv);
    const int lane = tid & 63, wave = __builtin_amdgcn_readfirstlane(tid >> 6);
    const int gw = F.vcu * 8 + wave, NGW = F.G * 8, h = gw & 7, g = lane >> 4, l15 = lane & 15;
    LAS unsigned char* xs = F.lds + wave * 9216;
    LAS float* cst = (LAS float*)(F.lds + 73728 + wave * 768);
    const bf16_t* LGW = (const bf16_t*)(F.ws + WS_LGW);
    float* LAG = F.LAG();
    bf16x8 wfa[4][2], wfx[4][2];
#pragma unroll
    for (int nt = 0; nt < 4; ++nt)
#pragma unroll
        for (int ks = 0; ks < 2; ++ks) {
            wfa[nt][ks] = *(const bf16x8*)(LGW + ((size_t)(h * 2 + 0) * 64 + 16 * nt + l15) * 64 + 32 * ks + 8 * g);
            wfx[nt][ks] = *(const bf16x8*)(LGW + ((size_t)(h * 2 + 1) * 64 + 16 * nt + l15) * 64 + 32 * ks + 8 * g); }
    cst[lane] = F.in[18][h * 64 + lane]; cst[64 + lane] = F.in[20][h * 64 + lane]; cst[128 + lane] = softplusf_(-F.in[21][h * 64 + lane]);
    for (int task = gw; task < 4224; task += NGW) {
        int s, c; if (task < 4096) { s = task >> 9; c = (task >> 3) & 63; } else { s = BP + ((task - 4096) >> 3); c = 0; }
        const int T = seq_len(s), base = seq_base(s), t0 = c * 64, ntile = s < BP ? 4 : 1;
        {
            int l1 = lane; asm volatile("" : "+v"(l1));
            const int cg = l1 & 7, tp = l1 >> 3;
#pragma unroll 1
            for (int hf2 = 0; hf2 < 2; ++hf2) {
                const int chb = h * 64 + cg * 8 + hf2 * 4;
                float xr[11][4];
#pragma unroll
                for (int i = 0; i < 11; ++i) {
                    const int tt = t0 + tp * 8 - 3 + i;
                    if (tt >= 0 && tt < T) { const u32x2 w = *(const u32x2*)(F.U0() + (size_t)(base + tt) * EV_IN + C_XA + chb);
                        xr[i][0] = lo16(w[0]); xr[i][1] = hi16(w[0]); xr[i][2] = lo16(w[1]); xr[i][3] = hi16(w[1]); }
                    else if (tt < 0 && s >= BP) { const f32x4 a = *(const f32x4*)(F.in[2] + ((size_t)(s - BP) * 3 + (tt + 3)) * 512 + chb); xr[i][0] = a[0]; xr[i][1] = a[1]; xr[i][2] = a[2]; xr[i][3] = a[3]; }
                    else { xr[i][0] = 0.f; xr[i][1] = 0.f; xr[i][2] = 0.f; xr[i][3] = 0.f; }
                }
                const f32x4 c0 = *(const f32x4*)(F.in[15] + chb), c1 = *(const f32x4*)(F.in[15] + 512 + chb), c2 = *(const f32x4*)(F.in[15] + 1024 + chb), c3 = *(const f32x4*)(F.in[15] + 1536 + chb), cb = *(const f32x4*)(F.in[16] + chb);
#pragma unroll
                for (int i = 0; i < 8; ++i) { float o[4];
#pragma unroll
                    for (int e = 0; e < 4; ++e) o[e] = c0[e] * xr[i][e] + c1[e] * xr[i + 1][e] + c2[e] * xr[i + 2][e] + c3[e] * xr[i + 3][e] + cb[e];
                    u32x2 w; w[0] = cvt2(o[0], o[1]); w[1] = cvt2(o[2], o[3]);
                    *(LAS u32x2*)(xs + (tp * 8 + i) * 144 + cg * 16 + hf2 * 8) = w; }
                if (PASS == 2 && t0 + 64 >= T && tp == ((T - 1) >> 3) - (t0 >> 3)) {
                    float* o = (s < BP ? F.out + O_LCP + (size_t)s * 3 * 512 : F.out + O_LCS + (size_t)(s - BP) * 3 * 512) + chb;
#pragma unroll
                    for (int q = 0; q < 3; ++q) *(f32x4*)(o + q * 512) = (f32x4){xr[8 + q][0], xr[8 + q][1], xr[8 + q][2], xr[8 + q][3]};
                }
            }
        }
        float hin[4][4], arun[4][4];
#pragma unroll
        for (int nt = 0; nt < 4; ++nt)
#pragma unroll
            for (int rg = 0; rg < 4; ++rg) { hin[nt][rg] = 0.f; arun[nt][rg] = 1.f; }
        if (PASS == 2) {
            float hf = s >= BP ? F.in[3][(s - BP) * 512 + h * 64 + lane] : 0.f;
            const f32x2* lp = (const f32x2*)LAG + (size_t)(s * 64) * 512 + h * 64 + lane;
            int j = 0;
            for (; j + 8 <= c; j += 8) { f32x2 v[8];
#pragma unroll
                for (int q = 0; q < 8; ++q) v[q] = lp[(size_t)(j + q) * 512];
#pragma unroll
                for (int q = 0; q < 8; ++q) hf = v[q][0] * hf + v[q][1]; }
            for (; j < c; ++j) { const f32x2 v = lp[(size_t)j * 512]; hf = v[0] * hf + v[1]; }
#pragma unroll
            for (int nt = 0; nt < 4; ++nt)
#pragma unroll
                for (int rg = 0; rg < 4; ++rg) hin[nt][rg] = shfl_idx(hf, 16 * nt + 4 * g + rg);
        }
        asm volatile("s_waitcnt lgkmcnt(0)" ::: "memory");
        for (int tt = 0; tt < ntile; ++tt) {
            const int tok = 16 * tt + l15;
            const bf16x8 b0 = *(const LAS bf16x8*)(xs + tok * 144 + (8 * g) * 2), b1 = *(const LAS bf16x8*)(xs + tok * 144 + (32 + 8 * g) * 2);
            const size_t m = (size_t)base + t0 + tok;
#pragma unroll
            for (int nt = 0; nt < 4; ++nt) {
                f32x4 za = {0.f, 0.f, 0.f, 0.f}, zx = {0.f, 0.f, 0.f, 0.f};
                za = MFMA16(wfa[nt][0], b0, za); za = MFMA16(wfa[nt][1], b1, za);
                zx = MFMA16(wfx[nt][0], b0, zx); zx = MFMA16(wfx[nt][1], b1, zx);
                const int n0 = 16 * nt + 4 * g;
                const u32x2 xw = *(const LAS u32x2*)(xs + tok * 144 + n0 * 2);
                const float xc[4] = {lo16(xw[0]), hi16(xw[0]), lo16(xw[1]), hi16(xw[1])};
                const f32x4 cba = *(const LAS f32x4*)(cst + n0), cbx = *(const LAS f32x4*)(cst + 64 + n0), csp = *(const LAS f32x4*)(cst + 128 + n0);
                float av[4], bv[4];
#pragma unroll
                for (int rg = 0; rg < 4; ++rg) {
                    const float r = sigmoidf_(za[rg] + cba[rg]), ig = sigmoidf_(zx[rg] + cbx[rg]), la = -8.0f * r * csp[rg], a = __expf(la);
                    av[rg] = a; bv[rg] = sqrtf(fmaxf(1.0f - a * a, 0.f)) * (ig * xc[rg]); }
#pragma unroll
                for (int o = 1; o < 16; o <<= 1)
#pragma unroll
                    for (int rg = 0; rg < 4; ++rg) { const float ap = dpp_shr_f(1.0f, av[rg], o), bp = dpp_shr_f(0.0f, bv[rg], o); bv[rg] = av[rg] * bp + bv[rg]; av[rg] = av[rg] * ap; }
                float hv[4];
#pragma unroll
                for (int rg = 0; rg < 4; ++rg) { hv[rg] = bv[rg] + av[rg] * hin[nt][rg]; hin[nt][rg] = shfl_idx(hv[rg], (lane & 48) | 15); }
                if (PASS == 1) {
#pragma unroll
                    for (int rg = 0; rg < 4; ++rg) arun[nt][rg] *= shfl_idx(av[rg], (lane & 48) | 15);
                } else {
                    const bool tok_ok = (t0 + tok) < T;
                    if (tok_ok) {
                        const u32x2 gw2 = *(const u32x2*)(F.U0() + m * EV_IN + C_GA + h * 64 + n0);
                        u32x2 yo; yo[0] = cvt2(hv[0] * siluf_(lo16(gw2[0])), hv[1] * siluf_(hi16(gw2[0]))); yo[1] = cvt2(hv[2] * siluf_(lo16(gw2[1])), hv[3] * siluf_(hi16(gw2[1])));
                        *(u32x2*)(F.Y0() + m * D + h * 64 + n0) = yo;
                        if (t0 + tok == T - 1) { float* o = (s < BP ? F.out + O_LHP + s * 512 : F.out + O_LHS + (s - BP) * 512) + h * 64 + n0; *(f32x4*)o = (f32x4){hv[0], hv[1], hv[2], hv[3]}; }
                    }
                }
                if (nt & 1) __builtin_amdgcn_sched_barrier(0);
            }
        }
        if (PASS == 1 && s < BP && l15 == 15) {
            f32x2* lp = (f32x2*)LAG + (size_t)(s * 64 + c) * 512 + h * 64;
#pragma unroll
            for (int nt = 0; nt < 4; ++nt)
#pragma unroll
                for (int rg = 0; rg < 4; ++rg) lp[16 * nt + 4 * g + rg] = (f32x2){arun[nt][rg], hin[nt][rg]};
        }
        asm volatile("s_waitcnt lgkmcnt(0)" ::: "memory");
    }
}

constexpr size_t RB_VTP = RB_WEND, RB_VTS = RB_VTP + (size_t)BP * 2 * 64 * TP * 2, RB_VTEND = RB_VTS + (size_t)BS * 2 * 64 * 192 * 2;
static_assert(RB_VTEND <= RB_BYTES, "ws map");
__device__ __forceinline__ void phase_vt_build(Frame& F) {
    PHASE_IDS();
    const int gw = F.vcu * 8 + wave, NGW = F.G * 8;
    LAS unsigned char* xs = F.lds + wave * 9216;
    bf16_t* VTP = (bf16_t*)(F.ws + WS_RB + RB_VTP); bf16_t* VTS = (bf16_t*)(F.ws + WS_RB + RB_VTS);
    for (int task = gw; task < 1024 + 96; task += NGW) {
        int s, kv, kb; if (task < 1024) { s = task >> 7; kv = (task >> 6) & 1; kb = task & 63; } else { const int r = task - 1024; s = BP + r / 6; kv = (r % 6) / 3; kb = r % 3; }
        const int row8 = lane >> 3, ch = lane & 7;
#pragma unroll
        for (int i = 0; i < 8; ++i) {
            const int key = 8 * i + row8, kg = kb * 64 + key; u32x4 w = {0u, 0u, 0u, 0u};
            if (s < BP) w = *(const u32x4*)(F.U0() + (size_t)(s * TP + kg) * EV_IN + C_V + kv * 64 + ch * 8);
            else if (kg < 128) { const f32x4* p = (const f32x4*)(F.in[5] + ((size_t)((s - BP) * 128 + kg) * 2 + kv) * 64 + ch * 8); const f32x4 a = p[0], b = p[1]; w[0] = cvt2(a[0], a[1]); w[1] = cvt2(a[2], a[3]); w[2] = cvt2(b[0], b[1]); w[3] = cvt2(b[2], b[3]); }
            else if (kg < 128 + TS) w = *(const u32x4*)(F.U0() + (size_t)(MP + (s - BP) * TS + (kg - 128)) * EV_IN + C_V + kv * 64 + ch * 8);
            *(LAS u32x4*)(xs + key * 144 + ch * 16) = w;
        }
        asm volatile("s_waitcnt lgkmcnt(0)" ::: "memory");
        bf16_t* dst = s < BP ? VTP + ((size_t)(s * 2 + kv) * 64 + lane) * TP + kb * 64 : VTS + ((size_t)((s - BP) * 2 + kv) * 64 + lane) * 192 + kb * 64;
#pragma unroll
        for (int q = 0; q < 8; ++q) { u32x4 o;
#pragma unroll
            for (int e = 0; e < 4; ++e) { const unsigned lo = *(const LAS bf16_t*)(xs + (8 * q + 2 * e) * 144 + lane * 2), hi = *(const LAS bf16_t*)(xs + (8 * q + 2 * e + 1) * 144 + lane * 2); o[e] = lo | (hi << 16); }
            *(u32x4*)(dst + 8 * q) = o; }
        asm volatile("s_waitcnt lgkmcnt(0)" ::: "memory");
    }
}
constexpr int AT_K = 0, AT_V = 27648;
__device__ __forceinline__ void phase_attn(Frame& F) {
    PHASE_IDS();
    LAS unsigned char* L = F.lds;
    const bf16_t* VTP = (const bf16_t*)(F.ws + WS_RB + RB_VTP); const bf16_t* VTS = (const bf16_t*)(F.ws + WS_RB + RB_VTS);
    for (int task = F.vcu; task < 1024 + 32; task += F.G) {
        int s, c, kv; if (task < 1024) { s = task >> 7; c = (task >> 1) & 63; kv = task & 1; } else { s = BP + ((task - 1024) >> 1); c = 0; kv = task & 1; }
        const int base = seq_base(s), tok0 = c * 64 - 128;
        const int kmin = s < BP ? (tok0 < 0 ? -tok0 : 0) : 0, kmax = s < BP ? 192 : 128 + TS;
        __syncthreads();
#pragma unroll
        for (int i = 0; i < 3; ++i) {
            const int idx = tid + 512 * i, key = idx >> 3, ch = idx & 7; u32x4 w = {0u, 0u, 0u, 0u};
            if (key >= kmin && key < kmax) {
                if (s < BP) w = *(const u32x4*)(F.U0() + (size_t)(base + tok0 + key) * EV_IN + C_K + kv * 64 + ch * 8);
                else if (key < 128) { const f32x4* p = (const f32x4*)(F.in[4] + ((size_t)((s - BP) * 128 + key) * 2 + kv) * 64 + ch * 8); const f32x4 a = p[0], b = p[1]; w[0] = cvt2(a[0], a[1]); w[1] = cvt2(a[2], a[3]); w[2] = cvt2(b[0], b[1]); w[3] = cvt2(b[2], b[3]); }
                else w = *(const u32x4*)(F.U0() + (size_t)(base + key - 128) * EV_IN + C_K + kv * 64 + ch * 8);
            }
            *(LAS u32x4*)(L + AT_K + key * 144 + ch * 16) = w;
        }
#pragma unroll
        for (int i = 0; i < 3; ++i) {
            const int idx = tid + 512 * i, d = idx / 24, ch = idx % 24, key = ch * 8; u32x4 w = {0u, 0u, 0u, 0u};
            if (s < BP) { if (key >= kmin) w = *(const u32x4*)(VTP + ((size_t)(s * 2 + kv) * 64 + d) * TP + tok0 + key); }
            else w = *(const u32x4*)(VTS + ((size_t)((s - BP) * 2 + kv) * 64 + d) * 192 + key);
            *(LAS u32x4*)(L + AT_V + d * 400 + ch * 16) = w;
        }
        const int g = wave >> 1, qh = wave & 1, hq = kv * 4 + g, r = lane & 31, hh = lane >> 5, qi = qh * 32 + r;
        const bool qok = s < BP ? true : qi < TS;
        const size_t m = (size_t)base + c * 64 + (qok ? qi : 0);
        bf16x8 qf[4];
#pragma unroll
        for (int ks = 0; ks < 4; ++ks) { u32x4 w = {0u, 0u, 0u, 0u};
            if (qok) { const u32x4 x = *(const u32x4*)(F.U0() + m * EV_IN + C_Q + hq * 64 + 16 * ks + 8 * hh);
#pragma unroll
                for (int e = 0; e < 4; ++e) w[e] = cvt2(lo16(x[e]) * 0.125f, hi16(x[e]) * 0.125f); }
            qf[ks] = __builtin_bit_cast(bf16x8, w); }
        const float sink = F.in[22][hq];
        __syncthreads();
        float mrun = sink, lrun = 1.0f;
        f32x16 o0, o1;
#pragma unroll
        for (int e = 0; e < 16; ++e) { o0[e] = 0.f; o1[e] = 0.f; }
#pragma unroll 1
        for (int half = 0; half < 2; ++half) {
            f32x16 sc[3];
#pragma unroll
            for (int k3 = 0; k3 < 3; ++k3) {
                const int kt = 3 * half + k3;
#pragma unroll
                for (int e = 0; e < 16; ++e) sc[k3][e] = 0.f;
#pragma unroll
                for (int ks = 0; ks < 4; ++ks) { const bf16x8 kf = *(const LAS bf16x8*)(L + AT_K + (32 * kt + r) * 144 + (16 * ks + 8 * hh) * 2); sc[k3] = MFMA32(kf, qf[ks], sc[k3]); }
            }
            float mx = -1e30f;
#pragma unroll
            for (int k3 = 0; k3 < 3; ++k3)
#pragma unroll
                for (int e = 0; e < 16; ++e) { const int kidx = 32 * (3 * half + k3) + (e & 3) + 8 * (e >> 2) + 4 * hh; const bool ok = kidx >= kmin && kidx < kmax; sc[k3][e] = ok ? sc[k3][e] : -1e30f; mx = fmaxf(mx, sc[k3][e]); }
            mx = fmaxf(mx, shfl_xor_l(mx, 32, lane));
            const float mnew = fmaxf(mrun, mx), alpha = __expf(mrun - mnew);
            float psum = 0.f;
#pragma unroll
            for (int k3 = 0; k3 < 3; ++k3)
#pragma unroll
                for (int e = 0; e < 16; ++e) { const float p = __expf(sc[k3][e] - mnew); sc[k3][e] = p; psum += p; }
            psum += shfl_xor_l(psum, 32, lane);
            lrun = lrun * alpha + psum; mrun = mnew;
            o0 = o0 * alpha; o1 = o1 * alpha;
#pragma unroll
            for (int k3 = 0; k3 < 3; ++k3)
#pragma unroll
                for (int ss = 0; ss < 2; ++ss) {
                    const int kt = 3 * half + k3;
                    const bf16x8 pb = pack8(sc[k3], ss);
                    const LAS unsigned char* vp = L + AT_V + r * 400 + (32 * kt + 16 * ss + 4 * hh) * 2;
                    const u32x2 a0 = *(const LAS u32x2*)vp, a1 = *(const LAS u32x2*)(vp + 16), b0 = *(const LAS u32x2*)(vp + 32 * 400), b1 = *(const LAS u32x2*)(vp + 32 * 400 + 16);
                    const u32x4 va = {a0[0], a0[1], a1[0], a1[1]}, vb = {b0[0], b0[1], b1[0], b1[1]};
                    o0 = MFMA32(__builtin_bit_cast(bf16x8, va), pb, o0); o1 = MFMA32(__builtin_bit_cast(bf16x8, vb), pb, o1);
                }
        }
        const float il = __builtin_amdgcn_rcpf(lrun);
        if (qok) {
#pragma unroll
            for (int qq = 0; qq < 4; ++qq) {
                { const int d = 8 * qq + 4 * hh; const u32x2 gb = *(const u32x2*)(F.U0() + m * EV_IN + C_GB + hq * 64 + d);
                  u32x2 yo; yo[0] = cvt2(o0[4 * qq] * il * siluf_(lo16(gb[0])), o0[4 * qq + 1] * il * siluf_(hi16(gb[0]))); yo[1] = cvt2(o0[4 * qq + 2] * il * siluf_(lo16(gb[1])), o0[4 * qq + 3] * il * siluf_(hi16(gb[1])));
                  *(u32x2*)(F.Y0() + m * D + 512 + hq * 64 + d) = yo; }
                { const int d = 32 + 8 * qq + 4 * hh; const u32x2 gb = *(const u32x2*)(F.U0() + m * EV_IN + C_GB + hq * 64 + d);
                  u32x2 yo; yo[0] = cvt2(o1[4 * qq] * il * siluf_(lo16(gb[0])), o1[4 * qq + 1] * il * siluf_(hi16(gb[0]))); yo[1] = cvt2(o1[4 * qq + 2] * il * siluf_(lo16(gb[1])), o1[4 * qq + 3] * il * siluf_(hi16(gb[1])));
                  *(u32x2*)(F.Y0() + m * D + 512 + hq * 64 + d) = yo; }
            }
        }
    }
    __syncthreads();
}

__device__ __forceinline__ void phase_final_rowwise(Frame& F) {
    PHASE_IDS();
    const int gw = F.vcu * 8 + wave, NGW = F.G * 8;
    for (int m = gw; m < MT; m += NGW) {
        int s, t; tok_info(m, s, t);
        const float* mod1 = F.MOD() + (size_t)(24 + s) * 3072;
        f32x4 y[4]; float ss = 0.f;
#pragma unroll
        for (int j = 0; j < 4; ++j) { const u32x2 w = *(const u32x2*)(F.YO() + (size_t)m * D + 4 * lane + 256 * j); y[j] = (f32x4){lo16(w.x), hi16(w.x), lo16(w.y), hi16(w.y)};
            ss += (y[j][0] * y[j][0] + y[j][1] * y[j][1]) + (y[j][2] * y[j][2] + y[j][3] * y[j][3]); }
        const float r1 = rsqrtf(wave_sum(ss, lane) * (1.f / D) + EPS);
#pragma unroll
        for (int j = 0; j < 4; ++j) { const int c = 4 * lane + 256 * j;
            float* op = F.out + O_Y + (size_t)m * D + c;
            const f32x4 xv = *(const f32x4*)op, g = *(const f32x4*)(F.in[27] + c), gt = *(const f32x4*)(mod1 + 2048 + c);
            f32x4 o;
#pragma unroll
            for (int e = 0; e < 4; ++e) o[e] = xv[e] + gt[e] * (y[j][e] * r1 * g[e]);
            *(f32x4*)op = o; }
    }
}

__global__ void __launch_bounds__(512, 2) fwd_megakernel(Params P) {
    extern __shared__ __attribute__((aligned(16))) unsigned char lds_raw[];
    cg::grid_group grid = cg::this_grid();
    Frame F;
    F.lds = (LAS unsigned char*)lds_raw;
    F.wv = __builtin_amdgcn_readfirstlane(threadIdx.x >> 6);
    F.G = gridDim.x; { const int bx = blockIdx.x; F.vcu = (F.G % 8 == 0) ? (bx % 8) * (F.G / 8) + bx / 8 : bx; }
    F.in = P.in; F.out = P.out; F.ws = P.ws;

    volatile LAS unsigned* misc = (volatile LAS unsigned*)(F.lds + LDS_BYTES - 64);
    if (threadIdx.x < 16) misc[threadIdx.x] = 0u;
    __syncthreads();
    XcdBarrier xbar = xcd_barrier_post((unsigned*)(P.ws + WS_CTL), misc);
#define GRID_BAR() xcd_barrier(xbar, F.wv)
    phase_prologue(F);
    grid.sync();
    phase_prenorm0(F);
    GRID_BAR();
    { pg8::Gemm g{F.XN(), F.W0I(), MT, EV_IN, D}; pg8::StaticOrder S; S.init(MT, EV_IN, F.G, (int)blockIdx.x);
      pg8::EpiBf16 E{F.U0(), EV_IN, 1 << 30, F.U0(), EV_IN}; pg8::gemm_phase(F.lds, g, S, E, F.wv); }
    GRID_BAR();
    phase_rope(F);
    phase_lru<1>(F);
    phase_vt_build(F);
    GRID_BAR();
    phase_lru<2>(F);
    phase_attn(F);
    GRID_BAR();
    { pg8::Gemm g{F.Y0(), F.W0O(), MT, D, D}; pg8::StaticOrder S; S.init(MT, D, F.G, (int)blockIdx.x);
      pg8::EpiBf16 E{F.YO(), D, 1 << 30, F.YO(), D}; pg8::gemm_phase(F.lds, g, S, E, F.wv); }
    GRID_BAR();
    phase_mid_rowwise(F);
    GRID_BAR();
    { pg8::Gemm g{F.XN(), F.W1I(), MT, OD_MAIN, D}; pg8::StaticOrder S; S.init(MT, OD_MAIN, F.G, (int)blockIdx.x);
      pg8::EpiBf16 E{F.QKV1(), 3072, 3072, F.Z1(), D}; pg8::gemm_phase(F.lds, g, S, E, F.wv); }
    GRID_BAR();
    phase_gdn_g1(F);
    GRID_BAR();
    phase_gdn_g2(F);
    GRID_BAR();
    { pg8::Gemm g{F.Y1(), F.W1O(), MT, D, D}; pg8::StaticOrder S; S.init(MT, D, F.G, (int)blockIdx.x);
      pg8::EpiBf16 E{F.YO(), D, 1 << 30, F.YO(), D}; pg8::gemm_phase(F.lds, g, S, E, F.wv); }
    GRID_BAR();
    phase_final_rowwise(F);
}

extern "C" void kernel_launch(void* const* d_in, const int* in_sizes, int n_in, void* d_out, int out_size, void* d_ws, size_t ws_size, hipStream_t stream) {
    static int grid = 0;
    if (grid == 0) {
        if (n_in != 34 || out_size != (int)O_END || ws_size < WS_END) { grid = -1; return; }
        int dev = 0, cus = 0, per_cu = 0;
        if (hipGetDevice(&dev) != hipSuccess || hipDeviceGetAttribute(&cus, hipDeviceAttributeMultiprocessorCount, dev) != hipSuccess) { grid = -1; return; }
        if (hipFuncSetAttribute((const void*)fwd_megakernel, hipFuncAttributeMaxDynamicSharedMemorySize, LDS_BYTES) != hipSuccess) { grid = -1; return; }
        if (hipOccupancyMaxActiveBlocksPerMultiprocessor(&per_cu, (const void*)fwd_megakernel, 512, LDS_BYTES) != hipSuccess || per_cu < 1) { grid = -1; return; }
        grid = cus;
    }
    if (grid < 0) return;
    if (hipMemsetAsync((char*)d_ws + WS_CTL, 0, 16384, stream) != hipSuccess) return;
    Params p{};
    for (int i = 0; i < 34; ++i) p.in[i] = (const float*)d_in[i];
    p.out = (float*)d_out; p.ws = (unsigned char*)d_ws;
    void* args[] = {&p};
    (void)hipLaunchCooperativeKernel((const void*)fwd_megakernel, dim3(grid), dim3(512), args, LDS_BYTES, stream);
}
```

```cpp
#include <hip/hip_runtime.h>
#include <hip/hip_cooperative_groups.h>
namespace cg = cooperative_groups;

#define LAS __attribute__((address_space(3)))
typedef unsigned short bf16_t;
typedef short bf16x8 __attribute__((ext_vector_type(8)));
typedef float f32x4 __attribute__((ext_vector_type(4)));
typedef float f32x2 __attribute__((ext_vector_type(2)));
typedef unsigned u32x4 __attribute__((ext_vector_type(4)));
typedef unsigned u32x2 __attribute__((ext_vector_type(2)));

constexpr int D = 1024, BP = 8, TP = 4096, BS = 16, TS = 16;
constexpr int MP = BP * TP, MS = BS * TS, MT = MP + MS;
constexpr int NSEQ = BP + BS;
constexpr int EV_IN = 2304, OD_IN = 4112, OD_MAIN = 4096;
constexpr int C_XA = 0, C_GA = 512, C_Q = 1024, C_K = 1536, C_V = 1664, C_GB = 1792;
constexpr float EPS = 1e-6f;
constexpr size_t O_Y = 0, O_LCP = 33816576, O_LCS = 33828864, O_LHP = 33853440, O_LHS = 33857536, O_KP = 33865728, O_KS = 33996800,
                 O_VP = 34029568, O_VS = 34160640, O_GCP = 34193408, O_GCS = 34267136, O_GSP = 34414592, O_GSS = 35463168, O_END = 37560320;
constexpr size_t MiB = 1u << 20;
constexpr size_t WS_CTL = 0, WS_W1O = 1 * MiB, WS_MOD = 3 * MiB, WS_ROPE = 4 * MiB, WS_BA = 5 * MiB, WS_LAG = 8 * MiB, WS_LGW = 10 * MiB;
constexpr size_t WS_RA = 16 * MiB, RA_BYTES = (size_t)MT * 4096 * 2;
constexpr size_t WS_RB = WS_RA + RA_BYTES;
constexpr size_t ACT_BYTES = (size_t)MT * D * 2;
constexpr size_t RB_XN = 0, RB_Y0 = ACT_BYTES, RB_YO = 2 * ACT_BYTES, RB_W0I = 3 * ACT_BYTES, RB_W0O = RB_W0I + (size_t)EV_IN * D * 2,
                 RB_W1I = RB_W0O + (size_t)D * D * 2, RB_WEND = RB_W1I + (size_t)OD_MAIN * D * 2;
constexpr size_t RB_BYTES = (size_t)4224 * 73728;
constexpr size_t WS_END = WS_RB + RB_BYTES;
static_assert(RB_WEND <= RB_BYTES, "ws map");
static_assert((size_t)MT * 3072 * 2 <= RB_BYTES, "ws map");
constexpr int LDS_BYTES = 155648;

struct Params { const float* in[34]; float* out; unsigned char* ws; };

__device__ __forceinline__ float bf2f(bf16_t b) { return __uint_as_float(((unsigned)b) << 16); }
__device__ __forceinline__ unsigned f2bf(float f) { unsigned u = __float_as_uint(f); return (u + 0x7fffu + ((u >> 16) & 1u)) >> 16; }
__device__ __forceinline__ unsigned pk2(float lo, float hi) { return f2bf(lo) | (f2bf(hi) << 16); }
__device__ __forceinline__ float lo16(unsigned w) { return __uint_as_float(w << 16); }
__device__ __forceinline__ float hi16(unsigned w) { return __uint_as_float(w & 0xffff0000u); }
__device__ __forceinline__ float shfl_idx(float x, int src_lane) { return __int_as_float(__builtin_amdgcn_ds_bpermute(src_lane << 2, __float_as_int(x))); }
__device__ __forceinline__ float shfl_xor_l(float x, int o, int lane) { return shfl_idx(x, lane ^ o); }
__device__ __forceinline__ float wave_sum(float v, int lane) {
#pragma unroll
    for (int o = 1; o < 64; o <<= 1) v += shfl_xor_l(v, o, lane);
    return v;
}
__device__ __forceinline__ float sigmoidf_(float x) { return __builtin_amdgcn_rcpf(1.0f + __expf(-x)); }
__device__ __forceinline__ float siluf_(float x) { return x * __builtin_amdgcn_rcpf(1.0f + __expf(-x)); }
__device__ __forceinline__ float softplusf_(float x) { return x > 20.f ? x : log1pf(__expf(x)); }
__device__ __forceinline__ int seq_base(int s) { return s < BP ? s * TP : MP + (s - BP) * TS; }
__device__ __forceinline__ int seq_len(int s) { return s < BP ? TP : TS; }
__device__ __forceinline__ void tok_info(int m, int& s, int& t) { if (m < MP) { s = m >> 12; t = m & 4095; } else { const int r = m - MP; s = BP + (r >> 4); t = r & 15; } }

__device__ __forceinline__ int opaque_tid(int wv) { unsigned z = 0u; asm volatile("" : "+v"(z)); const int l = __builtin_amdgcn_mbcnt_hi(~0u, __builtin_amdgcn_mbcnt_lo(~0u, z)); return wv * 64 + l; }
namespace pg8 {
constexpr int BM = 256, BK = 64, HALF = 128, HTB = HALF * BK * 2, STAGE_BYTES = 8 * HTB, NXCD = 8, WGM = 8;
__host__ __device__ __forceinline__ int lds_byte(int r, int c) { const int st = (r >> 4) * 2 + (c >> 5), rr = r & 15, cc = c & 31, ob = rr * 64 + cc * 2; return st * 1024 + (ob ^ (((ob >> 9) & 1) << 5)); }
__host__ __device__ __forceinline__ void stage_rc(int b, int& R, int& C) { const int st = b / 1024, sb = b % 1024, swz = sb ^ (((sb >> 9) & 1) << 5); R = (st >> 1) * 16 + swz / 64; C = (st & 1) * 32 + (swz % 64) / 2; }
__host__ __device__ __forceinline__ int perm32(int rho) { const int n = rho >> 4, i = rho & 15; return 8 * (i >> 2) + 4 * n + (i & 3); }
struct Unit { int pm, pn; };
struct Gemm { const bf16_t* A; const bf16_t* Bt; int M, N, K; };
struct StaticOrder {
    int nM, nN, nwg, G, c;
    __device__ void init(int M, int N, int G_, int c_) { nM = M / BM; nN = N / BM; nwg = nM * nN; G = G_; c = c_; }
    __device__ bool next(int i, Unit& u) const {
        const long L = (long)i * G + c; if (L >= nwg) return false;
        int wgid = (int)L; { const int q = nwg / NXCD, r = nwg % NXCD, xcd = wgid % NXCD, off = wgid / NXCD; wgid = (xcd < r ? xcd * (q + 1) : r * (q + 1) + (xcd - r) * q) + off; }
        const int nig = WGM * nN, gid = wgid / nig, fm = gid * WGM, gsz = (nM - fm) < WGM ? (nM - fm) : WGM;
        u.pm = fm + ((wgid % nig) % gsz); u.pn = (wgid % nig) / gsz; return true;
    }
};
__device__ __forceinline__ unsigned cvt_pk_bf16(float lo, float hi) { unsigned r; asm volatile("v_cvt_pk_bf16_f32 %0, %1, %2" : "=v"(r) : "v"(lo), "v"(hi)); return r; }
struct EpiBf16 {
    static constexpr bool PERM = true;
    bf16_t* O0; int ld0; int split; bf16_t* O1; int ld1;
    __device__ __forceinline__ void operator()(const f32x4 (&acc)[2][2][4][2], const Unit& u, int wr, int wc, int fr, int fq) const {
        const int row0 = u.pm * BM + wr * 64 + fr; int colt = u.pn * BM; bf16_t* base = O0; int ld = ld0;
        if (colt >= split) { base = O1; ld = ld1; colt -= split; }
        const int col0 = colt + wc * 32 + 8 * fq;
#pragma unroll
        for (int ai = 0; ai < 2; ++ai)
#pragma unroll
            for (int m = 0; m < 4; ++m) { bf16_t* rowp = base + (size_t)(row0 + ai * HALF + m * 16) * ld + col0;
#pragma unroll
                for (int bj = 0; bj < 2; ++bj) { const f32x4 v0 = acc[ai][bj][m][0], v1 = acc[ai][bj][m][1];
                    u32x4 w; w.x = cvt_pk_bf16(v0[0], v0[1]); w.y = cvt_pk_bf16(v0[2], v0[3]); w.z = cvt_pk_bf16(v1[0], v1[1]); w.w = cvt_pk_bf16(v1[2], v1[3]);
                    *(u32x4*)(rowp + bj * HALF) = w; } }
    }
};
template <class Epi, class Sched>
__device__ __forceinline__ void gemm_phase(LAS unsigned char* lds, const Gemm g, const Sched& S, const Epi& E, const int wv0) {
    int tid = opaque_tid(wv0);
    const int wid = __builtin_amdgcn_readfirstlane(tid >> 6), lane = tid & 63, wr = wid >> 2, wc = wid & 3, fr = lane & 15, fq = lane >> 4;
    const int K = g.K, nt = K / BK;
    unsigned voffA[2], voffB[2];
#pragma unroll
    for (int i = 0; i < 2; ++i) { int R, C; stage_rc(tid * 16 + i * 8192, R, C); const int Rb = Epi::PERM ? ((R & ~31) + perm32(R & 31)) : R;
        voffA[i] = (unsigned)(R * K + C) * 2u; voffB[i] = (unsigned)(Rb * K + C) * 2u; }
    const size_t kstep = (size_t)(BK * 2);
    const size_t hstep = (size_t)HALF * K * 2;
    const size_t tstep = 2 * hstep;
    const unsigned ldsw = (unsigned)wid * 1024u;
    const int aoff = lds_byte(wr * 64 + fr, fq * 8), boff = lds_byte(wc * 32 + fr, fq * 8);
#define PG8_SA(b, h) (((b) * 2 + (h)) * HTB)
#define PG8_SB(b, h) ((4 + (b) * 2 + (h)) * HTB)
#define PG8_STAGE(bufoff, gbase, voff) do { _Pragma("unroll") for (int _i = 0; _i < 2; ++_i) \
        __builtin_amdgcn_global_load_lds((const unsigned*)((const char*)(gbase) + (voff)[_i]), (LAS unsigned*)(lds + (bufoff) + ldsw + _i * 8192), 16, 0, 0); } while (0)
#define PG8_LDA(dst, b, h) do { _Pragma("unroll") for (int m = 0; m < 4; ++m) _Pragma("unroll") for (int k = 0; k < 2; ++k) dst[m][k] = *(const LAS bf16x8*)(lds + PG8_SA(b, h) + aoff + m * 2048 + k * 1024); } while (0)
#define PG8_LDB(dst, b, h) do { _Pragma("unroll") for (int n = 0; n < 2; ++n) _Pragma("unroll") for (int k = 0; k < 2; ++k) dst[n][k] = *(const LAS bf16x8*)(lds + PG8_SB(b, h) + boff + n * 2048 + k * 1024); } while (0)
#define PG8_MMA(ai, bj, At, Bt) do { __builtin_amdgcn_s_setprio(1); _Pragma("unroll") for (int m = 0; m < 4; ++m) _Pragma("unroll") for (int n = 0; n < 2; ++n) _Pragma("unroll") for (int k = 0; k < 2; ++k) \
        acc[ai][bj][m][n] = __builtin_amdgcn_mfma_f32_16x16x32_bf16(Bt[n][k], At[m][k], acc[ai][bj][m][n], 0, 0, 0); __builtin_amdgcn_s_setprio(0); } while (0)
#define PG8_WAIT_V(n) asm volatile("s_waitcnt vmcnt(" #n ")" ::: "memory")
#define PG8_WAIT_L(n) asm volatile("s_waitcnt lgkmcnt(" #n ")" ::: "memory")
#define PG8_BAR __builtin_amdgcn_s_barrier()
#define PG8_SCHED __builtin_amdgcn_sched_barrier(0)
    Unit cur, nxt; int ui = 0;
    if (!S.next(0, cur)) return;
    f32x4 acc[2][2][4][2];
#pragma unroll
    for (int a = 0; a < 2; ++a)
#pragma unroll
        for (int b = 0; b < 2; ++b)
#pragma unroll
            for (int m = 0; m < 4; ++m)
#pragma unroll
                for (int n = 0; n < 2; ++n) acc[a][b][m][n] = (f32x4){0.f, 0.f, 0.f, 0.f};
    bf16x8 At[4][2], B0[2][2], B1[2][2];
    const char* cA = (const char*)g.A + (size_t)cur.pm * tstep; const char* cB = (const char*)g.Bt + (size_t)cur.pn * tstep;
    PG8_STAGE(PG8_SB(0, 0), cB, voffB); PG8_STAGE(PG8_SA(0, 0), cA, voffA); PG8_STAGE(PG8_SB(0, 1), cB + hstep, voffB); PG8_STAGE(PG8_SA(0, 1), cA + hstep, voffA);
    if (wr == 1) PG8_BAR;
    PG8_WAIT_V(4); PG8_BAR;
    PG8_STAGE(PG8_SB(1, 0), cB + kstep, voffB); PG8_STAGE(PG8_SA(1, 0), cA + kstep, voffA); PG8_STAGE(PG8_SB(1, 1), cB + hstep + kstep, voffB);
    PG8_WAIT_V(6); PG8_BAR;
    for (;;) {
        const bool has_next = S.next(ui + 1, nxt);
        const char* nA = has_next ? (const char*)g.A + (size_t)nxt.pm * tstep : cA; const char* nB = has_next ? (const char*)g.Bt + (size_t)nxt.pn * tstep : cB;
        for (int t = 0; t < nt; t += 2) {
            const bool last = (t == nt - 2);
            const char* a1 = cA + (size_t)(t + 1) * kstep;
            const char* a2 = last ? nA : cA + (size_t)(t + 2) * kstep; const char* b2 = last ? nB : cB + (size_t)(t + 2) * kstep;
            const char* a3 = a2 + kstep; const char* b3 = b2 + kstep;
            PG8_LDB(B0, 0, 0); PG8_SCHED; PG8_LDA(At, 0, 0); PG8_STAGE(PG8_SA(1, 1), a1 + hstep, voffA);
            PG8_WAIT_L(8); PG8_BAR; PG8_WAIT_L(0); PG8_MMA(0, 0, At, B0); PG8_BAR; PG8_SCHED;
            PG8_LDB(B1, 0, 1); PG8_STAGE(PG8_SB(0, 0), b2, voffB);
            PG8_BAR; PG8_WAIT_L(0); PG8_MMA(0, 1, At, B1); PG8_BAR;
            PG8_LDA(At, 0, 1); PG8_STAGE(PG8_SA(0, 0), a2, voffA);
            PG8_BAR; PG8_WAIT_L(0); PG8_MMA(1, 0, At, B0); PG8_BAR; PG8_SCHED;
            PG8_STAGE(PG8_SB(0, 1), b2 + hstep, voffB);
            PG8_WAIT_V(6); PG8_BAR; PG8_MMA(1, 1, At, B1); PG8_BAR;
            PG8_LDB(B0, 1, 0); PG8_SCHED; PG8_LDA(At, 1, 0); PG8_STAGE(PG8_SA(0, 1), a2 + hstep, voffA);
            PG8_WAIT_L(8); PG8_BAR; PG8_WAIT_L(0); PG8_MMA(0, 0, At, B0); PG8_BAR; PG8_SCHED;
            PG8_LDB(B1, 1, 1); PG8_STAGE(PG8_SB(1, 0), b3, voffB);
            PG8_BAR; PG8_WAIT_L(0); PG8_MMA(0, 1, At, B1); PG8_BAR;
            PG8_LDA(At, 1, 1); PG8_STAGE(PG8_SA(1, 0), a3, voffA);
            PG8_BAR; PG8_WAIT_L(0); PG8_MMA(1, 0, At, B0); PG8_BAR; PG8_SCHED;
            PG8_STAGE(PG8_SB(1, 1), b3 + hstep, voffB);
            PG8_WAIT_V(6); PG8_BAR; PG8_MMA(1, 1, At, B1); PG8_BAR;
        }
        E(acc, cur, wr, wc, fr, fq);
        if (!has_next) break;
#pragma unroll
        for (int a = 0; a < 2; ++a)
#pragma unroll
            for (int b = 0; b < 2; ++b)
#pragma unroll
                for (int m = 0; m < 4; ++m)
#pragma unroll
                    for (int n = 0; n < 2; ++n) acc[a][b][m][n] = (f32x4){0.f, 0.f, 0.f, 0.f};
        cur = nxt; cA = nA; cB = nB; ++ui;
    }
    PG8_WAIT_V(0);
    if (wr == 0) PG8_BAR;
    PG8_BAR;
#undef PG8_SA
#undef PG8_SB
#undef PG8_STAGE
#undef PG8_LDA
#undef PG8_LDB
#undef PG8_MMA
#undef PG8_WAIT_V
#undef PG8_WAIT_L
#undef PG8_BAR
#undef PG8_SCHED
}
}


#define XB_TMO      128
#define XB_XCNT(j)  (256  + 64 * (j))
#define XB_XSUB(j)  (1280 + 64 * (j))
#define XB_XGEN(j)  (2304 + 64 * (j))
#define XB_TOP      3328
#define XB_TOPGEN   3392
#define XCD_BAR_WORDS 3456
#define XB_SPIN_CAP (1u << 18)
__device__ __forceinline__ unsigned xb_ld(unsigned* p)              { return __hip_atomic_load(p, __ATOMIC_RELAXED, __HIP_MEMORY_SCOPE_AGENT); }
__device__ __forceinline__ unsigned xb_add(unsigned* p, unsigned v) { return __hip_atomic_fetch_add(p, v, __ATOMIC_RELAXED, __HIP_MEMORY_SCOPE_AGENT); }
__device__ __forceinline__ unsigned xb_xcc_id() { return (unsigned)__builtin_amdgcn_s_getreg((3 << 11) | 20) & 0xFu; }
#define XB_SPIN(cond, bar) do { unsigned _sp = 0; while (cond) { __builtin_amdgcn_s_sleep(1); \
    if ((++_sp & 255u) == 0u) { if (xb_ld(&(bar)[XB_TMO])) break; if (_sp > XB_SPIN_CAP) { atomicAdd(&(bar)[XB_TMO], 1u); break; } } } } while (0)
struct XcdBarrier { unsigned* bar; unsigned x; volatile LAS unsigned* st; };
__device__ __forceinline__ XcdBarrier xcd_barrier_post(unsigned* bar, volatile LAS unsigned* st) {
    XcdBarrier b; b.bar = bar; b.x = xb_xcc_id(); b.st = st;
    if (threadIdx.x == 0) (void)xb_add(&bar[XB_XCNT(b.x)], 1u);
    return b;
}
__device__ __forceinline__ void xcd_barrier_complete(unsigned* bar, unsigned x, unsigned& nloc, unsigned& nx) {
    const unsigned G = gridDim.x * gridDim.y * gridDim.z;
    unsigned sum, cnt, mine, sp = 0u;
    for (;;) {
        sum = 0u; cnt = 0u; mine = 0u;
#pragma unroll
        for (unsigned j = 0; j < 16; ++j) { const unsigned c = xb_ld(&bar[XB_XCNT(j)]); sum += c; cnt += (c > 0u) ? 1u : 0u; mine = (j == x) ? c : mine; }
        if (sum == G) break;
        __builtin_amdgcn_s_sleep(1);
        if ((++sp & 255u) == 0u) { if (xb_ld(&bar[XB_TMO])) break; if (sp > XB_SPIN_CAP) { atomicAdd(&bar[XB_TMO], 1u); break; } }
    }
    nloc = mine > 0u ? mine : 1u; nx = cnt > 0u ? cnt : 1u;
}
__device__ __forceinline__ void xcd_barrier(const XcdBarrier& b, const int wv0) {
    asm volatile("s_waitcnt vmcnt(0)" ::: "memory");
    __syncthreads();
    if (opaque_tid(wv0) == 0) {
        unsigned* bar = b.bar;
        __builtin_amdgcn_s_waitcnt(0);
        unsigned nloc = b.st[0], nx = b.st[1];
        if (nloc == 0u) { xcd_barrier_complete(bar, b.x, nloc, nx); b.st[0] = nloc; b.st[1] = nx; }
        const unsigned old = xb_add(&bar[XB_XSUB(b.x)], 1u);
        const unsigned gen = old / nloc;
        if (old + 1u == (gen + 1u) * nloc) {
            __builtin_amdgcn_fence(__ATOMIC_RELEASE, "agent");
            asm volatile("s_waitcnt vmcnt(0)" ::: "memory");
            const unsigned og = xb_add(&bar[XB_TOP], 1u);
            const unsigned tg = og / nx;
            if (og + 1u == (tg + 1u) * nx) xb_add(&bar[XB_TOPGEN], 1u);
            else XB_SPIN(xb_ld(&bar[XB_TOPGEN]) == tg, bar);
            __builtin_amdgcn_fence(__ATOMIC_ACQUIRE, "agent");
            xb_add(&bar[XB_XGEN(b.x)], 1u);
            asm volatile("s_waitcnt vmcnt(0)" ::: "memory");
        } else {
            XB_SPIN(xb_ld(&bar[XB_XGEN(b.x)]) == gen, bar);
            __builtin_amdgcn_fence(__ATOMIC_ACQUIRE, "agent");
            asm volatile("s_waitcnt vmcnt(0)" ::: "memory");
        }
    }
    __syncthreads();
}

struct Frame {
    LAS unsigned char* lds;
    int vcu, G, wv;
    const float* const* in; float* out; unsigned char* ws;
    __device__ __forceinline__ float* MOD() const { return (float*)(ws + WS_MOD); }
    __device__ __forceinline__ float* ROPE() const { return (float*)(ws + WS_ROPE); }
    __device__ __forceinline__ float* BA() const { return (float*)(ws + WS_BA); }
    __device__ __forceinline__ float* LAG() const { return (float*)(ws + WS_LAG); }
    __device__ __forceinline__ bf16_t* W1O() const { return (bf16_t*)(ws + WS_W1O); }
    __device__ __forceinline__ bf16_t* U0() const { return (bf16_t*)(ws + WS_RA); }
    __device__ __forceinline__ bf16_t* QKV1() const { return (bf16_t*)(ws + WS_RA); }
    __device__ __forceinline__ bf16_t* Z1() const { return (bf16_t*)(ws + WS_RA + (size_t)MT * 3072 * 2); }
    __device__ __forceinline__ bf16_t* Y1() const { return (bf16_t*)(ws + WS_RA + (size_t)MT * 3072 * 2); }
    __device__ __forceinline__ bf16_t* XN() const { return (bf16_t*)(ws + WS_RB + RB_XN); }
    __device__ __forceinline__ bf16_t* Y0() const { return (bf16_t*)(ws + WS_RB + RB_Y0); }
    __device__ __forceinline__ bf16_t* YO() const { return (bf16_t*)(ws + WS_RB + RB_YO); }
    __device__ __forceinline__ bf16_t* W0I() const { return (bf16_t*)(ws + WS_RB + RB_W0I); }
    __device__ __forceinline__ bf16_t* W0O() const { return (bf16_t*)(ws + WS_RB + RB_W0O); }
    __device__ __forceinline__ bf16_t* W1I() const { return (bf16_t*)(ws + WS_RB + RB_W1I); }
    __device__ __forceinline__ bf16_t* QKVC() const { return (bf16_t*)(ws + WS_RB); }
};

#define PHASE_IDS() int tid = opaque_tid(F.wv); const int lane = tid & 63, wave = __builtin_amdgcn_readfirstlane(tid >> 6); (void)lane; (void)wave
__device__ __forceinline__ void p0_transpose_item(const float* W, int ldw, int nblk, int K, bf16_t* WT, LAS float* scr, int item, int lane) {
    const int kb = item / nblk, nb = item % nblk, k0 = 64 * kb, n0 = 32 * nb;
#pragma unroll 8
    for (int i = 0; i < 32; ++i) { const int kk = 2 * i + (lane >> 5); scr[kk * 33 + (lane & 31)] = W[(size_t)(k0 + kk) * ldw + n0 + (lane & 31)]; }
    asm volatile("s_waitcnt lgkmcnt(0)" ::: "memory");
    const int c = lane & 7;
#pragma unroll
    for (int j = 0; j < 4; ++j) { const int n = (lane >> 3) + 8 * j; const LAS float* s = scr + (8 * c) * 33 + n;
        u32x4 o; o.x = pk2(s[0 * 33], s[1 * 33]); o.y = pk2(s[2 * 33], s[3 * 33]); o.z = pk2(s[4 * 33], s[5 * 33]); o.w = pk2(s[6 * 33], s[7 * 33]);
        *(u32x4*)(WT + (size_t)(n0 + n) * K + k0 + 8 * c) = o; }
    asm volatile("s_waitcnt lgkmcnt(0)" ::: "memory");
}
__device__ __forceinline__ void phase_prologue(Frame& F) {
    PHASE_IDS();
    const int gw = F.vcu * 8 + wave, NGW = F.G * 8;
    {
        LAS float* scr = (LAS float*)(F.lds + wave * 16384);
        constexpr int I0 = 16 * (EV_IN / 32), I1 = 16 * 32, I2 = 16 * (OD_MAIN / 32), I3 = 16 * 32;
        for (int it = gw; it < I0 + I1 + I2 + I3; it += NGW) {
            int r = it;
            if (r < I0) { p0_transpose_item(F.in[14], EV_IN, EV_IN / 32, D, F.W0I(), scr, r, lane); continue; } r -= I0;
            if (r < I1) { p0_transpose_item(F.in[23], D, 32, D, F.W0O(), scr, r, lane); continue; } r -= I1;
            if (r < I2) { p0_transpose_item(F.in[28], OD_IN, OD_MAIN / 32, D, F.W1I(), scr, r, lane); continue; } r -= I2;
            p0_transpose_item(F.in[33], D, 32, D, F.W1O(), scr, r, lane);
        }
    }
    {
        const double inv[8] = {1.0, 0.19392274474868576, 0.03760603093086393, 0.007292664737217109, 0.001414213562373095, 0.0002742481756762073, 5.318295896944988e-05, 1.031338537721246e-05};
        for (int idx = F.vcu * 512 + tid; idx < 4112 * 8; idx += F.G * 512) {
            const int pos = idx >> 3, i = idx & 7;
            double iv = inv[0];
#pragma unroll
            for (int q = 1; q < 8; ++q) iv = (i == q) ? inv[q] : iv;
            const double ang = (double)pos * iv;
            const double n = __builtin_rint(ang * 0.15915494309189535);
            const float r = (float)__builtin_fma(-n, 6.283185307179586, ang);
            F.ROPE()[pos * 16 + i] = __cosf(r); F.ROPE()[pos * 16 + 8 + i] = __sinf(r);
        }
    }
    {
        bf16_t* LGW = (bf16_t*)(F.ws + WS_LGW);
        for (int idx = F.vcu * 512 + tid; idx < 8 * 2 * 64 * 64; idx += F.G * 512) { const int k = idx & 63, n = (idx >> 6) & 63, gate = (idx >> 12) & 1, hh = idx >> 13;
            LGW[idx] = (bf16_t)f2bf((gate ? F.in[19] : F.in[17])[(hh * 64 + k) * 64 + n]); }
    }
    __syncthreads();
    for (int bt = F.vcu; bt < 96; bt += F.G) {
        LAS float* tab = (LAS float*)F.lds;
        for (int idx = tid; idx < 24 * 1024; idx += 512) { const int s = idx >> 10, k = idx & 1023;
            const float c = s < BP ? F.in[8][s * D + k] : F.in[9][(s - BP) * D + k]; tab[k * 24 + s] = siluf_(c); }
        __syncthreads();
        const int L = bt / 48, n0 = (bt % 48) * 64;
        const float* mw = (L == 0 ? F.in[10] : F.in[24]) + n0 + lane;
        float acc[24];
#pragma unroll
        for (int r = 0; r < 24; ++r) acc[r] = 0.f;
        for (int k = wave * 128; k < wave * 128 + 128; ++k) {
            const float w = mw[(size_t)k * 3072];
            const LAS f32x4* tp = (const LAS f32x4*)(tab + k * 24);
#pragma unroll
            for (int q = 0; q < 6; ++q) { const f32x4 t4 = tp[q]; acc[4 * q] += t4[0] * w; acc[4 * q + 1] += t4[1] * w; acc[4 * q + 2] += t4[2] * w; acc[4 * q + 3] += t4[3] * w; }
        }
        __syncthreads();
        LAS float* red = (LAS float*)F.lds;
#pragma unroll
        for (int r = 0; r < 24; ++r) red[(wave * 24 + r) * 64 + lane] = acc[r];
        __syncthreads();
        const float* mb = (L == 0 ? F.in[11] : F.in[25]);
        for (int idx = tid; idx < 24 * 64; idx += 512) { const int r = idx >> 6, l = idx & 63; float s = 0.f;
#pragma unroll
            for (int w = 0; w < 8; ++w) s += red[(w * 24 + r) * 64 + l];
            F.MOD()[((size_t)L * 24 + r) * 3072 + n0 + l] = s + mb[n0 + l]; }
        __syncthreads();
    }
}

__device__ __forceinline__ void phase_prenorm0(Frame& F) {
    PHASE_IDS();
    const int gw = F.vcu * 8 + wave, NGW = F.G * 8;
    for (int m = gw; m < MT; m += NGW) {
        int s, t; tok_info(m, s, t);
        const float* xrow = m < MP ? F.in[0] + (size_t)m * D : F.in[1] + (size_t)(m - MP) * D;
        const float* modr = F.MOD() + (size_t)s * 3072;
        f32x4 v[4]; float ss = 0.f;
#pragma unroll
        for (int j = 0; j < 4; ++j) { v[j] = *(const f32x4*)(xrow + 4 * lane + 256 * j); ss += (v[j][0] * v[j][0] + v[j][1] * v[j][1]) + (v[j][2] * v[j][2] + v[j][3] * v[j][3]); }
        const float r = rsqrtf(wave_sum(ss, lane) * (1.f / D) + EPS);
#pragma unroll
        for (int j = 0; j < 4; ++j) { const int c = 4 * lane + 256 * j;
            const f32x4 g = *(const f32x4*)(F.in[12] + c), sh = *(const f32x4*)(modr + c), sc = *(const f32x4*)(modr + 1024 + c);
            f32x4 o;
#pragma unroll
            for (int e = 0; e < 4; ++e) o[e] = v[j][e] * r * g[e] * (1.f + sc[e]) + sh[e];
            u32x2 w; w.x = pk2(o[0], o[1]); w.y = pk2(o[2], o[3]); *(u32x2*)(F.XN() + (size_t)m * D + c) = w; }
    }
}

__device__ __forceinline__ void phase_rope(Frame& F) {
    PHASE_IDS();
    const int gt = F.vcu * 512 + tid, NT = F.G * 512;
    for (int idx = gt; idx < MT * 80; idx += NT) {
        const int m = idx / 80, r = idx % 80, slot = r >> 3, i = r & 7;
        int s, t; tok_info(m, s, t);
        const int pos = s < BP ? t : TP + t;
        const int col = slot < 8 ? C_Q + slot * 64 : C_K + (slot - 8) * 64;
        bf16_t* p = F.U0() + (size_t)m * EV_IN + col;
        const float x1 = bf2f(p[i]), x2 = bf2f(p[8 + i]), c = F.ROPE()[pos * 16 + i], sn = F.ROPE()[pos * 16 + 8 + i];
        const float o1 = x1 * c - x2 * sn, o2 = x2 * c + x1 * sn;
        p[i] = (bf16_t)f2bf(o1); p[8 + i] = (bf16_t)f2bf(o2);
        if (slot >= 8) { const int kv = slot - 8;
            if (s >= BP) { float* o = F.out + O_KS + ((size_t)((s - BP) * TS + t) * 2 + kv) * 64; o[i] = o1; o[8 + i] = o2; }
            else if (t >= TP - 128) { float* o = F.out + O_KP + ((size_t)(s * 128 + (t - (TP - 128))) * 2 + kv) * 64; o[i] = o1; o[8 + i] = o2; } }
    }
    for (int idx = gt; idx < 1280 * 224; idx += NT) {
        const int tk = idx / 224, e = idx % 224;
        int s, t, m; if (tk < 1024) { s = tk >> 7; t = TP - 128 + (tk & 127); m = s * TP + t; } else { s = BP + ((tk - 1024) >> 4); t = (tk - 1024) & 15; m = MP + (tk - 1024); }
        const bool isv = e >= 96; const int e2 = isv ? e - 96 : e; const int kv = isv ? (e2 >> 6) : (e2 / 48), d = isv ? (e2 & 63) : 16 + (e2 % 48);
        const float val = bf2f(F.U0()[(size_t)m * EV_IN + (isv ? C_V : C_K) + kv * 64 + d]);
        const size_t ob = s >= BP ? (isv ? O_VS : O_KS) + ((size_t)((s - BP) * TS + t) * 2 + kv) * 64 : (isv ? O_VP : O_KP) + ((size_t)(s * 128 + (t - (TP - 128))) * 2 + kv) * 64;
        F.out[ob + d] = val;
    }
}


__device__ __forceinline__ void phase_mid_rowwise(Frame& F) {
    PHASE_IDS();
    LAS float* baw = (LAS float*)F.lds;
    for (int idx = tid; idx < 16 * 1024; idx += 512) { const int j = idx & 15, k = idx >> 4; baw[j * 1024 + k] = F.in[28][(size_t)k * OD_IN + OD_MAIN + j]; }
    __syncthreads();
    const int gw = F.vcu * 8 + wave, NGW = F.G * 8;
    for (int m = gw; m < MT; m += NGW) {
        int s, t; tok_info(m, s, t);
        const float* xrow = m < MP ? F.in[0] + (size_t)m * D : F.in[1] + (size_t)(m - MP) * D;
        const float* mod0 = F.MOD() + (size_t)s * 3072; const float* mod1 = F.MOD() + (size_t)(24 + s) * 3072;
        f32x4 y[4]; float ss = 0.f;
#pragma unroll
        for (int j = 0; j < 4; ++j) { const u32x2 w = *(const u32x2*)(F.YO() + (size_t)m * D + 4 * lane + 256 * j); y[j] = (f32x4){lo16(w.x), hi16(w.x), lo16(w.y), hi16(w.y)};
            ss += (y[j][0] * y[j][0] + y[j][1] * y[j][1]) + (y[j][2] * y[j][2] + y[j][3] * y[j][3]); }
        const float r1 = rsqrtf(wave_sum(ss, lane) * (1.f / D) + EPS);
        f32x4 x1[4]; float s2 = 0.f;
#pragma unroll
        for (int j = 0; j < 4; ++j) { const int c = 4 * lane + 256 * j;
            const f32x4 xv = *(const f32x4*)(xrow + c), g = *(const f32x4*)(F.in[13] + c), gt = *(const f32x4*)(mod0 + 2048 + c);
#pragma unroll
            for (int e = 0; e < 4; ++e) x1[j][e] = xv[e] + gt[e] * (y[j][e] * r1 * g[e]);
            *(f32x4*)(F.out + O_Y + (size_t)m * D + c) = x1[j];
            s2 += (x1[j][0] * x1[j][0] + x1[j][1] * x1[j][1]) + (x1[j][2] * x1[j][2] + x1[j][3] * x1[j][3]); }
        const float r2 = rsqrtf(wave_sum(s2, lane) * (1.f / D) + EPS);
        f32x4 hm[4];
#pragma unroll
        for (int j = 0; j < 4; ++j) { const int c = 4 * lane + 256 * j;
            const f32x4 g = *(const f32x4*)(F.in[26] + c), sh = *(const f32x4*)(mod1 + c), sc = *(const f32x4*)(mod1 + 1024 + c);
#pragma unroll
            for (int e = 0; e < 4; ++e) hm[j][e] = x1[j][e] * r2 * g[e] * (1.f + sc[e]) + sh[e];
            u32x2 w; w.x = pk2(hm[j][0], hm[j][1]); w.y = pk2(hm[j][2], hm[j][3]); *(u32x2*)(F.XN() + (size_t)m * D + c) = w; }
        float mine = 0.f;
#pragma unroll 1
        for (int q = 0; q < 16; ++q) { float p = 0.f;
#pragma unroll
            for (int j = 0; j < 4; ++j) { const f32x4 w = *(const LAS f32x4*)(baw + q * 1024 + 256 * j + 4 * lane); p += (hm[j][0] * w[0] + hm[j][1] * w[1]) + (hm[j][2] * w[2] + hm[j][3] * w[3]); }
            p = wave_sum(p, lane); mine = (lane == q) ? p : mine; }
        if (lane < 16) F.BA()[(size_t)m * 16 + lane] = mine;
    }
}


typedef float f32x16 __attribute__((ext_vector_type(16)));
typedef __bf16 bf16x2_t __attribute__((ext_vector_type(2)));
constexpr int GS_WF = 0, GS_QF = 16384, GS_KF = 32768, GS_PF = 49152, GS_UF = 57344, GS_BYTES = 73728;
constexpr size_t WS_DEC = 11 * MiB;
__device__ __forceinline__ unsigned cvt2(float a, float b) { f32x2 v = {a, b}; bf16x2_t r = __builtin_convertvector(v, bf16x2_t); return __builtin_bit_cast(unsigned, r); }
__device__ __forceinline__ int krow(int s, int h, int j) { return 16 * s + 8 * (j >> 2) + 4 * h + (j & 3); }
#define MFMA32(a, b, c) __builtin_amdgcn_mfma_f32_32x32x16_bf16((a), (b), (c), 0, 0, 0)
#define MFMA16(a, b, c) __builtin_amdgcn_mfma_f32_16x16x32_bf16((a), (b), (c), 0, 0, 0)

typedef __amdgpu_buffer_rsrc_t brsrc_t;
__device__ __forceinline__ brsrc_t staging_rsrc(unsigned char* ws) { return __builtin_amdgcn_make_buffer_rsrc((void*)(ws + WS_RB), (short)0, (int)RB_BYTES, 0x00020000); }
__device__ __forceinline__ void st16_wt(brsrc_t r, unsigned off, u32x4 v) { __builtin_amdgcn_raw_buffer_store_b128(v, r, off, 0, 16); }
__device__ __forceinline__ u32x4 ld16_wt(brsrc_t r, unsigned off) { return __builtin_amdgcn_raw_buffer_load_b128(r, off, 0, 16); }
__device__ __forceinline__ void st8_wt(unsigned char* p, u32x2 v) { __hip_atomic_store((unsigned long long*)p, ((unsigned long long)v[1] << 32) | v[0], __ATOMIC_RELAXED, __HIP_MEMORY_SCOPE_AGENT); }
constexpr size_t WS_READY = 65536;
#define LDS_BARRIER() do { asm volatile("s_waitcnt lgkmcnt(0)" ::: "memory"); __builtin_amdgcn_s_barrier(); asm volatile("" ::: "memory"); } while (0)
constexpr int G1_QS = 0, G1_KS = 17408, G1_VS = 34816, G1_AS = 52224, G1_PS = 69632, G1_WS = 78848, G1_CW = 96256, G1_VEC = 102400, G1_ES = 103424;
__device__ __forceinline__ void g1_load_raw(Frame& F, u32x4 (&raw)[24], int s, int c, int h, int t1) {
    const int r = t1 >> 3, j = t1 & 7, t = c * 64 + r;
#pragma unroll
    for (int p = 0; p < 3; ++p)
#pragma unroll
        for (int jj = 0; jj < 4; ++jj) { const int tt = t - 3 + jj, ttc = tt < 0 ? 0 : tt;
            const u32x4* src = (const u32x4*)(F.QKV1() + (size_t)(s * TP + ttc) * 3072 + p * 1024 + h * 128 + j * 16); raw[p * 8 + jj * 2] = src[0]; raw[p * 8 + jj * 2 + 1] = src[1]; }
}
__device__ __forceinline__ bf16x8 g1_pack_b(const f32x4 p, const f32x4 q) { u32x4 w; w[0] = cvt2(p[0], p[1]); w[1] = cvt2(p[2], p[3]); w[2] = cvt2(q[0], q[1]); w[3] = cvt2(q[2], q[3]); return __builtin_bit_cast(bf16x8, w); }
__device__ __forceinline__ void g1_decode(int n, int& s, int& c, int& h) { if (n < 4096) { c = n >> 6; s = (n & 63) >> 3; h = n & 7; } else { s = BP + ((n - 4096) >> 3); c = 0; h = n & 7; } }
__device__ __forceinline__ void gdn_g1_tasks(Frame& F, const int first, const int stride) {
    int tid = opaque_tid(F.wv);
    const int lane = tid & 63, wave = __builtin_amdgcn_readfirstlane(tid >> 6);
    LAS unsigned char* L = F.lds;
    LAS float* cw_s = (LAS float*)(L + G1_CW);
    LAS float* beta_s = (LAS float*)(L + G1_VEC); LAS float* gcum_s = beta_s + 64; LAS float* eg_s = beta_s + 128; LAS float* ek_s = beta_s + 192;
    float* DEC = (float*)(F.ws + WS_DEC);
    u32x4 raw[24];
    float pcw[3], pb = 0.f, pa = 0.f;
    const brsrc_t srs = staging_rsrc(F.ws);
    unsigned* ready = (unsigned*)(F.ws + WS_READY);
    { int s0, c0, h0; g1_decode(first < 4095 ? first : 4095, s0, c0, h0); g1_load_raw(F, raw, s0, c0, h0, tid);
#pragma unroll
        for (int q = 0; q < 3; ++q) { const int i = tid + 512 * q, jj = i / 384, cc = i % 384; pcw[q] = F.in[29][(size_t)jj * 3072 + (cc >> 7) * 1024 + h0 * 128 + (cc & 127)]; }
        const float* ba = F.BA() + (size_t)(s0 * TP + c0 * 64 + (tid & 63)) * 16; pb = ba[h0]; pa = ba[8 + h0]; }
    for (int task = first; task < 4224; task += stride) {
        const int tid = opaque_tid(F.wv), lane = tid & 63;
        int s, c, h; g1_decode(task, s, c, h);
        const int nvalid = s < BP ? 64 : TS, t0 = c * 64, base = seq_base(s), T = seq_len(s);
        const int sidx = task < 4096 ? ((s * 8 + h) * 64 + c) : task;
        unsigned char* blk = F.ws + WS_RB + (size_t)sidx * GS_BYTES; const unsigned boff = (unsigned)sidx * (unsigned)GS_BYTES;
        if (s < BP) {
#pragma unroll
            for (int q = 0; q < 3; ++q) cw_s[tid + 512 * q] = pcw[q];
        } else for (int i = tid; i < 4 * 384; i += 512) { const int jj = i / 384, cc = i % 384; cw_s[i] = F.in[29][(size_t)jj * 3072 + (cc >> 7) * 1024 + h * 128 + (cc & 127)]; }
        if (tid < 64) {
            const bool ok = tid < nvalid; float beta = 0.f, g = 0.f;
            if (ok) { float vb = pb, va = pa; if (s >= BP) { const float* ba = F.BA() + (size_t)(base + t0 + tid) * 16; vb = ba[h]; va = ba[8 + h]; }
                beta = sigmoidf_(vb); g = -__expf(F.in[30][h]) * softplusf_(va + F.in[31][h]); }
            float x = g;
#pragma unroll
            for (int o = 1; o < 64; o <<= 1) { const float y = shfl_idx(x, lane >= o ? lane - o : lane); if (lane >= o) x += y; }
            const float gl = shfl_idx(x, 63);
            beta_s[tid] = beta; gcum_s[tid] = x; eg_s[tid] = __expf(x); ek_s[tid] = ok ? __expf(gl - x) : 0.f;
            if (tid == 0) __hip_atomic_store((unsigned*)DEC + sidx, __float_as_uint(__expf(gl)), __ATOMIC_RELAXED, __HIP_MEMORY_SCOPE_AGENT);
        }
        LDS_BARRIER();
        {
            int t1 = tid; asm volatile("" : "+v"(t1));
            const int r = t1 >> 3, j = t1 & 7, t = t0 + r; const bool ok = r < nvalid;
#pragma unroll
            for (int p = 0; p < 3; ++p) {
                float acc[16], cur[16];
#pragma unroll
                for (int e = 0; e < 16; ++e) { acc[e] = 0.f; cur[e] = 0.f; }
                const int cb = p * 1024 + h * 128 + j * 16;
#pragma unroll
                for (int jj = 0; jj < 4; ++jj) {
                    const int tt = t - 3 + jj; float x[16];
                    if (s < BP) { const u32x4 a = raw[p * 8 + jj * 2], b = raw[p * 8 + jj * 2 + 1]; const bool v = tt >= 0;
#pragma unroll
                        for (int e = 0; e < 4; ++e) { x[2 * e] = v ? lo16(a[e]) : 0.f; x[2 * e + 1] = v ? hi16(a[e]) : 0.f; x[8 + 2 * e] = v ? lo16(b[e]) : 0.f; x[8 + 2 * e + 1] = v ? hi16(b[e]) : 0.f; } }
                    else if (ok && tt >= 0) { const u32x4* src = (const u32x4*)(F.QKV1() + (size_t)(base + tt) * 3072 + cb); const u32x4 a = src[0], b = src[1];
#pragma unroll
                        for (int e = 0; e < 4; ++e) { x[2 * e] = lo16(a[e]); x[2 * e + 1] = hi16(a[e]); x[8 + 2 * e] = lo16(b[e]); x[8 + 2 * e + 1] = hi16(b[e]); } }
                    else if (ok) { const f32x4* src = (const f32x4*)(F.in[6] + ((size_t)(s - BP) * 3 + (tt + 3)) * 3072 + cb);
#pragma unroll
                        for (int q = 0; q < 4; ++q) { const f32x4 a = src[q]; x[4 * q] = a[0]; x[4 * q + 1] = a[1]; x[4 * q + 2] = a[2]; x[4 * q + 3] = a[3]; } }
                    else {
#pragma unroll
                        for (int e = 0; e < 16; ++e) x[e] = 0.f; }
                    const LAS f32x4* wp = (const LAS f32x4*)(cw_s + jj * 384 + p * 128 + j * 16);
#pragma unroll
                    for (int q = 0; q < 4; ++q) { const f32x4 w4 = wp[q]; acc[4 * q] += w4[0] * x[4 * q]; acc[4 * q + 1] += w4[1] * x[4 * q + 1]; acc[4 * q + 2] += w4[2] * x[4 * q + 2]; acc[4 * q + 3] += w4[3] * x[4 * q + 3]; }
                    if (jj == 3) {
#pragma unroll
                        for (int e = 0; e < 16; ++e) cur[e] = x[e]; }
                }
                if (ok && t >= T - 3) {
                    float* o = (s < BP ? F.out + O_GCP + ((size_t)s * 3 + (t - (T - 3))) * 3072 : F.out + O_GCS + ((size_t)(s - BP) * 3 + (t - (T - 3))) * 3072) + cb;
#pragma unroll
                    for (int q = 0; q < 4; ++q) *(f32x4*)(o + 4 * q) = (f32x4){cur[4 * q], cur[4 * q + 1], cur[4 * q + 2], cur[4 * q + 3]};
                }
                float ss = 0.f;
#pragma unroll
                for (int e = 0; e < 16; ++e) { acc[e] = siluf_(acc[e]); ss += acc[e] * acc[e]; }
                if (p < 2) { ss += shfl_xor_l(ss, 1, lane); ss += shfl_xor_l(ss, 2, lane); ss += shfl_xor_l(ss, 4, lane);
                    float sc = rsqrtf(ss + EPS); if (p == 0) sc *= 0.08838834764831845f;
#pragma unroll
                    for (int e = 0; e < 16; ++e) acc[e] *= sc; }
                u32x4 w0, w1;
#pragma unroll
                for (int e = 0; e < 4; ++e) { w0[e] = ok ? cvt2(acc[2 * e], acc[2 * e + 1]) : 0u; w1[e] = ok ? cvt2(acc[8 + 2 * e], acc[8 + 2 * e + 1]) : 0u; }
                LAS u32x4* dst = (LAS u32x4*)(L + (p == 0 ? G1_QS : p == 1 ? G1_KS : G1_VS) + r * 272 + j * 32);
                dst[0] = w0; dst[1] = w1;
                __builtin_amdgcn_sched_barrier(0);
            }
            { const int ntk = task + stride < 4095 ? task + stride : 4095; int s1, c1, h1; g1_decode(ntk, s1, c1, h1); g1_load_raw(F, raw, s1, c1, h1, t1);
#pragma unroll
              for (int q = 0; q < 3; ++q) { const int i = t1 + 512 * q, jj = i / 384, cc = i % 384; pcw[q] = F.in[29][(size_t)jj * 3072 + (cc >> 7) * 1024 + h1 * 128 + (cc & 127)]; }
              const float* ba = F.BA() + (size_t)(s1 * TP + c1 * 64 + (t1 & 63)) * 16; pb = ba[h1]; pa = ba[8 + h1]; }
        }
        LDS_BARRIER();
        {
            int l2 = lane; asm volatile("" : "+v"(l2));
            const int which = wave >> 2, ti = (wave >> 1) & 1, tj = wave & 1, r = l2 & 31, hh = l2 >> 5;
            f32x16 acc;
#pragma unroll
            for (int e = 0; e < 16; ++e) acc[e] = 0.f;
            if (!(ti == 0 && tj == 1)) {
                const LAS unsigned char* ap = L + (which ? G1_QS : G1_KS) + (32 * ti + r) * 272 + hh * 16;
                const LAS unsigned char* bp = L + G1_KS + (32 * tj + r) * 272 + hh * 16;
#pragma unroll
                for (int ks = 0; ks < 8; ++ks) { const bf16x8 a = *(const LAS bf16x8*)(ap + ks * 32), b = *(const LAS bf16x8*)(bp + ks * 32); acc = MFMA32(a, b, acc); }
            }
            const int jc = 32 * tj + r; const float gj = gcum_s[jc];
#pragma unroll
            for (int e = 0; e < 16; ++e) {
                const int i = 32 * ti + (e & 3) + 8 * (e >> 2) + 4 * hh; const float dg = gcum_s[i] - gj;
                if (which == 0) { const float f = (i > jc) ? __expf(dg) * beta_s[i] : 0.f; *(LAS float*)(L + G1_AS + i * 272 + jc * 4) = acc[e] * f; }
                else { const float f = (i >= jc) ? __expf(dg) : 0.f; *(LAS bf16_t*)(L + G1_PS + i * 144 + jc * 2) = (bf16_t)(cvt2(acc[e] * f, 0.f) & 0xffffu); }
            }
        }
        LDS_BARRIER();
        if (wave == 0) {
            int l3 = lane; asm volatile("" : "+v"(l3));
            const int bk = l3 >> 4, col = l3 & 15;
            float tcol[16];
#pragma unroll
            for (int rr = 0; rr < 16; ++rr) {
                float a = (rr == col) ? 1.0f : 0.f;
#pragma unroll
                for (int j4 = 0; j4 < (rr + 3) / 4; ++j4) { const f32x4 a4 = *(const LAS f32x4*)(L + G1_AS + (16 * bk + rr) * 272 + (16 * bk + 4 * j4) * 4);
#pragma unroll
                    for (int q = 0; q < 4; ++q) if (4 * j4 + q < rr) a -= a4[q] * tcol[4 * j4 + q]; }
                tcol[rr] = a;
                *(LAS float*)(L + G1_ES + ((bk * 16 + rr) * 16 + col) * 4) = a - ((rr == col) ? 1.0f : 0.f);
            }
        } else if (wave >= 4) {
            int l3 = lane; asm volatile("" : "+v"(l3));
            const int wv = wave - 4, r = l3 & 31, hh = l3 >> 5;
            {   const int rt4 = wv;
#pragma unroll
                for (int kt2 = 0; kt2 < 2; ++kt2)
#pragma unroll
                    for (int ss = 0; ss < 2; ++ss) { float v[8];
#pragma unroll
                        for (int j = 0; j < 8; ++j) { const int tok = 32 * kt2 + krow(ss, hh, j); v[j] = bf2f(*(const LAS bf16_t*)(L + G1_KS + tok * 272 + (32 * rt4 + r) * 2)) * ek_s[tok]; }
                        u32x4 o; o[0] = cvt2(v[0], v[1]); o[1] = cvt2(v[2], v[3]); o[2] = cvt2(v[4], v[5]); o[3] = cvt2(v[6], v[7]);
                        st16_wt(srs, boff + GS_KF + ((rt4 * 2 + kt2) * 2 + ss) * 1024 + l3 * 16, o); } }
            {   const int kt = wv;
#pragma unroll
                for (int rt = 0; rt < 2; ++rt)
#pragma unroll
                    for (int ss = 0; ss < 2; ++ss) { const int i = 32 * rt + r; const float sc = eg_s[i];
                        const u32x2 lo = *(const LAS u32x2*)(L + G1_QS + i * 272 + (32 * kt + 16 * ss + 4 * hh) * 2), hi = *(const LAS u32x2*)(L + G1_QS + i * 272 + (32 * kt + 16 * ss + 8 + 4 * hh) * 2);
                        u32x4 o; o[0] = cvt2(lo16(lo[0]) * sc, hi16(lo[0]) * sc); o[1] = cvt2(lo16(lo[1]) * sc, hi16(lo[1]) * sc); o[2] = cvt2(lo16(hi[0]) * sc, hi16(hi[0]) * sc); o[3] = cvt2(lo16(hi[1]) * sc, hi16(hi[1]) * sc);
                        st16_wt(srs, boff + GS_QF + ((rt * 4 + kt) * 2 + ss) * 1024 + l3 * 16, o); } }
            {   const int rt = wv >> 1, kt2 = wv & 1;
#pragma unroll
                for (int ss = 0; ss < 2; ++ss) { const int i = 32 * rt + r;
                    const u32x2 lo = *(const LAS u32x2*)(L + G1_PS + i * 144 + (32 * kt2 + 16 * ss + 4 * hh) * 2), hi = *(const LAS u32x2*)(L + G1_PS + i * 144 + (32 * kt2 + 16 * ss + 8 + 4 * hh) * 2);
                    u32x4 o; o[0] = lo[0]; o[1] = lo[1]; o[2] = hi[0]; o[3] = hi[1];
                    st16_wt(srs, boff + GS_PF + ((rt * 2 + kt2) * 2 + ss) * 1024 + l3 * 16, o); } }
        }
        LDS_BARRIER();
        {
            int l4 = lane; asm volatile("" : "+v"(l4));
            const int c16 = l4 & 15, g = l4 >> 4;
            const f32x4 z4 = {0.f, 0.f, 0.f, 0.f};
            f32x4 a10, a20, a21, a30, a31, a32, e0, e1, e2, e3;
            { const LAS unsigned char* ar = L + G1_AS + c16 * 272 + (4 * g) * 4;
              a10 = *(const LAS f32x4*)(ar + 16 * 272); a20 = *(const LAS f32x4*)(ar + 32 * 272); a21 = *(const LAS f32x4*)(ar + 32 * 272 + 64);
              a30 = *(const LAS f32x4*)(ar + 48 * 272); a31 = *(const LAS f32x4*)(ar + 48 * 272 + 64); a32 = *(const LAS f32x4*)(ar + 48 * 272 + 128);
              const LAS unsigned char* er = L + G1_ES + (c16 * 16 + 4 * g) * 4;
              e0 = *(const LAS f32x4*)er; e1 = *(const LAS f32x4*)(er + 1024); e2 = *(const LAS f32x4*)(er + 2048); e3 = *(const LAS f32x4*)(er + 3072); }
            const bf16x8 fA10 = g1_pack_b(z4 - a10, z4), fA2 = g1_pack_b(z4 - a20, z4 - a21), fA3a = g1_pack_b(z4 - a30, z4 - a31), fA3b = g1_pack_b(z4 - a32, z4);
            const bf16x8 fE0 = g1_pack_b(e0, z4), fE1 = g1_pack_b(e1, z4), fE2 = g1_pack_b(e2, z4), fE3 = g1_pack_b(e3, z4);
            const bool isw = wave < 4; const int cbase = 32 * (wave & 3);
#pragma unroll
            for (int tl = 0; tl < 2; ++tl) {
                const int d = cbase + 16 * tl + c16;
                f32x4 R[4];
#pragma unroll
                for (int i = 0; i < 4; ++i)
#pragma unroll
                    for (int e = 0; e < 4; ++e) { const int row = 16 * i + 4 * g + e; const float raw1 = bf2f(*(const LAS bf16_t*)(L + (isw ? G1_KS : G1_VS) + row * 272 + d * 2)); R[i][e] = raw1 * beta_s[row] * (isw ? eg_s[row] : 1.0f); }
                const f32x4 X0 = MFMA16(fE0, g1_pack_b(R[0], z4), R[0]);
                const f32x4 Y1 = MFMA16(fA10, g1_pack_b(X0, z4), R[1]);
                const f32x4 X1 = MFMA16(fE1, g1_pack_b(Y1, z4), Y1);
                const f32x4 Y2 = MFMA16(fA2, g1_pack_b(X0, X1), R[2]);
                const f32x4 X2 = MFMA16(fE2, g1_pack_b(Y2, z4), Y2);
                f32x4 Y3 = MFMA16(fA3a, g1_pack_b(X0, X1), R[3]);
                Y3 = MFMA16(fA3b, g1_pack_b(X2, z4), Y3);
                const f32x4 X3 = MFMA16(fE3, g1_pack_b(Y3, z4), Y3);
                const f32x4 X[4] = {X0, X1, X2, X3};
                if (isw) {
#pragma unroll
                    for (int i = 0; i < 4; ++i)
#pragma unroll
                        for (int e = 0; e < 4; ++e) *(LAS bf16_t*)(L + G1_WS + (16 * i + 4 * g + e) * 272 + d * 2) = (bf16_t)(cvt2(-X[i][e], 0.f) & 0xffffu);
                } else {
                    const int ws = wave & 3, cc = 16 * tl + c16;
#pragma unroll
                    for (int i = 0; i < 4; ++i) { const int rt = i >> 1, q = 2 * (i & 1) + (g >> 1), hh = g & 1;
                        u32x2 o; o[0] = cvt2(X[i][0], X[i][1]); o[1] = cvt2(X[i][2], X[i][3]);
                        st8_wt(blk + GS_UF + (size_t)(((ws * 2 + rt) * 64) + cc + 32 * hh) * 32 + q * 8, o); }
                }
            }
        }
        LDS_BARRIER();
        {
            int l5 = lane; asm volatile("" : "+v"(l5));
            const int kt = wave & 3, rt = wave >> 2, r = l5 & 31, hh = l5 >> 5, i = 32 * rt + r;
#pragma unroll
            for (int ss = 0; ss < 2; ++ss) {
                const u32x2 lo = *(const LAS u32x2*)(L + G1_WS + i * 272 + (32 * kt + 16 * ss + 4 * hh) * 2), hi = *(const LAS u32x2*)(L + G1_WS + i * 272 + (32 * kt + 16 * ss + 8 + 4 * hh) * 2);
                u32x4 o; o[0] = lo[0]; o[1] = lo[1]; o[2] = hi[0]; o[3] = hi[1];
                st16_wt(srs, boff + GS_WF + ((rt * 4 + kt) * 2 + ss) * 1024 + l5 * 16, o); }
        }
        asm volatile("s_waitcnt vmcnt(0)" ::: "memory");
        LDS_BARRIER();
        if (tid == 0 && task < 4096) __hip_atomic_store(ready + 16 * sidx, 1u, __ATOMIC_RELAXED, __HIP_MEMORY_SCOPE_AGENT);
    }
}

constexpr int G2_FB = GS_BYTES, G2_OSTRIDE = 528, G2_HN = 2 * G2_FB, G2_DEC = G2_HN + 512;
__device__ __forceinline__ bf16x8 pack8(const f32x16& x, const int s) {
    u32x4 p; p[0] = cvt2(x[8 * s], x[8 * s + 1]); p[1] = cvt2(x[8 * s + 2], x[8 * s + 3]); p[2] = cvt2(x[8 * s + 4], x[8 * s + 5]); p[3] = cvt2(x[8 * s + 6], x[8 * s + 7]);
    return __builtin_bit_cast(bf16x8, p);
}
template <bool WT>
__device__ __forceinline__ void g2_load_set(u32x4 (&pre)[18], float& dpre, const unsigned char* blk, int lt, brsrc_t srs, unsigned boff, const unsigned* flag, const float* decp) {
    if (WT) { unsigned sp = 0; while (__builtin_amdgcn_readfirstlane(__hip_atomic_load(flag, __ATOMIC_RELAXED, __HIP_MEMORY_SCOPE_AGENT)) == 0u && ++sp < (1u << 20)) __builtin_amdgcn_s_sleep(4);
        dpre = __uint_as_float(__hip_atomic_load((const unsigned*)decp, __ATOMIC_RELAXED, __HIP_MEMORY_SCOPE_AGENT));
#pragma unroll
        for (int i = 0; i < 18; ++i) pre[i] = ld16_wt(srs, boff + (unsigned)(i * 256 + lt) * 16u);
    } else { const u32x4* src = (const u32x4*)blk; dpre = *decp;
#pragma unroll
        for (int i = 0; i < 18; ++i) pre[i] = src[i * 256 + lt]; }
}
__device__ __forceinline__ void g2_store_set(const u32x4 (&pre)[18], LAS unsigned char* dst, int lt) {
#pragma unroll
    for (int i = 0; i < 18; ++i) *(LAS u32x4*)(dst + (size_t)(i * 256 + lt) * 16) = pre[i];
}
#define G2_FRAG(off) (*(const LAS bf16x8*)(B + (off)))
#define G2_SCHED() __builtin_amdgcn_sched_barrier(0)
__device__ __forceinline__ void g2_mfma_step(f32x16& S0, f32x16& S1, f32x16& S2, f32x16& S3, LAS unsigned char* Bimg, const float dec, int ws, int lane, int cc, int hh) {
    const LAS unsigned char* B = Bimg + lane * 16;
    f32x16 vn0, vn1, o0, o1;
    { const LAS u32x4* up = (const LAS u32x4*)(Bimg + GS_UF + (size_t)(ws * 2 * 64 + lane) * 32); const u32x4 u0 = up[0], u1 = up[1], u2 = up[128], u3 = up[129];
#pragma unroll
      for (int q = 0; q < 4; ++q) { vn0[2 * q] = lo16(u0[q]); vn0[2 * q + 1] = hi16(u0[q]); vn0[8 + 2 * q] = lo16(u1[q]); vn0[8 + 2 * q + 1] = hi16(u1[q]);
                                    vn1[2 * q] = lo16(u2[q]); vn1[2 * q + 1] = hi16(u2[q]); vn1[8 + 2 * q] = lo16(u3[q]); vn1[8 + 2 * q + 1] = hi16(u3[q]); } }
#pragma unroll
    for (int e = 0; e < 16; ++e) { o0[e] = 0.f; o1[e] = 0.f; }
#define G2_WQ(Sx, kt) do { _Pragma("unroll") for (int ss = 0; ss < 2; ++ss) { const bf16x8 sb = pack8(Sx, ss); \
        const bf16x8 fw0 = G2_FRAG(GS_WF + ((0 * 4 + kt) * 2 + ss) * 1024), fw1 = G2_FRAG(GS_WF + ((1 * 4 + kt) * 2 + ss) * 1024); \
        const bf16x8 fq0 = G2_FRAG(GS_QF + ((0 * 4 + kt) * 2 + ss) * 1024), fq1 = G2_FRAG(GS_QF + ((1 * 4 + kt) * 2 + ss) * 1024); \
        vn0 = MFMA32(fw0, sb, vn0); vn1 = MFMA32(fw1, sb, vn1); o0 = MFMA32(fq0, sb, o0); o1 = MFMA32(fq1, sb, o1); } } while (0)
    G2_WQ(S0, 0); G2_WQ(S1, 1); G2_WQ(S2, 2); G2_WQ(S3, 3);
#undef G2_WQ
    bf16x8 vb[2][2];
    vb[0][0] = pack8(vn0, 0); vb[0][1] = pack8(vn0, 1); vb[1][0] = pack8(vn1, 0); vb[1][1] = pack8(vn1, 1);
#pragma unroll
    for (int kt2 = 0; kt2 < 2; ++kt2)
#pragma unroll
        for (int ss = 0; ss < 2; ++ss) { o0 = MFMA32(G2_FRAG(GS_PF + ((0 * 2 + kt2) * 2 + ss) * 1024), vb[kt2][ss], o0); o1 = MFMA32(G2_FRAG(GS_PF + ((1 * 2 + kt2) * 2 + ss) * 1024), vb[kt2][ss], o1); }
    S0 = S0 * dec; S1 = S1 * dec; S2 = S2 * dec; S3 = S3 * dec;
#pragma unroll
    for (int kt2 = 0; kt2 < 2; ++kt2)
#pragma unroll
        for (int ss = 0; ss < 2; ++ss) {
            S0 = MFMA32(G2_FRAG(GS_KF + ((0 * 2 + kt2) * 2 + ss) * 1024), vb[kt2][ss], S0); S1 = MFMA32(G2_FRAG(GS_KF + ((1 * 2 + kt2) * 2 + ss) * 1024), vb[kt2][ss], S1);
            S2 = MFMA32(G2_FRAG(GS_KF + ((2 * 2 + kt2) * 2 + ss) * 1024), vb[kt2][ss], S2); S3 = MFMA32(G2_FRAG(GS_KF + ((3 * 2 + kt2) * 2 + ss) * 1024), vb[kt2][ss], S3); }
    LDS_BARRIER();
#pragma unroll
    for (int e = 0; e < 16; ++e) { const int rr = (e & 3) + 8 * (e >> 2) + 4 * hh;
        *(LAS float*)(Bimg + rr * G2_OSTRIDE + (32 * ws + cc) * 4) = o0[e]; *(LAS float*)(Bimg + (32 + rr) * G2_OSTRIDE + (32 * ws + cc) * 4) = o1[e]; }
    LDS_BARRIER();
}
__device__ __forceinline__ void g2_epi_step(Frame& F, LAS unsigned char* L, const LAS unsigned char* Oimg, const u32x4 (&zz)[4], int row, int seg, size_t m, int h, bool rok, int lane) {
    float ss = 0.f;
#pragma unroll
    for (int q = 0; q < 8; ++q) { const f32x4 ov = *(const LAS f32x4*)(Oimg + row * G2_OSTRIDE + (seg * 32 + 4 * q) * 4); ss += (ov[0] * ov[0] + ov[1] * ov[1]) + (ov[2] * ov[2] + ov[3] * ov[3]); }
    ss += shfl_xor_l(ss, 1, lane); ss += shfl_xor_l(ss, 2, lane);
    const float rn = rsqrtf(ss * (1.f / 128.f) + EPS);
    if (rok) {
        u32x4* yp = (u32x4*)(F.Y1() + m * D + h * 128 + seg * 32);
        const LAS float* hn_s = (const LAS float*)(L + G2_HN);
#pragma unroll
        for (int q = 0; q < 4; ++q) {
            const f32x4 oa = *(const LAS f32x4*)(Oimg + row * G2_OSTRIDE + (seg * 32 + 8 * q) * 4), ob = *(const LAS f32x4*)(Oimg + row * G2_OSTRIDE + (seg * 32 + 8 * q + 4) * 4);
            const f32x4 ha = *(const LAS f32x4*)(hn_s + seg * 32 + 8 * q), hb = *(const LAS f32x4*)(hn_s + seg * 32 + 8 * q + 4);
            u32x4 yo;
            yo[0] = cvt2(oa[0] * rn * ha[0] * siluf_(lo16(zz[q][0])), oa[1] * rn * ha[1] * siluf_(hi16(zz[q][0])));
            yo[1] = cvt2(oa[2] * rn * ha[2] * siluf_(lo16(zz[q][1])), oa[3] * rn * ha[3] * siluf_(hi16(zz[q][1])));
            yo[2] = cvt2(ob[0] * rn * hb[0] * siluf_(lo16(zz[q][2])), ob[1] * rn * hb[1] * siluf_(hi16(zz[q][2])));
            yo[3] = cvt2(ob[2] * rn * hb[2] * siluf_(lo16(zz[q][3])), ob[3] * rn * hb[3] * siluf_(hi16(zz[q][3])));
            yp[q] = yo; }
    }
}
template <int NCH>
__device__ __forceinline__ void g2_task(Frame& F, LAS unsigned char* L, const float* DEC, int s, int h, int ch0, int tid, int lane, int wave) {
    const size_t cstep = (size_t)GS_BYTES;
    const int base = seq_base(s), nvalid = s < BP ? 64 : TS;
    const unsigned char* blk0 = F.ws + WS_RB + (size_t)ch0 * GS_BYTES;
    constexpr int lastc = NCH - 1;
    if (wave < 4) {
        const int ws = wave, cc = lane & 31, hh = lane >> 5;
        f32x16 S0, S1, S2, S3;
        if (s < BP) {
#pragma unroll
            for (int e = 0; e < 16; ++e) { S0[e] = 0.f; S1[e] = 0.f; S2[e] = 0.f; S3[e] = 0.f; }
        } else {
            const float* sp = F.in[7] + ((size_t)(s - BP) * 8 + h) * 16384 + 32 * ws + cc;
#pragma unroll
            for (int e = 0; e < 16; ++e) { const int rr = (e & 3) + 8 * (e >> 2) + 4 * hh; S0[e] = sp[(size_t)rr * 128]; S1[e] = sp[(size_t)(32 + rr) * 128]; S2[e] = sp[(size_t)(64 + rr) * 128]; S3[e] = sp[(size_t)(96 + rr) * 128]; }
        }
        const LAS float* dec_s = (const LAS float*)(L + G2_DEC);
        LDS_BARRIER();
        if (NCH == 1) g2_mfma_step(S0, S1, S2, S3, L, dec_s[0], ws, lane, cc, hh);
        else for (int c = 0; c < NCH; c += 2) {
            g2_mfma_step(S0, S1, S2, S3, L, dec_s[c], ws, lane, cc, hh);
            g2_mfma_step(S0, S1, S2, S3, L + G2_FB, dec_s[c + 1], ws, lane, cc, hh);
        }
        int l9 = lane; asm volatile("" : "+v"(l9));
        const int cc9 = l9 & 31, hh9 = l9 >> 5;
        float* so = (s < BP ? F.out + O_GSP + ((size_t)s * 8 + h) * 16384 : F.out + O_GSS + ((size_t)(s - BP) * 8 + h) * 16384) + 32 * ws + cc9;
#pragma unroll
        for (int e = 0; e < 16; ++e) { const int rr = (e & 3) + 8 * (e >> 2) + 4 * hh9; so[(size_t)rr * 128] = S0[e]; so[(size_t)(32 + rr) * 128] = S1[e]; so[(size_t)(64 + rr) * 128] = S2[e]; so[(size_t)(96 + rr) * 128] = S3[e]; }
    } else {
        const int lt = tid - 256;
        if (lt < 128) ((LAS float*)(L + G2_HN))[lt] = F.in[32][lt];
        constexpr bool WT = NCH > 1;
        const brsrc_t srs = staging_rsrc(F.ws);
        const unsigned* ready = (const unsigned*)(F.ws + WS_READY);
        LAS float* dec_w = (LAS float*)(L + G2_DEC);
#define G2_LOAD(pre, dpre, k) do { const int _k = (k) < lastc ? (k) : lastc; g2_load_set<WT>(pre, dpre, blk0 + (size_t)_k * cstep, lt, srs, (unsigned)(ch0 + _k) * (unsigned)GS_BYTES, ready + 16 * (ch0 + _k), DEC + ch0 + _k); } while (0)
        u32x4 preA[18], preB[18]; float dA, dB;
        G2_LOAD(preA, dA, 0);
        G2_LOAD(preB, dB, 1);
        g2_store_set(preA, L, lt); if (lt == 0) dec_w[0] = dA;
        G2_LOAD(preA, dA, 2);
        const int row = lt >> 2, seg = lt & 3; const bool rok = row < nvalid;
        u32x4 zz[4];
        LDS_BARRIER();
        if (NCH == 1) {
            const size_t m = (size_t)base + row;
            if (rok) { const u32x4* zp = (const u32x4*)(F.Z1() + m * D + h * 128 + seg * 32);
#pragma unroll
                for (int q = 0; q < 4; ++q) zz[q] = zp[q]; }
            LDS_BARRIER();
            LDS_BARRIER();
            g2_epi_step(F, L, L, zz, row, seg, m, h, rok, lane);
        } else {
            for (int c = 0; c < NCH; c += 2) {
                {
                    const size_t m = (size_t)base + c * 64 + row;
                    { const u32x4* zp = (const u32x4*)(F.Z1() + m * D + h * 128 + seg * 32);
#pragma unroll
                      for (int q = 0; q < 4; ++q) zz[q] = zp[q]; }
                    g2_store_set(preB, L + G2_FB, lt); if (lt == 0) dec_w[(c + 1) & 63] = dB;
                    G2_LOAD(preB, dB, c + 3);
                    LDS_BARRIER();
                    LDS_BARRIER();
                    g2_epi_step(F, L, L, zz, row, seg, m, h, rok, lane);
                }
                {
                    const size_t m = (size_t)base + (c + 1) * 64 + row;
                    { const u32x4* zp = (const u32x4*)(F.Z1() + m * D + h * 128 + seg * 32);
#pragma unroll
                      for (int q = 0; q < 4; ++q) zz[q] = zp[q]; }
                    g2_store_set(preA, L, lt); if (lt == 0) dec_w[(c + 2) & 63] = dA;
                    G2_LOAD(preA, dA, c + 4);
                    LDS_BARRIER();
                    LDS_BARRIER();
                    g2_epi_step(F, L, L + G2_FB, zz, row, seg, m, h, rok, lane);
                }
            }
        }
    }
}
#undef G2_LOAD
constexpr int G12_CHAINS = 64;
__device__ __forceinline__ void phase_gdn_fused(Frame& F) {
    LAS unsigned char* L = F.lds;
    const float* DEC = (const float*)(F.ws + WS_DEC);
    if ((int)blockIdx.x < G12_CHAINS && F.G > G12_CHAINS) {
        const int tid = opaque_tid(F.wv);
        const int ci = blockIdx.x;
        g2_task<64>(F, L, DEC, ci >> 3, ci & 7, ci * 64, tid, tid & 63, F.wv);
    } else {
        const bool all = !(F.G > G12_CHAINS);
        gdn_g1_tasks(F, all ? (int)blockIdx.x : (int)blockIdx.x - G12_CHAINS, all ? F.G : F.G - G12_CHAINS);
    }
}
__device__ __forceinline__ void phase_gdn_g2_samples(Frame& F) {
    LAS unsigned char* L = F.lds;
    const float* DEC = (const float*)(F.ws + WS_DEC);
    for (int t = F.vcu; t < 128; t += F.G) {
        const int tid = opaque_tid(F.wv);
        g2_task<1>(F, L, DEC, BP + (t >> 3), t & 7, 4096 + t, tid, tid & 63, F.wv);
        __syncthreads();
    }
}

__device__ __forceinline__ float dpp_shr_f(float idv, float x, const int o) {
    int r;
    switch (o) {
        case 1: r = __builtin_amdgcn_update_dpp(__float_as_int(idv), __float_as_int(x), 0x111, 0xf, 0xf, false); break;
        case 2: r = __builtin_amdgcn_update_dpp(__float_as_int(idv), __float_as_int(x), 0x112, 0xf, 0xf, false); break;
        case 4: r = __builtin_amdgcn_update_dpp(__float_as_int(idv), __float_as_int(x), 0x114, 0xf, 0xf, false); break;
        default: r = __builtin_amdgcn_update_dpp(__float_as_int(idv), __float_as_int(x), 0x118, 0xf, 0xf, false); break;
    }
    return __int_as_float(r);
}
template <int PASS>
__device__ __forceinline__ void phase_lru(Frame& F) {
    int tid = opaque_tid(F.wv);
    const int lane = tid & 63, wave = __builtin_amdgcn_readfirstlane(tid >> 6);
    const int gw = F.vcu * 8 + wave, NGW = F.G * 8, h = gw & 7, g = lane >> 4, l15 = lane & 15;
    LAS unsigned char* xs = F.lds + wave * 9216;
    LAS float* cst = (LAS float*)(F.lds + 73728 + wave * 768);
    const bf16_t* LGW = (const bf16_t*)(F.ws + WS_LGW);
    float* LAG = F.LAG();
    bf16x8 wfa[4][2], wfx[4][2];
#pragma unroll
    for (int nt = 0; nt < 4; ++nt)
#pragma unroll
        for (int ks = 0; ks < 2; ++ks) {
            wfa[nt][ks] = *(const bf16x8*)(LGW + ((size_t)(h * 2 + 0) * 64 + 16 * nt + l15) * 64 + 32 * ks + 8 * g);
            wfx[nt][ks] = *(const bf16x8*)(LGW + ((size_t)(h * 2 + 1) * 64 + 16 * nt + l15) * 64 + 32 * ks + 8 * g); }
    cst[lane] = F.in[18][h * 64 + lane]; cst[64 + lane] = F.in[20][h * 64 + lane]; cst[128 + lane] = softplusf_(-F.in[21][h * 64 + lane]);
    for (int task = gw; task < 4224; task += NGW) {
        int s, c; if (task < 4096) { s = task >> 9; c = (task >> 3) & 63; } else { s = BP + ((task - 4096) >> 3); c = 0; }
        const int T = seq_len(s), base = seq_base(s), t0 = c * 64, ntile = s < BP ? 4 : 1;
        {
            int l1 = lane; asm volatile("" : "+v"(l1));
            const int cg = l1 & 7, tp = l1 >> 3;
#pragma unroll 1
            for (int hf2 = 0; hf2 < 2; ++hf2) {
                const int chb = h * 64 + cg * 8 + hf2 * 4;
                float xr[11][4];
#pragma unroll
                for (int i = 0; i < 11; ++i) {
                    const int tt = t0 + tp * 8 - 3 + i;
                    if (tt >= 0 && tt < T) { const u32x2 w = *(const u32x2*)(F.U0() + (size_t)(base + tt) * EV_IN + C_XA + chb);
                        xr[i][0] = lo16(w[0]); xr[i][1] = hi16(w[0]); xr[i][2] = lo16(w[1]); xr[i][3] = hi16(w[1]); }
                    else if (tt < 0 && s >= BP) { const f32x4 a = *(const f32x4*)(F.in[2] + ((size_t)(s - BP) * 3 + (tt + 3)) * 512 + chb); xr[i][0] = a[0]; xr[i][1] = a[1]; xr[i][2] = a[2]; xr[i][3] = a[3]; }
                    else { xr[i][0] = 0.f; xr[i][1] = 0.f; xr[i][2] = 0.f; xr[i][3] = 0.f; }
                }
                const f32x4 c0 = *(const f32x4*)(F.in[15] + chb), c1 = *(const f32x4*)(F.in[15] + 512 + chb), c2 = *(const f32x4*)(F.in[15] + 1024 + chb), c3 = *(const f32x4*)(F.in[15] + 1536 + chb), cb = *(const f32x4*)(F.in[16] + chb);
#pragma unroll
                for (int i = 0; i < 8; ++i) { float o[4];
#pragma unroll
                    for (int e = 0; e < 4; ++e) o[e] = c0[e] * xr[i][e] + c1[e] * xr[i + 1][e] + c2[e] * xr[i + 2][e] + c3[e] * xr[i + 3][e] + cb[e];
                    u32x2 w; w[0] = cvt2(o[0], o[1]); w[1] = cvt2(o[2], o[3]);
                    *(LAS u32x2*)(xs + (tp * 8 + i) * 144 + cg * 16 + hf2 * 8) = w; }
                if (PASS == 2 && t0 + 64 >= T && tp == ((T - 1) >> 3) - (t0 >> 3)) {
                    float* o = (s < BP ? F.out + O_LCP + (size_t)s * 3 * 512 : F.out + O_LCS + (size_t)(s - BP) * 3 * 512) + chb;
#pragma unroll
                    for (int q = 0; q < 3; ++q) *(f32x4*)(o + q * 512) = (f32x4){xr[8 + q][0], xr[8 + q][1], xr[8 + q][2], xr[8 + q][3]};
                }
            }
        }
        float hin[4][4], arun[4][4];
#pragma unroll
        for (int nt = 0; nt < 4; ++nt)
#pragma unroll
            for (int rg = 0; rg < 4; ++rg) { hin[nt][rg] = 0.f; arun[nt][rg] = 1.f; }
        if (PASS == 2) {
            float hf = s >= BP ? F.in[3][(s - BP) * 512 + h * 64 + lane] : 0.f;
            const f32x2* lp = (const f32x2*)LAG + (size_t)(s * 64) * 512 + h * 64 + lane;
            int j = 0;
            for (; j + 8 <= c; j += 8) { f32x2 v[8];
#pragma unroll
                for (int q = 0; q < 8; ++q) v[q] = lp[(size_t)(j + q) * 512];
#pragma unroll
                for (int q = 0; q < 8; ++q) hf = v[q][0] * hf + v[q][1]; }
            for (; j < c; ++j) { const f32x2 v = lp[(size_t)j * 512]; hf = v[0] * hf + v[1]; }
#pragma unroll
            for (int nt = 0; nt < 4; ++nt)
#pragma unroll
                for (int rg = 0; rg < 4; ++rg) hin[nt][rg] = shfl_idx(hf, 16 * nt + 4 * g + rg);
        }
        asm volatile("s_waitcnt lgkmcnt(0)" ::: "memory");
        for (int tt = 0; tt < ntile; ++tt) {
            const int tok = 16 * tt + l15;
            const bf16x8 b0 = *(const LAS bf16x8*)(xs + tok * 144 + (8 * g) * 2), b1 = *(const LAS bf16x8*)(xs + tok * 144 + (32 + 8 * g) * 2);
            const size_t m = (size_t)base + t0 + tok;
#pragma unroll
            for (int nt = 0; nt < 4; ++nt) {
                f32x4 za = {0.f, 0.f, 0.f, 0.f}, zx = {0.f, 0.f, 0.f, 0.f};
                za = MFMA16(wfa[nt][0], b0, za); za = MFMA16(wfa[nt][1], b1, za);
                zx = MFMA16(wfx[nt][0], b0, zx); zx = MFMA16(wfx[nt][1], b1, zx);
                const int n0 = 16 * nt + 4 * g;
                const u32x2 xw = *(const LAS u32x2*)(xs + tok * 144 + n0 * 2);
                const float xc[4] = {lo16(xw[0]), hi16(xw[0]), lo16(xw[1]), hi16(xw[1])};
                const f32x4 cba = *(const LAS f32x4*)(cst + n0), cbx = *(const LAS f32x4*)(cst + 64 + n0), csp = *(const LAS f32x4*)(cst + 128 + n0);
                float av[4], bv[4];
#pragma unroll
                for (int rg = 0; rg < 4; ++rg) {
                    const float r = sigmoidf_(za[rg] + cba[rg]), ig = sigmoidf_(zx[rg] + cbx[rg]), la = -8.0f * r * csp[rg], a = __expf(la);
                    av[rg] = a; bv[rg] = sqrtf(fmaxf(1.0f - a * a, 0.f)) * (ig * xc[rg]); }
#pragma unroll
                for (int o = 1; o < 16; o <<= 1)
#pragma unroll
                    for (int rg = 0; rg < 4; ++rg) { const float ap = dpp_shr_f(1.0f, av[rg], o), bp = dpp_shr_f(0.0f, bv[rg], o); bv[rg] = av[rg] * bp + bv[rg]; av[rg] = av[rg] * ap; }
                float hv[4];
#pragma unroll
                for (int rg = 0; rg < 4; ++rg) { hv[rg] = bv[rg] + av[rg] * hin[nt][rg]; hin[nt][rg] = shfl_idx(hv[rg], (lane & 48) | 15); }
                if (PASS == 1) {
#pragma unroll
                    for (int rg = 0; rg < 4; ++rg) arun[nt][rg] *= shfl_idx(av[rg], (lane & 48) | 15);
                } else {
                    const bool tok_ok = (t0 + tok) < T;
                    if (tok_ok) {
                        const u32x2 gw2 = *(const u32x2*)(F.U0() + m * EV_IN + C_GA + h * 64 + n0);
                        u32x2 yo; yo[0] = cvt2(hv[0] * siluf_(lo16(gw2[0])), hv[1] * siluf_(hi16(gw2[0]))); yo[1] = cvt2(hv[2] * siluf_(lo16(gw2[1])), hv[3] * siluf_(hi16(gw2[1])));
                        *(u32x2*)(F.Y0() + m * D + h * 64 + n0) = yo;
                        if (t0 + tok == T - 1) { float* o = (s < BP ? F.out + O_LHP + s * 512 : F.out + O_LHS + (s - BP) * 512) + h * 64 + n0; *(f32x4*)o = (f32x4){hv[0], hv[1], hv[2], hv[3]}; }
                    }
                }
                if (nt & 1) __builtin_amdgcn_sched_barrier(0);
            }
        }
        if (PASS == 1 && s < BP && l15 == 15) {
            f32x2* lp = (f32x2*)LAG + (size_t)(s * 64 + c) * 512 + h * 64;
#pragma unroll
            for (int nt = 0; nt < 4; ++nt)
#pragma unroll
                for (int rg = 0; rg < 4; ++rg) lp[16 * nt + 4 * g + rg] = (f32x2){arun[nt][rg], hin[nt][rg]};
        }
        asm volatile("s_waitcnt lgkmcnt(0)" ::: "memory");
    }
}

constexpr size_t RB_VTP = RB_WEND, RB_VTS = RB_VTP + (size_t)BP * 2 * 64 * TP * 2, RB_VTEND = RB_VTS + (size_t)BS * 2 * 64 * 192 * 2;
static_assert(RB_VTEND <= RB_BYTES, "ws map");
__device__ __forceinline__ void phase_vt_build(Frame& F) {
    PHASE_IDS();
    const int gw = F.vcu * 8 + wave, NGW = F.G * 8;
    LAS unsigned char* xs = F.lds + wave * 9216;
    bf16_t* VTP = (bf16_t*)(F.ws + WS_RB + RB_VTP); bf16_t* VTS = (bf16_t*)(F.ws + WS_RB + RB_VTS);
    for (int task = gw; task < 1024 + 96; task += NGW) {
        int s, kv, kb; if (task < 1024) { s = task >> 7; kv = (task >> 6) & 1; kb = task & 63; } else { const int r = task - 1024; s = BP + r / 6; kv = (r % 6) / 3; kb = r % 3; }
        const int row8 = lane >> 3, ch = lane & 7;
#pragma unroll
        for (int i = 0; i < 8; ++i) {
            const int key = 8 * i + row8, kg = kb * 64 + key; u32x4 w = {0u, 0u, 0u, 0u};
            if (s < BP) w = *(const u32x4*)(F.U0() + (size_t)(s * TP + kg) * EV_IN + C_V + kv * 64 + ch * 8);
            else if (kg < 128) { const f32x4* p = (const f32x4*)(F.in[5] + ((size_t)((s - BP) * 128 + kg) * 2 + kv) * 64 + ch * 8); const f32x4 a = p[0], b = p[1]; w[0] = cvt2(a[0], a[1]); w[1] = cvt2(a[2], a[3]); w[2] = cvt2(b[0], b[1]); w[3] = cvt2(b[2], b[3]); }
            else if (kg < 128 + TS) w = *(const u32x4*)(F.U0() + (size_t)(MP + (s - BP) * TS + (kg - 128)) * EV_IN + C_V + kv * 64 + ch * 8);
            *(LAS u32x4*)(xs + key * 144 + ch * 16) = w;
        }
        asm volatile("s_waitcnt lgkmcnt(0)" ::: "memory");
        bf16_t* dst = s < BP ? VTP + ((size_t)(s * 2 + kv) * 64 + lane) * TP + kb * 64 : VTS + ((size_t)((s - BP) * 2 + kv) * 64 + lane) * 192 + kb * 64;
#pragma unroll
        for (int q = 0; q < 8; ++q) { u32x4 o;
#pragma unroll
            for (int e = 0; e < 4; ++e) { const unsigned lo = *(const LAS bf16_t*)(xs + (8 * q + 2 * e) * 144 + lane * 2), hi = *(const LAS bf16_t*)(xs + (8 * q + 2 * e + 1) * 144 + lane * 2); o[e] = lo | (hi << 16); }
            *(u32x4*)(dst + 8 * q) = o; }
        asm volatile("s_waitcnt lgkmcnt(0)" ::: "memory");
    }
}
constexpr int AT_K = 0, AT_V = 27648;
__device__ __forceinline__ void phase_attn(Frame& F) {
    PHASE_IDS();
    LAS unsigned char* L = F.lds;
    const bf16_t* VTP = (const bf16_t*)(F.ws + WS_RB + RB_VTP); const bf16_t* VTS = (const bf16_t*)(F.ws + WS_RB + RB_VTS);
    for (int task = F.vcu; task < 1024 + 32; task += F.G) {
        int s, c, kv; if (task < 1024) { s = task >> 7; c = (task >> 1) & 63; kv = task & 1; } else { s = BP + ((task - 1024) >> 1); c = 0; kv = task & 1; }
        const int base = seq_base(s), tok0 = c * 64 - 128;
        const int kmin = s < BP ? (tok0 < 0 ? -tok0 : 0) : 0, kmax = s < BP ? 192 : 128 + TS;
        __syncthreads();
#pragma unroll
        for (int i = 0; i < 3; ++i) {
            const int idx = tid + 512 * i, key = idx >> 3, ch = idx & 7; u32x4 w = {0u, 0u, 0u, 0u};
            if (key >= kmin && key < kmax) {
                if (s < BP) w = *(const u32x4*)(F.U0() + (size_t)(base + tok0 + key) * EV_IN + C_K + kv * 64 + ch * 8);
                else if (key < 128) { const f32x4* p = (const f32x4*)(F.in[4] + ((size_t)((s - BP) * 128 + key) * 2 + kv) * 64 + ch * 8); const f32x4 a = p[0], b = p[1]; w[0] = cvt2(a[0], a[1]); w[1] = cvt2(a[2], a[3]); w[2] = cvt2(b[0], b[1]); w[3] = cvt2(b[2], b[3]); }
                else w = *(const u32x4*)(F.U0() + (size_t)(base + key - 128) * EV_IN + C_K + kv * 64 + ch * 8);
            }
            *(LAS u32x4*)(L + AT_K + key * 144 + ch * 16) = w;
        }
#pragma unroll
        for (int i = 0; i < 3; ++i) {
            const int idx = tid + 512 * i, d = idx / 24, ch = idx % 24, key = ch * 8; u32x4 w = {0u, 0u, 0u, 0u};
            if (s < BP) { if (key >= kmin) w = *(const u32x4*)(VTP + ((size_t)(s * 2 + kv) * 64 + d) * TP + tok0 + key); }
            else w = *(const u32x4*)(VTS + ((size_t)((s - BP) * 2 + kv) * 64 + d) * 192 + key);
            *(LAS u32x4*)(L + AT_V + d * 400 + ch * 16) = w;
        }
        const int g = wave >> 1, qh = wave & 1, hq = kv * 4 + g, r = lane & 31, hh = lane >> 5, qi = qh * 32 + r;
        const bool qok = s < BP ? true : qi < TS;
        const size_t m = (size_t)base + c * 64 + (qok ? qi : 0);
        bf16x8 qf[4];
#pragma unroll
        for (int ks = 0; ks < 4; ++ks) { u32x4 w = {0u, 0u, 0u, 0u};
            if (qok) { const u32x4 x = *(const u32x4*)(F.U0() + m * EV_IN + C_Q + hq * 64 + 16 * ks + 8 * hh);
#pragma unroll
                for (int e = 0; e < 4; ++e) w[e] = cvt2(lo16(x[e]) * 0.125f, hi16(x[e]) * 0.125f); }
            qf[ks] = __builtin_bit_cast(bf16x8, w); }
        const float sink = F.in[22][hq];
        __syncthreads();
        float mrun = sink, lrun = 1.0f;
        f32x16 o0, o1;
#pragma unroll
        for (int e = 0; e < 16; ++e) { o0[e] = 0.f; o1[e] = 0.f; }
#pragma unroll 1
        for (int half = 0; half < 2; ++half) {
            f32x16 sc[3];
#pragma unroll
            for (int k3 = 0; k3 < 3; ++k3) {
                const int kt = 3 * half + k3;
#pragma unroll
                for (int e = 0; e < 16; ++e) sc[k3][e] = 0.f;
#pragma unroll
                for (int ks = 0; ks < 4; ++ks) { const bf16x8 kf = *(const LAS bf16x8*)(L + AT_K + (32 * kt + r) * 144 + (16 * ks + 8 * hh) * 2); sc[k3] = MFMA32(kf, qf[ks], sc[k3]); }
            }
            float mx = -1e30f;
#pragma unroll
            for (int k3 = 0; k3 < 3; ++k3)
#pragma unroll
                for (int e = 0; e < 16; ++e) { const int kidx = 32 * (3 * half + k3) + (e & 3) + 8 * (e >> 2) + 4 * hh; const bool ok = kidx >= kmin && kidx < kmax; sc[k3][e] = ok ? sc[k3][e] : -1e30f; mx = fmaxf(mx, sc[k3][e]); }
            mx = fmaxf(mx, shfl_xor_l(mx, 32, lane));
            const float mnew = fmaxf(mrun, mx), alpha = __expf(mrun - mnew);
            float psum = 0.f;
#pragma unroll
            for (int k3 = 0; k3 < 3; ++k3)
#pragma unroll
                for (int e = 0; e < 16; ++e) { const float p = __expf(sc[k3][e] - mnew); sc[k3][e] = p; psum += p; }
            psum += shfl_xor_l(psum, 32, lane);
            lrun = lrun * alpha + psum; mrun = mnew;
            o0 = o0 * alpha; o1 = o1 * alpha;
#pragma unroll
            for (int k3 = 0; k3 < 3; ++k3)
#pragma unroll
                for (int ss = 0; ss < 2; ++ss) {
                    const int kt = 3 * half + k3;
                    const bf16x8 pb = pack8(sc[k3], ss);
                    const LAS unsigned char* vp = L + AT_V + r * 400 + (32 * kt + 16 * ss + 4 * hh) * 2;
                    const u32x2 a0 = *(const LAS u32x2*)vp, a1 = *(const LAS u32x2*)(vp + 16), b0 = *(const LAS u32x2*)(vp + 32 * 400), b1 = *(const LAS u32x2*)(vp + 32 * 400 + 16);
                    const u32x4 va = {a0[0], a0[1], a1[0], a1[1]}, vb = {b0[0], b0[1], b1[0], b1[1]};
                    o0 = MFMA32(__builtin_bit_cast(bf16x8, va), pb, o0); o1 = MFMA32(__builtin_bit_cast(bf16x8, vb), pb, o1);
                }
        }
        const float il = __builtin_amdgcn_rcpf(lrun);
        if (qok) {
#pragma unroll
            for (int qq = 0; qq < 4; ++qq) {
                { const int d = 8 * qq + 4 * hh; const u32x2 gb = *(const u32x2*)(F.U0() + m * EV_IN + C_GB + hq * 64 + d);
                  u32x2 yo; yo[0] = cvt2(o0[4 * qq] * il * siluf_(lo16(gb[0])), o0[4 * qq + 1] * il * siluf_(hi16(gb[0]))); yo[1] = cvt2(o0[4 * qq + 2] * il * siluf_(lo16(gb[1])), o0[4 * qq + 3] * il * siluf_(hi16(gb[1])));
                  *(u32x2*)(F.Y0() + m * D + 512 + hq * 64 + d) = yo; }
                { const int d = 32 + 8 * qq + 4 * hh; const u32x2 gb = *(const u32x2*)(F.U0() + m * EV_IN + C_GB + hq * 64 + d);
                  u32x2 yo; yo[0] = cvt2(o1[4 * qq] * il * siluf_(lo16(gb[0])), o1[4 * qq + 1] * il * siluf_(hi16(gb[0]))); yo[1] = cvt2(o1[4 * qq + 2] * il * siluf_(lo16(gb[1])), o1[4 * qq + 3] * il * siluf_(hi16(gb[1])));
                  *(u32x2*)(F.Y0() + m * D + 512 + hq * 64 + d) = yo; }
            }
        }
    }
    __syncthreads();
}

__device__ __forceinline__ void phase_final_rowwise(Frame& F) {
    PHASE_IDS();
    const int gw = F.vcu * 8 + wave, NGW = F.G * 8;
    for (int m = gw; m < MT; m += NGW) {
        int s, t; tok_info(m, s, t);
        const float* mod1 = F.MOD() + (size_t)(24 + s) * 3072;
        f32x4 y[4]; float ss = 0.f;
#pragma unroll
        for (int j = 0; j < 4; ++j) { const u32x2 w = *(const u32x2*)(F.YO() + (size_t)m * D + 4 * lane + 256 * j); y[j] = (f32x4){lo16(w.x), hi16(w.x), lo16(w.y), hi16(w.y)};
            ss += (y[j][0] * y[j][0] + y[j][1] * y[j][1]) + (y[j][2] * y[j][2] + y[j][3] * y[j][3]); }
        const float r1 = rsqrtf(wave_sum(ss, lane) * (1.f / D) + EPS);
#pragma unroll
        for (int j = 0; j < 4; ++j) { const int c = 4 * lane + 256 * j;
            float* op = F.out + O_Y + (size_t)m * D + c;
            const f32x4 xv = *(const f32x4*)op, g = *(const f32x4*)(F.in[27] + c), gt = *(const f32x4*)(mod1 + 2048 + c);
            f32x4 o;
#pragma unroll
            for (int e = 0; e < 4; ++e) o[e] = xv[e] + gt[e] * (y[j][e] * r1 * g[e]);
            *(f32x4*)op = o; }
    }
}

__global__ void __launch_bounds__(512, 2) fwd_megakernel(Params P) {
    extern __shared__ __attribute__((aligned(16))) unsigned char lds_raw[];
    cg::grid_group grid = cg::this_grid();
    Frame F;
    F.lds = (LAS unsigned char*)lds_raw;
    F.wv = __builtin_amdgcn_readfirstlane(threadIdx.x >> 6);
    F.G = gridDim.x; { const int bx = blockIdx.x; F.vcu = (F.G % 8 == 0) ? (bx % 8) * (F.G / 8) + bx / 8 : bx; }
    F.in = P.in; F.out = P.out; F.ws = P.ws;

    volatile LAS unsigned* misc = (volatile LAS unsigned*)(F.lds + LDS_BYTES - 64);
    if (threadIdx.x < 16) misc[threadIdx.x] = 0u;
    __syncthreads();
    XcdBarrier xbar = xcd_barrier_post((unsigned*)(P.ws + WS_CTL), misc);
#define GRID_BAR() xcd_barrier(xbar, F.wv)
    phase_prologue(F);
    grid.sync();
    phase_prenorm0(F);
    GRID_BAR();
    { pg8::Gemm g{F.XN(), F.W0I(), MT, EV_IN, D}; pg8::StaticOrder S; S.init(MT, EV_IN, F.G, (int)blockIdx.x);
      pg8::EpiBf16 E{F.U0(), EV_IN, 1 << 30, F.U0(), EV_IN}; pg8::gemm_phase(F.lds, g, S, E, F.wv); }
    GRID_BAR();
    phase_rope(F);
    phase_lru<1>(F);
    phase_vt_build(F);
    GRID_BAR();
    phase_lru<2>(F);
    phase_attn(F);
    GRID_BAR();
    { pg8::Gemm g{F.Y0(), F.W0O(), MT, D, D}; pg8::StaticOrder S; S.init(MT, D, F.G, (int)blockIdx.x);
      pg8::EpiBf16 E{F.YO(), D, 1 << 30, F.YO(), D}; pg8::gemm_phase(F.lds, g, S, E, F.wv); }
    GRID_BAR();
    phase_mid_rowwise(F);
    GRID_BAR();
    { pg8::Gemm g{F.XN(), F.W1I(), MT, OD_MAIN, D}; pg8::StaticOrder S; S.init(MT, OD_MAIN, F.G, (int)blockIdx.x);
      pg8::EpiBf16 E{F.QKV1(), 3072, 3072, F.Z1(), D}; pg8::gemm_phase(F.lds, g, S, E, F.wv); }
    GRID_BAR();
    phase_gdn_fused(F);
    GRID_BAR();
    phase_gdn_g2_samples(F);
    GRID_BAR();
    { pg8::Gemm g{F.Y1(), F.W1O(), MT, D, D}; pg8::StaticOrder S; S.init(MT, D, F.G, (int)blockIdx.x);
      pg8::EpiBf16 E{F.YO(), D, 1 << 30, F.YO(), D}; pg8::gemm_phase(F.lds, g, S, E, F.wv); }
    GRID_BAR();
    phase_final_rowwise(F);
}

extern "C" void kernel_launch(void* const* d_in, const int* in_sizes, int n_in, void* d_out, int out_size, void* d_ws, size_t ws_size, hipStream_t stream) {
    static int grid = 0;
    if (grid == 0) {
        if (n_in != 34 || out_size != (int)O_END || ws_size < WS_END) { grid = -1; return; }
        int dev = 0, cus = 0, per_cu = 0;
        if (hipGetDevice(&dev) != hipSuccess || hipDeviceGetAttribute(&cus, hipDeviceAttributeMultiprocessorCount, dev) != hipSuccess) { grid = -1; return; }
        if (hipFuncSetAttribute((const void*)fwd_megakernel, hipFuncAttributeMaxDynamicSharedMemorySize, LDS_BYTES) != hipSuccess) { grid = -1; return; }
        if (hipOccupancyMaxActiveBlocksPerMultiprocessor(&per_cu, (const void*)fwd_megakernel, 512, LDS_BYTES) != hipSuccess || per_cu < 1) { grid = -1; return; }
        grid = cus;
    }
    if (grid < 0) return;
    if (hipMemsetAsync((char*)d_ws + WS_CTL, 0, 65536 + 262144, stream) != hipSuccess) return;
    Params p{};
    for (int i = 0; i < 34; ++i) p.in[i] = (const float*)d_in[i];
    p.out = (float*)d_out; p.ws = (unsigned char*)d_ws;
    void* args[] = {&p};
    (void)hipLaunchCooperativeKernel((const void*)fwd_megakernel, dim3(grid), dim3(512), args, LDS_BYTES, stream);
}
```

```cpp
#include <hip/hip_runtime.h>
#include <hip/hip_cooperative_groups.h>
namespace cg = cooperative_groups;

#define LAS __attribute__((address_space(3)))
typedef unsigned short bf16_t;
typedef short bf16x8 __attribute__((ext_vector_type(8)));
typedef float f32x4 __attribute__((ext_vector_type(4)));
typedef float f32x2 __attribute__((ext_vector_type(2)));
typedef unsigned u32x4 __attribute__((ext_vector_type(4)));
typedef unsigned u32x2 __attribute__((ext_vector_type(2)));

constexpr int D = 1024, BP = 8, TP = 4096, BS = 16, TS = 16;
constexpr int MP = BP * TP, MS = BS * TS, MT = MP + MS;
constexpr int NSEQ = BP + BS;
constexpr int EV_IN = 2304, OD_IN = 4112, OD_MAIN = 4096;
constexpr int C_XA = 0, C_GA = 512, C_Q = 1024, C_K = 1536, C_V = 1664, C_GB = 1792;
constexpr float EPS = 1e-6f;
constexpr size_t O_Y = 0, O_LCP = 33816576, O_LCS = 33828864, O_LHP = 33853440, O_LHS = 33857536, O_KP = 33865728, O_KS = 33996800,
                 O_VP = 34029568, O_VS = 34160640, O_GCP = 34193408, O_GCS = 34267136, O_GSP = 34414592, O_GSS = 35463168, O_END = 37560320;
constexpr size_t MiB = 1u << 20;
constexpr size_t WS_CTL = 0, WS_W1O = 1 * MiB, WS_MOD = 3 * MiB, WS_ROPE = 4 * MiB, WS_BA = 5 * MiB, WS_LAG = 8 * MiB, WS_LGW = 10 * MiB;
constexpr size_t WS_RA = 16 * MiB, RA_BYTES = (size_t)MT * 4096 * 2;
constexpr size_t WS_RB = WS_RA + RA_BYTES;
constexpr size_t ACT_BYTES = (size_t)MT * D * 2;
constexpr size_t RB_XN = 0, RB_Y0 = ACT_BYTES, RB_YO = 2 * ACT_BYTES, RB_W0I = 3 * ACT_BYTES, RB_W0O = RB_W0I + (size_t)EV_IN * D * 2,
                 RB_W1I = RB_W0O + (size_t)D * D * 2, RB_WEND = RB_W1I + (size_t)OD_MAIN * D * 2;
constexpr size_t RB_BYTES = (size_t)4224 * 73728;
constexpr size_t WS_END = WS_RB + RB_BYTES;
static_assert(RB_WEND <= RB_BYTES, "ws map");
static_assert((size_t)MT * 3072 * 2 <= RB_BYTES, "ws map");
constexpr int LDS_BYTES = 155648;

struct Params { const float* in[34]; float* out; unsigned char* ws; };

__device__ __forceinline__ float bf2f(bf16_t b) { return __uint_as_float(((unsigned)b) << 16); }
__device__ __forceinline__ unsigned f2bf(float f) { unsigned u = __float_as_uint(f); return (u + 0x7fffu + ((u >> 16) & 1u)) >> 16; }
__device__ __forceinline__ unsigned pk2(float lo, float hi) { return f2bf(lo) | (f2bf(hi) << 16); }
__device__ __forceinline__ float lo16(unsigned w) { return __uint_as_float(w << 16); }
__device__ __forceinline__ float hi16(unsigned w) { return __uint_as_float(w & 0xffff0000u); }
__device__ __forceinline__ float shfl_idx(float x, int src_lane) { return __int_as_float(__builtin_amdgcn_ds_bpermute(src_lane << 2, __float_as_int(x))); }
__device__ __forceinline__ float shfl_xor_l(float x, int o, int lane) { return shfl_idx(x, lane ^ o); }
__device__ __forceinline__ float wave_sum(float v, int lane) {
#pragma unroll
    for (int o = 1; o < 64; o <<= 1) v += shfl_xor_l(v, o, lane);
    return v;
}
__device__ __forceinline__ float sigmoidf_(float x) { return __builtin_amdgcn_rcpf(1.0f + __expf(-x)); }
__device__ __forceinline__ float siluf_(float x) { return x * __builtin_amdgcn_rcpf(1.0f + __expf(-x)); }
__device__ __forceinline__ float softplusf_(float x) { return x > 20.f ? x : log1pf(__expf(x)); }
__device__ __forceinline__ int seq_base(int s) { return s < BP ? s * TP : MP + (s - BP) * TS; }
__device__ __forceinline__ int seq_len(int s) { return s < BP ? TP : TS; }
__device__ __forceinline__ void tok_info(int m, int& s, int& t) { if (m < MP) { s = m >> 12; t = m & 4095; } else { const int r = m - MP; s = BP + (r >> 4); t = r & 15; } }

__device__ __forceinline__ int opaque_tid(int wv) { unsigned z = 0u; asm volatile("" : "+v"(z)); const int l = __builtin_amdgcn_mbcnt_hi(~0u, __builtin_amdgcn_mbcnt_lo(~0u, z)); return wv * 64 + l; }
namespace pg8 {
constexpr int BM = 256, BK = 64, HALF = 128, HTB = HALF * BK * 2, STAGE_BYTES = 8 * HTB, NXCD = 8, WGM = 8;
__host__ __device__ __forceinline__ int lds_byte(int r, int c) { const int st = (r >> 4) * 2 + (c >> 5), rr = r & 15, cc = c & 31, ob = rr * 64 + cc * 2; return st * 1024 + (ob ^ (((ob >> 9) & 1) << 5)); }
__host__ __device__ __forceinline__ void stage_rc(int b, int& R, int& C) { const int st = b / 1024, sb = b % 1024, swz = sb ^ (((sb >> 9) & 1) << 5); R = (st >> 1) * 16 + swz / 64; C = (st & 1) * 32 + (swz % 64) / 2; }
__host__ __device__ __forceinline__ int perm32(int rho) { const int n = rho >> 4, i = rho & 15; return 8 * (i >> 2) + 4 * n + (i & 3); }
struct Unit { int pm, pn; };
struct Gemm { const bf16_t* A; const bf16_t* Bt; int M, N, K; };
struct StaticOrder {
    int nM, nN, nwg, G, c;
    __device__ void init(int M, int N, int G_, int c_) { nM = M / BM; nN = N / BM; nwg = nM * nN; G = G_; c = c_; }
    __device__ bool next(int i, Unit& u) const {
        const long L = (long)i * G + c; if (L >= nwg) return false;
        int wgid = (int)L; { const int q = nwg / NXCD, r = nwg % NXCD, xcd = wgid % NXCD, off = wgid / NXCD; wgid = (xcd < r ? xcd * (q + 1) : r * (q + 1) + (xcd - r) * q) + off; }
        const int nig = WGM * nN, gid = wgid / nig, fm = gid * WGM, gsz = (nM - fm) < WGM ? (nM - fm) : WGM;
        u.pm = fm + ((wgid % nig) % gsz); u.pn = (wgid % nig) / gsz; return true;
    }
};
__device__ __forceinline__ unsigned cvt_pk_bf16(float lo, float hi) { unsigned r; asm volatile("v_cvt_pk_bf16_f32 %0, %1, %2" : "=v"(r) : "v"(lo), "v"(hi)); return r; }
struct EpiBf16 {
    static constexpr bool PERM = true;
    bf16_t* O0; int ld0; int split; bf16_t* O1; int ld1;
    __device__ __forceinline__ void operator()(const f32x4 (&acc)[2][2][4][2], const Unit& u, int wr, int wc, int fr, int fq) const {
        const int row0 = u.pm * BM + wr * 64 + fr; int colt = u.pn * BM; bf16_t* base = O0; int ld = ld0;
        if (colt >= split) { base = O1; ld = ld1; colt -= split; }
        const int col0 = colt + wc * 32 + 8 * fq;
#pragma unroll
        for (int ai = 0; ai < 2; ++ai)
#pragma unroll
            for (int m = 0; m < 4; ++m) { bf16_t* rowp = base + (size_t)(row0 + ai * HALF + m * 16) * ld + col0;
#pragma unroll
                for (int bj = 0; bj < 2; ++bj) { const f32x4 v0 = acc[ai][bj][m][0], v1 = acc[ai][bj][m][1];
                    u32x4 w; w.x = cvt_pk_bf16(v0[0], v0[1]); w.y = cvt_pk_bf16(v0[2], v0[3]); w.z = cvt_pk_bf16(v1[0], v1[1]); w.w = cvt_pk_bf16(v1[2], v1[3]);
                    *(u32x4*)(rowp + bj * HALF) = w; } }
    }
};
template <class Epi, class Sched>
__device__ __forceinline__ void gemm_phase(LAS unsigned char* lds, const Gemm g, const Sched& S, const Epi& E, const int wv0) {
    int tid = opaque_tid(wv0);
    const int wid = __builtin_amdgcn_readfirstlane(tid >> 6), lane = tid & 63, wr = wid >> 2, wc = wid & 3, fr = lane & 15, fq = lane >> 4;
    const int K = g.K, nt = K / BK;
    unsigned voffA[2], voffB[2];
#pragma unroll
    for (int i = 0; i < 2; ++i) { int R, C; stage_rc(tid * 16 + i * 8192, R, C); const int Rb = Epi::PERM ? ((R & ~31) + perm32(R & 31)) : R;
        voffA[i] = (unsigned)(R * K + C) * 2u; voffB[i] = (unsigned)(Rb * K + C) * 2u; }
    const size_t kstep = (size_t)(BK * 2);
    const size_t hstep = (size_t)HALF * K * 2;
    const size_t tstep = 2 * hstep;
    const unsigned ldsw = (unsigned)wid * 1024u;
    const int aoff = lds_byte(wr * 64 + fr, fq * 8), boff = lds_byte(wc * 32 + fr, fq * 8);
#define PG8_SA(b, h) (((b) * 2 + (h)) * HTB)
#define PG8_SB(b, h) ((4 + (b) * 2 + (h)) * HTB)
#define PG8_STAGE(bufoff, gbase, voff) do { _Pragma("unroll") for (int _i = 0; _i < 2; ++_i) \
        __builtin_amdgcn_global_load_lds((const unsigned*)((const char*)(gbase) + (voff)[_i]), (LAS unsigned*)(lds + (bufoff) + ldsw + _i * 8192), 16, 0, 0); } while (0)
#define PG8_LDA(dst, b, h) do { _Pragma("unroll") for (int m = 0; m < 4; ++m) _Pragma("unroll") for (int k = 0; k < 2; ++k) dst[m][k] = *(const LAS bf16x8*)(lds + PG8_SA(b, h) + aoff + m * 2048 + k * 1024); } while (0)
#define PG8_LDB(dst, b, h) do { _Pragma("unroll") for (int n = 0; n < 2; ++n) _Pragma("unroll") for (int k = 0; k < 2; ++k) dst[n][k] = *(const LAS bf16x8*)(lds + PG8_SB(b, h) + boff + n * 2048 + k * 1024); } while (0)
#define PG8_MMA(ai, bj, At, Bt) do { __builtin_amdgcn_s_setprio(1); _Pragma("unroll") for (int m = 0; m < 4; ++m) _Pragma("unroll") for (int n = 0; n < 2; ++n) _Pragma("unroll") for (int k = 0; k < 2; ++k) \
        acc[ai][bj][m][n] = __builtin_amdgcn_mfma_f32_16x16x32_bf16(Bt[n][k], At[m][k], acc[ai][bj][m][n], 0, 0, 0); __builtin_amdgcn_s_setprio(0); } while (0)
#define PG8_WAIT_V(n) asm volatile("s_waitcnt vmcnt(" #n ")" ::: "memory")
#define PG8_WAIT_L(n) asm volatile("s_waitcnt lgkmcnt(" #n ")" ::: "memory")
#define PG8_BAR __builtin_amdgcn_s_barrier()
#define PG8_SCHED __builtin_amdgcn_sched_barrier(0)
    Unit cur, nxt; int ui = 0;
    if (!S.next(0, cur)) return;
    f32x4 acc[2][2][4][2];
#pragma unroll
    for (int a = 0; a < 2; ++a)
#pragma unroll
        for (int b = 0; b < 2; ++b)
#pragma unroll
            for (int m = 0; m < 4; ++m)
#pragma unroll
                for (int n = 0; n < 2; ++n) acc[a][b][m][n] = (f32x4){0.f, 0.f, 0.f, 0.f};
    bf16x8 At[4][2], B0[2][2], B1[2][2];
    const char* cA = (const char*)g.A + (size_t)cur.pm * tstep; const char* cB = (const char*)g.Bt + (size_t)cur.pn * tstep;
    PG8_STAGE(PG8_SB(0, 0), cB, voffB); PG8_STAGE(PG8_SA(0, 0), cA, voffA); PG8_STAGE(PG8_SB(0, 1), cB + hstep, voffB); PG8_STAGE(PG8_SA(0, 1), cA + hstep, voffA);
    if (wr == 1) PG8_BAR;
    PG8_WAIT_V(4); PG8_BAR;
    PG8_STAGE(PG8_SB(1, 0), cB + kstep, voffB); PG8_STAGE(PG8_SA(1, 0), cA + kstep, voffA); PG8_STAGE(PG8_SB(1, 1), cB + hstep + kstep, voffB);
    PG8_WAIT_V(6); PG8_BAR;
    for (;;) {
        const bool has_next = S.next(ui + 1, nxt);
        const char* nA = has_next ? (const char*)g.A + (size_t)nxt.pm * tstep : cA; const char* nB = has_next ? (const char*)g.Bt + (size_t)nxt.pn * tstep : cB;
        for (int t = 0; t < nt; t += 2) {
            const bool last = (t == nt - 2);
            const char* a1 = cA + (size_t)(t + 1) * kstep;
            const char* a2 = last ? nA : cA + (size_t)(t + 2) * kstep; const char* b2 = last ? nB : cB + (size_t)(t + 2) * kstep;
            const char* a3 = a2 + kstep; const char* b3 = b2 + kstep;
            PG8_LDB(B0, 0, 0); PG8_SCHED; PG8_LDA(At, 0, 0); PG8_STAGE(PG8_SA(1, 1), a1 + hstep, voffA);
            PG8_WAIT_L(8); PG8_BAR; PG8_WAIT_L(0); PG8_MMA(0, 0, At, B0); PG8_BAR; PG8_SCHED;
            PG8_LDB(B1, 0, 1); PG8_STAGE(PG8_SB(0, 0), b2, voffB);
            PG8_BAR; PG8_WAIT_L(0); PG8_MMA(0, 1, At, B1); PG8_BAR;
            PG8_LDA(At, 0, 1); PG8_STAGE(PG8_SA(0, 0), a2, voffA);
            PG8_BAR; PG8_WAIT_L(0); PG8_MMA(1, 0, At, B0); PG8_BAR; PG8_SCHED;
            PG8_STAGE(PG8_SB(0, 1), b2 + hstep, voffB);
            PG8_WAIT_V(6); PG8_BAR; PG8_MMA(1, 1, At, B1); PG8_BAR;
            PG8_LDB(B0, 1, 0); PG8_SCHED; PG8_LDA(At, 1, 0); PG8_STAGE(PG8_SA(0, 1), a2 + hstep, voffA);
            PG8_WAIT_L(8); PG8_BAR; PG8_WAIT_L(0); PG8_MMA(0, 0, At, B0); PG8_BAR; PG8_SCHED;
            PG8_LDB(B1, 1, 1); PG8_STAGE(PG8_SB(1, 0), b3, voffB);
            PG8_BAR; PG8_WAIT_L(0); PG8_MMA(0, 1, At, B1); PG8_BAR;
            PG8_LDA(At, 1, 1); PG8_STAGE(PG8_SA(1, 0), a3, voffA);
            PG8_BAR; PG8_WAIT_L(0); PG8_MMA(1, 0, At, B0); PG8_BAR; PG8_SCHED;
            PG8_STAGE(PG8_SB(1, 1), b3 + hstep, voffB);
            PG8_WAIT_V(6); PG8_BAR; PG8_MMA(1, 1, At, B1); PG8_BAR;
        }
        E(acc, cur, wr, wc, fr, fq);
        if (!has_next) break;
#pragma unroll
        for (int a = 0; a < 2; ++a)
#pragma unroll
            for (int b = 0; b < 2; ++b)
#pragma unroll
                for (int m = 0; m < 4; ++m)
#pragma unroll
                    for (int n = 0; n < 2; ++n) acc[a][b][m][n] = (f32x4){0.f, 0.f, 0.f, 0.f};
        cur = nxt; cA = nA; cB = nB; ++ui;
    }
    PG8_WAIT_V(0);
    if (wr == 0) PG8_BAR;
    PG8_BAR;
#undef PG8_SA
#undef PG8_SB
#undef PG8_STAGE
#undef PG8_LDA
#undef PG8_LDB
#undef PG8_MMA
#undef PG8_WAIT_V
#undef PG8_WAIT_L
#undef PG8_BAR
#undef PG8_SCHED
}
}


#define XB_TMO      128
#define XB_XCNT(j)  (256  + 64 * (j))
#define XB_XSUB(j)  (1280 + 64 * (j))
#define XB_XGEN(j)  (2304 + 64 * (j))
#define XB_TOP      3328
#define XB_TOPGEN   3392
#define XCD_BAR_WORDS 3456
#define XB_SPIN_CAP (1u << 18)
__device__ __forceinline__ unsigned xb_ld(unsigned* p)              { return __hip_atomic_load(p, __ATOMIC_RELAXED, __HIP_MEMORY_SCOPE_AGENT); }
__device__ __forceinline__ unsigned xb_add(unsigned* p, unsigned v) { return __hip_atomic_fetch_add(p, v, __ATOMIC_RELAXED, __HIP_MEMORY_SCOPE_AGENT); }
__device__ __forceinline__ unsigned xb_xcc_id() { return (unsigned)__builtin_amdgcn_s_getreg((3 << 11) | 20) & 0xFu; }
#define XB_SPIN(cond, bar) do { unsigned _sp = 0; while (cond) { __builtin_amdgcn_s_sleep(1); \
    if ((++_sp & 255u) == 0u) { if (xb_ld(&(bar)[XB_TMO])) break; if (_sp > XB_SPIN_CAP) { atomicAdd(&(bar)[XB_TMO], 1u); break; } } } } while (0)
struct XcdBarrier { unsigned* bar; unsigned x; volatile LAS unsigned* st; };
__device__ __forceinline__ XcdBarrier xcd_barrier_post(unsigned* bar, volatile LAS unsigned* st) {
    XcdBarrier b; b.bar = bar; b.x = xb_xcc_id(); b.st = st;
    if (threadIdx.x == 0) (void)xb_add(&bar[XB_XCNT(b.x)], 1u);
    return b;
}
__device__ __forceinline__ void xcd_barrier_complete(unsigned* bar, unsigned x, unsigned& nloc, unsigned& nx) {
    const unsigned G = gridDim.x * gridDim.y * gridDim.z;
    unsigned sum, cnt, mine, sp = 0u;
    for (;;) {
        sum = 0u; cnt = 0u; mine = 0u;
#pragma unroll
        for (unsigned j = 0; j < 16; ++j) { const unsigned c = xb_ld(&bar[XB_XCNT(j)]); sum += c; cnt += (c > 0u) ? 1u : 0u; mine = (j == x) ? c : mine; }
        if (sum == G) break;
        __builtin_amdgcn_s_sleep(1);
        if ((++sp & 255u) == 0u) { if (xb_ld(&bar[XB_TMO])) break; if (sp > XB_SPIN_CAP) { atomicAdd(&bar[XB_TMO], 1u); break; } }
    }
    nloc = mine > 0u ? mine : 1u; nx = cnt > 0u ? cnt : 1u;
}
__device__ __forceinline__ void xcd_barrier(const XcdBarrier& b, const int wv0) {
    asm volatile("s_waitcnt vmcnt(0)" ::: "memory");
    __syncthreads();
    if (opaque_tid(wv0) == 0) {
        unsigned* bar = b.bar;
        __builtin_amdgcn_s_waitcnt(0);
        unsigned nloc = b.st[0], nx = b.st[1];
        if (nloc == 0u) { xcd_barrier_complete(bar, b.x, nloc, nx); b.st[0] = nloc; b.st[1] = nx; }
        const unsigned old = xb_add(&bar[XB_XSUB(b.x)], 1u);
        const unsigned gen = old / nloc;
        if (old + 1u == (gen + 1u) * nloc) {
            __builtin_amdgcn_fence(__ATOMIC_RELEASE, "agent");
            asm volatile("s_waitcnt vmcnt(0)" ::: "memory");
            const unsigned og = xb_add(&bar[XB_TOP], 1u);
            const unsigned tg = og / nx;
            if (og + 1u == (tg + 1u) * nx) xb_add(&bar[XB_TOPGEN], 1u);
            else XB_SPIN(xb_ld(&bar[XB_TOPGEN]) == tg, bar);
            __builtin_amdgcn_fence(__ATOMIC_ACQUIRE, "agent");
            xb_add(&bar[XB_XGEN(b.x)], 1u);
            asm volatile("s_waitcnt vmcnt(0)" ::: "memory");
        } else {
            XB_SPIN(xb_ld(&bar[XB_XGEN(b.x)]) == gen, bar);
            __builtin_amdgcn_fence(__ATOMIC_ACQUIRE, "agent");
            asm volatile("s_waitcnt vmcnt(0)" ::: "memory");
        }
    }
    __syncthreads();
}

struct Frame {
    LAS unsigned char* lds;
    int vcu, G, wv;
    const float* const* in; float* out; unsigned char* ws;
    __device__ __forceinline__ float* MOD() const { return (float*)(ws + WS_MOD); }
    __device__ __forceinline__ float* ROPE() const { return (float*)(ws + WS_ROPE); }
    __device__ __forceinline__ float* BA() const { return (float*)(ws + WS_BA); }
    __device__ __forceinline__ float* LAG() const { return (float*)(ws + WS_LAG); }
    __device__ __forceinline__ bf16_t* W1O() const { return (bf16_t*)(ws + WS_W1O); }
    __device__ __forceinline__ bf16_t* U0() const { return (bf16_t*)(ws + WS_RA); }
    __device__ __forceinline__ bf16_t* QKV1() const { return (bf16_t*)(ws + WS_RA); }
    __device__ __forceinline__ bf16_t* Z1() const { return (bf16_t*)(ws + WS_RA + (size_t)MT * 3072 * 2); }
    __device__ __forceinline__ bf16_t* Y1() const { return (bf16_t*)(ws + WS_RA + (size_t)MT * 3072 * 2); }
    __device__ __forceinline__ bf16_t* XN() const { return (bf16_t*)(ws + WS_RB + RB_XN); }
    __device__ __forceinline__ bf16_t* Y0() const { return (bf16_t*)(ws + WS_RB + RB_Y0); }
    __device__ __forceinline__ bf16_t* YO() const { return (bf16_t*)(ws + WS_RB + RB_YO); }
    __device__ __forceinline__ bf16_t* W0I() const { return (bf16_t*)(ws + WS_RB + RB_W0I); }
    __device__ __forceinline__ bf16_t* W0O() const { return (bf16_t*)(ws + WS_RB + RB_W0O); }
    __device__ __forceinline__ bf16_t* W1I() const { return (bf16_t*)(ws + WS_RB + RB_W1I); }
    __device__ __forceinline__ bf16_t* QKVC() const { return (bf16_t*)(ws + WS_RB); }
};

#define PHASE_IDS() int tid = opaque_tid(F.wv); const int lane = tid & 63, wave = __builtin_amdgcn_readfirstlane(tid >> 6); (void)lane; (void)wave
__device__ __forceinline__ void p0_transpose_item(const float* W, int ldw, int nblk, int K, bf16_t* WT, LAS float* scr, int item, int lane) {
    const int kb = item / nblk, nb = item % nblk, k0 = 64 * kb, n0 = 32 * nb;
#pragma unroll 8
    for (int i = 0; i < 32; ++i) { const int kk = 2 * i + (lane >> 5); scr[kk * 33 + (lane & 31)] = W[(size_t)(k0 + kk) * ldw + n0 + (lane & 31)]; }
    asm volatile("s_waitcnt lgkmcnt(0)" ::: "memory");
    const int c = lane & 7;
#pragma unroll
    for (int j = 0; j < 4; ++j) { const int n = (lane >> 3) + 8 * j; const LAS float* s = scr + (8 * c) * 33 + n;
        u32x4 o; o.x = pk2(s[0 * 33], s[1 * 33]); o.y = pk2(s[2 * 33], s[3 * 33]); o.z = pk2(s[4 * 33], s[5 * 33]); o.w = pk2(s[6 * 33], s[7 * 33]);
        *(u32x4*)(WT + (size_t)(n0 + n) * K + k0 + 8 * c) = o; }
    asm volatile("s_waitcnt lgkmcnt(0)" ::: "memory");
}
__device__ __forceinline__ void phase_prologue(Frame& F) {
    PHASE_IDS();
    const int gw = F.vcu * 8 + wave, NGW = F.G * 8;
    {
        LAS float* scr = (LAS float*)(F.lds + wave * 16384);
        constexpr int I0 = 16 * (EV_IN / 32), I1 = 16 * 32, I2 = 16 * (OD_MAIN / 32), I3 = 16 * 32;
        for (int it = gw; it < I0 + I1 + I2 + I3; it += NGW) {
            int r = it;
            if (r < I0) { p0_transpose_item(F.in[14], EV_IN, EV_IN / 32, D, F.W0I(), scr, r, lane); continue; } r -= I0;
            if (r < I1) { p0_transpose_item(F.in[23], D, 32, D, F.W0O(), scr, r, lane); continue; } r -= I1;
            if (r < I2) { p0_transpose_item(F.in[28], OD_IN, OD_MAIN / 32, D, F.W1I(), scr, r, lane); continue; } r -= I2;
            p0_transpose_item(F.in[33], D, 32, D, F.W1O(), scr, r, lane);
        }
    }
    {
        const double inv[8] = {1.0, 0.19392274474868576, 0.03760603093086393, 0.007292664737217109, 0.001414213562373095, 0.0002742481756762073, 5.318295896944988e-05, 1.031338537721246e-05};
        for (int idx = F.vcu * 512 + tid; idx < 4112 * 8; idx += F.G * 512) {
            const int pos = idx >> 3, i = idx & 7;
            double iv = inv[0];
#pragma unroll
            for (int q = 1; q < 8; ++q) iv = (i == q) ? inv[q] : iv;
            const double ang = (double)pos * iv;
            const double n = __builtin_rint(ang * 0.15915494309189535);
            const float r = (float)__builtin_fma(-n, 6.283185307179586, ang);
            F.ROPE()[pos * 16 + i] = __cosf(r); F.ROPE()[pos * 16 + 8 + i] = __sinf(r);
        }
    }
    {
        bf16_t* LGW = (bf16_t*)(F.ws + WS_LGW);
        for (int idx = F.vcu * 512 + tid; idx < 8 * 2 * 64 * 64; idx += F.G * 512) { const int k = idx & 63, n = (idx >> 6) & 63, gate = (idx >> 12) & 1, hh = idx >> 13;
            LGW[idx] = (bf16_t)f2bf((gate ? F.in[19] : F.in[17])[(hh * 64 + k) * 64 + n]); }
    }
    __syncthreads();
    for (int bt = F.vcu; bt < 96; bt += F.G) {
        LAS float* tab = (LAS float*)F.lds;
        for (int idx = tid; idx < 24 * 1024; idx += 512) { const int s = idx >> 10, k = idx & 1023;
            const float c = s < BP ? F.in[8][s * D + k] : F.in[9][(s - BP) * D + k]; tab[k * 24 + s] = siluf_(c); }
        __syncthreads();
        const int L = bt / 48, n0 = (bt % 48) * 64;
        const float* mw = (L == 0 ? F.in[10] : F.in[24]) + n0 + lane;
        float acc[24];
#pragma unroll
        for (int r = 0; r < 24; ++r) acc[r] = 0.f;
        for (int k = wave * 128; k < wave * 128 + 128; ++k) {
            const float w = mw[(size_t)k * 3072];
            const LAS f32x4* tp = (const LAS f32x4*)(tab + k * 24);
#pragma unroll
            for (int q = 0; q < 6; ++q) { const f32x4 t4 = tp[q]; acc[4 * q] += t4[0] * w; acc[4 * q + 1] += t4[1] * w; acc[4 * q + 2] += t4[2] * w; acc[4 * q + 3] += t4[3] * w; }
        }
        __syncthreads();
        LAS float* red = (LAS float*)F.lds;
#pragma unroll
        for (int r = 0; r < 24; ++r) red[(wave * 24 + r) * 64 + lane] = acc[r];
        __syncthreads();
        const float* mb = (L == 0 ? F.in[11] : F.in[25]);
        for (int idx = tid; idx < 24 * 64; idx += 512) { const int r = idx >> 6, l = idx & 63; float s = 0.f;
#pragma unroll
            for (int w = 0; w < 8; ++w) s += red[(w * 24 + r) * 64 + l];
            F.MOD()[((size_t)L * 24 + r) * 3072 + n0 + l] = s + mb[n0 + l]; }
        __syncthreads();
    }
}

__device__ __forceinline__ void phase_prenorm0(Frame& F) {
    PHASE_IDS();
    const int gw = F.vcu * 8 + wave, NGW = F.G * 8;
    for (int m = gw; m < MT; m += NGW) {
        int s, t; tok_info(m, s, t);
        const float* xrow = m < MP ? F.in[0] + (size_t)m * D : F.in[1] + (size_t)(m - MP) * D;
        const float* modr = F.MOD() + (size_t)s * 3072;
        f32x4 v[4]; float ss = 0.f;
#pragma unroll
        for (int j = 0; j < 4; ++j) { v[j] = *(const f32x4*)(xrow + 4 * lane + 256 * j); ss += (v[j][0] * v[j][0] + v[j][1] * v[j][1]) + (v[j][2] * v[j][2] + v[j][3] * v[j][3]); }
        const float r = rsqrtf(wave_sum(ss, lane) * (1.f / D) + EPS);
#pragma unroll
        for (int j = 0; j < 4; ++j) { const int c = 4 * lane + 256 * j;
            const f32x4 g = *(const f32x4*)(F.in[12] + c), sh = *(const f32x4*)(modr + c), sc = *(const f32x4*)(modr + 1024 + c);
            f32x4 o;
#pragma unroll
            for (int e = 0; e < 4; ++e) o[e] = v[j][e] * r * g[e] * (1.f + sc[e]) + sh[e];
            u32x2 w; w.x = pk2(o[0], o[1]); w.y = pk2(o[2], o[3]); *(u32x2*)(F.XN() + (size_t)m * D + c) = w; }
    }
}

__device__ __forceinline__ void phase_rope(Frame& F) {
    PHASE_IDS();
    const int gt = F.vcu * 512 + tid, NT = F.G * 512;
    for (int idx = gt; idx < MT * 80; idx += NT) {
        const int m = idx / 80, r = idx % 80, slot = r >> 3, i = r & 7;
        int s, t; tok_info(m, s, t);
        const int pos = s < BP ? t : TP + t;
        const int col = slot < 8 ? C_Q + slot * 64 : C_K + (slot - 8) * 64;
        bf16_t* p = F.U0() + (size_t)m * EV_IN + col;
        const float x1 = bf2f(p[i]), x2 = bf2f(p[8 + i]), c = F.ROPE()[pos * 16 + i], sn = F.ROPE()[pos * 16 + 8 + i];
        const float o1 = x1 * c - x2 * sn, o2 = x2 * c + x1 * sn;
        p[i] = (bf16_t)f2bf(o1); p[8 + i] = (bf16_t)f2bf(o2);
        if (slot >= 8) { const int kv = slot - 8;
            if (s >= BP) { float* o = F.out + O_KS + ((size_t)((s - BP) * TS + t) * 2 + kv) * 64; o[i] = o1; o[8 + i] = o2; }
            else if (t >= TP - 128) { float* o = F.out + O_KP + ((size_t)(s * 128 + (t - (TP - 128))) * 2 + kv) * 64; o[i] = o1; o[8 + i] = o2; } }
    }
    for (int idx = gt; idx < 1280 * 224; idx += NT) {
        const int tk = idx / 224, e = idx % 224;
        int s, t, m; if (tk < 1024) { s = tk >> 7; t = TP - 128 + (tk & 127); m = s * TP + t; } else { s = BP + ((tk - 1024) >> 4); t = (tk - 1024) & 15; m = MP + (tk - 1024); }
        const bool isv = e >= 96; const int e2 = isv ? e - 96 : e; const int kv = isv ? (e2 >> 6) : (e2 / 48), d = isv ? (e2 & 63) : 16 + (e2 % 48);
        const float val = bf2f(F.U0()[(size_t)m * EV_IN + (isv ? C_V : C_K) + kv * 64 + d]);
        const size_t ob = s >= BP ? (isv ? O_VS : O_KS) + ((size_t)((s - BP) * TS + t) * 2 + kv) * 64 : (isv ? O_VP : O_KP) + ((size_t)(s * 128 + (t - (TP - 128))) * 2 + kv) * 64;
        F.out[ob + d] = val;
    }
}


__device__ __forceinline__ void phase_mid_rowwise(Frame& F) {
    PHASE_IDS();
    LAS float* baw = (LAS float*)F.lds;
    for (int idx = tid; idx < 16 * 1024; idx += 512) { const int j = idx & 15, k = idx >> 4; baw[j * 1024 + k] = F.in[28][(size_t)k * OD_IN + OD_MAIN + j]; }
    __syncthreads();
    const int gw = F.vcu * 8 + wave, NGW = F.G * 8;
    for (int m = gw; m < MT; m += NGW) {
        int s, t; tok_info(m, s, t);
        const float* xrow = m < MP ? F.in[0] + (size_t)m * D : F.in[1] + (size_t)(m - MP) * D;
        const float* mod0 = F.MOD() + (size_t)s * 3072; const float* mod1 = F.MOD() + (size_t)(24 + s) * 3072;
        f32x4 y[4]; float ss = 0.f;
#pragma unroll
        for (int j = 0; j < 4; ++j) { const u32x2 w = *(const u32x2*)(F.YO() + (size_t)m * D + 4 * lane + 256 * j); y[j] = (f32x4){lo16(w.x), hi16(w.x), lo16(w.y), hi16(w.y)};
            ss += (y[j][0] * y[j][0] + y[j][1] * y[j][1]) + (y[j][2] * y[j][2] + y[j][3] * y[j][3]); }
        const float r1 = rsqrtf(wave_sum(ss, lane) * (1.f / D) + EPS);
        f32x4 x1[4]; float s2 = 0.f;
#pragma unroll
        for (int j = 0; j < 4; ++j) { const int c = 4 * lane + 256 * j;
            const f32x4 xv = *(const f32x4*)(xrow + c), g = *(const f32x4*)(F.in[13] + c), gt = *(const f32x4*)(mod0 + 2048 + c);
#pragma unroll
            for (int e = 0; e < 4; ++e) x1[j][e] = xv[e] + gt[e] * (y[j][e] * r1 * g[e]);
            *(f32x4*)(F.out + O_Y + (size_t)m * D + c) = x1[j];
            s2 += (x1[j][0] * x1[j][0] + x1[j][1] * x1[j][1]) + (x1[j][2] * x1[j][2] + x1[j][3] * x1[j][3]); }
        const float r2 = rsqrtf(wave_sum(s2, lane) * (1.f / D) + EPS);
        f32x4 hm[4];
#pragma unroll
        for (int j = 0; j < 4; ++j) { const int c = 4 * lane + 256 * j;
            const f32x4 g = *(const f32x4*)(F.in[26] + c), sh = *(const f32x4*)(mod1 + c), sc = *(const f32x4*)(mod1 + 1024 + c);
#pragma unroll
            for (int e = 0; e < 4; ++e) hm[j][e] = x1[j][e] * r2 * g[e] * (1.f + sc[e]) + sh[e];
            u32x2 w; w.x = pk2(hm[j][0], hm[j][1]); w.y = pk2(hm[j][2], hm[j][3]); *(u32x2*)(F.XN() + (size_t)m * D + c) = w; }
        float p[16];
#pragma unroll
        for (int q = 0; q < 16; ++q) { p[q] = 0.f;
#pragma unroll
            for (int j = 0; j < 4; ++j) { const f32x4 w = *(const LAS f32x4*)(baw + q * 1024 + 256 * j + 4 * lane); p[q] += (hm[j][0] * w[0] + hm[j][1] * w[1]) + (hm[j][2] * w[2] + hm[j][3] * w[3]); }
            if ((q & 3) == 3) __builtin_amdgcn_sched_barrier(0); }
        { const bool u5 = (lane & 32) != 0;
#pragma unroll
          for (int q = 0; q < 8; ++q) { const float keep = u5 ? p[8 + q] : p[q], send = u5 ? p[q] : p[8 + q]; p[q] = keep + shfl_xor_l(send, 32, lane); } }
        { const bool u4 = (lane & 16) != 0;
#pragma unroll
          for (int q = 0; q < 4; ++q) { const float keep = u4 ? p[4 + q] : p[q], send = u4 ? p[q] : p[4 + q]; p[q] = keep + shfl_xor_l(send, 16, lane); } }
        { const bool u3 = (lane & 8) != 0;
#pragma unroll
          for (int q = 0; q < 2; ++q) { const float keep = u3 ? p[2 + q] : p[q], send = u3 ? p[q] : p[2 + q]; p[q] = keep + shfl_xor_l(send, 8, lane); } }
        { const bool u2 = (lane & 4) != 0; const float keep = u2 ? p[1] : p[0], send = u2 ? p[0] : p[1]; p[0] = keep + shfl_xor_l(send, 4, lane); }
        float mine = p[0]; mine += shfl_xor_l(mine, 2, lane); mine += shfl_xor_l(mine, 1, lane);
        if ((lane & 3) == 0) { const int col = lane >> 2, hh = col & 7;
            F.BA()[(size_t)m * 16 + col] = col < 8 ? sigmoidf_(mine) : -__expf(F.in[30][hh]) * softplusf_(mine + F.in[31][hh]); }
    }
}


typedef float f32x16 __attribute__((ext_vector_type(16)));
typedef __bf16 bf16x2_t __attribute__((ext_vector_type(2)));
constexpr int GS_WF = 0, GS_QF = 16384, GS_KF = 32768, GS_PF = 49152, GS_UF = 57344, GS_BYTES = 73728;
constexpr size_t WS_DEC = 11 * MiB;
__device__ __forceinline__ unsigned cvt2(float a, float b) { f32x2 v = {a, b}; bf16x2_t r = __builtin_convertvector(v, bf16x2_t); return __builtin_bit_cast(unsigned, r); }
__device__ __forceinline__ int krow(int s, int h, int j) { return 16 * s + 8 * (j >> 2) + 4 * h + (j & 3); }
#define MFMA32(a, b, c) __builtin_amdgcn_mfma_f32_32x32x16_bf16((a), (b), (c), 0, 0, 0)
#define MFMA16(a, b, c) __builtin_amdgcn_mfma_f32_16x16x32_bf16((a), (b), (c), 0, 0, 0)

typedef __amdgpu_buffer_rsrc_t brsrc_t;
__device__ __forceinline__ brsrc_t staging_rsrc(unsigned char* ws) { return __builtin_amdgcn_make_buffer_rsrc((void*)(ws + WS_RB), (short)0, (int)RB_BYTES, 0x00020000); }
__device__ __forceinline__ void st16_wt(brsrc_t r, unsigned off, u32x4 v) { __builtin_amdgcn_raw_buffer_store_b128(v, r, off, 0, 16); }
__device__ __forceinline__ u32x4 ld16_wt(brsrc_t r, unsigned off) { return __builtin_amdgcn_raw_buffer_load_b128(r, off, 0, 16); }
__device__ __forceinline__ void st8_wt(unsigned char* p, u32x2 v) { __hip_atomic_store((unsigned long long*)p, ((unsigned long long)v[1] << 32) | v[0], __ATOMIC_RELAXED, __HIP_MEMORY_SCOPE_AGENT); }
constexpr size_t WS_READY = 65536;
#define LDS_BARRIER() do { asm volatile("s_waitcnt lgkmcnt(0)" ::: "memory"); __builtin_amdgcn_s_barrier(); asm volatile("" ::: "memory"); } while (0)
constexpr int G1_QS = 0, G1_KS = 17408, G1_VS = 34816, G1_AS = 52224, G1_PS = 69632, G1_WS = 78848, G1_CW = 96256, G1_VEC = 102400, G1_ES = 103424;
__device__ __forceinline__ void g1_load_raw(Frame& F, u32x4 (&raw)[24], int s, int c, int h, int t1) {
    const int r = t1 >> 3, j = t1 & 7, t = c * 64 + r;
#pragma unroll
    for (int p = 0; p < 3; ++p)
#pragma unroll
        for (int jj = 0; jj < 4; ++jj) { const int tt = t - 3 + jj, ttc = tt < 0 ? 0 : tt;
            const u32x4* src = (const u32x4*)(F.QKV1() + (size_t)(s * TP + ttc) * 3072 + p * 1024 + h * 128 + j * 16); raw[p * 8 + jj * 2] = src[0]; raw[p * 8 + jj * 2 + 1] = src[1]; }
}
__device__ __forceinline__ bf16x8 g1_pack_b(const f32x4 p, const f32x4 q) { u32x4 w; w[0] = cvt2(p[0], p[1]); w[1] = cvt2(p[2], p[3]); w[2] = cvt2(q[0], q[1]); w[3] = cvt2(q[2], q[3]); return __builtin_bit_cast(bf16x8, w); }
__device__ __forceinline__ void g1_decode(int n, int& s, int& c, int& h) { if (n < 4096) { c = n >> 6; s = (n & 63) >> 3; h = n & 7; } else { s = BP + ((n - 4096) >> 3); c = 0; h = n & 7; } }
__device__ __forceinline__ void gdn_g1_tasks(Frame& F, const int first, const int stride) {
    int tid = opaque_tid(F.wv);
    const int lane = tid & 63, wave = __builtin_amdgcn_readfirstlane(tid >> 6);
    LAS unsigned char* L = F.lds;
    LAS float* cw_s = (LAS float*)(L + G1_CW);
    LAS float* beta_s = (LAS float*)(L + G1_VEC); LAS float* gcum_s = beta_s + 64; LAS float* eg_s = beta_s + 128; LAS float* ek_s = beta_s + 192;
    float* DEC = (float*)(F.ws + WS_DEC);
    u32x4 raw[24];
    float pcw[3], pb = 0.f, pa = 0.f;
    const brsrc_t srs = staging_rsrc(F.ws);
    unsigned* ready = (unsigned*)(F.ws + WS_READY);
    { int s0, c0, h0; g1_decode(first < 4095 ? first : 4095, s0, c0, h0); g1_load_raw(F, raw, s0, c0, h0, tid);
#pragma unroll
        for (int q = 0; q < 3; ++q) { const int i = tid + 512 * q, jj = i / 384, cc = i % 384; pcw[q] = F.in[29][(size_t)jj * 3072 + (cc >> 7) * 1024 + h0 * 128 + (cc & 127)]; }
        const float* ba = F.BA() + (size_t)(s0 * TP + c0 * 64 + (tid & 63)) * 16; pb = ba[h0]; pa = ba[8 + h0]; }
    for (int task = first; task < 4224; task += stride) {
        const int tid = opaque_tid(F.wv), lane = tid & 63;
        int s, c, h; g1_decode(task, s, c, h);
        const int nvalid = s < BP ? 64 : TS, t0 = c * 64, base = seq_base(s), T = seq_len(s);
        const int sidx = task < 4096 ? ((s * 8 + h) * 64 + c) : task;
        unsigned char* blk = F.ws + WS_RB + (size_t)sidx * GS_BYTES; const unsigned boff = (unsigned)sidx * (unsigned)GS_BYTES;
        if (s < BP) {
#pragma unroll
            for (int q = 0; q < 3; ++q) cw_s[tid + 512 * q] = pcw[q];
        } else for (int i = tid; i < 4 * 384; i += 512) { const int jj = i / 384, cc = i % 384; cw_s[i] = F.in[29][(size_t)jj * 3072 + (cc >> 7) * 1024 + h * 128 + (cc & 127)]; }
        if (tid < 64) {
            const bool ok = tid < nvalid; float beta = 0.f, g = 0.f;
            if (ok) { float vb = pb, va = pa; if (s >= BP) { const float* ba = F.BA() + (size_t)(base + t0 + tid) * 16; vb = ba[h]; va = ba[8 + h]; }
                beta = vb; g = va; }
            float x = g;
#pragma unroll
            for (int o = 1; o < 64; o <<= 1) { const float y = shfl_idx(x, lane >= o ? lane - o : lane); if (lane >= o) x += y; }
            const float gl = shfl_idx(x, 63);
            beta_s[tid] = beta; gcum_s[tid] = x; eg_s[tid] = __expf(x); ek_s[tid] = ok ? __expf(gl - x) : 0.f;
            if (tid == 0) __hip_atomic_store((unsigned*)DEC + sidx, __float_as_uint(__expf(gl)), __ATOMIC_RELAXED, __HIP_MEMORY_SCOPE_AGENT);
        }
        LDS_BARRIER();
        {
            int t1 = tid; asm volatile("" : "+v"(t1));
            const int r = t1 >> 3, j = t1 & 7, t = t0 + r; const bool ok = r < nvalid;
#pragma unroll
            for (int p = 0; p < 3; ++p) {
                float acc[16], cur[16];
#pragma unroll
                for (int e = 0; e < 16; ++e) { acc[e] = 0.f; cur[e] = 0.f; }
                const int cb = p * 1024 + h * 128 + j * 16;
#pragma unroll
                for (int jj = 0; jj < 4; ++jj) {
                    const int tt = t - 3 + jj; float x[16];
                    if (s < BP) { const u32x4 a = raw[p * 8 + jj * 2], b = raw[p * 8 + jj * 2 + 1]; const bool v = tt >= 0;
#pragma unroll
                        for (int e = 0; e < 4; ++e) { x[2 * e] = v ? lo16(a[e]) : 0.f; x[2 * e + 1] = v ? hi16(a[e]) : 0.f; x[8 + 2 * e] = v ? lo16(b[e]) : 0.f; x[8 + 2 * e + 1] = v ? hi16(b[e]) : 0.f; } }
                    else if (ok && tt >= 0) { const u32x4* src = (const u32x4*)(F.QKV1() + (size_t)(base + tt) * 3072 + cb); const u32x4 a = src[0], b = src[1];
#pragma unroll
                        for (int e = 0; e < 4; ++e) { x[2 * e] = lo16(a[e]); x[2 * e + 1] = hi16(a[e]); x[8 + 2 * e] = lo16(b[e]); x[8 + 2 * e + 1] = hi16(b[e]); } }
                    else if (ok) { const f32x4* src = (const f32x4*)(F.in[6] + ((size_t)(s - BP) * 3 + (tt + 3)) * 3072 + cb);
#pragma unroll
                        for (int q = 0; q < 4; ++q) { const f32x4 a = src[q]; x[4 * q] = a[0]; x[4 * q + 1] = a[1]; x[4 * q + 2] = a[2]; x[4 * q + 3] = a[3]; } }
                    else {
#pragma unroll
                        for (int e = 0; e < 16; ++e) x[e] = 0.f; }
                    const LAS f32x4* wp = (const LAS f32x4*)(cw_s + jj * 384 + p * 128 + j * 16);
#pragma unroll
                    for (int q = 0; q < 4; ++q) { const f32x4 w4 = wp[q]; acc[4 * q] += w4[0] * x[4 * q]; acc[4 * q + 1] += w4[1] * x[4 * q + 1]; acc[4 * q + 2] += w4[2] * x[4 * q + 2]; acc[4 * q + 3] += w4[3] * x[4 * q + 3]; }
                    if (jj == 3) {
#pragma unroll
                        for (int e = 0; e < 16; ++e) cur[e] = x[e]; }
                }
                if (ok && t >= T - 3) {
                    float* o = (s < BP ? F.out + O_GCP + ((size_t)s * 3 + (t - (T - 3))) * 3072 : F.out + O_GCS + ((size_t)(s - BP) * 3 + (t - (T - 3))) * 3072) + cb;
#pragma unroll
                    for (int q = 0; q < 4; ++q) *(f32x4*)(o + 4 * q) = (f32x4){cur[4 * q], cur[4 * q + 1], cur[4 * q + 2], cur[4 * q + 3]};
                }
                float ss = 0.f;
#pragma unroll
                for (int e = 0; e < 16; ++e) { acc[e] = siluf_(acc[e]); ss += acc[e] * acc[e]; }
                if (p < 2) { ss += shfl_xor_l(ss, 1, lane); ss += shfl_xor_l(ss, 2, lane); ss += shfl_xor_l(ss, 4, lane);
                    float sc = rsqrtf(ss + EPS); if (p == 0) sc *= 0.08838834764831845f;
#pragma unroll
                    for (int e = 0; e < 16; ++e) acc[e] *= sc; }
                u32x4 w0, w1;
#pragma unroll
                for (int e = 0; e < 4; ++e) { w0[e] = ok ? cvt2(acc[2 * e], acc[2 * e + 1]) : 0u; w1[e] = ok ? cvt2(acc[8 + 2 * e], acc[8 + 2 * e + 1]) : 0u; }
                LAS u32x4* dst = (LAS u32x4*)(L + (p == 0 ? G1_QS : p == 1 ? G1_KS : G1_VS) + r * 272 + j * 32);
                dst[0] = w0; dst[1] = w1;
                __builtin_amdgcn_sched_barrier(0);
            }
            { const int ntk = task + stride < 4095 ? task + stride : 4095; int s1, c1, h1; g1_decode(ntk, s1, c1, h1); g1_load_raw(F, raw, s1, c1, h1, t1);
#pragma unroll
              for (int q = 0; q < 3; ++q) { const int i = t1 + 512 * q, jj = i / 384, cc = i % 384; pcw[q] = F.in[29][(size_t)jj * 3072 + (cc >> 7) * 1024 + h1 * 128 + (cc & 127)]; }
              const float* ba = F.BA() + (size_t)(s1 * TP + c1 * 64 + (t1 & 63)) * 16; pb = ba[h1]; pa = ba[8 + h1]; }
        }
        LDS_BARRIER();
        {
            int l2 = lane; asm volatile("" : "+v"(l2));
            const int which = wave >> 2, ti = (wave >> 1) & 1, tj = wave & 1, r = l2 & 31, hh = l2 >> 5;
            f32x16 acc;
#pragma unroll
            for (int e = 0; e < 16; ++e) acc[e] = 0.f;
            if (!(ti == 0 && tj == 1)) {
                const LAS unsigned char* ap = L + (which ? G1_QS : G1_KS) + (32 * ti + r) * 272 + hh * 16;
                const LAS unsigned char* bp = L + G1_KS + (32 * tj + r) * 272 + hh * 16;
#pragma unroll
                for (int ks = 0; ks < 8; ++ks) { const bf16x8 a = *(const LAS bf16x8*)(ap + ks * 32), b = *(const LAS bf16x8*)(bp + ks * 32); acc = MFMA32(a, b, acc); }
            }
            const int jc = 32 * tj + r; const float gj = gcum_s[jc];
#pragma unroll
            for (int e = 0; e < 16; ++e) {
                const int i = 32 * ti + (e & 3) + 8 * (e >> 2) + 4 * hh; const float dg = gcum_s[i] - gj;
                if (which == 0) { const float f = (i > jc) ? __expf(dg) * beta_s[i] : 0.f; *(LAS float*)(L + G1_AS + i * 272 + jc * 4) = acc[e] * f; }
                else { const float f = (i >= jc) ? __expf(dg) : 0.f; *(LAS bf16_t*)(L + G1_PS + i * 144 + jc * 2) = (bf16_t)(cvt2(acc[e] * f, 0.f) & 0xffffu); }
            }
        }
        LDS_BARRIER();
        if (wave == 0) {
            int l3 = lane; asm volatile("" : "+v"(l3));
            const int bk = l3 >> 4, col = l3 & 15;
            float tcol[16];
#pragma unroll
            for (int rr = 0; rr < 16; ++rr) {
                float a = (rr == col) ? 1.0f : 0.f;
#pragma unroll
                for (int j4 = 0; j4 < (rr + 3) / 4; ++j4) { const f32x4 a4 = *(const LAS f32x4*)(L + G1_AS + (16 * bk + rr) * 272 + (16 * bk + 4 * j4) * 4);
#pragma unroll
                    for (int q = 0; q < 4; ++q) if (4 * j4 + q < rr) a -= a4[q] * tcol[4 * j4 + q]; }
                tcol[rr] = a;
                *(LAS float*)(L + G1_ES + ((bk * 16 + rr) * 16 + col) * 4) = a - ((rr == col) ? 1.0f : 0.f);
            }
        } else if (wave >= 4) {
            int l3 = lane; asm volatile("" : "+v"(l3));
            const int wv = wave - 4, r = l3 & 31, hh = l3 >> 5;
            {   const int rt4 = wv;
#pragma unroll
                for (int kt2 = 0; kt2 < 2; ++kt2)
#pragma unroll
                    for (int ss = 0; ss < 2; ++ss) { float v[8];
#pragma unroll
                        for (int j = 0; j < 8; ++j) { const int tok = 32 * kt2 + krow(ss, hh, j); v[j] = bf2f(*(const LAS bf16_t*)(L + G1_KS + tok * 272 + (32 * rt4 + r) * 2)) * ek_s[tok]; }
                        u32x4 o; o[0] = cvt2(v[0], v[1]); o[1] = cvt2(v[2], v[3]); o[2] = cvt2(v[4], v[5]); o[3] = cvt2(v[6], v[7]);
                        st16_wt(srs, boff + GS_KF + ((rt4 * 2 + kt2) * 2 + ss) * 1024 + l3 * 16, o); } }
            {   const int kt = wv;
#pragma unroll
                for (int rt = 0; rt < 2; ++rt)
#pragma unroll
                    for (int ss = 0; ss < 2; ++ss) { const int i = 32 * rt + r; const float sc = eg_s[i];
                        const u32x2 lo = *(const LAS u32x2*)(L + G1_QS + i * 272 + (32 * kt + 16 * ss + 4 * hh) * 2), hi = *(const LAS u32x2*)(L + G1_QS + i * 272 + (32 * kt + 16 * ss + 8 + 4 * hh) * 2);
                        u32x4 o; o[0] = cvt2(lo16(lo[0]) * sc, hi16(lo[0]) * sc); o[1] = cvt2(lo16(lo[1]) * sc, hi16(lo[1]) * sc); o[2] = cvt2(lo16(hi[0]) * sc, hi16(hi[0]) * sc); o[3] = cvt2(lo16(hi[1]) * sc, hi16(hi[1]) * sc);
                        st16_wt(srs, boff + GS_QF + ((rt * 4 + kt) * 2 + ss) * 1024 + l3 * 16, o); } }
            {   const int rt = wv >> 1, kt2 = wv & 1;
#pragma unroll
                for (int ss = 0; ss < 2; ++ss) { const int i = 32 * rt + r;
                    const u32x2 lo = *(const LAS u32x2*)(L + G1_PS + i * 144 + (32 * kt2 + 16 * ss + 4 * hh) * 2), hi = *(const LAS u32x2*)(L + G1_PS + i * 144 + (32 * kt2 + 16 * ss + 8 + 4 * hh) * 2);
                    u32x4 o; o[0] = lo[0]; o[1] = lo[1]; o[2] = hi[0]; o[3] = hi[1];
                    st16_wt(srs, boff + GS_PF + ((rt * 2 + kt2) * 2 + ss) * 1024 + l3 * 16, o); } }
        }
        LDS_BARRIER();
        {
            int l4 = lane; asm volatile("" : "+v"(l4));
            const int c16 = l4 & 15, g = l4 >> 4;
            const f32x4 z4 = {0.f, 0.f, 0.f, 0.f};
            f32x4 a10, a20, a21, a30, a31, a32, e0, e1, e2, e3;
            { const LAS unsigned char* ar = L + G1_AS + c16 * 272 + (4 * g) * 4;
              a10 = *(const LAS f32x4*)(ar + 16 * 272); a20 = *(const LAS f32x4*)(ar + 32 * 272); a21 = *(const LAS f32x4*)(ar + 32 * 272 + 64);
              a30 = *(const LAS f32x4*)(ar + 48 * 272); a31 = *(const LAS f32x4*)(ar + 48 * 272 + 64); a32 = *(const LAS f32x4*)(ar + 48 * 272 + 128);
              const LAS unsigned char* er = L + G1_ES + (c16 * 16 + 4 * g) * 4;
              e0 = *(const LAS f32x4*)er; e1 = *(const LAS f32x4*)(er + 1024); e2 = *(const LAS f32x4*)(er + 2048); e3 = *(const LAS f32x4*)(er + 3072); }
            const bf16x8 fA10 = g1_pack_b(z4 - a10, z4), fA2 = g1_pack_b(z4 - a20, z4 - a21), fA3a = g1_pack_b(z4 - a30, z4 - a31), fA3b = g1_pack_b(z4 - a32, z4);
            const bf16x8 fE0 = g1_pack_b(e0, z4), fE1 = g1_pack_b(e1, z4), fE2 = g1_pack_b(e2, z4), fE3 = g1_pack_b(e3, z4);
            const bool isw = wave < 4; const int cbase = 32 * (wave & 3);
#pragma unroll
            for (int tl = 0; tl < 2; ++tl) {
                const int d = cbase + 16 * tl + c16;
                f32x4 R[4];
#pragma unroll
                for (int i = 0; i < 4; ++i)
#pragma unroll
                    for (int e = 0; e < 4; ++e) { const int row = 16 * i + 4 * g + e; const float raw1 = bf2f(*(const LAS bf16_t*)(L + (isw ? G1_KS : G1_VS) + row * 272 + d * 2)); R[i][e] = raw1 * beta_s[row] * (isw ? eg_s[row] : 1.0f); }
                const f32x4 X0 = MFMA16(fE0, g1_pack_b(R[0], z4), R[0]);
                const f32x4 Y1 = MFMA16(fA10, g1_pack_b(X0, z4), R[1]);
                const f32x4 X1 = MFMA16(fE1, g1_pack_b(Y1, z4), Y1);
                const f32x4 Y2 = MFMA16(fA2, g1_pack_b(X0, X1), R[2]);
                const f32x4 X2 = MFMA16(fE2, g1_pack_b(Y2, z4), Y2);
                f32x4 Y3 = MFMA16(fA3a, g1_pack_b(X0, X1), R[3]);
                Y3 = MFMA16(fA3b, g1_pack_b(X2, z4), Y3);
                const f32x4 X3 = MFMA16(fE3, g1_pack_b(Y3, z4), Y3);
                const f32x4 X[4] = {X0, X1, X2, X3};
                if (isw) {
#pragma unroll
                    for (int i = 0; i < 4; ++i)
#pragma unroll
                        for (int e = 0; e < 4; ++e) *(LAS bf16_t*)(L + G1_WS + (16 * i + 4 * g + e) * 272 + d * 2) = (bf16_t)(cvt2(-X[i][e], 0.f) & 0xffffu);
                } else {
                    const int ws = wave & 3, cc = 16 * tl + c16;
#pragma unroll
                    for (int i = 0; i < 4; ++i) { const int rt = i >> 1, q = 2 * (i & 1) + (g >> 1), hh = g & 1;
                        u32x2 o; o[0] = cvt2(X[i][0], X[i][1]); o[1] = cvt2(X[i][2], X[i][3]);
                        st8_wt(blk + GS_UF + (size_t)(((ws * 2 + rt) * 64) + cc + 32 * hh) * 32 + q * 8, o); }
                }
            }
        }
        LDS_BARRIER();
        {
            int l5 = lane; asm volatile("" : "+v"(l5));
            const int kt = wave & 3, rt = wave >> 2, r = l5 & 31, hh = l5 >> 5, i = 32 * rt + r;
#pragma unroll
            for (int ss = 0; ss < 2; ++ss) {
                const u32x2 lo = *(const LAS u32x2*)(L + G1_WS + i * 272 + (32 * kt + 16 * ss + 4 * hh) * 2), hi = *(const LAS u32x2*)(L + G1_WS + i * 272 + (32 * kt + 16 * ss + 8 + 4 * hh) * 2);
                u32x4 o; o[0] = lo[0]; o[1] = lo[1]; o[2] = hi[0]; o[3] = hi[1];
                st16_wt(srs, boff + GS_WF + ((rt * 4 + kt) * 2 + ss) * 1024 + l5 * 16, o); }
        }
        asm volatile("s_waitcnt vmcnt(0)" ::: "memory");
        LDS_BARRIER();
        if (tid == 0 && task < 4096) __hip_atomic_store(ready + 16 * sidx, 1u, __ATOMIC_RELAXED, __HIP_MEMORY_SCOPE_AGENT);
    }
}

constexpr int G2_FB = GS_BYTES, G2_OSTRIDE = 528, G2_HN = 2 * G2_FB, G2_DEC = G2_HN + 512;
__device__ __forceinline__ bf16x8 pack8(const f32x16& x, const int s) {
    u32x4 p; p[0] = cvt2(x[8 * s], x[8 * s + 1]); p[1] = cvt2(x[8 * s + 2], x[8 * s + 3]); p[2] = cvt2(x[8 * s + 4], x[8 * s + 5]); p[3] = cvt2(x[8 * s + 6], x[8 * s + 7]);
    return __builtin_bit_cast(bf16x8, p);
}
template <bool WT>
__device__ __forceinline__ void g2_load_set(u32x4 (&pre)[18], float& dpre, const unsigned char* blk, int lt, brsrc_t srs, unsigned boff, const unsigned* flag, const float* decp) {
    if (WT) { unsigned sp = 0; while (__builtin_amdgcn_readfirstlane(__hip_atomic_load(flag, __ATOMIC_RELAXED, __HIP_MEMORY_SCOPE_AGENT)) == 0u && ++sp < (1u << 20)) __builtin_amdgcn_s_sleep(4);
        dpre = __uint_as_float(__hip_atomic_load((const unsigned*)decp, __ATOMIC_RELAXED, __HIP_MEMORY_SCOPE_AGENT));
#pragma unroll
        for (int i = 0; i < 18; ++i) pre[i] = ld16_wt(srs, boff + (unsigned)(i * 256 + lt) * 16u);
    } else { const u32x4* src = (const u32x4*)blk; dpre = *decp;
#pragma unroll
        for (int i = 0; i < 18; ++i) pre[i] = src[i * 256 + lt]; }
}
__device__ __forceinline__ void g2_store_set(const u32x4 (&pre)[18], LAS unsigned char* dst, int lt) {
#pragma unroll
    for (int i = 0; i < 18; ++i) *(LAS u32x4*)(dst + (size_t)(i * 256 + lt) * 16) = pre[i];
}
#define G2_FRAG(off) (*(const LAS bf16x8*)(B + (off)))
#define G2_SCHED() __builtin_amdgcn_sched_barrier(0)
__device__ __forceinline__ void g2_mfma_step(f32x16& S0, f32x16& S1, f32x16& S2, f32x16& S3, LAS unsigned char* Bimg, const float dec, int ws, int lane, int cc, int hh) {
    const LAS unsigned char* B = Bimg + lane * 16;
    f32x16 vn0, vn1, o0, o1;
    { const LAS u32x4* up = (const LAS u32x4*)(Bimg + GS_UF + (size_t)(ws * 2 * 64 + lane) * 32); const u32x4 u0 = up[0], u1 = up[1], u2 = up[128], u3 = up[129];
#pragma unroll
      for (int q = 0; q < 4; ++q) { vn0[2 * q] = lo16(u0[q]); vn0[2 * q + 1] = hi16(u0[q]); vn0[8 + 2 * q] = lo16(u1[q]); vn0[8 + 2 * q + 1] = hi16(u1[q]);
                                    vn1[2 * q] = lo16(u2[q]); vn1[2 * q + 1] = hi16(u2[q]); vn1[8 + 2 * q] = lo16(u3[q]); vn1[8 + 2 * q + 1] = hi16(u3[q]); } }
#pragma unroll
    for (int e = 0; e < 16; ++e) { o0[e] = 0.f; o1[e] = 0.f; }
#define G2_WQ(Sx, kt) do { _Pragma("unroll") for (int ss = 0; ss < 2; ++ss) { const bf16x8 sb = pack8(Sx, ss); \
        const bf16x8 fw0 = G2_FRAG(GS_WF + ((0 * 4 + kt) * 2 + ss) * 1024), fw1 = G2_FRAG(GS_WF + ((1 * 4 + kt) * 2 + ss) * 1024); \
        const bf16x8 fq0 = G2_FRAG(GS_QF + ((0 * 4 + kt) * 2 + ss) * 1024), fq1 = G2_FRAG(GS_QF + ((1 * 4 + kt) * 2 + ss) * 1024); \
        vn0 = MFMA32(fw0, sb, vn0); vn1 = MFMA32(fw1, sb, vn1); o0 = MFMA32(fq0, sb, o0); o1 = MFMA32(fq1, sb, o1); } } while (0)
    G2_WQ(S0, 0); G2_WQ(S1, 1); G2_WQ(S2, 2); G2_WQ(S3, 3);
#undef G2_WQ
    bf16x8 vb[2][2];
    vb[0][0] = pack8(vn0, 0); vb[0][1] = pack8(vn0, 1); vb[1][0] = pack8(vn1, 0); vb[1][1] = pack8(vn1, 1);
#pragma unroll
    for (int kt2 = 0; kt2 < 2; ++kt2)
#pragma unroll
        for (int ss = 0; ss < 2; ++ss) { o0 = MFMA32(G2_FRAG(GS_PF + ((0 * 2 + kt2) * 2 + ss) * 1024), vb[kt2][ss], o0); o1 = MFMA32(G2_FRAG(GS_PF + ((1 * 2 + kt2) * 2 + ss) * 1024), vb[kt2][ss], o1); }
    S0 = S0 * dec; S1 = S1 * dec; S2 = S2 * dec; S3 = S3 * dec;
#pragma unroll
    for (int kt2 = 0; kt2 < 2; ++kt2)
#pragma unroll
        for (int ss = 0; ss < 2; ++ss) {
            S0 = MFMA32(G2_FRAG(GS_KF + ((0 * 2 + kt2) * 2 + ss) * 1024), vb[kt2][ss], S0); S1 = MFMA32(G2_FRAG(GS_KF + ((1 * 2 + kt2) * 2 + ss) * 1024), vb[kt2][ss], S1);
            S2 = MFMA32(G2_FRAG(GS_KF + ((2 * 2 + kt2) * 2 + ss) * 1024), vb[kt2][ss], S2); S3 = MFMA32(G2_FRAG(GS_KF + ((3 * 2 + kt2) * 2 + ss) * 1024), vb[kt2][ss], S3); }
    LDS_BARRIER();
#pragma unroll
    for (int e = 0; e < 16; ++e) { const int rr = (e & 3) + 8 * (e >> 2) + 4 * hh;
        *(LAS float*)(Bimg + rr * G2_OSTRIDE + (32 * ws + cc) * 4) = o0[e]; *(LAS float*)(Bimg + (32 + rr) * G2_OSTRIDE + (32 * ws + cc) * 4) = o1[e]; }
    LDS_BARRIER();
}
__device__ __forceinline__ void g2_epi_step(Frame& F, LAS unsigned char* L, const LAS unsigned char* Oimg, const u32x4 (&zz)[4], int row, int seg, size_t m, int h, bool rok, int lane) {
    float ss = 0.f;
#pragma unroll
    for (int q = 0; q < 8; ++q) { const f32x4 ov = *(const LAS f32x4*)(Oimg + row * G2_OSTRIDE + (seg * 32 + 4 * q) * 4); ss += (ov[0] * ov[0] + ov[1] * ov[1]) + (ov[2] * ov[2] + ov[3] * ov[3]); }
    ss += shfl_xor_l(ss, 1, lane); ss += shfl_xor_l(ss, 2, lane);
    const float rn = rsqrtf(ss * (1.f / 128.f) + EPS);
    if (rok) {
        u32x4* yp = (u32x4*)(F.Y1() + m * D + h * 128 + seg * 32);
        const LAS float* hn_s = (const LAS float*)(L + G2_HN);
#pragma unroll
        for (int q = 0; q < 4; ++q) {
            const f32x4 oa = *(const LAS f32x4*)(Oimg + row * G2_OSTRIDE + (seg * 32 + 8 * q) * 4), ob = *(const LAS f32x4*)(Oimg + row * G2_OSTRIDE + (seg * 32 + 8 * q + 4) * 4);
            const f32x4 ha = *(const LAS f32x4*)(hn_s + seg * 32 + 8 * q), hb = *(const LAS f32x4*)(hn_s + seg * 32 + 8 * q + 4);
            u32x4 yo;
            yo[0] = cvt2(oa[0] * rn * ha[0] * siluf_(lo16(zz[q][0])), oa[1] * rn * ha[1] * siluf_(hi16(zz[q][0])));
            yo[1] = cvt2(oa[2] * rn * ha[2] * siluf_(lo16(zz[q][1])), oa[3] * rn * ha[3] * siluf_(hi16(zz[q][1])));
            yo[2] = cvt2(ob[0] * rn * hb[0] * siluf_(lo16(zz[q][2])), ob[1] * rn * hb[1] * siluf_(hi16(zz[q][2])));
            yo[3] = cvt2(ob[2] * rn * hb[2] * siluf_(lo16(zz[q][3])), ob[3] * rn * hb[3] * siluf_(hi16(zz[q][3])));
            yp[q] = yo; }
    }
}
template <int NCH>
__device__ __forceinline__ void g2_task(Frame& F, LAS unsigned char* L, const float* DEC, int s, int h, int ch0, int tid, int lane, int wave) {
    const size_t cstep = (size_t)GS_BYTES;
    const int base = seq_base(s), nvalid = s < BP ? 64 : TS;
    const unsigned char* blk0 = F.ws + WS_RB + (size_t)ch0 * GS_BYTES;
    constexpr int lastc = NCH - 1;
    if (wave < 4) {
        const int ws = wave, cc = lane & 31, hh = lane >> 5;
        f32x16 S0, S1, S2, S3;
        if (s < BP) {
#pragma unroll
            for (int e = 0; e < 16; ++e) { S0[e] = 0.f; S1[e] = 0.f; S2[e] = 0.f; S3[e] = 0.f; }
        } else {
            const float* sp = F.in[7] + ((size_t)(s - BP) * 8 + h) * 16384 + 32 * ws + cc;
#pragma unroll
            for (int e = 0; e < 16; ++e) { const int rr = (e & 3) + 8 * (e >> 2) + 4 * hh; S0[e] = sp[(size_t)rr * 128]; S1[e] = sp[(size_t)(32 + rr) * 128]; S2[e] = sp[(size_t)(64 + rr) * 128]; S3[e] = sp[(size_t)(96 + rr) * 128]; }
        }
        const LAS float* dec_s = (const LAS float*)(L + G2_DEC);
        LDS_BARRIER();
        if (NCH == 1) g2_mfma_step(S0, S1, S2, S3, L, dec_s[0], ws, lane, cc, hh);
        else for (int c = 0; c < NCH; c += 2) {
            g2_mfma_step(S0, S1, S2, S3, L, dec_s[c], ws, lane, cc, hh);
            g2_mfma_step(S0, S1, S2, S3, L + G2_FB, dec_s[c + 1], ws, lane, cc, hh);
        }
        int l9 = lane; asm volatile("" : "+v"(l9));
        const int cc9 = l9 & 31, hh9 = l9 >> 5;
        float* so = (s < BP ? F.out + O_GSP + ((size_t)s * 8 + h) * 16384 : F.out + O_GSS + ((size_t)(s - BP) * 8 + h) * 16384) + 32 * ws + cc9;
#pragma unroll
        for (int e = 0; e < 16; ++e) { const int rr = (e & 3) + 8 * (e >> 2) + 4 * hh9; so[(size_t)rr * 128] = S0[e]; so[(size_t)(32 + rr) * 128] = S1[e]; so[(size_t)(64 + rr) * 128] = S2[e]; so[(size_t)(96 + rr) * 128] = S3[e]; }
    } else {
        const int lt = tid - 256;
        if (lt < 128) ((LAS float*)(L + G2_HN))[lt] = F.in[32][lt];
        constexpr bool WT = NCH > 1;
        const brsrc_t srs = staging_rsrc(F.ws);
        const unsigned* ready = (const unsigned*)(F.ws + WS_READY);
        LAS float* dec_w = (LAS float*)(L + G2_DEC);
#define G2_LOAD(pre, dpre, k) do { const int _k = (k) < lastc ? (k) : lastc; g2_load_set<WT>(pre, dpre, blk0 + (size_t)_k * cstep, lt, srs, (unsigned)(ch0 + _k) * (unsigned)GS_BYTES, ready + 16 * (ch0 + _k), DEC + ch0 + _k); } while (0)
        u32x4 preA[18], preB[18]; float dA, dB;
        G2_LOAD(preA, dA, 0);
        G2_LOAD(preB, dB, 1);
        g2_store_set(preA, L, lt); if (lt == 0) dec_w[0] = dA;
        G2_LOAD(preA, dA, 2);
        const int row = lt >> 2, seg = lt & 3; const bool rok = row < nvalid;
        u32x4 zz[4];
        LDS_BARRIER();
        if (NCH == 1) {
            const size_t m = (size_t)base + row;
            if (rok) { const u32x4* zp = (const u32x4*)(F.Z1() + m * D + h * 128 + seg * 32);
#pragma unroll
                for (int q = 0; q < 4; ++q) zz[q] = zp[q]; }
            LDS_BARRIER();
            LDS_BARRIER();
            g2_epi_step(F, L, L, zz, row, seg, m, h, rok, lane);
        } else {
            for (int c = 0; c < NCH; c += 2) {
                {
                    const size_t m = (size_t)base + c * 64 + row;
                    { const u32x4* zp = (const u32x4*)(F.Z1() + m * D + h * 128 + seg * 32);
#pragma unroll
                      for (int q = 0; q < 4; ++q) zz[q] = zp[q]; }
                    g2_store_set(preB, L + G2_FB, lt); if (lt == 0) dec_w[(c + 1) & 63] = dB;
                    G2_LOAD(preB, dB, c + 3);
                    LDS_BARRIER();
                    LDS_BARRIER();
                    g2_epi_step(F, L, L, zz, row, seg, m, h, rok, lane);
                }
                {
                    const size_t m = (size_t)base + (c + 1) * 64 + row;
                    { const u32x4* zp = (const u32x4*)(F.Z1() + m * D + h * 128 + seg * 32);
#pragma unroll
                      for (int q = 0; q < 4; ++q) zz[q] = zp[q]; }
                    g2_store_set(preA, L, lt); if (lt == 0) dec_w[(c + 2) & 63] = dA;
                    G2_LOAD(preA, dA, c + 4);
                    LDS_BARRIER();
                    LDS_BARRIER();
                    g2_epi_step(F, L, L + G2_FB, zz, row, seg, m, h, rok, lane);
                }
            }
        }
    }
}
#undef G2_LOAD
constexpr int G12_CHAINS = 64;
__device__ __forceinline__ void phase_gdn_fused(Frame& F) {
    LAS unsigned char* L = F.lds;
    const float* DEC = (const float*)(F.ws + WS_DEC);
    if ((int)blockIdx.x < G12_CHAINS && F.G > G12_CHAINS) {
        const int tid = opaque_tid(F.wv);
        const int ci = blockIdx.x;
        g2_task<64>(F, L, DEC, ci >> 3, ci & 7, ci * 64, tid, tid & 63, F.wv);
    } else {
        const bool all = !(F.G > G12_CHAINS);
        gdn_g1_tasks(F, all ? (int)blockIdx.x : (int)blockIdx.x - G12_CHAINS, all ? F.G : F.G - G12_CHAINS);
    }
}
__device__ __forceinline__ void phase_gdn_g2_samples(Frame& F) {
    LAS unsigned char* L = F.lds;
    const float* DEC = (const float*)(F.ws + WS_DEC);
    for (int t = F.vcu; t < 128; t += F.G) {
        const int tid = opaque_tid(F.wv);
        g2_task<1>(F, L, DEC, BP + (t >> 3), t & 7, 4096 + t, tid, tid & 63, F.wv);
        __syncthreads();
    }
}

__device__ __forceinline__ float dpp_shr_f(float idv, float x, const int o) {
    int r;
    switch (o) {
        case 1: r = __builtin_amdgcn_update_dpp(__float_as_int(idv), __float_as_int(x), 0x111, 0xf, 0xf, false); break;
        case 2: r = __builtin_amdgcn_update_dpp(__float_as_int(idv), __float_as_int(x), 0x112, 0xf, 0xf, false); break;
        case 4: r = __builtin_amdgcn_update_dpp(__float_as_int(idv), __float_as_int(x), 0x114, 0xf, 0xf, false); break;
        default: r = __builtin_amdgcn_update_dpp(__float_as_int(idv), __float_as_int(x), 0x118, 0xf, 0xf, false); break;
    }
    return __int_as_float(r);
}
template <int PASS>
__device__ __forceinline__ void phase_lru(Frame& F) {
    int tid = opaque_tid(F.wv);
    const int lane = tid & 63, wave = __builtin_amdgcn_readfirstlane(tid >> 6);
    const int gw = F.vcu * 8 + wave, NGW = F.G * 8, h = gw & 7, g = lane >> 4, l15 = lane & 15;
    LAS unsigned char* xs = F.lds + wave * 9216;
    LAS float* cst = (LAS float*)(F.lds + 73728 + wave * 768);
    const bf16_t* LGW = (const bf16_t*)(F.ws + WS_LGW);
    float* LAG = F.LAG();
    bf16x8 wfa[4][2], wfx[4][2];
#pragma unroll
    for (int nt = 0; nt < 4; ++nt)
#pragma unroll
        for (int ks = 0; ks < 2; ++ks) {
            wfa[nt][ks] = *(const bf16x8*)(LGW + ((size_t)(h * 2 + 0) * 64 + 16 * nt + l15) * 64 + 32 * ks + 8 * g);
            wfx[nt][ks] = *(const bf16x8*)(LGW + ((size_t)(h * 2 + 1) * 64 + 16 * nt + l15) * 64 + 32 * ks + 8 * g); }
    cst[lane] = F.in[18][h * 64 + lane]; cst[64 + lane] = F.in[20][h * 64 + lane]; cst[128 + lane] = softplusf_(-F.in[21][h * 64 + lane]);
    for (int task = gw; task < 4224; task += NGW) {
        int s, c; if (task < 4096) { s = task >> 9; c = (task >> 3) & 63; } else { s = BP + ((task - 4096) >> 3); c = 0; }
        const int T = seq_len(s), base = seq_base(s), t0 = c * 64, ntile = s < BP ? 4 : 1;
        {
            int l1 = lane; asm volatile("" : "+v"(l1));
            const int cg = l1 & 7, tp = l1 >> 3;
#pragma unroll 1
            for (int hf2 = 0; hf2 < 2; ++hf2) {
                const int chb = h * 64 + cg * 8 + hf2 * 4;
                float xr[11][4];
#pragma unroll
                for (int i = 0; i < 11; ++i) {
                    const int tt = t0 + tp * 8 - 3 + i;
                    if (tt >= 0 && tt < T) { const u32x2 w = *(const u32x2*)(F.U0() + (size_t)(base + tt) * EV_IN + C_XA + chb);
                        xr[i][0] = lo16(w[0]); xr[i][1] = hi16(w[0]); xr[i][2] = lo16(w[1]); xr[i][3] = hi16(w[1]); }
                    else if (tt < 0 && s >= BP) { const f32x4 a = *(const f32x4*)(F.in[2] + ((size_t)(s - BP) * 3 + (tt + 3)) * 512 + chb); xr[i][0] = a[0]; xr[i][1] = a[1]; xr[i][2] = a[2]; xr[i][3] = a[3]; }
                    else { xr[i][0] = 0.f; xr[i][1] = 0.f; xr[i][2] = 0.f; xr[i][3] = 0.f; }
                }
                const f32x4 c0 = *(const f32x4*)(F.in[15] + chb), c1 = *(const f32x4*)(F.in[15] + 512 + chb), c2 = *(const f32x4*)(F.in[15] + 1024 + chb), c3 = *(const f32x4*)(F.in[15] + 1536 + chb), cb = *(const f32x4*)(F.in[16] + chb);
#pragma unroll
                for (int i = 0; i < 8; ++i) { float o[4];
#pragma unroll
                    for (int e = 0; e < 4; ++e) o[e] = c0[e] * xr[i][e] + c1[e] * xr[i + 1][e] + c2[e] * xr[i + 2][e] + c3[e] * xr[i + 3][e] + cb[e];
                    u32x2 w; w[0] = cvt2(o[0], o[1]); w[1] = cvt2(o[2], o[3]);
                    *(LAS u32x2*)(xs + (tp * 8 + i) * 144 + cg * 16 + hf2 * 8) = w; }
                if (PASS == 2 && t0 + 64 >= T && tp == ((T - 1) >> 3) - (t0 >> 3)) {
                    float* o = (s < BP ? F.out + O_LCP + (size_t)s * 3 * 512 : F.out + O_LCS + (size_t)(s - BP) * 3 * 512) + chb;
#pragma unroll
                    for (int q = 0; q < 3; ++q) *(f32x4*)(o + q * 512) = (f32x4){xr[8 + q][0], xr[8 + q][1], xr[8 + q][2], xr[8 + q][3]};
                }
            }
        }
        float hin[4][4], arun[4][4];
#pragma unroll
        for (int nt = 0; nt < 4; ++nt)
#pragma unroll
            for (int rg = 0; rg < 4; ++rg) { hin[nt][rg] = 0.f; arun[nt][rg] = 1.f; }
        if (PASS == 2) {
            float hf = s >= BP ? F.in[3][(s - BP) * 512 + h * 64 + lane] : 0.f;
            const f32x2* lp = (const f32x2*)LAG + (size_t)(s * 64) * 512 + h * 64 + lane;
            int j = 0;
            for (; j + 8 <= c; j += 8) { f32x2 v[8];
#pragma unroll
                for (int q = 0; q < 8; ++q) v[q] = lp[(size_t)(j + q) * 512];
#pragma unroll
                for (int q = 0; q < 8; ++q) hf = v[q][0] * hf + v[q][1]; }
            for (; j < c; ++j) { const f32x2 v = lp[(size_t)j * 512]; hf = v[0] * hf + v[1]; }
#pragma unroll
            for (int nt = 0; nt < 4; ++nt)
#pragma unroll
                for (int rg = 0; rg < 4; ++rg) hin[nt][rg] = shfl_idx(hf, 16 * nt + 4 * g + rg);
        }
        asm volatile("s_waitcnt lgkmcnt(0)" ::: "memory");
        for (int tt = 0; tt < ntile; ++tt) {
            const int tok = 16 * tt + l15;
            const bf16x8 b0 = *(const LAS bf16x8*)(xs + tok * 144 + (8 * g) * 2), b1 = *(const LAS bf16x8*)(xs + tok * 144 + (32 + 8 * g) * 2);
            const size_t m = (size_t)base + t0 + tok;
#pragma unroll
            for (int nt = 0; nt < 4; ++nt) {
                f32x4 za = {0.f, 0.f, 0.f, 0.f}, zx = {0.f, 0.f, 0.f, 0.f};
                za = MFMA16(wfa[nt][0], b0, za); za = MFMA16(wfa[nt][1], b1, za);
                zx = MFMA16(wfx[nt][0], b0, zx); zx = MFMA16(wfx[nt][1], b1, zx);
                const int n0 = 16 * nt + 4 * g;
                const u32x2 xw = *(const LAS u32x2*)(xs + tok * 144 + n0 * 2);
                const float xc[4] = {lo16(xw[0]), hi16(xw[0]), lo16(xw[1]), hi16(xw[1])};
                const f32x4 cba = *(const LAS f32x4*)(cst + n0), cbx = *(const LAS f32x4*)(cst + 64 + n0), csp = *(const LAS f32x4*)(cst + 128 + n0);
                float av[4], bv[4];
#pragma unroll
                for (int rg = 0; rg < 4; ++rg) {
                    const float r = sigmoidf_(za[rg] + cba[rg]), ig = sigmoidf_(zx[rg] + cbx[rg]), la = -8.0f * r * csp[rg], a = __expf(la);
                    av[rg] = a; bv[rg] = sqrtf(fmaxf(1.0f - a * a, 0.f)) * (ig * xc[rg]); }
#pragma unroll
                for (int o = 1; o < 16; o <<= 1)
#pragma unroll
                    for (int rg = 0; rg < 4; ++rg) { const float ap = dpp_shr_f(1.0f, av[rg], o), bp = dpp_shr_f(0.0f, bv[rg], o); bv[rg] = av[rg] * bp + bv[rg]; av[rg] = av[rg] * ap; }
                float hv[4];
#pragma unroll
                for (int rg = 0; rg < 4; ++rg) { hv[rg] = bv[rg] + av[rg] * hin[nt][rg]; hin[nt][rg] = shfl_idx(hv[rg], (lane & 48) | 15); }
                if (PASS == 1) {
#pragma unroll
                    for (int rg = 0; rg < 4; ++rg) arun[nt][rg] *= shfl_idx(av[rg], (lane & 48) | 15);
                } else {
                    const bool tok_ok = (t0 + tok) < T;
                    if (tok_ok) {
                        const u32x2 gw2 = *(const u32x2*)(F.U0() + m * EV_IN + C_GA + h * 64 + n0);
                        u32x2 yo; yo[0] = cvt2(hv[0] * siluf_(lo16(gw2[0])), hv[1] * siluf_(hi16(gw2[0]))); yo[1] = cvt2(hv[2] * siluf_(lo16(gw2[1])), hv[3] * siluf_(hi16(gw2[1])));
                        *(u32x2*)(F.Y0() + m * D + h * 64 + n0) = yo;
                        if (t0 + tok == T - 1) { float* o = (s < BP ? F.out + O_LHP + s * 512 : F.out + O_LHS + (s - BP) * 512) + h * 64 + n0; *(f32x4*)o = (f32x4){hv[0], hv[1], hv[2], hv[3]}; }
                    }
                }
                if (nt & 1) __builtin_amdgcn_sched_barrier(0);
            }
        }
        if (PASS == 1 && s < BP && l15 == 15) {
            f32x2* lp = (f32x2*)LAG + (size_t)(s * 64 + c) * 512 + h * 64;
#pragma unroll
            for (int nt = 0; nt < 4; ++nt)
#pragma unroll
                for (int rg = 0; rg < 4; ++rg) lp[16 * nt + 4 * g + rg] = (f32x2){arun[nt][rg], hin[nt][rg]};
        }
        asm volatile("s_waitcnt lgkmcnt(0)" ::: "memory");
    }
}

constexpr size_t RB_VTP = RB_WEND, RB_VTS = RB_VTP + (size_t)BP * 2 * 64 * TP * 2, RB_VTEND = RB_VTS + (size_t)BS * 2 * 64 * 192 * 2;
static_assert(RB_VTEND <= RB_BYTES, "ws map");
__device__ __forceinline__ void phase_vt_build(Frame& F) {
    PHASE_IDS();
    const int gw = F.vcu * 8 + wave, NGW = F.G * 8;
    LAS unsigned char* xs = F.lds + wave * 9216;
    bf16_t* VTP = (bf16_t*)(F.ws + WS_RB + RB_VTP); bf16_t* VTS = (bf16_t*)(F.ws + WS_RB + RB_VTS);
    for (int task = gw; task < 1024 + 96; task += NGW) {
        int s, kv, kb; if (task < 1024) { s = task >> 7; kv = (task >> 6) & 1; kb = task & 63; } else { const int r = task - 1024; s = BP + r / 6; kv = (r % 6) / 3; kb = r % 3; }
        const int row8 = lane >> 3, ch = lane & 7;
#pragma unroll
        for (int i = 0; i < 8; ++i) {
            const int key = 8 * i + row8, kg = kb * 64 + key; u32x4 w = {0u, 0u, 0u, 0u};
            if (s < BP) w = *(const u32x4*)(F.U0() + (size_t)(s * TP + kg) * EV_IN + C_V + kv * 64 + ch * 8);
            else if (kg < 128) { const f32x4* p = (const f32x4*)(F.in[5] + ((size_t)((s - BP) * 128 + kg) * 2 + kv) * 64 + ch * 8); const f32x4 a = p[0], b = p[1]; w[0] = cvt2(a[0], a[1]); w[1] = cvt2(a[2], a[3]); w[2] = cvt2(b[0], b[1]); w[3] = cvt2(b[2], b[3]); }
            else if (kg < 128 + TS) w = *(const u32x4*)(F.U0() + (size_t)(MP + (s - BP) * TS + (kg - 128)) * EV_IN + C_V + kv * 64 + ch * 8);
            *(LAS u32x4*)(xs + key * 144 + ch * 16) = w;
        }
        asm volatile("s_waitcnt lgkmcnt(0)" ::: "memory");
        bf16_t* dst = s < BP ? VTP + ((size_t)(s * 2 + kv) * 64 + lane) * TP + kb * 64 : VTS + ((size_t)((s - BP) * 2 + kv) * 64 + lane) * 192 + kb * 64;
#pragma unroll
        for (int q = 0; q < 8; ++q) { u32x4 o;
#pragma unroll
            for (int e = 0; e < 4; ++e) { const unsigned lo = *(const LAS bf16_t*)(xs + (8 * q + 2 * e) * 144 + lane * 2), hi = *(const LAS bf16_t*)(xs + (8 * q + 2 * e + 1) * 144 + lane * 2); o[e] = lo | (hi << 16); }
            *(u32x4*)(dst + 8 * q) = o; }
        asm volatile("s_waitcnt lgkmcnt(0)" ::: "memory");
    }
}
constexpr int AT_K = 0, AT_V = 27648;
__device__ __forceinline__ void phase_attn(Frame& F) {
    PHASE_IDS();
    LAS unsigned char* L = F.lds;
    const bf16_t* VTP = (const bf16_t*)(F.ws + WS_RB + RB_VTP); const bf16_t* VTS = (const bf16_t*)(F.ws + WS_RB + RB_VTS);
    for (int task = F.vcu; task < 1024 + 32; task += F.G) {
        int s, c, kv; if (task < 1024) { s = task >> 7; c = (task >> 1) & 63; kv = task & 1; } else { s = BP + ((task - 1024) >> 1); c = 0; kv = task & 1; }
        const int base = seq_base(s), tok0 = c * 64 - 128;
        const int kmin = s < BP ? (tok0 < 0 ? -tok0 : 0) : 0, kmax = s < BP ? 192 : 128 + TS;
        __syncthreads();
#pragma unroll
        for (int i = 0; i < 3; ++i) {
            const int idx = tid + 512 * i, key = idx >> 3, ch = idx & 7; u32x4 w = {0u, 0u, 0u, 0u};
            if (key >= kmin && key < kmax) {
                if (s < BP) w = *(const u32x4*)(F.U0() + (size_t)(base + tok0 + key) * EV_IN + C_K + kv * 64 + ch * 8);
                else if (key < 128) { const f32x4* p = (const f32x4*)(F.in[4] + ((size_t)((s - BP) * 128 + key) * 2 + kv) * 64 + ch * 8); const f32x4 a = p[0], b = p[1]; w[0] = cvt2(a[0], a[1]); w[1] = cvt2(a[2], a[3]); w[2] = cvt2(b[0], b[1]); w[3] = cvt2(b[2], b[3]); }
                else w = *(const u32x4*)(F.U0() + (size_t)(base + key - 128) * EV_IN + C_K + kv * 64 + ch * 8);
            }
            *(LAS u32x4*)(L + AT_K + key * 144 + ch * 16) = w;
        }
#pragma unroll
        for (int i = 0; i < 3; ++i) {
            const int idx = tid + 512 * i, d = idx / 24, ch = idx % 24, key = ch * 8; u32x4 w = {0u, 0u, 0u, 0u};
            if (s < BP) { if (key >= kmin) w = *(const u32x4*)(VTP + ((size_t)(s * 2 + kv) * 64 + d) * TP + tok0 + key); }
            else w = *(const u32x4*)(VTS + ((size_t)((s - BP) * 2 + kv) * 64 + d) * 192 + key);
            *(LAS u32x4*)(L + AT_V + d * 400 + ch * 16) = w;
        }
        const int g = wave >> 1, qh = wave & 1, hq = kv * 4 + g, r = lane & 31, hh = lane >> 5, qi = qh * 32 + r;
        const bool qok = s < BP ? true : qi < TS;
        const size_t m = (size_t)base + c * 64 + (qok ? qi : 0);
        bf16x8 qf[4];
#pragma unroll
        for (int ks = 0; ks < 4; ++ks) { u32x4 w = {0u, 0u, 0u, 0u};
            if (qok) { const u32x4 x = *(const u32x4*)(F.U0() + m * EV_IN + C_Q + hq * 64 + 16 * ks + 8 * hh);
#pragma unroll
                for (int e = 0; e < 4; ++e) w[e] = cvt2(lo16(x[e]) * 0.125f, hi16(x[e]) * 0.125f); }
            qf[ks] = __builtin_bit_cast(bf16x8, w); }
        const float sink = F.in[22][hq];
        __syncthreads();
        float mrun = sink, lrun = 1.0f;
        f32x16 o0, o1;
#pragma unroll
        for (int e = 0; e < 16; ++e) { o0[e] = 0.f; o1[e] = 0.f; }
#pragma unroll 1
        for (int half = 0; half < 2; ++half) {
            f32x16 sc[3];
#pragma unroll
            for (int k3 = 0; k3 < 3; ++k3) {
                const int kt = 3 * half + k3;
#pragma unroll
                for (int e = 0; e < 16; ++e) sc[k3][e] = 0.f;
#pragma unroll
                for (int ks = 0; ks < 4; ++ks) { const bf16x8 kf = *(const LAS bf16x8*)(L + AT_K + (32 * kt + r) * 144 + (16 * ks + 8 * hh) * 2); sc[k3] = MFMA32(kf, qf[ks], sc[k3]); }
            }
            float mx = -1e30f;
#pragma unroll
            for (int k3 = 0; k3 < 3; ++k3)
#pragma unroll
                for (int e = 0; e < 16; ++e) { const int kidx = 32 * (3 * half + k3) + (e & 3) + 8 * (e >> 2) + 4 * hh; const bool ok = kidx >= kmin && kidx < kmax; sc[k3][e] = ok ? sc[k3][e] : -1e30f; mx = fmaxf(mx, sc[k3][e]); }
            mx = fmaxf(mx, shfl_xor_l(mx, 32, lane));
            const float mnew = fmaxf(mrun, mx), alpha = __expf(mrun - mnew);
            float psum = 0.f;
#pragma unroll
            for (int k3 = 0; k3 < 3; ++k3)
#pragma unroll
                for (int e = 0; e < 16; ++e) { const float p = __expf(sc[k3][e] - mnew); sc[k3][e] = p; psum += p; }
            psum += shfl_xor_l(psum, 32, lane);
            lrun = lrun * alpha + psum; mrun = mnew;
            o0 = o0 * alpha; o1 = o1 * alpha;
#pragma unroll
            for (int k3 = 0; k3 < 3; ++k3)
#pragma unroll
                for (int ss = 0; ss < 2; ++ss) {
                    const int kt = 3 * half + k3;
                    const bf16x8 pb = pack8(sc[k3], ss);
                    const LAS unsigned char* vp = L + AT_V + r * 400 + (32 * kt + 16 * ss + 4 * hh) * 2;
                    const u32x2 a0 = *(const LAS u32x2*)vp, a1 = *(const LAS u32x2*)(vp + 16), b0 = *(const LAS u32x2*)(vp + 32 * 400), b1 = *(const LAS u32x2*)(vp + 32 * 400 + 16);
                    const u32x4 va = {a0[0], a0[1], a1[0], a1[1]}, vb = {b0[0], b0[1], b1[0], b1[1]};
                    o0 = MFMA32(__builtin_bit_cast(bf16x8, va), pb, o0); o1 = MFMA32(__builtin_bit_cast(bf16x8, vb), pb, o1);
                }
        }
        const float il = __builtin_amdgcn_rcpf(lrun);
        if (qok) {
#pragma unroll
            for (int qq = 0; qq < 4; ++qq) {
                { const int d = 8 * qq + 4 * hh; const u32x2 gb = *(const u32x2*)(F.U0() + m * EV_IN + C_GB + hq * 64 + d);
                  u32x2 yo; yo[0] = cvt2(o0[4 * qq] * il * siluf_(lo16(gb[0])), o0[4 * qq + 1] * il * siluf_(hi16(gb[0]))); yo[1] = cvt2(o0[4 * qq + 2] * il * siluf_(lo16(gb[1])), o0[4 * qq + 3] * il * siluf_(hi16(gb[1])));
                  *(u32x2*)(F.Y0() + m * D + 512 + hq * 64 + d) = yo; }
                { const int d = 32 + 8 * qq + 4 * hh; const u32x2 gb = *(const u32x2*)(F.U0() + m * EV_IN + C_GB + hq * 64 + d);
                  u32x2 yo; yo[0] = cvt2(o1[4 * qq] * il * siluf_(lo16(gb[0])), o1[4 * qq + 1] * il * siluf_(hi16(gb[0]))); yo[1] = cvt2(o1[4 * qq + 2] * il * siluf_(lo16(gb[1])), o1[4 * qq + 3] * il * siluf_(hi16(gb[1])));
                  *(u32x2*)(F.Y0() + m * D + 512 + hq * 64 + d) = yo; }
            }
        }
    }
    __syncthreads();
}

__device__ __forceinline__ void phase_final_rowwise(Frame& F) {
    PHASE_IDS();
    const int gw = F.vcu * 8 + wave, NGW = F.G * 8;
    for (int m = gw; m < MT; m += NGW) {
        int s, t; tok_info(m, s, t);
        const float* mod1 = F.MOD() + (size_t)(24 + s) * 3072;
        f32x4 y[4]; float ss = 0.f;
#pragma unroll
        for (int j = 0; j < 4; ++j) { const u32x2 w = *(const u32x2*)(F.YO() + (size_t)m * D + 4 * lane + 256 * j); y[j] = (f32x4){lo16(w.x), hi16(w.x), lo16(w.y), hi16(w.y)};
            ss += (y[j][0] * y[j][0] + y[j][1] * y[j][1]) + (y[j][2] * y[j][2] + y[j][3] * y[j][3]); }
        const float r1 = rsqrtf(wave_sum(ss, lane) * (1.f / D) + EPS);
#pragma unroll
        for (int j = 0; j < 4; ++j) { const int c = 4 * lane + 256 * j;
            float* op = F.out + O_Y + (size_t)m * D + c;
            const f32x4 xv = *(const f32x4*)op, g = *(const f32x4*)(F.in[27] + c), gt = *(const f32x4*)(mod1 + 2048 + c);
            f32x4 o;
#pragma unroll
            for (int e = 0; e < 4; ++e) o[e] = xv[e] + gt[e] * (y[j][e] * r1 * g[e]);
            *(f32x4*)op = o; }
    }
}

__global__ void __launch_bounds__(512, 2) fwd_megakernel(Params P) {
    extern __shared__ __attribute__((aligned(16))) unsigned char lds_raw[];
    Frame F;
    F.lds = (LAS unsigned char*)lds_raw;
    F.wv = __builtin_amdgcn_readfirstlane(threadIdx.x >> 6);
    F.G = gridDim.x; { const int bx = blockIdx.x; F.vcu = (F.G % 8 == 0) ? (bx % 8) * (F.G / 8) + bx / 8 : bx; }
    F.in = P.in; F.out = P.out; F.ws = P.ws;

    volatile LAS unsigned* misc = (volatile LAS unsigned*)(F.lds + LDS_BYTES - 64);
    if (threadIdx.x < 16) misc[threadIdx.x] = 0u;
    __syncthreads();
    XcdBarrier xbar = xcd_barrier_post((unsigned*)(P.ws + WS_CTL), misc);
#define GRID_BAR() xcd_barrier(xbar, F.wv)
    phase_prologue(F);
    GRID_BAR();
    phase_prenorm0(F);
    GRID_BAR();
    { pg8::Gemm g{F.XN(), F.W0I(), MT, EV_IN, D}; pg8::StaticOrder S; S.init(MT, EV_IN, F.G, (int)blockIdx.x);
      pg8::EpiBf16 E{F.U0(), EV_IN, 1 << 30, F.U0(), EV_IN}; pg8::gemm_phase(F.lds, g, S, E, F.wv); }
    GRID_BAR();
    phase_rope(F);
    phase_lru<1>(F);
    phase_vt_build(F);
    GRID_BAR();
    phase_lru<2>(F);
    phase_attn(F);
    GRID_BAR();
    { pg8::Gemm g{F.Y0(), F.W0O(), MT, D, D}; pg8::StaticOrder S; S.init(MT, D, F.G, (int)blockIdx.x);
      pg8::EpiBf16 E{F.YO(), D, 1 << 30, F.YO(), D}; pg8::gemm_phase(F.lds, g, S, E, F.wv); }
    GRID_BAR();
    phase_mid_rowwise(F);
    GRID_BAR();
    { pg8::Gemm g{F.XN(), F.W1I(), MT, OD_MAIN, D}; pg8::StaticOrder S; S.init(MT, OD_MAIN, F.G, (int)blockIdx.x);
      pg8::EpiBf16 E{F.QKV1(), 3072, 3072, F.Z1(), D}; pg8::gemm_phase(F.lds, g, S, E, F.wv); }
    GRID_BAR();
    phase_gdn_fused(F);
    GRID_BAR();
    phase_gdn_g2_samples(F);
    GRID_BAR();
    { pg8::Gemm g{F.Y1(), F.W1O(), MT, D, D}; pg8::StaticOrder S; S.init(MT, D, F.G, (int)blockIdx.x);
      pg8::EpiBf16 E{F.YO(), D, 1 << 30, F.YO(), D}; pg8::gemm_phase(F.lds, g, S, E, F.wv); }
    GRID_BAR();
    phase_final_rowwise(F);
}

extern "C" void kernel_launch(void* const* d_in, const int* in_sizes, int n_in, void* d_out, int out_size, void* d_ws, size_t ws_size, hipStream_t stream) {
    static int grid = 0;
    if (grid == 0) {
        if (n_in != 34 || out_size != (int)O_END || ws_size < WS_END) { grid = -1; return; }
        int dev = 0, cus = 0, per_cu = 0;
        if (hipGetDevice(&dev) != hipSuccess || hipDeviceGetAttribute(&cus, hipDeviceAttributeMultiprocessorCount, dev) != hipSuccess) { grid = -1; return; }
        if (hipFuncSetAttribute((const void*)fwd_megakernel, hipFuncAttributeMaxDynamicSharedMemorySize, LDS_BYTES) != hipSuccess) { grid = -1; return; }
        if (hipOccupancyMaxActiveBlocksPerMultiprocessor(&per_cu, (const void*)fwd_megakernel, 512, LDS_BYTES) != hipSuccess || per_cu < 1) { grid = -1; return; }
        grid = cus;
    }
    if (grid < 0) return;
    if (hipMemsetAsync((char*)d_ws + WS_CTL, 0, 65536 + 262144, stream) != hipSuccess) return;
    Params p{};
    for (int i = 0; i < 34; ++i) p.in[i] = (const float*)d_in[i];
    p.out = (float*)d_out; p.ws = (unsigned char*)d_ws;
    void* args[] = {&p};
    (void)hipLaunchCooperativeKernel((const void*)fwd_megakernel, dim3(grid), dim3(512), args, LDS_BYTES, stream);
}
```

```cpp
#include <hip/hip_runtime.h>
#include <hip/hip_cooperative_groups.h>
namespace cg = cooperative_groups;

#define LAS __attribute__((address_space(3)))
typedef unsigned short bf16_t;
typedef short bf16x8 __attribute__((ext_vector_type(8)));
typedef float f32x4 __attribute__((ext_vector_type(4)));
typedef float f32x2 __attribute__((ext_vector_type(2)));
typedef unsigned u32x4 __attribute__((ext_vector_type(4)));
typedef unsigned u32x2 __attribute__((ext_vector_type(2)));

constexpr int D = 1024, BP = 8, TP = 4096, BS = 16, TS = 16;
constexpr int MP = BP * TP, MS = BS * TS, MT = MP + MS;
constexpr int NSEQ = BP + BS;
constexpr int EV_IN = 2304, OD_IN = 4112, OD_MAIN = 4096;
constexpr int C_XA = 0, C_GA = 512, C_Q = 1024, C_K = 1536, C_V = 1664, C_GB = 1792;
constexpr float EPS = 1e-6f;
constexpr size_t O_Y = 0, O_LCP = 33816576, O_LCS = 33828864, O_LHP = 33853440, O_LHS = 33857536, O_KP = 33865728, O_KS = 33996800,
                 O_VP = 34029568, O_VS = 34160640, O_GCP = 34193408, O_GCS = 34267136, O_GSP = 34414592, O_GSS = 35463168, O_END = 37560320;
constexpr size_t MiB = 1u << 20;
constexpr size_t WS_CTL = 0, WS_W1O = 1 * MiB, WS_MOD = 3 * MiB, WS_ROPE = 4 * MiB, WS_BA = 5 * MiB, WS_LAG = 8 * MiB, WS_LGW = 10 * MiB;
constexpr size_t WS_RA = 16 * MiB, RA_BYTES = (size_t)MT * 4096 * 2;
constexpr size_t WS_RB = WS_RA + RA_BYTES;
constexpr size_t ACT_BYTES = (size_t)MT * D * 2;
constexpr size_t RB_XN = 0, RB_Y0 = ACT_BYTES, RB_YO = 2 * ACT_BYTES, RB_W0I = 3 * ACT_BYTES, RB_W0O = RB_W0I + (size_t)EV_IN * D * 2,
                 RB_W1I = RB_W0O + (size_t)D * D * 2, RB_WEND = RB_W1I + (size_t)OD_MAIN * D * 2;
constexpr size_t RB_BYTES = (size_t)4224 * 73728;
constexpr size_t WS_END = WS_RB + RB_BYTES;
static_assert(RB_WEND <= RB_BYTES, "ws map");
static_assert((size_t)MT * 3072 * 2 <= RB_BYTES, "ws map");
constexpr int LDS_BYTES = 155648;

struct Params { const float* in[34]; float* out; unsigned char* ws; };

__device__ __forceinline__ float bf2f(bf16_t b) { return __uint_as_float(((unsigned)b) << 16); }
__device__ __forceinline__ unsigned f2bf(float f) { unsigned u = __float_as_uint(f); return (u + 0x7fffu + ((u >> 16) & 1u)) >> 16; }
__device__ __forceinline__ unsigned pk2(float lo, float hi) { return f2bf(lo) | (f2bf(hi) << 16); }
typedef __bf16 bf16x2_t __attribute__((ext_vector_type(2)));
__device__ __forceinline__ unsigned cvt2(float a, float b) { f32x2 v = {a, b}; bf16x2_t r = __builtin_convertvector(v, bf16x2_t); return __builtin_bit_cast(unsigned, r); }
__device__ __forceinline__ float lo16(unsigned w) { return __uint_as_float(w << 16); }
__device__ __forceinline__ float hi16(unsigned w) { return __uint_as_float(w & 0xffff0000u); }
__device__ __forceinline__ float shfl_idx(float x, int src_lane) { return __int_as_float(__builtin_amdgcn_ds_bpermute(src_lane << 2, __float_as_int(x))); }
__device__ __forceinline__ float shfl_xor_l(float x, int o, int lane) { return shfl_idx(x, lane ^ o); }
__device__ __forceinline__ float wave_sum(float v, int lane) {
#pragma unroll
    for (int o = 1; o < 64; o <<= 1) v += shfl_xor_l(v, o, lane);
    return v;
}
__device__ __forceinline__ float sigmoidf_(float x) { return __builtin_amdgcn_rcpf(1.0f + __expf(-x)); }
__device__ __forceinline__ float siluf_(float x) { return x * __builtin_amdgcn_rcpf(1.0f + __expf(-x)); }
__device__ __forceinline__ float softplusf_(float x) { return x > 20.f ? x : log1pf(__expf(x)); }
__device__ __forceinline__ int seq_base(int s) { return s < BP ? s * TP : MP + (s - BP) * TS; }
__device__ __forceinline__ int seq_len(int s) { return s < BP ? TP : TS; }
__device__ __forceinline__ void tok_info(int m, int& s, int& t) { if (m < MP) { s = m >> 12; t = m & 4095; } else { const int r = m - MP; s = BP + (r >> 4); t = r & 15; } }

__device__ __forceinline__ int opaque_tid(int wv) { unsigned z = 0u; asm volatile("" : "+v"(z)); const int l = __builtin_amdgcn_mbcnt_hi(~0u, __builtin_amdgcn_mbcnt_lo(~0u, z)); return wv * 64 + l; }
namespace pg8 {
constexpr int BM = 256, BK = 64, HALF = 128, HTB = HALF * BK * 2, STAGE_BYTES = 8 * HTB, NXCD = 8, WGM = 8;
__host__ __device__ __forceinline__ int lds_byte(int r, int c) { const int st = (r >> 4) * 2 + (c >> 5), rr = r & 15, cc = c & 31, ob = rr * 64 + cc * 2; return st * 1024 + (ob ^ (((ob >> 9) & 1) << 5)); }
__host__ __device__ __forceinline__ void stage_rc(int b, int& R, int& C) { const int st = b / 1024, sb = b % 1024, swz = sb ^ (((sb >> 9) & 1) << 5); R = (st >> 1) * 16 + swz / 64; C = (st & 1) * 32 + (swz % 64) / 2; }
__host__ __device__ __forceinline__ int perm32(int rho) { const int n = rho >> 4, i = rho & 15; return 8 * (i >> 2) + 4 * n + (i & 3); }
struct Unit { int pm, pn; };
struct Gemm { const bf16_t* A; const bf16_t* Bt; int M, N, K; };
struct StaticOrder {
    int nM, nN, nwg, G, c;
    __device__ void init(int M, int N, int G_, int c_) { nM = M / BM; nN = N / BM; nwg = nM * nN; G = G_; c = c_; }
    __device__ bool next(int i, Unit& u) const {
        const long L = (long)i * G + c; if (L >= nwg) return false;
        int wgid = (int)L; { const int q = nwg / NXCD, r = nwg % NXCD, xcd = wgid % NXCD, off = wgid / NXCD; wgid = (xcd < r ? xcd * (q + 1) : r * (q + 1) + (xcd - r) * q) + off; }
        const int nig = WGM * nN, gid = wgid / nig, fm = gid * WGM, gsz = (nM - fm) < WGM ? (nM - fm) : WGM;
        u.pm = fm + ((wgid % nig) % gsz); u.pn = (wgid % nig) / gsz; return true;
    }
};
__device__ __forceinline__ unsigned cvt_pk_bf16(float lo, float hi) { unsigned r; asm volatile("v_cvt_pk_bf16_f32 %0, %1, %2" : "=v"(r) : "v"(lo), "v"(hi)); return r; }
struct EpiBf16 {
    static constexpr bool PERM = true;
    bf16_t* O0; int ld0; int split; bf16_t* O1; int ld1;
    __device__ __forceinline__ void operator()(const f32x4 (&acc)[2][2][4][2], const Unit& u, int wr, int wc, int fr, int fq) const {
        const int row0 = u.pm * BM + wr * 64 + fr; int colt = u.pn * BM; bf16_t* base = O0; int ld = ld0;
        if (colt >= split) { base = O1; ld = ld1; colt -= split; }
        const int col0 = colt + wc * 32 + 8 * fq;
#pragma unroll
        for (int ai = 0; ai < 2; ++ai)
#pragma unroll
            for (int m = 0; m < 4; ++m) { bf16_t* rowp = base + (size_t)(row0 + ai * HALF + m * 16) * ld + col0;
#pragma unroll
                for (int bj = 0; bj < 2; ++bj) { const f32x4 v0 = acc[ai][bj][m][0], v1 = acc[ai][bj][m][1];
                    u32x4 w; w.x = cvt_pk_bf16(v0[0], v0[1]); w.y = cvt_pk_bf16(v0[2], v0[3]); w.z = cvt_pk_bf16(v1[0], v1[1]); w.w = cvt_pk_bf16(v1[2], v1[3]);
                    *(u32x4*)(rowp + bj * HALF) = w; } }
    }
};
template <class Epi, class Sched>
__device__ __forceinline__ void gemm_phase(LAS unsigned char* lds, const Gemm g, const Sched& S, const Epi& E, const int wv0) {
    int tid = opaque_tid(wv0);
    const int wid = __builtin_amdgcn_readfirstlane(tid >> 6), lane = tid & 63, wr = wid >> 2, wc = wid & 3, fr = lane & 15, fq = lane >> 4;
    const int K = g.K, nt = K / BK;
    unsigned voffA[2], voffB[2];
#pragma unroll
    for (int i = 0; i < 2; ++i) { int R, C; stage_rc(tid * 16 + i * 8192, R, C); const int Rb = Epi::PERM ? ((R & ~31) + perm32(R & 31)) : R;
        voffA[i] = (unsigned)(R * K + C) * 2u; voffB[i] = (unsigned)(Rb * K + C) * 2u; }
    const size_t kstep = (size_t)(BK * 2);
    const size_t hstep = (size_t)HALF * K * 2;
    const size_t tstep = 2 * hstep;
    const unsigned ldsw = (unsigned)wid * 1024u;
    const int aoff = lds_byte(wr * 64 + fr, fq * 8), boff = lds_byte(wc * 32 + fr, fq * 8);
#define PG8_SA(b, h) (((b) * 2 + (h)) * HTB)
#define PG8_SB(b, h) ((4 + (b) * 2 + (h)) * HTB)
#define PG8_STAGE(bufoff, gbase, voff) do { _Pragma("unroll") for (int _i = 0; _i < 2; ++_i) \
        __builtin_amdgcn_global_load_lds((const unsigned*)((const char*)(gbase) + (voff)[_i]), (LAS unsigned*)(lds + (bufoff) + ldsw + _i * 8192), 16, 0, 0); } while (0)
#define PG8_LDA(dst, b, h) do { _Pragma("unroll") for (int m = 0; m < 4; ++m) _Pragma("unroll") for (int k = 0; k < 2; ++k) dst[m][k] = *(const LAS bf16x8*)(lds + PG8_SA(b, h) + aoff + m * 2048 + k * 1024); } while (0)
#define PG8_LDB(dst, b, h) do { _Pragma("unroll") for (int n = 0; n < 2; ++n) _Pragma("unroll") for (int k = 0; k < 2; ++k) dst[n][k] = *(const LAS bf16x8*)(lds + PG8_SB(b, h) + boff + n * 2048 + k * 1024); } while (0)
#define PG8_MMA(ai, bj, At, Bt) do { __builtin_amdgcn_s_setprio(1); _Pragma("unroll") for (int m = 0; m < 4; ++m) _Pragma("unroll") for (int n = 0; n < 2; ++n) _Pragma("unroll") for (int k = 0; k < 2; ++k) \
        acc[ai][bj][m][n] = __builtin_amdgcn_mfma_f32_16x16x32_bf16(Bt[n][k], At[m][k], acc[ai][bj][m][n], 0, 0, 0); __builtin_amdgcn_s_setprio(0); } while (0)
#define PG8_WAIT_V(n) asm volatile("s_waitcnt vmcnt(" #n ")" ::: "memory")
#define PG8_WAIT_L(n) asm volatile("s_waitcnt lgkmcnt(" #n ")" ::: "memory")
#define PG8_BAR __builtin_amdgcn_s_barrier()
#define PG8_SCHED __builtin_amdgcn_sched_barrier(0)
    Unit cur, nxt; int ui = 0;
    if (!S.next(0, cur)) return;
    f32x4 acc[2][2][4][2];
#pragma unroll
    for (int a = 0; a < 2; ++a)
#pragma unroll
        for (int b = 0; b < 2; ++b)
#pragma unroll
            for (int m = 0; m < 4; ++m)
#pragma unroll
                for (int n = 0; n < 2; ++n) acc[a][b][m][n] = (f32x4){0.f, 0.f, 0.f, 0.f};
    bf16x8 At[4][2], B0[2][2], B1[2][2];
    const char* cA = (const char*)g.A + (size_t)cur.pm * tstep; const char* cB = (const char*)g.Bt + (size_t)cur.pn * tstep;
    PG8_STAGE(PG8_SB(0, 0), cB, voffB); PG8_STAGE(PG8_SA(0, 0), cA, voffA); PG8_STAGE(PG8_SB(0, 1), cB + hstep, voffB); PG8_STAGE(PG8_SA(0, 1), cA + hstep, voffA);
    if (wr == 1) PG8_BAR;
    PG8_WAIT_V(4); PG8_BAR;
    PG8_STAGE(PG8_SB(1, 0), cB + kstep, voffB); PG8_STAGE(PG8_SA(1, 0), cA + kstep, voffA); PG8_STAGE(PG8_SB(1, 1), cB + hstep + kstep, voffB);
    PG8_WAIT_V(6); PG8_BAR;
    for (;;) {
        const bool has_next = S.next(ui + 1, nxt);
        const char* nA = has_next ? (const char*)g.A + (size_t)nxt.pm * tstep : cA; const char* nB = has_next ? (const char*)g.Bt + (size_t)nxt.pn * tstep : cB;
        for (int t = 0; t < nt; t += 2) {
            const bool last = (t == nt - 2);
            const char* a1 = cA + (size_t)(t + 1) * kstep;
            const char* a2 = last ? nA : cA + (size_t)(t + 2) * kstep; const char* b2 = last ? nB : cB + (size_t)(t + 2) * kstep;
            const char* a3 = a2 + kstep; const char* b3 = b2 + kstep;
            PG8_LDB(B0, 0, 0); PG8_SCHED; PG8_LDA(At, 0, 0); PG8_STAGE(PG8_SA(1, 1), a1 + hstep, voffA);
            PG8_WAIT_L(8); PG8_BAR; PG8_WAIT_L(0); PG8_MMA(0, 0, At, B0); PG8_BAR; PG8_SCHED;
            PG8_LDB(B1, 0, 1); PG8_STAGE(PG8_SB(0, 0), b2, voffB);
            PG8_BAR; PG8_WAIT_L(0); PG8_MMA(0, 1, At, B1); PG8_BAR;
            PG8_LDA(At, 0, 1); PG8_STAGE(PG8_SA(0, 0), a2, voffA);
            PG8_BAR; PG8_WAIT_L(0); PG8_MMA(1, 0, At, B0); PG8_BAR; PG8_SCHED;
            PG8_STAGE(PG8_SB(0, 1), b2 + hstep, voffB);
            PG8_WAIT_V(6); PG8_BAR; PG8_MMA(1, 1, At, B1); PG8_BAR;
            PG8_LDB(B0, 1, 0); PG8_SCHED; PG8_LDA(At, 1, 0); PG8_STAGE(PG8_SA(0, 1), a2 + hstep, voffA);
            PG8_WAIT_L(8); PG8_BAR; PG8_WAIT_L(0); PG8_MMA(0, 0, At, B0); PG8_BAR; PG8_SCHED;
            PG8_LDB(B1, 1, 1); PG8_STAGE(PG8_SB(1, 0), b3, voffB);
            PG8_BAR; PG8_WAIT_L(0); PG8_MMA(0, 1, At, B1); PG8_BAR;
            PG8_LDA(At, 1, 1); PG8_STAGE(PG8_SA(1, 0), a3, voffA);
            PG8_BAR; PG8_WAIT_L(0); PG8_MMA(1, 0, At, B0); PG8_BAR; PG8_SCHED;
            PG8_STAGE(PG8_SB(1, 1), b3 + hstep, voffB);
            PG8_WAIT_V(6); PG8_BAR; PG8_MMA(1, 1, At, B1); PG8_BAR;
        }
        E(acc, cur, wr, wc, fr, fq);
        if (!has_next) break;
#pragma unroll
        for (int a = 0; a < 2; ++a)
#pragma unroll
            for (int b = 0; b < 2; ++b)
#pragma unroll
                for (int m = 0; m < 4; ++m)
#pragma unroll
                    for (int n = 0; n < 2; ++n) acc[a][b][m][n] = (f32x4){0.f, 0.f, 0.f, 0.f};
        cur = nxt; cA = nA; cB = nB; ++ui;
    }
    PG8_WAIT_V(0);
    if (wr == 0) PG8_BAR;
    PG8_BAR;
#undef PG8_SA
#undef PG8_SB
#undef PG8_STAGE
#undef PG8_LDA
#undef PG8_LDB
#undef PG8_MMA
#undef PG8_WAIT_V
#undef PG8_WAIT_L
#undef PG8_BAR
#undef PG8_SCHED
}
}


#define XB_TMO      128
#define XB_XCNT(j)  (256  + 64 * (j))
#define XB_XSUB(j)  (1280 + 64 * (j))
#define XB_XGEN(j)  (2304 + 64 * (j))
#define XB_TOP      3328
#define XB_TOPGEN   3392
#define XCD_BAR_WORDS 3456
#define XB_SPIN_CAP (1u << 18)
__device__ __forceinline__ unsigned xb_ld(unsigned* p)              { return __hip_atomic_load(p, __ATOMIC_RELAXED, __HIP_MEMORY_SCOPE_AGENT); }
__device__ __forceinline__ unsigned xb_add(unsigned* p, unsigned v) { return __hip_atomic_fetch_add(p, v, __ATOMIC_RELAXED, __HIP_MEMORY_SCOPE_AGENT); }
__device__ __forceinline__ unsigned xb_xcc_id() { return (unsigned)__builtin_amdgcn_s_getreg((3 << 11) | 20) & 0xFu; }
#define XB_SPIN(cond, bar) do { unsigned _sp = 0; while (cond) { __builtin_amdgcn_s_sleep(1); \
    if ((++_sp & 255u) == 0u) { if (xb_ld(&(bar)[XB_TMO])) break; if (_sp > XB_SPIN_CAP) { atomicAdd(&(bar)[XB_TMO], 1u); break; } } } } while (0)
struct XcdBarrier { unsigned* bar; unsigned x; volatile LAS unsigned* st; };
__device__ __forceinline__ XcdBarrier xcd_barrier_post(unsigned* bar, volatile LAS unsigned* st) {
    XcdBarrier b; b.bar = bar; b.x = xb_xcc_id(); b.st = st;
    if (threadIdx.x == 0) (void)xb_add(&bar[XB_XCNT(b.x)], 1u);
    return b;
}
__device__ __forceinline__ void xcd_barrier_complete(unsigned* bar, unsigned x, unsigned& nloc, unsigned& nx) {
    const unsigned G = gridDim.x * gridDim.y * gridDim.z;
    unsigned sum, cnt, mine, sp = 0u;
    for (;;) {
        sum = 0u; cnt = 0u; mine = 0u;
#pragma unroll
        for (unsigned j = 0; j < 16; ++j) { const unsigned c = xb_ld(&bar[XB_XCNT(j)]); sum += c; cnt += (c > 0u) ? 1u : 0u; mine = (j == x) ? c : mine; }
        if (sum == G) break;
        __builtin_amdgcn_s_sleep(1);
        if ((++sp & 255u) == 0u) { if (xb_ld(&bar[XB_TMO])) break; if (sp > XB_SPIN_CAP) { atomicAdd(&bar[XB_TMO], 1u); break; } }
    }
    nloc = mine > 0u ? mine : 1u; nx = cnt > 0u ? cnt : 1u;
}
__device__ __forceinline__ void xcd_barrier(const XcdBarrier& b, const int wv0) {
    asm volatile("s_waitcnt vmcnt(0)" ::: "memory");
    __syncthreads();
    if (opaque_tid(wv0) == 0) {
        unsigned* bar = b.bar;
        __builtin_amdgcn_s_waitcnt(0);
        unsigned nloc = b.st[0], nx = b.st[1];
        if (nloc == 0u) { xcd_barrier_complete(bar, b.x, nloc, nx); b.st[0] = nloc; b.st[1] = nx; }
        const unsigned old = xb_add(&bar[XB_XSUB(b.x)], 1u);
        const unsigned gen = old / nloc;
        if (old + 1u == (gen + 1u) * nloc) {
            __builtin_amdgcn_fence(__ATOMIC_RELEASE, "agent");
            asm volatile("s_waitcnt vmcnt(0)" ::: "memory");
            const unsigned og = xb_add(&bar[XB_TOP], 1u);
            const unsigned tg = og / nx;
            if (og + 1u == (tg + 1u) * nx) xb_add(&bar[XB_TOPGEN], 1u);
            else XB_SPIN(xb_ld(&bar[XB_TOPGEN]) == tg, bar);
            __builtin_amdgcn_fence(__ATOMIC_ACQUIRE, "agent");
            xb_add(&bar[XB_XGEN(b.x)], 1u);
            asm volatile("s_waitcnt vmcnt(0)" ::: "memory");
        } else {
            XB_SPIN(xb_ld(&bar[XB_XGEN(b.x)]) == gen, bar);
            __builtin_amdgcn_fence(__ATOMIC_ACQUIRE, "agent");
            asm volatile("s_waitcnt vmcnt(0)" ::: "memory");
        }
    }
    __syncthreads();
}

struct Frame {
    LAS unsigned char* lds;
    int vcu, G, wv;
    const float* const* in; float* out; unsigned char* ws;
    __device__ __forceinline__ float* MOD() const { return (float*)(ws + WS_MOD); }
    __device__ __forceinline__ float* ROPE() const { return (float*)(ws + WS_ROPE); }
    __device__ __forceinline__ float* BA() const { return (float*)(ws + WS_BA); }
    __device__ __forceinline__ float* LAG() const { return (float*)(ws + WS_LAG); }
    __device__ __forceinline__ bf16_t* W1O() const { return (bf16_t*)(ws + WS_W1O); }
    __device__ __forceinline__ bf16_t* U0() const { return (bf16_t*)(ws + WS_RA); }
    __device__ __forceinline__ bf16_t* QKV1() const { return (bf16_t*)(ws + WS_RA); }
    __device__ __forceinline__ bf16_t* Z1() const { return (bf16_t*)(ws + WS_RA + (size_t)MT * 3072 * 2); }
    __device__ __forceinline__ bf16_t* Y1() const { return (bf16_t*)(ws + WS_RA + (size_t)MT * 3072 * 2); }
    __device__ __forceinline__ bf16_t* XN() const { return (bf16_t*)(ws + WS_RB + RB_XN); }
    __device__ __forceinline__ bf16_t* Y0() const { return (bf16_t*)(ws + WS_RB + RB_Y0); }
    __device__ __forceinline__ bf16_t* YO() const { return (bf16_t*)(ws + WS_RB + RB_YO); }
    __device__ __forceinline__ bf16_t* W0I() const { return (bf16_t*)(ws + WS_RB + RB_W0I); }
    __device__ __forceinline__ bf16_t* W0O() const { return (bf16_t*)(ws + WS_RB + RB_W0O); }
    __device__ __forceinline__ bf16_t* W1I() const { return (bf16_t*)(ws + WS_RB + RB_W1I); }
    __device__ __forceinline__ bf16_t* QKVC() const { return (bf16_t*)(ws + WS_RB); }
};

#define PHASE_IDS() int tid = opaque_tid(F.wv); const int lane = tid & 63, wave = __builtin_amdgcn_readfirstlane(tid >> 6); (void)lane; (void)wave
__device__ __forceinline__ void p0_transpose_item(const float* W, int ldw, int nblk, int K, bf16_t* WT, LAS float* scr, int item, int lane) {
    const int kb = item / nblk, nb = item % nblk, k0 = 64 * kb, n0 = 32 * nb;
#pragma unroll 8
    for (int i = 0; i < 32; ++i) { const int kk = 2 * i + (lane >> 5); scr[kk * 33 + (lane & 31)] = W[(size_t)(k0 + kk) * ldw + n0 + (lane & 31)]; }
    asm volatile("s_waitcnt lgkmcnt(0)" ::: "memory");
    const int c = lane & 7;
#pragma unroll
    for (int j = 0; j < 4; ++j) { const int n = (lane >> 3) + 8 * j; const LAS float* s = scr + (8 * c) * 33 + n;
        u32x4 o; o.x = pk2(s[0 * 33], s[1 * 33]); o.y = pk2(s[2 * 33], s[3 * 33]); o.z = pk2(s[4 * 33], s[5 * 33]); o.w = pk2(s[6 * 33], s[7 * 33]);
        *(u32x4*)(WT + (size_t)(n0 + n) * K + k0 + 8 * c) = o; }
    asm volatile("s_waitcnt lgkmcnt(0)" ::: "memory");
}
__device__ __forceinline__ void phase_prologue(Frame& F) {
    PHASE_IDS();
    const int gw = F.vcu * 8 + wave, NGW = F.G * 8;
    {
        LAS float* scr = (LAS float*)(F.lds + wave * 16384);
        constexpr int I0 = 16 * (EV_IN / 32), I1 = 16 * 32, I2 = 16 * (OD_MAIN / 32), I3 = 16 * 32;
        for (int it = gw; it < I0 + I1 + I2 + I3; it += NGW) {
            int r = it;
            if (r < I0) { p0_transpose_item(F.in[14], EV_IN, EV_IN / 32, D, F.W0I(), scr, r, lane); continue; } r -= I0;
            if (r < I1) { p0_transpose_item(F.in[23], D, 32, D, F.W0O(), scr, r, lane); continue; } r -= I1;
            if (r < I2) { p0_transpose_item(F.in[28], OD_IN, OD_MAIN / 32, D, F.W1I(), scr, r, lane); continue; } r -= I2;
            p0_transpose_item(F.in[33], D, 32, D, F.W1O(), scr, r, lane);
        }
    }
    {
        const double inv[8] = {1.0, 0.19392274474868576, 0.03760603093086393, 0.007292664737217109, 0.001414213562373095, 0.0002742481756762073, 5.318295896944988e-05, 1.031338537721246e-05};
        for (int idx = F.vcu * 512 + tid; idx < 4112 * 8; idx += F.G * 512) {
            const int pos = idx >> 3, i = idx & 7;
            double iv = inv[0];
#pragma unroll
            for (int q = 1; q < 8; ++q) iv = (i == q) ? inv[q] : iv;
            const double ang = (double)pos * iv;
            const double n = __builtin_rint(ang * 0.15915494309189535);
            const float r = (float)__builtin_fma(-n, 6.283185307179586, ang);
            F.ROPE()[pos * 16 + i] = __cosf(r); F.ROPE()[pos * 16 + 8 + i] = __sinf(r);
        }
    }
    {
        bf16_t* LGW = (bf16_t*)(F.ws + WS_LGW);
        for (int idx = F.vcu * 512 + tid; idx < 8 * 2 * 64 * 64; idx += F.G * 512) { const int k = idx & 63, n = (idx >> 6) & 63, gate = (idx >> 12) & 1, hh = idx >> 13;
            LGW[idx] = (bf16_t)f2bf((gate ? F.in[19] : F.in[17])[(hh * 64 + k) * 64 + n]); }
    }
    __syncthreads();
    for (int bt = F.vcu; bt < 96; bt += F.G) {
        LAS float* tab = (LAS float*)F.lds;
        for (int idx = tid; idx < 24 * 1024; idx += 512) { const int s = idx >> 10, k = idx & 1023;
            const float c = s < BP ? F.in[8][s * D + k] : F.in[9][(s - BP) * D + k]; tab[k * 24 + s] = siluf_(c); }
        __syncthreads();
        const int L = bt / 48, n0 = (bt % 48) * 64;
        const float* mw = (L == 0 ? F.in[10] : F.in[24]) + n0 + lane;
        float acc[24];
#pragma unroll
        for (int r = 0; r < 24; ++r) acc[r] = 0.f;
        for (int k0 = wave * 128; k0 < wave * 128 + 128; k0 += 16) {
            float wv[16];
#pragma unroll
            for (int u = 0; u < 16; ++u) wv[u] = mw[(size_t)(k0 + u) * 3072];
#pragma unroll
            for (int u = 0; u < 16; ++u) { const float w = wv[u];
                const LAS f32x4* tp = (const LAS f32x4*)(tab + (k0 + u) * 24);
#pragma unroll
                for (int q = 0; q < 6; ++q) { const f32x4 t4 = tp[q]; acc[4 * q] += t4[0] * w; acc[4 * q + 1] += t4[1] * w; acc[4 * q + 2] += t4[2] * w; acc[4 * q + 3] += t4[3] * w; } }
        }
        __syncthreads();
        LAS float* red = (LAS float*)F.lds;
#pragma unroll
        for (int r = 0; r < 24; ++r) red[(wave * 24 + r) * 64 + lane] = acc[r];
        __syncthreads();
        const float* mb = (L == 0 ? F.in[11] : F.in[25]);
        for (int idx = tid; idx < 24 * 64; idx += 512) { const int r = idx >> 6, l = idx & 63; float s = 0.f;
#pragma unroll
            for (int w = 0; w < 8; ++w) s += red[(w * 24 + r) * 64 + l];
            F.MOD()[((size_t)L * 24 + r) * 3072 + n0 + l] = s + mb[n0 + l]; }
        __syncthreads();
    }
}

__device__ __forceinline__ const float* x_row(Frame& F, int m) { return m < MP ? F.in[0] + (size_t)m * D : F.in[1] + (size_t)(m - MP) * D; }
__device__ __forceinline__ void rows_prenorm0(Frame& F, const int m0, const int n, const int s, const int lane) {
    const float* modr = F.MOD() + (size_t)s * 3072;
    f32x4 A[4], C[4];
#pragma unroll
    for (int j = 0; j < 4; ++j) { const int c = 4 * lane + 256 * j; const f32x4 g = *(const f32x4*)(F.in[12] + c), sc = *(const f32x4*)(modr + 1024 + c); C[j] = *(const f32x4*)(modr + c);
#pragma unroll
        for (int e = 0; e < 4; ++e) A[j][e] = g[e] * (1.f + sc[e]); }
    f32x4 cur[4];
#pragma unroll
    for (int j = 0; j < 4; ++j) cur[j] = *(const f32x4*)(x_row(F, m0) + 4 * lane + 256 * j);
    for (int i = 0; i < n; ++i) {
        const int mn = m0 + (i + 1 < n ? i + 1 : i); f32x4 nxt[4];
#pragma unroll
        for (int j = 0; j < 4; ++j) nxt[j] = *(const f32x4*)(x_row(F, mn) + 4 * lane + 256 * j);
        float ss = 0.f;
#pragma unroll
        for (int j = 0; j < 4; ++j) ss += (cur[j][0] * cur[j][0] + cur[j][1] * cur[j][1]) + (cur[j][2] * cur[j][2] + cur[j][3] * cur[j][3]);
        const float r = rsqrtf(wave_sum(ss, lane) * (1.f / D) + EPS);
#pragma unroll
        for (int j = 0; j < 4; ++j) { u32x2 w; w[0] = cvt2(cur[j][0] * r * A[j][0] + C[j][0], cur[j][1] * r * A[j][1] + C[j][1]); w[1] = cvt2(cur[j][2] * r * A[j][2] + C[j][2], cur[j][3] * r * A[j][3] + C[j][3]);
            *(u32x2*)(F.XN() + (size_t)(m0 + i) * D + 4 * lane + 256 * j) = w; }
#pragma unroll
        for (int j = 0; j < 4; ++j) cur[j] = nxt[j];
    }
}
__device__ __forceinline__ void phase_prenorm0(Frame& F) {
    PHASE_IDS();
    const int gw = F.vcu * 8 + wave, NGW = F.G * 8;
    for (int w = gw; w < MP / 16; w += NGW) rows_prenorm0(F, w * 16, 16, w >> 8, lane);
    for (int w = gw; w < MS; w += NGW) rows_prenorm0(F, MP + w, 1, BP + (w >> 4), lane);
}

__device__ __forceinline__ void phase_rope(Frame& F) {
    PHASE_IDS();
    const int gt = F.vcu * 512 + tid, NT = F.G * 512;
    for (int idx = gt; idx < MT * 80; idx += NT) {
        const int m = idx / 80, r = idx % 80, slot = r >> 3, i = r & 7;
        int s, t; tok_info(m, s, t);
        const int pos = s < BP ? t : TP + t;
        const int col = slot < 8 ? C_Q + slot * 64 : C_K + (slot - 8) * 64;
        bf16_t* p = F.U0() + (size_t)m * EV_IN + col;
        const float x1 = bf2f(p[i]), x2 = bf2f(p[8 + i]), c = F.ROPE()[pos * 16 + i], sn = F.ROPE()[pos * 16 + 8 + i];
        const float o1 = x1 * c - x2 * sn, o2 = x2 * c + x1 * sn;
        p[i] = (bf16_t)f2bf(o1); p[8 + i] = (bf16_t)f2bf(o2);
        if (slot >= 8) { const int kv = slot - 8;
            if (s >= BP) { float* o = F.out + O_KS + ((size_t)((s - BP) * TS + t) * 2 + kv) * 64; o[i] = o1; o[8 + i] = o2; }
            else if (t >= TP - 128) { float* o = F.out + O_KP + ((size_t)(s * 128 + (t - (TP - 128))) * 2 + kv) * 64; o[i] = o1; o[8 + i] = o2; } }
    }
    for (int idx = gt; idx < 1280 * 224; idx += NT) {
        const int tk = idx / 224, e = idx % 224;
        int s, t, m; if (tk < 1024) { s = tk >> 7; t = TP - 128 + (tk & 127); m = s * TP + t; } else { s = BP + ((tk - 1024) >> 4); t = (tk - 1024) & 15; m = MP + (tk - 1024); }
        const bool isv = e >= 96; const int e2 = isv ? e - 96 : e; const int kv = isv ? (e2 >> 6) : (e2 / 48), d = isv ? (e2 & 63) : 16 + (e2 % 48);
        const float val = bf2f(F.U0()[(size_t)m * EV_IN + (isv ? C_V : C_K) + kv * 64 + d]);
        const size_t ob = s >= BP ? (isv ? O_VS : O_KS) + ((size_t)((s - BP) * TS + t) * 2 + kv) * 64 : (isv ? O_VP : O_KP) + ((size_t)(s * 128 + (t - (TP - 128))) * 2 + kv) * 64;
        F.out[ob + d] = val;
    }
}


__device__ __forceinline__ void rows_mid(Frame& F, LAS float* baw, const int m0, const int n, const int s, const int lane) {
    const float* mod0 = F.MOD() + (size_t)s * 3072; const float* mod1 = F.MOD() + (size_t)(24 + s) * 3072;
    f32x4 A0[4], B1[4], C1[4];
#pragma unroll
    for (int j = 0; j < 4; ++j) { const int c = 4 * lane + 256 * j; const f32x4 g0 = *(const f32x4*)(F.in[13] + c), gt = *(const f32x4*)(mod0 + 2048 + c), g1 = *(const f32x4*)(F.in[26] + c), sc = *(const f32x4*)(mod1 + 1024 + c);
        C1[j] = *(const f32x4*)(mod1 + c);
#pragma unroll
        for (int e = 0; e < 4; ++e) { A0[j][e] = gt[e] * g0[e]; B1[j][e] = g1[e] * (1.f + sc[e]); } }
    u32x2 ycur[4]; f32x4 xcur[4];
#pragma unroll
    for (int j = 0; j < 4; ++j) { ycur[j] = *(const u32x2*)(F.YO() + (size_t)m0 * D + 4 * lane + 256 * j); xcur[j] = *(const f32x4*)(x_row(F, m0) + 4 * lane + 256 * j); }
    for (int i = 0; i < n; ++i) {
        const int m = m0 + i, mn = m0 + (i + 1 < n ? i + 1 : i); u32x2 ynxt[4]; f32x4 xnxt[4];
#pragma unroll
        for (int j = 0; j < 4; ++j) { ynxt[j] = *(const u32x2*)(F.YO() + (size_t)mn * D + 4 * lane + 256 * j); xnxt[j] = *(const f32x4*)(x_row(F, mn) + 4 * lane + 256 * j); }
        f32x4 y[4]; float ss = 0.f;
#pragma unroll
        for (int j = 0; j < 4; ++j) { y[j] = (f32x4){lo16(ycur[j][0]), hi16(ycur[j][0]), lo16(ycur[j][1]), hi16(ycur[j][1])}; ss += (y[j][0] * y[j][0] + y[j][1] * y[j][1]) + (y[j][2] * y[j][2] + y[j][3] * y[j][3]); }
        const float r1 = rsqrtf(wave_sum(ss, lane) * (1.f / D) + EPS);
        f32x4 x1[4]; float s2 = 0.f;
#pragma unroll
        for (int j = 0; j < 4; ++j) {
#pragma unroll
            for (int e = 0; e < 4; ++e) x1[j][e] = xcur[j][e] + A0[j][e] * (y[j][e] * r1);
            *(f32x4*)(F.out + O_Y + (size_t)m * D + 4 * lane + 256 * j) = x1[j];
            s2 += (x1[j][0] * x1[j][0] + x1[j][1] * x1[j][1]) + (x1[j][2] * x1[j][2] + x1[j][3] * x1[j][3]); }
        const float r2 = rsqrtf(wave_sum(s2, lane) * (1.f / D) + EPS);
        f32x4 hm[4];
#pragma unroll
        for (int j = 0; j < 4; ++j) {
#pragma unroll
            for (int e = 0; e < 4; ++e) hm[j][e] = x1[j][e] * r2 * B1[j][e] + C1[j][e];
            u32x2 w; w[0] = cvt2(hm[j][0], hm[j][1]); w[1] = cvt2(hm[j][2], hm[j][3]); *(u32x2*)(F.XN() + (size_t)m * D + 4 * lane + 256 * j) = w; }
        float p[16];
#pragma unroll
        for (int q = 0; q < 16; ++q) { p[q] = 0.f;
#pragma unroll
            for (int j = 0; j < 4; ++j) { const f32x4 w = *(const LAS f32x4*)(baw + q * 1024 + 256 * j + 4 * lane); p[q] += (hm[j][0] * w[0] + hm[j][1] * w[1]) + (hm[j][2] * w[2] + hm[j][3] * w[3]); }
            if ((q & 3) == 3) __builtin_amdgcn_sched_barrier(0); }
        { const bool u5 = (lane & 32) != 0;
#pragma unroll
          for (int q = 0; q < 8; ++q) { const float keep = u5 ? p[8 + q] : p[q], send = u5 ? p[q] : p[8 + q]; p[q] = keep + shfl_xor_l(send, 32, lane); } }
        { const bool u4 = (lane & 16) != 0;
#pragma unroll
          for (int q = 0; q < 4; ++q) { const float keep = u4 ? p[4 + q] : p[q], send = u4 ? p[q] : p[4 + q]; p[q] = keep + shfl_xor_l(send, 16, lane); } }
        { const bool u3 = (lane & 8) != 0;
#pragma unroll
          for (int q = 0; q < 2; ++q) { const float keep = u3 ? p[2 + q] : p[q], send = u3 ? p[q] : p[2 + q]; p[q] = keep + shfl_xor_l(send, 8, lane); } }
        { const bool u2 = (lane & 4) != 0; const float keep = u2 ? p[1] : p[0], send = u2 ? p[0] : p[1]; p[0] = keep + shfl_xor_l(send, 4, lane); }
        float mine = p[0]; mine += shfl_xor_l(mine, 2, lane); mine += shfl_xor_l(mine, 1, lane);
        if ((lane & 3) == 0) { const int col = lane >> 2, hh = col & 7;
            F.BA()[(size_t)m * 16 + col] = col < 8 ? sigmoidf_(mine) : -__expf(F.in[30][hh]) * softplusf_(mine + F.in[31][hh]); }
#pragma unroll
        for (int j = 0; j < 4; ++j) { ycur[j] = ynxt[j]; xcur[j] = xnxt[j]; }
    }
}
__device__ __forceinline__ void phase_mid_rowwise(Frame& F) {
    PHASE_IDS();
    LAS float* baw = (LAS float*)F.lds;
    for (int idx = tid; idx < 16 * 1024; idx += 512) { const int j = idx & 15, k = idx >> 4; baw[j * 1024 + k] = F.in[28][(size_t)k * OD_IN + OD_MAIN + j]; }
    __syncthreads();
    const int gw = F.vcu * 8 + wave, NGW = F.G * 8;
    for (int w = gw; w < MP / 16; w += NGW) rows_mid(F, baw, w * 16, 16, w >> 8, lane);
    for (int w = gw; w < MS; w += NGW) rows_mid(F, baw, MP + w, 1, BP + (w >> 4), lane);
}


typedef float f32x16 __attribute__((ext_vector_type(16)));
constexpr int GS_WF = 0, GS_QF = 16384, GS_KF = 32768, GS_PF = 49152, GS_UF = 57344, GS_BYTES = 73728;
constexpr size_t WS_DEC = 11 * MiB;
__device__ __forceinline__ int krow(int s, int h, int j) { return 16 * s + 8 * (j >> 2) + 4 * h + (j & 3); }
#define MFMA32(a, b, c) __builtin_amdgcn_mfma_f32_32x32x16_bf16((a), (b), (c), 0, 0, 0)
#define MFMA16(a, b, c) __builtin_amdgcn_mfma_f32_16x16x32_bf16((a), (b), (c), 0, 0, 0)

typedef __amdgpu_buffer_rsrc_t brsrc_t;
__device__ __forceinline__ brsrc_t staging_rsrc(unsigned char* ws) { return __builtin_amdgcn_make_buffer_rsrc((void*)(ws + WS_RB), (short)0, (int)RB_BYTES, 0x00020000); }
__device__ __forceinline__ void st16_wt(brsrc_t r, unsigned off, u32x4 v) { __builtin_amdgcn_raw_buffer_store_b128(v, r, off, 0, 16); }
__device__ __forceinline__ u32x4 ld16_wt(brsrc_t r, unsigned off) { return __builtin_amdgcn_raw_buffer_load_b128(r, off, 0, 16); }
__device__ __forceinline__ void st8_wt(unsigned char* p, u32x2 v) { __hip_atomic_store((unsigned long long*)p, ((unsigned long long)v[1] << 32) | v[0], __ATOMIC_RELAXED, __HIP_MEMORY_SCOPE_AGENT); }
constexpr size_t WS_READY = 65536;
#define LDS_BARRIER() do { asm volatile("s_waitcnt lgkmcnt(0)" ::: "memory"); __builtin_amdgcn_s_barrier(); asm volatile("" ::: "memory"); } while (0)
constexpr int G1_QS = 0, G1_KS = 17408, G1_VS = 34816, G1_AS = 52224, G1_PS = 69632, G1_WS = 78848, G1_CW = 96256, G1_VEC = 102400, G1_ES = 103424;
__device__ __forceinline__ void g1_load_raw(Frame& F, u32x4 (&raw)[24], int s, int c, int h, int t1) {
    const int r = t1 >> 3, j = t1 & 7, t = c * 64 + r;
#pragma unroll
    for (int p = 0; p < 3; ++p)
#pragma unroll
        for (int jj = 0; jj < 4; ++jj) { const int tt = t - 3 + jj, ttc = tt < 0 ? 0 : tt;
            const u32x4* src = (const u32x4*)(F.QKV1() + (size_t)(s * TP + ttc) * 3072 + p * 1024 + h * 128 + j * 16); raw[p * 8 + jj * 2] = src[0]; raw[p * 8 + jj * 2 + 1] = src[1]; }
}
__device__ __forceinline__ bf16x8 g1_pack_b(const f32x4 p, const f32x4 q) { u32x4 w; w[0] = cvt2(p[0], p[1]); w[1] = cvt2(p[2], p[3]); w[2] = cvt2(q[0], q[1]); w[3] = cvt2(q[2], q[3]); return __builtin_bit_cast(bf16x8, w); }
__device__ __forceinline__ void g1_decode(int n, int& s, int& c, int& h) { if (n < 4096) { c = n >> 6; s = (n & 63) >> 3; h = n & 7; } else { s = BP + ((n - 4096) >> 3); c = 0; h = n & 7; } }
__device__ __forceinline__ void gdn_g1_tasks(Frame& F, const int first, const int stride) {
    int tid = opaque_tid(F.wv);
    const int lane = tid & 63, wave = __builtin_amdgcn_readfirstlane(tid >> 6);
    LAS unsigned char* L = F.lds;
    LAS float* cw_s = (LAS float*)(L + G1_CW);
    LAS float* beta_s = (LAS float*)(L + G1_VEC); LAS float* gcum_s = beta_s + 64; LAS float* eg_s = beta_s + 128; LAS float* ek_s = beta_s + 192;
    float* DEC = (float*)(F.ws + WS_DEC);
    u32x4 raw[24];
    float pcw[3], pb = 0.f, pa = 0.f;
    const brsrc_t srs = staging_rsrc(F.ws);
    unsigned* ready = (unsigned*)(F.ws + WS_READY);
    { int s0, c0, h0; g1_decode(first < 4095 ? first : 4095, s0, c0, h0); g1_load_raw(F, raw, s0, c0, h0, tid);
#pragma unroll
        for (int q = 0; q < 3; ++q) { const int i = tid + 512 * q, jj = i / 384, cc = i % 384; pcw[q] = F.in[29][(size_t)jj * 3072 + (cc >> 7) * 1024 + h0 * 128 + (cc & 127)]; }
        const float* ba = F.BA() + (size_t)(s0 * TP + c0 * 64 + (tid & 63)) * 16; pb = ba[h0]; pa = ba[8 + h0]; }
    for (int task = first; task < 4224; task += stride) {
        const int tid = opaque_tid(F.wv), lane = tid & 63;
        int s, c, h; g1_decode(task, s, c, h);
        const int nvalid = s < BP ? 64 : TS, t0 = c * 64, base = seq_base(s), T = seq_len(s);
        const int sidx = task < 4096 ? ((s * 8 + h) * 64 + c) : task;
        unsigned char* blk = F.ws + WS_RB + (size_t)sidx * GS_BYTES; const unsigned boff = (unsigned)sidx * (unsigned)GS_BYTES;
        if (s < BP) {
#pragma unroll
            for (int q = 0; q < 3; ++q) cw_s[tid + 512 * q] = pcw[q];
        } else for (int i = tid; i < 4 * 384; i += 512) { const int jj = i / 384, cc = i % 384; cw_s[i] = F.in[29][(size_t)jj * 3072 + (cc >> 7) * 1024 + h * 128 + (cc & 127)]; }
        if (tid < 64) {
            const bool ok = tid < nvalid; float beta = 0.f, g = 0.f;
            if (ok) { float vb = pb, va = pa; if (s >= BP) { const float* ba = F.BA() + (size_t)(base + t0 + tid) * 16; vb = ba[h]; va = ba[8 + h]; }
                beta = vb; g = va; }
            float x = g;
#pragma unroll
            for (int o = 1; o < 64; o <<= 1) { const float y = shfl_idx(x, lane >= o ? lane - o : lane); if (lane >= o) x += y; }
            const float gl = shfl_idx(x, 63);
            beta_s[tid] = beta; gcum_s[tid] = x; eg_s[tid] = __expf(x); ek_s[tid] = ok ? __expf(gl - x) : 0.f;
            if (tid == 0) __hip_atomic_store((unsigned*)DEC + sidx, __float_as_uint(__expf(gl)), __ATOMIC_RELAXED, __HIP_MEMORY_SCOPE_AGENT);
        }
        LDS_BARRIER();
        {
            int t1 = tid; asm volatile("" : "+v"(t1));
            const int r = t1 >> 3, j = t1 & 7, t = t0 + r; const bool ok = r < nvalid;
#pragma unroll
            for (int p = 0; p < 3; ++p) {
                float acc[16], cur[16];
#pragma unroll
                for (int e = 0; e < 16; ++e) { acc[e] = 0.f; cur[e] = 0.f; }
                const int cb = p * 1024 + h * 128 + j * 16;
#pragma unroll
                for (int jj = 0; jj < 4; ++jj) {
                    const int tt = t - 3 + jj; float x[16];
                    if (s < BP) { const u32x4 a = raw[p * 8 + jj * 2], b = raw[p * 8 + jj * 2 + 1]; const bool v = tt >= 0;
#pragma unroll
                        for (int e = 0; e < 4; ++e) { x[2 * e] = v ? lo16(a[e]) : 0.f; x[2 * e + 1] = v ? hi16(a[e]) : 0.f; x[8 + 2 * e] = v ? lo16(b[e]) : 0.f; x[8 + 2 * e + 1] = v ? hi16(b[e]) : 0.f; } }
                    else if (ok && tt >= 0) { const u32x4* src = (const u32x4*)(F.QKV1() + (size_t)(base + tt) * 3072 + cb); const u32x4 a = src[0], b = src[1];
#pragma unroll
                        for (int e = 0; e < 4; ++e) { x[2 * e] = lo16(a[e]); x[2 * e + 1] = hi16(a[e]); x[8 + 2 * e] = lo16(b[e]); x[8 + 2 * e + 1] = hi16(b[e]); } }
                    else if (ok) { const f32x4* src = (const f32x4*)(F.in[6] + ((size_t)(s - BP) * 3 + (tt + 3)) * 3072 + cb);
#pragma unroll
                        for (int q = 0; q < 4; ++q) { const f32x4 a = src[q]; x[4 * q] = a[0]; x[4 * q + 1] = a[1]; x[4 * q + 2] = a[2]; x[4 * q + 3] = a[3]; } }
                    else {
#pragma unroll
                        for (int e = 0; e < 16; ++e) x[e] = 0.f; }
                    const LAS f32x4* wp = (const LAS f32x4*)(cw_s + jj * 384 + p * 128 + j * 16);
#pragma unroll
                    for (int q = 0; q < 4; ++q) { const f32x4 w4 = wp[q]; acc[4 * q] += w4[0] * x[4 * q]; acc[4 * q + 1] += w4[1] * x[4 * q + 1]; acc[4 * q + 2] += w4[2] * x[4 * q + 2]; acc[4 * q + 3] += w4[3] * x[4 * q + 3]; }
                    if (jj == 3) {
#pragma unroll
                        for (int e = 0; e < 16; ++e) cur[e] = x[e]; }
                }
                if (ok && t >= T - 3) {
                    float* o = (s < BP ? F.out + O_GCP + ((size_t)s * 3 + (t - (T - 3))) * 3072 : F.out + O_GCS + ((size_t)(s - BP) * 3 + (t - (T - 3))) * 3072) + cb;
#pragma unroll
                    for (int q = 0; q < 4; ++q) *(f32x4*)(o + 4 * q) = (f32x4){cur[4 * q], cur[4 * q + 1], cur[4 * q + 2], cur[4 * q + 3]};
                }
                float ss = 0.f;
#pragma unroll
                for (int e = 0; e < 16; ++e) { acc[e] = siluf_(acc[e]); ss += acc[e] * acc[e]; }
                if (p < 2) { ss += shfl_xor_l(ss, 1, lane); ss += shfl_xor_l(ss, 2, lane); ss += shfl_xor_l(ss, 4, lane);
                    float sc = rsqrtf(ss + EPS); if (p == 0) sc *= 0.08838834764831845f;
#pragma unroll
                    for (int e = 0; e < 16; ++e) acc[e] *= sc; }
                u32x4 w0, w1;
#pragma unroll
                for (int e = 0; e < 4; ++e) { w0[e] = ok ? cvt2(acc[2 * e], acc[2 * e + 1]) : 0u; w1[e] = ok ? cvt2(acc[8 + 2 * e], acc[8 + 2 * e + 1]) : 0u; }
                LAS u32x4* dst = (LAS u32x4*)(L + (p == 0 ? G1_QS : p == 1 ? G1_KS : G1_VS) + r * 272 + j * 32);
                dst[0] = w0; dst[1] = w1;
                __builtin_amdgcn_sched_barrier(0);
            }
            { const int ntk = task + stride < 4095 ? task + stride : 4095; int s1, c1, h1; g1_decode(ntk, s1, c1, h1); g1_load_raw(F, raw, s1, c1, h1, t1);
#pragma unroll
              for (int q = 0; q < 3; ++q) { const int i = t1 + 512 * q, jj = i / 384, cc = i % 384; pcw[q] = F.in[29][(size_t)jj * 3072 + (cc >> 7) * 1024 + h1 * 128 + (cc & 127)]; }
              const float* ba = F.BA() + (size_t)(s1 * TP + c1 * 64 + (t1 & 63)) * 16; pb = ba[h1]; pa = ba[8 + h1]; }
        }
        LDS_BARRIER();
        {
            int l2 = lane; asm volatile("" : "+v"(l2));
            const int which = wave >> 2, ti = (wave >> 1) & 1, tj = wave & 1, r = l2 & 31, hh = l2 >> 5;
            f32x16 acc;
#pragma unroll
            for (int e = 0; e < 16; ++e) acc[e] = 0.f;
            if (!(ti == 0 && tj == 1)) {
                const LAS unsigned char* ap = L + (which ? G1_QS : G1_KS) + (32 * ti + r) * 272 + hh * 16;
                const LAS unsigned char* bp = L + G1_KS + (32 * tj + r) * 272 + hh * 16;
#pragma unroll
                for (int ks = 0; ks < 8; ++ks) { const bf16x8 a = *(const LAS bf16x8*)(ap + ks * 32), b = *(const LAS bf16x8*)(bp + ks * 32); acc = MFMA32(a, b, acc); }
            }
            const int jc = 32 * tj + r; const float gj = gcum_s[jc];
#pragma unroll
            for (int e = 0; e < 16; ++e) {
                const int i = 32 * ti + (e & 3) + 8 * (e >> 2) + 4 * hh; const float dg = gcum_s[i] - gj;
                if (which == 0) { const float f = (i > jc) ? __expf(dg) * beta_s[i] : 0.f; *(LAS float*)(L + G1_AS + i * 272 + jc * 4) = acc[e] * f; }
                else { const float f = (i >= jc) ? __expf(dg) : 0.f; *(LAS bf16_t*)(L + G1_PS + i * 144 + jc * 2) = (bf16_t)(cvt2(acc[e] * f, 0.f) & 0xffffu); }
            }
        }
        LDS_BARRIER();
        if (wave == 0) {
            int l3 = lane; asm volatile("" : "+v"(l3));
            const int bk = l3 >> 4, col = l3 & 15;
            float tcol[16];
#pragma unroll
            for (int rr = 0; rr < 16; ++rr) {
                float a = (rr == col) ? 1.0f : 0.f;
#pragma unroll
                for (int j4 = 0; j4 < (rr + 3) / 4; ++j4) { const f32x4 a4 = *(const LAS f32x4*)(L + G1_AS + (16 * bk + rr) * 272 + (16 * bk + 4 * j4) * 4);
#pragma unroll
                    for (int q = 0; q < 4; ++q) if (4 * j4 + q < rr) a -= a4[q] * tcol[4 * j4 + q]; }
                tcol[rr] = a;
                *(LAS float*)(L + G1_ES + ((bk * 16 + rr) * 16 + col) * 4) = a - ((rr == col) ? 1.0f : 0.f);
            }
        } else if (wave >= 4) {
            int l3 = lane; asm volatile("" : "+v"(l3));
            const int wv = wave - 4, r = l3 & 31, hh = l3 >> 5;
            {   const int rt4 = wv;
#pragma unroll
                for (int kt2 = 0; kt2 < 2; ++kt2)
#pragma unroll
                    for (int ss = 0; ss < 2; ++ss) { float v[8];
#pragma unroll
                        for (int j = 0; j < 8; ++j) { const int tok = 32 * kt2 + krow(ss, hh, j); v[j] = bf2f(*(const LAS bf16_t*)(L + G1_KS + tok * 272 + (32 * rt4 + r) * 2)) * ek_s[tok]; }
                        u32x4 o; o[0] = cvt2(v[0], v[1]); o[1] = cvt2(v[2], v[3]); o[2] = cvt2(v[4], v[5]); o[3] = cvt2(v[6], v[7]);
                        st16_wt(srs, boff + GS_KF + ((rt4 * 2 + kt2) * 2 + ss) * 1024 + l3 * 16, o); } }
            {   const int kt = wv;
#pragma unroll
                for (int rt = 0; rt < 2; ++rt)
#pragma unroll
                    for (int ss = 0; ss < 2; ++ss) { const int i = 32 * rt + r; const float sc = eg_s[i];
                        const u32x2 lo = *(const LAS u32x2*)(L + G1_QS + i * 272 + (32 * kt + 16 * ss + 4 * hh) * 2), hi = *(const LAS u32x2*)(L + G1_QS + i * 272 + (32 * kt + 16 * ss + 8 + 4 * hh) * 2);
                        u32x4 o; o[0] = cvt2(lo16(lo[0]) * sc, hi16(lo[0]) * sc); o[1] = cvt2(lo16(lo[1]) * sc, hi16(lo[1]) * sc); o[2] = cvt2(lo16(hi[0]) * sc, hi16(hi[0]) * sc); o[3] = cvt2(lo16(hi[1]) * sc, hi16(hi[1]) * sc);
                        st16_wt(srs, boff + GS_QF + ((rt * 4 + kt) * 2 + ss) * 1024 + l3 * 16, o); } }
            {   const int rt = wv >> 1, kt2 = wv & 1;
#pragma unroll
                for (int ss = 0; ss < 2; ++ss) { const int i = 32 * rt + r;
                    const u32x2 lo = *(const LAS u32x2*)(L + G1_PS + i * 144 + (32 * kt2 + 16 * ss + 4 * hh) * 2), hi = *(const LAS u32x2*)(L + G1_PS + i * 144 + (32 * kt2 + 16 * ss + 8 + 4 * hh) * 2);
                    u32x4 o; o[0] = lo[0]; o[1] = lo[1]; o[2] = hi[0]; o[3] = hi[1];
                    st16_wt(srs, boff + GS_PF + ((rt * 2 + kt2) * 2 + ss) * 1024 + l3 * 16, o); } }
        }
        LDS_BARRIER();
        {
            int l4 = lane; asm volatile("" : "+v"(l4));
            const int c16 = l4 & 15, g = l4 >> 4;
            const f32x4 z4 = {0.f, 0.f, 0.f, 0.f};
            f32x4 a10, a20, a21, a30, a31, a32, e0, e1, e2, e3;
            { const LAS unsigned char* ar = L + G1_AS + c16 * 272 + (4 * g) * 4;
              a10 = *(const LAS f32x4*)(ar + 16 * 272); a20 = *(const LAS f32x4*)(ar + 32 * 272); a21 = *(const LAS f32x4*)(ar + 32 * 272 + 64);
              a30 = *(const LAS f32x4*)(ar + 48 * 272); a31 = *(const LAS f32x4*)(ar + 48 * 272 + 64); a32 = *(const LAS f32x4*)(ar + 48 * 272 + 128);
              const LAS unsigned char* er = L + G1_ES + (c16 * 16 + 4 * g) * 4;
              e0 = *(const LAS f32x4*)er; e1 = *(const LAS f32x4*)(er + 1024); e2 = *(const LAS f32x4*)(er + 2048); e3 = *(const LAS f32x4*)(er + 3072); }
            const bf16x8 fA10 = g1_pack_b(z4 - a10, z4), fA2 = g1_pack_b(z4 - a20, z4 - a21), fA3a = g1_pack_b(z4 - a30, z4 - a31), fA3b = g1_pack_b(z4 - a32, z4);
            const bf16x8 fE0 = g1_pack_b(e0, z4), fE1 = g1_pack_b(e1, z4), fE2 = g1_pack_b(e2, z4), fE3 = g1_pack_b(e3, z4);
            const bool isw = wave < 4; const int cbase = 32 * (wave & 3);
#pragma unroll
            for (int tl = 0; tl < 2; ++tl) {
                const int d = cbase + 16 * tl + c16;
                f32x4 R[4];
#pragma unroll
                for (int i = 0; i < 4; ++i)
#pragma unroll
                    for (int e = 0; e < 4; ++e) { const int row = 16 * i + 4 * g + e; const float raw1 = bf2f(*(const LAS bf16_t*)(L + (isw ? G1_KS : G1_VS) + row * 272 + d * 2)); R[i][e] = raw1 * beta_s[row] * (isw ? eg_s[row] : 1.0f); }
                const f32x4 X0 = MFMA16(fE0, g1_pack_b(R[0], z4), R[0]);
                const f32x4 Y1 = MFMA16(fA10, g1_pack_b(X0, z4), R[1]);
                const f32x4 X1 = MFMA16(fE1, g1_pack_b(Y1, z4), Y1);
                const f32x4 Y2 = MFMA16(fA2, g1_pack_b(X0, X1), R[2]);
                const f32x4 X2 = MFMA16(fE2, g1_pack_b(Y2, z4), Y2);
                f32x4 Y3 = MFMA16(fA3a, g1_pack_b(X0, X1), R[3]);
                Y3 = MFMA16(fA3b, g1_pack_b(X2, z4), Y3);
                const f32x4 X3 = MFMA16(fE3, g1_pack_b(Y3, z4), Y3);
                const f32x4 X[4] = {X0, X1, X2, X3};
                if (isw) {
#pragma unroll
                    for (int i = 0; i < 4; ++i)
#pragma unroll
                        for (int e = 0; e < 4; ++e) *(LAS bf16_t*)(L + G1_WS + (16 * i + 4 * g + e) * 272 + d * 2) = (bf16_t)(cvt2(-X[i][e], 0.f) & 0xffffu);
                } else {
                    const int ws = wave & 3, cc = 16 * tl + c16;
#pragma unroll
                    for (int i = 0; i < 4; ++i) { const int rt = i >> 1, q = 2 * (i & 1) + (g >> 1), hh = g & 1;
                        u32x2 o; o[0] = cvt2(X[i][0], X[i][1]); o[1] = cvt2(X[i][2], X[i][3]);
                        st8_wt(blk + GS_UF + (size_t)(((ws * 2 + rt) * 64) + cc + 32 * hh) * 32 + q * 8, o); }
                }
            }
        }
        LDS_BARRIER();
        {
            int l5 = lane; asm volatile("" : "+v"(l5));
            const int kt = wave & 3, rt = wave >> 2, r = l5 & 31, hh = l5 >> 5, i = 32 * rt + r;
#pragma unroll
            for (int ss = 0; ss < 2; ++ss) {
                const u32x2 lo = *(const LAS u32x2*)(L + G1_WS + i * 272 + (32 * kt + 16 * ss + 4 * hh) * 2), hi = *(const LAS u32x2*)(L + G1_WS + i * 272 + (32 * kt + 16 * ss + 8 + 4 * hh) * 2);
                u32x4 o; o[0] = lo[0]; o[1] = lo[1]; o[2] = hi[0]; o[3] = hi[1];
                st16_wt(srs, boff + GS_WF + ((rt * 4 + kt) * 2 + ss) * 1024 + l5 * 16, o); }
        }
        asm volatile("s_waitcnt vmcnt(0)" ::: "memory");
        LDS_BARRIER();
        if (tid == 0 && task < 4096) __hip_atomic_store(ready + 16 * sidx, 1u, __ATOMIC_RELAXED, __HIP_MEMORY_SCOPE_AGENT);
    }
}

constexpr int G2_FB = GS_BYTES, G2_OSTRIDE = 528, G2_HN = 2 * G2_FB, G2_DEC = G2_HN + 512;
__device__ __forceinline__ bf16x8 pack8(const f32x16& x, const int s) {
    u32x4 p; p[0] = cvt2(x[8 * s], x[8 * s + 1]); p[1] = cvt2(x[8 * s + 2], x[8 * s + 3]); p[2] = cvt2(x[8 * s + 4], x[8 * s + 5]); p[3] = cvt2(x[8 * s + 6], x[8 * s + 7]);
    return __builtin_bit_cast(bf16x8, p);
}
template <bool WT>
__device__ __forceinline__ void g2_load_set(u32x4 (&pre)[18], float& dpre, const unsigned char* blk, int lt, brsrc_t srs, unsigned boff, const unsigned* flag, const float* decp) {
    if (WT) { unsigned sp = 0; while (__builtin_amdgcn_readfirstlane(__hip_atomic_load(flag, __ATOMIC_RELAXED, __HIP_MEMORY_SCOPE_AGENT)) == 0u && ++sp < (1u << 20)) __builtin_amdgcn_s_sleep(4);
        dpre = __uint_as_float(__hip_atomic_load((const unsigned*)decp, __ATOMIC_RELAXED, __HIP_MEMORY_SCOPE_AGENT));
#pragma unroll
        for (int i = 0; i < 18; ++i) pre[i] = ld16_wt(srs, boff + (unsigned)(i * 256 + lt) * 16u);
    } else { const u32x4* src = (const u32x4*)blk; dpre = *decp;
#pragma unroll
        for (int i = 0; i < 18; ++i) pre[i] = src[i * 256 + lt]; }
}
__device__ __forceinline__ void g2_store_set(const u32x4 (&pre)[18], LAS unsigned char* dst, int lt) {
#pragma unroll
    for (int i = 0; i < 18; ++i) *(LAS u32x4*)(dst + (size_t)(i * 256 + lt) * 16) = pre[i];
}
#define G2_FRAG(off) (*(const LAS bf16x8*)(B + (off)))
#define G2_SCHED() __builtin_amdgcn_sched_barrier(0)
__device__ __forceinline__ void g2_mfma_step(f32x16& S0, f32x16& S1, f32x16& S2, f32x16& S3, LAS unsigned char* Bimg, const float dec, int ws, int lane, int cc, int hh) {
    const LAS unsigned char* B = Bimg + lane * 16;
    f32x16 vn0, vn1, o0, o1;
    { const LAS u32x4* up = (const LAS u32x4*)(Bimg + GS_UF + (size_t)(ws * 2 * 64 + lane) * 32); const u32x4 u0 = up[0], u1 = up[1], u2 = up[128], u3 = up[129];
#pragma unroll
      for (int q = 0; q < 4; ++q) { vn0[2 * q] = lo16(u0[q]); vn0[2 * q + 1] = hi16(u0[q]); vn0[8 + 2 * q] = lo16(u1[q]); vn0[8 + 2 * q + 1] = hi16(u1[q]);
                                    vn1[2 * q] = lo16(u2[q]); vn1[2 * q + 1] = hi16(u2[q]); vn1[8 + 2 * q] = lo16(u3[q]); vn1[8 + 2 * q + 1] = hi16(u3[q]); } }
#pragma unroll
    for (int e = 0; e < 16; ++e) { o0[e] = 0.f; o1[e] = 0.f; }
#define G2_WQ(Sx, kt) do { _Pragma("unroll") for (int ss = 0; ss < 2; ++ss) { const bf16x8 sb = pack8(Sx, ss); \
        const bf16x8 fw0 = G2_FRAG(GS_WF + ((0 * 4 + kt) * 2 + ss) * 1024), fw1 = G2_FRAG(GS_WF + ((1 * 4 + kt) * 2 + ss) * 1024); \
        const bf16x8 fq0 = G2_FRAG(GS_QF + ((0 * 4 + kt) * 2 + ss) * 1024), fq1 = G2_FRAG(GS_QF + ((1 * 4 + kt) * 2 + ss) * 1024); \
        vn0 = MFMA32(fw0, sb, vn0); vn1 = MFMA32(fw1, sb, vn1); o0 = MFMA32(fq0, sb, o0); o1 = MFMA32(fq1, sb, o1); } } while (0)
    G2_WQ(S0, 0); G2_WQ(S1, 1); G2_WQ(S2, 2); G2_WQ(S3, 3);
#undef G2_WQ
    bf16x8 vb[2][2];
    vb[0][0] = pack8(vn0, 0); vb[0][1] = pack8(vn0, 1); vb[1][0] = pack8(vn1, 0); vb[1][1] = pack8(vn1, 1);
#pragma unroll
    for (int kt2 = 0; kt2 < 2; ++kt2)
#pragma unroll
        for (int ss = 0; ss < 2; ++ss) { o0 = MFMA32(G2_FRAG(GS_PF + ((0 * 2 + kt2) * 2 + ss) * 1024), vb[kt2][ss], o0); o1 = MFMA32(G2_FRAG(GS_PF + ((1 * 2 + kt2) * 2 + ss) * 1024), vb[kt2][ss], o1); }
    S0 = S0 * dec; S1 = S1 * dec; S2 = S2 * dec; S3 = S3 * dec;
#pragma unroll
    for (int kt2 = 0; kt2 < 2; ++kt2)
#pragma unroll
        for (int ss = 0; ss < 2; ++ss) {
            S0 = MFMA32(G2_FRAG(GS_KF + ((0 * 2 + kt2) * 2 + ss) * 1024), vb[kt2][ss], S0); S1 = MFMA32(G2_FRAG(GS_KF + ((1 * 2 + kt2) * 2 + ss) * 1024), vb[kt2][ss], S1);
            S2 = MFMA32(G2_FRAG(GS_KF + ((2 * 2 + kt2) * 2 + ss) * 1024), vb[kt2][ss], S2); S3 = MFMA32(G2_FRAG(GS_KF + ((3 * 2 + kt2) * 2 + ss) * 1024), vb[kt2][ss], S3); }
    LDS_BARRIER();
#pragma unroll
    for (int e = 0; e < 16; ++e) { const int rr = (e & 3) + 8 * (e >> 2) + 4 * hh;
        *(LAS float*)(Bimg + rr * G2_OSTRIDE + (32 * ws + cc) * 4) = o0[e]; *(LAS float*)(Bimg + (32 + rr) * G2_OSTRIDE + (32 * ws + cc) * 4) = o1[e]; }
    LDS_BARRIER();
}
__device__ __forceinline__ void g2_epi_step(Frame& F, LAS unsigned char* L, const LAS unsigned char* Oimg, const u32x4 (&zz)[4], int row, int seg, size_t m, int h, bool rok, int lane) {
    float ss = 0.f;
#pragma unroll
    for (int q = 0; q < 8; ++q) { const f32x4 ov = *(const LAS f32x4*)(Oimg + row * G2_OSTRIDE + (seg * 32 + 4 * q) * 4); ss += (ov[0] * ov[0] + ov[1] * ov[1]) + (ov[2] * ov[2] + ov[3] * ov[3]); }
    ss += shfl_xor_l(ss, 1, lane); ss += shfl_xor_l(ss, 2, lane);
    const float rn = rsqrtf(ss * (1.f / 128.f) + EPS);
    if (rok) {
        u32x4* yp = (u32x4*)(F.Y1() + m * D + h * 128 + seg * 32);
        const LAS float* hn_s = (const LAS float*)(L + G2_HN);
#pragma unroll
        for (int q = 0; q < 4; ++q) {
            const f32x4 oa = *(const LAS f32x4*)(Oimg + row * G2_OSTRIDE + (seg * 32 + 8 * q) * 4), ob = *(const LAS f32x4*)(Oimg + row * G2_OSTRIDE + (seg * 32 + 8 * q + 4) * 4);
            const f32x4 ha = *(const LAS f32x4*)(hn_s + seg * 32 + 8 * q), hb = *(const LAS f32x4*)(hn_s + seg * 32 + 8 * q + 4);
            u32x4 yo;
            yo[0] = cvt2(oa[0] * rn * ha[0] * siluf_(lo16(zz[q][0])), oa[1] * rn * ha[1] * siluf_(hi16(zz[q][0])));
            yo[1] = cvt2(oa[2] * rn * ha[2] * siluf_(lo16(zz[q][1])), oa[3] * rn * ha[3] * siluf_(hi16(zz[q][1])));
            yo[2] = cvt2(ob[0] * rn * hb[0] * siluf_(lo16(zz[q][2])), ob[1] * rn * hb[1] * siluf_(hi16(zz[q][2])));
            yo[3] = cvt2(ob[2] * rn * hb[2] * siluf_(lo16(zz[q][3])), ob[3] * rn * hb[3] * siluf_(hi16(zz[q][3])));
            yp[q] = yo; }
    }
}
template <int NCH>
__device__ __forceinline__ void g2_task(Frame& F, LAS unsigned char* L, const float* DEC, int s, int h, int ch0, int tid, int lane, int wave) {
    const size_t cstep = (size_t)GS_BYTES;
    const int base = seq_base(s), nvalid = s < BP ? 64 : TS;
    const unsigned char* blk0 = F.ws + WS_RB + (size_t)ch0 * GS_BYTES;
    constexpr int lastc = NCH - 1;
    if (wave < 4) {
        const int ws = wave, cc = lane & 31, hh = lane >> 5;
        f32x16 S0, S1, S2, S3;
        if (s < BP) {
#pragma unroll
            for (int e = 0; e < 16; ++e) { S0[e] = 0.f; S1[e] = 0.f; S2[e] = 0.f; S3[e] = 0.f; }
        } else {
            const float* sp = F.in[7] + ((size_t)(s - BP) * 8 + h) * 16384 + 32 * ws + cc;
#pragma unroll
            for (int e = 0; e < 16; ++e) { const int rr = (e & 3) + 8 * (e >> 2) + 4 * hh; S0[e] = sp[(size_t)rr * 128]; S1[e] = sp[(size_t)(32 + rr) * 128]; S2[e] = sp[(size_t)(64 + rr) * 128]; S3[e] = sp[(size_t)(96 + rr) * 128]; }
        }
        const LAS float* dec_s = (const LAS float*)(L + G2_DEC);
        LDS_BARRIER();
        if (NCH == 1) g2_mfma_step(S0, S1, S2, S3, L, dec_s[0], ws, lane, cc, hh);
        else for (int c = 0; c < NCH; c += 2) {
            g2_mfma_step(S0, S1, S2, S3, L, dec_s[c], ws, lane, cc, hh);
            g2_mfma_step(S0, S1, S2, S3, L + G2_FB, dec_s[c + 1], ws, lane, cc, hh);
        }
        int l9 = lane; asm volatile("" : "+v"(l9));
        const int cc9 = l9 & 31, hh9 = l9 >> 5;
        float* so = (s < BP ? F.out + O_GSP + ((size_t)s * 8 + h) * 16384 : F.out + O_GSS + ((size_t)(s - BP) * 8 + h) * 16384) + 32 * ws + cc9;
#pragma unroll
        for (int e = 0; e < 16; ++e) { const int rr = (e & 3) + 8 * (e >> 2) + 4 * hh9; so[(size_t)rr * 128] = S0[e]; so[(size_t)(32 + rr) * 128] = S1[e]; so[(size_t)(64 + rr) * 128] = S2[e]; so[(size_t)(96 + rr) * 128] = S3[e]; }
    } else {
        const int lt = tid - 256;
        if (lt < 128) ((LAS float*)(L + G2_HN))[lt] = F.in[32][lt];
        constexpr bool WT = NCH > 1;
        const brsrc_t srs = staging_rsrc(F.ws);
        const unsigned* ready = (const unsigned*)(F.ws + WS_READY);
        LAS float* dec_w = (LAS float*)(L + G2_DEC);
#define G2_LOAD(pre, dpre, k) do { const int _k = (k) < lastc ? (k) : lastc; g2_load_set<WT>(pre, dpre, blk0 + (size_t)_k * cstep, lt, srs, (unsigned)(ch0 + _k) * (unsigned)GS_BYTES, ready + 16 * (ch0 + _k), DEC + ch0 + _k); } while (0)
        u32x4 preA[18], preB[18]; float dA, dB;
        G2_LOAD(preA, dA, 0);
        G2_LOAD(preB, dB, 1);
        g2_store_set(preA, L, lt); if (lt == 0) dec_w[0] = dA;
        G2_LOAD(preA, dA, 2);
        const int row = lt >> 2, seg = lt & 3; const bool rok = row < nvalid;
        u32x4 zz[4];
        LDS_BARRIER();
        if (NCH == 1) {
            const size_t m = (size_t)base + row;
            if (rok) { const u32x4* zp = (const u32x4*)(F.Z1() + m * D + h * 128 + seg * 32);
#pragma unroll
                for (int q = 0; q < 4; ++q) zz[q] = zp[q]; }
            LDS_BARRIER();
            LDS_BARRIER();
            g2_epi_step(F, L, L, zz, row, seg, m, h, rok, lane);
        } else {
            for (int c = 0; c < NCH; c += 2) {
                {
                    const size_t m = (size_t)base + c * 64 + row;
                    { const u32x4* zp = (const u32x4*)(F.Z1() + m * D + h * 128 + seg * 32);
#pragma unroll
                      for (int q = 0; q < 4; ++q) zz[q] = zp[q]; }
                    g2_store_set(preB, L + G2_FB, lt); if (lt == 0) dec_w[(c + 1) & 63] = dB;
                    G2_LOAD(preB, dB, c + 3);
                    LDS_BARRIER();
                    LDS_BARRIER();
                    g2_epi_step(F, L, L, zz, row, seg, m, h, rok, lane);
                }
                {
                    const size_t m = (size_t)base + (c + 1) * 64 + row;
                    { const u32x4* zp = (const u32x4*)(F.Z1() + m * D + h * 128 + seg * 32);
#pragma unroll
                      for (int q = 0; q < 4; ++q) zz[q] = zp[q]; }
                    g2_store_set(preA, L, lt); if (lt == 0) dec_w[(c + 2) & 63] = dA;
                    G2_LOAD(preA, dA, c + 4);
                    LDS_BARRIER();
                    LDS_BARRIER();
                    g2_epi_step(F, L, L + G2_FB, zz, row, seg, m, h, rok, lane);
                }
            }
        }
    }
}
#undef G2_LOAD
constexpr int G12_CHAINS = 64;
__device__ __forceinline__ void phase_gdn_fused(Frame& F) {
    LAS unsigned char* L = F.lds;
    const float* DEC = (const float*)(F.ws + WS_DEC);
    if ((int)blockIdx.x < G12_CHAINS && F.G > G12_CHAINS) {
        const int tid = opaque_tid(F.wv);
        const int ci = blockIdx.x;
        g2_task<64>(F, L, DEC, ci >> 3, ci & 7, ci * 64, tid, tid & 63, F.wv);
    } else {
        const bool all = !(F.G > G12_CHAINS);
        gdn_g1_tasks(F, all ? (int)blockIdx.x : (int)blockIdx.x - G12_CHAINS, all ? F.G : F.G - G12_CHAINS);
    }
}
__device__ __forceinline__ void phase_gdn_g2_samples(Frame& F) {
    LAS unsigned char* L = F.lds;
    const float* DEC = (const float*)(F.ws + WS_DEC);
    for (int t = F.vcu; t < 128; t += F.G) {
        const int tid = opaque_tid(F.wv);
        g2_task<1>(F, L, DEC, BP + (t >> 3), t & 7, 4096 + t, tid, tid & 63, F.wv);
        __syncthreads();
    }
}

__device__ __forceinline__ float dpp_shr_f(float idv, float x, const int o) {
    int r;
    switch (o) {
        case 1: r = __builtin_amdgcn_update_dpp(__float_as_int(idv), __float_as_int(x), 0x111, 0xf, 0xf, false); break;
        case 2: r = __builtin_amdgcn_update_dpp(__float_as_int(idv), __float_as_int(x), 0x112, 0xf, 0xf, false); break;
        case 4: r = __builtin_amdgcn_update_dpp(__float_as_int(idv), __float_as_int(x), 0x114, 0xf, 0xf, false); break;
        default: r = __builtin_amdgcn_update_dpp(__float_as_int(idv), __float_as_int(x), 0x118, 0xf, 0xf, false); break;
    }
    return __int_as_float(r);
}
template <int PASS>
__device__ __forceinline__ void phase_lru(Frame& F) {
    int tid = opaque_tid(F.wv);
    const int lane = tid & 63, wave = __builtin_amdgcn_readfirstlane(tid >> 6);
    const int gw = F.vcu * 8 + wave, NGW = F.G * 8, h = gw & 7, g = lane >> 4, l15 = lane & 15;
    LAS unsigned char* xs = F.lds + wave * 9216;
    LAS float* cst = (LAS float*)(F.lds + 73728 + wave * 768);
    const bf16_t* LGW = (const bf16_t*)(F.ws + WS_LGW);
    float* LAG = F.LAG();
    bf16x8 wfa[4][2], wfx[4][2];
#pragma unroll
    for (int nt = 0; nt < 4; ++nt)
#pragma unroll
        for (int ks = 0; ks < 2; ++ks) {
            wfa[nt][ks] = *(const bf16x8*)(LGW + ((size_t)(h * 2 + 0) * 64 + 16 * nt + l15) * 64 + 32 * ks + 8 * g);
            wfx[nt][ks] = *(const bf16x8*)(LGW + ((size_t)(h * 2 + 1) * 64 + 16 * nt + l15) * 64 + 32 * ks + 8 * g); }
    cst[lane] = F.in[18][h * 64 + lane]; cst[64 + lane] = F.in[20][h * 64 + lane]; cst[128 + lane] = softplusf_(-F.in[21][h * 64 + lane]);
    for (int task = gw; task < 4224; task += NGW) {
        int s, c; if (task < 4096) { s = task >> 9; c = (task >> 3) & 63; } else { s = BP + ((task - 4096) >> 3); c = 0; }
        const int T = seq_len(s), base = seq_base(s), t0 = c * 64, ntile = s < BP ? 4 : 1;
        {
            int l1 = lane; asm volatile("" : "+v"(l1));
            const int cg = l1 & 7, tp = l1 >> 3;
#pragma unroll 1
            for (int hf2 = 0; hf2 < 2; ++hf2) {
                const int chb = h * 64 + cg * 8 + hf2 * 4;
                float xr[11][4];
#pragma unroll
                for (int i = 0; i < 11; ++i) {
                    const int tt = t0 + tp * 8 - 3 + i;
                    if (tt >= 0 && tt < T) { const u32x2 w = *(const u32x2*)(F.U0() + (size_t)(base + tt) * EV_IN + C_XA + chb);
                        xr[i][0] = lo16(w[0]); xr[i][1] = hi16(w[0]); xr[i][2] = lo16(w[1]); xr[i][3] = hi16(w[1]); }
                    else if (tt < 0 && s >= BP) { const f32x4 a = *(const f32x4*)(F.in[2] + ((size_t)(s - BP) * 3 + (tt + 3)) * 512 + chb); xr[i][0] = a[0]; xr[i][1] = a[1]; xr[i][2] = a[2]; xr[i][3] = a[3]; }
                    else { xr[i][0] = 0.f; xr[i][1] = 0.f; xr[i][2] = 0.f; xr[i][3] = 0.f; }
                }
                const f32x4 c0 = *(const f32x4*)(F.in[15] + chb), c1 = *(const f32x4*)(F.in[15] + 512 + chb), c2 = *(const f32x4*)(F.in[15] + 1024 + chb), c3 = *(const f32x4*)(F.in[15] + 1536 + chb), cb = *(const f32x4*)(F.in[16] + chb);
#pragma unroll
                for (int i = 0; i < 8; ++i) { float o[4];
#pragma unroll
                    for (int e = 0; e < 4; ++e) o[e] = c0[e] * xr[i][e] + c1[e] * xr[i + 1][e] + c2[e] * xr[i + 2][e] + c3[e] * xr[i + 3][e] + cb[e];
                    u32x2 w; w[0] = cvt2(o[0], o[1]); w[1] = cvt2(o[2], o[3]);
                    *(LAS u32x2*)(xs + (tp * 8 + i) * 144 + cg * 16 + hf2 * 8) = w; }
                if (PASS == 2 && t0 + 64 >= T && tp == ((T - 1) >> 3) - (t0 >> 3)) {
                    float* o = (s < BP ? F.out + O_LCP + (size_t)s * 3 * 512 : F.out + O_LCS + (size_t)(s - BP) * 3 * 512) + chb;
#pragma unroll
                    for (int q = 0; q < 3; ++q) *(f32x4*)(o + q * 512) = (f32x4){xr[8 + q][0], xr[8 + q][1], xr[8 + q][2], xr[8 + q][3]};
                }
            }
        }
        float hin[4][4], arun[4][4];
#pragma unroll
        for (int nt = 0; nt < 4; ++nt)
#pragma unroll
            for (int rg = 0; rg < 4; ++rg) { hin[nt][rg] = 0.f; arun[nt][rg] = 1.f; }
        if (PASS == 2) {
            float hf = s >= BP ? F.in[3][(s - BP) * 512 + h * 64 + lane] : 0.f;
            const f32x2* lp = (const f32x2*)LAG + (size_t)(s * 64) * 512 + h * 64 + lane;
            int j = 0;
            for (; j + 8 <= c; j += 8) { f32x2 v[8];
#pragma unroll
                for (int q = 0; q < 8; ++q) v[q] = lp[(size_t)(j + q) * 512];
#pragma unroll
                for (int q = 0; q < 8; ++q) hf = v[q][0] * hf + v[q][1]; }
            for (; j < c; ++j) { const f32x2 v = lp[(size_t)j * 512]; hf = v[0] * hf + v[1]; }
#pragma unroll
            for (int nt = 0; nt < 4; ++nt)
#pragma unroll
                for (int rg = 0; rg < 4; ++rg) hin[nt][rg] = shfl_idx(hf, 16 * nt + 4 * g + rg);
        }
        asm volatile("s_waitcnt lgkmcnt(0)" ::: "memory");
        for (int tt = 0; tt < ntile; ++tt) {
            const int tok = 16 * tt + l15;
            const bf16x8 b0 = *(const LAS bf16x8*)(xs + tok * 144 + (8 * g) * 2), b1 = *(const LAS bf16x8*)(xs + tok * 144 + (32 + 8 * g) * 2);
            const size_t m = (size_t)base + t0 + tok;
#pragma unroll
            for (int nt = 0; nt < 4; ++nt) {
                f32x4 za = {0.f, 0.f, 0.f, 0.f}, zx = {0.f, 0.f, 0.f, 0.f};
                za = MFMA16(wfa[nt][0], b0, za); za = MFMA16(wfa[nt][1], b1, za);
                zx = MFMA16(wfx[nt][0], b0, zx); zx = MFMA16(wfx[nt][1], b1, zx);
                const int n0 = 16 * nt + 4 * g;
                const u32x2 xw = *(const LAS u32x2*)(xs + tok * 144 + n0 * 2);
                const float xc[4] = {lo16(xw[0]), hi16(xw[0]), lo16(xw[1]), hi16(xw[1])};
                const f32x4 cba = *(const LAS f32x4*)(cst + n0), cbx = *(const LAS f32x4*)(cst + 64 + n0), csp = *(const LAS f32x4*)(cst + 128 + n0);
                float av[4], bv[4];
#pragma unroll
                for (int rg = 0; rg < 4; ++rg) {
                    const float r = sigmoidf_(za[rg] + cba[rg]), ig = sigmoidf_(zx[rg] + cbx[rg]), la = -8.0f * r * csp[rg], a = __expf(la);
                    av[rg] = a; bv[rg] = sqrtf(fmaxf(1.0f - a * a, 0.f)) * (ig * xc[rg]); }
#pragma unroll
                for (int o = 1; o < 16; o <<= 1)
#pragma unroll
                    for (int rg = 0; rg < 4; ++rg) { const float ap = dpp_shr_f(1.0f, av[rg], o), bp = dpp_shr_f(0.0f, bv[rg], o); bv[rg] = av[rg] * bp + bv[rg]; av[rg] = av[rg] * ap; }
                float hv[4];
#pragma unroll
                for (int rg = 0; rg < 4; ++rg) { hv[rg] = bv[rg] + av[rg] * hin[nt][rg]; hin[nt][rg] = shfl_idx(hv[rg], (lane & 48) | 15); }
                if (PASS == 1) {
#pragma unroll
                    for (int rg = 0; rg < 4; ++rg) arun[nt][rg] *= shfl_idx(av[rg], (lane & 48) | 15);
                } else {
                    const bool tok_ok = (t0 + tok) < T;
                    if (tok_ok) {
                        const u32x2 gw2 = *(const u32x2*)(F.U0() + m * EV_IN + C_GA + h * 64 + n0);
                        u32x2 yo; yo[0] = cvt2(hv[0] * siluf_(lo16(gw2[0])), hv[1] * siluf_(hi16(gw2[0]))); yo[1] = cvt2(hv[2] * siluf_(lo16(gw2[1])), hv[3] * siluf_(hi16(gw2[1])));
                        *(u32x2*)(F.Y0() + m * D + h * 64 + n0) = yo;
                        if (t0 + tok == T - 1) { float* o = (s < BP ? F.out + O_LHP + s * 512 : F.out + O_LHS + (s - BP) * 512) + h * 64 + n0; *(f32x4*)o = (f32x4){hv[0], hv[1], hv[2], hv[3]}; }
                    }
                }
                if (nt & 1) __builtin_amdgcn_sched_barrier(0);
            }
        }
        if (PASS == 1 && s < BP && l15 == 15) {
            f32x2* lp = (f32x2*)LAG + (size_t)(s * 64 + c) * 512 + h * 64;
#pragma unroll
            for (int nt = 0; nt < 4; ++nt)
#pragma unroll
                for (int rg = 0; rg < 4; ++rg) lp[16 * nt + 4 * g + rg] = (f32x2){arun[nt][rg], hin[nt][rg]};
        }
        asm volatile("s_waitcnt lgkmcnt(0)" ::: "memory");
    }
}

constexpr size_t RB_VTP = RB_WEND, RB_VTS = RB_VTP + (size_t)BP * 2 * 64 * TP * 2, RB_VTEND = RB_VTS + (size_t)BS * 2 * 64 * 192 * 2;
static_assert(RB_VTEND <= RB_BYTES, "ws map");
__device__ __forceinline__ void phase_vt_build(Frame& F) {
    PHASE_IDS();
    const int gw = F.vcu * 8 + wave, NGW = F.G * 8;
    LAS unsigned char* xs = F.lds + wave * 9216;
    bf16_t* VTP = (bf16_t*)(F.ws + WS_RB + RB_VTP); bf16_t* VTS = (bf16_t*)(F.ws + WS_RB + RB_VTS);
    for (int task = gw; task < 1024 + 96; task += NGW) {
        int s, kv, kb; if (task < 1024) { s = task >> 7; kv = (task >> 6) & 1; kb = task & 63; } else { const int r = task - 1024; s = BP + r / 6; kv = (r % 6) / 3; kb = r % 3; }
        const int row8 = lane >> 3, ch = lane & 7;
#pragma unroll
        for (int i = 0; i < 8; ++i) {
            const int key = 8 * i + row8, kg = kb * 64 + key; u32x4 w = {0u, 0u, 0u, 0u};
            if (s < BP) w = *(const u32x4*)(F.U0() + (size_t)(s * TP + kg) * EV_IN + C_V + kv * 64 + ch * 8);
            else if (kg < 128) { const f32x4* p = (const f32x4*)(F.in[5] + ((size_t)((s - BP) * 128 + kg) * 2 + kv) * 64 + ch * 8); const f32x4 a = p[0], b = p[1]; w[0] = cvt2(a[0], a[1]); w[1] = cvt2(a[2], a[3]); w[2] = cvt2(b[0], b[1]); w[3] = cvt2(b[2], b[3]); }
            else if (kg < 128 + TS) w = *(const u32x4*)(F.U0() + (size_t)(MP + (s - BP) * TS + (kg - 128)) * EV_IN + C_V + kv * 64 + ch * 8);
            *(LAS u32x4*)(xs + key * 144 + ch * 16) = w;
        }
        asm volatile("s_waitcnt lgkmcnt(0)" ::: "memory");
        bf16_t* dst = s < BP ? VTP + ((size_t)(s * 2 + kv) * 64 + lane) * TP + kb * 64 : VTS + ((size_t)((s - BP) * 2 + kv) * 64 + lane) * 192 + kb * 64;
#pragma unroll
        for (int q = 0; q < 8; ++q) { u32x4 o;
#pragma unroll
            for (int e = 0; e < 4; ++e) { const unsigned lo = *(const LAS bf16_t*)(xs + (8 * q + 2 * e) * 144 + lane * 2), hi = *(const LAS bf16_t*)(xs + (8 * q + 2 * e + 1) * 144 + lane * 2); o[e] = lo | (hi << 16); }
            *(u32x4*)(dst + 8 * q) = o; }
        asm volatile("s_waitcnt lgkmcnt(0)" ::: "memory");
    }
}
constexpr int AT_K = 0, AT_V = 27648;
__device__ __forceinline__ void phase_attn(Frame& F) {
    PHASE_IDS();
    LAS unsigned char* L = F.lds;
    const bf16_t* VTP = (const bf16_t*)(F.ws + WS_RB + RB_VTP); const bf16_t* VTS = (const bf16_t*)(F.ws + WS_RB + RB_VTS);
    for (int task = F.vcu; task < 1024 + 32; task += F.G) {
        int s, c, kv; if (task < 1024) { s = task >> 7; c = (task >> 1) & 63; kv = task & 1; } else { s = BP + ((task - 1024) >> 1); c = 0; kv = task & 1; }
        const int base = seq_base(s), tok0 = c * 64 - 128;
        const int kmin = s < BP ? (tok0 < 0 ? -tok0 : 0) : 0, kmax = s < BP ? 192 : 128 + TS;
        __syncthreads();
#pragma unroll
        for (int i = 0; i < 3; ++i) {
            const int idx = tid + 512 * i, key = idx >> 3, ch = idx & 7; u32x4 w = {0u, 0u, 0u, 0u};
            if (key >= kmin && key < kmax) {
                if (s < BP) w = *(const u32x4*)(F.U0() + (size_t)(base + tok0 + key) * EV_IN + C_K + kv * 64 + ch * 8);
                else if (key < 128) { const f32x4* p = (const f32x4*)(F.in[4] + ((size_t)((s - BP) * 128 + key) * 2 + kv) * 64 + ch * 8); const f32x4 a = p[0], b = p[1]; w[0] = cvt2(a[0], a[1]); w[1] = cvt2(a[2], a[3]); w[2] = cvt2(b[0], b[1]); w[3] = cvt2(b[2], b[3]); }
                else w = *(const u32x4*)(F.U0() + (size_t)(base + key - 128) * EV_IN + C_K + kv * 64 + ch * 8);
            }
            *(LAS u32x4*)(L + AT_K + key * 144 + ch * 16) = w;
        }
#pragma unroll
        for (int i = 0; i < 3; ++i) {
            const int idx = tid + 512 * i, d = idx / 24, ch = idx % 24, key = ch * 8; u32x4 w = {0u, 0u, 0u, 0u};
            if (s < BP) { if (key >= kmin) w = *(const u32x4*)(VTP + ((size_t)(s * 2 + kv) * 64 + d) * TP + tok0 + key); }
            else w = *(const u32x4*)(VTS + ((size_t)((s - BP) * 2 + kv) * 64 + d) * 192 + key);
            *(LAS u32x4*)(L + AT_V + d * 400 + ch * 16) = w;
        }
        const int g = wave >> 1, qh = wave & 1, hq = kv * 4 + g, r = lane & 31, hh = lane >> 5, qi = qh * 32 + r;
        const bool qok = s < BP ? true : qi < TS;
        const size_t m = (size_t)base + c * 64 + (qok ? qi : 0);
        bf16x8 qf[4];
#pragma unroll
        for (int ks = 0; ks < 4; ++ks) { u32x4 w = {0u, 0u, 0u, 0u};
            if (qok) { const u32x4 x = *(const u32x4*)(F.U0() + m * EV_IN + C_Q + hq * 64 + 16 * ks + 8 * hh);
#pragma unroll
                for (int e = 0; e < 4; ++e) w[e] = cvt2(lo16(x[e]) * 0.125f, hi16(x[e]) * 0.125f); }
            qf[ks] = __builtin_bit_cast(bf16x8, w); }
        const float sink = F.in[22][hq];
        __syncthreads();
        float mrun = sink, lrun = 1.0f;
        f32x16 o0, o1;
#pragma unroll
        for (int e = 0; e < 16; ++e) { o0[e] = 0.f; o1[e] = 0.f; }
#pragma unroll 1
        for (int half = 0; half < 2; ++half) {
            f32x16 sc[3];
#pragma unroll
            for (int k3 = 0; k3 < 3; ++k3) {
                const int kt = 3 * half + k3;
#pragma unroll
                for (int e = 0; e < 16; ++e) sc[k3][e] = 0.f;
#pragma unroll
                for (int ks = 0; ks < 4; ++ks) { const bf16x8 kf = *(const LAS bf16x8*)(L + AT_K + (32 * kt + r) * 144 + (16 * ks + 8 * hh) * 2); sc[k3] = MFMA32(kf, qf[ks], sc[k3]); }
            }
            float mx = -1e30f;
#pragma unroll
            for (int k3 = 0; k3 < 3; ++k3)
#pragma unroll
                for (int e = 0; e < 16; ++e) { const int kidx = 32 * (3 * half + k3) + (e & 3) + 8 * (e >> 2) + 4 * hh; const bool ok = kidx >= kmin && kidx < kmax; sc[k3][e] = ok ? sc[k3][e] : -1e30f; mx = fmaxf(mx, sc[k3][e]); }
            mx = fmaxf(mx, shfl_xor_l(mx, 32, lane));
            const float mnew = fmaxf(mrun, mx), alpha = __expf(mrun - mnew);
            float psum = 0.f;
#pragma unroll
            for (int k3 = 0; k3 < 3; ++k3)
#pragma unroll
                for (int e = 0; e < 16; ++e) { const float p = __expf(sc[k3][e] - mnew); sc[k3][e] = p; psum += p; }
            psum += shfl_xor_l(psum, 32, lane);
            lrun = lrun * alpha + psum; mrun = mnew;
            o0 = o0 * alpha; o1 = o1 * alpha;
#pragma unroll
            for (int k3 = 0; k3 < 3; ++k3)
#pragma unroll
                for (int ss = 0; ss < 2; ++ss) {
                    const int kt = 3 * half + k3;
                    const bf16x8 pb = pack8(sc[k3], ss);
                    const LAS unsigned char* vp = L + AT_V + r * 400 + (32 * kt + 16 * ss + 4 * hh) * 2;
                    const u32x2 a0 = *(const LAS u32x2*)vp, a1 = *(const LAS u32x2*)(vp + 16), b0 = *(const LAS u32x2*)(vp + 32 * 400), b1 = *(const LAS u32x2*)(vp + 32 * 400 + 16);
                    const u32x4 va = {a0[0], a0[1], a1[0], a1[1]}, vb = {b0[0], b0[1], b1[0], b1[1]};
                    o0 = MFMA32(__builtin_bit_cast(bf16x8, va), pb, o0); o1 = MFMA32(__builtin_bit_cast(bf16x8, vb), pb, o1);
                }
        }
        const float il = __builtin_amdgcn_rcpf(lrun);
        if (qok) {
#pragma unroll
            for (int qq = 0; qq < 4; ++qq) {
                { const int d = 8 * qq + 4 * hh; const u32x2 gb = *(const u32x2*)(F.U0() + m * EV_IN + C_GB + hq * 64 + d);
                  u32x2 yo; yo[0] = cvt2(o0[4 * qq] * il * siluf_(lo16(gb[0])), o0[4 * qq + 1] * il * siluf_(hi16(gb[0]))); yo[1] = cvt2(o0[4 * qq + 2] * il * siluf_(lo16(gb[1])), o0[4 * qq + 3] * il * siluf_(hi16(gb[1])));
                  *(u32x2*)(F.Y0() + m * D + 512 + hq * 64 + d) = yo; }
                { const int d = 32 + 8 * qq + 4 * hh; const u32x2 gb = *(const u32x2*)(F.U0() + m * EV_IN + C_GB + hq * 64 + d);
                  u32x2 yo; yo[0] = cvt2(o1[4 * qq] * il * siluf_(lo16(gb[0])), o1[4 * qq + 1] * il * siluf_(hi16(gb[0]))); yo[1] = cvt2(o1[4 * qq + 2] * il * siluf_(lo16(gb[1])), o1[4 * qq + 3] * il * siluf_(hi16(gb[1])));
                  *(u32x2*)(F.Y0() + m * D + 512 + hq * 64 + d) = yo; }
            }
        }
    }
    __syncthreads();
}

__device__ __forceinline__ void rows_final(Frame& F, const int m0, const int n, const int s, const int lane) {
    const float* mod1 = F.MOD() + (size_t)(24 + s) * 3072;
    f32x4 A1[4];
#pragma unroll
    for (int j = 0; j < 4; ++j) { const int c = 4 * lane + 256 * j; const f32x4 g = *(const f32x4*)(F.in[27] + c), gt = *(const f32x4*)(mod1 + 2048 + c);
#pragma unroll
        for (int e = 0; e < 4; ++e) A1[j][e] = gt[e] * g[e]; }
    u32x2 ycur[4]; f32x4 xcur[4];
#pragma unroll
    for (int j = 0; j < 4; ++j) { ycur[j] = *(const u32x2*)(F.YO() + (size_t)m0 * D + 4 * lane + 256 * j); xcur[j] = *(const f32x4*)(F.out + O_Y + (size_t)m0 * D + 4 * lane + 256 * j); }
    for (int i = 0; i < n; ++i) {
        const int m = m0 + i, mn = m0 + (i + 1 < n ? i + 1 : i); u32x2 ynxt[4]; f32x4 xnxt[4];
#pragma unroll
        for (int j = 0; j < 4; ++j) { ynxt[j] = *(const u32x2*)(F.YO() + (size_t)mn * D + 4 * lane + 256 * j); xnxt[j] = *(const f32x4*)(F.out + O_Y + (size_t)mn * D + 4 * lane + 256 * j); }
        f32x4 y[4]; float ss = 0.f;
#pragma unroll
        for (int j = 0; j < 4; ++j) { y[j] = (f32x4){lo16(ycur[j][0]), hi16(ycur[j][0]), lo16(ycur[j][1]), hi16(ycur[j][1])}; ss += (y[j][0] * y[j][0] + y[j][1] * y[j][1]) + (y[j][2] * y[j][2] + y[j][3] * y[j][3]); }
        const float r1 = rsqrtf(wave_sum(ss, lane) * (1.f / D) + EPS);
#pragma unroll
        for (int j = 0; j < 4; ++j) { f32x4 o;
#pragma unroll
            for (int e = 0; e < 4; ++e) o[e] = xcur[j][e] + A1[j][e] * (y[j][e] * r1);
            *(f32x4*)(F.out + O_Y + (size_t)m * D + 4 * lane + 256 * j) = o; }
#pragma unroll
        for (int j = 0; j < 4; ++j) { ycur[j] = ynxt[j]; xcur[j] = xnxt[j]; }
    }
}
__device__ __forceinline__ void phase_final_rowwise(Frame& F) {
    PHASE_IDS();
    const int gw = F.vcu * 8 + wave, NGW = F.G * 8;
    for (int w = gw; w < MP / 16; w += NGW) rows_final(F, w * 16, 16, w >> 8, lane);
    for (int w = gw; w < MS; w += NGW) rows_final(F, MP + w, 1, BP + (w >> 4), lane);
}

__global__ void __launch_bounds__(512, 2) fwd_megakernel(Params P) {
    extern __shared__ __attribute__((aligned(16))) unsigned char lds_raw[];
    Frame F;
    F.lds = (LAS unsigned char*)lds_raw;
    F.wv = __builtin_amdgcn_readfirstlane(threadIdx.x >> 6);
    F.G = gridDim.x; { const int bx = blockIdx.x; F.vcu = (F.G % 8 == 0) ? (bx % 8) * (F.G / 8) + bx / 8 : bx; }
    F.in = P.in; F.out = P.out; F.ws = P.ws;

    volatile LAS unsigned* misc = (volatile LAS unsigned*)(F.lds + LDS_BYTES - 64);
    if (threadIdx.x < 16) misc[threadIdx.x] = 0u;
    __syncthreads();
    XcdBarrier xbar = xcd_barrier_post((unsigned*)(P.ws + WS_CTL), misc);
#define GRID_BAR() xcd_barrier(xbar, F.wv)
    phase_prologue(F);
    GRID_BAR();
    phase_prenorm0(F);
    GRID_BAR();
    { pg8::Gemm g{F.XN(), F.W0I(), MT, EV_IN, D}; pg8::StaticOrder S; S.init(MT, EV_IN, F.G, (int)blockIdx.x);
      pg8::EpiBf16 E{F.U0(), EV_IN, 1 << 30, F.U0(), EV_IN}; pg8::gemm_phase(F.lds, g, S, E, F.wv); }
    GRID_BAR();
    phase_rope(F);
    phase_lru<1>(F);
    phase_vt_build(F);
    GRID_BAR();
    phase_lru<2>(F);
    phase_attn(F);
    GRID_BAR();
    { pg8::Gemm g{F.Y0(), F.W0O(), MT, D, D}; pg8::StaticOrder S; S.init(MT, D, F.G, (int)blockIdx.x);
      pg8::EpiBf16 E{F.YO(), D, 1 << 30, F.YO(), D}; pg8::gemm_phase(F.lds, g, S, E, F.wv); }
    GRID_BAR();
    phase_mid_rowwise(F);
    GRID_BAR();
    { pg8::Gemm g{F.XN(), F.W1I(), MT, OD_MAIN, D}; pg8::StaticOrder S; S.init(MT, OD_MAIN, F.G, (int)blockIdx.x);
      pg8::EpiBf16 E{F.QKV1(), 3072, 3072, F.Z1(), D}; pg8::gemm_phase(F.lds, g, S, E, F.wv); }
    GRID_BAR();
    phase_gdn_fused(F);
    GRID_BAR();
    phase_gdn_g2_samples(F);
    GRID_BAR();
    { pg8::Gemm g{F.Y1(), F.W1O(), MT, D, D}; pg8::StaticOrder S; S.init(MT, D, F.G, (int)blockIdx.x);
      pg8::EpiBf16 E{F.YO(), D, 1 << 30, F.YO(), D}; pg8::gemm_phase(F.lds, g, S, E, F.wv); }
    GRID_BAR();
    phase_final_rowwise(F);
}

extern "C" void kernel_launch(void* const* d_in, const int* in_sizes, int n_in, void* d_out, int out_size, void* d_ws, size_t ws_size, hipStream_t stream) {
    static int grid = 0;
    if (grid == 0) {
        if (n_in != 34 || out_size != (int)O_END || ws_size < WS_END) { grid = -1; return; }
        int dev = 0, cus = 0, per_cu = 0;
        if (hipGetDevice(&dev) != hipSuccess || hipDeviceGetAttribute(&cus, hipDeviceAttributeMultiprocessorCount, dev) != hipSuccess) { grid = -1; return; }
        if (hipFuncSetAttribute((const void*)fwd_megakernel, hipFuncAttributeMaxDynamicSharedMemorySize, LDS_BYTES) != hipSuccess) { grid = -1; return; }
        if (hipOccupancyMaxActiveBlocksPerMultiprocessor(&per_cu, (const void*)fwd_megakernel, 512, LDS_BYTES) != hipSuccess || per_cu < 1) { grid = -1; return; }
        grid = cus;
    }
    if (grid < 0) return;
    if (hipMemsetAsync((char*)d_ws + WS_CTL, 0, 65536 + 262144, stream) != hipSuccess) return;
    Params p{};
    for (int i = 0; i < 34; ++i) p.in[i] = (const float*)d_in[i];
    p.out = (float*)d_out; p.ws = (unsigned char*)d_ws;
    void* args[] = {&p};
    (void)hipLaunchCooperativeKernel((const void*)fwd_megakernel, dim3(grid), dim3(512), args, LDS_BYTES, stream);
}
```

```cpp
#include <hip/hip_runtime.h>
#include <hip/hip_cooperative_groups.h>
namespace cg = cooperative_groups;

#define LAS __attribute__((address_space(3)))
typedef unsigned short bf16_t;
typedef short bf16x8 __attribute__((ext_vector_type(8)));
typedef float f32x4 __attribute__((ext_vector_type(4)));
typedef float f32x2 __attribute__((ext_vector_type(2)));
typedef unsigned u32x4 __attribute__((ext_vector_type(4)));
typedef unsigned u32x2 __attribute__((ext_vector_type(2)));

constexpr int D = 1024, BP = 8, TP = 4096, BS = 16, TS = 16;
constexpr int MP = BP * TP, MS = BS * TS, MT = MP + MS;
constexpr int NSEQ = BP + BS;
constexpr int EV_IN = 2304, OD_IN = 4112, OD_MAIN = 4096;
constexpr int C_XA = 0, C_GA = 512, C_Q = 1024, C_K = 1536, C_V = 1664, C_GB = 1792;
constexpr float EPS = 1e-6f;
constexpr size_t O_Y = 0, O_LCP = 33816576, O_LCS = 33828864, O_LHP = 33853440, O_LHS = 33857536, O_KP = 33865728, O_KS = 33996800,
                 O_VP = 34029568, O_VS = 34160640, O_GCP = 34193408, O_GCS = 34267136, O_GSP = 34414592, O_GSS = 35463168, O_END = 37560320;
constexpr size_t MiB = 1u << 20;
constexpr size_t WS_CTL = 0, WS_W1O = 1 * MiB, WS_MOD = 3 * MiB, WS_ROPE = 4 * MiB, WS_BA = 5 * MiB, WS_LAG = 8 * MiB, WS_LGW = 10 * MiB;
constexpr size_t WS_RA = 16 * MiB, RA_BYTES = (size_t)MT * 4096 * 2;
constexpr size_t WS_RB = WS_RA + RA_BYTES;
constexpr size_t ACT_BYTES = (size_t)MT * D * 2;
constexpr size_t RB_XN = 0, RB_Y0 = ACT_BYTES, RB_YO = 2 * ACT_BYTES, RB_W0I = 3 * ACT_BYTES, RB_W0O = RB_W0I + (size_t)EV_IN * D * 2,
                 RB_W1I = RB_W0O + (size_t)D * D * 2, RB_WEND = RB_W1I + (size_t)OD_MAIN * D * 2;
constexpr size_t RB_BYTES = (size_t)4224 * 73728;
constexpr size_t WS_END = WS_RB + RB_BYTES;
static_assert(RB_WEND <= RB_BYTES, "ws map");
static_assert((size_t)MT * 3072 * 2 <= RB_BYTES, "ws map");
constexpr int LDS_BYTES = 155648;

struct Params { const float* in[34]; float* out; unsigned char* ws; };

__device__ __forceinline__ float bf2f(bf16_t b) { return __uint_as_float(((unsigned)b) << 16); }
__device__ __forceinline__ unsigned f2bf(float f) { unsigned u = __float_as_uint(f); return (u + 0x7fffu + ((u >> 16) & 1u)) >> 16; }
__device__ __forceinline__ unsigned pk2(float lo, float hi) { return f2bf(lo) | (f2bf(hi) << 16); }
typedef __bf16 bf16x2_t __attribute__((ext_vector_type(2)));
__device__ __forceinline__ unsigned cvt2(float a, float b) { f32x2 v = {a, b}; bf16x2_t r = __builtin_convertvector(v, bf16x2_t); return __builtin_bit_cast(unsigned, r); }
__device__ __forceinline__ float lo16(unsigned w) { return __uint_as_float(w << 16); }
__device__ __forceinline__ float hi16(unsigned w) { return __uint_as_float(w & 0xffff0000u); }
__device__ __forceinline__ float shfl_idx(float x, int src_lane) { return __int_as_float(__builtin_amdgcn_ds_bpermute(src_lane << 2, __float_as_int(x))); }
__device__ __forceinline__ float shfl_xor_l(float x, int o, int lane) { return shfl_idx(x, lane ^ o); }
__device__ __forceinline__ float wave_sum(float v, int lane) {
#pragma unroll
    for (int o = 1; o < 64; o <<= 1) v += shfl_xor_l(v, o, lane);
    return v;
}
__device__ __forceinline__ float sigmoidf_(float x) { return __builtin_amdgcn_rcpf(1.0f + __expf(-x)); }
__device__ __forceinline__ float siluf_(float x) { return x * __builtin_amdgcn_rcpf(1.0f + __expf(-x)); }
__device__ __forceinline__ float softplusf_(float x) { return x > 20.f ? x : log1pf(__expf(x)); }
__device__ __forceinline__ int seq_base(int s) { return s < BP ? s * TP : MP + (s - BP) * TS; }
__device__ __forceinline__ int seq_len(int s) { return s < BP ? TP : TS; }
__device__ __forceinline__ void tok_info(int m, int& s, int& t) { if (m < MP) { s = m >> 12; t = m & 4095; } else { const int r = m - MP; s = BP + (r >> 4); t = r & 15; } }

__device__ __forceinline__ int opaque_tid(int wv) { unsigned z = 0u; asm volatile("" : "+v"(z)); const int l = __builtin_amdgcn_mbcnt_hi(~0u, __builtin_amdgcn_mbcnt_lo(~0u, z)); return wv * 64 + l; }
namespace pg8 {
constexpr int BM = 256, BK = 64, HALF = 128, HTB = HALF * BK * 2, STAGE_BYTES = 8 * HTB, NXCD = 8, WGM = 8;
__host__ __device__ __forceinline__ int lds_byte(int r, int c) { const int st = (r >> 4) * 2 + (c >> 5), rr = r & 15, cc = c & 31, ob = rr * 64 + cc * 2; return st * 1024 + (ob ^ (((ob >> 9) & 1) << 5)); }
__host__ __device__ __forceinline__ void stage_rc(int b, int& R, int& C) { const int st = b / 1024, sb = b % 1024, swz = sb ^ (((sb >> 9) & 1) << 5); R = (st >> 1) * 16 + swz / 64; C = (st & 1) * 32 + (swz % 64) / 2; }
__host__ __device__ __forceinline__ int perm32(int rho) { const int n = rho >> 4, i = rho & 15; return 8 * (i >> 2) + 4 * n + (i & 3); }
struct Unit { int pm, pn; };
struct Gemm { const bf16_t* A; const bf16_t* Bt; int M, N, K; };
struct StaticOrder {
    int nM, nN, nwg, G, c;
    __device__ void init(int M, int N, int G_, int c_) { nM = M / BM; nN = N / BM; nwg = nM * nN; G = G_; c = c_; }
    __device__ bool next(int i, Unit& u) const {
        const long L = (long)i * G + c; if (L >= nwg) return false;
        int wgid = (int)L; { const int q = nwg / NXCD, r = nwg % NXCD, xcd = wgid % NXCD, off = wgid / NXCD; wgid = (xcd < r ? xcd * (q + 1) : r * (q + 1) + (xcd - r) * q) + off; }
        const int nig = WGM * nN, gid = wgid / nig, fm = gid * WGM, gsz = (nM - fm) < WGM ? (nM - fm) : WGM;
        u.pm = fm + ((wgid % nig) % gsz); u.pn = (wgid % nig) / gsz; return true;
    }
};
__device__ __forceinline__ unsigned cvt_pk_bf16(float lo, float hi) { unsigned r; asm volatile("v_cvt_pk_bf16_f32 %0, %1, %2" : "=v"(r) : "v"(lo), "v"(hi)); return r; }
struct EpiBf16 {
    static constexpr bool PERM = true;
    bf16_t* O0; int ld0; int split; bf16_t* O1; int ld1;
    __device__ __forceinline__ void operator()(const f32x4 (&acc)[2][2][4][2], const Unit& u, int wr, int wc, int fr, int fq) const {
        const int row0 = u.pm * BM + wr * 64 + fr; int colt = u.pn * BM; bf16_t* base = O0; int ld = ld0;
        if (colt >= split) { base = O1; ld = ld1; colt -= split; }
        const int col0 = colt + wc * 32 + 8 * fq;
#pragma unroll
        for (int ai = 0; ai < 2; ++ai)
#pragma unroll
            for (int m = 0; m < 4; ++m) { bf16_t* rowp = base + (size_t)(row0 + ai * HALF + m * 16) * ld + col0;
#pragma unroll
                for (int bj = 0; bj < 2; ++bj) { const f32x4 v0 = acc[ai][bj][m][0], v1 = acc[ai][bj][m][1];
                    u32x4 w; w.x = cvt_pk_bf16(v0[0], v0[1]); w.y = cvt_pk_bf16(v0[2], v0[3]); w.z = cvt_pk_bf16(v1[0], v1[1]); w.w = cvt_pk_bf16(v1[2], v1[3]);
                    *(u32x4*)(rowp + bj * HALF) = w; } }
    }
};
template <class Epi, class Sched>
__device__ __forceinline__ void gemm_phase(LAS unsigned char* lds, const Gemm g, const Sched& S, const Epi& E, const int wv0) {
    int tid = opaque_tid(wv0);
    const int wid = __builtin_amdgcn_readfirstlane(tid >> 6), lane = tid & 63, wr = wid >> 2, wc = wid & 3, fr = lane & 15, fq = lane >> 4;
    const int K = g.K, nt = K / BK;
    unsigned voffA[2], voffB[2];
#pragma unroll
    for (int i = 0; i < 2; ++i) { int R, C; stage_rc(tid * 16 + i * 8192, R, C); const int Rb = Epi::PERM ? ((R & ~31) + perm32(R & 31)) : R;
        voffA[i] = (unsigned)(R * K + C) * 2u; voffB[i] = (unsigned)(Rb * K + C) * 2u; }
    const size_t kstep = (size_t)(BK * 2);
    const size_t hstep = (size_t)HALF * K * 2;
    const size_t tstep = 2 * hstep;
    const unsigned ldsw = (unsigned)wid * 1024u;
    const int aoff = lds_byte(wr * 64 + fr, fq * 8), boff = lds_byte(wc * 32 + fr, fq * 8);
#define PG8_SA(b, h) (((b) * 2 + (h)) * HTB)
#define PG8_SB(b, h) ((4 + (b) * 2 + (h)) * HTB)
#define PG8_STAGE(bufoff, gbase, voff) do { _Pragma("unroll") for (int _i = 0; _i < 2; ++_i) \
        __builtin_amdgcn_global_load_lds((const unsigned*)((const char*)(gbase) + (voff)[_i]), (LAS unsigned*)(lds + (bufoff) + ldsw + _i * 8192), 16, 0, 0); } while (0)
#define PG8_LDA(dst, b, h) do { _Pragma("unroll") for (int m = 0; m < 4; ++m) _Pragma("unroll") for (int k = 0; k < 2; ++k) dst[m][k] = *(const LAS bf16x8*)(lds + PG8_SA(b, h) + aoff + m * 2048 + k * 1024); } while (0)
#define PG8_LDB(dst, b, h) do { _Pragma("unroll") for (int n = 0; n < 2; ++n) _Pragma("unroll") for (int k = 0; k < 2; ++k) dst[n][k] = *(const LAS bf16x8*)(lds + PG8_SB(b, h) + boff + n * 2048 + k * 1024); } while (0)
#define PG8_MMA(ai, bj, At, Bt) do { __builtin_amdgcn_s_setprio(1); _Pragma("unroll") for (int m = 0; m < 4; ++m) _Pragma("unroll") for (int n = 0; n < 2; ++n) _Pragma("unroll") for (int k = 0; k < 2; ++k) \
        acc[ai][bj][m][n] = __builtin_amdgcn_mfma_f32_16x16x32_bf16(Bt[n][k], At[m][k], acc[ai][bj][m][n], 0, 0, 0); __builtin_amdgcn_s_setprio(0); } while (0)
#define PG8_WAIT_V(n) asm volatile("s_waitcnt vmcnt(" #n ")" ::: "memory")
#define PG8_WAIT_L(n) asm volatile("s_waitcnt lgkmcnt(" #n ")" ::: "memory")
#define PG8_BAR __builtin_amdgcn_s_barrier()
#define PG8_SCHED __builtin_amdgcn_sched_barrier(0)
    Unit cur, nxt; int ui = 0;
    if (!S.next(0, cur)) return;
    f32x4 acc[2][2][4][2];
#pragma unroll
    for (int a = 0; a < 2; ++a)
#pragma unroll
        for (int b = 0; b < 2; ++b)
#pragma unroll
            for (int m = 0; m < 4; ++m)
#pragma unroll
                for (int n = 0; n < 2; ++n) acc[a][b][m][n] = (f32x4){0.f, 0.f, 0.f, 0.f};
    bf16x8 At[4][2], B0[2][2], B1[2][2];
    const char* cA = (const char*)g.A + (size_t)cur.pm * tstep; const char* cB = (const char*)g.Bt + (size_t)cur.pn * tstep;
    PG8_STAGE(PG8_SB(0, 0), cB, voffB); PG8_STAGE(PG8_SA(0, 0), cA, voffA); PG8_STAGE(PG8_SB(0, 1), cB + hstep, voffB); PG8_STAGE(PG8_SA(0, 1), cA + hstep, voffA);
    if (wr == 1) PG8_BAR;
    PG8_WAIT_V(4); PG8_BAR;
    PG8_STAGE(PG8_SB(1, 0), cB + kstep, voffB); PG8_STAGE(PG8_SA(1, 0), cA + kstep, voffA); PG8_STAGE(PG8_SB(1, 1), cB + hstep + kstep, voffB);
    PG8_WAIT_V(6); PG8_BAR;
    for (;;) {
        const bool has_next = S.next(ui + 1, nxt);
        const char* nA = has_next ? (const char*)g.A + (size_t)nxt.pm * tstep : cA; const char* nB = has_next ? (const char*)g.Bt + (size_t)nxt.pn * tstep : cB;
        for (int t = 0; t < nt; t += 2) {
            const bool last = (t == nt - 2);
            const char* a1 = cA + (size_t)(t + 1) * kstep;
            const char* a2 = last ? nA : cA + (size_t)(t + 2) * kstep; const char* b2 = last ? nB : cB + (size_t)(t + 2) * kstep;
            const char* a3 = a2 + kstep; const char* b3 = b2 + kstep;
            PG8_LDB(B0, 0, 0); PG8_SCHED; PG8_LDA(At, 0, 0); PG8_STAGE(PG8_SA(1, 1), a1 + hstep, voffA);
            PG8_WAIT_L(8); PG8_BAR; PG8_WAIT_L(0); PG8_MMA(0, 0, At, B0); PG8_BAR; PG8_SCHED;
            PG8_LDB(B1, 0, 1); PG8_STAGE(PG8_SB(0, 0), b2, voffB);
            PG8_BAR; PG8_WAIT_L(0); PG8_MMA(0, 1, At, B1); PG8_BAR;
            PG8_LDA(At, 0, 1); PG8_STAGE(PG8_SA(0, 0), a2, voffA);
            PG8_BAR; PG8_WAIT_L(0); PG8_MMA(1, 0, At, B0); PG8_BAR; PG8_SCHED;
            PG8_STAGE(PG8_SB(0, 1), b2 + hstep, voffB);
            PG8_WAIT_V(6); PG8_BAR; PG8_MMA(1, 1, At, B1); PG8_BAR;
            PG8_LDB(B0, 1, 0); PG8_SCHED; PG8_LDA(At, 1, 0); PG8_STAGE(PG8_SA(0, 1), a2 + hstep, voffA);
            PG8_WAIT_L(8); PG8_BAR; PG8_WAIT_L(0); PG8_MMA(0, 0, At, B0); PG8_BAR; PG8_SCHED;
            PG8_LDB(B1, 1, 1); PG8_STAGE(PG8_SB(1, 0), b3, voffB);
            PG8_BAR; PG8_WAIT_L(0); PG8_MMA(0, 1, At, B1); PG8_BAR;
            PG8_LDA(At, 1, 1); PG8_STAGE(PG8_SA(1, 0), a3, voffA);
            PG8_BAR; PG8_WAIT_L(0); PG8_MMA(1, 0, At, B0); PG8_BAR; PG8_SCHED;
            PG8_STAGE(PG8_SB(1, 1), b3 + hstep, voffB);
            PG8_WAIT_V(6); PG8_BAR; PG8_MMA(1, 1, At, B1); PG8_BAR;
        }
        E(acc, cur, wr, wc, fr, fq);
        if (!has_next) break;
#pragma unroll
        for (int a = 0; a < 2; ++a)
#pragma unroll
            for (int b = 0; b < 2; ++b)
#pragma unroll
                for (int m = 0; m < 4; ++m)
#pragma unroll
                    for (int n = 0; n < 2; ++n) acc[a][b][m][n] = (f32x4){0.f, 0.f, 0.f, 0.f};
        cur = nxt; cA = nA; cB = nB; ++ui;
    }
    PG8_WAIT_V(0);
    if (wr == 0) PG8_BAR;
    PG8_BAR;
#undef PG8_SA
#undef PG8_SB
#undef PG8_STAGE
#undef PG8_LDA
#undef PG8_LDB
#undef PG8_MMA
#undef PG8_WAIT_V
#undef PG8_WAIT_L
#undef PG8_BAR
#undef PG8_SCHED
}
}


#define XB_TMO      128
#define XB_XCNT(j)  (256  + 64 * (j))
#define XB_XSUB(j)  (1280 + 64 * (j))
#define XB_XGEN(j)  (2304 + 64 * (j))
#define XB_TOP      3328
#define XB_TOPGEN   3392
#define XCD_BAR_WORDS 3456
#define XB_SPIN_CAP (1u << 18)
__device__ __forceinline__ unsigned xb_ld(unsigned* p)              { return __hip_atomic_load(p, __ATOMIC_RELAXED, __HIP_MEMORY_SCOPE_AGENT); }
__device__ __forceinline__ unsigned xb_add(unsigned* p, unsigned v) { return __hip_atomic_fetch_add(p, v, __ATOMIC_RELAXED, __HIP_MEMORY_SCOPE_AGENT); }
__device__ __forceinline__ unsigned xb_xcc_id() { return (unsigned)__builtin_amdgcn_s_getreg((3 << 11) | 20) & 0xFu; }
#define XB_SPIN(cond, bar) do { unsigned _sp = 0; while (cond) { __builtin_amdgcn_s_sleep(1); \
    if ((++_sp & 255u) == 0u) { if (xb_ld(&(bar)[XB_TMO])) break; if (_sp > XB_SPIN_CAP) { atomicAdd(&(bar)[XB_TMO], 1u); break; } } } } while (0)
struct XcdBarrier { unsigned* bar; unsigned x; volatile LAS unsigned* st; };
__device__ __forceinline__ XcdBarrier xcd_barrier_post(unsigned* bar, volatile LAS unsigned* st) {
    XcdBarrier b; b.bar = bar; b.x = xb_xcc_id(); b.st = st;
    if (threadIdx.x == 0) (void)xb_add(&bar[XB_XCNT(b.x)], 1u);
    return b;
}
__device__ __forceinline__ void xcd_barrier_complete(unsigned* bar, unsigned x, unsigned& nloc, unsigned& nx) {
    const unsigned G = gridDim.x * gridDim.y * gridDim.z;
    unsigned sum, cnt, mine, sp = 0u;
    for (;;) {
        sum = 0u; cnt = 0u; mine = 0u;
#pragma unroll
        for (unsigned j = 0; j < 16; ++j) { const unsigned c = xb_ld(&bar[XB_XCNT(j)]); sum += c; cnt += (c > 0u) ? 1u : 0u; mine = (j == x) ? c : mine; }
        if (sum == G) break;
        __builtin_amdgcn_s_sleep(1);
        if ((++sp & 255u) == 0u) { if (xb_ld(&bar[XB_TMO])) break; if (sp > XB_SPIN_CAP) { atomicAdd(&bar[XB_TMO], 1u); break; } }
    }
    nloc = mine > 0u ? mine : 1u; nx = cnt > 0u ? cnt : 1u;
}
__device__ __forceinline__ void xcd_barrier(const XcdBarrier& b, const int wv0) {
    asm volatile("s_waitcnt vmcnt(0)" ::: "memory");
    __syncthreads();
    if (opaque_tid(wv0) == 0) {
        unsigned* bar = b.bar;
        __builtin_amdgcn_s_waitcnt(0);
        unsigned nloc = b.st[0], nx = b.st[1];
        if (nloc == 0u) { xcd_barrier_complete(bar, b.x, nloc, nx); b.st[0] = nloc; b.st[1] = nx; }
        const unsigned old = xb_add(&bar[XB_XSUB(b.x)], 1u);
        const unsigned gen = old / nloc;
        if (old + 1u == (gen + 1u) * nloc) {
            __builtin_amdgcn_fence(__ATOMIC_RELEASE, "agent");
            asm volatile("s_waitcnt vmcnt(0)" ::: "memory");
            const unsigned og = xb_add(&bar[XB_TOP], 1u);
            const unsigned tg = og / nx;
            if (og + 1u == (tg + 1u) * nx) xb_add(&bar[XB_TOPGEN], 1u);
            else XB_SPIN(xb_ld(&bar[XB_TOPGEN]) == tg, bar);
            __builtin_amdgcn_fence(__ATOMIC_ACQUIRE, "agent");
            xb_add(&bar[XB_XGEN(b.x)], 1u);
            asm volatile("s_waitcnt vmcnt(0)" ::: "memory");
        } else {
            XB_SPIN(xb_ld(&bar[XB_XGEN(b.x)]) == gen, bar);
            __builtin_amdgcn_fence(__ATOMIC_ACQUIRE, "agent");
            asm volatile("s_waitcnt vmcnt(0)" ::: "memory");
        }
    }
    __syncthreads();
}

struct Frame {
    LAS unsigned char* lds;
    int vcu, G, wv;
    const float* const* in; float* out; unsigned char* ws;
    __device__ __forceinline__ float* MOD() const { return (float*)(ws + WS_MOD); }
    __device__ __forceinline__ float* ROPE() const { return (float*)(ws + WS_ROPE); }
    __device__ __forceinline__ float* BA() const { return (float*)(ws + WS_BA); }
    __device__ __forceinline__ float* LAG() const { return (float*)(ws + WS_LAG); }
    __device__ __forceinline__ bf16_t* W1O() const { return (bf16_t*)(ws + WS_W1O); }
    __device__ __forceinline__ bf16_t* U0() const { return (bf16_t*)(ws + WS_RA); }
    __device__ __forceinline__ bf16_t* QKV1() const { return (bf16_t*)(ws + WS_RA); }
    __device__ __forceinline__ bf16_t* Z1() const { return (bf16_t*)(ws + WS_RA + (size_t)MT * 3072 * 2); }
    __device__ __forceinline__ bf16_t* Y1() const { return (bf16_t*)(ws + WS_RA + (size_t)MT * 3072 * 2); }
    __device__ __forceinline__ bf16_t* XN() const { return (bf16_t*)(ws + WS_RB + RB_XN); }
    __device__ __forceinline__ bf16_t* Y0() const { return (bf16_t*)(ws + WS_RB + RB_Y0); }
    __device__ __forceinline__ bf16_t* YO() const { return (bf16_t*)(ws + WS_RB + RB_YO); }
    __device__ __forceinline__ bf16_t* W0I() const { return (bf16_t*)(ws + WS_RB + RB_W0I); }
    __device__ __forceinline__ bf16_t* W0O() const { return (bf16_t*)(ws + WS_RB + RB_W0O); }
    __device__ __forceinline__ bf16_t* W1I() const { return (bf16_t*)(ws + WS_RB + RB_W1I); }
    __device__ __forceinline__ bf16_t* QKVC() const { return (bf16_t*)(ws + WS_RB); }
};

#define PHASE_IDS() int tid = opaque_tid(F.wv); const int lane = tid & 63, wave = __builtin_amdgcn_readfirstlane(tid >> 6); (void)lane; (void)wave
__device__ __forceinline__ void p0_transpose_item(const float* W, int ldw, int nblk, int K, bf16_t* WT, LAS float* scr, int item, int lane) {
    const int kb = item / nblk, nb = item % nblk, k0 = 64 * kb, n0 = 32 * nb;
#pragma unroll 8
    for (int i = 0; i < 32; ++i) { const int kk = 2 * i + (lane >> 5); scr[kk * 33 + (lane & 31)] = W[(size_t)(k0 + kk) * ldw + n0 + (lane & 31)]; }
    asm volatile("s_waitcnt lgkmcnt(0)" ::: "memory");
    const int c = lane & 7;
#pragma unroll
    for (int j = 0; j < 4; ++j) { const int n = (lane >> 3) + 8 * j; const LAS float* s = scr + (8 * c) * 33 + n;
        u32x4 o; o.x = pk2(s[0 * 33], s[1 * 33]); o.y = pk2(s[2 * 33], s[3 * 33]); o.z = pk2(s[4 * 33], s[5 * 33]); o.w = pk2(s[6 * 33], s[7 * 33]);
        *(u32x4*)(WT + (size_t)(n0 + n) * K + k0 + 8 * c) = o; }
    asm volatile("s_waitcnt lgkmcnt(0)" ::: "memory");
}
__device__ __forceinline__ void phase_prologue(Frame& F) {
    PHASE_IDS();
    const int gw = F.vcu * 8 + wave, NGW = F.G * 8;
    {
        LAS float* scr = (LAS float*)(F.lds + wave * 16384);
        constexpr int I0 = 16 * (EV_IN / 32), I1 = 16 * 32, I2 = 16 * (OD_MAIN / 32), I3 = 16 * 32;
        const bool split = F.G >= 192; const int tw0 = split ? (F.vcu - 96) * 8 + wave : gw, tnw = split ? (F.G - 96) * 8 : NGW;
        for (int it = (split && F.vcu < 96) ? (I0 + I1 + I2 + I3) : tw0; it < I0 + I1 + I2 + I3; it += tnw) {
            int r = it;
            if (r < I0) { p0_transpose_item(F.in[14], EV_IN, EV_IN / 32, D, F.W0I(), scr, r, lane); continue; } r -= I0;
            if (r < I1) { p0_transpose_item(F.in[23], D, 32, D, F.W0O(), scr, r, lane); continue; } r -= I1;
            if (r < I2) { p0_transpose_item(F.in[28], OD_IN, OD_MAIN / 32, D, F.W1I(), scr, r, lane); continue; } r -= I2;
            p0_transpose_item(F.in[33], D, 32, D, F.W1O(), scr, r, lane);
        }
    }
    {
        const double inv[8] = {1.0, 0.19392274474868576, 0.03760603093086393, 0.007292664737217109, 0.001414213562373095, 0.0002742481756762073, 5.318295896944988e-05, 1.031338537721246e-05};
        for (int idx = F.vcu * 512 + tid; idx < 4112 * 8; idx += F.G * 512) {
            const int pos = idx >> 3, i = idx & 7;
            double iv = inv[0];
#pragma unroll
            for (int q = 1; q < 8; ++q) iv = (i == q) ? inv[q] : iv;
            const double ang = (double)pos * iv;
            const double n = __builtin_rint(ang * 0.15915494309189535);
            const float r = (float)__builtin_fma(-n, 6.283185307179586, ang);
            F.ROPE()[pos * 16 + i] = __cosf(r); F.ROPE()[pos * 16 + 8 + i] = __sinf(r);
        }
    }
    {
        bf16_t* LGW = (bf16_t*)(F.ws + WS_LGW);
        for (int idx = F.vcu * 512 + tid; idx < 8 * 2 * 64 * 64; idx += F.G * 512) { const int k = idx & 63, n = (idx >> 6) & 63, gate = (idx >> 12) & 1, hh = idx >> 13;
            LGW[idx] = (bf16_t)f2bf((gate ? F.in[19] : F.in[17])[(hh * 64 + k) * 64 + n]); }
    }
    __syncthreads();
    for (int bt = F.vcu; bt < 96; bt += F.G) {
        LAS float* tab = (LAS float*)F.lds;
        for (int idx = tid; idx < 24 * 1024; idx += 512) { const int s = idx >> 10, k = idx & 1023;
            const float c = s < BP ? F.in[8][s * D + k] : F.in[9][(s - BP) * D + k]; tab[k * 24 + s] = siluf_(c); }
        __syncthreads();
        const int L = bt / 48, n0 = (bt % 48) * 64;
        const float* mw = (L == 0 ? F.in[10] : F.in[24]) + n0 + lane;
        float acc[24];
#pragma unroll
        for (int r = 0; r < 24; ++r) acc[r] = 0.f;
        for (int k0 = wave * 128; k0 < wave * 128 + 128; k0 += 16) {
            float wv[16];
#pragma unroll
            for (int u = 0; u < 16; ++u) wv[u] = mw[(size_t)(k0 + u) * 3072];
#pragma unroll
            for (int u = 0; u < 16; ++u) { const float w = wv[u];
                const LAS f32x4* tp = (const LAS f32x4*)(tab + (k0 + u) * 24);
#pragma unroll
                for (int q = 0; q < 6; ++q) { const f32x4 t4 = tp[q]; acc[4 * q] += t4[0] * w; acc[4 * q + 1] += t4[1] * w; acc[4 * q + 2] += t4[2] * w; acc[4 * q + 3] += t4[3] * w; } }
        }
        __syncthreads();
        LAS float* red = (LAS float*)F.lds;
#pragma unroll
        for (int r = 0; r < 24; ++r) red[(wave * 24 + r) * 64 + lane] = acc[r];
        __syncthreads();
        const float* mb = (L == 0 ? F.in[11] : F.in[25]);
        for (int idx = tid; idx < 24 * 64; idx += 512) { const int r = idx >> 6, l = idx & 63; float s = 0.f;
#pragma unroll
            for (int w = 0; w < 8; ++w) s += red[(w * 24 + r) * 64 + l];
            F.MOD()[((size_t)L * 24 + r) * 3072 + n0 + l] = s + mb[n0 + l]; }
        __syncthreads();
    }
}

__device__ __forceinline__ const float* x_row(Frame& F, int m) { return m < MP ? F.in[0] + (size_t)m * D : F.in[1] + (size_t)(m - MP) * D; }
__device__ __forceinline__ void rows_prenorm0(Frame& F, const int m0, const int n, const int s, const int lane) {
    const float* modr = F.MOD() + (size_t)s * 3072;
    f32x4 A[4], C[4];
#pragma unroll
    for (int j = 0; j < 4; ++j) { const int c = 4 * lane + 256 * j; const f32x4 g = *(const f32x4*)(F.in[12] + c), sc = *(const f32x4*)(modr + 1024 + c); C[j] = *(const f32x4*)(modr + c);
#pragma unroll
        for (int e = 0; e < 4; ++e) A[j][e] = g[e] * (1.f + sc[e]); }
    f32x4 cur[4];
#pragma unroll
    for (int j = 0; j < 4; ++j) cur[j] = *(const f32x4*)(x_row(F, m0) + 4 * lane + 256 * j);
    for (int i = 0; i < n; ++i) {
        const int mn = m0 + (i + 1 < n ? i + 1 : i); f32x4 nxt[4];
#pragma unroll
        for (int j = 0; j < 4; ++j) nxt[j] = *(const f32x4*)(x_row(F, mn) + 4 * lane + 256 * j);
        float ss = 0.f;
#pragma unroll
        for (int j = 0; j < 4; ++j) ss += (cur[j][0] * cur[j][0] + cur[j][1] * cur[j][1]) + (cur[j][2] * cur[j][2] + cur[j][3] * cur[j][3]);
        const float r = rsqrtf(wave_sum(ss, lane) * (1.f / D) + EPS);
#pragma unroll
        for (int j = 0; j < 4; ++j) { u32x2 w; w[0] = cvt2(cur[j][0] * r * A[j][0] + C[j][0], cur[j][1] * r * A[j][1] + C[j][1]); w[1] = cvt2(cur[j][2] * r * A[j][2] + C[j][2], cur[j][3] * r * A[j][3] + C[j][3]);
            *(u32x2*)(F.XN() + (size_t)(m0 + i) * D + 4 * lane + 256 * j) = w; }
#pragma unroll
        for (int j = 0; j < 4; ++j) cur[j] = nxt[j];
    }
}
__device__ __forceinline__ void phase_prenorm0(Frame& F) {
    PHASE_IDS();
    const int gw = F.vcu * 8 + wave, NGW = F.G * 8;
    for (int w = gw; w < MP / 16; w += NGW) rows_prenorm0(F, w * 16, 16, w >> 8, lane);
    for (int w = gw; w < MS; w += NGW) rows_prenorm0(F, MP + w, 1, BP + (w >> 4), lane);
}

__device__ __forceinline__ void phase_rope(Frame& F) {
    PHASE_IDS();
    const int gt = F.vcu * 512 + tid, NT = F.G * 512;
    for (int idx = gt; idx < MT * 80; idx += NT) {
        const int m = idx / 80, r = idx % 80, slot = r >> 3, i = r & 7;
        int s, t; tok_info(m, s, t);
        const int pos = s < BP ? t : TP + t;
        const int col = slot < 8 ? C_Q + slot * 64 : C_K + (slot - 8) * 64;
        bf16_t* p = F.U0() + (size_t)m * EV_IN + col;
        const float x1 = bf2f(p[i]), x2 = bf2f(p[8 + i]), c = F.ROPE()[pos * 16 + i], sn = F.ROPE()[pos * 16 + 8 + i];
        const float o1 = x1 * c - x2 * sn, o2 = x2 * c + x1 * sn;
        p[i] = (bf16_t)f2bf(o1); p[8 + i] = (bf16_t)f2bf(o2);
        if (slot >= 8) { const int kv = slot - 8;
            if (s >= BP) { float* o = F.out + O_KS + ((size_t)((s - BP) * TS + t) * 2 + kv) * 64; o[i] = o1; o[8 + i] = o2; }
            else if (t >= TP - 128) { float* o = F.out + O_KP + ((size_t)(s * 128 + (t - (TP - 128))) * 2 + kv) * 64; o[i] = o1; o[8 + i] = o2; } }
    }
    for (int idx = gt; idx < 1280 * 224; idx += NT) {
        const int tk = idx / 224, e = idx % 224;
        int s, t, m; if (tk < 1024) { s = tk >> 7; t = TP - 128 + (tk & 127); m = s * TP + t; } else { s = BP + ((tk - 1024) >> 4); t = (tk - 1024) & 15; m = MP + (tk - 1024); }
        const bool isv = e >= 96; const int e2 = isv ? e - 96 : e; const int kv = isv ? (e2 >> 6) : (e2 / 48), d = isv ? (e2 & 63) : 16 + (e2 % 48);
        const float val = bf2f(F.U0()[(size_t)m * EV_IN + (isv ? C_V : C_K) + kv * 64 + d]);
        const size_t ob = s >= BP ? (isv ? O_VS : O_KS) + ((size_t)((s - BP) * TS + t) * 2 + kv) * 64 : (isv ? O_VP : O_KP) + ((size_t)(s * 128 + (t - (TP - 128))) * 2 + kv) * 64;
        F.out[ob + d] = val;
    }
}


__device__ __forceinline__ void rows_mid(Frame& F, LAS float* baw, const int m0, const int n, const int s, const int lane) {
    const float* mod0 = F.MOD() + (size_t)s * 3072; const float* mod1 = F.MOD() + (size_t)(24 + s) * 3072;
    f32x4 A0[4], B1[4], C1[4];
#pragma unroll
    for (int j = 0; j < 4; ++j) { const int c = 4 * lane + 256 * j; const f32x4 g0 = *(const f32x4*)(F.in[13] + c), gt = *(const f32x4*)(mod0 + 2048 + c), g1 = *(const f32x4*)(F.in[26] + c), sc = *(const f32x4*)(mod1 + 1024 + c);
        C1[j] = *(const f32x4*)(mod1 + c);
#pragma unroll
        for (int e = 0; e < 4; ++e) { A0[j][e] = gt[e] * g0[e]; B1[j][e] = g1[e] * (1.f + sc[e]); } }
    u32x2 ycur[4]; f32x4 xcur[4];
#pragma unroll
    for (int j = 0; j < 4; ++j) { ycur[j] = *(const u32x2*)(F.YO() + (size_t)m0 * D + 4 * lane + 256 * j); xcur[j] = *(const f32x4*)(x_row(F, m0) + 4 * lane + 256 * j); }
    for (int i = 0; i < n; ++i) {
        const int m = m0 + i, mn = m0 + (i + 1 < n ? i + 1 : i); u32x2 ynxt[4]; f32x4 xnxt[4];
#pragma unroll
        for (int j = 0; j < 4; ++j) { ynxt[j] = *(const u32x2*)(F.YO() + (size_t)mn * D + 4 * lane + 256 * j); xnxt[j] = *(const f32x4*)(x_row(F, mn) + 4 * lane + 256 * j); }
        f32x4 y[4]; float ss = 0.f;
#pragma unroll
        for (int j = 0; j < 4; ++j) { y[j] = (f32x4){lo16(ycur[j][0]), hi16(ycur[j][0]), lo16(ycur[j][1]), hi16(ycur[j][1])}; ss += (y[j][0] * y[j][0] + y[j][1] * y[j][1]) + (y[j][2] * y[j][2] + y[j][3] * y[j][3]); }
        const float r1 = rsqrtf(wave_sum(ss, lane) * (1.f / D) + EPS);
        f32x4 x1[4]; float s2 = 0.f;
#pragma unroll
        for (int j = 0; j < 4; ++j) {
#pragma unroll
            for (int e = 0; e < 4; ++e) x1[j][e] = xcur[j][e] + A0[j][e] * (y[j][e] * r1);
            *(f32x4*)(F.out + O_Y + (size_t)m * D + 4 * lane + 256 * j) = x1[j];
            s2 += (x1[j][0] * x1[j][0] + x1[j][1] * x1[j][1]) + (x1[j][2] * x1[j][2] + x1[j][3] * x1[j][3]); }
        const float r2 = rsqrtf(wave_sum(s2, lane) * (1.f / D) + EPS);
        f32x4 hm[4];
#pragma unroll
        for (int j = 0; j < 4; ++j) {
#pragma unroll
            for (int e = 0; e < 4; ++e) hm[j][e] = x1[j][e] * r2 * B1[j][e] + C1[j][e];
            u32x2 w; w[0] = cvt2(hm[j][0], hm[j][1]); w[1] = cvt2(hm[j][2], hm[j][3]); *(u32x2*)(F.XN() + (size_t)m * D + 4 * lane + 256 * j) = w; }
        float p[16];
#pragma unroll
        for (int q = 0; q < 16; ++q) { p[q] = 0.f;
#pragma unroll
            for (int j = 0; j < 4; ++j) { const f32x4 w = *(const LAS f32x4*)(baw + q * 1024 + 256 * j + 4 * lane); p[q] += (hm[j][0] * w[0] + hm[j][1] * w[1]) + (hm[j][2] * w[2] + hm[j][3] * w[3]); }
            if ((q & 3) == 3) __builtin_amdgcn_sched_barrier(0); }
        { const bool u5 = (lane & 32) != 0;
#pragma unroll
          for (int q = 0; q < 8; ++q) { const float keep = u5 ? p[8 + q] : p[q], send = u5 ? p[q] : p[8 + q]; p[q] = keep + shfl_xor_l(send, 32, lane); } }
        { const bool u4 = (lane & 16) != 0;
#pragma unroll
          for (int q = 0; q < 4; ++q) { const float keep = u4 ? p[4 + q] : p[q], send = u4 ? p[q] : p[4 + q]; p[q] = keep + shfl_xor_l(send, 16, lane); } }
        { const bool u3 = (lane & 8) != 0;
#pragma unroll
          for (int q = 0; q < 2; ++q) { const float keep = u3 ? p[2 + q] : p[q], send = u3 ? p[q] : p[2 + q]; p[q] = keep + shfl_xor_l(send, 8, lane); } }
        { const bool u2 = (lane & 4) != 0; const float keep = u2 ? p[1] : p[0], send = u2 ? p[0] : p[1]; p[0] = keep + shfl_xor_l(send, 4, lane); }
        float mine = p[0]; mine += shfl_xor_l(mine, 2, lane); mine += shfl_xor_l(mine, 1, lane);
        if ((lane & 3) == 0) { const int col = lane >> 2, hh = col & 7;
            F.BA()[(size_t)m * 16 + col] = col < 8 ? sigmoidf_(mine) : -__expf(F.in[30][hh]) * softplusf_(mine + F.in[31][hh]); }
#pragma unroll
        for (int j = 0; j < 4; ++j) { ycur[j] = ynxt[j]; xcur[j] = xnxt[j]; }
    }
}
__device__ __forceinline__ void phase_mid_rowwise(Frame& F) {
    PHASE_IDS();
    LAS float* baw = (LAS float*)F.lds;
    for (int idx = tid; idx < 16 * 1024; idx += 512) { const int j = idx & 15, k = idx >> 4; baw[j * 1024 + k] = F.in[28][(size_t)k * OD_IN + OD_MAIN + j]; }
    __syncthreads();
    const int gw = F.vcu * 8 + wave, NGW = F.G * 8;
    for (int w = gw; w < MP / 16; w += NGW) rows_mid(F, baw, w * 16, 16, w >> 8, lane);
    for (int w = gw; w < MS; w += NGW) rows_mid(F, baw, MP + w, 1, BP + (w >> 4), lane);
}


typedef float f32x16 __attribute__((ext_vector_type(16)));
constexpr int GS_WF = 0, GS_QF = 16384, GS_KF = 32768, GS_PF = 49152, GS_UF = 57344, GS_BYTES = 73728;
constexpr size_t WS_DEC = 11 * MiB;
__device__ __forceinline__ int krow(int s, int h, int j) { return 16 * s + 8 * (j >> 2) + 4 * h + (j & 3); }
#define MFMA32(a, b, c) __builtin_amdgcn_mfma_f32_32x32x16_bf16((a), (b), (c), 0, 0, 0)
#define MFMA16(a, b, c) __builtin_amdgcn_mfma_f32_16x16x32_bf16((a), (b), (c), 0, 0, 0)

typedef __amdgpu_buffer_rsrc_t brsrc_t;
__device__ __forceinline__ brsrc_t staging_rsrc(unsigned char* ws) { return __builtin_amdgcn_make_buffer_rsrc((void*)(ws + WS_RB), (short)0, (int)RB_BYTES, 0x00020000); }
__device__ __forceinline__ void st16_wt(brsrc_t r, unsigned off, u32x4 v) { __builtin_amdgcn_raw_buffer_store_b128(v, r, off, 0, 16); }
__device__ __forceinline__ u32x4 ld16_wt(brsrc_t r, unsigned off) { return __builtin_amdgcn_raw_buffer_load_b128(r, off, 0, 16); }
__device__ __forceinline__ void st8_wt(unsigned char* p, u32x2 v) { __hip_atomic_store((unsigned long long*)p, ((unsigned long long)v[1] << 32) | v[0], __ATOMIC_RELAXED, __HIP_MEMORY_SCOPE_AGENT); }
constexpr size_t WS_READY = 65536;
#define LDS_BARRIER() do { asm volatile("s_waitcnt lgkmcnt(0)" ::: "memory"); __builtin_amdgcn_s_barrier(); asm volatile("" ::: "memory"); } while (0)
constexpr int G1_QS = 0, G1_KS = 17408, G1_VS = 34816, G1_AS = 52224, G1_PS = 69632, G1_WS = 78848, G1_CW = 96256, G1_VEC = 102400, G1_ES = 103424;
__device__ __forceinline__ void g1_load_raw(Frame& F, u32x4 (&raw)[24], int s, int c, int h, int t1) {
    const int r = t1 >> 3, j = t1 & 7, t = c * 64 + r;
#pragma unroll
    for (int p = 0; p < 3; ++p)
#pragma unroll
        for (int jj = 0; jj < 4; ++jj) { const int tt = t - 3 + jj, ttc = tt < 0 ? 0 : tt;
            const u32x4* src = (const u32x4*)(F.QKV1() + (size_t)(s * TP + ttc) * 3072 + p * 1024 + h * 128 + j * 16); raw[p * 8 + jj * 2] = src[0]; raw[p * 8 + jj * 2 + 1] = src[1]; }
}
__device__ __forceinline__ bf16x8 g1_pack_b(const f32x4 p, const f32x4 q) { u32x4 w; w[0] = cvt2(p[0], p[1]); w[1] = cvt2(p[2], p[3]); w[2] = cvt2(q[0], q[1]); w[3] = cvt2(q[2], q[3]); return __builtin_bit_cast(bf16x8, w); }
__device__ __forceinline__ void g1_decode(int n, int& s, int& c, int& h) { if (n < 4096) { c = n >> 6; s = (n & 63) >> 3; h = n & 7; } else { s = BP + ((n - 4096) >> 3); c = 0; h = n & 7; } }
__device__ __forceinline__ void gdn_g1_tasks(Frame& F, const int first, const int stride) {
    int tid = opaque_tid(F.wv);
    const int lane = tid & 63, wave = __builtin_amdgcn_readfirstlane(tid >> 6);
    LAS unsigned char* L = F.lds;
    LAS float* cw_s = (LAS float*)(L + G1_CW);
    LAS float* beta_s = (LAS float*)(L + G1_VEC); LAS float* gcum_s = beta_s + 64; LAS float* eg_s = beta_s + 128; LAS float* ek_s = beta_s + 192;
    float* DEC = (float*)(F.ws + WS_DEC);
    u32x4 raw[24];
    float pcw[3], pb = 0.f, pa = 0.f;
    const brsrc_t srs = staging_rsrc(F.ws);
    unsigned* ready = (unsigned*)(F.ws + WS_READY);
    { int s0, c0, h0; g1_decode(first < 4095 ? first : 4095, s0, c0, h0); g1_load_raw(F, raw, s0, c0, h0, tid);
#pragma unroll
        for (int q = 0; q < 3; ++q) { const int i = tid + 512 * q, jj = i / 384, cc = i % 384; pcw[q] = F.in[29][(size_t)jj * 3072 + (cc >> 7) * 1024 + h0 * 128 + (cc & 127)]; }
        const float* ba = F.BA() + (size_t)(s0 * TP + c0 * 64 + (tid & 63)) * 16; pb = ba[h0]; pa = ba[8 + h0]; }
    for (int task = first; task < 4224; task += stride) {
        const int tid = opaque_tid(F.wv), lane = tid & 63;
        int s, c, h; g1_decode(task, s, c, h);
        const int nvalid = s < BP ? 64 : TS, t0 = c * 64, base = seq_base(s), T = seq_len(s);
        const int sidx = task < 4096 ? ((s * 8 + h) * 64 + c) : task;
        unsigned char* blk = F.ws + WS_RB + (size_t)sidx * GS_BYTES; const unsigned boff = (unsigned)sidx * (unsigned)GS_BYTES;
        if (s < BP) {
#pragma unroll
            for (int q = 0; q < 3; ++q) cw_s[tid + 512 * q] = pcw[q];
        } else for (int i = tid; i < 4 * 384; i += 512) { const int jj = i / 384, cc = i % 384; cw_s[i] = F.in[29][(size_t)jj * 3072 + (cc >> 7) * 1024 + h * 128 + (cc & 127)]; }
        if (tid < 64) {
            const bool ok = tid < nvalid; float beta = 0.f, g = 0.f;
            if (ok) { float vb = pb, va = pa; if (s >= BP) { const float* ba = F.BA() + (size_t)(base + t0 + tid) * 16; vb = ba[h]; va = ba[8 + h]; }
                beta = vb; g = va; }
            float x = g;
#pragma unroll
            for (int o = 1; o < 64; o <<= 1) { const float y = shfl_idx(x, lane >= o ? lane - o : lane); if (lane >= o) x += y; }
            const float gl = shfl_idx(x, 63);
            beta_s[tid] = beta; gcum_s[tid] = x; eg_s[tid] = __expf(x); ek_s[tid] = ok ? __expf(gl - x) : 0.f;
            if (tid == 0) __hip_atomic_store((unsigned*)DEC + sidx, __float_as_uint(__expf(gl)), __ATOMIC_RELAXED, __HIP_MEMORY_SCOPE_AGENT);
        }
        LDS_BARRIER();
        {
            int t1 = tid; asm volatile("" : "+v"(t1));
            const int r = t1 >> 3, j = t1 & 7, t = t0 + r; const bool ok = r < nvalid;
#pragma unroll
            for (int p = 0; p < 3; ++p) {
                float acc[16], cur[16];
#pragma unroll
                for (int e = 0; e < 16; ++e) { acc[e] = 0.f; cur[e] = 0.f; }
                const int cb = p * 1024 + h * 128 + j * 16;
#pragma unroll
                for (int jj = 0; jj < 4; ++jj) {
                    const int tt = t - 3 + jj; float x[16];
                    if (s < BP) { const u32x4 a = raw[p * 8 + jj * 2], b = raw[p * 8 + jj * 2 + 1]; const bool v = tt >= 0;
#pragma unroll
                        for (int e = 0; e < 4; ++e) { x[2 * e] = v ? lo16(a[e]) : 0.f; x[2 * e + 1] = v ? hi16(a[e]) : 0.f; x[8 + 2 * e] = v ? lo16(b[e]) : 0.f; x[8 + 2 * e + 1] = v ? hi16(b[e]) : 0.f; } }
                    else if (ok && tt >= 0) { const u32x4* src = (const u32x4*)(F.QKV1() + (size_t)(base + tt) * 3072 + cb); const u32x4 a = src[0], b = src[1];
#pragma unroll
                        for (int e = 0; e < 4; ++e) { x[2 * e] = lo16(a[e]); x[2 * e + 1] = hi16(a[e]); x[8 + 2 * e] = lo16(b[e]); x[8 + 2 * e + 1] = hi16(b[e]); } }
                    else if (ok) { const f32x4* src = (const f32x4*)(F.in[6] + ((size_t)(s - BP) * 3 + (tt + 3)) * 3072 + cb);
#pragma unroll
                        for (int q = 0; q < 4; ++q) { const f32x4 a = src[q]; x[4 * q] = a[0]; x[4 * q + 1] = a[1]; x[4 * q + 2] = a[2]; x[4 * q + 3] = a[3]; } }
                    else {
#pragma unroll
                        for (int e = 0; e < 16; ++e) x[e] = 0.f; }
                    const LAS f32x4* wp = (const LAS f32x4*)(cw_s + jj * 384 + p * 128 + j * 16);
#pragma unroll
                    for (int q = 0; q < 4; ++q) { const f32x4 w4 = wp[q]; acc[4 * q] += w4[0] * x[4 * q]; acc[4 * q + 1] += w4[1] * x[4 * q + 1]; acc[4 * q + 2] += w4[2] * x[4 * q + 2]; acc[4 * q + 3] += w4[3] * x[4 * q + 3]; }
                    if (jj == 3) {
#pragma unroll
                        for (int e = 0; e < 16; ++e) cur[e] = x[e]; }
                }
                if (ok && t >= T - 3) {
                    float* o = (s < BP ? F.out + O_GCP + ((size_t)s * 3 + (t - (T - 3))) * 3072 : F.out + O_GCS + ((size_t)(s - BP) * 3 + (t - (T - 3))) * 3072) + cb;
#pragma unroll
                    for (int q = 0; q < 4; ++q) *(f32x4*)(o + 4 * q) = (f32x4){cur[4 * q], cur[4 * q + 1], cur[4 * q + 2], cur[4 * q + 3]};
                }
                float ss = 0.f;
#pragma unroll
                for (int e = 0; e < 16; ++e) { acc[e] = siluf_(acc[e]); ss += acc[e] * acc[e]; }
                if (p < 2) { ss += shfl_xor_l(ss, 1, lane); ss += shfl_xor_l(ss, 2, lane); ss += shfl_xor_l(ss, 4, lane);
                    float sc = rsqrtf(ss + EPS); if (p == 0) sc *= 0.08838834764831845f;
#pragma unroll
                    for (int e = 0; e < 16; ++e) acc[e] *= sc; }
                u32x4 w0, w1;
#pragma unroll
                for (int e = 0; e < 4; ++e) { w0[e] = ok ? cvt2(acc[2 * e], acc[2 * e + 1]) : 0u; w1[e] = ok ? cvt2(acc[8 + 2 * e], acc[8 + 2 * e + 1]) : 0u; }
                LAS u32x4* dst = (LAS u32x4*)(L + (p == 0 ? G1_QS : p == 1 ? G1_KS : G1_VS) + r * 272 + j * 32);
                dst[0] = w0; dst[1] = w1;
                __builtin_amdgcn_sched_barrier(0);
            }
            { const int ntk = task + stride < 4095 ? task + stride : 4095; int s1, c1, h1; g1_decode(ntk, s1, c1, h1); g1_load_raw(F, raw, s1, c1, h1, t1);
#pragma unroll
              for (int q = 0; q < 3; ++q) { const int i = t1 + 512 * q, jj = i / 384, cc = i % 384; pcw[q] = F.in[29][(size_t)jj * 3072 + (cc >> 7) * 1024 + h1 * 128 + (cc & 127)]; }
              const float* ba = F.BA() + (size_t)(s1 * TP + c1 * 64 + (t1 & 63)) * 16; pb = ba[h1]; pa = ba[8 + h1]; }
        }
        LDS_BARRIER();
        {
            int l2 = lane; asm volatile("" : "+v"(l2));
            const int which = wave >> 2, ti = (wave >> 1) & 1, tj = wave & 1, r = l2 & 31, hh = l2 >> 5;
            f32x16 acc;
#pragma unroll
            for (int e = 0; e < 16; ++e) acc[e] = 0.f;
            if (!(ti == 0 && tj == 1)) {
                const LAS unsigned char* ap = L + (which ? G1_QS : G1_KS) + (32 * ti + r) * 272 + hh * 16;
                const LAS unsigned char* bp = L + G1_KS + (32 * tj + r) * 272 + hh * 16;
#pragma unroll
                for (int ks = 0; ks < 8; ++ks) { const bf16x8 a = *(const LAS bf16x8*)(ap + ks * 32), b = *(const LAS bf16x8*)(bp + ks * 32); acc = MFMA32(a, b, acc); }
            }
            const int jc = 32 * tj + r; const float gj = gcum_s[jc];
#pragma unroll
            for (int e = 0; e < 16; ++e) {
                const int i = 32 * ti + (e & 3) + 8 * (e >> 2) + 4 * hh; const float dg = gcum_s[i] - gj;
                if (which == 0) { const float f = (i > jc) ? __expf(dg) * beta_s[i] : 0.f; *(LAS float*)(L + G1_AS + i * 272 + jc * 4) = acc[e] * f; }
                else { const float f = (i >= jc) ? __expf(dg) : 0.f; *(LAS bf16_t*)(L + G1_PS + i * 144 + jc * 2) = (bf16_t)(cvt2(acc[e] * f, 0.f) & 0xffffu); }
            }
        }
        LDS_BARRIER();
        if (wave == 0) {
            int l3 = lane; asm volatile("" : "+v"(l3));
            const int bk = l3 >> 4, col = l3 & 15;
            float tcol[16];
#pragma unroll
            for (int rr = 0; rr < 16; ++rr) {
                float a = (rr == col) ? 1.0f : 0.f;
#pragma unroll
                for (int j4 = 0; j4 < (rr + 3) / 4; ++j4) { const f32x4 a4 = *(const LAS f32x4*)(L + G1_AS + (16 * bk + rr) * 272 + (16 * bk + 4 * j4) * 4);
#pragma unroll
                    for (int q = 0; q < 4; ++q) if (4 * j4 + q < rr) a -= a4[q] * tcol[4 * j4 + q]; }
                tcol[rr] = a;
                *(LAS float*)(L + G1_ES + ((bk * 16 + rr) * 16 + col) * 4) = a - ((rr == col) ? 1.0f : 0.f);
            }
        } else if (wave >= 4) {
            int l3 = lane; asm volatile("" : "+v"(l3));
            const int wv = wave - 4, r = l3 & 31, hh = l3 >> 5;
            {   const int rt4 = wv;
#pragma unroll
                for (int kt2 = 0; kt2 < 2; ++kt2)
#pragma unroll
                    for (int ss = 0; ss < 2; ++ss) { float v[8];
#pragma unroll
                        for (int j = 0; j < 8; ++j) { const int tok = 32 * kt2 + krow(ss, hh, j); v[j] = bf2f(*(const LAS bf16_t*)(L + G1_KS + tok * 272 + (32 * rt4 + r) * 2)) * ek_s[tok]; }
                        u32x4 o; o[0] = cvt2(v[0], v[1]); o[1] = cvt2(v[2], v[3]); o[2] = cvt2(v[4], v[5]); o[3] = cvt2(v[6], v[7]);
                        st16_wt(srs, boff + GS_KF + ((rt4 * 2 + kt2) * 2 + ss) * 1024 + l3 * 16, o); } }
            {   const int kt = wv;
#pragma unroll
                for (int rt = 0; rt < 2; ++rt)
#pragma unroll
                    for (int ss = 0; ss < 2; ++ss) { const int i = 32 * rt + r; const float sc = eg_s[i];
                        const u32x2 lo = *(const LAS u32x2*)(L + G1_QS + i * 272 + (32 * kt + 16 * ss + 4 * hh) * 2), hi = *(const LAS u32x2*)(L + G1_QS + i * 272 + (32 * kt + 16 * ss + 8 + 4 * hh) * 2);
                        u32x4 o; o[0] = cvt2(lo16(lo[0]) * sc, hi16(lo[0]) * sc); o[1] = cvt2(lo16(lo[1]) * sc, hi16(lo[1]) * sc); o[2] = cvt2(lo16(hi[0]) * sc, hi16(hi[0]) * sc); o[3] = cvt2(lo16(hi[1]) * sc, hi16(hi[1]) * sc);
                        st16_wt(srs, boff + GS_QF + ((rt * 4 + kt) * 2 + ss) * 1024 + l3 * 16, o); } }
            {   const int rt = wv >> 1, kt2 = wv & 1;
#pragma unroll
                for (int ss = 0; ss < 2; ++ss) { const int i = 32 * rt + r;
                    const u32x2 lo = *(const LAS u32x2*)(L + G1_PS + i * 144 + (32 * kt2 + 16 * ss + 4 * hh) * 2), hi = *(const LAS u32x2*)(L + G1_PS + i * 144 + (32 * kt2 + 16 * ss + 8 + 4 * hh) * 2);
                    u32x4 o; o[0] = lo[0]; o[1] = lo[1]; o[2] = hi[0]; o[3] = hi[1];
                    st16_wt(srs, boff + GS_PF + ((rt * 2 + kt2) * 2 + ss) * 1024 + l3 * 16, o); } }
        }
        LDS_BARRIER();
        {
            int l4 = lane; asm volatile("" : "+v"(l4));
            const int c16 = l4 & 15, g = l4 >> 4;
            const f32x4 z4 = {0.f, 0.f, 0.f, 0.f};
            f32x4 a10, a20, a21, a30, a31, a32, e0, e1, e2, e3;
            { const LAS unsigned char* ar = L + G1_AS + c16 * 272 + (4 * g) * 4;
              a10 = *(const LAS f32x4*)(ar + 16 * 272); a20 = *(const LAS f32x4*)(ar + 32 * 272); a21 = *(const LAS f32x4*)(ar + 32 * 272 + 64);
              a30 = *(const LAS f32x4*)(ar + 48 * 272); a31 = *(const LAS f32x4*)(ar + 48 * 272 + 64); a32 = *(const LAS f32x4*)(ar + 48 * 272 + 128);
              const LAS unsigned char* er = L + G1_ES + (c16 * 16 + 4 * g) * 4;
              e0 = *(const LAS f32x4*)er; e1 = *(const LAS f32x4*)(er + 1024); e2 = *(const LAS f32x4*)(er + 2048); e3 = *(const LAS f32x4*)(er + 3072); }
            const bf16x8 fA10 = g1_pack_b(z4 - a10, z4), fA2 = g1_pack_b(z4 - a20, z4 - a21), fA3a = g1_pack_b(z4 - a30, z4 - a31), fA3b = g1_pack_b(z4 - a32, z4);
            const bf16x8 fE0 = g1_pack_b(e0, z4), fE1 = g1_pack_b(e1, z4), fE2 = g1_pack_b(e2, z4), fE3 = g1_pack_b(e3, z4);
            const bool isw = wave < 4; const int cbase = 32 * (wave & 3);
#pragma unroll
            for (int tl = 0; tl < 2; ++tl) {
                const int d = cbase + 16 * tl + c16;
                f32x4 R[4];
#pragma unroll
                for (int i = 0; i < 4; ++i)
#pragma unroll
                    for (int e = 0; e < 4; ++e) { const int row = 16 * i + 4 * g + e; const float raw1 = bf2f(*(const LAS bf16_t*)(L + (isw ? G1_KS : G1_VS) + row * 272 + d * 2)); R[i][e] = raw1 * beta_s[row] * (isw ? eg_s[row] : 1.0f); }
                const f32x4 X0 = MFMA16(fE0, g1_pack_b(R[0], z4), R[0]);
                const f32x4 Y1 = MFMA16(fA10, g1_pack_b(X0, z4), R[1]);
                const f32x4 X1 = MFMA16(fE1, g1_pack_b(Y1, z4), Y1);
                const f32x4 Y2 = MFMA16(fA2, g1_pack_b(X0, X1), R[2]);
                const f32x4 X2 = MFMA16(fE2, g1_pack_b(Y2, z4), Y2);
                f32x4 Y3 = MFMA16(fA3a, g1_pack_b(X0, X1), R[3]);
                Y3 = MFMA16(fA3b, g1_pack_b(X2, z4), Y3);
                const f32x4 X3 = MFMA16(fE3, g1_pack_b(Y3, z4), Y3);
                const f32x4 X[4] = {X0, X1, X2, X3};
                if (isw) {
#pragma unroll
                    for (int i = 0; i < 4; ++i)
#pragma unroll
                        for (int e = 0; e < 4; ++e) *(LAS bf16_t*)(L + G1_WS + (16 * i + 4 * g + e) * 272 + d * 2) = (bf16_t)(cvt2(-X[i][e], 0.f) & 0xffffu);
                } else {
                    const int ws = wave & 3, cc = 16 * tl + c16;
#pragma unroll
                    for (int i = 0; i < 4; ++i) { const int rt = i >> 1, q = 2 * (i & 1) + (g >> 1), hh = g & 1;
                        u32x2 o; o[0] = cvt2(X[i][0], X[i][1]); o[1] = cvt2(X[i][2], X[i][3]);
                        st8_wt(blk + GS_UF + (size_t)(((ws * 2 + rt) * 64) + cc + 32 * hh) * 32 + q * 8, o); }
                }
            }
        }
        LDS_BARRIER();
        {
            int l5 = lane; asm volatile("" : "+v"(l5));
            const int kt = wave & 3, rt = wave >> 2, r = l5 & 31, hh = l5 >> 5, i = 32 * rt + r;
#pragma unroll
            for (int ss = 0; ss < 2; ++ss) {
                const u32x2 lo = *(const LAS u32x2*)(L + G1_WS + i * 272 + (32 * kt + 16 * ss + 4 * hh) * 2), hi = *(const LAS u32x2*)(L + G1_WS + i * 272 + (32 * kt + 16 * ss + 8 + 4 * hh) * 2);
                u32x4 o; o[0] = lo[0]; o[1] = lo[1]; o[2] = hi[0]; o[3] = hi[1];
                st16_wt(srs, boff + GS_WF + ((rt * 4 + kt) * 2 + ss) * 1024 + l5 * 16, o); }
        }
        asm volatile("s_waitcnt vmcnt(0)" ::: "memory");
        LDS_BARRIER();
        if (tid == 0) __hip_atomic_store(ready + 16 * sidx, 1u, __ATOMIC_RELAXED, __HIP_MEMORY_SCOPE_AGENT);
    }
}

constexpr int G2_FB = GS_BYTES, G2_OSTRIDE = 528, G2_HN = 2 * G2_FB, G2_DEC = G2_HN + 512;
__device__ __forceinline__ bf16x8 pack8(const f32x16& x, const int s) {
    u32x4 p; p[0] = cvt2(x[8 * s], x[8 * s + 1]); p[1] = cvt2(x[8 * s + 2], x[8 * s + 3]); p[2] = cvt2(x[8 * s + 4], x[8 * s + 5]); p[3] = cvt2(x[8 * s + 6], x[8 * s + 7]);
    return __builtin_bit_cast(bf16x8, p);
}
template <bool WT>
__device__ __forceinline__ void g2_load_set(u32x4 (&pre)[18], float& dpre, const unsigned char* blk, int lt, brsrc_t srs, unsigned boff, const unsigned* flag, const float* decp) {
    if (WT) { unsigned sp = 0; while (__builtin_amdgcn_readfirstlane(__hip_atomic_load(flag, __ATOMIC_RELAXED, __HIP_MEMORY_SCOPE_AGENT)) == 0u && ++sp < (1u << 20)) __builtin_amdgcn_s_sleep(4);
        dpre = __uint_as_float(__hip_atomic_load((const unsigned*)decp, __ATOMIC_RELAXED, __HIP_MEMORY_SCOPE_AGENT));
#pragma unroll
        for (int i = 0; i < 18; ++i) pre[i] = ld16_wt(srs, boff + (unsigned)(i * 256 + lt) * 16u);
    } else { const u32x4* src = (const u32x4*)blk; dpre = *decp;
#pragma unroll
        for (int i = 0; i < 18; ++i) pre[i] = src[i * 256 + lt]; }
}
__device__ __forceinline__ void g2_store_set(const u32x4 (&pre)[18], LAS unsigned char* dst, int lt) {
#pragma unroll
    for (int i = 0; i < 18; ++i) *(LAS u32x4*)(dst + (size_t)(i * 256 + lt) * 16) = pre[i];
}
#define G2_FRAG(off) (*(const LAS bf16x8*)(B + (off)))
#define G2_SCHED() __builtin_amdgcn_sched_barrier(0)
__device__ __forceinline__ void g2_mfma_step(f32x16& S0, f32x16& S1, f32x16& S2, f32x16& S3, LAS unsigned char* Bimg, const float dec, int ws, int lane, int cc, int hh) {
    const LAS unsigned char* B = Bimg + lane * 16;
    f32x16 vn0, vn1, o0, o1;
    { const LAS u32x4* up = (const LAS u32x4*)(Bimg + GS_UF + (size_t)(ws * 2 * 64 + lane) * 32); const u32x4 u0 = up[0], u1 = up[1], u2 = up[128], u3 = up[129];
#pragma unroll
      for (int q = 0; q < 4; ++q) { vn0[2 * q] = lo16(u0[q]); vn0[2 * q + 1] = hi16(u0[q]); vn0[8 + 2 * q] = lo16(u1[q]); vn0[8 + 2 * q + 1] = hi16(u1[q]);
                                    vn1[2 * q] = lo16(u2[q]); vn1[2 * q + 1] = hi16(u2[q]); vn1[8 + 2 * q] = lo16(u3[q]); vn1[8 + 2 * q + 1] = hi16(u3[q]); } }
#pragma unroll
    for (int e = 0; e < 16; ++e) { o0[e] = 0.f; o1[e] = 0.f; }
#define G2_WQ(Sx, kt) do { _Pragma("unroll") for (int ss = 0; ss < 2; ++ss) { const bf16x8 sb = pack8(Sx, ss); \
        const bf16x8 fw0 = G2_FRAG(GS_WF + ((0 * 4 + kt) * 2 + ss) * 1024), fw1 = G2_FRAG(GS_WF + ((1 * 4 + kt) * 2 + ss) * 1024); \
        const bf16x8 fq0 = G2_FRAG(GS_QF + ((0 * 4 + kt) * 2 + ss) * 1024), fq1 = G2_FRAG(GS_QF + ((1 * 4 + kt) * 2 + ss) * 1024); \
        vn0 = MFMA32(fw0, sb, vn0); vn1 = MFMA32(fw1, sb, vn1); o0 = MFMA32(fq0, sb, o0); o1 = MFMA32(fq1, sb, o1); } } while (0)
    G2_WQ(S0, 0); G2_WQ(S1, 1); G2_WQ(S2, 2); G2_WQ(S3, 3);
#undef G2_WQ
    bf16x8 vb[2][2];
    vb[0][0] = pack8(vn0, 0); vb[0][1] = pack8(vn0, 1); vb[1][0] = pack8(vn1, 0); vb[1][1] = pack8(vn1, 1);
#pragma unroll
    for (int kt2 = 0; kt2 < 2; ++kt2)
#pragma unroll
        for (int ss = 0; ss < 2; ++ss) { o0 = MFMA32(G2_FRAG(GS_PF + ((0 * 2 + kt2) * 2 + ss) * 1024), vb[kt2][ss], o0); o1 = MFMA32(G2_FRAG(GS_PF + ((1 * 2 + kt2) * 2 + ss) * 1024), vb[kt2][ss], o1); }
    S0 = S0 * dec; S1 = S1 * dec; S2 = S2 * dec; S3 = S3 * dec;
#pragma unroll
    for (int kt2 = 0; kt2 < 2; ++kt2)
#pragma unroll
        for (int ss = 0; ss < 2; ++ss) {
            S0 = MFMA32(G2_FRAG(GS_KF + ((0 * 2 + kt2) * 2 + ss) * 1024), vb[kt2][ss], S0); S1 = MFMA32(G2_FRAG(GS_KF + ((1 * 2 + kt2) * 2 + ss) * 1024), vb[kt2][ss], S1);
            S2 = MFMA32(G2_FRAG(GS_KF + ((2 * 2 + kt2) * 2 + ss) * 1024), vb[kt2][ss], S2); S3 = MFMA32(G2_FRAG(GS_KF + ((3 * 2 + kt2) * 2 + ss) * 1024), vb[kt2][ss], S3); }
    LDS_BARRIER();
#pragma unroll
    for (int e = 0; e < 16; ++e) { const int rr = (e & 3) + 8 * (e >> 2) + 4 * hh;
        *(LAS float*)(Bimg + rr * G2_OSTRIDE + (32 * ws + cc) * 4) = o0[e]; *(LAS float*)(Bimg + (32 + rr) * G2_OSTRIDE + (32 * ws + cc) * 4) = o1[e]; }
    LDS_BARRIER();
}
__device__ __forceinline__ void g2_epi_step(Frame& F, LAS unsigned char* L, const LAS unsigned char* Oimg, const u32x4 (&zz)[4], int row, int seg, size_t m, int h, bool rok, int lane) {
    float ss = 0.f;
#pragma unroll
    for (int q = 0; q < 8; ++q) { const f32x4 ov = *(const LAS f32x4*)(Oimg + row * G2_OSTRIDE + (seg * 32 + 4 * q) * 4); ss += (ov[0] * ov[0] + ov[1] * ov[1]) + (ov[2] * ov[2] + ov[3] * ov[3]); }
    ss += shfl_xor_l(ss, 1, lane); ss += shfl_xor_l(ss, 2, lane);
    const float rn = rsqrtf(ss * (1.f / 128.f) + EPS);
    if (rok) {
        u32x4* yp = (u32x4*)(F.Y1() + m * D + h * 128 + seg * 32);
        const LAS float* hn_s = (const LAS float*)(L + G2_HN);
#pragma unroll
        for (int q = 0; q < 4; ++q) {
            const f32x4 oa = *(const LAS f32x4*)(Oimg + row * G2_OSTRIDE + (seg * 32 + 8 * q) * 4), ob = *(const LAS f32x4*)(Oimg + row * G2_OSTRIDE + (seg * 32 + 8 * q + 4) * 4);
            const f32x4 ha = *(const LAS f32x4*)(hn_s + seg * 32 + 8 * q), hb = *(const LAS f32x4*)(hn_s + seg * 32 + 8 * q + 4);
            u32x4 yo;
            yo[0] = cvt2(oa[0] * rn * ha[0] * siluf_(lo16(zz[q][0])), oa[1] * rn * ha[1] * siluf_(hi16(zz[q][0])));
            yo[1] = cvt2(oa[2] * rn * ha[2] * siluf_(lo16(zz[q][1])), oa[3] * rn * ha[3] * siluf_(hi16(zz[q][1])));
            yo[2] = cvt2(ob[0] * rn * hb[0] * siluf_(lo16(zz[q][2])), ob[1] * rn * hb[1] * siluf_(hi16(zz[q][2])));
            yo[3] = cvt2(ob[2] * rn * hb[2] * siluf_(lo16(zz[q][3])), ob[3] * rn * hb[3] * siluf_(hi16(zz[q][3])));
            yp[q] = yo; }
    }
}
template <int NCH, bool WT>
__device__ __forceinline__ void g2_task(Frame& F, LAS unsigned char* L, const float* DEC, int s, int h, int ch0, int tid, int lane, int wave) {
    const size_t cstep = (size_t)GS_BYTES;
    const int base = seq_base(s), nvalid = s < BP ? 64 : TS;
    const unsigned char* blk0 = F.ws + WS_RB + (size_t)ch0 * GS_BYTES;
    constexpr int lastc = NCH - 1;
    if (wave < 4) {
        const int ws = wave, cc = lane & 31, hh = lane >> 5;
        f32x16 S0, S1, S2, S3;
        if (s < BP) {
#pragma unroll
            for (int e = 0; e < 16; ++e) { S0[e] = 0.f; S1[e] = 0.f; S2[e] = 0.f; S3[e] = 0.f; }
        } else {
            const float* sp = F.in[7] + ((size_t)(s - BP) * 8 + h) * 16384 + 32 * ws + cc;
#pragma unroll
            for (int e = 0; e < 16; ++e) { const int rr = (e & 3) + 8 * (e >> 2) + 4 * hh; S0[e] = sp[(size_t)rr * 128]; S1[e] = sp[(size_t)(32 + rr) * 128]; S2[e] = sp[(size_t)(64 + rr) * 128]; S3[e] = sp[(size_t)(96 + rr) * 128]; }
        }
        const LAS float* dec_s = (const LAS float*)(L + G2_DEC);
        LDS_BARRIER();
        if (NCH == 1) g2_mfma_step(S0, S1, S2, S3, L, dec_s[0], ws, lane, cc, hh);
        else for (int c = 0; c < NCH; c += 2) {
            g2_mfma_step(S0, S1, S2, S3, L, dec_s[c], ws, lane, cc, hh);
            g2_mfma_step(S0, S1, S2, S3, L + G2_FB, dec_s[c + 1], ws, lane, cc, hh);
        }
        int l9 = lane; asm volatile("" : "+v"(l9));
        const int cc9 = l9 & 31, hh9 = l9 >> 5;
        float* so = (s < BP ? F.out + O_GSP + ((size_t)s * 8 + h) * 16384 : F.out + O_GSS + ((size_t)(s - BP) * 8 + h) * 16384) + 32 * ws + cc9;
#pragma unroll
        for (int e = 0; e < 16; ++e) { const int rr = (e & 3) + 8 * (e >> 2) + 4 * hh9; so[(size_t)rr * 128] = S0[e]; so[(size_t)(32 + rr) * 128] = S1[e]; so[(size_t)(64 + rr) * 128] = S2[e]; so[(size_t)(96 + rr) * 128] = S3[e]; }
    } else {
        const int lt = tid - 256;
        if (lt < 128) ((LAS float*)(L + G2_HN))[lt] = F.in[32][lt];
        const brsrc_t srs = staging_rsrc(F.ws);
        const unsigned* ready = (const unsigned*)(F.ws + WS_READY);
        LAS float* dec_w = (LAS float*)(L + G2_DEC);
#define G2_LOAD(pre, dpre, k) do { const int _k = (k) < lastc ? (k) : lastc; g2_load_set<WT>(pre, dpre, blk0 + (size_t)_k * cstep, lt, srs, (unsigned)(ch0 + _k) * (unsigned)GS_BYTES, ready + 16 * (ch0 + _k), DEC + ch0 + _k); } while (0)
        u32x4 preA[18], preB[18]; float dA, dB;
        G2_LOAD(preA, dA, 0);
        G2_LOAD(preB, dB, 1);
        g2_store_set(preA, L, lt); if (lt == 0) dec_w[0] = dA;
        G2_LOAD(preA, dA, 2);
        const int row = lt >> 2, seg = lt & 3; const bool rok = row < nvalid;
        u32x4 zz[4];
        LDS_BARRIER();
        if (NCH == 1) {
            const size_t m = (size_t)base + row;
            if (rok) { const u32x4* zp = (const u32x4*)(F.Z1() + m * D + h * 128 + seg * 32);
#pragma unroll
                for (int q = 0; q < 4; ++q) zz[q] = zp[q]; }
            LDS_BARRIER();
            LDS_BARRIER();
            g2_epi_step(F, L, L, zz, row, seg, m, h, rok, lane);
        } else {
            for (int c = 0; c < NCH; c += 2) {
                {
                    const size_t m = (size_t)base + c * 64 + row;
                    { const u32x4* zp = (const u32x4*)(F.Z1() + m * D + h * 128 + seg * 32);
#pragma unroll
                      for (int q = 0; q < 4; ++q) zz[q] = zp[q]; }
                    g2_store_set(preB, L + G2_FB, lt); if (lt == 0) dec_w[(c + 1) & 63] = dB;
                    G2_LOAD(preB, dB, c + 3);
                    LDS_BARRIER();
                    LDS_BARRIER();
                    g2_epi_step(F, L, L, zz, row, seg, m, h, rok, lane);
                }
                {
                    const size_t m = (size_t)base + (c + 1) * 64 + row;
                    { const u32x4* zp = (const u32x4*)(F.Z1() + m * D + h * 128 + seg * 32);
#pragma unroll
                      for (int q = 0; q < 4; ++q) zz[q] = zp[q]; }
                    g2_store_set(preA, L, lt); if (lt == 0) dec_w[(c + 2) & 63] = dA;
                    G2_LOAD(preA, dA, c + 4);
                    LDS_BARRIER();
                    LDS_BARRIER();
                    g2_epi_step(F, L, L + G2_FB, zz, row, seg, m, h, rok, lane);
                }
            }
        }
    }
}
#undef G2_LOAD
constexpr int G12_CHAINS = 64;
__device__ __forceinline__ void phase_gdn_fused(Frame& F) {
    LAS unsigned char* L = F.lds;
    const float* DEC = (const float*)(F.ws + WS_DEC);
    if ((int)blockIdx.x < G12_CHAINS && F.G > G12_CHAINS) {
        const int tid = opaque_tid(F.wv);
        const int ci = blockIdx.x;
        g2_task<64, true>(F, L, DEC, ci >> 3, ci & 7, ci * 64, tid, tid & 63, F.wv);
    } else {
        const bool all = !(F.G > G12_CHAINS);
        const int p = all ? (int)blockIdx.x : (int)blockIdx.x - G12_CHAINS, np = all ? F.G : F.G - G12_CHAINS;
        gdn_g1_tasks(F, p, np);
        for (int t = p; t < 128; t += np) {
            const int tid = opaque_tid(F.wv);
            __syncthreads();
            g2_task<1, true>(F, L, DEC, BP + (t >> 3), t & 7, 4096 + t, tid, tid & 63, F.wv);
        }
    }
}

__device__ __forceinline__ float dpp_shr_f(float idv, float x, const int o) {
    int r;
    switch (o) {
        case 1: r = __builtin_amdgcn_update_dpp(__float_as_int(idv), __float_as_int(x), 0x111, 0xf, 0xf, false); break;
        case 2: r = __builtin_amdgcn_update_dpp(__float_as_int(idv), __float_as_int(x), 0x112, 0xf, 0xf, false); break;
        case 4: r = __builtin_amdgcn_update_dpp(__float_as_int(idv), __float_as_int(x), 0x114, 0xf, 0xf, false); break;
        default: r = __builtin_amdgcn_update_dpp(__float_as_int(idv), __float_as_int(x), 0x118, 0xf, 0xf, false); break;
    }
    return __int_as_float(r);
}
template <int PASS>
__device__ __forceinline__ void phase_lru(Frame& F) {
    int tid = opaque_tid(F.wv);
    const int lane = tid & 63, wave = __builtin_amdgcn_readfirstlane(tid >> 6);
    const int gw = F.vcu * 8 + wave, NGW = F.G * 8, h = gw & 7, g = lane >> 4, l15 = lane & 15;
    LAS unsigned char* xs = F.lds + wave * 9216;
    LAS float* cst = (LAS float*)(F.lds + 73728 + wave * 768);
    const bf16_t* LGW = (const bf16_t*)(F.ws + WS_LGW);
    float* LAG = F.LAG();
    bf16x8 wfa[4][2], wfx[4][2];
#pragma unroll
    for (int nt = 0; nt < 4; ++nt)
#pragma unroll
        for (int ks = 0; ks < 2; ++ks) {
            wfa[nt][ks] = *(const bf16x8*)(LGW + ((size_t)(h * 2 + 0) * 64 + 16 * nt + l15) * 64 + 32 * ks + 8 * g);
            wfx[nt][ks] = *(const bf16x8*)(LGW + ((size_t)(h * 2 + 1) * 64 + 16 * nt + l15) * 64 + 32 * ks + 8 * g); }
    cst[lane] = F.in[18][h * 64 + lane]; cst[64 + lane] = F.in[20][h * 64 + lane]; cst[128 + lane] = softplusf_(-F.in[21][h * 64 + lane]);
    for (int task = gw; task < 4224; task += NGW) {
        int s, c; if (task < 4096) { s = task >> 9; c = (task >> 3) & 63; } else { s = BP + ((task - 4096) >> 3); c = 0; }
        const int T = seq_len(s), base = seq_base(s), t0 = c * 64, ntile = s < BP ? 4 : 1;
        {
            int l1 = lane; asm volatile("" : "+v"(l1));
            const int cg = l1 & 7, tp = l1 >> 3;
#pragma unroll 1
            for (int hf2 = 0; hf2 < 2; ++hf2) {
                const int chb = h * 64 + cg * 8 + hf2 * 4;
                float xr[11][4];
#pragma unroll
                for (int i = 0; i < 11; ++i) {
                    const int tt = t0 + tp * 8 - 3 + i;
                    if (tt >= 0 && tt < T) { const u32x2 w = *(const u32x2*)(F.U0() + (size_t)(base + tt) * EV_IN + C_XA + chb);
                        xr[i][0] = lo16(w[0]); xr[i][1] = hi16(w[0]); xr[i][2] = lo16(w[1]); xr[i][3] = hi16(w[1]); }
                    else if (tt < 0 && s >= BP) { const f32x4 a = *(const f32x4*)(F.in[2] + ((size_t)(s - BP) * 3 + (tt + 3)) * 512 + chb); xr[i][0] = a[0]; xr[i][1] = a[1]; xr[i][2] = a[2]; xr[i][3] = a[3]; }
                    else { xr[i][0] = 0.f; xr[i][1] = 0.f; xr[i][2] = 0.f; xr[i][3] = 0.f; }
                }
                const f32x4 c0 = *(const f32x4*)(F.in[15] + chb), c1 = *(const f32x4*)(F.in[15] + 512 + chb), c2 = *(const f32x4*)(F.in[15] + 1024 + chb), c3 = *(const f32x4*)(F.in[15] + 1536 + chb), cb = *(const f32x4*)(F.in[16] + chb);
#pragma unroll
                for (int i = 0; i < 8; ++i) { float o[4];
#pragma unroll
                    for (int e = 0; e < 4; ++e) o[e] = c0[e] * xr[i][e] + c1[e] * xr[i + 1][e] + c2[e] * xr[i + 2][e] + c3[e] * xr[i + 3][e] + cb[e];
                    u32x2 w; w[0] = cvt2(o[0], o[1]); w[1] = cvt2(o[2], o[3]);
                    *(LAS u32x2*)(xs + (tp * 8 + i) * 144 + cg * 16 + hf2 * 8) = w; }
                if (PASS == 2 && t0 + 64 >= T && tp == ((T - 1) >> 3) - (t0 >> 3)) {
                    float* o = (s < BP ? F.out + O_LCP + (size_t)s * 3 * 512 : F.out + O_LCS + (size_t)(s - BP) * 3 * 512) + chb;
#pragma unroll
                    for (int q = 0; q < 3; ++q) *(f32x4*)(o + q * 512) = (f32x4){xr[8 + q][0], xr[8 + q][1], xr[8 + q][2], xr[8 + q][3]};
                }
            }
        }
        float hin[4][4], arun[4][4];
#pragma unroll
        for (int nt = 0; nt < 4; ++nt)
#pragma unroll
            for (int rg = 0; rg < 4; ++rg) { hin[nt][rg] = 0.f; arun[nt][rg] = 1.f; }
        if (PASS == 2) {
            float hf = s >= BP ? F.in[3][(s - BP) * 512 + h * 64 + lane] : 0.f;
            const f32x2* lp = (const f32x2*)LAG + (size_t)(s * 64) * 512 + h * 64 + lane;
            int j = 0;
            for (; j + 8 <= c; j += 8) { f32x2 v[8];
#pragma unroll
                for (int q = 0; q < 8; ++q) v[q] = lp[(size_t)(j + q) * 512];
#pragma unroll
                for (int q = 0; q < 8; ++q) hf = v[q][0] * hf + v[q][1]; }
            for (; j < c; ++j) { const f32x2 v = lp[(size_t)j * 512]; hf = v[0] * hf + v[1]; }
#pragma unroll
            for (int nt = 0; nt < 4; ++nt)
#pragma unroll
                for (int rg = 0; rg < 4; ++rg) hin[nt][rg] = shfl_idx(hf, 16 * nt + 4 * g + rg);
        }
        asm volatile("s_waitcnt lgkmcnt(0)" ::: "memory");
        for (int tt = 0; tt < ntile; ++tt) {
            const int tok = 16 * tt + l15;
            const bf16x8 b0 = *(const LAS bf16x8*)(xs + tok * 144 + (8 * g) * 2), b1 = *(const LAS bf16x8*)(xs + tok * 144 + (32 + 8 * g) * 2);
            const size_t m = (size_t)base + t0 + tok;
#pragma unroll
            for (int nt = 0; nt < 4; ++nt) {
                f32x4 za = {0.f, 0.f, 0.f, 0.f}, zx = {0.f, 0.f, 0.f, 0.f};
                za = MFMA16(wfa[nt][0], b0, za); za = MFMA16(wfa[nt][1], b1, za);
                zx = MFMA16(wfx[nt][0], b0, zx); zx = MFMA16(wfx[nt][1], b1, zx);
                const int n0 = 16 * nt + 4 * g;
                const u32x2 xw = *(const LAS u32x2*)(xs + tok * 144 + n0 * 2);
                const float xc[4] = {lo16(xw[0]), hi16(xw[0]), lo16(xw[1]), hi16(xw[1])};
                const f32x4 cba = *(const LAS f32x4*)(cst + n0), cbx = *(const LAS f32x4*)(cst + 64 + n0), csp = *(const LAS f32x4*)(cst + 128 + n0);
                float av[4], bv[4];
#pragma unroll
                for (int rg = 0; rg < 4; ++rg) {
                    const float r = sigmoidf_(za[rg] + cba[rg]), ig = sigmoidf_(zx[rg] + cbx[rg]), la = -8.0f * r * csp[rg], a = __expf(la);
                    av[rg] = a; bv[rg] = sqrtf(fmaxf(1.0f - a * a, 0.f)) * (ig * xc[rg]); }
#pragma unroll
                for (int o = 1; o < 16; o <<= 1)
#pragma unroll
                    for (int rg = 0; rg < 4; ++rg) { const float ap = dpp_shr_f(1.0f, av[rg], o), bp = dpp_shr_f(0.0f, bv[rg], o); bv[rg] = av[rg] * bp + bv[rg]; av[rg] = av[rg] * ap; }
                float hv[4];
#pragma unroll
                for (int rg = 0; rg < 4; ++rg) { hv[rg] = bv[rg] + av[rg] * hin[nt][rg]; hin[nt][rg] = shfl_idx(hv[rg], (lane & 48) | 15); }
                if (PASS == 1) {
#pragma unroll
                    for (int rg = 0; rg < 4; ++rg) arun[nt][rg] *= shfl_idx(av[rg], (lane & 48) | 15);
                } else {
                    const bool tok_ok = (t0 + tok) < T;
                    if (tok_ok) {
                        const u32x2 gw2 = *(const u32x2*)(F.U0() + m * EV_IN + C_GA + h * 64 + n0);
                        u32x2 yo; yo[0] = cvt2(hv[0] * siluf_(lo16(gw2[0])), hv[1] * siluf_(hi16(gw2[0]))); yo[1] = cvt2(hv[2] * siluf_(lo16(gw2[1])), hv[3] * siluf_(hi16(gw2[1])));
                        *(u32x2*)(F.Y0() + m * D + h * 64 + n0) = yo;
                        if (t0 + tok == T - 1) { float* o = (s < BP ? F.out + O_LHP + s * 512 : F.out + O_LHS + (s - BP) * 512) + h * 64 + n0; *(f32x4*)o = (f32x4){hv[0], hv[1], hv[2], hv[3]}; }
                    }
                }
                if (nt & 1) __builtin_amdgcn_sched_barrier(0);
            }
        }
        if (PASS == 1 && s < BP && l15 == 15) {
            f32x2* lp = (f32x2*)LAG + (size_t)(s * 64 + c) * 512 + h * 64;
#pragma unroll
            for (int nt = 0; nt < 4; ++nt)
#pragma unroll
                for (int rg = 0; rg < 4; ++rg) lp[16 * nt + 4 * g + rg] = (f32x2){arun[nt][rg], hin[nt][rg]};
        }
        asm volatile("s_waitcnt lgkmcnt(0)" ::: "memory");
    }
}

constexpr size_t RB_VTP = RB_WEND, RB_VTS = RB_VTP + (size_t)BP * 2 * 64 * TP * 2, RB_VTEND = RB_VTS + (size_t)BS * 2 * 64 * 192 * 2;
static_assert(RB_VTEND <= RB_BYTES, "ws map");
__device__ __forceinline__ void phase_vt_build(Frame& F) {
    PHASE_IDS();
    const int gw = F.vcu * 8 + wave, NGW = F.G * 8;
    LAS unsigned char* xs = F.lds + wave * 9216;
    bf16_t* VTP = (bf16_t*)(F.ws + WS_RB + RB_VTP); bf16_t* VTS = (bf16_t*)(F.ws + WS_RB + RB_VTS);
    for (int task = gw; task < 1024 + 96; task += NGW) {
        int s, kv, kb; if (task < 1024) { s = task >> 7; kv = (task >> 6) & 1; kb = task & 63; } else { const int r = task - 1024; s = BP + r / 6; kv = (r % 6) / 3; kb = r % 3; }
        const int row8 = lane >> 3, ch = lane & 7;
#pragma unroll
        for (int i = 0; i < 8; ++i) {
            const int key = 8 * i + row8, kg = kb * 64 + key; u32x4 w = {0u, 0u, 0u, 0u};
            if (s < BP) w = *(const u32x4*)(F.U0() + (size_t)(s * TP + kg) * EV_IN + C_V + kv * 64 + ch * 8);
            else if (kg < 128) { const f32x4* p = (const f32x4*)(F.in[5] + ((size_t)((s - BP) * 128 + kg) * 2 + kv) * 64 + ch * 8); const f32x4 a = p[0], b = p[1]; w[0] = cvt2(a[0], a[1]); w[1] = cvt2(a[2], a[3]); w[2] = cvt2(b[0], b[1]); w[3] = cvt2(b[2], b[3]); }
            else if (kg < 128 + TS) w = *(const u32x4*)(F.U0() + (size_t)(MP + (s - BP) * TS + (kg - 128)) * EV_IN + C_V + kv * 64 + ch * 8);
            *(LAS u32x4*)(xs + key * 144 + ch * 16) = w;
        }
        asm volatile("s_waitcnt lgkmcnt(0)" ::: "memory");
        bf16_t* dst = s < BP ? VTP + ((size_t)(s * 2 + kv) * 64 + lane) * TP + kb * 64 : VTS + ((size_t)((s - BP) * 2 + kv) * 64 + lane) * 192 + kb * 64;
#pragma unroll
        for (int q = 0; q < 8; ++q) { u32x4 o;
#pragma unroll
            for (int e = 0; e < 4; ++e) { const unsigned lo = *(const LAS bf16_t*)(xs + (8 * q + 2 * e) * 144 + lane * 2), hi = *(const LAS bf16_t*)(xs + (8 * q + 2 * e + 1) * 144 + lane * 2); o[e] = lo | (hi << 16); }
            *(u32x4*)(dst + 8 * q) = o; }
        asm volatile("s_waitcnt lgkmcnt(0)" ::: "memory");
    }
}
constexpr int AT_K = 0, AT_V = 27648;
__device__ __forceinline__ void phase_attn(Frame& F) {
    PHASE_IDS();
    LAS unsigned char* L = F.lds;
    const bf16_t* VTP = (const bf16_t*)(F.ws + WS_RB + RB_VTP); const bf16_t* VTS = (const bf16_t*)(F.ws + WS_RB + RB_VTS);
    for (int task = F.vcu; task < 1024 + 32; task += F.G) {
        int s, c, kv; if (task < 1024) { s = task >> 7; c = (task >> 1) & 63; kv = task & 1; } else { s = BP + ((task - 1024) >> 1); c = 0; kv = task & 1; }
        const int base = seq_base(s), tok0 = c * 64 - 128;
        const int kmin = s < BP ? (tok0 < 0 ? -tok0 : 0) : 0, kmax = s < BP ? 192 : 128 + TS;
        __syncthreads();
#pragma unroll
        for (int i = 0; i < 3; ++i) {
            const int idx = tid + 512 * i, key = idx >> 3, ch = idx & 7; u32x4 w = {0u, 0u, 0u, 0u};
            if (key >= kmin && key < kmax) {
                if (s < BP) w = *(const u32x4*)(F.U0() + (size_t)(base + tok0 + key) * EV_IN + C_K + kv * 64 + ch * 8);
                else if (key < 128) { const f32x4* p = (const f32x4*)(F.in[4] + ((size_t)((s - BP) * 128 + key) * 2 + kv) * 64 + ch * 8); const f32x4 a = p[0], b = p[1]; w[0] = cvt2(a[0], a[1]); w[1] = cvt2(a[2], a[3]); w[2] = cvt2(b[0], b[1]); w[3] = cvt2(b[2], b[3]); }
                else w = *(const u32x4*)(F.U0() + (size_t)(base + key - 128) * EV_IN + C_K + kv * 64 + ch * 8);
            }
            *(LAS u32x4*)(L + AT_K + key * 144 + ch * 16) = w;
        }
#pragma unroll
        for (int i = 0; i < 3; ++i) {
            const int idx = tid + 512 * i, d = idx / 24, ch = idx % 24, key = ch * 8; u32x4 w = {0u, 0u, 0u, 0u};
            if (s < BP) { if (key >= kmin) w = *(const u32x4*)(VTP + ((size_t)(s * 2 + kv) * 64 + d) * TP + tok0 + key); }
            else w = *(const u32x4*)(VTS + ((size_t)((s - BP) * 2 + kv) * 64 + d) * 192 + key);
            *(LAS u32x4*)(L + AT_V + d * 400 + ch * 16) = w;
        }
        const int g = wave >> 1, qh = wave & 1, hq = kv * 4 + g, r = lane & 31, hh = lane >> 5, qi = qh * 32 + r;
        const bool qok = s < BP ? true : qi < TS;
        const size_t m = (size_t)base + c * 64 + (qok ? qi : 0);
        bf16x8 qf[4];
#pragma unroll
        for (int ks = 0; ks < 4; ++ks) { u32x4 w = {0u, 0u, 0u, 0u};
            if (qok) { const u32x4 x = *(const u32x4*)(F.U0() + m * EV_IN + C_Q + hq * 64 + 16 * ks + 8 * hh);
#pragma unroll
                for (int e = 0; e < 4; ++e) w[e] = cvt2(lo16(x[e]) * 0.125f, hi16(x[e]) * 0.125f); }
            qf[ks] = __builtin_bit_cast(bf16x8, w); }
        const float sink = F.in[22][hq];
        __syncthreads();
        float mrun = sink, lrun = 1.0f;
        f32x16 o0, o1;
#pragma unroll
        for (int e = 0; e < 16; ++e) { o0[e] = 0.f; o1[e] = 0.f; }
#pragma unroll 1
        for (int half = 0; half < 2; ++half) {
            f32x16 sc[3];
#pragma unroll
            for (int k3 = 0; k3 < 3; ++k3) {
                const int kt = 3 * half + k3;
#pragma unroll
                for (int e = 0; e < 16; ++e) sc[k3][e] = 0.f;
#pragma unroll
                for (int ks = 0; ks < 4; ++ks) { const bf16x8 kf = *(const LAS bf16x8*)(L + AT_K + (32 * kt + r) * 144 + (16 * ks + 8 * hh) * 2); sc[k3] = MFMA32(kf, qf[ks], sc[k3]); }
            }
            float mx = -1e30f;
#pragma unroll
            for (int k3 = 0; k3 < 3; ++k3)
#pragma unroll
                for (int e = 0; e < 16; ++e) { const int kidx = 32 * (3 * half + k3) + (e & 3) + 8 * (e >> 2) + 4 * hh; const bool ok = kidx >= kmin && kidx < kmax; sc[k3][e] = ok ? sc[k3][e] : -1e30f; mx = fmaxf(mx, sc[k3][e]); }
            mx = fmaxf(mx, shfl_xor_l(mx, 32, lane));
            const float mnew = fmaxf(mrun, mx), alpha = __expf(mrun - mnew);
            float psum = 0.f;
#pragma unroll
            for (int k3 = 0; k3 < 3; ++k3)
#pragma unroll
                for (int e = 0; e < 16; ++e) { const float p = __expf(sc[k3][e] - mnew); sc[k3][e] = p; psum += p; }
            psum += shfl_xor_l(psum, 32, lane);
            lrun = lrun * alpha + psum; mrun = mnew;
            o0 = o0 * alpha; o1 = o1 * alpha;
#pragma unroll
            for (int k3 = 0; k3 < 3; ++k3)
#pragma unroll
                for (int ss = 0; ss < 2; ++ss) {
                    const int kt = 3 * half + k3;
                    const bf16x8 pb = pack8(sc[k3], ss);
                    const LAS unsigned char* vp = L + AT_V + r * 400 + (32 * kt + 16 * ss + 4 * hh) * 2;
                    const u32x2 a0 = *(const LAS u32x2*)vp, a1 = *(const LAS u32x2*)(vp + 16), b0 = *(const LAS u32x2*)(vp + 32 * 400), b1 = *(const LAS u32x2*)(vp + 32 * 400 + 16);
                    const u32x4 va = {a0[0], a0[1], a1[0], a1[1]}, vb = {b0[0], b0[1], b1[0], b1[1]};
                    o0 = MFMA32(__builtin_bit_cast(bf16x8, va), pb, o0); o1 = MFMA32(__builtin_bit_cast(bf16x8, vb), pb, o1);
                }
        }
        const float il = __builtin_amdgcn_rcpf(lrun);
        if (qok) {
#pragma unroll
            for (int qq = 0; qq < 4; ++qq) {
                { const int d = 8 * qq + 4 * hh; const u32x2 gb = *(const u32x2*)(F.U0() + m * EV_IN + C_GB + hq * 64 + d);
                  u32x2 yo; yo[0] = cvt2(o0[4 * qq] * il * siluf_(lo16(gb[0])), o0[4 * qq + 1] * il * siluf_(hi16(gb[0]))); yo[1] = cvt2(o0[4 * qq + 2] * il * siluf_(lo16(gb[1])), o0[4 * qq + 3] * il * siluf_(hi16(gb[1])));
                  *(u32x2*)(F.Y0() + m * D + 512 + hq * 64 + d) = yo; }
                { const int d = 32 + 8 * qq + 4 * hh; const u32x2 gb = *(const u32x2*)(F.U0() + m * EV_IN + C_GB + hq * 64 + d);
                  u32x2 yo; yo[0] = cvt2(o1[4 * qq] * il * siluf_(lo16(gb[0])), o1[4 * qq + 1] * il * siluf_(hi16(gb[0]))); yo[1] = cvt2(o1[4 * qq + 2] * il * siluf_(lo16(gb[1])), o1[4 * qq + 3] * il * siluf_(hi16(gb[1])));
                  *(u32x2*)(F.Y0() + m * D + 512 + hq * 64 + d) = yo; }
            }
        }
    }
    __syncthreads();
}

__device__ __forceinline__ void rows_final(Frame& F, const int m0, const int n, const int s, const int lane) {
    const float* mod1 = F.MOD() + (size_t)(24 + s) * 3072;
    f32x4 A1[4];
#pragma unroll
    for (int j = 0; j < 4; ++j) { const int c = 4 * lane + 256 * j; const f32x4 g = *(const f32x4*)(F.in[27] + c), gt = *(const f32x4*)(mod1 + 2048 + c);
#pragma unroll
        for (int e = 0; e < 4; ++e) A1[j][e] = gt[e] * g[e]; }
    u32x2 ycur[4]; f32x4 xcur[4];
#pragma unroll
    for (int j = 0; j < 4; ++j) { ycur[j] = *(const u32x2*)(F.YO() + (size_t)m0 * D + 4 * lane + 256 * j); xcur[j] = *(const f32x4*)(F.out + O_Y + (size_t)m0 * D + 4 * lane + 256 * j); }
    for (int i = 0; i < n; ++i) {
        const int m = m0 + i, mn = m0 + (i + 1 < n ? i + 1 : i); u32x2 ynxt[4]; f32x4 xnxt[4];
#pragma unroll
        for (int j = 0; j < 4; ++j) { ynxt[j] = *(const u32x2*)(F.YO() + (size_t)mn * D + 4 * lane + 256 * j); xnxt[j] = *(const f32x4*)(F.out + O_Y + (size_t)mn * D + 4 * lane + 256 * j); }
        f32x4 y[4]; float ss = 0.f;
#pragma unroll
        for (int j = 0; j < 4; ++j) { y[j] = (f32x4){lo16(ycur[j][0]), hi16(ycur[j][0]), lo16(ycur[j][1]), hi16(ycur[j][1])}; ss += (y[j][0] * y[j][0] + y[j][1] * y[j][1]) + (y[j][2] * y[j][2] + y[j][3] * y[j][3]); }
        const float r1 = rsqrtf(wave_sum(ss, lane) * (1.f / D) + EPS);
#pragma unroll
        for (int j = 0; j < 4; ++j) { f32x4 o;
#pragma unroll
            for (int e = 0; e < 4; ++e) o[e] = xcur[j][e] + A1[j][e] * (y[j][e] * r1);
            *(f32x4*)(F.out + O_Y + (size_t)m * D + 4 * lane + 256 * j) = o; }
#pragma unroll
        for (int j = 0; j < 4; ++j) { ycur[j] = ynxt[j]; xcur[j] = xnxt[j]; }
    }
}
__device__ __forceinline__ void phase_final_rowwise(Frame& F) {
    PHASE_IDS();
    const int gw = F.vcu * 8 + wave, NGW = F.G * 8;
    for (int w = gw; w < MP / 16; w += NGW) rows_final(F, w * 16, 16, w >> 8, lane);
    for (int w = gw; w < MS; w += NGW) rows_final(F, MP + w, 1, BP + (w >> 4), lane);
}

__global__ void __launch_bounds__(512, 2) fwd_megakernel(Params P) {
    extern __shared__ __attribute__((aligned(16))) unsigned char lds_raw[];
    Frame F;
    F.lds = (LAS unsigned char*)lds_raw;
    F.wv = __builtin_amdgcn_readfirstlane(threadIdx.x >> 6);
    F.G = gridDim.x; { const int bx = blockIdx.x; F.vcu = (F.G % 8 == 0) ? (bx % 8) * (F.G / 8) + bx / 8 : bx; }
    F.in = P.in; F.out = P.out; F.ws = P.ws;

    volatile LAS unsigned* misc = (volatile LAS unsigned*)(F.lds + LDS_BYTES - 64);
    if (threadIdx.x < 16) misc[threadIdx.x] = 0u;
    __syncthreads();
    XcdBarrier xbar = xcd_barrier_post((unsigned*)(P.ws + WS_CTL), misc);
#define GRID_BAR() xcd_barrier(xbar, F.wv)
    phase_prologue(F);
    GRID_BAR();
    phase_prenorm0(F);
    GRID_BAR();
    { pg8::Gemm g{F.XN(), F.W0I(), MT, EV_IN, D}; pg8::StaticOrder S; S.init(MT, EV_IN, F.G, (int)blockIdx.x);
      pg8::EpiBf16 E{F.U0(), EV_IN, 1 << 30, F.U0(), EV_IN}; pg8::gemm_phase(F.lds, g, S, E, F.wv); }
    GRID_BAR();
    phase_rope(F);
    phase_lru<1>(F);
    phase_vt_build(F);
    GRID_BAR();
    phase_lru<2>(F);
    phase_attn(F);
    GRID_BAR();
    { pg8::Gemm g{F.Y0(), F.W0O(), MT, D, D}; pg8::StaticOrder S; S.init(MT, D, F.G, (int)blockIdx.x);
      pg8::EpiBf16 E{F.YO(), D, 1 << 30, F.YO(), D}; pg8::gemm_phase(F.lds, g, S, E, F.wv); }
    GRID_BAR();
    phase_mid_rowwise(F);
    GRID_BAR();
    { pg8::Gemm g{F.XN(), F.W1I(), MT, OD_MAIN, D}; pg8::StaticOrder S; S.init(MT, OD_MAIN, F.G, (int)blockIdx.x);
      pg8::EpiBf16 E{F.QKV1(), 3072, 3072, F.Z1(), D}; pg8::gemm_phase(F.lds, g, S, E, F.wv); }
    GRID_BAR();
    phase_gdn_fused(F);
    GRID_BAR();
    { pg8::Gemm g{F.Y1(), F.W1O(), MT, D, D}; pg8::StaticOrder S; S.init(MT, D, F.G, (int)blockIdx.x);
      pg8::EpiBf16 E{F.YO(), D, 1 << 30, F.YO(), D}; pg8::gemm_phase(F.lds, g, S, E, F.wv); }
    GRID_BAR();
    phase_final_rowwise(F);
}

extern "C" void kernel_launch(void* const* d_in, const int* in_sizes, int n_in, void* d_out, int out_size, void* d_ws, size_t ws_size, hipStream_t stream) {
    static int grid = 0;
    if (grid == 0) {
        if (n_in != 34 || out_size != (int)O_END || ws_size < WS_END) { grid = -1; return; }
        int dev = 0, cus = 0, per_cu = 0;
        if (hipGetDevice(&dev) != hipSuccess || hipDeviceGetAttribute(&cus, hipDeviceAttributeMultiprocessorCount, dev) != hipSuccess) { grid = -1; return; }
        if (hipFuncSetAttribute((const void*)fwd_megakernel, hipFuncAttributeMaxDynamicSharedMemorySize, LDS_BYTES) != hipSuccess) { grid = -1; return; }
        if (hipOccupancyMaxActiveBlocksPerMultiprocessor(&per_cu, (const void*)fwd_megakernel, 512, LDS_BYTES) != hipSuccess || per_cu < 1) { grid = -1; return; }
        grid = cus;
    }
    if (grid < 0) return;
    if (hipMemsetAsync((char*)d_ws + WS_CTL, 0, 65536 + 4224 * 64, stream) != hipSuccess) return;
    Params p{};
    for (int i = 0; i < 34; ++i) p.in[i] = (const float*)d_in[i];
    p.out = (float*)d_out; p.ws = (unsigned char*)d_ws;
    void* args[] = {&p};
    (void)hipLaunchCooperativeKernel((const void*)fwd_megakernel, dim3(grid), dim3(512), args, LDS_BYTES, stream);
}
```

```cpp
#include <hip/hip_runtime.h>
#include <hip/hip_cooperative_groups.h>
namespace cg = cooperative_groups;

#define LAS __attribute__((address_space(3)))
typedef unsigned short bf16_t;
typedef short bf16x8 __attribute__((ext_vector_type(8)));
typedef float f32x4 __attribute__((ext_vector_type(4)));
typedef float f32x2 __attribute__((ext_vector_type(2)));
typedef unsigned u32x4 __attribute__((ext_vector_type(4)));
typedef unsigned u32x2 __attribute__((ext_vector_type(2)));

constexpr int D = 1024, BP = 8, TP = 4096, BS = 16, TS = 16;
constexpr int MP = BP * TP, MS = BS * TS, MT = MP + MS;
constexpr int NSEQ = BP + BS;
constexpr int EV_IN = 2304, OD_IN = 4112, OD_MAIN = 4096;
constexpr int C_XA = 0, C_GA = 512, C_Q = 1024, C_K = 1536, C_V = 1664, C_GB = 1792;
constexpr float EPS = 1e-6f;
constexpr size_t O_Y = 0, O_LCP = 33816576, O_LCS = 33828864, O_LHP = 33853440, O_LHS = 33857536, O_KP = 33865728, O_KS = 33996800,
                 O_VP = 34029568, O_VS = 34160640, O_GCP = 34193408, O_GCS = 34267136, O_GSP = 34414592, O_GSS = 35463168, O_END = 37560320;
constexpr size_t MiB = 1u << 20;
constexpr size_t WS_CTL = 0, WS_W1O = 1 * MiB, WS_MOD = 3 * MiB, WS_ROPE = 4 * MiB, WS_BA = 5 * MiB, WS_LAG = 8 * MiB, WS_LGW = 10 * MiB;
constexpr size_t WS_RA = 16 * MiB, RA_BYTES = (size_t)MT * 4096 * 2;
constexpr size_t WS_RB = WS_RA + RA_BYTES;
constexpr size_t ACT_BYTES = (size_t)MT * D * 2;
constexpr size_t RB_XN = 0, RB_Y0 = ACT_BYTES, RB_YO = 2 * ACT_BYTES, RB_W0I = 3 * ACT_BYTES, RB_W0O = RB_W0I + (size_t)EV_IN * D * 2,
                 RB_W1I = RB_W0O + (size_t)D * D * 2, RB_WEND = RB_W1I + (size_t)OD_MAIN * D * 2;
constexpr size_t RB_BYTES = (size_t)4224 * 73728;
constexpr size_t WS_END = WS_RB + RB_BYTES;
static_assert(RB_WEND <= RB_BYTES, "ws map");
static_assert((size_t)MT * 3072 * 2 <= RB_BYTES, "ws map");
constexpr int LDS_BYTES = 155648;

struct Params { const float* in[34]; float* out; unsigned char* ws; };

__device__ __forceinline__ float bf2f(bf16_t b) { return __uint_as_float(((unsigned)b) << 16); }
__device__ __forceinline__ unsigned f2bf(float f) { unsigned u = __float_as_uint(f); return (u + 0x7fffu + ((u >> 16) & 1u)) >> 16; }
__device__ __forceinline__ unsigned pk2(float lo, float hi) { return f2bf(lo) | (f2bf(hi) << 16); }
typedef __bf16 bf16x2_t __attribute__((ext_vector_type(2)));
__device__ __forceinline__ unsigned cvt2(float a, float b) { f32x2 v = {a, b}; bf16x2_t r = __builtin_convertvector(v, bf16x2_t); return __builtin_bit_cast(unsigned, r); }
__device__ __forceinline__ float lo16(unsigned w) { return __uint_as_float(w << 16); }
__device__ __forceinline__ float hi16(unsigned w) { return __uint_as_float(w & 0xffff0000u); }
__device__ __forceinline__ float shfl_idx(float x, int src_lane) { return __int_as_float(__builtin_amdgcn_ds_bpermute(src_lane << 2, __float_as_int(x))); }
__device__ __forceinline__ float shfl_xor_l(float x, int o, int lane) { return shfl_idx(x, lane ^ o); }
__device__ __forceinline__ float wave_sum(float v, int lane) {
#pragma unroll
    for (int o = 1; o < 64; o <<= 1) v += shfl_xor_l(v, o, lane);
    return v;
}
__device__ __forceinline__ float sigmoidf_(float x) { return __builtin_amdgcn_rcpf(1.0f + __expf(-x)); }
__device__ __forceinline__ float siluf_(float x) { return x * __builtin_amdgcn_rcpf(1.0f + __expf(-x)); }
__device__ __forceinline__ float softplusf_(float x) { return x > 20.f ? x : log1pf(__expf(x)); }
__device__ __forceinline__ int seq_base(int s) { return s < BP ? s * TP : MP + (s - BP) * TS; }
__device__ __forceinline__ int seq_len(int s) { return s < BP ? TP : TS; }
__device__ __forceinline__ void tok_info(int m, int& s, int& t) { if (m < MP) { s = m >> 12; t = m & 4095; } else { const int r = m - MP; s = BP + (r >> 4); t = r & 15; } }

__device__ __forceinline__ int opaque_tid(int wv) { unsigned z = 0u; asm volatile("" : "+v"(z)); const int l = __builtin_amdgcn_mbcnt_hi(~0u, __builtin_amdgcn_mbcnt_lo(~0u, z)); return wv * 64 + l; }
namespace pg8 {
constexpr int BM = 256, BK = 64, HALF = 128, HTB = HALF * BK * 2, STAGE_BYTES = 8 * HTB, NXCD = 8, WGM = 8;
__host__ __device__ __forceinline__ int lds_byte(int r, int c) { const int st = (r >> 4) * 2 + (c >> 5), rr = r & 15, cc = c & 31, ob = rr * 64 + cc * 2; return st * 1024 + (ob ^ (((ob >> 9) & 1) << 5)); }
__host__ __device__ __forceinline__ void stage_rc(int b, int& R, int& C) { const int st = b / 1024, sb = b % 1024, swz = sb ^ (((sb >> 9) & 1) << 5); R = (st >> 1) * 16 + swz / 64; C = (st & 1) * 32 + (swz % 64) / 2; }
__host__ __device__ __forceinline__ int perm32(int rho) { const int n = rho >> 4, i = rho & 15; return 8 * (i >> 2) + 4 * n + (i & 3); }
struct Unit { int pm, pn; };
struct Gemm { const bf16_t* A; const bf16_t* Bt; int M, N, K; };
struct StaticOrder {
    int nM, nN, nwg, G, c;
    __device__ void init(int M, int N, int G_, int c_) { nM = M / BM; nN = N / BM; nwg = nM * nN; G = G_; c = c_; }
    __device__ bool next(int i, Unit& u) const {
        const long L = (long)i * G + c; if (L >= nwg) return false;
        int wgid = (int)L; { const int q = nwg / NXCD, r = nwg % NXCD, xcd = wgid % NXCD, off = wgid / NXCD; wgid = (xcd < r ? xcd * (q + 1) : r * (q + 1) + (xcd - r) * q) + off; }
        const int nig = WGM * nN, gid = wgid / nig, fm = gid * WGM, gsz = (nM - fm) < WGM ? (nM - fm) : WGM;
        u.pm = fm + ((wgid % nig) % gsz); u.pn = (wgid % nig) / gsz; return true;
    }
};
__device__ __forceinline__ unsigned cvt_pk_bf16(float lo, float hi) { unsigned r; asm volatile("v_cvt_pk_bf16_f32 %0, %1, %2" : "=v"(r) : "v"(lo), "v"(hi)); return r; }
struct EpiBf16 {
    static constexpr bool PERM = true;
    bf16_t* O0; int ld0; int split; bf16_t* O1; int ld1;
    __device__ __forceinline__ void operator()(const f32x4 (&acc)[2][2][4][2], const Unit& u, int wr, int wc, int fr, int fq) const {
        const int row0 = u.pm * BM + wr * 64 + fr; int colt = u.pn * BM; bf16_t* base = O0; int ld = ld0;
        if (colt >= split) { base = O1; ld = ld1; colt -= split; }
        const int col0 = colt + wc * 32 + 8 * fq;
#pragma unroll
        for (int ai = 0; ai < 2; ++ai)
#pragma unroll
            for (int m = 0; m < 4; ++m) { bf16_t* rowp = base + (size_t)(row0 + ai * HALF + m * 16) * ld + col0;
#pragma unroll
                for (int bj = 0; bj < 2; ++bj) { const f32x4 v0 = acc[ai][bj][m][0], v1 = acc[ai][bj][m][1];
                    u32x4 w; w.x = cvt_pk_bf16(v0[0], v0[1]); w.y = cvt_pk_bf16(v0[2], v0[3]); w.z = cvt_pk_bf16(v1[0], v1[1]); w.w = cvt_pk_bf16(v1[2], v1[3]);
                    *(u32x4*)(rowp + bj * HALF) = w; } }
    }
};
template <class Epi, class Sched>
__device__ __forceinline__ void gemm_phase(LAS unsigned char* lds, const Gemm g, const Sched& S, const Epi& E, const int wv0) {
    int tid = opaque_tid(wv0);
    const int wid = __builtin_amdgcn_readfirstlane(tid >> 6), lane = tid & 63, wr = wid >> 2, wc = wid & 3, fr = lane & 15, fq = lane >> 4;
    const int K = g.K, nt = K / BK;
    unsigned voffA[2], voffB[2];
#pragma unroll
    for (int i = 0; i < 2; ++i) { int R, C; stage_rc(tid * 16 + i * 8192, R, C); const int Rb = Epi::PERM ? ((R & ~31) + perm32(R & 31)) : R;
        voffA[i] = (unsigned)(R * K + C) * 2u; voffB[i] = (unsigned)(Rb * K + C) * 2u; }
    const size_t kstep = (size_t)(BK * 2);
    const size_t hstep = (size_t)HALF * K * 2;
    const size_t tstep = 2 * hstep;
    const unsigned ldsw = (unsigned)wid * 1024u;
    const int aoff = lds_byte(wr * 64 + fr, fq * 8), boff = lds_byte(wc * 32 + fr, fq * 8);
#define PG8_SA(b, h) (((b) * 2 + (h)) * HTB)
#define PG8_SB(b, h) ((4 + (b) * 2 + (h)) * HTB)
#define PG8_STAGE(bufoff, gbase, voff) do { _Pragma("unroll") for (int _i = 0; _i < 2; ++_i) \
        __builtin_amdgcn_global_load_lds((const unsigned*)((const char*)(gbase) + (voff)[_i]), (LAS unsigned*)(lds + (bufoff) + ldsw + _i * 8192), 16, 0, 0); } while (0)
#define PG8_LDA(dst, b, h) do { _Pragma("unroll") for (int m = 0; m < 4; ++m) _Pragma("unroll") for (int k = 0; k < 2; ++k) dst[m][k] = *(const LAS bf16x8*)(lds + PG8_SA(b, h) + aoff + m * 2048 + k * 1024); } while (0)
#define PG8_LDB(dst, b, h) do { _Pragma("unroll") for (int n = 0; n < 2; ++n) _Pragma("unroll") for (int k = 0; k < 2; ++k) dst[n][k] = *(const LAS bf16x8*)(lds + PG8_SB(b, h) + boff + n * 2048 + k * 1024); } while (0)
#define PG8_MMA(ai, bj, At, Bt) do { __builtin_amdgcn_s_setprio(1); _Pragma("unroll") for (int m = 0; m < 4; ++m) _Pragma("unroll") for (int n = 0; n < 2; ++n) _Pragma("unroll") for (int k = 0; k < 2; ++k) \
        acc[ai][bj][m][n] = __builtin_amdgcn_mfma_f32_16x16x32_bf16(Bt[n][k], At[m][k], acc[ai][bj][m][n], 0, 0, 0); __builtin_amdgcn_s_setprio(0); } while (0)
#define PG8_WAIT_V(n) asm volatile("s_waitcnt vmcnt(" #n ")" ::: "memory")
#define PG8_WAIT_L(n) asm volatile("s_waitcnt lgkmcnt(" #n ")" ::: "memory")
#define PG8_BAR __builtin_amdgcn_s_barrier()
#define PG8_SCHED __builtin_amdgcn_sched_barrier(0)
    Unit cur, nxt; int ui = 0;
    if (!S.next(0, cur)) return;
    f32x4 acc[2][2][4][2];
#pragma unroll
    for (int a = 0; a < 2; ++a)
#pragma unroll
        for (int b = 0; b < 2; ++b)
#pragma unroll
            for (int m = 0; m < 4; ++m)
#pragma unroll
                for (int n = 0; n < 2; ++n) acc[a][b][m][n] = (f32x4){0.f, 0.f, 0.f, 0.f};
    bf16x8 At[4][2], B0[2][2], B1[2][2];
    const char* cA = (const char*)g.A + (size_t)cur.pm * tstep; const char* cB = (const char*)g.Bt + (size_t)cur.pn * tstep;
    PG8_STAGE(PG8_SB(0, 0), cB, voffB); PG8_STAGE(PG8_SA(0, 0), cA, voffA); PG8_STAGE(PG8_SB(0, 1), cB + hstep, voffB); PG8_STAGE(PG8_SA(0, 1), cA + hstep, voffA);
    if (wr == 1) PG8_BAR;
    PG8_WAIT_V(4); PG8_BAR;
    PG8_STAGE(PG8_SB(1, 0), cB + kstep, voffB); PG8_STAGE(PG8_SA(1, 0), cA + kstep, voffA); PG8_STAGE(PG8_SB(1, 1), cB + hstep + kstep, voffB);
    PG8_WAIT_V(6); PG8_BAR;
    for (;;) {
        const bool has_next = S.next(ui + 1, nxt);
        const char* nA = has_next ? (const char*)g.A + (size_t)nxt.pm * tstep : cA; const char* nB = has_next ? (const char*)g.Bt + (size_t)nxt.pn * tstep : cB;
        for (int t = 0; t < nt; t += 2) {
            const bool last = (t == nt - 2);
            const char* a1 = cA + (size_t)(t + 1) * kstep;
            const char* a2 = last ? nA : cA + (size_t)(t + 2) * kstep; const char* b2 = last ? nB : cB + (size_t)(t + 2) * kstep;
            const char* a3 = a2 + kstep; const char* b3 = b2 + kstep;
            PG8_LDB(B0, 0, 0); PG8_SCHED; PG8_LDA(At, 0, 0); PG8_STAGE(PG8_SA(1, 1), a1 + hstep, voffA);
            PG8_WAIT_L(8); PG8_BAR; PG8_WAIT_L(0); PG8_MMA(0, 0, At, B0); PG8_BAR; PG8_SCHED;
            PG8_LDB(B1, 0, 1); PG8_STAGE(PG8_SB(0, 0), b2, voffB);
            PG8_BAR; PG8_WAIT_L(0); PG8_MMA(0, 1, At, B1); PG8_BAR;
            PG8_LDA(At, 0, 1); PG8_STAGE(PG8_SA(0, 0), a2, voffA);
            PG8_BAR; PG8_WAIT_L(0); PG8_MMA(1, 0, At, B0); PG8_BAR; PG8_SCHED;
            PG8_STAGE(PG8_SB(0, 1), b2 + hstep, voffB);
            PG8_WAIT_V(6); PG8_BAR; PG8_MMA(1, 1, At, B1); PG8_BAR;
            PG8_LDB(B0, 1, 0); PG8_SCHED; PG8_LDA(At, 1, 0); PG8_STAGE(PG8_SA(0, 1), a2 + hstep, voffA);
            PG8_WAIT_L(8); PG8_BAR; PG8_WAIT_L(0); PG8_MMA(0, 0, At, B0); PG8_BAR; PG8_SCHED;
            PG8_LDB(B1, 1, 1); PG8_STAGE(PG8_SB(1, 0), b3, voffB);
            PG8_BAR; PG8_WAIT_L(0); PG8_MMA(0, 1, At, B1); PG8_BAR;
            PG8_LDA(At, 1, 1); PG8_STAGE(PG8_SA(1, 0), a3, voffA);
            PG8_BAR; PG8_WAIT_L(0); PG8_MMA(1, 0, At, B0); PG8_BAR; PG8_SCHED;
            PG8_STAGE(PG8_SB(1, 1), b3 + hstep, voffB);
            PG8_WAIT_V(6); PG8_BAR; PG8_MMA(1, 1, At, B1); PG8_BAR;
        }
        E(acc, cur, wr, wc, fr, fq);
        if (!has_next) break;
#pragma unroll
        for (int a = 0; a < 2; ++a)
#pragma unroll
            for (int b = 0; b < 2; ++b)
#pragma unroll
                for (int m = 0; m < 4; ++m)
#pragma unroll
                    for (int n = 0; n < 2; ++n) acc[a][b][m][n] = (f32x4){0.f, 0.f, 0.f, 0.f};
        cur = nxt; cA = nA; cB = nB; ++ui;
    }
    PG8_WAIT_V(0);
    if (wr == 0) PG8_BAR;
    PG8_BAR;
#undef PG8_SA
#undef PG8_SB
#undef PG8_STAGE
#undef PG8_LDA
#undef PG8_LDB
#undef PG8_MMA
#undef PG8_WAIT_V
#undef PG8_WAIT_L
#undef PG8_BAR
#undef PG8_SCHED
}
}


#define XB_TMO      128
#define XB_XCNT(j)  (256  + 64 * (j))
#define XB_XSUB(j)  (1280 + 64 * (j))
#define XB_XGEN(j)  (2304 + 64 * (j))
#define XB_TOP      3328
#define XB_TOPGEN   3392
#define XCD_BAR_WORDS 3456
#define XB_SPIN_CAP (1u << 18)
__device__ __forceinline__ unsigned xb_ld(unsigned* p)              { return __hip_atomic_load(p, __ATOMIC_RELAXED, __HIP_MEMORY_SCOPE_AGENT); }
__device__ __forceinline__ unsigned xb_add(unsigned* p, unsigned v) { return __hip_atomic_fetch_add(p, v, __ATOMIC_RELAXED, __HIP_MEMORY_SCOPE_AGENT); }
__device__ __forceinline__ unsigned xb_xcc_id() { return (unsigned)__builtin_amdgcn_s_getreg((3 << 11) | 20) & 0xFu; }
#define XB_SPIN(cond, bar) do { unsigned _sp = 0; while (cond) { __builtin_amdgcn_s_sleep(1); \
    if ((++_sp & 255u) == 0u) { if (xb_ld(&(bar)[XB_TMO])) break; if (_sp > XB_SPIN_CAP) { atomicAdd(&(bar)[XB_TMO], 1u); break; } } } } while (0)
struct XcdBarrier { unsigned* bar; unsigned x; volatile LAS unsigned* st; };
__device__ __forceinline__ XcdBarrier xcd_barrier_post(unsigned* bar, volatile LAS unsigned* st) {
    XcdBarrier b; b.bar = bar; b.x = xb_xcc_id(); b.st = st;
    if (threadIdx.x == 0) (void)xb_add(&bar[XB_XCNT(b.x)], 1u);
    return b;
}
__device__ __forceinline__ void xcd_barrier_complete(unsigned* bar, unsigned x, unsigned& nloc, unsigned& nx) {
    const unsigned G = gridDim.x * gridDim.y * gridDim.z;
    unsigned sum, cnt, mine, sp = 0u;
    for (;;) {
        sum = 0u; cnt = 0u; mine = 0u;
#pragma unroll
        for (unsigned j = 0; j < 16; ++j) { const unsigned c = xb_ld(&bar[XB_XCNT(j)]); sum += c; cnt += (c > 0u) ? 1u : 0u; mine = (j == x) ? c : mine; }
        if (sum == G) break;
        __builtin_amdgcn_s_sleep(1);
        if ((++sp & 255u) == 0u) { if (xb_ld(&bar[XB_TMO])) break; if (sp > XB_SPIN_CAP) { atomicAdd(&bar[XB_TMO], 1u); break; } }
    }
    nloc = mine > 0u ? mine : 1u; nx = cnt > 0u ? cnt : 1u;
}
__device__ __forceinline__ void xcd_barrier(const XcdBarrier& b, const int wv0) {
    asm volatile("s_waitcnt vmcnt(0)" ::: "memory");
    __syncthreads();
    if (opaque_tid(wv0) == 0) {
        unsigned* bar = b.bar;
        __builtin_amdgcn_s_waitcnt(0);
        unsigned nloc = b.st[0], nx = b.st[1];
        if (nloc == 0u) { xcd_barrier_complete(bar, b.x, nloc, nx); b.st[0] = nloc; b.st[1] = nx; }
        const unsigned old = xb_add(&bar[XB_XSUB(b.x)], 1u);
        const unsigned gen = old / nloc;
        if (old + 1u == (gen + 1u) * nloc) {
            __builtin_amdgcn_fence(__ATOMIC_RELEASE, "agent");
            asm volatile("s_waitcnt vmcnt(0)" ::: "memory");
            const unsigned og = xb_add(&bar[XB_TOP], 1u);
            const unsigned tg = og / nx;
            if (og + 1u == (tg + 1u) * nx) xb_add(&bar[XB_TOPGEN], 1u);
            else XB_SPIN(xb_ld(&bar[XB_TOPGEN]) == tg, bar);
            __builtin_amdgcn_fence(__ATOMIC_ACQUIRE, "agent");
            xb_add(&bar[XB_XGEN(b.x)], 1u);
            asm volatile("s_waitcnt vmcnt(0)" ::: "memory");
        } else {
            XB_SPIN(xb_ld(&bar[XB_XGEN(b.x)]) == gen, bar);
            __builtin_amdgcn_fence(__ATOMIC_ACQUIRE, "agent");
            asm volatile("s_waitcnt vmcnt(0)" ::: "memory");
        }
    }
    __syncthreads();
}

struct Frame {
    LAS unsigned char* lds;
    int vcu, G, wv;
    const float* const* in; float* out; unsigned char* ws;
    __device__ __forceinline__ float* MOD() const { return (float*)(ws + WS_MOD); }
    __device__ __forceinline__ float* ROPE() const { return (float*)(ws + WS_ROPE); }
    __device__ __forceinline__ float* BA() const { return (float*)(ws + WS_BA); }
    __device__ __forceinline__ float* LAG() const { return (float*)(ws + WS_LAG); }
    __device__ __forceinline__ bf16_t* W1O() const { return (bf16_t*)(ws + WS_W1O); }
    __device__ __forceinline__ bf16_t* U0() const { return (bf16_t*)(ws + WS_RA); }
    __device__ __forceinline__ bf16_t* QKV1() const { return (bf16_t*)(ws + WS_RA); }
    __device__ __forceinline__ bf16_t* Z1() const { return (bf16_t*)(ws + WS_RA + (size_t)MT * 3072 * 2); }
    __device__ __forceinline__ bf16_t* Y1() const { return (bf16_t*)(ws + WS_RA + (size_t)MT * 3072 * 2); }
    __device__ __forceinline__ bf16_t* XN() const { return (bf16_t*)(ws + WS_RB + RB_XN); }
    __device__ __forceinline__ bf16_t* Y0() const { return (bf16_t*)(ws + WS_RB + RB_Y0); }
    __device__ __forceinline__ bf16_t* YO() const { return (bf16_t*)(ws + WS_RB + RB_YO); }
    __device__ __forceinline__ bf16_t* W0I() const { return (bf16_t*)(ws + WS_RB + RB_W0I); }
    __device__ __forceinline__ bf16_t* W0O() const { return (bf16_t*)(ws + WS_RB + RB_W0O); }
    __device__ __forceinline__ bf16_t* W1I() const { return (bf16_t*)(ws + WS_RB + RB_W1I); }
    __device__ __forceinline__ bf16_t* QKVC() const { return (bf16_t*)(ws + WS_RB); }
};

#define PHASE_IDS() int tid = opaque_tid(F.wv); const int lane = tid & 63, wave = __builtin_amdgcn_readfirstlane(tid >> 6); (void)lane; (void)wave
__device__ __forceinline__ void p0_transpose_item(const float* W, int ldw, int nblk, int K, bf16_t* WT, LAS float* scr, int item, int lane) {
    const int kb = item / nblk, nb = item % nblk, k0 = 64 * kb, n0 = 32 * nb;
    f32x4 v[8];
#pragma unroll
    for (int i = 0; i < 8; ++i) v[i] = *(const f32x4*)(W + (size_t)(k0 + 8 * i + (lane >> 3)) * ldw + n0 + 4 * (lane & 7));
#pragma unroll
    for (int i = 0; i < 8; ++i) { LAS float* d = scr + (8 * i + (lane >> 3)) * 33 + 4 * (lane & 7); d[0] = v[i][0]; d[1] = v[i][1]; d[2] = v[i][2]; d[3] = v[i][3]; }
    asm volatile("s_waitcnt lgkmcnt(0)" ::: "memory");
    const int c = lane & 7;
#pragma unroll
    for (int j = 0; j < 4; ++j) { const int n = (lane >> 3) + 8 * j; const LAS float* s = scr + (8 * c) * 33 + n;
        u32x4 o; o.x = pk2(s[0 * 33], s[1 * 33]); o.y = pk2(s[2 * 33], s[3 * 33]); o.z = pk2(s[4 * 33], s[5 * 33]); o.w = pk2(s[6 * 33], s[7 * 33]);
        *(u32x4*)(WT + (size_t)(n0 + n) * K + k0 + 8 * c) = o; }
    asm volatile("s_waitcnt lgkmcnt(0)" ::: "memory");
}
__device__ __forceinline__ void phase_prologue(Frame& F) {
    PHASE_IDS();
    const int gw = F.vcu * 8 + wave, NGW = F.G * 8;
    {
        LAS float* scr = (LAS float*)(F.lds + wave * 16384);
        constexpr int I0 = 16 * (EV_IN / 32), I1 = 16 * 32, I2 = 16 * (OD_MAIN / 32), I3 = 16 * 32;
        const bool split = F.G >= 192; const int tw0 = split ? (F.vcu - 96) * 8 + wave : gw, tnw = split ? (F.G - 96) * 8 : NGW;
        for (int it = (split && F.vcu < 96) ? (I0 + I1 + I2 + I3) : tw0; it < I0 + I1 + I2 + I3; it += tnw) {
            int r = it;
            if (r < I0) { p0_transpose_item(F.in[14], EV_IN, EV_IN / 32, D, F.W0I(), scr, r, lane); continue; } r -= I0;
            if (r < I1) { p0_transpose_item(F.in[23], D, 32, D, F.W0O(), scr, r, lane); continue; } r -= I1;
            if (r < I2) { p0_transpose_item(F.in[28], OD_IN, OD_MAIN / 32, D, F.W1I(), scr, r, lane); continue; } r -= I2;
            p0_transpose_item(F.in[33], D, 32, D, F.W1O(), scr, r, lane);
        }
    }
    {
        const double inv[8] = {1.0, 0.19392274474868576, 0.03760603093086393, 0.007292664737217109, 0.001414213562373095, 0.0002742481756762073, 5.318295896944988e-05, 1.031338537721246e-05};
        for (int idx = F.vcu * 512 + tid; idx < 4112 * 8; idx += F.G * 512) {
            const int pos = idx >> 3, i = idx & 7;
            double iv = inv[0];
#pragma unroll
            for (int q = 1; q < 8; ++q) iv = (i == q) ? inv[q] : iv;
            const double ang = (double)pos * iv;
            const double n = __builtin_rint(ang * 0.15915494309189535);
            const float r = (float)__builtin_fma(-n, 6.283185307179586, ang);
            F.ROPE()[pos * 16 + i] = __cosf(r); F.ROPE()[pos * 16 + 8 + i] = __sinf(r);
        }
    }
    {
        bf16_t* LGW = (bf16_t*)(F.ws + WS_LGW);
        for (int idx = F.vcu * 512 + tid; idx < 8 * 2 * 64 * 64; idx += F.G * 512) { const int k = idx & 63, n = (idx >> 6) & 63, gate = (idx >> 12) & 1, hh = idx >> 13;
            LGW[idx] = (bf16_t)f2bf((gate ? F.in[19] : F.in[17])[(hh * 64 + k) * 64 + n]); }
    }
    __syncthreads();
    for (int bt = F.vcu; bt < 96; bt += F.G) {
        LAS float* tab = (LAS float*)F.lds;
        const float* cpr = F.in[8]; const float* csm = F.in[9];
        int t2 = tid; asm volatile("" : "+v"(t2));
#pragma unroll
        for (int i0 = 0; i0 < 48; i0 += 16) {
            float cv[16];
#pragma unroll
            for (int u = 0; u < 16; ++u) { const int idx = t2 + 512 * (i0 + u), s = idx >> 10, k = idx & 1023; const float* cp = s < BP ? cpr + s * D + k : csm + (s - BP) * D + k; cv[u] = *cp; }
#pragma unroll
            for (int u = 0; u < 16; ++u) { const int idx = t2 + 512 * (i0 + u), s = idx >> 10, k = idx & 1023; tab[k * 24 + s] = siluf_(cv[u]); } }
        __syncthreads();
        const int L = bt / 48, n0 = (bt % 48) * 64;
        const float* mw = (L == 0 ? F.in[10] : F.in[24]) + n0 + lane;
        float acc[24];
#pragma unroll
        for (int r = 0; r < 24; ++r) acc[r] = 0.f;
        for (int k0 = wave * 128; k0 < wave * 128 + 128; k0 += 16) {
            float wv[16];
#pragma unroll
            for (int u = 0; u < 16; ++u) wv[u] = mw[(size_t)(k0 + u) * 3072];
#pragma unroll
            for (int u = 0; u < 16; ++u) { const float w = wv[u];
                const LAS f32x4* tp = (const LAS f32x4*)(tab + (k0 + u) * 24);
#pragma unroll
                for (int q = 0; q < 6; ++q) { const f32x4 t4 = tp[q]; acc[4 * q] += t4[0] * w; acc[4 * q + 1] += t4[1] * w; acc[4 * q + 2] += t4[2] * w; acc[4 * q + 3] += t4[3] * w; } }
        }
        __syncthreads();
        LAS float* red = (LAS float*)F.lds;
#pragma unroll
        for (int r = 0; r < 24; ++r) red[(wave * 24 + r) * 64 + lane] = acc[r];
        __syncthreads();
        const float* mb = (L == 0 ? F.in[11] : F.in[25]);
        for (int idx = tid; idx < 24 * 64; idx += 512) { const int r = idx >> 6, l = idx & 63; float s = 0.f;
#pragma unroll
            for (int w = 0; w < 8; ++w) s += red[(w * 24 + r) * 64 + l];
            F.MOD()[((size_t)L * 24 + r) * 3072 + n0 + l] = s + mb[n0 + l]; }
        __syncthreads();
    }
}

__device__ __forceinline__ const float* x_row(Frame& F, int m) { return m < MP ? F.in[0] + (size_t)m * D : F.in[1] + (size_t)(m - MP) * D; }
__device__ __forceinline__ void rows_prenorm0(Frame& F, const int m0, const int n, const int s, const int lane) {
    const float* modr = F.MOD() + (size_t)s * 3072;
    f32x4 A[4], C[4];
#pragma unroll
    for (int j = 0; j < 4; ++j) { const int c = 4 * lane + 256 * j; const f32x4 g = *(const f32x4*)(F.in[12] + c), sc = *(const f32x4*)(modr + 1024 + c); C[j] = *(const f32x4*)(modr + c);
#pragma unroll
        for (int e = 0; e < 4; ++e) A[j][e] = g[e] * (1.f + sc[e]); }
    f32x4 cur[4];
#pragma unroll
    for (int j = 0; j < 4; ++j) cur[j] = *(const f32x4*)(x_row(F, m0) + 4 * lane + 256 * j);
    for (int i = 0; i < n; ++i) {
        const int mn = m0 + (i + 1 < n ? i + 1 : i); f32x4 nxt[4];
#pragma unroll
        for (int j = 0; j < 4; ++j) nxt[j] = *(const f32x4*)(x_row(F, mn) + 4 * lane + 256 * j);
        float ss = 0.f;
#pragma unroll
        for (int j = 0; j < 4; ++j) ss += (cur[j][0] * cur[j][0] + cur[j][1] * cur[j][1]) + (cur[j][2] * cur[j][2] + cur[j][3] * cur[j][3]);
        const float r = rsqrtf(wave_sum(ss, lane) * (1.f / D) + EPS);
#pragma unroll
        for (int j = 0; j < 4; ++j) { u32x2 w; w[0] = cvt2(cur[j][0] * r * A[j][0] + C[j][0], cur[j][1] * r * A[j][1] + C[j][1]); w[1] = cvt2(cur[j][2] * r * A[j][2] + C[j][2], cur[j][3] * r * A[j][3] + C[j][3]);
            *(u32x2*)(F.XN() + (size_t)(m0 + i) * D + 4 * lane + 256 * j) = w; }
#pragma unroll
        for (int j = 0; j < 4; ++j) cur[j] = nxt[j];
    }
}
__device__ __forceinline__ void phase_prenorm0(Frame& F) {
    PHASE_IDS();
    const int gw = F.vcu * 8 + wave, NGW = F.G * 8;
    for (int w = gw; w < MP / 16; w += NGW) rows_prenorm0(F, w * 16, 16, w >> 8, lane);
    for (int w = gw; w < MS; w += NGW) rows_prenorm0(F, MP + w, 1, BP + (w >> 4), lane);
}

__device__ __forceinline__ void phase_rope(Frame& F) {
    PHASE_IDS();
    const int gt = F.vcu * 512 + tid, NT = F.G * 512;
    for (int idx = gt; idx < MT * 80; idx += NT) {
        const int m = idx / 80, r = idx % 80, slot = r >> 3, i = r & 7;
        int s, t; tok_info(m, s, t);
        const int pos = s < BP ? t : TP + t;
        const int col = slot < 8 ? C_Q + slot * 64 : C_K + (slot - 8) * 64;
        bf16_t* p = F.U0() + (size_t)m * EV_IN + col;
        const float x1 = bf2f(p[i]), x2 = bf2f(p[8 + i]), c = F.ROPE()[pos * 16 + i], sn = F.ROPE()[pos * 16 + 8 + i];
        const float o1 = x1 * c - x2 * sn, o2 = x2 * c + x1 * sn;
        p[i] = (bf16_t)f2bf(o1); p[8 + i] = (bf16_t)f2bf(o2);
        if (slot >= 8) { const int kv = slot - 8;
            if (s >= BP) { float* o = F.out + O_KS + ((size_t)((s - BP) * TS + t) * 2 + kv) * 64; o[i] = o1; o[8 + i] = o2; }
            else if (t >= TP - 128) { float* o = F.out + O_KP + ((size_t)(s * 128 + (t - (TP - 128))) * 2 + kv) * 64; o[i] = o1; o[8 + i] = o2; } }
    }
    for (int idx = gt; idx < 1280 * 224; idx += NT) {
        const int tk = idx / 224, e = idx % 224;
        int s, t, m; if (tk < 1024) { s = tk >> 7; t = TP - 128 + (tk & 127); m = s * TP + t; } else { s = BP + ((tk - 1024) >> 4); t = (tk - 1024) & 15; m = MP + (tk - 1024); }
        const bool isv = e >= 96; const int e2 = isv ? e - 96 : e; const int kv = isv ? (e2 >> 6) : (e2 / 48), d = isv ? (e2 & 63) : 16 + (e2 % 48);
        const float val = bf2f(F.U0()[(size_t)m * EV_IN + (isv ? C_V : C_K) + kv * 64 + d]);
        const size_t ob = s >= BP ? (isv ? O_VS : O_KS) + ((size_t)((s - BP) * TS + t) * 2 + kv) * 64 : (isv ? O_VP : O_KP) + ((size_t)(s * 128 + (t - (TP - 128))) * 2 + kv) * 64;
        F.out[ob + d] = val;
    }
}


__device__ __forceinline__ void rows_mid(Frame& F, LAS float* baw, const int m0, const int n, const int s, const int lane) {
    const float* mod0 = F.MOD() + (size_t)s * 3072; const float* mod1 = F.MOD() + (size_t)(24 + s) * 3072;
    f32x4 A0[4], B1[4], C1[4];
#pragma unroll
    for (int j = 0; j < 4; ++j) { const int c = 4 * lane + 256 * j; const f32x4 g0 = *(const f32x4*)(F.in[13] + c), gt = *(const f32x4*)(mod0 + 2048 + c), g1 = *(const f32x4*)(F.in[26] + c), sc = *(const f32x4*)(mod1 + 1024 + c);
        C1[j] = *(const f32x4*)(mod1 + c);
#pragma unroll
        for (int e = 0; e < 4; ++e) { A0[j][e] = gt[e] * g0[e]; B1[j][e] = g1[e] * (1.f + sc[e]); } }
    u32x2 ycur[4]; f32x4 xcur[4];
#pragma unroll
    for (int j = 0; j < 4; ++j) { ycur[j] = *(const u32x2*)(F.YO() + (size_t)m0 * D + 4 * lane + 256 * j); xcur[j] = *(const f32x4*)(x_row(F, m0) + 4 * lane + 256 * j); }
    for (int i = 0; i < n; ++i) {
        const int m = m0 + i, mn = m0 + (i + 1 < n ? i + 1 : i); u32x2 ynxt[4]; f32x4 xnxt[4];
#pragma unroll
        for (int j = 0; j < 4; ++j) { ynxt[j] = *(const u32x2*)(F.YO() + (size_t)mn * D + 4 * lane + 256 * j); xnxt[j] = *(const f32x4*)(x_row(F, mn) + 4 * lane + 256 * j); }
        f32x4 y[4]; float ss = 0.f;
#pragma unroll
        for (int j = 0; j < 4; ++j) { y[j] = (f32x4){lo16(ycur[j][0]), hi16(ycur[j][0]), lo16(ycur[j][1]), hi16(ycur[j][1])}; ss += (y[j][0] * y[j][0] + y[j][1] * y[j][1]) + (y[j][2] * y[j][2] + y[j][3] * y[j][3]); }
        const float r1 = rsqrtf(wave_sum(ss, lane) * (1.f / D) + EPS);
        f32x4 x1[4]; float s2 = 0.f;
#pragma unroll
        for (int j = 0; j < 4; ++j) {
#pragma unroll
            for (int e = 0; e < 4; ++e) x1[j][e] = xcur[j][e] + A0[j][e] * (y[j][e] * r1);
            *(f32x4*)(F.out + O_Y + (size_t)m * D + 4 * lane + 256 * j) = x1[j];
            s2 += (x1[j][0] * x1[j][0] + x1[j][1] * x1[j][1]) + (x1[j][2] * x1[j][2] + x1[j][3] * x1[j][3]); }
        const float r2 = rsqrtf(wave_sum(s2, lane) * (1.f / D) + EPS);
        f32x4 hm[4];
#pragma unroll
        for (int j = 0; j < 4; ++j) {
#pragma unroll
            for (int e = 0; e < 4; ++e) hm[j][e] = x1[j][e] * r2 * B1[j][e] + C1[j][e];
            u32x2 w; w[0] = cvt2(hm[j][0], hm[j][1]); w[1] = cvt2(hm[j][2], hm[j][3]); *(u32x2*)(F.XN() + (size_t)m * D + 4 * lane + 256 * j) = w; }
        float p[16];
#pragma unroll
        for (int q = 0; q < 16; ++q) { p[q] = 0.f;
#pragma unroll
            for (int j = 0; j < 4; ++j) { const f32x4 w = *(const LAS f32x4*)(baw + q * 1024 + 256 * j + 4 * lane); p[q] += (hm[j][0] * w[0] + hm[j][1] * w[1]) + (hm[j][2] * w[2] + hm[j][3] * w[3]); }
            if ((q & 3) == 3) __builtin_amdgcn_sched_barrier(0); }
        { const bool u5 = (lane & 32) != 0;
#pragma unroll
          for (int q = 0; q < 8; ++q) { const float keep = u5 ? p[8 + q] : p[q], send = u5 ? p[q] : p[8 + q]; p[q] = keep + shfl_xor_l(send, 32, lane); } }
        { const bool u4 = (lane & 16) != 0;
#pragma unroll
          for (int q = 0; q < 4; ++q) { const float keep = u4 ? p[4 + q] : p[q], send = u4 ? p[q] : p[4 + q]; p[q] = keep + shfl_xor_l(send, 16, lane); } }
        { const bool u3 = (lane & 8) != 0;
#pragma unroll
          for (int q = 0; q < 2; ++q) { const float keep = u3 ? p[2 + q] : p[q], send = u3 ? p[q] : p[2 + q]; p[q] = keep + shfl_xor_l(send, 8, lane); } }
        { const bool u2 = (lane & 4) != 0; const float keep = u2 ? p[1] : p[0], send = u2 ? p[0] : p[1]; p[0] = keep + shfl_xor_l(send, 4, lane); }
        float mine = p[0]; mine += shfl_xor_l(mine, 2, lane); mine += shfl_xor_l(mine, 1, lane);
        if ((lane & 3) == 0) { const int col = lane >> 2, hh = col & 7;
            F.BA()[(size_t)m * 16 + col] = col < 8 ? sigmoidf_(mine) : -__expf(F.in[30][hh]) * softplusf_(mine + F.in[31][hh]); }
#pragma unroll
        for (int j = 0; j < 4; ++j) { ycur[j] = ynxt[j]; xcur[j] = xnxt[j]; }
    }
}
__device__ __forceinline__ void phase_mid_rowwise(Frame& F) {
    PHASE_IDS();
    LAS float* baw = (LAS float*)F.lds;
    for (int idx = tid; idx < 16 * 1024; idx += 512) { const int j = idx & 15, k = idx >> 4; baw[j * 1024 + k] = F.in[28][(size_t)k * OD_IN + OD_MAIN + j]; }
    __syncthreads();
    const int gw = F.vcu * 8 + wave, NGW = F.G * 8;
    for (int w = gw; w < MP / 16; w += NGW) rows_mid(F, baw, w * 16, 16, w >> 8, lane);
    for (int w = gw; w < MS; w += NGW) rows_mid(F, baw, MP + w, 1, BP + (w >> 4), lane);
}


typedef float f32x16 __attribute__((ext_vector_type(16)));
constexpr int GS_WF = 0, GS_QF = 16384, GS_KF = 32768, GS_PF = 49152, GS_UF = 57344, GS_BYTES = 73728;
constexpr size_t WS_DEC = 11 * MiB;
__device__ __forceinline__ int krow(int s, int h, int j) { return 16 * s + 8 * (j >> 2) + 4 * h + (j & 3); }
#define MFMA32(a, b, c) __builtin_amdgcn_mfma_f32_32x32x16_bf16((a), (b), (c), 0, 0, 0)
#define MFMA16(a, b, c) __builtin_amdgcn_mfma_f32_16x16x32_bf16((a), (b), (c), 0, 0, 0)

typedef __amdgpu_buffer_rsrc_t brsrc_t;
__device__ __forceinline__ brsrc_t staging_rsrc(unsigned char* ws) { return __builtin_amdgcn_make_buffer_rsrc((void*)(ws + WS_RB), (short)0, (int)RB_BYTES, 0x00020000); }
__device__ __forceinline__ void st16_wt(brsrc_t r, unsigned off, u32x4 v) { __builtin_amdgcn_raw_buffer_store_b128(v, r, off, 0, 16); }
__device__ __forceinline__ u32x4 ld16_wt(brsrc_t r, unsigned off) { return __builtin_amdgcn_raw_buffer_load_b128(r, off, 0, 16); }
__device__ __forceinline__ void st8_wt(unsigned char* p, u32x2 v) { __hip_atomic_store((unsigned long long*)p, ((unsigned long long)v[1] << 32) | v[0], __ATOMIC_RELAXED, __HIP_MEMORY_SCOPE_AGENT); }
constexpr size_t WS_READY = 65536;
#define LDS_BARRIER() do { asm volatile("s_waitcnt lgkmcnt(0)" ::: "memory"); __builtin_amdgcn_s_barrier(); asm volatile("" ::: "memory"); } while (0)
constexpr int G1_QS = 0, G1_KS = 17408, G1_VS = 34816, G1_AS = 52224, G1_PS = 69632, G1_WS = 78848, G1_CW = 96256, G1_VEC = 102400, G1_ES = 103424;
__device__ __forceinline__ void g1_load_raw(Frame& F, u32x4 (&raw)[24], int s, int c, int h, int t1) {
    const int r = t1 >> 3, j = t1 & 7, t = c * 64 + r;
#pragma unroll
    for (int p = 0; p < 3; ++p)
#pragma unroll
        for (int jj = 0; jj < 4; ++jj) { const int tt = t - 3 + jj, ttc = tt < 0 ? 0 : tt;
            const u32x4* src = (const u32x4*)(F.QKV1() + (size_t)(s * TP + ttc) * 3072 + p * 1024 + h * 128 + j * 16); raw[p * 8 + jj * 2] = src[0]; raw[p * 8 + jj * 2 + 1] = src[1]; }
}
__device__ __forceinline__ bf16x8 g1_pack_b(const f32x4 p, const f32x4 q) { u32x4 w; w[0] = cvt2(p[0], p[1]); w[1] = cvt2(p[2], p[3]); w[2] = cvt2(q[0], q[1]); w[3] = cvt2(q[2], q[3]); return __builtin_bit_cast(bf16x8, w); }
__device__ __forceinline__ void g1_decode(int n, int& s, int& c, int& h) { if (n < 4096) { c = n >> 6; s = (n & 63) >> 3; h = n & 7; } else { s = BP + ((n - 4096) >> 3); c = 0; h = n & 7; } }
__device__ __forceinline__ void gdn_g1_tasks(Frame& F, const int first, const int stride) {
    int tid = opaque_tid(F.wv);
    const int lane = tid & 63, wave = __builtin_amdgcn_readfirstlane(tid >> 6);
    LAS unsigned char* L = F.lds;
    LAS float* cw_s = (LAS float*)(L + G1_CW);
    LAS float* beta_s = (LAS float*)(L + G1_VEC); LAS float* gcum_s = beta_s + 64; LAS float* eg_s = beta_s + 128; LAS float* ek_s = beta_s + 192;
    float* DEC = (float*)(F.ws + WS_DEC);
    u32x4 raw[24];
    float pcw[3], pb = 0.f, pa = 0.f;
    const brsrc_t srs = staging_rsrc(F.ws);
    unsigned* ready = (unsigned*)(F.ws + WS_READY);
    { int s0, c0, h0; g1_decode(first < 4095 ? first : 4095, s0, c0, h0); g1_load_raw(F, raw, s0, c0, h0, tid);
#pragma unroll
        for (int q = 0; q < 3; ++q) { const int i = tid + 512 * q, jj = i / 384, cc = i % 384; pcw[q] = F.in[29][(size_t)jj * 3072 + (cc >> 7) * 1024 + h0 * 128 + (cc & 127)]; }
        const float* ba = F.BA() + (size_t)(s0 * TP + c0 * 64 + (tid & 63)) * 16; pb = ba[h0]; pa = ba[8 + h0]; }
    for (int task = first; task < 4224; task += stride) {
        const int tid = opaque_tid(F.wv), lane = tid & 63;
        int s, c, h; g1_decode(task, s, c, h);
        const int nvalid = s < BP ? 64 : TS, t0 = c * 64, base = seq_base(s), T = seq_len(s);
        const int sidx = task < 4096 ? ((s * 8 + h) * 64 + c) : task;
        unsigned char* blk = F.ws + WS_RB + (size_t)sidx * GS_BYTES; const unsigned boff = (unsigned)sidx * (unsigned)GS_BYTES;
        if (s < BP) {
#pragma unroll
            for (int q = 0; q < 3; ++q) cw_s[tid + 512 * q] = pcw[q];
        } else for (int i = tid; i < 4 * 384; i += 512) { const int jj = i / 384, cc = i % 384; cw_s[i] = F.in[29][(size_t)jj * 3072 + (cc >> 7) * 1024 + h * 128 + (cc & 127)]; }
        if (tid < 64) {
            const bool ok = tid < nvalid; float beta = 0.f, g = 0.f;
            if (ok) { float vb = pb, va = pa; if (s >= BP) { const float* ba = F.BA() + (size_t)(base + t0 + tid) * 16; vb = ba[h]; va = ba[8 + h]; }
                beta = vb; g = va; }
            float x = g;
#pragma unroll
            for (int o = 1; o < 64; o <<= 1) { const float y = shfl_idx(x, lane >= o ? lane - o : lane); if (lane >= o) x += y; }
            const float gl = shfl_idx(x, 63);
            beta_s[tid] = beta; gcum_s[tid] = x; eg_s[tid] = __expf(x); ek_s[tid] = ok ? __expf(gl - x) : 0.f;
            if (tid == 0) __hip_atomic_store((unsigned*)DEC + sidx, __float_as_uint(__expf(gl)), __ATOMIC_RELAXED, __HIP_MEMORY_SCOPE_AGENT);
        }
        LDS_BARRIER();
        {
            int t1 = tid; asm volatile("" : "+v"(t1));
            const int r = t1 >> 3, j = t1 & 7, t = t0 + r; const bool ok = r < nvalid;
#pragma unroll
            for (int p = 0; p < 3; ++p) {
                float acc[16], cur[16];
#pragma unroll
                for (int e = 0; e < 16; ++e) { acc[e] = 0.f; cur[e] = 0.f; }
                const int cb = p * 1024 + h * 128 + j * 16;
#pragma unroll
                for (int jj = 0; jj < 4; ++jj) {
                    const int tt = t - 3 + jj; float x[16];
                    if (s < BP) { const u32x4 a = raw[p * 8 + jj * 2], b = raw[p * 8 + jj * 2 + 1]; const bool v = tt >= 0;
#pragma unroll
                        for (int e = 0; e < 4; ++e) { x[2 * e] = v ? lo16(a[e]) : 0.f; x[2 * e + 1] = v ? hi16(a[e]) : 0.f; x[8 + 2 * e] = v ? lo16(b[e]) : 0.f; x[8 + 2 * e + 1] = v ? hi16(b[e]) : 0.f; } }
                    else if (ok && tt >= 0) { const u32x4* src = (const u32x4*)(F.QKV1() + (size_t)(base + tt) * 3072 + cb); const u32x4 a = src[0], b = src[1];
#pragma unroll
                        for (int e = 0; e < 4; ++e) { x[2 * e] = lo16(a[e]); x[2 * e + 1] = hi16(a[e]); x[8 + 2 * e] = lo16(b[e]); x[8 + 2 * e + 1] = hi16(b[e]); } }
                    else if (ok) { const f32x4* src = (const f32x4*)(F.in[6] + ((size_t)(s - BP) * 3 + (tt + 3)) * 3072 + cb);
#pragma unroll
                        for (int q = 0; q < 4; ++q) { const f32x4 a = src[q]; x[4 * q] = a[0]; x[4 * q + 1] = a[1]; x[4 * q + 2] = a[2]; x[4 * q + 3] = a[3]; } }
                    else {
#pragma unroll
                        for (int e = 0; e < 16; ++e) x[e] = 0.f; }
                    const LAS f32x4* wp = (const LAS f32x4*)(cw_s + jj * 384 + p * 128 + j * 16);
#pragma unroll
                    for (int q = 0; q < 4; ++q) { const f32x4 w4 = wp[q]; acc[4 * q] += w4[0] * x[4 * q]; acc[4 * q + 1] += w4[1] * x[4 * q + 1]; acc[4 * q + 2] += w4[2] * x[4 * q + 2]; acc[4 * q + 3] += w4[3] * x[4 * q + 3]; }
                    if (jj == 3) {
#pragma unroll
                        for (int e = 0; e < 16; ++e) cur[e] = x[e]; }
                }
                if (ok && t >= T - 3) {
                    float* o = (s < BP ? F.out + O_GCP + ((size_t)s * 3 + (t - (T - 3))) * 3072 : F.out + O_GCS + ((size_t)(s - BP) * 3 + (t - (T - 3))) * 3072) + cb;
#pragma unroll
                    for (int q = 0; q < 4; ++q) *(f32x4*)(o + 4 * q) = (f32x4){cur[4 * q], cur[4 * q + 1], cur[4 * q + 2], cur[4 * q + 3]};
                }
                float ss = 0.f;
#pragma unroll
                for (int e = 0; e < 16; ++e) { acc[e] = siluf_(acc[e]); ss += acc[e] * acc[e]; }
                if (p < 2) { ss += shfl_xor_l(ss, 1, lane); ss += shfl_xor_l(ss, 2, lane); ss += shfl_xor_l(ss, 4, lane);
                    float sc = rsqrtf(ss + EPS); if (p == 0) sc *= 0.08838834764831845f;
#pragma unroll
                    for (int e = 0; e < 16; ++e) acc[e] *= sc; }
                u32x4 w0, w1;
#pragma unroll
                for (int e = 0; e < 4; ++e) { w0[e] = ok ? cvt2(acc[2 * e], acc[2 * e + 1]) : 0u; w1[e] = ok ? cvt2(acc[8 + 2 * e], acc[8 + 2 * e + 1]) : 0u; }
                LAS u32x4* dst = (LAS u32x4*)(L + (p == 0 ? G1_QS : p == 1 ? G1_KS : G1_VS) + r * 272 + j * 32);
                dst[0] = w0; dst[1] = w1;
                __builtin_amdgcn_sched_barrier(0);
            }
            { const int ntk = task + stride < 4095 ? task + stride : 4095; int s1, c1, h1; g1_decode(ntk, s1, c1, h1); g1_load_raw(F, raw, s1, c1, h1, t1);
#pragma unroll
              for (int q = 0; q < 3; ++q) { const int i = t1 + 512 * q, jj = i / 384, cc = i % 384; pcw[q] = F.in[29][(size_t)jj * 3072 + (cc >> 7) * 1024 + h1 * 128 + (cc & 127)]; }
              const float* ba = F.BA() + (size_t)(s1 * TP + c1 * 64 + (t1 & 63)) * 16; pb = ba[h1]; pa = ba[8 + h1]; }
        }
        LDS_BARRIER();
        {
            int l2 = lane; asm volatile("" : "+v"(l2));
            const int which = wave >> 2, ti = (wave >> 1) & 1, tj = wave & 1, r = l2 & 31, hh = l2 >> 5;
            f32x16 acc;
#pragma unroll
            for (int e = 0; e < 16; ++e) acc[e] = 0.f;
            if (!(ti == 0 && tj == 1)) {
                const LAS unsigned char* ap = L + (which ? G1_QS : G1_KS) + (32 * ti + r) * 272 + hh * 16;
                const LAS unsigned char* bp = L + G1_KS + (32 * tj + r) * 272 + hh * 16;
#pragma unroll
                for (int ks = 0; ks < 8; ++ks) { const bf16x8 a = *(const LAS bf16x8*)(ap + ks * 32), b = *(const LAS bf16x8*)(bp + ks * 32); acc = MFMA32(a, b, acc); }
            }
            const int jc = 32 * tj + r; const float gj = gcum_s[jc];
#pragma unroll
            for (int e = 0; e < 16; ++e) {
                const int i = 32 * ti + (e & 3) + 8 * (e >> 2) + 4 * hh; const float dg = gcum_s[i] - gj;
                if (which == 0) { const float f = (i > jc) ? __expf(dg) * beta_s[i] : 0.f; *(LAS float*)(L + G1_AS + i * 272 + jc * 4) = acc[e] * f; }
                else { const float f = (i >= jc) ? __expf(dg) : 0.f; *(LAS bf16_t*)(L + G1_PS + i * 144 + jc * 2) = (bf16_t)(cvt2(acc[e] * f, 0.f) & 0xffffu); }
            }
        }
        LDS_BARRIER();
        if (wave == 0) {
            int l3 = lane; asm volatile("" : "+v"(l3));
            const int bk = l3 >> 4, col = l3 & 15;
            float tcol[16];
#pragma unroll
            for (int rr = 0; rr < 16; ++rr) {
                float a = (rr == col) ? 1.0f : 0.f;
#pragma unroll
                for (int j4 = 0; j4 < (rr + 3) / 4; ++j4) { const f32x4 a4 = *(const LAS f32x4*)(L + G1_AS + (16 * bk + rr) * 272 + (16 * bk + 4 * j4) * 4);
#pragma unroll
                    for (int q = 0; q < 4; ++q) if (4 * j4 + q < rr) a -= a4[q] * tcol[4 * j4 + q]; }
                tcol[rr] = a;
                *(LAS float*)(L + G1_ES + ((bk * 16 + rr) * 16 + col) * 4) = a - ((rr == col) ? 1.0f : 0.f);
            }
        } else if (wave >= 4) {
            int l3 = lane; asm volatile("" : "+v"(l3));
            const int wv = wave - 4, r = l3 & 31, hh = l3 >> 5;
            {   const int rt4 = wv;
#pragma unroll
                for (int kt2 = 0; kt2 < 2; ++kt2)
#pragma unroll
                    for (int ss = 0; ss < 2; ++ss) { float v[8];
#pragma unroll
                        for (int j = 0; j < 8; ++j) { const int tok = 32 * kt2 + krow(ss, hh, j); v[j] = bf2f(*(const LAS bf16_t*)(L + G1_KS + tok * 272 + (32 * rt4 + r) * 2)) * ek_s[tok]; }
                        u32x4 o; o[0] = cvt2(v[0], v[1]); o[1] = cvt2(v[2], v[3]); o[2] = cvt2(v[4], v[5]); o[3] = cvt2(v[6], v[7]);
                        st16_wt(srs, boff + GS_KF + ((rt4 * 2 + kt2) * 2 + ss) * 1024 + l3 * 16, o); } }
            {   const int kt = wv;
#pragma unroll
                for (int rt = 0; rt < 2; ++rt)
#pragma unroll
                    for (int ss = 0; ss < 2; ++ss) { const int i = 32 * rt + r; const float sc = eg_s[i];
                        const u32x2 lo = *(const LAS u32x2*)(L + G1_QS + i * 272 + (32 * kt + 16 * ss + 4 * hh) * 2), hi = *(const LAS u32x2*)(L + G1_QS + i * 272 + (32 * kt + 16 * ss + 8 + 4 * hh) * 2);
                        u32x4 o; o[0] = cvt2(lo16(lo[0]) * sc, hi16(lo[0]) * sc); o[1] = cvt2(lo16(lo[1]) * sc, hi16(lo[1]) * sc); o[2] = cvt2(lo16(hi[0]) * sc, hi16(hi[0]) * sc); o[3] = cvt2(lo16(hi[1]) * sc, hi16(hi[1]) * sc);
                        st16_wt(srs, boff + GS_QF + ((rt * 4 + kt) * 2 + ss) * 1024 + l3 * 16, o); } }
            {   const int rt = wv >> 1, kt2 = wv & 1;
#pragma unroll
                for (int ss = 0; ss < 2; ++ss) { const int i = 32 * rt + r;
                    const u32x2 lo = *(const LAS u32x2*)(L + G1_PS + i * 144 + (32 * kt2 + 16 * ss + 4 * hh) * 2), hi = *(const LAS u32x2*)(L + G1_PS + i * 144 + (32 * kt2 + 16 * ss + 8 + 4 * hh) * 2);
                    u32x4 o; o[0] = lo[0]; o[1] = lo[1]; o[2] = hi[0]; o[3] = hi[1];
                    st16_wt(srs, boff + GS_PF + ((rt * 2 + kt2) * 2 + ss) * 1024 + l3 * 16, o); } }
        }
        LDS_BARRIER();
        {
            int l4 = lane; asm volatile("" : "+v"(l4));
            const int c16 = l4 & 15, g = l4 >> 4;
            const f32x4 z4 = {0.f, 0.f, 0.f, 0.f};
            f32x4 a10, a20, a21, a30, a31, a32, e0, e1, e2, e3;
            { const LAS unsigned char* ar = L + G1_AS + c16 * 272 + (4 * g) * 4;
              a10 = *(const LAS f32x4*)(ar + 16 * 272); a20 = *(const LAS f32x4*)(ar + 32 * 272); a21 = *(const LAS f32x4*)(ar + 32 * 272 + 64);
              a30 = *(const LAS f32x4*)(ar + 48 * 272); a31 = *(const LAS f32x4*)(ar + 48 * 272 + 64); a32 = *(const LAS f32x4*)(ar + 48 * 272 + 128);
              const LAS unsigned char* er = L + G1_ES + (c16 * 16 + 4 * g) * 4;
              e0 = *(const LAS f32x4*)er; e1 = *(const LAS f32x4*)(er + 1024); e2 = *(const LAS f32x4*)(er + 2048); e3 = *(const LAS f32x4*)(er + 3072); }
            const bf16x8 fA10 = g1_pack_b(z4 - a10, z4), fA2 = g1_pack_b(z4 - a20, z4 - a21), fA3a = g1_pack_b(z4 - a30, z4 - a31), fA3b = g1_pack_b(z4 - a32, z4);
            const bf16x8 fE0 = g1_pack_b(e0, z4), fE1 = g1_pack_b(e1, z4), fE2 = g1_pack_b(e2, z4), fE3 = g1_pack_b(e3, z4);
            const bool isw = wave < 4; const int cbase = 32 * (wave & 3);
#pragma unroll
            for (int tl = 0; tl < 2; ++tl) {
                const int d = cbase + 16 * tl + c16;
                f32x4 R[4];
#pragma unroll
                for (int i = 0; i < 4; ++i)
#pragma unroll
                    for (int e = 0; e < 4; ++e) { const int row = 16 * i + 4 * g + e; const float raw1 = bf2f(*(const LAS bf16_t*)(L + (isw ? G1_KS : G1_VS) + row * 272 + d * 2)); R[i][e] = raw1 * beta_s[row] * (isw ? eg_s[row] : 1.0f); }
                const f32x4 X0 = MFMA16(fE0, g1_pack_b(R[0], z4), R[0]);
                const f32x4 Y1 = MFMA16(fA10, g1_pack_b(X0, z4), R[1]);
                const f32x4 X1 = MFMA16(fE1, g1_pack_b(Y1, z4), Y1);
                const f32x4 Y2 = MFMA16(fA2, g1_pack_b(X0, X1), R[2]);
                const f32x4 X2 = MFMA16(fE2, g1_pack_b(Y2, z4), Y2);
                f32x4 Y3 = MFMA16(fA3a, g1_pack_b(X0, X1), R[3]);
                Y3 = MFMA16(fA3b, g1_pack_b(X2, z4), Y3);
                const f32x4 X3 = MFMA16(fE3, g1_pack_b(Y3, z4), Y3);
                const f32x4 X[4] = {X0, X1, X2, X3};
                if (isw) {
#pragma unroll
                    for (int i = 0; i < 4; ++i)
#pragma unroll
                        for (int e = 0; e < 4; ++e) *(LAS bf16_t*)(L + G1_WS + (16 * i + 4 * g + e) * 272 + d * 2) = (bf16_t)(cvt2(-X[i][e], 0.f) & 0xffffu);
                } else {
                    const int ws = wave & 3, cc = 16 * tl + c16;
#pragma unroll
                    for (int i = 0; i < 4; ++i) { const int rt = i >> 1, q = 2 * (i & 1) + (g >> 1), hh = g & 1;
                        u32x2 o; o[0] = cvt2(X[i][0], X[i][1]); o[1] = cvt2(X[i][2], X[i][3]);
                        st8_wt(blk + GS_UF + (size_t)(((ws * 2 + rt) * 64) + cc + 32 * hh) * 32 + q * 8, o); }
                }
            }
        }
        LDS_BARRIER();
        {
            int l5 = lane; asm volatile("" : "+v"(l5));
            const int kt = wave & 3, rt = wave >> 2, r = l5 & 31, hh = l5 >> 5, i = 32 * rt + r;
#pragma unroll
            for (int ss = 0; ss < 2; ++ss) {
                const u32x2 lo = *(const LAS u32x2*)(L + G1_WS + i * 272 + (32 * kt + 16 * ss + 4 * hh) * 2), hi = *(const LAS u32x2*)(L + G1_WS + i * 272 + (32 * kt + 16 * ss + 8 + 4 * hh) * 2);
                u32x4 o; o[0] = lo[0]; o[1] = lo[1]; o[2] = hi[0]; o[3] = hi[1];
                st16_wt(srs, boff + GS_WF + ((rt * 4 + kt) * 2 + ss) * 1024 + l5 * 16, o); }
        }
        asm volatile("s_waitcnt vmcnt(0)" ::: "memory");
        LDS_BARRIER();
        if (tid == 0) __hip_atomic_store(ready + 16 * sidx, 1u, __ATOMIC_RELAXED, __HIP_MEMORY_SCOPE_AGENT);
    }
}

constexpr int G2_FB = GS_BYTES, G2_OSTRIDE = 528, G2_HN = 2 * G2_FB, G2_DEC = G2_HN + 512;
__device__ __forceinline__ bf16x8 pack8(const f32x16& x, const int s) {
    u32x4 p; p[0] = cvt2(x[8 * s], x[8 * s + 1]); p[1] = cvt2(x[8 * s + 2], x[8 * s + 3]); p[2] = cvt2(x[8 * s + 4], x[8 * s + 5]); p[3] = cvt2(x[8 * s + 6], x[8 * s + 7]);
    return __builtin_bit_cast(bf16x8, p);
}
template <bool WT>
__device__ __forceinline__ void g2_load_set(u32x4 (&pre)[18], float& dpre, const unsigned char* blk, int lt, brsrc_t srs, unsigned boff, const unsigned* flag, const float* decp) {
    if (WT) { unsigned sp = 0; while (__builtin_amdgcn_readfirstlane(__hip_atomic_load(flag, __ATOMIC_RELAXED, __HIP_MEMORY_SCOPE_AGENT)) == 0u && ++sp < (1u << 20)) __builtin_amdgcn_s_sleep(4);
        dpre = __uint_as_float(__hip_atomic_load((const unsigned*)decp, __ATOMIC_RELAXED, __HIP_MEMORY_SCOPE_AGENT));
#pragma unroll
        for (int i = 0; i < 18; ++i) pre[i] = ld16_wt(srs, boff + (unsigned)(i * 256 + lt) * 16u);
    } else { const u32x4* src = (const u32x4*)blk; dpre = *decp;
#pragma unroll
        for (int i = 0; i < 18; ++i) pre[i] = src[i * 256 + lt]; }
}
__device__ __forceinline__ void g2_store_set(const u32x4 (&pre)[18], LAS unsigned char* dst, int lt) {
#pragma unroll
    for (int i = 0; i < 18; ++i) *(LAS u32x4*)(dst + (size_t)(i * 256 + lt) * 16) = pre[i];
}
#define G2_FRAG(off) (*(const LAS bf16x8*)(B + (off)))
#define G2_SCHED() __builtin_amdgcn_sched_barrier(0)
__device__ __forceinline__ void g2_mfma_step(f32x16& S0, f32x16& S1, f32x16& S2, f32x16& S3, LAS unsigned char* Bimg, const float dec, int ws, int lane, int cc, int hh) {
    const LAS unsigned char* B = Bimg + lane * 16;
    f32x16 vn0, vn1, o0, o1;
    { const LAS u32x4* up = (const LAS u32x4*)(Bimg + GS_UF + (size_t)(ws * 2 * 64 + lane) * 32); const u32x4 u0 = up[0], u1 = up[1], u2 = up[128], u3 = up[129];
#pragma unroll
      for (int q = 0; q < 4; ++q) { vn0[2 * q] = lo16(u0[q]); vn0[2 * q + 1] = hi16(u0[q]); vn0[8 + 2 * q] = lo16(u1[q]); vn0[8 + 2 * q + 1] = hi16(u1[q]);
                                    vn1[2 * q] = lo16(u2[q]); vn1[2 * q + 1] = hi16(u2[q]); vn1[8 + 2 * q] = lo16(u3[q]); vn1[8 + 2 * q + 1] = hi16(u3[q]); } }
#pragma unroll
    for (int e = 0; e < 16; ++e) { o0[e] = 0.f; o1[e] = 0.f; }
#define G2_WQ(Sx, kt) do { _Pragma("unroll") for (int ss = 0; ss < 2; ++ss) { const bf16x8 sb = pack8(Sx, ss); \
        const bf16x8 fw0 = G2_FRAG(GS_WF + ((0 * 4 + kt) * 2 + ss) * 1024), fw1 = G2_FRAG(GS_WF + ((1 * 4 + kt) * 2 + ss) * 1024); \
        const bf16x8 fq0 = G2_FRAG(GS_QF + ((0 * 4 + kt) * 2 + ss) * 1024), fq1 = G2_FRAG(GS_QF + ((1 * 4 + kt) * 2 + ss) * 1024); \
        vn0 = MFMA32(fw0, sb, vn0); vn1 = MFMA32(fw1, sb, vn1); o0 = MFMA32(fq0, sb, o0); o1 = MFMA32(fq1, sb, o1); } } while (0)
    G2_WQ(S0, 0); G2_WQ(S1, 1); G2_WQ(S2, 2); G2_WQ(S3, 3);
#undef G2_WQ
    bf16x8 vb[2][2];
    vb[0][0] = pack8(vn0, 0); vb[0][1] = pack8(vn0, 1); vb[1][0] = pack8(vn1, 0); vb[1][1] = pack8(vn1, 1);
#pragma unroll
    for (int kt2 = 0; kt2 < 2; ++kt2)
#pragma unroll
        for (int ss = 0; ss < 2; ++ss) { o0 = MFMA32(G2_FRAG(GS_PF + ((0 * 2 + kt2) * 2 + ss) * 1024), vb[kt2][ss], o0); o1 = MFMA32(G2_FRAG(GS_PF + ((1 * 2 + kt2) * 2 + ss) * 1024), vb[kt2][ss], o1); }
    S0 = S0 * dec; S1 = S1 * dec; S2 = S2 * dec; S3 = S3 * dec;
#pragma unroll
    for (int kt2 = 0; kt2 < 2; ++kt2)
#pragma unroll
        for (int ss = 0; ss < 2; ++ss) {
            S0 = MFMA32(G2_FRAG(GS_KF + ((0 * 2 + kt2) * 2 + ss) * 1024), vb[kt2][ss], S0); S1 = MFMA32(G2_FRAG(GS_KF + ((1 * 2 + kt2) * 2 + ss) * 1024), vb[kt2][ss], S1);
            S2 = MFMA32(G2_FRAG(GS_KF + ((2 * 2 + kt2) * 2 + ss) * 1024), vb[kt2][ss], S2); S3 = MFMA32(G2_FRAG(GS_KF + ((3 * 2 + kt2) * 2 + ss) * 1024), vb[kt2][ss], S3); }
    LDS_BARRIER();
#pragma unroll
    for (int e = 0; e < 16; ++e) { const int rr = (e & 3) + 8 * (e >> 2) + 4 * hh;
        *(LAS float*)(Bimg + rr * G2_OSTRIDE + (32 * ws + cc) * 4) = o0[e]; *(LAS float*)(Bimg + (32 + rr) * G2_OSTRIDE + (32 * ws + cc) * 4) = o1[e]; }
    LDS_BARRIER();
}
__device__ __forceinline__ void g2_epi_step(Frame& F, LAS unsigned char* L, const LAS unsigned char* Oimg, const u32x4 (&zz)[4], int row, int seg, size_t m, int h, bool rok, int lane) {
    float ss = 0.f;
#pragma unroll
    for (int q = 0; q < 8; ++q) { const f32x4 ov = *(const LAS f32x4*)(Oimg + row * G2_OSTRIDE + (seg * 32 + 4 * q) * 4); ss += (ov[0] * ov[0] + ov[1] * ov[1]) + (ov[2] * ov[2] + ov[3] * ov[3]); }
    ss += shfl_xor_l(ss, 1, lane); ss += shfl_xor_l(ss, 2, lane);
    const float rn = rsqrtf(ss * (1.f / 128.f) + EPS);
    if (rok) {
        u32x4* yp = (u32x4*)(F.Y1() + m * D + h * 128 + seg * 32);
        const LAS float* hn_s = (const LAS float*)(L + G2_HN);
#pragma unroll
        for (int q = 0; q < 4; ++q) {
            const f32x4 oa = *(const LAS f32x4*)(Oimg + row * G2_OSTRIDE + (seg * 32 + 8 * q) * 4), ob = *(const LAS f32x4*)(Oimg + row * G2_OSTRIDE + (seg * 32 + 8 * q + 4) * 4);
            const f32x4 ha = *(const LAS f32x4*)(hn_s + seg * 32 + 8 * q), hb = *(const LAS f32x4*)(hn_s + seg * 32 + 8 * q + 4);
            u32x4 yo;
            yo[0] = cvt2(oa[0] * rn * ha[0] * siluf_(lo16(zz[q][0])), oa[1] * rn * ha[1] * siluf_(hi16(zz[q][0])));
            yo[1] = cvt2(oa[2] * rn * ha[2] * siluf_(lo16(zz[q][1])), oa[3] * rn * ha[3] * siluf_(hi16(zz[q][1])));
            yo[2] = cvt2(ob[0] * rn * hb[0] * siluf_(lo16(zz[q][2])), ob[1] * rn * hb[1] * siluf_(hi16(zz[q][2])));
            yo[3] = cvt2(ob[2] * rn * hb[2] * siluf_(lo16(zz[q][3])), ob[3] * rn * hb[3] * siluf_(hi16(zz[q][3])));
            yp[q] = yo; }
    }
}
template <int NCH, bool WT>
__device__ __forceinline__ void g2_task(Frame& F, LAS unsigned char* L, const float* DEC, int s, int h, int ch0, int tid, int lane, int wave) {
    const size_t cstep = (size_t)GS_BYTES;
    const int base = seq_base(s), nvalid = s < BP ? 64 : TS;
    const unsigned char* blk0 = F.ws + WS_RB + (size_t)ch0 * GS_BYTES;
    constexpr int lastc = NCH - 1;
    if (wave < 4) {
        const int ws = wave, cc = lane & 31, hh = lane >> 5;
        f32x16 S0, S1, S2, S3;
        if (s < BP) {
#pragma unroll
            for (int e = 0; e < 16; ++e) { S0[e] = 0.f; S1[e] = 0.f; S2[e] = 0.f; S3[e] = 0.f; }
        } else {
            const float* sp = F.in[7] + ((size_t)(s - BP) * 8 + h) * 16384 + 32 * ws + cc;
#pragma unroll
            for (int e = 0; e < 16; ++e) { const int rr = (e & 3) + 8 * (e >> 2) + 4 * hh; S0[e] = sp[(size_t)rr * 128]; S1[e] = sp[(size_t)(32 + rr) * 128]; S2[e] = sp[(size_t)(64 + rr) * 128]; S3[e] = sp[(size_t)(96 + rr) * 128]; }
        }
        const LAS float* dec_s = (const LAS float*)(L + G2_DEC);
        LDS_BARRIER();
        if (NCH == 1) g2_mfma_step(S0, S1, S2, S3, L, dec_s[0], ws, lane, cc, hh);
        else for (int c = 0; c < NCH; c += 2) {
            g2_mfma_step(S0, S1, S2, S3, L, dec_s[c], ws, lane, cc, hh);
            g2_mfma_step(S0, S1, S2, S3, L + G2_FB, dec_s[c + 1], ws, lane, cc, hh);
        }
        int l9 = lane; asm volatile("" : "+v"(l9));
        const int cc9 = l9 & 31, hh9 = l9 >> 5;
        float* so = (s < BP ? F.out + O_GSP + ((size_t)s * 8 + h) * 16384 : F.out + O_GSS + ((size_t)(s - BP) * 8 + h) * 16384) + 32 * ws + cc9;
#pragma unroll
        for (int e = 0; e < 16; ++e) { const int rr = (e & 3) + 8 * (e >> 2) + 4 * hh9; so[(size_t)rr * 128] = S0[e]; so[(size_t)(32 + rr) * 128] = S1[e]; so[(size_t)(64 + rr) * 128] = S2[e]; so[(size_t)(96 + rr) * 128] = S3[e]; }
    } else {
        const int lt = tid - 256;
        if (lt < 128) ((LAS float*)(L + G2_HN))[lt] = F.in[32][lt];
        const brsrc_t srs = staging_rsrc(F.ws);
        const unsigned* ready = (const unsigned*)(F.ws + WS_READY);
        LAS float* dec_w = (LAS float*)(L + G2_DEC);
#define G2_LOAD(pre, dpre, k) do { const int _k = (k) < lastc ? (k) : lastc; g2_load_set<WT>(pre, dpre, blk0 + (size_t)_k * cstep, lt, srs, (unsigned)(ch0 + _k) * (unsigned)GS_BYTES, ready + 16 * (ch0 + _k), DEC + ch0 + _k); } while (0)
        u32x4 preA[18], preB[18]; float dA, dB;
        G2_LOAD(preA, dA, 0);
        G2_LOAD(preB, dB, 1);
        g2_store_set(preA, L, lt); if (lt == 0) dec_w[0] = dA;
        G2_LOAD(preA, dA, 2);
        const int row = lt >> 2, seg = lt & 3; const bool rok = row < nvalid;
        u32x4 zz[4];
        LDS_BARRIER();
        if (NCH == 1) {
            const size_t m = (size_t)base + row;
            if (rok) { const u32x4* zp = (const u32x4*)(F.Z1() + m * D + h * 128 + seg * 32);
#pragma unroll
                for (int q = 0; q < 4; ++q) zz[q] = zp[q]; }
            LDS_BARRIER();
            LDS_BARRIER();
            g2_epi_step(F, L, L, zz, row, seg, m, h, rok, lane);
        } else {
            for (int c = 0; c < NCH; c += 2) {
                {
                    const size_t m = (size_t)base + c * 64 + row;
                    { const u32x4* zp = (const u32x4*)(F.Z1() + m * D + h * 128 + seg * 32);
#pragma unroll
                      for (int q = 0; q < 4; ++q) zz[q] = zp[q]; }
                    g2_store_set(preB, L + G2_FB, lt); if (lt == 0) dec_w[(c + 1) & 63] = dB;
                    G2_LOAD(preB, dB, c + 3);
                    LDS_BARRIER();
                    LDS_BARRIER();
                    g2_epi_step(F, L, L, zz, row, seg, m, h, rok, lane);
                }
                {
                    const size_t m = (size_t)base + (c + 1) * 64 + row;
                    { const u32x4* zp = (const u32x4*)(F.Z1() + m * D + h * 128 + seg * 32);
#pragma unroll
                      for (int q = 0; q < 4; ++q) zz[q] = zp[q]; }
                    g2_store_set(preA, L, lt); if (lt == 0) dec_w[(c + 2) & 63] = dA;
                    G2_LOAD(preA, dA, c + 4);
                    LDS_BARRIER();
                    LDS_BARRIER();
                    g2_epi_step(F, L, L + G2_FB, zz, row, seg, m, h, rok, lane);
                }
            }
        }
    }
}
#undef G2_LOAD
constexpr int G12_CHAINS = 64;
__device__ __forceinline__ void phase_gdn_fused(Frame& F) {
    LAS unsigned char* L = F.lds;
    const float* DEC = (const float*)(F.ws + WS_DEC);
    if ((int)blockIdx.x < G12_CHAINS && F.G > G12_CHAINS) {
        const int tid = opaque_tid(F.wv);
        const int ci = blockIdx.x;
        g2_task<64, true>(F, L, DEC, ci >> 3, ci & 7, ci * 64, tid, tid & 63, F.wv);
    } else {
        const bool all = !(F.G > G12_CHAINS);
        const int p = all ? (int)blockIdx.x : (int)blockIdx.x - G12_CHAINS, np = all ? F.G : F.G - G12_CHAINS;
        gdn_g1_tasks(F, p, np);
        for (int t = p; t < 128; t += np) {
            const int tid = opaque_tid(F.wv);
            __syncthreads();
            g2_task<1, true>(F, L, DEC, BP + (t >> 3), t & 7, 4096 + t, tid, tid & 63, F.wv);
        }
    }
}

__device__ __forceinline__ float dpp_shr_f(float idv, float x, const int o) {
    int r;
    switch (o) {
        case 1: r = __builtin_amdgcn_update_dpp(__float_as_int(idv), __float_as_int(x), 0x111, 0xf, 0xf, false); break;
        case 2: r = __builtin_amdgcn_update_dpp(__float_as_int(idv), __float_as_int(x), 0x112, 0xf, 0xf, false); break;
        case 4: r = __builtin_amdgcn_update_dpp(__float_as_int(idv), __float_as_int(x), 0x114, 0xf, 0xf, false); break;
        default: r = __builtin_amdgcn_update_dpp(__float_as_int(idv), __float_as_int(x), 0x118, 0xf, 0xf, false); break;
    }
    return __int_as_float(r);
}
template <int PASS>
__device__ __forceinline__ void phase_lru(Frame& F) {
    int tid = opaque_tid(F.wv);
    const int lane = tid & 63, wave = __builtin_amdgcn_readfirstlane(tid >> 6);
    const int gw = F.vcu * 8 + wave, NGW = F.G * 8, h = gw & 7, g = lane >> 4, l15 = lane & 15;
    LAS unsigned char* xs = F.lds + wave * 9216;
    LAS float* cst = (LAS float*)(F.lds + 73728 + wave * 768);
    const bf16_t* LGW = (const bf16_t*)(F.ws + WS_LGW);
    float* LAG = F.LAG();
    bf16x8 wfa[4][2], wfx[4][2];
#pragma unroll
    for (int nt = 0; nt < 4; ++nt)
#pragma unroll
        for (int ks = 0; ks < 2; ++ks) {
            wfa[nt][ks] = *(const bf16x8*)(LGW + ((size_t)(h * 2 + 0) * 64 + 16 * nt + l15) * 64 + 32 * ks + 8 * g);
            wfx[nt][ks] = *(const bf16x8*)(LGW + ((size_t)(h * 2 + 1) * 64 + 16 * nt + l15) * 64 + 32 * ks + 8 * g); }
    cst[lane] = F.in[18][h * 64 + lane]; cst[64 + lane] = F.in[20][h * 64 + lane]; cst[128 + lane] = softplusf_(-F.in[21][h * 64 + lane]);
    for (int task = gw; task < 4224; task += NGW) {
        int s, c; if (task < 4096) { s = task >> 9; c = (task >> 3) & 63; } else { s = BP + ((task - 4096) >> 3); c = 0; }
        const int T = seq_len(s), base = seq_base(s), t0 = c * 64, ntile = s < BP ? 4 : 1;
        {
            int l1 = lane; asm volatile("" : "+v"(l1));
            const int cg = l1 & 7, tp = l1 >> 3;
#pragma unroll 1
            for (int hf2 = 0; hf2 < 2; ++hf2) {
                const int chb = h * 64 + cg * 8 + hf2 * 4;
                float xr[11][4];
#pragma unroll
                for (int i = 0; i < 11; ++i) {
                    const int tt = t0 + tp * 8 - 3 + i;
                    if (tt >= 0 && tt < T) { const u32x2 w = *(const u32x2*)(F.U0() + (size_t)(base + tt) * EV_IN + C_XA + chb);
                        xr[i][0] = lo16(w[0]); xr[i][1] = hi16(w[0]); xr[i][2] = lo16(w[1]); xr[i][3] = hi16(w[1]); }
                    else if (tt < 0 && s >= BP) { const f32x4 a = *(const f32x4*)(F.in[2] + ((size_t)(s - BP) * 3 + (tt + 3)) * 512 + chb); xr[i][0] = a[0]; xr[i][1] = a[1]; xr[i][2] = a[2]; xr[i][3] = a[3]; }
                    else { xr[i][0] = 0.f; xr[i][1] = 0.f; xr[i][2] = 0.f; xr[i][3] = 0.f; }
                }
                const f32x4 c0 = *(const f32x4*)(F.in[15] + chb), c1 = *(const f32x4*)(F.in[15] + 512 + chb), c2 = *(const f32x4*)(F.in[15] + 1024 + chb), c3 = *(const f32x4*)(F.in[15] + 1536 + chb), cb = *(const f32x4*)(F.in[16] + chb);
#pragma unroll
                for (int i = 0; i < 8; ++i) { float o[4];
#pragma unroll
                    for (int e = 0; e < 4; ++e) o[e] = c0[e] * xr[i][e] + c1[e] * xr[i + 1][e] + c2[e] * xr[i + 2][e] + c3[e] * xr[i + 3][e] + cb[e];
                    u32x2 w; w[0] = cvt2(o[0], o[1]); w[1] = cvt2(o[2], o[3]);
                    *(LAS u32x2*)(xs + (tp * 8 + i) * 144 + cg * 16 + hf2 * 8) = w; }
                if (PASS == 2 && t0 + 64 >= T && tp == ((T - 1) >> 3) - (t0 >> 3)) {
                    float* o = (s < BP ? F.out + O_LCP + (size_t)s * 3 * 512 : F.out + O_LCS + (size_t)(s - BP) * 3 * 512) + chb;
#pragma unroll
                    for (int q = 0; q < 3; ++q) *(f32x4*)(o + q * 512) = (f32x4){xr[8 + q][0], xr[8 + q][1], xr[8 + q][2], xr[8 + q][3]};
                }
            }
        }
        float hin[4][4], arun[4][4];
#pragma unroll
        for (int nt = 0; nt < 4; ++nt)
#pragma unroll
            for (int rg = 0; rg < 4; ++rg) { hin[nt][rg] = 0.f; arun[nt][rg] = 1.f; }
        if (PASS == 2) {
            float hf = s >= BP ? F.in[3][(s - BP) * 512 + h * 64 + lane] : 0.f;
            const f32x2* lp = (const f32x2*)LAG + (size_t)(s * 64) * 512 + h * 64 + lane;
            int j = 0;
            for (; j + 8 <= c; j += 8) { f32x2 v[8];
#pragma unroll
                for (int q = 0; q < 8; ++q) v[q] = lp[(size_t)(j + q) * 512];
#pragma unroll
                for (int q = 0; q < 8; ++q) hf = v[q][0] * hf + v[q][1]; }
            for (; j < c; ++j) { const f32x2 v = lp[(size_t)j * 512]; hf = v[0] * hf + v[1]; }
#pragma unroll
            for (int nt = 0; nt < 4; ++nt)
#pragma unroll
                for (int rg = 0; rg < 4; ++rg) hin[nt][rg] = shfl_idx(hf, 16 * nt + 4 * g + rg);
        }
        asm volatile("s_waitcnt lgkmcnt(0)" ::: "memory");
        for (int tt = 0; tt < ntile; ++tt) {
            const int tok = 16 * tt + l15;
            const bf16x8 b0 = *(const LAS bf16x8*)(xs + tok * 144 + (8 * g) * 2), b1 = *(const LAS bf16x8*)(xs + tok * 144 + (32 + 8 * g) * 2);
            const size_t m = (size_t)base + t0 + tok;
#pragma unroll
            for (int nt = 0; nt < 4; ++nt) {
                f32x4 za = {0.f, 0.f, 0.f, 0.f}, zx = {0.f, 0.f, 0.f, 0.f};
                za = MFMA16(wfa[nt][0], b0, za); za = MFMA16(wfa[nt][1], b1, za);
                zx = MFMA16(wfx[nt][0], b0, zx); zx = MFMA16(wfx[nt][1], b1, zx);
                const int n0 = 16 * nt + 4 * g;
                const u32x2 xw = *(const LAS u32x2*)(xs + tok * 144 + n0 * 2);
                const float xc[4] = {lo16(xw[0]), hi16(xw[0]), lo16(xw[1]), hi16(xw[1])};
                const f32x4 cba = *(const LAS f32x4*)(cst + n0), cbx = *(const LAS f32x4*)(cst + 64 + n0), csp = *(const LAS f32x4*)(cst + 128 + n0);
                float av[4], bv[4];
#pragma unroll
                for (int rg = 0; rg < 4; ++rg) {
                    const float r = sigmoidf_(za[rg] + cba[rg]), ig = sigmoidf_(zx[rg] + cbx[rg]), la = -8.0f * r * csp[rg], a = __expf(la);
                    av[rg] = a; bv[rg] = sqrtf(fmaxf(1.0f - a * a, 0.f)) * (ig * xc[rg]); }
#pragma unroll
                for (int o = 1; o < 16; o <<= 1)
#pragma unroll
                    for (int rg = 0; rg < 4; ++rg) { const float ap = dpp_shr_f(1.0f, av[rg], o), bp = dpp_shr_f(0.0f, bv[rg], o); bv[rg] = av[rg] * bp + bv[rg]; av[rg] = av[rg] * ap; }
                float hv[4];
#pragma unroll
                for (int rg = 0; rg < 4; ++rg) { hv[rg] = bv[rg] + av[rg] * hin[nt][rg]; hin[nt][rg] = shfl_idx(hv[rg], (lane & 48) | 15); }
                if (PASS == 1) {
#pragma unroll
                    for (int rg = 0; rg < 4; ++rg) arun[nt][rg] *= shfl_idx(av[rg], (lane & 48) | 15);
                } else {
                    const bool tok_ok = (t0 + tok) < T;
                    if (tok_ok) {
                        const u32x2 gw2 = *(const u32x2*)(F.U0() + m * EV_IN + C_GA + h * 64 + n0);
                        u32x2 yo; yo[0] = cvt2(hv[0] * siluf_(lo16(gw2[0])), hv[1] * siluf_(hi16(gw2[0]))); yo[1] = cvt2(hv[2] * siluf_(lo16(gw2[1])), hv[3] * siluf_(hi16(gw2[1])));
                        *(u32x2*)(F.Y0() + m * D + h * 64 + n0) = yo;
                        if (t0 + tok == T - 1) { float* o = (s < BP ? F.out + O_LHP + s * 512 : F.out + O_LHS + (s - BP) * 512) + h * 64 + n0; *(f32x4*)o = (f32x4){hv[0], hv[1], hv[2], hv[3]}; }
                    }
                }
                if (nt & 1) __builtin_amdgcn_sched_barrier(0);
            }
        }
        if (PASS == 1 && s < BP && l15 == 15) {
            f32x2* lp = (f32x2*)LAG + (size_t)(s * 64 + c) * 512 + h * 64;
#pragma unroll
            for (int nt = 0; nt < 4; ++nt)
#pragma unroll
                for (int rg = 0; rg < 4; ++rg) lp[16 * nt + 4 * g + rg] = (f32x2){arun[nt][rg], hin[nt][rg]};
        }
        asm volatile("s_waitcnt lgkmcnt(0)" ::: "memory");
    }
}

constexpr size_t RB_VTP = RB_WEND, RB_VTS = RB_VTP + (size_t)BP * 2 * 64 * TP * 2, RB_VTEND = RB_VTS + (size_t)BS * 2 * 64 * 192 * 2;
static_assert(RB_VTEND <= RB_BYTES, "ws map");
__device__ __forceinline__ void phase_vt_build(Frame& F) {
    PHASE_IDS();
    const int gw = F.vcu * 8 + wave, NGW = F.G * 8;
    LAS unsigned char* xs = F.lds + wave * 9216;
    bf16_t* VTP = (bf16_t*)(F.ws + WS_RB + RB_VTP); bf16_t* VTS = (bf16_t*)(F.ws + WS_RB + RB_VTS);
    for (int task = gw; task < 1024 + 96; task += NGW) {
        int s, kv, kb; if (task < 1024) { s = task >> 7; kv = (task >> 6) & 1; kb = task & 63; } else { const int r = task - 1024; s = BP + r / 6; kv = (r % 6) / 3; kb = r % 3; }
        const int row8 = lane >> 3, ch = lane & 7;
#pragma unroll
        for (int i = 0; i < 8; ++i) {
            const int key = 8 * i + row8, kg = kb * 64 + key; u32x4 w = {0u, 0u, 0u, 0u};
            if (s < BP) w = *(const u32x4*)(F.U0() + (size_t)(s * TP + kg) * EV_IN + C_V + kv * 64 + ch * 8);
            else if (kg < 128) { const f32x4* p = (const f32x4*)(F.in[5] + ((size_t)((s - BP) * 128 + kg) * 2 + kv) * 64 + ch * 8); const f32x4 a = p[0], b = p[1]; w[0] = cvt2(a[0], a[1]); w[1] = cvt2(a[2], a[3]); w[2] = cvt2(b[0], b[1]); w[3] = cvt2(b[2], b[3]); }
            else if (kg < 128 + TS) w = *(const u32x4*)(F.U0() + (size_t)(MP + (s - BP) * TS + (kg - 128)) * EV_IN + C_V + kv * 64 + ch * 8);
            *(LAS u32x4*)(xs + key * 144 + ch * 16) = w;
        }
        asm volatile("s_waitcnt lgkmcnt(0)" ::: "memory");
        bf16_t* dst = s < BP ? VTP + ((size_t)(s * 2 + kv) * 64 + lane) * TP + kb * 64 : VTS + ((size_t)((s - BP) * 2 + kv) * 64 + lane) * 192 + kb * 64;
#pragma unroll
        for (int q = 0; q < 8; ++q) { u32x4 o;
#pragma unroll
            for (int e = 0; e < 4; ++e) { const unsigned lo = *(const LAS bf16_t*)(xs + (8 * q + 2 * e) * 144 + lane * 2), hi = *(const LAS bf16_t*)(xs + (8 * q + 2 * e + 1) * 144 + lane * 2); o[e] = lo | (hi << 16); }
            *(u32x4*)(dst + 8 * q) = o; }
        asm volatile("s_waitcnt lgkmcnt(0)" ::: "memory");
    }
}
constexpr int AT_K = 0, AT_V = 27648;
__device__ __forceinline__ void attn_issue(Frame& F, const bf16_t* VTP, int task, int tid, int wave, int lane, u32x4 (&kreg)[3], u32x4 (&vreg)[3], u32x4 (&qreg)[4]) {
    const int s = task >> 7, c = (task >> 1) & 63, kv = task & 1, tok0 = c * 64 - 128;
#pragma unroll
    for (int i = 0; i < 3; ++i) { const int idx = tid + 512 * i, key = idx >> 3, ch = idx & 7; int tk = tok0 + key; tk = tk < 0 ? 0 : tk;
        kreg[i] = *(const u32x4*)(F.U0() + (size_t)(s * TP + tk) * EV_IN + C_K + kv * 64 + ch * 8); }
#pragma unroll
    for (int i = 0; i < 3; ++i) { const int idx = tid + 512 * i, d = idx / 24, ch = idx % 24; int tk = tok0 + ch * 8; tk = tk < 0 ? 0 : tk;
        vreg[i] = *(const u32x4*)(VTP + ((size_t)(s * 2 + kv) * 64 + d) * TP + tk); }
    const int g = wave >> 1, qh = wave & 1, hq = kv * 4 + g, r = lane & 31, hh = lane >> 5;
    const size_t m = (size_t)s * TP + c * 64 + qh * 32 + r;
#pragma unroll
    for (int ks = 0; ks < 4; ++ks) qreg[ks] = *(const u32x4*)(F.U0() + m * EV_IN + C_Q + hq * 64 + 16 * ks + 8 * hh);
}
__device__ __forceinline__ void phase_attn(Frame& F) {
    PHASE_IDS();
    LAS unsigned char* L = F.lds;
    const bf16_t* VTP = (const bf16_t*)(F.ws + WS_RB + RB_VTP); const bf16_t* VTS = (const bf16_t*)(F.ws + WS_RB + RB_VTS);
    u32x4 kreg[3], vreg[3], qreg[4];
    attn_issue(F, VTP, F.vcu < 1024 ? F.vcu : 0, tid, wave, lane, kreg, vreg, qreg);
    for (int ti = F.vcu; ti < 1024 + 64; ti += F.G) {
        if (ti >= 1024 && ti < 1056) continue;
        const int task = ti < 1024 ? ti : ti - 32;
        int s, c, kv; if (task < 1024) { s = task >> 7; c = (task >> 1) & 63; kv = task & 1; } else { s = BP + ((task - 1024) >> 1); c = 0; kv = task & 1; }
        const int base = seq_base(s), tok0 = c * 64 - 128;
        const int kmin = s < BP ? (tok0 < 0 ? -tok0 : 0) : 0, kmax = s < BP ? 192 : 128 + TS;
        const int tid = opaque_tid(F.wv), lane = tid & 63;
        const int g = wave >> 1, qh = wave & 1, hq = kv * 4 + g, r = lane & 31, hh = lane >> 5, qi = qh * 32 + r;
        const bool qok = s < BP ? true : qi < TS;
        const size_t m = (size_t)base + c * 64 + (qok ? qi : 0);
        bf16x8 qf[4]; u32x2 gbr[8];
        LDS_BARRIER();
        if (s < BP) {
#pragma unroll
            for (int i = 0; i < 3; ++i) { const int idx = tid + 512 * i, key = idx >> 3, ch = idx & 7; const u32x4 z = {0u, 0u, 0u, 0u}; *(LAS u32x4*)(L + AT_K + key * 144 + ch * 16) = key >= kmin ? kreg[i] : z; }
#pragma unroll
            for (int i = 0; i < 3; ++i) { const int idx = tid + 512 * i, d = idx / 24, ch = idx % 24; const u32x4 z = {0u, 0u, 0u, 0u}; *(LAS u32x4*)(L + AT_V + d * 400 + ch * 16) = ch * 8 >= kmin ? vreg[i] : z; }
#pragma unroll
            for (int ks = 0; ks < 4; ++ks) { u32x4 w;
#pragma unroll
                for (int e = 0; e < 4; ++e) w[e] = cvt2(lo16(qreg[ks][e]) * 0.125f, hi16(qreg[ks][e]) * 0.125f);
                qf[ks] = __builtin_bit_cast(bf16x8, w); }
        } else {
#pragma unroll
            for (int i = 0; i < 3; ++i) {
                const int idx = tid + 512 * i, key = idx >> 3, ch = idx & 7; u32x4 w = {0u, 0u, 0u, 0u};
                if (key < kmax) {
                    if (key < 128) { const f32x4* p = (const f32x4*)(F.in[4] + ((size_t)((s - BP) * 128 + key) * 2 + kv) * 64 + ch * 8); const f32x4 a = p[0], b2 = p[1]; w[0] = cvt2(a[0], a[1]); w[1] = cvt2(a[2], a[3]); w[2] = cvt2(b2[0], b2[1]); w[3] = cvt2(b2[2], b2[3]); }
                    else w = *(const u32x4*)(F.U0() + (size_t)(base + key - 128) * EV_IN + C_K + kv * 64 + ch * 8);
                }
                *(LAS u32x4*)(L + AT_K + key * 144 + ch * 16) = w;
            }
#pragma unroll
            for (int i = 0; i < 3; ++i) {
                const int idx = tid + 512 * i, d = idx / 24, ch = idx % 24, key = ch * 8;
                *(LAS u32x4*)(L + AT_V + d * 400 + ch * 16) = *(const u32x4*)(VTS + ((size_t)((s - BP) * 2 + kv) * 64 + d) * 192 + key);
            }
#pragma unroll
            for (int ks = 0; ks < 4; ++ks) { u32x4 w = {0u, 0u, 0u, 0u};
                if (qok) { const u32x4 x = *(const u32x4*)(F.U0() + m * EV_IN + C_Q + hq * 64 + 16 * ks + 8 * hh);
#pragma unroll
                    for (int e = 0; e < 4; ++e) w[e] = cvt2(lo16(x[e]) * 0.125f, hi16(x[e]) * 0.125f); }
                qf[ks] = __builtin_bit_cast(bf16x8, w); }
        }
#pragma unroll
        for (int qq = 0; qq < 4; ++qq) { gbr[2 * qq] = qok ? *(const u32x2*)(F.U0() + m * EV_IN + C_GB + hq * 64 + 8 * qq + 4 * hh) : (u32x2){0u, 0u}; gbr[2 * qq + 1] = qok ? *(const u32x2*)(F.U0() + m * EV_IN + C_GB + hq * 64 + 32 + 8 * qq + 4 * hh) : (u32x2){0u, 0u}; }
        { const int nt = ti + F.G < 1024 ? ti + F.G : (ti < 1024 ? ti : 0); int t9 = tid; asm volatile("" : "+v"(t9)); attn_issue(F, VTP, nt, t9, wave, t9 & 63, kreg, vreg, qreg); }
        const float sink = F.in[22][hq];
        LDS_BARRIER();
        float mrun = sink, lrun = 1.0f;
        f32x16 o0, o1;
#pragma unroll
        for (int e = 0; e < 16; ++e) { o0[e] = 0.f; o1[e] = 0.f; }
#pragma unroll 1
        for (int half = 0; half < 2; ++half) {
            f32x16 sc[3];
#pragma unroll
            for (int k3 = 0; k3 < 3; ++k3) {
                const int kt = 3 * half + k3;
#pragma unroll
                for (int e = 0; e < 16; ++e) sc[k3][e] = 0.f;
#pragma unroll
                for (int ks = 0; ks < 4; ++ks) { const bf16x8 kf = *(const LAS bf16x8*)(L + AT_K + (32 * kt + r) * 144 + (16 * ks + 8 * hh) * 2); sc[k3] = MFMA32(kf, qf[ks], sc[k3]); }
            }
            float mx = -1e30f;
#pragma unroll
            for (int k3 = 0; k3 < 3; ++k3)
#pragma unroll
                for (int e = 0; e < 16; ++e) { const int kidx = 32 * (3 * half + k3) + (e & 3) + 8 * (e >> 2) + 4 * hh; const bool ok = kidx >= kmin && kidx < kmax; sc[k3][e] = ok ? sc[k3][e] : -1e30f; mx = fmaxf(mx, sc[k3][e]); }
            mx = fmaxf(mx, shfl_xor_l(mx, 32, lane));
            const float mnew = fmaxf(mrun, mx), alpha = __expf(mrun - mnew);
            float psum = 0.f;
#pragma unroll
            for (int k3 = 0; k3 < 3; ++k3)
#pragma unroll
                for (int e = 0; e < 16; ++e) { const float p = __expf(sc[k3][e] - mnew); sc[k3][e] = p; psum += p; }
            psum += shfl_xor_l(psum, 32, lane);
            lrun = lrun * alpha + psum; mrun = mnew;
            o0 = o0 * alpha; o1 = o1 * alpha;
#pragma unroll
            for (int k3 = 0; k3 < 3; ++k3)
#pragma unroll
                for (int ss = 0; ss < 2; ++ss) {
                    const int kt = 3 * half + k3;
                    const bf16x8 pb = pack8(sc[k3], ss);
                    const LAS unsigned char* vp = L + AT_V + r * 400 + (32 * kt + 16 * ss + 4 * hh) * 2;
                    const u32x2 a0 = *(const LAS u32x2*)vp, a1 = *(const LAS u32x2*)(vp + 16), b0 = *(const LAS u32x2*)(vp + 32 * 400), b1 = *(const LAS u32x2*)(vp + 32 * 400 + 16);
                    const u32x4 va = {a0[0], a0[1], a1[0], a1[1]}, vb = {b0[0], b0[1], b1[0], b1[1]};
                    o0 = MFMA32(__builtin_bit_cast(bf16x8, va), pb, o0); o1 = MFMA32(__builtin_bit_cast(bf16x8, vb), pb, o1);
                }
        }
        const float il = __builtin_amdgcn_rcpf(lrun);
        if (qok) {
#pragma unroll
            for (int qq = 0; qq < 4; ++qq) {
                { const int d = 8 * qq + 4 * hh; const u32x2 gb = gbr[2 * qq];
                  u32x2 yo; yo[0] = cvt2(o0[4 * qq] * il * siluf_(lo16(gb[0])), o0[4 * qq + 1] * il * siluf_(hi16(gb[0]))); yo[1] = cvt2(o0[4 * qq + 2] * il * siluf_(lo16(gb[1])), o0[4 * qq + 3] * il * siluf_(hi16(gb[1])));
                  *(u32x2*)(F.Y0() + m * D + 512 + hq * 64 + d) = yo; }
                { const int d = 32 + 8 * qq + 4 * hh; const u32x2 gb = gbr[2 * qq + 1];
                  u32x2 yo; yo[0] = cvt2(o1[4 * qq] * il * siluf_(lo16(gb[0])), o1[4 * qq + 1] * il * siluf_(hi16(gb[0]))); yo[1] = cvt2(o1[4 * qq + 2] * il * siluf_(lo16(gb[1])), o1[4 * qq + 3] * il * siluf_(hi16(gb[1])));
                  *(u32x2*)(F.Y0() + m * D + 512 + hq * 64 + d) = yo; }
            }
        }
    }
    __syncthreads();
}

__device__ __forceinline__ void rows_final(Frame& F, const int m0, const int n, const int s, const int lane) {
    const float* mod1 = F.MOD() + (size_t)(24 + s) * 3072;
    f32x4 A1[4];
#pragma unroll
    for (int j = 0; j < 4; ++j) { const int c = 4 * lane + 256 * j; const f32x4 g = *(const f32x4*)(F.in[27] + c), gt = *(const f32x4*)(mod1 + 2048 + c);
#pragma unroll
        for (int e = 0; e < 4; ++e) A1[j][e] = gt[e] * g[e]; }
    u32x2 ycur[4]; f32x4 xcur[4];
#pragma unroll
    for (int j = 0; j < 4; ++j) { ycur[j] = *(const u32x2*)(F.YO() + (size_t)m0 * D + 4 * lane + 256 * j); xcur[j] = *(const f32x4*)(F.out + O_Y + (size_t)m0 * D + 4 * lane + 256 * j); }
    for (int i = 0; i < n; ++i) {
        const int m = m0 + i, mn = m0 + (i + 1 < n ? i + 1 : i); u32x2 ynxt[4]; f32x4 xnxt[4];
#pragma unroll
        for (int j = 0; j < 4; ++j) { ynxt[j] = *(const u32x2*)(F.YO() + (size_t)mn * D + 4 * lane + 256 * j); xnxt[j] = *(const f32x4*)(F.out + O_Y + (size_t)mn * D + 4 * lane + 256 * j); }
        f32x4 y[4]; float ss = 0.f;
#pragma unroll
        for (int j = 0; j < 4; ++j) { y[j] = (f32x4){lo16(ycur[j][0]), hi16(ycur[j][0]), lo16(ycur[j][1]), hi16(ycur[j][1])}; ss += (y[j][0] * y[j][0] + y[j][1] * y[j][1]) + (y[j][2] * y[j][2] + y[j][3] * y[j][3]); }
        const float r1 = rsqrtf(wave_sum(ss, lane) * (1.f / D) + EPS);
#pragma unroll
        for (int j = 0; j < 4; ++j) { f32x4 o;
#pragma unroll
            for (int e = 0; e < 4; ++e) o[e] = xcur[j][e] + A1[j][e] * (y[j][e] * r1);
            *(f32x4*)(F.out + O_Y + (size_t)m * D + 4 * lane + 256 * j) = o; }
#pragma unroll
        for (int j = 0; j < 4; ++j) { ycur[j] = ynxt[j]; xcur[j] = xnxt[j]; }
    }
}
__device__ __forceinline__ void phase_final_rowwise(Frame& F) {
    PHASE_IDS();
    const int gw = F.vcu * 8 + wave, NGW = F.G * 8;
    for (int w = gw; w < MP / 16; w += NGW) rows_final(F, w * 16, 16, w >> 8, lane);
    for (int w = gw; w < MS; w += NGW) rows_final(F, MP + w, 1, BP + (w >> 4), lane);
}

__global__ void __launch_bounds__(512, 2) fwd_megakernel(Params P) {
    extern __shared__ __attribute__((aligned(16))) unsigned char lds_raw[];
    Frame F;
    F.lds = (LAS unsigned char*)lds_raw;
    F.wv = __builtin_amdgcn_readfirstlane(threadIdx.x >> 6);
    F.G = gridDim.x; { const int bx = blockIdx.x; F.vcu = (F.G % 8 == 0) ? (bx % 8) * (F.G / 8) + bx / 8 : bx; }
    F.in = P.in; F.out = P.out; F.ws = P.ws;

    volatile LAS unsigned* misc = (volatile LAS unsigned*)(F.lds + LDS_BYTES - 64);
    if (threadIdx.x < 16) misc[threadIdx.x] = 0u;
    __syncthreads();
    XcdBarrier xbar = xcd_barrier_post((unsigned*)(P.ws + WS_CTL), misc);
#define GRID_BAR() xcd_barrier(xbar, F.wv)
    phase_prologue(F);
    GRID_BAR();
    phase_prenorm0(F);
    GRID_BAR();
    { pg8::Gemm g{F.XN(), F.W0I(), MT, EV_IN, D}; pg8::StaticOrder S; S.init(MT, EV_IN, F.G, (int)blockIdx.x);
      pg8::EpiBf16 E{F.U0(), EV_IN, 1 << 30, F.U0(), EV_IN}; pg8::gemm_phase(F.lds, g, S, E, F.wv); }
    GRID_BAR();
    phase_rope(F);
    phase_lru<1>(F);
    phase_vt_build(F);
    GRID_BAR();
    phase_lru<2>(F);
    phase_attn(F);
    GRID_BAR();
    { pg8::Gemm g{F.Y0(), F.W0O(), MT, D, D}; pg8::StaticOrder S; S.init(MT, D, F.G, (int)blockIdx.x);
      pg8::EpiBf16 E{F.YO(), D, 1 << 30, F.YO(), D}; pg8::gemm_phase(F.lds, g, S, E, F.wv); }
    GRID_BAR();
    phase_mid_rowwise(F);
    GRID_BAR();
    { pg8::Gemm g{F.XN(), F.W1I(), MT, OD_MAIN, D}; pg8::StaticOrder S; S.init(MT, OD_MAIN, F.G, (int)blockIdx.x);
      pg8::EpiBf16 E{F.QKV1(), 3072, 3072, F.Z1(), D}; pg8::gemm_phase(F.lds, g, S, E, F.wv); }
    GRID_BAR();
    phase_gdn_fused(F);
    GRID_BAR();
    { pg8::Gemm g{F.Y1(), F.W1O(), MT, D, D}; pg8::StaticOrder S; S.init(MT, D, F.G, (int)blockIdx.x);
      pg8::EpiBf16 E{F.YO(), D, 1 << 30, F.YO(), D}; pg8::gemm_phase(F.lds, g, S, E, F.wv); }
    GRID_BAR();
    phase_final_rowwise(F);
}

extern "C" void kernel_launch(void* const* d_in, const int* in_sizes, int n_in, void* d_out, int out_size, void* d_ws, size_t ws_size, hipStream_t stream) {
    static int grid = 0;
    if (grid == 0) {
        if (n_in != 34 || out_size != (int)O_END || ws_size < WS_END) { grid = -1; return; }
        int dev = 0, cus = 0, per_cu = 0;
        if (hipGetDevice(&dev) != hipSuccess || hipDeviceGetAttribute(&cus, hipDeviceAttributeMultiprocessorCount, dev) != hipSuccess) { grid = -1; return; }
        if (hipFuncSetAttribute((const void*)fwd_megakernel, hipFuncAttributeMaxDynamicSharedMemorySize, LDS_BYTES) != hipSuccess) { grid = -1; return; }
        if (hipOccupancyMaxActiveBlocksPerMultiprocessor(&per_cu, (const void*)fwd_megakernel, 512, LDS_BYTES) != hipSuccess || per_cu < 1) { grid = -1; return; }
        grid = cus;
    }
    if (grid < 0) return;
    if (hipMemsetAsync((char*)d_ws + WS_CTL, 0, 65536 + 4224 * 64, stream) != hipSuccess) return;
    Params p{};
    for (int i = 0; i < 34; ++i) p.in[i] = (const float*)d_in[i];
    p.out = (float*)d_out; p.ws = (unsigned char*)d_ws;
    void* args[] = {&p};
    (void)hipLaunchCooperativeKernel((const void*)fwd_megakernel, dim3(grid), dim3(512), args, LDS_BYTES, stream);
}
```

```cpp
#include <hip/hip_runtime.h>
#include <hip/hip_cooperative_groups.h>
namespace cg = cooperative_groups;

#define LAS __attribute__((address_space(3)))
typedef unsigned short bf16_t;
typedef short bf16x8 __attribute__((ext_vector_type(8)));
typedef float f32x4 __attribute__((ext_vector_type(4)));
typedef float f32x2 __attribute__((ext_vector_type(2)));
typedef unsigned u32x4 __attribute__((ext_vector_type(4)));
typedef unsigned u32x2 __attribute__((ext_vector_type(2)));

constexpr int D = 1024, BP = 8, TP = 4096, BS = 16, TS = 16;
constexpr int MP = BP * TP, MS = BS * TS, MT = MP + MS;
constexpr int NSEQ = BP + BS;
constexpr int EV_IN = 2304, OD_IN = 4112, OD_MAIN = 4096;
constexpr int C_XA = 0, C_GA = 512, C_Q = 1024, C_K = 1536, C_V = 1664, C_GB = 1792;
constexpr float EPS = 1e-6f;
constexpr size_t O_Y = 0, O_LCP = 33816576, O_LCS = 33828864, O_LHP = 33853440, O_LHS = 33857536, O_KP = 33865728, O_KS = 33996800,
                 O_VP = 34029568, O_VS = 34160640, O_GCP = 34193408, O_GCS = 34267136, O_GSP = 34414592, O_GSS = 35463168, O_END = 37560320;
constexpr size_t MiB = 1u << 20;
constexpr size_t WS_CTL = 0, WS_W1O = 1 * MiB, WS_MOD = 3 * MiB, WS_ROPE = 4 * MiB, WS_BA = 5 * MiB, WS_LAG = 8 * MiB, WS_LGW = 10 * MiB;
constexpr size_t WS_RA = 16 * MiB, RA_BYTES = (size_t)MT * 4096 * 2;
constexpr size_t WS_RB = WS_RA + RA_BYTES;
constexpr size_t ACT_BYTES = (size_t)MT * D * 2;
constexpr size_t RB_XN = 0, RB_Y0 = ACT_BYTES, RB_YO = 2 * ACT_BYTES, RB_W0I = 3 * ACT_BYTES, RB_W0O = RB_W0I + (size_t)EV_IN * D * 2,
                 RB_W1I = RB_W0O + (size_t)D * D * 2, RB_WEND = RB_W1I + (size_t)OD_MAIN * D * 2;
constexpr size_t RB_BYTES = (size_t)4224 * 73728;
constexpr size_t WS_END = WS_RB + RB_BYTES;
static_assert(RB_WEND <= RB_BYTES, "ws map");
static_assert((size_t)MT * 3072 * 2 <= RB_BYTES, "ws map");
constexpr int LDS_BYTES = 155648;

struct Params { const float* in[34]; float* out; unsigned char* ws; };

__device__ __forceinline__ float bf2f(bf16_t b) { return __uint_as_float(((unsigned)b) << 16); }
__device__ __forceinline__ unsigned f2bf(float f) { unsigned u = __float_as_uint(f); return (u + 0x7fffu + ((u >> 16) & 1u)) >> 16; }
__device__ __forceinline__ unsigned pk2(float lo, float hi) { return f2bf(lo) | (f2bf(hi) << 16); }
typedef __bf16 bf16x2_t __attribute__((ext_vector_type(2)));
__device__ __forceinline__ unsigned cvt2(float a, float b) { f32x2 v = {a, b}; bf16x2_t r = __builtin_convertvector(v, bf16x2_t); return __builtin_bit_cast(unsigned, r); }
__device__ __forceinline__ float lo16(unsigned w) { return __uint_as_float(w << 16); }
__device__ __forceinline__ float hi16(unsigned w) { return __uint_as_float(w & 0xffff0000u); }
__device__ __forceinline__ float shfl_idx(float x, int src_lane) { return __int_as_float(__builtin_amdgcn_ds_bpermute(src_lane << 2, __float_as_int(x))); }
__device__ __forceinline__ float shfl_xor_l(float x, int o, int lane) { return shfl_idx(x, lane ^ o); }
__device__ __forceinline__ float wave_sum(float v, int lane) {
#pragma unroll
    for (int o = 1; o < 64; o <<= 1) v += shfl_xor_l(v, o, lane);
    return v;
}
__device__ __forceinline__ float sigmoidf_(float x) { return __builtin_amdgcn_rcpf(1.0f + __expf(-x)); }
__device__ __forceinline__ float siluf_(float x) { return x * __builtin_amdgcn_rcpf(1.0f + __expf(-x)); }
__device__ __forceinline__ float softplusf_(float x) { return x > 20.f ? x : log1pf(__expf(x)); }
__device__ __forceinline__ int seq_base(int s) { return s < BP ? s * TP : MP + (s - BP) * TS; }
__device__ __forceinline__ int seq_len(int s) { return s < BP ? TP : TS; }
__device__ __forceinline__ void tok_info(int m, int& s, int& t) { if (m < MP) { s = m >> 12; t = m & 4095; } else { const int r = m - MP; s = BP + (r >> 4); t = r & 15; } }

__device__ __forceinline__ int opaque_tid(int wv) { unsigned z = 0u; asm volatile("" : "+v"(z)); const int l = __builtin_amdgcn_mbcnt_hi(~0u, __builtin_amdgcn_mbcnt_lo(~0u, z)); return wv * 64 + l; }
namespace pg8 {
constexpr int BM = 256, BK = 64, HALF = 128, HTB = HALF * BK * 2, STAGE_BYTES = 8 * HTB, NXCD = 8, WGM = 8;
__host__ __device__ __forceinline__ int lds_byte(int r, int c) { const int st = (r >> 4) * 2 + (c >> 5), rr = r & 15, cc = c & 31, ob = rr * 64 + cc * 2; return st * 1024 + (ob ^ (((ob >> 9) & 1) << 5)); }
__host__ __device__ __forceinline__ void stage_rc(int b, int& R, int& C) { const int st = b / 1024, sb = b % 1024, swz = sb ^ (((sb >> 9) & 1) << 5); R = (st >> 1) * 16 + swz / 64; C = (st & 1) * 32 + (swz % 64) / 2; }
__host__ __device__ __forceinline__ int perm32(int rho) { const int n = rho >> 4, i = rho & 15; return 8 * (i >> 2) + 4 * n + (i & 3); }
struct Unit { int pm, pn; };
struct Gemm { const bf16_t* A; const bf16_t* Bt; int M, N, K; };
struct StaticOrder {
    int nM, nN, nwg, G, c;
    __device__ void init(int M, int N, int G_, int c_) { nM = M / BM; nN = N / BM; nwg = nM * nN; G = G_; c = c_; }
    __device__ bool next(int i, Unit& u) const {
        const long L = (long)i * G + c; if (L >= nwg) return false;
        int wgid = (int)L; { const int q = nwg / NXCD, r = nwg % NXCD, xcd = wgid % NXCD, off = wgid / NXCD; wgid = (xcd < r ? xcd * (q + 1) : r * (q + 1) + (xcd - r) * q) + off; }
        const int nig = WGM * nN, gid = wgid / nig, fm = gid * WGM, gsz = (nM - fm) < WGM ? (nM - fm) : WGM;
        u.pm = fm + ((wgid % nig) % gsz); u.pn = (wgid % nig) / gsz; return true;
    }
};
__device__ __forceinline__ unsigned cvt_pk_bf16(float lo, float hi) { unsigned r; asm volatile("v_cvt_pk_bf16_f32 %0, %1, %2" : "=v"(r) : "v"(lo), "v"(hi)); return r; }
struct EpiBf16 {
    static constexpr bool PERM = true;
    bf16_t* O0; int ld0; int split; bf16_t* O1; int ld1;
    __device__ __forceinline__ void operator()(const f32x4 (&acc)[2][2][4][2], const Unit& u, int wr, int wc, int fr, int fq) const {
        const int row0 = u.pm * BM + wr * 64 + fr; int colt = u.pn * BM; bf16_t* base = O0; int ld = ld0;
        if (colt >= split) { base = O1; ld = ld1; colt -= split; }
        const int col0 = colt + wc * 32 + 8 * fq;
#pragma unroll
        for (int ai = 0; ai < 2; ++ai)
#pragma unroll
            for (int m = 0; m < 4; ++m) { bf16_t* rowp = base + (size_t)(row0 + ai * HALF + m * 16) * ld + col0;
#pragma unroll
                for (int bj = 0; bj < 2; ++bj) { const f32x4 v0 = acc[ai][bj][m][0], v1 = acc[ai][bj][m][1];
                    u32x4 w; w.x = cvt_pk_bf16(v0[0], v0[1]); w.y = cvt_pk_bf16(v0[2], v0[3]); w.z = cvt_pk_bf16(v1[0], v1[1]); w.w = cvt_pk_bf16(v1[2], v1[3]);
                    *(u32x4*)(rowp + bj * HALF) = w; } }
    }
};
template <class Epi, class Sched>
__device__ __forceinline__ void gemm_phase(LAS unsigned char* lds, const Gemm g, const Sched& S, const Epi& E, const int wv0) {
    int tid = opaque_tid(wv0);
    const int wid = __builtin_amdgcn_readfirstlane(tid >> 6), lane = tid & 63, wr = wid >> 2, wc = wid & 3, fr = lane & 15, fq = lane >> 4;
    const int K = g.K, nt = K / BK;
    unsigned voffA[2], voffB[2];
#pragma unroll
    for (int i = 0; i < 2; ++i) { int R, C; stage_rc(tid * 16 + i * 8192, R, C); const int Rb = Epi::PERM ? ((R & ~31) + perm32(R & 31)) : R;
        voffA[i] = (unsigned)(R * K + C) * 2u; voffB[i] = (unsigned)(Rb * K + C) * 2u; }
    const size_t kstep = (size_t)(BK * 2);
    const size_t hstep = (size_t)HALF * K * 2;
    const size_t tstep = 2 * hstep;
    const unsigned ldsw = (unsigned)wid * 1024u;
    const int aoff = lds_byte(wr * 64 + fr, fq * 8), boff = lds_byte(wc * 32 + fr, fq * 8);
#define PG8_SA(b, h) (((b) * 2 + (h)) * HTB)
#define PG8_SB(b, h) ((4 + (b) * 2 + (h)) * HTB)
#define PG8_STAGE(bufoff, gbase, voff) do { _Pragma("unroll") for (int _i = 0; _i < 2; ++_i) \
        __builtin_amdgcn_global_load_lds((const unsigned*)((const char*)(gbase) + (voff)[_i]), (LAS unsigned*)(lds + (bufoff) + ldsw + _i * 8192), 16, 0, 0); } while (0)
#define PG8_LDA(dst, b, h) do { _Pragma("unroll") for (int m = 0; m < 4; ++m) _Pragma("unroll") for (int k = 0; k < 2; ++k) dst[m][k] = *(const LAS bf16x8*)(lds + PG8_SA(b, h) + aoff + m * 2048 + k * 1024); } while (0)
#define PG8_LDB(dst, b, h) do { _Pragma("unroll") for (int n = 0; n < 2; ++n) _Pragma("unroll") for (int k = 0; k < 2; ++k) dst[n][k] = *(const LAS bf16x8*)(lds + PG8_SB(b, h) + boff + n * 2048 + k * 1024); } while (0)
#define PG8_MMA(ai, bj, At, Bt) do { __builtin_amdgcn_s_setprio(1); _Pragma("unroll") for (int m = 0; m < 4; ++m) _Pragma("unroll") for (int n = 0; n < 2; ++n) _Pragma("unroll") for (int k = 0; k < 2; ++k) \
        acc[ai][bj][m][n] = __builtin_amdgcn_mfma_f32_16x16x32_bf16(Bt[n][k], At[m][k], acc[ai][bj][m][n], 0, 0, 0); __builtin_amdgcn_s_setprio(0); } while (0)
#define PG8_WAIT_V(n) asm volatile("s_waitcnt vmcnt(" #n ")" ::: "memory")
#define PG8_WAIT_L(n) asm volatile("s_waitcnt lgkmcnt(" #n ")" ::: "memory")
#define PG8_BAR __builtin_amdgcn_s_barrier()
#define PG8_SCHED __builtin_amdgcn_sched_barrier(0)
    Unit cur, nxt; int ui = 0;
    if (!S.next(0, cur)) return;
    f32x4 acc[2][2][4][2];
#pragma unroll
    for (int a = 0; a < 2; ++a)
#pragma unroll
        for (int b = 0; b < 2; ++b)
#pragma unroll
            for (int m = 0; m < 4; ++m)
#pragma unroll
                for (int n = 0; n < 2; ++n) acc[a][b][m][n] = (f32x4){0.f, 0.f, 0.f, 0.f};
    bf16x8 At[4][2], B0[2][2], B1[2][2];
    const char* cA = (const char*)g.A + (size_t)cur.pm * tstep; const char* cB = (const char*)g.Bt + (size_t)cur.pn * tstep;
    PG8_STAGE(PG8_SB(0, 0), cB, voffB); PG8_STAGE(PG8_SA(0, 0), cA, voffA); PG8_STAGE(PG8_SB(0, 1), cB + hstep, voffB); PG8_STAGE(PG8_SA(0, 1), cA + hstep, voffA);
    if (wr == 1) PG8_BAR;
    PG8_WAIT_V(4); PG8_BAR;
    PG8_STAGE(PG8_SB(1, 0), cB + kstep, voffB); PG8_STAGE(PG8_SA(1, 0), cA + kstep, voffA); PG8_STAGE(PG8_SB(1, 1), cB + hstep + kstep, voffB);
    PG8_WAIT_V(6); PG8_BAR;
    for (;;) {
        const bool has_next = S.next(ui + 1, nxt);
        const char* nA = has_next ? (const char*)g.A + (size_t)nxt.pm * tstep : cA; const char* nB = has_next ? (const char*)g.Bt + (size_t)nxt.pn * tstep : cB;
        for (int t = 0; t < nt; t += 2) {
            const bool last = (t == nt - 2);
            const char* a1 = cA + (size_t)(t + 1) * kstep;
            const char* a2 = last ? nA : cA + (size_t)(t + 2) * kstep; const char* b2 = last ? nB : cB + (size_t)(t + 2) * kstep;
            const char* a3 = a2 + kstep; const char* b3 = b2 + kstep;
            PG8_LDB(B0, 0, 0); PG8_SCHED; PG8_LDA(At, 0, 0); PG8_STAGE(PG8_SA(1, 1), a1 + hstep, voffA);
            PG8_WAIT_L(8); PG8_BAR; PG8_WAIT_L(0); PG8_MMA(0, 0, At, B0); PG8_BAR; PG8_SCHED;
            PG8_LDB(B1, 0, 1); PG8_STAGE(PG8_SB(0, 0), b2, voffB);
            PG8_BAR; PG8_WAIT_L(0); PG8_MMA(0, 1, At, B1); PG8_BAR;
            PG8_LDA(At, 0, 1); PG8_STAGE(PG8_SA(0, 0), a2, voffA);
            PG8_BAR; PG8_WAIT_L(0); PG8_MMA(1, 0, At, B0); PG8_BAR; PG8_SCHED;
            PG8_STAGE(PG8_SB(0, 1), b2 + hstep, voffB);
            PG8_WAIT_V(6); PG8_BAR; PG8_MMA(1, 1, At, B1); PG8_BAR;
            PG8_LDB(B0, 1, 0); PG8_SCHED; PG8_LDA(At, 1, 0); PG8_STAGE(PG8_SA(0, 1), a2 + hstep, voffA);
            PG8_WAIT_L(8); PG8_BAR; PG8_WAIT_L(0); PG8_MMA(0, 0, At, B0); PG8_BAR; PG8_SCHED;
            PG8_LDB(B1, 1, 1); PG8_STAGE(PG8_SB(1, 0), b3, voffB);
            PG8_BAR; PG8_WAIT_L(0); PG8_MMA(0, 1, At, B1); PG8_BAR;
            PG8_LDA(At, 1, 1); PG8_STAGE(PG8_SA(1, 0), a3, voffA);
            PG8_BAR; PG8_WAIT_L(0); PG8_MMA(1, 0, At, B0); PG8_BAR; PG8_SCHED;
            PG8_STAGE(PG8_SB(1, 1), b3 + hstep, voffB);
            PG8_WAIT_V(6); PG8_BAR; PG8_MMA(1, 1, At, B1); PG8_BAR;
        }
        E(acc, cur, wr, wc, fr, fq);
        if (!has_next) break;
#pragma unroll
        for (int a = 0; a < 2; ++a)
#pragma unroll
            for (int b = 0; b < 2; ++b)
#pragma unroll
                for (int m = 0; m < 4; ++m)
#pragma unroll
                    for (int n = 0; n < 2; ++n) acc[a][b][m][n] = (f32x4){0.f, 0.f, 0.f, 0.f};
        cur = nxt; cA = nA; cB = nB; ++ui;
    }
    PG8_WAIT_V(0);
    if (wr == 0) PG8_BAR;
    PG8_BAR;
#undef PG8_SA
#undef PG8_SB
#undef PG8_STAGE
#undef PG8_LDA
#undef PG8_LDB
#undef PG8_MMA
#undef PG8_WAIT_V
#undef PG8_WAIT_L
#undef PG8_BAR
#undef PG8_SCHED
}
}


#define XB_TMO      128
#define XB_XCNT(j)  (256  + 64 * (j))
#define XB_XSUB(j)  (1280 + 64 * (j))
#define XB_XGEN(j)  (2304 + 64 * (j))
#define XB_TOP      3328
#define XB_TOPGEN   3392
#define XCD_BAR_WORDS 3456
#define XB_SPIN_CAP (1u << 18)
__device__ __forceinline__ unsigned xb_ld(unsigned* p)              { return __hip_atomic_load(p, __ATOMIC_RELAXED, __HIP_MEMORY_SCOPE_AGENT); }
__device__ __forceinline__ unsigned xb_add(unsigned* p, unsigned v) { return __hip_atomic_fetch_add(p, v, __ATOMIC_RELAXED, __HIP_MEMORY_SCOPE_AGENT); }
__device__ __forceinline__ unsigned xb_xcc_id() { return (unsigned)__builtin_amdgcn_s_getreg((3 << 11) | 20) & 0xFu; }
#define XB_SPIN(cond, bar) do { unsigned _sp = 0; while (cond) { __builtin_amdgcn_s_sleep(1); \
    if ((++_sp & 255u) == 0u) { if (xb_ld(&(bar)[XB_TMO])) break; if (_sp > XB_SPIN_CAP) { atomicAdd(&(bar)[XB_TMO], 1u); break; } } } } while (0)
struct XcdBarrier { unsigned* bar; unsigned x; volatile LAS unsigned* st; };
__device__ __forceinline__ XcdBarrier xcd_barrier_post(unsigned* bar, volatile LAS unsigned* st) {
    XcdBarrier b; b.bar = bar; b.x = xb_xcc_id(); b.st = st;
    if (threadIdx.x == 0) (void)xb_add(&bar[XB_XCNT(b.x)], 1u);
    return b;
}
__device__ __forceinline__ void xcd_barrier_complete(unsigned* bar, unsigned x, unsigned& nloc, unsigned& nx) {
    const unsigned G = gridDim.x * gridDim.y * gridDim.z;
    unsigned sum, cnt, mine, sp = 0u;
    for (;;) {
        sum = 0u; cnt = 0u; mine = 0u;
#pragma unroll
        for (unsigned j = 0; j < 16; ++j) { const unsigned c = xb_ld(&bar[XB_XCNT(j)]); sum += c; cnt += (c > 0u) ? 1u : 0u; mine = (j == x) ? c : mine; }
        if (sum == G) break;
        __builtin_amdgcn_s_sleep(1);
        if ((++sp & 255u) == 0u) { if (xb_ld(&bar[XB_TMO])) break; if (sp > XB_SPIN_CAP) { atomicAdd(&bar[XB_TMO], 1u); break; } }
    }
    nloc = mine > 0u ? mine : 1u; nx = cnt > 0u ? cnt : 1u;
}
__device__ __forceinline__ void xcd_barrier(const XcdBarrier& b, const int wv0) {
    asm volatile("s_waitcnt vmcnt(0)" ::: "memory");
    __syncthreads();
    if (opaque_tid(wv0) == 0) {
        unsigned* bar = b.bar;
        __builtin_amdgcn_s_waitcnt(0);
        unsigned nloc = b.st[0], nx = b.st[1];
        if (nloc == 0u) { xcd_barrier_complete(bar, b.x, nloc, nx); b.st[0] = nloc; b.st[1] = nx; }
        const unsigned old = xb_add(&bar[XB_XSUB(b.x)], 1u);
        const unsigned gen = old / nloc;
        if (old + 1u == (gen + 1u) * nloc) {
            __builtin_amdgcn_fence(__ATOMIC_RELEASE, "agent");
            asm volatile("s_waitcnt vmcnt(0)" ::: "memory");
            const unsigned og = xb_add(&bar[XB_TOP], 1u);
            const unsigned tg = og / nx;
            if (og + 1u == (tg + 1u) * nx) xb_add(&bar[XB_TOPGEN], 1u);
            else XB_SPIN(xb_ld(&bar[XB_TOPGEN]) == tg, bar);
            __builtin_amdgcn_fence(__ATOMIC_ACQUIRE, "agent");
            xb_add(&bar[XB_XGEN(b.x)], 1u);
            asm volatile("s_waitcnt vmcnt(0)" ::: "memory");
        } else {
            XB_SPIN(xb_ld(&bar[XB_XGEN(b.x)]) == gen, bar);
            __builtin_amdgcn_fence(__ATOMIC_ACQUIRE, "agent");
            asm volatile("s_waitcnt vmcnt(0)" ::: "memory");
        }
    }
    __syncthreads();
}

struct Frame {
    LAS unsigned char* lds;
    int vcu, G, wv;
    const float* const* in; float* out; unsigned char* ws;
    __device__ __forceinline__ float* MOD() const { return (float*)(ws + WS_MOD); }
    __device__ __forceinline__ float* ROPE() const { return (float*)(ws + WS_ROPE); }
    __device__ __forceinline__ float* BA() const { return (float*)(ws + WS_BA); }
    __device__ __forceinline__ float* LAG() const { return (float*)(ws + WS_LAG); }
    __device__ __forceinline__ bf16_t* W1O() const { return (bf16_t*)(ws + WS_W1O); }
    __device__ __forceinline__ bf16_t* U0() const { return (bf16_t*)(ws + WS_RA); }
    __device__ __forceinline__ bf16_t* QKV1() const { return (bf16_t*)(ws + WS_RA); }
    __device__ __forceinline__ bf16_t* Z1() const { return (bf16_t*)(ws + WS_RA + (size_t)MT * 3072 * 2); }
    __device__ __forceinline__ bf16_t* Y1() const { return (bf16_t*)(ws + WS_RA + (size_t)MT * 3072 * 2); }
    __device__ __forceinline__ bf16_t* XN() const { return (bf16_t*)(ws + WS_RB + RB_XN); }
    __device__ __forceinline__ bf16_t* Y0() const { return (bf16_t*)(ws + WS_RB + RB_Y0); }
    __device__ __forceinline__ bf16_t* YO() const { return (bf16_t*)(ws + WS_RB + RB_YO); }
    __device__ __forceinline__ bf16_t* W0I() const { return (bf16_t*)(ws + WS_RB + RB_W0I); }
    __device__ __forceinline__ bf16_t* W0O() const { return (bf16_t*)(ws + WS_RB + RB_W0O); }
    __device__ __forceinline__ bf16_t* W1I() const { return (bf16_t*)(ws + WS_RB + RB_W1I); }
    __device__ __forceinline__ bf16_t* QKVC() const { return (bf16_t*)(ws + WS_RB); }
};

#define PHASE_IDS() int tid = opaque_tid(F.wv); const int lane = tid & 63, wave = __builtin_amdgcn_readfirstlane(tid >> 6); (void)lane; (void)wave
__device__ __forceinline__ void p0_transpose_item(const float* W, int ldw, int nblk, int K, bf16_t* WT, LAS float* scr, int item, int lane) {
    const int kb = item / nblk, nb = item % nblk, k0 = 64 * kb, n0 = 32 * nb;
    f32x4 v[8];
#pragma unroll
    for (int i = 0; i < 8; ++i) v[i] = *(const f32x4*)(W + (size_t)(k0 + 8 * i + (lane >> 3)) * ldw + n0 + 4 * (lane & 7));
#pragma unroll
    for (int i = 0; i < 8; ++i) { LAS float* d = scr + (8 * i + (lane >> 3)) * 33 + 4 * (lane & 7); d[0] = v[i][0]; d[1] = v[i][1]; d[2] = v[i][2]; d[3] = v[i][3]; }
    asm volatile("s_waitcnt lgkmcnt(0)" ::: "memory");
    const int c = lane & 7;
#pragma unroll
    for (int j = 0; j < 4; ++j) { const int n = (lane >> 3) + 8 * j; const LAS float* s = scr + (8 * c) * 33 + n;
        u32x4 o; o.x = pk2(s[0 * 33], s[1 * 33]); o.y = pk2(s[2 * 33], s[3 * 33]); o.z = pk2(s[4 * 33], s[5 * 33]); o.w = pk2(s[6 * 33], s[7 * 33]);
        *(u32x4*)(WT + (size_t)(n0 + n) * K + k0 + 8 * c) = o; }
    asm volatile("s_waitcnt lgkmcnt(0)" ::: "memory");
}
constexpr size_t WS_MODP = 12 * MiB;
__device__ __forceinline__ f32x4 mod4(const float* MODP, int L, int s, int off) {
    f32x4 a = *(const f32x4*)(MODP + ((size_t)((L * 4 + 0) * 24 + s)) * 3072 + off);
#pragma unroll
    for (int sl = 1; sl < 4; ++sl) a += *(const f32x4*)(MODP + ((size_t)((L * 4 + sl) * 24 + s)) * 3072 + off);
    return a;
}
__device__ __forceinline__ void mod_task(Frame& F, const int bt, const int tid, const int lane, const int wave) {
    const int L = bt / 192, sl = (bt % 192) / 48, n0 = (bt % 48) * 64, kb = sl * 256;
    LAS float* tab = (LAS float*)F.lds;
    {   float cv[12];
#pragma unroll
        for (int u = 0; u < 12; ++u) { const int idx = tid + 512 * u, s = idx >> 8, k = kb + (idx & 255); cv[u] = s < BP ? F.in[8][s * D + k] : F.in[9][(s - BP) * D + k]; }
#pragma unroll
        for (int u = 0; u < 12; ++u) { const int idx = tid + 512 * u, s = idx >> 8, k = idx & 255; tab[k * 24 + s] = siluf_(cv[u]); } }
    __syncthreads();
    const float* mw = (L == 0 ? F.in[10] : F.in[24]) + n0 + lane;
    float acc[24];
#pragma unroll
    for (int r = 0; r < 24; ++r) acc[r] = 0.f;
    for (int k0 = wave * 32; k0 < wave * 32 + 32; k0 += 16) {
        float wv[16];
#pragma unroll
        for (int u = 0; u < 16; ++u) wv[u] = mw[(size_t)(kb + k0 + u) * 3072];
#pragma unroll
        for (int u = 0; u < 16; ++u) { const float w = wv[u];
            const LAS f32x4* tp = (const LAS f32x4*)(tab + (k0 + u) * 24);
#pragma unroll
            for (int q = 0; q < 6; ++q) { const f32x4 t4 = tp[q]; acc[4 * q] += t4[0] * w; acc[4 * q + 1] += t4[1] * w; acc[4 * q + 2] += t4[2] * w; acc[4 * q + 3] += t4[3] * w; } }
    }
    __syncthreads();
    LAS float* red = (LAS float*)F.lds;
#pragma unroll
    for (int r = 0; r < 24; ++r) red[(wave * 24 + r) * 64 + lane] = acc[r];
    __syncthreads();
    const float* mb = (L == 0 ? F.in[11] : F.in[25]);
    float* MODP = (float*)(F.ws + WS_MODP);
    for (int idx = tid; idx < 24 * 64; idx += 512) { const int r = idx >> 6, l = idx & 63; float s = 0.f;
#pragma unroll
        for (int w = 0; w < 8; ++w) s += red[(w * 24 + r) * 64 + l];
        MODP[((size_t)((L * 4 + sl) * 24 + r)) * 3072 + n0 + l] = s + (sl == 0 ? mb[n0 + l] : 0.f); }
    __syncthreads();
}
__device__ __forceinline__ void phase_mod0(Frame& F) {
    PHASE_IDS();
    for (int bt = F.vcu; bt < 192; bt += F.G) { int t2 = tid; asm volatile("" : "+v"(t2)); mod_task(F, bt, t2, t2 & 63, wave); }
}
__device__ __forceinline__ void phase_mod1(Frame& F) {
    PHASE_IDS();
    __syncthreads();
    for (int bt = 192 + F.vcu; bt < 384; bt += F.G) { int t2 = tid; asm volatile("" : "+v"(t2)); mod_task(F, bt, t2, t2 & 63, wave); }
}
__device__ __forceinline__ void phase_prologue(Frame& F) {
    PHASE_IDS();
    const int gw = F.vcu * 8 + wave, NGW = F.G * 8;
    {
        LAS float* scr = (LAS float*)(F.lds + wave * 16384);
        constexpr int I0 = 16 * (EV_IN / 32), I1 = 16 * 32, I2 = 16 * (OD_MAIN / 32), I3 = 16 * 32;
        for (int it = gw; it < I0 + I1 + I2 + I3; it += NGW) {
            int r = it;
            if (r < I0) { p0_transpose_item(F.in[14], EV_IN, EV_IN / 32, D, F.W0I(), scr, r, lane); continue; } r -= I0;
            if (r < I1) { p0_transpose_item(F.in[23], D, 32, D, F.W0O(), scr, r, lane); continue; } r -= I1;
            if (r < I2) { p0_transpose_item(F.in[28], OD_IN, OD_MAIN / 32, D, F.W1I(), scr, r, lane); continue; } r -= I2;
            p0_transpose_item(F.in[33], D, 32, D, F.W1O(), scr, r, lane);
        }
    }
    {
        const double inv[8] = {1.0, 0.19392274474868576, 0.03760603093086393, 0.007292664737217109, 0.001414213562373095, 0.0002742481756762073, 5.318295896944988e-05, 1.031338537721246e-05};
        for (int idx = F.vcu * 512 + tid; idx < 4112 * 8; idx += F.G * 512) {
            const int pos = idx >> 3, i = idx & 7;
            double iv = inv[0];
#pragma unroll
            for (int q = 1; q < 8; ++q) iv = (i == q) ? inv[q] : iv;
            const double ang = (double)pos * iv;
            const double n = __builtin_rint(ang * 0.15915494309189535);
            const float r = (float)__builtin_fma(-n, 6.283185307179586, ang);
            F.ROPE()[pos * 16 + i] = __cosf(r); F.ROPE()[pos * 16 + 8 + i] = __sinf(r);
        }
    }
    {
        bf16_t* LGW = (bf16_t*)(F.ws + WS_LGW);
        for (int idx = F.vcu * 512 + tid; idx < 8 * 2 * 64 * 64; idx += F.G * 512) { const int k = idx & 63, n = (idx >> 6) & 63, gate = (idx >> 12) & 1, hh = idx >> 13;
            LGW[idx] = (bf16_t)f2bf((gate ? F.in[19] : F.in[17])[(hh * 64 + k) * 64 + n]); }
    }
}

__device__ __forceinline__ const float* x_row(Frame& F, int m) { return m < MP ? F.in[0] + (size_t)m * D : F.in[1] + (size_t)(m - MP) * D; }
__device__ __forceinline__ void rows_prenorm0(Frame& F, const int m0, const int n, const int s, const int lane) {
    const float* MODP = (const float*)(F.ws + WS_MODP);
    f32x4 A[4], C[4];
#pragma unroll
    for (int j = 0; j < 4; ++j) { const int c = 4 * lane + 256 * j; const f32x4 g = *(const f32x4*)(F.in[12] + c), sc = mod4(MODP, 0, s, 1024 + c); C[j] = mod4(MODP, 0, s, c);
#pragma unroll
        for (int e = 0; e < 4; ++e) A[j][e] = g[e] * (1.f + sc[e]); }
    f32x4 cur[4];
#pragma unroll
    for (int j = 0; j < 4; ++j) cur[j] = *(const f32x4*)(x_row(F, m0) + 4 * lane + 256 * j);
    for (int i = 0; i < n; ++i) {
        const int mn = m0 + (i + 1 < n ? i + 1 : i); f32x4 nxt[4];
#pragma unroll
        for (int j = 0; j < 4; ++j) nxt[j] = *(const f32x4*)(x_row(F, mn) + 4 * lane + 256 * j);
        float ss = 0.f;
#pragma unroll
        for (int j = 0; j < 4; ++j) ss += (cur[j][0] * cur[j][0] + cur[j][1] * cur[j][1]) + (cur[j][2] * cur[j][2] + cur[j][3] * cur[j][3]);
        const float r = rsqrtf(wave_sum(ss, lane) * (1.f / D) + EPS);
#pragma unroll
        for (int j = 0; j < 4; ++j) { u32x2 w; w[0] = cvt2(cur[j][0] * r * A[j][0] + C[j][0], cur[j][1] * r * A[j][1] + C[j][1]); w[1] = cvt2(cur[j][2] * r * A[j][2] + C[j][2], cur[j][3] * r * A[j][3] + C[j][3]);
            *(u32x2*)(F.XN() + (size_t)(m0 + i) * D + 4 * lane + 256 * j) = w; }
#pragma unroll
        for (int j = 0; j < 4; ++j) cur[j] = nxt[j];
    }
}
__device__ __forceinline__ void phase_prenorm0(Frame& F) {
    PHASE_IDS();
    const int gw = F.vcu * 8 + wave, NGW = F.G * 8;
    for (int w = gw; w < MP / 16; w += NGW) rows_prenorm0(F, w * 16, 16, w >> 8, lane);
    for (int w = gw; w < MS; w += NGW) rows_prenorm0(F, MP + w, 1, BP + (w >> 4), lane);
}

__device__ __forceinline__ void phase_rope(Frame& F) {
    PHASE_IDS();
    const int gt = F.vcu * 512 + tid, NT = F.G * 512;
    for (int idx = gt; idx < MT * 10; idx += NT) {
        const int m = idx / 10, slot = idx % 10;
        int s, t; tok_info(m, s, t);
        const int pos = s < BP ? t : TP + t;
        const int col = slot < 8 ? C_Q + slot * 64 : C_K + (slot - 8) * 64;
        u32x4* p = (u32x4*)(F.U0() + (size_t)m * EV_IN + col);
        const u32x4 xa = p[0], xb = p[1];
        const f32x4* rp = (const f32x4*)(F.ROPE() + pos * 16); const f32x4 c0 = rp[0], c1 = rp[1], s0 = rp[2], s1 = rp[3];
        float x1[8], x2[8], o1[8], o2[8];
#pragma unroll
        for (int e = 0; e < 4; ++e) { x1[2 * e] = lo16(xa[e]); x1[2 * e + 1] = hi16(xa[e]); x2[2 * e] = lo16(xb[e]); x2[2 * e + 1] = hi16(xb[e]); }
#pragma unroll
        for (int i = 0; i < 8; ++i) { const float c = i < 4 ? c0[i & 3] : c1[i & 3], sn = i < 4 ? s0[i & 3] : s1[i & 3]; o1[i] = x1[i] * c - x2[i] * sn; o2[i] = x2[i] * c + x1[i] * sn; }
        u32x4 ya, yb;
#pragma unroll
        for (int e = 0; e < 4; ++e) { ya[e] = cvt2(o1[2 * e], o1[2 * e + 1]); yb[e] = cvt2(o2[2 * e], o2[2 * e + 1]); }
        p[0] = ya; p[1] = yb;
        if (slot >= 8) { const int kv = slot - 8; float* o = nullptr;
            if (s >= BP) o = F.out + O_KS + ((size_t)((s - BP) * TS + t) * 2 + kv) * 64;
            else if (t >= TP - 128) o = F.out + O_KP + ((size_t)(s * 128 + (t - (TP - 128))) * 2 + kv) * 64;
            if (o) { *(f32x4*)o = (f32x4){o1[0], o1[1], o1[2], o1[3]}; *(f32x4*)(o + 4) = (f32x4){o1[4], o1[5], o1[6], o1[7]}; *(f32x4*)(o + 8) = (f32x4){o2[0], o2[1], o2[2], o2[3]}; *(f32x4*)(o + 12) = (f32x4){o2[4], o2[5], o2[6], o2[7]}; } }
    }
    for (int idx = gt; idx < 1280 * 224; idx += NT) {
        const int tk = idx / 224, e = idx % 224;
        int s, t, m; if (tk < 1024) { s = tk >> 7; t = TP - 128 + (tk & 127); m = s * TP + t; } else { s = BP + ((tk - 1024) >> 4); t = (tk - 1024) & 15; m = MP + (tk - 1024); }
        const bool isv = e >= 96; const int e2 = isv ? e - 96 : e; const int kv = isv ? (e2 >> 6) : (e2 / 48), d = isv ? (e2 & 63) : 16 + (e2 % 48);
        const float val = bf2f(F.U0()[(size_t)m * EV_IN + (isv ? C_V : C_K) + kv * 64 + d]);
        const size_t ob = s >= BP ? (isv ? O_VS : O_KS) + ((size_t)((s - BP) * TS + t) * 2 + kv) * 64 : (isv ? O_VP : O_KP) + ((size_t)(s * 128 + (t - (TP - 128))) * 2 + kv) * 64;
        F.out[ob + d] = val;
    }
}


__device__ __forceinline__ void rows_mid(Frame& F, LAS float* baw, const int m0, const int n, const int s, const int lane) {
    const float* MODP = (const float*)(F.ws + WS_MODP);
    f32x4 A0[4], B1[4], C1[4];
#pragma unroll
    for (int j = 0; j < 4; ++j) { const int c = 4 * lane + 256 * j; const f32x4 g0 = *(const f32x4*)(F.in[13] + c), gt = mod4(MODP, 0, s, 2048 + c), g1 = *(const f32x4*)(F.in[26] + c), sc = mod4(MODP, 1, s, 1024 + c);
        C1[j] = mod4(MODP, 1, s, c);
#pragma unroll
        for (int e = 0; e < 4; ++e) { A0[j][e] = gt[e] * g0[e]; B1[j][e] = g1[e] * (1.f + sc[e]); } }
    u32x2 ycur[4]; f32x4 xcur[4];
#pragma unroll
    for (int j = 0; j < 4; ++j) { ycur[j] = *(const u32x2*)(F.YO() + (size_t)m0 * D + 4 * lane + 256 * j); xcur[j] = *(const f32x4*)(x_row(F, m0) + 4 * lane + 256 * j); }
    for (int i = 0; i < n; ++i) {
        const int m = m0 + i, mn = m0 + (i + 1 < n ? i + 1 : i); u32x2 ynxt[4]; f32x4 xnxt[4];
#pragma unroll
        for (int j = 0; j < 4; ++j) { ynxt[j] = *(const u32x2*)(F.YO() + (size_t)mn * D + 4 * lane + 256 * j); xnxt[j] = *(const f32x4*)(x_row(F, mn) + 4 * lane + 256 * j); }
        f32x4 y[4]; float ss = 0.f;
#pragma unroll
        for (int j = 0; j < 4; ++j) { y[j] = (f32x4){lo16(ycur[j][0]), hi16(ycur[j][0]), lo16(ycur[j][1]), hi16(ycur[j][1])}; ss += (y[j][0] * y[j][0] + y[j][1] * y[j][1]) + (y[j][2] * y[j][2] + y[j][3] * y[j][3]); }
        const float r1 = rsqrtf(wave_sum(ss, lane) * (1.f / D) + EPS);
        f32x4 x1[4]; float s2 = 0.f;
#pragma unroll
        for (int j = 0; j < 4; ++j) {
#pragma unroll
            for (int e = 0; e < 4; ++e) x1[j][e] = xcur[j][e] + A0[j][e] * (y[j][e] * r1);
            *(f32x4*)(F.out + O_Y + (size_t)m * D + 4 * lane + 256 * j) = x1[j];
            s2 += (x1[j][0] * x1[j][0] + x1[j][1] * x1[j][1]) + (x1[j][2] * x1[j][2] + x1[j][3] * x1[j][3]); }
        const float r2 = rsqrtf(wave_sum(s2, lane) * (1.f / D) + EPS);
        f32x4 hm[4];
#pragma unroll
        for (int j = 0; j < 4; ++j) {
#pragma unroll
            for (int e = 0; e < 4; ++e) hm[j][e] = x1[j][e] * r2 * B1[j][e] + C1[j][e];
            u32x2 w; w[0] = cvt2(hm[j][0], hm[j][1]); w[1] = cvt2(hm[j][2], hm[j][3]); *(u32x2*)(F.XN() + (size_t)m * D + 4 * lane + 256 * j) = w; }
        __builtin_amdgcn_sched_barrier(0);
        float p[16];
#pragma unroll
        for (int q = 0; q < 16; ++q) { p[q] = 0.f;
#pragma unroll
            for (int j = 0; j < 4; ++j) { const f32x4 w = *(const LAS f32x4*)(baw + q * 1024 + 256 * j + 4 * lane); p[q] += (hm[j][0] * w[0] + hm[j][1] * w[1]) + (hm[j][2] * w[2] + hm[j][3] * w[3]); }
            if ((q & 3) == 3) __builtin_amdgcn_sched_barrier(0); }
        { const bool u5 = (lane & 32) != 0;
#pragma unroll
          for (int q = 0; q < 8; ++q) { const float keep = u5 ? p[8 + q] : p[q], send = u5 ? p[q] : p[8 + q]; p[q] = keep + shfl_xor_l(send, 32, lane); } }
        { const bool u4 = (lane & 16) != 0;
#pragma unroll
          for (int q = 0; q < 4; ++q) { const float keep = u4 ? p[4 + q] : p[q], send = u4 ? p[q] : p[4 + q]; p[q] = keep + shfl_xor_l(send, 16, lane); } }
        { const bool u3 = (lane & 8) != 0;
#pragma unroll
          for (int q = 0; q < 2; ++q) { const float keep = u3 ? p[2 + q] : p[q], send = u3 ? p[q] : p[2 + q]; p[q] = keep + shfl_xor_l(send, 8, lane); } }
        { const bool u2 = (lane & 4) != 0; const float keep = u2 ? p[1] : p[0], send = u2 ? p[0] : p[1]; p[0] = keep + shfl_xor_l(send, 4, lane); }
        float mine = p[0]; mine += shfl_xor_l(mine, 2, lane); mine += shfl_xor_l(mine, 1, lane);
        if ((lane & 3) == 0) { const int col = lane >> 2, hh = col & 7;
            F.BA()[(size_t)m * 16 + col] = col < 8 ? sigmoidf_(mine) : -__expf(F.in[30][hh]) * softplusf_(mine + F.in[31][hh]); }
#pragma unroll
        for (int j = 0; j < 4; ++j) { ycur[j] = ynxt[j]; xcur[j] = xnxt[j]; }
    }
}
__device__ __forceinline__ void phase_mid_rowwise(Frame& F) {
    PHASE_IDS();
    LAS float* baw = (LAS float*)F.lds;
    for (int idx = tid; idx < 16 * 1024; idx += 512) { const int j = idx & 15, k = idx >> 4; baw[j * 1024 + k] = F.in[28][(size_t)k * OD_IN + OD_MAIN + j]; }
    __syncthreads();
    const int gw = F.vcu * 8 + wave, NGW = F.G * 8;
    for (int w = gw; w < MP / 16; w += NGW) rows_mid(F, baw, w * 16, 16, w >> 8, lane);
    for (int w = gw; w < MS; w += NGW) rows_mid(F, baw, MP + w, 1, BP + (w >> 4), lane);
}


typedef float f32x16 __attribute__((ext_vector_type(16)));
constexpr int GS_WF = 0, GS_QF = 16384, GS_KF = 32768, GS_PF = 49152, GS_UF = 57344, GS_BYTES = 73728;
constexpr size_t WS_DEC = 11 * MiB;
__device__ __forceinline__ int krow(int s, int h, int j) { return 16 * s + 8 * (j >> 2) + 4 * h + (j & 3); }
#define MFMA32(a, b, c) __builtin_amdgcn_mfma_f32_32x32x16_bf16((a), (b), (c), 0, 0, 0)
#define MFMA16(a, b, c) __builtin_amdgcn_mfma_f32_16x16x32_bf16((a), (b), (c), 0, 0, 0)

typedef __amdgpu_buffer_rsrc_t brsrc_t;
__device__ __forceinline__ brsrc_t staging_rsrc(unsigned char* ws) { return __builtin_amdgcn_make_buffer_rsrc((void*)(ws + WS_RB), (short)0, (int)RB_BYTES, 0x00020000); }
__device__ __forceinline__ void st16_wt(brsrc_t r, unsigned off, u32x4 v) { __builtin_amdgcn_raw_buffer_store_b128(v, r, off, 0, 16); }
__device__ __forceinline__ u32x4 ld16_wt(brsrc_t r, unsigned off) { return __builtin_amdgcn_raw_buffer_load_b128(r, off, 0, 16); }
__device__ __forceinline__ void st8_wt(unsigned char* p, u32x2 v) { __hip_atomic_store((unsigned long long*)p, ((unsigned long long)v[1] << 32) | v[0], __ATOMIC_RELAXED, __HIP_MEMORY_SCOPE_AGENT); }
constexpr size_t WS_READY = 65536;
#define LDS_BARRIER() do { asm volatile("s_waitcnt lgkmcnt(0)" ::: "memory"); __builtin_amdgcn_s_barrier(); asm volatile("" ::: "memory"); } while (0)
constexpr int G1_QS = 0, G1_KS = 17408, G1_VS = 34816, G1_AS = 52224, G1_PS = 69632, G1_WS = 78848, G1_CW = 96256, G1_VEC = 102400, G1_ES = 103424;
__device__ __forceinline__ void g1_load_raw(Frame& F, u32x4 (&raw)[24], int s, int c, int h, int t1) {
    const int r = t1 >> 3, j = t1 & 7, t = c * 64 + r;
#pragma unroll
    for (int p = 0; p < 3; ++p)
#pragma unroll
        for (int jj = 0; jj < 4; ++jj) { const int tt = t - 3 + jj, ttc = tt < 0 ? 0 : tt;
            const u32x4* src = (const u32x4*)(F.QKV1() + (size_t)(s * TP + ttc) * 3072 + p * 1024 + h * 128 + j * 16); raw[p * 8 + jj * 2] = src[0]; raw[p * 8 + jj * 2 + 1] = src[1]; }
}
__device__ __forceinline__ bf16x8 g1_pack_b(const f32x4 p, const f32x4 q) { u32x4 w; w[0] = cvt2(p[0], p[1]); w[1] = cvt2(p[2], p[3]); w[2] = cvt2(q[0], q[1]); w[3] = cvt2(q[2], q[3]); return __builtin_bit_cast(bf16x8, w); }
__device__ __forceinline__ void g1_decode(int n, int& s, int& c, int& h) { if (n < 4096) { c = n >> 6; s = (n & 63) >> 3; h = n & 7; } else { s = BP + ((n - 4096) >> 3); c = 0; h = n & 7; } }
__device__ __forceinline__ void gdn_g1_tasks(Frame& F, const int first, const int stride) {
    int tid = opaque_tid(F.wv);
    const int lane = tid & 63, wave = __builtin_amdgcn_readfirstlane(tid >> 6);
    LAS unsigned char* L = F.lds;
    LAS float* cw_s = (LAS float*)(L + G1_CW);
    LAS float* beta_s = (LAS float*)(L + G1_VEC); LAS float* gcum_s = beta_s + 64; LAS float* eg_s = beta_s + 128; LAS float* ek_s = beta_s + 192;
    float* DEC = (float*)(F.ws + WS_DEC);
    u32x4 raw[24];
    float pcw[3], pb = 0.f, pa = 0.f;
    const brsrc_t srs = staging_rsrc(F.ws);
    unsigned* ready = (unsigned*)(F.ws + WS_READY);
    { int s0, c0, h0; g1_decode(first < 4095 ? first : 4095, s0, c0, h0); g1_load_raw(F, raw, s0, c0, h0, tid);
#pragma unroll
        for (int q = 0; q < 3; ++q) { const int i = tid + 512 * q, jj = i / 384, cc = i % 384; pcw[q] = F.in[29][(size_t)jj * 3072 + (cc >> 7) * 1024 + h0 * 128 + (cc & 127)]; }
        const float* ba = F.BA() + (size_t)(s0 * TP + c0 * 64 + (tid & 63)) * 16; pb = ba[h0]; pa = ba[8 + h0]; }
    for (int task = first; task < 4224; task += stride) {
        const int tid = opaque_tid(F.wv), lane = tid & 63;
        int s, c, h; g1_decode(task, s, c, h);
        const int nvalid = s < BP ? 64 : TS, t0 = c * 64, base = seq_base(s), T = seq_len(s);
        const int sidx = task < 4096 ? ((s * 8 + h) * 64 + c) : task;
        unsigned char* blk = F.ws + WS_RB + (size_t)sidx * GS_BYTES; const unsigned boff = (unsigned)sidx * (unsigned)GS_BYTES;
        if (s < BP) {
#pragma unroll
            for (int q = 0; q < 3; ++q) cw_s[tid + 512 * q] = pcw[q];
        } else for (int i = tid; i < 4 * 384; i += 512) { const int jj = i / 384, cc = i % 384; cw_s[i] = F.in[29][(size_t)jj * 3072 + (cc >> 7) * 1024 + h * 128 + (cc & 127)]; }
        if (tid < 64) {
            const bool ok = tid < nvalid; float beta = 0.f, g = 0.f;
            if (ok) { float vb = pb, va = pa; if (s >= BP) { const float* ba = F.BA() + (size_t)(base + t0 + tid) * 16; vb = ba[h]; va = ba[8 + h]; }
                beta = vb; g = va; }
            float x = g;
#pragma unroll
            for (int o = 1; o < 64; o <<= 1) { const float y = shfl_idx(x, lane >= o ? lane - o : lane); if (lane >= o) x += y; }
            const float gl = shfl_idx(x, 63);
            beta_s[tid] = beta; gcum_s[tid] = x; eg_s[tid] = __expf(x); ek_s[tid] = ok ? __expf(gl - x) : 0.f;
            if (tid == 0) __hip_atomic_store((unsigned*)DEC + sidx, __float_as_uint(__expf(gl)), __ATOMIC_RELAXED, __HIP_MEMORY_SCOPE_AGENT);
        }
        LDS_BARRIER();
        {
            int t1 = tid; asm volatile("" : "+v"(t1));
            const int r = t1 >> 3, j = t1 & 7, t = t0 + r; const bool ok = r < nvalid;
#pragma unroll
            for (int p = 0; p < 3; ++p) {
                float acc[16], cur[16];
#pragma unroll
                for (int e = 0; e < 16; ++e) { acc[e] = 0.f; cur[e] = 0.f; }
                const int cb = p * 1024 + h * 128 + j * 16;
#pragma unroll
                for (int jj = 0; jj < 4; ++jj) {
                    const int tt = t - 3 + jj; float x[16];
                    if (s < BP) { const u32x4 a = raw[p * 8 + jj * 2], b = raw[p * 8 + jj * 2 + 1]; const bool v = tt >= 0;
#pragma unroll
                        for (int e = 0; e < 4; ++e) { x[2 * e] = v ? lo16(a[e]) : 0.f; x[2 * e + 1] = v ? hi16(a[e]) : 0.f; x[8 + 2 * e] = v ? lo16(b[e]) : 0.f; x[8 + 2 * e + 1] = v ? hi16(b[e]) : 0.f; } }
                    else if (ok && tt >= 0) { const u32x4* src = (const u32x4*)(F.QKV1() + (size_t)(base + tt) * 3072 + cb); const u32x4 a = src[0], b = src[1];
#pragma unroll
                        for (int e = 0; e < 4; ++e) { x[2 * e] = lo16(a[e]); x[2 * e + 1] = hi16(a[e]); x[8 + 2 * e] = lo16(b[e]); x[8 + 2 * e + 1] = hi16(b[e]); } }
                    else if (ok) { const f32x4* src = (const f32x4*)(F.in[6] + ((size_t)(s - BP) * 3 + (tt + 3)) * 3072 + cb);
#pragma unroll
                        for (int q = 0; q < 4; ++q) { const f32x4 a = src[q]; x[4 * q] = a[0]; x[4 * q + 1] = a[1]; x[4 * q + 2] = a[2]; x[4 * q + 3] = a[3]; } }
                    else {
#pragma unroll
                        for (int e = 0; e < 16; ++e) x[e] = 0.f; }
                    const LAS f32x4* wp = (const LAS f32x4*)(cw_s + jj * 384 + p * 128 + j * 16);
#pragma unroll
                    for (int q = 0; q < 4; ++q) { const f32x4 w4 = wp[q]; acc[4 * q] += w4[0] * x[4 * q]; acc[4 * q + 1] += w4[1] * x[4 * q + 1]; acc[4 * q + 2] += w4[2] * x[4 * q + 2]; acc[4 * q + 3] += w4[3] * x[4 * q + 3]; }
                    if (jj == 3) {
#pragma unroll
                        for (int e = 0; e < 16; ++e) cur[e] = x[e]; }
                }
                if (ok && t >= T - 3) {
                    float* o = (s < BP ? F.out + O_GCP + ((size_t)s * 3 + (t - (T - 3))) * 3072 : F.out + O_GCS + ((size_t)(s - BP) * 3 + (t - (T - 3))) * 3072) + cb;
#pragma unroll
                    for (int q = 0; q < 4; ++q) *(f32x4*)(o + 4 * q) = (f32x4){cur[4 * q], cur[4 * q + 1], cur[4 * q + 2], cur[4 * q + 3]};
                }
                float ss = 0.f;
#pragma unroll
                for (int e = 0; e < 16; ++e) { acc[e] = siluf_(acc[e]); ss += acc[e] * acc[e]; }
                if (p < 2) { ss += shfl_xor_l(ss, 1, lane); ss += shfl_xor_l(ss, 2, lane); ss += shfl_xor_l(ss, 4, lane);
                    float sc = rsqrtf(ss + EPS); if (p == 0) sc *= 0.08838834764831845f;
#pragma unroll
                    for (int e = 0; e < 16; ++e) acc[e] *= sc; }
                u32x4 w0, w1;
#pragma unroll
                for (int e = 0; e < 4; ++e) { w0[e] = ok ? cvt2(acc[2 * e], acc[2 * e + 1]) : 0u; w1[e] = ok ? cvt2(acc[8 + 2 * e], acc[8 + 2 * e + 1]) : 0u; }
                LAS u32x4* dst = (LAS u32x4*)(L + (p == 0 ? G1_QS : p == 1 ? G1_KS : G1_VS) + r * 272 + j * 32);
                dst[0] = w0; dst[1] = w1;
                __builtin_amdgcn_sched_barrier(0);
            }
            { const int ntk = task + stride < 4095 ? task + stride : 4095; int s1, c1, h1; g1_decode(ntk, s1, c1, h1); g1_load_raw(F, raw, s1, c1, h1, t1);
#pragma unroll
              for (int q = 0; q < 3; ++q) { const int i = t1 + 512 * q, jj = i / 384, cc = i % 384; pcw[q] = F.in[29][(size_t)jj * 3072 + (cc >> 7) * 1024 + h1 * 128 + (cc & 127)]; }
              const float* ba = F.BA() + (size_t)(s1 * TP + c1 * 64 + (t1 & 63)) * 16; pb = ba[h1]; pa = ba[8 + h1]; }
        }
        LDS_BARRIER();
        {
            int l2 = lane; asm volatile("" : "+v"(l2));
            const int which = wave >> 2, ti = (wave >> 1) & 1, tj = wave & 1, r = l2 & 31, hh = l2 >> 5;
            f32x16 acc;
#pragma unroll
            for (int e = 0; e < 16; ++e) acc[e] = 0.f;
            if (!(ti == 0 && tj == 1)) {
                const LAS unsigned char* ap = L + (which ? G1_QS : G1_KS) + (32 * ti + r) * 272 + hh * 16;
                const LAS unsigned char* bp = L + G1_KS + (32 * tj + r) * 272 + hh * 16;
#pragma unroll
                for (int ks = 0; ks < 8; ++ks) { const bf16x8 a = *(const LAS bf16x8*)(ap + ks * 32), b = *(const LAS bf16x8*)(bp + ks * 32); acc = MFMA32(a, b, acc); }
            }
            const int jc = 32 * tj + r; const float gj = gcum_s[jc];
#pragma unroll
            for (int e = 0; e < 16; ++e) {
                const int i = 32 * ti + (e & 3) + 8 * (e >> 2) + 4 * hh; const float dg = gcum_s[i] - gj;
                if (which == 0) { const float f = (i > jc) ? __expf(dg) * beta_s[i] : 0.f; *(LAS float*)(L + G1_AS + i * 272 + jc * 4) = acc[e] * f; }
                else { const float f = (i >= jc) ? __expf(dg) : 0.f; *(LAS bf16_t*)(L + G1_PS + i * 144 + jc * 2) = (bf16_t)(cvt2(acc[e] * f, 0.f) & 0xffffu); }
            }
        }
        LDS_BARRIER();
        if (wave == 0) {
            int l3 = lane; asm volatile("" : "+v"(l3));
            const int bk = l3 >> 4, col = l3 & 15;
            float tcol[16];
#pragma unroll
            for (int rr = 0; rr < 16; ++rr) {
                float a = (rr == col) ? 1.0f : 0.f;
#pragma unroll
                for (int j4 = 0; j4 < (rr + 3) / 4; ++j4) { const f32x4 a4 = *(const LAS f32x4*)(L + G1_AS + (16 * bk + rr) * 272 + (16 * bk + 4 * j4) * 4);
#pragma unroll
                    for (int q = 0; q < 4; ++q) if (4 * j4 + q < rr) a -= a4[q] * tcol[4 * j4 + q]; }
                tcol[rr] = a;
                *(LAS float*)(L + G1_ES + ((bk * 16 + rr) * 16 + col) * 4) = a - ((rr == col) ? 1.0f : 0.f);
            }
        } else if (wave >= 4) {
            int l3 = lane; asm volatile("" : "+v"(l3));
            const int wv = wave - 4, r = l3 & 31, hh = l3 >> 5;
            {   const int rt4 = wv;
#pragma unroll
                for (int kt2 = 0; kt2 < 2; ++kt2)
#pragma unroll
                    for (int ss = 0; ss < 2; ++ss) { float v[8];
#pragma unroll
                        for (int j = 0; j < 8; ++j) { const int tok = 32 * kt2 + krow(ss, hh, j); v[j] = bf2f(*(const LAS bf16_t*)(L + G1_KS + tok * 272 + (32 * rt4 + r) * 2)) * ek_s[tok]; }
                        u32x4 o; o[0] = cvt2(v[0], v[1]); o[1] = cvt2(v[2], v[3]); o[2] = cvt2(v[4], v[5]); o[3] = cvt2(v[6], v[7]);
                        st16_wt(srs, boff + GS_KF + ((rt4 * 2 + kt2) * 2 + ss) * 1024 + l3 * 16, o); } }
            {   const int kt = wv;
#pragma unroll
                for (int rt = 0; rt < 2; ++rt)
#pragma unroll
                    for (int ss = 0; ss < 2; ++ss) { const int i = 32 * rt + r; const float sc = eg_s[i];
                        const u32x2 lo = *(const LAS u32x2*)(L + G1_QS + i * 272 + (32 * kt + 16 * ss + 4 * hh) * 2), hi = *(const LAS u32x2*)(L + G1_QS + i * 272 + (32 * kt + 16 * ss + 8 + 4 * hh) * 2);
                        u32x4 o; o[0] = cvt2(lo16(lo[0]) * sc, hi16(lo[0]) * sc); o[1] = cvt2(lo16(lo[1]) * sc, hi16(lo[1]) * sc); o[2] = cvt2(lo16(hi[0]) * sc, hi16(hi[0]) * sc); o[3] = cvt2(lo16(hi[1]) * sc, hi16(hi[1]) * sc);
                        st16_wt(srs, boff + GS_QF + ((rt * 4 + kt) * 2 + ss) * 1024 + l3 * 16, o); } }
            {   const int rt = wv >> 1, kt2 = wv & 1;
#pragma unroll
                for (int ss = 0; ss < 2; ++ss) { const int i = 32 * rt + r;
                    const u32x2 lo = *(const LAS u32x2*)(L + G1_PS + i * 144 + (32 * kt2 + 16 * ss + 4 * hh) * 2), hi = *(const LAS u32x2*)(L + G1_PS + i * 144 + (32 * kt2 + 16 * ss + 8 + 4 * hh) * 2);
                    u32x4 o; o[0] = lo[0]; o[1] = lo[1]; o[2] = hi[0]; o[3] = hi[1];
                    st16_wt(srs, boff + GS_PF + ((rt * 2 + kt2) * 2 + ss) * 1024 + l3 * 16, o); } }
        }
        LDS_BARRIER();
        {
            int l4 = lane; asm volatile("" : "+v"(l4));
            const int c16 = l4 & 15, g = l4 >> 4;
            const f32x4 z4 = {0.f, 0.f, 0.f, 0.f};
            f32x4 a10, a20, a21, a30, a31, a32, e0, e1, e2, e3;
            { const LAS unsigned char* ar = L + G1_AS + c16 * 272 + (4 * g) * 4;
              a10 = *(const LAS f32x4*)(ar + 16 * 272); a20 = *(const LAS f32x4*)(ar + 32 * 272); a21 = *(const LAS f32x4*)(ar + 32 * 272 + 64);
              a30 = *(const LAS f32x4*)(ar + 48 * 272); a31 = *(const LAS f32x4*)(ar + 48 * 272 + 64); a32 = *(const LAS f32x4*)(ar + 48 * 272 + 128);
              const LAS unsigned char* er = L + G1_ES + (c16 * 16 + 4 * g) * 4;
              e0 = *(const LAS f32x4*)er; e1 = *(const LAS f32x4*)(er + 1024); e2 = *(const LAS f32x4*)(er + 2048); e3 = *(const LAS f32x4*)(er + 3072); }
            const bf16x8 fA10 = g1_pack_b(z4 - a10, z4), fA2 = g1_pack_b(z4 - a20, z4 - a21), fA3a = g1_pack_b(z4 - a30, z4 - a31), fA3b = g1_pack_b(z4 - a32, z4);
            const bf16x8 fE0 = g1_pack_b(e0, z4), fE1 = g1_pack_b(e1, z4), fE2 = g1_pack_b(e2, z4), fE3 = g1_pack_b(e3, z4);
            const bool isw = wave < 4; const int cbase = 32 * (wave & 3);
#pragma unroll
            for (int tl = 0; tl < 2; ++tl) {
                const int d = cbase + 16 * tl + c16;
                f32x4 R[4];
#pragma unroll
                for (int i = 0; i < 4; ++i)
#pragma unroll
                    for (int e = 0; e < 4; ++e) { const int row = 16 * i + 4 * g + e; const float raw1 = bf2f(*(const LAS bf16_t*)(L + (isw ? G1_KS : G1_VS) + row * 272 + d * 2)); R[i][e] = raw1 * beta_s[row] * (isw ? eg_s[row] : 1.0f); }
                const f32x4 X0 = MFMA16(fE0, g1_pack_b(R[0], z4), R[0]);
                const f32x4 Y1 = MFMA16(fA10, g1_pack_b(X0, z4), R[1]);
                const f32x4 X1 = MFMA16(fE1, g1_pack_b(Y1, z4), Y1);
                const f32x4 Y2 = MFMA16(fA2, g1_pack_b(X0, X1), R[2]);
                const f32x4 X2 = MFMA16(fE2, g1_pack_b(Y2, z4), Y2);
                f32x4 Y3 = MFMA16(fA3a, g1_pack_b(X0, X1), R[3]);
                Y3 = MFMA16(fA3b, g1_pack_b(X2, z4), Y3);
                const f32x4 X3 = MFMA16(fE3, g1_pack_b(Y3, z4), Y3);
                const f32x4 X[4] = {X0, X1, X2, X3};
                if (isw) {
#pragma unroll
                    for (int i = 0; i < 4; ++i)
#pragma unroll
                        for (int e = 0; e < 4; ++e) *(LAS bf16_t*)(L + G1_WS + (16 * i + 4 * g + e) * 272 + d * 2) = (bf16_t)(cvt2(-X[i][e], 0.f) & 0xffffu);
                } else {
                    const int ws = wave & 3, cc = 16 * tl + c16;
#pragma unroll
                    for (int i = 0; i < 4; ++i) { const int rt = i >> 1, q = 2 * (i & 1) + (g >> 1), hh = g & 1;
                        u32x2 o; o[0] = cvt2(X[i][0], X[i][1]); o[1] = cvt2(X[i][2], X[i][3]);
                        st8_wt(blk + GS_UF + (size_t)(((ws * 2 + rt) * 64) + cc + 32 * hh) * 32 + q * 8, o); }
                }
            }
        }
        LDS_BARRIER();
        {
            int l5 = lane; asm volatile("" : "+v"(l5));
            const int kt = wave & 3, rt = wave >> 2, r = l5 & 31, hh = l5 >> 5, i = 32 * rt + r;
#pragma unroll
            for (int ss = 0; ss < 2; ++ss) {
                const u32x2 lo = *(const LAS u32x2*)(L + G1_WS + i * 272 + (32 * kt + 16 * ss + 4 * hh) * 2), hi = *(const LAS u32x2*)(L + G1_WS + i * 272 + (32 * kt + 16 * ss + 8 + 4 * hh) * 2);
                u32x4 o; o[0] = lo[0]; o[1] = lo[1]; o[2] = hi[0]; o[3] = hi[1];
                st16_wt(srs, boff + GS_WF + ((rt * 4 + kt) * 2 + ss) * 1024 + l5 * 16, o); }
        }
        asm volatile("s_waitcnt vmcnt(0)" ::: "memory");
        LDS_BARRIER();
        if (tid == 0) __hip_atomic_store(ready + 16 * sidx, 1u, __ATOMIC_RELAXED, __HIP_MEMORY_SCOPE_AGENT);
    }
}

constexpr int G2_FB = GS_BYTES, G2_OSTRIDE = 528, G2_HN = 2 * G2_FB, G2_DEC = G2_HN + 512;
__device__ __forceinline__ bf16x8 pack8(const f32x16& x, const int s) {
    u32x4 p; p[0] = cvt2(x[8 * s], x[8 * s + 1]); p[1] = cvt2(x[8 * s + 2], x[8 * s + 3]); p[2] = cvt2(x[8 * s + 4], x[8 * s + 5]); p[3] = cvt2(x[8 * s + 6], x[8 * s + 7]);
    return __builtin_bit_cast(bf16x8, p);
}
template <bool WT>
__device__ __forceinline__ void g2_load_set(u32x4 (&pre)[18], float& dpre, const unsigned char* blk, int lt, brsrc_t srs, unsigned boff, const unsigned* flag, const float* decp) {
    if (WT) { unsigned sp = 0; while (__builtin_amdgcn_readfirstlane(__hip_atomic_load(flag, __ATOMIC_RELAXED, __HIP_MEMORY_SCOPE_AGENT)) == 0u && ++sp < (1u << 20)) __builtin_amdgcn_s_sleep(4);
        dpre = __uint_as_float(__hip_atomic_load((const unsigned*)decp, __ATOMIC_RELAXED, __HIP_MEMORY_SCOPE_AGENT));
#pragma unroll
        for (int i = 0; i < 18; ++i) pre[i] = ld16_wt(srs, boff + (unsigned)(i * 256 + lt) * 16u);
    } else { const u32x4* src = (const u32x4*)blk; dpre = *decp;
#pragma unroll
        for (int i = 0; i < 18; ++i) pre[i] = src[i * 256 + lt]; }
}
__device__ __forceinline__ void g2_store_set(const u32x4 (&pre)[18], LAS unsigned char* dst, int lt) {
#pragma unroll
    for (int i = 0; i < 18; ++i) *(LAS u32x4*)(dst + (size_t)(i * 256 + lt) * 16) = pre[i];
}
#define G2_FRAG(off) (*(const LAS bf16x8*)(B + (off)))
#define G2_SCHED() __builtin_amdgcn_sched_barrier(0)
__device__ __forceinline__ void g2_mfma_step(f32x16& S0, f32x16& S1, f32x16& S2, f32x16& S3, LAS unsigned char* Bimg, const float dec, int ws, int lane, int cc, int hh) {
    const LAS unsigned char* B = Bimg + lane * 16;
    f32x16 vn0, vn1, o0, o1;
    { const LAS u32x4* up = (const LAS u32x4*)(Bimg + GS_UF + (size_t)(ws * 2 * 64 + lane) * 32); const u32x4 u0 = up[0], u1 = up[1], u2 = up[128], u3 = up[129];
#pragma unroll
      for (int q = 0; q < 4; ++q) { vn0[2 * q] = lo16(u0[q]); vn0[2 * q + 1] = hi16(u0[q]); vn0[8 + 2 * q] = lo16(u1[q]); vn0[8 + 2 * q + 1] = hi16(u1[q]);
                                    vn1[2 * q] = lo16(u2[q]); vn1[2 * q + 1] = hi16(u2[q]); vn1[8 + 2 * q] = lo16(u3[q]); vn1[8 + 2 * q + 1] = hi16(u3[q]); } }
#pragma unroll
    for (int e = 0; e < 16; ++e) { o0[e] = 0.f; o1[e] = 0.f; }
#define G2_WQ(Sx, kt) do { _Pragma("unroll") for (int ss = 0; ss < 2; ++ss) { const bf16x8 sb = pack8(Sx, ss); \
        const bf16x8 fw0 = G2_FRAG(GS_WF + ((0 * 4 + kt) * 2 + ss) * 1024), fw1 = G2_FRAG(GS_WF + ((1 * 4 + kt) * 2 + ss) * 1024); \
        const bf16x8 fq0 = G2_FRAG(GS_QF + ((0 * 4 + kt) * 2 + ss) * 1024), fq1 = G2_FRAG(GS_QF + ((1 * 4 + kt) * 2 + ss) * 1024); \
        vn0 = MFMA32(fw0, sb, vn0); vn1 = MFMA32(fw1, sb, vn1); o0 = MFMA32(fq0, sb, o0); o1 = MFMA32(fq1, sb, o1); } } while (0)
    G2_WQ(S0, 0); G2_WQ(S1, 1); G2_WQ(S2, 2); G2_WQ(S3, 3);
#undef G2_WQ
    bf16x8 vb[2][2];
    vb[0][0] = pack8(vn0, 0); vb[0][1] = pack8(vn0, 1); vb[1][0] = pack8(vn1, 0); vb[1][1] = pack8(vn1, 1);
#pragma unroll
    for (int kt2 = 0; kt2 < 2; ++kt2)
#pragma unroll
        for (int ss = 0; ss < 2; ++ss) { o0 = MFMA32(G2_FRAG(GS_PF + ((0 * 2 + kt2) * 2 + ss) * 1024), vb[kt2][ss], o0); o1 = MFMA32(G2_FRAG(GS_PF + ((1 * 2 + kt2) * 2 + ss) * 1024), vb[kt2][ss], o1); }
    S0 = S0 * dec; S1 = S1 * dec; S2 = S2 * dec; S3 = S3 * dec;
#pragma unroll
    for (int kt2 = 0; kt2 < 2; ++kt2)
#pragma unroll
        for (int ss = 0; ss < 2; ++ss) {
            S0 = MFMA32(G2_FRAG(GS_KF + ((0 * 2 + kt2) * 2 + ss) * 1024), vb[kt2][ss], S0); S1 = MFMA32(G2_FRAG(GS_KF + ((1 * 2 + kt2) * 2 + ss) * 1024), vb[kt2][ss], S1);
            S2 = MFMA32(G2_FRAG(GS_KF + ((2 * 2 + kt2) * 2 + ss) * 1024), vb[kt2][ss], S2); S3 = MFMA32(G2_FRAG(GS_KF + ((3 * 2 + kt2) * 2 + ss) * 1024), vb[kt2][ss], S3); }
    LDS_BARRIER();
#pragma unroll
    for (int e = 0; e < 16; ++e) { const int rr = (e & 3) + 8 * (e >> 2) + 4 * hh;
        *(LAS float*)(Bimg + rr * G2_OSTRIDE + (32 * ws + cc) * 4) = o0[e]; *(LAS float*)(Bimg + (32 + rr) * G2_OSTRIDE + (32 * ws + cc) * 4) = o1[e]; }
    LDS_BARRIER();
}
__device__ __forceinline__ void g2_epi_step(Frame& F, LAS unsigned char* L, const LAS unsigned char* Oimg, const u32x4 (&zz)[4], int row, int seg, size_t m, int h, bool rok, int lane) {
    float ss = 0.f;
#pragma unroll
    for (int q = 0; q < 8; ++q) { const f32x4 ov = *(const LAS f32x4*)(Oimg + row * G2_OSTRIDE + (seg * 32 + 4 * q) * 4); ss += (ov[0] * ov[0] + ov[1] * ov[1]) + (ov[2] * ov[2] + ov[3] * ov[3]); }
    ss += shfl_xor_l(ss, 1, lane); ss += shfl_xor_l(ss, 2, lane);
    const float rn = rsqrtf(ss * (1.f / 128.f) + EPS);
    if (rok) {
        u32x4* yp = (u32x4*)(F.Y1() + m * D + h * 128 + seg * 32);
        const LAS float* hn_s = (const LAS float*)(L + G2_HN);
#pragma unroll
        for (int q = 0; q < 4; ++q) {
            const f32x4 oa = *(const LAS f32x4*)(Oimg + row * G2_OSTRIDE + (seg * 32 + 8 * q) * 4), ob = *(const LAS f32x4*)(Oimg + row * G2_OSTRIDE + (seg * 32 + 8 * q + 4) * 4);
            const f32x4 ha = *(const LAS f32x4*)(hn_s + seg * 32 + 8 * q), hb = *(const LAS f32x4*)(hn_s + seg * 32 + 8 * q + 4);
            u32x4 yo;
            yo[0] = cvt2(oa[0] * rn * ha[0] * siluf_(lo16(zz[q][0])), oa[1] * rn * ha[1] * siluf_(hi16(zz[q][0])));
            yo[1] = cvt2(oa[2] * rn * ha[2] * siluf_(lo16(zz[q][1])), oa[3] * rn * ha[3] * siluf_(hi16(zz[q][1])));
            yo[2] = cvt2(ob[0] * rn * hb[0] * siluf_(lo16(zz[q][2])), ob[1] * rn * hb[1] * siluf_(hi16(zz[q][2])));
            yo[3] = cvt2(ob[2] * rn * hb[2] * siluf_(lo16(zz[q][3])), ob[3] * rn * hb[3] * siluf_(hi16(zz[q][3])));
            yp[q] = yo; }
    }
}
template <int NCH, bool WT>
__device__ __forceinline__ void g2_task(Frame& F, LAS unsigned char* L, const float* DEC, int s, int h, int ch0, int tid, int lane, int wave) {
    const size_t cstep = (size_t)GS_BYTES;
    const int base = seq_base(s), nvalid = s < BP ? 64 : TS;
    const unsigned char* blk0 = F.ws + WS_RB + (size_t)ch0 * GS_BYTES;
    constexpr int lastc = NCH - 1;
    if (wave < 4) {
        const int ws = wave, cc = lane & 31, hh = lane >> 5;
        f32x16 S0, S1, S2, S3;
        if (s < BP) {
#pragma unroll
            for (int e = 0; e < 16; ++e) { S0[e] = 0.f; S1[e] = 0.f; S2[e] = 0.f; S3[e] = 0.f; }
        } else {
            const float* sp = F.in[7] + ((size_t)(s - BP) * 8 + h) * 16384 + 32 * ws + cc;
#pragma unroll
            for (int e = 0; e < 16; ++e) { const int rr = (e & 3) + 8 * (e >> 2) + 4 * hh; S0[e] = sp[(size_t)rr * 128]; S1[e] = sp[(size_t)(32 + rr) * 128]; S2[e] = sp[(size_t)(64 + rr) * 128]; S3[e] = sp[(size_t)(96 + rr) * 128]; }
        }
        const LAS float* dec_s = (const LAS float*)(L + G2_DEC);
        LDS_BARRIER();
        if (NCH == 1) g2_mfma_step(S0, S1, S2, S3, L, dec_s[0], ws, lane, cc, hh);
        else for (int c = 0; c < NCH; c += 2) {
            g2_mfma_step(S0, S1, S2, S3, L, dec_s[c], ws, lane, cc, hh);
            g2_mfma_step(S0, S1, S2, S3, L + G2_FB, dec_s[c + 1], ws, lane, cc, hh);
        }
        int l9 = lane; asm volatile("" : "+v"(l9));
        const int cc9 = l9 & 31, hh9 = l9 >> 5;
        float* so = (s < BP ? F.out + O_GSP + ((size_t)s * 8 + h) * 16384 : F.out + O_GSS + ((size_t)(s - BP) * 8 + h) * 16384) + 32 * ws + cc9;
#pragma unroll
        for (int e = 0; e < 16; ++e) { const int rr = (e & 3) + 8 * (e >> 2) + 4 * hh9; so[(size_t)rr * 128] = S0[e]; so[(size_t)(32 + rr) * 128] = S1[e]; so[(size_t)(64 + rr) * 128] = S2[e]; so[(size_t)(96 + rr) * 128] = S3[e]; }
    } else {
        const int lt = tid - 256;
        if (lt < 128) ((LAS float*)(L + G2_HN))[lt] = F.in[32][lt];
        const brsrc_t srs = staging_rsrc(F.ws);
        const unsigned* ready = (const unsigned*)(F.ws + WS_READY);
        LAS float* dec_w = (LAS float*)(L + G2_DEC);
#define G2_LOAD(pre, dpre, k) do { const int _k = (k) < lastc ? (k) : lastc; g2_load_set<WT>(pre, dpre, blk0 + (size_t)_k * cstep, lt, srs, (unsigned)(ch0 + _k) * (unsigned)GS_BYTES, ready + 16 * (ch0 + _k), DEC + ch0 + _k); } while (0)
        u32x4 preA[18], preB[18]; float dA, dB;
        G2_LOAD(preA, dA, 0);
        G2_LOAD(preB, dB, 1);
        g2_store_set(preA, L, lt); if (lt == 0) dec_w[0] = dA;
        G2_LOAD(preA, dA, 2);
        const int row = lt >> 2, seg = lt & 3; const bool rok = row < nvalid;
        u32x4 zz[4];
        LDS_BARRIER();
        if (NCH == 1) {
            const size_t m = (size_t)base + row;
            if (rok) { const u32x4* zp = (const u32x4*)(F.Z1() + m * D + h * 128 + seg * 32);
#pragma unroll
                for (int q = 0; q < 4; ++q) zz[q] = zp[q]; }
            LDS_BARRIER();
            LDS_BARRIER();
            g2_epi_step(F, L, L, zz, row, seg, m, h, rok, lane);
        } else {
            for (int c = 0; c < NCH; c += 2) {
                {
                    const size_t m = (size_t)base + c * 64 + row;
                    { const u32x4* zp = (const u32x4*)(F.Z1() + m * D + h * 128 + seg * 32);
#pragma unroll
                      for (int q = 0; q < 4; ++q) zz[q] = zp[q]; }
                    g2_store_set(preB, L + G2_FB, lt); if (lt == 0) dec_w[(c + 1) & 63] = dB;
                    G2_LOAD(preB, dB, c + 3);
                    LDS_BARRIER();
                    LDS_BARRIER();
                    g2_epi_step(F, L, L, zz, row, seg, m, h, rok, lane);
                }
                {
                    const size_t m = (size_t)base + (c + 1) * 64 + row;
                    { const u32x4* zp = (const u32x4*)(F.Z1() + m * D + h * 128 + seg * 32);
#pragma unroll
                      for (int q = 0; q < 4; ++q) zz[q] = zp[q]; }
                    g2_store_set(preA, L, lt); if (lt == 0) dec_w[(c + 2) & 63] = dA;
                    G2_LOAD(preA, dA, c + 4);
                    LDS_BARRIER();
                    LDS_BARRIER();
                    g2_epi_step(F, L, L + G2_FB, zz, row, seg, m, h, rok, lane);
                }
            }
        }
    }
}
#undef G2_LOAD
constexpr int G12_CHAINS = 64;
__device__ __forceinline__ void phase_gdn_fused(Frame& F) {
    LAS unsigned char* L = F.lds;
    const float* DEC = (const float*)(F.ws + WS_DEC);
    if ((int)blockIdx.x < G12_CHAINS && F.G > G12_CHAINS) {
        const int tid = opaque_tid(F.wv);
        const int ci = blockIdx.x;
        g2_task<64, true>(F, L, DEC, ci >> 3, ci & 7, ci * 64, tid, tid & 63, F.wv);
    } else {
        const bool all = !(F.G > G12_CHAINS);
        const int p = all ? (int)blockIdx.x : (int)blockIdx.x - G12_CHAINS, np = all ? F.G : F.G - G12_CHAINS;
        gdn_g1_tasks(F, p, np);
        for (int t = p; t < 128; t += np) {
            const int tid = opaque_tid(F.wv);
            __syncthreads();
            g2_task<1, true>(F, L, DEC, BP + (t >> 3), t & 7, 4096 + t, tid, tid & 63, F.wv);
        }
    }
}

__device__ __forceinline__ float dpp_shr_f(float idv, float x, const int o) {
    int r;
    switch (o) {
        case 1: r = __builtin_amdgcn_update_dpp(__float_as_int(idv), __float_as_int(x), 0x111, 0xf, 0xf, false); break;
        case 2: r = __builtin_amdgcn_update_dpp(__float_as_int(idv), __float_as_int(x), 0x112, 0xf, 0xf, false); break;
        case 4: r = __builtin_amdgcn_update_dpp(__float_as_int(idv), __float_as_int(x), 0x114, 0xf, 0xf, false); break;
        default: r = __builtin_amdgcn_update_dpp(__float_as_int(idv), __float_as_int(x), 0x118, 0xf, 0xf, false); break;
    }
    return __int_as_float(r);
}
template <int PASS>
__device__ __forceinline__ void phase_lru(Frame& F) {
    int tid = opaque_tid(F.wv);
    const int lane = tid & 63, wave = __builtin_amdgcn_readfirstlane(tid >> 6);
    const int gw = F.vcu * 8 + wave, NGW = F.G * 8, h = gw & 7, g = lane >> 4, l15 = lane & 15;
    LAS unsigned char* xs = F.lds + wave * 9216;
    LAS float* cst = (LAS float*)(F.lds + 73728 + wave * 768);
    const bf16_t* LGW = (const bf16_t*)(F.ws + WS_LGW);
    float* LAG = F.LAG();
    bf16x8 wfa[4][2], wfx[4][2];
#pragma unroll
    for (int nt = 0; nt < 4; ++nt)
#pragma unroll
        for (int ks = 0; ks < 2; ++ks) {
            wfa[nt][ks] = *(const bf16x8*)(LGW + ((size_t)(h * 2 + 0) * 64 + 16 * nt + l15) * 64 + 32 * ks + 8 * g);
            wfx[nt][ks] = *(const bf16x8*)(LGW + ((size_t)(h * 2 + 1) * 64 + 16 * nt + l15) * 64 + 32 * ks + 8 * g); }
    cst[lane] = F.in[18][h * 64 + lane]; cst[64 + lane] = F.in[20][h * 64 + lane]; cst[128 + lane] = softplusf_(-F.in[21][h * 64 + lane]);
    for (int task = gw; task < 4224; task += NGW) {
        int s, c; if (task < 4096) { s = task >> 9; c = (task >> 3) & 63; } else { s = BP + ((task - 4096) >> 3); c = 0; }
        const int T = seq_len(s), base = seq_base(s), t0 = c * 64, ntile = s < BP ? 4 : 1;
        {
            int l1 = lane; asm volatile("" : "+v"(l1));
            const int cg = l1 & 7, tp = l1 >> 3;
#pragma unroll 1
            for (int hf2 = 0; hf2 < 2; ++hf2) {
                const int chb = h * 64 + cg * 8 + hf2 * 4;
                float xr[11][4];
#pragma unroll
                for (int i = 0; i < 11; ++i) {
                    const int tt = t0 + tp * 8 - 3 + i;
                    if (tt >= 0 && tt < T) { const u32x2 w = *(const u32x2*)(F.U0() + (size_t)(base + tt) * EV_IN + C_XA + chb);
                        xr[i][0] = lo16(w[0]); xr[i][1] = hi16(w[0]); xr[i][2] = lo16(w[1]); xr[i][3] = hi16(w[1]); }
                    else if (tt < 0 && s >= BP) { const f32x4 a = *(const f32x4*)(F.in[2] + ((size_t)(s - BP) * 3 + (tt + 3)) * 512 + chb); xr[i][0] = a[0]; xr[i][1] = a[1]; xr[i][2] = a[2]; xr[i][3] = a[3]; }
                    else { xr[i][0] = 0.f; xr[i][1] = 0.f; xr[i][2] = 0.f; xr[i][3] = 0.f; }
                }
                const f32x4 c0 = *(const f32x4*)(F.in[15] + chb), c1 = *(const f32x4*)(F.in[15] + 512 + chb), c2 = *(const f32x4*)(F.in[15] + 1024 + chb), c3 = *(const f32x4*)(F.in[15] + 1536 + chb), cb = *(const f32x4*)(F.in[16] + chb);
#pragma unroll
                for (int i = 0; i < 8; ++i) { float o[4];
#pragma unroll
                    for (int e = 0; e < 4; ++e) o[e] = c0[e] * xr[i][e] + c1[e] * xr[i + 1][e] + c2[e] * xr[i + 2][e] + c3[e] * xr[i + 3][e] + cb[e];
                    u32x2 w; w[0] = cvt2(o[0], o[1]); w[1] = cvt2(o[2], o[3]);
                    *(LAS u32x2*)(xs + (tp * 8 + i) * 144 + cg * 16 + hf2 * 8) = w; }
                if (PASS == 2 && t0 + 64 >= T && tp == ((T - 1) >> 3) - (t0 >> 3)) {
                    float* o = (s < BP ? F.out + O_LCP + (size_t)s * 3 * 512 : F.out + O_LCS + (size_t)(s - BP) * 3 * 512) + chb;
#pragma unroll
                    for (int q = 0; q < 3; ++q) *(f32x4*)(o + q * 512) = (f32x4){xr[8 + q][0], xr[8 + q][1], xr[8 + q][2], xr[8 + q][3]};
                }
            }
        }
        float hin[4][4], arun[4][4];
#pragma unroll
        for (int nt = 0; nt < 4; ++nt)
#pragma unroll
            for (int rg = 0; rg < 4; ++rg) { hin[nt][rg] = 0.f; arun[nt][rg] = 1.f; }
        if (PASS == 2) {
            float hf = s >= BP ? F.in[3][(s - BP) * 512 + h * 64 + lane] : 0.f;
            const f32x2* lp = (const f32x2*)LAG + (size_t)(s * 64) * 512 + h * 64 + lane;
            for (int j0 = 0; j0 < c; j0 += 16) { f32x2 v[16];
#pragma unroll
                for (int q = 0; q < 16; ++q) { const int jj = j0 + q < c ? j0 + q : c - 1; v[q] = lp[(size_t)jj * 512]; }
#pragma unroll
                for (int q = 0; q < 16; ++q) if (j0 + q < c) hf = v[q][0] * hf + v[q][1]; }
#pragma unroll
            for (int nt = 0; nt < 4; ++nt)
#pragma unroll
                for (int rg = 0; rg < 4; ++rg) hin[nt][rg] = shfl_idx(hf, 16 * nt + 4 * g + rg);
        }
        asm volatile("s_waitcnt lgkmcnt(0)" ::: "memory");
        for (int tt = 0; tt < ntile; ++tt) {
            const int tok = 16 * tt + l15;
            const bf16x8 b0 = *(const LAS bf16x8*)(xs + tok * 144 + (8 * g) * 2), b1 = *(const LAS bf16x8*)(xs + tok * 144 + (32 + 8 * g) * 2);
            const size_t m = (size_t)base + t0 + tok;
#pragma unroll
            for (int nt = 0; nt < 4; ++nt) {
                f32x4 za = {0.f, 0.f, 0.f, 0.f}, zx = {0.f, 0.f, 0.f, 0.f};
                za = MFMA16(wfa[nt][0], b0, za); za = MFMA16(wfa[nt][1], b1, za);
                zx = MFMA16(wfx[nt][0], b0, zx); zx = MFMA16(wfx[nt][1], b1, zx);
                const int n0 = 16 * nt + 4 * g;
                const u32x2 xw = *(const LAS u32x2*)(xs + tok * 144 + n0 * 2);
                const float xc[4] = {lo16(xw[0]), hi16(xw[0]), lo16(xw[1]), hi16(xw[1])};
                const f32x4 cba = *(const LAS f32x4*)(cst + n0), cbx = *(const LAS f32x4*)(cst + 64 + n0), csp = *(const LAS f32x4*)(cst + 128 + n0);
                float av[4], bv[4];
#pragma unroll
                for (int rg = 0; rg < 4; ++rg) {
                    const float r = sigmoidf_(za[rg] + cba[rg]), ig = sigmoidf_(zx[rg] + cbx[rg]), la = -8.0f * r * csp[rg], a = __expf(la);
                    av[rg] = a; bv[rg] = sqrtf(fmaxf(1.0f - a * a, 0.f)) * (ig * xc[rg]); }
#pragma unroll
                for (int o = 1; o < 16; o <<= 1)
#pragma unroll
                    for (int rg = 0; rg < 4; ++rg) { const float ap = dpp_shr_f(1.0f, av[rg], o), bp = dpp_shr_f(0.0f, bv[rg], o); bv[rg] = av[rg] * bp + bv[rg]; av[rg] = av[rg] * ap; }
                float hv[4];
#pragma unroll
                for (int rg = 0; rg < 4; ++rg) { hv[rg] = bv[rg] + av[rg] * hin[nt][rg]; hin[nt][rg] = shfl_idx(hv[rg], (lane & 48) | 15); }
                if (PASS == 1) {
#pragma unroll
                    for (int rg = 0; rg < 4; ++rg) arun[nt][rg] *= shfl_idx(av[rg], (lane & 48) | 15);
                } else {
                    const bool tok_ok = (t0 + tok) < T;
                    if (tok_ok) {
                        const u32x2 gw2 = *(const u32x2*)(F.U0() + m * EV_IN + C_GA + h * 64 + n0);
                        u32x2 yo; yo[0] = cvt2(hv[0] * siluf_(lo16(gw2[0])), hv[1] * siluf_(hi16(gw2[0]))); yo[1] = cvt2(hv[2] * siluf_(lo16(gw2[1])), hv[3] * siluf_(hi16(gw2[1])));
                        *(u32x2*)(F.Y0() + m * D + h * 64 + n0) = yo;
                        if (t0 + tok == T - 1) { float* o = (s < BP ? F.out + O_LHP + s * 512 : F.out + O_LHS + (s - BP) * 512) + h * 64 + n0; *(f32x4*)o = (f32x4){hv[0], hv[1], hv[2], hv[3]}; }
                    }
                }
                if (nt & 1) __builtin_amdgcn_sched_barrier(0);
            }
        }
        if (PASS == 1 && s < BP && l15 == 15) {
            f32x2* lp = (f32x2*)LAG + (size_t)(s * 64 + c) * 512 + h * 64;
#pragma unroll
            for (int nt = 0; nt < 4; ++nt)
#pragma unroll
                for (int rg = 0; rg < 4; ++rg) lp[16 * nt + 4 * g + rg] = (f32x2){arun[nt][rg], hin[nt][rg]};
        }
        asm volatile("s_waitcnt lgkmcnt(0)" ::: "memory");
    }
}

constexpr size_t RB_VTP = RB_WEND, RB_VTS = RB_VTP + (size_t)BP * 2 * 64 * TP * 2, RB_VTEND = RB_VTS + (size_t)BS * 2 * 64 * 192 * 2;
static_assert(RB_VTEND <= RB_BYTES, "ws map");
__device__ __forceinline__ void phase_vt_build(Frame& F) {
    PHASE_IDS();
    const int gw = F.vcu * 8 + wave, NGW = F.G * 8;
    LAS unsigned char* xs = F.lds + wave * 9216;
    bf16_t* VTP = (bf16_t*)(F.ws + WS_RB + RB_VTP); bf16_t* VTS = (bf16_t*)(F.ws + WS_RB + RB_VTS);
    for (int task = gw; task < 1024 + 96; task += NGW) {
        int s, kv, kb; if (task < 1024) { s = task >> 7; kv = (task >> 6) & 1; kb = task & 63; } else { const int r = task - 1024; s = BP + r / 6; kv = (r % 6) / 3; kb = r % 3; }
        const int row8 = lane >> 3, ch = lane & 7;
#pragma unroll
        for (int i = 0; i < 8; ++i) {
            const int key = 8 * i + row8, kg = kb * 64 + key; u32x4 w = {0u, 0u, 0u, 0u};
            if (s < BP) w = *(const u32x4*)(F.U0() + (size_t)(s * TP + kg) * EV_IN + C_V + kv * 64 + ch * 8);
            else if (kg < 128) { const f32x4* p = (const f32x4*)(F.in[5] + ((size_t)((s - BP) * 128 + kg) * 2 + kv) * 64 + ch * 8); const f32x4 a = p[0], b = p[1]; w[0] = cvt2(a[0], a[1]); w[1] = cvt2(a[2], a[3]); w[2] = cvt2(b[0], b[1]); w[3] = cvt2(b[2], b[3]); }
            else if (kg < 128 + TS) w = *(const u32x4*)(F.U0() + (size_t)(MP + (s - BP) * TS + (kg - 128)) * EV_IN + C_V + kv * 64 + ch * 8);
            *(LAS u32x4*)(xs + key * 144 + ch * 16) = w;
        }
        asm volatile("s_waitcnt lgkmcnt(0)" ::: "memory");
        bf16_t* dst = s < BP ? VTP + ((size_t)(s * 2 + kv) * 64 + lane) * TP + kb * 64 : VTS + ((size_t)((s - BP) * 2 + kv) * 64 + lane) * 192 + kb * 64;
#pragma unroll
        for (int q = 0; q < 8; ++q) { u32x4 o;
#pragma unroll
            for (int e = 0; e < 4; ++e) { const unsigned lo = *(const LAS bf16_t*)(xs + (8 * q + 2 * e) * 144 + lane * 2), hi = *(const LAS bf16_t*)(xs + (8 * q + 2 * e + 1) * 144 + lane * 2); o[e] = lo | (hi << 16); }
            *(u32x4*)(dst + 8 * q) = o; }
        asm volatile("s_waitcnt lgkmcnt(0)" ::: "memory");
    }
}
constexpr int AT_K = 0, AT_V = 27648;
__device__ __forceinline__ void attn_issue(Frame& F, const bf16_t* VTP, int task, int tid, int wave, int lane, u32x4 (&kreg)[3], u32x4 (&vreg)[3], u32x4 (&qreg)[4]) {
    const int s = task >> 7, c = (task >> 1) & 63, kv = task & 1, tok0 = c * 64 - 128;
#pragma unroll
    for (int i = 0; i < 3; ++i) { const int idx = tid + 512 * i, key = idx >> 3, ch = idx & 7; int tk = tok0 + key; tk = tk < 0 ? 0 : tk;
        kreg[i] = *(const u32x4*)(F.U0() + (size_t)(s * TP + tk) * EV_IN + C_K + kv * 64 + ch * 8); }
#pragma unroll
    for (int i = 0; i < 3; ++i) { const int idx = tid + 512 * i, d = idx / 24, ch = idx % 24; int tk = tok0 + ch * 8; tk = tk < 0 ? 0 : tk;
        vreg[i] = *(const u32x4*)(VTP + ((size_t)(s * 2 + kv) * 64 + d) * TP + tk); }
    const int g = wave >> 1, qh = wave & 1, hq = kv * 4 + g, r = lane & 31, hh = lane >> 5;
    const size_t m = (size_t)s * TP + c * 64 + qh * 32 + r;
#pragma unroll
    for (int ks = 0; ks < 4; ++ks) qreg[ks] = *(const u32x4*)(F.U0() + m * EV_IN + C_Q + hq * 64 + 16 * ks + 8 * hh);
}
__device__ __forceinline__ void phase_attn(Frame& F) {
    PHASE_IDS();
    LAS unsigned char* L = F.lds;
    const bf16_t* VTP = (const bf16_t*)(F.ws + WS_RB + RB_VTP); const bf16_t* VTS = (const bf16_t*)(F.ws + WS_RB + RB_VTS);
    u32x4 kreg[3], vreg[3], qreg[4];
    attn_issue(F, VTP, F.vcu < 1024 ? F.vcu : 0, tid, wave, lane, kreg, vreg, qreg);
    for (int ti = F.vcu; ti < 1024 + 64; ti += F.G) {
        if (ti >= 1024 && ti < 1056) continue;
        const int task = ti < 1024 ? ti : ti - 32;
        int s, c, kv; if (task < 1024) { s = task >> 7; c = (task >> 1) & 63; kv = task & 1; } else { s = BP + ((task - 1024) >> 1); c = 0; kv = task & 1; }
        const int base = seq_base(s), tok0 = c * 64 - 128;
        const int kmin = s < BP ? (tok0 < 0 ? -tok0 : 0) : 0, kmax = s < BP ? 192 : 128 + TS;
        const int tid = opaque_tid(F.wv), lane = tid & 63;
        const int g = wave >> 1, qh = wave & 1, hq = kv * 4 + g, r = lane & 31, hh = lane >> 5, qi = qh * 32 + r;
        const bool qok = s < BP ? true : qi < TS;
        const size_t m = (size_t)base + c * 64 + (qok ? qi : 0);
        bf16x8 qf[4]; u32x2 gbr[8];
        LDS_BARRIER();
        if (s < BP) {
#pragma unroll
            for (int i = 0; i < 3; ++i) { const int idx = tid + 512 * i, key = idx >> 3, ch = idx & 7; const u32x4 z = {0u, 0u, 0u, 0u}; *(LAS u32x4*)(L + AT_K + key * 144 + ch * 16) = key >= kmin ? kreg[i] : z; }
#pragma unroll
            for (int i = 0; i < 3; ++i) { const int idx = tid + 512 * i, d = idx / 24, ch = idx % 24; const u32x4 z = {0u, 0u, 0u, 0u}; *(LAS u32x4*)(L + AT_V + d * 400 + ch * 16) = ch * 8 >= kmin ? vreg[i] : z; }
#pragma unroll
            for (int ks = 0; ks < 4; ++ks) { u32x4 w;
#pragma unroll
                for (int e = 0; e < 4; ++e) w[e] = cvt2(lo16(qreg[ks][e]) * 0.125f, hi16(qreg[ks][e]) * 0.125f);
                qf[ks] = __builtin_bit_cast(bf16x8, w); }
        } else {
#pragma unroll
            for (int i = 0; i < 3; ++i) {
                const int idx = tid + 512 * i, key = idx >> 3, ch = idx & 7; u32x4 w = {0u, 0u, 0u, 0u};
                if (key < kmax) {
                    if (key < 128) { const f32x4* p = (const f32x4*)(F.in[4] + ((size_t)((s - BP) * 128 + key) * 2 + kv) * 64 + ch * 8); const f32x4 a = p[0], b2 = p[1]; w[0] = cvt2(a[0], a[1]); w[1] = cvt2(a[2], a[3]); w[2] = cvt2(b2[0], b2[1]); w[3] = cvt2(b2[2], b2[3]); }
                    else w = *(const u32x4*)(F.U0() + (size_t)(base + key - 128) * EV_IN + C_K + kv * 64 + ch * 8);
                }
                *(LAS u32x4*)(L + AT_K + key * 144 + ch * 16) = w;
            }
#pragma unroll
            for (int i = 0; i < 3; ++i) {
                const int idx = tid + 512 * i, d = idx / 24, ch = idx % 24, key = ch * 8;
                *(LAS u32x4*)(L + AT_V + d * 400 + ch * 16) = *(const u32x4*)(VTS + ((size_t)((s - BP) * 2 + kv) * 64 + d) * 192 + key);
            }
#pragma unroll
            for (int ks = 0; ks < 4; ++ks) { u32x4 w = {0u, 0u, 0u, 0u};
                if (qok) { const u32x4 x = *(const u32x4*)(F.U0() + m * EV_IN + C_Q + hq * 64 + 16 * ks + 8 * hh);
#pragma unroll
                    for (int e = 0; e < 4; ++e) w[e] = cvt2(lo16(x[e]) * 0.125f, hi16(x[e]) * 0.125f); }
                qf[ks] = __builtin_bit_cast(bf16x8, w); }
        }
#pragma unroll
        for (int qq = 0; qq < 4; ++qq) { gbr[2 * qq] = qok ? *(const u32x2*)(F.U0() + m * EV_IN + C_GB + hq * 64 + 8 * qq + 4 * hh) : (u32x2){0u, 0u}; gbr[2 * qq + 1] = qok ? *(const u32x2*)(F.U0() + m * EV_IN + C_GB + hq * 64 + 32 + 8 * qq + 4 * hh) : (u32x2){0u, 0u}; }
        { const int nt = ti + F.G < 1024 ? ti + F.G : (ti < 1024 ? ti : 0); int t9 = tid; asm volatile("" : "+v"(t9)); attn_issue(F, VTP, nt, t9, wave, t9 & 63, kreg, vreg, qreg); }
        const float sink = F.in[22][hq];
        LDS_BARRIER();
        float mrun = sink, lrun = 1.0f;
        f32x16 o0, o1;
#pragma unroll
        for (int e = 0; e < 16; ++e) { o0[e] = 0.f; o1[e] = 0.f; }
#pragma unroll 1
        for (int half = 0; half < 2; ++half) {
            f32x16 sc[3];
#pragma unroll
            for (int k3 = 0; k3 < 3; ++k3) {
                const int kt = 3 * half + k3;
#pragma unroll
                for (int e = 0; e < 16; ++e) sc[k3][e] = 0.f;
#pragma unroll
                for (int ks = 0; ks < 4; ++ks) { const bf16x8 kf = *(const LAS bf16x8*)(L + AT_K + (32 * kt + r) * 144 + (16 * ks + 8 * hh) * 2); sc[k3] = MFMA32(kf, qf[ks], sc[k3]); }
            }
            float mx = -1e30f;
#pragma unroll
            for (int k3 = 0; k3 < 3; ++k3)
#pragma unroll
                for (int e = 0; e < 16; ++e) { const int kidx = 32 * (3 * half + k3) + (e & 3) + 8 * (e >> 2) + 4 * hh; const bool ok = kidx >= kmin && kidx < kmax; sc[k3][e] = ok ? sc[k3][e] : -1e30f; mx = fmaxf(mx, sc[k3][e]); }
            mx = fmaxf(mx, shfl_xor_l(mx, 32, lane));
            const float mnew = fmaxf(mrun, mx), alpha = __expf(mrun - mnew);
            float psum = 0.f;
#pragma unroll
            for (int k3 = 0; k3 < 3; ++k3)
#pragma unroll
                for (int e = 0; e < 16; ++e) { const float p = __expf(sc[k3][e] - mnew); sc[k3][e] = p; psum += p; }
            psum += shfl_xor_l(psum, 32, lane);
            lrun = lrun * alpha + psum; mrun = mnew;
            o0 = o0 * alpha; o1 = o1 * alpha;
#pragma unroll
            for (int k3 = 0; k3 < 3; ++k3)
#pragma unroll
                for (int ss = 0; ss < 2; ++ss) {
                    const int kt = 3 * half + k3;
                    const bf16x8 pb = pack8(sc[k3], ss);
                    const LAS unsigned char* vp = L + AT_V + r * 400 + (32 * kt + 16 * ss + 4 * hh) * 2;
                    const u32x2 a0 = *(const LAS u32x2*)vp, a1 = *(const LAS u32x2*)(vp + 16), b0 = *(const LAS u32x2*)(vp + 32 * 400), b1 = *(const LAS u32x2*)(vp + 32 * 400 + 16);
                    const u32x4 va = {a0[0], a0[1], a1[0], a1[1]}, vb = {b0[0], b0[1], b1[0], b1[1]};
                    o0 = MFMA32(__builtin_bit_cast(bf16x8, va), pb, o0); o1 = MFMA32(__builtin_bit_cast(bf16x8, vb), pb, o1);
                }
        }
        const float il = __builtin_amdgcn_rcpf(lrun);
        if (qok) {
#pragma unroll
            for (int qq = 0; qq < 4; ++qq) {
                { const int d = 8 * qq + 4 * hh; const u32x2 gb = gbr[2 * qq];
                  u32x2 yo; yo[0] = cvt2(o0[4 * qq] * il * siluf_(lo16(gb[0])), o0[4 * qq + 1] * il * siluf_(hi16(gb[0]))); yo[1] = cvt2(o0[4 * qq + 2] * il * siluf_(lo16(gb[1])), o0[4 * qq + 3] * il * siluf_(hi16(gb[1])));
                  *(u32x2*)(F.Y0() + m * D + 512 + hq * 64 + d) = yo; }
                { const int d = 32 + 8 * qq + 4 * hh; const u32x2 gb = gbr[2 * qq + 1];
                  u32x2 yo; yo[0] = cvt2(o1[4 * qq] * il * siluf_(lo16(gb[0])), o1[4 * qq + 1] * il * siluf_(hi16(gb[0]))); yo[1] = cvt2(o1[4 * qq + 2] * il * siluf_(lo16(gb[1])), o1[4 * qq + 3] * il * siluf_(hi16(gb[1])));
                  *(u32x2*)(F.Y0() + m * D + 512 + hq * 64 + d) = yo; }
            }
        }
    }
    __syncthreads();
}

__device__ __forceinline__ void rows_final(Frame& F, const int m0, const int n, const int s, const int lane) {
    const float* MODP = (const float*)(F.ws + WS_MODP);
    f32x4 A1[4];
#pragma unroll
    for (int j = 0; j < 4; ++j) { const int c = 4 * lane + 256 * j; const f32x4 g = *(const f32x4*)(F.in[27] + c), gt = mod4(MODP, 1, s, 2048 + c);
#pragma unroll
        for (int e = 0; e < 4; ++e) A1[j][e] = gt[e] * g[e]; }
    u32x2 ycur[4]; f32x4 xcur[4];
#pragma unroll
    for (int j = 0; j < 4; ++j) { ycur[j] = *(const u32x2*)(F.YO() + (size_t)m0 * D + 4 * lane + 256 * j); xcur[j] = *(const f32x4*)(F.out + O_Y + (size_t)m0 * D + 4 * lane + 256 * j); }
    for (int i = 0; i < n; ++i) {
        const int m = m0 + i, mn = m0 + (i + 1 < n ? i + 1 : i); u32x2 ynxt[4]; f32x4 xnxt[4];
#pragma unroll
        for (int j = 0; j < 4; ++j) { ynxt[j] = *(const u32x2*)(F.YO() + (size_t)mn * D + 4 * lane + 256 * j); xnxt[j] = *(const f32x4*)(F.out + O_Y + (size_t)mn * D + 4 * lane + 256 * j); }
        f32x4 y[4]; float ss = 0.f;
#pragma unroll
        for (int j = 0; j < 4; ++j) { y[j] = (f32x4){lo16(ycur[j][0]), hi16(ycur[j][0]), lo16(ycur[j][1]), hi16(ycur[j][1])}; ss += (y[j][0] * y[j][0] + y[j][1] * y[j][1]) + (y[j][2] * y[j][2] + y[j][3] * y[j][3]); }
        const float r1 = rsqrtf(wave_sum(ss, lane) * (1.f / D) + EPS);
#pragma unroll
        for (int j = 0; j < 4; ++j) { f32x4 o;
#pragma unroll
            for (int e = 0; e < 4; ++e) o[e] = xcur[j][e] + A1[j][e] * (y[j][e] * r1);
            *(f32x4*)(F.out + O_Y + (size_t)m * D + 4 * lane + 256 * j) = o; }
#pragma unroll
        for (int j = 0; j < 4; ++j) { ycur[j] = ynxt[j]; xcur[j] = xnxt[j]; }
    }
}
__device__ __forceinline__ void phase_final_rowwise(Frame& F) {
    PHASE_IDS();
    const int gw = F.vcu * 8 + wave, NGW = F.G * 8;
    for (int w = gw; w < MP / 16; w += NGW) rows_final(F, w * 16, 16, w >> 8, lane);
    for (int w = gw; w < MS; w += NGW) rows_final(F, MP + w, 1, BP + (w >> 4), lane);
}

__global__ void __launch_bounds__(512, 2) fwd_megakernel(Params P) {
    extern __shared__ __attribute__((aligned(16))) unsigned char lds_raw[];
    Frame F;
    F.lds = (LAS unsigned char*)lds_raw;
    F.wv = __builtin_amdgcn_readfirstlane(threadIdx.x >> 6);
    F.G = gridDim.x; { const int bx = blockIdx.x; F.vcu = (F.G % 8 == 0) ? (bx % 8) * (F.G / 8) + bx / 8 : bx; }
    F.in = P.in; F.out = P.out; F.ws = P.ws;

    volatile LAS unsigned* misc = (volatile LAS unsigned*)(F.lds + LDS_BYTES - 64);
    if (threadIdx.x < 16) misc[threadIdx.x] = 0u;
    __syncthreads();
    XcdBarrier xbar = xcd_barrier_post((unsigned*)(P.ws + WS_CTL), misc);
#define GRID_BAR() xcd_barrier(xbar, F.wv)
    phase_mod0(F);
    GRID_BAR();
    phase_prologue(F);
    phase_mod1(F);
    phase_prenorm0(F);
    GRID_BAR();
    { pg8::Gemm g{F.XN(), F.W0I(), MT, EV_IN, D}; pg8::StaticOrder S; S.init(MT, EV_IN, F.G, (int)blockIdx.x);
      pg8::EpiBf16 E{F.U0(), EV_IN, 1 << 30, F.U0(), EV_IN}; pg8::gemm_phase(F.lds, g, S, E, F.wv); }
    GRID_BAR();
    phase_rope(F);
    phase_lru<1>(F);
    phase_vt_build(F);
    GRID_BAR();
    phase_lru<2>(F);
    phase_attn(F);
    GRID_BAR();
    { pg8::Gemm g{F.Y0(), F.W0O(), MT, D, D}; pg8::StaticOrder S; S.init(MT, D, F.G, (int)blockIdx.x);
      pg8::EpiBf16 E{F.YO(), D, 1 << 30, F.YO(), D}; pg8::gemm_phase(F.lds, g, S, E, F.wv); }
    GRID_BAR();
    phase_mid_rowwise(F);
    GRID_BAR();
    { pg8::Gemm g{F.XN(), F.W1I(), MT, OD_MAIN, D}; pg8::StaticOrder S; S.init(MT, OD_MAIN, F.G, (int)blockIdx.x);
      pg8::EpiBf16 E{F.QKV1(), 3072, 3072, F.Z1(), D}; pg8::gemm_phase(F.lds, g, S, E, F.wv); }
    GRID_BAR();
    phase_gdn_fused(F);
    GRID_BAR();
    { pg8::Gemm g{F.Y1(), F.W1O(), MT, D, D}; pg8::StaticOrder S; S.init(MT, D, F.G, (int)blockIdx.x);
      pg8::EpiBf16 E{F.YO(), D, 1 << 30, F.YO(), D}; pg8::gemm_phase(F.lds, g, S, E, F.wv); }
    GRID_BAR();
    phase_final_rowwise(F);
}

extern "C" void kernel_launch(void* const* d_in, const int* in_sizes, int n_in, void* d_out, int out_size, void* d_ws, size_t ws_size, hipStream_t stream) {
    static int grid = 0;
    if (grid == 0) {
        if (n_in != 34 || out_size != (int)O_END || ws_size < WS_END) { grid = -1; return; }
        int dev = 0, cus = 0, per_cu = 0;
        if (hipGetDevice(&dev) != hipSuccess || hipDeviceGetAttribute(&cus, hipDeviceAttributeMultiprocessorCount, dev) != hipSuccess) { grid = -1; return; }
        if (hipFuncSetAttribute((const void*)fwd_megakernel, hipFuncAttributeMaxDynamicSharedMemorySize, LDS_BYTES) != hipSuccess) { grid = -1; return; }
        if (hipOccupancyMaxActiveBlocksPerMultiprocessor(&per_cu, (const void*)fwd_megakernel, 512, LDS_BYTES) != hipSuccess || per_cu < 1) { grid = -1; return; }
        grid = cus;
    }
    if (grid < 0) return;
    if (hipMemsetAsync((char*)d_ws + WS_CTL, 0, 65536 + 4224 * 64, stream) != hipSuccess) return;
    Params p{};
    for (int i = 0; i < 34; ++i) p.in[i] = (const float*)d_in[i];
    p.out = (float*)d_out; p.ws = (unsigned char*)d_ws;
    void* args[] = {&p};
    (void)hipLaunchCooperativeKernel((const void*)fwd_megakernel, dim3(grid), dim3(512), args, LDS_BYTES, stream);
}
```

```cpp
#include <hip/hip_runtime.h>
#include <hip/hip_cooperative_groups.h>
namespace cg = cooperative_groups;

#define LAS __attribute__((address_space(3)))
typedef unsigned short bf16_t;
typedef short bf16x8 __attribute__((ext_vector_type(8)));
typedef float f32x4 __attribute__((ext_vector_type(4)));
typedef float f32x2 __attribute__((ext_vector_type(2)));
typedef unsigned u32x4 __attribute__((ext_vector_type(4)));
typedef unsigned u32x2 __attribute__((ext_vector_type(2)));

constexpr int D = 1024, BP = 8, TP = 4096, BS = 16, TS = 16;
constexpr int MP = BP * TP, MS = BS * TS, MT = MP + MS;
constexpr int NSEQ = BP + BS;
constexpr int EV_IN = 2304, OD_IN = 4112, OD_MAIN = 4096;
constexpr int C_XA = 0, C_GA = 512, C_Q = 1024, C_K = 1536, C_V = 1664, C_GB = 1792;
constexpr float EPS = 1e-6f;
constexpr size_t O_Y = 0, O_LCP = 33816576, O_LCS = 33828864, O_LHP = 33853440, O_LHS = 33857536, O_KP = 33865728, O_KS = 33996800,
                 O_VP = 34029568, O_VS = 34160640, O_GCP = 34193408, O_GCS = 34267136, O_GSP = 34414592, O_GSS = 35463168, O_END = 37560320;
constexpr size_t MiB = 1u << 20;
constexpr size_t WS_CTL = 0, WS_W1O = 1 * MiB, WS_MOD = 3 * MiB, WS_ROPE = 4 * MiB, WS_BA = 5 * MiB, WS_LAG = 8 * MiB, WS_LGW = 10 * MiB;
constexpr size_t WS_RA = 16 * MiB, RA_BYTES = (size_t)MT * 4096 * 2;
constexpr size_t WS_RB = WS_RA + RA_BYTES;
constexpr size_t ACT_BYTES = (size_t)MT * D * 2;
constexpr size_t RB_XN = 0, RB_Y0 = ACT_BYTES, RB_YO = 2 * ACT_BYTES, RB_W0I = 3 * ACT_BYTES, RB_W0O = RB_W0I + (size_t)EV_IN * D * 2,
                 RB_W1I = RB_W0O + (size_t)D * D * 2, RB_WEND = RB_W1I + (size_t)OD_MAIN * D * 2;
constexpr size_t RB_BYTES = (size_t)4224 * 73728;
constexpr size_t WS_END = WS_RB + RB_BYTES;
static_assert(RB_WEND <= RB_BYTES, "ws map");
static_assert((size_t)MT * 3072 * 2 <= RB_BYTES, "ws map");
constexpr int LDS_BYTES = 155648;

struct Params { const float* in[34]; float* out; unsigned char* ws; };

__device__ __forceinline__ float bf2f(bf16_t b) { return __uint_as_float(((unsigned)b) << 16); }
__device__ __forceinline__ unsigned f2bf(float f) { unsigned u = __float_as_uint(f); return (u + 0x7fffu + ((u >> 16) & 1u)) >> 16; }
__device__ __forceinline__ unsigned pk2(float lo, float hi) { return f2bf(lo) | (f2bf(hi) << 16); }
typedef __bf16 bf16x2_t __attribute__((ext_vector_type(2)));
__device__ __forceinline__ unsigned cvt2(float a, float b) { f32x2 v = {a, b}; bf16x2_t r = __builtin_convertvector(v, bf16x2_t); return __builtin_bit_cast(unsigned, r); }
__device__ __forceinline__ float lo16(unsigned w) { return __uint_as_float(w << 16); }
__device__ __forceinline__ float hi16(unsigned w) { return __uint_as_float(w & 0xffff0000u); }
__device__ __forceinline__ float shfl_idx(float x, int src_lane) { return __int_as_float(__builtin_amdgcn_ds_bpermute(src_lane << 2, __float_as_int(x))); }
__device__ __forceinline__ float shfl_xor_l(float x, int o, int lane) { return shfl_idx(x, lane ^ o); }
__device__ __forceinline__ float wave_sum(float v, int lane) {
#pragma unroll
    for (int o = 1; o < 64; o <<= 1) v += shfl_xor_l(v, o, lane);
    return v;
}
__device__ __forceinline__ float sigmoidf_(float x) { return __builtin_amdgcn_rcpf(1.0f + __expf(-x)); }
__device__ __forceinline__ float siluf_(float x) { return x * __builtin_amdgcn_rcpf(1.0f + __expf(-x)); }
__device__ __forceinline__ float softplusf_(float x) { return x > 20.f ? x : log1pf(__expf(x)); }
__device__ __forceinline__ int seq_base(int s) { return s < BP ? s * TP : MP + (s - BP) * TS; }
__device__ __forceinline__ int seq_len(int s) { return s < BP ? TP : TS; }
__device__ __forceinline__ void tok_info(int m, int& s, int& t) { if (m < MP) { s = m >> 12; t = m & 4095; } else { const int r = m - MP; s = BP + (r >> 4); t = r & 15; } }

__device__ __forceinline__ int opaque_tid(int wv) { unsigned z = 0u; asm volatile("" : "+v"(z)); const int l = __builtin_amdgcn_mbcnt_hi(~0u, __builtin_amdgcn_mbcnt_lo(~0u, z)); return wv * 64 + l; }
namespace pg8 {
constexpr int BM = 256, BK = 64, HALF = 128, HTB = HALF * BK * 2, STAGE_BYTES = 8 * HTB, NXCD = 8, WGM = 8;
__host__ __device__ __forceinline__ int lds_byte(int r, int c) { const int st = (r >> 4) * 2 + (c >> 5), rr = r & 15, cc = c & 31, ob = rr * 64 + cc * 2; return st * 1024 + (ob ^ (((ob >> 9) & 1) << 5)); }
__host__ __device__ __forceinline__ void stage_rc(int b, int& R, int& C) { const int st = b / 1024, sb = b % 1024, swz = sb ^ (((sb >> 9) & 1) << 5); R = (st >> 1) * 16 + swz / 64; C = (st & 1) * 32 + (swz % 64) / 2; }
__host__ __device__ __forceinline__ int perm32(int rho) { const int n = rho >> 4, i = rho & 15; return 8 * (i >> 2) + 4 * n + (i & 3); }
struct Unit { int pm, pn; };
struct Gemm { const bf16_t* A; const bf16_t* Bt; int M, N, K; };
struct StaticOrder {
    int nM, nN, nwg, G, c;
    __device__ void init(int M, int N, int G_, int c_) { nM = M / BM; nN = N / BM; nwg = nM * nN; G = G_; c = c_; }
    __device__ bool next(int i, Unit& u) const {
        const long L = (long)i * G + c; if (L >= nwg) return false;
        int wgid = (int)L; { const int q = nwg / NXCD, r = nwg % NXCD, xcd = wgid % NXCD, off = wgid / NXCD; wgid = (xcd < r ? xcd * (q + 1) : r * (q + 1) + (xcd - r) * q) + off; }
        const int nig = WGM * nN, gid = wgid / nig, fm = gid * WGM, gsz = (nM - fm) < WGM ? (nM - fm) : WGM;
        u.pm = fm + ((wgid % nig) % gsz); u.pn = (wgid % nig) / gsz; return true;
    }
};
__device__ __forceinline__ unsigned cvt_pk_bf16(float lo, float hi) { unsigned r; asm volatile("v_cvt_pk_bf16_f32 %0, %1, %2" : "=v"(r) : "v"(lo), "v"(hi)); return r; }
struct EpiBf16 {
    static constexpr bool PERM = true;
    bf16_t* O0; int ld0; int split; bf16_t* O1; int ld1;
    __device__ __forceinline__ void operator()(const f32x4 (&acc)[2][2][4][2], const Unit& u, int wr, int wc, int fr, int fq) const {
        const int row0 = u.pm * BM + wr * 64 + fr; int colt = u.pn * BM; bf16_t* base = O0; int ld = ld0;
        if (colt >= split) { base = O1; ld = ld1; colt -= split; }
        const int col0 = colt + wc * 32 + 8 * fq;
#pragma unroll
        for (int ai = 0; ai < 2; ++ai)
#pragma unroll
            for (int m = 0; m < 4; ++m) { bf16_t* rowp = base + (size_t)(row0 + ai * HALF + m * 16) * ld + col0;
#pragma unroll
                for (int bj = 0; bj < 2; ++bj) { const f32x4 v0 = acc[ai][bj][m][0], v1 = acc[ai][bj][m][1];
                    u32x4 w; w.x = cvt_pk_bf16(v0[0], v0[1]); w.y = cvt_pk_bf16(v0[2], v0[3]); w.z = cvt_pk_bf16(v1[0], v1[1]); w.w = cvt_pk_bf16(v1[2], v1[3]);
                    *(u32x4*)(rowp + bj * HALF) = w; } }
    }
};
template <class Epi, class Sched>
__device__ __forceinline__ void gemm_phase(LAS unsigned char* lds, const Gemm g, const Sched& S, const Epi& E, const int wv0) {
    int tid = opaque_tid(wv0);
    const int wid = __builtin_amdgcn_readfirstlane(tid >> 6), lane = tid & 63, wr = wid >> 2, wc = wid & 3, fr = lane & 15, fq = lane >> 4;
    const int K = g.K, nt = K / BK;
    unsigned voffA[2], voffB[2];
#pragma unroll
    for (int i = 0; i < 2; ++i) { int R, C; stage_rc(tid * 16 + i * 8192, R, C); const int Rb = Epi::PERM ? ((R & ~31) + perm32(R & 31)) : R;
        voffA[i] = (unsigned)(R * K + C) * 2u; voffB[i] = (unsigned)(Rb * K + C) * 2u; }
    const size_t kstep = (size_t)(BK * 2);
    const size_t hstep = (size_t)HALF * K * 2;
    const size_t tstep = 2 * hstep;
    const unsigned ldsw = (unsigned)wid * 1024u;
    const int aoff = lds_byte(wr * 64 + fr, fq * 8), boff = lds_byte(wc * 32 + fr, fq * 8);
#define PG8_SA(b, h) (((b) * 2 + (h)) * HTB)
#define PG8_SB(b, h) ((4 + (b) * 2 + (h)) * HTB)
#define PG8_STAGE(bufoff, gbase, voff) do { _Pragma("unroll") for (int _i = 0; _i < 2; ++_i) \
        __builtin_amdgcn_global_load_lds((const unsigned*)((const char*)(gbase) + (voff)[_i]), (LAS unsigned*)(lds + (bufoff) + ldsw + _i * 8192), 16, 0, 0); } while (0)
#define PG8_LDA(dst, b, h) do { _Pragma("unroll") for (int m = 0; m < 4; ++m) _Pragma("unroll") for (int k = 0; k < 2; ++k) dst[m][k] = *(const LAS bf16x8*)(lds + PG8_SA(b, h) + aoff + m * 2048 + k * 1024); } while (0)
#define PG8_LDB(dst, b, h) do { _Pragma("unroll") for (int n = 0; n < 2; ++n) _Pragma("unroll") for (int k = 0; k < 2; ++k) dst[n][k] = *(const LAS bf16x8*)(lds + PG8_SB(b, h) + boff + n * 2048 + k * 1024); } while (0)
#define PG8_MMA(ai, bj, At, Bt) do { __builtin_amdgcn_s_setprio(1); _Pragma("unroll") for (int m = 0; m < 4; ++m) _Pragma("unroll") for (int n = 0; n < 2; ++n) _Pragma("unroll") for (int k = 0; k < 2; ++k) \
        acc[ai][bj][m][n] = __builtin_amdgcn_mfma_f32_16x16x32_bf16(Bt[n][k], At[m][k], acc[ai][bj][m][n], 0, 0, 0); __builtin_amdgcn_s_setprio(0); } while (0)
#define PG8_WAIT_V(n) asm volatile("s_waitcnt vmcnt(" #n ")" ::: "memory")
#define PG8_WAIT_L(n) asm volatile("s_waitcnt lgkmcnt(" #n ")" ::: "memory")
#define PG8_BAR __builtin_amdgcn_s_barrier()
#define PG8_SCHED __builtin_amdgcn_sched_barrier(0)
    Unit cur, nxt; int ui = 0;
    if (!S.next(0, cur)) return;
    f32x4 acc[2][2][4][2];
#pragma unroll
    for (int a = 0; a < 2; ++a)
#pragma unroll
        for (int b = 0; b < 2; ++b)
#pragma unroll
            for (int m = 0; m < 4; ++m)
#pragma unroll
                for (int n = 0; n < 2; ++n) acc[a][b][m][n] = (f32x4){0.f, 0.f, 0.f, 0.f};
    bf16x8 At[4][2], B0[2][2], B1[2][2];
    const char* cA = (const char*)g.A + (size_t)cur.pm * tstep; const char* cB = (const char*)g.Bt + (size_t)cur.pn * tstep;
    PG8_STAGE(PG8_SB(0, 0), cB, voffB); PG8_STAGE(PG8_SA(0, 0), cA, voffA); PG8_STAGE(PG8_SB(0, 1), cB + hstep, voffB); PG8_STAGE(PG8_SA(0, 1), cA + hstep, voffA);
    if (wr == 1) PG8_BAR;
    PG8_WAIT_V(4); PG8_BAR;
    PG8_STAGE(PG8_SB(1, 0), cB + kstep, voffB); PG8_STAGE(PG8_SA(1, 0), cA + kstep, voffA); PG8_STAGE(PG8_SB(1, 1), cB + hstep + kstep, voffB);
    PG8_WAIT_V(6); PG8_BAR;
    for (;;) {
        const bool has_next = S.next(ui + 1, nxt);
        const char* nA = has_next ? (const char*)g.A + (size_t)nxt.pm * tstep : cA; const char* nB = has_next ? (const char*)g.Bt + (size_t)nxt.pn * tstep : cB;
        for (int t = 0; t < nt; t += 2) {
            const bool last = (t == nt - 2);
            const char* a1 = cA + (size_t)(t + 1) * kstep;
            const char* a2 = last ? nA : cA + (size_t)(t + 2) * kstep; const char* b2 = last ? nB : cB + (size_t)(t + 2) * kstep;
            const char* a3 = a2 + kstep; const char* b3 = b2 + kstep;
            PG8_LDB(B0, 0, 0); PG8_SCHED; PG8_LDA(At, 0, 0); PG8_STAGE(PG8_SA(1, 1), a1 + hstep, voffA);
            PG8_WAIT_L(8); PG8_BAR; PG8_WAIT_L(0); PG8_MMA(0, 0, At, B0); PG8_BAR; PG8_SCHED;
            PG8_LDB(B1, 0, 1); PG8_STAGE(PG8_SB(0, 0), b2, voffB);
            PG8_BAR; PG8_WAIT_L(0); PG8_MMA(0, 1, At, B1); PG8_BAR;
            PG8_LDA(At, 0, 1); PG8_STAGE(PG8_SA(0, 0), a2, voffA);
            PG8_BAR; PG8_WAIT_L(0); PG8_MMA(1, 0, At, B0); PG8_BAR; PG8_SCHED;
            PG8_STAGE(PG8_SB(0, 1), b2 + hstep, voffB);
            PG8_WAIT_V(6); PG8_BAR; PG8_MMA(1, 1, At, B1); PG8_BAR;
            PG8_LDB(B0, 1, 0); PG8_SCHED; PG8_LDA(At, 1, 0); PG8_STAGE(PG8_SA(0, 1), a2 + hstep, voffA);
            PG8_WAIT_L(8); PG8_BAR; PG8_WAIT_L(0); PG8_MMA(0, 0, At, B0); PG8_BAR; PG8_SCHED;
            PG8_LDB(B1, 1, 1); PG8_STAGE(PG8_SB(1, 0), b3, voffB);
            PG8_BAR; PG8_WAIT_L(0); PG8_MMA(0, 1, At, B1); PG8_BAR;
            PG8_LDA(At, 1, 1); PG8_STAGE(PG8_SA(1, 0), a3, voffA);
            PG8_BAR; PG8_WAIT_L(0); PG8_MMA(1, 0, At, B0); PG8_BAR; PG8_SCHED;
            PG8_STAGE(PG8_SB(1, 1), b3 + hstep, voffB);
            PG8_WAIT_V(6); PG8_BAR; PG8_MMA(1, 1, At, B1); PG8_BAR;
        }
        E(acc, cur, wr, wc, fr, fq);
        if (!has_next) break;
#pragma unroll
        for (int a = 0; a < 2; ++a)
#pragma unroll
            for (int b = 0; b < 2; ++b)
#pragma unroll
                for (int m = 0; m < 4; ++m)
#pragma unroll
                    for (int n = 0; n < 2; ++n) acc[a][b][m][n] = (f32x4){0.f, 0.f, 0.f, 0.f};
        cur = nxt; cA = nA; cB = nB; ++ui;
    }
    PG8_WAIT_V(0);
    if (wr == 0) PG8_BAR;
    PG8_BAR;
#undef PG8_SA
#undef PG8_SB
#undef PG8_STAGE
#undef PG8_LDA
#undef PG8_LDB
#undef PG8_MMA
#undef PG8_WAIT_V
#undef PG8_WAIT_L
#undef PG8_BAR
#undef PG8_SCHED
}
}


#define XB_TMO      128
#define XB_XCNT(j)  (256  + 64 * (j))
#define XB_XSUB(j)  (1280 + 64 * (j))
#define XB_XGEN(j)  (2304 + 64 * (j))
#define XB_TOP      3328
#define XB_TOPGEN   3392
#define XCD_BAR_WORDS 3456
#define XB_SPIN_CAP (1u << 18)
__device__ __forceinline__ unsigned xb_ld(unsigned* p)              { return __hip_atomic_load(p, __ATOMIC_RELAXED, __HIP_MEMORY_SCOPE_AGENT); }
__device__ __forceinline__ unsigned xb_add(unsigned* p, unsigned v) { return __hip_atomic_fetch_add(p, v, __ATOMIC_RELAXED, __HIP_MEMORY_SCOPE_AGENT); }
__device__ __forceinline__ unsigned xb_xcc_id() { return (unsigned)__builtin_amdgcn_s_getreg((3 << 11) | 20) & 0xFu; }
#define XB_SPIN(cond, bar) do { unsigned _sp = 0; while (cond) { __builtin_amdgcn_s_sleep(1); \
    if ((++_sp & 255u) == 0u) { if (xb_ld(&(bar)[XB_TMO])) break; if (_sp > XB_SPIN_CAP) { atomicAdd(&(bar)[XB_TMO], 1u); break; } } } } while (0)
struct XcdBarrier { unsigned* bar; unsigned x; volatile LAS unsigned* st; };
__device__ __forceinline__ XcdBarrier xcd_barrier_post(unsigned* bar, volatile LAS unsigned* st) {
    XcdBarrier b; b.bar = bar; b.x = xb_xcc_id(); b.st = st;
    if (threadIdx.x == 0) (void)xb_add(&bar[XB_XCNT(b.x)], 1u);
    return b;
}
__device__ __forceinline__ void xcd_barrier_complete(unsigned* bar, unsigned x, unsigned& nloc, unsigned& nx) {
    const unsigned G = gridDim.x * gridDim.y * gridDim.z;
    unsigned sum, cnt, mine, sp = 0u;
    for (;;) {
        sum = 0u; cnt = 0u; mine = 0u;
#pragma unroll
        for (unsigned j = 0; j < 16; ++j) { const unsigned c = xb_ld(&bar[XB_XCNT(j)]); sum += c; cnt += (c > 0u) ? 1u : 0u; mine = (j == x) ? c : mine; }
        if (sum == G) break;
        __builtin_amdgcn_s_sleep(1);
        if ((++sp & 255u) == 0u) { if (xb_ld(&bar[XB_TMO])) break; if (sp > XB_SPIN_CAP) { atomicAdd(&bar[XB_TMO], 1u); break; } }
    }
    nloc = mine > 0u ? mine : 1u; nx = cnt > 0u ? cnt : 1u;
}
__device__ __forceinline__ void xcd_barrier(const XcdBarrier& b, const int wv0) {
    asm volatile("s_waitcnt vmcnt(0)" ::: "memory");
    __syncthreads();
    if (opaque_tid(wv0) == 0) {
        unsigned* bar = b.bar;
        __builtin_amdgcn_s_waitcnt(0);
        unsigned nloc = b.st[0], nx = b.st[1];
        if (nloc == 0u) { xcd_barrier_complete(bar, b.x, nloc, nx); b.st[0] = nloc; b.st[1] = nx; }
        const unsigned old = xb_add(&bar[XB_XSUB(b.x)], 1u);
        const unsigned gen = old / nloc;
        if (old + 1u == (gen + 1u) * nloc) {
            __builtin_amdgcn_fence(__ATOMIC_RELEASE, "agent");
            asm volatile("s_waitcnt vmcnt(0)" ::: "memory");
            const unsigned og = xb_add(&bar[XB_TOP], 1u);
            const unsigned tg = og / nx;
            if (og + 1u == (tg + 1u) * nx) xb_add(&bar[XB_TOPGEN], 1u);
            else XB_SPIN(xb_ld(&bar[XB_TOPGEN]) == tg, bar);
            __builtin_amdgcn_fence(__ATOMIC_ACQUIRE, "agent");
            xb_add(&bar[XB_XGEN(b.x)], 1u);
            asm volatile("s_waitcnt vmcnt(0)" ::: "memory");
        } else {
            XB_SPIN(xb_ld(&bar[XB_XGEN(b.x)]) == gen, bar);
            __builtin_amdgcn_fence(__ATOMIC_ACQUIRE, "agent");
            asm volatile("s_waitcnt vmcnt(0)" ::: "memory");
        }
    }
    __syncthreads();
}

struct Frame {
    LAS unsigned char* lds;
    int vcu, G, wv;
    const float* const* in; float* out; unsigned char* ws;
    __device__ __forceinline__ float* MOD() const { return (float*)(ws + WS_MOD); }
    __device__ __forceinline__ float* ROPE() const { return (float*)(ws + WS_ROPE); }
    __device__ __forceinline__ float* BA() const { return (float*)(ws + WS_BA); }
    __device__ __forceinline__ float* LAG() const { return (float*)(ws + WS_LAG); }
    __device__ __forceinline__ bf16_t* W1O() const { return (bf16_t*)(ws + WS_W1O); }
    __device__ __forceinline__ bf16_t* U0() const { return (bf16_t*)(ws + WS_RA); }
    __device__ __forceinline__ bf16_t* QKV1() const { return (bf16_t*)(ws + WS_RA); }
    __device__ __forceinline__ bf16_t* Z1() const { return (bf16_t*)(ws + WS_RA + (size_t)MT * 3072 * 2); }
    __device__ __forceinline__ bf16_t* Y1() const { return (bf16_t*)(ws + WS_RA + (size_t)MT * 3072 * 2); }
    __device__ __forceinline__ bf16_t* XN() const { return (bf16_t*)(ws + WS_RB + RB_XN); }
    __device__ __forceinline__ bf16_t* Y0() const { return (bf16_t*)(ws + WS_RB + RB_Y0); }
    __device__ __forceinline__ bf16_t* YO() const { return (bf16_t*)(ws + WS_RB + RB_YO); }
    __device__ __forceinline__ bf16_t* W0I() const { return (bf16_t*)(ws + WS_RB + RB_W0I); }
    __device__ __forceinline__ bf16_t* W0O() const { return (bf16_t*)(ws + WS_RB + RB_W0O); }
    __device__ __forceinline__ bf16_t* W1I() const { return (bf16_t*)(ws + WS_RB + RB_W1I); }
    __device__ __forceinline__ bf16_t* QKVC() const { return (bf16_t*)(ws + WS_RB); }
};

#define PHASE_IDS() int tid = opaque_tid(F.wv); const int lane = tid & 63, wave = __builtin_amdgcn_readfirstlane(tid >> 6); (void)lane; (void)wave
__device__ __forceinline__ void p0_transpose_item(const float* W, int ldw, int nblk, int K, bf16_t* WT, LAS float* scr, int item, int lane) {
    const int kb = item / nblk, nb = item % nblk, k0 = 64 * kb, n0 = 32 * nb;
    f32x4 v[8];
#pragma unroll
    for (int i = 0; i < 8; ++i) v[i] = *(const f32x4*)(W + (size_t)(k0 + 8 * i + (lane >> 3)) * ldw + n0 + 4 * (lane & 7));
#pragma unroll
    for (int i = 0; i < 8; ++i) { LAS float* d = scr + (8 * i + (lane >> 3)) * 33 + 4 * (lane & 7); d[0] = v[i][0]; d[1] = v[i][1]; d[2] = v[i][2]; d[3] = v[i][3]; }
    asm volatile("s_waitcnt lgkmcnt(0)" ::: "memory");
    const int c = lane & 7;
#pragma unroll
    for (int j = 0; j < 4; ++j) { const int n = (lane >> 3) + 8 * j; const LAS float* s = scr + (8 * c) * 33 + n;
        u32x4 o; o.x = pk2(s[0 * 33], s[1 * 33]); o.y = pk2(s[2 * 33], s[3 * 33]); o.z = pk2(s[4 * 33], s[5 * 33]); o.w = pk2(s[6 * 33], s[7 * 33]);
        *(u32x4*)(WT + (size_t)(n0 + n) * K + k0 + 8 * c) = o; }
    asm volatile("s_waitcnt lgkmcnt(0)" ::: "memory");
}
constexpr size_t WS_MODP = 12 * MiB;
__device__ __forceinline__ f32x4 mod4(const float* MODP, int L, int s, int off) {
    f32x4 a = *(const f32x4*)(MODP + ((size_t)((L * 4 + 0) * 24 + s)) * 3072 + off);
#pragma unroll
    for (int sl = 1; sl < 4; ++sl) a += *(const f32x4*)(MODP + ((size_t)((L * 4 + sl) * 24 + s)) * 3072 + off);
    return a;
}
__device__ __forceinline__ void mod_task(Frame& F, const int bt, const int tid, const int lane, const int wave) {
    const int L = bt / 192, sl = (bt % 192) / 48, n0 = (bt % 48) * 64, kb = sl * 256;
    LAS float* tab = (LAS float*)F.lds;
    {   float cv[12];
#pragma unroll
        for (int u = 0; u < 12; ++u) { const int idx = tid + 512 * u, s = idx >> 8, k = kb + (idx & 255); cv[u] = s < BP ? F.in[8][s * D + k] : F.in[9][(s - BP) * D + k]; }
#pragma unroll
        for (int u = 0; u < 12; ++u) { const int idx = tid + 512 * u, s = idx >> 8, k = idx & 255; tab[k * 24 + s] = siluf_(cv[u]); } }
    __syncthreads();
    const float* mw = (L == 0 ? F.in[10] : F.in[24]) + n0 + lane;
    float acc[24];
#pragma unroll
    for (int r = 0; r < 24; ++r) acc[r] = 0.f;
    for (int k0 = wave * 32; k0 < wave * 32 + 32; k0 += 16) {
        float wv[16];
#pragma unroll
        for (int u = 0; u < 16; ++u) wv[u] = mw[(size_t)(kb + k0 + u) * 3072];
#pragma unroll
        for (int u = 0; u < 16; ++u) { const float w = wv[u];
            const LAS f32x4* tp = (const LAS f32x4*)(tab + (k0 + u) * 24);
#pragma unroll
            for (int q = 0; q < 6; ++q) { const f32x4 t4 = tp[q]; acc[4 * q] += t4[0] * w; acc[4 * q + 1] += t4[1] * w; acc[4 * q + 2] += t4[2] * w; acc[4 * q + 3] += t4[3] * w; } }
    }
    __syncthreads();
    LAS float* red = (LAS float*)F.lds;
#pragma unroll
    for (int r = 0; r < 24; ++r) red[(wave * 24 + r) * 64 + lane] = acc[r];
    __syncthreads();
    const float* mb = (L == 0 ? F.in[11] : F.in[25]);
    float* MODP = (float*)(F.ws + WS_MODP);
    for (int idx = tid; idx < 24 * 64; idx += 512) { const int r = idx >> 6, l = idx & 63; float s = 0.f;
#pragma unroll
        for (int w = 0; w < 8; ++w) s += red[(w * 24 + r) * 64 + l];
        MODP[((size_t)((L * 4 + sl) * 24 + r)) * 3072 + n0 + l] = s + (sl == 0 ? mb[n0 + l] : 0.f); }
    __syncthreads();
}
__device__ __forceinline__ void phase_mod0(Frame& F) {
    PHASE_IDS();
    for (int bt = F.vcu; bt < 192; bt += F.G) { int t2 = tid; asm volatile("" : "+v"(t2)); mod_task(F, bt, t2, t2 & 63, wave); }
}
__device__ __forceinline__ void phase_mod1(Frame& F) {
    PHASE_IDS();
    __syncthreads();
    for (int bt = 192 + F.vcu; bt < 384; bt += F.G) { int t2 = tid; asm volatile("" : "+v"(t2)); mod_task(F, bt, t2, t2 & 63, wave); }
}
__device__ __forceinline__ void phase_prologue(Frame& F) {
    PHASE_IDS();
    const int gw = F.vcu * 8 + wave, NGW = F.G * 8;
    {
        LAS float* scr = (LAS float*)(F.lds + wave * 16384);
        constexpr int I0 = 16 * (EV_IN / 32), I1 = 16 * 32, I2 = 16 * (OD_MAIN / 32), I3 = 16 * 32;
        for (int it = gw; it < I0 + I1 + I2 + I3; it += NGW) {
            int r = it;
            if (r < I0) { p0_transpose_item(F.in[14], EV_IN, EV_IN / 32, D, F.W0I(), scr, r, lane); continue; } r -= I0;
            if (r < I1) { p0_transpose_item(F.in[23], D, 32, D, F.W0O(), scr, r, lane); continue; } r -= I1;
            if (r < I2) { p0_transpose_item(F.in[28], OD_IN, OD_MAIN / 32, D, F.W1I(), scr, r, lane); continue; } r -= I2;
            p0_transpose_item(F.in[33], D, 32, D, F.W1O(), scr, r, lane);
        }
    }
    {
        const double inv[8] = {1.0, 0.19392274474868576, 0.03760603093086393, 0.007292664737217109, 0.001414213562373095, 0.0002742481756762073, 5.318295896944988e-05, 1.031338537721246e-05};
        for (int idx = F.vcu * 512 + tid; idx < 4112 * 8; idx += F.G * 512) {
            const int pos = idx >> 3, i = idx & 7;
            double iv = inv[0];
#pragma unroll
            for (int q = 1; q < 8; ++q) iv = (i == q) ? inv[q] : iv;
            const double ang = (double)pos * iv;
            const double n = __builtin_rint(ang * 0.15915494309189535);
            const float r = (float)__builtin_fma(-n, 6.283185307179586, ang);
            F.ROPE()[pos * 16 + i] = __cosf(r); F.ROPE()[pos * 16 + 8 + i] = __sinf(r);
        }
    }
    {
        bf16_t* LGW = (bf16_t*)(F.ws + WS_LGW);
        for (int idx = F.vcu * 512 + tid; idx < 8 * 2 * 64 * 64; idx += F.G * 512) { const int k = idx & 63, n = (idx >> 6) & 63, gate = (idx >> 12) & 1, hh = idx >> 13;
            LGW[idx] = (bf16_t)f2bf((gate ? F.in[19] : F.in[17])[(hh * 64 + k) * 64 + n]); }
    }
}

__device__ __forceinline__ const float* x_row(Frame& F, int m) { return m < MP ? F.in[0] + (size_t)m * D : F.in[1] + (size_t)(m - MP) * D; }
__device__ __forceinline__ void rows_prenorm0(Frame& F, const int m0, const int n, const int s, const int lane) {
    const float* MODP = (const float*)(F.ws + WS_MODP);
    f32x4 A[4], C[4];
#pragma unroll
    for (int j = 0; j < 4; ++j) { const int c = 4 * lane + 256 * j; const f32x4 g = *(const f32x4*)(F.in[12] + c), sc = mod4(MODP, 0, s, 1024 + c); C[j] = mod4(MODP, 0, s, c);
#pragma unroll
        for (int e = 0; e < 4; ++e) A[j][e] = g[e] * (1.f + sc[e]); }
    f32x4 cur[4];
#pragma unroll
    for (int j = 0; j < 4; ++j) cur[j] = *(const f32x4*)(x_row(F, m0) + 4 * lane + 256 * j);
    for (int i = 0; i < n; ++i) {
        const int mn = m0 + (i + 1 < n ? i + 1 : i); f32x4 nxt[4];
#pragma unroll
        for (int j = 0; j < 4; ++j) nxt[j] = *(const f32x4*)(x_row(F, mn) + 4 * lane + 256 * j);
        float ss = 0.f;
#pragma unroll
        for (int j = 0; j < 4; ++j) ss += (cur[j][0] * cur[j][0] + cur[j][1] * cur[j][1]) + (cur[j][2] * cur[j][2] + cur[j][3] * cur[j][3]);
        const float r = rsqrtf(wave_sum(ss, lane) * (1.f / D) + EPS);
#pragma unroll
        for (int j = 0; j < 4; ++j) { u32x2 w; w[0] = cvt2(cur[j][0] * r * A[j][0] + C[j][0], cur[j][1] * r * A[j][1] + C[j][1]); w[1] = cvt2(cur[j][2] * r * A[j][2] + C[j][2], cur[j][3] * r * A[j][3] + C[j][3]);
            *(u32x2*)(F.XN() + (size_t)(m0 + i) * D + 4 * lane + 256 * j) = w; }
#pragma unroll
        for (int j = 0; j < 4; ++j) cur[j] = nxt[j];
    }
}
__device__ __forceinline__ void phase_prenorm0(Frame& F) {
    PHASE_IDS();
    const int gw = F.vcu * 8 + wave, NGW = F.G * 8;
    for (int w = gw; w < MP / 16; w += NGW) rows_prenorm0(F, w * 16, 16, w >> 8, lane);
    for (int w = gw; w < MS; w += NGW) rows_prenorm0(F, MP + w, 1, BP + (w >> 4), lane);
}

__device__ __forceinline__ void phase_rope(Frame& F) {
    PHASE_IDS();
    const int gt = F.vcu * 512 + tid, NT = F.G * 512;
    for (int idx = gt; idx < MT * 10; idx += NT) {
        const int m = idx / 10, slot = idx % 10;
        int s, t; tok_info(m, s, t);
        const int pos = s < BP ? t : TP + t;
        const int col = slot < 8 ? C_Q + slot * 64 : C_K + (slot - 8) * 64;
        u32x4* p = (u32x4*)(F.U0() + (size_t)m * EV_IN + col);
        const u32x4 xa = p[0], xb = p[1];
        const f32x4* rp = (const f32x4*)(F.ROPE() + pos * 16); const f32x4 c0 = rp[0], c1 = rp[1], s0 = rp[2], s1 = rp[3];
        float x1[8], x2[8], o1[8], o2[8];
#pragma unroll
        for (int e = 0; e < 4; ++e) { x1[2 * e] = lo16(xa[e]); x1[2 * e + 1] = hi16(xa[e]); x2[2 * e] = lo16(xb[e]); x2[2 * e + 1] = hi16(xb[e]); }
#pragma unroll
        for (int i = 0; i < 8; ++i) { const float c = i < 4 ? c0[i & 3] : c1[i & 3], sn = i < 4 ? s0[i & 3] : s1[i & 3]; o1[i] = x1[i] * c - x2[i] * sn; o2[i] = x2[i] * c + x1[i] * sn; }
        u32x4 ya, yb;
#pragma unroll
        for (int e = 0; e < 4; ++e) { ya[e] = cvt2(o1[2 * e], o1[2 * e + 1]); yb[e] = cvt2(o2[2 * e], o2[2 * e + 1]); }
        p[0] = ya; p[1] = yb;
        if (slot >= 8) { const int kv = slot - 8; float* o = nullptr;
            if (s >= BP) o = F.out + O_KS + ((size_t)((s - BP) * TS + t) * 2 + kv) * 64;
            else if (t >= TP - 128) o = F.out + O_KP + ((size_t)(s * 128 + (t - (TP - 128))) * 2 + kv) * 64;
            if (o) { *(f32x4*)o = (f32x4){o1[0], o1[1], o1[2], o1[3]}; *(f32x4*)(o + 4) = (f32x4){o1[4], o1[5], o1[6], o1[7]}; *(f32x4*)(o + 8) = (f32x4){o2[0], o2[1], o2[2], o2[3]}; *(f32x4*)(o + 12) = (f32x4){o2[4], o2[5], o2[6], o2[7]}; } }
    }
    for (int idx = gt; idx < 1280 * 224; idx += NT) {
        const int tk = idx / 224, e = idx % 224;
        int s, t, m; if (tk < 1024) { s = tk >> 7; t = TP - 128 + (tk & 127); m = s * TP + t; } else { s = BP + ((tk - 1024) >> 4); t = (tk - 1024) & 15; m = MP + (tk - 1024); }
        const bool isv = e >= 96; const int e2 = isv ? e - 96 : e; const int kv = isv ? (e2 >> 6) : (e2 / 48), d = isv ? (e2 & 63) : 16 + (e2 % 48);
        const float val = bf2f(F.U0()[(size_t)m * EV_IN + (isv ? C_V : C_K) + kv * 64 + d]);
        const size_t ob = s >= BP ? (isv ? O_VS : O_KS) + ((size_t)((s - BP) * TS + t) * 2 + kv) * 64 : (isv ? O_VP : O_KP) + ((size_t)(s * 128 + (t - (TP - 128))) * 2 + kv) * 64;
        F.out[ob + d] = val;
    }
}


__device__ __forceinline__ void rows_mid(Frame& F, LAS float* baw, const int m0, const int n, const int s, const int lane) {
    const float* MODP = (const float*)(F.ws + WS_MODP);
    f32x4 A0[4], B1[4], C1[4];
#pragma unroll
    for (int j = 0; j < 4; ++j) { const int c = 4 * lane + 256 * j; const f32x4 g0 = *(const f32x4*)(F.in[13] + c), gt = mod4(MODP, 0, s, 2048 + c), g1 = *(const f32x4*)(F.in[26] + c), sc = mod4(MODP, 1, s, 1024 + c);
        C1[j] = mod4(MODP, 1, s, c);
#pragma unroll
        for (int e = 0; e < 4; ++e) { A0[j][e] = gt[e] * g0[e]; B1[j][e] = g1[e] * (1.f + sc[e]); } }
    u32x2 ycur[4]; f32x4 xcur[4];
#pragma unroll
    for (int j = 0; j < 4; ++j) { ycur[j] = *(const u32x2*)(F.YO() + (size_t)m0 * D + 4 * lane + 256 * j); xcur[j] = *(const f32x4*)(x_row(F, m0) + 4 * lane + 256 * j); }
    for (int i = 0; i < n; ++i) {
        const int m = m0 + i, mn = m0 + (i + 1 < n ? i + 1 : i); u32x2 ynxt[4]; f32x4 xnxt[4];
#pragma unroll
        for (int j = 0; j < 4; ++j) { ynxt[j] = *(const u32x2*)(F.YO() + (size_t)mn * D + 4 * lane + 256 * j); xnxt[j] = *(const f32x4*)(x_row(F, mn) + 4 * lane + 256 * j); }
        f32x4 y[4]; float ss = 0.f;
#pragma unroll
        for (int j = 0; j < 4; ++j) { y[j] = (f32x4){lo16(ycur[j][0]), hi16(ycur[j][0]), lo16(ycur[j][1]), hi16(ycur[j][1])}; ss += (y[j][0] * y[j][0] + y[j][1] * y[j][1]) + (y[j][2] * y[j][2] + y[j][3] * y[j][3]); }
        const float r1 = rsqrtf(wave_sum(ss, lane) * (1.f / D) + EPS);
        f32x4 x1[4]; float s2 = 0.f;
#pragma unroll
        for (int j = 0; j < 4; ++j) {
#pragma unroll
            for (int e = 0; e < 4; ++e) x1[j][e] = xcur[j][e] + A0[j][e] * (y[j][e] * r1);
            *(f32x4*)(F.out + O_Y + (size_t)m * D + 4 * lane + 256 * j) = x1[j];
            s2 += (x1[j][0] * x1[j][0] + x1[j][1] * x1[j][1]) + (x1[j][2] * x1[j][2] + x1[j][3] * x1[j][3]); }
        const float r2 = rsqrtf(wave_sum(s2, lane) * (1.f / D) + EPS);
        f32x4 hm[4];
#pragma unroll
        for (int j = 0; j < 4; ++j) {
#pragma unroll
            for (int e = 0; e < 4; ++e) hm[j][e] = x1[j][e] * r2 * B1[j][e] + C1[j][e];
            u32x2 w; w[0] = cvt2(hm[j][0], hm[j][1]); w[1] = cvt2(hm[j][2], hm[j][3]); *(u32x2*)(F.XN() + (size_t)m * D + 4 * lane + 256 * j) = w; }
        __builtin_amdgcn_sched_barrier(0);
        float p[16];
#pragma unroll
        for (int q = 0; q < 16; ++q) { p[q] = 0.f;
#pragma unroll
            for (int j = 0; j < 4; ++j) { const f32x4 w = *(const LAS f32x4*)(baw + q * 1024 + 256 * j + 4 * lane); p[q] += (hm[j][0] * w[0] + hm[j][1] * w[1]) + (hm[j][2] * w[2] + hm[j][3] * w[3]); }
            if ((q & 3) == 3) __builtin_amdgcn_sched_barrier(0); }
        { const bool u5 = (lane & 32) != 0;
#pragma unroll
          for (int q = 0; q < 8; ++q) { const float keep = u5 ? p[8 + q] : p[q], send = u5 ? p[q] : p[8 + q]; p[q] = keep + shfl_xor_l(send, 32, lane); } }
        { const bool u4 = (lane & 16) != 0;
#pragma unroll
          for (int q = 0; q < 4; ++q) { const float keep = u4 ? p[4 + q] : p[q], send = u4 ? p[q] : p[4 + q]; p[q] = keep + shfl_xor_l(send, 16, lane); } }
        { const bool u3 = (lane & 8) != 0;
#pragma unroll
          for (int q = 0; q < 2; ++q) { const float keep = u3 ? p[2 + q] : p[q], send = u3 ? p[q] : p[2 + q]; p[q] = keep + shfl_xor_l(send, 8, lane); } }
        { const bool u2 = (lane & 4) != 0; const float keep = u2 ? p[1] : p[0], send = u2 ? p[0] : p[1]; p[0] = keep + shfl_xor_l(send, 4, lane); }
        float mine = p[0]; mine += shfl_xor_l(mine, 2, lane); mine += shfl_xor_l(mine, 1, lane);
        if ((lane & 3) == 0) { const int col = lane >> 2, hh = col & 7;
            F.BA()[(size_t)m * 16 + col] = col < 8 ? sigmoidf_(mine) : -__expf(F.in[30][hh]) * softplusf_(mine + F.in[31][hh]); }
#pragma unroll
        for (int j = 0; j < 4; ++j) { ycur[j] = ynxt[j]; xcur[j] = xnxt[j]; }
    }
}
__device__ __forceinline__ void phase_mid_rowwise(Frame& F) {
    PHASE_IDS();
    LAS float* baw = (LAS float*)F.lds;
    for (int idx = tid; idx < 16 * 1024; idx += 512) { const int j = idx & 15, k = idx >> 4; baw[j * 1024 + k] = F.in[28][(size_t)k * OD_IN + OD_MAIN + j]; }
    __syncthreads();
    const int gw = F.vcu * 8 + wave, NGW = F.G * 8;
    for (int w = gw; w < MP / 16; w += NGW) rows_mid(F, baw, w * 16, 16, w >> 8, lane);
    for (int w = gw; w < MS; w += NGW) rows_mid(F, baw, MP + w, 1, BP + (w >> 4), lane);
}


typedef float f32x16 __attribute__((ext_vector_type(16)));
constexpr int GS_WF = 0, GS_QF = 16384, GS_KF = 32768, GS_PF = 49152, GS_UF = 57344, GS_BYTES = 73728;
constexpr size_t WS_DEC = 11 * MiB;
__device__ __forceinline__ int krow(int s, int h, int j) { return 16 * s + 8 * (j >> 2) + 4 * h + (j & 3); }
#define MFMA32(a, b, c) __builtin_amdgcn_mfma_f32_32x32x16_bf16((a), (b), (c), 0, 0, 0)
#define MFMA16(a, b, c) __builtin_amdgcn_mfma_f32_16x16x32_bf16((a), (b), (c), 0, 0, 0)

typedef __amdgpu_buffer_rsrc_t brsrc_t;
__device__ __forceinline__ brsrc_t staging_rsrc(unsigned char* ws) { return __builtin_amdgcn_make_buffer_rsrc((void*)(ws + WS_RB), (short)0, (int)RB_BYTES, 0x00020000); }
__device__ __forceinline__ void st16_wt(brsrc_t r, unsigned off, u32x4 v) { __builtin_amdgcn_raw_buffer_store_b128(v, r, off, 0, 16); }
__device__ __forceinline__ u32x4 ld16_wt(brsrc_t r, unsigned off) { return __builtin_amdgcn_raw_buffer_load_b128(r, off, 0, 16); }
__device__ __forceinline__ void st8_wt(unsigned char* p, u32x2 v) { __hip_atomic_store((unsigned long long*)p, ((unsigned long long)v[1] << 32) | v[0], __ATOMIC_RELAXED, __HIP_MEMORY_SCOPE_AGENT); }
constexpr size_t WS_READY = 65536;
#define LDS_BARRIER() do { asm volatile("s_waitcnt lgkmcnt(0)" ::: "memory"); __builtin_amdgcn_s_barrier(); asm volatile("" ::: "memory"); } while (0)
constexpr int G1_QS = 0, G1_KS = 17408, G1_VS = 34816, G1_AS = 52224, G1_PS = 69632, G1_WS = 78848, G1_CW = 96256, G1_VEC = 102400, G1_ES = 103424;
__device__ __forceinline__ void g1_load_raw(Frame& F, u32x4 (&raw)[24], int s, int c, int h, int t1) {
    const int r = t1 >> 3, j = t1 & 7, t = c * 64 + r;
#pragma unroll
    for (int p = 0; p < 3; ++p)
#pragma unroll
        for (int jj = 0; jj < 4; ++jj) { const int tt = t - 3 + jj, ttc = tt < 0 ? 0 : tt;
            const u32x4* src = (const u32x4*)(F.QKV1() + (size_t)(s * TP + ttc) * 3072 + p * 1024 + h * 128 + j * 16); raw[p * 8 + jj * 2] = src[0]; raw[p * 8 + jj * 2 + 1] = src[1]; }
}
__device__ __forceinline__ bf16x8 g1_pack_b(const f32x4 p, const f32x4 q) { u32x4 w; w[0] = cvt2(p[0], p[1]); w[1] = cvt2(p[2], p[3]); w[2] = cvt2(q[0], q[1]); w[3] = cvt2(q[2], q[3]); return __builtin_bit_cast(bf16x8, w); }
__device__ __forceinline__ void g1_decode(int n, int& s, int& c, int& h) { if (n < 4096) { c = n >> 6; s = (n & 63) >> 3; h = n & 7; } else { s = BP + ((n - 4096) >> 3); c = 0; h = n & 7; } }
__device__ __forceinline__ void gdn_g1_tasks(Frame& F, const int first, const int stride) {
    int tid = opaque_tid(F.wv);
    const int lane = tid & 63, wave = __builtin_amdgcn_readfirstlane(tid >> 6);
    LAS unsigned char* L = F.lds;
    LAS float* cw_s = (LAS float*)(L + G1_CW);
    LAS float* beta_s = (LAS float*)(L + G1_VEC); LAS float* gcum_s = beta_s + 64; LAS float* eg_s = beta_s + 128; LAS float* ek_s = beta_s + 192;
    float* DEC = (float*)(F.ws + WS_DEC);
    u32x4 raw[24];
    float pcw[3], pb = 0.f, pa = 0.f;
    const brsrc_t srs = staging_rsrc(F.ws);
    unsigned* ready = (unsigned*)(F.ws + WS_READY);
    { int s0, c0, h0; g1_decode(first < 4095 ? first : 4095, s0, c0, h0); g1_load_raw(F, raw, s0, c0, h0, tid);
#pragma unroll
        for (int q = 0; q < 3; ++q) { const int i = tid + 512 * q, jj = i / 384, cc = i % 384; pcw[q] = F.in[29][(size_t)jj * 3072 + (cc >> 7) * 1024 + h0 * 128 + (cc & 127)]; }
        const float* ba = F.BA() + (size_t)(s0 * TP + c0 * 64 + (tid & 63)) * 16; pb = ba[h0]; pa = ba[8 + h0]; }
    for (int task = first; task < 4224; task += stride) {
        const int tid = opaque_tid(F.wv), lane = tid & 63;
        int s, c, h; g1_decode(task, s, c, h);
        const int nvalid = s < BP ? 64 : TS, t0 = c * 64, base = seq_base(s), T = seq_len(s);
        const int sidx = task < 4096 ? ((s * 8 + h) * 64 + c) : task;
        unsigned char* blk = F.ws + WS_RB + (size_t)sidx * GS_BYTES; const unsigned boff = (unsigned)sidx * (unsigned)GS_BYTES;
        if (s < BP) {
#pragma unroll
            for (int q = 0; q < 3; ++q) cw_s[tid + 512 * q] = pcw[q];
        } else for (int i = tid; i < 4 * 384; i += 512) { const int jj = i / 384, cc = i % 384; cw_s[i] = F.in[29][(size_t)jj * 3072 + (cc >> 7) * 1024 + h * 128 + (cc & 127)]; }
        if (tid < 64) {
            const bool ok = tid < nvalid; float beta = 0.f, g = 0.f;
            if (ok) { float vb = pb, va = pa; if (s >= BP) { const float* ba = F.BA() + (size_t)(base + t0 + tid) * 16; vb = ba[h]; va = ba[8 + h]; }
                beta = vb; g = va; }
            float x = g;
#pragma unroll
            for (int o = 1; o < 64; o <<= 1) { const float y = shfl_idx(x, lane >= o ? lane - o : lane); if (lane >= o) x += y; }
            const float gl = shfl_idx(x, 63);
            beta_s[tid] = beta; gcum_s[tid] = x; eg_s[tid] = __expf(x); ek_s[tid] = ok ? __expf(gl - x) : 0.f;
            if (tid == 0) __hip_atomic_store((unsigned*)DEC + sidx, __float_as_uint(__expf(gl)), __ATOMIC_RELAXED, __HIP_MEMORY_SCOPE_AGENT);
        }
        LDS_BARRIER();
        {
            int t1 = tid; asm volatile("" : "+v"(t1));
            const int r = t1 >> 3, j = t1 & 7, t = t0 + r; const bool ok = r < nvalid;
            if (s < BP && t0 == 0 && r < 3) {
#pragma unroll
                for (int p = 0; p < 3; ++p)
#pragma unroll
                    for (int jj = 0; jj < 3; ++jj) if (r - 3 + jj < 0) { raw[p * 8 + jj * 2] = (u32x4){0u, 0u, 0u, 0u}; raw[p * 8 + jj * 2 + 1] = (u32x4){0u, 0u, 0u, 0u}; }
            }
#pragma unroll
            for (int p = 0; p < 3; ++p) {
                float acc[16], cur[16];
#pragma unroll
                for (int e = 0; e < 16; ++e) { acc[e] = 0.f; cur[e] = 0.f; }
                const int cb = p * 1024 + h * 128 + j * 16;
#pragma unroll
                for (int jj = 0; jj < 4; ++jj) {
                    const int tt = t - 3 + jj; float x[16];
                    if (s < BP) { const u32x4 a = raw[p * 8 + jj * 2], b = raw[p * 8 + jj * 2 + 1];
#pragma unroll
                        for (int e = 0; e < 4; ++e) { x[2 * e] = lo16(a[e]); x[2 * e + 1] = hi16(a[e]); x[8 + 2 * e] = lo16(b[e]); x[8 + 2 * e + 1] = hi16(b[e]); } }
                    else if (ok && tt >= 0) { const u32x4* src = (const u32x4*)(F.QKV1() + (size_t)(base + tt) * 3072 + cb); const u32x4 a = src[0], b = src[1];
#pragma unroll
                        for (int e = 0; e < 4; ++e) { x[2 * e] = lo16(a[e]); x[2 * e + 1] = hi16(a[e]); x[8 + 2 * e] = lo16(b[e]); x[8 + 2 * e + 1] = hi16(b[e]); } }
                    else if (ok) { const f32x4* src = (const f32x4*)(F.in[6] + ((size_t)(s - BP) * 3 + (tt + 3)) * 3072 + cb);
#pragma unroll
                        for (int q = 0; q < 4; ++q) { const f32x4 a = src[q]; x[4 * q] = a[0]; x[4 * q + 1] = a[1]; x[4 * q + 2] = a[2]; x[4 * q + 3] = a[3]; } }
                    else {
#pragma unroll
                        for (int e = 0; e < 16; ++e) x[e] = 0.f; }
                    const LAS f32x4* wp = (const LAS f32x4*)(cw_s + jj * 384 + p * 128 + j * 16);
#pragma unroll
                    for (int q = 0; q < 4; ++q) { const f32x4 w4 = wp[q]; acc[4 * q] += w4[0] * x[4 * q]; acc[4 * q + 1] += w4[1] * x[4 * q + 1]; acc[4 * q + 2] += w4[2] * x[4 * q + 2]; acc[4 * q + 3] += w4[3] * x[4 * q + 3]; }
                    if (jj == 3) {
#pragma unroll
                        for (int e = 0; e < 16; ++e) cur[e] = x[e]; }
                }
                if (ok && t >= T - 3) {
                    float* o = (s < BP ? F.out + O_GCP + ((size_t)s * 3 + (t - (T - 3))) * 3072 : F.out + O_GCS + ((size_t)(s - BP) * 3 + (t - (T - 3))) * 3072) + cb;
#pragma unroll
                    for (int q = 0; q < 4; ++q) *(f32x4*)(o + 4 * q) = (f32x4){cur[4 * q], cur[4 * q + 1], cur[4 * q + 2], cur[4 * q + 3]};
                }
                float ss = 0.f;
#pragma unroll
                for (int e = 0; e < 16; ++e) { acc[e] = siluf_(acc[e]); ss += acc[e] * acc[e]; }
                if (p < 2) { ss += shfl_xor_l(ss, 1, lane); ss += shfl_xor_l(ss, 2, lane); ss += shfl_xor_l(ss, 4, lane);
                    float sc = rsqrtf(ss + EPS); if (p == 0) sc *= 0.08838834764831845f;
#pragma unroll
                    for (int e = 0; e < 16; ++e) acc[e] *= sc; }
                u32x4 w0, w1;
#pragma unroll
                for (int e = 0; e < 4; ++e) { w0[e] = ok ? cvt2(acc[2 * e], acc[2 * e + 1]) : 0u; w1[e] = ok ? cvt2(acc[8 + 2 * e], acc[8 + 2 * e + 1]) : 0u; }
                LAS u32x4* dst = (LAS u32x4*)(L + (p == 0 ? G1_QS : p == 1 ? G1_KS : G1_VS) + r * 272 + j * 32);
                dst[0] = w0; dst[1] = w1;
                __builtin_amdgcn_sched_barrier(0);
            }
            { const int ntk = task + stride < 4095 ? task + stride : 4095; int s1, c1, h1; g1_decode(ntk, s1, c1, h1); g1_load_raw(F, raw, s1, c1, h1, t1);
#pragma unroll
              for (int q = 0; q < 3; ++q) { const int i = t1 + 512 * q, jj = i / 384, cc = i % 384; pcw[q] = F.in[29][(size_t)jj * 3072 + (cc >> 7) * 1024 + h1 * 128 + (cc & 127)]; }
              const float* ba = F.BA() + (size_t)(s1 * TP + c1 * 64 + (t1 & 63)) * 16; pb = ba[h1]; pa = ba[8 + h1]; }
        }
        LDS_BARRIER();
        {
            int l2 = lane; asm volatile("" : "+v"(l2));
            const int which = wave >> 2, ti = (wave >> 1) & 1, tj = wave & 1, r = l2 & 31, hh = l2 >> 5;
            f32x16 acc;
#pragma unroll
            for (int e = 0; e < 16; ++e) acc[e] = 0.f;
            if (!(ti == 0 && tj == 1)) {
                const LAS unsigned char* ap = L + (which ? G1_QS : G1_KS) + (32 * ti + r) * 272 + hh * 16;
                const LAS unsigned char* bp = L + G1_KS + (32 * tj + r) * 272 + hh * 16;
#pragma unroll
                for (int ks = 0; ks < 8; ++ks) { const bf16x8 a = *(const LAS bf16x8*)(ap + ks * 32), b = *(const LAS bf16x8*)(bp + ks * 32); acc = MFMA32(a, b, acc); }
            }
            const int jc = 32 * tj + r; const float gj = gcum_s[jc];
#pragma unroll
            for (int e = 0; e < 16; ++e) {
                const int i = 32 * ti + (e & 3) + 8 * (e >> 2) + 4 * hh; const float dg = gcum_s[i] - gj;
                if (which == 0) { const float f = (i > jc) ? __expf(dg) * beta_s[i] : 0.f; *(LAS float*)(L + G1_AS + i * 272 + jc * 4) = acc[e] * f; }
                else { const float f = (i >= jc) ? __expf(dg) : 0.f; *(LAS bf16_t*)(L + G1_PS + i * 144 + jc * 2) = (bf16_t)(cvt2(acc[e] * f, 0.f) & 0xffffu); }
            }
        }
        LDS_BARRIER();
        if (wave == 0) {
            int l3 = lane; asm volatile("" : "+v"(l3));
            const int bk = l3 >> 4, col = l3 & 15;
            float tcol[16];
#pragma unroll
            for (int rr = 0; rr < 16; ++rr) {
                float a = (rr == col) ? 1.0f : 0.f;
#pragma unroll
                for (int j4 = 0; j4 < (rr + 3) / 4; ++j4) { const f32x4 a4 = *(const LAS f32x4*)(L + G1_AS + (16 * bk + rr) * 272 + (16 * bk + 4 * j4) * 4);
#pragma unroll
                    for (int q = 0; q < 4; ++q) if (4 * j4 + q < rr) a -= a4[q] * tcol[4 * j4 + q]; }
                tcol[rr] = a;
                *(LAS float*)(L + G1_ES + ((bk * 16 + rr) * 16 + col) * 4) = a - ((rr == col) ? 1.0f : 0.f);
            }
        } else if (wave >= 4) {
            int l3 = lane; asm volatile("" : "+v"(l3));
            const int wv = wave - 4, r = l3 & 31, hh = l3 >> 5;
            {   const int rt4 = wv;
#pragma unroll
                for (int kt2 = 0; kt2 < 2; ++kt2)
#pragma unroll
                    for (int ss = 0; ss < 2; ++ss) { float v[8];
#pragma unroll
                        for (int j = 0; j < 8; ++j) { const int tok = 32 * kt2 + krow(ss, hh, j); v[j] = bf2f(*(const LAS bf16_t*)(L + G1_KS + tok * 272 + (32 * rt4 + r) * 2)) * ek_s[tok]; }
                        u32x4 o; o[0] = cvt2(v[0], v[1]); o[1] = cvt2(v[2], v[3]); o[2] = cvt2(v[4], v[5]); o[3] = cvt2(v[6], v[7]);
                        st16_wt(srs, boff + GS_KF + ((rt4 * 2 + kt2) * 2 + ss) * 1024 + l3 * 16, o); } }
            {   const int kt = wv;
#pragma unroll
                for (int rt = 0; rt < 2; ++rt)
#pragma unroll
                    for (int ss = 0; ss < 2; ++ss) { const int i = 32 * rt + r; const float sc = eg_s[i];
                        const u32x2 lo = *(const LAS u32x2*)(L + G1_QS + i * 272 + (32 * kt + 16 * ss + 4 * hh) * 2), hi = *(const LAS u32x2*)(L + G1_QS + i * 272 + (32 * kt + 16 * ss + 8 + 4 * hh) * 2);
                        u32x4 o; o[0] = cvt2(lo16(lo[0]) * sc, hi16(lo[0]) * sc); o[1] = cvt2(lo16(lo[1]) * sc, hi16(lo[1]) * sc); o[2] = cvt2(lo16(hi[0]) * sc, hi16(hi[0]) * sc); o[3] = cvt2(lo16(hi[1]) * sc, hi16(hi[1]) * sc);
                        st16_wt(srs, boff + GS_QF + ((rt * 4 + kt) * 2 + ss) * 1024 + l3 * 16, o); } }
            {   const int rt = wv >> 1, kt2 = wv & 1;
#pragma unroll
                for (int ss = 0; ss < 2; ++ss) { const int i = 32 * rt + r;
                    const u32x2 lo = *(const LAS u32x2*)(L + G1_PS + i * 144 + (32 * kt2 + 16 * ss + 4 * hh) * 2), hi = *(const LAS u32x2*)(L + G1_PS + i * 144 + (32 * kt2 + 16 * ss + 8 + 4 * hh) * 2);
                    u32x4 o; o[0] = lo[0]; o[1] = lo[1]; o[2] = hi[0]; o[3] = hi[1];
                    st16_wt(srs, boff + GS_PF + ((rt * 2 + kt2) * 2 + ss) * 1024 + l3 * 16, o); } }
        }
        LDS_BARRIER();
        {
            int l4 = lane; asm volatile("" : "+v"(l4));
            const int c16 = l4 & 15, g = l4 >> 4;
            const f32x4 z4 = {0.f, 0.f, 0.f, 0.f};
            f32x4 a10, a20, a21, a30, a31, a32, e0, e1, e2, e3;
            { const LAS unsigned char* ar = L + G1_AS + c16 * 272 + (4 * g) * 4;
              a10 = *(const LAS f32x4*)(ar + 16 * 272); a20 = *(const LAS f32x4*)(ar + 32 * 272); a21 = *(const LAS f32x4*)(ar + 32 * 272 + 64);
              a30 = *(const LAS f32x4*)(ar + 48 * 272); a31 = *(const LAS f32x4*)(ar + 48 * 272 + 64); a32 = *(const LAS f32x4*)(ar + 48 * 272 + 128);
              const LAS unsigned char* er = L + G1_ES + (c16 * 16 + 4 * g) * 4;
              e0 = *(const LAS f32x4*)er; e1 = *(const LAS f32x4*)(er + 1024); e2 = *(const LAS f32x4*)(er + 2048); e3 = *(const LAS f32x4*)(er + 3072); }
            const bf16x8 fA10 = g1_pack_b(z4 - a10, z4), fA2 = g1_pack_b(z4 - a20, z4 - a21), fA3a = g1_pack_b(z4 - a30, z4 - a31), fA3b = g1_pack_b(z4 - a32, z4);
            const bf16x8 fE0 = g1_pack_b(e0, z4), fE1 = g1_pack_b(e1, z4), fE2 = g1_pack_b(e2, z4), fE3 = g1_pack_b(e3, z4);
            const bool isw = wave < 4; const int cbase = 32 * (wave & 3);
#pragma unroll
            for (int tl = 0; tl < 2; ++tl) {
                const int d = cbase + 16 * tl + c16;
                f32x4 R[4];
#pragma unroll
                for (int i = 0; i < 4; ++i)
#pragma unroll
                    for (int e = 0; e < 4; ++e) { const int row = 16 * i + 4 * g + e; const float raw1 = bf2f(*(const LAS bf16_t*)(L + (isw ? G1_KS : G1_VS) + row * 272 + d * 2)); R[i][e] = raw1 * beta_s[row] * (isw ? eg_s[row] : 1.0f); }
                const f32x4 X0 = MFMA16(fE0, g1_pack_b(R[0], z4), R[0]);
                const f32x4 Y1 = MFMA16(fA10, g1_pack_b(X0, z4), R[1]);
                const f32x4 X1 = MFMA16(fE1, g1_pack_b(Y1, z4), Y1);
                const f32x4 Y2 = MFMA16(fA2, g1_pack_b(X0, X1), R[2]);
                const f32x4 X2 = MFMA16(fE2, g1_pack_b(Y2, z4), Y2);
                f32x4 Y3 = MFMA16(fA3a, g1_pack_b(X0, X1), R[3]);
                Y3 = MFMA16(fA3b, g1_pack_b(X2, z4), Y3);
                const f32x4 X3 = MFMA16(fE3, g1_pack_b(Y3, z4), Y3);
                const f32x4 X[4] = {X0, X1, X2, X3};
                if (isw) {
#pragma unroll
                    for (int i = 0; i < 4; ++i)
#pragma unroll
                        for (int e = 0; e < 4; ++e) *(LAS bf16_t*)(L + G1_WS + (16 * i + 4 * g + e) * 272 + d * 2) = (bf16_t)(cvt2(-X[i][e], 0.f) & 0xffffu);
                } else {
                    const int ws = wave & 3, cc = 16 * tl + c16;
#pragma unroll
                    for (int i = 0; i < 4; ++i) { const int rt = i >> 1, q = 2 * (i & 1) + (g >> 1), hh = g & 1;
                        u32x2 o; o[0] = cvt2(X[i][0], X[i][1]); o[1] = cvt2(X[i][2], X[i][3]);
                        st8_wt(blk + GS_UF + (size_t)(((ws * 2 + rt) * 64) + cc + 32 * hh) * 32 + q * 8, o); }
                }
            }
        }
        LDS_BARRIER();
        {
            int l5 = lane; asm volatile("" : "+v"(l5));
            const int kt = wave & 3, rt = wave >> 2, r = l5 & 31, hh = l5 >> 5, i = 32 * rt + r;
#pragma unroll
            for (int ss = 0; ss < 2; ++ss) {
                const u32x2 lo = *(const LAS u32x2*)(L + G1_WS + i * 272 + (32 * kt + 16 * ss + 4 * hh) * 2), hi = *(const LAS u32x2*)(L + G1_WS + i * 272 + (32 * kt + 16 * ss + 8 + 4 * hh) * 2);
                u32x4 o; o[0] = lo[0]; o[1] = lo[1]; o[2] = hi[0]; o[3] = hi[1];
                st16_wt(srs, boff + GS_WF + ((rt * 4 + kt) * 2 + ss) * 1024 + l5 * 16, o); }
        }
        asm volatile("s_waitcnt vmcnt(0)" ::: "memory");
        LDS_BARRIER();
        if (tid == 0) __hip_atomic_store(ready + 16 * sidx, 1u, __ATOMIC_RELAXED, __HIP_MEMORY_SCOPE_AGENT);
    }
}

constexpr int G2_FB = GS_BYTES, G2_OSTRIDE = 528, G2_HN = 2 * G2_FB, G2_DEC = G2_HN + 512;
__device__ __forceinline__ bf16x8 pack8(const f32x16& x, const int s) {
    u32x4 p; p[0] = cvt2(x[8 * s], x[8 * s + 1]); p[1] = cvt2(x[8 * s + 2], x[8 * s + 3]); p[2] = cvt2(x[8 * s + 4], x[8 * s + 5]); p[3] = cvt2(x[8 * s + 6], x[8 * s + 7]);
    return __builtin_bit_cast(bf16x8, p);
}
template <bool WT>
__device__ __forceinline__ void g2_load_set(u32x4 (&pre)[18], float& dpre, const unsigned char* blk, int lt, brsrc_t srs, unsigned boff, const unsigned* flag, const float* decp) {
    if (WT) { unsigned sp = 0; while (__builtin_amdgcn_readfirstlane(__hip_atomic_load(flag, __ATOMIC_RELAXED, __HIP_MEMORY_SCOPE_AGENT)) == 0u && ++sp < (1u << 20)) __builtin_amdgcn_s_sleep(4);
        dpre = __uint_as_float(__hip_atomic_load((const unsigned*)decp, __ATOMIC_RELAXED, __HIP_MEMORY_SCOPE_AGENT));
#pragma unroll
        for (int i = 0; i < 18; ++i) pre[i] = ld16_wt(srs, boff + (unsigned)(i * 256 + lt) * 16u);
    } else { const u32x4* src = (const u32x4*)blk; dpre = *decp;
#pragma unroll
        for (int i = 0; i < 18; ++i) pre[i] = src[i * 256 + lt]; }
}
__device__ __forceinline__ void g2_store_set(const u32x4 (&pre)[18], LAS unsigned char* dst, int lt) {
#pragma unroll
    for (int i = 0; i < 18; ++i) *(LAS u32x4*)(dst + (size_t)(i * 256 + lt) * 16) = pre[i];
}
#define G2_FRAG(off) (*(const LAS bf16x8*)(B + (off)))
#define G2_SCHED() __builtin_amdgcn_sched_barrier(0)
__device__ __forceinline__ void g2_mfma_step(f32x16& S0, f32x16& S1, f32x16& S2, f32x16& S3, LAS unsigned char* Bimg, const float dec, int ws, int lane, int cc, int hh) {
    const LAS unsigned char* B = Bimg + lane * 16;
    f32x16 vn0, vn1, o0, o1;
    { const LAS u32x4* up = (const LAS u32x4*)(Bimg + GS_UF + (size_t)(ws * 2 * 64 + lane) * 32); const u32x4 u0 = up[0], u1 = up[1], u2 = up[128], u3 = up[129];
#pragma unroll
      for (int q = 0; q < 4; ++q) { vn0[2 * q] = lo16(u0[q]); vn0[2 * q + 1] = hi16(u0[q]); vn0[8 + 2 * q] = lo16(u1[q]); vn0[8 + 2 * q + 1] = hi16(u1[q]);
                                    vn1[2 * q] = lo16(u2[q]); vn1[2 * q + 1] = hi16(u2[q]); vn1[8 + 2 * q] = lo16(u3[q]); vn1[8 + 2 * q + 1] = hi16(u3[q]); } }
#pragma unroll
    for (int e = 0; e < 16; ++e) { o0[e] = 0.f; o1[e] = 0.f; }
#define G2_WQ(Sx, kt) do { _Pragma("unroll") for (int ss = 0; ss < 2; ++ss) { const bf16x8 sb = pack8(Sx, ss); \
        const bf16x8 fw0 = G2_FRAG(GS_WF + ((0 * 4 + kt) * 2 + ss) * 1024), fw1 = G2_FRAG(GS_WF + ((1 * 4 + kt) * 2 + ss) * 1024); \
        const bf16x8 fq0 = G2_FRAG(GS_QF + ((0 * 4 + kt) * 2 + ss) * 1024), fq1 = G2_FRAG(GS_QF + ((1 * 4 + kt) * 2 + ss) * 1024); \
        vn0 = MFMA32(fw0, sb, vn0); vn1 = MFMA32(fw1, sb, vn1); o0 = MFMA32(fq0, sb, o0); o1 = MFMA32(fq1, sb, o1); } } while (0)
    G2_WQ(S0, 0); G2_WQ(S1, 1); G2_WQ(S2, 2); G2_WQ(S3, 3);
#undef G2_WQ
    bf16x8 vb[2][2];
    vb[0][0] = pack8(vn0, 0); vb[0][1] = pack8(vn0, 1); vb[1][0] = pack8(vn1, 0); vb[1][1] = pack8(vn1, 1);
#pragma unroll
    for (int kt2 = 0; kt2 < 2; ++kt2)
#pragma unroll
        for (int ss = 0; ss < 2; ++ss) { o0 = MFMA32(G2_FRAG(GS_PF + ((0 * 2 + kt2) * 2 + ss) * 1024), vb[kt2][ss], o0); o1 = MFMA32(G2_FRAG(GS_PF + ((1 * 2 + kt2) * 2 + ss) * 1024), vb[kt2][ss], o1); }
    S0 = S0 * dec; S1 = S1 * dec; S2 = S2 * dec; S3 = S3 * dec;
#pragma unroll
    for (int kt2 = 0; kt2 < 2; ++kt2)
#pragma unroll
        for (int ss = 0; ss < 2; ++ss) {
            S0 = MFMA32(G2_FRAG(GS_KF + ((0 * 2 + kt2) * 2 + ss) * 1024), vb[kt2][ss], S0); S1 = MFMA32(G2_FRAG(GS_KF + ((1 * 2 + kt2) * 2 + ss) * 1024), vb[kt2][ss], S1);
            S2 = MFMA32(G2_FRAG(GS_KF + ((2 * 2 + kt2) * 2 + ss) * 1024), vb[kt2][ss], S2); S3 = MFMA32(G2_FRAG(GS_KF + ((3 * 2 + kt2) * 2 + ss) * 1024), vb[kt2][ss], S3); }
    LDS_BARRIER();
#pragma unroll
    for (int e = 0; e < 16; ++e) { const int rr = (e & 3) + 8 * (e >> 2) + 4 * hh;
        *(LAS float*)(Bimg + rr * G2_OSTRIDE + (32 * ws + cc) * 4) = o0[e]; *(LAS float*)(Bimg + (32 + rr) * G2_OSTRIDE + (32 * ws + cc) * 4) = o1[e]; }
    LDS_BARRIER();
}
__device__ __forceinline__ void g2_epi_step(Frame& F, LAS unsigned char* L, const LAS unsigned char* Oimg, const u32x4 (&zz)[4], int row, int seg, size_t m, int h, bool rok, int lane) {
    float ss = 0.f;
#pragma unroll
    for (int q = 0; q < 8; ++q) { const f32x4 ov = *(const LAS f32x4*)(Oimg + row * G2_OSTRIDE + (seg * 32 + 4 * q) * 4); ss += (ov[0] * ov[0] + ov[1] * ov[1]) + (ov[2] * ov[2] + ov[3] * ov[3]); }
    ss += shfl_xor_l(ss, 1, lane); ss += shfl_xor_l(ss, 2, lane);
    const float rn = rsqrtf(ss * (1.f / 128.f) + EPS);
    if (rok) {
        u32x4* yp = (u32x4*)(F.Y1() + m * D + h * 128 + seg * 32);
        const LAS float* hn_s = (const LAS float*)(L + G2_HN);
#pragma unroll
        for (int q = 0; q < 4; ++q) {
            const f32x4 oa = *(const LAS f32x4*)(Oimg + row * G2_OSTRIDE + (seg * 32 + 8 * q) * 4), ob = *(const LAS f32x4*)(Oimg + row * G2_OSTRIDE + (seg * 32 + 8 * q + 4) * 4);
            const f32x4 ha = *(const LAS f32x4*)(hn_s + seg * 32 + 8 * q), hb = *(const LAS f32x4*)(hn_s + seg * 32 + 8 * q + 4);
            u32x4 yo;
            yo[0] = cvt2(oa[0] * rn * ha[0] * siluf_(lo16(zz[q][0])), oa[1] * rn * ha[1] * siluf_(hi16(zz[q][0])));
            yo[1] = cvt2(oa[2] * rn * ha[2] * siluf_(lo16(zz[q][1])), oa[3] * rn * ha[3] * siluf_(hi16(zz[q][1])));
            yo[2] = cvt2(ob[0] * rn * hb[0] * siluf_(lo16(zz[q][2])), ob[1] * rn * hb[1] * siluf_(hi16(zz[q][2])));
            yo[3] = cvt2(ob[2] * rn * hb[2] * siluf_(lo16(zz[q][3])), ob[3] * rn * hb[3] * siluf_(hi16(zz[q][3])));
            yp[q] = yo; }
    }
}
template <int NCH, bool WT>
__device__ __forceinline__ void g2_task(Frame& F, LAS unsigned char* L, const float* DEC, int s, int h, int ch0, int tid, int lane, int wave) {
    const size_t cstep = (size_t)GS_BYTES;
    const int base = seq_base(s), nvalid = s < BP ? 64 : TS;
    const unsigned char* blk0 = F.ws + WS_RB + (size_t)ch0 * GS_BYTES;
    constexpr int lastc = NCH - 1;
    if (wave < 4) {
        const int ws = wave, cc = lane & 31, hh = lane >> 5;
        f32x16 S0, S1, S2, S3;
        if (s < BP) {
#pragma unroll
            for (int e = 0; e < 16; ++e) { S0[e] = 0.f; S1[e] = 0.f; S2[e] = 0.f; S3[e] = 0.f; }
        } else {
            const float* sp = F.in[7] + ((size_t)(s - BP) * 8 + h) * 16384 + 32 * ws + cc;
#pragma unroll
            for (int e = 0; e < 16; ++e) { const int rr = (e & 3) + 8 * (e >> 2) + 4 * hh; S0[e] = sp[(size_t)rr * 128]; S1[e] = sp[(size_t)(32 + rr) * 128]; S2[e] = sp[(size_t)(64 + rr) * 128]; S3[e] = sp[(size_t)(96 + rr) * 128]; }
        }
        const LAS float* dec_s = (const LAS float*)(L + G2_DEC);
        LDS_BARRIER();
        if (NCH == 1) g2_mfma_step(S0, S1, S2, S3, L, dec_s[0], ws, lane, cc, hh);
        else for (int c = 0; c < NCH; c += 2) {
            g2_mfma_step(S0, S1, S2, S3, L, dec_s[c], ws, lane, cc, hh);
            g2_mfma_step(S0, S1, S2, S3, L + G2_FB, dec_s[c + 1], ws, lane, cc, hh);
        }
        int l9 = lane; asm volatile("" : "+v"(l9));
        const int cc9 = l9 & 31, hh9 = l9 >> 5;
        float* so = (s < BP ? F.out + O_GSP + ((size_t)s * 8 + h) * 16384 : F.out + O_GSS + ((size_t)(s - BP) * 8 + h) * 16384) + 32 * ws + cc9;
#pragma unroll
        for (int e = 0; e < 16; ++e) { const int rr = (e & 3) + 8 * (e >> 2) + 4 * hh9; so[(size_t)rr * 128] = S0[e]; so[(size_t)(32 + rr) * 128] = S1[e]; so[(size_t)(64 + rr) * 128] = S2[e]; so[(size_t)(96 + rr) * 128] = S3[e]; }
    } else {
        const int lt = tid - 256;
        if (lt < 128) ((LAS float*)(L + G2_HN))[lt] = F.in[32][lt];
        const brsrc_t srs = staging_rsrc(F.ws);
        const unsigned* ready = (const unsigned*)(F.ws + WS_READY);
        LAS float* dec_w = (LAS float*)(L + G2_DEC);
#define G2_LOAD(pre, dpre, k) do { const int _k = (k) < lastc ? (k) : lastc; g2_load_set<WT>(pre, dpre, blk0 + (size_t)_k * cstep, lt, srs, (unsigned)(ch0 + _k) * (unsigned)GS_BYTES, ready + 16 * (ch0 + _k), DEC + ch0 + _k); } while (0)
        u32x4 preA[18], preB[18]; float dA, dB;
        G2_LOAD(preA, dA, 0);
        G2_LOAD(preB, dB, 1);
        g2_store_set(preA, L, lt); if (lt == 0) dec_w[0] = dA;
        G2_LOAD(preA, dA, 2);
        const int row = lt >> 2, seg = lt & 3; const bool rok = row < nvalid;
        u32x4 zz[4];
        LDS_BARRIER();
        if (NCH == 1) {
            const size_t m = (size_t)base + row;
            if (rok) { const u32x4* zp = (const u32x4*)(F.Z1() + m * D + h * 128 + seg * 32);
#pragma unroll
                for (int q = 0; q < 4; ++q) zz[q] = zp[q]; }
            LDS_BARRIER();
            LDS_BARRIER();
            g2_epi_step(F, L, L, zz, row, seg, m, h, rok, lane);
        } else {
            for (int c = 0; c < NCH; c += 2) {
                {
                    const size_t m = (size_t)base + c * 64 + row;
                    { const u32x4* zp = (const u32x4*)(F.Z1() + m * D + h * 128 + seg * 32);
#pragma unroll
                      for (int q = 0; q < 4; ++q) zz[q] = zp[q]; }
                    g2_store_set(preB, L + G2_FB, lt); if (lt == 0) dec_w[(c + 1) & 63] = dB;
                    G2_LOAD(preB, dB, c + 3);
                    LDS_BARRIER();
                    LDS_BARRIER();
                    g2_epi_step(F, L, L, zz, row, seg, m, h, rok, lane);
                }
                {
                    const size_t m = (size_t)base + (c + 1) * 64 + row;
                    { const u32x4* zp = (const u32x4*)(F.Z1() + m * D + h * 128 + seg * 32);
#pragma unroll
                      for (int q = 0; q < 4; ++q) zz[q] = zp[q]; }
                    g2_store_set(preA, L, lt); if (lt == 0) dec_w[(c + 2) & 63] = dA;
                    G2_LOAD(preA, dA, c + 4);
                    LDS_BARRIER();
                    LDS_BARRIER();
                    g2_epi_step(F, L, L + G2_FB, zz, row, seg, m, h, rok, lane);
                }
            }
        }
    }
}
#undef G2_LOAD
constexpr int G12_CHAINS = 64;
__device__ __forceinline__ void phase_gdn_fused(Frame& F) {
    LAS unsigned char* L = F.lds;
    const float* DEC = (const float*)(F.ws + WS_DEC);
    if ((int)blockIdx.x < G12_CHAINS && F.G > G12_CHAINS) {
        const int tid = opaque_tid(F.wv);
        const int ci = blockIdx.x;
        g2_task<64, true>(F, L, DEC, ci >> 3, ci & 7, ci * 64, tid, tid & 63, F.wv);
    } else {
        const bool all = !(F.G > G12_CHAINS);
        const int p = all ? (int)blockIdx.x : (int)blockIdx.x - G12_CHAINS, np = all ? F.G : F.G - G12_CHAINS;
        gdn_g1_tasks(F, p, np);
        for (int t = p; t < 128; t += np) {
            const int tid = opaque_tid(F.wv);
            __syncthreads();
            g2_task<1, true>(F, L, DEC, BP + (t >> 3), t & 7, 4096 + t, tid, tid & 63, F.wv);
        }
    }
}

__device__ __forceinline__ float dpp_shr_f(float idv, float x, const int o) {
    int r;
    switch (o) {
        case 1: r = __builtin_amdgcn_update_dpp(__float_as_int(idv), __float_as_int(x), 0x111, 0xf, 0xf, false); break;
        case 2: r = __builtin_amdgcn_update_dpp(__float_as_int(idv), __float_as_int(x), 0x112, 0xf, 0xf, false); break;
        case 4: r = __builtin_amdgcn_update_dpp(__float_as_int(idv), __float_as_int(x), 0x114, 0xf, 0xf, false); break;
        default: r = __builtin_amdgcn_update_dpp(__float_as_int(idv), __float_as_int(x), 0x118, 0xf, 0xf, false); break;
    }
    return __int_as_float(r);
}
template <int PASS>
__device__ __forceinline__ void phase_lru(Frame& F) {
    int tid = opaque_tid(F.wv);
    const int lane = tid & 63, wave = __builtin_amdgcn_readfirstlane(tid >> 6);
    const int gw = F.vcu * 8 + wave, NGW = F.G * 8, h = gw & 7, g = lane >> 4, l15 = lane & 15;
    LAS unsigned char* xs = F.lds + wave * 9216;
    LAS float* cst = (LAS float*)(F.lds + 73728 + wave * 768);
    const bf16_t* LGW = (const bf16_t*)(F.ws + WS_LGW);
    float* LAG = F.LAG();
    bf16x8 wfa[4][2], wfx[4][2];
#pragma unroll
    for (int nt = 0; nt < 4; ++nt)
#pragma unroll
        for (int ks = 0; ks < 2; ++ks) {
            wfa[nt][ks] = *(const bf16x8*)(LGW + ((size_t)(h * 2 + 0) * 64 + 16 * nt + l15) * 64 + 32 * ks + 8 * g);
            wfx[nt][ks] = *(const bf16x8*)(LGW + ((size_t)(h * 2 + 1) * 64 + 16 * nt + l15) * 64 + 32 * ks + 8 * g); }
    cst[lane] = F.in[18][h * 64 + lane]; cst[64 + lane] = F.in[20][h * 64 + lane]; cst[128 + lane] = softplusf_(-F.in[21][h * 64 + lane]);
    for (int task = gw; task < 4224; task += NGW) {
        int s, c; if (task < 4096) { s = task >> 9; c = (task >> 3) & 63; } else { s = BP + ((task - 4096) >> 3); c = 0; }
        const int T = seq_len(s), base = seq_base(s), t0 = c * 64, ntile = s < BP ? 4 : 1;
        {
            int l1 = lane; asm volatile("" : "+v"(l1));
            const int cg = l1 & 7, tp = l1 >> 3;
#pragma unroll 1
            for (int hf2 = 0; hf2 < 2; ++hf2) {
                const int chb = h * 64 + cg * 8 + hf2 * 4;
                float xr[11][4];
                if (s < BP) {
                    u32x2 w[11];
#pragma unroll
                    for (int i = 0; i < 11; ++i) { int tt = t0 + tp * 8 - 3 + i; tt = tt < 0 ? 0 : tt; w[i] = *(const u32x2*)(F.U0() + (size_t)(base + tt) * EV_IN + C_XA + chb); }
                    if (t0 == 0 && tp == 0) { w[0] = (u32x2){0u, 0u}; w[1] = (u32x2){0u, 0u}; w[2] = (u32x2){0u, 0u}; }
#pragma unroll
                    for (int i = 0; i < 11; ++i) { xr[i][0] = lo16(w[i][0]); xr[i][1] = hi16(w[i][0]); xr[i][2] = lo16(w[i][1]); xr[i][3] = hi16(w[i][1]); }
                } else {
#pragma unroll
                    for (int i = 0; i < 11; ++i) {
                        const int tt = t0 + tp * 8 - 3 + i;
                        if (tt >= 0 && tt < T) { const u32x2 w = *(const u32x2*)(F.U0() + (size_t)(base + tt) * EV_IN + C_XA + chb);
                            xr[i][0] = lo16(w[0]); xr[i][1] = hi16(w[0]); xr[i][2] = lo16(w[1]); xr[i][3] = hi16(w[1]); }
                        else if (tt < 0) { const f32x4 a = *(const f32x4*)(F.in[2] + ((size_t)(s - BP) * 3 + (tt + 3)) * 512 + chb); xr[i][0] = a[0]; xr[i][1] = a[1]; xr[i][2] = a[2]; xr[i][3] = a[3]; }
                        else { xr[i][0] = 0.f; xr[i][1] = 0.f; xr[i][2] = 0.f; xr[i][3] = 0.f; }
                    }
                }
                const f32x4 c0 = *(const f32x4*)(F.in[15] + chb), c1 = *(const f32x4*)(F.in[15] + 512 + chb), c2 = *(const f32x4*)(F.in[15] + 1024 + chb), c3 = *(const f32x4*)(F.in[15] + 1536 + chb), cb = *(const f32x4*)(F.in[16] + chb);
#pragma unroll
                for (int i = 0; i < 8; ++i) { float o[4];
#pragma unroll
                    for (int e = 0; e < 4; ++e) o[e] = c0[e] * xr[i][e] + c1[e] * xr[i + 1][e] + c2[e] * xr[i + 2][e] + c3[e] * xr[i + 3][e] + cb[e];
                    u32x2 w; w[0] = cvt2(o[0], o[1]); w[1] = cvt2(o[2], o[3]);
                    *(LAS u32x2*)(xs + (tp * 8 + i) * 144 + cg * 16 + hf2 * 8) = w; }
                if (PASS == 2 && t0 + 64 >= T && tp == ((T - 1) >> 3) - (t0 >> 3)) {
                    float* o = (s < BP ? F.out + O_LCP + (size_t)s * 3 * 512 : F.out + O_LCS + (size_t)(s - BP) * 3 * 512) + chb;
#pragma unroll
                    for (int q = 0; q < 3; ++q) *(f32x4*)(o + q * 512) = (f32x4){xr[8 + q][0], xr[8 + q][1], xr[8 + q][2], xr[8 + q][3]};
                }
            }
        }
        float hin[4][4], arun[4][4];
#pragma unroll
        for (int nt = 0; nt < 4; ++nt)
#pragma unroll
            for (int rg = 0; rg < 4; ++rg) { hin[nt][rg] = 0.f; arun[nt][rg] = 1.f; }
        if (PASS == 2) {
            float hf = s >= BP ? F.in[3][(s - BP) * 512 + h * 64 + lane] : 0.f;
            const f32x2* lp = (const f32x2*)LAG + (size_t)(s * 64) * 512 + h * 64 + lane;
            for (int j0 = 0; j0 < c; j0 += 16) { f32x2 v[16];
#pragma unroll
                for (int q = 0; q < 16; ++q) { const int jj = j0 + q < c ? j0 + q : c - 1; v[q] = lp[(size_t)jj * 512]; }
#pragma unroll
                for (int q = 0; q < 16; ++q) if (j0 + q < c) hf = v[q][0] * hf + v[q][1]; }
#pragma unroll
            for (int nt = 0; nt < 4; ++nt)
#pragma unroll
                for (int rg = 0; rg < 4; ++rg) hin[nt][rg] = shfl_idx(hf, 16 * nt + 4 * g + rg);
        }
        asm volatile("s_waitcnt lgkmcnt(0)" ::: "memory");
        for (int tt = 0; tt < ntile; ++tt) {
            const int tok = 16 * tt + l15;
            const bf16x8 b0 = *(const LAS bf16x8*)(xs + tok * 144 + (8 * g) * 2), b1 = *(const LAS bf16x8*)(xs + tok * 144 + (32 + 8 * g) * 2);
            const size_t m = (size_t)base + t0 + tok;
#pragma unroll
            for (int nt = 0; nt < 4; ++nt) {
                f32x4 za = {0.f, 0.f, 0.f, 0.f}, zx = {0.f, 0.f, 0.f, 0.f};
                za = MFMA16(wfa[nt][0], b0, za); za = MFMA16(wfa[nt][1], b1, za);
                zx = MFMA16(wfx[nt][0], b0, zx); zx = MFMA16(wfx[nt][1], b1, zx);
                const int n0 = 16 * nt + 4 * g;
                const u32x2 xw = *(const LAS u32x2*)(xs + tok * 144 + n0 * 2);
                const float xc[4] = {lo16(xw[0]), hi16(xw[0]), lo16(xw[1]), hi16(xw[1])};
                const f32x4 cba = *(const LAS f32x4*)(cst + n0), cbx = *(const LAS f32x4*)(cst + 64 + n0), csp = *(const LAS f32x4*)(cst + 128 + n0);
                float av[4], bv[4];
#pragma unroll
                for (int rg = 0; rg < 4; ++rg) {
                    const float r = sigmoidf_(za[rg] + cba[rg]), ig = sigmoidf_(zx[rg] + cbx[rg]), la = -8.0f * r * csp[rg], a = __expf(la);
                    av[rg] = a; bv[rg] = sqrtf(fmaxf(1.0f - a * a, 0.f)) * (ig * xc[rg]); }
#pragma unroll
                for (int o = 1; o < 16; o <<= 1)
#pragma unroll
                    for (int rg = 0; rg < 4; ++rg) { const float ap = dpp_shr_f(1.0f, av[rg], o), bp = dpp_shr_f(0.0f, bv[rg], o); bv[rg] = av[rg] * bp + bv[rg]; av[rg] = av[rg] * ap; }
                float hv[4];
#pragma unroll
                for (int rg = 0; rg < 4; ++rg) { hv[rg] = bv[rg] + av[rg] * hin[nt][rg]; hin[nt][rg] = shfl_idx(hv[rg], (lane & 48) | 15); }
                if (PASS == 1) {
#pragma unroll
                    for (int rg = 0; rg < 4; ++rg) arun[nt][rg] *= shfl_idx(av[rg], (lane & 48) | 15);
                } else {
                    const bool tok_ok = (t0 + tok) < T;
                    if (tok_ok) {
                        const u32x2 gw2 = *(const u32x2*)(F.U0() + m * EV_IN + C_GA + h * 64 + n0);
                        u32x2 yo; yo[0] = cvt2(hv[0] * siluf_(lo16(gw2[0])), hv[1] * siluf_(hi16(gw2[0]))); yo[1] = cvt2(hv[2] * siluf_(lo16(gw2[1])), hv[3] * siluf_(hi16(gw2[1])));
                        *(u32x2*)(F.Y0() + m * D + h * 64 + n0) = yo;
                        if (t0 + tok == T - 1) { float* o = (s < BP ? F.out + O_LHP + s * 512 : F.out + O_LHS + (s - BP) * 512) + h * 64 + n0; *(f32x4*)o = (f32x4){hv[0], hv[1], hv[2], hv[3]}; }
                    }
                }
                if (nt & 1) __builtin_amdgcn_sched_barrier(0);
            }
        }
        if (PASS == 1 && s < BP && l15 == 15) {
            f32x2* lp = (f32x2*)LAG + (size_t)(s * 64 + c) * 512 + h * 64;
#pragma unroll
            for (int nt = 0; nt < 4; ++nt)
#pragma unroll
                for (int rg = 0; rg < 4; ++rg) lp[16 * nt + 4 * g + rg] = (f32x2){arun[nt][rg], hin[nt][rg]};
        }
        asm volatile("s_waitcnt lgkmcnt(0)" ::: "memory");
    }
}

constexpr size_t RB_VTP = RB_WEND, RB_VTS = RB_VTP + (size_t)BP * 2 * 64 * TP * 2, RB_VTEND = RB_VTS + (size_t)BS * 2 * 64 * 192 * 2;
static_assert(RB_VTEND <= RB_BYTES, "ws map");
__device__ __forceinline__ void phase_vt_build(Frame& F) {
    PHASE_IDS();
    const int gw = F.vcu * 8 + wave, NGW = F.G * 8;
    LAS unsigned char* xs = F.lds + wave * 9216;
    bf16_t* VTP = (bf16_t*)(F.ws + WS_RB + RB_VTP); bf16_t* VTS = (bf16_t*)(F.ws + WS_RB + RB_VTS);
    for (int task = gw; task < 1024 + 96; task += NGW) {
        int s, kv, kb; if (task < 1024) { s = task >> 7; kv = (task >> 6) & 1; kb = task & 63; } else { const int r = task - 1024; s = BP + r / 6; kv = (r % 6) / 3; kb = r % 3; }
        const int row8 = lane >> 3, ch = lane & 7;
#pragma unroll
        for (int i = 0; i < 8; ++i) {
            const int key = 8 * i + row8, kg = kb * 64 + key; u32x4 w = {0u, 0u, 0u, 0u};
            if (s < BP) w = *(const u32x4*)(F.U0() + (size_t)(s * TP + kg) * EV_IN + C_V + kv * 64 + ch * 8);
            else if (kg < 128) { const f32x4* p = (const f32x4*)(F.in[5] + ((size_t)((s - BP) * 128 + kg) * 2 + kv) * 64 + ch * 8); const f32x4 a = p[0], b = p[1]; w[0] = cvt2(a[0], a[1]); w[1] = cvt2(a[2], a[3]); w[2] = cvt2(b[0], b[1]); w[3] = cvt2(b[2], b[3]); }
            else if (kg < 128 + TS) w = *(const u32x4*)(F.U0() + (size_t)(MP + (s - BP) * TS + (kg - 128)) * EV_IN + C_V + kv * 64 + ch * 8);
            *(LAS u32x4*)(xs + key * 144 + ch * 16) = w;
        }
        asm volatile("s_waitcnt lgkmcnt(0)" ::: "memory");
        bf16_t* dst = s < BP ? VTP + ((size_t)(s * 2 + kv) * 64 + lane) * TP + kb * 64 : VTS + ((size_t)((s - BP) * 2 + kv) * 64 + lane) * 192 + kb * 64;
#pragma unroll
        for (int q = 0; q < 8; ++q) { u32x4 o;
#pragma unroll
            for (int e = 0; e < 4; ++e) { const unsigned lo = *(const LAS bf16_t*)(xs + (8 * q + 2 * e) * 144 + lane * 2), hi = *(const LAS bf16_t*)(xs + (8 * q + 2 * e + 1) * 144 + lane * 2); o[e] = lo | (hi << 16); }
            *(u32x4*)(dst + 8 * q) = o; }
        asm volatile("s_waitcnt lgkmcnt(0)" ::: "memory");
    }
}
constexpr int AT_K = 0, AT_V = 27648;
__device__ __forceinline__ void attn_issue(Frame& F, const bf16_t* VTP, int task, int tid, int wave, int lane, u32x4 (&kreg)[3], u32x4 (&vreg)[3], u32x4 (&qreg)[4]) {
    const int s = task >> 7, c = (task >> 1) & 63, kv = task & 1, tok0 = c * 64 - 128;
#pragma unroll
    for (int i = 0; i < 3; ++i) { const int idx = tid + 512 * i, key = idx >> 3, ch = idx & 7; int tk = tok0 + key; tk = tk < 0 ? 0 : tk;
        kreg[i] = *(const u32x4*)(F.U0() + (size_t)(s * TP + tk) * EV_IN + C_K + kv * 64 + ch * 8); }
#pragma unroll
    for (int i = 0; i < 3; ++i) { const int idx = tid + 512 * i, d = idx / 24, ch = idx % 24; int tk = tok0 + ch * 8; tk = tk < 0 ? 0 : tk;
        vreg[i] = *(const u32x4*)(VTP + ((size_t)(s * 2 + kv) * 64 + d) * TP + tk); }
    const int g = wave >> 1, qh = wave & 1, hq = kv * 4 + g, r = lane & 31, hh = lane >> 5;
    const size_t m = (size_t)s * TP + c * 64 + qh * 32 + r;
#pragma unroll
    for (int ks = 0; ks < 4; ++ks) qreg[ks] = *(const u32x4*)(F.U0() + m * EV_IN + C_Q + hq * 64 + 16 * ks + 8 * hh);
}
__device__ __forceinline__ void phase_attn(Frame& F) {
    PHASE_IDS();
    LAS unsigned char* L = F.lds;
    const bf16_t* VTP = (const bf16_t*)(F.ws + WS_RB + RB_VTP); const bf16_t* VTS = (const bf16_t*)(F.ws + WS_RB + RB_VTS);
    u32x4 kreg[3], vreg[3], qreg[4];
    attn_issue(F, VTP, F.vcu < 1024 ? F.vcu : 0, tid, wave, lane, kreg, vreg, qreg);
    for (int ti = F.vcu; ti < 1024 + 64; ti += F.G) {
        if (ti >= 1024 && ti < 1056) continue;
        const int task = ti < 1024 ? ti : ti - 32;
        int s, c, kv; if (task < 1024) { s = task >> 7; c = (task >> 1) & 63; kv = task & 1; } else { s = BP + ((task - 1024) >> 1); c = 0; kv = task & 1; }
        const int base = seq_base(s), tok0 = c * 64 - 128;
        const int kmin = s < BP ? (tok0 < 0 ? -tok0 : 0) : 0, kmax = s < BP ? 192 : 128 + TS;
        const int tid = opaque_tid(F.wv), lane = tid & 63;
        const int g = wave >> 1, qh = wave & 1, hq = kv * 4 + g, r = lane & 31, hh = lane >> 5, qi = qh * 32 + r;
        const bool qok = s < BP ? true : qi < TS;
        const size_t m = (size_t)base + c * 64 + (qok ? qi : 0);
        bf16x8 qf[4]; u32x2 gbr[8];
        LDS_BARRIER();
        if (s < BP) {
#pragma unroll
            for (int i = 0; i < 3; ++i) { const int idx = tid + 512 * i, key = idx >> 3, ch = idx & 7; const u32x4 z = {0u, 0u, 0u, 0u}; *(LAS u32x4*)(L + AT_K + key * 144 + ch * 16) = key >= kmin ? kreg[i] : z; }
#pragma unroll
            for (int i = 0; i < 3; ++i) { const int idx = tid + 512 * i, d = idx / 24, ch = idx % 24; const u32x4 z = {0u, 0u, 0u, 0u}; *(LAS u32x4*)(L + AT_V + d * 400 + ch * 16) = ch * 8 >= kmin ? vreg[i] : z; }
#pragma unroll
            for (int ks = 0; ks < 4; ++ks) { u32x4 w;
#pragma unroll
                for (int e = 0; e < 4; ++e) w[e] = cvt2(lo16(qreg[ks][e]) * 0.125f, hi16(qreg[ks][e]) * 0.125f);
                qf[ks] = __builtin_bit_cast(bf16x8, w); }
        } else {
#pragma unroll
            for (int i = 0; i < 3; ++i) {
                const int idx = tid + 512 * i, key = idx >> 3, ch = idx & 7; u32x4 w = {0u, 0u, 0u, 0u};
                if (key < kmax) {
                    if (key < 128) { const f32x4* p = (const f32x4*)(F.in[4] + ((size_t)((s - BP) * 128 + key) * 2 + kv) * 64 + ch * 8); const f32x4 a = p[0], b2 = p[1]; w[0] = cvt2(a[0], a[1]); w[1] = cvt2(a[2], a[3]); w[2] = cvt2(b2[0], b2[1]); w[3] = cvt2(b2[2], b2[3]); }
                    else w = *(const u32x4*)(F.U0() + (size_t)(base + key - 128) * EV_IN + C_K + kv * 64 + ch * 8);
                }
                *(LAS u32x4*)(L + AT_K + key * 144 + ch * 16) = w;
            }
#pragma unroll
            for (int i = 0; i < 3; ++i) {
                const int idx = tid + 512 * i, d = idx / 24, ch = idx % 24, key = ch * 8;
                *(LAS u32x4*)(L + AT_V + d * 400 + ch * 16) = *(const u32x4*)(VTS + ((size_t)((s - BP) * 2 + kv) * 64 + d) * 192 + key);
            }
#pragma unroll
            for (int ks = 0; ks < 4; ++ks) { u32x4 w = {0u, 0u, 0u, 0u};
                if (qok) { const u32x4 x = *(const u32x4*)(F.U0() + m * EV_IN + C_Q + hq * 64 + 16 * ks + 8 * hh);
#pragma unroll
                    for (int e = 0; e < 4; ++e) w[e] = cvt2(lo16(x[e]) * 0.125f, hi16(x[e]) * 0.125f); }
                qf[ks] = __builtin_bit_cast(bf16x8, w); }
        }
#pragma unroll
        for (int qq = 0; qq < 4; ++qq) { gbr[2 * qq] = qok ? *(const u32x2*)(F.U0() + m * EV_IN + C_GB + hq * 64 + 8 * qq + 4 * hh) : (u32x2){0u, 0u}; gbr[2 * qq + 1] = qok ? *(const u32x2*)(F.U0() + m * EV_IN + C_GB + hq * 64 + 32 + 8 * qq + 4 * hh) : (u32x2){0u, 0u}; }
        { const int nt = ti + F.G < 1024 ? ti + F.G : (ti < 1024 ? ti : 0); int t9 = tid; asm volatile("" : "+v"(t9)); attn_issue(F, VTP, nt, t9, wave, t9 & 63, kreg, vreg, qreg); }
        const float sink = F.in[22][hq];
        LDS_BARRIER();
        float mrun = sink, lrun = 1.0f;
        f32x16 o0, o1;
#pragma unroll
        for (int e = 0; e < 16; ++e) { o0[e] = 0.f; o1[e] = 0.f; }
#pragma unroll 1
        for (int half = 0; half < 2; ++half) {
            f32x16 sc[3];
#pragma unroll
            for (int k3 = 0; k3 < 3; ++k3) {
                const int kt = 3 * half + k3;
#pragma unroll
                for (int e = 0; e < 16; ++e) sc[k3][e] = 0.f;
#pragma unroll
                for (int ks = 0; ks < 4; ++ks) { const bf16x8 kf = *(const LAS bf16x8*)(L + AT_K + (32 * kt + r) * 144 + (16 * ks + 8 * hh) * 2); sc[k3] = MFMA32(kf, qf[ks], sc[k3]); }
            }
            float mx = -1e30f;
#pragma unroll
            for (int k3 = 0; k3 < 3; ++k3)
#pragma unroll
                for (int e = 0; e < 16; ++e) { const int kidx = 32 * (3 * half + k3) + (e & 3) + 8 * (e >> 2) + 4 * hh; const bool ok = kidx >= kmin && kidx < kmax; sc[k3][e] = ok ? sc[k3][e] : -1e30f; mx = fmaxf(mx, sc[k3][e]); }
            mx = fmaxf(mx, shfl_xor_l(mx, 32, lane));
            const float mnew = fmaxf(mrun, mx), alpha = __expf(mrun - mnew);
            float psum = 0.f;
#pragma unroll
            for (int k3 = 0; k3 < 3; ++k3)
#pragma unroll
                for (int e = 0; e < 16; ++e) { const float p = __expf(sc[k3][e] - mnew); sc[k3][e] = p; psum += p; }
            psum += shfl_xor_l(psum, 32, lane);
            lrun = lrun * alpha + psum; mrun = mnew;
            o0 = o0 * alpha; o1 = o1 * alpha;
#pragma unroll
            for (int k3 = 0; k3 < 3; ++k3)
#pragma unroll
                for (int ss = 0; ss < 2; ++ss) {
                    const int kt = 3 * half + k3;
                    const bf16x8 pb = pack8(sc[k3], ss);
                    const LAS unsigned char* vp = L + AT_V + r * 400 + (32 * kt + 16 * ss + 4 * hh) * 2;
                    const u32x2 a0 = *(const LAS u32x2*)vp, a1 = *(const LAS u32x2*)(vp + 16), b0 = *(const LAS u32x2*)(vp + 32 * 400), b1 = *(const LAS u32x2*)(vp + 32 * 400 + 16);
                    const u32x4 va = {a0[0], a0[1], a1[0], a1[1]}, vb = {b0[0], b0[1], b1[0], b1[1]};
                    o0 = MFMA32(__builtin_bit_cast(bf16x8, va), pb, o0); o1 = MFMA32(__builtin_bit_cast(bf16x8, vb), pb, o1);
                }
        }
        const float il = __builtin_amdgcn_rcpf(lrun);
        if (qok) {
#pragma unroll
            for (int qq = 0; qq < 4; ++qq) {
                { const int d = 8 * qq + 4 * hh; const u32x2 gb = gbr[2 * qq];
                  u32x2 yo; yo[0] = cvt2(o0[4 * qq] * il * siluf_(lo16(gb[0])), o0[4 * qq + 1] * il * siluf_(hi16(gb[0]))); yo[1] = cvt2(o0[4 * qq + 2] * il * siluf_(lo16(gb[1])), o0[4 * qq + 3] * il * siluf_(hi16(gb[1])));
                  *(u32x2*)(F.Y0() + m * D + 512 + hq * 64 + d) = yo; }
                { const int d = 32 + 8 * qq + 4 * hh; const u32x2 gb = gbr[2 * qq + 1];
                  u32x2 yo; yo[0] = cvt2(o1[4 * qq] * il * siluf_(lo16(gb[0])), o1[4 * qq + 1] * il * siluf_(hi16(gb[0]))); yo[1] = cvt2(o1[4 * qq + 2] * il * siluf_(lo16(gb[1])), o1[4 * qq + 3] * il * siluf_(hi16(gb[1])));
                  *(u32x2*)(F.Y0() + m * D + 512 + hq * 64 + d) = yo; }
            }
        }
    }
    __syncthreads();
}

__device__ __forceinline__ void rows_final(Frame& F, const int m0, const int n, const int s, const int lane) {
    const float* MODP = (const float*)(F.ws + WS_MODP);
    f32x4 A1[4];
#pragma unroll
    for (int j = 0; j < 4; ++j) { const int c = 4 * lane + 256 * j; const f32x4 g = *(const f32x4*)(F.in[27] + c), gt = mod4(MODP, 1, s, 2048 + c);
#pragma unroll
        for (int e = 0; e < 4; ++e) A1[j][e] = gt[e] * g[e]; }
    u32x2 ycur[4]; f32x4 xcur[4];
#pragma unroll
    for (int j = 0; j < 4; ++j) { ycur[j] = *(const u32x2*)(F.YO() + (size_t)m0 * D + 4 * lane + 256 * j); xcur[j] = *(const f32x4*)(F.out + O_Y + (size_t)m0 * D + 4 * lane + 256 * j); }
    for (int i = 0; i < n; ++i) {
        const int m = m0 + i, mn = m0 + (i + 1 < n ? i + 1 : i); u32x2 ynxt[4]; f32x4 xnxt[4];
#pragma unroll
        for (int j = 0; j < 4; ++j) { ynxt[j] = *(const u32x2*)(F.YO() + (size_t)mn * D + 4 * lane + 256 * j); xnxt[j] = *(const f32x4*)(F.out + O_Y + (size_t)mn * D + 4 * lane + 256 * j); }
        f32x4 y[4]; float ss = 0.f;
#pragma unroll
        for (int j = 0; j < 4; ++j) { y[j] = (f32x4){lo16(ycur[j][0]), hi16(ycur[j][0]), lo16(ycur[j][1]), hi16(ycur[j][1])}; ss += (y[j][0] * y[j][0] + y[j][1] * y[j][1]) + (y[j][2] * y[j][2] + y[j][3] * y[j][3]); }
        const float r1 = rsqrtf(wave_sum(ss, lane) * (1.f / D) + EPS);
#pragma unroll
        for (int j = 0; j < 4; ++j) { f32x4 o;
#pragma unroll
            for (int e = 0; e < 4; ++e) o[e] = xcur[j][e] + A1[j][e] * (y[j][e] * r1);
            *(f32x4*)(F.out + O_Y + (size_t)m * D + 4 * lane + 256 * j) = o; }
#pragma unroll
        for (int j = 0; j < 4; ++j) { ycur[j] = ynxt[j]; xcur[j] = xnxt[j]; }
    }
}
__device__ __forceinline__ void phase_final_rowwise(Frame& F) {
    PHASE_IDS();
    const int gw = F.vcu * 8 + wave, NGW = F.G * 8;
    for (int w = gw; w < MP / 16; w += NGW) rows_final(F, w * 16, 16, w >> 8, lane);
    for (int w = gw; w < MS; w += NGW) rows_final(F, MP + w, 1, BP + (w >> 4), lane);
}

__global__ void __launch_bounds__(512, 2) fwd_megakernel(Params P) {
    extern __shared__ __attribute__((aligned(16))) unsigned char lds_raw[];
    Frame F;
    F.lds = (LAS unsigned char*)lds_raw;
    F.wv = __builtin_amdgcn_readfirstlane(threadIdx.x >> 6);
    F.G = gridDim.x; { const int bx = blockIdx.x; F.vcu = (F.G % 8 == 0) ? (bx % 8) * (F.G / 8) + bx / 8 : bx; }
    F.in = P.in; F.out = P.out; F.ws = P.ws;

    volatile LAS unsigned* misc = (volatile LAS unsigned*)(F.lds + LDS_BYTES - 64);
    if (threadIdx.x < 16) misc[threadIdx.x] = 0u;
    __syncthreads();
    XcdBarrier xbar = xcd_barrier_post((unsigned*)(P.ws + WS_CTL), misc);
#define GRID_BAR() xcd_barrier(xbar, F.wv)
    phase_mod0(F);
    GRID_BAR();
    phase_prologue(F);
    phase_mod1(F);
    phase_prenorm0(F);
    GRID_BAR();
    { pg8::Gemm g{F.XN(), F.W0I(), MT, EV_IN, D}; pg8::StaticOrder S; S.init(MT, EV_IN, F.G, (int)blockIdx.x);
      pg8::EpiBf16 E{F.U0(), EV_IN, 1 << 30, F.U0(), EV_IN}; pg8::gemm_phase(F.lds, g, S, E, F.wv); }
    GRID_BAR();
    phase_rope(F);
    phase_lru<1>(F);
    phase_vt_build(F);
    GRID_BAR();
    phase_lru<2>(F);
    phase_attn(F);
    GRID_BAR();
    { pg8::Gemm g{F.Y0(), F.W0O(), MT, D, D}; pg8::StaticOrder S; S.init(MT, D, F.G, (int)blockIdx.x);
      pg8::EpiBf16 E{F.YO(), D, 1 << 30, F.YO(), D}; pg8::gemm_phase(F.lds, g, S, E, F.wv); }
    GRID_BAR();
    phase_mid_rowwise(F);
    GRID_BAR();
    { pg8::Gemm g{F.XN(), F.W1I(), MT, OD_MAIN, D}; pg8::StaticOrder S; S.init(MT, OD_MAIN, F.G, (int)blockIdx.x);
      pg8::EpiBf16 E{F.QKV1(), 3072, 3072, F.Z1(), D}; pg8::gemm_phase(F.lds, g, S, E, F.wv); }
    GRID_BAR();
    phase_gdn_fused(F);
    GRID_BAR();
    { pg8::Gemm g{F.Y1(), F.W1O(), MT, D, D}; pg8::StaticOrder S; S.init(MT, D, F.G, (int)blockIdx.x);
      pg8::EpiBf16 E{F.YO(), D, 1 << 30, F.YO(), D}; pg8::gemm_phase(F.lds, g, S, E, F.wv); }
    GRID_BAR();
    phase_final_rowwise(F);
}

extern "C" void kernel_launch(void* const* d_in, const int* in_sizes, int n_in, void* d_out, int out_size, void* d_ws, size_t ws_size, hipStream_t stream) {
    static int grid = 0;
    if (grid == 0) {
        if (n_in != 34 || out_size != (int)O_END || ws_size < WS_END) { grid = -1; return; }
        int dev = 0, cus = 0, per_cu = 0;
        if (hipGetDevice(&dev) != hipSuccess || hipDeviceGetAttribute(&cus, hipDeviceAttributeMultiprocessorCount, dev) != hipSuccess) { grid = -1; return; }
        if (hipFuncSetAttribute((const void*)fwd_megakernel, hipFuncAttributeMaxDynamicSharedMemorySize, LDS_BYTES) != hipSuccess) { grid = -1; return; }
        if (hipOccupancyMaxActiveBlocksPerMultiprocessor(&per_cu, (const void*)fwd_megakernel, 512, LDS_BYTES) != hipSuccess || per_cu < 1) { grid = -1; return; }
        grid = cus;
    }
    if (grid < 0) return;
    if (hipMemsetAsync((char*)d_ws + WS_CTL, 0, 65536 + 4224 * 64, stream) != hipSuccess) return;
    Params p{};
    for (int i = 0; i < 34; ++i) p.in[i] = (const float*)d_in[i];
    p.out = (float*)d_out; p.ws = (unsigned char*)d_ws;
    void* args[] = {&p};
    (void)hipLaunchCooperativeKernel((const void*)fwd_megakernel, dim3(grid), dim3(512), args, LDS_BYTES, stream);
}
```

```cpp
#include <hip/hip_runtime.h>
#include <hip/hip_cooperative_groups.h>
namespace cg = cooperative_groups;

#define LAS __attribute__((address_space(3)))
typedef unsigned short bf16_t;
typedef short bf16x8 __attribute__((ext_vector_type(8)));
typedef float f32x4 __attribute__((ext_vector_type(4)));
typedef float f32x2 __attribute__((ext_vector_type(2)));
typedef unsigned u32x4 __attribute__((ext_vector_type(4)));
typedef unsigned u32x2 __attribute__((ext_vector_type(2)));

constexpr int D = 1024, BP = 8, TP = 4096, BS = 16, TS = 16;
constexpr int MP = BP * TP, MS = BS * TS, MT = MP + MS;
constexpr int NSEQ = BP + BS;
constexpr int EV_IN = 2304, OD_IN = 4112, OD_MAIN = 4096;
constexpr int C_XA = 0, C_GA = 512, C_Q = 1024, C_K = 1536, C_V = 1664, C_GB = 1792;
constexpr float EPS = 1e-6f;
constexpr size_t O_Y = 0, O_LCP = 33816576, O_LCS = 33828864, O_LHP = 33853440, O_LHS = 33857536, O_KP = 33865728, O_KS = 33996800,
                 O_VP = 34029568, O_VS = 34160640, O_GCP = 34193408, O_GCS = 34267136, O_GSP = 34414592, O_GSS = 35463168, O_END = 37560320;
constexpr size_t MiB = 1u << 20;
constexpr size_t WS_CTL = 0, WS_W1O = 1 * MiB, WS_MOD = 3 * MiB, WS_ROPE = 4 * MiB, WS_BA = 5 * MiB, WS_LAG = 8 * MiB, WS_LGW = 10 * MiB;
constexpr size_t WS_RA = 16 * MiB, RA_BYTES = (size_t)MT * 4096 * 2;
constexpr size_t WS_RB = WS_RA + RA_BYTES;
constexpr size_t ACT_BYTES = (size_t)MT * D * 2;
constexpr size_t RB_XN = 0, RB_Y0 = ACT_BYTES, RB_YO = 2 * ACT_BYTES, RB_W0I = 3 * ACT_BYTES, RB_W0O = RB_W0I + (size_t)EV_IN * D * 2,
                 RB_W1I = RB_W0O + (size_t)D * D * 2, RB_WEND = RB_W1I + (size_t)OD_MAIN * D * 2;
constexpr size_t RB_BYTES = (size_t)4224 * 73728;
constexpr size_t WS_END = WS_RB + RB_BYTES;
static_assert(RB_WEND <= RB_BYTES, "ws map");
static_assert((size_t)MT * 3072 * 2 <= RB_BYTES, "ws map");
constexpr int LDS_BYTES = 155648;

struct Params { const float* in[34]; float* out; unsigned char* ws; };

__device__ __forceinline__ float bf2f(bf16_t b) { return __uint_as_float(((unsigned)b) << 16); }
__device__ __forceinline__ unsigned f2bf(float f) { unsigned u = __float_as_uint(f); return (u + 0x7fffu + ((u >> 16) & 1u)) >> 16; }
__device__ __forceinline__ unsigned pk2(float lo, float hi) { return f2bf(lo) | (f2bf(hi) << 16); }
typedef __bf16 bf16x2_t __attribute__((ext_vector_type(2)));
__device__ __forceinline__ unsigned cvt2(float a, float b) { f32x2 v = {a, b}; bf16x2_t r = __builtin_convertvector(v, bf16x2_t); return __builtin_bit_cast(unsigned, r); }
__device__ __forceinline__ float lo16(unsigned w) { return __uint_as_float(w << 16); }
__device__ __forceinline__ float hi16(unsigned w) { return __uint_as_float(w & 0xffff0000u); }
__device__ __forceinline__ float shfl_idx(float x, int src_lane) { return __int_as_float(__builtin_amdgcn_ds_bpermute(src_lane << 2, __float_as_int(x))); }
__device__ __forceinline__ float shfl_xor_l(float x, int o, int lane) { return shfl_idx(x, lane ^ o); }
__device__ __forceinline__ float wave_sum(float v, int lane) {
#pragma unroll
    for (int o = 1; o < 64; o <<= 1) v += shfl_xor_l(v, o, lane);
    return v;
}
__device__ __forceinline__ float sigmoidf_(float x) { return __builtin_amdgcn_rcpf(1.0f + __expf(-x)); }
__device__ __forceinline__ float siluf_(float x) { return x * __builtin_amdgcn_rcpf(1.0f + __expf(-x)); }
__device__ __forceinline__ float softplusf_(float x) { return x > 20.f ? x : log1pf(__expf(x)); }
__device__ __forceinline__ int seq_base(int s) { return s < BP ? s * TP : MP + (s - BP) * TS; }
__device__ __forceinline__ int seq_len(int s) { return s < BP ? TP : TS; }
__device__ __forceinline__ void tok_info(int m, int& s, int& t) { if (m < MP) { s = m >> 12; t = m & 4095; } else { const int r = m - MP; s = BP + (r >> 4); t = r & 15; } }

__device__ __forceinline__ int opaque_tid(int wv) { unsigned z = 0u; asm volatile("" : "+v"(z)); const int l = __builtin_amdgcn_mbcnt_hi(~0u, __builtin_amdgcn_mbcnt_lo(~0u, z)); return wv * 64 + l; }
namespace pg8 {
constexpr int BM = 256, BK = 64, HALF = 128, HTB = HALF * BK * 2, STAGE_BYTES = 8 * HTB, NXCD = 8, WGM = 8;
__host__ __device__ __forceinline__ int lds_byte(int r, int c) { const int st = (r >> 4) * 2 + (c >> 5), rr = r & 15, cc = c & 31, ob = rr * 64 + cc * 2; return st * 1024 + (ob ^ (((ob >> 9) & 1) << 5)); }
__host__ __device__ __forceinline__ void stage_rc(int b, int& R, int& C) { const int st = b / 1024, sb = b % 1024, swz = sb ^ (((sb >> 9) & 1) << 5); R = (st >> 1) * 16 + swz / 64; C = (st & 1) * 32 + (swz % 64) / 2; }
__host__ __device__ __forceinline__ int perm32(int rho) { const int n = rho >> 4, i = rho & 15; return 8 * (i >> 2) + 4 * n + (i & 3); }
struct Unit { int pm, pn; };
struct Gemm { const bf16_t* A; const bf16_t* Bt; int M, N, K; };
struct StaticOrder {
    int nM, nN, nwg, G, c;
    __device__ void init(int M, int N, int G_, int c_) { nM = M / BM; nN = N / BM; nwg = nM * nN; G = G_; c = c_; }
    __device__ bool next(int i, Unit& u) const {
        const long L = (long)i * G + c; if (L >= nwg) return false;
        int wgid = (int)L; { const int q = nwg / NXCD, r = nwg % NXCD, xcd = wgid % NXCD, off = wgid / NXCD; wgid = (xcd < r ? xcd * (q + 1) : r * (q + 1) + (xcd - r) * q) + off; }
        const int nig = WGM * nN, gid = wgid / nig, fm = gid * WGM, gsz = (nM - fm) < WGM ? (nM - fm) : WGM;
        u.pm = fm + ((wgid % nig) % gsz); u.pn = (wgid % nig) / gsz; return true;
    }
};
__device__ __forceinline__ unsigned cvt_pk_bf16(float lo, float hi) { unsigned r; asm volatile("v_cvt_pk_bf16_f32 %0, %1, %2" : "=v"(r) : "v"(lo), "v"(hi)); return r; }
struct EpiBf16 {
    static constexpr bool PERM = true;
    bf16_t* O0; int ld0; int split; bf16_t* O1; int ld1;
    __device__ __forceinline__ void operator()(const f32x4 (&acc)[2][2][4][2], const Unit& u, int wr, int wc, int fr, int fq) const {
        const int row0 = u.pm * BM + wr * 64 + fr; int colt = u.pn * BM; bf16_t* base = O0; int ld = ld0;
        if (colt >= split) { base = O1; ld = ld1; colt -= split; }
        const int col0 = colt + wc * 32 + 8 * fq;
#pragma unroll
        for (int ai = 0; ai < 2; ++ai)
#pragma unroll
            for (int m = 0; m < 4; ++m) { bf16_t* rowp = base + (size_t)(row0 + ai * HALF + m * 16) * ld + col0;
#pragma unroll
                for (int bj = 0; bj < 2; ++bj) { const f32x4 v0 = acc[ai][bj][m][0], v1 = acc[ai][bj][m][1];
                    u32x4 w; w.x = cvt_pk_bf16(v0[0], v0[1]); w.y = cvt_pk_bf16(v0[2], v0[3]); w.z = cvt_pk_bf16(v1[0], v1[1]); w.w = cvt_pk_bf16(v1[2], v1[3]);
                    *(u32x4*)(rowp + bj * HALF) = w; } }
    }
};
template <class Epi, class Sched>
__device__ __forceinline__ void gemm_phase(LAS unsigned char* lds, const Gemm g, const Sched& S, const Epi& E, const int wv0) {
    int tid = opaque_tid(wv0);
    const int wid = __builtin_amdgcn_readfirstlane(tid >> 6), lane = tid & 63, wr = wid >> 2, wc = wid & 3, fr = lane & 15, fq = lane >> 4;
    const int K = g.K, nt = K / BK;
    unsigned voffA[2], voffB[2];
#pragma unroll
    for (int i = 0; i < 2; ++i) { int R, C; stage_rc(tid * 16 + i * 8192, R, C); const int Rb = Epi::PERM ? ((R & ~31) + perm32(R & 31)) : R;
        voffA[i] = (unsigned)(R * K + C) * 2u; voffB[i] = (unsigned)(Rb * K + C) * 2u; }
    const size_t kstep = (size_t)(BK * 2);
    const size_t hstep = (size_t)HALF * K * 2;
    const size_t tstep = 2 * hstep;
    const unsigned ldsw = (unsigned)wid * 1024u;
    const int aoff = lds_byte(wr * 64 + fr, fq * 8), boff = lds_byte(wc * 32 + fr, fq * 8);
#define PG8_SA(b, h) (((b) * 2 + (h)) * HTB)
#define PG8_SB(b, h) ((4 + (b) * 2 + (h)) * HTB)
#define PG8_STAGE(bufoff, gbase, voff) do { _Pragma("unroll") for (int _i = 0; _i < 2; ++_i) \
        __builtin_amdgcn_global_load_lds((const unsigned*)((const char*)(gbase) + (voff)[_i]), (LAS unsigned*)(lds + (bufoff) + ldsw + _i * 8192), 16, 0, 0); } while (0)
#define PG8_LDA(dst, b, h) do { _Pragma("unroll") for (int m = 0; m < 4; ++m) _Pragma("unroll") for (int k = 0; k < 2; ++k) dst[m][k] = *(const LAS bf16x8*)(lds + PG8_SA(b, h) + aoff + m * 2048 + k * 1024); } while (0)
#define PG8_LDB(dst, b, h) do { _Pragma("unroll") for (int n = 0; n < 2; ++n) _Pragma("unroll") for (int k = 0; k < 2; ++k) dst[n][k] = *(const LAS bf16x8*)(lds + PG8_SB(b, h) + boff + n * 2048 + k * 1024); } while (0)
#define PG8_MMA(ai, bj, At, Bt) do { __builtin_amdgcn_s_setprio(1); _Pragma("unroll") for (int m = 0; m < 4; ++m) _Pragma("unroll") for (int n = 0; n < 2; ++n) _Pragma("unroll") for (int k = 0; k < 2; ++k) \
        acc[ai][bj][m][n] = __builtin_amdgcn_mfma_f32_16x16x32_bf16(Bt[n][k], At[m][k], acc[ai][bj][m][n], 0, 0, 0); __builtin_amdgcn_s_setprio(0); } while (0)
#define PG8_WAIT_V(n) asm volatile("s_waitcnt vmcnt(" #n ")" ::: "memory")
#define PG8_WAIT_L(n) asm volatile("s_waitcnt lgkmcnt(" #n ")" ::: "memory")
#define PG8_BAR __builtin_amdgcn_s_barrier()
#define PG8_SCHED __builtin_amdgcn_sched_barrier(0)
    Unit cur, nxt; int ui = 0;
    if (!S.next(0, cur)) return;
    f32x4 acc[2][2][4][2];
#pragma unroll
    for (int a = 0; a < 2; ++a)
#pragma unroll
        for (int b = 0; b < 2; ++b)
#pragma unroll
            for (int m = 0; m < 4; ++m)
#pragma unroll
                for (int n = 0; n < 2; ++n) acc[a][b][m][n] = (f32x4){0.f, 0.f, 0.f, 0.f};
    bf16x8 At[4][2], B0[2][2], B1[2][2];
    const char* cA = (const char*)g.A + (size_t)cur.pm * tstep; const char* cB = (const char*)g.Bt + (size_t)cur.pn * tstep;
    PG8_STAGE(PG8_SB(0, 0), cB, voffB); PG8_STAGE(PG8_SA(0, 0), cA, voffA); PG8_STAGE(PG8_SB(0, 1), cB + hstep, voffB); PG8_STAGE(PG8_SA(0, 1), cA + hstep, voffA);
    if (wr == 1) PG8_BAR;
    PG8_WAIT_V(4); PG8_BAR;
    PG8_STAGE(PG8_SB(1, 0), cB + kstep, voffB); PG8_STAGE(PG8_SA(1, 0), cA + kstep, voffA); PG8_STAGE(PG8_SB(1, 1), cB + hstep + kstep, voffB);
    PG8_WAIT_V(6); PG8_BAR;
    for (;;) {
        const bool has_next = S.next(ui + 1, nxt);
        const char* nA = has_next ? (const char*)g.A + (size_t)nxt.pm * tstep : cA; const char* nB = has_next ? (const char*)g.Bt + (size_t)nxt.pn * tstep : cB;
        for (int t = 0; t < nt; t += 2) {
            const bool last = (t == nt - 2);
            const char* a1 = cA + (size_t)(t + 1) * kstep;
            const char* a2 = last ? nA : cA + (size_t)(t + 2) * kstep; const char* b2 = last ? nB : cB + (size_t)(t + 2) * kstep;
            const char* a3 = a2 + kstep; const char* b3 = b2 + kstep;
            PG8_LDB(B0, 0, 0); PG8_SCHED; PG8_LDA(At, 0, 0); PG8_STAGE(PG8_SA(1, 1), a1 + hstep, voffA);
            PG8_WAIT_L(8); PG8_BAR; PG8_WAIT_L(0); PG8_MMA(0, 0, At, B0); PG8_BAR; PG8_SCHED;
            PG8_LDB(B1, 0, 1); PG8_STAGE(PG8_SB(0, 0), b2, voffB);
            PG8_BAR; PG8_WAIT_L(0); PG8_MMA(0, 1, At, B1); PG8_BAR;
            PG8_LDA(At, 0, 1); PG8_STAGE(PG8_SA(0, 0), a2, voffA);
            PG8_BAR; PG8_WAIT_L(0); PG8_MMA(1, 0, At, B0); PG8_BAR; PG8_SCHED;
            PG8_STAGE(PG8_SB(0, 1), b2 + hstep, voffB);
            PG8_WAIT_V(6); PG8_BAR; PG8_MMA(1, 1, At, B1); PG8_BAR;
            PG8_LDB(B0, 1, 0); PG8_SCHED; PG8_LDA(At, 1, 0); PG8_STAGE(PG8_SA(0, 1), a2 + hstep, voffA);
            PG8_WAIT_L(8); PG8_BAR; PG8_WAIT_L(0); PG8_MMA(0, 0, At, B0); PG8_BAR; PG8_SCHED;
            PG8_LDB(B1, 1, 1); PG8_STAGE(PG8_SB(1, 0), b3, voffB);
            PG8_BAR; PG8_WAIT_L(0); PG8_MMA(0, 1, At, B1); PG8_BAR;
            PG8_LDA(At, 1, 1); PG8_STAGE(PG8_SA(1, 0), a3, voffA);
            PG8_BAR; PG8_WAIT_L(0); PG8_MMA(1, 0, At, B0); PG8_BAR; PG8_SCHED;
            PG8_STAGE(PG8_SB(1, 1), b3 + hstep, voffB);
            PG8_WAIT_V(6); PG8_BAR; PG8_MMA(1, 1, At, B1); PG8_BAR;
        }
        E(acc, cur, wr, wc, fr, fq);
        if (!has_next) break;
#pragma unroll
        for (int a = 0; a < 2; ++a)
#pragma unroll
            for (int b = 0; b < 2; ++b)
#pragma unroll
                for (int m = 0; m < 4; ++m)
#pragma unroll
                    for (int n = 0; n < 2; ++n) acc[a][b][m][n] = (f32x4){0.f, 0.f, 0.f, 0.f};
        cur = nxt; cA = nA; cB = nB; ++ui;
    }
    PG8_WAIT_V(0);
    if (wr == 0) PG8_BAR;
    PG8_BAR;
#undef PG8_SA
#undef PG8_SB
#undef PG8_STAGE
#undef PG8_LDA
#undef PG8_LDB
#undef PG8_MMA
#undef PG8_WAIT_V
#undef PG8_WAIT_L
#undef PG8_BAR
#undef PG8_SCHED
}
}


#define XB_TMO      128
#define XB_XCNT(j)  (256  + 64 * (j))
#define XB_XSUB(j)  (1280 + 64 * (j))
#define XB_XGEN(j)  (2304 + 64 * (j))
#define XB_TOP      3328
#define XB_TOPGEN   3392
#define XCD_BAR_WORDS 3456
#define XB_SPIN_CAP (1u << 18)
__device__ __forceinline__ unsigned xb_ld(unsigned* p)              { return __hip_atomic_load(p, __ATOMIC_RELAXED, __HIP_MEMORY_SCOPE_AGENT); }
__device__ __forceinline__ unsigned xb_add(unsigned* p, unsigned v) { return __hip_atomic_fetch_add(p, v, __ATOMIC_RELAXED, __HIP_MEMORY_SCOPE_AGENT); }
__device__ __forceinline__ unsigned xb_xcc_id() { return (unsigned)__builtin_amdgcn_s_getreg((3 << 11) | 20) & 0xFu; }
#define XB_SPIN(cond, bar) do { unsigned _sp = 0; while (cond) { __builtin_amdgcn_s_sleep(1); \
    if ((++_sp & 255u) == 0u) { if (xb_ld(&(bar)[XB_TMO])) break; if (_sp > XB_SPIN_CAP) { atomicAdd(&(bar)[XB_TMO], 1u); break; } } } } while (0)
struct XcdBarrier { unsigned* bar; unsigned x; volatile LAS unsigned* st; };
__device__ __forceinline__ XcdBarrier xcd_barrier_post(unsigned* bar, volatile LAS unsigned* st) {
    XcdBarrier b; b.bar = bar; b.x = xb_xcc_id(); b.st = st;
    if (threadIdx.x == 0) (void)xb_add(&bar[XB_XCNT(b.x)], 1u);
    return b;
}
__device__ __forceinline__ void xcd_barrier_complete(unsigned* bar, unsigned x, unsigned& nloc, unsigned& nx) {
    const unsigned G = gridDim.x * gridDim.y * gridDim.z;
    unsigned sum, cnt, mine, sp = 0u;
    for (;;) {
        sum = 0u; cnt = 0u; mine = 0u;
#pragma unroll
        for (unsigned j = 0; j < 16; ++j) { const unsigned c = xb_ld(&bar[XB_XCNT(j)]); sum += c; cnt += (c > 0u) ? 1u : 0u; mine = (j == x) ? c : mine; }
        if (sum == G) break;
        __builtin_amdgcn_s_sleep(1);
        if ((++sp & 255u) == 0u) { if (xb_ld(&bar[XB_TMO])) break; if (sp > XB_SPIN_CAP) { atomicAdd(&bar[XB_TMO], 1u); break; } }
    }
    nloc = mine > 0u ? mine : 1u; nx = cnt > 0u ? cnt : 1u;
}
__device__ __forceinline__ void xcd_barrier(const XcdBarrier& b, const int wv0) {
    asm volatile("s_waitcnt vmcnt(0)" ::: "memory");
    __syncthreads();
    if (opaque_tid(wv0) == 0) {
        unsigned* bar = b.bar;
        __builtin_amdgcn_s_waitcnt(0);
        unsigned nloc = b.st[0], nx = b.st[1];
        if (nloc == 0u) { xcd_barrier_complete(bar, b.x, nloc, nx); b.st[0] = nloc; b.st[1] = nx; }
        const unsigned old = xb_add(&bar[XB_XSUB(b.x)], 1u);
        const unsigned gen = old / nloc;
        if (old + 1u == (gen + 1u) * nloc) {
            __builtin_amdgcn_fence(__ATOMIC_RELEASE, "agent");
            asm volatile("s_waitcnt vmcnt(0)" ::: "memory");
            const unsigned og = xb_add(&bar[XB_TOP], 1u);
            const unsigned tg = og / nx;
            if (og + 1u == (tg + 1u) * nx) xb_add(&bar[XB_TOPGEN], 1u);
            else XB_SPIN(xb_ld(&bar[XB_TOPGEN]) == tg, bar);
            __builtin_amdgcn_fence(__ATOMIC_ACQUIRE, "agent");
            xb_add(&bar[XB_XGEN(b.x)], 1u);
            asm volatile("s_waitcnt vmcnt(0)" ::: "memory");
        } else {
            XB_SPIN(xb_ld(&bar[XB_XGEN(b.x)]) == gen, bar);
            __builtin_amdgcn_fence(__ATOMIC_ACQUIRE, "agent");
            asm volatile("s_waitcnt vmcnt(0)" ::: "memory");
        }
    }
    __syncthreads();
}

struct Frame {
    LAS unsigned char* lds;
    int vcu, G, wv;
    const float* const* in; float* out; unsigned char* ws;
    __device__ __forceinline__ float* MOD() const { return (float*)(ws + WS_MOD); }
    __device__ __forceinline__ float* ROPE() const { return (float*)(ws + WS_ROPE); }
    __device__ __forceinline__ float* BA() const { return (float*)(ws + WS_BA); }
    __device__ __forceinline__ float* LAG() const { return (float*)(ws + WS_LAG); }
    __device__ __forceinline__ bf16_t* W1O() const { return (bf16_t*)(ws + WS_W1O); }
    __device__ __forceinline__ bf16_t* U0() const { return (bf16_t*)(ws + WS_RA); }
    __device__ __forceinline__ bf16_t* QKV1() const { return (bf16_t*)(ws + WS_RA); }
    __device__ __forceinline__ bf16_t* Z1() const { return (bf16_t*)(ws + WS_RA + (size_t)MT * 3072 * 2); }
    __device__ __forceinline__ bf16_t* Y1() const { return (bf16_t*)(ws + WS_RA + (size_t)MT * 3072 * 2); }
    __device__ __forceinline__ bf16_t* XN() const { return (bf16_t*)(ws + WS_RB + RB_XN); }
    __device__ __forceinline__ bf16_t* Y0() const { return (bf16_t*)(ws + WS_RB + RB_Y0); }
    __device__ __forceinline__ bf16_t* YO() const { return (bf16_t*)(ws + WS_RB + RB_YO); }
    __device__ __forceinline__ bf16_t* W0I() const { return (bf16_t*)(ws + WS_RB + RB_W0I); }
    __device__ __forceinline__ bf16_t* W0O() const { return (bf16_t*)(ws + WS_RB + RB_W0O); }
    __device__ __forceinline__ bf16_t* W1I() const { return (bf16_t*)(ws + WS_RB + RB_W1I); }
    __device__ __forceinline__ bf16_t* QKVC() const { return (bf16_t*)(ws + WS_RB); }
};

#define PHASE_IDS() int tid = opaque_tid(F.wv); const int lane = tid & 63, wave = __builtin_amdgcn_readfirstlane(tid >> 6); (void)lane; (void)wave
__device__ __forceinline__ void p0_transpose_item(const float* W, int ldw, int nblk, int K, bf16_t* WT, LAS float* scr, int item, int lane) {
    const int kb = item / nblk, nb = item % nblk, k0 = 64 * kb, n0 = 32 * nb;
    f32x4 v[8];
#pragma unroll
    for (int i = 0; i < 8; ++i) v[i] = *(const f32x4*)(W + (size_t)(k0 + 8 * i + (lane >> 3)) * ldw + n0 + 4 * (lane & 7));
#pragma unroll
    for (int i = 0; i < 8; ++i) { LAS float* d = scr + (8 * i + (lane >> 3)) * 33 + 4 * (lane & 7); d[0] = v[i][0]; d[1] = v[i][1]; d[2] = v[i][2]; d[3] = v[i][3]; }
    asm volatile("s_waitcnt lgkmcnt(0)" ::: "memory");
    const int c = lane & 7;
#pragma unroll
    for (int j = 0; j < 4; ++j) { const int n = (lane >> 3) + 8 * j; const LAS float* s = scr + (8 * c) * 33 + n;
        u32x4 o; o.x = pk2(s[0 * 33], s[1 * 33]); o.y = pk2(s[2 * 33], s[3 * 33]); o.z = pk2(s[4 * 33], s[5 * 33]); o.w = pk2(s[6 * 33], s[7 * 33]);
        *(u32x4*)(WT + (size_t)(n0 + n) * K + k0 + 8 * c) = o; }
    asm volatile("s_waitcnt lgkmcnt(0)" ::: "memory");
}
constexpr size_t WS_MODP = 12 * MiB;
__device__ __forceinline__ f32x4 mod4(const float* MODP, int L, int s, int off) {
    f32x4 a = *(const f32x4*)(MODP + ((size_t)((L * 4 + 0) * 24 + s)) * 3072 + off);
#pragma unroll
    for (int sl = 1; sl < 4; ++sl) a += *(const f32x4*)(MODP + ((size_t)((L * 4 + sl) * 24 + s)) * 3072 + off);
    return a;
}
__device__ __forceinline__ void mod_task(Frame& F, const int bt, const int tid, const int lane, const int wave) {
    const int L = bt / 192, sl = (bt % 192) / 48, n0 = (bt % 48) * 64, kb = sl * 256;
    LAS float* tab = (LAS float*)F.lds;
    {   float cv[12];
#pragma unroll
        for (int u = 0; u < 12; ++u) { const int idx = tid + 512 * u, s = idx >> 8, k = kb + (idx & 255); cv[u] = s < BP ? F.in[8][s * D + k] : F.in[9][(s - BP) * D + k]; }
#pragma unroll
        for (int u = 0; u < 12; ++u) { const int idx = tid + 512 * u, s = idx >> 8, k = idx & 255; tab[k * 24 + s] = siluf_(cv[u]); } }
    __syncthreads();
    const float* mw = (L == 0 ? F.in[10] : F.in[24]) + n0 + lane;
    float acc[24];
#pragma unroll
    for (int r = 0; r < 24; ++r) acc[r] = 0.f;
    for (int k0 = wave * 32; k0 < wave * 32 + 32; k0 += 16) {
        float wv[16];
#pragma unroll
        for (int u = 0; u < 16; ++u) wv[u] = mw[(size_t)(kb + k0 + u) * 3072];
#pragma unroll
        for (int u = 0; u < 16; ++u) { const float w = wv[u];
            const LAS f32x4* tp = (const LAS f32x4*)(tab + (k0 + u) * 24);
#pragma unroll
            for (int q = 0; q < 6; ++q) { const f32x4 t4 = tp[q]; acc[4 * q] += t4[0] * w; acc[4 * q + 1] += t4[1] * w; acc[4 * q + 2] += t4[2] * w; acc[4 * q + 3] += t4[3] * w; } }
    }
    __syncthreads();
    LAS float* red = (LAS float*)F.lds;
#pragma unroll
    for (int r = 0; r < 24; ++r) red[(wave * 24 + r) * 64 + lane] = acc[r];
    __syncthreads();
    const float* mb = (L == 0 ? F.in[11] : F.in[25]);
    float* MODP = (float*)(F.ws + WS_MODP);
    for (int idx = tid; idx < 24 * 64; idx += 512) { const int r = idx >> 6, l = idx & 63; float s = 0.f;
#pragma unroll
        for (int w = 0; w < 8; ++w) s += red[(w * 24 + r) * 64 + l];
        MODP[((size_t)((L * 4 + sl) * 24 + r)) * 3072 + n0 + l] = s + (sl == 0 ? mb[n0 + l] : 0.f); }
    __syncthreads();
}
__device__ __forceinline__ void phase_mod0(Frame& F) {
    PHASE_IDS();
    for (int bt = F.vcu; bt < 192; bt += F.G) { int t2 = tid; asm volatile("" : "+v"(t2)); mod_task(F, bt, t2, t2 & 63, wave); }
}
__device__ __forceinline__ void phase_mod1(Frame& F) {
    PHASE_IDS();
    __syncthreads();
    for (int bt = 192 + F.vcu; bt < 384; bt += F.G) { int t2 = tid; asm volatile("" : "+v"(t2)); mod_task(F, bt, t2, t2 & 63, wave); }
}
__device__ __forceinline__ void phase_prologue(Frame& F) {
    PHASE_IDS();
    const int gw = F.vcu * 8 + wave, NGW = F.G * 8;
    {
        LAS float* scr = (LAS float*)(F.lds + wave * 16384);
        constexpr int I0 = 16 * (EV_IN / 32), I1 = 16 * 32, I2 = 16 * (OD_MAIN / 32), I3 = 16 * 32;
        for (int it = gw; it < I0 + I1 + I2 + I3; it += NGW) {
            int r = it;
            if (r < I0) { p0_transpose_item(F.in[14], EV_IN, EV_IN / 32, D, F.W0I(), scr, r, lane); continue; } r -= I0;
            if (r < I1) { p0_transpose_item(F.in[23], D, 32, D, F.W0O(), scr, r, lane); continue; } r -= I1;
            if (r < I2) { p0_transpose_item(F.in[28], OD_IN, OD_MAIN / 32, D, F.W1I(), scr, r, lane); continue; } r -= I2;
            p0_transpose_item(F.in[33], D, 32, D, F.W1O(), scr, r, lane);
        }
    }
    {
        const double inv[8] = {1.0, 0.19392274474868576, 0.03760603093086393, 0.007292664737217109, 0.001414213562373095, 0.0002742481756762073, 5.318295896944988e-05, 1.031338537721246e-05};
        for (int idx = F.vcu * 512 + tid; idx < 4112 * 8; idx += F.G * 512) {
            const int pos = idx >> 3, i = idx & 7;
            double iv = inv[0];
#pragma unroll
            for (int q = 1; q < 8; ++q) iv = (i == q) ? inv[q] : iv;
            const double ang = (double)pos * iv;
            const double n = __builtin_rint(ang * 0.15915494309189535);
            const float r = (float)__builtin_fma(-n, 6.283185307179586, ang);
            F.ROPE()[pos * 16 + i] = __cosf(r); F.ROPE()[pos * 16 + 8 + i] = __sinf(r);
        }
    }
    {
        bf16_t* LGW = (bf16_t*)(F.ws + WS_LGW);
        for (int idx = F.vcu * 512 + tid; idx < 8 * 2 * 64 * 64; idx += F.G * 512) { const int k = idx & 63, n = (idx >> 6) & 63, gate = (idx >> 12) & 1, hh = idx >> 13;
            LGW[idx] = (bf16_t)f2bf((gate ? F.in[19] : F.in[17])[(hh * 64 + k) * 64 + n]); }
    }
}

__device__ __forceinline__ const float* x_row(Frame& F, int m) { return m < MP ? F.in[0] + (size_t)m * D : F.in[1] + (size_t)(m - MP) * D; }
__device__ __forceinline__ void rows_prenorm0(Frame& F, const int m0, const int n, const int s, const int lane) {
    const float* MODP = (const float*)(F.ws + WS_MODP);
    f32x4 A[4], C[4];
#pragma unroll
    for (int j = 0; j < 4; ++j) { const int c = 4 * lane + 256 * j; const f32x4 g = *(const f32x4*)(F.in[12] + c), sc = mod4(MODP, 0, s, 1024 + c); C[j] = mod4(MODP, 0, s, c);
#pragma unroll
        for (int e = 0; e < 4; ++e) A[j][e] = g[e] * (1.f + sc[e]); }
    f32x4 cur[4];
#pragma unroll
    for (int j = 0; j < 4; ++j) cur[j] = *(const f32x4*)(x_row(F, m0) + 4 * lane + 256 * j);
    for (int i = 0; i < n; ++i) {
        const int mn = m0 + (i + 1 < n ? i + 1 : i); f32x4 nxt[4];
#pragma unroll
        for (int j = 0; j < 4; ++j) nxt[j] = *(const f32x4*)(x_row(F, mn) + 4 * lane + 256 * j);
        float ss = 0.f;
#pragma unroll
        for (int j = 0; j < 4; ++j) ss += (cur[j][0] * cur[j][0] + cur[j][1] * cur[j][1]) + (cur[j][2] * cur[j][2] + cur[j][3] * cur[j][3]);
        const float r = rsqrtf(wave_sum(ss, lane) * (1.f / D) + EPS);
#pragma unroll
        for (int j = 0; j < 4; ++j) { u32x2 w; w[0] = cvt2(cur[j][0] * r * A[j][0] + C[j][0], cur[j][1] * r * A[j][1] + C[j][1]); w[1] = cvt2(cur[j][2] * r * A[j][2] + C[j][2], cur[j][3] * r * A[j][3] + C[j][3]);
            *(u32x2*)(F.XN() + (size_t)(m0 + i) * D + 4 * lane + 256 * j) = w; }
#pragma unroll
        for (int j = 0; j < 4; ++j) cur[j] = nxt[j];
    }
}
__device__ __forceinline__ void phase_prenorm0(Frame& F) {
    PHASE_IDS();
    const int gw = F.vcu * 8 + wave, NGW = F.G * 8;
    for (int w = gw; w < MP / 16; w += NGW) rows_prenorm0(F, w * 16, 16, w >> 8, lane);
    for (int w = gw; w < MS; w += NGW) rows_prenorm0(F, MP + w, 1, BP + (w >> 4), lane);
}

__device__ __forceinline__ void phase_rope(Frame& F) {
    PHASE_IDS();
    const int gt = F.vcu * 512 + tid, NT = F.G * 512;
    for (int idx = gt; idx < MT * 10; idx += NT) {
        const int m = idx / 10, slot = idx % 10;
        int s, t; tok_info(m, s, t);
        const int pos = s < BP ? t : TP + t;
        const int col = slot < 8 ? C_Q + slot * 64 : C_K + (slot - 8) * 64;
        u32x4* p = (u32x4*)(F.U0() + (size_t)m * EV_IN + col);
        const u32x4 xa = p[0], xb = p[1];
        const f32x4* rp = (const f32x4*)(F.ROPE() + pos * 16); const f32x4 c0 = rp[0], c1 = rp[1], s0 = rp[2], s1 = rp[3];
        float x1[8], x2[8], o1[8], o2[8];
#pragma unroll
        for (int e = 0; e < 4; ++e) { x1[2 * e] = lo16(xa[e]); x1[2 * e + 1] = hi16(xa[e]); x2[2 * e] = lo16(xb[e]); x2[2 * e + 1] = hi16(xb[e]); }
#pragma unroll
        for (int i = 0; i < 8; ++i) { const float c = i < 4 ? c0[i & 3] : c1[i & 3], sn = i < 4 ? s0[i & 3] : s1[i & 3]; o1[i] = x1[i] * c - x2[i] * sn; o2[i] = x2[i] * c + x1[i] * sn; }
        u32x4 ya, yb;
#pragma unroll
        for (int e = 0; e < 4; ++e) { ya[e] = cvt2(o1[2 * e], o1[2 * e + 1]); yb[e] = cvt2(o2[2 * e], o2[2 * e + 1]); }
        p[0] = ya; p[1] = yb;
        if (slot >= 8) { const int kv = slot - 8; float* o = nullptr;
            if (s >= BP) o = F.out + O_KS + ((size_t)((s - BP) * TS + t) * 2 + kv) * 64;
            else if (t >= TP - 128) o = F.out + O_KP + ((size_t)(s * 128 + (t - (TP - 128))) * 2 + kv) * 64;
            if (o) { *(f32x4*)o = (f32x4){o1[0], o1[1], o1[2], o1[3]}; *(f32x4*)(o + 4) = (f32x4){o1[4], o1[5], o1[6], o1[7]}; *(f32x4*)(o + 8) = (f32x4){o2[0], o2[1], o2[2], o2[3]}; *(f32x4*)(o + 12) = (f32x4){o2[4], o2[5], o2[6], o2[7]}; } }
    }
    for (int idx = gt; idx < 1280 * 224; idx += NT) {
        const int tk = idx / 224, e = idx % 224;
        int s, t, m; if (tk < 1024) { s = tk >> 7; t = TP - 128 + (tk & 127); m = s * TP + t; } else { s = BP + ((tk - 1024) >> 4); t = (tk - 1024) & 15; m = MP + (tk - 1024); }
        const bool isv = e >= 96; const int e2 = isv ? e - 96 : e; const int kv = isv ? (e2 >> 6) : (e2 / 48), d = isv ? (e2 & 63) : 16 + (e2 % 48);
        const float val = bf2f(F.U0()[(size_t)m * EV_IN + (isv ? C_V : C_K) + kv * 64 + d]);
        const size_t ob = s >= BP ? (isv ? O_VS : O_KS) + ((size_t)((s - BP) * TS + t) * 2 + kv) * 64 : (isv ? O_VP : O_KP) + ((size_t)(s * 128 + (t - (TP - 128))) * 2 + kv) * 64;
        F.out[ob + d] = val;
    }
}


__device__ __forceinline__ void rows_mid(Frame& F, LAS float* baw, const int m0, const int n, const int s, const int lane) {
    const float* MODP = (const float*)(F.ws + WS_MODP);
    f32x4 A0[4], B1[4], C1[4];
#pragma unroll
    for (int j = 0; j < 4; ++j) { const int c = 4 * lane + 256 * j; const f32x4 g0 = *(const f32x4*)(F.in[13] + c), gt = mod4(MODP, 0, s, 2048 + c), g1 = *(const f32x4*)(F.in[26] + c), sc = mod4(MODP, 1, s, 1024 + c);
        C1[j] = mod4(MODP, 1, s, c);
#pragma unroll
        for (int e = 0; e < 4; ++e) { A0[j][e] = gt[e] * g0[e]; B1[j][e] = g1[e] * (1.f + sc[e]); } }
    u32x2 ycur[4]; f32x4 xcur[4];
#pragma unroll
    for (int j = 0; j < 4; ++j) { ycur[j] = *(const u32x2*)(F.YO() + (size_t)m0 * D + 4 * lane + 256 * j); xcur[j] = *(const f32x4*)(x_row(F, m0) + 4 * lane + 256 * j); }
    for (int i = 0; i < n; ++i) {
        const int m = m0 + i, mn = m0 + (i + 1 < n ? i + 1 : i); u32x2 ynxt[4]; f32x4 xnxt[4];
#pragma unroll
        for (int j = 0; j < 4; ++j) { ynxt[j] = *(const u32x2*)(F.YO() + (size_t)mn * D + 4 * lane + 256 * j); xnxt[j] = *(const f32x4*)(x_row(F, mn) + 4 * lane + 256 * j); }
        f32x4 y[4]; float ss = 0.f;
#pragma unroll
        for (int j = 0; j < 4; ++j) { y[j] = (f32x4){lo16(ycur[j][0]), hi16(ycur[j][0]), lo16(ycur[j][1]), hi16(ycur[j][1])}; ss += (y[j][0] * y[j][0] + y[j][1] * y[j][1]) + (y[j][2] * y[j][2] + y[j][3] * y[j][3]); }
        const float r1 = rsqrtf(wave_sum(ss, lane) * (1.f / D) + EPS);
        f32x4 x1[4]; float s2 = 0.f;
#pragma unroll
        for (int j = 0; j < 4; ++j) {
#pragma unroll
            for (int e = 0; e < 4; ++e) x1[j][e] = xcur[j][e] + A0[j][e] * (y[j][e] * r1);
            *(f32x4*)(F.out + O_Y + (size_t)m * D + 4 * lane + 256 * j) = x1[j];
            s2 += (x1[j][0] * x1[j][0] + x1[j][1] * x1[j][1]) + (x1[j][2] * x1[j][2] + x1[j][3] * x1[j][3]); }
        const float r2 = rsqrtf(wave_sum(s2, lane) * (1.f / D) + EPS);
        f32x4 hm[4];
#pragma unroll
        for (int j = 0; j < 4; ++j) {
#pragma unroll
            for (int e = 0; e < 4; ++e) hm[j][e] = x1[j][e] * r2 * B1[j][e] + C1[j][e];
            u32x2 w; w[0] = cvt2(hm[j][0], hm[j][1]); w[1] = cvt2(hm[j][2], hm[j][3]); *(u32x2*)(F.XN() + (size_t)m * D + 4 * lane + 256 * j) = w; }
        __builtin_amdgcn_sched_barrier(0);
        float p[16];
#pragma unroll
        for (int q = 0; q < 16; ++q) { p[q] = 0.f;
#pragma unroll
            for (int j = 0; j < 4; ++j) { const f32x4 w = *(const LAS f32x4*)(baw + q * 1024 + 256 * j + 4 * lane); p[q] += (hm[j][0] * w[0] + hm[j][1] * w[1]) + (hm[j][2] * w[2] + hm[j][3] * w[3]); }
            if ((q & 3) == 3) __builtin_amdgcn_sched_barrier(0); }
        { const bool u5 = (lane & 32) != 0;
#pragma unroll
          for (int q = 0; q < 8; ++q) { const float keep = u5 ? p[8 + q] : p[q], send = u5 ? p[q] : p[8 + q]; p[q] = keep + shfl_xor_l(send, 32, lane); } }
        { const bool u4 = (lane & 16) != 0;
#pragma unroll
          for (int q = 0; q < 4; ++q) { const float keep = u4 ? p[4 + q] : p[q], send = u4 ? p[q] : p[4 + q]; p[q] = keep + shfl_xor_l(send, 16, lane); } }
        { const bool u3 = (lane & 8) != 0;
#pragma unroll
          for (int q = 0; q < 2; ++q) { const float keep = u3 ? p[2 + q] : p[q], send = u3 ? p[q] : p[2 + q]; p[q] = keep + shfl_xor_l(send, 8, lane); } }
        { const bool u2 = (lane & 4) != 0; const float keep = u2 ? p[1] : p[0], send = u2 ? p[0] : p[1]; p[0] = keep + shfl_xor_l(send, 4, lane); }
        float mine = p[0]; mine += shfl_xor_l(mine, 2, lane); mine += shfl_xor_l(mine, 1, lane);
        if ((lane & 3) == 0) { const int col = lane >> 2, hh = col & 7;
            F.BA()[(size_t)m * 16 + col] = col < 8 ? sigmoidf_(mine) : -__expf(F.in[30][hh]) * softplusf_(mine + F.in[31][hh]); }
#pragma unroll
        for (int j = 0; j < 4; ++j) { ycur[j] = ynxt[j]; xcur[j] = xnxt[j]; }
    }
}
__device__ __forceinline__ void phase_mid_rowwise(Frame& F) {
    PHASE_IDS();
    LAS float* baw = (LAS float*)F.lds;
    for (int idx = tid; idx < 16 * 1024; idx += 512) { const int j = idx & 15, k = idx >> 4; baw[j * 1024 + k] = F.in[28][(size_t)k * OD_IN + OD_MAIN + j]; }
    __syncthreads();
    const int gw = F.vcu * 8 + wave, NGW = F.G * 8;
    for (int w = gw; w < MP / 16; w += NGW) rows_mid(F, baw, w * 16, 16, w >> 8, lane);
    for (int w = gw; w < MS; w += NGW) rows_mid(F, baw, MP + w, 1, BP + (w >> 4), lane);
}


typedef float f32x16 __attribute__((ext_vector_type(16)));
constexpr int GS_WF = 0, GS_QF = 16384, GS_KF = 32768, GS_PF = 49152, GS_UF = 57344, GS_BYTES = 73728;
constexpr size_t WS_DEC = 11 * MiB;
__device__ __forceinline__ int krow(int s, int h, int j) { return 16 * s + 8 * (j >> 2) + 4 * h + (j & 3); }
#define MFMA32(a, b, c) __builtin_amdgcn_mfma_f32_32x32x16_bf16((a), (b), (c), 0, 0, 0)
#define MFMA16(a, b, c) __builtin_amdgcn_mfma_f32_16x16x32_bf16((a), (b), (c), 0, 0, 0)

typedef __amdgpu_buffer_rsrc_t brsrc_t;
__device__ __forceinline__ brsrc_t staging_rsrc(unsigned char* ws) { return __builtin_amdgcn_make_buffer_rsrc((void*)(ws + WS_RB), (short)0, (int)RB_BYTES, 0x00020000); }
__device__ __forceinline__ void st16_wt(brsrc_t r, unsigned off, u32x4 v) { __builtin_amdgcn_raw_buffer_store_b128(v, r, off, 0, 16); }
__device__ __forceinline__ u32x4 ld16_wt(brsrc_t r, unsigned off) { return __builtin_amdgcn_raw_buffer_load_b128(r, off, 0, 16); }
__device__ __forceinline__ void st8_wt(unsigned char* p, u32x2 v) { __hip_atomic_store((unsigned long long*)p, ((unsigned long long)v[1] << 32) | v[0], __ATOMIC_RELAXED, __HIP_MEMORY_SCOPE_AGENT); }
constexpr size_t WS_READY = 65536;
#define LDS_BARRIER() do { asm volatile("s_waitcnt lgkmcnt(0)" ::: "memory"); __builtin_amdgcn_s_barrier(); asm volatile("" ::: "memory"); } while (0)
constexpr int G1_QS = 0, G1_KS = 17408, G1_VS = 34816, G1_AS = 52224, G1_PS = 69632, G1_WS = 78848, G1_CW = 96256, G1_VEC = 102400, G1_ES = 103424;
__device__ __forceinline__ void g1_load_raw(Frame& F, u32x4 (&raw)[24], int s, int c, int h, int t1) {
    const int r = t1 >> 3, j = t1 & 7, t = c * 64 + r;
#pragma unroll
    for (int p = 0; p < 3; ++p)
#pragma unroll
        for (int jj = 0; jj < 4; ++jj) { const int tt = t - 3 + jj, ttc = tt < 0 ? 0 : tt;
            const u32x4* src = (const u32x4*)(F.QKV1() + (size_t)(s * TP + ttc) * 3072 + p * 1024 + h * 128 + j * 16); raw[p * 8 + jj * 2] = src[0]; raw[p * 8 + jj * 2 + 1] = src[1]; }
}
__device__ __forceinline__ bf16x8 g1_pack_b(const f32x4 p, const f32x4 q) { u32x4 w; w[0] = cvt2(p[0], p[1]); w[1] = cvt2(p[2], p[3]); w[2] = cvt2(q[0], q[1]); w[3] = cvt2(q[2], q[3]); return __builtin_bit_cast(bf16x8, w); }
__device__ __forceinline__ void g1_decode(int n, int& s, int& c, int& h) { if (n < 4096) { c = n >> 6; s = (n & 63) >> 3; h = n & 7; } else { s = BP + ((n - 4096) >> 3); c = 0; h = n & 7; } }
constexpr int P2_SET = 52224, P2_Q = 0, P2_K = 17408, P2_V = 34816;
constexpr int P2_AS = 2 * P2_SET, P2_PS = P2_AS + 17408, P2_ES = P2_PS + 9216, P2_CW = P2_ES + 4096, P2_VEC = P2_CW + 6144;
static_assert(P2_VEC + 2048 <= LDS_BYTES - 64, "producer LDS map");
__device__ __forceinline__ void p2_load_part(Frame& F, u32x4 (&rw)[16], int s, int c, int h, int p, int tb) {
    const int r = tb >> 3, j = tb & 7;
#pragma unroll
    for (int it = 0; it < 2; ++it)
#pragma unroll
        for (int jj = 0; jj < 4; ++jj) { int tt = c * 64 + r + 32 * it - 3 + jj; tt = tt < 0 ? 0 : tt;
            const u32x4* src = (const u32x4*)(F.QKV1() + (size_t)(s * TP + tt) * 3072 + p * 1024 + h * 128 + j * 16); rw[it * 8 + jj * 2] = src[0]; rw[it * 8 + jj * 2 + 1] = src[1]; }
}
__device__ __forceinline__ void p2_conv_item(Frame& F, const u32x4 (&rw)[16], const int it, const f32x4 (&wreg)[16], const int p, const int j, const int lane, const bool ok, float* state_out, LAS u32x4* dst) {
    float acc[16];
#pragma unroll
    for (int e = 0; e < 16; ++e) acc[e] = 0.f;
#pragma unroll
    for (int jj = 0; jj < 4; ++jj) {
        const u32x4 a = rw[it * 8 + jj * 2], b = rw[it * 8 + jj * 2 + 1]; float x[16];
#pragma unroll
        for (int e = 0; e < 4; ++e) { x[2 * e] = lo16(a[e]); x[2 * e + 1] = hi16(a[e]); x[8 + 2 * e] = lo16(b[e]); x[8 + 2 * e + 1] = hi16(b[e]); }
#pragma unroll
        for (int q = 0; q < 4; ++q) { const f32x4 w4 = wreg[jj * 4 + q]; acc[4 * q] += w4[0] * x[4 * q]; acc[4 * q + 1] += w4[1] * x[4 * q + 1]; acc[4 * q + 2] += w4[2] * x[4 * q + 2]; acc[4 * q + 3] += w4[3] * x[4 * q + 3]; }
        if (jj == 3 && state_out) {
#pragma unroll
            for (int q = 0; q < 4; ++q) *(f32x4*)(state_out + 4 * q) = (f32x4){x[4 * q], x[4 * q + 1], x[4 * q + 2], x[4 * q + 3]}; }
    }
    float ss = 0.f;
#pragma unroll
    for (int e = 0; e < 16; ++e) { acc[e] = siluf_(acc[e]); ss += acc[e] * acc[e]; }
    if (p < 2) { ss += shfl_xor_l(ss, 1, lane); ss += shfl_xor_l(ss, 2, lane); ss += shfl_xor_l(ss, 4, lane);
        float sc = __builtin_amdgcn_rsqf(ss + EPS); if (p == 0) sc *= 0.08838834764831845f;
#pragma unroll
        for (int e = 0; e < 16; ++e) acc[e] *= sc; }
    u32x4 w0, w1;
#pragma unroll
    for (int e = 0; e < 4; ++e) { w0[e] = ok ? cvt2(acc[2 * e], acc[2 * e + 1]) : 0u; w1[e] = ok ? cvt2(acc[8 + 2 * e], acc[8 + 2 * e + 1]) : 0u; }
    dst[0] = w0; dst[1] = w1;
}
__device__ __forceinline__ void gdn_g1_tasks(Frame& F, const int first, const int stride) {
    LAS unsigned char* L = F.lds;
    LAS float* cw_s = (LAS float*)(L + P2_CW);
    float* DEC = (float*)(F.ws + WS_DEC);
    const brsrc_t srs = staging_rsrc(F.ws);
    unsigned* ready = (unsigned*)(F.ws + WS_READY);
    const int wave = F.wv;
    const bool grpB = wave >= 4;
    int ntask = 0; for (int t = first; t < 4224; t += stride) ++ntask;
    u32x4 rwA[16]; float pcw[6];
    if (grpB) {
        const int tb = opaque_tid(wave) - 256; int s0, c0, h0; g1_decode(first < 4095 ? first : 4095, s0, c0, h0);
        p2_load_part(F, rwA, s0, c0, h0, 0, tb);
#pragma unroll
        for (int q = 0; q < 6; ++q) { const int i = tb + 256 * q, jj = i / 384, cc = i % 384; pcw[q] = F.in[29][(size_t)jj * 3072 + (cc >> 7) * 1024 + h0 * 128 + (cc & 127)]; }
#pragma unroll
        for (int q = 0; q < 6; ++q) cw_s[tb + 256 * q] = pcw[q];
    }
    LDS_BARRIER();
    for (int i = 0; i <= ntask; ++i) {
        const int tid = opaque_tid(wave), lane = tid & 63;
        const int taskB = first + i * stride, taskA = taskB - stride;
        const bool actB = grpB && i < ntask, actA = !grpB && i >= 1;
        int s = 0, c = 0, h = 0; g1_decode(grpB ? (i < ntask ? taskB : 4095) : (i >= 1 ? taskA : 0), s, c, h);
        const int task = grpB ? taskB : taskA;
        const int sidx = task < 4096 ? ((s * 8 + h) * 64 + c) : task;
        const int nvalid = s < BP ? 64 : TS, t0 = c * 64, base = seq_base(s), T = seq_len(s);
        LAS unsigned char* Sb = L + (grpB ? (i & 1) : ((i - 1) & 1)) * P2_SET;
        LAS float* vec = (LAS float*)(L + P2_VEC + (grpB ? (i & 1) : ((i - 1) & 1)) * 1024); LAS float* beta_s = vec; LAS float* gcum_s = vec + 64; LAS float* eg_s = vec + 128; LAS float* ek_s = vec + 192;
        unsigned char* blk = F.ws + WS_RB + (size_t)sidx * GS_BYTES; const unsigned boff = (unsigned)sidx * (unsigned)GS_BYTES;
        float gvb = 0.f, gva = 0.f; int gs = 0, gc = 0, gh = 0; const bool gact = (wave == 3) && i < ntask;
        if (gact) { g1_decode(taskB, gs, gc, gh); if (lane < (gs < BP ? 64 : TS)) { const float* ba = F.BA() + (size_t)(seq_base(gs) + gc * 64 + lane) * 16; gvb = ba[gh]; gva = ba[8 + gh]; } }
        const int tb = tid - 256, rB = tb >> 3, jB = tb & 7;
#define P2_PART(p, rw) do { if (actB) { \
            if (s >= BP) { _Pragma("unroll") for (int it = 0; it < 2; ++it) _Pragma("unroll") for (int jj = 0; jj < 4; ++jj) { const int r_ = rB + 32 * it, tt = r_ - 3 + jj; u32x4 a_ = {0u, 0u, 0u, 0u}, b_ = {0u, 0u, 0u, 0u}; \
                    if (r_ < nvalid) { const int cb_ = (p) * 1024 + h * 128 + jB * 16; \
                        if (tt >= 0) { const u32x4* src = (const u32x4*)(F.QKV1() + (size_t)(base + tt) * 3072 + cb_); a_ = src[0]; b_ = src[1]; } \
                        else { const f32x4* src = (const f32x4*)(F.in[6] + ((size_t)(s - BP) * 3 + (tt + 3)) * 3072 + cb_); const f32x4 f0 = src[0], f1 = src[1], f2 = src[2], f3 = src[3]; \
                            a_[0] = cvt2(f0[0], f0[1]); a_[1] = cvt2(f0[2], f0[3]); a_[2] = cvt2(f1[0], f1[1]); a_[3] = cvt2(f1[2], f1[3]); b_[0] = cvt2(f2[0], f2[1]); b_[1] = cvt2(f2[2], f2[3]); b_[2] = cvt2(f3[0], f3[1]); b_[3] = cvt2(f3[2], f3[3]); } } \
                    rw[it * 8 + jj * 2] = a_; rw[it * 8 + jj * 2 + 1] = b_; } } \
            else if (t0 == 0 && rB < 3) { _Pragma("unroll") for (int jj = 0; jj < 3; ++jj) if (rB - 3 + jj < 0) { rw[jj * 2] = (u32x4){0u, 0u, 0u, 0u}; rw[jj * 2 + 1] = (u32x4){0u, 0u, 0u, 0u}; } } \
            f32x4 wreg_[16]; _Pragma("unroll") for (int jj = 0; jj < 4; ++jj) _Pragma("unroll") for (int q = 0; q < 4; ++q) wreg_[jj * 4 + q] = *(const LAS f32x4*)(cw_s + jj * 384 + (p) * 128 + jB * 16 + 4 * q);   \
            _Pragma("unroll") for (int it = 0; it < 2; ++it) { const int r_ = rB + 32 * it, t_ = t0 + r_; const bool ok_ = r_ < nvalid; \
                float* so_ = (ok_ && t_ >= T - 3) ? ((s < BP ? F.out + O_GCP + ((size_t)s * 3 + (t_ - (T - 3))) * 3072 : F.out + O_GCS + ((size_t)(s - BP) * 3 + (t_ - (T - 3))) * 3072) + (p) * 1024 + h * 128 + jB * 16) : nullptr; \
                p2_conv_item(F, rw, it, wreg_, (p), jB, lane, ok_, so_, (LAS u32x4*)(Sb + ((p) == 0 ? P2_Q : (p) == 1 ? P2_K : P2_V) + r_ * 272 + jB * 32)); } } } while (0)
        if (grpB) {
            P2_PART(0, rwA);
            if (actB && s < BP) p2_load_part(F, rwA, s, c, h, 1, tb);
        } else if (actA) {
            int l2 = lane; asm volatile("" : "+v"(l2));
            const int r = l2 & 31, hh = l2 >> 5;
#pragma unroll
            for (int half = 0; half < 2; ++half) {
                const int tile8 = wave + 4 * half, which = tile8 >> 2, ti = (tile8 >> 1) & 1, tj = tile8 & 1;
                f32x16 acc;
#pragma unroll
                for (int e = 0; e < 16; ++e) acc[e] = 0.f;
                if (!(ti == 0 && tj == 1)) {
                    const LAS unsigned char* ap = Sb + (which ? P2_Q : P2_K) + (32 * ti + r) * 272 + hh * 16;
                    const LAS unsigned char* bp = Sb + P2_K + (32 * tj + r) * 272 + hh * 16;
#pragma unroll
                    for (int ks = 0; ks < 8; ++ks) { const bf16x8 a = *(const LAS bf16x8*)(ap + ks * 32), b = *(const LAS bf16x8*)(bp + ks * 32); acc = MFMA32(a, b, acc); }
                }
                const int jc = 32 * tj + r; const float gj = gcum_s[jc];
#pragma unroll
                for (int e = 0; e < 16; ++e) {
                    const int ii = 32 * ti + (e & 3) + 8 * (e >> 2) + 4 * hh; const float dg = gcum_s[ii] - gj;
                    if (which == 0) { const float f = (ii > jc) ? __expf(dg) * beta_s[ii] : 0.f; *(LAS float*)(L + P2_AS + ii * 272 + jc * 4) = acc[e] * f; }
                    else { const float f = (ii >= jc) ? __expf(dg) : 0.f; *(LAS bf16_t*)(L + P2_PS + ii * 144 + jc * 2) = (bf16_t)(cvt2(acc[e] * f, 0.f) & 0xffffu); }
                }
            }
        }
        LDS_BARRIER();
        if (grpB) {
            P2_PART(1, rwA);
            if (actB && s < BP) p2_load_part(F, rwA, s, c, h, 2, tb);
        } else if (actA) {
            int l3 = lane; asm volatile("" : "+v"(l3));
            if (wave == 0) {
                const int bk = l3 >> 4, col = l3 & 15;
                float tcol[16];
#pragma unroll
                for (int rr = 0; rr < 16; ++rr) {
                    float a = (rr == col) ? 1.0f : 0.f;
#pragma unroll
                    for (int j4 = 0; j4 < (rr + 3) / 4; ++j4) { const f32x4 a4 = *(const LAS f32x4*)(L + P2_AS + (16 * bk + rr) * 272 + (16 * bk + 4 * j4) * 4);
#pragma unroll
                        for (int q = 0; q < 4; ++q) if (4 * j4 + q < rr) a -= a4[q] * tcol[4 * j4 + q]; }
                    tcol[rr] = a;
                    *(LAS float*)(L + P2_ES + ((bk * 16 + rr) * 16 + col) * 4) = a - ((rr == col) ? 1.0f : 0.f);
                }
            } else {
                const int r = l3 & 31, hh = l3 >> 5;
                if (wave == 1) {
#pragma unroll
                    for (int rt4 = 0; rt4 < 4; ++rt4)
#pragma unroll
                        for (int kt2 = 0; kt2 < 2; ++kt2)
#pragma unroll
                            for (int ss = 0; ss < 2; ++ss) { float v[8];
#pragma unroll
                                for (int j = 0; j < 8; ++j) { const int tok = 32 * kt2 + krow(ss, hh, j); v[j] = bf2f(*(const LAS bf16_t*)(Sb + P2_K + tok * 272 + (32 * rt4 + r) * 2)) * ek_s[tok]; }
                                u32x4 o; o[0] = cvt2(v[0], v[1]); o[1] = cvt2(v[2], v[3]); o[2] = cvt2(v[4], v[5]); o[3] = cvt2(v[6], v[7]);
                                st16_wt(srs, boff + GS_KF + ((rt4 * 2 + kt2) * 2 + ss) * 1024 + l3 * 16, o); }
                } else if (wave == 2) {
#pragma unroll
                    for (int kt = 0; kt < 4; ++kt)
#pragma unroll
                        for (int rt = 0; rt < 2; ++rt)
#pragma unroll
                            for (int ss = 0; ss < 2; ++ss) { const int ii = 32 * rt + r; const float sc = eg_s[ii];
                                const u32x2 lo = *(const LAS u32x2*)(Sb + P2_Q + ii * 272 + (32 * kt + 16 * ss + 4 * hh) * 2), hi = *(const LAS u32x2*)(Sb + P2_Q + ii * 272 + (32 * kt + 16 * ss + 8 + 4 * hh) * 2);
                                u32x4 o; o[0] = cvt2(lo16(lo[0]) * sc, hi16(lo[0]) * sc); o[1] = cvt2(lo16(lo[1]) * sc, hi16(lo[1]) * sc); o[2] = cvt2(lo16(hi[0]) * sc, hi16(hi[0]) * sc); o[3] = cvt2(lo16(hi[1]) * sc, hi16(hi[1]) * sc);
                                st16_wt(srs, boff + GS_QF + ((rt * 4 + kt) * 2 + ss) * 1024 + l3 * 16, o); }
                } else {
#pragma unroll
                    for (int rt = 0; rt < 2; ++rt)
#pragma unroll
                        for (int kt2 = 0; kt2 < 2; ++kt2)
#pragma unroll
                            for (int ss = 0; ss < 2; ++ss) { const int ii = 32 * rt + r;
                                const u32x2 lo = *(const LAS u32x2*)(L + P2_PS + ii * 144 + (32 * kt2 + 16 * ss + 4 * hh) * 2), hi = *(const LAS u32x2*)(L + P2_PS + ii * 144 + (32 * kt2 + 16 * ss + 8 + 4 * hh) * 2);
                                u32x4 o; o[0] = lo[0]; o[1] = lo[1]; o[2] = hi[0]; o[3] = hi[1];
                                st16_wt(srs, boff + GS_PF + ((rt * 2 + kt2) * 2 + ss) * 1024 + l3 * 16, o); }
                }
            }
        }
        LDS_BARRIER();
        if (grpB) {
            P2_PART(2, rwA);
        } else if (actA) {
            int l4 = lane; asm volatile("" : "+v"(l4));
            const int c16 = l4 & 15, g = l4 >> 4;
            const f32x4 z4 = {0.f, 0.f, 0.f, 0.f};
            f32x4 a10, a20, a21, a30, a31, a32, e0, e1, e2, e3;
            { const LAS unsigned char* ar = L + P2_AS + c16 * 272 + (4 * g) * 4;
              a10 = *(const LAS f32x4*)(ar + 16 * 272); a20 = *(const LAS f32x4*)(ar + 32 * 272); a21 = *(const LAS f32x4*)(ar + 32 * 272 + 64);
              a30 = *(const LAS f32x4*)(ar + 48 * 272); a31 = *(const LAS f32x4*)(ar + 48 * 272 + 64); a32 = *(const LAS f32x4*)(ar + 48 * 272 + 128);
              const LAS unsigned char* er = L + P2_ES + (c16 * 16 + 4 * g) * 4;
              e0 = *(const LAS f32x4*)er; e1 = *(const LAS f32x4*)(er + 1024); e2 = *(const LAS f32x4*)(er + 2048); e3 = *(const LAS f32x4*)(er + 3072); }
            const bf16x8 fA10 = g1_pack_b(z4 - a10, z4), fA2 = g1_pack_b(z4 - a20, z4 - a21), fA3a = g1_pack_b(z4 - a30, z4 - a31), fA3b = g1_pack_b(z4 - a32, z4);
            const bf16x8 fE0 = g1_pack_b(e0, z4), fE1 = g1_pack_b(e1, z4), fE2 = g1_pack_b(e2, z4), fE3 = g1_pack_b(e3, z4);
#pragma unroll
            for (int tl = 0; tl < 4; ++tl) {
                const int t16 = 4 * wave + tl; const bool isw = t16 < 8; const int d = 16 * (t16 & 7) + c16;
                f32x4 R[4];
#pragma unroll
                for (int ib = 0; ib < 4; ++ib)
#pragma unroll
                    for (int e = 0; e < 4; ++e) { const int row = 16 * ib + 4 * g + e; const float raw1 = bf2f(*(const LAS bf16_t*)(Sb + (isw ? P2_K : P2_V) + row * 272 + d * 2)); R[ib][e] = raw1 * beta_s[row] * (isw ? eg_s[row] : 1.0f); }
                const f32x4 X0 = MFMA16(fE0, g1_pack_b(R[0], z4), R[0]);
                const f32x4 Y1 = MFMA16(fA10, g1_pack_b(X0, z4), R[1]);
                const f32x4 X1 = MFMA16(fE1, g1_pack_b(Y1, z4), Y1);
                const f32x4 Y2 = MFMA16(fA2, g1_pack_b(X0, X1), R[2]);
                const f32x4 X2 = MFMA16(fE2, g1_pack_b(Y2, z4), Y2);
                f32x4 Y3 = MFMA16(fA3a, g1_pack_b(X0, X1), R[3]);
                Y3 = MFMA16(fA3b, g1_pack_b(X2, z4), Y3);
                const f32x4 X3 = MFMA16(fE3, g1_pack_b(Y3, z4), Y3);
                const f32x4 X[4] = {X0, X1, X2, X3};
                if (isw) {
#pragma unroll
                    for (int ib = 0; ib < 4; ++ib)
#pragma unroll
                        for (int e = 0; e < 4; ++e) *(LAS bf16_t*)(Sb + P2_Q + (16 * ib + 4 * g + e) * 272 + d * 2) = (bf16_t)(cvt2(-X[ib][e], 0.f) & 0xffffu);
                } else {
                    const int ws = d >> 5, cc = d & 31;
#pragma unroll
                    for (int ib = 0; ib < 4; ++ib) { const int rt = ib >> 1, q = 2 * (ib & 1) + (g >> 1), hh = g & 1;
                        u32x2 o; o[0] = cvt2(X[ib][0], X[ib][1]); o[1] = cvt2(X[ib][2], X[ib][3]);
                        st8_wt(blk + GS_UF + (size_t)(((ws * 2 + rt) * 64) + cc + 32 * hh) * 32 + q * 8, o); }
                }
            }
        }
        LDS_BARRIER();
        if (grpB) {
            { const int ntk = taskB + stride < 4224 ? taskB + stride : 4223; int s1, c1, h1; g1_decode(ntk, s1, c1, h1);
#pragma unroll
              for (int q = 0; q < 6; ++q) { const int ii = tb + 256 * q, jj = ii / 384, cc = ii % 384; pcw[q] = F.in[29][(size_t)jj * 3072 + (cc >> 7) * 1024 + h1 * 128 + (cc & 127)]; }
              const int ntp = ntk < 4095 ? ntk : 4095; int s2, c2, h2; g1_decode(ntp, s2, c2, h2);
              p2_load_part(F, rwA, s2, c2, h2, 0, tb);
#pragma unroll
              for (int q = 0; q < 6; ++q) cw_s[tb + 256 * q] = pcw[q]; }
        } else if (actA) {
            int l5 = lane; asm volatile("" : "+v"(l5));
            const int kt = wave, r = l5 & 31, hh = l5 >> 5;
#pragma unroll
            for (int rt = 0; rt < 2; ++rt)
#pragma unroll
                for (int ss = 0; ss < 2; ++ss) { const int ii = 32 * rt + r;
                    const u32x2 lo = *(const LAS u32x2*)(Sb + P2_Q + ii * 272 + (32 * kt + 16 * ss + 4 * hh) * 2), hi = *(const LAS u32x2*)(Sb + P2_Q + ii * 272 + (32 * kt + 16 * ss + 8 + 4 * hh) * 2);
                    u32x4 o; o[0] = lo[0]; o[1] = lo[1]; o[2] = hi[0]; o[3] = hi[1];
                    st16_wt(srs, boff + GS_WF + ((rt * 4 + kt) * 2 + ss) * 1024 + l5 * 16, o); }
            asm volatile("s_waitcnt vmcnt(0)" ::: "memory");
        }
        if (gact) {
            LAS float* gv = (LAS float*)(L + P2_VEC + (i & 1) * 1024);
            const bool ok = lane < (gs < BP ? 64 : TS); float x = ok ? gva : 0.f;
#pragma unroll
            for (int o = 1; o < 64; o <<= 1) { const float y = shfl_idx(x, lane >= o ? lane - o : lane); if (lane >= o) x += y; }
            const float gl = shfl_idx(x, 63);
            gv[lane] = ok ? gvb : 0.f; gv[64 + lane] = x; gv[128 + lane] = __expf(x); gv[192 + lane] = ok ? __expf(gl - x) : 0.f;
            const int gsidx = taskB < 4096 ? ((gs * 8 + gh) * 64 + gc) : taskB;
            if (lane == 0) __hip_atomic_store((unsigned*)DEC + gsidx, __float_as_uint(__expf(gl)), __ATOMIC_RELAXED, __HIP_MEMORY_SCOPE_AGENT);
        }
        LDS_BARRIER();
        if (tid == 0 && i >= 1) __hip_atomic_store(ready + 16 * sidx, 1u, __ATOMIC_RELAXED, __HIP_MEMORY_SCOPE_AGENT);
#undef P2_PART
    }
}

constexpr int G2_FB = GS_BYTES, G2_OSTRIDE = 528, G2_HN = 2 * G2_FB, G2_DEC = G2_HN + 512;
__device__ __forceinline__ bf16x8 pack8(const f32x16& x, const int s) {
    u32x4 p; p[0] = cvt2(x[8 * s], x[8 * s + 1]); p[1] = cvt2(x[8 * s + 2], x[8 * s + 3]); p[2] = cvt2(x[8 * s + 4], x[8 * s + 5]); p[3] = cvt2(x[8 * s + 6], x[8 * s + 7]);
    return __builtin_bit_cast(bf16x8, p);
}
template <bool WT>
__device__ __forceinline__ void g2_load_set(u32x4 (&pre)[18], float& dpre, const unsigned char* blk, int lt, brsrc_t srs, unsigned boff, const unsigned* flag, const float* decp) {
    if (WT) { unsigned sp = 0; while (__builtin_amdgcn_readfirstlane(__hip_atomic_load(flag, __ATOMIC_RELAXED, __HIP_MEMORY_SCOPE_AGENT)) == 0u && ++sp < (1u << 20)) __builtin_amdgcn_s_sleep(4);
        dpre = __uint_as_float(__hip_atomic_load((const unsigned*)decp, __ATOMIC_RELAXED, __HIP_MEMORY_SCOPE_AGENT));
#pragma unroll
        for (int i = 0; i < 18; ++i) pre[i] = ld16_wt(srs, boff + (unsigned)(i * 256 + lt) * 16u);
    } else { const u32x4* src = (const u32x4*)blk; dpre = *decp;
#pragma unroll
        for (int i = 0; i < 18; ++i) pre[i] = src[i * 256 + lt]; }
}
__device__ __forceinline__ void g2_store_set(const u32x4 (&pre)[18], LAS unsigned char* dst, int lt) {
#pragma unroll
    for (int i = 0; i < 18; ++i) *(LAS u32x4*)(dst + (size_t)(i * 256 + lt) * 16) = pre[i];
}
#define G2_FRAG(off) (*(const LAS bf16x8*)(B + (off)))
#define G2_SCHED() __builtin_amdgcn_sched_barrier(0)
__device__ __forceinline__ void g2_mfma_step(f32x16& S0, f32x16& S1, f32x16& S2, f32x16& S3, LAS unsigned char* Bimg, const float dec, int ws, int lane, int cc, int hh) {
    const LAS unsigned char* B = Bimg + lane * 16;
    f32x16 vn0, vn1, o0, o1;
    { const LAS u32x4* up = (const LAS u32x4*)(Bimg + GS_UF + (size_t)(ws * 2 * 64 + lane) * 32); const u32x4 u0 = up[0], u1 = up[1], u2 = up[128], u3 = up[129];
#pragma unroll
      for (int q = 0; q < 4; ++q) { vn0[2 * q] = lo16(u0[q]); vn0[2 * q + 1] = hi16(u0[q]); vn0[8 + 2 * q] = lo16(u1[q]); vn0[8 + 2 * q + 1] = hi16(u1[q]);
                                    vn1[2 * q] = lo16(u2[q]); vn1[2 * q + 1] = hi16(u2[q]); vn1[8 + 2 * q] = lo16(u3[q]); vn1[8 + 2 * q + 1] = hi16(u3[q]); } }
#pragma unroll
    for (int e = 0; e < 16; ++e) { o0[e] = 0.f; o1[e] = 0.f; }
#define G2_WQ(Sx, kt) do { _Pragma("unroll") for (int ss = 0; ss < 2; ++ss) { const bf16x8 sb = pack8(Sx, ss); \
        const bf16x8 fw0 = G2_FRAG(GS_WF + ((0 * 4 + kt) * 2 + ss) * 1024), fw1 = G2_FRAG(GS_WF + ((1 * 4 + kt) * 2 + ss) * 1024); \
        const bf16x8 fq0 = G2_FRAG(GS_QF + ((0 * 4 + kt) * 2 + ss) * 1024), fq1 = G2_FRAG(GS_QF + ((1 * 4 + kt) * 2 + ss) * 1024); \
        vn0 = MFMA32(fw0, sb, vn0); vn1 = MFMA32(fw1, sb, vn1); o0 = MFMA32(fq0, sb, o0); o1 = MFMA32(fq1, sb, o1); } } while (0)
    G2_WQ(S0, 0); G2_WQ(S1, 1); G2_WQ(S2, 2); G2_WQ(S3, 3);
#undef G2_WQ
    bf16x8 vb[2][2];
    vb[0][0] = pack8(vn0, 0); vb[0][1] = pack8(vn0, 1); vb[1][0] = pack8(vn1, 0); vb[1][1] = pack8(vn1, 1);
#pragma unroll
    for (int kt2 = 0; kt2 < 2; ++kt2)
#pragma unroll
        for (int ss = 0; ss < 2; ++ss) { o0 = MFMA32(G2_FRAG(GS_PF + ((0 * 2 + kt2) * 2 + ss) * 1024), vb[kt2][ss], o0); o1 = MFMA32(G2_FRAG(GS_PF + ((1 * 2 + kt2) * 2 + ss) * 1024), vb[kt2][ss], o1); }
    S0 = S0 * dec; S1 = S1 * dec; S2 = S2 * dec; S3 = S3 * dec;
#pragma unroll
    for (int kt2 = 0; kt2 < 2; ++kt2)
#pragma unroll
        for (int ss = 0; ss < 2; ++ss) {
            S0 = MFMA32(G2_FRAG(GS_KF + ((0 * 2 + kt2) * 2 + ss) * 1024), vb[kt2][ss], S0); S1 = MFMA32(G2_FRAG(GS_KF + ((1 * 2 + kt2) * 2 + ss) * 1024), vb[kt2][ss], S1);
            S2 = MFMA32(G2_FRAG(GS_KF + ((2 * 2 + kt2) * 2 + ss) * 1024), vb[kt2][ss], S2); S3 = MFMA32(G2_FRAG(GS_KF + ((3 * 2 + kt2) * 2 + ss) * 1024), vb[kt2][ss], S3); }
    LDS_BARRIER();
#pragma unroll
    for (int e = 0; e < 16; ++e) { const int rr = (e & 3) + 8 * (e >> 2) + 4 * hh;
        *(LAS float*)(Bimg + rr * G2_OSTRIDE + (32 * ws + cc) * 4) = o0[e]; *(LAS float*)(Bimg + (32 + rr) * G2_OSTRIDE + (32 * ws + cc) * 4) = o1[e]; }
    LDS_BARRIER();
}
__device__ __forceinline__ void g2_epi16(Frame& F, LAS unsigned char* L, const LAS unsigned char* Oimg, const u32x4 (&zz)[2], int row, int sub, size_t m, int h, bool rok, int lane) {
    f32x4 ov[4]; float ss = 0.f;
#pragma unroll
    for (int q = 0; q < 4; ++q) { ov[q] = *(const LAS f32x4*)(Oimg + row * G2_OSTRIDE + (sub * 16 + 4 * q) * 4); ss += (ov[q][0] * ov[q][0] + ov[q][1] * ov[q][1]) + (ov[q][2] * ov[q][2] + ov[q][3] * ov[q][3]); }
    ss += shfl_xor_l(ss, 1, lane); ss += shfl_xor_l(ss, 2, lane); ss += shfl_xor_l(ss, 4, lane);
    const float rn = __builtin_amdgcn_rsqf(ss * (1.f / 128.f) + EPS);
    if (rok) {
        const LAS float* hn_s = (const LAS float*)(L + G2_HN);
        u32x4* yp = (u32x4*)(F.Y1() + m * D + h * 128 + sub * 16);
#pragma unroll
        for (int q = 0; q < 2; ++q) {
            const f32x4 oa = ov[2 * q], ob = ov[2 * q + 1];
            const f32x4 ha = *(const LAS f32x4*)(hn_s + sub * 16 + 8 * q), hb = *(const LAS f32x4*)(hn_s + sub * 16 + 8 * q + 4);
            u32x4 yo;
            yo[0] = cvt2(oa[0] * rn * ha[0] * siluf_(lo16(zz[q][0])), oa[1] * rn * ha[1] * siluf_(hi16(zz[q][0])));
            yo[1] = cvt2(oa[2] * rn * ha[2] * siluf_(lo16(zz[q][1])), oa[3] * rn * ha[3] * siluf_(hi16(zz[q][1])));
            yo[2] = cvt2(ob[0] * rn * hb[0] * siluf_(lo16(zz[q][2])), ob[1] * rn * hb[1] * siluf_(hi16(zz[q][2])));
            yo[3] = cvt2(ob[2] * rn * hb[2] * siluf_(lo16(zz[q][3])), ob[3] * rn * hb[3] * siluf_(hi16(zz[q][3])));
            yp[q] = yo; }
    }
}
template <int NCH, bool WT>
__device__ __forceinline__ void g2_task(Frame& F, LAS unsigned char* L, const float* DEC, int s, int h, int ch0, int tid, int lane, int wave) {
    const size_t cstep = (size_t)GS_BYTES;
    const int base = seq_base(s), nvalid = s < BP ? 64 : TS;
    const unsigned char* blk0 = F.ws + WS_RB + (size_t)ch0 * GS_BYTES;
    constexpr int lastc = NCH - 1;
    if (wave < 4) {
        const int ws = wave, cc = lane & 31, hh = lane >> 5;
        f32x16 S0, S1, S2, S3;
        if (s < BP) {
#pragma unroll
            for (int e = 0; e < 16; ++e) { S0[e] = 0.f; S1[e] = 0.f; S2[e] = 0.f; S3[e] = 0.f; }
        } else {
            const float* sp = F.in[7] + ((size_t)(s - BP) * 8 + h) * 16384 + 32 * ws + cc;
#pragma unroll
            for (int e = 0; e < 16; ++e) { const int rr = (e & 3) + 8 * (e >> 2) + 4 * hh; S0[e] = sp[(size_t)rr * 128]; S1[e] = sp[(size_t)(32 + rr) * 128]; S2[e] = sp[(size_t)(64 + rr) * 128]; S3[e] = sp[(size_t)(96 + rr) * 128]; }
        }
        const LAS float* dec_s = (const LAS float*)(L + G2_DEC);
        const int erow = tid >> 3, esub = tid & 7; const bool erok = erow < nvalid;
        u32x4 zz[2];
#define G2_ZLOAD(cidx) do { const u32x4* zp = (const u32x4*)(F.Z1() + ((size_t)base + (cidx) * 64 + erow) * D + h * 128 + esub * 16); zz[0] = zp[0]; zz[1] = zp[1]; } while (0)
        LDS_BARRIER();
        if (NCH == 1) { if (erok) G2_ZLOAD(0); g2_mfma_step(S0, S1, S2, S3, L, dec_s[0], ws, lane, cc, hh); g2_epi16(F, L, L, zz, erow, esub, (size_t)base + erow, h, erok, lane); LDS_BARRIER(); }
        else for (int c = 0; c < NCH; c += 2) {
            G2_ZLOAD(c);
            g2_mfma_step(S0, S1, S2, S3, L, dec_s[c], ws, lane, cc, hh);
            g2_epi16(F, L, L, zz, erow, esub, (size_t)base + c * 64 + erow, h, erok, lane);
            LDS_BARRIER();
            G2_ZLOAD(c + 1);
            g2_mfma_step(S0, S1, S2, S3, L + G2_FB, dec_s[c + 1], ws, lane, cc, hh);
            g2_epi16(F, L, L + G2_FB, zz, erow, esub, (size_t)base + (c + 1) * 64 + erow, h, erok, lane);
            LDS_BARRIER();
        }
        int l9 = lane; asm volatile("" : "+v"(l9));
        const int cc9 = l9 & 31, hh9 = l9 >> 5;
        float* so = (s < BP ? F.out + O_GSP + ((size_t)s * 8 + h) * 16384 : F.out + O_GSS + ((size_t)(s - BP) * 8 + h) * 16384) + 32 * ws + cc9;
#pragma unroll
        for (int e = 0; e < 16; ++e) { const int rr = (e & 3) + 8 * (e >> 2) + 4 * hh9; so[(size_t)rr * 128] = S0[e]; so[(size_t)(32 + rr) * 128] = S1[e]; so[(size_t)(64 + rr) * 128] = S2[e]; so[(size_t)(96 + rr) * 128] = S3[e]; }
    } else {
        const int lt = tid - 256;
        if (lt < 128) ((LAS float*)(L + G2_HN))[lt] = F.in[32][lt];
        const brsrc_t srs = staging_rsrc(F.ws);
        const unsigned* ready = (const unsigned*)(F.ws + WS_READY);
        LAS float* dec_w = (LAS float*)(L + G2_DEC);
#define G2_LOAD(pre, dpre, k) do { const int _k = (k) < lastc ? (k) : lastc; g2_load_set<WT>(pre, dpre, blk0 + (size_t)_k * cstep, lt, srs, (unsigned)(ch0 + _k) * (unsigned)GS_BYTES, ready + 16 * (ch0 + _k), DEC + ch0 + _k); } while (0)
        u32x4 preA[18], preB[18]; float dA, dB;
        G2_LOAD(preA, dA, 0);
        G2_LOAD(preB, dB, 1);
        g2_store_set(preA, L, lt); if (lt == 0) dec_w[0] = dA;
        G2_LOAD(preA, dA, 2);
        const int erow = tid >> 3, esub = tid & 7; const bool erok = erow < nvalid;
        u32x4 zz[2];
#define G2_ZLOAD(cidx) do { const u32x4* zp = (const u32x4*)(F.Z1() + ((size_t)base + (cidx) * 64 + erow) * D + h * 128 + esub * 16); zz[0] = zp[0]; zz[1] = zp[1]; } while (0)
        LDS_BARRIER();
        if (NCH == 1) {
            if (erok) G2_ZLOAD(0);
            LDS_BARRIER();
            LDS_BARRIER();
            g2_epi16(F, L, L, zz, erow, esub, (size_t)base + erow, h, erok, lane);
            LDS_BARRIER();
        } else {
            for (int c = 0; c < NCH; c += 2) {
                {
                    g2_store_set(preB, L + G2_FB, lt); if (lt == 0) dec_w[(c + 1) & 63] = dB;
                    G2_ZLOAD(c);
                    G2_LOAD(preB, dB, c + 3);
                    LDS_BARRIER();
                    LDS_BARRIER();
                    g2_epi16(F, L, L, zz, erow, esub, (size_t)base + c * 64 + erow, h, erok, lane);
                    LDS_BARRIER();
                }
                {
                    g2_store_set(preA, L, lt); if (lt == 0) dec_w[(c + 2) & 63] = dA;
                    G2_ZLOAD(c + 1);
                    G2_LOAD(preA, dA, c + 4);
                    LDS_BARRIER();
                    LDS_BARRIER();
                    g2_epi16(F, L, L + G2_FB, zz, erow, esub, (size_t)base + (c + 1) * 64 + erow, h, erok, lane);
                    LDS_BARRIER();
                }
            }
        }
    }
}
#undef G2_ZLOAD
#undef G2_LOAD
constexpr int G12_CHAINS = 64;
__device__ __forceinline__ void phase_gdn_fused(Frame& F) {
    LAS unsigned char* L = F.lds;
    const float* DEC = (const float*)(F.ws + WS_DEC);
    if ((int)blockIdx.x < G12_CHAINS && F.G > G12_CHAINS) {
        const int tid = opaque_tid(F.wv);
        const int ci = blockIdx.x;
        g2_task<64, true>(F, L, DEC, ci >> 3, ci & 7, ci * 64, tid, tid & 63, F.wv);
    } else {
        const bool all = !(F.G > G12_CHAINS);
        const int p = all ? (int)blockIdx.x : (int)blockIdx.x - G12_CHAINS, np = all ? F.G : F.G - G12_CHAINS;
        gdn_g1_tasks(F, p, np);
        for (int t = p; t < 128; t += np) {
            const int tid = opaque_tid(F.wv);
            __syncthreads();
            g2_task<1, true>(F, L, DEC, BP + (t >> 3), t & 7, 4096 + t, tid, tid & 63, F.wv);
        }
    }
}

__device__ __forceinline__ float dpp_shr_f(float idv, float x, const int o) {
    int r;
    switch (o) {
        case 1: r = __builtin_amdgcn_update_dpp(__float_as_int(idv), __float_as_int(x), 0x111, 0xf, 0xf, false); break;
        case 2: r = __builtin_amdgcn_update_dpp(__float_as_int(idv), __float_as_int(x), 0x112, 0xf, 0xf, false); break;
        case 4: r = __builtin_amdgcn_update_dpp(__float_as_int(idv), __float_as_int(x), 0x114, 0xf, 0xf, false); break;
        default: r = __builtin_amdgcn_update_dpp(__float_as_int(idv), __float_as_int(x), 0x118, 0xf, 0xf, false); break;
    }
    return __int_as_float(r);
}
template <int PASS>
__device__ __forceinline__ void phase_lru(Frame& F) {
    int tid = opaque_tid(F.wv);
    const int lane = tid & 63, wave = __builtin_amdgcn_readfirstlane(tid >> 6);
    const int gw = F.vcu * 8 + wave, NGW = F.G * 8, h = gw & 7, g = lane >> 4, l15 = lane & 15;
    LAS unsigned char* xs = F.lds + wave * 9216;
    LAS float* cst = (LAS float*)(F.lds + 73728 + wave * 768);
    const bf16_t* LGW = (const bf16_t*)(F.ws + WS_LGW);
    float* LAG = F.LAG();
    bf16x8 wfa[4][2], wfx[4][2];
#pragma unroll
    for (int nt = 0; nt < 4; ++nt)
#pragma unroll
        for (int ks = 0; ks < 2; ++ks) {
            wfa[nt][ks] = *(const bf16x8*)(LGW + ((size_t)(h * 2 + 0) * 64 + 16 * nt + l15) * 64 + 32 * ks + 8 * g);
            wfx[nt][ks] = *(const bf16x8*)(LGW + ((size_t)(h * 2 + 1) * 64 + 16 * nt + l15) * 64 + 32 * ks + 8 * g); }
    cst[lane] = F.in[18][h * 64 + lane]; cst[64 + lane] = F.in[20][h * 64 + lane]; cst[128 + lane] = softplusf_(-F.in[21][h * 64 + lane]);
    for (int task = gw; task < 4224; task += NGW) {
        int s, c; if (task < 4096) { s = task >> 9; c = (task >> 3) & 63; } else { s = BP + ((task - 4096) >> 3); c = 0; }
        const int T = seq_len(s), base = seq_base(s), t0 = c * 64, ntile = s < BP ? 4 : 1;
        {
            int l1 = lane; asm volatile("" : "+v"(l1));
            const int cg = l1 & 7, tp = l1 >> 3;
#pragma unroll 1
            for (int hf2 = 0; hf2 < 2; ++hf2) {
                const int chb = h * 64 + cg * 8 + hf2 * 4;
                float xr[11][4];
                if (s < BP) {
                    u32x2 w[11];
#pragma unroll
                    for (int i = 0; i < 11; ++i) { int tt = t0 + tp * 8 - 3 + i; tt = tt < 0 ? 0 : tt; w[i] = *(const u32x2*)(F.U0() + (size_t)(base + tt) * EV_IN + C_XA + chb); }
                    if (t0 == 0 && tp == 0) { w[0] = (u32x2){0u, 0u}; w[1] = (u32x2){0u, 0u}; w[2] = (u32x2){0u, 0u}; }
#pragma unroll
                    for (int i = 0; i < 11; ++i) { xr[i][0] = lo16(w[i][0]); xr[i][1] = hi16(w[i][0]); xr[i][2] = lo16(w[i][1]); xr[i][3] = hi16(w[i][1]); }
                } else {
#pragma unroll
                    for (int i = 0; i < 11; ++i) {
                        const int tt = t0 + tp * 8 - 3 + i;
                        if (tt >= 0 && tt < T) { const u32x2 w = *(const u32x2*)(F.U0() + (size_t)(base + tt) * EV_IN + C_XA + chb);
                            xr[i][0] = lo16(w[0]); xr[i][1] = hi16(w[0]); xr[i][2] = lo16(w[1]); xr[i][3] = hi16(w[1]); }
                        else if (tt < 0) { const f32x4 a = *(const f32x4*)(F.in[2] + ((size_t)(s - BP) * 3 + (tt + 3)) * 512 + chb); xr[i][0] = a[0]; xr[i][1] = a[1]; xr[i][2] = a[2]; xr[i][3] = a[3]; }
                        else { xr[i][0] = 0.f; xr[i][1] = 0.f; xr[i][2] = 0.f; xr[i][3] = 0.f; }
                    }
                }
                const f32x4 c0 = *(const f32x4*)(F.in[15] + chb), c1 = *(const f32x4*)(F.in[15] + 512 + chb), c2 = *(const f32x4*)(F.in[15] + 1024 + chb), c3 = *(const f32x4*)(F.in[15] + 1536 + chb), cb = *(const f32x4*)(F.in[16] + chb);
#pragma unroll
                for (int i = 0; i < 8; ++i) { float o[4];
#pragma unroll
                    for (int e = 0; e < 4; ++e) o[e] = c0[e] * xr[i][e] + c1[e] * xr[i + 1][e] + c2[e] * xr[i + 2][e] + c3[e] * xr[i + 3][e] + cb[e];
                    u32x2 w; w[0] = cvt2(o[0], o[1]); w[1] = cvt2(o[2], o[3]);
                    *(LAS u32x2*)(xs + (tp * 8 + i) * 144 + cg * 16 + hf2 * 8) = w; }
                if (PASS == 2 && t0 + 64 >= T && tp == ((T - 1) >> 3) - (t0 >> 3)) {
                    float* o = (s < BP ? F.out + O_LCP + (size_t)s * 3 * 512 : F.out + O_LCS + (size_t)(s - BP) * 3 * 512) + chb;
#pragma unroll
                    for (int q = 0; q < 3; ++q) *(f32x4*)(o + q * 512) = (f32x4){xr[8 + q][0], xr[8 + q][1], xr[8 + q][2], xr[8 + q][3]};
                }
            }
        }
        float hin[4][4], arun[4][4];
#pragma unroll
        for (int nt = 0; nt < 4; ++nt)
#pragma unroll
            for (int rg = 0; rg < 4; ++rg) { hin[nt][rg] = 0.f; arun[nt][rg] = 1.f; }
        if (PASS == 2) {
            float hf = s >= BP ? F.in[3][(s - BP) * 512 + h * 64 + lane] : 0.f;
            const f32x2* lp = (const f32x2*)LAG + (size_t)(s * 64) * 512 + h * 64 + lane;
            for (int j0 = 0; j0 < c; j0 += 16) { f32x2 v[16];
#pragma unroll
                for (int q = 0; q < 16; ++q) { const int jj = j0 + q < c ? j0 + q : c - 1; v[q] = lp[(size_t)jj * 512]; }
#pragma unroll
                for (int q = 0; q < 16; ++q) if (j0 + q < c) hf = v[q][0] * hf + v[q][1]; }
#pragma unroll
            for (int nt = 0; nt < 4; ++nt)
#pragma unroll
                for (int rg = 0; rg < 4; ++rg) hin[nt][rg] = shfl_idx(hf, 16 * nt + 4 * g + rg);
        }
        asm volatile("s_waitcnt lgkmcnt(0)" ::: "memory");
        for (int tt = 0; tt < ntile; ++tt) {
            const int tok = 16 * tt + l15;
            const bf16x8 b0 = *(const LAS bf16x8*)(xs + tok * 144 + (8 * g) * 2), b1 = *(const LAS bf16x8*)(xs + tok * 144 + (32 + 8 * g) * 2);
            const size_t m = (size_t)base + t0 + tok;
#pragma unroll
            for (int nt = 0; nt < 4; ++nt) {
                f32x4 za = {0.f, 0.f, 0.f, 0.f}, zx = {0.f, 0.f, 0.f, 0.f};
                za = MFMA16(wfa[nt][0], b0, za); za = MFMA16(wfa[nt][1], b1, za);
                zx = MFMA16(wfx[nt][0], b0, zx); zx = MFMA16(wfx[nt][1], b1, zx);
                const int n0 = 16 * nt + 4 * g;
                const u32x2 xw = *(const LAS u32x2*)(xs + tok * 144 + n0 * 2);
                const float xc[4] = {lo16(xw[0]), hi16(xw[0]), lo16(xw[1]), hi16(xw[1])};
                const f32x4 cba = *(const LAS f32x4*)(cst + n0), cbx = *(const LAS f32x4*)(cst + 64 + n0), csp = *(const LAS f32x4*)(cst + 128 + n0);
                float av[4], bv[4];
#pragma unroll
                for (int rg = 0; rg < 4; ++rg) {
                    const float r = sigmoidf_(za[rg] + cba[rg]), ig = sigmoidf_(zx[rg] + cbx[rg]), la = -8.0f * r * csp[rg], a = __expf(la);
                    av[rg] = a; bv[rg] = __builtin_amdgcn_sqrtf(fmaxf(1.0f - a * a, 0.f)) * (ig * xc[rg]); }
#pragma unroll
                for (int o = 1; o < 16; o <<= 1)
#pragma unroll
                    for (int rg = 0; rg < 4; ++rg) { const float ap = dpp_shr_f(1.0f, av[rg], o), bp = dpp_shr_f(0.0f, bv[rg], o); bv[rg] = av[rg] * bp + bv[rg]; av[rg] = av[rg] * ap; }
                float hv[4];
#pragma unroll
                for (int rg = 0; rg < 4; ++rg) { hv[rg] = bv[rg] + av[rg] * hin[nt][rg]; hin[nt][rg] = shfl_idx(hv[rg], (lane & 48) | 15); }
                if (PASS == 1) {
#pragma unroll
                    for (int rg = 0; rg < 4; ++rg) arun[nt][rg] *= shfl_idx(av[rg], (lane & 48) | 15);
                } else {
                    const bool tok_ok = (t0 + tok) < T;
                    if (tok_ok) {
                        const u32x2 gw2 = *(const u32x2*)(F.U0() + m * EV_IN + C_GA + h * 64 + n0);
                        u32x2 yo; yo[0] = cvt2(hv[0] * siluf_(lo16(gw2[0])), hv[1] * siluf_(hi16(gw2[0]))); yo[1] = cvt2(hv[2] * siluf_(lo16(gw2[1])), hv[3] * siluf_(hi16(gw2[1])));
                        *(u32x2*)(F.Y0() + m * D + h * 64 + n0) = yo;
                        if (t0 + tok == T - 1) { float* o = (s < BP ? F.out + O_LHP + s * 512 : F.out + O_LHS + (s - BP) * 512) + h * 64 + n0; *(f32x4*)o = (f32x4){hv[0], hv[1], hv[2], hv[3]}; }
                    }
                }
                if (nt & 1) __builtin_amdgcn_sched_barrier(0);
            }
        }
        if (PASS == 1 && s < BP && l15 == 15) {
            f32x2* lp = (f32x2*)LAG + (size_t)(s * 64 + c) * 512 + h * 64;
#pragma unroll
            for (int nt = 0; nt < 4; ++nt)
#pragma unroll
                for (int rg = 0; rg < 4; ++rg) lp[16 * nt + 4 * g + rg] = (f32x2){arun[nt][rg], hin[nt][rg]};
        }
        asm volatile("s_waitcnt lgkmcnt(0)" ::: "memory");
    }
}

constexpr size_t RB_VTP = RB_WEND, RB_VTS = RB_VTP + (size_t)BP * 2 * 64 * TP * 2, RB_VTEND = RB_VTS + (size_t)BS * 2 * 64 * 192 * 2;
static_assert(RB_VTEND <= RB_BYTES, "ws map");
__device__ __forceinline__ void phase_vt_build(Frame& F) {
    PHASE_IDS();
    const int gw = F.vcu * 8 + wave, NGW = F.G * 8;
    LAS unsigned char* xs = F.lds + wave * 9216;
    bf16_t* VTP = (bf16_t*)(F.ws + WS_RB + RB_VTP); bf16_t* VTS = (bf16_t*)(F.ws + WS_RB + RB_VTS);
    for (int task = gw; task < 1024 + 96; task += NGW) {
        int s, kv, kb; if (task < 1024) { s = task >> 7; kv = (task >> 6) & 1; kb = task & 63; } else { const int r = task - 1024; s = BP + r / 6; kv = (r % 6) / 3; kb = r % 3; }
        const int row8 = lane >> 3, ch = lane & 7;
#pragma unroll
        for (int i = 0; i < 8; ++i) {
            const int key = 8 * i + row8, kg = kb * 64 + key; u32x4 w = {0u, 0u, 0u, 0u};
            if (s < BP) w = *(const u32x4*)(F.U0() + (size_t)(s * TP + kg) * EV_IN + C_V + kv * 64 + ch * 8);
            else if (kg < 128) { const f32x4* p = (const f32x4*)(F.in[5] + ((size_t)((s - BP) * 128 + kg) * 2 + kv) * 64 + ch * 8); const f32x4 a = p[0], b = p[1]; w[0] = cvt2(a[0], a[1]); w[1] = cvt2(a[2], a[3]); w[2] = cvt2(b[0], b[1]); w[3] = cvt2(b[2], b[3]); }
            else if (kg < 128 + TS) w = *(const u32x4*)(F.U0() + (size_t)(MP + (s - BP) * TS + (kg - 128)) * EV_IN + C_V + kv * 64 + ch * 8);
            *(LAS u32x4*)(xs + key * 144 + ch * 16) = w;
        }
        asm volatile("s_waitcnt lgkmcnt(0)" ::: "memory");
        bf16_t* dst = s < BP ? VTP + ((size_t)(s * 2 + kv) * 64 + lane) * TP + kb * 64 : VTS + ((size_t)((s - BP) * 2 + kv) * 64 + lane) * 192 + kb * 64;
#pragma unroll
        for (int q = 0; q < 8; ++q) { u32x4 o;
#pragma unroll
            for (int e = 0; e < 4; ++e) { const unsigned lo = *(const LAS bf16_t*)(xs + (8 * q + 2 * e) * 144 + lane * 2), hi = *(const LAS bf16_t*)(xs + (8 * q + 2 * e + 1) * 144 + lane * 2); o[e] = lo | (hi << 16); }
            *(u32x4*)(dst + 8 * q) = o; }
        asm volatile("s_waitcnt lgkmcnt(0)" ::: "memory");
    }
}
constexpr int AT_K = 0, AT_V = 27648;
__device__ __forceinline__ void attn_issue(Frame& F, const bf16_t* VTP, int task, int tid, int wave, int lane, u32x4 (&kreg)[3], u32x4 (&vreg)[3], u32x4 (&qreg)[4]) {
    const int s = task >> 7, c = (task >> 1) & 63, kv = task & 1, tok0 = c * 64 - 128;
#pragma unroll
    for (int i = 0; i < 3; ++i) { const int idx = tid + 512 * i, key = idx >> 3, ch = idx & 7; int tk = tok0 + key; tk = tk < 0 ? 0 : tk;
        kreg[i] = *(const u32x4*)(F.U0() + (size_t)(s * TP + tk) * EV_IN + C_K + kv * 64 + ch * 8); }
#pragma unroll
    for (int i = 0; i < 3; ++i) { const int idx = tid + 512 * i, d = idx / 24, ch = idx % 24; int tk = tok0 + ch * 8; tk = tk < 0 ? 0 : tk;
        vreg[i] = *(const u32x4*)(VTP + ((size_t)(s * 2 + kv) * 64 + d) * TP + tk); }
    const int g = wave >> 1, qh = wave & 1, hq = kv * 4 + g, r = lane & 31, hh = lane >> 5;
    const size_t m = (size_t)s * TP + c * 64 + qh * 32 + r;
#pragma unroll
    for (int ks = 0; ks < 4; ++ks) qreg[ks] = *(const u32x4*)(F.U0() + m * EV_IN + C_Q + hq * 64 + 16 * ks + 8 * hh);
}
__device__ __forceinline__ void phase_attn(Frame& F) {
    PHASE_IDS();
    LAS unsigned char* L = F.lds;
    const bf16_t* VTP = (const bf16_t*)(F.ws + WS_RB + RB_VTP); const bf16_t* VTS = (const bf16_t*)(F.ws + WS_RB + RB_VTS);
    u32x4 kreg[3], vreg[3], qreg[4];
    attn_issue(F, VTP, F.vcu < 1024 ? F.vcu : 0, tid, wave, lane, kreg, vreg, qreg);
    for (int ti = F.vcu; ti < 1024 + 64; ti += F.G) {
        if (ti >= 1024 && ti < 1056) continue;
        const int task = ti < 1024 ? ti : ti - 32;
        int s, c, kv; if (task < 1024) { s = task >> 7; c = (task >> 1) & 63; kv = task & 1; } else { s = BP + ((task - 1024) >> 1); c = 0; kv = task & 1; }
        const int base = seq_base(s), tok0 = c * 64 - 128;
        const int kmin = s < BP ? (tok0 < 0 ? -tok0 : 0) : 0, kmax = s < BP ? 192 : 128 + TS;
        const int tid = opaque_tid(F.wv), lane = tid & 63;
        const int g = wave >> 1, qh = wave & 1, hq = kv * 4 + g, r = lane & 31, hh = lane >> 5, qi = qh * 32 + r;
        const bool qok = s < BP ? true : qi < TS;
        const size_t m = (size_t)base + c * 64 + (qok ? qi : 0);
        bf16x8 qf[4]; u32x2 gbr[8];
        LDS_BARRIER();
        if (s < BP) {
#pragma unroll
            for (int i = 0; i < 3; ++i) { const int idx = tid + 512 * i, key = idx >> 3, ch = idx & 7; const u32x4 z = {0u, 0u, 0u, 0u}; *(LAS u32x4*)(L + AT_K + key * 144 + ch * 16) = key >= kmin ? kreg[i] : z; }
#pragma unroll
            for (int i = 0; i < 3; ++i) { const int idx = tid + 512 * i, d = idx / 24, ch = idx % 24; const u32x4 z = {0u, 0u, 0u, 0u}; *(LAS u32x4*)(L + AT_V + d * 400 + ch * 16) = ch * 8 >= kmin ? vreg[i] : z; }
#pragma unroll
            for (int ks = 0; ks < 4; ++ks) { u32x4 w;
#pragma unroll
                for (int e = 0; e < 4; ++e) w[e] = cvt2(lo16(qreg[ks][e]) * 0.125f, hi16(qreg[ks][e]) * 0.125f);
                qf[ks] = __builtin_bit_cast(bf16x8, w); }
        } else {
#pragma unroll
            for (int i = 0; i < 3; ++i) {
                const int idx = tid + 512 * i, key = idx >> 3, ch = idx & 7; u32x4 w = {0u, 0u, 0u, 0u};
                if (key < kmax) {
                    if (key < 128) { const f32x4* p = (const f32x4*)(F.in[4] + ((size_t)((s - BP) * 128 + key) * 2 + kv) * 64 + ch * 8); const f32x4 a = p[0], b2 = p[1]; w[0] = cvt2(a[0], a[1]); w[1] = cvt2(a[2], a[3]); w[2] = cvt2(b2[0], b2[1]); w[3] = cvt2(b2[2], b2[3]); }
                    else w = *(const u32x4*)(F.U0() + (size_t)(base + key - 128) * EV_IN + C_K + kv * 64 + ch * 8);
                }
                *(LAS u32x4*)(L + AT_K + key * 144 + ch * 16) = w;
            }
#pragma unroll
            for (int i = 0; i < 3; ++i) {
                const int idx = tid + 512 * i, d = idx / 24, ch = idx % 24, key = ch * 8;
                *(LAS u32x4*)(L + AT_V + d * 400 + ch * 16) = *(const u32x4*)(VTS + ((size_t)((s - BP) * 2 + kv) * 64 + d) * 192 + key);
            }
#pragma unroll
            for (int ks = 0; ks < 4; ++ks) { u32x4 w = {0u, 0u, 0u, 0u};
                if (qok) { const u32x4 x = *(const u32x4*)(F.U0() + m * EV_IN + C_Q + hq * 64 + 16 * ks + 8 * hh);
#pragma unroll
                    for (int e = 0; e < 4; ++e) w[e] = cvt2(lo16(x[e]) * 0.125f, hi16(x[e]) * 0.125f); }
                qf[ks] = __builtin_bit_cast(bf16x8, w); }
        }
#pragma unroll
        for (int qq = 0; qq < 4; ++qq) { gbr[2 * qq] = qok ? *(const u32x2*)(F.U0() + m * EV_IN + C_GB + hq * 64 + 8 * qq + 4 * hh) : (u32x2){0u, 0u}; gbr[2 * qq + 1] = qok ? *(const u32x2*)(F.U0() + m * EV_IN + C_GB + hq * 64 + 32 + 8 * qq + 4 * hh) : (u32x2){0u, 0u}; }
        { const int nt = ti + F.G < 1024 ? ti + F.G : (ti < 1024 ? ti : 0); int t9 = tid; asm volatile("" : "+v"(t9)); attn_issue(F, VTP, nt, t9, wave, t9 & 63, kreg, vreg, qreg); }
        const float sink = F.in[22][hq];
        LDS_BARRIER();
        float mrun = sink, lrun = 1.0f;
        f32x16 o0, o1;
#pragma unroll
        for (int e = 0; e < 16; ++e) { o0[e] = 0.f; o1[e] = 0.f; }
#pragma unroll 1
        for (int half = 0; half < 2; ++half) {
            f32x16 sc[3];
#pragma unroll
            for (int k3 = 0; k3 < 3; ++k3) {
                const int kt = 3 * half + k3;
#pragma unroll
                for (int e = 0; e < 16; ++e) sc[k3][e] = 0.f;
#pragma unroll
                for (int ks = 0; ks < 4; ++ks) { const bf16x8 kf = *(const LAS bf16x8*)(L + AT_K + (32 * kt + r) * 144 + (16 * ks + 8 * hh) * 2); sc[k3] = MFMA32(kf, qf[ks], sc[k3]); }
            }
            float mx = -1e30f;
#pragma unroll
            for (int k3 = 0; k3 < 3; ++k3)
#pragma unroll
                for (int e = 0; e < 16; ++e) { const int kidx = 32 * (3 * half + k3) + (e & 3) + 8 * (e >> 2) + 4 * hh; const bool ok = kidx >= kmin && kidx < kmax; sc[k3][e] = ok ? sc[k3][e] : -1e30f; mx = fmaxf(mx, sc[k3][e]); }
            mx = fmaxf(mx, shfl_xor_l(mx, 32, lane));
            const float mnew = fmaxf(mrun, mx), alpha = __expf(mrun - mnew);
            float psum = 0.f;
#pragma unroll
            for (int k3 = 0; k3 < 3; ++k3)
#pragma unroll
                for (int e = 0; e < 16; ++e) { const float p = __expf(sc[k3][e] - mnew); sc[k3][e] = p; psum += p; }
            psum += shfl_xor_l(psum, 32, lane);
            lrun = lrun * alpha + psum; mrun = mnew;
            o0 = o0 * alpha; o1 = o1 * alpha;
#pragma unroll
            for (int k3 = 0; k3 < 3; ++k3)
#pragma unroll
                for (int ss = 0; ss < 2; ++ss) {
                    const int kt = 3 * half + k3;
                    const bf16x8 pb = pack8(sc[k3], ss);
                    const LAS unsigned char* vp = L + AT_V + r * 400 + (32 * kt + 16 * ss + 4 * hh) * 2;
                    const u32x2 a0 = *(const LAS u32x2*)vp, a1 = *(const LAS u32x2*)(vp + 16), b0 = *(const LAS u32x2*)(vp + 32 * 400), b1 = *(const LAS u32x2*)(vp + 32 * 400 + 16);
                    const u32x4 va = {a0[0], a0[1], a1[0], a1[1]}, vb = {b0[0], b0[1], b1[0], b1[1]};
                    o0 = MFMA32(__builtin_bit_cast(bf16x8, va), pb, o0); o1 = MFMA32(__builtin_bit_cast(bf16x8, vb), pb, o1);
                }
        }
        const float il = __builtin_amdgcn_rcpf(lrun);
        if (qok) {
#pragma unroll
            for (int qq = 0; qq < 4; ++qq) {
                { const int d = 8 * qq + 4 * hh; const u32x2 gb = gbr[2 * qq];
                  u32x2 yo; yo[0] = cvt2(o0[4 * qq] * il * siluf_(lo16(gb[0])), o0[4 * qq + 1] * il * siluf_(hi16(gb[0]))); yo[1] = cvt2(o0[4 * qq + 2] * il * siluf_(lo16(gb[1])), o0[4 * qq + 3] * il * siluf_(hi16(gb[1])));
                  *(u32x2*)(F.Y0() + m * D + 512 + hq * 64 + d) = yo; }
                { const int d = 32 + 8 * qq + 4 * hh; const u32x2 gb = gbr[2 * qq + 1];
                  u32x2 yo; yo[0] = cvt2(o1[4 * qq] * il * siluf_(lo16(gb[0])), o1[4 * qq + 1] * il * siluf_(hi16(gb[0]))); yo[1] = cvt2(o1[4 * qq + 2] * il * siluf_(lo16(gb[1])), o1[4 * qq + 3] * il * siluf_(hi16(gb[1])));
                  *(u32x2*)(F.Y0() + m * D + 512 + hq * 64 + d) = yo; }
            }
        }
    }
    __syncthreads();
}

constexpr int SG_A = 0, SG_B = 36864, SG_BUF = 36864 + 9216;
struct SOut { bf16_t* O0; int ld0; int split; bf16_t* O1; int ld1; };
__device__ __forceinline__ void sgemm_strip(Frame& F, const bf16_t* A, const bf16_t* Bt, const int K, const int n0, const SOut o, const int tid, const int lane, const int wave) {
    LAS unsigned char* L = F.lds;
    const int nkt = K / 64;
    const bf16_t* ap = A + (size_t)(tid >> 3) * K + (tid & 7) * 8;
    const bf16_t* bp = Bt + (size_t)(n0 + (tid >> 3)) * K + (tid & 7) * 8;
    const int lofs = (tid >> 3) * 144 + (tid & 7) * 16;
    u32x4 ra[4], rb, sa[4], sb;
#define SG_LOAD(RA, RB, kt) do { _Pragma("unroll") for (int i = 0; i < 4; ++i) RA[i] = *(const u32x4*)(ap + (size_t)i * 64 * K + (kt) * 64); RB = *(const u32x4*)(bp + (kt) * 64); } while (0)
#define SG_STORE(RA, RB, buf) do { _Pragma("unroll") for (int i = 0; i < 4; ++i) *(LAS u32x4*)(L + (buf) * SG_BUF + SG_A + lofs + i * 64 * 144) = RA[i]; *(LAS u32x4*)(L + (buf) * SG_BUF + SG_B + lofs) = RB; } while (0)
    SG_LOAD(ra, rb, 0); SG_LOAD(sa, sb, 1);
    SG_STORE(ra, rb, 0);
    SG_LOAD(ra, rb, (2 < nkt ? 2 : nkt - 1));
    f32x16 acc0, acc1;
#pragma unroll
    for (int e = 0; e < 16; ++e) { acc0[e] = 0.f; acc1[e] = 0.f; }
    const int r = lane & 31, hh = lane >> 5;
    LDS_BARRIER();
    for (int kt = 0; kt < nkt; kt += 2) {
#define SG_STEP(buf, RA, RB, knext) do { \
        const LAS unsigned char* Ab = L + (buf) * SG_BUF + SG_A + (32 * wave + r) * 144 + hh * 16; const LAS unsigned char* Bb = L + (buf) * SG_BUF + SG_B + r * 144 + hh * 16; \
        _Pragma("unroll") for (int ks = 0; ks < 4; ++ks) { const bf16x8 af = *(const LAS bf16x8*)(Ab + ks * 32), b0 = *(const LAS bf16x8*)(Bb + ks * 32), b1 = *(const LAS bf16x8*)(Bb + 32 * 144 + ks * 32); \
            acc0 = MFMA32(b0, af, acc0); acc1 = MFMA32(b1, af, acc1); } \
        SG_STORE(RA, RB, (buf) ^ 1); { const int kn = (knext) < nkt ? (knext) : nkt - 1; SG_LOAD(RA, RB, kn); } \
        LDS_BARRIER(); } while (0)
        SG_STEP(0, sa, sb, kt + 3);
        SG_STEP(1, ra, rb, kt + 4);
    }
#undef SG_STEP
#undef SG_LOAD
#undef SG_STORE
    const int row = 32 * wave + r; int colt = n0; bf16_t* base = o.O0; int ld = o.ld0;
    if (colt >= o.split) { base = o.O1; ld = o.ld1; colt -= o.split; }
    bf16_t* rowp = base + (size_t)row * ld + colt;
#pragma unroll
    for (int q = 0; q < 4; ++q) {
        u32x2 w0, w1; w0[0] = cvt2(acc0[4 * q], acc0[4 * q + 1]); w0[1] = cvt2(acc0[4 * q + 2], acc0[4 * q + 3]); w1[0] = cvt2(acc1[4 * q], acc1[4 * q + 1]); w1[1] = cvt2(acc1[4 * q + 2], acc1[4 * q + 3]);
        *(u32x2*)(rowp + 8 * q + 4 * hh) = w0; *(u32x2*)(rowp + 32 + 8 * q + 4 * hh) = w1; }
    LDS_BARRIER();
}
__device__ __forceinline__ void sgemm_phase(Frame& F, const bf16_t* A, const bf16_t* Bt, const int N, const int K, const SOut o, const int from) {
    const int nstrip = N / 64;
    for (int st = ((int)blockIdx.x - from + F.G) % F.G; st < nstrip; st += F.G) {
        const int tid = opaque_tid(F.wv);
        sgemm_strip(F, A, Bt, K, st * 64, o, tid, tid & 63, F.wv);
    }
}

__device__ __forceinline__ void rows_final(Frame& F, const int m0, const int n, const int s, const int lane) {
    const float* MODP = (const float*)(F.ws + WS_MODP);
    f32x4 A1[4];
#pragma unroll
    for (int j = 0; j < 4; ++j) { const int c = 4 * lane + 256 * j; const f32x4 g = *(const f32x4*)(F.in[27] + c), gt = mod4(MODP, 1, s, 2048 + c);
#pragma unroll
        for (int e = 0; e < 4; ++e) A1[j][e] = gt[e] * g[e]; }
    u32x2 ycur[4]; f32x4 xcur[4];
#pragma unroll
    for (int j = 0; j < 4; ++j) { ycur[j] = *(const u32x2*)(F.YO() + (size_t)m0 * D + 4 * lane + 256 * j); xcur[j] = *(const f32x4*)(F.out + O_Y + (size_t)m0 * D + 4 * lane + 256 * j); }
    for (int i = 0; i < n; ++i) {
        const int m = m0 + i, mn = m0 + (i + 1 < n ? i + 1 : i); u32x2 ynxt[4]; f32x4 xnxt[4];
#pragma unroll
        for (int j = 0; j < 4; ++j) { ynxt[j] = *(const u32x2*)(F.YO() + (size_t)mn * D + 4 * lane + 256 * j); xnxt[j] = *(const f32x4*)(F.out + O_Y + (size_t)mn * D + 4 * lane + 256 * j); }
        f32x4 y[4]; float ss = 0.f;
#pragma unroll
        for (int j = 0; j < 4; ++j) { y[j] = (f32x4){lo16(ycur[j][0]), hi16(ycur[j][0]), lo16(ycur[j][1]), hi16(ycur[j][1])}; ss += (y[j][0] * y[j][0] + y[j][1] * y[j][1]) + (y[j][2] * y[j][2] + y[j][3] * y[j][3]); }
        const float r1 = rsqrtf(wave_sum(ss, lane) * (1.f / D) + EPS);
#pragma unroll
        for (int j = 0; j < 4; ++j) { f32x4 o;
#pragma unroll
            for (int e = 0; e < 4; ++e) o[e] = xcur[j][e] + A1[j][e] * (y[j][e] * r1);
            *(f32x4*)(F.out + O_Y + (size_t)m * D + 4 * lane + 256 * j) = o; }
#pragma unroll
        for (int j = 0; j < 4; ++j) { ycur[j] = ynxt[j]; xcur[j] = xnxt[j]; }
    }
}
__device__ __forceinline__ void phase_final_rowwise(Frame& F) {
    PHASE_IDS();
    const int gw = F.vcu * 8 + wave, NGW = F.G * 8;
    for (int w = gw; w < MP / 16; w += NGW) rows_final(F, w * 16, 16, w >> 8, lane);
    for (int w = gw; w < MS; w += NGW) rows_final(F, MP + w, 1, BP + (w >> 4), lane);
}

__global__ void __launch_bounds__(512, 2) fwd_megakernel(Params P) {
    extern __shared__ __attribute__((aligned(16))) unsigned char lds_raw[];
    Frame F;
    F.lds = (LAS unsigned char*)lds_raw;
    F.wv = __builtin_amdgcn_readfirstlane(threadIdx.x >> 6);
    F.G = gridDim.x; { const int bx = blockIdx.x; F.vcu = (F.G % 8 == 0) ? (bx % 8) * (F.G / 8) + bx / 8 : bx; }
    F.in = P.in; F.out = P.out; F.ws = P.ws;

    volatile LAS unsigned* misc = (volatile LAS unsigned*)(F.lds + LDS_BYTES - 64);
    if (threadIdx.x < 16) misc[threadIdx.x] = 0u;
    __syncthreads();
    XcdBarrier xbar = xcd_barrier_post((unsigned*)(P.ws + WS_CTL), misc);
#define GRID_BAR() xcd_barrier(xbar, F.wv)
    phase_mod0(F);
    GRID_BAR();
    phase_prologue(F);
    phase_mod1(F);
    phase_prenorm0(F);
    GRID_BAR();
    { pg8::Gemm g{F.XN(), F.W0I(), MP, EV_IN, D}; pg8::StaticOrder S; S.init(MP, EV_IN, F.G, (int)blockIdx.x);
      pg8::EpiBf16 E{F.U0(), EV_IN, 1 << 30, F.U0(), EV_IN}; pg8::gemm_phase(F.lds, g, S, E, F.wv);
      sgemm_phase(F, F.XN() + (size_t)MP * D, F.W0I(), EV_IN, D, SOut{F.U0() + (size_t)MP * EV_IN, EV_IN, 1 << 30, nullptr, 0}, 128); }
    GRID_BAR();
    phase_rope(F);
    phase_lru<1>(F);
    phase_vt_build(F);
    GRID_BAR();
    phase_lru<2>(F);
    phase_attn(F);
    GRID_BAR();
    { pg8::Gemm g{F.Y0(), F.W0O(), MP, D, D}; pg8::StaticOrder S; S.init(MP, D, F.G, (int)blockIdx.x);
      pg8::EpiBf16 E{F.YO(), D, 1 << 30, F.YO(), D}; pg8::gemm_phase(F.lds, g, S, E, F.wv);
      sgemm_phase(F, F.Y0() + (size_t)MP * D, F.W0O(), D, D, SOut{F.YO() + (size_t)MP * D, D, 1 << 30, nullptr, 0}, 0); }
    GRID_BAR();
    phase_mid_rowwise(F);
    GRID_BAR();
    { pg8::Gemm g{F.XN(), F.W1I(), MP, OD_MAIN, D}; pg8::StaticOrder S; S.init(MP, OD_MAIN, F.G, (int)blockIdx.x);
      pg8::EpiBf16 E{F.QKV1(), 3072, 3072, F.Z1(), D}; pg8::gemm_phase(F.lds, g, S, E, F.wv);
      sgemm_phase(F, F.XN() + (size_t)MP * D, F.W1I(), OD_MAIN, D, SOut{F.QKV1() + (size_t)MP * 3072, 3072, 3072, F.Z1() + (size_t)MP * D, D}, 0); }
    GRID_BAR();
    phase_gdn_fused(F);
    GRID_BAR();
    { pg8::Gemm g{F.Y1(), F.W1O(), MP, D, D}; pg8::StaticOrder S; S.init(MP, D, F.G, (int)blockIdx.x);
      pg8::EpiBf16 E{F.YO(), D, 1 << 30, F.YO(), D}; pg8::gemm_phase(F.lds, g, S, E, F.wv);
      sgemm_phase(F, F.Y1() + (size_t)MP * D, F.W1O(), D, D, SOut{F.YO() + (size_t)MP * D, D, 1 << 30, nullptr, 0}, 0); }
    GRID_BAR();
    phase_final_rowwise(F);
}

extern "C" void kernel_launch(void* const* d_in, const int* in_sizes, int n_in, void* d_out, int out_size, void* d_ws, size_t ws_size, hipStream_t stream) {
    static int grid = 0;
    if (grid == 0) {
        if (n_in != 34 || out_size != (int)O_END || ws_size < WS_END) { grid = -1; return; }
        int dev = 0, cus = 0, per_cu = 0;
        if (hipGetDevice(&dev) != hipSuccess || hipDeviceGetAttribute(&cus, hipDeviceAttributeMultiprocessorCount, dev) != hipSuccess) { grid = -1; return; }
        if (hipFuncSetAttribute((const void*)fwd_megakernel, hipFuncAttributeMaxDynamicSharedMemorySize, LDS_BYTES) != hipSuccess) { grid = -1; return; }
        if (hipOccupancyMaxActiveBlocksPerMultiprocessor(&per_cu, (const void*)fwd_megakernel, 512, LDS_BYTES) != hipSuccess || per_cu < 1) { grid = -1; return; }
        grid = cus;
    }
    if (grid < 0) return;
    if (hipMemsetAsync((char*)d_ws + WS_CTL, 0, 65536 + 4224 * 64, stream) != hipSuccess) return;
    Params p{};
    for (int i = 0; i < 34; ++i) p.in[i] = (const float*)d_in[i];
    p.out = (float*)d_out; p.ws = (unsigned char*)d_ws;
    void* args[] = {&p};
    (void)hipLaunchCooperativeKernel((const void*)fwd_megakernel, dim3(grid), dim3(512), args, LDS_BYTES, stream);
}
```

```cpp
#include <hip/hip_runtime.h>
#include <hip/hip_cooperative_groups.h>
namespace cg = cooperative_groups;

#define LAS __attribute__((address_space(3)))
typedef unsigned short bf16_t;
typedef short bf16x8 __attribute__((ext_vector_type(8)));
typedef float f32x4 __attribute__((ext_vector_type(4)));
typedef float f32x2 __attribute__((ext_vector_type(2)));
typedef unsigned u32x4 __attribute__((ext_vector_type(4)));
typedef unsigned u32x2 __attribute__((ext_vector_type(2)));

constexpr int D = 1024, BP = 8, TP = 4096, BS = 16, TS = 16;
constexpr int MP = BP * TP, MS = BS * TS, MT = MP + MS;
constexpr int NSEQ = BP + BS;
constexpr int EV_IN = 2304, OD_IN = 4112, OD_MAIN = 4096;
constexpr int C_XA = 0, C_GA = 512, C_Q = 1024, C_K = 1536, C_V = 1664, C_GB = 1792;
constexpr float EPS = 1e-6f;
constexpr size_t O_Y = 0, O_LCP = 33816576, O_LCS = 33828864, O_LHP = 33853440, O_LHS = 33857536, O_KP = 33865728, O_KS = 33996800,
                 O_VP = 34029568, O_VS = 34160640, O_GCP = 34193408, O_GCS = 34267136, O_GSP = 34414592, O_GSS = 35463168, O_END = 37560320;
constexpr size_t MiB = 1u << 20;
constexpr size_t WS_CTL = 0, WS_W1O = 1 * MiB, WS_MOD = 3 * MiB, WS_ROPE = 4 * MiB, WS_BA = 5 * MiB, WS_LAG = 8 * MiB, WS_LGW = 10 * MiB;
constexpr size_t WS_RA = 16 * MiB, RA_BYTES = (size_t)MT * 4096 * 2;
constexpr size_t WS_RB = WS_RA + RA_BYTES;
constexpr size_t ACT_BYTES = (size_t)MT * D * 2;
constexpr size_t RB_XN = 0, RB_Y0 = ACT_BYTES, RB_YO = 2 * ACT_BYTES, RB_W0I = 3 * ACT_BYTES, RB_W0O = RB_W0I + (size_t)EV_IN * D * 2,
                 RB_W1I = RB_W0O + (size_t)D * D * 2, RB_WEND = RB_W1I + (size_t)OD_MAIN * D * 2;
constexpr size_t RB_BYTES = (size_t)4224 * 73728;
constexpr size_t WS_END = WS_RB + RB_BYTES;
static_assert(RB_WEND <= RB_BYTES, "ws map");
static_assert((size_t)MT * 3072 * 2 <= RB_BYTES, "ws map");
constexpr int LDS_BYTES = 155648;

struct Params { const float* in[34]; float* out; unsigned char* ws; };

__device__ __forceinline__ float bf2f(bf16_t b) { return __uint_as_float(((unsigned)b) << 16); }
__device__ __forceinline__ unsigned f2bf(float f) { unsigned u = __float_as_uint(f); return (u + 0x7fffu + ((u >> 16) & 1u)) >> 16; }
__device__ __forceinline__ unsigned pk2(float lo, float hi) { return f2bf(lo) | (f2bf(hi) << 16); }
typedef __bf16 bf16x2_t __attribute__((ext_vector_type(2)));
__device__ __forceinline__ unsigned cvt2(float a, float b) { f32x2 v = {a, b}; bf16x2_t r = __builtin_convertvector(v, bf16x2_t); return __builtin_bit_cast(unsigned, r); }
__device__ __forceinline__ float lo16(unsigned w) { return __uint_as_float(w << 16); }
__device__ __forceinline__ float hi16(unsigned w) { return __uint_as_float(w & 0xffff0000u); }
__device__ __forceinline__ float shfl_idx(float x, int src_lane) { return __int_as_float(__builtin_amdgcn_ds_bpermute(src_lane << 2, __float_as_int(x))); }
__device__ __forceinline__ float shfl_xor_l(float x, int o, int lane) { return shfl_idx(x, lane ^ o); }
__device__ __forceinline__ float wave_sum(float v, int lane) {
#pragma unroll
    for (int o = 1; o < 64; o <<= 1) v += shfl_xor_l(v, o, lane);
    return v;
}
__device__ __forceinline__ float sigmoidf_(float x) { return __builtin_amdgcn_rcpf(1.0f + __expf(-x)); }
__device__ __forceinline__ float siluf_(float x) { return x * __builtin_amdgcn_rcpf(1.0f + __expf(-x)); }
__device__ __forceinline__ float softplusf_(float x) { return x > 20.f ? x : log1pf(__expf(x)); }
__device__ __forceinline__ int seq_base(int s) { return s < BP ? s * TP : MP + (s - BP) * TS; }
__device__ __forceinline__ int seq_len(int s) { return s < BP ? TP : TS; }
__device__ __forceinline__ void tok_info(int m, int& s, int& t) { if (m < MP) { s = m >> 12; t = m & 4095; } else { const int r = m - MP; s = BP + (r >> 4); t = r & 15; } }

__device__ __forceinline__ int opaque_tid(int wv) { unsigned z = 0u; asm volatile("" : "+v"(z)); const int l = __builtin_amdgcn_mbcnt_hi(~0u, __builtin_amdgcn_mbcnt_lo(~0u, z)); return wv * 64 + l; }
namespace pg8 {
constexpr int BM = 256, BK = 64, HALF = 128, HTB = HALF * BK * 2, STAGE_BYTES = 8 * HTB, NXCD = 8, WGM = 8;
__host__ __device__ __forceinline__ int lds_byte(int r, int c) { const int st = (r >> 4) * 2 + (c >> 5), rr = r & 15, cc = c & 31, ob = rr * 64 + cc * 2; return st * 1024 + (ob ^ (((ob >> 9) & 1) << 5)); }
__host__ __device__ __forceinline__ void stage_rc(int b, int& R, int& C) { const int st = b / 1024, sb = b % 1024, swz = sb ^ (((sb >> 9) & 1) << 5); R = (st >> 1) * 16 + swz / 64; C = (st & 1) * 32 + (swz % 64) / 2; }
__host__ __device__ __forceinline__ int perm32(int rho) { const int n = rho >> 4, i = rho & 15; return 8 * (i >> 2) + 4 * n + (i & 3); }
struct Unit { int pm, pn; };
struct Gemm { const bf16_t* A; const bf16_t* Bt; int M, N, K; };
struct StaticOrder {
    int nM, nN, nwg, G, c;
    __device__ void init(int M, int N, int G_, int c_) { nM = M / BM; nN = N / BM; nwg = nM * nN; G = G_; c = c_; }
    __device__ bool next(int i, Unit& u) const {
        const long L = (long)i * G + c; if (L >= nwg) return false;
        int wgid = (int)L; { const int q = nwg / NXCD, r = nwg % NXCD, xcd = wgid % NXCD, off = wgid / NXCD; wgid = (xcd < r ? xcd * (q + 1) : r * (q + 1) + (xcd - r) * q) + off; }
        const int nig = WGM * nN, gid = wgid / nig, fm = gid * WGM, gsz = (nM - fm) < WGM ? (nM - fm) : WGM;
        u.pm = fm + ((wgid % nig) % gsz); u.pn = (wgid % nig) / gsz; return true;
    }
};
__device__ __forceinline__ unsigned cvt_pk_bf16(float lo, float hi) { unsigned r; asm volatile("v_cvt_pk_bf16_f32 %0, %1, %2" : "=v"(r) : "v"(lo), "v"(hi)); return r; }
struct EpiBf16 {
    static constexpr bool PERM = true;
    bf16_t* O0; int ld0; int split; bf16_t* O1; int ld1;
    __device__ __forceinline__ void operator()(const f32x4 (&acc)[2][2][4][2], const Unit& u, int wr, int wc, int fr, int fq) const {
        const int row0 = u.pm * BM + wr * 64 + fr; int colt = u.pn * BM; bf16_t* base = O0; int ld = ld0;
        if (colt >= split) { base = O1; ld = ld1; colt -= split; }
        const int col0 = colt + wc * 32 + 8 * fq;
#pragma unroll
        for (int ai = 0; ai < 2; ++ai)
#pragma unroll
            for (int m = 0; m < 4; ++m) { bf16_t* rowp = base + (size_t)(row0 + ai * HALF + m * 16) * ld + col0;
#pragma unroll
                for (int bj = 0; bj < 2; ++bj) { const f32x4 v0 = acc[ai][bj][m][0], v1 = acc[ai][bj][m][1];
                    u32x4 w; w.x = cvt_pk_bf16(v0[0], v0[1]); w.y = cvt_pk_bf16(v0[2], v0[3]); w.z = cvt_pk_bf16(v1[0], v1[1]); w.w = cvt_pk_bf16(v1[2], v1[3]);
                    *(u32x4*)(rowp + bj * HALF) = w; } }
    }
};
template <class Epi, class Sched>
__device__ __forceinline__ void gemm_phase(LAS unsigned char* lds, const Gemm g, const Sched& S, const Epi& E, const int wv0) {
    int tid = opaque_tid(wv0);
    const int wid = __builtin_amdgcn_readfirstlane(tid >> 6), lane = tid & 63, wr = wid >> 2, wc = wid & 3, fr = lane & 15, fq = lane >> 4;
    const int K = g.K, nt = K / BK;
    unsigned voffA[2], voffB[2];
#pragma unroll
    for (int i = 0; i < 2; ++i) { int R, C; stage_rc(tid * 16 + i * 8192, R, C); const int Rb = Epi::PERM ? ((R & ~31) + perm32(R & 31)) : R;
        voffA[i] = (unsigned)(R * K + C) * 2u; voffB[i] = (unsigned)(Rb * K + C) * 2u; }
    const size_t kstep = (size_t)(BK * 2);
    const size_t hstep = (size_t)HALF * K * 2;
    const size_t tstep = 2 * hstep;
    const unsigned ldsw = (unsigned)wid * 1024u;
    const int aoff = lds_byte(wr * 64 + fr, fq * 8), boff = lds_byte(wc * 32 + fr, fq * 8);
#define PG8_SA(b, h) (((b) * 2 + (h)) * HTB)
#define PG8_SB(b, h) ((4 + (b) * 2 + (h)) * HTB)
#define PG8_STAGE(bufoff, gbase, voff) do { _Pragma("unroll") for (int _i = 0; _i < 2; ++_i) \
        __builtin_amdgcn_global_load_lds((const unsigned*)((const char*)(gbase) + (voff)[_i]), (LAS unsigned*)(lds + (bufoff) + ldsw + _i * 8192), 16, 0, 0); } while (0)
#define PG8_LDA(dst, b, h) do { _Pragma("unroll") for (int m = 0; m < 4; ++m) _Pragma("unroll") for (int k = 0; k < 2; ++k) dst[m][k] = *(const LAS bf16x8*)(lds + PG8_SA(b, h) + aoff + m * 2048 + k * 1024); } while (0)
#define PG8_LDB(dst, b, h) do { _Pragma("unroll") for (int n = 0; n < 2; ++n) _Pragma("unroll") for (int k = 0; k < 2; ++k) dst[n][k] = *(const LAS bf16x8*)(lds + PG8_SB(b, h) + boff + n * 2048 + k * 1024); } while (0)
#define PG8_MMA(ai, bj, At, Bt) do { __builtin_amdgcn_s_setprio(1); _Pragma("unroll") for (int m = 0; m < 4; ++m) _Pragma("unroll") for (int n = 0; n < 2; ++n) _Pragma("unroll") for (int k = 0; k < 2; ++k) \
        acc[ai][bj][m][n] = __builtin_amdgcn_mfma_f32_16x16x32_bf16(Bt[n][k], At[m][k], acc[ai][bj][m][n], 0, 0, 0); __builtin_amdgcn_s_setprio(0); } while (0)
#define PG8_WAIT_V(n) asm volatile("s_waitcnt vmcnt(" #n ")" ::: "memory")
#define PG8_WAIT_L(n) asm volatile("s_waitcnt lgkmcnt(" #n ")" ::: "memory")
#define PG8_BAR __builtin_amdgcn_s_barrier()
#define PG8_SCHED __builtin_amdgcn_sched_barrier(0)
    Unit cur, nxt; int ui = 0;
    if (!S.next(0, cur)) return;
    f32x4 acc[2][2][4][2];
#pragma unroll
    for (int a = 0; a < 2; ++a)
#pragma unroll
        for (int b = 0; b < 2; ++b)
#pragma unroll
            for (int m = 0; m < 4; ++m)
#pragma unroll
                for (int n = 0; n < 2; ++n) acc[a][b][m][n] = (f32x4){0.f, 0.f, 0.f, 0.f};
    bf16x8 At[4][2], B0[2][2], B1[2][2];
    const char* cA = (const char*)g.A + (size_t)cur.pm * tstep; const char* cB = (const char*)g.Bt + (size_t)cur.pn * tstep;
    PG8_STAGE(PG8_SB(0, 0), cB, voffB); PG8_STAGE(PG8_SA(0, 0), cA, voffA); PG8_STAGE(PG8_SB(0, 1), cB + hstep, voffB); PG8_STAGE(PG8_SA(0, 1), cA + hstep, voffA);
    if (wr == 1) PG8_BAR;
    PG8_WAIT_V(4); PG8_BAR;
    PG8_STAGE(PG8_SB(1, 0), cB + kstep, voffB); PG8_STAGE(PG8_SA(1, 0), cA + kstep, voffA); PG8_STAGE(PG8_SB(1, 1), cB + hstep + kstep, voffB);
    PG8_WAIT_V(6); PG8_BAR;
    for (;;) {
        const bool has_next = S.next(ui + 1, nxt);
        const char* nA = has_next ? (const char*)g.A + (size_t)nxt.pm * tstep : cA; const char* nB = has_next ? (const char*)g.Bt + (size_t)nxt.pn * tstep : cB;
        for (int t = 0; t < nt; t += 2) {
            const bool last = (t == nt - 2);
            const char* a1 = cA + (size_t)(t + 1) * kstep;
            const char* a2 = last ? nA : cA + (size_t)(t + 2) * kstep; const char* b2 = last ? nB : cB + (size_t)(t + 2) * kstep;
            const char* a3 = a2 + kstep; const char* b3 = b2 + kstep;
            PG8_LDB(B0, 0, 0); PG8_SCHED; PG8_LDA(At, 0, 0); PG8_STAGE(PG8_SA(1, 1), a1 + hstep, voffA);
            PG8_WAIT_L(8); PG8_BAR; PG8_WAIT_L(0); PG8_MMA(0, 0, At, B0); PG8_BAR; PG8_SCHED;
            PG8_LDB(B1, 0, 1); PG8_STAGE(PG8_SB(0, 0), b2, voffB);
            PG8_BAR; PG8_WAIT_L(0); PG8_MMA(0, 1, At, B1); PG8_BAR;
            PG8_LDA(At, 0, 1); PG8_STAGE(PG8_SA(0, 0), a2, voffA);
            PG8_BAR; PG8_WAIT_L(0); PG8_MMA(1, 0, At, B0); PG8_BAR; PG8_SCHED;
            PG8_STAGE(PG8_SB(0, 1), b2 + hstep, voffB);
            PG8_WAIT_V(6); PG8_BAR; PG8_MMA(1, 1, At, B1); PG8_BAR;
            PG8_LDB(B0, 1, 0); PG8_SCHED; PG8_LDA(At, 1, 0); PG8_STAGE(PG8_SA(0, 1), a2 + hstep, voffA);
            PG8_WAIT_L(8); PG8_BAR; PG8_WAIT_L(0); PG8_MMA(0, 0, At, B0); PG8_BAR; PG8_SCHED;
            PG8_LDB(B1, 1, 1); PG8_STAGE(PG8_SB(1, 0), b3, voffB);
            PG8_BAR; PG8_WAIT_L(0); PG8_MMA(0, 1, At, B1); PG8_BAR;
            PG8_LDA(At, 1, 1); PG8_STAGE(PG8_SA(1, 0), a3, voffA);
            PG8_BAR; PG8_WAIT_L(0); PG8_MMA(1, 0, At, B0); PG8_BAR; PG8_SCHED;
            PG8_STAGE(PG8_SB(1, 1), b3 + hstep, voffB);
            PG8_WAIT_V(6); PG8_BAR; PG8_MMA(1, 1, At, B1); PG8_BAR;
        }
        E(acc, cur, wr, wc, fr, fq);
        if (!has_next) break;
#pragma unroll
        for (int a = 0; a < 2; ++a)
#pragma unroll
            for (int b = 0; b < 2; ++b)
#pragma unroll
                for (int m = 0; m < 4; ++m)
#pragma unroll
                    for (int n = 0; n < 2; ++n) acc[a][b][m][n] = (f32x4){0.f, 0.f, 0.f, 0.f};
        cur = nxt; cA = nA; cB = nB; ++ui;
    }
    PG8_WAIT_V(0);
    if (wr == 0) PG8_BAR;
    PG8_BAR;
#undef PG8_SA
#undef PG8_SB
#undef PG8_STAGE
#undef PG8_LDA
#undef PG8_LDB
#undef PG8_MMA
#undef PG8_WAIT_V
#undef PG8_WAIT_L
#undef PG8_BAR
#undef PG8_SCHED
}
}


#define XB_TMO      128
#define XB_XCNT(j)  (256  + 64 * (j))
#define XB_XSUB(j)  (1280 + 64 * (j))
#define XB_XGEN(j)  (2304 + 64 * (j))
#define XB_TOP      3328
#define XB_TOPGEN   3392
#define XCD_BAR_WORDS 3456
#define XB_SPIN_CAP (1u << 18)
__device__ __forceinline__ unsigned xb_ld(unsigned* p)              { return __hip_atomic_load(p, __ATOMIC_RELAXED, __HIP_MEMORY_SCOPE_AGENT); }
__device__ __forceinline__ unsigned xb_add(unsigned* p, unsigned v) { return __hip_atomic_fetch_add(p, v, __ATOMIC_RELAXED, __HIP_MEMORY_SCOPE_AGENT); }
__device__ __forceinline__ unsigned xb_xcc_id() { return (unsigned)__builtin_amdgcn_s_getreg((3 << 11) | 20) & 0xFu; }
#define XB_SPIN(cond, bar) do { unsigned _sp = 0; while (cond) { __builtin_amdgcn_s_sleep(1); \
    if ((++_sp & 255u) == 0u) { if (xb_ld(&(bar)[XB_TMO])) break; if (_sp > XB_SPIN_CAP) { atomicAdd(&(bar)[XB_TMO], 1u); break; } } } } while (0)
struct XcdBarrier { unsigned* bar; unsigned x; volatile LAS unsigned* st; };
__device__ __forceinline__ XcdBarrier xcd_barrier_post(unsigned* bar, volatile LAS unsigned* st) {
    XcdBarrier b; b.bar = bar; b.x = xb_xcc_id(); b.st = st;
    if (threadIdx.x == 0) (void)xb_add(&bar[XB_XCNT(b.x)], 1u);
    return b;
}
__device__ __forceinline__ void xcd_barrier_complete(unsigned* bar, unsigned x, unsigned& nloc, unsigned& nx) {
    const unsigned G = gridDim.x * gridDim.y * gridDim.z;
    unsigned sum, cnt, mine, sp = 0u;
    for (;;) {
        sum = 0u; cnt = 0u; mine = 0u;
#pragma unroll
        for (unsigned j = 0; j < 16; ++j) { const unsigned c = xb_ld(&bar[XB_XCNT(j)]); sum += c; cnt += (c > 0u) ? 1u : 0u; mine = (j == x) ? c : mine; }
        if (sum == G) break;
        __builtin_amdgcn_s_sleep(1);
        if ((++sp & 255u) == 0u) { if (xb_ld(&bar[XB_TMO])) break; if (sp > XB_SPIN_CAP) { atomicAdd(&bar[XB_TMO], 1u); break; } }
    }
    nloc = mine > 0u ? mine : 1u; nx = cnt > 0u ? cnt : 1u;
}
__device__ __forceinline__ void xcd_barrier(const XcdBarrier& b, const int wv0) {
    asm volatile("s_waitcnt vmcnt(0)" ::: "memory");
    __syncthreads();
    if (opaque_tid(wv0) == 0) {
        unsigned* bar = b.bar;
        __builtin_amdgcn_s_waitcnt(0);
        unsigned nloc = b.st[0], nx = b.st[1];
        if (nloc == 0u) { xcd_barrier_complete(bar, b.x, nloc, nx); b.st[0] = nloc; b.st[1] = nx; }
        const unsigned old = xb_add(&bar[XB_XSUB(b.x)], 1u);
        const unsigned gen = old / nloc;
        if (old + 1u == (gen + 1u) * nloc) {
            __builtin_amdgcn_fence(__ATOMIC_RELEASE, "agent");
            asm volatile("s_waitcnt vmcnt(0)" ::: "memory");
            const unsigned og = xb_add(&bar[XB_TOP], 1u);
            const unsigned tg = og / nx;
            if (og + 1u == (tg + 1u) * nx) xb_add(&bar[XB_TOPGEN], 1u);
            else XB_SPIN(xb_ld(&bar[XB_TOPGEN]) == tg, bar);
            __builtin_amdgcn_fence(__ATOMIC_ACQUIRE, "agent");
            xb_add(&bar[XB_XGEN(b.x)], 1u);
            asm volatile("s_waitcnt vmcnt(0)" ::: "memory");
        } else {
            XB_SPIN(xb_ld(&bar[XB_XGEN(b.x)]) == gen, bar);
            __builtin_amdgcn_fence(__ATOMIC_ACQUIRE, "agent");
            asm volatile("s_waitcnt vmcnt(0)" ::: "memory");
        }
    }
    __syncthreads();
}

struct Frame {
    LAS unsigned char* lds;
    int vcu, G, wv;
    const float* const* in; float* out; unsigned char* ws;
    __device__ __forceinline__ float* MOD() const { return (float*)(ws + WS_MOD); }
    __device__ __forceinline__ float* ROPE() const { return (float*)(ws + WS_ROPE); }
    __device__ __forceinline__ float* BA() const { return (float*)(ws + WS_BA); }
    __device__ __forceinline__ float* LAG() const { return (float*)(ws + WS_LAG); }
    __device__ __forceinline__ bf16_t* W1O() const { return (bf16_t*)(ws + WS_W1O); }
    __device__ __forceinline__ bf16_t* U0() const { return (bf16_t*)(ws + WS_RA); }
    __device__ __forceinline__ bf16_t* QKV1() const { return (bf16_t*)(ws + WS_RA); }
    __device__ __forceinline__ bf16_t* Z1() const { return (bf16_t*)(ws + WS_RA + (size_t)MT * 3072 * 2); }
    __device__ __forceinline__ bf16_t* Y1() const { return (bf16_t*)(ws + WS_RA + (size_t)MT * 3072 * 2); }
    __device__ __forceinline__ bf16_t* XN() const { return (bf16_t*)(ws + WS_RB + RB_XN); }
    __device__ __forceinline__ bf16_t* Y0() const { return (bf16_t*)(ws + WS_RB + RB_Y0); }
    __device__ __forceinline__ bf16_t* YO() const { return (bf16_t*)(ws + WS_RB + RB_YO); }
    __device__ __forceinline__ bf16_t* W0I() const { return (bf16_t*)(ws + WS_RB + RB_W0I); }
    __device__ __forceinline__ bf16_t* W0O() const { return (bf16_t*)(ws + WS_RB + RB_W0O); }
    __device__ __forceinline__ bf16_t* W1I() const { return (bf16_t*)(ws + WS_RB + RB_W1I); }
    __device__ __forceinline__ bf16_t* QKVC() const { return (bf16_t*)(ws + WS_RB); }
};

#define PHASE_IDS() int tid = opaque_tid(F.wv); const int lane = tid & 63, wave = __builtin_amdgcn_readfirstlane(tid >> 6); (void)lane; (void)wave
__device__ __forceinline__ void p0_transpose_item(const float* W, int ldw, int nblk, int K, bf16_t* WT, LAS float* scr, int item, int lane) {
    const int kb = item / nblk, nb = item % nblk, k0 = 64 * kb, n0 = 32 * nb;
    f32x4 v[8];
#pragma unroll
    for (int i = 0; i < 8; ++i) v[i] = *(const f32x4*)(W + (size_t)(k0 + 8 * i + (lane >> 3)) * ldw + n0 + 4 * (lane & 7));
#pragma unroll
    for (int i = 0; i < 8; ++i) { LAS float* d = scr + (8 * i + (lane >> 3)) * 33 + 4 * (lane & 7); d[0] = v[i][0]; d[1] = v[i][1]; d[2] = v[i][2]; d[3] = v[i][3]; }
    asm volatile("s_waitcnt lgkmcnt(0)" ::: "memory");
    const int c = lane & 7;
#pragma unroll
    for (int j = 0; j < 4; ++j) { const int n = (lane >> 3) + 8 * j; const LAS float* s = scr + (8 * c) * 33 + n;
        u32x4 o; o.x = pk2(s[0 * 33], s[1 * 33]); o.y = pk2(s[2 * 33], s[3 * 33]); o.z = pk2(s[4 * 33], s[5 * 33]); o.w = pk2(s[6 * 33], s[7 * 33]);
        *(u32x4*)(WT + (size_t)(n0 + n) * K + k0 + 8 * c) = o; }
    asm volatile("s_waitcnt lgkmcnt(0)" ::: "memory");
}
constexpr size_t WS_MODP = 12 * MiB;
__device__ __forceinline__ f32x4 mod4(const float* MODP, int L, int s, int off) {
    f32x4 a = *(const f32x4*)(MODP + ((size_t)((L * 4 + 0) * 24 + s)) * 3072 + off);
#pragma unroll
    for (int sl = 1; sl < 4; ++sl) a += *(const f32x4*)(MODP + ((size_t)((L * 4 + sl) * 24 + s)) * 3072 + off);
    return a;
}
__device__ __forceinline__ void mod_task(Frame& F, const int bt, const int tid, const int lane, const int wave) {
    const int L = bt / 192, sl = (bt % 192) / 48, n0 = (bt % 48) * 64, kb = sl * 256;
    LAS float* tab = (LAS float*)F.lds;
    {   float cv[12];
#pragma unroll
        for (int u = 0; u < 12; ++u) { const int idx = tid + 512 * u, s = idx >> 8, k = kb + (idx & 255); cv[u] = s < BP ? F.in[8][s * D + k] : F.in[9][(s - BP) * D + k]; }
#pragma unroll
        for (int u = 0; u < 12; ++u) { const int idx = tid + 512 * u, s = idx >> 8, k = idx & 255; tab[k * 24 + s] = siluf_(cv[u]); } }
    __syncthreads();
    const float* mw = (L == 0 ? F.in[10] : F.in[24]) + n0 + lane;
    float acc[24];
#pragma unroll
    for (int r = 0; r < 24; ++r) acc[r] = 0.f;
    for (int k0 = wave * 32; k0 < wave * 32 + 32; k0 += 16) {
        float wv[16];
#pragma unroll
        for (int u = 0; u < 16; ++u) wv[u] = mw[(size_t)(kb + k0 + u) * 3072];
#pragma unroll
        for (int u = 0; u < 16; ++u) { const float w = wv[u];
            const LAS f32x4* tp = (const LAS f32x4*)(tab + (k0 + u) * 24);
#pragma unroll
            for (int q = 0; q < 6; ++q) { const f32x4 t4 = tp[q]; acc[4 * q] += t4[0] * w; acc[4 * q + 1] += t4[1] * w; acc[4 * q + 2] += t4[2] * w; acc[4 * q + 3] += t4[3] * w; } }
    }
    __syncthreads();
    LAS float* red = (LAS float*)F.lds;
#pragma unroll
    for (int r = 0; r < 24; ++r) red[(wave * 24 + r) * 64 + lane] = acc[r];
    __syncthreads();
    const float* mb = (L == 0 ? F.in[11] : F.in[25]);
    float* MODP = (float*)(F.ws + WS_MODP);
    for (int idx = tid; idx < 24 * 64; idx += 512) { const int r = idx >> 6, l = idx & 63; float s = 0.f;
#pragma unroll
        for (int w = 0; w < 8; ++w) s += red[(w * 24 + r) * 64 + l];
        MODP[((size_t)((L * 4 + sl) * 24 + r)) * 3072 + n0 + l] = s + (sl == 0 ? mb[n0 + l] : 0.f); }
    __syncthreads();
}
__device__ __forceinline__ void phase_mod0(Frame& F) {
    PHASE_IDS();
    for (int bt = F.vcu; bt < 192; bt += F.G) { int t2 = tid; asm volatile("" : "+v"(t2)); mod_task(F, bt, t2, t2 & 63, wave); }
}
__device__ __forceinline__ void phase_mod1(Frame& F) {
    PHASE_IDS();
    __syncthreads();
    for (int bt = 192 + F.vcu; bt < 384; bt += F.G) { int t2 = tid; asm volatile("" : "+v"(t2)); mod_task(F, bt, t2, t2 & 63, wave); }
}
__device__ __forceinline__ void phase_prologue(Frame& F) {
    PHASE_IDS();
    const int gw = F.vcu * 8 + wave, NGW = F.G * 8;
    {
        LAS float* scr = (LAS float*)(F.lds + wave * 16384);
        constexpr int I0 = 16 * (EV_IN / 32), I1 = 16 * 32, I2 = 16 * (OD_MAIN / 32), I3 = 16 * 32;
        for (int it = gw; it < I0 + I1 + I2 + I3; it += NGW) {
            int r = it;
            if (r < I0) { p0_transpose_item(F.in[14], EV_IN, EV_IN / 32, D, F.W0I(), scr, r, lane); continue; } r -= I0;
            if (r < I1) { p0_transpose_item(F.in[23], D, 32, D, F.W0O(), scr, r, lane); continue; } r -= I1;
            if (r < I2) { p0_transpose_item(F.in[28], OD_IN, OD_MAIN / 32, D, F.W1I(), scr, r, lane); continue; } r -= I2;
            p0_transpose_item(F.in[33], D, 32, D, F.W1O(), scr, r, lane);
        }
    }
    {
        const double inv[8] = {1.0, 0.19392274474868576, 0.03760603093086393, 0.007292664737217109, 0.001414213562373095, 0.0002742481756762073, 5.318295896944988e-05, 1.031338537721246e-05};
        for (int idx = F.vcu * 512 + tid; idx < 4112 * 8; idx += F.G * 512) {
            const int pos = idx >> 3, i = idx & 7;
            double iv = inv[0];
#pragma unroll
            for (int q = 1; q < 8; ++q) iv = (i == q) ? inv[q] : iv;
            const double ang = (double)pos * iv;
            const double n = __builtin_rint(ang * 0.15915494309189535);
            const float r = (float)__builtin_fma(-n, 6.283185307179586, ang);
            F.ROPE()[pos * 16 + i] = __cosf(r); F.ROPE()[pos * 16 + 8 + i] = __sinf(r);
        }
    }
    {
        bf16_t* LGW = (bf16_t*)(F.ws + WS_LGW);
        for (int idx = F.vcu * 512 + tid; idx < 8 * 2 * 64 * 64; idx += F.G * 512) { const int k = idx & 63, n = (idx >> 6) & 63, gate = (idx >> 12) & 1, hh = idx >> 13;
            LGW[idx] = (bf16_t)f2bf((gate ? F.in[19] : F.in[17])[(hh * 64 + k) * 64 + n]); }
    }
}

__device__ __forceinline__ const float* x_row(Frame& F, int m) { return m < MP ? F.in[0] + (size_t)m * D : F.in[1] + (size_t)(m - MP) * D; }
__device__ __forceinline__ void rows_prenorm0(Frame& F, const int m0, const int n, const int s, const int lane) {
    const float* MODP = (const float*)(F.ws + WS_MODP);
    f32x4 A[4], C[4];
#pragma unroll
    for (int j = 0; j < 4; ++j) { const int c = 4 * lane + 256 * j; const f32x4 g = *(const f32x4*)(F.in[12] + c), sc = mod4(MODP, 0, s, 1024 + c); C[j] = mod4(MODP, 0, s, c);
#pragma unroll
        for (int e = 0; e < 4; ++e) A[j][e] = g[e] * (1.f + sc[e]); }
    f32x4 cur[4];
#pragma unroll
    for (int j = 0; j < 4; ++j) cur[j] = *(const f32x4*)(x_row(F, m0) + 4 * lane + 256 * j);
    for (int i = 0; i < n; ++i) {
        const int mn = m0 + (i + 1 < n ? i + 1 : i); f32x4 nxt[4];
#pragma unroll
        for (int j = 0; j < 4; ++j) nxt[j] = *(const f32x4*)(x_row(F, mn) + 4 * lane + 256 * j);
        float ss = 0.f;
#pragma unroll
        for (int j = 0; j < 4; ++j) ss += (cur[j][0] * cur[j][0] + cur[j][1] * cur[j][1]) + (cur[j][2] * cur[j][2] + cur[j][3] * cur[j][3]);
        const float r = rsqrtf(wave_sum(ss, lane) * (1.f / D) + EPS);
#pragma unroll
        for (int j = 0; j < 4; ++j) { u32x2 w; w[0] = cvt2(cur[j][0] * r * A[j][0] + C[j][0], cur[j][1] * r * A[j][1] + C[j][1]); w[1] = cvt2(cur[j][2] * r * A[j][2] + C[j][2], cur[j][3] * r * A[j][3] + C[j][3]);
            *(u32x2*)(F.XN() + (size_t)(m0 + i) * D + 4 * lane + 256 * j) = w; }
#pragma unroll
        for (int j = 0; j < 4; ++j) cur[j] = nxt[j];
    }
}
__device__ __forceinline__ void phase_prenorm0(Frame& F) {
    PHASE_IDS();
    const int gw = F.vcu * 8 + wave, NGW = F.G * 8;
    for (int w = gw; w < MP / 16; w += NGW) rows_prenorm0(F, w * 16, 16, w >> 8, lane);
    for (int w = gw; w < MS; w += NGW) rows_prenorm0(F, MP + w, 1, BP + (w >> 4), lane);
}

__device__ __forceinline__ void phase_rope(Frame& F) {
    PHASE_IDS();
    const int gt = F.vcu * 512 + tid, NT = F.G * 512;
    for (int idx = gt; idx < MT * 10; idx += NT) {
        const int m = idx / 10, slot = idx % 10;
        int s, t; tok_info(m, s, t);
        const int pos = s < BP ? t : TP + t;
        const int col = slot < 8 ? C_Q + slot * 64 : C_K + (slot - 8) * 64;
        u32x4* p = (u32x4*)(F.U0() + (size_t)m * EV_IN + col);
        const u32x4 xa = p[0], xb = p[1];
        const f32x4* rp = (const f32x4*)(F.ROPE() + pos * 16); const f32x4 c0 = rp[0], c1 = rp[1], s0 = rp[2], s1 = rp[3];
        float x1[8], x2[8], o1[8], o2[8];
#pragma unroll
        for (int e = 0; e < 4; ++e) { x1[2 * e] = lo16(xa[e]); x1[2 * e + 1] = hi16(xa[e]); x2[2 * e] = lo16(xb[e]); x2[2 * e + 1] = hi16(xb[e]); }
#pragma unroll
        for (int i = 0; i < 8; ++i) { const float c = i < 4 ? c0[i & 3] : c1[i & 3], sn = i < 4 ? s0[i & 3] : s1[i & 3]; o1[i] = x1[i] * c - x2[i] * sn; o2[i] = x2[i] * c + x1[i] * sn; }
        u32x4 ya, yb;
#pragma unroll
        for (int e = 0; e < 4; ++e) { ya[e] = cvt2(o1[2 * e], o1[2 * e + 1]); yb[e] = cvt2(o2[2 * e], o2[2 * e + 1]); }
        p[0] = ya; p[1] = yb;
        if (slot >= 8) { const int kv = slot - 8; float* o = nullptr;
            if (s >= BP) o = F.out + O_KS + ((size_t)((s - BP) * TS + t) * 2 + kv) * 64;
            else if (t >= TP - 128) o = F.out + O_KP + ((size_t)(s * 128 + (t - (TP - 128))) * 2 + kv) * 64;
            if (o) { *(f32x4*)o = (f32x4){o1[0], o1[1], o1[2], o1[3]}; *(f32x4*)(o + 4) = (f32x4){o1[4], o1[5], o1[6], o1[7]}; *(f32x4*)(o + 8) = (f32x4){o2[0], o2[1], o2[2], o2[3]}; *(f32x4*)(o + 12) = (f32x4){o2[4], o2[5], o2[6], o2[7]}; } }
    }
    for (int idx = gt; idx < 1280 * 224; idx += NT) {
        const int tk = idx / 224, e = idx % 224;
        int s, t, m; if (tk < 1024) { s = tk >> 7; t = TP - 128 + (tk & 127); m = s * TP + t; } else { s = BP + ((tk - 1024) >> 4); t = (tk - 1024) & 15; m = MP + (tk - 1024); }
        const bool isv = e >= 96; const int e2 = isv ? e - 96 : e; const int kv = isv ? (e2 >> 6) : (e2 / 48), d = isv ? (e2 & 63) : 16 + (e2 % 48);
        const float val = bf2f(F.U0()[(size_t)m * EV_IN + (isv ? C_V : C_K) + kv * 64 + d]);
        const size_t ob = s >= BP ? (isv ? O_VS : O_KS) + ((size_t)((s - BP) * TS + t) * 2 + kv) * 64 : (isv ? O_VP : O_KP) + ((size_t)(s * 128 + (t - (TP - 128))) * 2 + kv) * 64;
        F.out[ob + d] = val;
    }
}


__device__ __forceinline__ void rows_mid(Frame& F, LAS float* baw, const int m0, const int n, const int s, const int lane) {
    const float* MODP = (const float*)(F.ws + WS_MODP);
    f32x4 A0[4], B1[4], C1[4];
#pragma unroll
    for (int j = 0; j < 4; ++j) { const int c = 4 * lane + 256 * j; const f32x4 g0 = *(const f32x4*)(F.in[13] + c), gt = mod4(MODP, 0, s, 2048 + c), g1 = *(const f32x4*)(F.in[26] + c), sc = mod4(MODP, 1, s, 1024 + c);
        C1[j] = mod4(MODP, 1, s, c);
#pragma unroll
        for (int e = 0; e < 4; ++e) { A0[j][e] = gt[e] * g0[e]; B1[j][e] = g1[e] * (1.f + sc[e]); } }
    u32x2 ycur[4]; f32x4 xcur[4];
#pragma unroll
    for (int j = 0; j < 4; ++j) { ycur[j] = *(const u32x2*)(F.YO() + (size_t)m0 * D + 4 * lane + 256 * j); xcur[j] = *(const f32x4*)(x_row(F, m0) + 4 * lane + 256 * j); }
    for (int i = 0; i < n; ++i) {
        const int m = m0 + i, mn = m0 + (i + 1 < n ? i + 1 : i); u32x2 ynxt[4]; f32x4 xnxt[4];
#pragma unroll
        for (int j = 0; j < 4; ++j) { ynxt[j] = *(const u32x2*)(F.YO() + (size_t)mn * D + 4 * lane + 256 * j); xnxt[j] = *(const f32x4*)(x_row(F, mn) + 4 * lane + 256 * j); }
        f32x4 y[4]; float ss = 0.f;
#pragma unroll
        for (int j = 0; j < 4; ++j) { y[j] = (f32x4){lo16(ycur[j][0]), hi16(ycur[j][0]), lo16(ycur[j][1]), hi16(ycur[j][1])}; ss += (y[j][0] * y[j][0] + y[j][1] * y[j][1]) + (y[j][2] * y[j][2] + y[j][3] * y[j][3]); }
        const float r1 = rsqrtf(wave_sum(ss, lane) * (1.f / D) + EPS);
        f32x4 x1[4]; float s2 = 0.f;
#pragma unroll
        for (int j = 0; j < 4; ++j) {
#pragma unroll
            for (int e = 0; e < 4; ++e) x1[j][e] = xcur[j][e] + A0[j][e] * (y[j][e] * r1);
            *(f32x4*)(F.out + O_Y + (size_t)m * D + 4 * lane + 256 * j) = x1[j];
            s2 += (x1[j][0] * x1[j][0] + x1[j][1] * x1[j][1]) + (x1[j][2] * x1[j][2] + x1[j][3] * x1[j][3]); }
        const float r2 = rsqrtf(wave_sum(s2, lane) * (1.f / D) + EPS);
        f32x4 hm[4];
#pragma unroll
        for (int j = 0; j < 4; ++j) {
#pragma unroll
            for (int e = 0; e < 4; ++e) hm[j][e] = x1[j][e] * r2 * B1[j][e] + C1[j][e];
            u32x2 w; w[0] = cvt2(hm[j][0], hm[j][1]); w[1] = cvt2(hm[j][2], hm[j][3]); *(u32x2*)(F.XN() + (size_t)m * D + 4 * lane + 256 * j) = w; }
        __builtin_amdgcn_sched_barrier(0);
        float p[16];
#pragma unroll
        for (int q = 0; q < 16; ++q) { p[q] = 0.f;
#pragma unroll
            for (int j = 0; j < 4; ++j) { const f32x4 w = *(const LAS f32x4*)(baw + q * 1024 + 256 * j + 4 * lane); p[q] += (hm[j][0] * w[0] + hm[j][1] * w[1]) + (hm[j][2] * w[2] + hm[j][3] * w[3]); }
            if ((q & 3) == 3) __builtin_amdgcn_sched_barrier(0); }
        { const bool u5 = (lane & 32) != 0;
#pragma unroll
          for (int q = 0; q < 8; ++q) { const float keep = u5 ? p[8 + q] : p[q], send = u5 ? p[q] : p[8 + q]; p[q] = keep + shfl_xor_l(send, 32, lane); } }
        { const bool u4 = (lane & 16) != 0;
#pragma unroll
          for (int q = 0; q < 4; ++q) { const float keep = u4 ? p[4 + q] : p[q], send = u4 ? p[q] : p[4 + q]; p[q] = keep + shfl_xor_l(send, 16, lane); } }
        { const bool u3 = (lane & 8) != 0;
#pragma unroll
          for (int q = 0; q < 2; ++q) { const float keep = u3 ? p[2 + q] : p[q], send = u3 ? p[q] : p[2 + q]; p[q] = keep + shfl_xor_l(send, 8, lane); } }
        { const bool u2 = (lane & 4) != 0; const float keep = u2 ? p[1] : p[0], send = u2 ? p[0] : p[1]; p[0] = keep + shfl_xor_l(send, 4, lane); }
        float mine = p[0]; mine += shfl_xor_l(mine, 2, lane); mine += shfl_xor_l(mine, 1, lane);
        if ((lane & 3) == 0) { const int col = lane >> 2, hh = col & 7;
            F.BA()[(size_t)m * 16 + col] = col < 8 ? sigmoidf_(mine) : -__expf(F.in[30][hh]) * softplusf_(mine + F.in[31][hh]); }
#pragma unroll
        for (int j = 0; j < 4; ++j) { ycur[j] = ynxt[j]; xcur[j] = xnxt[j]; }
    }
}
__device__ __forceinline__ void phase_mid_rowwise(Frame& F) {
    PHASE_IDS();
    LAS float* baw = (LAS float*)F.lds;
    for (int idx = tid; idx < 16 * 1024; idx += 512) { const int j = idx & 15, k = idx >> 4; baw[j * 1024 + k] = F.in[28][(size_t)k * OD_IN + OD_MAIN + j]; }
    __syncthreads();
    const int gw = F.vcu * 8 + wave, NGW = F.G * 8;
    for (int w = gw; w < MP / 16; w += NGW) rows_mid(F, baw, w * 16, 16, w >> 8, lane);
    for (int w = gw; w < MS; w += NGW) rows_mid(F, baw, MP + w, 1, BP + (w >> 4), lane);
}


typedef float f32x16 __attribute__((ext_vector_type(16)));
constexpr int GS_WF = 0, GS_QF = 16384, GS_KF = 32768, GS_PF = 49152, GS_UF = 57344, GS_BYTES = 73728;
constexpr size_t WS_DEC = 11 * MiB;
__device__ __forceinline__ int krow(int s, int h, int j) { return 16 * s + 8 * (j >> 2) + 4 * h + (j & 3); }
#define MFMA32(a, b, c) __builtin_amdgcn_mfma_f32_32x32x16_bf16((a), (b), (c), 0, 0, 0)
#define MFMA16(a, b, c) __builtin_amdgcn_mfma_f32_16x16x32_bf16((a), (b), (c), 0, 0, 0)

typedef __amdgpu_buffer_rsrc_t brsrc_t;
__device__ __forceinline__ brsrc_t staging_rsrc(unsigned char* ws) { return __builtin_amdgcn_make_buffer_rsrc((void*)(ws + WS_RB), (short)0, (int)RB_BYTES, 0x00020000); }
__device__ __forceinline__ void st16_wt(brsrc_t r, unsigned off, u32x4 v) { __builtin_amdgcn_raw_buffer_store_b128(v, r, off, 0, 16); }
__device__ __forceinline__ u32x4 ld16_wt(brsrc_t r, unsigned off) { return __builtin_amdgcn_raw_buffer_load_b128(r, off, 0, 16); }
__device__ __forceinline__ void st8_wt(unsigned char* p, u32x2 v) { __hip_atomic_store((unsigned long long*)p, ((unsigned long long)v[1] << 32) | v[0], __ATOMIC_RELAXED, __HIP_MEMORY_SCOPE_AGENT); }
constexpr size_t WS_READY = 65536;
#define LDS_BARRIER() do { asm volatile("s_waitcnt lgkmcnt(0)" ::: "memory"); __builtin_amdgcn_s_barrier(); asm volatile("" ::: "memory"); } while (0)
constexpr int G1_QS = 0, G1_KS = 17408, G1_VS = 34816, G1_AS = 52224, G1_PS = 69632, G1_WS = 78848, G1_CW = 96256, G1_VEC = 102400, G1_ES = 103424;
__device__ __forceinline__ void g1_load_raw(Frame& F, u32x4 (&raw)[24], int s, int c, int h, int t1) {
    const int r = t1 >> 3, j = t1 & 7, t = c * 64 + r;
#pragma unroll
    for (int p = 0; p < 3; ++p)
#pragma unroll
        for (int jj = 0; jj < 4; ++jj) { const int tt = t - 3 + jj, ttc = tt < 0 ? 0 : tt;
            const u32x4* src = (const u32x4*)(F.QKV1() + (size_t)(s * TP + ttc) * 3072 + p * 1024 + h * 128 + j * 16); raw[p * 8 + jj * 2] = src[0]; raw[p * 8 + jj * 2 + 1] = src[1]; }
}
__device__ __forceinline__ bf16x8 g1_pack_b(const f32x4 p, const f32x4 q) { u32x4 w; w[0] = cvt2(p[0], p[1]); w[1] = cvt2(p[2], p[3]); w[2] = cvt2(q[0], q[1]); w[3] = cvt2(q[2], q[3]); return __builtin_bit_cast(bf16x8, w); }
__device__ __forceinline__ void g1_decode(int n, int& s, int& c, int& h) { if (n < 4096) { c = n >> 6; s = (n & 63) >> 3; h = n & 7; } else { s = BP + ((n - 4096) >> 3); c = 0; h = n & 7; } }
constexpr int P2_SET = 52224, P2_Q = 0, P2_K = 17408, P2_V = 34816;
constexpr int P2_AS = 2 * P2_SET, P2_PS = P2_AS + 17408, P2_ES = P2_PS + 9216, P2_CW = P2_ES + 4096, P2_VEC = P2_CW + 6144;
static_assert(P2_VEC + 2048 <= LDS_BYTES - 64, "producer LDS map");
__device__ __forceinline__ void p2_load_part(Frame& F, u32x4 (&rw)[16], int s, int c, int h, int p, int tb) {
    const int r = tb >> 3, j = tb & 7;
#pragma unroll
    for (int it = 0; it < 2; ++it)
#pragma unroll
        for (int jj = 0; jj < 4; ++jj) { int tt = c * 64 + r + 32 * it - 3 + jj; tt = tt < 0 ? 0 : tt;
            const u32x4* src = (const u32x4*)(F.QKV1() + (size_t)(s * TP + tt) * 3072 + p * 1024 + h * 128 + j * 16); rw[it * 8 + jj * 2] = src[0]; rw[it * 8 + jj * 2 + 1] = src[1]; }
}
__device__ __forceinline__ void p2_conv_item(Frame& F, const u32x4 (&rw)[16], const int it, const f32x4 (&wreg)[16], const int p, const int j, const int lane, const bool ok, float* state_out, LAS u32x4* dst) {
    float acc[16];
#pragma unroll
    for (int e = 0; e < 16; ++e) acc[e] = 0.f;
#pragma unroll
    for (int jj = 0; jj < 4; ++jj) {
        const u32x4 a = rw[it * 8 + jj * 2], b = rw[it * 8 + jj * 2 + 1]; float x[16];
#pragma unroll
        for (int e = 0; e < 4; ++e) { x[2 * e] = lo16(a[e]); x[2 * e + 1] = hi16(a[e]); x[8 + 2 * e] = lo16(b[e]); x[8 + 2 * e + 1] = hi16(b[e]); }
#pragma unroll
        for (int q = 0; q < 4; ++q) { const f32x4 w4 = wreg[jj * 4 + q]; acc[4 * q] += w4[0] * x[4 * q]; acc[4 * q + 1] += w4[1] * x[4 * q + 1]; acc[4 * q + 2] += w4[2] * x[4 * q + 2]; acc[4 * q + 3] += w4[3] * x[4 * q + 3]; }
        if (jj == 3 && state_out) {
#pragma unroll
            for (int q = 0; q < 4; ++q) *(f32x4*)(state_out + 4 * q) = (f32x4){x[4 * q], x[4 * q + 1], x[4 * q + 2], x[4 * q + 3]}; }
    }
    float ss = 0.f;
#pragma unroll
    for (int e = 0; e < 16; ++e) { acc[e] = siluf_(acc[e]); ss += acc[e] * acc[e]; }
    if (p < 2) { ss += shfl_xor_l(ss, 1, lane); ss += shfl_xor_l(ss, 2, lane); ss += shfl_xor_l(ss, 4, lane);
        float sc = __builtin_amdgcn_rsqf(ss + EPS); if (p == 0) sc *= 0.08838834764831845f;
#pragma unroll
        for (int e = 0; e < 16; ++e) acc[e] *= sc; }
    u32x4 w0, w1;
#pragma unroll
    for (int e = 0; e < 4; ++e) { w0[e] = ok ? cvt2(acc[2 * e], acc[2 * e + 1]) : 0u; w1[e] = ok ? cvt2(acc[8 + 2 * e], acc[8 + 2 * e + 1]) : 0u; }
    dst[0] = w0; dst[1] = w1;
}
__device__ __forceinline__ void gdn_g1_tasks(Frame& F, const int first, const int stride) {
    LAS unsigned char* L = F.lds;
    LAS float* cw_s = (LAS float*)(L + P2_CW);
    float* DEC = (float*)(F.ws + WS_DEC);
    const brsrc_t srs = staging_rsrc(F.ws);
    unsigned* ready = (unsigned*)(F.ws + WS_READY);
    const int wave = F.wv;
    const bool grpB = wave >= 4;
    int ntask = 0; for (int t = first; t < 4224; t += stride) ++ntask;
    u32x4 rwA[16]; float pcw[6];
    if (grpB) {
        const int tb = opaque_tid(wave) - 256; int s0, c0, h0; g1_decode(first < 4095 ? first : 4095, s0, c0, h0);
        p2_load_part(F, rwA, s0, c0, h0, 0, tb);
#pragma unroll
        for (int q = 0; q < 6; ++q) { const int i = tb + 256 * q, jj = i / 384, cc = i % 384; pcw[q] = F.in[29][(size_t)jj * 3072 + (cc >> 7) * 1024 + h0 * 128 + (cc & 127)]; }
#pragma unroll
        for (int q = 0; q < 6; ++q) cw_s[tb + 256 * q] = pcw[q];
    }
    LDS_BARRIER();
    for (int i = 0; i <= ntask; ++i) {
        const int tid = opaque_tid(wave), lane = tid & 63;
        const int taskB = first + i * stride, taskA = taskB - stride;
        const bool actB = grpB && i < ntask, actA = !grpB && i >= 1;
        int s = 0, c = 0, h = 0; g1_decode(grpB ? (i < ntask ? taskB : 4095) : (i >= 1 ? taskA : 0), s, c, h);
        const int task = grpB ? taskB : taskA;
        const int sidx = task < 4096 ? ((s * 8 + h) * 64 + c) : task;
        const int nvalid = s < BP ? 64 : TS, t0 = c * 64, base = seq_base(s), T = seq_len(s);
        LAS unsigned char* Sb = L + (grpB ? (i & 1) : ((i - 1) & 1)) * P2_SET;
        LAS float* vec = (LAS float*)(L + P2_VEC + (grpB ? (i & 1) : ((i - 1) & 1)) * 1024); LAS float* beta_s = vec; LAS float* gcum_s = vec + 64; LAS float* eg_s = vec + 128; LAS float* ek_s = vec + 192;
        unsigned char* blk = F.ws + WS_RB + (size_t)sidx * GS_BYTES; const unsigned boff = (unsigned)sidx * (unsigned)GS_BYTES;
        float gvb = 0.f, gva = 0.f; int gs = 0, gc = 0, gh = 0; const bool gact = (wave == 3) && i < ntask;
        if (gact) { g1_decode(taskB, gs, gc, gh); if (lane < (gs < BP ? 64 : TS)) { const float* ba = F.BA() + (size_t)(seq_base(gs) + gc * 64 + lane) * 16; gvb = ba[gh]; gva = ba[8 + gh]; } }
        const int tb = tid - 256, rB = tb >> 3, jB = tb & 7;
#define P2_PART(p, rw) do { if (actB) { \
            if (s >= BP) { _Pragma("unroll") for (int it = 0; it < 2; ++it) _Pragma("unroll") for (int jj = 0; jj < 4; ++jj) { const int r_ = rB + 32 * it, tt = r_ - 3 + jj; u32x4 a_ = {0u, 0u, 0u, 0u}, b_ = {0u, 0u, 0u, 0u}; \
                    if (r_ < nvalid) { const int cb_ = (p) * 1024 + h * 128 + jB * 16; \
                        if (tt >= 0) { const u32x4* src = (const u32x4*)(F.QKV1() + (size_t)(base + tt) * 3072 + cb_); a_ = src[0]; b_ = src[1]; } \
                        else { const f32x4* src = (const f32x4*)(F.in[6] + ((size_t)(s - BP) * 3 + (tt + 3)) * 3072 + cb_); const f32x4 f0 = src[0], f1 = src[1], f2 = src[2], f3 = src[3]; \
                            a_[0] = cvt2(f0[0], f0[1]); a_[1] = cvt2(f0[2], f0[3]); a_[2] = cvt2(f1[0], f1[1]); a_[3] = cvt2(f1[2], f1[3]); b_[0] = cvt2(f2[0], f2[1]); b_[1] = cvt2(f2[2], f2[3]); b_[2] = cvt2(f3[0], f3[1]); b_[3] = cvt2(f3[2], f3[3]); } } \
                    rw[it * 8 + jj * 2] = a_; rw[it * 8 + jj * 2 + 1] = b_; } } \
            else if (t0 == 0 && rB < 3) { _Pragma("unroll") for (int jj = 0; jj < 3; ++jj) if (rB - 3 + jj < 0) { rw[jj * 2] = (u32x4){0u, 0u, 0u, 0u}; rw[jj * 2 + 1] = (u32x4){0u, 0u, 0u, 0u}; } } \
            f32x4 wreg_[16]; _Pragma("unroll") for (int jj = 0; jj < 4; ++jj) _Pragma("unroll") for (int q = 0; q < 4; ++q) wreg_[jj * 4 + q] = *(const LAS f32x4*)(cw_s + jj * 384 + (p) * 128 + jB * 16 + 4 * q);   \
            _Pragma("unroll") for (int it = 0; it < 2; ++it) { const int r_ = rB + 32 * it, t_ = t0 + r_; const bool ok_ = r_ < nvalid; \
                float* so_ = (ok_ && t_ >= T - 3) ? ((s < BP ? F.out + O_GCP + ((size_t)s * 3 + (t_ - (T - 3))) * 3072 : F.out + O_GCS + ((size_t)(s - BP) * 3 + (t_ - (T - 3))) * 3072) + (p) * 1024 + h * 128 + jB * 16) : nullptr; \
                p2_conv_item(F, rw, it, wreg_, (p), jB, lane, ok_, so_, (LAS u32x4*)(Sb + ((p) == 0 ? P2_Q : (p) == 1 ? P2_K : P2_V) + r_ * 272 + jB * 32)); } } } while (0)
        if (grpB) {
            P2_PART(0, rwA);
            if (actB && s < BP) p2_load_part(F, rwA, s, c, h, 1, tb);
        } else if (actA) {
            int l2 = lane; asm volatile("" : "+v"(l2));
            const int r = l2 & 31, hh = l2 >> 5;
#pragma unroll
            for (int half = 0; half < 2; ++half) {
                const int tile8 = wave + 4 * half, which = tile8 >> 2, ti = (tile8 >> 1) & 1, tj = tile8 & 1;
                f32x16 acc;
#pragma unroll
                for (int e = 0; e < 16; ++e) acc[e] = 0.f;
                if (!(ti == 0 && tj == 1)) {
                    const LAS unsigned char* ap = Sb + (which ? P2_Q : P2_K) + (32 * ti + r) * 272 + hh * 16;
                    const LAS unsigned char* bp = Sb + P2_K + (32 * tj + r) * 272 + hh * 16;
#pragma unroll
                    for (int ks = 0; ks < 8; ++ks) { const bf16x8 a = *(const LAS bf16x8*)(ap + ks * 32), b = *(const LAS bf16x8*)(bp + ks * 32); acc = MFMA32(a, b, acc); }
                }
                const int jc = 32 * tj + r; const float gj = gcum_s[jc];
#pragma unroll
                for (int e = 0; e < 16; ++e) {
                    const int ii = 32 * ti + (e & 3) + 8 * (e >> 2) + 4 * hh; const float dg = gcum_s[ii] - gj;
                    if (which == 0) { const float f = (ii > jc) ? __expf(dg) * beta_s[ii] : 0.f; *(LAS float*)(L + P2_AS + ii * 272 + jc * 4) = acc[e] * f; }
                    else { const float f = (ii >= jc) ? __expf(dg) : 0.f; *(LAS bf16_t*)(L + P2_PS + ii * 144 + jc * 2) = (bf16_t)(cvt2(acc[e] * f, 0.f) & 0xffffu); }
                }
            }
        }
        LDS_BARRIER();
        if (grpB) {
            P2_PART(1, rwA);
            if (actB && s < BP) p2_load_part(F, rwA, s, c, h, 2, tb);
        } else if (actA) {
            int l3 = lane; asm volatile("" : "+v"(l3));
            if (wave == 0) {
                const int bk = l3 >> 4, col = l3 & 15;
                float tcol[16];
#pragma unroll
                for (int rr = 0; rr < 16; ++rr) {
                    float a = (rr == col) ? 1.0f : 0.f;
#pragma unroll
                    for (int j4 = 0; j4 < (rr + 3) / 4; ++j4) { const f32x4 a4 = *(const LAS f32x4*)(L + P2_AS + (16 * bk + rr) * 272 + (16 * bk + 4 * j4) * 4);
#pragma unroll
                        for (int q = 0; q < 4; ++q) if (4 * j4 + q < rr) a -= a4[q] * tcol[4 * j4 + q]; }
                    tcol[rr] = a;
                    *(LAS float*)(L + P2_ES + ((bk * 16 + rr) * 16 + col) * 4) = a - ((rr == col) ? 1.0f : 0.f);
                }
            } else {
                const int r = l3 & 31, hh = l3 >> 5;
                if (wave == 1) {
#pragma unroll
                    for (int rt4 = 0; rt4 < 4; ++rt4)
#pragma unroll
                        for (int kt2 = 0; kt2 < 2; ++kt2)
#pragma unroll
                            for (int ss = 0; ss < 2; ++ss) { float v[8];
#pragma unroll
                                for (int j = 0; j < 8; ++j) { const int tok = 32 * kt2 + krow(ss, hh, j); v[j] = bf2f(*(const LAS bf16_t*)(Sb + P2_K + tok * 272 + (32 * rt4 + r) * 2)) * ek_s[tok]; }
                                u32x4 o; o[0] = cvt2(v[0], v[1]); o[1] = cvt2(v[2], v[3]); o[2] = cvt2(v[4], v[5]); o[3] = cvt2(v[6], v[7]);
                                st16_wt(srs, boff + GS_KF + ((rt4 * 2 + kt2) * 2 + ss) * 1024 + l3 * 16, o); }
                } else if (wave == 2) {
#pragma unroll
                    for (int kt = 0; kt < 4; ++kt)
#pragma unroll
                        for (int rt = 0; rt < 2; ++rt)
#pragma unroll
                            for (int ss = 0; ss < 2; ++ss) { const int ii = 32 * rt + r; const float sc = eg_s[ii];
                                const u32x2 lo = *(const LAS u32x2*)(Sb + P2_Q + ii * 272 + (32 * kt + 16 * ss + 4 * hh) * 2), hi = *(const LAS u32x2*)(Sb + P2_Q + ii * 272 + (32 * kt + 16 * ss + 8 + 4 * hh) * 2);
                                u32x4 o; o[0] = cvt2(lo16(lo[0]) * sc, hi16(lo[0]) * sc); o[1] = cvt2(lo16(lo[1]) * sc, hi16(lo[1]) * sc); o[2] = cvt2(lo16(hi[0]) * sc, hi16(hi[0]) * sc); o[3] = cvt2(lo16(hi[1]) * sc, hi16(hi[1]) * sc);
                                st16_wt(srs, boff + GS_QF + ((rt * 4 + kt) * 2 + ss) * 1024 + l3 * 16, o); }
                } else {
#pragma unroll
                    for (int rt = 0; rt < 2; ++rt)
#pragma unroll
                        for (int kt2 = 0; kt2 < 2; ++kt2)
#pragma unroll
                            for (int ss = 0; ss < 2; ++ss) { const int ii = 32 * rt + r;
                                const u32x2 lo = *(const LAS u32x2*)(L + P2_PS + ii * 144 + (32 * kt2 + 16 * ss + 4 * hh) * 2), hi = *(const LAS u32x2*)(L + P2_PS + ii * 144 + (32 * kt2 + 16 * ss + 8 + 4 * hh) * 2);
                                u32x4 o; o[0] = lo[0]; o[1] = lo[1]; o[2] = hi[0]; o[3] = hi[1];
                                st16_wt(srs, boff + GS_PF + ((rt * 2 + kt2) * 2 + ss) * 1024 + l3 * 16, o); }
                }
            }
        }
        LDS_BARRIER();
        if (grpB) {
            P2_PART(2, rwA);
        } else if (actA) {
            int l4 = lane; asm volatile("" : "+v"(l4));
            const int c16 = l4 & 15, g = l4 >> 4;
            const f32x4 z4 = {0.f, 0.f, 0.f, 0.f};
            f32x4 a10, a20, a21, a30, a31, a32, e0, e1, e2, e3;
            { const LAS unsigned char* ar = L + P2_AS + c16 * 272 + (4 * g) * 4;
              a10 = *(const LAS f32x4*)(ar + 16 * 272); a20 = *(const LAS f32x4*)(ar + 32 * 272); a21 = *(const LAS f32x4*)(ar + 32 * 272 + 64);
              a30 = *(const LAS f32x4*)(ar + 48 * 272); a31 = *(const LAS f32x4*)(ar + 48 * 272 + 64); a32 = *(const LAS f32x4*)(ar + 48 * 272 + 128);
              const LAS unsigned char* er = L + P2_ES + (c16 * 16 + 4 * g) * 4;
              e0 = *(const LAS f32x4*)er; e1 = *(const LAS f32x4*)(er + 1024); e2 = *(const LAS f32x4*)(er + 2048); e3 = *(const LAS f32x4*)(er + 3072); }
            const bf16x8 fA10 = g1_pack_b(z4 - a10, z4), fA2 = g1_pack_b(z4 - a20, z4 - a21), fA3a = g1_pack_b(z4 - a30, z4 - a31), fA3b = g1_pack_b(z4 - a32, z4);
            const bf16x8 fE0 = g1_pack_b(e0, z4), fE1 = g1_pack_b(e1, z4), fE2 = g1_pack_b(e2, z4), fE3 = g1_pack_b(e3, z4);
#pragma unroll
            for (int tl = 0; tl < 4; ++tl) {
                const int t16 = 4 * wave + tl; const bool isw = t16 < 8; const int d = 16 * (t16 & 7) + c16;
                f32x4 R[4];
#pragma unroll
                for (int ib = 0; ib < 4; ++ib)
#pragma unroll
                    for (int e = 0; e < 4; ++e) { const int row = 16 * ib + 4 * g + e; const float raw1 = bf2f(*(const LAS bf16_t*)(Sb + (isw ? P2_K : P2_V) + row * 272 + d * 2)); R[ib][e] = raw1 * beta_s[row] * (isw ? eg_s[row] : 1.0f); }
                const f32x4 X0 = MFMA16(fE0, g1_pack_b(R[0], z4), R[0]);
                const f32x4 Y1 = MFMA16(fA10, g1_pack_b(X0, z4), R[1]);
                const f32x4 X1 = MFMA16(fE1, g1_pack_b(Y1, z4), Y1);
                const f32x4 Y2 = MFMA16(fA2, g1_pack_b(X0, X1), R[2]);
                const f32x4 X2 = MFMA16(fE2, g1_pack_b(Y2, z4), Y2);
                f32x4 Y3 = MFMA16(fA3a, g1_pack_b(X0, X1), R[3]);
                Y3 = MFMA16(fA3b, g1_pack_b(X2, z4), Y3);
                const f32x4 X3 = MFMA16(fE3, g1_pack_b(Y3, z4), Y3);
                const f32x4 X[4] = {X0, X1, X2, X3};
                if (isw) {
#pragma unroll
                    for (int ib = 0; ib < 4; ++ib)
#pragma unroll
                        for (int e = 0; e < 4; ++e) *(LAS bf16_t*)(Sb + P2_Q + (16 * ib + 4 * g + e) * 272 + d * 2) = (bf16_t)(cvt2(-X[ib][e], 0.f) & 0xffffu);
                } else {
                    const int ws = d >> 5, cc = d & 31;
#pragma unroll
                    for (int ib = 0; ib < 4; ++ib) { const int rt = ib >> 1, q = 2 * (ib & 1) + (g >> 1), hh = g & 1;
                        u32x2 o; o[0] = cvt2(X[ib][0], X[ib][1]); o[1] = cvt2(X[ib][2], X[ib][3]);
                        st8_wt(blk + GS_UF + (size_t)(((ws * 2 + rt) * 64) + cc + 32 * hh) * 32 + q * 8, o); }
                }
            }
        }
        LDS_BARRIER();
        if (grpB) {
            { const int ntk = taskB + stride < 4224 ? taskB + stride : 4223; int s1, c1, h1; g1_decode(ntk, s1, c1, h1);
#pragma unroll
              for (int q = 0; q < 6; ++q) { const int ii = tb + 256 * q, jj = ii / 384, cc = ii % 384; pcw[q] = F.in[29][(size_t)jj * 3072 + (cc >> 7) * 1024 + h1 * 128 + (cc & 127)]; }
              const int ntp = ntk < 4095 ? ntk : 4095; int s2, c2, h2; g1_decode(ntp, s2, c2, h2);
              p2_load_part(F, rwA, s2, c2, h2, 0, tb);
#pragma unroll
              for (int q = 0; q < 6; ++q) cw_s[tb + 256 * q] = pcw[q]; }
        } else if (actA) {
            int l5 = lane; asm volatile("" : "+v"(l5));
            const int kt = wave, r = l5 & 31, hh = l5 >> 5;
#pragma unroll
            for (int rt = 0; rt < 2; ++rt)
#pragma unroll
                for (int ss = 0; ss < 2; ++ss) { const int ii = 32 * rt + r;
                    const u32x2 lo = *(const LAS u32x2*)(Sb + P2_Q + ii * 272 + (32 * kt + 16 * ss + 4 * hh) * 2), hi = *(const LAS u32x2*)(Sb + P2_Q + ii * 272 + (32 * kt + 16 * ss + 8 + 4 * hh) * 2);
                    u32x4 o; o[0] = lo[0]; o[1] = lo[1]; o[2] = hi[0]; o[3] = hi[1];
                    st16_wt(srs, boff + GS_WF + ((rt * 4 + kt) * 2 + ss) * 1024 + l5 * 16, o); }
            asm volatile("s_waitcnt vmcnt(0)" ::: "memory");
        }
        if (gact) {
            LAS float* gv = (LAS float*)(L + P2_VEC + (i & 1) * 1024);
            const bool ok = lane < (gs < BP ? 64 : TS); float x = ok ? gva : 0.f;
#pragma unroll
            for (int o = 1; o < 64; o <<= 1) { const float y = shfl_idx(x, lane >= o ? lane - o : lane); if (lane >= o) x += y; }
            const float gl = shfl_idx(x, 63);
            gv[lane] = ok ? gvb : 0.f; gv[64 + lane] = x; gv[128 + lane] = __expf(x); gv[192 + lane] = ok ? __expf(gl - x) : 0.f;
            const int gsidx = taskB < 4096 ? ((gs * 8 + gh) * 64 + gc) : taskB;
            if (lane == 0) __hip_atomic_store((unsigned*)DEC + gsidx, __float_as_uint(__expf(gl)), __ATOMIC_RELAXED, __HIP_MEMORY_SCOPE_AGENT);
        }
        LDS_BARRIER();
        if (tid == 0 && i >= 1) __hip_atomic_store(ready + 16 * sidx, 1u, __ATOMIC_RELAXED, __HIP_MEMORY_SCOPE_AGENT);
#undef P2_PART
    }
}

constexpr int G2_FB = GS_BYTES, G2_OSTRIDE = 528, G2_HN = 2 * G2_FB, G2_DEC = G2_HN + 512;
__device__ __forceinline__ bf16x8 pack8(const f32x16& x, const int s) {
    u32x4 p; p[0] = cvt2(x[8 * s], x[8 * s + 1]); p[1] = cvt2(x[8 * s + 2], x[8 * s + 3]); p[2] = cvt2(x[8 * s + 4], x[8 * s + 5]); p[3] = cvt2(x[8 * s + 6], x[8 * s + 7]);
    return __builtin_bit_cast(bf16x8, p);
}
template <bool WT>
__device__ __forceinline__ void g2_load_set(u32x4 (&pre)[18], float& dpre, const unsigned char* blk, int lt, brsrc_t srs, unsigned boff, const unsigned* flag, const float* decp) {
    if (WT) { unsigned sp = 0; while (__builtin_amdgcn_readfirstlane(__hip_atomic_load(flag, __ATOMIC_RELAXED, __HIP_MEMORY_SCOPE_AGENT)) == 0u && ++sp < (1u << 20)) __builtin_amdgcn_s_sleep(4);
        dpre = __uint_as_float(__hip_atomic_load((const unsigned*)decp, __ATOMIC_RELAXED, __HIP_MEMORY_SCOPE_AGENT));
#pragma unroll
        for (int i = 0; i < 18; ++i) pre[i] = ld16_wt(srs, boff + (unsigned)(i * 256 + lt) * 16u);
    } else { const u32x4* src = (const u32x4*)blk; dpre = *decp;
#pragma unroll
        for (int i = 0; i < 18; ++i) pre[i] = src[i * 256 + lt]; }
}
__device__ __forceinline__ void g2_store_set(const u32x4 (&pre)[18], LAS unsigned char* dst, int lt) {
#pragma unroll
    for (int i = 0; i < 18; ++i) *(LAS u32x4*)(dst + (size_t)(i * 256 + lt) * 16) = pre[i];
}
#define G2_FRAG(off) (*(const LAS bf16x8*)(B + (off)))
#define G2_SCHED() __builtin_amdgcn_sched_barrier(0)
__device__ __forceinline__ void g2_mfma_step(f32x16& S0, f32x16& S1, f32x16& S2, f32x16& S3, LAS unsigned char* Bimg, const float dec, int ws, int lane, int cc, int hh) {
    const LAS unsigned char* B = Bimg + lane * 16;
    f32x16 vn0, vn1, o0, o1;
    { const LAS u32x4* up = (const LAS u32x4*)(Bimg + GS_UF + (size_t)(ws * 2 * 64 + lane) * 32); const u32x4 u0 = up[0], u1 = up[1], u2 = up[128], u3 = up[129];
#pragma unroll
      for (int q = 0; q < 4; ++q) { vn0[2 * q] = lo16(u0[q]); vn0[2 * q + 1] = hi16(u0[q]); vn0[8 + 2 * q] = lo16(u1[q]); vn0[8 + 2 * q + 1] = hi16(u1[q]);
                                    vn1[2 * q] = lo16(u2[q]); vn1[2 * q + 1] = hi16(u2[q]); vn1[8 + 2 * q] = lo16(u3[q]); vn1[8 + 2 * q + 1] = hi16(u3[q]); } }
#pragma unroll
    for (int e = 0; e < 16; ++e) { o0[e] = 0.f; o1[e] = 0.f; }
#define G2_WQ(Sx, kt) do { _Pragma("unroll") for (int ss = 0; ss < 2; ++ss) { const bf16x8 sb = pack8(Sx, ss); \
        const bf16x8 fw0 = G2_FRAG(GS_WF + ((0 * 4 + kt) * 2 + ss) * 1024), fw1 = G2_FRAG(GS_WF + ((1 * 4 + kt) * 2 + ss) * 1024); \
        const bf16x8 fq0 = G2_FRAG(GS_QF + ((0 * 4 + kt) * 2 + ss) * 1024), fq1 = G2_FRAG(GS_QF + ((1 * 4 + kt) * 2 + ss) * 1024); \
        vn0 = MFMA32(fw0, sb, vn0); vn1 = MFMA32(fw1, sb, vn1); o0 = MFMA32(fq0, sb, o0); o1 = MFMA32(fq1, sb, o1); } } while (0)
    G2_WQ(S0, 0); G2_WQ(S1, 1); G2_WQ(S2, 2); G2_WQ(S3, 3);
#undef G2_WQ
    bf16x8 vb[2][2];
    vb[0][0] = pack8(vn0, 0); vb[0][1] = pack8(vn0, 1); vb[1][0] = pack8(vn1, 0); vb[1][1] = pack8(vn1, 1);
#pragma unroll
    for (int kt2 = 0; kt2 < 2; ++kt2)
#pragma unroll
        for (int ss = 0; ss < 2; ++ss) { o0 = MFMA32(G2_FRAG(GS_PF + ((0 * 2 + kt2) * 2 + ss) * 1024), vb[kt2][ss], o0); o1 = MFMA32(G2_FRAG(GS_PF + ((1 * 2 + kt2) * 2 + ss) * 1024), vb[kt2][ss], o1); }
    S0 = S0 * dec; S1 = S1 * dec; S2 = S2 * dec; S3 = S3 * dec;
#pragma unroll
    for (int kt2 = 0; kt2 < 2; ++kt2)
#pragma unroll
        for (int ss = 0; ss < 2; ++ss) {
            S0 = MFMA32(G2_FRAG(GS_KF + ((0 * 2 + kt2) * 2 + ss) * 1024), vb[kt2][ss], S0); S1 = MFMA32(G2_FRAG(GS_KF + ((1 * 2 + kt2) * 2 + ss) * 1024), vb[kt2][ss], S1);
            S2 = MFMA32(G2_FRAG(GS_KF + ((2 * 2 + kt2) * 2 + ss) * 1024), vb[kt2][ss], S2); S3 = MFMA32(G2_FRAG(GS_KF + ((3 * 2 + kt2) * 2 + ss) * 1024), vb[kt2][ss], S3); }
    LDS_BARRIER();
#pragma unroll
    for (int e = 0; e < 16; ++e) { const int rr = (e & 3) + 8 * (e >> 2) + 4 * hh;
        *(LAS float*)(Bimg + rr * G2_OSTRIDE + (32 * ws + cc) * 4) = o0[e]; *(LAS float*)(Bimg + (32 + rr) * G2_OSTRIDE + (32 * ws + cc) * 4) = o1[e]; }
    LDS_BARRIER();
}
__device__ __forceinline__ void g2_epi16(Frame& F, LAS unsigned char* L, const LAS unsigned char* Oimg, const u32x4 (&zz)[2], int row, int sub, size_t m, int h, bool rok, int lane) {
    f32x4 ov[4]; float ss = 0.f;
#pragma unroll
    for (int q = 0; q < 4; ++q) { ov[q] = *(const LAS f32x4*)(Oimg + row * G2_OSTRIDE + (sub * 16 + 4 * q) * 4); ss += (ov[q][0] * ov[q][0] + ov[q][1] * ov[q][1]) + (ov[q][2] * ov[q][2] + ov[q][3] * ov[q][3]); }
    ss += shfl_xor_l(ss, 1, lane); ss += shfl_xor_l(ss, 2, lane); ss += shfl_xor_l(ss, 4, lane);
    const float rn = __builtin_amdgcn_rsqf(ss * (1.f / 128.f) + EPS);
    if (rok) {
        const LAS float* hn_s = (const LAS float*)(L + G2_HN);
        u32x4* yp = (u32x4*)(F.Y1() + m * D + h * 128 + sub * 16);
#pragma unroll
        for (int q = 0; q < 2; ++q) {
            const f32x4 oa = ov[2 * q], ob = ov[2 * q + 1];
            const f32x4 ha = *(const LAS f32x4*)(hn_s + sub * 16 + 8 * q), hb = *(const LAS f32x4*)(hn_s + sub * 16 + 8 * q + 4);
            u32x4 yo;
            yo[0] = cvt2(oa[0] * rn * ha[0] * siluf_(lo16(zz[q][0])), oa[1] * rn * ha[1] * siluf_(hi16(zz[q][0])));
            yo[1] = cvt2(oa[2] * rn * ha[2] * siluf_(lo16(zz[q][1])), oa[3] * rn * ha[3] * siluf_(hi16(zz[q][1])));
            yo[2] = cvt2(ob[0] * rn * hb[0] * siluf_(lo16(zz[q][2])), ob[1] * rn * hb[1] * siluf_(hi16(zz[q][2])));
            yo[3] = cvt2(ob[2] * rn * hb[2] * siluf_(lo16(zz[q][3])), ob[3] * rn * hb[3] * siluf_(hi16(zz[q][3])));
            yp[q] = yo; }
    }
}
template <int NCH, bool WT>
__device__ __forceinline__ void g2_task(Frame& F, LAS unsigned char* L, const float* DEC, int s, int h, int ch0, int tid, int lane, int wave) {
    const size_t cstep = (size_t)GS_BYTES;
    const int base = seq_base(s), nvalid = s < BP ? 64 : TS;
    const unsigned char* blk0 = F.ws + WS_RB + (size_t)ch0 * GS_BYTES;
    constexpr int lastc = NCH - 1;
    if (wave < 4) {
        const int ws = wave, cc = lane & 31, hh = lane >> 5;
        f32x16 S0, S1, S2, S3;
        if (s < BP) {
#pragma unroll
            for (int e = 0; e < 16; ++e) { S0[e] = 0.f; S1[e] = 0.f; S2[e] = 0.f; S3[e] = 0.f; }
        } else {
            const float* sp = F.in[7] + ((size_t)(s - BP) * 8 + h) * 16384 + 32 * ws + cc;
#pragma unroll
            for (int e = 0; e < 16; ++e) { const int rr = (e & 3) + 8 * (e >> 2) + 4 * hh; S0[e] = sp[(size_t)rr * 128]; S1[e] = sp[(size_t)(32 + rr) * 128]; S2[e] = sp[(size_t)(64 + rr) * 128]; S3[e] = sp[(size_t)(96 + rr) * 128]; }
        }
        const LAS float* dec_s = (const LAS float*)(L + G2_DEC);
        const int erow = tid >> 3, esub = tid & 7; const bool erok = erow < nvalid;
        u32x4 zz[2];
#define G2_ZLOAD(cidx) do { const u32x4* zp = (const u32x4*)(F.Z1() + ((size_t)base + (cidx) * 64 + erow) * D + h * 128 + esub * 16); zz[0] = zp[0]; zz[1] = zp[1]; } while (0)
        LDS_BARRIER();
        if (NCH == 1) { if (erok) G2_ZLOAD(0); g2_mfma_step(S0, S1, S2, S3, L, dec_s[0], ws, lane, cc, hh); g2_epi16(F, L, L, zz, erow, esub, (size_t)base + erow, h, erok, lane); LDS_BARRIER(); }
        else for (int c = 0; c < NCH; c += 2) {
            G2_ZLOAD(c);
            g2_mfma_step(S0, S1, S2, S3, L, dec_s[c], ws, lane, cc, hh);
            g2_epi16(F, L, L, zz, erow, esub, (size_t)base + c * 64 + erow, h, erok, lane);
            LDS_BARRIER();
            G2_ZLOAD(c + 1);
            g2_mfma_step(S0, S1, S2, S3, L + G2_FB, dec_s[c + 1], ws, lane, cc, hh);
            g2_epi16(F, L, L + G2_FB, zz, erow, esub, (size_t)base + (c + 1) * 64 + erow, h, erok, lane);
            LDS_BARRIER();
        }
        int l9 = lane; asm volatile("" : "+v"(l9));
        const int cc9 = l9 & 31, hh9 = l9 >> 5;
        float* so = (s < BP ? F.out + O_GSP + ((size_t)s * 8 + h) * 16384 : F.out + O_GSS + ((size_t)(s - BP) * 8 + h) * 16384) + 32 * ws + cc9;
#pragma unroll
        for (int e = 0; e < 16; ++e) { const int rr = (e & 3) + 8 * (e >> 2) + 4 * hh9; so[(size_t)rr * 128] = S0[e]; so[(size_t)(32 + rr) * 128] = S1[e]; so[(size_t)(64 + rr) * 128] = S2[e]; so[(size_t)(96 + rr) * 128] = S3[e]; }
    } else {
        const int lt = tid - 256;
        if (lt < 128) ((LAS float*)(L + G2_HN))[lt] = F.in[32][lt];
        const brsrc_t srs = staging_rsrc(F.ws);
        const unsigned* ready = (const unsigned*)(F.ws + WS_READY);
        LAS float* dec_w = (LAS float*)(L + G2_DEC);
#define G2_LOAD(pre, dpre, k) do { const int _k = (k) < lastc ? (k) : lastc; g2_load_set<WT>(pre, dpre, blk0 + (size_t)_k * cstep, lt, srs, (unsigned)(ch0 + _k) * (unsigned)GS_BYTES, ready + 16 * (ch0 + _k), DEC + ch0 + _k); } while (0)
        u32x4 preA[18], preB[18]; float dA, dB;
        G2_LOAD(preA, dA, 0);
        G2_LOAD(preB, dB, 1);
        g2_store_set(preA, L, lt); if (lt == 0) dec_w[0] = dA;
        G2_LOAD(preA, dA, 2);
        const int erow = tid >> 3, esub = tid & 7; const bool erok = erow < nvalid;
        u32x4 zz[2];
#define G2_ZLOAD(cidx) do { const u32x4* zp = (const u32x4*)(F.Z1() + ((size_t)base + (cidx) * 64 + erow) * D + h * 128 + esub * 16); zz[0] = zp[0]; zz[1] = zp[1]; } while (0)
        LDS_BARRIER();
        if (NCH == 1) {
            if (erok) G2_ZLOAD(0);
            LDS_BARRIER();
            LDS_BARRIER();
            g2_epi16(F, L, L, zz, erow, esub, (size_t)base + erow, h, erok, lane);
            LDS_BARRIER();
        } else {
            for (int c = 0; c < NCH; c += 2) {
                {
                    g2_store_set(preB, L + G2_FB, lt); if (lt == 0) dec_w[(c + 1) & 63] = dB;
                    G2_ZLOAD(c);
                    G2_LOAD(preB, dB, c + 3);
                    LDS_BARRIER();
                    LDS_BARRIER();
                    g2_epi16(F, L, L, zz, erow, esub, (size_t)base + c * 64 + erow, h, erok, lane);
                    LDS_BARRIER();
                }
                {
                    g2_store_set(preA, L, lt); if (lt == 0) dec_w[(c + 2) & 63] = dA;
                    G2_ZLOAD(c + 1);
                    G2_LOAD(preA, dA, c + 4);
                    LDS_BARRIER();
                    LDS_BARRIER();
                    g2_epi16(F, L, L + G2_FB, zz, erow, esub, (size_t)base + (c + 1) * 64 + erow, h, erok, lane);
                    LDS_BARRIER();
                }
            }
        }
    }
}
#undef G2_ZLOAD
#undef G2_LOAD
constexpr int G12_CHAINS = 64;
__device__ __forceinline__ void phase_gdn_fused(Frame& F) {
    LAS unsigned char* L = F.lds;
    const float* DEC = (const float*)(F.ws + WS_DEC);
    if ((int)blockIdx.x < G12_CHAINS && F.G > G12_CHAINS) {
        const int tid = opaque_tid(F.wv);
        const int ci = blockIdx.x;
        g2_task<64, true>(F, L, DEC, ci >> 3, ci & 7, ci * 64, tid, tid & 63, F.wv);
    } else {
        const bool all = !(F.G > G12_CHAINS);
        const int p = all ? (int)blockIdx.x : (int)blockIdx.x - G12_CHAINS, np = all ? F.G : F.G - G12_CHAINS;
        gdn_g1_tasks(F, p, np);
        for (int t = p; t < 128; t += np) {
            const int tid = opaque_tid(F.wv);
            __syncthreads();
            g2_task<1, true>(F, L, DEC, BP + (t >> 3), t & 7, 4096 + t, tid, tid & 63, F.wv);
        }
    }
}

__device__ __forceinline__ float dpp_shr_f(float idv, float x, const int o) {
    int r;
    switch (o) {
        case 1: r = __builtin_amdgcn_update_dpp(__float_as_int(idv), __float_as_int(x), 0x111, 0xf, 0xf, false); break;
        case 2: r = __builtin_amdgcn_update_dpp(__float_as_int(idv), __float_as_int(x), 0x112, 0xf, 0xf, false); break;
        case 4: r = __builtin_amdgcn_update_dpp(__float_as_int(idv), __float_as_int(x), 0x114, 0xf, 0xf, false); break;
        default: r = __builtin_amdgcn_update_dpp(__float_as_int(idv), __float_as_int(x), 0x118, 0xf, 0xf, false); break;
    }
    return __int_as_float(r);
}
__device__ __forceinline__ float dpp_shr0_f(float x, const int o) {
    int r;
    switch (o) {
        case 1: r = __builtin_amdgcn_update_dpp(0, __float_as_int(x), 0x111, 0xf, 0xf, true); break;
        case 2: r = __builtin_amdgcn_update_dpp(0, __float_as_int(x), 0x112, 0xf, 0xf, true); break;
        case 4: r = __builtin_amdgcn_update_dpp(0, __float_as_int(x), 0x114, 0xf, 0xf, true); break;
        default: r = __builtin_amdgcn_update_dpp(0, __float_as_int(x), 0x118, 0xf, 0xf, true); break;
    }
    return __int_as_float(r);
}
template <int PASS>
__device__ __forceinline__ void phase_lru(Frame& F) {
    int tid = opaque_tid(F.wv);
    const int lane = tid & 63, wave = __builtin_amdgcn_readfirstlane(tid >> 6);
    const int gw = F.vcu * 8 + wave, NGW = F.G * 8, h = gw & 7, g = lane >> 4, l15 = lane & 15;
    LAS unsigned char* xs = F.lds + wave * 9216;
    LAS float* cst = (LAS float*)(F.lds + 73728 + wave * 768);
    const bf16_t* LGW = (const bf16_t*)(F.ws + WS_LGW);
    float* LAG = F.LAG();
    bf16x8 wfa[4][2], wfx[4][2];
#pragma unroll
    for (int nt = 0; nt < 4; ++nt)
#pragma unroll
        for (int ks = 0; ks < 2; ++ks) {
            wfa[nt][ks] = *(const bf16x8*)(LGW + ((size_t)(h * 2 + 0) * 64 + 16 * nt + l15) * 64 + 32 * ks + 8 * g);
            wfx[nt][ks] = *(const bf16x8*)(LGW + ((size_t)(h * 2 + 1) * 64 + 16 * nt + l15) * 64 + 32 * ks + 8 * g); }
    cst[lane] = F.in[18][h * 64 + lane]; cst[64 + lane] = F.in[20][h * 64 + lane]; cst[128 + lane] = softplusf_(-F.in[21][h * 64 + lane]);
    for (int task = gw; task < 4224; task += NGW) {
        int s, c; if (task < 4096) { s = task >> 9; c = (task >> 3) & 63; } else { s = BP + ((task - 4096) >> 3); c = 0; }
        const int T = seq_len(s), base = seq_base(s), t0 = c * 64, ntile = s < BP ? 4 : 1;
        {
            int l1 = lane; asm volatile("" : "+v"(l1));
            const int cg = l1 & 7, tp = l1 >> 3;
#pragma unroll 1
            for (int hf2 = 0; hf2 < 2; ++hf2) {
                const int chb = h * 64 + cg * 8 + hf2 * 4;
                float xr[11][4];
                if (s < BP) {
                    u32x2 w[11];
#pragma unroll
                    for (int i = 0; i < 11; ++i) { int tt = t0 + tp * 8 - 3 + i; tt = tt < 0 ? 0 : tt; w[i] = *(const u32x2*)(F.U0() + (size_t)(base + tt) * EV_IN + C_XA + chb); }
                    if (t0 == 0 && tp == 0) { w[0] = (u32x2){0u, 0u}; w[1] = (u32x2){0u, 0u}; w[2] = (u32x2){0u, 0u}; }
#pragma unroll
                    for (int i = 0; i < 11; ++i) { xr[i][0] = lo16(w[i][0]); xr[i][1] = hi16(w[i][0]); xr[i][2] = lo16(w[i][1]); xr[i][3] = hi16(w[i][1]); }
                } else {
#pragma unroll
                    for (int i = 0; i < 11; ++i) {
                        const int tt = t0 + tp * 8 - 3 + i;
                        if (tt >= 0 && tt < T) { const u32x2 w = *(const u32x2*)(F.U0() + (size_t)(base + tt) * EV_IN + C_XA + chb);
                            xr[i][0] = lo16(w[0]); xr[i][1] = hi16(w[0]); xr[i][2] = lo16(w[1]); xr[i][3] = hi16(w[1]); }
                        else if (tt < 0) { const f32x4 a = *(const f32x4*)(F.in[2] + ((size_t)(s - BP) * 3 + (tt + 3)) * 512 + chb); xr[i][0] = a[0]; xr[i][1] = a[1]; xr[i][2] = a[2]; xr[i][3] = a[3]; }
                        else { xr[i][0] = 0.f; xr[i][1] = 0.f; xr[i][2] = 0.f; xr[i][3] = 0.f; }
                    }
                }
                const f32x4 c0 = *(const f32x4*)(F.in[15] + chb), c1 = *(const f32x4*)(F.in[15] + 512 + chb), c2 = *(const f32x4*)(F.in[15] + 1024 + chb), c3 = *(const f32x4*)(F.in[15] + 1536 + chb), cb = *(const f32x4*)(F.in[16] + chb);
#pragma unroll
                for (int i = 0; i < 8; ++i) { float o[4];
#pragma unroll
                    for (int e = 0; e < 4; ++e) o[e] = c0[e] * xr[i][e] + c1[e] * xr[i + 1][e] + c2[e] * xr[i + 2][e] + c3[e] * xr[i + 3][e] + cb[e];
                    u32x2 w; w[0] = cvt2(o[0], o[1]); w[1] = cvt2(o[2], o[3]);
                    *(LAS u32x2*)(xs + (tp * 8 + i) * 144 + cg * 16 + hf2 * 8) = w; }
                if (PASS == 2 && t0 + 64 >= T && tp == ((T - 1) >> 3) - (t0 >> 3)) {
                    float* o = (s < BP ? F.out + O_LCP + (size_t)s * 3 * 512 : F.out + O_LCS + (size_t)(s - BP) * 3 * 512) + chb;
#pragma unroll
                    for (int q = 0; q < 3; ++q) *(f32x4*)(o + q * 512) = (f32x4){xr[8 + q][0], xr[8 + q][1], xr[8 + q][2], xr[8 + q][3]};
                }
            }
        }
        float hin[4][4], arun[4][4];
#pragma unroll
        for (int nt = 0; nt < 4; ++nt)
#pragma unroll
            for (int rg = 0; rg < 4; ++rg) { hin[nt][rg] = 0.f; arun[nt][rg] = 1.f; }
        if (PASS == 2) {
            float hf = s >= BP ? F.in[3][(s - BP) * 512 + h * 64 + lane] : 0.f;
            const f32x2* lp = (const f32x2*)LAG + (size_t)(s * 64) * 512 + h * 64 + lane;
            for (int j0 = 0; j0 < c; j0 += 16) { f32x2 v[16];
#pragma unroll
                for (int q = 0; q < 16; ++q) { const int jj = j0 + q < c ? j0 + q : c - 1; v[q] = lp[(size_t)jj * 512]; }
#pragma unroll
                for (int q = 0; q < 16; ++q) if (j0 + q < c) hf = v[q][0] * hf + v[q][1]; }
#pragma unroll
            for (int nt = 0; nt < 4; ++nt)
#pragma unroll
                for (int rg = 0; rg < 4; ++rg) hin[nt][rg] = shfl_idx(hf, 16 * nt + 4 * g + rg);
        }
        asm volatile("s_waitcnt lgkmcnt(0)" ::: "memory");
        for (int tt = 0; tt < ntile; ++tt) {
            const int tok = 16 * tt + l15;
            const bf16x8 b0 = *(const LAS bf16x8*)(xs + tok * 144 + (8 * g) * 2), b1 = *(const LAS bf16x8*)(xs + tok * 144 + (32 + 8 * g) * 2);
            const size_t m = (size_t)base + t0 + tok;
#pragma unroll
            for (int nt = 0; nt < 4; ++nt) {
                f32x4 za = {0.f, 0.f, 0.f, 0.f}, zx = {0.f, 0.f, 0.f, 0.f};
                za = MFMA16(wfa[nt][0], b0, za); za = MFMA16(wfa[nt][1], b1, za);
                zx = MFMA16(wfx[nt][0], b0, zx); zx = MFMA16(wfx[nt][1], b1, zx);
                const int n0 = 16 * nt + 4 * g;
                const u32x2 xw = *(const LAS u32x2*)(xs + tok * 144 + n0 * 2);
                const float xc[4] = {lo16(xw[0]), hi16(xw[0]), lo16(xw[1]), hi16(xw[1])};
                const f32x4 cba = *(const LAS f32x4*)(cst + n0), cbx = *(const LAS f32x4*)(cst + 64 + n0), csp = *(const LAS f32x4*)(cst + 128 + n0);
                float av[4], bv[4];
#pragma unroll
                for (int rg = 0; rg < 4; ++rg) {
                    const float r = sigmoidf_(za[rg] + cba[rg]), ig = sigmoidf_(zx[rg] + cbx[rg]), la = -8.0f * r * csp[rg], a = __expf(la);
                    av[rg] = a; bv[rg] = __builtin_amdgcn_sqrtf(fmaxf(1.0f - a * a, 0.f)) * (ig * xc[rg]); }
#pragma unroll
                for (int o = 1; o < 16; o <<= 1)
#pragma unroll
                    for (int rg = 0; rg < 4; ++rg) { const float ap = dpp_shr_f(1.0f, av[rg], o), bp = dpp_shr0_f(bv[rg], o); bv[rg] = av[rg] * bp + bv[rg]; av[rg] = av[rg] * ap; }
                float hv[4];
#pragma unroll
                for (int rg = 0; rg < 4; ++rg) { hv[rg] = bv[rg] + av[rg] * hin[nt][rg]; hin[nt][rg] = shfl_idx(hv[rg], (lane & 48) | 15); }
                if (PASS == 1) {
#pragma unroll
                    for (int rg = 0; rg < 4; ++rg) arun[nt][rg] *= shfl_idx(av[rg], (lane & 48) | 15);
                } else {
                    const bool tok_ok = (t0 + tok) < T;
                    if (tok_ok) {
                        const u32x2 gw2 = *(const u32x2*)(F.U0() + m * EV_IN + C_GA + h * 64 + n0);
                        u32x2 yo; yo[0] = cvt2(hv[0] * siluf_(lo16(gw2[0])), hv[1] * siluf_(hi16(gw2[0]))); yo[1] = cvt2(hv[2] * siluf_(lo16(gw2[1])), hv[3] * siluf_(hi16(gw2[1])));
                        *(u32x2*)(F.Y0() + m * D + h * 64 + n0) = yo;
                        if (t0 + tok == T - 1) { float* o = (s < BP ? F.out + O_LHP + s * 512 : F.out + O_LHS + (s - BP) * 512) + h * 64 + n0; *(f32x4*)o = (f32x4){hv[0], hv[1], hv[2], hv[3]}; }
                    }
                }
                if (nt & 1) __builtin_amdgcn_sched_barrier(0);
            }
        }
        if (PASS == 1 && s < BP && l15 == 15) {
            f32x2* lp = (f32x2*)LAG + (size_t)(s * 64 + c) * 512 + h * 64;
#pragma unroll
            for (int nt = 0; nt < 4; ++nt)
#pragma unroll
                for (int rg = 0; rg < 4; ++rg) lp[16 * nt + 4 * g + rg] = (f32x2){arun[nt][rg], hin[nt][rg]};
        }
        asm volatile("s_waitcnt lgkmcnt(0)" ::: "memory");
    }
}

constexpr size_t RB_VTP = RB_WEND, RB_VTS = RB_VTP + (size_t)BP * 2 * 64 * TP * 2, RB_VTEND = RB_VTS + (size_t)BS * 2 * 64 * 192 * 2;
static_assert(RB_VTEND <= RB_BYTES, "ws map");
__device__ __forceinline__ void phase_vt_build(Frame& F) {
    PHASE_IDS();
    const int gw = F.vcu * 8 + wave, NGW = F.G * 8;
    LAS unsigned char* xs = F.lds + wave * 9216;
    bf16_t* VTP = (bf16_t*)(F.ws + WS_RB + RB_VTP); bf16_t* VTS = (bf16_t*)(F.ws + WS_RB + RB_VTS);
    for (int task = gw; task < 1024 + 96; task += NGW) {
        int s, kv, kb; if (task < 1024) { s = task >> 7; kv = (task >> 6) & 1; kb = task & 63; } else { const int r = task - 1024; s = BP + r / 6; kv = (r % 6) / 3; kb = r % 3; }
        const int row8 = lane >> 3, ch = lane & 7;
#pragma unroll
        for (int i = 0; i < 8; ++i) {
            const int key = 8 * i + row8, kg = kb * 64 + key; u32x4 w = {0u, 0u, 0u, 0u};
            if (s < BP) w = *(const u32x4*)(F.U0() + (size_t)(s * TP + kg) * EV_IN + C_V + kv * 64 + ch * 8);
            else if (kg < 128) { const f32x4* p = (const f32x4*)(F.in[5] + ((size_t)((s - BP) * 128 + kg) * 2 + kv) * 64 + ch * 8); const f32x4 a = p[0], b = p[1]; w[0] = cvt2(a[0], a[1]); w[1] = cvt2(a[2], a[3]); w[2] = cvt2(b[0], b[1]); w[3] = cvt2(b[2], b[3]); }
            else if (kg < 128 + TS) w = *(const u32x4*)(F.U0() + (size_t)(MP + (s - BP) * TS + (kg - 128)) * EV_IN + C_V + kv * 64 + ch * 8);
            *(LAS u32x4*)(xs + key * 144 + ch * 16) = w;
        }
        asm volatile("s_waitcnt lgkmcnt(0)" ::: "memory");
        bf16_t* dst = s < BP ? VTP + ((size_t)(s * 2 + kv) * 64 + lane) * TP + kb * 64 : VTS + ((size_t)((s - BP) * 2 + kv) * 64 + lane) * 192 + kb * 64;
#pragma unroll
        for (int q = 0; q < 8; ++q) { u32x4 o;
#pragma unroll
            for (int e = 0; e < 4; ++e) { const unsigned lo = *(const LAS bf16_t*)(xs + (8 * q + 2 * e) * 144 + lane * 2), hi = *(const LAS bf16_t*)(xs + (8 * q + 2 * e + 1) * 144 + lane * 2); o[e] = lo | (hi << 16); }
            *(u32x4*)(dst + 8 * q) = o; }
        asm volatile("s_waitcnt lgkmcnt(0)" ::: "memory");
    }
}
constexpr int AT_K = 0, AT_V = 27648;
__device__ __forceinline__ void attn_issue(Frame& F, const bf16_t* VTP, int task, int tid, int wave, int lane, u32x4 (&kreg)[3], u32x4 (&vreg)[3], u32x4 (&qreg)[4]) {
    const int s = task >> 7, c = (task >> 1) & 63, kv = task & 1, tok0 = c * 64 - 128;
#pragma unroll
    for (int i = 0; i < 3; ++i) { const int idx = tid + 512 * i, key = idx >> 3, ch = idx & 7; int tk = tok0 + key; tk = tk < 0 ? 0 : tk;
        kreg[i] = *(const u32x4*)(F.U0() + (size_t)(s * TP + tk) * EV_IN + C_K + kv * 64 + ch * 8); }
#pragma unroll
    for (int i = 0; i < 3; ++i) { const int idx = tid + 512 * i, d = idx / 24, ch = idx % 24; int tk = tok0 + ch * 8; tk = tk < 0 ? 0 : tk;
        vreg[i] = *(const u32x4*)(VTP + ((size_t)(s * 2 + kv) * 64 + d) * TP + tk); }
    const int g = wave >> 1, qh = wave & 1, hq = kv * 4 + g, r = lane & 31, hh = lane >> 5;
    const size_t m = (size_t)s * TP + c * 64 + qh * 32 + r;
#pragma unroll
    for (int ks = 0; ks < 4; ++ks) qreg[ks] = *(const u32x4*)(F.U0() + m * EV_IN + C_Q + hq * 64 + 16 * ks + 8 * hh);
}
__device__ __forceinline__ void phase_attn(Frame& F) {
    PHASE_IDS();
    LAS unsigned char* L = F.lds;
    const bf16_t* VTP = (const bf16_t*)(F.ws + WS_RB + RB_VTP); const bf16_t* VTS = (const bf16_t*)(F.ws + WS_RB + RB_VTS);
    u32x4 kreg[3], vreg[3], qreg[4];
    attn_issue(F, VTP, F.vcu < 1024 ? F.vcu : 0, tid, wave, lane, kreg, vreg, qreg);
    for (int ti = F.vcu; ti < 1024 + 64; ti += F.G) {
        if (ti >= 1024 && ti < 1056) continue;
        const int task = ti < 1024 ? ti : ti - 32;
        int s, c, kv; if (task < 1024) { s = task >> 7; c = (task >> 1) & 63; kv = task & 1; } else { s = BP + ((task - 1024) >> 1); c = 0; kv = task & 1; }
        const int base = seq_base(s), tok0 = c * 64 - 128;
        const int kmin = s < BP ? (tok0 < 0 ? -tok0 : 0) : 0, kmax = s < BP ? 192 : 128 + TS;
        const int tid = opaque_tid(F.wv), lane = tid & 63;
        const int g = wave >> 1, qh = wave & 1, hq = kv * 4 + g, r = lane & 31, hh = lane >> 5, qi = qh * 32 + r;
        const bool qok = s < BP ? true : qi < TS;
        const size_t m = (size_t)base + c * 64 + (qok ? qi : 0);
        bf16x8 qf[4]; u32x2 gbr[8];
        LDS_BARRIER();
        if (s < BP) {
#pragma unroll
            for (int i = 0; i < 3; ++i) { const int idx = tid + 512 * i, key = idx >> 3, ch = idx & 7; const u32x4 z = {0u, 0u, 0u, 0u}; *(LAS u32x4*)(L + AT_K + key * 144 + ch * 16) = key >= kmin ? kreg[i] : z; }
#pragma unroll
            for (int i = 0; i < 3; ++i) { const int idx = tid + 512 * i, d = idx / 24, ch = idx % 24; const u32x4 z = {0u, 0u, 0u, 0u}; *(LAS u32x4*)(L + AT_V + d * 400 + ch * 16) = ch * 8 >= kmin ? vreg[i] : z; }
#pragma unroll
            for (int ks = 0; ks < 4; ++ks) { u32x4 w;
#pragma unroll
                for (int e = 0; e < 4; ++e) w[e] = cvt2(lo16(qreg[ks][e]) * 0.125f, hi16(qreg[ks][e]) * 0.125f);
                qf[ks] = __builtin_bit_cast(bf16x8, w); }
        } else {
#pragma unroll
            for (int i = 0; i < 3; ++i) {
                const int idx = tid + 512 * i, key = idx >> 3, ch = idx & 7; u32x4 w = {0u, 0u, 0u, 0u};
                if (key < kmax) {
                    if (key < 128) { const f32x4* p = (const f32x4*)(F.in[4] + ((size_t)((s - BP) * 128 + key) * 2 + kv) * 64 + ch * 8); const f32x4 a = p[0], b2 = p[1]; w[0] = cvt2(a[0], a[1]); w[1] = cvt2(a[2], a[3]); w[2] = cvt2(b2[0], b2[1]); w[3] = cvt2(b2[2], b2[3]); }
                    else w = *(const u32x4*)(F.U0() + (size_t)(base + key - 128) * EV_IN + C_K + kv * 64 + ch * 8);
                }
                *(LAS u32x4*)(L + AT_K + key * 144 + ch * 16) = w;
            }
#pragma unroll
            for (int i = 0; i < 3; ++i) {
                const int idx = tid + 512 * i, d = idx / 24, ch = idx % 24, key = ch * 8;
                *(LAS u32x4*)(L + AT_V + d * 400 + ch * 16) = *(const u32x4*)(VTS + ((size_t)((s - BP) * 2 + kv) * 64 + d) * 192 + key);
            }
#pragma unroll
            for (int ks = 0; ks < 4; ++ks) { u32x4 w = {0u, 0u, 0u, 0u};
                if (qok) { const u32x4 x = *(const u32x4*)(F.U0() + m * EV_IN + C_Q + hq * 64 + 16 * ks + 8 * hh);
#pragma unroll
                    for (int e = 0; e < 4; ++e) w[e] = cvt2(lo16(x[e]) * 0.125f, hi16(x[e]) * 0.125f); }
                qf[ks] = __builtin_bit_cast(bf16x8, w); }
        }
#pragma unroll
        for (int qq = 0; qq < 4; ++qq) { gbr[2 * qq] = qok ? *(const u32x2*)(F.U0() + m * EV_IN + C_GB + hq * 64 + 8 * qq + 4 * hh) : (u32x2){0u, 0u}; gbr[2 * qq + 1] = qok ? *(const u32x2*)(F.U0() + m * EV_IN + C_GB + hq * 64 + 32 + 8 * qq + 4 * hh) : (u32x2){0u, 0u}; }
        { const int nt = ti + F.G < 1024 ? ti + F.G : (ti < 1024 ? ti : 0); int t9 = tid; asm volatile("" : "+v"(t9)); attn_issue(F, VTP, nt, t9, wave, t9 & 63, kreg, vreg, qreg); }
        const float sink = F.in[22][hq];
        LDS_BARRIER();
        float mrun = sink, lrun = 1.0f;
        f32x16 o0, o1;
#pragma unroll
        for (int e = 0; e < 16; ++e) { o0[e] = 0.f; o1[e] = 0.f; }
#pragma unroll 1
        for (int half = 0; half < 2; ++half) {
            f32x16 sc[3];
#pragma unroll
            for (int k3 = 0; k3 < 3; ++k3) {
                const int kt = 3 * half + k3;
#pragma unroll
                for (int e = 0; e < 16; ++e) sc[k3][e] = 0.f;
#pragma unroll
                for (int ks = 0; ks < 4; ++ks) { const bf16x8 kf = *(const LAS bf16x8*)(L + AT_K + (32 * kt + r) * 144 + (16 * ks + 8 * hh) * 2); sc[k3] = MFMA32(kf, qf[ks], sc[k3]); }
            }
            float mx = -1e30f;
#pragma unroll
            for (int k3 = 0; k3 < 3; ++k3)
#pragma unroll
                for (int e = 0; e < 16; ++e) { const int kidx = 32 * (3 * half + k3) + (e & 3) + 8 * (e >> 2) + 4 * hh; const bool ok = kidx >= kmin && kidx < kmax; sc[k3][e] = ok ? sc[k3][e] : -1e30f; mx = fmaxf(mx, sc[k3][e]); }
            mx = fmaxf(mx, shfl_xor_l(mx, 32, lane));
            const float mnew = fmaxf(mrun, mx), alpha = __expf(mrun - mnew);
            float psum = 0.f;
#pragma unroll
            for (int k3 = 0; k3 < 3; ++k3)
#pragma unroll
                for (int e = 0; e < 16; ++e) { const float p = __expf(sc[k3][e] - mnew); sc[k3][e] = p; psum += p; }
            psum += shfl_xor_l(psum, 32, lane);
            lrun = lrun * alpha + psum; mrun = mnew;
            o0 = o0 * alpha; o1 = o1 * alpha;
#pragma unroll
            for (int k3 = 0; k3 < 3; ++k3)
#pragma unroll
                for (int ss = 0; ss < 2; ++ss) {
                    const int kt = 3 * half + k3;
                    const bf16x8 pb = pack8(sc[k3], ss);
                    const LAS unsigned char* vp = L + AT_V + r * 400 + (32 * kt + 16 * ss + 4 * hh) * 2;
                    const u32x2 a0 = *(const LAS u32x2*)vp, a1 = *(const LAS u32x2*)(vp + 16), b0 = *(const LAS u32x2*)(vp + 32 * 400), b1 = *(const LAS u32x2*)(vp + 32 * 400 + 16);
                    const u32x4 va = {a0[0], a0[1], a1[0], a1[1]}, vb = {b0[0], b0[1], b1[0], b1[1]};
                    o0 = MFMA32(__builtin_bit_cast(bf16x8, va), pb, o0); o1 = MFMA32(__builtin_bit_cast(bf16x8, vb), pb, o1);
                }
        }
        const float il = __builtin_amdgcn_rcpf(lrun);
        if (qok) {
#pragma unroll
            for (int qq = 0; qq < 4; ++qq) {
                { const int d = 8 * qq + 4 * hh; const u32x2 gb = gbr[2 * qq];
                  u32x2 yo; yo[0] = cvt2(o0[4 * qq] * il * siluf_(lo16(gb[0])), o0[4 * qq + 1] * il * siluf_(hi16(gb[0]))); yo[1] = cvt2(o0[4 * qq + 2] * il * siluf_(lo16(gb[1])), o0[4 * qq + 3] * il * siluf_(hi16(gb[1])));
                  *(u32x2*)(F.Y0() + m * D + 512 + hq * 64 + d) = yo; }
                { const int d = 32 + 8 * qq + 4 * hh; const u32x2 gb = gbr[2 * qq + 1];
                  u32x2 yo; yo[0] = cvt2(o1[4 * qq] * il * siluf_(lo16(gb[0])), o1[4 * qq + 1] * il * siluf_(hi16(gb[0]))); yo[1] = cvt2(o1[4 * qq + 2] * il * siluf_(lo16(gb[1])), o1[4 * qq + 3] * il * siluf_(hi16(gb[1])));
                  *(u32x2*)(F.Y0() + m * D + 512 + hq * 64 + d) = yo; }
            }
        }
    }
    __syncthreads();
}

constexpr int SG_A = 0, SG_B = 36864, SG_BUF = 36864 + 9216;
struct SOut { bf16_t* O0; int ld0; int split; bf16_t* O1; int ld1; };
__device__ __forceinline__ void sgemm_strip(Frame& F, const bf16_t* A, const bf16_t* Bt, const int K, const int n0, const SOut o, const int tid, const int lane, const int wave) {
    LAS unsigned char* L = F.lds;
    const int nkt = K / 64;
    const bf16_t* ap = A + (size_t)(tid >> 3) * K + (tid & 7) * 8;
    const bf16_t* bp = Bt + (size_t)(n0 + (tid >> 3)) * K + (tid & 7) * 8;
    const int lofs = (tid >> 3) * 144 + (tid & 7) * 16;
    u32x4 ra[4], rb, sa[4], sb;
#define SG_LOAD(RA, RB, kt) do { _Pragma("unroll") for (int i = 0; i < 4; ++i) RA[i] = *(const u32x4*)(ap + (size_t)i * 64 * K + (kt) * 64); RB = *(const u32x4*)(bp + (kt) * 64); } while (0)
#define SG_STORE(RA, RB, buf) do { _Pragma("unroll") for (int i = 0; i < 4; ++i) *(LAS u32x4*)(L + (buf) * SG_BUF + SG_A + lofs + i * 64 * 144) = RA[i]; *(LAS u32x4*)(L + (buf) * SG_BUF + SG_B + lofs) = RB; } while (0)
    SG_LOAD(ra, rb, 0); SG_LOAD(sa, sb, 1);
    SG_STORE(ra, rb, 0);
    SG_LOAD(ra, rb, (2 < nkt ? 2 : nkt - 1));
    f32x16 acc0, acc1;
#pragma unroll
    for (int e = 0; e < 16; ++e) { acc0[e] = 0.f; acc1[e] = 0.f; }
    const int r = lane & 31, hh = lane >> 5;
    LDS_BARRIER();
    for (int kt = 0; kt < nkt; kt += 2) {
#define SG_STEP(buf, RA, RB, knext) do { \
        const LAS unsigned char* Ab = L + (buf) * SG_BUF + SG_A + (32 * wave + r) * 144 + hh * 16; const LAS unsigned char* Bb = L + (buf) * SG_BUF + SG_B + r * 144 + hh * 16; \
        _Pragma("unroll") for (int ks = 0; ks < 4; ++ks) { const bf16x8 af = *(const LAS bf16x8*)(Ab + ks * 32), b0 = *(const LAS bf16x8*)(Bb + ks * 32), b1 = *(const LAS bf16x8*)(Bb + 32 * 144 + ks * 32); \
            acc0 = MFMA32(b0, af, acc0); acc1 = MFMA32(b1, af, acc1); } \
        SG_STORE(RA, RB, (buf) ^ 1); { const int kn = (knext) < nkt ? (knext) : nkt - 1; SG_LOAD(RA, RB, kn); } \
        LDS_BARRIER(); } while (0)
        SG_STEP(0, sa, sb, kt + 3);
        SG_STEP(1, ra, rb, kt + 4);
    }
#undef SG_STEP
#undef SG_LOAD
#undef SG_STORE
    const int row = 32 * wave + r; int colt = n0; bf16_t* base = o.O0; int ld = o.ld0;
    if (colt >= o.split) { base = o.O1; ld = o.ld1; colt -= o.split; }
    bf16_t* rowp = base + (size_t)row * ld + colt;
#pragma unroll
    for (int q = 0; q < 4; ++q) {
        u32x2 w0, w1; w0[0] = cvt2(acc0[4 * q], acc0[4 * q + 1]); w0[1] = cvt2(acc0[4 * q + 2], acc0[4 * q + 3]); w1[0] = cvt2(acc1[4 * q], acc1[4 * q + 1]); w1[1] = cvt2(acc1[4 * q + 2], acc1[4 * q + 3]);
        *(u32x2*)(rowp + 8 * q + 4 * hh) = w0; *(u32x2*)(rowp + 32 + 8 * q + 4 * hh) = w1; }
    LDS_BARRIER();
}
__device__ __forceinline__ void sgemm_phase(Frame& F, const bf16_t* A, const bf16_t* Bt, const int N, const int K, const SOut o, const int from) {
    const int nstrip = N / 64;
    for (int st = ((int)blockIdx.x - from + F.G) % F.G; st < nstrip; st += F.G) {
        const int tid = opaque_tid(F.wv);
        sgemm_strip(F, A, Bt, K, st * 64, o, tid, tid & 63, F.wv);
    }
}

__device__ __forceinline__ void rows_final(Frame& F, const int m0, const int n, const int s, const int lane) {
    const float* MODP = (const float*)(F.ws + WS_MODP);
    f32x4 A1[4];
#pragma unroll
    for (int j = 0; j < 4; ++j) { const int c = 4 * lane + 256 * j; const f32x4 g = *(const f32x4*)(F.in[27] + c), gt = mod4(MODP, 1, s, 2048 + c);
#pragma unroll
        for (int e = 0; e < 4; ++e) A1[j][e] = gt[e] * g[e]; }
    u32x2 ycur[4]; f32x4 xcur[4];
#pragma unroll
    for (int j = 0; j < 4; ++j) { ycur[j] = *(const u32x2*)(F.YO() + (size_t)m0 * D + 4 * lane + 256 * j); xcur[j] = *(const f32x4*)(F.out + O_Y + (size_t)m0 * D + 4 * lane + 256 * j); }
    for (int i = 0; i < n; ++i) {
        const int m = m0 + i, mn = m0 + (i + 1 < n ? i + 1 : i); u32x2 ynxt[4]; f32x4 xnxt[4];
#pragma unroll
        for (int j = 0; j < 4; ++j) { ynxt[j] = *(const u32x2*)(F.YO() + (size_t)mn * D + 4 * lane + 256 * j); xnxt[j] = *(const f32x4*)(F.out + O_Y + (size_t)mn * D + 4 * lane + 256 * j); }
        f32x4 y[4]; float ss = 0.f;
#pragma unroll
        for (int j = 0; j < 4; ++j) { y[j] = (f32x4){lo16(ycur[j][0]), hi16(ycur[j][0]), lo16(ycur[j][1]), hi16(ycur[j][1])}; ss += (y[j][0] * y[j][0] + y[j][1] * y[j][1]) + (y[j][2] * y[j][2] + y[j][3] * y[j][3]); }
        const float r1 = rsqrtf(wave_sum(ss, lane) * (1.f / D) + EPS);
#pragma unroll
        for (int j = 0; j < 4; ++j) { f32x4 o;
#pragma unroll
            for (int e = 0; e < 4; ++e) o[e] = xcur[j][e] + A1[j][e] * (y[j][e] * r1);
            *(f32x4*)(F.out + O_Y + (size_t)m * D + 4 * lane + 256 * j) = o; }
#pragma unroll
        for (int j = 0; j < 4; ++j) { ycur[j] = ynxt[j]; xcur[j] = xnxt[j]; }
    }
}
__device__ __forceinline__ void phase_final_rowwise(Frame& F) {
    PHASE_IDS();
    const int gw = F.vcu * 8 + wave, NGW = F.G * 8;
    for (int w = gw; w < MP / 16; w += NGW) rows_final(F, w * 16, 16, w >> 8, lane);
    for (int w = gw; w < MS; w += NGW) rows_final(F, MP + w, 1, BP + (w >> 4), lane);
}

__global__ void __launch_bounds__(512, 2) fwd_megakernel(Params P) {
    extern __shared__ __attribute__((aligned(16))) unsigned char lds_raw[];
    Frame F;
    F.lds = (LAS unsigned char*)lds_raw;
    F.wv = __builtin_amdgcn_readfirstlane(threadIdx.x >> 6);
    F.G = gridDim.x; { const int bx = blockIdx.x; F.vcu = (F.G % 8 == 0) ? (bx % 8) * (F.G / 8) + bx / 8 : bx; }
    F.in = P.in; F.out = P.out; F.ws = P.ws;

    volatile LAS unsigned* misc = (volatile LAS unsigned*)(F.lds + LDS_BYTES - 64);
    if (threadIdx.x < 16) misc[threadIdx.x] = 0u;
    __syncthreads();
    XcdBarrier xbar = xcd_barrier_post((unsigned*)(P.ws + WS_CTL), misc);
#define GRID_BAR() xcd_barrier(xbar, F.wv)
    phase_mod0(F);
    GRID_BAR();
    phase_prologue(F);
    phase_mod1(F);
    phase_prenorm0(F);
    GRID_BAR();
    { pg8::Gemm g{F.XN(), F.W0I(), MP, EV_IN, D}; pg8::StaticOrder S; S.init(MP, EV_IN, F.G, (int)blockIdx.x);
      pg8::EpiBf16 E{F.U0(), EV_IN, 1 << 30, F.U0(), EV_IN}; pg8::gemm_phase(F.lds, g, S, E, F.wv);
      sgemm_phase(F, F.XN() + (size_t)MP * D, F.W0I(), EV_IN, D, SOut{F.U0() + (size_t)MP * EV_IN, EV_IN, 1 << 30, nullptr, 0}, 128); }
    GRID_BAR();
    phase_rope(F);
    phase_lru<1>(F);
    phase_vt_build(F);
    GRID_BAR();
    phase_lru<2>(F);
    phase_attn(F);
    GRID_BAR();
    { pg8::Gemm g{F.Y0(), F.W0O(), MP, D, D}; pg8::StaticOrder S; S.init(MP, D, F.G, (int)blockIdx.x);
      pg8::EpiBf16 E{F.YO(), D, 1 << 30, F.YO(), D}; pg8::gemm_phase(F.lds, g, S, E, F.wv);
      sgemm_phase(F, F.Y0() + (size_t)MP * D, F.W0O(), D, D, SOut{F.YO() + (size_t)MP * D, D, 1 << 30, nullptr, 0}, 0); }
    GRID_BAR();
    phase_mid_rowwise(F);
    GRID_BAR();
    { pg8::Gemm g{F.XN(), F.W1I(), MP, OD_MAIN, D}; pg8::StaticOrder S; S.init(MP, OD_MAIN, F.G, (int)blockIdx.x);
      pg8::EpiBf16 E{F.QKV1(), 3072, 3072, F.Z1(), D}; pg8::gemm_phase(F.lds, g, S, E, F.wv);
      sgemm_phase(F, F.XN() + (size_t)MP * D, F.W1I(), OD_MAIN, D, SOut{F.QKV1() + (size_t)MP * 3072, 3072, 3072, F.Z1() + (size_t)MP * D, D}, 0); }
    GRID_BAR();
    phase_gdn_fused(F);
    GRID_BAR();
    { pg8::Gemm g{F.Y1(), F.W1O(), MP, D, D}; pg8::StaticOrder S; S.init(MP, D, F.G, (int)blockIdx.x);
      pg8::EpiBf16 E{F.YO(), D, 1 << 30, F.YO(), D}; pg8::gemm_phase(F.lds, g, S, E, F.wv);
      sgemm_phase(F, F.Y1() + (size_t)MP * D, F.W1O(), D, D, SOut{F.YO() + (size_t)MP * D, D, 1 << 30, nullptr, 0}, 0); }
    GRID_BAR();
    phase_final_rowwise(F);
}

extern "C" void kernel_launch(void* const* d_in, const int* in_sizes, int n_in, void* d_out, int out_size, void* d_ws, size_t ws_size, hipStream_t stream) {
    static int grid = 0;
    if (grid == 0) {
        if (n_in != 34 || out_size != (int)O_END || ws_size < WS_END) { grid = -1; return; }
        int dev = 0, cus = 0, per_cu = 0;
        if (hipGetDevice(&dev) != hipSuccess || hipDeviceGetAttribute(&cus, hipDeviceAttributeMultiprocessorCount, dev) != hipSuccess) { grid = -1; return; }
        if (hipFuncSetAttribute((const void*)fwd_megakernel, hipFuncAttributeMaxDynamicSharedMemorySize, LDS_BYTES) != hipSuccess) { grid = -1; return; }
        if (hipOccupancyMaxActiveBlocksPerMultiprocessor(&per_cu, (const void*)fwd_megakernel, 512, LDS_BYTES) != hipSuccess || per_cu < 1) { grid = -1; return; }
        grid = cus;
    }
    if (grid < 0) return;
    if (hipMemsetAsync((char*)d_ws + WS_CTL, 0, 65536 + 4224 * 64, stream) != hipSuccess) return;
    Params p{};
    for (int i = 0; i < 34; ++i) p.in[i] = (const float*)d_in[i];
    p.out = (float*)d_out; p.ws = (unsigned char*)d_ws;
    void* args[] = {&p};
    (void)hipLaunchCooperativeKernel((const void*)fwd_megakernel, dim3(grid), dim3(512), args, LDS_BYTES, stream);
}
```

```cpp
#include <hip/hip_runtime.h>
#include <hip/hip_cooperative_groups.h>
namespace cg = cooperative_groups;

#define LAS __attribute__((address_space(3)))
typedef unsigned short bf16_t;
typedef short bf16x8 __attribute__((ext_vector_type(8)));
typedef float f32x4 __attribute__((ext_vector_type(4)));
typedef float f32x2 __attribute__((ext_vector_type(2)));
typedef unsigned u32x4 __attribute__((ext_vector_type(4)));
typedef unsigned u32x2 __attribute__((ext_vector_type(2)));

constexpr int D = 1024, BP = 8, TP = 4096, BS = 16, TS = 16;
constexpr int MP = BP * TP, MS = BS * TS, MT = MP + MS;
constexpr int NSEQ = BP + BS;
constexpr int EV_IN = 2304, OD_IN = 4112, OD_MAIN = 4096;
constexpr int C_XA = 0, C_GA = 512, C_Q = 1024, C_K = 1536, C_V = 1664, C_GB = 1792;
constexpr float EPS = 1e-6f;
constexpr size_t O_Y = 0, O_LCP = 33816576, O_LCS = 33828864, O_LHP = 33853440, O_LHS = 33857536, O_KP = 33865728, O_KS = 33996800,
                 O_VP = 34029568, O_VS = 34160640, O_GCP = 34193408, O_GCS = 34267136, O_GSP = 34414592, O_GSS = 35463168, O_END = 37560320;
constexpr size_t MiB = 1u << 20;
constexpr size_t WS_CTL = 0, WS_W1O = 1 * MiB, WS_MOD = 3 * MiB, WS_ROPE = 4 * MiB, WS_BA = 5 * MiB, WS_LAG = 8 * MiB, WS_LGW = 10 * MiB;
constexpr size_t WS_RA = 16 * MiB, RA_BYTES = (size_t)MT * 4096 * 2;
constexpr size_t WS_RB = WS_RA + RA_BYTES;
constexpr size_t ACT_BYTES = (size_t)MT * D * 2;
constexpr size_t RB_XN = 0, RB_Y0 = ACT_BYTES, RB_YO = 2 * ACT_BYTES, RB_W0I = 3 * ACT_BYTES, RB_W0O = RB_W0I + (size_t)EV_IN * D * 2,
                 RB_W1I = RB_W0O + (size_t)D * D * 2, RB_WEND = RB_W1I + (size_t)OD_MAIN * D * 2;
constexpr size_t RB_BYTES = (size_t)4224 * 73728;
constexpr size_t WS_END = WS_RB + RB_BYTES;
static_assert(RB_WEND <= RB_BYTES, "ws map");
static_assert((size_t)MT * 3072 * 2 <= RB_BYTES, "ws map");
constexpr int LDS_BYTES = 155648;

struct Params { const float* in[34]; float* out; unsigned char* ws; };

__device__ __forceinline__ float bf2f(bf16_t b) { return __uint_as_float(((unsigned)b) << 16); }
__device__ __forceinline__ unsigned f2bf(float f) { unsigned u = __float_as_uint(f); return (u + 0x7fffu + ((u >> 16) & 1u)) >> 16; }
__device__ __forceinline__ unsigned pk2(float lo, float hi) { return f2bf(lo) | (f2bf(hi) << 16); }
typedef __bf16 bf16x2_t __attribute__((ext_vector_type(2)));
__device__ __forceinline__ unsigned cvt2(float a, float b) { f32x2 v = {a, b}; bf16x2_t r = __builtin_convertvector(v, bf16x2_t); return __builtin_bit_cast(unsigned, r); }
__device__ __forceinline__ float lo16(unsigned w) { return __uint_as_float(w << 16); }
__device__ __forceinline__ float hi16(unsigned w) { return __uint_as_float(w & 0xffff0000u); }
__device__ __forceinline__ float shfl_idx(float x, int src_lane) { return __int_as_float(__builtin_amdgcn_ds_bpermute(src_lane << 2, __float_as_int(x))); }
__device__ __forceinline__ float shfl_xor_l(float x, int o, int lane) { return shfl_idx(x, lane ^ o); }
__device__ __forceinline__ float wave_sum_b(float v, int lane) {
#pragma unroll
    for (int o = 1; o < 64; o <<= 1) v += shfl_xor_l(v, o, lane);
    return v;
}
#define DPP_ADD(v, ctrl, rmask) v += __int_as_float(__builtin_amdgcn_update_dpp(0, __float_as_int(v), (ctrl), (rmask), 0xf, false))
__device__ __forceinline__ float wave_sum(float v, int lane) {
    (void)lane;
    DPP_ADD(v, 0xB1, 0xf); DPP_ADD(v, 0x4E, 0xf); DPP_ADD(v, 0x141, 0xf); DPP_ADD(v, 0x140, 0xf);
    DPP_ADD(v, 0x142, 0xa); DPP_ADD(v, 0x143, 0xc);
    float r = __int_as_float(__builtin_amdgcn_readlane(__float_as_int(v), 63)); asm volatile("" : "+v"(r)); return r;
}
__device__ __forceinline__ float sigmoidf_(float x) { return __builtin_amdgcn_rcpf(1.0f + __expf(-x)); }
__device__ __forceinline__ float siluf_(float x) { return x * __builtin_amdgcn_rcpf(1.0f + __expf(-x)); }
__device__ __forceinline__ float softplusf_(float x) { return x > 20.f ? x : log1pf(__expf(x)); }
__device__ __forceinline__ int seq_base(int s) { return s < BP ? s * TP : MP + (s - BP) * TS; }
__device__ __forceinline__ int seq_len(int s) { return s < BP ? TP : TS; }
__device__ __forceinline__ void tok_info(int m, int& s, int& t) { if (m < MP) { s = m >> 12; t = m & 4095; } else { const int r = m - MP; s = BP + (r >> 4); t = r & 15; } }

__device__ __forceinline__ int opaque_tid(int wv) { unsigned z = 0u; asm volatile("" : "+v"(z)); const int l = __builtin_amdgcn_mbcnt_hi(~0u, __builtin_amdgcn_mbcnt_lo(~0u, z)); return wv * 64 + l; }
namespace pg8 {
constexpr int BM = 256, BK = 64, HALF = 128, HTB = HALF * BK * 2, STAGE_BYTES = 8 * HTB, NXCD = 8, WGM = 8;
__host__ __device__ __forceinline__ int lds_byte(int r, int c) { const int st = (r >> 4) * 2 + (c >> 5), rr = r & 15, cc = c & 31, ob = rr * 64 + cc * 2; return st * 1024 + (ob ^ (((ob >> 9) & 1) << 5)); }
__host__ __device__ __forceinline__ void stage_rc(int b, int& R, int& C) { const int st = b / 1024, sb = b % 1024, swz = sb ^ (((sb >> 9) & 1) << 5); R = (st >> 1) * 16 + swz / 64; C = (st & 1) * 32 + (swz % 64) / 2; }
__host__ __device__ __forceinline__ int perm32(int rho) { const int n = rho >> 4, i = rho & 15; return 8 * (i >> 2) + 4 * n + (i & 3); }
struct Unit { int pm, pn; };
struct Gemm { const bf16_t* A; const bf16_t* Bt; int M, N, K; };
struct StaticOrder {
    int nM, nN, nwg, G, c;
    __device__ void init(int M, int N, int G_, int c_) { nM = M / BM; nN = N / BM; nwg = nM * nN; G = G_; c = c_; }
    __device__ bool next(int i, Unit& u) const {
        const long L = (long)i * G + c; if (L >= nwg) return false;
        int wgid = (int)L; { const int q = nwg / NXCD, r = nwg % NXCD, xcd = wgid % NXCD, off = wgid / NXCD; wgid = (xcd < r ? xcd * (q + 1) : r * (q + 1) + (xcd - r) * q) + off; }
        const int nig = WGM * nN, gid = wgid / nig, fm = gid * WGM, gsz = (nM - fm) < WGM ? (nM - fm) : WGM;
        u.pm = fm + ((wgid % nig) % gsz); u.pn = (wgid % nig) / gsz; return true;
    }
};
__device__ __forceinline__ unsigned cvt_pk_bf16(float lo, float hi) { unsigned r; asm volatile("v_cvt_pk_bf16_f32 %0, %1, %2" : "=v"(r) : "v"(lo), "v"(hi)); return r; }
struct EpiBf16 {
    static constexpr bool PERM = true;
    bf16_t* O0; int ld0; int split; bf16_t* O1; int ld1;
    __device__ __forceinline__ void operator()(const f32x4 (&acc)[2][2][4][2], const Unit& u, int wr, int wc, int fr, int fq) const {
        const int row0 = u.pm * BM + wr * 64 + fr; int colt = u.pn * BM; bf16_t* base = O0; int ld = ld0;
        if (colt >= split) { base = O1; ld = ld1; colt -= split; }
        const int col0 = colt + wc * 32 + 8 * fq;
#pragma unroll
        for (int ai = 0; ai < 2; ++ai)
#pragma unroll
            for (int m = 0; m < 4; ++m) { bf16_t* rowp = base + (size_t)(row0 + ai * HALF + m * 16) * ld + col0;
#pragma unroll
                for (int bj = 0; bj < 2; ++bj) { const f32x4 v0 = acc[ai][bj][m][0], v1 = acc[ai][bj][m][1];
                    u32x4 w; w.x = cvt_pk_bf16(v0[0], v0[1]); w.y = cvt_pk_bf16(v0[2], v0[3]); w.z = cvt_pk_bf16(v1[0], v1[1]); w.w = cvt_pk_bf16(v1[2], v1[3]);
                    *(u32x4*)(rowp + bj * HALF) = w; } }
    }
};
template <class Epi, class Sched>
__device__ __forceinline__ void gemm_phase(LAS unsigned char* lds, const Gemm g, const Sched& S, const Epi& E, const int wv0) {
    int tid = opaque_tid(wv0);
    const int wid = __builtin_amdgcn_readfirstlane(tid >> 6), lane = tid & 63, wr = wid >> 2, wc = wid & 3, fr = lane & 15, fq = lane >> 4;
    const int K = g.K, nt = K / BK;
    unsigned voffA[2], voffB[2];
#pragma unroll
    for (int i = 0; i < 2; ++i) { int R, C; stage_rc(tid * 16 + i * 8192, R, C); const int Rb = Epi::PERM ? ((R & ~31) + perm32(R & 31)) : R;
        voffA[i] = (unsigned)(R * K + C) * 2u; voffB[i] = (unsigned)(Rb * K + C) * 2u; }
    const size_t kstep = (size_t)(BK * 2);
    const size_t hstep = (size_t)HALF * K * 2;
    const size_t tstep = 2 * hstep;
    const unsigned ldsw = (unsigned)wid * 1024u;
    const int aoff = lds_byte(wr * 64 + fr, fq * 8), boff = lds_byte(wc * 32 + fr, fq * 8);
#define PG8_SA(b, h) (((b) * 2 + (h)) * HTB)
#define PG8_SB(b, h) ((4 + (b) * 2 + (h)) * HTB)
#define PG8_STAGE(bufoff, gbase, voff) do { _Pragma("unroll") for (int _i = 0; _i < 2; ++_i) \
        __builtin_amdgcn_global_load_lds((const unsigned*)((const char*)(gbase) + (voff)[_i]), (LAS unsigned*)(lds + (bufoff) + ldsw + _i * 8192), 16, 0, 0); } while (0)
#define PG8_LDA(dst, b, h) do { _Pragma("unroll") for (int m = 0; m < 4; ++m) _Pragma("unroll") for (int k = 0; k < 2; ++k) dst[m][k] = *(const LAS bf16x8*)(lds + PG8_SA(b, h) + aoff + m * 2048 + k * 1024); } while (0)
#define PG8_LDB(dst, b, h) do { _Pragma("unroll") for (int n = 0; n < 2; ++n) _Pragma("unroll") for (int k = 0; k < 2; ++k) dst[n][k] = *(const LAS bf16x8*)(lds + PG8_SB(b, h) + boff + n * 2048 + k * 1024); } while (0)
#define PG8_MMA(ai, bj, At, Bt) do { __builtin_amdgcn_s_setprio(1); _Pragma("unroll") for (int m = 0; m < 4; ++m) _Pragma("unroll") for (int n = 0; n < 2; ++n) _Pragma("unroll") for (int k = 0; k < 2; ++k) \
        acc[ai][bj][m][n] = __builtin_amdgcn_mfma_f32_16x16x32_bf16(Bt[n][k], At[m][k], acc[ai][bj][m][n], 0, 0, 0); __builtin_amdgcn_s_setprio(0); } while (0)
#define PG8_WAIT_V(n) asm volatile("s_waitcnt vmcnt(" #n ")" ::: "memory")
#define PG8_WAIT_L(n) asm volatile("s_waitcnt lgkmcnt(" #n ")" ::: "memory")
#define PG8_BAR __builtin_amdgcn_s_barrier()
#define PG8_SCHED __builtin_amdgcn_sched_barrier(0)
    Unit cur, nxt; int ui = 0;
    if (!S.next(0, cur)) return;
    f32x4 acc[2][2][4][2];
#pragma unroll
    for (int a = 0; a < 2; ++a)
#pragma unroll
        for (int b = 0; b < 2; ++b)
#pragma unroll
            for (int m = 0; m < 4; ++m)
#pragma unroll
                for (int n = 0; n < 2; ++n) acc[a][b][m][n] = (f32x4){0.f, 0.f, 0.f, 0.f};
    bf16x8 At[4][2], B0[2][2], B1[2][2];
    const char* cA = (const char*)g.A + (size_t)cur.pm * tstep; const char* cB = (const char*)g.Bt + (size_t)cur.pn * tstep;
    PG8_STAGE(PG8_SB(0, 0), cB, voffB); PG8_STAGE(PG8_SA(0, 0), cA, voffA); PG8_STAGE(PG8_SB(0, 1), cB + hstep, voffB); PG8_STAGE(PG8_SA(0, 1), cA + hstep, voffA);
    if (wr == 1) PG8_BAR;
    PG8_WAIT_V(4); PG8_BAR;
    PG8_STAGE(PG8_SB(1, 0), cB + kstep, voffB); PG8_STAGE(PG8_SA(1, 0), cA + kstep, voffA); PG8_STAGE(PG8_SB(1, 1), cB + hstep + kstep, voffB);
    PG8_WAIT_V(6); PG8_BAR;
    for (;;) {
        const bool has_next = S.next(ui + 1, nxt);
        const char* nA = has_next ? (const char*)g.A + (size_t)nxt.pm * tstep : cA; const char* nB = has_next ? (const char*)g.Bt + (size_t)nxt.pn * tstep : cB;
        for (int t = 0; t < nt; t += 2) {
            const bool last = (t == nt - 2);
            const char* a1 = cA + (size_t)(t + 1) * kstep;
            const char* a2 = last ? nA : cA + (size_t)(t + 2) * kstep; const char* b2 = last ? nB : cB + (size_t)(t + 2) * kstep;
            const char* a3 = a2 + kstep; const char* b3 = b2 + kstep;
            PG8_LDB(B0, 0, 0); PG8_SCHED; PG8_LDA(At, 0, 0); PG8_STAGE(PG8_SA(1, 1), a1 + hstep, voffA);
            PG8_WAIT_L(8); PG8_BAR; PG8_WAIT_L(0); PG8_MMA(0, 0, At, B0); PG8_BAR; PG8_SCHED;
            PG8_LDB(B1, 0, 1); PG8_STAGE(PG8_SB(0, 0), b2, voffB);
            PG8_BAR; PG8_WAIT_L(0); PG8_MMA(0, 1, At, B1); PG8_BAR;
            PG8_LDA(At, 0, 1); PG8_STAGE(PG8_SA(0, 0), a2, voffA);
            PG8_BAR; PG8_WAIT_L(0); PG8_MMA(1, 0, At, B0); PG8_BAR; PG8_SCHED;
            PG8_STAGE(PG8_SB(0, 1), b2 + hstep, voffB);
            PG8_WAIT_V(6); PG8_BAR; PG8_MMA(1, 1, At, B1); PG8_BAR;
            PG8_LDB(B0, 1, 0); PG8_SCHED; PG8_LDA(At, 1, 0); PG8_STAGE(PG8_SA(0, 1), a2 + hstep, voffA);
            PG8_WAIT_L(8); PG8_BAR; PG8_WAIT_L(0); PG8_MMA(0, 0, At, B0); PG8_BAR; PG8_SCHED;
            PG8_LDB(B1, 1, 1); PG8_STAGE(PG8_SB(1, 0), b3, voffB);
            PG8_BAR; PG8_WAIT_L(0); PG8_MMA(0, 1, At, B1); PG8_BAR;
            PG8_LDA(At, 1, 1); PG8_STAGE(PG8_SA(1, 0), a3, voffA);
            PG8_BAR; PG8_WAIT_L(0); PG8_MMA(1, 0, At, B0); PG8_BAR; PG8_SCHED;
            PG8_STAGE(PG8_SB(1, 1), b3 + hstep, voffB);
            PG8_WAIT_V(6); PG8_BAR; PG8_MMA(1, 1, At, B1); PG8_BAR;
        }
        E(acc, cur, wr, wc, fr, fq);
        if (!has_next) break;
#pragma unroll
        for (int a = 0; a < 2; ++a)
#pragma unroll
            for (int b = 0; b < 2; ++b)
#pragma unroll
                for (int m = 0; m < 4; ++m)
#pragma unroll
                    for (int n = 0; n < 2; ++n) acc[a][b][m][n] = (f32x4){0.f, 0.f, 0.f, 0.f};
        cur = nxt; cA = nA; cB = nB; ++ui;
    }
    PG8_WAIT_V(0);
    if (wr == 0) PG8_BAR;
    PG8_BAR;
#undef PG8_SA
#undef PG8_SB
#undef PG8_STAGE
#undef PG8_LDA
#undef PG8_LDB
#undef PG8_MMA
#undef PG8_WAIT_V
#undef PG8_WAIT_L
#undef PG8_BAR
#undef PG8_SCHED
}
}


#define XB_TMO      128
#define XB_XCNT(j)  (256  + 64 * (j))
#define XB_XSUB(j)  (1280 + 64 * (j))
#define XB_XGEN(j)  (2304 + 64 * (j))
#define XB_TOP      3328
#define XB_TOPGEN   3392
#define XCD_BAR_WORDS 3456
#define XB_SPIN_CAP (1u << 18)
__device__ __forceinline__ unsigned xb_ld(unsigned* p)              { return __hip_atomic_load(p, __ATOMIC_RELAXED, __HIP_MEMORY_SCOPE_AGENT); }
__device__ __forceinline__ unsigned xb_add(unsigned* p, unsigned v) { return __hip_atomic_fetch_add(p, v, __ATOMIC_RELAXED, __HIP_MEMORY_SCOPE_AGENT); }
__device__ __forceinline__ unsigned xb_xcc_id() { return (unsigned)__builtin_amdgcn_s_getreg((3 << 11) | 20) & 0xFu; }
#define XB_SPIN(cond, bar) do { unsigned _sp = 0; while (cond) { __builtin_amdgcn_s_sleep(1); \
    if ((++_sp & 255u) == 0u) { if (xb_ld(&(bar)[XB_TMO])) break; if (_sp > XB_SPIN_CAP) { atomicAdd(&(bar)[XB_TMO], 1u); break; } } } } while (0)
struct XcdBarrier { unsigned* bar; unsigned x; volatile LAS unsigned* st; };
__device__ __forceinline__ XcdBarrier xcd_barrier_post(unsigned* bar, volatile LAS unsigned* st) {
    XcdBarrier b; b.bar = bar; b.x = xb_xcc_id(); b.st = st;
    if (threadIdx.x == 0) (void)xb_add(&bar[XB_XCNT(b.x)], 1u);
    return b;
}
__device__ __forceinline__ void xcd_barrier_complete(unsigned* bar, unsigned x, unsigned& nloc, unsigned& nx) {
    const unsigned G = gridDim.x * gridDim.y * gridDim.z;
    unsigned sum, cnt, mine, sp = 0u;
    for (;;) {
        sum = 0u; cnt = 0u; mine = 0u;
#pragma unroll
        for (unsigned j = 0; j < 16; ++j) { const unsigned c = xb_ld(&bar[XB_XCNT(j)]); sum += c; cnt += (c > 0u) ? 1u : 0u; mine = (j == x) ? c : mine; }
        if (sum == G) break;
        __builtin_amdgcn_s_sleep(1);
        if ((++sp & 255u) == 0u) { if (xb_ld(&bar[XB_TMO])) break; if (sp > XB_SPIN_CAP) { atomicAdd(&bar[XB_TMO], 1u); break; } }
    }
    nloc = mine > 0u ? mine : 1u; nx = cnt > 0u ? cnt : 1u;
}
__device__ __forceinline__ void xcd_barrier(const XcdBarrier& b, const int wv0) {
    asm volatile("s_waitcnt vmcnt(0)" ::: "memory");
    __syncthreads();
    if (opaque_tid(wv0) == 0) {
        unsigned* bar = b.bar;
        __builtin_amdgcn_s_waitcnt(0);
        unsigned nloc = b.st[0], nx = b.st[1];
        if (nloc == 0u) { xcd_barrier_complete(bar, b.x, nloc, nx); b.st[0] = nloc; b.st[1] = nx; }
        const unsigned old = xb_add(&bar[XB_XSUB(b.x)], 1u);
        const unsigned gen = old / nloc;
        if (old + 1u == (gen + 1u) * nloc) {
            __builtin_amdgcn_fence(__ATOMIC_RELEASE, "agent");
            asm volatile("s_waitcnt vmcnt(0)" ::: "memory");
            const unsigned og = xb_add(&bar[XB_TOP], 1u);
            const unsigned tg = og / nx;
            if (og + 1u == (tg + 1u) * nx) xb_add(&bar[XB_TOPGEN], 1u);
            else XB_SPIN(xb_ld(&bar[XB_TOPGEN]) == tg, bar);
            __builtin_amdgcn_fence(__ATOMIC_ACQUIRE, "agent");
            xb_add(&bar[XB_XGEN(b.x)], 1u);
            asm volatile("s_waitcnt vmcnt(0)" ::: "memory");
        } else {
            XB_SPIN(xb_ld(&bar[XB_XGEN(b.x)]) == gen, bar);
            __builtin_amdgcn_fence(__ATOMIC_ACQUIRE, "agent");
            asm volatile("s_waitcnt vmcnt(0)" ::: "memory");
        }
    }
    __syncthreads();
}

struct Frame {
    LAS unsigned char* lds;
    int vcu, G, wv;
    const float* const* in; float* out; unsigned char* ws;
    __device__ __forceinline__ float* MOD() const { return (float*)(ws + WS_MOD); }
    __device__ __forceinline__ float* ROPE() const { return (float*)(ws + WS_ROPE); }
    __device__ __forceinline__ float* BA() const { return (float*)(ws + WS_BA); }
    __device__ __forceinline__ float* LAG() const { return (float*)(ws + WS_LAG); }
    __device__ __forceinline__ bf16_t* W1O() const { return (bf16_t*)(ws + WS_W1O); }
    __device__ __forceinline__ bf16_t* U0() const { return (bf16_t*)(ws + WS_RA); }
    __device__ __forceinline__ bf16_t* QKV1() const { return (bf16_t*)(ws + WS_RA); }
    __device__ __forceinline__ bf16_t* Z1() const { return (bf16_t*)(ws + WS_RA + (size_t)MT * 3072 * 2); }
    __device__ __forceinline__ bf16_t* Y1() const { return (bf16_t*)(ws + WS_RA + (size_t)MT * 3072 * 2); }
    __device__ __forceinline__ bf16_t* XN() const { return (bf16_t*)(ws + WS_RB + RB_XN); }
    __device__ __forceinline__ bf16_t* Y0() const { return (bf16_t*)(ws + WS_RB + RB_Y0); }
    __device__ __forceinline__ bf16_t* YO() const { return (bf16_t*)(ws + WS_RB + RB_YO); }
    __device__ __forceinline__ bf16_t* W0I() const { return (bf16_t*)(ws + WS_RB + RB_W0I); }
    __device__ __forceinline__ bf16_t* W0O() const { return (bf16_t*)(ws + WS_RB + RB_W0O); }
    __device__ __forceinline__ bf16_t* W1I() const { return (bf16_t*)(ws + WS_RB + RB_W1I); }
    __device__ __forceinline__ bf16_t* QKVC() const { return (bf16_t*)(ws + WS_RB); }
};

#define PHASE_IDS() int tid = opaque_tid(F.wv); const int lane = tid & 63, wave = __builtin_amdgcn_readfirstlane(tid >> 6); (void)lane; (void)wave
__device__ __forceinline__ void p0_transpose_item(const float* W, int ldw, int nblk, int K, bf16_t* WT, LAS float* scr, int item, int lane) {
    const int kb = item / nblk, nb = item % nblk, k0 = 64 * kb, n0 = 32 * nb;
    f32x4 v[8];
#pragma unroll
    for (int i = 0; i < 8; ++i) v[i] = *(const f32x4*)(W + (size_t)(k0 + 8 * i + (lane >> 3)) * ldw + n0 + 4 * (lane & 7));
#pragma unroll
    for (int i = 0; i < 8; ++i) { LAS float* d = scr + (8 * i + (lane >> 3)) * 33 + 4 * (lane & 7); d[0] = v[i][0]; d[1] = v[i][1]; d[2] = v[i][2]; d[3] = v[i][3]; }
    asm volatile("s_waitcnt lgkmcnt(0)" ::: "memory");
    const int c = lane & 7;
#pragma unroll
    for (int j = 0; j < 4; ++j) { const int n = (lane >> 3) + 8 * j; const LAS float* s = scr + (8 * c) * 33 + n;
        u32x4 o; o.x = pk2(s[0 * 33], s[1 * 33]); o.y = pk2(s[2 * 33], s[3 * 33]); o.z = pk2(s[4 * 33], s[5 * 33]); o.w = pk2(s[6 * 33], s[7 * 33]);
        *(u32x4*)(WT + (size_t)(n0 + n) * K + k0 + 8 * c) = o; }
    asm volatile("s_waitcnt lgkmcnt(0)" ::: "memory");
}
constexpr size_t WS_MODP = 12 * MiB;
__device__ __forceinline__ f32x4 mod4(const float* MODP, int L, int s, int off) {
    f32x4 a = *(const f32x4*)(MODP + ((size_t)((L * 4 + 0) * 24 + s)) * 3072 + off);
#pragma unroll
    for (int sl = 1; sl < 4; ++sl) a += *(const f32x4*)(MODP + ((size_t)((L * 4 + sl) * 24 + s)) * 3072 + off);
    return a;
}
__device__ __forceinline__ void mod_task(Frame& F, const int bt, const int tid, const int lane, const int wave) {
    const int L = bt / 192, sl = (bt % 192) / 48, n0 = (bt % 48) * 64, kb = sl * 256;
    LAS float* tab = (LAS float*)F.lds;
    {   float cv[12];
#pragma unroll
        for (int u = 0; u < 12; ++u) { const int idx = tid + 512 * u, s = idx >> 8, k = kb + (idx & 255); cv[u] = s < BP ? F.in[8][s * D + k] : F.in[9][(s - BP) * D + k]; }
#pragma unroll
        for (int u = 0; u < 12; ++u) { const int idx = tid + 512 * u, s = idx >> 8, k = idx & 255; tab[k * 24 + s] = siluf_(cv[u]); } }
    __syncthreads();
    const float* mw = (L == 0 ? F.in[10] : F.in[24]) + n0 + lane;
    float acc[24];
#pragma unroll
    for (int r = 0; r < 24; ++r) acc[r] = 0.f;
    for (int k0 = wave * 32; k0 < wave * 32 + 32; k0 += 16) {
        float wv[16];
#pragma unroll
        for (int u = 0; u < 16; ++u) wv[u] = mw[(size_t)(kb + k0 + u) * 3072];
#pragma unroll
        for (int u = 0; u < 16; ++u) { const float w = wv[u];
            const LAS f32x4* tp = (const LAS f32x4*)(tab + (k0 + u) * 24);
#pragma unroll
            for (int q = 0; q < 6; ++q) { const f32x4 t4 = tp[q]; acc[4 * q] += t4[0] * w; acc[4 * q + 1] += t4[1] * w; acc[4 * q + 2] += t4[2] * w; acc[4 * q + 3] += t4[3] * w; } }
    }
    __syncthreads();
    LAS float* red = (LAS float*)F.lds;
#pragma unroll
    for (int r = 0; r < 24; ++r) red[(wave * 24 + r) * 64 + lane] = acc[r];
    __syncthreads();
    const float* mb = (L == 0 ? F.in[11] : F.in[25]);
    float* MODP = (float*)(F.ws + WS_MODP);
    for (int idx = tid; idx < 24 * 64; idx += 512) { const int r = idx >> 6, l = idx & 63; float s = 0.f;
#pragma unroll
        for (int w = 0; w < 8; ++w) s += red[(w * 24 + r) * 64 + l];
        MODP[((size_t)((L * 4 + sl) * 24 + r)) * 3072 + n0 + l] = s + (sl == 0 ? mb[n0 + l] : 0.f); }
    __syncthreads();
}
__device__ __forceinline__ void phase_mod0(Frame& F) {
    PHASE_IDS();
    for (int bt = F.vcu; bt < 192; bt += F.G) { int t2 = tid; asm volatile("" : "+v"(t2)); mod_task(F, bt, t2, t2 & 63, wave); }
}
__device__ __forceinline__ void phase_mod1(Frame& F) {
    PHASE_IDS();
    __syncthreads();
    for (int bt = 192 + F.vcu; bt < 384; bt += F.G) { int t2 = tid; asm volatile("" : "+v"(t2)); mod_task(F, bt, t2, t2 & 63, wave); }
}
__device__ __forceinline__ void phase_prologue(Frame& F) {
    PHASE_IDS();
    const int gw = F.vcu * 8 + wave, NGW = F.G * 8;
    {
        LAS float* scr = (LAS float*)(F.lds + wave * 16384);
        constexpr int I0 = 16 * (EV_IN / 32), I1 = 16 * 32, I2 = 16 * (OD_MAIN / 32), I3 = 16 * 32;
        for (int it = gw; it < I0 + I1 + I2 + I3; it += NGW) {
            int r = it;
            if (r < I0) { p0_transpose_item(F.in[14], EV_IN, EV_IN / 32, D, F.W0I(), scr, r, lane); continue; } r -= I0;
            if (r < I1) { p0_transpose_item(F.in[23], D, 32, D, F.W0O(), scr, r, lane); continue; } r -= I1;
            if (r < I2) { p0_transpose_item(F.in[28], OD_IN, OD_MAIN / 32, D, F.W1I(), scr, r, lane); continue; } r -= I2;
            p0_transpose_item(F.in[33], D, 32, D, F.W1O(), scr, r, lane);
        }
    }
    {
        const double inv[8] = {1.0, 0.19392274474868576, 0.03760603093086393, 0.007292664737217109, 0.001414213562373095, 0.0002742481756762073, 5.318295896944988e-05, 1.031338537721246e-05};
        for (int idx = F.vcu * 512 + tid; idx < 4112 * 8; idx += F.G * 512) {
            const int pos = idx >> 3, i = idx & 7;
            double iv = inv[0];
#pragma unroll
            for (int q = 1; q < 8; ++q) iv = (i == q) ? inv[q] : iv;
            const double ang = (double)pos * iv;
            const double n = __builtin_rint(ang * 0.15915494309189535);
            const float r = (float)__builtin_fma(-n, 6.283185307179586, ang);
            F.ROPE()[pos * 16 + i] = __cosf(r); F.ROPE()[pos * 16 + 8 + i] = __sinf(r);
        }
    }
    {
        bf16_t* LGW = (bf16_t*)(F.ws + WS_LGW);
        for (int idx = F.vcu * 512 + tid; idx < 8 * 2 * 64 * 64; idx += F.G * 512) { const int k = idx & 63, n = (idx >> 6) & 63, gate = (idx >> 12) & 1, hh = idx >> 13;
            LGW[idx] = (bf16_t)f2bf((gate ? F.in[19] : F.in[17])[(hh * 64 + k) * 64 + n]); }
    }
}

__device__ __forceinline__ const float* x_row(Frame& F, int m) { return m < MP ? F.in[0] + (size_t)m * D : F.in[1] + (size_t)(m - MP) * D; }
__device__ __forceinline__ void rows_prenorm0(Frame& F, const int m0, const int n, const int s, const int lane) {
    const float* MODP = (const float*)(F.ws + WS_MODP);
    f32x4 A[4], C[4];
#pragma unroll
    for (int j = 0; j < 4; ++j) { const int c = 4 * lane + 256 * j; const f32x4 g = *(const f32x4*)(F.in[12] + c), sc = mod4(MODP, 0, s, 1024 + c); C[j] = mod4(MODP, 0, s, c);
#pragma unroll
        for (int e = 0; e < 4; ++e) A[j][e] = g[e] * (1.f + sc[e]); }
    f32x4 cur[4];
#pragma unroll
    for (int j = 0; j < 4; ++j) cur[j] = *(const f32x4*)(x_row(F, m0) + 4 * lane + 256 * j);
    for (int i = 0; i < n; ++i) {
        const int mn = m0 + (i + 1 < n ? i + 1 : i); f32x4 nxt[4];
#pragma unroll
        for (int j = 0; j < 4; ++j) nxt[j] = *(const f32x4*)(x_row(F, mn) + 4 * lane + 256 * j);
        float ss = 0.f;
#pragma unroll
        for (int j = 0; j < 4; ++j) ss += (cur[j][0] * cur[j][0] + cur[j][1] * cur[j][1]) + (cur[j][2] * cur[j][2] + cur[j][3] * cur[j][3]);
        const float r = rsqrtf(wave_sum(ss, lane) * (1.f / D) + EPS);
#pragma unroll
        for (int j = 0; j < 4; ++j) { u32x2 w; w[0] = cvt2(cur[j][0] * r * A[j][0] + C[j][0], cur[j][1] * r * A[j][1] + C[j][1]); w[1] = cvt2(cur[j][2] * r * A[j][2] + C[j][2], cur[j][3] * r * A[j][3] + C[j][3]);
            *(u32x2*)(F.XN() + (size_t)(m0 + i) * D + 4 * lane + 256 * j) = w; }
#pragma unroll
        for (int j = 0; j < 4; ++j) cur[j] = nxt[j];
    }
}
__device__ __forceinline__ void phase_prenorm0(Frame& F) {
    PHASE_IDS();
    const int gw = F.vcu * 8 + wave, NGW = F.G * 8;
    for (int w = gw; w < MP / 16; w += NGW) rows_prenorm0(F, w * 16, 16, w >> 8, lane);
    for (int w = gw; w < MS; w += NGW) rows_prenorm0(F, MP + w, 1, BP + (w >> 4), lane);
}

__device__ __forceinline__ void phase_rope(Frame& F) {
    PHASE_IDS();
    const int gt = F.vcu * 512 + tid, NT = F.G * 512;
    for (int idx = gt; idx < MT * 10; idx += NT) {
        const int m = idx / 10, slot = idx % 10;
        int s, t; tok_info(m, s, t);
        const int pos = s < BP ? t : TP + t;
        const int col = slot < 8 ? C_Q + slot * 64 : C_K + (slot - 8) * 64;
        u32x4* p = (u32x4*)(F.U0() + (size_t)m * EV_IN + col);
        const u32x4 xa = p[0], xb = p[1];
        const f32x4* rp = (const f32x4*)(F.ROPE() + pos * 16); const f32x4 c0 = rp[0], c1 = rp[1], s0 = rp[2], s1 = rp[3];
        float x1[8], x2[8], o1[8], o2[8];
#pragma unroll
        for (int e = 0; e < 4; ++e) { x1[2 * e] = lo16(xa[e]); x1[2 * e + 1] = hi16(xa[e]); x2[2 * e] = lo16(xb[e]); x2[2 * e + 1] = hi16(xb[e]); }
#pragma unroll
        for (int i = 0; i < 8; ++i) { const float c = i < 4 ? c0[i & 3] : c1[i & 3], sn = i < 4 ? s0[i & 3] : s1[i & 3]; o1[i] = x1[i] * c - x2[i] * sn; o2[i] = x2[i] * c + x1[i] * sn; }
        u32x4 ya, yb;
#pragma unroll
        for (int e = 0; e < 4; ++e) { ya[e] = cvt2(o1[2 * e], o1[2 * e + 1]); yb[e] = cvt2(o2[2 * e], o2[2 * e + 1]); }
        p[0] = ya; p[1] = yb;
        if (slot >= 8) { const int kv = slot - 8; float* o = nullptr;
            if (s >= BP) o = F.out + O_KS + ((size_t)((s - BP) * TS + t) * 2 + kv) * 64;
            else if (t >= TP - 128) o = F.out + O_KP + ((size_t)(s * 128 + (t - (TP - 128))) * 2 + kv) * 64;
            if (o) { *(f32x4*)o = (f32x4){o1[0], o1[1], o1[2], o1[3]}; *(f32x4*)(o + 4) = (f32x4){o1[4], o1[5], o1[6], o1[7]}; *(f32x4*)(o + 8) = (f32x4){o2[0], o2[1], o2[2], o2[3]}; *(f32x4*)(o + 12) = (f32x4){o2[4], o2[5], o2[6], o2[7]}; } }
    }
    for (int idx = gt; idx < 1280 * 224; idx += NT) {
        const int tk = idx / 224, e = idx % 224;
        int s, t, m; if (tk < 1024) { s = tk >> 7; t = TP - 128 + (tk & 127); m = s * TP + t; } else { s = BP + ((tk - 1024) >> 4); t = (tk - 1024) & 15; m = MP + (tk - 1024); }
        const bool isv = e >= 96; const int e2 = isv ? e - 96 : e; const int kv = isv ? (e2 >> 6) : (e2 / 48), d = isv ? (e2 & 63) : 16 + (e2 % 48);
        const float val = bf2f(F.U0()[(size_t)m * EV_IN + (isv ? C_V : C_K) + kv * 64 + d]);
        const size_t ob = s >= BP ? (isv ? O_VS : O_KS) + ((size_t)((s - BP) * TS + t) * 2 + kv) * 64 : (isv ? O_VP : O_KP) + ((size_t)(s * 128 + (t - (TP - 128))) * 2 + kv) * 64;
        F.out[ob + d] = val;
    }
}


#define MFMA32(a, b, c) __builtin_amdgcn_mfma_f32_32x32x16_bf16((a), (b), (c), 0, 0, 0)
#define MFMA16(a, b, c) __builtin_amdgcn_mfma_f32_16x16x32_bf16((a), (b), (c), 0, 0, 0)
typedef __amdgpu_buffer_rsrc_t brsrc_t;
__device__ __forceinline__ brsrc_t staging_rsrc(unsigned char* ws) { return __builtin_amdgcn_make_buffer_rsrc((void*)(ws + WS_RB), (short)0, (int)RB_BYTES, 0x00020000); }
__device__ __forceinline__ void st16_wt(brsrc_t r, unsigned off, u32x4 v) { __builtin_amdgcn_raw_buffer_store_b128(v, r, off, 0, 16); }
__device__ __forceinline__ u32x4 ld16_wt(brsrc_t r, unsigned off) { return __builtin_amdgcn_raw_buffer_load_b128(r, off, 0, 16); }
__device__ __forceinline__ void rows_mid(Frame& F, const LAS unsigned char* bawb, const int m0, const int n, const int s, const int lane) {
    const float* MODP = (const float*)(F.ws + WS_MODP);
    f32x4 A0[4], B1[4], C1[4];
#pragma unroll
    for (int j = 0; j < 4; ++j) { const int c = 4 * lane + 256 * j; const f32x4 g0 = *(const f32x4*)(F.in[13] + c), gt = mod4(MODP, 0, s, 2048 + c), g1 = *(const f32x4*)(F.in[26] + c), sc = mod4(MODP, 1, s, 1024 + c);
        C1[j] = mod4(MODP, 1, s, c);
#pragma unroll
        for (int e = 0; e < 4; ++e) { A0[j][e] = gt[e] * g0[e]; B1[j][e] = g1[e] * (1.f + sc[e]); } }
    u32x2 ycur[4]; f32x4 xcur[4];
#pragma unroll
    for (int j = 0; j < 4; ++j) { ycur[j] = *(const u32x2*)(F.YO() + (size_t)m0 * D + 4 * lane + 256 * j); xcur[j] = *(const f32x4*)(x_row(F, m0) + 4 * lane + 256 * j); }
    for (int i = 0; i < n; ++i) {
        const int m = m0 + i, mn = m0 + (i + 1 < n ? i + 1 : i); u32x2 ynxt[4]; f32x4 xnxt[4];
#pragma unroll
        for (int j = 0; j < 4; ++j) { ynxt[j] = *(const u32x2*)(F.YO() + (size_t)mn * D + 4 * lane + 256 * j); xnxt[j] = *(const f32x4*)(x_row(F, mn) + 4 * lane + 256 * j); }
        f32x4 y[4]; float ss = 0.f;
#pragma unroll
        for (int j = 0; j < 4; ++j) { y[j] = (f32x4){lo16(ycur[j][0]), hi16(ycur[j][0]), lo16(ycur[j][1]), hi16(ycur[j][1])}; ss += (y[j][0] * y[j][0] + y[j][1] * y[j][1]) + (y[j][2] * y[j][2] + y[j][3] * y[j][3]); }
        const float r1 = rsqrtf(wave_sum(ss, lane) * (1.f / D) + EPS);
        f32x4 x1[4]; float s2 = 0.f;
#pragma unroll
        for (int j = 0; j < 4; ++j) {
#pragma unroll
            for (int e = 0; e < 4; ++e) x1[j][e] = xcur[j][e] + A0[j][e] * (y[j][e] * r1);
            *(f32x4*)(F.out + O_Y + (size_t)m * D + 4 * lane + 256 * j) = x1[j];
            s2 += (x1[j][0] * x1[j][0] + x1[j][1] * x1[j][1]) + (x1[j][2] * x1[j][2] + x1[j][3] * x1[j][3]); }
        const float r2 = rsqrtf(wave_sum(s2, lane) * (1.f / D) + EPS);
        f32x4 hm[4];
#pragma unroll
        for (int j = 0; j < 4; ++j) {
#pragma unroll
            for (int e = 0; e < 4; ++e) hm[j][e] = x1[j][e] * r2 * B1[j][e] + C1[j][e];
            u32x2 w; w[0] = cvt2(hm[j][0], hm[j][1]); w[1] = cvt2(hm[j][2], hm[j][3]); *(u32x2*)(F.XN() + (size_t)m * D + 4 * lane + 256 * j) = w; }
#pragma unroll
        for (int j = 0; j < 4; ++j) { ycur[j] = ynxt[j]; xcur[j] = xnxt[j]; }
    }
    asm volatile("s_waitcnt vmcnt(0)" ::: "memory");
    {   const brsrc_t rs = staging_rsrc(F.ws);
        const int r = lane & 15, g = lane >> 4;
        const unsigned abase = (unsigned)RB_XN + (unsigned)(m0 + (r < n ? r : 0)) * (unsigned)(D * 2) + (unsigned)g * 16u;
        f32x4 acc = {0.f, 0.f, 0.f, 0.f};
#pragma unroll
        for (int h = 0; h < 2; ++h) { u32x4 a[16];
#pragma unroll
            for (int k = 0; k < 16; ++k) a[k] = ld16_wt(rs, abase + (unsigned)(h * 16 + k) * 64u);
#pragma unroll
            for (int k = 0; k < 16; ++k) acc = MFMA16(__builtin_bit_cast(bf16x8, a[k]), *(const LAS bf16x8*)(bawb + ((h * 16 + k) * 64 + lane) * 16), acc); }
        const int hh = r & 7; const float ea = -__expf(F.in[30][hh]), db = F.in[31][hh];
#pragma unroll
        for (int e = 0; e < 4; ++e) { const int row = 4 * g + e; if (row < n) F.BA()[(size_t)(m0 + row) * 16 + r] = r < 8 ? sigmoidf_(acc[e]) : ea * softplusf_(acc[e] + db); }
    }
}
__device__ __forceinline__ void phase_mid_rowwise(Frame& F) {
    PHASE_IDS();
    LAS unsigned char* bawb = F.lds;
    for (int idx = tid; idx < 32 * 64; idx += 512) { const int kk = idx >> 6, l = idx & 63, c = l & 15, g = l >> 4; const float* wp = F.in[28] + (size_t)(32 * kk + 8 * g) * OD_IN + OD_MAIN + c;
        u32x4 w; w[0] = cvt2(wp[0], wp[OD_IN]); w[1] = cvt2(wp[2 * OD_IN], wp[3 * OD_IN]); w[2] = cvt2(wp[4 * OD_IN], wp[5 * OD_IN]); w[3] = cvt2(wp[6 * OD_IN], wp[7 * OD_IN]);
        *(LAS u32x4*)(bawb + idx * 16) = w; }
    __syncthreads();
    const int gw = F.vcu * 8 + wave, NGW = F.G * 8;
    for (int w = gw; w < MP / 16; w += NGW) rows_mid(F, bawb, w * 16, 16, w >> 8, lane);
    for (int w = gw; w < MS; w += NGW) rows_mid(F, bawb, MP + w, 1, BP + (w >> 4), lane);
}


typedef float f32x16 __attribute__((ext_vector_type(16)));
constexpr int GS_WF = 0, GS_QF = 16384, GS_KF = 32768, GS_PF = 49152, GS_UF = 57344, GS_BYTES = 73728;
constexpr size_t WS_DEC = 11 * MiB;
__device__ __forceinline__ int krow(int s, int h, int j) { return 16 * s + 8 * (j >> 2) + 4 * h + (j & 3); }

__device__ __forceinline__ void st8_wt(unsigned char* p, u32x2 v) { __hip_atomic_store((unsigned long long*)p, ((unsigned long long)v[1] << 32) | v[0], __ATOMIC_RELAXED, __HIP_MEMORY_SCOPE_AGENT); }
constexpr size_t WS_READY = 65536;
#define LDS_BARRIER() do { asm volatile("s_waitcnt lgkmcnt(0)" ::: "memory"); __builtin_amdgcn_s_barrier(); asm volatile("" ::: "memory"); } while (0)
constexpr int G1_QS = 0, G1_KS = 17408, G1_VS = 34816, G1_AS = 52224, G1_PS = 69632, G1_WS = 78848, G1_CW = 96256, G1_VEC = 102400, G1_ES = 103424;
__device__ __forceinline__ void g1_load_raw(Frame& F, u32x4 (&raw)[24], int s, int c, int h, int t1) {
    const int r = t1 >> 3, j = t1 & 7, t = c * 64 + r;
#pragma unroll
    for (int p = 0; p < 3; ++p)
#pragma unroll
        for (int jj = 0; jj < 4; ++jj) { const int tt = t - 3 + jj, ttc = tt < 0 ? 0 : tt;
            const u32x4* src = (const u32x4*)(F.QKV1() + (size_t)(s * TP + ttc) * 3072 + p * 1024 + h * 128 + j * 16); raw[p * 8 + jj * 2] = src[0]; raw[p * 8 + jj * 2 + 1] = src[1]; }
}
__device__ __forceinline__ bf16x8 g1_pack_b(const f32x4 p, const f32x4 q) { u32x4 w; w[0] = cvt2(p[0], p[1]); w[1] = cvt2(p[2], p[3]); w[2] = cvt2(q[0], q[1]); w[3] = cvt2(q[2], q[3]); return __builtin_bit_cast(bf16x8, w); }
__device__ __forceinline__ void g1_decode(int n, int& s, int& c, int& h) { if (n < 4096) { c = n >> 6; s = (n & 63) >> 3; h = n & 7; } else { s = BP + ((n - 4096) >> 3); c = 0; h = n & 7; } }
constexpr int P2_SET = 52224, P2_Q = 0, P2_K = 17408, P2_V = 34816;
constexpr int P2_AS = 2 * P2_SET, P2_PS = P2_AS + 17408, P2_ES = P2_PS + 9216, P2_CW = P2_ES + 4096, P2_VEC = P2_CW + 6144;
static_assert(P2_VEC + 2048 <= LDS_BYTES - 64, "producer LDS map");
__device__ __forceinline__ void p2_load_part(Frame& F, u32x4 (&rw)[16], int s, int c, int h, int p, int tb) {
    const int r = tb >> 3, j = tb & 7;
#pragma unroll
    for (int it = 0; it < 2; ++it)
#pragma unroll
        for (int jj = 0; jj < 4; ++jj) { int tt = c * 64 + r + 32 * it - 3 + jj; tt = tt < 0 ? 0 : tt;
            const u32x4* src = (const u32x4*)(F.QKV1() + (size_t)(s * TP + tt) * 3072 + p * 1024 + h * 128 + j * 16); rw[it * 8 + jj * 2] = src[0]; rw[it * 8 + jj * 2 + 1] = src[1]; }
}
__device__ __forceinline__ void p2_conv_item(Frame& F, const u32x4 (&rw)[16], const int it, const f32x4 (&wreg)[16], const int p, const int j, const int lane, const bool ok, float* state_out, LAS u32x4* dst) {
    float acc[16];
#pragma unroll
    for (int e = 0; e < 16; ++e) acc[e] = 0.f;
#pragma unroll
    for (int jj = 0; jj < 4; ++jj) {
        const u32x4 a = rw[it * 8 + jj * 2], b = rw[it * 8 + jj * 2 + 1]; float x[16];
#pragma unroll
        for (int e = 0; e < 4; ++e) { x[2 * e] = lo16(a[e]); x[2 * e + 1] = hi16(a[e]); x[8 + 2 * e] = lo16(b[e]); x[8 + 2 * e + 1] = hi16(b[e]); }
#pragma unroll
        for (int q = 0; q < 4; ++q) { const f32x4 w4 = wreg[jj * 4 + q]; acc[4 * q] += w4[0] * x[4 * q]; acc[4 * q + 1] += w4[1] * x[4 * q + 1]; acc[4 * q + 2] += w4[2] * x[4 * q + 2]; acc[4 * q + 3] += w4[3] * x[4 * q + 3]; }
        if (jj == 3 && state_out) {
#pragma unroll
            for (int q = 0; q < 4; ++q) *(f32x4*)(state_out + 4 * q) = (f32x4){x[4 * q], x[4 * q + 1], x[4 * q + 2], x[4 * q + 3]}; }
    }
    float ss = 0.f;
#pragma unroll
    for (int e = 0; e < 16; ++e) { acc[e] = siluf_(acc[e]); ss += acc[e] * acc[e]; }
    if (p < 2) { ss += shfl_xor_l(ss, 1, lane); ss += shfl_xor_l(ss, 2, lane); ss += shfl_xor_l(ss, 4, lane);
        float sc = __builtin_amdgcn_rsqf(ss + EPS); if (p == 0) sc *= 0.08838834764831845f;
#pragma unroll
        for (int e = 0; e < 16; ++e) acc[e] *= sc; }
    u32x4 w0, w1;
#pragma unroll
    for (int e = 0; e < 4; ++e) { w0[e] = ok ? cvt2(acc[2 * e], acc[2 * e + 1]) : 0u; w1[e] = ok ? cvt2(acc[8 + 2 * e], acc[8 + 2 * e + 1]) : 0u; }
    dst[0] = w0; dst[1] = w1;
}
__device__ __forceinline__ void gdn_g1_tasks(Frame& F, const int first, const int stride) {
    LAS unsigned char* L = F.lds;
    LAS float* cw_s = (LAS float*)(L + P2_CW);
    float* DEC = (float*)(F.ws + WS_DEC);
    const brsrc_t srs = staging_rsrc(F.ws);
    unsigned* ready = (unsigned*)(F.ws + WS_READY);
    const int wave = F.wv;
    const bool grpB = wave >= 4;
    int ntask = 0; for (int t = first; t < 4224; t += stride) ++ntask;
    u32x4 rwA[16]; float pcw[6];
    if (grpB) {
        const int tb = opaque_tid(wave) - 256; int s0, c0, h0; g1_decode(first < 4095 ? first : 4095, s0, c0, h0);
        p2_load_part(F, rwA, s0, c0, h0, 0, tb);
#pragma unroll
        for (int q = 0; q < 6; ++q) { const int i = tb + 256 * q, jj = i / 384, cc = i % 384; pcw[q] = F.in[29][(size_t)jj * 3072 + (cc >> 7) * 1024 + h0 * 128 + (cc & 127)]; }
#pragma unroll
        for (int q = 0; q < 6; ++q) cw_s[tb + 256 * q] = pcw[q];
    }
    LDS_BARRIER();
    for (int i = 0; i <= ntask; ++i) {
        const int tid = opaque_tid(wave), lane = tid & 63;
        const int taskB = first + i * stride, taskA = taskB - stride;
        const bool actB = grpB && i < ntask, actA = !grpB && i >= 1;
        int s = 0, c = 0, h = 0; g1_decode(grpB ? (i < ntask ? taskB : 4095) : (i >= 1 ? taskA : 0), s, c, h);
        const int task = grpB ? taskB : taskA;
        const int sidx = task < 4096 ? ((s * 8 + h) * 64 + c) : task;
        const int nvalid = s < BP ? 64 : TS, t0 = c * 64, base = seq_base(s), T = seq_len(s);
        LAS unsigned char* Sb = L + (grpB ? (i & 1) : ((i - 1) & 1)) * P2_SET;
        LAS float* vec = (LAS float*)(L + P2_VEC + (grpB ? (i & 1) : ((i - 1) & 1)) * 1024); LAS float* beta_s = vec; LAS float* gcum_s = vec + 64; LAS float* eg_s = vec + 128; LAS float* ek_s = vec + 192;
        unsigned char* blk = F.ws + WS_RB + (size_t)sidx * GS_BYTES; const unsigned boff = (unsigned)sidx * (unsigned)GS_BYTES;
        float gvb = 0.f, gva = 0.f; int gs = 0, gc = 0, gh = 0; const bool gact = (wave == 3) && i < ntask;
        if (gact) { g1_decode(taskB, gs, gc, gh); if (lane < (gs < BP ? 64 : TS)) { const float* ba = F.BA() + (size_t)(seq_base(gs) + gc * 64 + lane) * 16; gvb = ba[gh]; gva = ba[8 + gh]; } }
        const int tb = tid - 256, rB = tb >> 3, jB = tb & 7;
#define P2_PART(p, rw) do { if (actB) { \
            if (s >= BP) { _Pragma("unroll") for (int it = 0; it < 2; ++it) _Pragma("unroll") for (int jj = 0; jj < 4; ++jj) { const int r_ = rB + 32 * it, tt = r_ - 3 + jj; u32x4 a_ = {0u, 0u, 0u, 0u}, b_ = {0u, 0u, 0u, 0u}; \
                    if (r_ < nvalid) { const int cb_ = (p) * 1024 + h * 128 + jB * 16; \
                        if (tt >= 0) { const u32x4* src = (const u32x4*)(F.QKV1() + (size_t)(base + tt) * 3072 + cb_); a_ = src[0]; b_ = src[1]; } \
                        else { const f32x4* src = (const f32x4*)(F.in[6] + ((size_t)(s - BP) * 3 + (tt + 3)) * 3072 + cb_); const f32x4 f0 = src[0], f1 = src[1], f2 = src[2], f3 = src[3]; \
                            a_[0] = cvt2(f0[0], f0[1]); a_[1] = cvt2(f0[2], f0[3]); a_[2] = cvt2(f1[0], f1[1]); a_[3] = cvt2(f1[2], f1[3]); b_[0] = cvt2(f2[0], f2[1]); b_[1] = cvt2(f2[2], f2[3]); b_[2] = cvt2(f3[0], f3[1]); b_[3] = cvt2(f3[2], f3[3]); } } \
                    rw[it * 8 + jj * 2] = a_; rw[it * 8 + jj * 2 + 1] = b_; } } \
            else if (t0 == 0 && rB < 3) { _Pragma("unroll") for (int jj = 0; jj < 3; ++jj) if (rB - 3 + jj < 0) { rw[jj * 2] = (u32x4){0u, 0u, 0u, 0u}; rw[jj * 2 + 1] = (u32x4){0u, 0u, 0u, 0u}; } } \
            f32x4 wreg_[16]; _Pragma("unroll") for (int jj = 0; jj < 4; ++jj) _Pragma("unroll") for (int q = 0; q < 4; ++q) wreg_[jj * 4 + q] = *(const LAS f32x4*)(cw_s + jj * 384 + (p) * 128 + jB * 16 + 4 * q);   \
            _Pragma("unroll") for (int it = 0; it < 2; ++it) { const int r_ = rB + 32 * it, t_ = t0 + r_; const bool ok_ = r_ < nvalid; \
                float* so_ = (ok_ && t_ >= T - 3) ? ((s < BP ? F.out + O_GCP + ((size_t)s * 3 + (t_ - (T - 3))) * 3072 : F.out + O_GCS + ((size_t)(s - BP) * 3 + (t_ - (T - 3))) * 3072) + (p) * 1024 + h * 128 + jB * 16) : nullptr; \
                p2_conv_item(F, rw, it, wreg_, (p), jB, lane, ok_, so_, (LAS u32x4*)(Sb + ((p) == 0 ? P2_Q : (p) == 1 ? P2_K : P2_V) + r_ * 272 + jB * 32)); } } } while (0)
        if (grpB) {
            P2_PART(0, rwA);
            if (actB && s < BP) p2_load_part(F, rwA, s, c, h, 1, tb);
        } else if (actA) {
            int l2 = lane; asm volatile("" : "+v"(l2));
            const int r = l2 & 31, hh = l2 >> 5;
#pragma unroll
            for (int half = 0; half < 2; ++half) {
                const int tile8 = wave + 4 * half, which = tile8 >> 2, ti = (tile8 >> 1) & 1, tj = tile8 & 1;
                f32x16 acc;
#pragma unroll
                for (int e = 0; e < 16; ++e) acc[e] = 0.f;
                if (!(ti == 0 && tj == 1)) {
                    const LAS unsigned char* ap = Sb + (which ? P2_Q : P2_K) + (32 * ti + r) * 272 + hh * 16;
                    const LAS unsigned char* bp = Sb + P2_K + (32 * tj + r) * 272 + hh * 16;
#pragma unroll
                    for (int ks = 0; ks < 8; ++ks) { const bf16x8 a = *(const LAS bf16x8*)(ap + ks * 32), b = *(const LAS bf16x8*)(bp + ks * 32); acc = MFMA32(a, b, acc); }
                }
                const int jc = 32 * tj + r; const float gj = gcum_s[jc];
#pragma unroll
                for (int e = 0; e < 16; ++e) {
                    const int ii = 32 * ti + (e & 3) + 8 * (e >> 2) + 4 * hh; const float dg = gcum_s[ii] - gj;
                    if (which == 0) { const float f = (ii > jc) ? __expf(dg) * beta_s[ii] : 0.f; *(LAS float*)(L + P2_AS + ii * 272 + jc * 4) = acc[e] * f; }
                    else { const float f = (ii >= jc) ? __expf(dg) : 0.f; *(LAS bf16_t*)(L + P2_PS + ii * 144 + jc * 2) = (bf16_t)(cvt2(acc[e] * f, 0.f) & 0xffffu); }
                }
            }
        }
        LDS_BARRIER();
        if (grpB) {
            P2_PART(1, rwA);
            if (actB && s < BP) p2_load_part(F, rwA, s, c, h, 2, tb);
        } else if (actA) {
            int l3 = lane; asm volatile("" : "+v"(l3));
            if (wave == 0) {
                const int bk = l3 >> 4, col = l3 & 15;
                float tcol[16];
#pragma unroll
                for (int rr = 0; rr < 16; ++rr) {
                    float a = (rr == col) ? 1.0f : 0.f;
#pragma unroll
                    for (int j4 = 0; j4 < (rr + 3) / 4; ++j4) { const f32x4 a4 = *(const LAS f32x4*)(L + P2_AS + (16 * bk + rr) * 272 + (16 * bk + 4 * j4) * 4);
#pragma unroll
                        for (int q = 0; q < 4; ++q) if (4 * j4 + q < rr) a -= a4[q] * tcol[4 * j4 + q]; }
                    tcol[rr] = a;
                    *(LAS float*)(L + P2_ES + ((bk * 16 + rr) * 16 + col) * 4) = a - ((rr == col) ? 1.0f : 0.f);
                }
            } else {
                const int r = l3 & 31, hh = l3 >> 5;
                if (wave == 1) {
#pragma unroll
                    for (int rt4 = 0; rt4 < 4; ++rt4)
#pragma unroll
                        for (int kt2 = 0; kt2 < 2; ++kt2)
#pragma unroll
                            for (int ss = 0; ss < 2; ++ss) { float v[8];
#pragma unroll
                                for (int j = 0; j < 8; ++j) { const int tok = 32 * kt2 + krow(ss, hh, j); v[j] = bf2f(*(const LAS bf16_t*)(Sb + P2_K + tok * 272 + (32 * rt4 + r) * 2)) * ek_s[tok]; }
                                u32x4 o; o[0] = cvt2(v[0], v[1]); o[1] = cvt2(v[2], v[3]); o[2] = cvt2(v[4], v[5]); o[3] = cvt2(v[6], v[7]);
                                st16_wt(srs, boff + GS_KF + ((rt4 * 2 + kt2) * 2 + ss) * 1024 + l3 * 16, o); }
                } else if (wave == 2) {
#pragma unroll
                    for (int kt = 0; kt < 4; ++kt)
#pragma unroll
                        for (int rt = 0; rt < 2; ++rt)
#pragma unroll
                            for (int ss = 0; ss < 2; ++ss) { const int ii = 32 * rt + r; const float sc = eg_s[ii];
                                const u32x2 lo = *(const LAS u32x2*)(Sb + P2_Q + ii * 272 + (32 * kt + 16 * ss + 4 * hh) * 2), hi = *(const LAS u32x2*)(Sb + P2_Q + ii * 272 + (32 * kt + 16 * ss + 8 + 4 * hh) * 2);
                                u32x4 o; o[0] = cvt2(lo16(lo[0]) * sc, hi16(lo[0]) * sc); o[1] = cvt2(lo16(lo[1]) * sc, hi16(lo[1]) * sc); o[2] = cvt2(lo16(hi[0]) * sc, hi16(hi[0]) * sc); o[3] = cvt2(lo16(hi[1]) * sc, hi16(hi[1]) * sc);
                                st16_wt(srs, boff + GS_QF + ((rt * 4 + kt) * 2 + ss) * 1024 + l3 * 16, o); }
                } else {
#pragma unroll
                    for (int rt = 0; rt < 2; ++rt)
#pragma unroll
                        for (int kt2 = 0; kt2 < 2; ++kt2)
#pragma unroll
                            for (int ss = 0; ss < 2; ++ss) { const int ii = 32 * rt + r;
                                const u32x2 lo = *(const LAS u32x2*)(L + P2_PS + ii * 144 + (32 * kt2 + 16 * ss + 4 * hh) * 2), hi = *(const LAS u32x2*)(L + P2_PS + ii * 144 + (32 * kt2 + 16 * ss + 8 + 4 * hh) * 2);
                                u32x4 o; o[0] = lo[0]; o[1] = lo[1]; o[2] = hi[0]; o[3] = hi[1];
                                st16_wt(srs, boff + GS_PF + ((rt * 2 + kt2) * 2 + ss) * 1024 + l3 * 16, o); }
                }
            }
        }
        LDS_BARRIER();
        if (grpB) {
            P2_PART(2, rwA);
        } else if (actA) {
            int l4 = lane; asm volatile("" : "+v"(l4));
            const int c16 = l4 & 15, g = l4 >> 4;
            const f32x4 z4 = {0.f, 0.f, 0.f, 0.f};
            f32x4 a10, a20, a21, a30, a31, a32, e0, e1, e2, e3;
            { const LAS unsigned char* ar = L + P2_AS + c16 * 272 + (4 * g) * 4;
              a10 = *(const LAS f32x4*)(ar + 16 * 272); a20 = *(const LAS f32x4*)(ar + 32 * 272); a21 = *(const LAS f32x4*)(ar + 32 * 272 + 64);
              a30 = *(const LAS f32x4*)(ar + 48 * 272); a31 = *(const LAS f32x4*)(ar + 48 * 272 + 64); a32 = *(const LAS f32x4*)(ar + 48 * 272 + 128);
              const LAS unsigned char* er = L + P2_ES + (c16 * 16 + 4 * g) * 4;
              e0 = *(const LAS f32x4*)er; e1 = *(const LAS f32x4*)(er + 1024); e2 = *(const LAS f32x4*)(er + 2048); e3 = *(const LAS f32x4*)(er + 3072); }
            const bf16x8 fA10 = g1_pack_b(z4 - a10, z4), fA2 = g1_pack_b(z4 - a20, z4 - a21), fA3a = g1_pack_b(z4 - a30, z4 - a31), fA3b = g1_pack_b(z4 - a32, z4);
            const bf16x8 fE0 = g1_pack_b(e0, z4), fE1 = g1_pack_b(e1, z4), fE2 = g1_pack_b(e2, z4), fE3 = g1_pack_b(e3, z4);
#pragma unroll
            for (int tl = 0; tl < 4; ++tl) {
                const int t16 = 4 * wave + tl; const bool isw = t16 < 8; const int d = 16 * (t16 & 7) + c16;
                f32x4 R[4];
#pragma unroll
                for (int ib = 0; ib < 4; ++ib)
#pragma unroll
                    for (int e = 0; e < 4; ++e) { const int row = 16 * ib + 4 * g + e; const float raw1 = bf2f(*(const LAS bf16_t*)(Sb + (isw ? P2_K : P2_V) + row * 272 + d * 2)); R[ib][e] = raw1 * beta_s[row] * (isw ? eg_s[row] : 1.0f); }
                const f32x4 X0 = MFMA16(fE0, g1_pack_b(R[0], z4), R[0]);
                const f32x4 Y1 = MFMA16(fA10, g1_pack_b(X0, z4), R[1]);
                const f32x4 X1 = MFMA16(fE1, g1_pack_b(Y1, z4), Y1);
                const f32x4 Y2 = MFMA16(fA2, g1_pack_b(X0, X1), R[2]);
                const f32x4 X2 = MFMA16(fE2, g1_pack_b(Y2, z4), Y2);
                f32x4 Y3 = MFMA16(fA3a, g1_pack_b(X0, X1), R[3]);
                Y3 = MFMA16(fA3b, g1_pack_b(X2, z4), Y3);
                const f32x4 X3 = MFMA16(fE3, g1_pack_b(Y3, z4), Y3);
                const f32x4 X[4] = {X0, X1, X2, X3};
                if (isw) {
#pragma unroll
                    for (int ib = 0; ib < 4; ++ib)
#pragma unroll
                        for (int e = 0; e < 4; ++e) *(LAS bf16_t*)(Sb + P2_Q + (16 * ib + 4 * g + e) * 272 + d * 2) = (bf16_t)(cvt2(-X[ib][e], 0.f) & 0xffffu);
                } else {
                    const int ws = d >> 5, cc = d & 31;
#pragma unroll
                    for (int ib = 0; ib < 4; ++ib) { const int rt = ib >> 1, q = 2 * (ib & 1) + (g >> 1), hh = g & 1;
                        u32x2 o; o[0] = cvt2(X[ib][0], X[ib][1]); o[1] = cvt2(X[ib][2], X[ib][3]);
                        st8_wt(blk + GS_UF + (size_t)(((ws * 2 + rt) * 64) + cc + 32 * hh) * 32 + q * 8, o); }
                }
            }
        }
        LDS_BARRIER();
        if (grpB) {
            { const int ntk = taskB + stride < 4224 ? taskB + stride : 4223; int s1, c1, h1; g1_decode(ntk, s1, c1, h1);
#pragma unroll
              for (int q = 0; q < 6; ++q) { const int ii = tb + 256 * q, jj = ii / 384, cc = ii % 384; pcw[q] = F.in[29][(size_t)jj * 3072 + (cc >> 7) * 1024 + h1 * 128 + (cc & 127)]; }
              const int ntp = ntk < 4095 ? ntk : 4095; int s2, c2, h2; g1_decode(ntp, s2, c2, h2);
              p2_load_part(F, rwA, s2, c2, h2, 0, tb);
#pragma unroll
              for (int q = 0; q < 6; ++q) cw_s[tb + 256 * q] = pcw[q]; }
        } else if (actA) {
            int l5 = lane; asm volatile("" : "+v"(l5));
            const int kt = wave, r = l5 & 31, hh = l5 >> 5;
#pragma unroll
            for (int rt = 0; rt < 2; ++rt)
#pragma unroll
                for (int ss = 0; ss < 2; ++ss) { const int ii = 32 * rt + r;
                    const u32x2 lo = *(const LAS u32x2*)(Sb + P2_Q + ii * 272 + (32 * kt + 16 * ss + 4 * hh) * 2), hi = *(const LAS u32x2*)(Sb + P2_Q + ii * 272 + (32 * kt + 16 * ss + 8 + 4 * hh) * 2);
                    u32x4 o; o[0] = lo[0]; o[1] = lo[1]; o[2] = hi[0]; o[3] = hi[1];
                    st16_wt(srs, boff + GS_WF + ((rt * 4 + kt) * 2 + ss) * 1024 + l5 * 16, o); }
            asm volatile("s_waitcnt vmcnt(0)" ::: "memory");
        }
        if (gact) {
            LAS float* gv = (LAS float*)(L + P2_VEC + (i & 1) * 1024);
            const bool ok = lane < (gs < BP ? 64 : TS); float x = ok ? gva : 0.f;
#pragma unroll
            for (int o = 1; o < 64; o <<= 1) { const float y = shfl_idx(x, lane >= o ? lane - o : lane); if (lane >= o) x += y; }
            const float gl = shfl_idx(x, 63);
            gv[lane] = ok ? gvb : 0.f; gv[64 + lane] = x; gv[128 + lane] = __expf(x); gv[192 + lane] = ok ? __expf(gl - x) : 0.f;
            const int gsidx = taskB < 4096 ? ((gs * 8 + gh) * 64 + gc) : taskB;
            if (lane == 0) __hip_atomic_store((unsigned*)DEC + gsidx, __float_as_uint(__expf(gl)), __ATOMIC_RELAXED, __HIP_MEMORY_SCOPE_AGENT);
        }
        LDS_BARRIER();
        if (tid == 0 && i >= 1) __hip_atomic_store(ready + 16 * sidx, 1u, __ATOMIC_RELAXED, __HIP_MEMORY_SCOPE_AGENT);
#undef P2_PART
    }
}

constexpr int G2_FB = GS_BYTES, G2_OSTRIDE = 528, G2_HN = 2 * G2_FB, G2_DEC = G2_HN + 512;
__device__ __forceinline__ bf16x8 pack8(const f32x16& x, const int s) {
    u32x4 p; p[0] = cvt2(x[8 * s], x[8 * s + 1]); p[1] = cvt2(x[8 * s + 2], x[8 * s + 3]); p[2] = cvt2(x[8 * s + 4], x[8 * s + 5]); p[3] = cvt2(x[8 * s + 6], x[8 * s + 7]);
    return __builtin_bit_cast(bf16x8, p);
}
template <bool WT>
__device__ __forceinline__ void g2_load_set(u32x4 (&pre)[18], float& dpre, const unsigned char* blk, int lt, brsrc_t srs, unsigned boff, const unsigned* flag, const float* decp) {
    if (WT) { unsigned sp = 0; while (__builtin_amdgcn_readfirstlane(__hip_atomic_load(flag, __ATOMIC_RELAXED, __HIP_MEMORY_SCOPE_AGENT)) == 0u && ++sp < (1u << 20)) __builtin_amdgcn_s_sleep(4);
        dpre = __uint_as_float(__hip_atomic_load((const unsigned*)decp, __ATOMIC_RELAXED, __HIP_MEMORY_SCOPE_AGENT));
#pragma unroll
        for (int i = 0; i < 18; ++i) pre[i] = ld16_wt(srs, boff + (unsigned)(i * 256 + lt) * 16u);
    } else { const u32x4* src = (const u32x4*)blk; dpre = *decp;
#pragma unroll
        for (int i = 0; i < 18; ++i) pre[i] = src[i * 256 + lt]; }
}
__device__ __forceinline__ void g2_store_set(const u32x4 (&pre)[18], LAS unsigned char* dst, int lt) {
#pragma unroll
    for (int i = 0; i < 18; ++i) *(LAS u32x4*)(dst + (size_t)(i * 256 + lt) * 16) = pre[i];
}
#define G2_FRAG(off) (*(const LAS bf16x8*)(B + (off)))
#define G2_SCHED() __builtin_amdgcn_sched_barrier(0)
__device__ __forceinline__ void g2_mfma_step(f32x16& S0, f32x16& S1, f32x16& S2, f32x16& S3, LAS unsigned char* Bimg, const float dec, int ws, int lane, int cc, int hh) {
    const LAS unsigned char* B = Bimg + lane * 16;
    f32x16 vn0, vn1, o0, o1;
    { const LAS u32x4* up = (const LAS u32x4*)(Bimg + GS_UF + (size_t)(ws * 2 * 64 + lane) * 32); const u32x4 u0 = up[0], u1 = up[1], u2 = up[128], u3 = up[129];
#pragma unroll
      for (int q = 0; q < 4; ++q) { vn0[2 * q] = lo16(u0[q]); vn0[2 * q + 1] = hi16(u0[q]); vn0[8 + 2 * q] = lo16(u1[q]); vn0[8 + 2 * q + 1] = hi16(u1[q]);
                                    vn1[2 * q] = lo16(u2[q]); vn1[2 * q + 1] = hi16(u2[q]); vn1[8 + 2 * q] = lo16(u3[q]); vn1[8 + 2 * q + 1] = hi16(u3[q]); } }
#pragma unroll
    for (int e = 0; e < 16; ++e) { o0[e] = 0.f; o1[e] = 0.f; }
#define G2_WQ(Sx, kt) do { _Pragma("unroll") for (int ss = 0; ss < 2; ++ss) { const bf16x8 sb = pack8(Sx, ss); \
        const bf16x8 fw0 = G2_FRAG(GS_WF + ((0 * 4 + kt) * 2 + ss) * 1024), fw1 = G2_FRAG(GS_WF + ((1 * 4 + kt) * 2 + ss) * 1024); \
        const bf16x8 fq0 = G2_FRAG(GS_QF + ((0 * 4 + kt) * 2 + ss) * 1024), fq1 = G2_FRAG(GS_QF + ((1 * 4 + kt) * 2 + ss) * 1024); \
        vn0 = MFMA32(fw0, sb, vn0); vn1 = MFMA32(fw1, sb, vn1); o0 = MFMA32(fq0, sb, o0); o1 = MFMA32(fq1, sb, o1); } } while (0)
    G2_WQ(S0, 0); G2_WQ(S1, 1); G2_WQ(S2, 2); G2_WQ(S3, 3);
#undef G2_WQ
    bf16x8 vb[2][2];
    vb[0][0] = pack8(vn0, 0); vb[0][1] = pack8(vn0, 1); vb[1][0] = pack8(vn1, 0); vb[1][1] = pack8(vn1, 1);
#pragma unroll
    for (int kt2 = 0; kt2 < 2; ++kt2)
#pragma unroll
        for (int ss = 0; ss < 2; ++ss) { o0 = MFMA32(G2_FRAG(GS_PF + ((0 * 2 + kt2) * 2 + ss) * 1024), vb[kt2][ss], o0); o1 = MFMA32(G2_FRAG(GS_PF + ((1 * 2 + kt2) * 2 + ss) * 1024), vb[kt2][ss], o1); }
    S0 = S0 * dec; S1 = S1 * dec; S2 = S2 * dec; S3 = S3 * dec;
#pragma unroll
    for (int kt2 = 0; kt2 < 2; ++kt2)
#pragma unroll
        for (int ss = 0; ss < 2; ++ss) {
            S0 = MFMA32(G2_FRAG(GS_KF + ((0 * 2 + kt2) * 2 + ss) * 1024), vb[kt2][ss], S0); S1 = MFMA32(G2_FRAG(GS_KF + ((1 * 2 + kt2) * 2 + ss) * 1024), vb[kt2][ss], S1);
            S2 = MFMA32(G2_FRAG(GS_KF + ((2 * 2 + kt2) * 2 + ss) * 1024), vb[kt2][ss], S2); S3 = MFMA32(G2_FRAG(GS_KF + ((3 * 2 + kt2) * 2 + ss) * 1024), vb[kt2][ss], S3); }
    LDS_BARRIER();
#pragma unroll
    for (int e = 0; e < 16; ++e) { const int rr = (e & 3) + 8 * (e >> 2) + 4 * hh;
        *(LAS float*)(Bimg + rr * G2_OSTRIDE + (32 * ws + cc) * 4) = o0[e]; *(LAS float*)(Bimg + (32 + rr) * G2_OSTRIDE + (32 * ws + cc) * 4) = o1[e]; }
    LDS_BARRIER();
}
__device__ __forceinline__ void g2_epi16(Frame& F, LAS unsigned char* L, const LAS unsigned char* Oimg, const u32x4 (&zz)[2], int row, int sub, size_t m, int h, bool rok, int lane) {
    f32x4 ov[4]; float ss = 0.f;
#pragma unroll
    for (int q = 0; q < 4; ++q) { ov[q] = *(const LAS f32x4*)(Oimg + row * G2_OSTRIDE + (sub * 16 + 4 * q) * 4); ss += (ov[q][0] * ov[q][0] + ov[q][1] * ov[q][1]) + (ov[q][2] * ov[q][2] + ov[q][3] * ov[q][3]); }
    ss += shfl_xor_l(ss, 1, lane); ss += shfl_xor_l(ss, 2, lane); ss += shfl_xor_l(ss, 4, lane);
    const float rn = __builtin_amdgcn_rsqf(ss * (1.f / 128.f) + EPS);
    if (rok) {
        const LAS float* hn_s = (const LAS float*)(L + G2_HN);
        u32x4* yp = (u32x4*)(F.Y1() + m * D + h * 128 + sub * 16);
#pragma unroll
        for (int q = 0; q < 2; ++q) {
            const f32x4 oa = ov[2 * q], ob = ov[2 * q + 1];
            const f32x4 ha = *(const LAS f32x4*)(hn_s + sub * 16 + 8 * q), hb = *(const LAS f32x4*)(hn_s + sub * 16 + 8 * q + 4);
            u32x4 yo;
            yo[0] = cvt2(oa[0] * rn * ha[0] * siluf_(lo16(zz[q][0])), oa[1] * rn * ha[1] * siluf_(hi16(zz[q][0])));
            yo[1] = cvt2(oa[2] * rn * ha[2] * siluf_(lo16(zz[q][1])), oa[3] * rn * ha[3] * siluf_(hi16(zz[q][1])));
            yo[2] = cvt2(ob[0] * rn * hb[0] * siluf_(lo16(zz[q][2])), ob[1] * rn * hb[1] * siluf_(hi16(zz[q][2])));
            yo[3] = cvt2(ob[2] * rn * hb[2] * siluf_(lo16(zz[q][3])), ob[3] * rn * hb[3] * siluf_(hi16(zz[q][3])));
            yp[q] = yo; }
    }
}
template <int NCH, bool WT>
__device__ __forceinline__ void g2_task(Frame& F, LAS unsigned char* L, const float* DEC, int s, int h, int ch0, int tid, int lane, int wave) {
    const size_t cstep = (size_t)GS_BYTES;
    const int base = seq_base(s), nvalid = s < BP ? 64 : TS;
    const unsigned char* blk0 = F.ws + WS_RB + (size_t)ch0 * GS_BYTES;
    constexpr int lastc = NCH - 1;
    if (wave < 4) {
        const int ws = wave, cc = lane & 31, hh = lane >> 5;
        f32x16 S0, S1, S2, S3;
        if (s < BP) {
#pragma unroll
            for (int e = 0; e < 16; ++e) { S0[e] = 0.f; S1[e] = 0.f; S2[e] = 0.f; S3[e] = 0.f; }
        } else {
            const float* sp = F.in[7] + ((size_t)(s - BP) * 8 + h) * 16384 + 32 * ws + cc;
#pragma unroll
            for (int e = 0; e < 16; ++e) { const int rr = (e & 3) + 8 * (e >> 2) + 4 * hh; S0[e] = sp[(size_t)rr * 128]; S1[e] = sp[(size_t)(32 + rr) * 128]; S2[e] = sp[(size_t)(64 + rr) * 128]; S3[e] = sp[(size_t)(96 + rr) * 128]; }
        }
        const LAS float* dec_s = (const LAS float*)(L + G2_DEC);
        const int erow = tid >> 3, esub = tid & 7; const bool erok = erow < nvalid;
        u32x4 zz[2];
#define G2_ZLOAD(cidx) do { const u32x4* zp = (const u32x4*)(F.Z1() + ((size_t)base + (cidx) * 64 + erow) * D + h * 128 + esub * 16); zz[0] = zp[0]; zz[1] = zp[1]; } while (0)
        LDS_BARRIER();
        if (NCH == 1) { if (erok) G2_ZLOAD(0); g2_mfma_step(S0, S1, S2, S3, L, dec_s[0], ws, lane, cc, hh); g2_epi16(F, L, L, zz, erow, esub, (size_t)base + erow, h, erok, lane); LDS_BARRIER(); }
        else for (int c = 0; c < NCH; c += 2) {
            G2_ZLOAD(c);
            g2_mfma_step(S0, S1, S2, S3, L, dec_s[c], ws, lane, cc, hh);
            g2_epi16(F, L, L, zz, erow, esub, (size_t)base + c * 64 + erow, h, erok, lane);
            LDS_BARRIER();
            G2_ZLOAD(c + 1);
            g2_mfma_step(S0, S1, S2, S3, L + G2_FB, dec_s[c + 1], ws, lane, cc, hh);
            g2_epi16(F, L, L + G2_FB, zz, erow, esub, (size_t)base + (c + 1) * 64 + erow, h, erok, lane);
            LDS_BARRIER();
        }
        int l9 = lane; asm volatile("" : "+v"(l9));
        const int cc9 = l9 & 31, hh9 = l9 >> 5;
        float* so = (s < BP ? F.out + O_GSP + ((size_t)s * 8 + h) * 16384 : F.out + O_GSS + ((size_t)(s - BP) * 8 + h) * 16384) + 32 * ws + cc9;
#pragma unroll
        for (int e = 0; e < 16; ++e) { const int rr = (e & 3) + 8 * (e >> 2) + 4 * hh9; so[(size_t)rr * 128] = S0[e]; so[(size_t)(32 + rr) * 128] = S1[e]; so[(size_t)(64 + rr) * 128] = S2[e]; so[(size_t)(96 + rr) * 128] = S3[e]; }
    } else {
        const int lt = tid - 256;
        if (lt < 128) ((LAS float*)(L + G2_HN))[lt] = F.in[32][lt];
        const brsrc_t srs = staging_rsrc(F.ws);
        const unsigned* ready = (const unsigned*)(F.ws + WS_READY);
        LAS float* dec_w = (LAS float*)(L + G2_DEC);
#define G2_LOAD(pre, dpre, k) do { const int _k = (k) < lastc ? (k) : lastc; g2_load_set<WT>(pre, dpre, blk0 + (size_t)_k * cstep, lt, srs, (unsigned)(ch0 + _k) * (unsigned)GS_BYTES, ready + 16 * (ch0 + _k), DEC + ch0 + _k); } while (0)
        u32x4 preA[18], preB[18]; float dA, dB;
        G2_LOAD(preA, dA, 0);
        G2_LOAD(preB, dB, 1);
        g2_store_set(preA, L, lt); if (lt == 0) dec_w[0] = dA;
        G2_LOAD(preA, dA, 2);
        const int erow = tid >> 3, esub = tid & 7; const bool erok = erow < nvalid;
        u32x4 zz[2];
#define G2_ZLOAD(cidx) do { const u32x4* zp = (const u32x4*)(F.Z1() + ((size_t)base + (cidx) * 64 + erow) * D + h * 128 + esub * 16); zz[0] = zp[0]; zz[1] = zp[1]; } while (0)
        LDS_BARRIER();
        if (NCH == 1) {
            if (erok) G2_ZLOAD(0);
            LDS_BARRIER();
            LDS_BARRIER();
            g2_epi16(F, L, L, zz, erow, esub, (size_t)base + erow, h, erok, lane);
            LDS_BARRIER();
        } else {
            for (int c = 0; c < NCH; c += 2) {
                {
                    g2_store_set(preB, L + G2_FB, lt); if (lt == 0) dec_w[(c + 1) & 63] = dB;
                    G2_ZLOAD(c);
                    G2_LOAD(preB, dB, c + 3);
                    LDS_BARRIER();
                    LDS_BARRIER();
                    g2_epi16(F, L, L, zz, erow, esub, (size_t)base + c * 64 + erow, h, erok, lane);
                    LDS_BARRIER();
                }
                {
                    g2_store_set(preA, L, lt); if (lt == 0) dec_w[(c + 2) & 63] = dA;
                    G2_ZLOAD(c + 1);
                    G2_LOAD(preA, dA, c + 4);
                    LDS_BARRIER();
                    LDS_BARRIER();
                    g2_epi16(F, L, L + G2_FB, zz, erow, esub, (size_t)base + (c + 1) * 64 + erow, h, erok, lane);
                    LDS_BARRIER();
                }
            }
        }
    }
}
#undef G2_ZLOAD
#undef G2_LOAD
constexpr int G12_CHAINS = 64;
__device__ __forceinline__ void phase_gdn_fused(Frame& F) {
    LAS unsigned char* L = F.lds;
    const float* DEC = (const float*)(F.ws + WS_DEC);
    if ((int)blockIdx.x < G12_CHAINS && F.G > G12_CHAINS) {
        const int tid = opaque_tid(F.wv);
        const int ci = blockIdx.x;
        g2_task<64, true>(F, L, DEC, ci >> 3, ci & 7, ci * 64, tid, tid & 63, F.wv);
    } else {
        const bool all = !(F.G > G12_CHAINS);
        const int p = all ? (int)blockIdx.x : (int)blockIdx.x - G12_CHAINS, np = all ? F.G : F.G - G12_CHAINS;
        gdn_g1_tasks(F, p, np);
        for (int t = p; t < 128; t += np) {
            const int tid = opaque_tid(F.wv);
            __syncthreads();
            g2_task<1, true>(F, L, DEC, BP + (t >> 3), t & 7, 4096 + t, tid, tid & 63, F.wv);
        }
    }
}

__device__ __forceinline__ float dpp_shr_f(float idv, float x, const int o) {
    int r;
    switch (o) {
        case 1: r = __builtin_amdgcn_update_dpp(__float_as_int(idv), __float_as_int(x), 0x111, 0xf, 0xf, false); break;
        case 2: r = __builtin_amdgcn_update_dpp(__float_as_int(idv), __float_as_int(x), 0x112, 0xf, 0xf, false); break;
        case 4: r = __builtin_amdgcn_update_dpp(__float_as_int(idv), __float_as_int(x), 0x114, 0xf, 0xf, false); break;
        default: r = __builtin_amdgcn_update_dpp(__float_as_int(idv), __float_as_int(x), 0x118, 0xf, 0xf, false); break;
    }
    return __int_as_float(r);
}
__device__ __forceinline__ float dpp_shr0_f(float x, const int o) {
    int r;
    switch (o) {
        case 1: r = __builtin_amdgcn_update_dpp(0, __float_as_int(x), 0x111, 0xf, 0xf, true); break;
        case 2: r = __builtin_amdgcn_update_dpp(0, __float_as_int(x), 0x112, 0xf, 0xf, true); break;
        case 4: r = __builtin_amdgcn_update_dpp(0, __float_as_int(x), 0x114, 0xf, 0xf, true); break;
        default: r = __builtin_amdgcn_update_dpp(0, __float_as_int(x), 0x118, 0xf, 0xf, true); break;
    }
    return __int_as_float(r);
}
__device__ __forceinline__ void phase_lru(Frame& F) {
    int tid = opaque_tid(F.wv);
    const int lane = tid & 63, wave = __builtin_amdgcn_readfirstlane(tid >> 6);
    const int gw = F.vcu * 8 + wave, NGW = F.G * 8, h = gw & 7, g = lane >> 4, l15 = lane & 15;
    LAS unsigned char* xs = F.lds + wave * 9216;
    LAS float* cst = (LAS float*)(F.lds + 73728 + wave * 768);
    const bf16_t* LGW = (const bf16_t*)(F.ws + WS_LGW);
    float* LAG = F.LAG();
    bf16x8 wfa[4][2], wfx[4][2];
#pragma unroll
    for (int nt = 0; nt < 4; ++nt)
#pragma unroll
        for (int ks = 0; ks < 2; ++ks) {
            wfa[nt][ks] = *(const bf16x8*)(LGW + ((size_t)(h * 2 + 0) * 64 + 16 * nt + l15) * 64 + 32 * ks + 8 * g);
            wfx[nt][ks] = *(const bf16x8*)(LGW + ((size_t)(h * 2 + 1) * 64 + 16 * nt + l15) * 64 + 32 * ks + 8 * g); }
    cst[lane] = F.in[18][h * 64 + lane]; cst[64 + lane] = F.in[20][h * 64 + lane]; cst[128 + lane] = softplusf_(-F.in[21][h * 64 + lane]);
    for (int task = gw; task < 4224; task += NGW) {
        int s, c; if (task < 4096) { s = task >> 9; c = (task >> 3) & 63; } else { s = BP + ((task - 4096) >> 3); c = 0; }
        const int T = seq_len(s), base = seq_base(s), t0 = c * 64, ntile = s < BP ? 4 : 1;
        {
            int l1 = lane; asm volatile("" : "+v"(l1));
            const int cg = l1 & 7, tp = l1 >> 3;
#pragma unroll 1
            for (int hf2 = 0; hf2 < 2; ++hf2) {
                const int chb = h * 64 + cg * 8 + hf2 * 4;
                float xr[11][4];
                if (s < BP) {
                    u32x2 w[11];
#pragma unroll
                    for (int i = 0; i < 11; ++i) { int tt = t0 + tp * 8 - 3 + i; tt = tt < 0 ? 0 : tt; w[i] = *(const u32x2*)(F.U0() + (size_t)(base + tt) * EV_IN + C_XA + chb); }
                    if (t0 == 0 && tp == 0) { w[0] = (u32x2){0u, 0u}; w[1] = (u32x2){0u, 0u}; w[2] = (u32x2){0u, 0u}; }
#pragma unroll
                    for (int i = 0; i < 11; ++i) { xr[i][0] = lo16(w[i][0]); xr[i][1] = hi16(w[i][0]); xr[i][2] = lo16(w[i][1]); xr[i][3] = hi16(w[i][1]); }
                } else {
#pragma unroll
                    for (int i = 0; i < 11; ++i) {
                        const int tt = t0 + tp * 8 - 3 + i;
                        if (tt >= 0 && tt < T) { const u32x2 w = *(const u32x2*)(F.U0() + (size_t)(base + tt) * EV_IN + C_XA + chb);
                            xr[i][0] = lo16(w[0]); xr[i][1] = hi16(w[0]); xr[i][2] = lo16(w[1]); xr[i][3] = hi16(w[1]); }
                        else if (tt < 0) { const f32x4 a = *(const f32x4*)(F.in[2] + ((size_t)(s - BP) * 3 + (tt + 3)) * 512 + chb); xr[i][0] = a[0]; xr[i][1] = a[1]; xr[i][2] = a[2]; xr[i][3] = a[3]; }
                        else { xr[i][0] = 0.f; xr[i][1] = 0.f; xr[i][2] = 0.f; xr[i][3] = 0.f; }
                    }
                }
                const f32x4 c0 = *(const f32x4*)(F.in[15] + chb), c1 = *(const f32x4*)(F.in[15] + 512 + chb), c2 = *(const f32x4*)(F.in[15] + 1024 + chb), c3 = *(const f32x4*)(F.in[15] + 1536 + chb), cb = *(const f32x4*)(F.in[16] + chb);
#pragma unroll
                for (int i = 0; i < 8; ++i) { float o[4];
#pragma unroll
                    for (int e = 0; e < 4; ++e) o[e] = c0[e] * xr[i][e] + c1[e] * xr[i + 1][e] + c2[e] * xr[i + 2][e] + c3[e] * xr[i + 3][e] + cb[e];
                    u32x2 w; w[0] = cvt2(o[0], o[1]); w[1] = cvt2(o[2], o[3]);
                    *(LAS u32x2*)(xs + (tp * 8 + i) * 144 + cg * 16 + hf2 * 8) = w; }
                if (t0 + 64 >= T && tp == ((T - 1) >> 3) - (t0 >> 3)) {
                    float* o = (s < BP ? F.out + O_LCP + (size_t)s * 3 * 512 : F.out + O_LCS + (size_t)(s - BP) * 3 * 512) + chb;
#pragma unroll
                    for (int q = 0; q < 3; ++q) *(f32x4*)(o + q * 512) = (f32x4){xr[8 + q][0], xr[8 + q][1], xr[8 + q][2], xr[8 + q][3]};
                }
            }
        }
        float hin[4][4], arun[4][4];
#pragma unroll
        for (int nt = 0; nt < 4; ++nt)
#pragma unroll
            for (int rg = 0; rg < 4; ++rg) { hin[nt][rg] = 0.f; arun[nt][rg] = 1.f; }
        asm volatile("s_waitcnt lgkmcnt(0)" ::: "memory");
        for (int tt = 0; tt < ntile; ++tt) {
            const int tok = 16 * tt + l15;
            const bf16x8 b0 = *(const LAS bf16x8*)(xs + tok * 144 + (8 * g) * 2), b1 = *(const LAS bf16x8*)(xs + tok * 144 + (32 + 8 * g) * 2);
            const size_t m = (size_t)base + t0 + tok;
#pragma unroll
            for (int nt = 0; nt < 4; ++nt) {
                f32x4 za = {0.f, 0.f, 0.f, 0.f}, zx = {0.f, 0.f, 0.f, 0.f};
                za = MFMA16(wfa[nt][0], b0, za); za = MFMA16(wfa[nt][1], b1, za);
                zx = MFMA16(wfx[nt][0], b0, zx); zx = MFMA16(wfx[nt][1], b1, zx);
                const int n0 = 16 * nt + 4 * g;
                const u32x2 xw = *(const LAS u32x2*)(xs + tok * 144 + n0 * 2);
                const float xc[4] = {lo16(xw[0]), hi16(xw[0]), lo16(xw[1]), hi16(xw[1])};
                const f32x4 cba = *(const LAS f32x4*)(cst + n0), cbx = *(const LAS f32x4*)(cst + 64 + n0), csp = *(const LAS f32x4*)(cst + 128 + n0);
                float av[4], bv[4];
#pragma unroll
                for (int rg = 0; rg < 4; ++rg) {
                    const float r = sigmoidf_(za[rg] + cba[rg]), ig = sigmoidf_(zx[rg] + cbx[rg]), la = -8.0f * r * csp[rg], a = __expf(la);
                    av[rg] = a; bv[rg] = __builtin_amdgcn_sqrtf(fmaxf(1.0f - a * a, 0.f)) * (ig * xc[rg]); }
#pragma unroll
                for (int o = 1; o < 16; o <<= 1)
#pragma unroll
                    for (int rg = 0; rg < 4; ++rg) { const float ap = dpp_shr_f(1.0f, av[rg], o), bp = dpp_shr0_f(bv[rg], o); bv[rg] = av[rg] * bp + bv[rg]; av[rg] = av[rg] * ap; }
                float hv[4];
#pragma unroll
                for (int rg = 0; rg < 4; ++rg) { hv[rg] = bv[rg] + av[rg] * hin[nt][rg]; hin[nt][rg] = shfl_idx(hv[rg], (lane & 48) | 15); }
                {
                    u32x2 hw, pw; hw[0] = cvt2(hv[0], hv[1]); hw[1] = cvt2(hv[2], hv[3]);
                    pw[0] = cvt2(av[0] * arun[nt][0], av[1] * arun[nt][1]); pw[1] = cvt2(av[2] * arun[nt][2], av[3] * arun[nt][3]);
                    *(u32x2*)(F.Y0() + m * D + h * 64 + n0) = hw;
                    *(u32x2*)(F.YO() + m * D + h * 64 + n0) = pw;
#pragma unroll
                    for (int rg = 0; rg < 4; ++rg) arun[nt][rg] *= shfl_idx(av[rg], (lane & 48) | 15);
                }
                if (nt & 1) __builtin_amdgcn_sched_barrier(0);
            }
        }
        if (s < BP && l15 == 15) {
            f32x2* lp = (f32x2*)LAG + (size_t)(s * 64 + c) * 512 + h * 64;
#pragma unroll
            for (int nt = 0; nt < 4; ++nt)
#pragma unroll
                for (int rg = 0; rg < 4; ++rg) lp[16 * nt + 4 * g + rg] = (f32x2){arun[nt][rg], hin[nt][rg]};
        }
        asm volatile("s_waitcnt lgkmcnt(0)" ::: "memory");
    }
}

__device__ __forceinline__ void phase_lru_apply(Frame& F) {
    PHASE_IDS();
    const int gw = F.vcu * 8 + wave, NGW = F.G * 8, h = gw & 7, cg = lane & 7, tq = lane >> 3;
    float* LAG = F.LAG();
    for (int task = gw; task < 4224; task += NGW) {
        int s, c; if (task < 4096) { s = task >> 9; c = (task >> 3) & 63; } else { s = BP + ((task - 4096) >> 3); c = 0; }
        const int T = seq_len(s), base = seq_base(s), t0 = c * 64, nit = s < BP ? 8 : 2;
        u32x4 hl[8], pp[8], gg[8];
#pragma unroll
        for (int it = 0; it < 8; ++it) { const size_t m = (size_t)base + t0 + 8 * (it < nit ? it : nit - 1) + tq;
            hl[it] = *(const u32x4*)(F.Y0() + m * D + h * 64 + 8 * cg); pp[it] = *(const u32x4*)(F.YO() + m * D + h * 64 + 8 * cg); gg[it] = *(const u32x4*)(F.U0() + m * EV_IN + C_GA + h * 64 + 8 * cg); }
        float hf = s >= BP ? F.in[3][(s - BP) * 512 + h * 64 + lane] : 0.f;
        const f32x2* lp = (const f32x2*)LAG + (size_t)(s * 64) * 512 + h * 64 + lane;
        for (int j0 = 0; j0 < c; j0 += 16) { f32x2 v[16];
#pragma unroll
            for (int q = 0; q < 16; ++q) { const int jj = j0 + q < c ? j0 + q : c - 1; v[q] = lp[(size_t)jj * 512]; }
#pragma unroll
            for (int q = 0; q < 16; ++q) if (j0 + q < c) hf = v[q][0] * hf + v[q][1]; }
        float cr[8];
#pragma unroll
        for (int e = 0; e < 8; ++e) cr[e] = shfl_idx(hf, 8 * cg + e);
#pragma unroll
        for (int it = 0; it < 8; ++it) if (it < nit) {
            const int t = t0 + 8 * it + tq; const size_t m = (size_t)base + t;
            float hv[8]; u32x4 yo;
#pragma unroll
            for (int e = 0; e < 4; ++e) { hv[2 * e] = lo16(hl[it][e]) + lo16(pp[it][e]) * cr[2 * e]; hv[2 * e + 1] = hi16(hl[it][e]) + hi16(pp[it][e]) * cr[2 * e + 1];
                yo[e] = cvt2(hv[2 * e] * siluf_(lo16(gg[it][e])), hv[2 * e + 1] * siluf_(hi16(gg[it][e]))); }
            *(u32x4*)(F.Y0() + m * D + h * 64 + 8 * cg) = yo;
            if (t == T - 1) { float* o = (s < BP ? F.out + O_LHP + s * 512 : F.out + O_LHS + (s - BP) * 512) + h * 64 + 8 * cg;
                *(f32x4*)o = (f32x4){hv[0], hv[1], hv[2], hv[3]}; *(f32x4*)(o + 4) = (f32x4){hv[4], hv[5], hv[6], hv[7]}; }
        }
    }
}

constexpr size_t RB_VTP = RB_WEND, RB_VTS = RB_VTP + (size_t)BP * 2 * 64 * TP * 2, RB_VTEND = RB_VTS + (size_t)BS * 2 * 64 * 192 * 2;
static_assert(RB_VTEND <= RB_BYTES, "ws map");
__device__ __forceinline__ void phase_vt_build(Frame& F) {
    PHASE_IDS();
    const int gw = F.vcu * 8 + wave, NGW = F.G * 8;
    LAS unsigned char* xs = F.lds + wave * 9216;
    bf16_t* VTP = (bf16_t*)(F.ws + WS_RB + RB_VTP); bf16_t* VTS = (bf16_t*)(F.ws + WS_RB + RB_VTS);
    for (int task = gw; task < 1024 + 96; task += NGW) {
        int s, kv, kb; if (task < 1024) { s = task >> 7; kv = (task >> 6) & 1; kb = task & 63; } else { const int r = task - 1024; s = BP + r / 6; kv = (r % 6) / 3; kb = r % 3; }
        const int row8 = lane >> 3, ch = lane & 7;
#pragma unroll
        for (int i = 0; i < 8; ++i) {
            const int key = 8 * i + row8, kg = kb * 64 + key; u32x4 w = {0u, 0u, 0u, 0u};
            if (s < BP) w = *(const u32x4*)(F.U0() + (size_t)(s * TP + kg) * EV_IN + C_V + kv * 64 + ch * 8);
            else if (kg < 128) { const f32x4* p = (const f32x4*)(F.in[5] + ((size_t)((s - BP) * 128 + kg) * 2 + kv) * 64 + ch * 8); const f32x4 a = p[0], b = p[1]; w[0] = cvt2(a[0], a[1]); w[1] = cvt2(a[2], a[3]); w[2] = cvt2(b[0], b[1]); w[3] = cvt2(b[2], b[3]); }
            else if (kg < 128 + TS) w = *(const u32x4*)(F.U0() + (size_t)(MP + (s - BP) * TS + (kg - 128)) * EV_IN + C_V + kv * 64 + ch * 8);
            *(LAS u32x4*)(xs + key * 144 + ch * 16) = w;
        }
        asm volatile("s_waitcnt lgkmcnt(0)" ::: "memory");
        bf16_t* dst = s < BP ? VTP + ((size_t)(s * 2 + kv) * 64 + lane) * TP + kb * 64 : VTS + ((size_t)((s - BP) * 2 + kv) * 64 + lane) * 192 + kb * 64;
#pragma unroll
        for (int q = 0; q < 8; ++q) { u32x4 o;
#pragma unroll
            for (int e = 0; e < 4; ++e) { const unsigned lo = *(const LAS bf16_t*)(xs + (8 * q + 2 * e) * 144 + lane * 2), hi = *(const LAS bf16_t*)(xs + (8 * q + 2 * e + 1) * 144 + lane * 2); o[e] = lo | (hi << 16); }
            *(u32x4*)(dst + 8 * q) = o; }
        asm volatile("s_waitcnt lgkmcnt(0)" ::: "memory");
    }
}
constexpr int AT_K = 0, AT_V = 27648;
__device__ __forceinline__ void attn_issue(Frame& F, const bf16_t* VTP, int task, int tid, int wave, int lane, u32x4 (&kreg)[3], u32x4 (&vreg)[3], u32x4 (&qreg)[4]) {
    const int s = task >> 7, c = (task >> 1) & 63, kv = task & 1, tok0 = c * 64 - 128;
#pragma unroll
    for (int i = 0; i < 3; ++i) { const int idx = tid + 512 * i, key = idx >> 3, ch = idx & 7; int tk = tok0 + key; tk = tk < 0 ? 0 : tk;
        kreg[i] = *(const u32x4*)(F.U0() + (size_t)(s * TP + tk) * EV_IN + C_K + kv * 64 + ch * 8); }
#pragma unroll
    for (int i = 0; i < 3; ++i) { const int idx = tid + 512 * i, d = idx / 24, ch = idx % 24; int tk = tok0 + ch * 8; tk = tk < 0 ? 0 : tk;
        vreg[i] = *(const u32x4*)(VTP + ((size_t)(s * 2 + kv) * 64 + d) * TP + tk); }
    const int g = wave >> 1, qh = wave & 1, hq = kv * 4 + g, r = lane & 31, hh = lane >> 5;
    const size_t m = (size_t)s * TP + c * 64 + qh * 32 + r;
#pragma unroll
    for (int ks = 0; ks < 4; ++ks) qreg[ks] = *(const u32x4*)(F.U0() + m * EV_IN + C_Q + hq * 64 + 16 * ks + 8 * hh);
}
__device__ __forceinline__ void phase_attn(Frame& F) {
    PHASE_IDS();
    LAS unsigned char* L = F.lds;
    const bf16_t* VTP = (const bf16_t*)(F.ws + WS_RB + RB_VTP); const bf16_t* VTS = (const bf16_t*)(F.ws + WS_RB + RB_VTS);
    u32x4 kreg[3], vreg[3], qreg[4];
    attn_issue(F, VTP, F.vcu < 1024 ? F.vcu : 0, tid, wave, lane, kreg, vreg, qreg);
    for (int ti = F.vcu; ti < 1024 + 64; ti += F.G) {
        if (ti >= 1024 && ti < 1056) continue;
        const int task = ti < 1024 ? ti : ti - 32;
        int s, c, kv; if (task < 1024) { s = task >> 7; c = (task >> 1) & 63; kv = task & 1; } else { s = BP + ((task - 1024) >> 1); c = 0; kv = task & 1; }
        const int base = seq_base(s), tok0 = c * 64 - 128;
        const int kmin = s < BP ? (tok0 < 0 ? -tok0 : 0) : 0, kmax = s < BP ? 192 : 128 + TS;
        const int tid = opaque_tid(F.wv), lane = tid & 63;
        const int g = wave >> 1, qh = wave & 1, hq = kv * 4 + g, r = lane & 31, hh = lane >> 5, qi = qh * 32 + r;
        const bool qok = s < BP ? true : qi < TS;
        const size_t m = (size_t)base + c * 64 + (qok ? qi : 0);
        bf16x8 qf[4]; u32x2 gbr[8];
        LDS_BARRIER();
        if (s < BP) {
#pragma unroll
            for (int i = 0; i < 3; ++i) { const int idx = tid + 512 * i, key = idx >> 3, ch = idx & 7; const u32x4 z = {0u, 0u, 0u, 0u}; *(LAS u32x4*)(L + AT_K + key * 144 + ch * 16) = key >= kmin ? kreg[i] : z; }
#pragma unroll
            for (int i = 0; i < 3; ++i) { const int idx = tid + 512 * i, d = idx / 24, ch = idx % 24; const u32x4 z = {0u, 0u, 0u, 0u}; *(LAS u32x4*)(L + AT_V + d * 400 + ch * 16) = ch * 8 >= kmin ? vreg[i] : z; }
#pragma unroll
            for (int ks = 0; ks < 4; ++ks) { u32x4 w;
#pragma unroll
                for (int e = 0; e < 4; ++e) w[e] = cvt2(lo16(qreg[ks][e]) * 0.125f, hi16(qreg[ks][e]) * 0.125f);
                qf[ks] = __builtin_bit_cast(bf16x8, w); }
        } else {
#pragma unroll
            for (int i = 0; i < 3; ++i) {
                const int idx = tid + 512 * i, key = idx >> 3, ch = idx & 7; u32x4 w = {0u, 0u, 0u, 0u};
                if (key < kmax) {
                    if (key < 128) { const f32x4* p = (const f32x4*)(F.in[4] + ((size_t)((s - BP) * 128 + key) * 2 + kv) * 64 + ch * 8); const f32x4 a = p[0], b2 = p[1]; w[0] = cvt2(a[0], a[1]); w[1] = cvt2(a[2], a[3]); w[2] = cvt2(b2[0], b2[1]); w[3] = cvt2(b2[2], b2[3]); }
                    else w = *(const u32x4*)(F.U0() + (size_t)(base + key - 128) * EV_IN + C_K + kv * 64 + ch * 8);
                }
                *(LAS u32x4*)(L + AT_K + key * 144 + ch * 16) = w;
            }
#pragma unroll
            for (int i = 0; i < 3; ++i) {
                const int idx = tid + 512 * i, d = idx / 24, ch = idx % 24, key = ch * 8;
                *(LAS u32x4*)(L + AT_V + d * 400 + ch * 16) = *(const u32x4*)(VTS + ((size_t)((s - BP) * 2 + kv) * 64 + d) * 192 + key);
            }
#pragma unroll
            for (int ks = 0; ks < 4; ++ks) { u32x4 w = {0u, 0u, 0u, 0u};
                if (qok) { const u32x4 x = *(const u32x4*)(F.U0() + m * EV_IN + C_Q + hq * 64 + 16 * ks + 8 * hh);
#pragma unroll
                    for (int e = 0; e < 4; ++e) w[e] = cvt2(lo16(x[e]) * 0.125f, hi16(x[e]) * 0.125f); }
                qf[ks] = __builtin_bit_cast(bf16x8, w); }
        }
#pragma unroll
        for (int qq = 0; qq < 4; ++qq) { gbr[2 * qq] = qok ? *(const u32x2*)(F.U0() + m * EV_IN + C_GB + hq * 64 + 8 * qq + 4 * hh) : (u32x2){0u, 0u}; gbr[2 * qq + 1] = qok ? *(const u32x2*)(F.U0() + m * EV_IN + C_GB + hq * 64 + 32 + 8 * qq + 4 * hh) : (u32x2){0u, 0u}; }
        { const int nt = ti + F.G < 1024 ? ti + F.G : (ti < 1024 ? ti : 0); int t9 = tid; asm volatile("" : "+v"(t9)); attn_issue(F, VTP, nt, t9, wave, t9 & 63, kreg, vreg, qreg); }
        const float sink = F.in[22][hq];
        LDS_BARRIER();
        float mrun = sink, lrun = 1.0f;
        f32x16 o0, o1;
#pragma unroll
        for (int e = 0; e < 16; ++e) { o0[e] = 0.f; o1[e] = 0.f; }
#pragma unroll 1
        for (int half = 0; half < 2; ++half) {
            f32x16 sc[3];
#pragma unroll
            for (int k3 = 0; k3 < 3; ++k3) {
                const int kt = 3 * half + k3;
#pragma unroll
                for (int e = 0; e < 16; ++e) sc[k3][e] = 0.f;
#pragma unroll
                for (int ks = 0; ks < 4; ++ks) { const bf16x8 kf = *(const LAS bf16x8*)(L + AT_K + (32 * kt + r) * 144 + (16 * ks + 8 * hh) * 2); sc[k3] = MFMA32(kf, qf[ks], sc[k3]); }
            }
            float mx = -1e30f;
#pragma unroll
            for (int k3 = 0; k3 < 3; ++k3)
#pragma unroll
                for (int e = 0; e < 16; ++e) { const int kidx = 32 * (3 * half + k3) + (e & 3) + 8 * (e >> 2) + 4 * hh; const bool ok = kidx >= kmin && kidx < kmax; sc[k3][e] = ok ? sc[k3][e] : -1e30f; mx = fmaxf(mx, sc[k3][e]); }
            mx = fmaxf(mx, shfl_xor_l(mx, 32, lane));
            const float mnew = fmaxf(mrun, mx), alpha = __expf(mrun - mnew);
            float psum = 0.f;
#pragma unroll
            for (int k3 = 0; k3 < 3; ++k3)
#pragma unroll
                for (int e = 0; e < 16; ++e) { const float p = __expf(sc[k3][e] - mnew); sc[k3][e] = p; psum += p; }
            psum += shfl_xor_l(psum, 32, lane);
            lrun = lrun * alpha + psum; mrun = mnew;
            o0 = o0 * alpha; o1 = o1 * alpha;
#pragma unroll
            for (int k3 = 0; k3 < 3; ++k3)
#pragma unroll
                for (int ss = 0; ss < 2; ++ss) {
                    const int kt = 3 * half + k3;
                    const bf16x8 pb = pack8(sc[k3], ss);
                    const LAS unsigned char* vp = L + AT_V + r * 400 + (32 * kt + 16 * ss + 4 * hh) * 2;
                    const u32x2 a0 = *(const LAS u32x2*)vp, a1 = *(const LAS u32x2*)(vp + 16), b0 = *(const LAS u32x2*)(vp + 32 * 400), b1 = *(const LAS u32x2*)(vp + 32 * 400 + 16);
                    const u32x4 va = {a0[0], a0[1], a1[0], a1[1]}, vb = {b0[0], b0[1], b1[0], b1[1]};
                    o0 = MFMA32(__builtin_bit_cast(bf16x8, va), pb, o0); o1 = MFMA32(__builtin_bit_cast(bf16x8, vb), pb, o1);
                }
        }
        const float il = __builtin_amdgcn_rcpf(lrun);
        if (qok) {
#pragma unroll
            for (int qq = 0; qq < 4; ++qq) {
                { const int d = 8 * qq + 4 * hh; const u32x2 gb = gbr[2 * qq];
                  u32x2 yo; yo[0] = cvt2(o0[4 * qq] * il * siluf_(lo16(gb[0])), o0[4 * qq + 1] * il * siluf_(hi16(gb[0]))); yo[1] = cvt2(o0[4 * qq + 2] * il * siluf_(lo16(gb[1])), o0[4 * qq + 3] * il * siluf_(hi16(gb[1])));
                  *(u32x2*)(F.Y0() + m * D + 512 + hq * 64 + d) = yo; }
                { const int d = 32 + 8 * qq + 4 * hh; const u32x2 gb = gbr[2 * qq + 1];
                  u32x2 yo; yo[0] = cvt2(o1[4 * qq] * il * siluf_(lo16(gb[0])), o1[4 * qq + 1] * il * siluf_(hi16(gb[0]))); yo[1] = cvt2(o1[4 * qq + 2] * il * siluf_(lo16(gb[1])), o1[4 * qq + 3] * il * siluf_(hi16(gb[1])));
                  *(u32x2*)(F.Y0() + m * D + 512 + hq * 64 + d) = yo; }
            }
        }
    }
    __syncthreads();
}

constexpr int SG_A = 0, SG_B = 36864, SG_BUF = 36864 + 9216;
struct SOut { bf16_t* O0; int ld0; int split; bf16_t* O1; int ld1; };
__device__ __forceinline__ void sgemm_strip(Frame& F, const bf16_t* A, const bf16_t* Bt, const int K, const int n0, const SOut o, const int tid, const int lane, const int wave) {
    LAS unsigned char* L = F.lds;
    const int nkt = K / 64;
    const bf16_t* ap = A + (size_t)(tid >> 3) * K + (tid & 7) * 8;
    const bf16_t* bp = Bt + (size_t)(n0 + (tid >> 3)) * K + (tid & 7) * 8;
    const int lofs = (tid >> 3) * 144 + (tid & 7) * 16;
    u32x4 ra[4], rb, sa[4], sb;
#define SG_LOAD(RA, RB, kt) do { _Pragma("unroll") for (int i = 0; i < 4; ++i) RA[i] = *(const u32x4*)(ap + (size_t)i * 64 * K + (kt) * 64); RB = *(const u32x4*)(bp + (kt) * 64); } while (0)
#define SG_STORE(RA, RB, buf) do { _Pragma("unroll") for (int i = 0; i < 4; ++i) *(LAS u32x4*)(L + (buf) * SG_BUF + SG_A + lofs + i * 64 * 144) = RA[i]; *(LAS u32x4*)(L + (buf) * SG_BUF + SG_B + lofs) = RB; } while (0)
    SG_LOAD(ra, rb, 0); SG_LOAD(sa, sb, 1);
    SG_STORE(ra, rb, 0);
    SG_LOAD(ra, rb, (2 < nkt ? 2 : nkt - 1));
    f32x16 acc0, acc1;
#pragma unroll
    for (int e = 0; e < 16; ++e) { acc0[e] = 0.f; acc1[e] = 0.f; }
    const int r = lane & 31, hh = lane >> 5;
    LDS_BARRIER();
    for (int kt = 0; kt < nkt; kt += 2) {
#define SG_STEP(buf, RA, RB, knext) do { \
        const LAS unsigned char* Ab = L + (buf) * SG_BUF + SG_A + (32 * wave + r) * 144 + hh * 16; const LAS unsigned char* Bb = L + (buf) * SG_BUF + SG_B + r * 144 + hh * 16; \
        _Pragma("unroll") for (int ks = 0; ks < 4; ++ks) { const bf16x8 af = *(const LAS bf16x8*)(Ab + ks * 32), b0 = *(const LAS bf16x8*)(Bb + ks * 32), b1 = *(const LAS bf16x8*)(Bb + 32 * 144 + ks * 32); \
            acc0 = MFMA32(b0, af, acc0); acc1 = MFMA32(b1, af, acc1); } \
        SG_STORE(RA, RB, (buf) ^ 1); { const int kn = (knext) < nkt ? (knext) : nkt - 1; SG_LOAD(RA, RB, kn); } \
        LDS_BARRIER(); } while (0)
        SG_STEP(0, sa, sb, kt + 3);
        SG_STEP(1, ra, rb, kt + 4);
    }
#undef SG_STEP
#undef SG_LOAD
#undef SG_STORE
    const int row = 32 * wave + r; int colt = n0; bf16_t* base = o.O0; int ld = o.ld0;
    if (colt >= o.split) { base = o.O1; ld = o.ld1; colt -= o.split; }
    bf16_t* rowp = base + (size_t)row * ld + colt;
#pragma unroll
    for (int q = 0; q < 4; ++q) {
        u32x2 w0, w1; w0[0] = cvt2(acc0[4 * q], acc0[4 * q + 1]); w0[1] = cvt2(acc0[4 * q + 2], acc0[4 * q + 3]); w1[0] = cvt2(acc1[4 * q], acc1[4 * q + 1]); w1[1] = cvt2(acc1[4 * q + 2], acc1[4 * q + 3]);
        *(u32x2*)(rowp + 8 * q + 4 * hh) = w0; *(u32x2*)(rowp + 32 + 8 * q + 4 * hh) = w1; }
    LDS_BARRIER();
}
__device__ __forceinline__ void sgemm_phase(Frame& F, const bf16_t* A, const bf16_t* Bt, const int N, const int K, const SOut o, const int from) {
    const int nstrip = N / 64;
    for (int st = ((int)blockIdx.x - from + F.G) % F.G; st < nstrip; st += F.G) {
        const int tid = opaque_tid(F.wv);
        sgemm_strip(F, A, Bt, K, st * 64, o, tid, tid & 63, F.wv);
    }
}

__device__ __forceinline__ void rows_final(Frame& F, const int m0, const int n, const int s, const int lane) {
    const float* MODP = (const float*)(F.ws + WS_MODP);
    f32x4 A1[4];
#pragma unroll
    for (int j = 0; j < 4; ++j) { const int c = 4 * lane + 256 * j; const f32x4 g = *(const f32x4*)(F.in[27] + c), gt = mod4(MODP, 1, s, 2048 + c);
#pragma unroll
        for (int e = 0; e < 4; ++e) A1[j][e] = gt[e] * g[e]; }
    u32x2 ycur[4]; f32x4 xcur[4];
#pragma unroll
    for (int j = 0; j < 4; ++j) { ycur[j] = *(const u32x2*)(F.YO() + (size_t)m0 * D + 4 * lane + 256 * j); xcur[j] = *(const f32x4*)(F.out + O_Y + (size_t)m0 * D + 4 * lane + 256 * j); }
    for (int i = 0; i < n; ++i) {
        const int m = m0 + i, mn = m0 + (i + 1 < n ? i + 1 : i); u32x2 ynxt[4]; f32x4 xnxt[4];
#pragma unroll
        for (int j = 0; j < 4; ++j) { ynxt[j] = *(const u32x2*)(F.YO() + (size_t)mn * D + 4 * lane + 256 * j); xnxt[j] = *(const f32x4*)(F.out + O_Y + (size_t)mn * D + 4 * lane + 256 * j); }
        f32x4 y[4]; float ss = 0.f;
#pragma unroll
        for (int j = 0; j < 4; ++j) { y[j] = (f32x4){lo16(ycur[j][0]), hi16(ycur[j][0]), lo16(ycur[j][1]), hi16(ycur[j][1])}; ss += (y[j][0] * y[j][0] + y[j][1] * y[j][1]) + (y[j][2] * y[j][2] + y[j][3] * y[j][3]); }
        const float r1 = rsqrtf(wave_sum(ss, lane) * (1.f / D) + EPS);
#pragma unroll
        for (int j = 0; j < 4; ++j) { f32x4 o;
#pragma unroll
            for (int e = 0; e < 4; ++e) o[e] = xcur[j][e] + A1[j][e] * (y[j][e] * r1);
            *(f32x4*)(F.out + O_Y + (size_t)m * D + 4 * lane + 256 * j) = o; }
#pragma unroll
        for (int j = 0; j < 4; ++j) { ycur[j] = ynxt[j]; xcur[j] = xnxt[j]; }
    }
}
__device__ __forceinline__ void phase_final_rowwise(Frame& F) {
    PHASE_IDS();
    const int gw = F.vcu * 8 + wave, NGW = F.G * 8;
    for (int w = gw; w < MP / 16; w += NGW) rows_final(F, w * 16, 16, w >> 8, lane);
    for (int w = gw; w < MS; w += NGW) rows_final(F, MP + w, 1, BP + (w >> 4), lane);
}

__global__ void __launch_bounds__(512, 2) fwd_megakernel(Params P) {
    extern __shared__ __attribute__((aligned(16))) unsigned char lds_raw[];
    Frame F;
    F.lds = (LAS unsigned char*)lds_raw;
    F.wv = __builtin_amdgcn_readfirstlane(threadIdx.x >> 6);
    F.G = gridDim.x; { const int bx = blockIdx.x; F.vcu = (F.G % 8 == 0) ? (bx % 8) * (F.G / 8) + bx / 8 : bx; }
    F.in = P.in; F.out = P.out; F.ws = P.ws;

    volatile LAS unsigned* misc = (volatile LAS unsigned*)(F.lds + LDS_BYTES - 64);
    if (threadIdx.x < 16) misc[threadIdx.x] = 0u;
    __syncthreads();
    XcdBarrier xbar = xcd_barrier_post((unsigned*)(P.ws + WS_CTL), misc);
#define GRID_BAR() xcd_barrier(xbar, F.wv)
    phase_mod0(F);
    GRID_BAR();
    phase_prologue(F);
    phase_mod1(F);
    phase_prenorm0(F);
    GRID_BAR();
    { pg8::Gemm g{F.XN(), F.W0I(), MP, EV_IN, D}; pg8::StaticOrder S; S.init(MP, EV_IN, F.G, (int)blockIdx.x);
      pg8::EpiBf16 E{F.U0(), EV_IN, 1 << 30, F.U0(), EV_IN}; pg8::gemm_phase(F.lds, g, S, E, F.wv);
      sgemm_phase(F, F.XN() + (size_t)MP * D, F.W0I(), EV_IN, D, SOut{F.U0() + (size_t)MP * EV_IN, EV_IN, 1 << 30, nullptr, 0}, 128); }
    GRID_BAR();
    phase_rope(F);
    phase_lru(F);
    phase_vt_build(F);
    GRID_BAR();
    phase_lru_apply(F);
    phase_attn(F);
    GRID_BAR();
    { pg8::Gemm g{F.Y0(), F.W0O(), MP, D, D}; pg8::StaticOrder S; S.init(MP, D, F.G, (int)blockIdx.x);
      pg8::EpiBf16 E{F.YO(), D, 1 << 30, F.YO(), D}; pg8::gemm_phase(F.lds, g, S, E, F.wv);
      sgemm_phase(F, F.Y0() + (size_t)MP * D, F.W0O(), D, D, SOut{F.YO() + (size_t)MP * D, D, 1 << 30, nullptr, 0}, 0); }
    GRID_BAR();
    phase_mid_rowwise(F);
    GRID_BAR();
    { pg8::Gemm g{F.XN(), F.W1I(), MP, OD_MAIN, D}; pg8::StaticOrder S; S.init(MP, OD_MAIN, F.G, (int)blockIdx.x);
      pg8::EpiBf16 E{F.QKV1(), 3072, 3072, F.Z1(), D}; pg8::gemm_phase(F.lds, g, S, E, F.wv);
      sgemm_phase(F, F.XN() + (size_t)MP * D, F.W1I(), OD_MAIN, D, SOut{F.QKV1() + (size_t)MP * 3072, 3072, 3072, F.Z1() + (size_t)MP * D, D}, 0); }
    GRID_BAR();
    phase_gdn_fused(F);
    GRID_BAR();
    { pg8::Gemm g{F.Y1(), F.W1O(), MP, D, D}; pg8::StaticOrder S; S.init(MP, D, F.G, (int)blockIdx.x);
      pg8::EpiBf16 E{F.YO(), D, 1 << 30, F.YO(), D}; pg8::gemm_phase(F.lds, g, S, E, F.wv);
      sgemm_phase(F, F.Y1() + (size_t)MP * D, F.W1O(), D, D, SOut{F.YO() + (size_t)MP * D, D, 1 << 30, nullptr, 0}, 0); }
    GRID_BAR();
    phase_final_rowwise(F);
}

extern "C" void kernel_launch(void* const* d_in, const int* in_sizes, int n_in, void* d_out, int out_size, void* d_ws, size_t ws_size, hipStream_t stream) {
    static int grid = 0;
    if (grid == 0) {
        if (n_in != 34 || out_size != (int)O_END || ws_size < WS_END) { grid = -1; return; }
        int dev = 0, cus = 0, per_cu = 0;
        if (hipGetDevice(&dev) != hipSuccess || hipDeviceGetAttribute(&cus, hipDeviceAttributeMultiprocessorCount, dev) != hipSuccess) { grid = -1; return; }
        if (hipFuncSetAttribute((const void*)fwd_megakernel, hipFuncAttributeMaxDynamicSharedMemorySize, LDS_BYTES) != hipSuccess) { grid = -1; return; }
        if (hipOccupancyMaxActiveBlocksPerMultiprocessor(&per_cu, (const void*)fwd_megakernel, 512, LDS_BYTES) != hipSuccess || per_cu < 1) { grid = -1; return; }
        grid = cus;
    }
    if (grid < 0) return;
    if (hipMemsetAsync((char*)d_ws + WS_CTL, 0, 65536 + 4224 * 64, stream) != hipSuccess) return;
    Params p{};
    for (int i = 0; i < 34; ++i) p.in[i] = (const float*)d_in[i];
    p.out = (float*)d_out; p.ws = (unsigned char*)d_ws;
    void* args[] = {&p};
    (void)hipLaunchCooperativeKernel((const void*)fwd_megakernel, dim3(grid), dim3(512), args, LDS_BYTES, stream);
}
```

```cpp
#include <hip/hip_runtime.h>
#include <hip/hip_cooperative_groups.h>
namespace cg = cooperative_groups;

#define LAS __attribute__((address_space(3)))
typedef unsigned short bf16_t;
typedef short bf16x8 __attribute__((ext_vector_type(8)));
typedef float f32x4 __attribute__((ext_vector_type(4)));
typedef float f32x2 __attribute__((ext_vector_type(2)));
typedef unsigned u32x4 __attribute__((ext_vector_type(4)));
typedef unsigned u32x2 __attribute__((ext_vector_type(2)));

constexpr int D = 1024, BP = 8, TP = 4096, BS = 16, TS = 16;
constexpr int MP = BP * TP, MS = BS * TS, MT = MP + MS;
constexpr int NSEQ = BP + BS;
constexpr int EV_IN = 2304, OD_IN = 4112, OD_MAIN = 4096;
constexpr int C_XA = 0, C_GA = 512, C_Q = 1024, C_K = 1536, C_V = 1664, C_GB = 1792;
constexpr float EPS = 1e-6f;
constexpr size_t O_Y = 0, O_LCP = 33816576, O_LCS = 33828864, O_LHP = 33853440, O_LHS = 33857536, O_KP = 33865728, O_KS = 33996800,
                 O_VP = 34029568, O_VS = 34160640, O_GCP = 34193408, O_GCS = 34267136, O_GSP = 34414592, O_GSS = 35463168, O_END = 37560320;
constexpr size_t MiB = 1u << 20;
constexpr size_t WS_CTL = 0, WS_W1O = 1 * MiB, WS_MOD = 3 * MiB, WS_ROPE = 4 * MiB, WS_BA = 5 * MiB, WS_LAG = 8 * MiB, WS_LGW = 10 * MiB;
constexpr size_t WS_RA = 16 * MiB, RA_BYTES = (size_t)MT * 4096 * 2;
constexpr size_t WS_RB = WS_RA + RA_BYTES;
constexpr size_t ACT_BYTES = (size_t)MT * D * 2;
constexpr size_t RB_XN = 0, RB_Y0 = ACT_BYTES, RB_YO = 2 * ACT_BYTES, RB_W0I = 3 * ACT_BYTES, RB_W0O = RB_W0I + (size_t)EV_IN * D * 2,
                 RB_W1I = RB_W0O + (size_t)D * D * 2, RB_WEND = RB_W1I + (size_t)OD_MAIN * D * 2;
constexpr size_t RB_BYTES = (size_t)4224 * 73728;
constexpr size_t WS_END = WS_RB + RB_BYTES;
static_assert(RB_WEND <= RB_BYTES, "ws map");
static_assert((size_t)MT * 3072 * 2 <= RB_BYTES, "ws map");
constexpr int LDS_BYTES = 155648;

struct Params { const float* in[34]; float* out; unsigned char* ws; };

__device__ __forceinline__ float bf2f(bf16_t b) { return __uint_as_float(((unsigned)b) << 16); }
__device__ __forceinline__ unsigned f2bf(float f) { unsigned u = __float_as_uint(f); return (u + 0x7fffu + ((u >> 16) & 1u)) >> 16; }
__device__ __forceinline__ unsigned pk2(float lo, float hi) { return f2bf(lo) | (f2bf(hi) << 16); }
typedef __bf16 bf16x2_t __attribute__((ext_vector_type(2)));
__device__ __forceinline__ unsigned cvt2(float a, float b) { f32x2 v = {a, b}; bf16x2_t r = __builtin_convertvector(v, bf16x2_t); return __builtin_bit_cast(unsigned, r); }
__device__ __forceinline__ float lo16(unsigned w) { return __uint_as_float(w << 16); }
__device__ __forceinline__ float hi16(unsigned w) { return __uint_as_float(w & 0xffff0000u); }
__device__ __forceinline__ float shfl_idx(float x, int src_lane) { return __int_as_float(__builtin_amdgcn_ds_bpermute(src_lane << 2, __float_as_int(x))); }
__device__ __forceinline__ float shfl_xor_l(float x, int o, int lane) { return shfl_idx(x, lane ^ o); }
__device__ __forceinline__ float wave_sum_b(float v, int lane) {
#pragma unroll
    for (int o = 1; o < 64; o <<= 1) v += shfl_xor_l(v, o, lane);
    return v;
}
#define DPP_ADD(v, ctrl, rmask) v += __int_as_float(__builtin_amdgcn_update_dpp(0, __float_as_int(v), (ctrl), (rmask), 0xf, false))
__device__ __forceinline__ float wave_sum(float v, int lane) {
    (void)lane;
    DPP_ADD(v, 0xB1, 0xf); DPP_ADD(v, 0x4E, 0xf); DPP_ADD(v, 0x141, 0xf); DPP_ADD(v, 0x140, 0xf);
    DPP_ADD(v, 0x142, 0xa); DPP_ADD(v, 0x143, 0xc);
    float r = __int_as_float(__builtin_amdgcn_readlane(__float_as_int(v), 63)); asm volatile("" : "+v"(r)); return r;
}
__device__ __forceinline__ float sigmoidf_(float x) { return __builtin_amdgcn_rcpf(1.0f + __expf(-x)); }
__device__ __forceinline__ float siluf_(float x) { return x * __builtin_amdgcn_rcpf(1.0f + __expf(-x)); }
__device__ __forceinline__ float softplusf_(float x) { return x > 20.f ? x : log1pf(__expf(x)); }
__device__ __forceinline__ int seq_base(int s) { return s < BP ? s * TP : MP + (s - BP) * TS; }
__device__ __forceinline__ int seq_len(int s) { return s < BP ? TP : TS; }
__device__ __forceinline__ void tok_info(int m, int& s, int& t) { if (m < MP) { s = m >> 12; t = m & 4095; } else { const int r = m - MP; s = BP + (r >> 4); t = r & 15; } }

__device__ __forceinline__ int opaque_tid(int wv) { unsigned z = 0u; asm volatile("" : "+v"(z)); const int l = __builtin_amdgcn_mbcnt_hi(~0u, __builtin_amdgcn_mbcnt_lo(~0u, z)); return wv * 64 + l; }
namespace pg8 {
constexpr int BM = 256, BK = 64, HALF = 128, HTB = HALF * BK * 2, STAGE_BYTES = 8 * HTB, NXCD = 8, WGM = 8;
__host__ __device__ __forceinline__ int lds_byte(int r, int c) { const int st = (r >> 4) * 2 + (c >> 5), rr = r & 15, cc = c & 31, ob = rr * 64 + cc * 2; return st * 1024 + (ob ^ (((ob >> 9) & 1) << 5)); }
__host__ __device__ __forceinline__ void stage_rc(int b, int& R, int& C) { const int st = b / 1024, sb = b % 1024, swz = sb ^ (((sb >> 9) & 1) << 5); R = (st >> 1) * 16 + swz / 64; C = (st & 1) * 32 + (swz % 64) / 2; }
__host__ __device__ __forceinline__ int perm32(int rho) { const int n = rho >> 4, i = rho & 15; return 8 * (i >> 2) + 4 * n + (i & 3); }
struct Unit { int pm, pn; };
struct Gemm { const bf16_t* A; const bf16_t* Bt; int M, N, K; };
struct StaticOrder {
    int nM, nN, nwg, G, c;
    __device__ void init(int M, int N, int G_, int c_) { nM = M / BM; nN = N / BM; nwg = nM * nN; G = G_; c = c_; }
    __device__ bool next(int i, Unit& u) const {
        const long L = (long)i * G + c; if (L >= nwg) return false;
        int wgid = (int)L; { const int q = nwg / NXCD, r = nwg % NXCD, xcd = wgid % NXCD, off = wgid / NXCD; wgid = (xcd < r ? xcd * (q + 1) : r * (q + 1) + (xcd - r) * q) + off; }
        const int nig = WGM * nN, gid = wgid / nig, fm = gid * WGM, gsz = (nM - fm) < WGM ? (nM - fm) : WGM;
        u.pm = fm + ((wgid % nig) % gsz); u.pn = (wgid % nig) / gsz; return true;
    }
};
__device__ __forceinline__ unsigned cvt_pk_bf16(float lo, float hi) { unsigned r; asm volatile("v_cvt_pk_bf16_f32 %0, %1, %2" : "=v"(r) : "v"(lo), "v"(hi)); return r; }
struct EpiBf16 {
    static constexpr bool PERM = true;
    bf16_t* O0; int ld0; int split; bf16_t* O1; int ld1;
    __device__ __forceinline__ void operator()(const f32x4 (&acc)[2][2][4][2], const Unit& u, int wr, int wc, int fr, int fq) const {
        const int row0 = u.pm * BM + wr * 64 + fr; int colt = u.pn * BM; bf16_t* base = O0; int ld = ld0;
        if (colt >= split) { base = O1; ld = ld1; colt -= split; }
        const int col0 = colt + wc * 32 + 8 * fq;
#pragma unroll
        for (int ai = 0; ai < 2; ++ai)
#pragma unroll
            for (int m = 0; m < 4; ++m) { bf16_t* rowp = base + (size_t)(row0 + ai * HALF + m * 16) * ld + col0;
#pragma unroll
                for (int bj = 0; bj < 2; ++bj) { const f32x4 v0 = acc[ai][bj][m][0], v1 = acc[ai][bj][m][1];
                    u32x4 w; w.x = cvt_pk_bf16(v0[0], v0[1]); w.y = cvt_pk_bf16(v0[2], v0[3]); w.z = cvt_pk_bf16(v1[0], v1[1]); w.w = cvt_pk_bf16(v1[2], v1[3]);
                    *(u32x4*)(rowp + bj * HALF) = w; } }
    }
};
template <class Epi, class Sched>
__device__ __forceinline__ void gemm_phase(LAS unsigned char* lds, const Gemm g, const Sched& S, const Epi& E, const int wv0) {
    int tid = opaque_tid(wv0);
    const int wid = __builtin_amdgcn_readfirstlane(tid >> 6), lane = tid & 63, wr = wid >> 2, wc = wid & 3, fr = lane & 15, fq = lane >> 4;
    const int K = g.K, nt = K / BK;
    unsigned voffA[2], voffB[2];
#pragma unroll
    for (int i = 0; i < 2; ++i) { int R, C; stage_rc(tid * 16 + i * 8192, R, C); const int Rb = Epi::PERM ? ((R & ~31) + perm32(R & 31)) : R;
        voffA[i] = (unsigned)(R * K + C) * 2u; voffB[i] = (unsigned)(Rb * K + C) * 2u; }
    const size_t kstep = (size_t)(BK * 2);
    const size_t hstep = (size_t)HALF * K * 2;
    const size_t tstep = 2 * hstep;
    const unsigned ldsw = (unsigned)wid * 1024u;
    const int aoff = lds_byte(wr * 64 + fr, fq * 8), boff = lds_byte(wc * 32 + fr, fq * 8);
#define PG8_SA(b, h) (((b) * 2 + (h)) * HTB)
#define PG8_SB(b, h) ((4 + (b) * 2 + (h)) * HTB)
#define PG8_STAGE(bufoff, gbase, voff) do { _Pragma("unroll") for (int _i = 0; _i < 2; ++_i) \
        __builtin_amdgcn_global_load_lds((const unsigned*)((const char*)(gbase) + (voff)[_i]), (LAS unsigned*)(lds + (bufoff) + ldsw + _i * 8192), 16, 0, 0); } while (0)
#define PG8_LDA(dst, b, h) do { _Pragma("unroll") for (int m = 0; m < 4; ++m) _Pragma("unroll") for (int k = 0; k < 2; ++k) dst[m][k] = *(const LAS bf16x8*)(lds + PG8_SA(b, h) + aoff + m * 2048 + k * 1024); } while (0)
#define PG8_LDB(dst, b, h) do { _Pragma("unroll") for (int n = 0; n < 2; ++n) _Pragma("unroll") for (int k = 0; k < 2; ++k) dst[n][k] = *(const LAS bf16x8*)(lds + PG8_SB(b, h) + boff + n * 2048 + k * 1024); } while (0)
#define PG8_MMA(ai, bj, At, Bt) do { __builtin_amdgcn_s_setprio(1); _Pragma("unroll") for (int m = 0; m < 4; ++m) _Pragma("unroll") for (int n = 0; n < 2; ++n) _Pragma("unroll") for (int k = 0; k < 2; ++k) \
        acc[ai][bj][m][n] = __builtin_amdgcn_mfma_f32_16x16x32_bf16(Bt[n][k], At[m][k], acc[ai][bj][m][n], 0, 0, 0); __builtin_amdgcn_s_setprio(0); } while (0)
#define PG8_WAIT_V(n) asm volatile("s_waitcnt vmcnt(" #n ")" ::: "memory")
#define PG8_WAIT_L(n) asm volatile("s_waitcnt lgkmcnt(" #n ")" ::: "memory")
#define PG8_BAR __builtin_amdgcn_s_barrier()
#define PG8_SCHED __builtin_amdgcn_sched_barrier(0)
    Unit cur, nxt; int ui = 0;
    if (!S.next(0, cur)) return;
    f32x4 acc[2][2][4][2];
#pragma unroll
    for (int a = 0; a < 2; ++a)
#pragma unroll
        for (int b = 0; b < 2; ++b)
#pragma unroll
            for (int m = 0; m < 4; ++m)
#pragma unroll
                for (int n = 0; n < 2; ++n) acc[a][b][m][n] = (f32x4){0.f, 0.f, 0.f, 0.f};
    bf16x8 At[4][2], B0[2][2], B1[2][2];
    const char* cA = (const char*)g.A + (size_t)cur.pm * tstep; const char* cB = (const char*)g.Bt + (size_t)cur.pn * tstep;
    PG8_STAGE(PG8_SB(0, 0), cB, voffB); PG8_STAGE(PG8_SA(0, 0), cA, voffA); PG8_STAGE(PG8_SB(0, 1), cB + hstep, voffB); PG8_STAGE(PG8_SA(0, 1), cA + hstep, voffA);
    if (wr == 1) PG8_BAR;
    PG8_WAIT_V(4); PG8_BAR;
    PG8_STAGE(PG8_SB(1, 0), cB + kstep, voffB); PG8_STAGE(PG8_SA(1, 0), cA + kstep, voffA); PG8_STAGE(PG8_SB(1, 1), cB + hstep + kstep, voffB);
    PG8_WAIT_V(6); PG8_BAR;
    for (;;) {
        const bool has_next = S.next(ui + 1, nxt);
        const char* nA = has_next ? (const char*)g.A + (size_t)nxt.pm * tstep : cA; const char* nB = has_next ? (const char*)g.Bt + (size_t)nxt.pn * tstep : cB;
        for (int t = 0; t < nt; t += 2) {
            const bool last = (t == nt - 2);
            const char* a1 = cA + (size_t)(t + 1) * kstep;
            const char* a2 = last ? nA : cA + (size_t)(t + 2) * kstep; const char* b2 = last ? nB : cB + (size_t)(t + 2) * kstep;
            const char* a3 = a2 + kstep; const char* b3 = b2 + kstep;
            PG8_LDB(B0, 0, 0); PG8_SCHED; PG8_LDA(At, 0, 0); PG8_STAGE(PG8_SA(1, 1), a1 + hstep, voffA);
            PG8_WAIT_L(8); PG8_BAR; PG8_WAIT_L(0); PG8_MMA(0, 0, At, B0); PG8_BAR; PG8_SCHED;
            PG8_LDB(B1, 0, 1); PG8_STAGE(PG8_SB(0, 0), b2, voffB);
            PG8_BAR; PG8_WAIT_L(0); PG8_MMA(0, 1, At, B1); PG8_BAR;
            PG8_LDA(At, 0, 1); PG8_STAGE(PG8_SA(0, 0), a2, voffA);
            PG8_BAR; PG8_WAIT_L(0); PG8_MMA(1, 0, At, B0); PG8_BAR; PG8_SCHED;
            PG8_STAGE(PG8_SB(0, 1), b2 + hstep, voffB);
            PG8_WAIT_V(6); PG8_BAR; PG8_MMA(1, 1, At, B1); PG8_BAR;
            PG8_LDB(B0, 1, 0); PG8_SCHED; PG8_LDA(At, 1, 0); PG8_STAGE(PG8_SA(0, 1), a2 + hstep, voffA);
            PG8_WAIT_L(8); PG8_BAR; PG8_WAIT_L(0); PG8_MMA(0, 0, At, B0); PG8_BAR; PG8_SCHED;
            PG8_LDB(B1, 1, 1); PG8_STAGE(PG8_SB(1, 0), b3, voffB);
            PG8_BAR; PG8_WAIT_L(0); PG8_MMA(0, 1, At, B1); PG8_BAR;
            PG8_LDA(At, 1, 1); PG8_STAGE(PG8_SA(1, 0), a3, voffA);
            PG8_BAR; PG8_WAIT_L(0); PG8_MMA(1, 0, At, B0); PG8_BAR; PG8_SCHED;
            PG8_STAGE(PG8_SB(1, 1), b3 + hstep, voffB);
            PG8_WAIT_V(6); PG8_BAR; PG8_MMA(1, 1, At, B1); PG8_BAR;
        }
        E(acc, cur, wr, wc, fr, fq);
        if (!has_next) break;
#pragma unroll
        for (int a = 0; a < 2; ++a)
#pragma unroll
            for (int b = 0; b < 2; ++b)
#pragma unroll
                for (int m = 0; m < 4; ++m)
#pragma unroll
                    for (int n = 0; n < 2; ++n) acc[a][b][m][n] = (f32x4){0.f, 0.f, 0.f, 0.f};
        cur = nxt; cA = nA; cB = nB; ++ui;
    }
    PG8_WAIT_V(0);
    if (wr == 0) PG8_BAR;
    PG8_BAR;
#undef PG8_SA
#undef PG8_SB
#undef PG8_STAGE
#undef PG8_LDA
#undef PG8_LDB
#undef PG8_MMA
#undef PG8_WAIT_V
#undef PG8_WAIT_L
#undef PG8_BAR
#undef PG8_SCHED
}
}


#define XB_TMO      128
#define XB_XCNT(j)  (256  + 64 * (j))
#define XB_XSUB(j)  (1280 + 64 * (j))
#define XB_XGEN(j)  (2304 + 64 * (j))
#define XB_TOP      3328
#define XB_TOPGEN   3392
#define XCD_BAR_WORDS 3456
#define XB_SPIN_CAP (1u << 18)
__device__ __forceinline__ unsigned xb_ld(unsigned* p)              { return __hip_atomic_load(p, __ATOMIC_RELAXED, __HIP_MEMORY_SCOPE_AGENT); }
__device__ __forceinline__ unsigned xb_add(unsigned* p, unsigned v) { return __hip_atomic_fetch_add(p, v, __ATOMIC_RELAXED, __HIP_MEMORY_SCOPE_AGENT); }
__device__ __forceinline__ unsigned xb_xcc_id() { return (unsigned)__builtin_amdgcn_s_getreg((3 << 11) | 20) & 0xFu; }
#define XB_SPIN(cond, bar) do { unsigned _sp = 0; while (cond) { __builtin_amdgcn_s_sleep(1); \
    if ((++_sp & 255u) == 0u) { if (xb_ld(&(bar)[XB_TMO])) break; if (_sp > XB_SPIN_CAP) { atomicAdd(&(bar)[XB_TMO], 1u); break; } } } } while (0)
struct XcdBarrier { unsigned* bar; unsigned x; volatile LAS unsigned* st; };
__device__ __forceinline__ XcdBarrier xcd_barrier_post(unsigned* bar, volatile LAS unsigned* st) {
    XcdBarrier b; b.bar = bar; b.x = xb_xcc_id(); b.st = st;
    if (threadIdx.x == 0) (void)xb_add(&bar[XB_XCNT(b.x)], 1u);
    return b;
}
__device__ __forceinline__ void xcd_barrier_complete(unsigned* bar, unsigned x, unsigned& nloc, unsigned& nx) {
    const unsigned G = gridDim.x * gridDim.y * gridDim.z;
    unsigned sum, cnt, mine, sp = 0u;
    for (;;) {
        sum = 0u; cnt = 0u; mine = 0u;
#pragma unroll
        for (unsigned j = 0; j < 16; ++j) { const unsigned c = xb_ld(&bar[XB_XCNT(j)]); sum += c; cnt += (c > 0u) ? 1u : 0u; mine = (j == x) ? c : mine; }
        if (sum == G) break;
        __builtin_amdgcn_s_sleep(1);
        if ((++sp & 255u) == 0u) { if (xb_ld(&bar[XB_TMO])) break; if (sp > XB_SPIN_CAP) { atomicAdd(&bar[XB_TMO], 1u); break; } }
    }
    nloc = mine > 0u ? mine : 1u; nx = cnt > 0u ? cnt : 1u;
}
__device__ __forceinline__ void xcd_barrier(const XcdBarrier& b, const int wv0) {
    asm volatile("s_waitcnt vmcnt(0)" ::: "memory");
    __syncthreads();
    if (opaque_tid(wv0) == 0) {
        unsigned* bar = b.bar;
        __builtin_amdgcn_s_waitcnt(0);
        unsigned nloc = b.st[0], nx = b.st[1];
        if (nloc == 0u) { xcd_barrier_complete(bar, b.x, nloc, nx); b.st[0] = nloc; b.st[1] = nx; }
        const unsigned old = xb_add(&bar[XB_XSUB(b.x)], 1u);
        const unsigned gen = old / nloc;
        if (old + 1u == (gen + 1u) * nloc) {
            __builtin_amdgcn_fence(__ATOMIC_RELEASE, "agent");
            asm volatile("s_waitcnt vmcnt(0)" ::: "memory");
            const unsigned og = xb_add(&bar[XB_TOP], 1u);
            const unsigned tg = og / nx;
            if (og + 1u == (tg + 1u) * nx) xb_add(&bar[XB_TOPGEN], 1u);
            else XB_SPIN(xb_ld(&bar[XB_TOPGEN]) == tg, bar);
            __builtin_amdgcn_fence(__ATOMIC_ACQUIRE, "agent");
            xb_add(&bar[XB_XGEN(b.x)], 1u);
            asm volatile("s_waitcnt vmcnt(0)" ::: "memory");
        } else {
            XB_SPIN(xb_ld(&bar[XB_XGEN(b.x)]) == gen, bar);
            __builtin_amdgcn_fence(__ATOMIC_ACQUIRE, "agent");
            asm volatile("s_waitcnt vmcnt(0)" ::: "memory");
        }
    }
    __syncthreads();
}

struct Frame {
    LAS unsigned char* lds;
    int vcu, G, wv;
    const float* const* in; float* out; unsigned char* ws;
    __device__ __forceinline__ float* MOD() const { return (float*)(ws + WS_MOD); }
    __device__ __forceinline__ float* ROPE() const { return (float*)(ws + WS_ROPE); }
    __device__ __forceinline__ float* BA() const { return (float*)(ws + WS_BA); }
    __device__ __forceinline__ float* LAG() const { return (float*)(ws + WS_LAG); }
    __device__ __forceinline__ bf16_t* W1O() const { return (bf16_t*)(ws + WS_W1O); }
    __device__ __forceinline__ bf16_t* U0() const { return (bf16_t*)(ws + WS_RA); }
    __device__ __forceinline__ bf16_t* QKV1() const { return (bf16_t*)(ws + WS_RA); }
    __device__ __forceinline__ bf16_t* Z1() const { return (bf16_t*)(ws + WS_RA + (size_t)MT * 3072 * 2); }
    __device__ __forceinline__ bf16_t* Y1() const { return (bf16_t*)(ws + WS_RA + (size_t)MT * 3072 * 2); }
    __device__ __forceinline__ bf16_t* XN() const { return (bf16_t*)(ws + WS_RB + RB_XN); }
    __device__ __forceinline__ bf16_t* Y0() const { return (bf16_t*)(ws + WS_RB + RB_Y0); }
    __device__ __forceinline__ bf16_t* YO() const { return (bf16_t*)(ws + WS_RB + RB_YO); }
    __device__ __forceinline__ bf16_t* W0I() const { return (bf16_t*)(ws + WS_RB + RB_W0I); }
    __device__ __forceinline__ bf16_t* W0O() const { return (bf16_t*)(ws + WS_RB + RB_W0O); }
    __device__ __forceinline__ bf16_t* W1I() const { return (bf16_t*)(ws + WS_RB + RB_W1I); }
    __device__ __forceinline__ bf16_t* QKVC() const { return (bf16_t*)(ws + WS_RB); }
};

#define PHASE_IDS() int tid = opaque_tid(F.wv); const int lane = tid & 63, wave = __builtin_amdgcn_readfirstlane(tid >> 6); (void)lane; (void)wave
__device__ __forceinline__ void p0_transpose_item(const float* W, int ldw, int nblk, int K, bf16_t* WT, LAS float* scr, int item, int lane) {
    const int kb = item / nblk, nb = item % nblk, k0 = 64 * kb, n0 = 32 * nb;
    f32x4 v[8];
#pragma unroll
    for (int i = 0; i < 8; ++i) v[i] = *(const f32x4*)(W + (size_t)(k0 + 8 * i + (lane >> 3)) * ldw + n0 + 4 * (lane & 7));
#pragma unroll
    for (int i = 0; i < 8; ++i) { LAS float* d = scr + (8 * i + (lane >> 3)) * 33 + 4 * (lane & 7); d[0] = v[i][0]; d[1] = v[i][1]; d[2] = v[i][2]; d[3] = v[i][3]; }
    asm volatile("s_waitcnt lgkmcnt(0)" ::: "memory");
    const int c = lane & 7;
#pragma unroll
    for (int j = 0; j < 4; ++j) { const int n = (lane >> 3) + 8 * j; const LAS float* s = scr + (8 * c) * 33 + n;
        u32x4 o; o.x = pk2(s[0 * 33], s[1 * 33]); o.y = pk2(s[2 * 33], s[3 * 33]); o.z = pk2(s[4 * 33], s[5 * 33]); o.w = pk2(s[6 * 33], s[7 * 33]);
        *(u32x4*)(WT + (size_t)(n0 + n) * K + k0 + 8 * c) = o; }
    asm volatile("s_waitcnt lgkmcnt(0)" ::: "memory");
}
constexpr size_t WS_MODP = 12 * MiB;
__device__ __forceinline__ f32x4 mod4(const float* MODP, int L, int s, int off) {
    f32x4 a = *(const f32x4*)(MODP + ((size_t)((L * 4 + 0) * 24 + s)) * 3072 + off);
#pragma unroll
    for (int sl = 1; sl < 4; ++sl) a += *(const f32x4*)(MODP + ((size_t)((L * 4 + sl) * 24 + s)) * 3072 + off);
    return a;
}
__device__ __forceinline__ void mod_task(Frame& F, const int bt, const int tid, const int lane, const int wave) {
    const int L = bt / 192, sl = (bt % 192) / 48, n0 = (bt % 48) * 64, kb = sl * 256;
    LAS float* tab = (LAS float*)F.lds;
    {   float cv[12];
#pragma unroll
        for (int u = 0; u < 12; ++u) { const int idx = tid + 512 * u, s = idx >> 8, k = kb + (idx & 255); cv[u] = s < BP ? F.in[8][s * D + k] : F.in[9][(s - BP) * D + k]; }
#pragma unroll
        for (int u = 0; u < 12; ++u) { const int idx = tid + 512 * u, s = idx >> 8, k = idx & 255; tab[k * 24 + s] = siluf_(cv[u]); } }
    __syncthreads();
    const float* mw = (L == 0 ? F.in[10] : F.in[24]) + n0 + lane;
    float acc[24];
#pragma unroll
    for (int r = 0; r < 24; ++r) acc[r] = 0.f;
    for (int k0 = wave * 32; k0 < wave * 32 + 32; k0 += 16) {
        float wv[16];
#pragma unroll
        for (int u = 0; u < 16; ++u) wv[u] = mw[(size_t)(kb + k0 + u) * 3072];
#pragma unroll
        for (int u = 0; u < 16; ++u) { const float w = wv[u];
            const LAS f32x4* tp = (const LAS f32x4*)(tab + (k0 + u) * 24);
#pragma unroll
            for (int q = 0; q < 6; ++q) { const f32x4 t4 = tp[q]; acc[4 * q] += t4[0] * w; acc[4 * q + 1] += t4[1] * w; acc[4 * q + 2] += t4[2] * w; acc[4 * q + 3] += t4[3] * w; } }
    }
    __syncthreads();
    LAS float* red = (LAS float*)F.lds;
#pragma unroll
    for (int r = 0; r < 24; ++r) red[(wave * 24 + r) * 64 + lane] = acc[r];
    __syncthreads();
    const float* mb = (L == 0 ? F.in[11] : F.in[25]);
    float* MODP = (float*)(F.ws + WS_MODP);
    for (int idx = tid; idx < 24 * 64; idx += 512) { const int r = idx >> 6, l = idx & 63; float s = 0.f;
#pragma unroll
        for (int w = 0; w < 8; ++w) s += red[(w * 24 + r) * 64 + l];
        MODP[((size_t)((L * 4 + sl) * 24 + r)) * 3072 + n0 + l] = s + (sl == 0 ? mb[n0 + l] : 0.f); }
    __syncthreads();
}
__device__ __forceinline__ void phase_mod0(Frame& F) {
    PHASE_IDS();
    for (int bt = F.vcu; bt < 192; bt += F.G) { int t2 = tid; asm volatile("" : "+v"(t2)); mod_task(F, bt, t2, t2 & 63, wave); }
}
__device__ __forceinline__ void phase_mod1(Frame& F) {
    PHASE_IDS();
    __syncthreads();
    for (int bt = 192 + F.vcu; bt < 384; bt += F.G) { int t2 = tid; asm volatile("" : "+v"(t2)); mod_task(F, bt, t2, t2 & 63, wave); }
}
__device__ __forceinline__ void phase_prologue(Frame& F) {
    PHASE_IDS();
    const int gw = F.vcu * 8 + wave, NGW = F.G * 8;
    {
        LAS float* scr = (LAS float*)(F.lds + wave * 16384);
        constexpr int I0 = 16 * (EV_IN / 32), I1 = 16 * 32, I2 = 16 * (OD_MAIN / 32), I3 = 16 * 32;
        for (int it = gw; it < I0 + I1 + I2 + I3; it += NGW) {
            int r = it;
            if (r < I0) { p0_transpose_item(F.in[14], EV_IN, EV_IN / 32, D, F.W0I(), scr, r, lane); continue; } r -= I0;
            if (r < I1) { p0_transpose_item(F.in[23], D, 32, D, F.W0O(), scr, r, lane); continue; } r -= I1;
            if (r < I2) { p0_transpose_item(F.in[28], OD_IN, OD_MAIN / 32, D, F.W1I(), scr, r, lane); continue; } r -= I2;
            p0_transpose_item(F.in[33], D, 32, D, F.W1O(), scr, r, lane);
        }
    }
    {
        const double inv[8] = {1.0, 0.19392274474868576, 0.03760603093086393, 0.007292664737217109, 0.001414213562373095, 0.0002742481756762073, 5.318295896944988e-05, 1.031338537721246e-05};
        for (int idx = F.vcu * 512 + tid; idx < 4112 * 8; idx += F.G * 512) {
            const int pos = idx >> 3, i = idx & 7;
            double iv = inv[0];
#pragma unroll
            for (int q = 1; q < 8; ++q) iv = (i == q) ? inv[q] : iv;
            const double ang = (double)pos * iv;
            const double n = __builtin_rint(ang * 0.15915494309189535);
            const float r = (float)__builtin_fma(-n, 6.283185307179586, ang);
            F.ROPE()[pos * 16 + i] = __cosf(r); F.ROPE()[pos * 16 + 8 + i] = __sinf(r);
        }
    }
    {
        bf16_t* LGW = (bf16_t*)(F.ws + WS_LGW);
        for (int idx = F.vcu * 512 + tid; idx < 8 * 2 * 64 * 64; idx += F.G * 512) { const int k = idx & 63, n = (idx >> 6) & 63, gate = (idx >> 12) & 1, hh = idx >> 13;
            LGW[idx] = (bf16_t)f2bf((gate ? F.in[19] : F.in[17])[(hh * 64 + k) * 64 + n]); }
    }
}

__device__ __forceinline__ const float* x_row(Frame& F, int m) { return m < MP ? F.in[0] + (size_t)m * D : F.in[1] + (size_t)(m - MP) * D; }
__device__ __forceinline__ void rows_prenorm0(Frame& F, const int m0, const int n, const int s, const int lane) {
    const float* MODP = (const float*)(F.ws + WS_MODP);
    f32x4 A[4], C[4];
#pragma unroll
    for (int j = 0; j < 4; ++j) { const int c = 4 * lane + 256 * j; const f32x4 g = *(const f32x4*)(F.in[12] + c), sc = mod4(MODP, 0, s, 1024 + c); C[j] = mod4(MODP, 0, s, c);
#pragma unroll
        for (int e = 0; e < 4; ++e) A[j][e] = g[e] * (1.f + sc[e]); }
    f32x4 cur[4];
#pragma unroll
    for (int j = 0; j < 4; ++j) cur[j] = *(const f32x4*)(x_row(F, m0) + 4 * lane + 256 * j);
    for (int i = 0; i < n; ++i) {
        const int mn = m0 + (i + 1 < n ? i + 1 : i); f32x4 nxt[4];
#pragma unroll
        for (int j = 0; j < 4; ++j) nxt[j] = *(const f32x4*)(x_row(F, mn) + 4 * lane + 256 * j);
        float ss = 0.f;
#pragma unroll
        for (int j = 0; j < 4; ++j) ss += (cur[j][0] * cur[j][0] + cur[j][1] * cur[j][1]) + (cur[j][2] * cur[j][2] + cur[j][3] * cur[j][3]);
        const float r = rsqrtf(wave_sum(ss, lane) * (1.f / D) + EPS);
#pragma unroll
        for (int j = 0; j < 4; ++j) { u32x2 w; w[0] = cvt2(cur[j][0] * r * A[j][0] + C[j][0], cur[j][1] * r * A[j][1] + C[j][1]); w[1] = cvt2(cur[j][2] * r * A[j][2] + C[j][2], cur[j][3] * r * A[j][3] + C[j][3]);
            *(u32x2*)(F.XN() + (size_t)(m0 + i) * D + 4 * lane + 256 * j) = w; }
#pragma unroll
        for (int j = 0; j < 4; ++j) cur[j] = nxt[j];
    }
}
__device__ __forceinline__ void phase_prenorm0(Frame& F) {
    PHASE_IDS();
    const int gw = F.vcu * 8 + wave, NGW = F.G * 8;
    for (int w = gw; w < MP / 16; w += NGW) rows_prenorm0(F, w * 16, 16, w >> 8, lane);
    for (int w = gw; w < MS; w += NGW) rows_prenorm0(F, MP + w, 1, BP + (w >> 4), lane);
}

__device__ __forceinline__ void phase_rope(Frame& F) {
    PHASE_IDS();
    const int gt = F.vcu * 512 + tid, NT = F.G * 512;
    for (int idx = gt; idx < MT * 10; idx += NT) {
        const int m = idx / 10, slot = idx % 10;
        int s, t; tok_info(m, s, t);
        const int pos = s < BP ? t : TP + t;
        const int col = slot < 8 ? C_Q + slot * 64 : C_K + (slot - 8) * 64;
        u32x4* p = (u32x4*)(F.U0() + (size_t)m * EV_IN + col);
        const u32x4 xa = p[0], xb = p[1];
        const f32x4* rp = (const f32x4*)(F.ROPE() + pos * 16); const f32x4 c0 = rp[0], c1 = rp[1], s0 = rp[2], s1 = rp[3];
        float x1[8], x2[8], o1[8], o2[8];
#pragma unroll
        for (int e = 0; e < 4; ++e) { x1[2 * e] = lo16(xa[e]); x1[2 * e + 1] = hi16(xa[e]); x2[2 * e] = lo16(xb[e]); x2[2 * e + 1] = hi16(xb[e]); }
#pragma unroll
        for (int i = 0; i < 8; ++i) { const float c = i < 4 ? c0[i & 3] : c1[i & 3], sn = i < 4 ? s0[i & 3] : s1[i & 3]; o1[i] = x1[i] * c - x2[i] * sn; o2[i] = x2[i] * c + x1[i] * sn; }
        u32x4 ya, yb;
#pragma unroll
        for (int e = 0; e < 4; ++e) { ya[e] = cvt2(o1[2 * e], o1[2 * e + 1]); yb[e] = cvt2(o2[2 * e], o2[2 * e + 1]); }
        p[0] = ya; p[1] = yb;
        if (slot >= 8) { const int kv = slot - 8; float* o = nullptr;
            if (s >= BP) o = F.out + O_KS + ((size_t)((s - BP) * TS + t) * 2 + kv) * 64;
            else if (t >= TP - 128) o = F.out + O_KP + ((size_t)(s * 128 + (t - (TP - 128))) * 2 + kv) * 64;
            if (o) { *(f32x4*)o = (f32x4){o1[0], o1[1], o1[2], o1[3]}; *(f32x4*)(o + 4) = (f32x4){o1[4], o1[5], o1[6], o1[7]}; *(f32x4*)(o + 8) = (f32x4){o2[0], o2[1], o2[2], o2[3]}; *(f32x4*)(o + 12) = (f32x4){o2[4], o2[5], o2[6], o2[7]}; } }
    }
    for (int idx = gt; idx < 1280 * 224; idx += NT) {
        const int tk = idx / 224, e = idx % 224;
        int s, t, m; if (tk < 1024) { s = tk >> 7; t = TP - 128 + (tk & 127); m = s * TP + t; } else { s = BP + ((tk - 1024) >> 4); t = (tk - 1024) & 15; m = MP + (tk - 1024); }
        const bool isv = e >= 96; const int e2 = isv ? e - 96 : e; const int kv = isv ? (e2 >> 6) : (e2 / 48), d = isv ? (e2 & 63) : 16 + (e2 % 48);
        const float val = bf2f(F.U0()[(size_t)m * EV_IN + (isv ? C_V : C_K) + kv * 64 + d]);
        const size_t ob = s >= BP ? (isv ? O_VS : O_KS) + ((size_t)((s - BP) * TS + t) * 2 + kv) * 64 : (isv ? O_VP : O_KP) + ((size_t)(s * 128 + (t - (TP - 128))) * 2 + kv) * 64;
        F.out[ob + d] = val;
    }
}


#define MFMA32(a, b, c) __builtin_amdgcn_mfma_f32_32x32x16_bf16((a), (b), (c), 0, 0, 0)
#define MFMA16(a, b, c) __builtin_amdgcn_mfma_f32_16x16x32_bf16((a), (b), (c), 0, 0, 0)
typedef __amdgpu_buffer_rsrc_t brsrc_t;
__device__ __forceinline__ brsrc_t staging_rsrc(unsigned char* ws) { return __builtin_amdgcn_make_buffer_rsrc((void*)(ws + WS_RB), (short)0, (int)RB_BYTES, 0x00020000); }
__device__ __forceinline__ void st16_wt(brsrc_t r, unsigned off, u32x4 v) { __builtin_amdgcn_raw_buffer_store_b128(v, r, off, 0, 16); }
__device__ __forceinline__ u32x4 ld16_wt(brsrc_t r, unsigned off) { return __builtin_amdgcn_raw_buffer_load_b128(r, off, 0, 16); }
__device__ __forceinline__ void rows_mid(Frame& F, const LAS unsigned char* bawb, const int m0, const int n, const int s, const int lane) {
    const float* MODP = (const float*)(F.ws + WS_MODP);
    f32x4 A0[4], B1[4], C1[4];
#pragma unroll
    for (int j = 0; j < 4; ++j) { const int c = 4 * lane + 256 * j; const f32x4 g0 = *(const f32x4*)(F.in[13] + c), gt = mod4(MODP, 0, s, 2048 + c), g1 = *(const f32x4*)(F.in[26] + c), sc = mod4(MODP, 1, s, 1024 + c);
        C1[j] = mod4(MODP, 1, s, c);
#pragma unroll
        for (int e = 0; e < 4; ++e) { A0[j][e] = gt[e] * g0[e]; B1[j][e] = g1[e] * (1.f + sc[e]); } }
    u32x2 ycur[4]; f32x4 xcur[4];
#pragma unroll
    for (int j = 0; j < 4; ++j) { ycur[j] = *(const u32x2*)(F.YO() + (size_t)m0 * D + 4 * lane + 256 * j); xcur[j] = *(const f32x4*)(x_row(F, m0) + 4 * lane + 256 * j); }
    for (int i = 0; i < n; ++i) {
        const int m = m0 + i, mn = m0 + (i + 1 < n ? i + 1 : i); u32x2 ynxt[4]; f32x4 xnxt[4];
#pragma unroll
        for (int j = 0; j < 4; ++j) { ynxt[j] = *(const u32x2*)(F.YO() + (size_t)mn * D + 4 * lane + 256 * j); xnxt[j] = *(const f32x4*)(x_row(F, mn) + 4 * lane + 256 * j); }
        f32x4 y[4]; float ss = 0.f;
#pragma unroll
        for (int j = 0; j < 4; ++j) { y[j] = (f32x4){lo16(ycur[j][0]), hi16(ycur[j][0]), lo16(ycur[j][1]), hi16(ycur[j][1])}; ss += (y[j][0] * y[j][0] + y[j][1] * y[j][1]) + (y[j][2] * y[j][2] + y[j][3] * y[j][3]); }
        const float r1 = rsqrtf(wave_sum(ss, lane) * (1.f / D) + EPS);
        f32x4 x1[4]; float s2 = 0.f;
#pragma unroll
        for (int j = 0; j < 4; ++j) {
#pragma unroll
            for (int e = 0; e < 4; ++e) x1[j][e] = xcur[j][e] + A0[j][e] * (y[j][e] * r1);
            *(f32x4*)(F.out + O_Y + (size_t)m * D + 4 * lane + 256 * j) = x1[j];
            s2 += (x1[j][0] * x1[j][0] + x1[j][1] * x1[j][1]) + (x1[j][2] * x1[j][2] + x1[j][3] * x1[j][3]); }
        const float r2 = rsqrtf(wave_sum(s2, lane) * (1.f / D) + EPS);
        f32x4 hm[4];
#pragma unroll
        for (int j = 0; j < 4; ++j) {
#pragma unroll
            for (int e = 0; e < 4; ++e) hm[j][e] = x1[j][e] * r2 * B1[j][e] + C1[j][e];
            u32x2 w; w[0] = cvt2(hm[j][0], hm[j][1]); w[1] = cvt2(hm[j][2], hm[j][3]); *(u32x2*)(F.XN() + (size_t)m * D + 4 * lane + 256 * j) = w; }
#pragma unroll
        for (int j = 0; j < 4; ++j) { ycur[j] = ynxt[j]; xcur[j] = xnxt[j]; }
    }
    asm volatile("s_waitcnt vmcnt(0)" ::: "memory");
    {   const brsrc_t rs = staging_rsrc(F.ws);
        const int r = lane & 15, g = lane >> 4;
        const unsigned abase = (unsigned)RB_XN + (unsigned)(m0 + (r < n ? r : 0)) * (unsigned)(D * 2) + (unsigned)g * 16u;
        f32x4 acc = {0.f, 0.f, 0.f, 0.f};
#pragma unroll
        for (int h = 0; h < 2; ++h) { u32x4 a[16];
#pragma unroll
            for (int k = 0; k < 16; ++k) a[k] = ld16_wt(rs, abase + (unsigned)(h * 16 + k) * 64u);
#pragma unroll
            for (int k = 0; k < 16; ++k) acc = MFMA16(__builtin_bit_cast(bf16x8, a[k]), *(const LAS bf16x8*)(bawb + ((h * 16 + k) * 64 + lane) * 16), acc); }
        const int hh = r & 7; const float ea = -__expf(F.in[30][hh]), db = F.in[31][hh];
#pragma unroll
        for (int e = 0; e < 4; ++e) { const int row = 4 * g + e; if (row < n) F.BA()[(size_t)(m0 + row) * 16 + r] = r < 8 ? sigmoidf_(acc[e]) : ea * softplusf_(acc[e] + db); }
    }
}
__device__ __forceinline__ void phase_mid_rowwise(Frame& F) {
    PHASE_IDS();
    LAS unsigned char* bawb = F.lds;
    for (int idx = tid; idx < 32 * 64; idx += 512) { const int kk = idx >> 6, l = idx & 63, c = l & 15, g = l >> 4; const float* wp = F.in[28] + (size_t)(32 * kk + 8 * g) * OD_IN + OD_MAIN + c;
        u32x4 w; w[0] = cvt2(wp[0], wp[OD_IN]); w[1] = cvt2(wp[2 * OD_IN], wp[3 * OD_IN]); w[2] = cvt2(wp[4 * OD_IN], wp[5 * OD_IN]); w[3] = cvt2(wp[6 * OD_IN], wp[7 * OD_IN]);
        *(LAS u32x4*)(bawb + idx * 16) = w; }
    __syncthreads();
    const int gw = F.vcu * 8 + wave, NGW = F.G * 8;
    for (int w = gw; w < MP / 16; w += NGW) rows_mid(F, bawb, w * 16, 16, w >> 8, lane);
    for (int w = gw; w < MS; w += NGW) rows_mid(F, bawb, MP + w, 1, BP + (w >> 4), lane);
}


typedef float f32x16 __attribute__((ext_vector_type(16)));
constexpr int GS_WF = 0, GS_QF = 16384, GS_KF = 32768, GS_PF = 49152, GS_UF = 57344, GS_BYTES = 73728;
constexpr size_t WS_DEC = 11 * MiB;
__device__ __forceinline__ int krow(int s, int h, int j) { return 16 * s + 8 * (j >> 2) + 4 * h + (j & 3); }

__device__ __forceinline__ void st8_wt(unsigned char* p, u32x2 v) { __hip_atomic_store((unsigned long long*)p, ((unsigned long long)v[1] << 32) | v[0], __ATOMIC_RELAXED, __HIP_MEMORY_SCOPE_AGENT); }
constexpr size_t WS_READY = 65536;
#define LDS_BARRIER() do { asm volatile("s_waitcnt lgkmcnt(0)" ::: "memory"); __builtin_amdgcn_s_barrier(); asm volatile("" ::: "memory"); } while (0)
constexpr int G1_QS = 0, G1_KS = 17408, G1_VS = 34816, G1_AS = 52224, G1_PS = 69632, G1_WS = 78848, G1_CW = 96256, G1_VEC = 102400, G1_ES = 103424;
__device__ __forceinline__ void g1_load_raw(Frame& F, u32x4 (&raw)[24], int s, int c, int h, int t1) {
    const int r = t1 >> 3, j = t1 & 7, t = c * 64 + r;
#pragma unroll
    for (int p = 0; p < 3; ++p)
#pragma unroll
        for (int jj = 0; jj < 4; ++jj) { const int tt = t - 3 + jj, ttc = tt < 0 ? 0 : tt;
            const u32x4* src = (const u32x4*)(F.QKV1() + (size_t)(s * TP + ttc) * 3072 + p * 1024 + h * 128 + j * 16); raw[p * 8 + jj * 2] = src[0]; raw[p * 8 + jj * 2 + 1] = src[1]; }
}
__device__ __forceinline__ bf16x8 g1_pack_b(const f32x4 p, const f32x4 q) { u32x4 w; w[0] = cvt2(p[0], p[1]); w[1] = cvt2(p[2], p[3]); w[2] = cvt2(q[0], q[1]); w[3] = cvt2(q[2], q[3]); return __builtin_bit_cast(bf16x8, w); }
__device__ __forceinline__ void g1_decode(int n, int& s, int& c, int& h) { if (n < 4096) { c = n >> 6; s = (n & 63) >> 3; h = n & 7; } else { s = BP + ((n - 4096) >> 3); c = 0; h = n & 7; } }
constexpr int P2_SET = 52224, P2_Q = 0, P2_K = 17408, P2_V = 34816;
constexpr int P2_AS = 2 * P2_SET, P2_PS = P2_AS + 17408, P2_ES = P2_PS + 9216, P2_CW = P2_ES + 4096, P2_VEC = P2_CW + 6144;
static_assert(P2_VEC + 2048 <= LDS_BYTES - 64, "producer LDS map");
__device__ __forceinline__ void p2_load_part(Frame& F, u32x4 (&rw)[16], int s, int c, int h, int p, int tb) {
    const int r = tb >> 3, j = tb & 7;
#pragma unroll
    for (int it = 0; it < 2; ++it)
#pragma unroll
        for (int jj = 0; jj < 4; ++jj) { int tt = c * 64 + r + 32 * it - 3 + jj; tt = tt < 0 ? 0 : tt;
            const u32x4* src = (const u32x4*)(F.QKV1() + (size_t)(s * TP + tt) * 3072 + p * 1024 + h * 128 + j * 16); rw[it * 8 + jj * 2] = src[0]; rw[it * 8 + jj * 2 + 1] = src[1]; }
}
__device__ __forceinline__ void p2_conv_item(Frame& F, const u32x4 (&rw)[16], const int it, const f32x4 (&wreg)[16], const int p, const int j, const int lane, const bool ok, float* state_out, LAS u32x4* dst) {
    float acc[16];
#pragma unroll
    for (int e = 0; e < 16; ++e) acc[e] = 0.f;
#pragma unroll
    for (int jj = 0; jj < 4; ++jj) {
        const u32x4 a = rw[it * 8 + jj * 2], b = rw[it * 8 + jj * 2 + 1]; float x[16];
#pragma unroll
        for (int e = 0; e < 4; ++e) { x[2 * e] = lo16(a[e]); x[2 * e + 1] = hi16(a[e]); x[8 + 2 * e] = lo16(b[e]); x[8 + 2 * e + 1] = hi16(b[e]); }
#pragma unroll
        for (int q = 0; q < 4; ++q) { const f32x4 w4 = wreg[jj * 4 + q]; acc[4 * q] += w4[0] * x[4 * q]; acc[4 * q + 1] += w4[1] * x[4 * q + 1]; acc[4 * q + 2] += w4[2] * x[4 * q + 2]; acc[4 * q + 3] += w4[3] * x[4 * q + 3]; }
        if (jj == 3 && state_out) {
#pragma unroll
            for (int q = 0; q < 4; ++q) *(f32x4*)(state_out + 4 * q) = (f32x4){x[4 * q], x[4 * q + 1], x[4 * q + 2], x[4 * q + 3]}; }
    }
    float ss = 0.f;
#pragma unroll
    for (int e = 0; e < 16; ++e) { acc[e] = siluf_(acc[e]); ss += acc[e] * acc[e]; }
    if (p < 2) { ss += shfl_xor_l(ss, 1, lane); ss += shfl_xor_l(ss, 2, lane); ss += shfl_xor_l(ss, 4, lane);
        float sc = __builtin_amdgcn_rsqf(ss + EPS); if (p == 0) sc *= 0.08838834764831845f;
#pragma unroll
        for (int e = 0; e < 16; ++e) acc[e] *= sc; }
    u32x4 w0, w1;
#pragma unroll
    for (int e = 0; e < 4; ++e) { w0[e] = ok ? cvt2(acc[2 * e], acc[2 * e + 1]) : 0u; w1[e] = ok ? cvt2(acc[8 + 2 * e], acc[8 + 2 * e + 1]) : 0u; }
    dst[0] = w0; dst[1] = w1;
}
__device__ __forceinline__ void gdn_g1_tasks(Frame& F, const int first, const int stride) {
    LAS unsigned char* L = F.lds;
    LAS float* cw_s = (LAS float*)(L + P2_CW);
    float* DEC = (float*)(F.ws + WS_DEC);
    const brsrc_t srs = staging_rsrc(F.ws);
    unsigned* ready = (unsigned*)(F.ws + WS_READY);
    const int wave = F.wv;
    const bool grpB = wave >= 4;
    int ntask = 0; for (int t = first; t < 4224; t += stride) ++ntask;
    u32x4 rwA[16]; float pcw[6];
    if (grpB) {
        const int tb = opaque_tid(wave) - 256; int s0, c0, h0; g1_decode(first < 4095 ? first : 4095, s0, c0, h0);
        p2_load_part(F, rwA, s0, c0, h0, 0, tb);
#pragma unroll
        for (int q = 0; q < 6; ++q) { const int i = tb + 256 * q, jj = i / 384, cc = i % 384; pcw[q] = F.in[29][(size_t)jj * 3072 + (cc >> 7) * 1024 + h0 * 128 + (cc & 127)]; }
#pragma unroll
        for (int q = 0; q < 6; ++q) cw_s[tb + 256 * q] = pcw[q];
    }
    LDS_BARRIER();
    for (int i = 0; i <= ntask; ++i) {
        const int tid = opaque_tid(wave), lane = tid & 63;
        const int taskB = first + i * stride, taskA = taskB - stride;
        const bool actB = grpB && i < ntask, actA = !grpB && i >= 1;
        int s = 0, c = 0, h = 0; g1_decode(grpB ? (i < ntask ? taskB : 4095) : (i >= 1 ? taskA : 0), s, c, h);
        const int task = grpB ? taskB : taskA;
        const int sidx = task < 4096 ? ((s * 8 + h) * 64 + c) : task;
        const int nvalid = s < BP ? 64 : TS, t0 = c * 64, base = seq_base(s), T = seq_len(s);
        LAS unsigned char* Sb = L + (grpB ? (i & 1) : ((i - 1) & 1)) * P2_SET;
        LAS float* vec = (LAS float*)(L + P2_VEC + (grpB ? (i & 1) : ((i - 1) & 1)) * 1024); LAS float* beta_s = vec; LAS float* gcum_s = vec + 64; LAS float* eg_s = vec + 128; LAS float* ek_s = vec + 192;
        unsigned char* blk = F.ws + WS_RB + (size_t)sidx * GS_BYTES; const unsigned boff = (unsigned)sidx * (unsigned)GS_BYTES;
        float gvb = 0.f, gva = 0.f; int gs = 0, gc = 0, gh = 0; const bool gact = (wave == 3) && i < ntask;
        if (gact) { g1_decode(taskB, gs, gc, gh); if (lane < (gs < BP ? 64 : TS)) { const float* ba = F.BA() + (size_t)(seq_base(gs) + gc * 64 + lane) * 16; gvb = ba[gh]; gva = ba[8 + gh]; } }
        const int tb = tid - 256, rB = tb >> 3, jB = tb & 7;
#define P2_PART(p, rw) do { if (actB) { \
            if (s >= BP) { _Pragma("unroll") for (int it = 0; it < 2; ++it) _Pragma("unroll") for (int jj = 0; jj < 4; ++jj) { const int r_ = rB + 32 * it, tt = r_ - 3 + jj; u32x4 a_ = {0u, 0u, 0u, 0u}, b_ = {0u, 0u, 0u, 0u}; \
                    if (r_ < nvalid) { const int cb_ = (p) * 1024 + h * 128 + jB * 16; \
                        if (tt >= 0) { const u32x4* src = (const u32x4*)(F.QKV1() + (size_t)(base + tt) * 3072 + cb_); a_ = src[0]; b_ = src[1]; } \
                        else { const f32x4* src = (const f32x4*)(F.in[6] + ((size_t)(s - BP) * 3 + (tt + 3)) * 3072 + cb_); const f32x4 f0 = src[0], f1 = src[1], f2 = src[2], f3 = src[3]; \
                            a_[0] = cvt2(f0[0], f0[1]); a_[1] = cvt2(f0[2], f0[3]); a_[2] = cvt2(f1[0], f1[1]); a_[3] = cvt2(f1[2], f1[3]); b_[0] = cvt2(f2[0], f2[1]); b_[1] = cvt2(f2[2], f2[3]); b_[2] = cvt2(f3[0], f3[1]); b_[3] = cvt2(f3[2], f3[3]); } } \
                    rw[it * 8 + jj * 2] = a_; rw[it * 8 + jj * 2 + 1] = b_; } } \
            else if (t0 == 0 && rB < 3) { _Pragma("unroll") for (int jj = 0; jj < 3; ++jj) if (rB - 3 + jj < 0) { rw[jj * 2] = (u32x4){0u, 0u, 0u, 0u}; rw[jj * 2 + 1] = (u32x4){0u, 0u, 0u, 0u}; } } \
            f32x4 wreg_[16]; _Pragma("unroll") for (int jj = 0; jj < 4; ++jj) _Pragma("unroll") for (int q = 0; q < 4; ++q) wreg_[jj * 4 + q] = *(const LAS f32x4*)(cw_s + jj * 384 + (p) * 128 + jB * 16 + 4 * q);   \
            _Pragma("unroll") for (int it = 0; it < 2; ++it) { const int r_ = rB + 32 * it, t_ = t0 + r_; const bool ok_ = r_ < nvalid; \
                float* so_ = (ok_ && t_ >= T - 3) ? ((s < BP ? F.out + O_GCP + ((size_t)s * 3 + (t_ - (T - 3))) * 3072 : F.out + O_GCS + ((size_t)(s - BP) * 3 + (t_ - (T - 3))) * 3072) + (p) * 1024 + h * 128 + jB * 16) : nullptr; \
                p2_conv_item(F, rw, it, wreg_, (p), jB, lane, ok_, so_, (LAS u32x4*)(Sb + ((p) == 0 ? P2_Q : (p) == 1 ? P2_K : P2_V) + r_ * 272 + jB * 32)); } } } while (0)
        if (grpB) {
            P2_PART(0, rwA);
            if (actB && s < BP) p2_load_part(F, rwA, s, c, h, 1, tb);
        } else if (actA) {
            int l2 = lane; asm volatile("" : "+v"(l2));
            const int r = l2 & 31, hh = l2 >> 5;
#pragma unroll
            for (int half = 0; half < 2; ++half) {
                const int tile8 = wave + 4 * half, which = tile8 >> 2, ti = (tile8 >> 1) & 1, tj = tile8 & 1;
                f32x16 acc;
#pragma unroll
                for (int e = 0; e < 16; ++e) acc[e] = 0.f;
                if (!(ti == 0 && tj == 1)) {
                    const LAS unsigned char* ap = Sb + (which ? P2_Q : P2_K) + (32 * ti + r) * 272 + hh * 16;
                    const LAS unsigned char* bp = Sb + P2_K + (32 * tj + r) * 272 + hh * 16;
#pragma unroll
                    for (int ks = 0; ks < 8; ++ks) { const bf16x8 a = *(const LAS bf16x8*)(ap + ks * 32), b = *(const LAS bf16x8*)(bp + ks * 32); acc = MFMA32(a, b, acc); }
                }
                const int jc = 32 * tj + r; const float gj = gcum_s[jc];
#pragma unroll
                for (int e = 0; e < 16; ++e) {
                    const int ii = 32 * ti + (e & 3) + 8 * (e >> 2) + 4 * hh; const float dg = gcum_s[ii] - gj;
                    if (which == 0) { const float f = (ii > jc) ? __expf(dg) * beta_s[ii] : 0.f; *(LAS float*)(L + P2_AS + ii * 272 + jc * 4) = acc[e] * f; }
                    else { const float f = (ii >= jc) ? __expf(dg) : 0.f; *(LAS bf16_t*)(L + P2_PS + ii * 144 + jc * 2) = (bf16_t)(cvt2(acc[e] * f, 0.f) & 0xffffu); }
                }
            }
        }
        LDS_BARRIER();
        if (grpB) {
            P2_PART(1, rwA);
            if (actB && s < BP) p2_load_part(F, rwA, s, c, h, 2, tb);
        } else if (actA) {
            int l3 = lane; asm volatile("" : "+v"(l3));
            if (wave == 0) {
                const int bk = l3 >> 4, col = l3 & 15;
                float tcol[16];
#pragma unroll
                for (int rr = 0; rr < 16; ++rr) {
                    float a = (rr == col) ? 1.0f : 0.f;
#pragma unroll
                    for (int j4 = 0; j4 < (rr + 3) / 4; ++j4) { const f32x4 a4 = *(const LAS f32x4*)(L + P2_AS + (16 * bk + rr) * 272 + (16 * bk + 4 * j4) * 4);
#pragma unroll
                        for (int q = 0; q < 4; ++q) if (4 * j4 + q < rr) a -= a4[q] * tcol[4 * j4 + q]; }
                    tcol[rr] = a;
                    *(LAS float*)(L + P2_ES + ((bk * 16 + rr) * 16 + col) * 4) = a - ((rr == col) ? 1.0f : 0.f);
                }
            } else {
                const int r = l3 & 31, hh = l3 >> 5;
                if (wave == 1) {
#pragma unroll
                    for (int rt4 = 0; rt4 < 4; ++rt4)
#pragma unroll
                        for (int kt2 = 0; kt2 < 2; ++kt2)
#pragma unroll
                            for (int ss = 0; ss < 2; ++ss) { float v[8];
#pragma unroll
                                for (int j = 0; j < 8; ++j) { const int tok = 32 * kt2 + krow(ss, hh, j); v[j] = bf2f(*(const LAS bf16_t*)(Sb + P2_K + tok * 272 + (32 * rt4 + r) * 2)) * ek_s[tok]; }
                                u32x4 o; o[0] = cvt2(v[0], v[1]); o[1] = cvt2(v[2], v[3]); o[2] = cvt2(v[4], v[5]); o[3] = cvt2(v[6], v[7]);
                                st16_wt(srs, boff + GS_KF + ((rt4 * 2 + kt2) * 2 + ss) * 1024 + l3 * 16, o); }
                } else if (wave == 2) {
#pragma unroll
                    for (int kt = 0; kt < 4; ++kt)
#pragma unroll
                        for (int rt = 0; rt < 2; ++rt)
#pragma unroll
                            for (int ss = 0; ss < 2; ++ss) { const int ii = 32 * rt + r; const float sc = eg_s[ii];
                                const u32x2 lo = *(const LAS u32x2*)(Sb + P2_Q + ii * 272 + (32 * kt + 16 * ss + 4 * hh) * 2), hi = *(const LAS u32x2*)(Sb + P2_Q + ii * 272 + (32 * kt + 16 * ss + 8 + 4 * hh) * 2);
                                u32x4 o; o[0] = cvt2(lo16(lo[0]) * sc, hi16(lo[0]) * sc); o[1] = cvt2(lo16(lo[1]) * sc, hi16(lo[1]) * sc); o[2] = cvt2(lo16(hi[0]) * sc, hi16(hi[0]) * sc); o[3] = cvt2(lo16(hi[1]) * sc, hi16(hi[1]) * sc);
                                st16_wt(srs, boff + GS_QF + ((rt * 4 + kt) * 2 + ss) * 1024 + l3 * 16, o); }
                } else {
#pragma unroll
                    for (int rt = 0; rt < 2; ++rt)
#pragma unroll
                        for (int kt2 = 0; kt2 < 2; ++kt2)
#pragma unroll
                            for (int ss = 0; ss < 2; ++ss) { const int ii = 32 * rt + r;
                                const u32x2 lo = *(const LAS u32x2*)(L + P2_PS + ii * 144 + (32 * kt2 + 16 * ss + 4 * hh) * 2), hi = *(const LAS u32x2*)(L + P2_PS + ii * 144 + (32 * kt2 + 16 * ss + 8 + 4 * hh) * 2);
                                u32x4 o; o[0] = lo[0]; o[1] = lo[1]; o[2] = hi[0]; o[3] = hi[1];
                                st16_wt(srs, boff + GS_PF + ((rt * 2 + kt2) * 2 + ss) * 1024 + l3 * 16, o); }
                }
            }
        }
        LDS_BARRIER();
        if (grpB) {
            P2_PART(2, rwA);
        } else if (actA) {
            int l4 = lane; asm volatile("" : "+v"(l4));
            const int c16 = l4 & 15, g = l4 >> 4;
            const f32x4 z4 = {0.f, 0.f, 0.f, 0.f};
            f32x4 a10, a20, a21, a30, a31, a32, e0, e1, e2, e3;
            { const LAS unsigned char* ar = L + P2_AS + c16 * 272 + (4 * g) * 4;
              a10 = *(const LAS f32x4*)(ar + 16 * 272); a20 = *(const LAS f32x4*)(ar + 32 * 272); a21 = *(const LAS f32x4*)(ar + 32 * 272 + 64);
              a30 = *(const LAS f32x4*)(ar + 48 * 272); a31 = *(const LAS f32x4*)(ar + 48 * 272 + 64); a32 = *(const LAS f32x4*)(ar + 48 * 272 + 128);
              const LAS unsigned char* er = L + P2_ES + (c16 * 16 + 4 * g) * 4;
              e0 = *(const LAS f32x4*)er; e1 = *(const LAS f32x4*)(er + 1024); e2 = *(const LAS f32x4*)(er + 2048); e3 = *(const LAS f32x4*)(er + 3072); }
            const bf16x8 fA10 = g1_pack_b(z4 - a10, z4), fA2 = g1_pack_b(z4 - a20, z4 - a21), fA3a = g1_pack_b(z4 - a30, z4 - a31), fA3b = g1_pack_b(z4 - a32, z4);
            const bf16x8 fE0 = g1_pack_b(e0, z4), fE1 = g1_pack_b(e1, z4), fE2 = g1_pack_b(e2, z4), fE3 = g1_pack_b(e3, z4);
#pragma unroll
            for (int tl = 0; tl < 4; ++tl) {
                const int t16 = 4 * wave + tl; const bool isw = t16 < 8; const int d = 16 * (t16 & 7) + c16;
                f32x4 R[4];
#pragma unroll
                for (int ib = 0; ib < 4; ++ib)
#pragma unroll
                    for (int e = 0; e < 4; ++e) { const int row = 16 * ib + 4 * g + e; const float raw1 = bf2f(*(const LAS bf16_t*)(Sb + (isw ? P2_K : P2_V) + row * 272 + d * 2)); R[ib][e] = raw1 * beta_s[row] * (isw ? eg_s[row] : 1.0f); }
                const f32x4 X0 = MFMA16(fE0, g1_pack_b(R[0], z4), R[0]);
                const f32x4 Y1 = MFMA16(fA10, g1_pack_b(X0, z4), R[1]);
                const f32x4 X1 = MFMA16(fE1, g1_pack_b(Y1, z4), Y1);
                const f32x4 Y2 = MFMA16(fA2, g1_pack_b(X0, X1), R[2]);
                const f32x4 X2 = MFMA16(fE2, g1_pack_b(Y2, z4), Y2);
                f32x4 Y3 = MFMA16(fA3a, g1_pack_b(X0, X1), R[3]);
                Y3 = MFMA16(fA3b, g1_pack_b(X2, z4), Y3);
                const f32x4 X3 = MFMA16(fE3, g1_pack_b(Y3, z4), Y3);
                const f32x4 X[4] = {X0, X1, X2, X3};
                if (isw) {
#pragma unroll
                    for (int ib = 0; ib < 4; ++ib)
#pragma unroll
                        for (int e = 0; e < 4; ++e) *(LAS bf16_t*)(Sb + P2_Q + (16 * ib + 4 * g + e) * 272 + d * 2) = (bf16_t)(cvt2(-X[ib][e], 0.f) & 0xffffu);
                } else {
                    const int ws = d >> 5, cc = d & 31;
#pragma unroll
                    for (int ib = 0; ib < 4; ++ib) { const int rt = ib >> 1, q = 2 * (ib & 1) + (g >> 1), hh = g & 1;
                        u32x2 o; o[0] = cvt2(X[ib][0], X[ib][1]); o[1] = cvt2(X[ib][2], X[ib][3]);
                        st8_wt(blk + GS_UF + (size_t)(((ws * 2 + rt) * 64) + cc + 32 * hh) * 32 + q * 8, o); }
                }
            }
        }
        LDS_BARRIER();
        if (grpB) {
            { const int ntk = taskB + stride < 4224 ? taskB + stride : 4223; int s1, c1, h1; g1_decode(ntk, s1, c1, h1);
#pragma unroll
              for (int q = 0; q < 6; ++q) { const int ii = tb + 256 * q, jj = ii / 384, cc = ii % 384; pcw[q] = F.in[29][(size_t)jj * 3072 + (cc >> 7) * 1024 + h1 * 128 + (cc & 127)]; }
              const int ntp = ntk < 4095 ? ntk : 4095; int s2, c2, h2; g1_decode(ntp, s2, c2, h2);
              p2_load_part(F, rwA, s2, c2, h2, 0, tb);
#pragma unroll
              for (int q = 0; q < 6; ++q) cw_s[tb + 256 * q] = pcw[q]; }
        } else if (actA) {
            int l5 = lane; asm volatile("" : "+v"(l5));
            const int kt = wave, r = l5 & 31, hh = l5 >> 5;
#pragma unroll
            for (int rt = 0; rt < 2; ++rt)
#pragma unroll
                for (int ss = 0; ss < 2; ++ss) { const int ii = 32 * rt + r;
                    const u32x2 lo = *(const LAS u32x2*)(Sb + P2_Q + ii * 272 + (32 * kt + 16 * ss + 4 * hh) * 2), hi = *(const LAS u32x2*)(Sb + P2_Q + ii * 272 + (32 * kt + 16 * ss + 8 + 4 * hh) * 2);
                    u32x4 o; o[0] = lo[0]; o[1] = lo[1]; o[2] = hi[0]; o[3] = hi[1];
                    st16_wt(srs, boff + GS_WF + ((rt * 4 + kt) * 2 + ss) * 1024 + l5 * 16, o); }
            asm volatile("s_waitcnt vmcnt(0)" ::: "memory");
        }
        if (gact) {
            LAS float* gv = (LAS float*)(L + P2_VEC + (i & 1) * 1024);
            const bool ok = lane < (gs < BP ? 64 : TS); float x = ok ? gva : 0.f;
#pragma unroll
            for (int o = 1; o < 64; o <<= 1) { const float y = shfl_idx(x, lane >= o ? lane - o : lane); if (lane >= o) x += y; }
            const float gl = shfl_idx(x, 63);
            gv[lane] = ok ? gvb : 0.f; gv[64 + lane] = x; gv[128 + lane] = __expf(x); gv[192 + lane] = ok ? __expf(gl - x) : 0.f;
            const int gsidx = taskB < 4096 ? ((gs * 8 + gh) * 64 + gc) : taskB;
            if (lane == 0) __hip_atomic_store((unsigned*)DEC + gsidx, __float_as_uint(__expf(gl)), __ATOMIC_RELAXED, __HIP_MEMORY_SCOPE_AGENT);
        }
        LDS_BARRIER();
        if (tid == 0 && i >= 1) __hip_atomic_store(ready + 16 * sidx, 1u, __ATOMIC_RELAXED, __HIP_MEMORY_SCOPE_AGENT);
#undef P2_PART
    }
}

constexpr int G2_FB = GS_BYTES, G2_OSTRIDE = 528, G2_HN = 2 * G2_FB, G2_DEC = G2_HN + 512;
__device__ __forceinline__ bf16x8 pack8(const f32x16& x, const int s) {
    u32x4 p; p[0] = cvt2(x[8 * s], x[8 * s + 1]); p[1] = cvt2(x[8 * s + 2], x[8 * s + 3]); p[2] = cvt2(x[8 * s + 4], x[8 * s + 5]); p[3] = cvt2(x[8 * s + 6], x[8 * s + 7]);
    return __builtin_bit_cast(bf16x8, p);
}
template <bool WT>
__device__ __forceinline__ void g2_load_set(u32x4 (&pre)[18], float& dpre, const unsigned char* blk, int lt, brsrc_t srs, unsigned boff, const unsigned* flag, const float* decp) {
    if (WT) { unsigned sp = 0; while (__builtin_amdgcn_readfirstlane(__hip_atomic_load(flag, __ATOMIC_RELAXED, __HIP_MEMORY_SCOPE_AGENT)) == 0u && ++sp < (1u << 20)) __builtin_amdgcn_s_sleep(4);
        dpre = __uint_as_float(__hip_atomic_load((const unsigned*)decp, __ATOMIC_RELAXED, __HIP_MEMORY_SCOPE_AGENT));
#pragma unroll
        for (int i = 0; i < 18; ++i) pre[i] = ld16_wt(srs, boff + (unsigned)(i * 256 + lt) * 16u);
    } else { const u32x4* src = (const u32x4*)blk; dpre = *decp;
#pragma unroll
        for (int i = 0; i < 18; ++i) pre[i] = src[i * 256 + lt]; }
}
__device__ __forceinline__ void g2_store_set(const u32x4 (&pre)[18], LAS unsigned char* dst, int lt) {
#pragma unroll
    for (int i = 0; i < 18; ++i) *(LAS u32x4*)(dst + (size_t)(i * 256 + lt) * 16) = pre[i];
}
#define G2_FRAG(off) (*(const LAS bf16x8*)(B + (off)))
#define G2_SCHED() __builtin_amdgcn_sched_barrier(0)
__device__ __forceinline__ void g2_mfma_step(f32x16& S0, f32x16& S1, f32x16& S2, f32x16& S3, LAS unsigned char* Bimg, const float dec, int ws, int lane, int cc, int hh) {
    const LAS unsigned char* B = Bimg + lane * 16;
    f32x16 vn0, vn1, o0, o1;
    { const LAS u32x4* up = (const LAS u32x4*)(Bimg + GS_UF + (size_t)(ws * 2 * 64 + lane) * 32); const u32x4 u0 = up[0], u1 = up[1], u2 = up[128], u3 = up[129];
#pragma unroll
      for (int q = 0; q < 4; ++q) { vn0[2 * q] = lo16(u0[q]); vn0[2 * q + 1] = hi16(u0[q]); vn0[8 + 2 * q] = lo16(u1[q]); vn0[8 + 2 * q + 1] = hi16(u1[q]);
                                    vn1[2 * q] = lo16(u2[q]); vn1[2 * q + 1] = hi16(u2[q]); vn1[8 + 2 * q] = lo16(u3[q]); vn1[8 + 2 * q + 1] = hi16(u3[q]); } }
#pragma unroll
    for (int e = 0; e < 16; ++e) { o0[e] = 0.f; o1[e] = 0.f; }
#define G2_WQ(Sx, kt) do { _Pragma("unroll") for (int ss = 0; ss < 2; ++ss) { const bf16x8 sb = pack8(Sx, ss); \
        const bf16x8 fw0 = G2_FRAG(GS_WF + ((0 * 4 + kt) * 2 + ss) * 1024), fw1 = G2_FRAG(GS_WF + ((1 * 4 + kt) * 2 + ss) * 1024); \
        const bf16x8 fq0 = G2_FRAG(GS_QF + ((0 * 4 + kt) * 2 + ss) * 1024), fq1 = G2_FRAG(GS_QF + ((1 * 4 + kt) * 2 + ss) * 1024); \
        vn0 = MFMA32(fw0, sb, vn0); vn1 = MFMA32(fw1, sb, vn1); o0 = MFMA32(fq0, sb, o0); o1 = MFMA32(fq1, sb, o1); } } while (0)
    G2_WQ(S0, 0); G2_WQ(S1, 1); G2_WQ(S2, 2); G2_WQ(S3, 3);
#undef G2_WQ
    bf16x8 vb[2][2];
    vb[0][0] = pack8(vn0, 0); vb[0][1] = pack8(vn0, 1); vb[1][0] = pack8(vn1, 0); vb[1][1] = pack8(vn1, 1);
#pragma unroll
    for (int kt2 = 0; kt2 < 2; ++kt2)
#pragma unroll
        for (int ss = 0; ss < 2; ++ss) { o0 = MFMA32(G2_FRAG(GS_PF + ((0 * 2 + kt2) * 2 + ss) * 1024), vb[kt2][ss], o0); o1 = MFMA32(G2_FRAG(GS_PF + ((1 * 2 + kt2) * 2 + ss) * 1024), vb[kt2][ss], o1); }
    S0 = S0 * dec; S1 = S1 * dec; S2 = S2 * dec; S3 = S3 * dec;
#pragma unroll
    for (int kt2 = 0; kt2 < 2; ++kt2)
#pragma unroll
        for (int ss = 0; ss < 2; ++ss) {
            S0 = MFMA32(G2_FRAG(GS_KF + ((0 * 2 + kt2) * 2 + ss) * 1024), vb[kt2][ss], S0); S1 = MFMA32(G2_FRAG(GS_KF + ((1 * 2 + kt2) * 2 + ss) * 1024), vb[kt2][ss], S1);
            S2 = MFMA32(G2_FRAG(GS_KF + ((2 * 2 + kt2) * 2 + ss) * 1024), vb[kt2][ss], S2); S3 = MFMA32(G2_FRAG(GS_KF + ((3 * 2 + kt2) * 2 + ss) * 1024), vb[kt2][ss], S3); }
    LDS_BARRIER();
#pragma unroll
    for (int e = 0; e < 16; ++e) { const int rr = (e & 3) + 8 * (e >> 2) + 4 * hh;
        *(LAS float*)(Bimg + rr * G2_OSTRIDE + (32 * ws + cc) * 4) = o0[e]; *(LAS float*)(Bimg + (32 + rr) * G2_OSTRIDE + (32 * ws + cc) * 4) = o1[e]; }
    LDS_BARRIER();
}
__device__ __forceinline__ void g2_epi16(Frame& F, LAS unsigned char* L, const LAS unsigned char* Oimg, const u32x4 (&zz)[2], int row, int sub, size_t m, int h, bool rok, int lane) {
    f32x4 ov[4]; float ss = 0.f;
#pragma unroll
    for (int q = 0; q < 4; ++q) { ov[q] = *(const LAS f32x4*)(Oimg + row * G2_OSTRIDE + (sub * 16 + 4 * q) * 4); ss += (ov[q][0] * ov[q][0] + ov[q][1] * ov[q][1]) + (ov[q][2] * ov[q][2] + ov[q][3] * ov[q][3]); }
    ss += shfl_xor_l(ss, 1, lane); ss += shfl_xor_l(ss, 2, lane); ss += shfl_xor_l(ss, 4, lane);
    const float rn = __builtin_amdgcn_rsqf(ss * (1.f / 128.f) + EPS);
    if (rok) {
        const LAS float* hn_s = (const LAS float*)(L + G2_HN);
        u32x4* yp = (u32x4*)(F.Y1() + m * D + h * 128 + sub * 16);
#pragma unroll
        for (int q = 0; q < 2; ++q) {
            const f32x4 oa = ov[2 * q], ob = ov[2 * q + 1];
            const f32x4 ha = *(const LAS f32x4*)(hn_s + sub * 16 + 8 * q), hb = *(const LAS f32x4*)(hn_s + sub * 16 + 8 * q + 4);
            u32x4 yo;
            yo[0] = cvt2(oa[0] * rn * ha[0] * siluf_(lo16(zz[q][0])), oa[1] * rn * ha[1] * siluf_(hi16(zz[q][0])));
            yo[1] = cvt2(oa[2] * rn * ha[2] * siluf_(lo16(zz[q][1])), oa[3] * rn * ha[3] * siluf_(hi16(zz[q][1])));
            yo[2] = cvt2(ob[0] * rn * hb[0] * siluf_(lo16(zz[q][2])), ob[1] * rn * hb[1] * siluf_(hi16(zz[q][2])));
            yo[3] = cvt2(ob[2] * rn * hb[2] * siluf_(lo16(zz[q][3])), ob[3] * rn * hb[3] * siluf_(hi16(zz[q][3])));
            yp[q] = yo; }
    }
}
template <int NCH, bool WT>
__device__ __forceinline__ void g2_task(Frame& F, LAS unsigned char* L, const float* DEC, int s, int h, int ch0, int tid, int lane, int wave) {
    const size_t cstep = (size_t)GS_BYTES;
    const int base = seq_base(s), nvalid = s < BP ? 64 : TS;
    const unsigned char* blk0 = F.ws + WS_RB + (size_t)ch0 * GS_BYTES;
    constexpr int lastc = NCH - 1;
    if (wave < 4) {
        const int ws = wave, cc = lane & 31, hh = lane >> 5;
        f32x16 S0, S1, S2, S3;
        if (s < BP) {
#pragma unroll
            for (int e = 0; e < 16; ++e) { S0[e] = 0.f; S1[e] = 0.f; S2[e] = 0.f; S3[e] = 0.f; }
        } else {
            const float* sp = F.in[7] + ((size_t)(s - BP) * 8 + h) * 16384 + 32 * ws + cc;
#pragma unroll
            for (int e = 0; e < 16; ++e) { const int rr = (e & 3) + 8 * (e >> 2) + 4 * hh; S0[e] = sp[(size_t)rr * 128]; S1[e] = sp[(size_t)(32 + rr) * 128]; S2[e] = sp[(size_t)(64 + rr) * 128]; S3[e] = sp[(size_t)(96 + rr) * 128]; }
        }
        const LAS float* dec_s = (const LAS float*)(L + G2_DEC);
        const int erow = tid >> 3, esub = tid & 7; const bool erok = erow < nvalid;
        u32x4 zz[2];
#define G2_ZLOAD(cidx) do { const u32x4* zp = (const u32x4*)(F.Z1() + ((size_t)base + (cidx) * 64 + erow) * D + h * 128 + esub * 16); zz[0] = zp[0]; zz[1] = zp[1]; } while (0)
        LDS_BARRIER();
        if (NCH == 1) { if (erok) G2_ZLOAD(0); g2_mfma_step(S0, S1, S2, S3, L, dec_s[0], ws, lane, cc, hh); g2_epi16(F, L, L, zz, erow, esub, (size_t)base + erow, h, erok, lane); LDS_BARRIER(); }
        else for (int c = 0; c < NCH; c += 2) {
            G2_ZLOAD(c);
            g2_mfma_step(S0, S1, S2, S3, L, dec_s[c], ws, lane, cc, hh);
            g2_epi16(F, L, L, zz, erow, esub, (size_t)base + c * 64 + erow, h, erok, lane);
            LDS_BARRIER();
            G2_ZLOAD(c + 1);
            g2_mfma_step(S0, S1, S2, S3, L + G2_FB, dec_s[c + 1], ws, lane, cc, hh);
            g2_epi16(F, L, L + G2_FB, zz, erow, esub, (size_t)base + (c + 1) * 64 + erow, h, erok, lane);
            LDS_BARRIER();
        }
        int l9 = lane; asm volatile("" : "+v"(l9));
        const int cc9 = l9 & 31, hh9 = l9 >> 5;
        float* so = (s < BP ? F.out + O_GSP + ((size_t)s * 8 + h) * 16384 : F.out + O_GSS + ((size_t)(s - BP) * 8 + h) * 16384) + 32 * ws + cc9;
#pragma unroll
        for (int e = 0; e < 16; ++e) { const int rr = (e & 3) + 8 * (e >> 2) + 4 * hh9; so[(size_t)rr * 128] = S0[e]; so[(size_t)(32 + rr) * 128] = S1[e]; so[(size_t)(64 + rr) * 128] = S2[e]; so[(size_t)(96 + rr) * 128] = S3[e]; }
    } else {
        const int lt = tid - 256;
        if (lt < 128) ((LAS float*)(L + G2_HN))[lt] = F.in[32][lt];
        const brsrc_t srs = staging_rsrc(F.ws);
        const unsigned* ready = (const unsigned*)(F.ws + WS_READY);
        LAS float* dec_w = (LAS float*)(L + G2_DEC);
#define G2_LOAD(pre, dpre, k) do { const int _k = (k) < lastc ? (k) : lastc; g2_load_set<WT>(pre, dpre, blk0 + (size_t)_k * cstep, lt, srs, (unsigned)(ch0 + _k) * (unsigned)GS_BYTES, ready + 16 * (ch0 + _k), DEC + ch0 + _k); } while (0)
        u32x4 preA[18], preB[18]; float dA, dB;
        G2_LOAD(preA, dA, 0);
        G2_LOAD(preB, dB, 1);
        g2_store_set(preA, L, lt); if (lt == 0) dec_w[0] = dA;
        G2_LOAD(preA, dA, 2);
        const int erow = tid >> 3, esub = tid & 7; const bool erok = erow < nvalid;
        u32x4 zz[2];
#define G2_ZLOAD(cidx) do { const u32x4* zp = (const u32x4*)(F.Z1() + ((size_t)base + (cidx) * 64 + erow) * D + h * 128 + esub * 16); zz[0] = zp[0]; zz[1] = zp[1]; } while (0)
        LDS_BARRIER();
        if (NCH == 1) {
            if (erok) G2_ZLOAD(0);
            LDS_BARRIER();
            LDS_BARRIER();
            g2_epi16(F, L, L, zz, erow, esub, (size_t)base + erow, h, erok, lane);
            LDS_BARRIER();
        } else {
            for (int c = 0; c < NCH; c += 2) {
                {
                    g2_store_set(preB, L + G2_FB, lt); if (lt == 0) dec_w[(c + 1) & 63] = dB;
                    G2_ZLOAD(c);
                    G2_LOAD(preB, dB, c + 3);
                    LDS_BARRIER();
                    LDS_BARRIER();
                    g2_epi16(F, L, L, zz, erow, esub, (size_t)base + c * 64 + erow, h, erok, lane);
                    LDS_BARRIER();
                }
                {
                    g2_store_set(preA, L, lt); if (lt == 0) dec_w[(c + 2) & 63] = dA;
                    G2_ZLOAD(c + 1);
                    G2_LOAD(preA, dA, c + 4);
                    LDS_BARRIER();
                    LDS_BARRIER();
                    g2_epi16(F, L, L + G2_FB, zz, erow, esub, (size_t)base + (c + 1) * 64 + erow, h, erok, lane);
                    LDS_BARRIER();
                }
            }
        }
    }
}
#undef G2_ZLOAD
#undef G2_LOAD
constexpr int G12_CHAINS = 64;
__device__ __forceinline__ void phase_gdn_fused(Frame& F) {
    LAS unsigned char* L = F.lds;
    const float* DEC = (const float*)(F.ws + WS_DEC);
    if ((int)blockIdx.x < G12_CHAINS && F.G > G12_CHAINS) {
        const int tid = opaque_tid(F.wv);
        const int ci = blockIdx.x;
        g2_task<64, true>(F, L, DEC, ci >> 3, ci & 7, ci * 64, tid, tid & 63, F.wv);
    } else {
        const bool all = !(F.G > G12_CHAINS);
        const int p = all ? (int)blockIdx.x : (int)blockIdx.x - G12_CHAINS, np = all ? F.G : F.G - G12_CHAINS;
        gdn_g1_tasks(F, p, np);
        for (int t = p; t < 128; t += np) {
            const int tid = opaque_tid(F.wv);
            __syncthreads();
            g2_task<1, true>(F, L, DEC, BP + (t >> 3), t & 7, 4096 + t, tid, tid & 63, F.wv);
        }
    }
}

__device__ __forceinline__ float dpp_shr_f(float idv, float x, const int o) {
    int r;
    switch (o) {
        case 1: r = __builtin_amdgcn_update_dpp(__float_as_int(idv), __float_as_int(x), 0x111, 0xf, 0xf, false); break;
        case 2: r = __builtin_amdgcn_update_dpp(__float_as_int(idv), __float_as_int(x), 0x112, 0xf, 0xf, false); break;
        case 4: r = __builtin_amdgcn_update_dpp(__float_as_int(idv), __float_as_int(x), 0x114, 0xf, 0xf, false); break;
        default: r = __builtin_amdgcn_update_dpp(__float_as_int(idv), __float_as_int(x), 0x118, 0xf, 0xf, false); break;
    }
    return __int_as_float(r);
}
__device__ __forceinline__ float dpp_shr0_f(float x, const int o) {
    int r;
    switch (o) {
        case 1: r = __builtin_amdgcn_update_dpp(0, __float_as_int(x), 0x111, 0xf, 0xf, true); break;
        case 2: r = __builtin_amdgcn_update_dpp(0, __float_as_int(x), 0x112, 0xf, 0xf, true); break;
        case 4: r = __builtin_amdgcn_update_dpp(0, __float_as_int(x), 0x114, 0xf, 0xf, true); break;
        default: r = __builtin_amdgcn_update_dpp(0, __float_as_int(x), 0x118, 0xf, 0xf, true); break;
    }
    return __int_as_float(r);
}
__device__ __forceinline__ void phase_lru(Frame& F) {
    int tid = opaque_tid(F.wv);
    const int lane = tid & 63, wave = __builtin_amdgcn_readfirstlane(tid >> 6);
    const int gw = F.vcu * 8 + wave, NGW = F.G * 8, h = gw & 7, g = lane >> 4, l15 = lane & 15;
    LAS unsigned char* xs = F.lds + wave * 9216;
    LAS float* cst = (LAS float*)(F.lds + 73728 + wave * 768);
    const bf16_t* LGW = (const bf16_t*)(F.ws + WS_LGW);
    float* LAG = F.LAG();
    bf16x8 wfa[4][2], wfx[4][2];
#pragma unroll
    for (int nt = 0; nt < 4; ++nt)
#pragma unroll
        for (int ks = 0; ks < 2; ++ks) {
            wfa[nt][ks] = *(const bf16x8*)(LGW + ((size_t)(h * 2 + 0) * 64 + 16 * nt + l15) * 64 + 32 * ks + 8 * g);
            wfx[nt][ks] = *(const bf16x8*)(LGW + ((size_t)(h * 2 + 1) * 64 + 16 * nt + l15) * 64 + 32 * ks + 8 * g); }
    cst[lane] = F.in[18][h * 64 + lane]; cst[64 + lane] = F.in[20][h * 64 + lane]; cst[128 + lane] = softplusf_(-F.in[21][h * 64 + lane]);
    for (int task = gw; task < 4224; task += NGW) {
        int s, c; if (task < 4096) { s = task >> 9; c = (task >> 3) & 63; } else { s = BP + ((task - 4096) >> 3); c = 0; }
        const int T = seq_len(s), base = seq_base(s), t0 = c * 64, ntile = s < BP ? 4 : 1;
        {
            int l1 = lane; asm volatile("" : "+v"(l1));
            const int cg = l1 & 7, tp = l1 >> 3;
#pragma unroll 1
            for (int hf2 = 0; hf2 < 2; ++hf2) {
                const int chb = h * 64 + cg * 8 + hf2 * 4;
                float xr[11][4];
                if (s < BP) {
                    u32x2 w[11];
#pragma unroll
                    for (int i = 0; i < 11; ++i) { int tt = t0 + tp * 8 - 3 + i; tt = tt < 0 ? 0 : tt; w[i] = *(const u32x2*)(F.U0() + (size_t)(base + tt) * EV_IN + C_XA + chb); }
                    if (t0 == 0 && tp == 0) { w[0] = (u32x2){0u, 0u}; w[1] = (u32x2){0u, 0u}; w[2] = (u32x2){0u, 0u}; }
#pragma unroll
                    for (int i = 0; i < 11; ++i) { xr[i][0] = lo16(w[i][0]); xr[i][1] = hi16(w[i][0]); xr[i][2] = lo16(w[i][1]); xr[i][3] = hi16(w[i][1]); }
                } else {
#pragma unroll
                    for (int i = 0; i < 11; ++i) {
                        const int tt = t0 + tp * 8 - 3 + i;
                        if (tt >= 0 && tt < T) { const u32x2 w = *(const u32x2*)(F.U0() + (size_t)(base + tt) * EV_IN + C_XA + chb);
                            xr[i][0] = lo16(w[0]); xr[i][1] = hi16(w[0]); xr[i][2] = lo16(w[1]); xr[i][3] = hi16(w[1]); }
                        else if (tt < 0) { const f32x4 a = *(const f32x4*)(F.in[2] + ((size_t)(s - BP) * 3 + (tt + 3)) * 512 + chb); xr[i][0] = a[0]; xr[i][1] = a[1]; xr[i][2] = a[2]; xr[i][3] = a[3]; }
                        else { xr[i][0] = 0.f; xr[i][1] = 0.f; xr[i][2] = 0.f; xr[i][3] = 0.f; }
                    }
                }
                const f32x4 c0 = *(const f32x4*)(F.in[15] + chb), c1 = *(const f32x4*)(F.in[15] + 512 + chb), c2 = *(const f32x4*)(F.in[15] + 1024 + chb), c3 = *(const f32x4*)(F.in[15] + 1536 + chb), cb = *(const f32x4*)(F.in[16] + chb);
#pragma unroll
                for (int i = 0; i < 8; ++i) { float o[4];
#pragma unroll
                    for (int e = 0; e < 4; ++e) o[e] = c0[e] * xr[i][e] + c1[e] * xr[i + 1][e] + c2[e] * xr[i + 2][e] + c3[e] * xr[i + 3][e] + cb[e];
                    u32x2 w; w[0] = cvt2(o[0], o[1]); w[1] = cvt2(o[2], o[3]);
                    *(LAS u32x2*)(xs + (tp * 8 + i) * 144 + cg * 16 + hf2 * 8) = w; }
                if (t0 + 64 >= T && tp == ((T - 1) >> 3) - (t0 >> 3)) {
                    float* o = (s < BP ? F.out + O_LCP + (size_t)s * 3 * 512 : F.out + O_LCS + (size_t)(s - BP) * 3 * 512) + chb;
#pragma unroll
                    for (int q = 0; q < 3; ++q) *(f32x4*)(o + q * 512) = (f32x4){xr[8 + q][0], xr[8 + q][1], xr[8 + q][2], xr[8 + q][3]};
                }
            }
        }
        float hin[4][4], arun[4][4];
#pragma unroll
        for (int nt = 0; nt < 4; ++nt)
#pragma unroll
            for (int rg = 0; rg < 4; ++rg) { hin[nt][rg] = 0.f; arun[nt][rg] = 1.f; }
        asm volatile("s_waitcnt lgkmcnt(0)" ::: "memory");
        for (int tt = 0; tt < ntile; ++tt) {
            const int tok = 16 * tt + l15;
            const bf16x8 b0 = *(const LAS bf16x8*)(xs + tok * 144 + (8 * g) * 2), b1 = *(const LAS bf16x8*)(xs + tok * 144 + (32 + 8 * g) * 2);
            const size_t m = (size_t)base + t0 + tok;
#pragma unroll
            for (int nt = 0; nt < 4; ++nt) {
                f32x4 za = {0.f, 0.f, 0.f, 0.f}, zx = {0.f, 0.f, 0.f, 0.f};
                za = MFMA16(wfa[nt][0], b0, za); za = MFMA16(wfa[nt][1], b1, za);
                zx = MFMA16(wfx[nt][0], b0, zx); zx = MFMA16(wfx[nt][1], b1, zx);
                const int n0 = 16 * nt + 4 * g;
                const u32x2 xw = *(const LAS u32x2*)(xs + tok * 144 + n0 * 2);
                const float xc[4] = {lo16(xw[0]), hi16(xw[0]), lo16(xw[1]), hi16(xw[1])};
                const f32x4 cba = *(const LAS f32x4*)(cst + n0), cbx = *(const LAS f32x4*)(cst + 64 + n0), csp = *(const LAS f32x4*)(cst + 128 + n0);
                float av[4], bv[4];
#pragma unroll
                for (int rg = 0; rg < 4; ++rg) {
                    const float r = sigmoidf_(za[rg] + cba[rg]), ig = sigmoidf_(zx[rg] + cbx[rg]), la = -8.0f * r * csp[rg], a = __expf(la);
                    av[rg] = a; bv[rg] = __builtin_amdgcn_sqrtf(fmaxf(1.0f - a * a, 0.f)) * (ig * xc[rg]); }
#pragma unroll
                for (int o = 1; o < 16; o <<= 1)
#pragma unroll
                    for (int rg = 0; rg < 4; ++rg) { const float ap = dpp_shr_f(1.0f, av[rg], o), bp = dpp_shr0_f(bv[rg], o); bv[rg] = av[rg] * bp + bv[rg]; av[rg] = av[rg] * ap; }
                float hv[4];
#pragma unroll
                for (int rg = 0; rg < 4; ++rg) { hv[rg] = bv[rg] + av[rg] * hin[nt][rg]; hin[nt][rg] = shfl_idx(hv[rg], (lane & 48) | 15); }
                {
                    u32x2 hw, pw; hw[0] = cvt2(hv[0], hv[1]); hw[1] = cvt2(hv[2], hv[3]);
                    pw[0] = cvt2(av[0] * arun[nt][0], av[1] * arun[nt][1]); pw[1] = cvt2(av[2] * arun[nt][2], av[3] * arun[nt][3]);
                    *(u32x4*)(F.YO() + m * D + h * 128 + 2 * n0) = (u32x4){hw[0], hw[1], pw[0], pw[1]};
#pragma unroll
                    for (int rg = 0; rg < 4; ++rg) arun[nt][rg] *= shfl_idx(av[rg], (lane & 48) | 15);
                }
                if (nt & 1) __builtin_amdgcn_sched_barrier(0);
            }
        }
        if (s < BP && l15 == 15) {
            f32x2* lp = (f32x2*)LAG + (size_t)(s * 64 + c) * 512 + h * 64;
#pragma unroll
            for (int nt = 0; nt < 4; ++nt)
#pragma unroll
                for (int rg = 0; rg < 4; ++rg) lp[16 * nt + 4 * g + rg] = (f32x2){arun[nt][rg], hin[nt][rg]};
        }
        asm volatile("s_waitcnt lgkmcnt(0)" ::: "memory");
    }
}

#define LRA_LOAD(c_) do { _Pragma("unroll") for (int it = 0; it < 8; ++it) { const size_t m = (size_t)base + (c_) * 64 + 8 * (it < nit ? it : nit - 1) + tq; \
    hl[it] = *(const u32x4*)(F.YO() + m * D + h * 128 + 16 * cg); pp[it] = *(const u32x4*)(F.YO() + m * D + h * 128 + 16 * cg + 8); gg[it] = *(const u32x4*)(F.U0() + m * EV_IN + C_GA + h * 64 + 8 * cg); } } while (0)
__device__ __forceinline__ void lru_apply_chunk(Frame& F, const u32x4 (&hl)[8], const u32x4 (&pp)[8], const u32x4 (&gg)[8], const float hf, const int s, const int base, const int t0, const int T, const int nit, const int h, const int lane) {
    const int cg = lane & 7, tq = lane >> 3;
    float cr[8];
#pragma unroll
    for (int e = 0; e < 8; ++e) cr[e] = shfl_idx(hf, 8 * cg + e);
#pragma unroll
    for (int it = 0; it < 8; ++it) if (it < nit) {
        const int t = t0 + 8 * it + tq; const size_t m = (size_t)base + t;
        float hv[8]; u32x4 yo;
#pragma unroll
        for (int e = 0; e < 4; ++e) { const unsigned hw = e < 2 ? hl[it][e] : pp[it][e - 2], pw = e < 2 ? hl[it][e + 2] : pp[it][e];
            hv[2 * e] = lo16(hw) + lo16(pw) * cr[2 * e]; hv[2 * e + 1] = hi16(hw) + hi16(pw) * cr[2 * e + 1];
            yo[e] = cvt2(hv[2 * e] * siluf_(lo16(gg[it][e])), hv[2 * e + 1] * siluf_(hi16(gg[it][e]))); }
        *(u32x4*)(F.Y0() + m * D + h * 64 + 8 * cg) = yo;
        if (t == T - 1) { float* o = (s < BP ? F.out + O_LHP + s * 512 : F.out + O_LHS + (s - BP) * 512) + h * 64 + 8 * cg;
            *(f32x4*)o = (f32x4){hv[0], hv[1], hv[2], hv[3]}; *(f32x4*)(o + 4) = (f32x4){hv[4], hv[5], hv[6], hv[7]}; }
    }
}
__device__ __forceinline__ void phase_lru_apply(Frame& F) {
    PHASE_IDS();
    const int gw = F.vcu * 8 + wave, NGW = F.G * 8, cg = lane & 7, tq = lane >> 3;
    for (int w = gw; w < 2048; w += NGW) {
        const int s = w >> 8, c0 = 2 * ((w >> 3) & 31), h = w & 7, base = s * TP, nit = 8;
        u32x4 hl[8], pp[8], gg[8];
        LRA_LOAD(c0);
        const f32x2* lp = (const f32x2*)F.LAG() + (size_t)(s * 64) * 512 + h * 64 + lane;
        const f32x2 own = lp[(size_t)c0 * 512];
        float hf = 0.f;
        for (int j0 = 0; j0 < c0; j0 += 32) { f32x2 v[32];
#pragma unroll
            for (int q = 0; q < 32; ++q) { const int jj = j0 + q < c0 ? j0 + q : c0 - 1; v[q] = lp[(size_t)jj * 512]; }
#pragma unroll
            for (int q = 0; q < 32; ++q) if (j0 + q < c0) hf = v[q][0] * hf + v[q][1]; }
        lru_apply_chunk(F, hl, pp, gg, hf, s, base, c0 * 64, TP, 8, h, lane);
        hf = own[0] * hf + own[1];
        LRA_LOAD(c0 + 1);
        lru_apply_chunk(F, hl, pp, gg, hf, s, base, (c0 + 1) * 64, TP, 8, h, lane);
    }
    for (int w = gw; w < 128; w += NGW) {
        const int s = BP + (w >> 3), h = w & 7, base = seq_base(s), nit = 2;
        u32x4 hl[8], pp[8], gg[8];
        LRA_LOAD(0);
        const float hf = F.in[3][(s - BP) * 512 + h * 64 + lane];
        lru_apply_chunk(F, hl, pp, gg, hf, s, base, 0, TS, 2, h, lane);
    }
}

constexpr size_t RB_VTP = RB_WEND, RB_VTS = RB_VTP + (size_t)BP * 2 * 64 * TP * 2, RB_VTEND = RB_VTS + (size_t)BS * 2 * 64 * 192 * 2;
static_assert(RB_VTEND <= RB_BYTES, "ws map");
__device__ __forceinline__ void phase_vt_build(Frame& F) {
    PHASE_IDS();
    const int gw = F.vcu * 8 + wave, NGW = F.G * 8;
    LAS unsigned char* xs = F.lds + wave * 9216;
    bf16_t* VTP = (bf16_t*)(F.ws + WS_RB + RB_VTP); bf16_t* VTS = (bf16_t*)(F.ws + WS_RB + RB_VTS);
    for (int task = gw; task < 1024 + 96; task += NGW) {
        int s, kv, kb; if (task < 1024) { s = task >> 7; kv = (task >> 6) & 1; kb = task & 63; } else { const int r = task - 1024; s = BP + r / 6; kv = (r % 6) / 3; kb = r % 3; }
        const int row8 = lane >> 3, ch = lane & 7;
#pragma unroll
        for (int i = 0; i < 8; ++i) {
            const int key = 8 * i + row8, kg = kb * 64 + key; u32x4 w = {0u, 0u, 0u, 0u};
            if (s < BP) w = *(const u32x4*)(F.U0() + (size_t)(s * TP + kg) * EV_IN + C_V + kv * 64 + ch * 8);
            else if (kg < 128) { const f32x4* p = (const f32x4*)(F.in[5] + ((size_t)((s - BP) * 128 + kg) * 2 + kv) * 64 + ch * 8); const f32x4 a = p[0], b = p[1]; w[0] = cvt2(a[0], a[1]); w[1] = cvt2(a[2], a[3]); w[2] = cvt2(b[0], b[1]); w[3] = cvt2(b[2], b[3]); }
            else if (kg < 128 + TS) w = *(const u32x4*)(F.U0() + (size_t)(MP + (s - BP) * TS + (kg - 128)) * EV_IN + C_V + kv * 64 + ch * 8);
            *(LAS u32x4*)(xs + key * 144 + ch * 16) = w;
        }
        asm volatile("s_waitcnt lgkmcnt(0)" ::: "memory");
        bf16_t* dst = s < BP ? VTP + ((size_t)(s * 2 + kv) * 64 + lane) * TP + kb * 64 : VTS + ((size_t)((s - BP) * 2 + kv) * 64 + lane) * 192 + kb * 64;
#pragma unroll
        for (int q = 0; q < 8; ++q) { u32x4 o;
#pragma unroll
            for (int e = 0; e < 4; ++e) { const unsigned lo = *(const LAS bf16_t*)(xs + (8 * q + 2 * e) * 144 + lane * 2), hi = *(const LAS bf16_t*)(xs + (8 * q + 2 * e + 1) * 144 + lane * 2); o[e] = lo | (hi << 16); }
            *(u32x4*)(dst + 8 * q) = o; }
        asm volatile("s_waitcnt lgkmcnt(0)" ::: "memory");
    }
}
constexpr int AT_K = 0, AT_V = 27648;
__device__ __forceinline__ void attn_issue(Frame& F, const bf16_t* VTP, int task, int tid, int wave, int lane, u32x4 (&kreg)[3], u32x4 (&vreg)[3], u32x4 (&qreg)[4]) {
    const int s = task >> 7, c = (task >> 1) & 63, kv = task & 1, tok0 = c * 64 - 128;
#pragma unroll
    for (int i = 0; i < 3; ++i) { const int idx = tid + 512 * i, key = idx >> 3, ch = idx & 7; int tk = tok0 + key; tk = tk < 0 ? 0 : tk;
        kreg[i] = *(const u32x4*)(F.U0() + (size_t)(s * TP + tk) * EV_IN + C_K + kv * 64 + ch * 8); }
#pragma unroll
    for (int i = 0; i < 3; ++i) { const int idx = tid + 512 * i, d = idx / 24, ch = idx % 24; int tk = tok0 + ch * 8; tk = tk < 0 ? 0 : tk;
        vreg[i] = *(const u32x4*)(VTP + ((size_t)(s * 2 + kv) * 64 + d) * TP + tk); }
    const int g = wave >> 1, qh = wave & 1, hq = kv * 4 + g, r = lane & 31, hh = lane >> 5;
    const size_t m = (size_t)s * TP + c * 64 + qh * 32 + r;
#pragma unroll
    for (int ks = 0; ks < 4; ++ks) qreg[ks] = *(const u32x4*)(F.U0() + m * EV_IN + C_Q + hq * 64 + 16 * ks + 8 * hh);
}
__device__ __forceinline__ void phase_attn(Frame& F) {
    PHASE_IDS();
    LAS unsigned char* L = F.lds;
    const bf16_t* VTP = (const bf16_t*)(F.ws + WS_RB + RB_VTP); const bf16_t* VTS = (const bf16_t*)(F.ws + WS_RB + RB_VTS);
    u32x4 kreg[3], vreg[3], qreg[4];
    attn_issue(F, VTP, F.vcu < 1024 ? F.vcu : 0, tid, wave, lane, kreg, vreg, qreg);
    for (int ti = F.vcu; ti < 1024 + 64; ti += F.G) {
        if (ti >= 1024 && ti < 1056) continue;
        const int task = ti < 1024 ? ti : ti - 32;
        int s, c, kv; if (task < 1024) { s = task >> 7; c = (task >> 1) & 63; kv = task & 1; } else { s = BP + ((task - 1024) >> 1); c = 0; kv = task & 1; }
        const int base = seq_base(s), tok0 = c * 64 - 128;
        const int kmin = s < BP ? (tok0 < 0 ? -tok0 : 0) : 0, kmax = s < BP ? 192 : 128 + TS;
        const int tid = opaque_tid(F.wv), lane = tid & 63;
        const int g = wave >> 1, qh = wave & 1, hq = kv * 4 + g, r = lane & 31, hh = lane >> 5, qi = qh * 32 + r;
        const bool qok = s < BP ? true : qi < TS;
        const size_t m = (size_t)base + c * 64 + (qok ? qi : 0);
        bf16x8 qf[4]; u32x2 gbr[8];
        LDS_BARRIER();
        if (s < BP) {
#pragma unroll
            for (int i = 0; i < 3; ++i) { const int idx = tid + 512 * i, key = idx >> 3, ch = idx & 7; const u32x4 z = {0u, 0u, 0u, 0u}; *(LAS u32x4*)(L + AT_K + key * 144 + ch * 16) = key >= kmin ? kreg[i] : z; }
#pragma unroll
            for (int i = 0; i < 3; ++i) { const int idx = tid + 512 * i, d = idx / 24, ch = idx % 24; const u32x4 z = {0u, 0u, 0u, 0u}; *(LAS u32x4*)(L + AT_V + d * 400 + ch * 16) = ch * 8 >= kmin ? vreg[i] : z; }
#pragma unroll
            for (int ks = 0; ks < 4; ++ks) { u32x4 w;
#pragma unroll
                for (int e = 0; e < 4; ++e) w[e] = cvt2(lo16(qreg[ks][e]) * 0.125f, hi16(qreg[ks][e]) * 0.125f);
                qf[ks] = __builtin_bit_cast(bf16x8, w); }
        } else {
#pragma unroll
            for (int i = 0; i < 3; ++i) {
                const int idx = tid + 512 * i, key = idx >> 3, ch = idx & 7; u32x4 w = {0u, 0u, 0u, 0u};
                if (key < kmax) {
                    if (key < 128) { const f32x4* p = (const f32x4*)(F.in[4] + ((size_t)((s - BP) * 128 + key) * 2 + kv) * 64 + ch * 8); const f32x4 a = p[0], b2 = p[1]; w[0] = cvt2(a[0], a[1]); w[1] = cvt2(a[2], a[3]); w[2] = cvt2(b2[0], b2[1]); w[3] = cvt2(b2[2], b2[3]); }
                    else w = *(const u32x4*)(F.U0() + (size_t)(base + key - 128) * EV_IN + C_K + kv * 64 + ch * 8);
                }
                *(LAS u32x4*)(L + AT_K + key * 144 + ch * 16) = w;
            }
#pragma unroll
            for (int i = 0; i < 3; ++i) {
                const int idx = tid + 512 * i, d = idx / 24, ch = idx % 24, key = ch * 8;
                *(LAS u32x4*)(L + AT_V + d * 400 + ch * 16) = *(const u32x4*)(VTS + ((size_t)((s - BP) * 2 + kv) * 64 + d) * 192 + key);
            }
#pragma unroll
            for (int ks = 0; ks < 4; ++ks) { u32x4 w = {0u, 0u, 0u, 0u};
                if (qok) { const u32x4 x = *(const u32x4*)(F.U0() + m * EV_IN + C_Q + hq * 64 + 16 * ks + 8 * hh);
#pragma unroll
                    for (int e = 0; e < 4; ++e) w[e] = cvt2(lo16(x[e]) * 0.125f, hi16(x[e]) * 0.125f); }
                qf[ks] = __builtin_bit_cast(bf16x8, w); }
        }
#pragma unroll
        for (int qq = 0; qq < 4; ++qq) { gbr[2 * qq] = qok ? *(const u32x2*)(F.U0() + m * EV_IN + C_GB + hq * 64 + 8 * qq + 4 * hh) : (u32x2){0u, 0u}; gbr[2 * qq + 1] = qok ? *(const u32x2*)(F.U0() + m * EV_IN + C_GB + hq * 64 + 32 + 8 * qq + 4 * hh) : (u32x2){0u, 0u}; }
        { const int nt = ti + F.G < 1024 ? ti + F.G : (ti < 1024 ? ti : 0); int t9 = tid; asm volatile("" : "+v"(t9)); attn_issue(F, VTP, nt, t9, wave, t9 & 63, kreg, vreg, qreg); }
        const float sink = F.in[22][hq];
        LDS_BARRIER();
        float mrun = sink, lrun = 1.0f;
        f32x16 o0, o1;
#pragma unroll
        for (int e = 0; e < 16; ++e) { o0[e] = 0.f; o1[e] = 0.f; }
#pragma unroll 1
        for (int half = 0; half < 2; ++half) {
            f32x16 sc[3];
#pragma unroll
            for (int k3 = 0; k3 < 3; ++k3) {
                const int kt = 3 * half + k3;
#pragma unroll
                for (int e = 0; e < 16; ++e) sc[k3][e] = 0.f;
#pragma unroll
                for (int ks = 0; ks < 4; ++ks) { const bf16x8 kf = *(const LAS bf16x8*)(L + AT_K + (32 * kt + r) * 144 + (16 * ks + 8 * hh) * 2); sc[k3] = MFMA32(kf, qf[ks], sc[k3]); }
            }
            float mx = -1e30f;
#pragma unroll
            for (int k3 = 0; k3 < 3; ++k3)
#pragma unroll
                for (int e = 0; e < 16; ++e) { const int kidx = 32 * (3 * half + k3) + (e & 3) + 8 * (e >> 2) + 4 * hh; const bool ok = kidx >= kmin && kidx < kmax; sc[k3][e] = ok ? sc[k3][e] : -1e30f; mx = fmaxf(mx, sc[k3][e]); }
            mx = fmaxf(mx, shfl_xor_l(mx, 32, lane));
            const float mnew = fmaxf(mrun, mx), alpha = __expf(mrun - mnew);
            float psum = 0.f;
#pragma unroll
            for (int k3 = 0; k3 < 3; ++k3)
#pragma unroll
                for (int e = 0; e < 16; ++e) { const float p = __expf(sc[k3][e] - mnew); sc[k3][e] = p; psum += p; }
            psum += shfl_xor_l(psum, 32, lane);
            lrun = lrun * alpha + psum; mrun = mnew;
            o0 = o0 * alpha; o1 = o1 * alpha;
#pragma unroll
            for (int k3 = 0; k3 < 3; ++k3)
#pragma unroll
                for (int ss = 0; ss < 2; ++ss) {
                    const int kt = 3 * half + k3;
                    const bf16x8 pb = pack8(sc[k3], ss);
                    const LAS unsigned char* vp = L + AT_V + r * 400 + (32 * kt + 16 * ss + 4 * hh) * 2;
                    const u32x2 a0 = *(const LAS u32x2*)vp, a1 = *(const LAS u32x2*)(vp + 16), b0 = *(const LAS u32x2*)(vp + 32 * 400), b1 = *(const LAS u32x2*)(vp + 32 * 400 + 16);
                    const u32x4 va = {a0[0], a0[1], a1[0], a1[1]}, vb = {b0[0], b0[1], b1[0], b1[1]};
                    o0 = MFMA32(__builtin_bit_cast(bf16x8, va), pb, o0); o1 = MFMA32(__builtin_bit_cast(bf16x8, vb), pb, o1);
                }
        }
        const float il = __builtin_amdgcn_rcpf(lrun);
        if (qok) {
#pragma unroll
            for (int qq = 0; qq < 4; ++qq) {
                { const int d = 8 * qq + 4 * hh; const u32x2 gb = gbr[2 * qq];
                  u32x2 yo; yo[0] = cvt2(o0[4 * qq] * il * siluf_(lo16(gb[0])), o0[4 * qq + 1] * il * siluf_(hi16(gb[0]))); yo[1] = cvt2(o0[4 * qq + 2] * il * siluf_(lo16(gb[1])), o0[4 * qq + 3] * il * siluf_(hi16(gb[1])));
                  *(u32x2*)(F.Y0() + m * D + 512 + hq * 64 + d) = yo; }
                { const int d = 32 + 8 * qq + 4 * hh; const u32x2 gb = gbr[2 * qq + 1];
                  u32x2 yo; yo[0] = cvt2(o1[4 * qq] * il * siluf_(lo16(gb[0])), o1[4 * qq + 1] * il * siluf_(hi16(gb[0]))); yo[1] = cvt2(o1[4 * qq + 2] * il * siluf_(lo16(gb[1])), o1[4 * qq + 3] * il * siluf_(hi16(gb[1])));
                  *(u32x2*)(F.Y0() + m * D + 512 + hq * 64 + d) = yo; }
            }
        }
    }
    __syncthreads();
}

constexpr int SG_A = 0, SG_B = 36864, SG_BUF = 36864 + 9216;
struct SOut { bf16_t* O0; int ld0; int split; bf16_t* O1; int ld1; };
__device__ __forceinline__ void sgemm_strip(Frame& F, const bf16_t* A, const bf16_t* Bt, const int K, const int n0, const SOut o, const int tid, const int lane, const int wave) {
    LAS unsigned char* L = F.lds;
    const int nkt = K / 64;
    const bf16_t* ap = A + (size_t)(tid >> 3) * K + (tid & 7) * 8;
    const bf16_t* bp = Bt + (size_t)(n0 + (tid >> 3)) * K + (tid & 7) * 8;
    const int lofs = (tid >> 3) * 144 + (tid & 7) * 16;
    u32x4 ra[4], rb, sa[4], sb;
#define SG_LOAD(RA, RB, kt) do { _Pragma("unroll") for (int i = 0; i < 4; ++i) RA[i] = *(const u32x4*)(ap + (size_t)i * 64 * K + (kt) * 64); RB = *(const u32x4*)(bp + (kt) * 64); } while (0)
#define SG_STORE(RA, RB, buf) do { _Pragma("unroll") for (int i = 0; i < 4; ++i) *(LAS u32x4*)(L + (buf) * SG_BUF + SG_A + lofs + i * 64 * 144) = RA[i]; *(LAS u32x4*)(L + (buf) * SG_BUF + SG_B + lofs) = RB; } while (0)
    SG_LOAD(ra, rb, 0); SG_LOAD(sa, sb, 1);
    SG_STORE(ra, rb, 0);
    SG_LOAD(ra, rb, (2 < nkt ? 2 : nkt - 1));
    f32x16 acc0, acc1;
#pragma unroll
    for (int e = 0; e < 16; ++e) { acc0[e] = 0.f; acc1[e] = 0.f; }
    const int r = lane & 31, hh = lane >> 5;
    LDS_BARRIER();
    for (int kt = 0; kt < nkt; kt += 2) {
#define SG_STEP(buf, RA, RB, knext) do { \
        const LAS unsigned char* Ab = L + (buf) * SG_BUF + SG_A + (32 * wave + r) * 144 + hh * 16; const LAS unsigned char* Bb = L + (buf) * SG_BUF + SG_B + r * 144 + hh * 16; \
        _Pragma("unroll") for (int ks = 0; ks < 4; ++ks) { const bf16x8 af = *(const LAS bf16x8*)(Ab + ks * 32), b0 = *(const LAS bf16x8*)(Bb + ks * 32), b1 = *(const LAS bf16x8*)(Bb + 32 * 144 + ks * 32); \
            acc0 = MFMA32(b0, af, acc0); acc1 = MFMA32(b1, af, acc1); } \
        SG_STORE(RA, RB, (buf) ^ 1); { const int kn = (knext) < nkt ? (knext) : nkt - 1; SG_LOAD(RA, RB, kn); } \
        LDS_BARRIER(); } while (0)
        SG_STEP(0, sa, sb, kt + 3);
        SG_STEP(1, ra, rb, kt + 4);
    }
#undef SG_STEP
#undef SG_LOAD
#undef SG_STORE
    const int row = 32 * wave + r; int colt = n0; bf16_t* base = o.O0; int ld = o.ld0;
    if (colt >= o.split) { base = o.O1; ld = o.ld1; colt -= o.split; }
    bf16_t* rowp = base + (size_t)row * ld + colt;
#pragma unroll
    for (int q = 0; q < 4; ++q) {
        u32x2 w0, w1; w0[0] = cvt2(acc0[4 * q], acc0[4 * q + 1]); w0[1] = cvt2(acc0[4 * q + 2], acc0[4 * q + 3]); w1[0] = cvt2(acc1[4 * q], acc1[4 * q + 1]); w1[1] = cvt2(acc1[4 * q + 2], acc1[4 * q + 3]);
        *(u32x2*)(rowp + 8 * q + 4 * hh) = w0; *(u32x2*)(rowp + 32 + 8 * q + 4 * hh) = w1; }
    LDS_BARRIER();
}
__device__ __forceinline__ void sgemm_phase(Frame& F, const bf16_t* A, const bf16_t* Bt, const int N, const int K, const SOut o, const int from) {
    const int nstrip = N / 64;
    for (int st = ((int)blockIdx.x - from + F.G) % F.G; st < nstrip; st += F.G) {
        const int tid = opaque_tid(F.wv);
        sgemm_strip(F, A, Bt, K, st * 64, o, tid, tid & 63, F.wv);
    }
}

__device__ __forceinline__ void rows_final(Frame& F, const int m0, const int n, const int s, const int lane) {
    const float* MODP = (const float*)(F.ws + WS_MODP);
    f32x4 A1[4];
#pragma unroll
    for (int j = 0; j < 4; ++j) { const int c = 4 * lane + 256 * j; const f32x4 g = *(const f32x4*)(F.in[27] + c), gt = mod4(MODP, 1, s, 2048 + c);
#pragma unroll
        for (int e = 0; e < 4; ++e) A1[j][e] = gt[e] * g[e]; }
    u32x2 ycur[4]; f32x4 xcur[4];
#pragma unroll
    for (int j = 0; j < 4; ++j) { ycur[j] = *(const u32x2*)(F.YO() + (size_t)m0 * D + 4 * lane + 256 * j); xcur[j] = *(const f32x4*)(F.out + O_Y + (size_t)m0 * D + 4 * lane + 256 * j); }
    for (int i = 0; i < n; ++i) {
        const int m = m0 + i, mn = m0 + (i + 1 < n ? i + 1 : i); u32x2 ynxt[4]; f32x4 xnxt[4];
#pragma unroll
        for (int j = 0; j < 4; ++j) { ynxt[j] = *(const u32x2*)(F.YO() + (size_t)mn * D + 4 * lane + 256 * j); xnxt[j] = *(const f32x4*)(F.out + O_Y + (size_t)mn * D + 4 * lane + 256 * j); }
        f32x4 y[4]; float ss = 0.f;
#pragma unroll
        for (int j = 0; j < 4; ++j) { y[j] = (f32x4){lo16(ycur[j][0]), hi16(ycur[j][0]), lo16(ycur[j][1]), hi16(ycur[j][1])}; ss += (y[j][0] * y[j][0] + y[j][1] * y[j][1]) + (y[j][2] * y[j][2] + y[j][3] * y[j][3]); }
        const float r1 = rsqrtf(wave_sum(ss, lane) * (1.f / D) + EPS);
#pragma unroll
        for (int j = 0; j < 4; ++j) { f32x4 o;
#pragma unroll
            for (int e = 0; e < 4; ++e) o[e] = xcur[j][e] + A1[j][e] * (y[j][e] * r1);
            *(f32x4*)(F.out + O_Y + (size_t)m * D + 4 * lane + 256 * j) = o; }
#pragma unroll
        for (int j = 0; j < 4; ++j) { ycur[j] = ynxt[j]; xcur[j] = xnxt[j]; }
    }
}
__device__ __forceinline__ void phase_final_rowwise(Frame& F) {
    PHASE_IDS();
    const int gw = F.vcu * 8 + wave, NGW = F.G * 8;
    for (int w = gw; w < MP / 16; w += NGW) rows_final(F, w * 16, 16, w >> 8, lane);
    for (int w = gw; w < MS; w += NGW) rows_final(F, MP + w, 1, BP + (w >> 4), lane);
}

__global__ void __launch_bounds__(512, 2) fwd_megakernel(Params P) {
    extern __shared__ __attribute__((aligned(16))) unsigned char lds_raw[];
    Frame F;
    F.lds = (LAS unsigned char*)lds_raw;
    F.wv = __builtin_amdgcn_readfirstlane(threadIdx.x >> 6);
    F.G = gridDim.x; { const int bx = blockIdx.x; F.vcu = (F.G % 8 == 0) ? (bx % 8) * (F.G / 8) + bx / 8 : bx; }
    F.in = P.in; F.out = P.out; F.ws = P.ws;

    volatile LAS unsigned* misc = (volatile LAS unsigned*)(F.lds + LDS_BYTES - 64);
    if (threadIdx.x < 16) misc[threadIdx.x] = 0u;
    __syncthreads();
    XcdBarrier xbar = xcd_barrier_post((unsigned*)(P.ws + WS_CTL), misc);
#define GRID_BAR() xcd_barrier(xbar, F.wv)
    phase_mod0(F);
    GRID_BAR();
    phase_prologue(F);
    phase_mod1(F);
    phase_prenorm0(F);
    GRID_BAR();
    { pg8::Gemm g{F.XN(), F.W0I(), MP, EV_IN, D}; pg8::StaticOrder S; S.init(MP, EV_IN, F.G, (int)blockIdx.x);
      pg8::EpiBf16 E{F.U0(), EV_IN, 1 << 30, F.U0(), EV_IN}; pg8::gemm_phase(F.lds, g, S, E, F.wv);
      sgemm_phase(F, F.XN() + (size_t)MP * D, F.W0I(), EV_IN, D, SOut{F.U0() + (size_t)MP * EV_IN, EV_IN, 1 << 30, nullptr, 0}, 128); }
    GRID_BAR();
    phase_rope(F);
    phase_lru(F);
    phase_vt_build(F);
    GRID_BAR();
    phase_lru_apply(F);
    phase_attn(F);
    GRID_BAR();
    { pg8::Gemm g{F.Y0(), F.W0O(), MP, D, D}; pg8::StaticOrder S; S.init(MP, D, F.G, (int)blockIdx.x);
      pg8::EpiBf16 E{F.YO(), D, 1 << 30, F.YO(), D}; pg8::gemm_phase(F.lds, g, S, E, F.wv);
      sgemm_phase(F, F.Y0() + (size_t)MP * D, F.W0O(), D, D, SOut{F.YO() + (size_t)MP * D, D, 1 << 30, nullptr, 0}, 0); }
    GRID_BAR();
    phase_mid_rowwise(F);
    GRID_BAR();
    { pg8::Gemm g{F.XN(), F.W1I(), MP, OD_MAIN, D}; pg8::StaticOrder S; S.init(MP, OD_MAIN, F.G, (int)blockIdx.x);
      pg8::EpiBf16 E{F.QKV1(), 3072, 3072, F.Z1(), D}; pg8::gemm_phase(F.lds, g, S, E, F.wv);
      sgemm_phase(F, F.XN() + (size_t)MP * D, F.W1I(), OD_MAIN, D, SOut{F.QKV1() + (size_t)MP * 3072, 3072, 3072, F.Z1() + (size_t)MP * D, D}, 0); }
    GRID_BAR();
    phase_gdn_fused(F);
    GRID_BAR();
    { pg8::Gemm g{F.Y1(), F.W1O(), MP, D, D}; pg8::StaticOrder S; S.init(MP, D, F.G, (int)blockIdx.x);
      pg8::EpiBf16 E{F.YO(), D, 1 << 30, F.YO(), D}; pg8::gemm_phase(F.lds, g, S, E, F.wv);
      sgemm_phase(F, F.Y1() + (size_t)MP * D, F.W1O(), D, D, SOut{F.YO() + (size_t)MP * D, D, 1 << 30, nullptr, 0}, 0); }
    GRID_BAR();
    phase_final_rowwise(F);
}

extern "C" void kernel_launch(void* const* d_in, const int* in_sizes, int n_in, void* d_out, int out_size, void* d_ws, size_t ws_size, hipStream_t stream) {
    static int grid = 0;
    if (grid == 0) {
        if (n_in != 34 || out_size != (int)O_END || ws_size < WS_END) { grid = -1; return; }
        int dev = 0, cus = 0, per_cu = 0;
        if (hipGetDevice(&dev) != hipSuccess || hipDeviceGetAttribute(&cus, hipDeviceAttributeMultiprocessorCount, dev) != hipSuccess) { grid = -1; return; }
        if (hipFuncSetAttribute((const void*)fwd_megakernel, hipFuncAttributeMaxDynamicSharedMemorySize, LDS_BYTES) != hipSuccess) { grid = -1; return; }
        if (hipOccupancyMaxActiveBlocksPerMultiprocessor(&per_cu, (const void*)fwd_megakernel, 512, LDS_BYTES) != hipSuccess || per_cu < 1) { grid = -1; return; }
        grid = cus;
    }
    if (grid < 0) return;
    if (hipMemsetAsync((char*)d_ws + WS_CTL, 0, 65536 + 4224 * 64, stream) != hipSuccess) return;
    Params p{};
    for (int i = 0; i < 34; ++i) p.in[i] = (const float*)d_in[i];
    p.out = (float*)d_out; p.ws = (unsigned char*)d_ws;
    void* args[] = {&p};
    (void)hipLaunchCooperativeKernel((const void*)fwd_megakernel, dim3(grid), dim3(512), args, LDS_BYTES, stream);
}
```

```cpp
#include <hip/hip_runtime.h>
#include <hip/hip_cooperative_groups.h>
namespace cg = cooperative_groups;

#define LAS __attribute__((address_space(3)))
typedef unsigned short bf16_t;
typedef short bf16x8 __attribute__((ext_vector_type(8)));
typedef float f32x4 __attribute__((ext_vector_type(4)));
typedef float f32x2 __attribute__((ext_vector_type(2)));
typedef unsigned u32x4 __attribute__((ext_vector_type(4)));
typedef unsigned u32x2 __attribute__((ext_vector_type(2)));

constexpr int D = 1024, BP = 8, TP = 4096, BS = 16, TS = 16;
constexpr int MP = BP * TP, MS = BS * TS, MT = MP + MS;
constexpr int NSEQ = BP + BS;
constexpr int EV_IN = 2304, OD_IN = 4112, OD_MAIN = 4096;
constexpr int C_XA = 0, C_GA = 512, C_Q = 1024, C_K = 1536, C_V = 1664, C_GB = 1792;
constexpr float EPS = 1e-6f;
constexpr size_t O_Y = 0, O_LCP = 33816576, O_LCS = 33828864, O_LHP = 33853440, O_LHS = 33857536, O_KP = 33865728, O_KS = 33996800,
                 O_VP = 34029568, O_VS = 34160640, O_GCP = 34193408, O_GCS = 34267136, O_GSP = 34414592, O_GSS = 35463168, O_END = 37560320;
constexpr size_t MiB = 1u << 20;
constexpr size_t WS_CTL = 0, WS_W1O = 1 * MiB, WS_MOD = 3 * MiB, WS_ROPE = 4 * MiB, WS_BA = 5 * MiB, WS_LAG = 8 * MiB, WS_LGW = 10 * MiB;
constexpr size_t WS_RA = 16 * MiB, RA_BYTES = (size_t)MT * 4096 * 2;
constexpr size_t WS_RB = WS_RA + RA_BYTES;
constexpr size_t ACT_BYTES = (size_t)MT * D * 2;
constexpr size_t RB_XN = 0, RB_Y0 = ACT_BYTES, RB_YO = 2 * ACT_BYTES, RB_W0I = 3 * ACT_BYTES, RB_W0O = RB_W0I + (size_t)EV_IN * D * 2,
                 RB_W1I = RB_W0O + (size_t)D * D * 2, RB_WEND = RB_W1I + (size_t)OD_MAIN * D * 2;
constexpr size_t RB_BYTES = (size_t)4224 * 73728;
constexpr size_t WS_END = WS_RB + RB_BYTES;
static_assert(RB_WEND <= RB_BYTES, "ws map");
static_assert((size_t)MT * 3072 * 2 <= RB_BYTES, "ws map");
constexpr int LDS_BYTES = 155648;

struct Params { const float* in[34]; float* out; unsigned char* ws; };

__device__ __forceinline__ float bf2f(bf16_t b) { return __uint_as_float(((unsigned)b) << 16); }
__device__ __forceinline__ unsigned f2bf(float f) { unsigned u = __float_as_uint(f); return (u + 0x7fffu + ((u >> 16) & 1u)) >> 16; }
__device__ __forceinline__ unsigned pk2(float lo, float hi) { return f2bf(lo) | (f2bf(hi) << 16); }
typedef __bf16 bf16x2_t __attribute__((ext_vector_type(2)));
__device__ __forceinline__ unsigned cvt2(float a, float b) { f32x2 v = {a, b}; bf16x2_t r = __builtin_convertvector(v, bf16x2_t); return __builtin_bit_cast(unsigned, r); }
__device__ __forceinline__ float lo16(unsigned w) { return __uint_as_float(w << 16); }
__device__ __forceinline__ float hi16(unsigned w) { return __uint_as_float(w & 0xffff0000u); }
__device__ __forceinline__ float shfl_idx(float x, int src_lane) { return __int_as_float(__builtin_amdgcn_ds_bpermute(src_lane << 2, __float_as_int(x))); }
__device__ __forceinline__ float shfl_xor_l(float x, int o, int lane) { return shfl_idx(x, lane ^ o); }
__device__ __forceinline__ float wave_sum_b(float v, int lane) {
#pragma unroll
    for (int o = 1; o < 64; o <<= 1) v += shfl_xor_l(v, o, lane);
    return v;
}
#define DPP_ADD(v, ctrl, rmask) v += __int_as_float(__builtin_amdgcn_update_dpp(0, __float_as_int(v), (ctrl), (rmask), 0xf, false))
__device__ __forceinline__ float wave_sum(float v, int lane) {
    (void)lane;
    DPP_ADD(v, 0xB1, 0xf); DPP_ADD(v, 0x4E, 0xf); DPP_ADD(v, 0x141, 0xf); DPP_ADD(v, 0x140, 0xf);
    DPP_ADD(v, 0x142, 0xa); DPP_ADD(v, 0x143, 0xc);
    float r = __int_as_float(__builtin_amdgcn_readlane(__float_as_int(v), 63)); asm volatile("" : "+v"(r)); return r;
}
__device__ __forceinline__ float sigmoidf_(float x) { return __builtin_amdgcn_rcpf(1.0f + __expf(-x)); }
__device__ __forceinline__ float siluf_(float x) { return x * __builtin_amdgcn_rcpf(1.0f + __expf(-x)); }
__device__ __forceinline__ float softplusf_(float x) { return x > 20.f ? x : log1pf(__expf(x)); }
__device__ __forceinline__ int seq_base(int s) { return s < BP ? s * TP : MP + (s - BP) * TS; }
__device__ __forceinline__ int seq_len(int s) { return s < BP ? TP : TS; }
__device__ __forceinline__ void tok_info(int m, int& s, int& t) { if (m < MP) { s = m >> 12; t = m & 4095; } else { const int r = m - MP; s = BP + (r >> 4); t = r & 15; } }

__device__ __forceinline__ int opaque_tid(int wv) { unsigned z = 0u; asm volatile("" : "+v"(z)); const int l = __builtin_amdgcn_mbcnt_hi(~0u, __builtin_amdgcn_mbcnt_lo(~0u, z)); return wv * 64 + l; }
namespace pg8 {
constexpr int BM = 256, BK = 64, HALF = 128, HTB = HALF * BK * 2, STAGE_BYTES = 8 * HTB, NXCD = 8, WGM = 8;
__host__ __device__ __forceinline__ int lds_byte(int r, int c) { const int st = (r >> 4) * 2 + (c >> 5), rr = r & 15, cc = c & 31, ob = rr * 64 + cc * 2; return st * 1024 + (ob ^ (((ob >> 9) & 1) << 5)); }
__host__ __device__ __forceinline__ void stage_rc(int b, int& R, int& C) { const int st = b / 1024, sb = b % 1024, swz = sb ^ (((sb >> 9) & 1) << 5); R = (st >> 1) * 16 + swz / 64; C = (st & 1) * 32 + (swz % 64) / 2; }
__host__ __device__ __forceinline__ int perm32(int rho) { const int n = rho >> 4, i = rho & 15; return 8 * (i >> 2) + 4 * n + (i & 3); }
struct Unit { int pm, pn; };
struct Gemm { const bf16_t* A; const bf16_t* Bt; int M, N, K; };
struct StaticOrder {
    int nM, nN, nwg, G, c;
    __device__ void init(int M, int N, int G_, int c_) { nM = M / BM; nN = N / BM; nwg = nM * nN; G = G_; c = c_; }
    __device__ bool next(int i, Unit& u) const {
        const long L = (long)i * G + c; if (L >= nwg) return false;
        int wgid = (int)L; { const int q = nwg / NXCD, r = nwg % NXCD, xcd = wgid % NXCD, off = wgid / NXCD; wgid = (xcd < r ? xcd * (q + 1) : r * (q + 1) + (xcd - r) * q) + off; }
        const int nig = WGM * nN, gid = wgid / nig, fm = gid * WGM, gsz = (nM - fm) < WGM ? (nM - fm) : WGM;
        u.pm = fm + ((wgid % nig) % gsz); u.pn = (wgid % nig) / gsz; return true;
    }
};
__device__ __forceinline__ unsigned cvt_pk_bf16(float lo, float hi) { unsigned r; asm volatile("v_cvt_pk_bf16_f32 %0, %1, %2" : "=v"(r) : "v"(lo), "v"(hi)); return r; }
struct EpiBf16 {
    static constexpr bool PERM = true;
    bf16_t* O0; int ld0; int split; bf16_t* O1; int ld1;
    __device__ __forceinline__ void operator()(const f32x4 (&acc)[2][2][4][2], const Unit& u, int wr, int wc, int fr, int fq) const {
        const int row0 = u.pm * BM + wr * 64 + fr; int colt = u.pn * BM; bf16_t* base = O0; int ld = ld0;
        if (colt >= split) { base = O1; ld = ld1; colt -= split; }
        const int col0 = colt + wc * 32 + 8 * fq;
#pragma unroll
        for (int ai = 0; ai < 2; ++ai)
#pragma unroll
            for (int m = 0; m < 4; ++m) { bf16_t* rowp = base + (size_t)(row0 + ai * HALF + m * 16) * ld + col0;
#pragma unroll
                for (int bj = 0; bj < 2; ++bj) { const f32x4 v0 = acc[ai][bj][m][0], v1 = acc[ai][bj][m][1];
                    u32x4 w; w.x = cvt_pk_bf16(v0[0], v0[1]); w.y = cvt_pk_bf16(v0[2], v0[3]); w.z = cvt_pk_bf16(v1[0], v1[1]); w.w = cvt_pk_bf16(v1[2], v1[3]);
                    *(u32x4*)(rowp + bj * HALF) = w; } }
    }
};
template <class Epi, class Sched>
__device__ __forceinline__ void gemm_phase(LAS unsigned char* lds, const Gemm g, const Sched& S, const Epi& E, const int wv0) {
    int tid = opaque_tid(wv0);
    const int wid = __builtin_amdgcn_readfirstlane(tid >> 6), lane = tid & 63, wr = wid >> 2, wc = wid & 3, fr = lane & 15, fq = lane >> 4;
    const int K = g.K, nt = K / BK;
    unsigned voffA[2], voffB[2];
#pragma unroll
    for (int i = 0; i < 2; ++i) { int R, C; stage_rc(tid * 16 + i * 8192, R, C); const int Rb = Epi::PERM ? ((R & ~31) + perm32(R & 31)) : R;
        voffA[i] = (unsigned)(R * K + C) * 2u; voffB[i] = (unsigned)(Rb * K + C) * 2u; }
    const size_t kstep = (size_t)(BK * 2);
    const size_t hstep = (size_t)HALF * K * 2;
    const size_t tstep = 2 * hstep;
    const unsigned ldsw = (unsigned)wid * 1024u;
    const int aoff = lds_byte(wr * 64 + fr, fq * 8), boff = lds_byte(wc * 32 + fr, fq * 8);
#define PG8_SA(b, h) (((b) * 2 + (h)) * HTB)
#define PG8_SB(b, h) ((4 + (b) * 2 + (h)) * HTB)
#define PG8_STAGE(bufoff, gbase, voff) do { _Pragma("unroll") for (int _i = 0; _i < 2; ++_i) \
        __builtin_amdgcn_global_load_lds((const unsigned*)((const char*)(gbase) + (voff)[_i]), (LAS unsigned*)(lds + (bufoff) + ldsw + _i * 8192), 16, 0, 0); } while (0)
#define PG8_LDA(dst, b, h) do { _Pragma("unroll") for (int m = 0; m < 4; ++m) _Pragma("unroll") for (int k = 0; k < 2; ++k) dst[m][k] = *(const LAS bf16x8*)(lds + PG8_SA(b, h) + aoff + m * 2048 + k * 1024); } while (0)
#define PG8_LDB(dst, b, h) do { _Pragma("unroll") for (int n = 0; n < 2; ++n) _Pragma("unroll") for (int k = 0; k < 2; ++k) dst[n][k] = *(const LAS bf16x8*)(lds + PG8_SB(b, h) + boff + n * 2048 + k * 1024); } while (0)
#define PG8_MMA(ai, bj, At, Bt) do { __builtin_amdgcn_s_setprio(1); _Pragma("unroll") for (int m = 0; m < 4; ++m) _Pragma("unroll") for (int n = 0; n < 2; ++n) _Pragma("unroll") for (int k = 0; k < 2; ++k) \
        acc[ai][bj][m][n] = __builtin_amdgcn_mfma_f32_16x16x32_bf16(Bt[n][k], At[m][k], acc[ai][bj][m][n], 0, 0, 0); __builtin_amdgcn_s_setprio(0); } while (0)
#define PG8_WAIT_V(n) asm volatile("s_waitcnt vmcnt(" #n ")" ::: "memory")
#define PG8_WAIT_L(n) asm volatile("s_waitcnt lgkmcnt(" #n ")" ::: "memory")
#define PG8_BAR __builtin_amdgcn_s_barrier()
#define PG8_SCHED __builtin_amdgcn_sched_barrier(0)
    Unit cur, nxt; int ui = 0;
    if (!S.next(0, cur)) return;
    f32x4 acc[2][2][4][2];
#pragma unroll
    for (int a = 0; a < 2; ++a)
#pragma unroll
        for (int b = 0; b < 2; ++b)
#pragma unroll
            for (int m = 0; m < 4; ++m)
#pragma unroll
                for (int n = 0; n < 2; ++n) acc[a][b][m][n] = (f32x4){0.f, 0.f, 0.f, 0.f};
    bf16x8 At[4][2], B0[2][2], B1[2][2];
    const char* cA = (const char*)g.A + (size_t)cur.pm * tstep; const char* cB = (const char*)g.Bt + (size_t)cur.pn * tstep;
    PG8_STAGE(PG8_SB(0, 0), cB, voffB); PG8_STAGE(PG8_SA(0, 0), cA, voffA); PG8_STAGE(PG8_SB(0, 1), cB + hstep, voffB); PG8_STAGE(PG8_SA(0, 1), cA + hstep, voffA);
    if (wr == 1) PG8_BAR;
    PG8_WAIT_V(4); PG8_BAR;
    PG8_STAGE(PG8_SB(1, 0), cB + kstep, voffB); PG8_STAGE(PG8_SA(1, 0), cA + kstep, voffA); PG8_STAGE(PG8_SB(1, 1), cB + hstep + kstep, voffB);
    PG8_WAIT_V(6); PG8_BAR;
    for (;;) {
        const bool has_next = S.next(ui + 1, nxt);
        const char* nA = has_next ? (const char*)g.A + (size_t)nxt.pm * tstep : cA; const char* nB = has_next ? (const char*)g.Bt + (size_t)nxt.pn * tstep : cB;
        for (int t = 0; t < nt; t += 2) {
            const bool last = (t == nt - 2);
            const char* a1 = cA + (size_t)(t + 1) * kstep;
            const char* a2 = last ? nA : cA + (size_t)(t + 2) * kstep; const char* b2 = last ? nB : cB + (size_t)(t + 2) * kstep;
            const char* a3 = a2 + kstep; const char* b3 = b2 + kstep;
            PG8_LDB(B0, 0, 0); PG8_SCHED; PG8_LDA(At, 0, 0); PG8_STAGE(PG8_SA(1, 1), a1 + hstep, voffA);
            PG8_WAIT_L(8); PG8_BAR; PG8_WAIT_L(0); PG8_MMA(0, 0, At, B0); PG8_BAR; PG8_SCHED;
            PG8_LDB(B1, 0, 1); PG8_STAGE(PG8_SB(0, 0), b2, voffB);
            PG8_BAR; PG8_WAIT_L(0); PG8_MMA(0, 1, At, B1); PG8_BAR;
            PG8_LDA(At, 0, 1); PG8_STAGE(PG8_SA(0, 0), a2, voffA);
            PG8_BAR; PG8_WAIT_L(0); PG8_MMA(1, 0, At, B0); PG8_BAR; PG8_SCHED;
            PG8_STAGE(PG8_SB(0, 1), b2 + hstep, voffB);
            PG8_WAIT_V(6); PG8_BAR; PG8_MMA(1, 1, At, B1); PG8_BAR;
            PG8_LDB(B0, 1, 0); PG8_SCHED; PG8_LDA(At, 1, 0); PG8_STAGE(PG8_SA(0, 1), a2 + hstep, voffA);
            PG8_WAIT_L(8); PG8_BAR; PG8_WAIT_L(0); PG8_MMA(0, 0, At, B0); PG8_BAR; PG8_SCHED;
            PG8_LDB(B1, 1, 1); PG8_STAGE(PG8_SB(1, 0), b3, voffB);
            PG8_BAR; PG8_WAIT_L(0); PG8_MMA(0, 1, At, B1); PG8_BAR;
            PG8_LDA(At, 1, 1); PG8_STAGE(PG8_SA(1, 0), a3, voffA);
            PG8_BAR; PG8_WAIT_L(0); PG8_MMA(1, 0, At, B0); PG8_BAR; PG8_SCHED;
            PG8_STAGE(PG8_SB(1, 1), b3 + hstep, voffB);
            PG8_WAIT_V(6); PG8_BAR; PG8_MMA(1, 1, At, B1); PG8_BAR;
        }
        E(acc, cur, wr, wc, fr, fq);
        if (!has_next) break;
#pragma unroll
        for (int a = 0; a < 2; ++a)
#pragma unroll
            for (int b = 0; b < 2; ++b)
#pragma unroll
                for (int m = 0; m < 4; ++m)
#pragma unroll
                    for (int n = 0; n < 2; ++n) acc[a][b][m][n] = (f32x4){0.f, 0.f, 0.f, 0.f};
        cur = nxt; cA = nA; cB = nB; ++ui;
    }
    PG8_WAIT_V(0);
    if (wr == 0) PG8_BAR;
    PG8_BAR;
#undef PG8_SA
#undef PG8_SB
#undef PG8_STAGE
#undef PG8_LDA
#undef PG8_LDB
#undef PG8_MMA
#undef PG8_WAIT_V
#undef PG8_WAIT_L
#undef PG8_BAR
#undef PG8_SCHED
}
}


#define XB_TMO      128
#define XB_XCNT(j)  (256  + 64 * (j))
#define XB_XSUB(j)  (1280 + 64 * (j))
#define XB_XGEN(j)  (2304 + 64 * (j))
#define XB_TOP      3328
#define XB_TOPGEN   3392
#define XCD_BAR_WORDS 3456
#define XB_SPIN_CAP (1u << 18)
__device__ __forceinline__ unsigned xb_ld(unsigned* p)              { return __hip_atomic_load(p, __ATOMIC_RELAXED, __HIP_MEMORY_SCOPE_AGENT); }
__device__ __forceinline__ unsigned xb_add(unsigned* p, unsigned v) { return __hip_atomic_fetch_add(p, v, __ATOMIC_RELAXED, __HIP_MEMORY_SCOPE_AGENT); }
__device__ __forceinline__ unsigned xb_xcc_id() { return (unsigned)__builtin_amdgcn_s_getreg((3 << 11) | 20) & 0xFu; }
#define XB_SPIN(cond, bar) do { unsigned _sp = 0; while (cond) { __builtin_amdgcn_s_sleep(1); \
    if ((++_sp & 255u) == 0u) { if (xb_ld(&(bar)[XB_TMO])) break; if (_sp > XB_SPIN_CAP) { atomicAdd(&(bar)[XB_TMO], 1u); break; } } } } while (0)
struct XcdBarrier { unsigned* bar; unsigned x; volatile LAS unsigned* st; };
__device__ __forceinline__ XcdBarrier xcd_barrier_post(unsigned* bar, volatile LAS unsigned* st) {
    XcdBarrier b; b.bar = bar; b.x = xb_xcc_id(); b.st = st;
    if (threadIdx.x == 0) (void)xb_add(&bar[XB_XCNT(b.x)], 1u);
    return b;
}
__device__ __forceinline__ void xcd_barrier_complete(unsigned* bar, unsigned x, unsigned& nloc, unsigned& nx) {
    const unsigned G = gridDim.x * gridDim.y * gridDim.z;
    unsigned sum, cnt, mine, sp = 0u;
    for (;;) {
        sum = 0u; cnt = 0u; mine = 0u;
#pragma unroll
        for (unsigned j = 0; j < 16; ++j) { const unsigned c = xb_ld(&bar[XB_XCNT(j)]); sum += c; cnt += (c > 0u) ? 1u : 0u; mine = (j == x) ? c : mine; }
        if (sum == G) break;
        __builtin_amdgcn_s_sleep(1);
        if ((++sp & 255u) == 0u) { if (xb_ld(&bar[XB_TMO])) break; if (sp > XB_SPIN_CAP) { atomicAdd(&bar[XB_TMO], 1u); break; } }
    }
    nloc = mine > 0u ? mine : 1u; nx = cnt > 0u ? cnt : 1u;
}
__device__ __forceinline__ void xcd_barrier(const XcdBarrier& b, const int wv0) {
    asm volatile("s_waitcnt vmcnt(0)" ::: "memory");
    __syncthreads();
    if (opaque_tid(wv0) == 0) {
        unsigned* bar = b.bar;
        __builtin_amdgcn_s_waitcnt(0);
        unsigned nloc = b.st[0], nx = b.st[1];
        if (nloc == 0u) { xcd_barrier_complete(bar, b.x, nloc, nx); b.st[0] = nloc; b.st[1] = nx; }
        const unsigned old = xb_add(&bar[XB_XSUB(b.x)], 1u);
        const unsigned gen = old / nloc;
        if (old + 1u == (gen + 1u) * nloc) {
            __builtin_amdgcn_fence(__ATOMIC_RELEASE, "agent");
            asm volatile("s_waitcnt vmcnt(0)" ::: "memory");
            const unsigned og = xb_add(&bar[XB_TOP], 1u);
            const unsigned tg = og / nx;
            if (og + 1u == (tg + 1u) * nx) xb_add(&bar[XB_TOPGEN], 1u);
            else XB_SPIN(xb_ld(&bar[XB_TOPGEN]) == tg, bar);
            __builtin_amdgcn_fence(__ATOMIC_ACQUIRE, "agent");
            xb_add(&bar[XB_XGEN(b.x)], 1u);
            asm volatile("s_waitcnt vmcnt(0)" ::: "memory");
        } else {
            XB_SPIN(xb_ld(&bar[XB_XGEN(b.x)]) == gen, bar);
            __builtin_amdgcn_fence(__ATOMIC_ACQUIRE, "agent");
            asm volatile("s_waitcnt vmcnt(0)" ::: "memory");
        }
    }
    __syncthreads();
}

struct Frame {
    LAS unsigned char* lds;
    int vcu, G, wv;
    const float* const* in; float* out; unsigned char* ws;
    __device__ __forceinline__ float* MOD() const { return (float*)(ws + WS_MOD); }
    __device__ __forceinline__ float* ROPE() const { return (float*)(ws + WS_ROPE); }
    __device__ __forceinline__ float* BA() const { return (float*)(ws + WS_BA); }
    __device__ __forceinline__ float* LAG() const { return (float*)(ws + WS_LAG); }
    __device__ __forceinline__ bf16_t* W1O() const { return (bf16_t*)(ws + WS_W1O); }
    __device__ __forceinline__ bf16_t* U0() const { return (bf16_t*)(ws + WS_RA); }
    __device__ __forceinline__ bf16_t* QKV1() const { return (bf16_t*)(ws + WS_RA); }
    __device__ __forceinline__ bf16_t* Z1() const { return (bf16_t*)(ws + WS_RA + (size_t)MT * 3072 * 2); }
    __device__ __forceinline__ bf16_t* Y1() const { return (bf16_t*)(ws + WS_RA + (size_t)MT * 3072 * 2); }
    __device__ __forceinline__ bf16_t* XN() const { return (bf16_t*)(ws + WS_RB + RB_XN); }
    __device__ __forceinline__ bf16_t* Y0() const { return (bf16_t*)(ws + WS_RB + RB_Y0); }
    __device__ __forceinline__ bf16_t* YO() const { return (bf16_t*)(ws + WS_RB + RB_YO); }
    __device__ __forceinline__ bf16_t* W0I() const { return (bf16_t*)(ws + WS_RB + RB_W0I); }
    __device__ __forceinline__ bf16_t* W0O() const { return (bf16_t*)(ws + WS_RB + RB_W0O); }
    __device__ __forceinline__ bf16_t* W1I() const { return (bf16_t*)(ws + WS_RB + RB_W1I); }
    __device__ __forceinline__ bf16_t* QKVC() const { return (bf16_t*)(ws + WS_RB); }
};

#define PHASE_IDS() int tid = opaque_tid(F.wv); const int lane = tid & 63, wave = __builtin_amdgcn_readfirstlane(tid >> 6); (void)lane; (void)wave
__device__ __forceinline__ void p0_transpose_item(const float* W, int ldw, int nblk, int K, bf16_t* WT, LAS float* scr, int item, int lane) {
    const int kb = item / nblk, nb = item % nblk, k0 = 64 * kb, n0 = 32 * nb;
    f32x4 v[8];
#pragma unroll
    for (int i = 0; i < 8; ++i) v[i] = *(const f32x4*)(W + (size_t)(k0 + 8 * i + (lane >> 3)) * ldw + n0 + 4 * (lane & 7));
#pragma unroll
    for (int i = 0; i < 8; ++i) { LAS float* d = scr + (8 * i + (lane >> 3)) * 33 + 4 * (lane & 7); d[0] = v[i][0]; d[1] = v[i][1]; d[2] = v[i][2]; d[3] = v[i][3]; }
    asm volatile("s_waitcnt lgkmcnt(0)" ::: "memory");
    const int c = lane & 7;
#pragma unroll
    for (int j = 0; j < 4; ++j) { const int n = (lane >> 3) + 8 * j; const LAS float* s = scr + (8 * c) * 33 + n;
        u32x4 o; o.x = pk2(s[0 * 33], s[1 * 33]); o.y = pk2(s[2 * 33], s[3 * 33]); o.z = pk2(s[4 * 33], s[5 * 33]); o.w = pk2(s[6 * 33], s[7 * 33]);
        *(u32x4*)(WT + (size_t)(n0 + n) * K + k0 + 8 * c) = o; }
    asm volatile("s_waitcnt lgkmcnt(0)" ::: "memory");
}
constexpr size_t WS_MODP = 12 * MiB;
__device__ __forceinline__ f32x4 mod4(const float* MODP, int L, int s, int off) {
    f32x4 a = *(const f32x4*)(MODP + ((size_t)((L * 4 + 0) * 24 + s)) * 3072 + off);
#pragma unroll
    for (int sl = 1; sl < 4; ++sl) a += *(const f32x4*)(MODP + ((size_t)((L * 4 + sl) * 24 + s)) * 3072 + off);
    return a;
}
__device__ __forceinline__ void mod_task(Frame& F, const int bt, const int tid, const int lane, const int wave) {
    const int L = bt / 192, sl = (bt % 192) / 48, n0 = (bt % 48) * 64, kb = sl * 256;
    LAS float* tab = (LAS float*)F.lds;
    {   float cv[12];
#pragma unroll
        for (int u = 0; u < 12; ++u) { const int idx = tid + 512 * u, s = idx >> 8, k = kb + (idx & 255); cv[u] = s < BP ? F.in[8][s * D + k] : F.in[9][(s - BP) * D + k]; }
#pragma unroll
        for (int u = 0; u < 12; ++u) { const int idx = tid + 512 * u, s = idx >> 8, k = idx & 255; tab[k * 24 + s] = siluf_(cv[u]); } }
    __syncthreads();
    const float* mw = (L == 0 ? F.in[10] : F.in[24]) + n0 + lane;
    float acc[24];
#pragma unroll
    for (int r = 0; r < 24; ++r) acc[r] = 0.f;
    for (int k0 = wave * 32; k0 < wave * 32 + 32; k0 += 16) {
        float wv[16];
#pragma unroll
        for (int u = 0; u < 16; ++u) wv[u] = mw[(size_t)(kb + k0 + u) * 3072];
#pragma unroll
        for (int u = 0; u < 16; ++u) { const float w = wv[u];
            const LAS f32x4* tp = (const LAS f32x4*)(tab + (k0 + u) * 24);
#pragma unroll
            for (int q = 0; q < 6; ++q) { const f32x4 t4 = tp[q]; acc[4 * q] += t4[0] * w; acc[4 * q + 1] += t4[1] * w; acc[4 * q + 2] += t4[2] * w; acc[4 * q + 3] += t4[3] * w; } }
    }
    __syncthreads();
    LAS float* red = (LAS float*)F.lds;
#pragma unroll
    for (int r = 0; r < 24; ++r) red[(wave * 24 + r) * 64 + lane] = acc[r];
    __syncthreads();
    const float* mb = (L == 0 ? F.in[11] : F.in[25]);
    float* MODP = (float*)(F.ws + WS_MODP);
    for (int idx = tid; idx < 24 * 64; idx += 512) { const int r = idx >> 6, l = idx & 63; float s = 0.f;
#pragma unroll
        for (int w = 0; w < 8; ++w) s += red[(w * 24 + r) * 64 + l];
        MODP[((size_t)((L * 4 + sl) * 24 + r)) * 3072 + n0 + l] = s + (sl == 0 ? mb[n0 + l] : 0.f); }
    __syncthreads();
}
__device__ __forceinline__ void phase_mod0(Frame& F) {
    PHASE_IDS();
    for (int bt = F.vcu; bt < 192; bt += F.G) { int t2 = tid; asm volatile("" : "+v"(t2)); mod_task(F, bt, t2, t2 & 63, wave); }
}
__device__ __forceinline__ void phase_mod1(Frame& F) {
    PHASE_IDS();
    __syncthreads();
    for (int bt = 192 + F.vcu; bt < 384; bt += F.G) { int t2 = tid; asm volatile("" : "+v"(t2)); mod_task(F, bt, t2, t2 & 63, wave); }
}
__device__ __forceinline__ void phase_prologue(Frame& F) {
    PHASE_IDS();
    const int gw = F.vcu * 8 + wave, NGW = F.G * 8;
    {
        LAS float* scr = (LAS float*)(F.lds + wave * 16384);
        constexpr int I0 = 16 * (EV_IN / 32), I1 = 16 * 32, I2 = 16 * (OD_MAIN / 32), I3 = 16 * 32;
        for (int it = gw; it < I0 + I1 + I2 + I3; it += NGW) {
            int r = it;
            if (r < I0) { p0_transpose_item(F.in[14], EV_IN, EV_IN / 32, D, F.W0I(), scr, r, lane); continue; } r -= I0;
            if (r < I1) { p0_transpose_item(F.in[23], D, 32, D, F.W0O(), scr, r, lane); continue; } r -= I1;
            if (r < I2) { p0_transpose_item(F.in[28], OD_IN, OD_MAIN / 32, D, F.W1I(), scr, r, lane); continue; } r -= I2;
            p0_transpose_item(F.in[33], D, 32, D, F.W1O(), scr, r, lane);
        }
    }
    {
        const double inv[8] = {1.0, 0.19392274474868576, 0.03760603093086393, 0.007292664737217109, 0.001414213562373095, 0.0002742481756762073, 5.318295896944988e-05, 1.031338537721246e-05};
        for (int idx = F.vcu * 512 + tid; idx < 4112 * 8; idx += F.G * 512) {
            const int pos = idx >> 3, i = idx & 7;
            double iv = inv[0];
#pragma unroll
            for (int q = 1; q < 8; ++q) iv = (i == q) ? inv[q] : iv;
            const double ang = (double)pos * iv;
            const double n = __builtin_rint(ang * 0.15915494309189535);
            const float r = (float)__builtin_fma(-n, 6.283185307179586, ang);
            F.ROPE()[pos * 16 + i] = __cosf(r); F.ROPE()[pos * 16 + 8 + i] = __sinf(r);
        }
    }
    {
        bf16_t* LGW = (bf16_t*)(F.ws + WS_LGW);
        for (int idx = F.vcu * 512 + tid; idx < 8 * 2 * 64 * 64; idx += F.G * 512) { const int k = idx & 63, n = (idx >> 6) & 63, gate = (idx >> 12) & 1, hh = idx >> 13;
            LGW[idx] = (bf16_t)f2bf((gate ? F.in[19] : F.in[17])[(hh * 64 + k) * 64 + n]); }
    }
}

__device__ __forceinline__ const float* x_row(Frame& F, int m) { return m < MP ? F.in[0] + (size_t)m * D : F.in[1] + (size_t)(m - MP) * D; }
__device__ __forceinline__ void rows_prenorm0(Frame& F, const int m0, const int n, const int s, const int lane) {
    const float* MODP = (const float*)(F.ws + WS_MODP);
    f32x4 A[4], C[4];
#pragma unroll
    for (int j = 0; j < 4; ++j) { const int c = 4 * lane + 256 * j; const f32x4 g = *(const f32x4*)(F.in[12] + c), sc = mod4(MODP, 0, s, 1024 + c); C[j] = mod4(MODP, 0, s, c);
#pragma unroll
        for (int e = 0; e < 4; ++e) A[j][e] = g[e] * (1.f + sc[e]); }
    f32x4 cur[4];
#pragma unroll
    for (int j = 0; j < 4; ++j) cur[j] = *(const f32x4*)(x_row(F, m0) + 4 * lane + 256 * j);
    for (int i = 0; i < n; ++i) {
        const int mn = m0 + (i + 1 < n ? i + 1 : i); f32x4 nxt[4];
#pragma unroll
        for (int j = 0; j < 4; ++j) nxt[j] = *(const f32x4*)(x_row(F, mn) + 4 * lane + 256 * j);
        float ss = 0.f;
#pragma unroll
        for (int j = 0; j < 4; ++j) ss += (cur[j][0] * cur[j][0] + cur[j][1] * cur[j][1]) + (cur[j][2] * cur[j][2] + cur[j][3] * cur[j][3]);
        const float r = rsqrtf(wave_sum(ss, lane) * (1.f / D) + EPS);
#pragma unroll
        for (int j = 0; j < 4; ++j) { u32x2 w; w[0] = cvt2(cur[j][0] * r * A[j][0] + C[j][0], cur[j][1] * r * A[j][1] + C[j][1]); w[1] = cvt2(cur[j][2] * r * A[j][2] + C[j][2], cur[j][3] * r * A[j][3] + C[j][3]);
            *(u32x2*)(F.XN() + (size_t)(m0 + i) * D + 4 * lane + 256 * j) = w; }
#pragma unroll
        for (int j = 0; j < 4; ++j) cur[j] = nxt[j];
    }
}
__device__ __forceinline__ void phase_prenorm0(Frame& F) {
    PHASE_IDS();
    const int gw = F.vcu * 8 + wave, NGW = F.G * 8;
    for (int w = gw; w < MP / 16; w += NGW) rows_prenorm0(F, w * 16, 16, w >> 8, lane);
    for (int w = gw; w < MS; w += NGW) rows_prenorm0(F, MP + w, 1, BP + (w >> 4), lane);
}

__device__ __forceinline__ void phase_rope(Frame& F) {
    PHASE_IDS();
    const int gt = F.vcu * 512 + tid, NT = F.G * 512;
    for (int idx = gt; idx < MT * 10; idx += NT) {
        const int m = idx / 10, slot = idx % 10;
        int s, t; tok_info(m, s, t);
        const int pos = s < BP ? t : TP + t;
        const int col = slot < 8 ? C_Q + slot * 64 : C_K + (slot - 8) * 64;
        u32x4* p = (u32x4*)(F.U0() + (size_t)m * EV_IN + col);
        const u32x4 xa = p[0], xb = p[1];
        const f32x4* rp = (const f32x4*)(F.ROPE() + pos * 16); const f32x4 c0 = rp[0], c1 = rp[1], s0 = rp[2], s1 = rp[3];
        float x1[8], x2[8], o1[8], o2[8];
#pragma unroll
        for (int e = 0; e < 4; ++e) { x1[2 * e] = lo16(xa[e]); x1[2 * e + 1] = hi16(xa[e]); x2[2 * e] = lo16(xb[e]); x2[2 * e + 1] = hi16(xb[e]); }
#pragma unroll
        for (int i = 0; i < 8; ++i) { const float c = i < 4 ? c0[i & 3] : c1[i & 3], sn = i < 4 ? s0[i & 3] : s1[i & 3]; o1[i] = x1[i] * c - x2[i] * sn; o2[i] = x2[i] * c + x1[i] * sn; }
        u32x4 ya, yb;
#pragma unroll
        for (int e = 0; e < 4; ++e) { ya[e] = cvt2(o1[2 * e], o1[2 * e + 1]); yb[e] = cvt2(o2[2 * e], o2[2 * e + 1]); }
        p[0] = ya; p[1] = yb;
        if (slot >= 8) { const int kv = slot - 8; float* o = nullptr;
            if (s >= BP) o = F.out + O_KS + ((size_t)((s - BP) * TS + t) * 2 + kv) * 64;
            else if (t >= TP - 128) o = F.out + O_KP + ((size_t)(s * 128 + (t - (TP - 128))) * 2 + kv) * 64;
            if (o) { *(f32x4*)o = (f32x4){o1[0], o1[1], o1[2], o1[3]}; *(f32x4*)(o + 4) = (f32x4){o1[4], o1[5], o1[6], o1[7]}; *(f32x4*)(o + 8) = (f32x4){o2[0], o2[1], o2[2], o2[3]}; *(f32x4*)(o + 12) = (f32x4){o2[4], o2[5], o2[6], o2[7]}; } }
    }
    for (int idx = gt; idx < 1280 * 224; idx += NT) {
        const int tk = idx / 224, e = idx % 224;
        int s, t, m; if (tk < 1024) { s = tk >> 7; t = TP - 128 + (tk & 127); m = s * TP + t; } else { s = BP + ((tk - 1024) >> 4); t = (tk - 1024) & 15; m = MP + (tk - 1024); }
        const bool isv = e >= 96; const int e2 = isv ? e - 96 : e; const int kv = isv ? (e2 >> 6) : (e2 / 48), d = isv ? (e2 & 63) : 16 + (e2 % 48);
        const float val = bf2f(F.U0()[(size_t)m * EV_IN + (isv ? C_V : C_K) + kv * 64 + d]);
        const size_t ob = s >= BP ? (isv ? O_VS : O_KS) + ((size_t)((s - BP) * TS + t) * 2 + kv) * 64 : (isv ? O_VP : O_KP) + ((size_t)(s * 128 + (t - (TP - 128))) * 2 + kv) * 64;
        F.out[ob + d] = val;
    }
}


#define MFMA32(a, b, c) __builtin_amdgcn_mfma_f32_32x32x16_bf16((a), (b), (c), 0, 0, 0)
#define MFMA16(a, b, c) __builtin_amdgcn_mfma_f32_16x16x32_bf16((a), (b), (c), 0, 0, 0)
typedef __amdgpu_buffer_rsrc_t brsrc_t;
__device__ __forceinline__ brsrc_t staging_rsrc(unsigned char* ws) { return __builtin_amdgcn_make_buffer_rsrc((void*)(ws + WS_RB), (short)0, (int)RB_BYTES, 0x00020000); }
__device__ __forceinline__ void st16_wt(brsrc_t r, unsigned off, u32x4 v) { __builtin_amdgcn_raw_buffer_store_b128(v, r, off, 0, 16); }
__device__ __forceinline__ u32x4 ld16_wt(brsrc_t r, unsigned off) { return __builtin_amdgcn_raw_buffer_load_b128(r, off, 0, 16); }
__device__ __forceinline__ void rows_mid(Frame& F, const LAS unsigned char* bawb, const int m0, const int n, const int s, const int lane) {
    const float* MODP = (const float*)(F.ws + WS_MODP);
    f32x4 A0[4], B1[4], C1[4];
#pragma unroll
    for (int j = 0; j < 4; ++j) { const int c = 4 * lane + 256 * j; const f32x4 g0 = *(const f32x4*)(F.in[13] + c), gt = mod4(MODP, 0, s, 2048 + c), g1 = *(const f32x4*)(F.in[26] + c), sc = mod4(MODP, 1, s, 1024 + c);
        C1[j] = mod4(MODP, 1, s, c);
#pragma unroll
        for (int e = 0; e < 4; ++e) { A0[j][e] = gt[e] * g0[e]; B1[j][e] = g1[e] * (1.f + sc[e]); } }
    u32x2 ycur[4]; f32x4 xcur[4];
#pragma unroll
    for (int j = 0; j < 4; ++j) { ycur[j] = *(const u32x2*)(F.YO() + (size_t)m0 * D + 4 * lane + 256 * j); xcur[j] = *(const f32x4*)(x_row(F, m0) + 4 * lane + 256 * j); }
    for (int i = 0; i < n; ++i) {
        const int m = m0 + i, mn = m0 + (i + 1 < n ? i + 1 : i); u32x2 ynxt[4]; f32x4 xnxt[4];
#pragma unroll
        for (int j = 0; j < 4; ++j) { ynxt[j] = *(const u32x2*)(F.YO() + (size_t)mn * D + 4 * lane + 256 * j); xnxt[j] = *(const f32x4*)(x_row(F, mn) + 4 * lane + 256 * j); }
        f32x4 y[4]; float ss = 0.f;
#pragma unroll
        for (int j = 0; j < 4; ++j) { y[j] = (f32x4){lo16(ycur[j][0]), hi16(ycur[j][0]), lo16(ycur[j][1]), hi16(ycur[j][1])}; ss += (y[j][0] * y[j][0] + y[j][1] * y[j][1]) + (y[j][2] * y[j][2] + y[j][3] * y[j][3]); }
        const float r1 = rsqrtf(wave_sum(ss, lane) * (1.f / D) + EPS);
        f32x4 x1[4]; float s2 = 0.f;
#pragma unroll
        for (int j = 0; j < 4; ++j) {
#pragma unroll
            for (int e = 0; e < 4; ++e) x1[j][e] = xcur[j][e] + A0[j][e] * (y[j][e] * r1);
            { u32x2 xb; xb[0] = cvt2(x1[j][0], x1[j][1]); xb[1] = cvt2(x1[j][2], x1[j][3]); *(u32x2*)((bf16_t*)(F.out + O_Y + (size_t)m * D) + 4 * lane + 256 * j) = xb; }
            s2 += (x1[j][0] * x1[j][0] + x1[j][1] * x1[j][1]) + (x1[j][2] * x1[j][2] + x1[j][3] * x1[j][3]); }
        const float r2 = rsqrtf(wave_sum(s2, lane) * (1.f / D) + EPS);
        f32x4 hm[4];
#pragma unroll
        for (int j = 0; j < 4; ++j) {
#pragma unroll
            for (int e = 0; e < 4; ++e) hm[j][e] = x1[j][e] * r2 * B1[j][e] + C1[j][e];
            u32x2 w; w[0] = cvt2(hm[j][0], hm[j][1]); w[1] = cvt2(hm[j][2], hm[j][3]); *(u32x2*)(F.XN() + (size_t)m * D + 4 * lane + 256 * j) = w; }
#pragma unroll
        for (int j = 0; j < 4; ++j) { ycur[j] = ynxt[j]; xcur[j] = xnxt[j]; }
    }
    asm volatile("s_waitcnt vmcnt(0)" ::: "memory");
    {   const brsrc_t rs = staging_rsrc(F.ws);
        const int r = lane & 15, g = lane >> 4;
        const unsigned abase = (unsigned)RB_XN + (unsigned)(m0 + (r < n ? r : 0)) * (unsigned)(D * 2) + (unsigned)g * 16u;
        f32x4 acc = {0.f, 0.f, 0.f, 0.f};
#pragma unroll
        for (int h = 0; h < 2; ++h) { u32x4 a[16];
#pragma unroll
            for (int k = 0; k < 16; ++k) a[k] = ld16_wt(rs, abase + (unsigned)(h * 16 + k) * 64u);
#pragma unroll
            for (int k = 0; k < 16; ++k) acc = MFMA16(__builtin_bit_cast(bf16x8, a[k]), *(const LAS bf16x8*)(bawb + ((h * 16 + k) * 64 + lane) * 16), acc); }
        const int hh = r & 7; const float ea = -__expf(F.in[30][hh]), db = F.in[31][hh];
#pragma unroll
        for (int e = 0; e < 4; ++e) { const int row = 4 * g + e; if (row < n) F.BA()[(size_t)(m0 + row) * 16 + r] = r < 8 ? sigmoidf_(acc[e]) : ea * softplusf_(acc[e] + db); }
    }
}
__device__ __forceinline__ void phase_mid_rowwise(Frame& F) {
    PHASE_IDS();
    LAS unsigned char* bawb = F.lds;
    for (int idx = tid; idx < 32 * 64; idx += 512) { const int kk = idx >> 6, l = idx & 63, c = l & 15, g = l >> 4; const float* wp = F.in[28] + (size_t)(32 * kk + 8 * g) * OD_IN + OD_MAIN + c;
        u32x4 w; w[0] = cvt2(wp[0], wp[OD_IN]); w[1] = cvt2(wp[2 * OD_IN], wp[3 * OD_IN]); w[2] = cvt2(wp[4 * OD_IN], wp[5 * OD_IN]); w[3] = cvt2(wp[6 * OD_IN], wp[7 * OD_IN]);
        *(LAS u32x4*)(bawb + idx * 16) = w; }
    __syncthreads();
    const int gw = F.vcu * 8 + wave, NGW = F.G * 8;
    for (int w = gw; w < MP / 16; w += NGW) rows_mid(F, bawb, w * 16, 16, w >> 8, lane);
    for (int w = gw; w < MS; w += NGW) rows_mid(F, bawb, MP + w, 1, BP + (w >> 4), lane);
}


typedef float f32x16 __attribute__((ext_vector_type(16)));
constexpr int GS_WF = 0, GS_QF = 16384, GS_KF = 32768, GS_PF = 49152, GS_UF = 57344, GS_BYTES = 73728;
constexpr size_t WS_DEC = 11 * MiB;
__device__ __forceinline__ int krow(int s, int h, int j) { return 16 * s + 8 * (j >> 2) + 4 * h + (j & 3); }

__device__ __forceinline__ void st8_wt(unsigned char* p, u32x2 v) { __hip_atomic_store((unsigned long long*)p, ((unsigned long long)v[1] << 32) | v[0], __ATOMIC_RELAXED, __HIP_MEMORY_SCOPE_AGENT); }
constexpr size_t WS_READY = 65536;
#define LDS_BARRIER() do { asm volatile("s_waitcnt lgkmcnt(0)" ::: "memory"); __builtin_amdgcn_s_barrier(); asm volatile("" ::: "memory"); } while (0)
constexpr int G1_QS = 0, G1_KS = 17408, G1_VS = 34816, G1_AS = 52224, G1_PS = 69632, G1_WS = 78848, G1_CW = 96256, G1_VEC = 102400, G1_ES = 103424;
__device__ __forceinline__ void g1_load_raw(Frame& F, u32x4 (&raw)[24], int s, int c, int h, int t1) {
    const int r = t1 >> 3, j = t1 & 7, t = c * 64 + r;
#pragma unroll
    for (int p = 0; p < 3; ++p)
#pragma unroll
        for (int jj = 0; jj < 4; ++jj) { const int tt = t - 3 + jj, ttc = tt < 0 ? 0 : tt;
            const u32x4* src = (const u32x4*)(F.QKV1() + (size_t)(s * TP + ttc) * 3072 + p * 1024 + h * 128 + j * 16); raw[p * 8 + jj * 2] = src[0]; raw[p * 8 + jj * 2 + 1] = src[1]; }
}
__device__ __forceinline__ bf16x8 g1_pack_b(const f32x4 p, const f32x4 q) { u32x4 w; w[0] = cvt2(p[0], p[1]); w[1] = cvt2(p[2], p[3]); w[2] = cvt2(q[0], q[1]); w[3] = cvt2(q[2], q[3]); return __builtin_bit_cast(bf16x8, w); }
__device__ __forceinline__ void g1_decode(int n, int& s, int& c, int& h) { if (n < 4096) { c = n >> 6; s = (n & 63) >> 3; h = n & 7; } else { s = BP + ((n - 4096) >> 3); c = 0; h = n & 7; } }
constexpr int P2_SET = 52224, P2_Q = 0, P2_K = 17408, P2_V = 34816;
constexpr int P2_AS = 2 * P2_SET, P2_PS = P2_AS + 17408, P2_ES = P2_PS + 9216, P2_CW = P2_ES + 4096, P2_VEC = P2_CW + 6144;
static_assert(P2_VEC + 2048 <= LDS_BYTES - 64, "producer LDS map");
__device__ __forceinline__ void p2_load_part(Frame& F, u32x4 (&rw)[16], int s, int c, int h, int p, int tb) {
    const int r = tb >> 3, j = tb & 7;
#pragma unroll
    for (int it = 0; it < 2; ++it)
#pragma unroll
        for (int jj = 0; jj < 4; ++jj) { int tt = c * 64 + r + 32 * it - 3 + jj; tt = tt < 0 ? 0 : tt;
            const u32x4* src = (const u32x4*)(F.QKV1() + (size_t)(s * TP + tt) * 3072 + p * 1024 + h * 128 + j * 16); rw[it * 8 + jj * 2] = src[0]; rw[it * 8 + jj * 2 + 1] = src[1]; }
}
__device__ __forceinline__ void p2_conv_item(Frame& F, const u32x4 (&rw)[16], const int it, const f32x4 (&wreg)[16], const int p, const int j, const int lane, const bool ok, float* state_out, LAS u32x4* dst) {
    float acc[16];
#pragma unroll
    for (int e = 0; e < 16; ++e) acc[e] = 0.f;
#pragma unroll
    for (int jj = 0; jj < 4; ++jj) {
        const u32x4 a = rw[it * 8 + jj * 2], b = rw[it * 8 + jj * 2 + 1]; float x[16];
#pragma unroll
        for (int e = 0; e < 4; ++e) { x[2 * e] = lo16(a[e]); x[2 * e + 1] = hi16(a[e]); x[8 + 2 * e] = lo16(b[e]); x[8 + 2 * e + 1] = hi16(b[e]); }
#pragma unroll
        for (int q = 0; q < 4; ++q) { const f32x4 w4 = wreg[jj * 4 + q]; acc[4 * q] += w4[0] * x[4 * q]; acc[4 * q + 1] += w4[1] * x[4 * q + 1]; acc[4 * q + 2] += w4[2] * x[4 * q + 2]; acc[4 * q + 3] += w4[3] * x[4 * q + 3]; }
        if (jj == 3 && state_out) {
#pragma unroll
            for (int q = 0; q < 4; ++q) *(f32x4*)(state_out + 4 * q) = (f32x4){x[4 * q], x[4 * q + 1], x[4 * q + 2], x[4 * q + 3]}; }
    }
    float ss = 0.f;
#pragma unroll
    for (int e = 0; e < 16; ++e) { acc[e] = siluf_(acc[e]); ss += acc[e] * acc[e]; }
    if (p < 2) { ss += shfl_xor_l(ss, 1, lane); ss += shfl_xor_l(ss, 2, lane); ss += shfl_xor_l(ss, 4, lane);
        float sc = __builtin_amdgcn_rsqf(ss + EPS); if (p == 0) sc *= 0.08838834764831845f;
#pragma unroll
        for (int e = 0; e < 16; ++e) acc[e] *= sc; }
    u32x4 w0, w1;
#pragma unroll
    for (int e = 0; e < 4; ++e) { w0[e] = ok ? cvt2(acc[2 * e], acc[2 * e + 1]) : 0u; w1[e] = ok ? cvt2(acc[8 + 2 * e], acc[8 + 2 * e + 1]) : 0u; }
    dst[0] = w0; dst[1] = w1;
}
__device__ __forceinline__ void gdn_g1_tasks(Frame& F, const int first, const int stride) {
    LAS unsigned char* L = F.lds;
    LAS float* cw_s = (LAS float*)(L + P2_CW);
    float* DEC = (float*)(F.ws + WS_DEC);
    const brsrc_t srs = staging_rsrc(F.ws);
    unsigned* ready = (unsigned*)(F.ws + WS_READY);
    const int wave = F.wv;
    const bool grpB = wave >= 4;
    int ntask = 0; for (int t = first; t < 4224; t += stride) ++ntask;
    u32x4 rwA[16]; float pcw[6];
    if (grpB) {
        const int tb = opaque_tid(wave) - 256; int s0, c0, h0; g1_decode(first < 4095 ? first : 4095, s0, c0, h0);
        p2_load_part(F, rwA, s0, c0, h0, 0, tb);
#pragma unroll
        for (int q = 0; q < 6; ++q) { const int i = tb + 256 * q, jj = i / 384, cc = i % 384; pcw[q] = F.in[29][(size_t)jj * 3072 + (cc >> 7) * 1024 + h0 * 128 + (cc & 127)]; }
#pragma unroll
        for (int q = 0; q < 6; ++q) cw_s[tb + 256 * q] = pcw[q];
    }
    LDS_BARRIER();
    for (int i = 0; i <= ntask; ++i) {
        const int tid = opaque_tid(wave), lane = tid & 63;
        const int taskB = first + i * stride, taskA = taskB - stride;
        const bool actB = grpB && i < ntask, actA = !grpB && i >= 1;
        int s = 0, c = 0, h = 0; g1_decode(grpB ? (i < ntask ? taskB : 4095) : (i >= 1 ? taskA : 0), s, c, h);
        const int task = grpB ? taskB : taskA;
        const int sidx = task < 4096 ? ((s * 8 + h) * 64 + c) : task;
        const int nvalid = s < BP ? 64 : TS, t0 = c * 64, base = seq_base(s), T = seq_len(s);
        LAS unsigned char* Sb = L + (grpB ? (i & 1) : ((i - 1) & 1)) * P2_SET;
        LAS float* vec = (LAS float*)(L + P2_VEC + (grpB ? (i & 1) : ((i - 1) & 1)) * 1024); LAS float* beta_s = vec; LAS float* gcum_s = vec + 64; LAS float* eg_s = vec + 128; LAS float* ek_s = vec + 192;
        unsigned char* blk = F.ws + WS_RB + (size_t)sidx * GS_BYTES; const unsigned boff = (unsigned)sidx * (unsigned)GS_BYTES;
        float gvb = 0.f, gva = 0.f; int gs = 0, gc = 0, gh = 0; const bool gact = (wave == 3) && i < ntask;
        if (gact) { g1_decode(taskB, gs, gc, gh); if (lane < (gs < BP ? 64 : TS)) { const float* ba = F.BA() + (size_t)(seq_base(gs) + gc * 64 + lane) * 16; gvb = ba[gh]; gva = ba[8 + gh]; } }
        const int tb = tid - 256, rB = tb >> 3, jB = tb & 7;
#define P2_PART(p, rw) do { if (actB) { \
            if (s >= BP) { _Pragma("unroll") for (int it = 0; it < 2; ++it) _Pragma("unroll") for (int jj = 0; jj < 4; ++jj) { const int r_ = rB + 32 * it, tt = r_ - 3 + jj; u32x4 a_ = {0u, 0u, 0u, 0u}, b_ = {0u, 0u, 0u, 0u}; \
                    if (r_ < nvalid) { const int cb_ = (p) * 1024 + h * 128 + jB * 16; \
                        if (tt >= 0) { const u32x4* src = (const u32x4*)(F.QKV1() + (size_t)(base + tt) * 3072 + cb_); a_ = src[0]; b_ = src[1]; } \
                        else { const f32x4* src = (const f32x4*)(F.in[6] + ((size_t)(s - BP) * 3 + (tt + 3)) * 3072 + cb_); const f32x4 f0 = src[0], f1 = src[1], f2 = src[2], f3 = src[3]; \
                            a_[0] = cvt2(f0[0], f0[1]); a_[1] = cvt2(f0[2], f0[3]); a_[2] = cvt2(f1[0], f1[1]); a_[3] = cvt2(f1[2], f1[3]); b_[0] = cvt2(f2[0], f2[1]); b_[1] = cvt2(f2[2], f2[3]); b_[2] = cvt2(f3[0], f3[1]); b_[3] = cvt2(f3[2], f3[3]); } } \
                    rw[it * 8 + jj * 2] = a_; rw[it * 8 + jj * 2 + 1] = b_; } } \
            else if (t0 == 0 && rB < 3) { _Pragma("unroll") for (int jj = 0; jj < 3; ++jj) if (rB - 3 + jj < 0) { rw[jj * 2] = (u32x4){0u, 0u, 0u, 0u}; rw[jj * 2 + 1] = (u32x4){0u, 0u, 0u, 0u}; } } \
            f32x4 wreg_[16]; _Pragma("unroll") for (int jj = 0; jj < 4; ++jj) _Pragma("unroll") for (int q = 0; q < 4; ++q) wreg_[jj * 4 + q] = *(const LAS f32x4*)(cw_s + jj * 384 + (p) * 128 + jB * 16 + 4 * q);   \
            _Pragma("unroll") for (int it = 0; it < 2; ++it) { const int r_ = rB + 32 * it, t_ = t0 + r_; const bool ok_ = r_ < nvalid; \
                float* so_ = (ok_ && t_ >= T - 3) ? ((s < BP ? F.out + O_GCP + ((size_t)s * 3 + (t_ - (T - 3))) * 3072 : F.out + O_GCS + ((size_t)(s - BP) * 3 + (t_ - (T - 3))) * 3072) + (p) * 1024 + h * 128 + jB * 16) : nullptr; \
                p2_conv_item(F, rw, it, wreg_, (p), jB, lane, ok_, so_, (LAS u32x4*)(Sb + ((p) == 0 ? P2_Q : (p) == 1 ? P2_K : P2_V) + r_ * 272 + jB * 32)); } } } while (0)
        if (grpB) {
            P2_PART(0, rwA);
            if (actB && s < BP) p2_load_part(F, rwA, s, c, h, 1, tb);
        } else if (actA) {
            int l2 = lane; asm volatile("" : "+v"(l2));
            const int r = l2 & 31, hh = l2 >> 5;
#pragma unroll
            for (int half = 0; half < 2; ++half) {
                const int tile8 = wave + 4 * half, which = tile8 >> 2, ti = (tile8 >> 1) & 1, tj = tile8 & 1;
                f32x16 acc;
#pragma unroll
                for (int e = 0; e < 16; ++e) acc[e] = 0.f;
                if (!(ti == 0 && tj == 1)) {
                    const LAS unsigned char* ap = Sb + (which ? P2_Q : P2_K) + (32 * ti + r) * 272 + hh * 16;
                    const LAS unsigned char* bp = Sb + P2_K + (32 * tj + r) * 272 + hh * 16;
#pragma unroll
                    for (int ks = 0; ks < 8; ++ks) { const bf16x8 a = *(const LAS bf16x8*)(ap + ks * 32), b = *(const LAS bf16x8*)(bp + ks * 32); acc = MFMA32(a, b, acc); }
                }
                const int jc = 32 * tj + r; const float gj = gcum_s[jc];
#pragma unroll
                for (int e = 0; e < 16; ++e) {
                    const int ii = 32 * ti + (e & 3) + 8 * (e >> 2) + 4 * hh; const float dg = gcum_s[ii] - gj;
                    if (which == 0) { const float f = (ii > jc) ? __expf(dg) * beta_s[ii] : 0.f; *(LAS float*)(L + P2_AS + ii * 272 + jc * 4) = acc[e] * f; }
                    else { const float f = (ii >= jc) ? __expf(dg) : 0.f; *(LAS bf16_t*)(L + P2_PS + ii * 144 + jc * 2) = (bf16_t)(cvt2(acc[e] * f, 0.f) & 0xffffu); }
                }
            }
        }
        LDS_BARRIER();
        if (grpB) {
            P2_PART(1, rwA);
            if (actB && s < BP) p2_load_part(F, rwA, s, c, h, 2, tb);
        } else if (actA) {
            int l3 = lane; asm volatile("" : "+v"(l3));
            if (wave == 0) {
                const int bk = l3 >> 4, col = l3 & 15;
                float tcol[16];
#pragma unroll
                for (int rr = 0; rr < 16; ++rr) {
                    float a = (rr == col) ? 1.0f : 0.f;
#pragma unroll
                    for (int j4 = 0; j4 < (rr + 3) / 4; ++j4) { const f32x4 a4 = *(const LAS f32x4*)(L + P2_AS + (16 * bk + rr) * 272 + (16 * bk + 4 * j4) * 4);
#pragma unroll
                        for (int q = 0; q < 4; ++q) if (4 * j4 + q < rr) a -= a4[q] * tcol[4 * j4 + q]; }
                    tcol[rr] = a;
                    *(LAS float*)(L + P2_ES + ((bk * 16 + rr) * 16 + col) * 4) = a - ((rr == col) ? 1.0f : 0.f);
                }
            } else {
                const int r = l3 & 31, hh = l3 >> 5;
                if (wave == 1) {
#pragma unroll
                    for (int rt4 = 0; rt4 < 4; ++rt4)
#pragma unroll
                        for (int kt2 = 0; kt2 < 2; ++kt2)
#pragma unroll
                            for (int ss = 0; ss < 2; ++ss) { float v[8];
#pragma unroll
                                for (int j = 0; j < 8; ++j) { const int tok = 32 * kt2 + krow(ss, hh, j); v[j] = bf2f(*(const LAS bf16_t*)(Sb + P2_K + tok * 272 + (32 * rt4 + r) * 2)) * ek_s[tok]; }
                                u32x4 o; o[0] = cvt2(v[0], v[1]); o[1] = cvt2(v[2], v[3]); o[2] = cvt2(v[4], v[5]); o[3] = cvt2(v[6], v[7]);
                                st16_wt(srs, boff + GS_KF + ((rt4 * 2 + kt2) * 2 + ss) * 1024 + l3 * 16, o); }
                } else if (wave == 2) {
#pragma unroll
                    for (int kt = 0; kt < 4; ++kt)
#pragma unroll
                        for (int rt = 0; rt < 2; ++rt)
#pragma unroll
                            for (int ss = 0; ss < 2; ++ss) { const int ii = 32 * rt + r; const float sc = eg_s[ii];
                                const u32x2 lo = *(const LAS u32x2*)(Sb + P2_Q + ii * 272 + (32 * kt + 16 * ss + 4 * hh) * 2), hi = *(const LAS u32x2*)(Sb + P2_Q + ii * 272 + (32 * kt + 16 * ss + 8 + 4 * hh) * 2);
                                u32x4 o; o[0] = cvt2(lo16(lo[0]) * sc, hi16(lo[0]) * sc); o[1] = cvt2(lo16(lo[1]) * sc, hi16(lo[1]) * sc); o[2] = cvt2(lo16(hi[0]) * sc, hi16(hi[0]) * sc); o[3] = cvt2(lo16(hi[1]) * sc, hi16(hi[1]) * sc);
                                st16_wt(srs, boff + GS_QF + ((rt * 4 + kt) * 2 + ss) * 1024 + l3 * 16, o); }
                } else {
#pragma unroll
                    for (int rt = 0; rt < 2; ++rt)
#pragma unroll
                        for (int kt2 = 0; kt2 < 2; ++kt2)
#pragma unroll
                            for (int ss = 0; ss < 2; ++ss) { const int ii = 32 * rt + r;
                                const u32x2 lo = *(const LAS u32x2*)(L + P2_PS + ii * 144 + (32 * kt2 + 16 * ss + 4 * hh) * 2), hi = *(const LAS u32x2*)(L + P2_PS + ii * 144 + (32 * kt2 + 16 * ss + 8 + 4 * hh) * 2);
                                u32x4 o; o[0] = lo[0]; o[1] = lo[1]; o[2] = hi[0]; o[3] = hi[1];
                                st16_wt(srs, boff + GS_PF + ((rt * 2 + kt2) * 2 + ss) * 1024 + l3 * 16, o); }
                }
            }
        }
        LDS_BARRIER();
        if (grpB) {
            P2_PART(2, rwA);
        } else if (actA) {
            int l4 = lane; asm volatile("" : "+v"(l4));
            const int c16 = l4 & 15, g = l4 >> 4;
            const f32x4 z4 = {0.f, 0.f, 0.f, 0.f};
            f32x4 a10, a20, a21, a30, a31, a32, e0, e1, e2, e3;
            { const LAS unsigned char* ar = L + P2_AS + c16 * 272 + (4 * g) * 4;
              a10 = *(const LAS f32x4*)(ar + 16 * 272); a20 = *(const LAS f32x4*)(ar + 32 * 272); a21 = *(const LAS f32x4*)(ar + 32 * 272 + 64);
              a30 = *(const LAS f32x4*)(ar + 48 * 272); a31 = *(const LAS f32x4*)(ar + 48 * 272 + 64); a32 = *(const LAS f32x4*)(ar + 48 * 272 + 128);
              const LAS unsigned char* er = L + P2_ES + (c16 * 16 + 4 * g) * 4;
              e0 = *(const LAS f32x4*)er; e1 = *(const LAS f32x4*)(er + 1024); e2 = *(const LAS f32x4*)(er + 2048); e3 = *(const LAS f32x4*)(er + 3072); }
            const bf16x8 fA10 = g1_pack_b(z4 - a10, z4), fA2 = g1_pack_b(z4 - a20, z4 - a21), fA3a = g1_pack_b(z4 - a30, z4 - a31), fA3b = g1_pack_b(z4 - a32, z4);
            const bf16x8 fE0 = g1_pack_b(e0, z4), fE1 = g1_pack_b(e1, z4), fE2 = g1_pack_b(e2, z4), fE3 = g1_pack_b(e3, z4);
#pragma unroll
            for (int tl = 0; tl < 4; ++tl) {
                const int t16 = 4 * wave + tl; const bool isw = t16 < 8; const int d = 16 * (t16 & 7) + c16;
                f32x4 R[4];
#pragma unroll
                for (int ib = 0; ib < 4; ++ib)
#pragma unroll
                    for (int e = 0; e < 4; ++e) { const int row = 16 * ib + 4 * g + e; const float raw1 = bf2f(*(const LAS bf16_t*)(Sb + (isw ? P2_K : P2_V) + row * 272 + d * 2)); R[ib][e] = raw1 * beta_s[row] * (isw ? eg_s[row] : 1.0f); }
                const f32x4 X0 = MFMA16(fE0, g1_pack_b(R[0], z4), R[0]);
                const f32x4 Y1 = MFMA16(fA10, g1_pack_b(X0, z4), R[1]);
                const f32x4 X1 = MFMA16(fE1, g1_pack_b(Y1, z4), Y1);
                const f32x4 Y2 = MFMA16(fA2, g1_pack_b(X0, X1), R[2]);
                const f32x4 X2 = MFMA16(fE2, g1_pack_b(Y2, z4), Y2);
                f32x4 Y3 = MFMA16(fA3a, g1_pack_b(X0, X1), R[3]);
                Y3 = MFMA16(fA3b, g1_pack_b(X2, z4), Y3);
                const f32x4 X3 = MFMA16(fE3, g1_pack_b(Y3, z4), Y3);
                const f32x4 X[4] = {X0, X1, X2, X3};
                if (isw) {
#pragma unroll
                    for (int ib = 0; ib < 4; ++ib)
#pragma unroll
                        for (int e = 0; e < 4; ++e) *(LAS bf16_t*)(Sb + P2_Q + (16 * ib + 4 * g + e) * 272 + d * 2) = (bf16_t)(cvt2(-X[ib][e], 0.f) & 0xffffu);
                } else {
                    const int ws = d >> 5, cc = d & 31;
#pragma unroll
                    for (int ib = 0; ib < 4; ++ib) { const int rt = ib >> 1, q = 2 * (ib & 1) + (g >> 1), hh = g & 1;
                        u32x2 o; o[0] = cvt2(X[ib][0], X[ib][1]); o[1] = cvt2(X[ib][2], X[ib][3]);
                        st8_wt(blk + GS_UF + (size_t)(((ws * 2 + rt) * 64) + cc + 32 * hh) * 32 + q * 8, o); }
                }
            }
        }
        LDS_BARRIER();
        if (grpB) {
            { const int ntk = taskB + stride < 4224 ? taskB + stride : 4223; int s1, c1, h1; g1_decode(ntk, s1, c1, h1);
#pragma unroll
              for (int q = 0; q < 6; ++q) { const int ii = tb + 256 * q, jj = ii / 384, cc = ii % 384; pcw[q] = F.in[29][(size_t)jj * 3072 + (cc >> 7) * 1024 + h1 * 128 + (cc & 127)]; }
              const int ntp = ntk < 4095 ? ntk : 4095; int s2, c2, h2; g1_decode(ntp, s2, c2, h2);
              p2_load_part(F, rwA, s2, c2, h2, 0, tb);
#pragma unroll
              for (int q = 0; q < 6; ++q) cw_s[tb + 256 * q] = pcw[q]; }
        } else if (actA) {
            int l5 = lane; asm volatile("" : "+v"(l5));
            const int kt = wave, r = l5 & 31, hh = l5 >> 5;
#pragma unroll
            for (int rt = 0; rt < 2; ++rt)
#pragma unroll
                for (int ss = 0; ss < 2; ++ss) { const int ii = 32 * rt + r;
                    const u32x2 lo = *(const LAS u32x2*)(Sb + P2_Q + ii * 272 + (32 * kt + 16 * ss + 4 * hh) * 2), hi = *(const LAS u32x2*)(Sb + P2_Q + ii * 272 + (32 * kt + 16 * ss + 8 + 4 * hh) * 2);
                    u32x4 o; o[0] = lo[0]; o[1] = lo[1]; o[2] = hi[0]; o[3] = hi[1];
                    st16_wt(srs, boff + GS_WF + ((rt * 4 + kt) * 2 + ss) * 1024 + l5 * 16, o); }
            asm volatile("s_waitcnt vmcnt(0)" ::: "memory");
        }
        if (gact) {
            LAS float* gv = (LAS float*)(L + P2_VEC + (i & 1) * 1024);
            const bool ok = lane < (gs < BP ? 64 : TS); float x = ok ? gva : 0.f;
#pragma unroll
            for (int o = 1; o < 64; o <<= 1) { const float y = shfl_idx(x, lane >= o ? lane - o : lane); if (lane >= o) x += y; }
            const float gl = shfl_idx(x, 63);
            gv[lane] = ok ? gvb : 0.f; gv[64 + lane] = x; gv[128 + lane] = __expf(x); gv[192 + lane] = ok ? __expf(gl - x) : 0.f;
            const int gsidx = taskB < 4096 ? ((gs * 8 + gh) * 64 + gc) : taskB;
            if (lane == 0) __hip_atomic_store((unsigned*)DEC + gsidx, __float_as_uint(__expf(gl)), __ATOMIC_RELAXED, __HIP_MEMORY_SCOPE_AGENT);
        }
        LDS_BARRIER();
        if (tid == 0 && i >= 1) __hip_atomic_store(ready + 16 * sidx, 1u, __ATOMIC_RELAXED, __HIP_MEMORY_SCOPE_AGENT);
#undef P2_PART
    }
}

constexpr int G2_FB = GS_BYTES, G2_OSTRIDE = 528, G2_HN = 2 * G2_FB, G2_DEC = G2_HN + 512;
__device__ __forceinline__ bf16x8 pack8(const f32x16& x, const int s) {
    u32x4 p; p[0] = cvt2(x[8 * s], x[8 * s + 1]); p[1] = cvt2(x[8 * s + 2], x[8 * s + 3]); p[2] = cvt2(x[8 * s + 4], x[8 * s + 5]); p[3] = cvt2(x[8 * s + 6], x[8 * s + 7]);
    return __builtin_bit_cast(bf16x8, p);
}
template <bool WT>
__device__ __forceinline__ void g2_load_set(u32x4 (&pre)[18], float& dpre, const unsigned char* blk, int lt, brsrc_t srs, unsigned boff, const unsigned* flag, const float* decp) {
    if (WT) { unsigned sp = 0; while (__builtin_amdgcn_readfirstlane(__hip_atomic_load(flag, __ATOMIC_RELAXED, __HIP_MEMORY_SCOPE_AGENT)) == 0u && ++sp < (1u << 20)) __builtin_amdgcn_s_sleep(4);
        dpre = __uint_as_float(__hip_atomic_load((const unsigned*)decp, __ATOMIC_RELAXED, __HIP_MEMORY_SCOPE_AGENT));
#pragma unroll
        for (int i = 0; i < 18; ++i) pre[i] = ld16_wt(srs, boff + (unsigned)(i * 256 + lt) * 16u);
    } else { const u32x4* src = (const u32x4*)blk; dpre = *decp;
#pragma unroll
        for (int i = 0; i < 18; ++i) pre[i] = src[i * 256 + lt]; }
}
__device__ __forceinline__ void g2_store_set(const u32x4 (&pre)[18], LAS unsigned char* dst, int lt) {
#pragma unroll
    for (int i = 0; i < 18; ++i) *(LAS u32x4*)(dst + (size_t)(i * 256 + lt) * 16) = pre[i];
}
#define G2_FRAG(off) (*(const LAS bf16x8*)(B + (off)))
#define G2_SCHED() __builtin_amdgcn_sched_barrier(0)
__device__ __forceinline__ void g2_mfma_step(f32x16& S0, f32x16& S1, f32x16& S2, f32x16& S3, LAS unsigned char* Bimg, const float dec, int ws, int lane, int cc, int hh) {
    const LAS unsigned char* B = Bimg + lane * 16;
    f32x16 vn0, vn1, o0, o1;
    { const LAS u32x4* up = (const LAS u32x4*)(Bimg + GS_UF + (size_t)(ws * 2 * 64 + lane) * 32); const u32x4 u0 = up[0], u1 = up[1], u2 = up[128], u3 = up[129];
#pragma unroll
      for (int q = 0; q < 4; ++q) { vn0[2 * q] = lo16(u0[q]); vn0[2 * q + 1] = hi16(u0[q]); vn0[8 + 2 * q] = lo16(u1[q]); vn0[8 + 2 * q + 1] = hi16(u1[q]);
                                    vn1[2 * q] = lo16(u2[q]); vn1[2 * q + 1] = hi16(u2[q]); vn1[8 + 2 * q] = lo16(u3[q]); vn1[8 + 2 * q + 1] = hi16(u3[q]); } }
#pragma unroll
    for (int e = 0; e < 16; ++e) { o0[e] = 0.f; o1[e] = 0.f; }
#define G2_WQ(Sx, kt) do { _Pragma("unroll") for (int ss = 0; ss < 2; ++ss) { const bf16x8 sb = pack8(Sx, ss); \
        const bf16x8 fw0 = G2_FRAG(GS_WF + ((0 * 4 + kt) * 2 + ss) * 1024), fw1 = G2_FRAG(GS_WF + ((1 * 4 + kt) * 2 + ss) * 1024); \
        const bf16x8 fq0 = G2_FRAG(GS_QF + ((0 * 4 + kt) * 2 + ss) * 1024), fq1 = G2_FRAG(GS_QF + ((1 * 4 + kt) * 2 + ss) * 1024); \
        vn0 = MFMA32(fw0, sb, vn0); vn1 = MFMA32(fw1, sb, vn1); o0 = MFMA32(fq0, sb, o0); o1 = MFMA32(fq1, sb, o1); } } while (0)
    G2_WQ(S0, 0); G2_WQ(S1, 1); G2_WQ(S2, 2); G2_WQ(S3, 3);
#undef G2_WQ
    bf16x8 vb[2][2];
    vb[0][0] = pack8(vn0, 0); vb[0][1] = pack8(vn0, 1); vb[1][0] = pack8(vn1, 0); vb[1][1] = pack8(vn1, 1);
#pragma unroll
    for (int kt2 = 0; kt2 < 2; ++kt2)
#pragma unroll
        for (int ss = 0; ss < 2; ++ss) { o0 = MFMA32(G2_FRAG(GS_PF + ((0 * 2 + kt2) * 2 + ss) * 1024), vb[kt2][ss], o0); o1 = MFMA32(G2_FRAG(GS_PF + ((1 * 2 + kt2) * 2 + ss) * 1024), vb[kt2][ss], o1); }
    S0 = S0 * dec; S1 = S1 * dec; S2 = S2 * dec; S3 = S3 * dec;
#pragma unroll
    for (int kt2 = 0; kt2 < 2; ++kt2)
#pragma unroll
        for (int ss = 0; ss < 2; ++ss) {
            S0 = MFMA32(G2_FRAG(GS_KF + ((0 * 2 + kt2) * 2 + ss) * 1024), vb[kt2][ss], S0); S1 = MFMA32(G2_FRAG(GS_KF + ((1 * 2 + kt2) * 2 + ss) * 1024), vb[kt2][ss], S1);
            S2 = MFMA32(G2_FRAG(GS_KF + ((2 * 2 + kt2) * 2 + ss) * 1024), vb[kt2][ss], S2); S3 = MFMA32(G2_FRAG(GS_KF + ((3 * 2 + kt2) * 2 + ss) * 1024), vb[kt2][ss], S3); }
    LDS_BARRIER();
#pragma unroll
    for (int e = 0; e < 16; ++e) { const int rr = (e & 3) + 8 * (e >> 2) + 4 * hh;
        *(LAS float*)(Bimg + rr * G2_OSTRIDE + (32 * ws + cc) * 4) = o0[e]; *(LAS float*)(Bimg + (32 + rr) * G2_OSTRIDE + (32 * ws + cc) * 4) = o1[e]; }
    LDS_BARRIER();
}
__device__ __forceinline__ void g2_epi16(Frame& F, LAS unsigned char* L, const LAS unsigned char* Oimg, const u32x4 (&zz)[2], int row, int sub, size_t m, int h, bool rok, int lane) {
    f32x4 ov[4]; float ss = 0.f;
#pragma unroll
    for (int q = 0; q < 4; ++q) { ov[q] = *(const LAS f32x4*)(Oimg + row * G2_OSTRIDE + (sub * 16 + 4 * q) * 4); ss += (ov[q][0] * ov[q][0] + ov[q][1] * ov[q][1]) + (ov[q][2] * ov[q][2] + ov[q][3] * ov[q][3]); }
    ss += shfl_xor_l(ss, 1, lane); ss += shfl_xor_l(ss, 2, lane); ss += shfl_xor_l(ss, 4, lane);
    const float rn = __builtin_amdgcn_rsqf(ss * (1.f / 128.f) + EPS);
    if (rok) {
        const LAS float* hn_s = (const LAS float*)(L + G2_HN);
        u32x4* yp = (u32x4*)(F.Y1() + m * D + h * 128 + sub * 16);
#pragma unroll
        for (int q = 0; q < 2; ++q) {
            const f32x4 oa = ov[2 * q], ob = ov[2 * q + 1];
            const f32x4 ha = *(const LAS f32x4*)(hn_s + sub * 16 + 8 * q), hb = *(const LAS f32x4*)(hn_s + sub * 16 + 8 * q + 4);
            u32x4 yo;
            yo[0] = cvt2(oa[0] * rn * ha[0] * siluf_(lo16(zz[q][0])), oa[1] * rn * ha[1] * siluf_(hi16(zz[q][0])));
            yo[1] = cvt2(oa[2] * rn * ha[2] * siluf_(lo16(zz[q][1])), oa[3] * rn * ha[3] * siluf_(hi16(zz[q][1])));
            yo[2] = cvt2(ob[0] * rn * hb[0] * siluf_(lo16(zz[q][2])), ob[1] * rn * hb[1] * siluf_(hi16(zz[q][2])));
            yo[3] = cvt2(ob[2] * rn * hb[2] * siluf_(lo16(zz[q][3])), ob[3] * rn * hb[3] * siluf_(hi16(zz[q][3])));
            yp[q] = yo; }
    }
}
template <int NCH, bool WT>
__device__ __forceinline__ void g2_task(Frame& F, LAS unsigned char* L, const float* DEC, int s, int h, int ch0, int tid, int lane, int wave) {
    const size_t cstep = (size_t)GS_BYTES;
    const int base = seq_base(s), nvalid = s < BP ? 64 : TS;
    const unsigned char* blk0 = F.ws + WS_RB + (size_t)ch0 * GS_BYTES;
    constexpr int lastc = NCH - 1;
    if (wave < 4) {
        const int ws = wave, cc = lane & 31, hh = lane >> 5;
        f32x16 S0, S1, S2, S3;
        if (s < BP) {
#pragma unroll
            for (int e = 0; e < 16; ++e) { S0[e] = 0.f; S1[e] = 0.f; S2[e] = 0.f; S3[e] = 0.f; }
        } else {
            const float* sp = F.in[7] + ((size_t)(s - BP) * 8 + h) * 16384 + 32 * ws + cc;
#pragma unroll
            for (int e = 0; e < 16; ++e) { const int rr = (e & 3) + 8 * (e >> 2) + 4 * hh; S0[e] = sp[(size_t)rr * 128]; S1[e] = sp[(size_t)(32 + rr) * 128]; S2[e] = sp[(size_t)(64 + rr) * 128]; S3[e] = sp[(size_t)(96 + rr) * 128]; }
        }
        const LAS float* dec_s = (const LAS float*)(L + G2_DEC);
        const int erow = tid >> 3, esub = tid & 7; const bool erok = erow < nvalid;
        u32x4 zz[2];
#define G2_ZLOAD(cidx) do { const u32x4* zp = (const u32x4*)(F.Z1() + ((size_t)base + (cidx) * 64 + erow) * D + h * 128 + esub * 16); zz[0] = zp[0]; zz[1] = zp[1]; } while (0)
        LDS_BARRIER();
        if (NCH == 1) { if (erok) G2_ZLOAD(0); g2_mfma_step(S0, S1, S2, S3, L, dec_s[0], ws, lane, cc, hh); g2_epi16(F, L, L, zz, erow, esub, (size_t)base + erow, h, erok, lane); LDS_BARRIER(); }
        else for (int c = 0; c < NCH; c += 2) {
            G2_ZLOAD(c);
            g2_mfma_step(S0, S1, S2, S3, L, dec_s[c], ws, lane, cc, hh);
            g2_epi16(F, L, L, zz, erow, esub, (size_t)base + c * 64 + erow, h, erok, lane);
            LDS_BARRIER();
            G2_ZLOAD(c + 1);
            g2_mfma_step(S0, S1, S2, S3, L + G2_FB, dec_s[c + 1], ws, lane, cc, hh);
            g2_epi16(F, L, L + G2_FB, zz, erow, esub, (size_t)base + (c + 1) * 64 + erow, h, erok, lane);
            LDS_BARRIER();
        }
        int l9 = lane; asm volatile("" : "+v"(l9));
        const int cc9 = l9 & 31, hh9 = l9 >> 5;
        float* so = (s < BP ? F.out + O_GSP + ((size_t)s * 8 + h) * 16384 : F.out + O_GSS + ((size_t)(s - BP) * 8 + h) * 16384) + 32 * ws + cc9;
#pragma unroll
        for (int e = 0; e < 16; ++e) { const int rr = (e & 3) + 8 * (e >> 2) + 4 * hh9; so[(size_t)rr * 128] = S0[e]; so[(size_t)(32 + rr) * 128] = S1[e]; so[(size_t)(64 + rr) * 128] = S2[e]; so[(size_t)(96 + rr) * 128] = S3[e]; }
    } else {
        const int lt = tid - 256;
        if (lt < 128) ((LAS float*)(L + G2_HN))[lt] = F.in[32][lt];
        const brsrc_t srs = staging_rsrc(F.ws);
        const unsigned* ready = (const unsigned*)(F.ws + WS_READY);
        LAS float* dec_w = (LAS float*)(L + G2_DEC);
#define G2_LOAD(pre, dpre, k) do { const int _k = (k) < lastc ? (k) : lastc; g2_load_set<WT>(pre, dpre, blk0 + (size_t)_k * cstep, lt, srs, (unsigned)(ch0 + _k) * (unsigned)GS_BYTES, ready + 16 * (ch0 + _k), DEC + ch0 + _k); } while (0)
        u32x4 preA[18], preB[18]; float dA, dB;
        G2_LOAD(preA, dA, 0);
        G2_LOAD(preB, dB, 1);
        g2_store_set(preA, L, lt); if (lt == 0) dec_w[0] = dA;
        G2_LOAD(preA, dA, 2);
        const int erow = tid >> 3, esub = tid & 7; const bool erok = erow < nvalid;
        u32x4 zz[2];
#define G2_ZLOAD(cidx) do { const u32x4* zp = (const u32x4*)(F.Z1() + ((size_t)base + (cidx) * 64 + erow) * D + h * 128 + esub * 16); zz[0] = zp[0]; zz[1] = zp[1]; } while (0)
        LDS_BARRIER();
        if (NCH == 1) {
            if (erok) G2_ZLOAD(0);
            LDS_BARRIER();
            LDS_BARRIER();
            g2_epi16(F, L, L, zz, erow, esub, (size_t)base + erow, h, erok, lane);
            LDS_BARRIER();
        } else {
            for (int c = 0; c < NCH; c += 2) {
                {
                    g2_store_set(preB, L + G2_FB, lt); if (lt == 0) dec_w[(c + 1) & 63] = dB;
                    G2_ZLOAD(c);
                    G2_LOAD(preB, dB, c + 3);
                    LDS_BARRIER();
                    LDS_BARRIER();
                    g2_epi16(F, L, L, zz, erow, esub, (size_t)base + c * 64 + erow, h, erok, lane);
                    LDS_BARRIER();
                }
                {
                    g2_store_set(preA, L, lt); if (lt == 0) dec_w[(c + 2) & 63] = dA;
                    G2_ZLOAD(c + 1);
                    G2_LOAD(preA, dA, c + 4);
                    LDS_BARRIER();
                    LDS_BARRIER();
                    g2_epi16(F, L, L + G2_FB, zz, erow, esub, (size_t)base + (c + 1) * 64 + erow, h, erok, lane);
                    LDS_BARRIER();
                }
            }
        }
    }
}
#undef G2_ZLOAD
#undef G2_LOAD
constexpr int G12_CHAINS = 64;
__device__ __forceinline__ void phase_gdn_fused(Frame& F) {
    LAS unsigned char* L = F.lds;
    const float* DEC = (const float*)(F.ws + WS_DEC);
    if ((int)blockIdx.x < G12_CHAINS && F.G > G12_CHAINS) {
        const int tid = opaque_tid(F.wv);
        const int ci = blockIdx.x;
        g2_task<64, true>(F, L, DEC, ci >> 3, ci & 7, ci * 64, tid, tid & 63, F.wv);
    } else {
        const bool all = !(F.G > G12_CHAINS);
        const int p = all ? (int)blockIdx.x : (int)blockIdx.x - G12_CHAINS, np = all ? F.G : F.G - G12_CHAINS;
        gdn_g1_tasks(F, p, np);
        for (int t = p; t < 128; t += np) {
            const int tid = opaque_tid(F.wv);
            __syncthreads();
            g2_task<1, true>(F, L, DEC, BP + (t >> 3), t & 7, 4096 + t, tid, tid & 63, F.wv);
        }
    }
}

__device__ __forceinline__ float dpp_shr_f(float idv, float x, const int o) {
    int r;
    switch (o) {
        case 1: r = __builtin_amdgcn_update_dpp(__float_as_int(idv), __float_as_int(x), 0x111, 0xf, 0xf, false); break;
        case 2: r = __builtin_amdgcn_update_dpp(__float_as_int(idv), __float_as_int(x), 0x112, 0xf, 0xf, false); break;
        case 4: r = __builtin_amdgcn_update_dpp(__float_as_int(idv), __float_as_int(x), 0x114, 0xf, 0xf, false); break;
        default: r = __builtin_amdgcn_update_dpp(__float_as_int(idv), __float_as_int(x), 0x118, 0xf, 0xf, false); break;
    }
    return __int_as_float(r);
}
__device__ __forceinline__ float dpp_shr0_f(float x, const int o) {
    int r;
    switch (o) {
        case 1: r = __builtin_amdgcn_update_dpp(0, __float_as_int(x), 0x111, 0xf, 0xf, true); break;
        case 2: r = __builtin_amdgcn_update_dpp(0, __float_as_int(x), 0x112, 0xf, 0xf, true); break;
        case 4: r = __builtin_amdgcn_update_dpp(0, __float_as_int(x), 0x114, 0xf, 0xf, true); break;
        default: r = __builtin_amdgcn_update_dpp(0, __float_as_int(x), 0x118, 0xf, 0xf, true); break;
    }
    return __int_as_float(r);
}
__device__ __forceinline__ void phase_lru(Frame& F) {
    int tid = opaque_tid(F.wv);
    const int lane = tid & 63, wave = __builtin_amdgcn_readfirstlane(tid >> 6);
    const int gw = F.vcu * 8 + wave, NGW = F.G * 8, h = gw & 7, g = lane >> 4, l15 = lane & 15;
    LAS unsigned char* xs = F.lds + wave * 9216;
    LAS float* cst = (LAS float*)(F.lds + 73728 + wave * 768);
    const bf16_t* LGW = (const bf16_t*)(F.ws + WS_LGW);
    float* LAG = F.LAG();
    bf16x8 wfa[4][2], wfx[4][2];
#pragma unroll
    for (int nt = 0; nt < 4; ++nt)
#pragma unroll
        for (int ks = 0; ks < 2; ++ks) {
            wfa[nt][ks] = *(const bf16x8*)(LGW + ((size_t)(h * 2 + 0) * 64 + 16 * nt + l15) * 64 + 32 * ks + 8 * g);
            wfx[nt][ks] = *(const bf16x8*)(LGW + ((size_t)(h * 2 + 1) * 64 + 16 * nt + l15) * 64 + 32 * ks + 8 * g); }
    cst[lane] = F.in[18][h * 64 + lane]; cst[64 + lane] = F.in[20][h * 64 + lane]; cst[128 + lane] = softplusf_(-F.in[21][h * 64 + lane]);
    for (int task = gw; task < 4224; task += NGW) {
        int s, c; if (task < 4096) { s = task >> 9; c = (task >> 3) & 63; } else { s = BP + ((task - 4096) >> 3); c = 0; }
        const int T = seq_len(s), base = seq_base(s), t0 = c * 64, ntile = s < BP ? 4 : 1;
        {
            int l1 = lane; asm volatile("" : "+v"(l1));
            const int cg = l1 & 7, tp = l1 >> 3;
#pragma unroll 1
            for (int hf2 = 0; hf2 < 2; ++hf2) {
                const int chb = h * 64 + cg * 8 + hf2 * 4;
                float xr[11][4];
                if (s < BP) {
                    u32x2 w[11];
#pragma unroll
                    for (int i = 0; i < 11; ++i) { int tt = t0 + tp * 8 - 3 + i; tt = tt < 0 ? 0 : tt; w[i] = *(const u32x2*)(F.U0() + (size_t)(base + tt) * EV_IN + C_XA + chb); }
                    if (t0 == 0 && tp == 0) { w[0] = (u32x2){0u, 0u}; w[1] = (u32x2){0u, 0u}; w[2] = (u32x2){0u, 0u}; }
#pragma unroll
                    for (int i = 0; i < 11; ++i) { xr[i][0] = lo16(w[i][0]); xr[i][1] = hi16(w[i][0]); xr[i][2] = lo16(w[i][1]); xr[i][3] = hi16(w[i][1]); }
                } else {
#pragma unroll
                    for (int i = 0; i < 11; ++i) {
                        const int tt = t0 + tp * 8 - 3 + i;
                        if (tt >= 0 && tt < T) { const u32x2 w = *(const u32x2*)(F.U0() + (size_t)(base + tt) * EV_IN + C_XA + chb);
                            xr[i][0] = lo16(w[0]); xr[i][1] = hi16(w[0]); xr[i][2] = lo16(w[1]); xr[i][3] = hi16(w[1]); }
                        else if (tt < 0) { const f32x4 a = *(const f32x4*)(F.in[2] + ((size_t)(s - BP) * 3 + (tt + 3)) * 512 + chb); xr[i][0] = a[0]; xr[i][1] = a[1]; xr[i][2] = a[2]; xr[i][3] = a[3]; }
                        else { xr[i][0] = 0.f; xr[i][1] = 0.f; xr[i][2] = 0.f; xr[i][3] = 0.f; }
                    }
                }
                const f32x4 c0 = *(const f32x4*)(F.in[15] + chb), c1 = *(const f32x4*)(F.in[15] + 512 + chb), c2 = *(const f32x4*)(F.in[15] + 1024 + chb), c3 = *(const f32x4*)(F.in[15] + 1536 + chb), cb = *(const f32x4*)(F.in[16] + chb);
#pragma unroll
                for (int i = 0; i < 8; ++i) { float o[4];
#pragma unroll
                    for (int e = 0; e < 4; ++e) o[e] = c0[e] * xr[i][e] + c1[e] * xr[i + 1][e] + c2[e] * xr[i + 2][e] + c3[e] * xr[i + 3][e] + cb[e];
                    u32x2 w; w[0] = cvt2(o[0], o[1]); w[1] = cvt2(o[2], o[3]);
                    *(LAS u32x2*)(xs + (tp * 8 + i) * 144 + cg * 16 + hf2 * 8) = w; }
                if (t0 + 64 >= T && tp == ((T - 1) >> 3) - (t0 >> 3)) {
                    float* o = (s < BP ? F.out + O_LCP + (size_t)s * 3 * 512 : F.out + O_LCS + (size_t)(s - BP) * 3 * 512) + chb;
#pragma unroll
                    for (int q = 0; q < 3; ++q) *(f32x4*)(o + q * 512) = (f32x4){xr[8 + q][0], xr[8 + q][1], xr[8 + q][2], xr[8 + q][3]};
                }
            }
        }
        float hin[4][4], arun[4][4];
#pragma unroll
        for (int nt = 0; nt < 4; ++nt)
#pragma unroll
            for (int rg = 0; rg < 4; ++rg) { hin[nt][rg] = 0.f; arun[nt][rg] = 1.f; }
        asm volatile("s_waitcnt lgkmcnt(0)" ::: "memory");
        for (int tt = 0; tt < ntile; ++tt) {
            const int tok = 16 * tt + l15;
            const bf16x8 b0 = *(const LAS bf16x8*)(xs + tok * 144 + (8 * g) * 2), b1 = *(const LAS bf16x8*)(xs + tok * 144 + (32 + 8 * g) * 2);
            const size_t m = (size_t)base + t0 + tok;
#pragma unroll
            for (int nt = 0; nt < 4; ++nt) {
                f32x4 za = {0.f, 0.f, 0.f, 0.f}, zx = {0.f, 0.f, 0.f, 0.f};
                za = MFMA16(wfa[nt][0], b0, za); za = MFMA16(wfa[nt][1], b1, za);
                zx = MFMA16(wfx[nt][0], b0, zx); zx = MFMA16(wfx[nt][1], b1, zx);
                const int n0 = 16 * nt + 4 * g;
                const u32x2 xw = *(const LAS u32x2*)(xs + tok * 144 + n0 * 2);
                const float xc[4] = {lo16(xw[0]), hi16(xw[0]), lo16(xw[1]), hi16(xw[1])};
                const f32x4 cba = *(const LAS f32x4*)(cst + n0), cbx = *(const LAS f32x4*)(cst + 64 + n0), csp = *(const LAS f32x4*)(cst + 128 + n0);
                float av[4], bv[4];
#pragma unroll
                for (int rg = 0; rg < 4; ++rg) {
                    const float r = sigmoidf_(za[rg] + cba[rg]), ig = sigmoidf_(zx[rg] + cbx[rg]), la = -8.0f * r * csp[rg], a = __expf(la);
                    av[rg] = a; bv[rg] = __builtin_amdgcn_sqrtf(fmaxf(1.0f - a * a, 0.f)) * (ig * xc[rg]); }
#pragma unroll
                for (int o = 1; o < 16; o <<= 1)
#pragma unroll
                    for (int rg = 0; rg < 4; ++rg) { const float ap = dpp_shr_f(1.0f, av[rg], o), bp = dpp_shr0_f(bv[rg], o); bv[rg] = av[rg] * bp + bv[rg]; av[rg] = av[rg] * ap; }
                float hv[4];
#pragma unroll
                for (int rg = 0; rg < 4; ++rg) { hv[rg] = bv[rg] + av[rg] * hin[nt][rg]; hin[nt][rg] = shfl_idx(hv[rg], (lane & 48) | 15); }
                {
                    u32x2 hw, pw; hw[0] = cvt2(hv[0], hv[1]); hw[1] = cvt2(hv[2], hv[3]);
                    pw[0] = cvt2(av[0] * arun[nt][0], av[1] * arun[nt][1]); pw[1] = cvt2(av[2] * arun[nt][2], av[3] * arun[nt][3]);
                    *(u32x4*)(F.YO() + m * D + h * 128 + 2 * n0) = (u32x4){hw[0], hw[1], pw[0], pw[1]};
#pragma unroll
                    for (int rg = 0; rg < 4; ++rg) arun[nt][rg] *= shfl_idx(av[rg], (lane & 48) | 15);
                }
                if (nt & 1) __builtin_amdgcn_sched_barrier(0);
            }
        }
        if (s < BP && l15 == 15) {
            f32x2* lp = (f32x2*)LAG + (size_t)(s * 64 + c) * 512 + h * 64;
#pragma unroll
            for (int nt = 0; nt < 4; ++nt)
#pragma unroll
                for (int rg = 0; rg < 4; ++rg) lp[16 * nt + 4 * g + rg] = (f32x2){arun[nt][rg], hin[nt][rg]};
        }
        asm volatile("s_waitcnt lgkmcnt(0)" ::: "memory");
    }
}

#define LRA_LOAD(c_) do { _Pragma("unroll") for (int it = 0; it < 8; ++it) { const size_t m = (size_t)base + (c_) * 64 + 8 * (it < nit ? it : nit - 1) + tq; \
    hl[it] = *(const u32x4*)(F.YO() + m * D + h * 128 + 16 * cg); pp[it] = *(const u32x4*)(F.YO() + m * D + h * 128 + 16 * cg + 8); gg[it] = *(const u32x4*)(F.U0() + m * EV_IN + C_GA + h * 64 + 8 * cg); } } while (0)
__device__ __forceinline__ void lru_apply_chunk(Frame& F, const u32x4 (&hl)[8], const u32x4 (&pp)[8], const u32x4 (&gg)[8], const float hf, const int s, const int base, const int t0, const int T, const int nit, const int h, const int lane) {
    const int cg = lane & 7, tq = lane >> 3;
    float cr[8];
#pragma unroll
    for (int e = 0; e < 8; ++e) cr[e] = shfl_idx(hf, 8 * cg + e);
#pragma unroll
    for (int it = 0; it < 8; ++it) if (it < nit) {
        const int t = t0 + 8 * it + tq; const size_t m = (size_t)base + t;
        float hv[8]; u32x4 yo;
#pragma unroll
        for (int e = 0; e < 4; ++e) { const unsigned hw = e < 2 ? hl[it][e] : pp[it][e - 2], pw = e < 2 ? hl[it][e + 2] : pp[it][e];
            hv[2 * e] = lo16(hw) + lo16(pw) * cr[2 * e]; hv[2 * e + 1] = hi16(hw) + hi16(pw) * cr[2 * e + 1];
            yo[e] = cvt2(hv[2 * e] * siluf_(lo16(gg[it][e])), hv[2 * e + 1] * siluf_(hi16(gg[it][e]))); }
        *(u32x4*)(F.Y0() + m * D + h * 64 + 8 * cg) = yo;
        if (t == T - 1) { float* o = (s < BP ? F.out + O_LHP + s * 512 : F.out + O_LHS + (s - BP) * 512) + h * 64 + 8 * cg;
            *(f32x4*)o = (f32x4){hv[0], hv[1], hv[2], hv[3]}; *(f32x4*)(o + 4) = (f32x4){hv[4], hv[5], hv[6], hv[7]}; }
    }
}
__device__ __forceinline__ void phase_lru_apply(Frame& F) {
    PHASE_IDS();
    const int gw = F.vcu * 8 + wave, NGW = F.G * 8, cg = lane & 7, tq = lane >> 3;
    for (int w = gw; w < 2048; w += NGW) {
        const int s = w >> 8, c0 = 2 * ((w >> 3) & 31), h = w & 7, base = s * TP, nit = 8;
        u32x4 hl[8], pp[8], gg[8];
        LRA_LOAD(c0);
        const f32x2* lp = (const f32x2*)F.LAG() + (size_t)(s * 64) * 512 + h * 64 + lane;
        const f32x2 own = lp[(size_t)c0 * 512];
        float hf = 0.f;
        for (int j0 = 0; j0 < c0; j0 += 32) { f32x2 v[32];
#pragma unroll
            for (int q = 0; q < 32; ++q) { const int jj = j0 + q < c0 ? j0 + q : c0 - 1; v[q] = lp[(size_t)jj * 512]; }
#pragma unroll
            for (int q = 0; q < 32; ++q) if (j0 + q < c0) hf = v[q][0] * hf + v[q][1]; }
        lru_apply_chunk(F, hl, pp, gg, hf, s, base, c0 * 64, TP, 8, h, lane);
        hf = own[0] * hf + own[1];
        LRA_LOAD(c0 + 1);
        lru_apply_chunk(F, hl, pp, gg, hf, s, base, (c0 + 1) * 64, TP, 8, h, lane);
    }
    for (int w = gw; w < 128; w += NGW) {
        const int s = BP + (w >> 3), h = w & 7, base = seq_base(s), nit = 2;
        u32x4 hl[8], pp[8], gg[8];
        LRA_LOAD(0);
        const float hf = F.in[3][(s - BP) * 512 + h * 64 + lane];
        lru_apply_chunk(F, hl, pp, gg, hf, s, base, 0, TS, 2, h, lane);
    }
}

constexpr size_t RB_VTP = RB_WEND, RB_VTS = RB_VTP + (size_t)BP * 2 * 64 * TP * 2, RB_VTEND = RB_VTS + (size_t)BS * 2 * 64 * 192 * 2;
static_assert(RB_VTEND <= RB_BYTES, "ws map");
__device__ __forceinline__ void phase_vt_build(Frame& F) {
    PHASE_IDS();
    const int gw = F.vcu * 8 + wave, NGW = F.G * 8;
    LAS unsigned char* xs = F.lds + wave * 9216;
    bf16_t* VTP = (bf16_t*)(F.ws + WS_RB + RB_VTP); bf16_t* VTS = (bf16_t*)(F.ws + WS_RB + RB_VTS);
    for (int task = gw; task < 1024 + 96; task += NGW) {
        int s, kv, kb; if (task < 1024) { s = task >> 7; kv = (task >> 6) & 1; kb = task & 63; } else { const int r = task - 1024; s = BP + r / 6; kv = (r % 6) / 3; kb = r % 3; }
        const int row8 = lane >> 3, ch = lane & 7;
#pragma unroll
        for (int i = 0; i < 8; ++i) {
            const int key = 8 * i + row8, kg = kb * 64 + key; u32x4 w = {0u, 0u, 0u, 0u};
            if (s < BP) w = *(const u32x4*)(F.U0() + (size_t)(s * TP + kg) * EV_IN + C_V + kv * 64 + ch * 8);
            else if (kg < 128) { const f32x4* p = (const f32x4*)(F.in[5] + ((size_t)((s - BP) * 128 + kg) * 2 + kv) * 64 + ch * 8); const f32x4 a = p[0], b = p[1]; w[0] = cvt2(a[0], a[1]); w[1] = cvt2(a[2], a[3]); w[2] = cvt2(b[0], b[1]); w[3] = cvt2(b[2], b[3]); }
            else if (kg < 128 + TS) w = *(const u32x4*)(F.U0() + (size_t)(MP + (s - BP) * TS + (kg - 128)) * EV_IN + C_V + kv * 64 + ch * 8);
            *(LAS u32x4*)(xs + key * 144 + ch * 16) = w;
        }
        asm volatile("s_waitcnt lgkmcnt(0)" ::: "memory");
        bf16_t* dst = s < BP ? VTP + ((size_t)(s * 2 + kv) * 64 + lane) * TP + kb * 64 : VTS + ((size_t)((s - BP) * 2 + kv) * 64 + lane) * 192 + kb * 64;
#pragma unroll
        for (int q = 0; q < 8; ++q) { u32x4 o;
#pragma unroll
            for (int e = 0; e < 4; ++e) { const unsigned lo = *(const LAS bf16_t*)(xs + (8 * q + 2 * e) * 144 + lane * 2), hi = *(const LAS bf16_t*)(xs + (8 * q + 2 * e + 1) * 144 + lane * 2); o[e] = lo | (hi << 16); }
            *(u32x4*)(dst + 8 * q) = o; }
        asm volatile("s_waitcnt lgkmcnt(0)" ::: "memory");
    }
}
constexpr int AT_K = 0, AT_V = 27648;
__device__ __forceinline__ void attn_issue(Frame& F, const bf16_t* VTP, int task, int tid, int wave, int lane, u32x4 (&kreg)[3], u32x4 (&vreg)[3], u32x4 (&qreg)[4]) {
    const int s = task >> 7, c = (task >> 1) & 63, kv = task & 1, tok0 = c * 64 - 128;
#pragma unroll
    for (int i = 0; i < 3; ++i) { const int idx = tid + 512 * i, key = idx >> 3, ch = idx & 7; int tk = tok0 + key; tk = tk < 0 ? 0 : tk;
        kreg[i] = *(const u32x4*)(F.U0() + (size_t)(s * TP + tk) * EV_IN + C_K + kv * 64 + ch * 8); }
#pragma unroll
    for (int i = 0; i < 3; ++i) { const int idx = tid + 512 * i, d = idx / 24, ch = idx % 24; int tk = tok0 + ch * 8; tk = tk < 0 ? 0 : tk;
        vreg[i] = *(const u32x4*)(VTP + ((size_t)(s * 2 + kv) * 64 + d) * TP + tk); }
    const int g = wave >> 1, qh = wave & 1, hq = kv * 4 + g, r = lane & 31, hh = lane >> 5;
    const size_t m = (size_t)s * TP + c * 64 + qh * 32 + r;
#pragma unroll
    for (int ks = 0; ks < 4; ++ks) qreg[ks] = *(const u32x4*)(F.U0() + m * EV_IN + C_Q + hq * 64 + 16 * ks + 8 * hh);
}
__device__ __forceinline__ void phase_attn(Frame& F) {
    PHASE_IDS();
    LAS unsigned char* L = F.lds;
    const bf16_t* VTP = (const bf16_t*)(F.ws + WS_RB + RB_VTP); const bf16_t* VTS = (const bf16_t*)(F.ws + WS_RB + RB_VTS);
    u32x4 kreg[3], vreg[3], qreg[4];
    attn_issue(F, VTP, F.vcu < 1024 ? F.vcu : 0, tid, wave, lane, kreg, vreg, qreg);
    for (int ti = F.vcu; ti < 1024 + 64; ti += F.G) {
        if (ti >= 1024 && ti < 1056) continue;
        const int task = ti < 1024 ? ti : ti - 32;
        int s, c, kv; if (task < 1024) { s = task >> 7; c = (task >> 1) & 63; kv = task & 1; } else { s = BP + ((task - 1024) >> 1); c = 0; kv = task & 1; }
        const int base = seq_base(s), tok0 = c * 64 - 128;
        const int kmin = s < BP ? (tok0 < 0 ? -tok0 : 0) : 0, kmax = s < BP ? 192 : 128 + TS;
        const int tid = opaque_tid(F.wv), lane = tid & 63;
        const int g = wave >> 1, qh = wave & 1, hq = kv * 4 + g, r = lane & 31, hh = lane >> 5, qi = qh * 32 + r;
        const bool qok = s < BP ? true : qi < TS;
        const size_t m = (size_t)base + c * 64 + (qok ? qi : 0);
        bf16x8 qf[4]; u32x2 gbr[8];
        LDS_BARRIER();
        if (s < BP) {
#pragma unroll
            for (int i = 0; i < 3; ++i) { const int idx = tid + 512 * i, key = idx >> 3, ch = idx & 7; const u32x4 z = {0u, 0u, 0u, 0u}; *(LAS u32x4*)(L + AT_K + key * 144 + ch * 16) = key >= kmin ? kreg[i] : z; }
#pragma unroll
            for (int i = 0; i < 3; ++i) { const int idx = tid + 512 * i, d = idx / 24, ch = idx % 24; const u32x4 z = {0u, 0u, 0u, 0u}; *(LAS u32x4*)(L + AT_V + d * 400 + ch * 16) = ch * 8 >= kmin ? vreg[i] : z; }
#pragma unroll
            for (int ks = 0; ks < 4; ++ks) { u32x4 w;
#pragma unroll
                for (int e = 0; e < 4; ++e) w[e] = cvt2(lo16(qreg[ks][e]) * 0.125f, hi16(qreg[ks][e]) * 0.125f);
                qf[ks] = __builtin_bit_cast(bf16x8, w); }
        } else {
#pragma unroll
            for (int i = 0; i < 3; ++i) {
                const int idx = tid + 512 * i, key = idx >> 3, ch = idx & 7; u32x4 w = {0u, 0u, 0u, 0u};
                if (key < kmax) {
                    if (key < 128) { const f32x4* p = (const f32x4*)(F.in[4] + ((size_t)((s - BP) * 128 + key) * 2 + kv) * 64 + ch * 8); const f32x4 a = p[0], b2 = p[1]; w[0] = cvt2(a[0], a[1]); w[1] = cvt2(a[2], a[3]); w[2] = cvt2(b2[0], b2[1]); w[3] = cvt2(b2[2], b2[3]); }
                    else w = *(const u32x4*)(F.U0() + (size_t)(base + key - 128) * EV_IN + C_K + kv * 64 + ch * 8);
                }
                *(LAS u32x4*)(L + AT_K + key * 144 + ch * 16) = w;
            }
#pragma unroll
            for (int i = 0; i < 3; ++i) {
                const int idx = tid + 512 * i, d = idx / 24, ch = idx % 24, key = ch * 8;
                *(LAS u32x4*)(L + AT_V + d * 400 + ch * 16) = *(const u32x4*)(VTS + ((size_t)((s - BP) * 2 + kv) * 64 + d) * 192 + key);
            }
#pragma unroll
            for (int ks = 0; ks < 4; ++ks) { u32x4 w = {0u, 0u, 0u, 0u};
                if (qok) { const u32x4 x = *(const u32x4*)(F.U0() + m * EV_IN + C_Q + hq * 64 + 16 * ks + 8 * hh);
#pragma unroll
                    for (int e = 0; e < 4; ++e) w[e] = cvt2(lo16(x[e]) * 0.125f, hi16(x[e]) * 0.125f); }
                qf[ks] = __builtin_bit_cast(bf16x8, w); }
        }
#pragma unroll
        for (int qq = 0; qq < 4; ++qq) { gbr[2 * qq] = qok ? *(const u32x2*)(F.U0() + m * EV_IN + C_GB + hq * 64 + 8 * qq + 4 * hh) : (u32x2){0u, 0u}; gbr[2 * qq + 1] = qok ? *(const u32x2*)(F.U0() + m * EV_IN + C_GB + hq * 64 + 32 + 8 * qq + 4 * hh) : (u32x2){0u, 0u}; }
        { const int nt = ti + F.G < 1024 ? ti + F.G : (ti < 1024 ? ti : 0); int t9 = tid; asm volatile("" : "+v"(t9)); attn_issue(F, VTP, nt, t9, wave, t9 & 63, kreg, vreg, qreg); }
        const float sink = F.in[22][hq];
        LDS_BARRIER();
        float mrun = sink, lrun = 1.0f;
        f32x16 o0, o1;
#pragma unroll
        for (int e = 0; e < 16; ++e) { o0[e] = 0.f; o1[e] = 0.f; }
#pragma unroll 1
        for (int half = 0; half < 2; ++half) {
            f32x16 sc[3];
#pragma unroll
            for (int k3 = 0; k3 < 3; ++k3) {
                const int kt = 3 * half + k3;
#pragma unroll
                for (int e = 0; e < 16; ++e) sc[k3][e] = 0.f;
#pragma unroll
                for (int ks = 0; ks < 4; ++ks) { const bf16x8 kf = *(const LAS bf16x8*)(L + AT_K + (32 * kt + r) * 144 + (16 * ks + 8 * hh) * 2); sc[k3] = MFMA32(kf, qf[ks], sc[k3]); }
            }
            float mx = -1e30f;
#pragma unroll
            for (int k3 = 0; k3 < 3; ++k3)
#pragma unroll
                for (int e = 0; e < 16; ++e) { const int kidx = 32 * (3 * half + k3) + (e & 3) + 8 * (e >> 2) + 4 * hh; const bool ok = kidx >= kmin && kidx < kmax; sc[k3][e] = ok ? sc[k3][e] : -1e30f; mx = fmaxf(mx, sc[k3][e]); }
            mx = fmaxf(mx, shfl_xor_l(mx, 32, lane));
            const float mnew = fmaxf(mrun, mx), alpha = __expf(mrun - mnew);
            float psum = 0.f;
#pragma unroll
            for (int k3 = 0; k3 < 3; ++k3)
#pragma unroll
                for (int e = 0; e < 16; ++e) { const float p = __expf(sc[k3][e] - mnew); sc[k3][e] = p; psum += p; }
            psum += shfl_xor_l(psum, 32, lane);
            lrun = lrun * alpha + psum; mrun = mnew;
            o0 = o0 * alpha; o1 = o1 * alpha;
#pragma unroll
            for (int k3 = 0; k3 < 3; ++k3)
#pragma unroll
                for (int ss = 0; ss < 2; ++ss) {
                    const int kt = 3 * half + k3;
                    const bf16x8 pb = pack8(sc[k3], ss);
                    const LAS unsigned char* vp = L + AT_V + r * 400 + (32 * kt + 16 * ss + 4 * hh) * 2;
                    const u32x2 a0 = *(const LAS u32x2*)vp, a1 = *(const LAS u32x2*)(vp + 16), b0 = *(const LAS u32x2*)(vp + 32 * 400), b1 = *(const LAS u32x2*)(vp + 32 * 400 + 16);
                    const u32x4 va = {a0[0], a0[1], a1[0], a1[1]}, vb = {b0[0], b0[1], b1[0], b1[1]};
                    o0 = MFMA32(__builtin_bit_cast(bf16x8, va), pb, o0); o1 = MFMA32(__builtin_bit_cast(bf16x8, vb), pb, o1);
                }
        }
        const float il = __builtin_amdgcn_rcpf(lrun);
        if (qok) {
#pragma unroll
            for (int qq = 0; qq < 4; ++qq) {
                { const int d = 8 * qq + 4 * hh; const u32x2 gb = gbr[2 * qq];
                  u32x2 yo; yo[0] = cvt2(o0[4 * qq] * il * siluf_(lo16(gb[0])), o0[4 * qq + 1] * il * siluf_(hi16(gb[0]))); yo[1] = cvt2(o0[4 * qq + 2] * il * siluf_(lo16(gb[1])), o0[4 * qq + 3] * il * siluf_(hi16(gb[1])));
                  *(u32x2*)(F.Y0() + m * D + 512 + hq * 64 + d) = yo; }
                { const int d = 32 + 8 * qq + 4 * hh; const u32x2 gb = gbr[2 * qq + 1];
                  u32x2 yo; yo[0] = cvt2(o1[4 * qq] * il * siluf_(lo16(gb[0])), o1[4 * qq + 1] * il * siluf_(hi16(gb[0]))); yo[1] = cvt2(o1[4 * qq + 2] * il * siluf_(lo16(gb[1])), o1[4 * qq + 3] * il * siluf_(hi16(gb[1])));
                  *(u32x2*)(F.Y0() + m * D + 512 + hq * 64 + d) = yo; }
            }
        }
    }
    __syncthreads();
}

constexpr int SG_A = 0, SG_B = 36864, SG_BUF = 36864 + 9216;
struct SOut { bf16_t* O0; int ld0; int split; bf16_t* O1; int ld1; };
__device__ __forceinline__ void sgemm_strip(Frame& F, const bf16_t* A, const bf16_t* Bt, const int K, const int n0, const SOut o, const int tid, const int lane, const int wave) {
    LAS unsigned char* L = F.lds;
    const int nkt = K / 64;
    const bf16_t* ap = A + (size_t)(tid >> 3) * K + (tid & 7) * 8;
    const bf16_t* bp = Bt + (size_t)(n0 + (tid >> 3)) * K + (tid & 7) * 8;
    const int lofs = (tid >> 3) * 144 + (tid & 7) * 16;
    u32x4 ra[4], rb, sa[4], sb;
#define SG_LOAD(RA, RB, kt) do { _Pragma("unroll") for (int i = 0; i < 4; ++i) RA[i] = *(const u32x4*)(ap + (size_t)i * 64 * K + (kt) * 64); RB = *(const u32x4*)(bp + (kt) * 64); } while (0)
#define SG_STORE(RA, RB, buf) do { _Pragma("unroll") for (int i = 0; i < 4; ++i) *(LAS u32x4*)(L + (buf) * SG_BUF + SG_A + lofs + i * 64 * 144) = RA[i]; *(LAS u32x4*)(L + (buf) * SG_BUF + SG_B + lofs) = RB; } while (0)
    SG_LOAD(ra, rb, 0); SG_LOAD(sa, sb, 1);
    SG_STORE(ra, rb, 0);
    SG_LOAD(ra, rb, (2 < nkt ? 2 : nkt - 1));
    f32x16 acc0, acc1;
#pragma unroll
    for (int e = 0; e < 16; ++e) { acc0[e] = 0.f; acc1[e] = 0.f; }
    const int r = lane & 31, hh = lane >> 5;
    LDS_BARRIER();
    for (int kt = 0; kt < nkt; kt += 2) {
#define SG_STEP(buf, RA, RB, knext) do { \
        const LAS unsigned char* Ab = L + (buf) * SG_BUF + SG_A + (32 * wave + r) * 144 + hh * 16; const LAS unsigned char* Bb = L + (buf) * SG_BUF + SG_B + r * 144 + hh * 16; \
        _Pragma("unroll") for (int ks = 0; ks < 4; ++ks) { const bf16x8 af = *(const LAS bf16x8*)(Ab + ks * 32), b0 = *(const LAS bf16x8*)(Bb + ks * 32), b1 = *(const LAS bf16x8*)(Bb + 32 * 144 + ks * 32); \
            acc0 = MFMA32(b0, af, acc0); acc1 = MFMA32(b1, af, acc1); } \
        SG_STORE(RA, RB, (buf) ^ 1); { const int kn = (knext) < nkt ? (knext) : nkt - 1; SG_LOAD(RA, RB, kn); } \
        LDS_BARRIER(); } while (0)
        SG_STEP(0, sa, sb, kt + 3);
        SG_STEP(1, ra, rb, kt + 4);
    }
#undef SG_STEP
#undef SG_LOAD
#undef SG_STORE
    const int row = 32 * wave + r; int colt = n0; bf16_t* base = o.O0; int ld = o.ld0;
    if (colt >= o.split) { base = o.O1; ld = o.ld1; colt -= o.split; }
    bf16_t* rowp = base + (size_t)row * ld + colt;
#pragma unroll
    for (int q = 0; q < 4; ++q) {
        u32x2 w0, w1; w0[0] = cvt2(acc0[4 * q], acc0[4 * q + 1]); w0[1] = cvt2(acc0[4 * q + 2], acc0[4 * q + 3]); w1[0] = cvt2(acc1[4 * q], acc1[4 * q + 1]); w1[1] = cvt2(acc1[4 * q + 2], acc1[4 * q + 3]);
        *(u32x2*)(rowp + 8 * q + 4 * hh) = w0; *(u32x2*)(rowp + 32 + 8 * q + 4 * hh) = w1; }
    LDS_BARRIER();
}
__device__ __forceinline__ void sgemm_phase(Frame& F, const bf16_t* A, const bf16_t* Bt, const int N, const int K, const SOut o, const int from) {
    const int nstrip = N / 64;
    for (int st = ((int)blockIdx.x - from + F.G) % F.G; st < nstrip; st += F.G) {
        const int tid = opaque_tid(F.wv);
        sgemm_strip(F, A, Bt, K, st * 64, o, tid, tid & 63, F.wv);
    }
}

__device__ __forceinline__ void rows_final(Frame& F, const int m0, const int n, const int s, const int lane) {
    const float* MODP = (const float*)(F.ws + WS_MODP);
    f32x4 A1[4];
#pragma unroll
    for (int j = 0; j < 4; ++j) { const int c = 4 * lane + 256 * j; const f32x4 g = *(const f32x4*)(F.in[27] + c), gt = mod4(MODP, 1, s, 2048 + c);
#pragma unroll
        for (int e = 0; e < 4; ++e) A1[j][e] = gt[e] * g[e]; }
    u32x2 ycur[4], xcur[4];
#pragma unroll
    for (int j = 0; j < 4; ++j) { ycur[j] = *(const u32x2*)(F.YO() + (size_t)m0 * D + 4 * lane + 256 * j); xcur[j] = *(const u32x2*)((const bf16_t*)(F.out + O_Y + (size_t)m0 * D) + 4 * lane + 256 * j); }
    for (int i = 0; i < n; ++i) {
        const int m = m0 + i, mn = m0 + (i + 1 < n ? i + 1 : i); u32x2 ynxt[4], xnxt[4];
#pragma unroll
        for (int j = 0; j < 4; ++j) { ynxt[j] = *(const u32x2*)(F.YO() + (size_t)mn * D + 4 * lane + 256 * j); xnxt[j] = *(const u32x2*)((const bf16_t*)(F.out + O_Y + (size_t)mn * D) + 4 * lane + 256 * j); }
        f32x4 y[4]; float ss = 0.f;
#pragma unroll
        for (int j = 0; j < 4; ++j) { y[j] = (f32x4){lo16(ycur[j][0]), hi16(ycur[j][0]), lo16(ycur[j][1]), hi16(ycur[j][1])}; ss += (y[j][0] * y[j][0] + y[j][1] * y[j][1]) + (y[j][2] * y[j][2] + y[j][3] * y[j][3]); }
        const float r1 = rsqrtf(wave_sum(ss, lane) * (1.f / D) + EPS);
#pragma unroll
        for (int j = 0; j < 4; ++j) { f32x4 o;
#pragma unroll
            for (int e = 0; e < 4; ++e) o[e] = ((e & 1) ? hi16(xcur[j][e >> 1]) : lo16(xcur[j][e >> 1])) + A1[j][e] * (y[j][e] * r1);
            *(f32x4*)(F.out + O_Y + (size_t)m * D + 4 * lane + 256 * j) = o; }
#pragma unroll
        for (int j = 0; j < 4; ++j) { ycur[j] = ynxt[j]; xcur[j] = xnxt[j]; }
    }
}
__device__ __forceinline__ void phase_final_rowwise(Frame& F) {
    PHASE_IDS();
    const int gw = F.vcu * 8 + wave, NGW = F.G * 8;
    for (int w = gw; w < MP / 16; w += NGW) rows_final(F, w * 16, 16, w >> 8, lane);
    for (int w = gw; w < MS; w += NGW) rows_final(F, MP + w, 1, BP + (w >> 4), lane);
}

__global__ void __launch_bounds__(512, 2) fwd_megakernel(Params P) {
    extern __shared__ __attribute__((aligned(16))) unsigned char lds_raw[];
    Frame F;
    F.lds = (LAS unsigned char*)lds_raw;
    F.wv = __builtin_amdgcn_readfirstlane(threadIdx.x >> 6);
    F.G = gridDim.x; { const int bx = blockIdx.x; F.vcu = (F.G % 8 == 0) ? (bx % 8) * (F.G / 8) + bx / 8 : bx; }
    F.in = P.in; F.out = P.out; F.ws = P.ws;

    volatile LAS unsigned* misc = (volatile LAS unsigned*)(F.lds + LDS_BYTES - 64);
    if (threadIdx.x < 16) misc[threadIdx.x] = 0u;
    __syncthreads();
    XcdBarrier xbar = xcd_barrier_post((unsigned*)(P.ws + WS_CTL), misc);
#define GRID_BAR() xcd_barrier(xbar, F.wv)
    phase_mod0(F);
    GRID_BAR();
    phase_prologue(F);
    phase_mod1(F);
    phase_prenorm0(F);
    GRID_BAR();
    { pg8::Gemm g{F.XN(), F.W0I(), MP, EV_IN, D}; pg8::StaticOrder S; S.init(MP, EV_IN, F.G, (int)blockIdx.x);
      pg8::EpiBf16 E{F.U0(), EV_IN, 1 << 30, F.U0(), EV_IN}; pg8::gemm_phase(F.lds, g, S, E, F.wv);
      sgemm_phase(F, F.XN() + (size_t)MP * D, F.W0I(), EV_IN, D, SOut{F.U0() + (size_t)MP * EV_IN, EV_IN, 1 << 30, nullptr, 0}, 128); }
    GRID_BAR();
    phase_rope(F);
    phase_lru(F);
    phase_vt_build(F);
    GRID_BAR();
    phase_lru_apply(F);
    phase_attn(F);
    GRID_BAR();
    { pg8::Gemm g{F.Y0(), F.W0O(), MP, D, D}; pg8::StaticOrder S; S.init(MP, D, F.G, (int)blockIdx.x);
      pg8::EpiBf16 E{F.YO(), D, 1 << 30, F.YO(), D}; pg8::gemm_phase(F.lds, g, S, E, F.wv);
      sgemm_phase(F, F.Y0() + (size_t)MP * D, F.W0O(), D, D, SOut{F.YO() + (size_t)MP * D, D, 1 << 30, nullptr, 0}, 0); }
    GRID_BAR();
    phase_mid_rowwise(F);
    GRID_BAR();
    { pg8::Gemm g{F.XN(), F.W1I(), MP, OD_MAIN, D}; pg8::StaticOrder S; S.init(MP, OD_MAIN, F.G, (int)blockIdx.x);
      pg8::EpiBf16 E{F.QKV1(), 3072, 3072, F.Z1(), D}; pg8::gemm_phase(F.lds, g, S, E, F.wv);
      sgemm_phase(F, F.XN() + (size_t)MP * D, F.W1I(), OD_MAIN, D, SOut{F.QKV1() + (size_t)MP * 3072, 3072, 3072, F.Z1() + (size_t)MP * D, D}, 0); }
    GRID_BAR();
    phase_gdn_fused(F);
    GRID_BAR();
    { pg8::Gemm g{F.Y1(), F.W1O(), MP, D, D}; pg8::StaticOrder S; S.init(MP, D, F.G, (int)blockIdx.x);
      pg8::EpiBf16 E{F.YO(), D, 1 << 30, F.YO(), D}; pg8::gemm_phase(F.lds, g, S, E, F.wv);
      sgemm_phase(F, F.Y1() + (size_t)MP * D, F.W1O(), D, D, SOut{F.YO() + (size_t)MP * D, D, 1 << 30, nullptr, 0}, 0); }
    GRID_BAR();
    phase_final_rowwise(F);
}

extern "C" void kernel_launch(void* const* d_in, const int* in_sizes, int n_in, void* d_out, int out_size, void* d_ws, size_t ws_size, hipStream_t stream) {
    static int grid = 0;
    if (grid == 0) {
        if (n_in != 34 || out_size != (int)O_END || ws_size < WS_END) { grid = -1; return; }
        int dev = 0, cus = 0, per_cu = 0;
        if (hipGetDevice(&dev) != hipSuccess || hipDeviceGetAttribute(&cus, hipDeviceAttributeMultiprocessorCount, dev) != hipSuccess) { grid = -1; return; }
        if (hipFuncSetAttribute((const void*)fwd_megakernel, hipFuncAttributeMaxDynamicSharedMemorySize, LDS_BYTES) != hipSuccess) { grid = -1; return; }
        if (hipOccupancyMaxActiveBlocksPerMultiprocessor(&per_cu, (const void*)fwd_megakernel, 512, LDS_BYTES) != hipSuccess || per_cu < 1) { grid = -1; return; }
        grid = cus;
    }
    if (grid < 0) return;
    if (hipMemsetAsync((char*)d_ws + WS_CTL, 0, 65536 + 4224 * 64, stream) != hipSuccess) return;
    Params p{};
    for (int i = 0; i < 34; ++i) p.in[i] = (const float*)d_in[i];
    p.out = (float*)d_out; p.ws = (unsigned char*)d_ws;
    void* args[] = {&p};
    (void)hipLaunchCooperativeKernel((const void*)fwd_megakernel, dim3(grid), dim3(512), args, LDS_BYTES, stream);
}
```

```cpp
#include <hip/hip_runtime.h>
#include <hip/hip_cooperative_groups.h>
namespace cg = cooperative_groups;

#define LAS __attribute__((address_space(3)))
typedef unsigned short bf16_t;
typedef short bf16x8 __attribute__((ext_vector_type(8)));
typedef float f32x4 __attribute__((ext_vector_type(4)));
typedef float f32x2 __attribute__((ext_vector_type(2)));
typedef unsigned u32x4 __attribute__((ext_vector_type(4)));
typedef unsigned u32x2 __attribute__((ext_vector_type(2)));

constexpr int D = 1024, BP = 8, TP = 4096, BS = 16, TS = 16;
constexpr int MP = BP * TP, MS = BS * TS, MT = MP + MS;
constexpr int NSEQ = BP + BS;
constexpr int EV_IN = 2304, OD_IN = 4112, OD_MAIN = 4096;
constexpr int C_XA = 0, C_GA = 512, C_Q = 1024, C_K = 1536, C_V = 1664, C_GB = 1792;
constexpr float EPS = 1e-6f;
constexpr size_t O_Y = 0, O_LCP = 33816576, O_LCS = 33828864, O_LHP = 33853440, O_LHS = 33857536, O_KP = 33865728, O_KS = 33996800,
                 O_VP = 34029568, O_VS = 34160640, O_GCP = 34193408, O_GCS = 34267136, O_GSP = 34414592, O_GSS = 35463168, O_END = 37560320;
constexpr size_t MiB = 1u << 20;
constexpr size_t WS_CTL = 0, WS_W1O = 1 * MiB, WS_MOD = 3 * MiB, WS_ROPE = 4 * MiB, WS_BA = 5 * MiB, WS_LAG = 8 * MiB, WS_LGW = 10 * MiB;
constexpr size_t WS_RA = 16 * MiB, RA_BYTES = (size_t)MT * 4096 * 2;
constexpr size_t WS_RB = WS_RA + RA_BYTES;
constexpr size_t ACT_BYTES = (size_t)MT * D * 2;
constexpr size_t RB_XN = 0, RB_Y0 = ACT_BYTES, RB_YO = 2 * ACT_BYTES, RB_W0I = 3 * ACT_BYTES, RB_W0O = RB_W0I + (size_t)EV_IN * D * 2,
                 RB_W1I = RB_W0O + (size_t)D * D * 2, RB_WEND = RB_W1I + (size_t)OD_MAIN * D * 2;
constexpr size_t RB_BYTES = (size_t)4224 * 73728;
constexpr size_t WS_END = WS_RB + RB_BYTES;
static_assert(RB_WEND <= RB_BYTES, "ws map");
static_assert((size_t)MT * 3072 * 2 <= RB_BYTES, "ws map");
constexpr int LDS_BYTES = 155648;

struct Params { const float* in[34]; float* out; unsigned char* ws; };

__device__ __forceinline__ float bf2f(bf16_t b) { return __uint_as_float(((unsigned)b) << 16); }
__device__ __forceinline__ unsigned f2bf(float f) { unsigned u = __float_as_uint(f); return (u + 0x7fffu + ((u >> 16) & 1u)) >> 16; }
__device__ __forceinline__ unsigned pk2(float lo, float hi) { return f2bf(lo) | (f2bf(hi) << 16); }
typedef __bf16 bf16x2_t __attribute__((ext_vector_type(2)));
__device__ __forceinline__ unsigned cvt2(float a, float b) { f32x2 v = {a, b}; bf16x2_t r = __builtin_convertvector(v, bf16x2_t); return __builtin_bit_cast(unsigned, r); }
__device__ __forceinline__ float lo16(unsigned w) { return __uint_as_float(w << 16); }
__device__ __forceinline__ float hi16(unsigned w) { return __uint_as_float(w & 0xffff0000u); }
__device__ __forceinline__ float shfl_idx(float x, int src_lane) { return __int_as_float(__builtin_amdgcn_ds_bpermute(src_lane << 2, __float_as_int(x))); }
__device__ __forceinline__ float shfl_xor_l(float x, int o, int lane) { return shfl_idx(x, lane ^ o); }
__device__ __forceinline__ float wave_sum_b(float v, int lane) {
#pragma unroll
    for (int o = 1; o < 64; o <<= 1) v += shfl_xor_l(v, o, lane);
    return v;
}
#define DPP_ADD(v, ctrl, rmask) v += __int_as_float(__builtin_amdgcn_update_dpp(0, __float_as_int(v), (ctrl), (rmask), 0xf, false))
__device__ __forceinline__ float wave_sum(float v, int lane) {
    (void)lane;
    DPP_ADD(v, 0xB1, 0xf); DPP_ADD(v, 0x4E, 0xf); DPP_ADD(v, 0x141, 0xf); DPP_ADD(v, 0x140, 0xf);
    DPP_ADD(v, 0x142, 0xa); DPP_ADD(v, 0x143, 0xc);
    float r = __int_as_float(__builtin_amdgcn_readlane(__float_as_int(v), 63)); asm volatile("" : "+v"(r)); return r;
}
__device__ __forceinline__ float sigmoidf_(float x) { return __builtin_amdgcn_rcpf(1.0f + __expf(-x)); }
__device__ __forceinline__ float siluf_(float x) { return x * __builtin_amdgcn_rcpf(1.0f + __expf(-x)); }
__device__ __forceinline__ float softplusf_(float x) { return x > 20.f ? x : log1pf(__expf(x)); }
__device__ __forceinline__ int seq_base(int s) { return s < BP ? s * TP : MP + (s - BP) * TS; }
__device__ __forceinline__ int seq_len(int s) { return s < BP ? TP : TS; }
__device__ __forceinline__ void tok_info(int m, int& s, int& t) { if (m < MP) { s = m >> 12; t = m & 4095; } else { const int r = m - MP; s = BP + (r >> 4); t = r & 15; } }

__device__ __forceinline__ int opaque_tid(int wv) { unsigned z = 0u; asm volatile("" : "+v"(z)); const int l = __builtin_amdgcn_mbcnt_hi(~0u, __builtin_amdgcn_mbcnt_lo(~0u, z)); return wv * 64 + l; }
namespace pg8 {
constexpr int BM = 256, BK = 64, HALF = 128, HTB = HALF * BK * 2, STAGE_BYTES = 8 * HTB, NXCD = 8, WGM = 8;
__host__ __device__ __forceinline__ int lds_byte(int r, int c) { const int st = (r >> 4) * 2 + (c >> 5), rr = r & 15, cc = c & 31, ob = rr * 64 + cc * 2; return st * 1024 + (ob ^ (((ob >> 9) & 1) << 5)); }
__host__ __device__ __forceinline__ void stage_rc(int b, int& R, int& C) { const int st = b / 1024, sb = b % 1024, swz = sb ^ (((sb >> 9) & 1) << 5); R = (st >> 1) * 16 + swz / 64; C = (st & 1) * 32 + (swz % 64) / 2; }
__host__ __device__ __forceinline__ int perm32(int rho) { const int n = rho >> 4, i = rho & 15; return 8 * (i >> 2) + 4 * n + (i & 3); }
struct Unit { int pm, pn; };
struct Gemm { const bf16_t* A; const bf16_t* Bt; int M, N, K; };
struct StaticOrder {
    int nM, nN, nwg, G, c;
    __device__ void init(int M, int N, int G_, int c_) { nM = M / BM; nN = N / BM; nwg = nM * nN; G = G_; c = c_; }
    __device__ bool next(int i, Unit& u) const {
        const long L = (long)i * G + c; if (L >= nwg) return false;
        int wgid = (int)L; { const int q = nwg / NXCD, r = nwg % NXCD, xcd = wgid % NXCD, off = wgid / NXCD; wgid = (xcd < r ? xcd * (q + 1) : r * (q + 1) + (xcd - r) * q) + off; }
        const int nig = WGM * nN, gid = wgid / nig, fm = gid * WGM, gsz = (nM - fm) < WGM ? (nM - fm) : WGM;
        u.pm = fm + ((wgid % nig) % gsz); u.pn = (wgid % nig) / gsz; return true;
    }
};
__device__ __forceinline__ unsigned cvt_pk_bf16(float lo, float hi) { unsigned r; asm volatile("v_cvt_pk_bf16_f32 %0, %1, %2" : "=v"(r) : "v"(lo), "v"(hi)); return r; }
struct EpiBf16 {
    static constexpr bool PERM = true;
    bf16_t* O0; int ld0; int split; bf16_t* O1; int ld1;
    __device__ __forceinline__ void operator()(const f32x4 (&acc)[2][2][4][2], const Unit& u, int wr, int wc, int fr, int fq) const {
        const int row0 = u.pm * BM + wr * 64 + fr; int colt = u.pn * BM; bf16_t* base = O0; int ld = ld0;
        if (colt >= split) { base = O1; ld = ld1; colt -= split; }
        const int col0 = colt + wc * 32 + 8 * fq;
#pragma unroll
        for (int ai = 0; ai < 2; ++ai)
#pragma unroll
            for (int m = 0; m < 4; ++m) { bf16_t* rowp = base + (size_t)(row0 + ai * HALF + m * 16) * ld + col0;
#pragma unroll
                for (int bj = 0; bj < 2; ++bj) { const f32x4 v0 = acc[ai][bj][m][0], v1 = acc[ai][bj][m][1];
                    u32x4 w; w.x = cvt_pk_bf16(v0[0], v0[1]); w.y = cvt_pk_bf16(v0[2], v0[3]); w.z = cvt_pk_bf16(v1[0], v1[1]); w.w = cvt_pk_bf16(v1[2], v1[3]);
                    *(u32x4*)(rowp + bj * HALF) = w; } }
    }
};
template <class Epi, class Sched>
__device__ __forceinline__ void gemm_phase(LAS unsigned char* lds, const Gemm g, const Sched& S, const Epi& E, const int wv0) {
    int tid = opaque_tid(wv0);
    const int wid = __builtin_amdgcn_readfirstlane(tid >> 6), lane = tid & 63, wr = wid >> 2, wc = wid & 3, fr = lane & 15, fq = lane >> 4;
    const int K = g.K, nt = K / BK;
    unsigned voffA[2], voffB[2];
#pragma unroll
    for (int i = 0; i < 2; ++i) { int R, C; stage_rc(tid * 16 + i * 8192, R, C); const int Rb = Epi::PERM ? ((R & ~31) + perm32(R & 31)) : R;
        voffA[i] = (unsigned)(R * K + C) * 2u; voffB[i] = (unsigned)(Rb * K + C) * 2u; }
    const size_t kstep = (size_t)(BK * 2);
    const size_t hstep = (size_t)HALF * K * 2;
    const size_t tstep = 2 * hstep;
    const unsigned ldsw = (unsigned)wid * 1024u;
    const int aoff = lds_byte(wr * 64 + fr, fq * 8), boff = lds_byte(wc * 32 + fr, fq * 8);
#define PG8_SA(b, h) (((b) * 2 + (h)) * HTB)
#define PG8_SB(b, h) ((4 + (b) * 2 + (h)) * HTB)
#define PG8_STAGE(bufoff, gbase, voff) do { _Pragma("unroll") for (int _i = 0; _i < 2; ++_i) \
        __builtin_amdgcn_global_load_lds((const unsigned*)((const char*)(gbase) + (voff)[_i]), (LAS unsigned*)(lds + (bufoff) + ldsw + _i * 8192), 16, 0, 0); } while (0)
#define PG8_LDA(dst, b, h) do { _Pragma("unroll") for (int m = 0; m < 4; ++m) _Pragma("unroll") for (int k = 0; k < 2; ++k) dst[m][k] = *(const LAS bf16x8*)(lds + PG8_SA(b, h) + aoff + m * 2048 + k * 1024); } while (0)
#define PG8_LDB(dst, b, h) do { _Pragma("unroll") for (int n = 0; n < 2; ++n) _Pragma("unroll") for (int k = 0; k < 2; ++k) dst[n][k] = *(const LAS bf16x8*)(lds + PG8_SB(b, h) + boff + n * 2048 + k * 1024); } while (0)
#define PG8_MMA(ai, bj, At, Bt) do { __builtin_amdgcn_s_setprio(1); _Pragma("unroll") for (int m = 0; m < 4; ++m) _Pragma("unroll") for (int n = 0; n < 2; ++n) _Pragma("unroll") for (int k = 0; k < 2; ++k) \
        acc[ai][bj][m][n] = __builtin_amdgcn_mfma_f32_16x16x32_bf16(Bt[n][k], At[m][k], acc[ai][bj][m][n], 0, 0, 0); __builtin_amdgcn_s_setprio(0); } while (0)
#define PG8_WAIT_V(n) asm volatile("s_waitcnt vmcnt(" #n ")" ::: "memory")
#define PG8_WAIT_L(n) asm volatile("s_waitcnt lgkmcnt(" #n ")" ::: "memory")
#define PG8_BAR __builtin_amdgcn_s_barrier()
#define PG8_SCHED __builtin_amdgcn_sched_barrier(0)
    Unit cur, nxt; int ui = 0;
    if (!S.next(0, cur)) return;
    f32x4 acc[2][2][4][2];
#pragma unroll
    for (int a = 0; a < 2; ++a)
#pragma unroll
        for (int b = 0; b < 2; ++b)
#pragma unroll
            for (int m = 0; m < 4; ++m)
#pragma unroll
                for (int n = 0; n < 2; ++n) acc[a][b][m][n] = (f32x4){0.f, 0.f, 0.f, 0.f};
    bf16x8 At[4][2], B0[2][2], B1[2][2];
    const char* cA = (const char*)g.A + (size_t)cur.pm * tstep; const char* cB = (const char*)g.Bt + (size_t)cur.pn * tstep;
    PG8_STAGE(PG8_SB(0, 0), cB, voffB); PG8_STAGE(PG8_SA(0, 0), cA, voffA); PG8_STAGE(PG8_SB(0, 1), cB + hstep, voffB); PG8_STAGE(PG8_SA(0, 1), cA + hstep, voffA);
    if (wr == 1) PG8_BAR;
    PG8_WAIT_V(4); PG8_BAR;
    PG8_STAGE(PG8_SB(1, 0), cB + kstep, voffB); PG8_STAGE(PG8_SA(1, 0), cA + kstep, voffA); PG8_STAGE(PG8_SB(1, 1), cB + hstep + kstep, voffB);
    PG8_WAIT_V(6); PG8_BAR;
    for (;;) {
        const bool has_next = S.next(ui + 1, nxt);
        const char* nA = has_next ? (const char*)g.A + (size_t)nxt.pm * tstep : cA; const char* nB = has_next ? (const char*)g.Bt + (size_t)nxt.pn * tstep : cB;
        for (int t = 0; t < nt; t += 2) {
            const bool last = (t == nt - 2);
            const char* a1 = cA + (size_t)(t + 1) * kstep;
            const char* a2 = last ? nA : cA + (size_t)(t + 2) * kstep; const char* b2 = last ? nB : cB + (size_t)(t + 2) * kstep;
            const char* a3 = a2 + kstep; const char* b3 = b2 + kstep;
            PG8_LDB(B0, 0, 0); PG8_SCHED; PG8_LDA(At, 0, 0); PG8_STAGE(PG8_SA(1, 1), a1 + hstep, voffA);
            PG8_WAIT_L(8); PG8_BAR; PG8_WAIT_L(0); PG8_MMA(0, 0, At, B0); PG8_BAR; PG8_SCHED;
            PG8_LDB(B1, 0, 1); PG8_STAGE(PG8_SB(0, 0), b2, voffB);
            PG8_BAR; PG8_WAIT_L(0); PG8_MMA(0, 1, At, B1); PG8_BAR;
            PG8_LDA(At, 0, 1); PG8_STAGE(PG8_SA(0, 0), a2, voffA);
            PG8_BAR; PG8_WAIT_L(0); PG8_MMA(1, 0, At, B0); PG8_BAR; PG8_SCHED;
            PG8_STAGE(PG8_SB(0, 1), b2 + hstep, voffB);
            PG8_WAIT_V(6); PG8_BAR; PG8_MMA(1, 1, At, B1); PG8_BAR;
            PG8_LDB(B0, 1, 0); PG8_SCHED; PG8_LDA(At, 1, 0); PG8_STAGE(PG8_SA(0, 1), a2 + hstep, voffA);
            PG8_WAIT_L(8); PG8_BAR; PG8_WAIT_L(0); PG8_MMA(0, 0, At, B0); PG8_BAR; PG8_SCHED;
            PG8_LDB(B1, 1, 1); PG8_STAGE(PG8_SB(1, 0), b3, voffB);
            PG8_BAR; PG8_WAIT_L(0); PG8_MMA(0, 1, At, B1); PG8_BAR;
            PG8_LDA(At, 1, 1); PG8_STAGE(PG8_SA(1, 0), a3, voffA);
            PG8_BAR; PG8_WAIT_L(0); PG8_MMA(1, 0, At, B0); PG8_BAR; PG8_SCHED;
            PG8_STAGE(PG8_SB(1, 1), b3 + hstep, voffB);
            PG8_WAIT_V(6); PG8_BAR; PG8_MMA(1, 1, At, B1); PG8_BAR;
        }
        E(acc, cur, wr, wc, fr, fq);
        if (!has_next) break;
#pragma unroll
        for (int a = 0; a < 2; ++a)
#pragma unroll
            for (int b = 0; b < 2; ++b)
#pragma unroll
                for (int m = 0; m < 4; ++m)
#pragma unroll
                    for (int n = 0; n < 2; ++n) acc[a][b][m][n] = (f32x4){0.f, 0.f, 0.f, 0.f};
        cur = nxt; cA = nA; cB = nB; ++ui;
    }
    PG8_WAIT_V(0);
    if (wr == 0) PG8_BAR;
    PG8_BAR;
#undef PG8_SA
#undef PG8_SB
#undef PG8_STAGE
#undef PG8_LDA
#undef PG8_LDB
#undef PG8_MMA
#undef PG8_WAIT_V
#undef PG8_WAIT_L
#undef PG8_BAR
#undef PG8_SCHED
}
}


#define XB_TMO      128
#define XB_XCNT(j)  (256  + 64 * (j))
#define XB_XSUB(j)  (1280 + 64 * (j))
#define XB_XGEN(j)  (2304 + 64 * (j))
#define XB_TOP      3328
#define XB_TOPGEN   3392
#define XCD_BAR_WORDS 3456
#define XB_SPIN_CAP (1u << 18)
__device__ __forceinline__ unsigned xb_ld(unsigned* p)              { return __hip_atomic_load(p, __ATOMIC_RELAXED, __HIP_MEMORY_SCOPE_AGENT); }
__device__ __forceinline__ unsigned xb_add(unsigned* p, unsigned v) { return __hip_atomic_fetch_add(p, v, __ATOMIC_RELAXED, __HIP_MEMORY_SCOPE_AGENT); }
__device__ __forceinline__ unsigned xb_xcc_id() { return (unsigned)__builtin_amdgcn_s_getreg((3 << 11) | 20) & 0xFu; }
#define XB_SPIN(cond, bar) do { unsigned _sp = 0; while (cond) { __builtin_amdgcn_s_sleep(1); \
    if ((++_sp & 255u) == 0u) { if (xb_ld(&(bar)[XB_TMO])) break; if (_sp > XB_SPIN_CAP) { atomicAdd(&(bar)[XB_TMO], 1u); break; } } } } while (0)
struct XcdBarrier { unsigned* bar; unsigned x; volatile LAS unsigned* st; };
__device__ __forceinline__ XcdBarrier xcd_barrier_post(unsigned* bar, volatile LAS unsigned* st) {
    XcdBarrier b; b.bar = bar; b.x = xb_xcc_id(); b.st = st;
    if (threadIdx.x == 0) (void)xb_add(&bar[XB_XCNT(b.x)], 1u);
    return b;
}
__device__ __forceinline__ void xcd_barrier_complete(unsigned* bar, unsigned x, unsigned& nloc, unsigned& nx) {
    const unsigned G = gridDim.x * gridDim.y * gridDim.z;
    unsigned sum, cnt, mine, sp = 0u;
    for (;;) {
        sum = 0u; cnt = 0u; mine = 0u;
#pragma unroll
        for (unsigned j = 0; j < 16; ++j) { const unsigned c = xb_ld(&bar[XB_XCNT(j)]); sum += c; cnt += (c > 0u) ? 1u : 0u; mine = (j == x) ? c : mine; }
        if (sum == G) break;
        __builtin_amdgcn_s_sleep(1);
        if ((++sp & 255u) == 0u) { if (xb_ld(&bar[XB_TMO])) break; if (sp > XB_SPIN_CAP) { atomicAdd(&bar[XB_TMO], 1u); break; } }
    }
    nloc = mine > 0u ? mine : 1u; nx = cnt > 0u ? cnt : 1u;
}
__device__ __forceinline__ void xcd_barrier(const XcdBarrier& b, const int wv0) {
    asm volatile("s_waitcnt vmcnt(0)" ::: "memory");
    __syncthreads();
    if (opaque_tid(wv0) == 0) {
        unsigned* bar = b.bar;
        __builtin_amdgcn_s_waitcnt(0);
        unsigned nloc = b.st[0], nx = b.st[1];
        if (nloc == 0u) { xcd_barrier_complete(bar, b.x, nloc, nx); b.st[0] = nloc; b.st[1] = nx; }
        const unsigned old = xb_add(&bar[XB_XSUB(b.x)], 1u);
        const unsigned gen = old / nloc;
        if (old + 1u == (gen + 1u) * nloc) {
            __builtin_amdgcn_fence(__ATOMIC_RELEASE, "agent");
            asm volatile("s_waitcnt vmcnt(0)" ::: "memory");
            const unsigned og = xb_add(&bar[XB_TOP], 1u);
            const unsigned tg = og / nx;
            if (og + 1u == (tg + 1u) * nx) xb_add(&bar[XB_TOPGEN], 1u);
            else XB_SPIN(xb_ld(&bar[XB_TOPGEN]) == tg, bar);
            __builtin_amdgcn_fence(__ATOMIC_ACQUIRE, "agent");
            xb_add(&bar[XB_XGEN(b.x)], 1u);
            asm volatile("s_waitcnt vmcnt(0)" ::: "memory");
        } else {
            XB_SPIN(xb_ld(&bar[XB_XGEN(b.x)]) == gen, bar);
            __builtin_amdgcn_fence(__ATOMIC_ACQUIRE, "agent");
            asm volatile("s_waitcnt vmcnt(0)" ::: "memory");
        }
    }
    __syncthreads();
}

struct Frame {
    LAS unsigned char* lds;
    int vcu, G, wv;
    const float* const* in; float* out; unsigned char* ws;
    __device__ __forceinline__ float* MOD() const { return (float*)(ws + WS_MOD); }
    __device__ __forceinline__ float* ROPE() const { return (float*)(ws + WS_ROPE); }
    __device__ __forceinline__ float* BA() const { return (float*)(ws + WS_BA); }
    __device__ __forceinline__ float* LAG() const { return (float*)(ws + WS_LAG); }
    __device__ __forceinline__ bf16_t* W1O() const { return (bf16_t*)(ws + WS_W1O); }
    __device__ __forceinline__ bf16_t* U0() const { return (bf16_t*)(ws + WS_RA); }
    __device__ __forceinline__ bf16_t* QKV1() const { return (bf16_t*)(ws + WS_RA); }
    __device__ __forceinline__ bf16_t* Z1() const { return (bf16_t*)(ws + WS_RA + (size_t)MT * 3072 * 2); }
    __device__ __forceinline__ bf16_t* Y1() const { return (bf16_t*)(ws + WS_RA + (size_t)MT * 3072 * 2); }
    __device__ __forceinline__ bf16_t* XN() const { return (bf16_t*)(ws + WS_RB + RB_XN); }
    __device__ __forceinline__ bf16_t* Y0() const { return (bf16_t*)(ws + WS_RB + RB_Y0); }
    __device__ __forceinline__ bf16_t* YO() const { return (bf16_t*)(ws + WS_RB + RB_YO); }
    __device__ __forceinline__ bf16_t* W0I() const { return (bf16_t*)(ws + WS_RB + RB_W0I); }
    __device__ __forceinline__ bf16_t* W0O() const { return (bf16_t*)(ws + WS_RB + RB_W0O); }
    __device__ __forceinline__ bf16_t* W1I() const { return (bf16_t*)(ws + WS_RB + RB_W1I); }
    __device__ __forceinline__ bf16_t* QKVC() const { return (bf16_t*)(ws + WS_RB); }
};

#define PHASE_IDS() int tid = opaque_tid(F.wv); const int lane = tid & 63, wave = __builtin_amdgcn_readfirstlane(tid >> 6); (void)lane; (void)wave
__device__ __forceinline__ void p0_transpose_item(const float* W, int ldw, int nblk, int K, bf16_t* WT, LAS float* scr, int item, int lane) {
    const int kb = item / nblk, nb = item % nblk, k0 = 64 * kb, n0 = 32 * nb;
    f32x4 v[8];
#pragma unroll
    for (int i = 0; i < 8; ++i) v[i] = *(const f32x4*)(W + (size_t)(k0 + 8 * i + (lane >> 3)) * ldw + n0 + 4 * (lane & 7));
#pragma unroll
    for (int i = 0; i < 8; ++i) { LAS float* d = scr + (8 * i + (lane >> 3)) * 33 + 4 * (lane & 7); d[0] = v[i][0]; d[1] = v[i][1]; d[2] = v[i][2]; d[3] = v[i][3]; }
    asm volatile("s_waitcnt lgkmcnt(0)" ::: "memory");
    const int c = lane & 7;
#pragma unroll
    for (int j = 0; j < 4; ++j) { const int n = (lane >> 3) + 8 * j; const LAS float* s = scr + (8 * c) * 33 + n;
        u32x4 o; o.x = pk2(s[0 * 33], s[1 * 33]); o.y = pk2(s[2 * 33], s[3 * 33]); o.z = pk2(s[4 * 33], s[5 * 33]); o.w = pk2(s[6 * 33], s[7 * 33]);
        *(u32x4*)(WT + (size_t)(n0 + n) * K + k0 + 8 * c) = o; }
    asm volatile("s_waitcnt lgkmcnt(0)" ::: "memory");
}
constexpr size_t WS_MODP = 12 * MiB;
__device__ __forceinline__ f32x4 mod4(const float* MODP, int L, int s, int off) {
    f32x4 a = *(const f32x4*)(MODP + ((size_t)((L * 4 + 0) * 24 + s)) * 3072 + off);
#pragma unroll
    for (int sl = 1; sl < 4; ++sl) a += *(const f32x4*)(MODP + ((size_t)((L * 4 + sl) * 24 + s)) * 3072 + off);
    return a;
}
__device__ __forceinline__ void mod_task(Frame& F, const int bt, const int tid, const int lane, const int wave) {
    const int L = bt / 192, sl = (bt % 192) / 48, n0 = (bt % 48) * 64, kb = sl * 256;
    LAS float* tab = (LAS float*)F.lds;
    {   float cv[12];
#pragma unroll
        for (int u = 0; u < 12; ++u) { const int idx = tid + 512 * u, s = idx >> 8, k = kb + (idx & 255); cv[u] = s < BP ? F.in[8][s * D + k] : F.in[9][(s - BP) * D + k]; }
#pragma unroll
        for (int u = 0; u < 12; ++u) { const int idx = tid + 512 * u, s = idx >> 8, k = idx & 255; tab[k * 24 + s] = siluf_(cv[u]); } }
    __syncthreads();
    const float* mw = (L == 0 ? F.in[10] : F.in[24]) + n0 + lane;
    float acc[24];
#pragma unroll
    for (int r = 0; r < 24; ++r) acc[r] = 0.f;
    for (int k0 = wave * 32; k0 < wave * 32 + 32; k0 += 16) {
        float wv[16];
#pragma unroll
        for (int u = 0; u < 16; ++u) wv[u] = mw[(size_t)(kb + k0 + u) * 3072];
#pragma unroll
        for (int u = 0; u < 16; ++u) { const float w = wv[u];
            const LAS f32x4* tp = (const LAS f32x4*)(tab + (k0 + u) * 24);
#pragma unroll
            for (int q = 0; q < 6; ++q) { const f32x4 t4 = tp[q]; acc[4 * q] += t4[0] * w; acc[4 * q + 1] += t4[1] * w; acc[4 * q + 2] += t4[2] * w; acc[4 * q + 3] += t4[3] * w; } }
    }
    __syncthreads();
    LAS float* red = (LAS float*)F.lds;
#pragma unroll
    for (int r = 0; r < 24; ++r) red[(wave * 24 + r) * 64 + lane] = acc[r];
    __syncthreads();
    const float* mb = (L == 0 ? F.in[11] : F.in[25]);
    float* MODP = (float*)(F.ws + WS_MODP);
    for (int idx = tid; idx < 24 * 64; idx += 512) { const int r = idx >> 6, l = idx & 63; float s = 0.f;
#pragma unroll
        for (int w = 0; w < 8; ++w) s += red[(w * 24 + r) * 64 + l];
        MODP[((size_t)((L * 4 + sl) * 24 + r)) * 3072 + n0 + l] = s + (sl == 0 ? mb[n0 + l] : 0.f); }
    __syncthreads();
}
__device__ __forceinline__ void phase_mod0(Frame& F) {
    PHASE_IDS();
    for (int bt = F.vcu; bt < 192; bt += F.G) { int t2 = tid; asm volatile("" : "+v"(t2)); mod_task(F, bt, t2, t2 & 63, wave); }
}
__device__ __forceinline__ void phase_mod1(Frame& F) {
    PHASE_IDS();
    __syncthreads();
    for (int bt = 192 + F.vcu; bt < 384; bt += F.G) { int t2 = tid; asm volatile("" : "+v"(t2)); mod_task(F, bt, t2, t2 & 63, wave); }
}
__device__ __forceinline__ void phase_prologue(Frame& F) {
    PHASE_IDS();
    const int gw = F.vcu * 8 + wave, NGW = F.G * 8;
    {
        LAS float* scr = (LAS float*)(F.lds + wave * 16384);
        constexpr int I0 = 16 * (EV_IN / 32), I1 = 16 * 32, I2 = 16 * (OD_MAIN / 32), I3 = 16 * 32;
        for (int it = gw; it < I0 + I1 + I2 + I3; it += NGW) {
            int r = it;
            if (r < I0) { p0_transpose_item(F.in[14], EV_IN, EV_IN / 32, D, F.W0I(), scr, r, lane); continue; } r -= I0;
            if (r < I1) { p0_transpose_item(F.in[23], D, 32, D, F.W0O(), scr, r, lane); continue; } r -= I1;
            if (r < I2) { p0_transpose_item(F.in[28], OD_IN, OD_MAIN / 32, D, F.W1I(), scr, r, lane); continue; } r -= I2;
            p0_transpose_item(F.in[33], D, 32, D, F.W1O(), scr, r, lane);
        }
    }
    {
        const double inv[8] = {1.0, 0.19392274474868576, 0.03760603093086393, 0.007292664737217109, 0.001414213562373095, 0.0002742481756762073, 5.318295896944988e-05, 1.031338537721246e-05};
        for (int idx = F.vcu * 512 + tid; idx < 4112 * 8; idx += F.G * 512) {
            const int pos = idx >> 3, i = idx & 7;
            double iv = inv[0];
#pragma unroll
            for (int q = 1; q < 8; ++q) iv = (i == q) ? inv[q] : iv;
            const double ang = (double)pos * iv;
            const double n = __builtin_rint(ang * 0.15915494309189535);
            const float r = (float)__builtin_fma(-n, 6.283185307179586, ang);
            F.ROPE()[pos * 16 + i] = __cosf(r); F.ROPE()[pos * 16 + 8 + i] = __sinf(r);
        }
    }
    {
        bf16_t* LGW = (bf16_t*)(F.ws + WS_LGW);
        for (int idx = F.vcu * 512 + tid; idx < 8 * 2 * 64 * 64; idx += F.G * 512) { const int k = idx & 63, n = (idx >> 6) & 63, gate = (idx >> 12) & 1, hh = idx >> 13;
            LGW[idx] = (bf16_t)f2bf(-1.4426950408889634f * (gate ? F.in[19] : F.in[17])[(hh * 64 + k) * 64 + n]); }
    }
}

__device__ __forceinline__ const float* x_row(Frame& F, int m) { return m < MP ? F.in[0] + (size_t)m * D : F.in[1] + (size_t)(m - MP) * D; }
__device__ __forceinline__ void rows_prenorm0(Frame& F, const int m0, const int n, const int s, const int lane) {
    const float* MODP = (const float*)(F.ws + WS_MODP);
    f32x4 A[4], C[4];
#pragma unroll
    for (int j = 0; j < 4; ++j) { const int c = 4 * lane + 256 * j; const f32x4 g = *(const f32x4*)(F.in[12] + c), sc = mod4(MODP, 0, s, 1024 + c); C[j] = mod4(MODP, 0, s, c);
#pragma unroll
        for (int e = 0; e < 4; ++e) A[j][e] = g[e] * (1.f + sc[e]); }
    f32x4 cur[4];
#pragma unroll
    for (int j = 0; j < 4; ++j) cur[j] = *(const f32x4*)(x_row(F, m0) + 4 * lane + 256 * j);
    for (int i = 0; i < n; ++i) {
        const int mn = m0 + (i + 1 < n ? i + 1 : i); f32x4 nxt[4];
#pragma unroll
        for (int j = 0; j < 4; ++j) nxt[j] = *(const f32x4*)(x_row(F, mn) + 4 * lane + 256 * j);
        float ss = 0.f;
#pragma unroll
        for (int j = 0; j < 4; ++j) ss += (cur[j][0] * cur[j][0] + cur[j][1] * cur[j][1]) + (cur[j][2] * cur[j][2] + cur[j][3] * cur[j][3]);
        const float r = rsqrtf(wave_sum(ss, lane) * (1.f / D) + EPS);
#pragma unroll
        for (int j = 0; j < 4; ++j) { u32x2 w; w[0] = cvt2(cur[j][0] * r * A[j][0] + C[j][0], cur[j][1] * r * A[j][1] + C[j][1]); w[1] = cvt2(cur[j][2] * r * A[j][2] + C[j][2], cur[j][3] * r * A[j][3] + C[j][3]);
            *(u32x2*)(F.XN() + (size_t)(m0 + i) * D + 4 * lane + 256 * j) = w; }
#pragma unroll
        for (int j = 0; j < 4; ++j) cur[j] = nxt[j];
    }
}
__device__ __forceinline__ void phase_prenorm0(Frame& F) {
    PHASE_IDS();
    const int gw = F.vcu * 8 + wave, NGW = F.G * 8;
    for (int w = gw; w < MP / 16; w += NGW) rows_prenorm0(F, w * 16, 16, w >> 8, lane);
    for (int w = gw; w < MS; w += NGW) rows_prenorm0(F, MP + w, 1, BP + (w >> 4), lane);
}

__device__ __forceinline__ void rope_phase_body(Frame& F, const int tid) {
    const int gt = F.vcu * 512 + tid, NT = F.G * 512;
    for (int i0 = gt; i0 < MT * 10; i0 += 3 * NT) {
        u32x4 xa[3], xb[3]; f32x4 rc[3][4];
#pragma unroll
        for (int k = 0; k < 3; ++k) { const int idx = i0 + k * NT < MT * 10 ? i0 + k * NT : i0, m = idx / 10, slot = idx % 10;
            int sq, t; tok_info(m, sq, t); const int pos = sq < BP ? t : TP + t, col = slot < 8 ? C_Q + slot * 64 : C_K + (slot - 8) * 64;
            const u32x4* p = (const u32x4*)(F.U0() + (size_t)m * EV_IN + col); xa[k] = p[0]; xb[k] = p[1];
            const f32x4* rp = (const f32x4*)(F.ROPE() + pos * 16); rc[k][0] = rp[0]; rc[k][1] = rp[1]; rc[k][2] = rp[2]; rc[k][3] = rp[3]; }
#pragma unroll
        for (int k = 0; k < 3; ++k) if (i0 + k * NT < MT * 10) { const int idx = i0 + k * NT, m = idx / 10, slot = idx % 10;
            int sq, t; tok_info(m, sq, t); const int col = slot < 8 ? C_Q + slot * 64 : C_K + (slot - 8) * 64;
            u32x4* p = (u32x4*)(F.U0() + (size_t)m * EV_IN + col);
            float x1[8], x2[8], o1[8], o2[8];
#pragma unroll
            for (int e = 0; e < 4; ++e) { x1[2 * e] = lo16(xa[k][e]); x1[2 * e + 1] = hi16(xa[k][e]); x2[2 * e] = lo16(xb[k][e]); x2[2 * e + 1] = hi16(xb[k][e]); }
#pragma unroll
            for (int i = 0; i < 8; ++i) { const float cs = i < 4 ? rc[k][0][i & 3] : rc[k][1][i & 3], sn = i < 4 ? rc[k][2][i & 3] : rc[k][3][i & 3]; o1[i] = x1[i] * cs - x2[i] * sn; o2[i] = x2[i] * cs + x1[i] * sn; }
            u32x4 ya, yb;
#pragma unroll
            for (int e = 0; e < 4; ++e) { ya[e] = cvt2(o1[2 * e], o1[2 * e + 1]); yb[e] = cvt2(o2[2 * e], o2[2 * e + 1]); }
            p[0] = ya; p[1] = yb;
            if (slot >= 8) { const int kv = slot - 8; float* o = nullptr;
                if (sq >= BP) o = F.out + O_KS + ((size_t)((sq - BP) * TS + t) * 2 + kv) * 64;
                else if (t >= TP - 128) o = F.out + O_KP + ((size_t)(sq * 128 + (t - (TP - 128))) * 2 + kv) * 64;
                if (o) { *(f32x4*)o = (f32x4){o1[0], o1[1], o1[2], o1[3]}; *(f32x4*)(o + 4) = (f32x4){o1[4], o1[5], o1[6], o1[7]}; *(f32x4*)(o + 8) = (f32x4){o2[0], o2[1], o2[2], o2[3]}; *(f32x4*)(o + 12) = (f32x4){o2[4], o2[5], o2[6], o2[7]}; } }
        }
    }
    for (int i0 = gt; i0 < 1280 * 224; i0 += 3 * NT) {
        unsigned short v3[3];
#pragma unroll
        for (int k = 0; k < 3; ++k) { const int idx = i0 + k * NT < 1280 * 224 ? i0 + k * NT : i0, tk = idx / 224, e = idx % 224;
            int m; if (tk < 1024) m = (tk >> 7) * TP + TP - 128 + (tk & 127); else m = MP + (tk - 1024);
            const bool isv = e >= 96; const int e2 = isv ? e - 96 : e; const int kv = isv ? (e2 >> 6) : (e2 / 48), d = isv ? (e2 & 63) : 16 + (e2 % 48);
            v3[k] = F.U0()[(size_t)m * EV_IN + (isv ? C_V : C_K) + kv * 64 + d]; }
#pragma unroll
        for (int k = 0; k < 3; ++k) if (i0 + k * NT < 1280 * 224) { const int idx = i0 + k * NT, tk = idx / 224, e = idx % 224;
            int sq, t; if (tk < 1024) { sq = tk >> 7; t = TP - 128 + (tk & 127); } else { sq = BP + ((tk - 1024) >> 4); t = (tk - 1024) & 15; }
            const bool isv = e >= 96; const int e2 = isv ? e - 96 : e; const int kv = isv ? (e2 >> 6) : (e2 / 48), d = isv ? (e2 & 63) : 16 + (e2 % 48);
            const size_t ob = sq >= BP ? (isv ? O_VS : O_KS) + ((size_t)((sq - BP) * TS + t) * 2 + kv) * 64 : (isv ? O_VP : O_KP) + ((size_t)(sq * 128 + (t - (TP - 128))) * 2 + kv) * 64;
            F.out[ob + d] = bf2f(v3[k]); }
    }
}


#define MFMA32(a, b, c) __builtin_amdgcn_mfma_f32_32x32x16_bf16((a), (b), (c), 0, 0, 0)
#define MFMA16(a, b, c) __builtin_amdgcn_mfma_f32_16x16x32_bf16((a), (b), (c), 0, 0, 0)
typedef __amdgpu_buffer_rsrc_t brsrc_t;
__device__ __forceinline__ brsrc_t staging_rsrc(unsigned char* ws) { return __builtin_amdgcn_make_buffer_rsrc((void*)(ws + WS_RB), (short)0, (int)RB_BYTES, 0x00020000); }
__device__ __forceinline__ void st16_wt(brsrc_t r, unsigned off, u32x4 v) { __builtin_amdgcn_raw_buffer_store_b128(v, r, off, 0, 16); }
__device__ __forceinline__ u32x4 ld16_wt(brsrc_t r, unsigned off) { return __builtin_amdgcn_raw_buffer_load_b128(r, off, 0, 16); }
__device__ __forceinline__ void rows_mid(Frame& F, const LAS unsigned char* bawb, const int m0, const int n, const int s, const int lane) {
    const float* MODP = (const float*)(F.ws + WS_MODP);
    f32x4 A0[4], B1[4], C1[4];
#pragma unroll
    for (int j = 0; j < 4; ++j) { const int c = 4 * lane + 256 * j; const f32x4 g0 = *(const f32x4*)(F.in[13] + c), gt = mod4(MODP, 0, s, 2048 + c), g1 = *(const f32x4*)(F.in[26] + c), sc = mod4(MODP, 1, s, 1024 + c);
        C1[j] = mod4(MODP, 1, s, c);
#pragma unroll
        for (int e = 0; e < 4; ++e) { A0[j][e] = gt[e] * g0[e]; B1[j][e] = g1[e] * (1.f + sc[e]); } }
    u32x2 ycur[4]; f32x4 xcur[4];
#pragma unroll
    for (int j = 0; j < 4; ++j) { ycur[j] = *(const u32x2*)(F.YO() + (size_t)m0 * D + 4 * lane + 256 * j); xcur[j] = *(const f32x4*)(x_row(F, m0) + 4 * lane + 256 * j); }
    for (int i = 0; i < n; ++i) {
        const int m = m0 + i, mn = m0 + (i + 1 < n ? i + 1 : i); u32x2 ynxt[4]; f32x4 xnxt[4];
#pragma unroll
        for (int j = 0; j < 4; ++j) { ynxt[j] = *(const u32x2*)(F.YO() + (size_t)mn * D + 4 * lane + 256 * j); xnxt[j] = *(const f32x4*)(x_row(F, mn) + 4 * lane + 256 * j); }
        f32x4 y[4]; float ss = 0.f;
#pragma unroll
        for (int j = 0; j < 4; ++j) { y[j] = (f32x4){lo16(ycur[j][0]), hi16(ycur[j][0]), lo16(ycur[j][1]), hi16(ycur[j][1])}; ss += (y[j][0] * y[j][0] + y[j][1] * y[j][1]) + (y[j][2] * y[j][2] + y[j][3] * y[j][3]); }
        const float r1 = rsqrtf(wave_sum(ss, lane) * (1.f / D) + EPS);
        f32x4 x1[4]; float s2 = 0.f;
#pragma unroll
        for (int j = 0; j < 4; ++j) {
#pragma unroll
            for (int e = 0; e < 4; ++e) x1[j][e] = xcur[j][e] + A0[j][e] * (y[j][e] * r1);
            { u32x2 xb; xb[0] = cvt2(x1[j][0], x1[j][1]); xb[1] = cvt2(x1[j][2], x1[j][3]); *(u32x2*)((bf16_t*)(F.out + O_Y + (size_t)m * D) + 4 * lane + 256 * j) = xb; }
            s2 += (x1[j][0] * x1[j][0] + x1[j][1] * x1[j][1]) + (x1[j][2] * x1[j][2] + x1[j][3] * x1[j][3]); }
        const float r2 = rsqrtf(wave_sum(s2, lane) * (1.f / D) + EPS);
        f32x4 hm[4];
#pragma unroll
        for (int j = 0; j < 4; ++j) {
#pragma unroll
            for (int e = 0; e < 4; ++e) hm[j][e] = x1[j][e] * r2 * B1[j][e] + C1[j][e];
            u32x2 w; w[0] = cvt2(hm[j][0], hm[j][1]); w[1] = cvt2(hm[j][2], hm[j][3]); *(u32x2*)(F.XN() + (size_t)m * D + 4 * lane + 256 * j) = w; }
#pragma unroll
        for (int j = 0; j < 4; ++j) { ycur[j] = ynxt[j]; xcur[j] = xnxt[j]; }
    }
    asm volatile("s_waitcnt vmcnt(0)" ::: "memory");
    {   const brsrc_t rs = staging_rsrc(F.ws);
        const int r = lane & 15, g = lane >> 4;
        const unsigned abase = (unsigned)RB_XN + (unsigned)(m0 + (r < n ? r : 0)) * (unsigned)(D * 2) + (unsigned)g * 16u;
        f32x4 acc = {0.f, 0.f, 0.f, 0.f};
#pragma unroll
        for (int h = 0; h < 2; ++h) { u32x4 a[16];
#pragma unroll
            for (int k = 0; k < 16; ++k) a[k] = ld16_wt(rs, abase + (unsigned)(h * 16 + k) * 64u);
#pragma unroll
            for (int k = 0; k < 16; ++k) acc = MFMA16(__builtin_bit_cast(bf16x8, a[k]), *(const LAS bf16x8*)(bawb + ((h * 16 + k) * 64 + lane) * 16), acc); }
        const int hh = r & 7; const float ea = -__expf(F.in[30][hh]), db = F.in[31][hh];
#pragma unroll
        for (int e = 0; e < 4; ++e) { const int row = 4 * g + e; if (row < n) F.BA()[(size_t)(m0 + row) * 16 + r] = r < 8 ? sigmoidf_(acc[e]) : ea * softplusf_(acc[e] + db); }
    }
}
__device__ __forceinline__ void phase_mid_rowwise(Frame& F) {
    PHASE_IDS();
    LAS unsigned char* bawb = F.lds;
    for (int idx = tid; idx < 32 * 64; idx += 512) { const int kk = idx >> 6, l = idx & 63, c = l & 15, g = l >> 4; const float* wp = F.in[28] + (size_t)(32 * kk + 8 * g) * OD_IN + OD_MAIN + c;
        u32x4 w; w[0] = cvt2(wp[0], wp[OD_IN]); w[1] = cvt2(wp[2 * OD_IN], wp[3 * OD_IN]); w[2] = cvt2(wp[4 * OD_IN], wp[5 * OD_IN]); w[3] = cvt2(wp[6 * OD_IN], wp[7 * OD_IN]);
        *(LAS u32x4*)(bawb + idx * 16) = w; }
    __syncthreads();
    const int gw = F.vcu * 8 + wave, NGW = F.G * 8;
    for (int w = gw; w < MP / 16; w += NGW) rows_mid(F, bawb, w * 16, 16, w >> 8, lane);
    for (int w = gw; w < MS; w += NGW) rows_mid(F, bawb, MP + w, 1, BP + (w >> 4), lane);
}


typedef float f32x16 __attribute__((ext_vector_type(16)));
constexpr int GS_WF = 0, GS_QF = 16384, GS_KF = 32768, GS_PF = 49152, GS_UF = 57344, GS_BYTES = 73728;
constexpr size_t WS_DEC = 11 * MiB;
__device__ __forceinline__ int krow(int s, int h, int j) { return 16 * s + 8 * (j >> 2) + 4 * h + (j & 3); }

__device__ __forceinline__ void st8_wt(unsigned char* p, u32x2 v) { __hip_atomic_store((unsigned long long*)p, ((unsigned long long)v[1] << 32) | v[0], __ATOMIC_RELAXED, __HIP_MEMORY_SCOPE_AGENT); }
constexpr size_t WS_READY = 65536;
#define LDS_BARRIER() do { asm volatile("s_waitcnt lgkmcnt(0)" ::: "memory"); __builtin_amdgcn_s_barrier(); asm volatile("" ::: "memory"); } while (0)
constexpr int G1_QS = 0, G1_KS = 17408, G1_VS = 34816, G1_AS = 52224, G1_PS = 69632, G1_WS = 78848, G1_CW = 96256, G1_VEC = 102400, G1_ES = 103424;
__device__ __forceinline__ void g1_load_raw(Frame& F, u32x4 (&raw)[24], int s, int c, int h, int t1) {
    const int r = t1 >> 3, j = t1 & 7, t = c * 64 + r;
#pragma unroll
    for (int p = 0; p < 3; ++p)
#pragma unroll
        for (int jj = 0; jj < 4; ++jj) { const int tt = t - 3 + jj, ttc = tt < 0 ? 0 : tt;
            const u32x4* src = (const u32x4*)(F.QKV1() + (size_t)(s * TP + ttc) * 3072 + p * 1024 + h * 128 + j * 16); raw[p * 8 + jj * 2] = src[0]; raw[p * 8 + jj * 2 + 1] = src[1]; }
}
__device__ __forceinline__ bf16x8 g1_pack_b(const f32x4 p, const f32x4 q) { u32x4 w; w[0] = cvt2(p[0], p[1]); w[1] = cvt2(p[2], p[3]); w[2] = cvt2(q[0], q[1]); w[3] = cvt2(q[2], q[3]); return __builtin_bit_cast(bf16x8, w); }
__device__ __forceinline__ void g1_decode(int n, int& s, int& c, int& h) { if (n < 4096) { c = n >> 6; s = (n & 63) >> 3; h = n & 7; } else { s = BP + ((n - 4096) >> 3); c = 0; h = n & 7; } }
constexpr int P2_SET = 52224, P2_Q = 0, P2_K = 17408, P2_V = 34816;
constexpr int P2_AS = 2 * P2_SET, P2_PS = P2_AS + 17408, P2_ES = P2_PS + 9216, P2_CW = P2_ES + 4096, P2_VEC = P2_CW + 6144;
static_assert(P2_VEC + 2048 <= LDS_BYTES - 64, "producer LDS map");
__device__ __forceinline__ void p2_load_part(Frame& F, u32x4 (&rw)[16], int s, int c, int h, int p, int tb) {
    const int r = tb >> 3, j = tb & 7;
#pragma unroll
    for (int it = 0; it < 2; ++it)
#pragma unroll
        for (int jj = 0; jj < 4; ++jj) { int tt = c * 64 + r + 32 * it - 3 + jj; tt = tt < 0 ? 0 : tt;
            const u32x4* src = (const u32x4*)(F.QKV1() + (size_t)(s * TP + tt) * 3072 + p * 1024 + h * 128 + j * 16); rw[it * 8 + jj * 2] = src[0]; rw[it * 8 + jj * 2 + 1] = src[1]; }
}
__device__ __forceinline__ void p2_conv_item(Frame& F, const u32x4 (&rw)[16], const int it, const f32x4 (&wreg)[16], const int p, const int j, const int lane, const bool ok, float* state_out, LAS u32x4* dst) {
    float acc[16];
#pragma unroll
    for (int e = 0; e < 16; ++e) acc[e] = 0.f;
#pragma unroll
    for (int jj = 0; jj < 4; ++jj) {
        const u32x4 a = rw[it * 8 + jj * 2], b = rw[it * 8 + jj * 2 + 1]; float x[16];
#pragma unroll
        for (int e = 0; e < 4; ++e) { x[2 * e] = lo16(a[e]); x[2 * e + 1] = hi16(a[e]); x[8 + 2 * e] = lo16(b[e]); x[8 + 2 * e + 1] = hi16(b[e]); }
#pragma unroll
        for (int q = 0; q < 4; ++q) { const f32x4 w4 = wreg[jj * 4 + q]; acc[4 * q] += w4[0] * x[4 * q]; acc[4 * q + 1] += w4[1] * x[4 * q + 1]; acc[4 * q + 2] += w4[2] * x[4 * q + 2]; acc[4 * q + 3] += w4[3] * x[4 * q + 3]; }
        if (jj == 3 && state_out) {
#pragma unroll
            for (int q = 0; q < 4; ++q) *(f32x4*)(state_out + 4 * q) = (f32x4){x[4 * q], x[4 * q + 1], x[4 * q + 2], x[4 * q + 3]}; }
    }
    float ss = 0.f;
#pragma unroll
    for (int e = 0; e < 16; ++e) { acc[e] = siluf_(acc[e]); ss += acc[e] * acc[e]; }
    if (p < 2) { ss += shfl_xor_l(ss, 1, lane); ss += shfl_xor_l(ss, 2, lane); ss += shfl_xor_l(ss, 4, lane);
        float sc = __builtin_amdgcn_rsqf(ss + EPS); if (p == 0) sc *= 0.08838834764831845f;
#pragma unroll
        for (int e = 0; e < 16; ++e) acc[e] *= sc; }
    u32x4 w0, w1;
#pragma unroll
    for (int e = 0; e < 4; ++e) { w0[e] = ok ? cvt2(acc[2 * e], acc[2 * e + 1]) : 0u; w1[e] = ok ? cvt2(acc[8 + 2 * e], acc[8 + 2 * e + 1]) : 0u; }
    dst[0] = w0; dst[1] = w1;
}
__device__ __forceinline__ void gdn_g1_tasks(Frame& F, const int first, const int stride) {
    LAS unsigned char* L = F.lds;
    LAS float* cw_s = (LAS float*)(L + P2_CW);
    float* DEC = (float*)(F.ws + WS_DEC);
    const brsrc_t srs = staging_rsrc(F.ws);
    unsigned* ready = (unsigned*)(F.ws + WS_READY);
    const int wave = F.wv;
    const bool grpB = wave >= 4;
    int ntask = 0; for (int t = first; t < 4224; t += stride) ++ntask;
    u32x4 rwA[16]; float pcw[6];
    if (grpB) {
        const int tb = opaque_tid(wave) - 256; int s0, c0, h0; g1_decode(first < 4095 ? first : 4095, s0, c0, h0);
        p2_load_part(F, rwA, s0, c0, h0, 0, tb);
#pragma unroll
        for (int q = 0; q < 6; ++q) { const int i = tb + 256 * q, jj = i / 384, cc = i % 384; pcw[q] = F.in[29][(size_t)jj * 3072 + (cc >> 7) * 1024 + h0 * 128 + (cc & 127)]; }
#pragma unroll
        for (int q = 0; q < 6; ++q) cw_s[tb + 256 * q] = pcw[q];
    }
    LDS_BARRIER();
    for (int i = 0; i <= ntask; ++i) {
        const int tid = opaque_tid(wave), lane = tid & 63;
        const int taskB = first + i * stride, taskA = taskB - stride;
        const bool actB = grpB && i < ntask, actA = !grpB && i >= 1;
        int s = 0, c = 0, h = 0; g1_decode(grpB ? (i < ntask ? taskB : 4095) : (i >= 1 ? taskA : 0), s, c, h);
        const int task = grpB ? taskB : taskA;
        const int sidx = task < 4096 ? ((s * 8 + h) * 64 + c) : task;
        const int nvalid = s < BP ? 64 : TS, t0 = c * 64, base = seq_base(s), T = seq_len(s);
        LAS unsigned char* Sb = L + (grpB ? (i & 1) : ((i - 1) & 1)) * P2_SET;
        LAS float* vec = (LAS float*)(L + P2_VEC + (grpB ? (i & 1) : ((i - 1) & 1)) * 1024); LAS float* beta_s = vec; LAS float* gcum_s = vec + 64; LAS float* eg_s = vec + 128; LAS float* ek_s = vec + 192;
        unsigned char* blk = F.ws + WS_RB + (size_t)sidx * GS_BYTES; const unsigned boff = (unsigned)sidx * (unsigned)GS_BYTES;
        float gvb = 0.f, gva = 0.f; int gs = 0, gc = 0, gh = 0; const bool gact = (wave == 3) && i < ntask;
        if (gact) { g1_decode(taskB, gs, gc, gh); if (lane < (gs < BP ? 64 : TS)) { const float* ba = F.BA() + (size_t)(seq_base(gs) + gc * 64 + lane) * 16; gvb = ba[gh]; gva = ba[8 + gh]; } }
        const int tb = tid - 256, rB = tb >> 3, jB = tb & 7;
#define P2_PART(p, rw) do { if (actB) { \
            if (s >= BP) { _Pragma("unroll") for (int it = 0; it < 2; ++it) _Pragma("unroll") for (int jj = 0; jj < 4; ++jj) { const int r_ = rB + 32 * it, tt = r_ - 3 + jj; u32x4 a_ = {0u, 0u, 0u, 0u}, b_ = {0u, 0u, 0u, 0u}; \
                    if (r_ < nvalid) { const int cb_ = (p) * 1024 + h * 128 + jB * 16; \
                        if (tt >= 0) { const u32x4* src = (const u32x4*)(F.QKV1() + (size_t)(base + tt) * 3072 + cb_); a_ = src[0]; b_ = src[1]; } \
                        else { const f32x4* src = (const f32x4*)(F.in[6] + ((size_t)(s - BP) * 3 + (tt + 3)) * 3072 + cb_); const f32x4 f0 = src[0], f1 = src[1], f2 = src[2], f3 = src[3]; \
                            a_[0] = cvt2(f0[0], f0[1]); a_[1] = cvt2(f0[2], f0[3]); a_[2] = cvt2(f1[0], f1[1]); a_[3] = cvt2(f1[2], f1[3]); b_[0] = cvt2(f2[0], f2[1]); b_[1] = cvt2(f2[2], f2[3]); b_[2] = cvt2(f3[0], f3[1]); b_[3] = cvt2(f3[2], f3[3]); } } \
                    rw[it * 8 + jj * 2] = a_; rw[it * 8 + jj * 2 + 1] = b_; } } \
            else if (t0 == 0 && rB < 3) { _Pragma("unroll") for (int jj = 0; jj < 3; ++jj) if (rB - 3 + jj < 0) { rw[jj * 2] = (u32x4){0u, 0u, 0u, 0u}; rw[jj * 2 + 1] = (u32x4){0u, 0u, 0u, 0u}; } } \
            f32x4 wreg_[16]; _Pragma("unroll") for (int jj = 0; jj < 4; ++jj) _Pragma("unroll") for (int q = 0; q < 4; ++q) wreg_[jj * 4 + q] = *(const LAS f32x4*)(cw_s + jj * 384 + (p) * 128 + jB * 16 + 4 * q);   \
            _Pragma("unroll") for (int it = 0; it < 2; ++it) { const int r_ = rB + 32 * it, t_ = t0 + r_; const bool ok_ = r_ < nvalid; \
                float* so_ = (ok_ && t_ >= T - 3) ? ((s < BP ? F.out + O_GCP + ((size_t)s * 3 + (t_ - (T - 3))) * 3072 : F.out + O_GCS + ((size_t)(s - BP) * 3 + (t_ - (T - 3))) * 3072) + (p) * 1024 + h * 128 + jB * 16) : nullptr; \
                p2_conv_item(F, rw, it, wreg_, (p), jB, lane, ok_, so_, (LAS u32x4*)(Sb + ((p) == 0 ? P2_Q : (p) == 1 ? P2_K : P2_V) + r_ * 272 + jB * 32)); } } } while (0)
        if (grpB) {
            P2_PART(0, rwA);
            if (actB && s < BP) p2_load_part(F, rwA, s, c, h, 1, tb);
        } else if (actA) {
            int l2 = lane; asm volatile("" : "+v"(l2));
            const int r = l2 & 31, hh = l2 >> 5;
#pragma unroll
            for (int half = 0; half < 2; ++half) {
                const int tile8 = wave + 4 * half, which = tile8 >> 2, ti = (tile8 >> 1) & 1, tj = tile8 & 1;
                f32x16 acc;
#pragma unroll
                for (int e = 0; e < 16; ++e) acc[e] = 0.f;
                if (!(ti == 0 && tj == 1)) {
                    const LAS unsigned char* ap = Sb + (which ? P2_Q : P2_K) + (32 * ti + r) * 272 + hh * 16;
                    const LAS unsigned char* bp = Sb + P2_K + (32 * tj + r) * 272 + hh * 16;
#pragma unroll
                    for (int ks = 0; ks < 8; ++ks) { const bf16x8 a = *(const LAS bf16x8*)(ap + ks * 32), b = *(const LAS bf16x8*)(bp + ks * 32); acc = MFMA32(a, b, acc); }
                }
                const int jc = 32 * tj + r; const float gj = gcum_s[jc];
#pragma unroll
                for (int e = 0; e < 16; ++e) {
                    const int ii = 32 * ti + (e & 3) + 8 * (e >> 2) + 4 * hh; const float dg = gcum_s[ii] - gj;
                    if (which == 0) { const float f = (ii > jc) ? __expf(dg) * beta_s[ii] : 0.f; *(LAS float*)(L + P2_AS + ii * 272 + jc * 4) = acc[e] * f; }
                    else { const float f = (ii >= jc) ? __expf(dg) : 0.f; *(LAS bf16_t*)(L + P2_PS + ii * 144 + jc * 2) = (bf16_t)(cvt2(acc[e] * f, 0.f) & 0xffffu); }
                }
            }
        }
        LDS_BARRIER();
        if (grpB) {
            P2_PART(1, rwA);
            if (actB && s < BP) p2_load_part(F, rwA, s, c, h, 2, tb);
        } else if (actA) {
            int l3 = lane; asm volatile("" : "+v"(l3));
            if (wave == 0) {
                const int bk = l3 >> 4, col = l3 & 15;
                float tcol[16];
#pragma unroll
                for (int rr = 0; rr < 16; ++rr) {
                    float a = (rr == col) ? 1.0f : 0.f;
#pragma unroll
                    for (int j4 = 0; j4 < (rr + 3) / 4; ++j4) { const f32x4 a4 = *(const LAS f32x4*)(L + P2_AS + (16 * bk + rr) * 272 + (16 * bk + 4 * j4) * 4);
#pragma unroll
                        for (int q = 0; q < 4; ++q) if (4 * j4 + q < rr) a -= a4[q] * tcol[4 * j4 + q]; }
                    tcol[rr] = a;
                    *(LAS float*)(L + P2_ES + ((bk * 16 + rr) * 16 + col) * 4) = a - ((rr == col) ? 1.0f : 0.f);
                }
            } else {
                const int r = l3 & 31, hh = l3 >> 5;
                if (wave == 1) {
#pragma unroll
                    for (int rt4 = 0; rt4 < 4; ++rt4)
#pragma unroll
                        for (int kt2 = 0; kt2 < 2; ++kt2)
#pragma unroll
                            for (int ss = 0; ss < 2; ++ss) { float v[8];
#pragma unroll
                                for (int j = 0; j < 8; ++j) { const int tok = 32 * kt2 + krow(ss, hh, j); v[j] = bf2f(*(const LAS bf16_t*)(Sb + P2_K + tok * 272 + (32 * rt4 + r) * 2)) * ek_s[tok]; }
                                u32x4 o; o[0] = cvt2(v[0], v[1]); o[1] = cvt2(v[2], v[3]); o[2] = cvt2(v[4], v[5]); o[3] = cvt2(v[6], v[7]);
                                st16_wt(srs, boff + GS_KF + ((rt4 * 2 + kt2) * 2 + ss) * 1024 + l3 * 16, o); }
                } else if (wave == 2) {
#pragma unroll
                    for (int kt = 0; kt < 4; ++kt)
#pragma unroll
                        for (int rt = 0; rt < 2; ++rt)
#pragma unroll
                            for (int ss = 0; ss < 2; ++ss) { const int ii = 32 * rt + r; const float sc = eg_s[ii];
                                const u32x2 lo = *(const LAS u32x2*)(Sb + P2_Q + ii * 272 + (32 * kt + 16 * ss + 4 * hh) * 2), hi = *(const LAS u32x2*)(Sb + P2_Q + ii * 272 + (32 * kt + 16 * ss + 8 + 4 * hh) * 2);
                                u32x4 o; o[0] = cvt2(lo16(lo[0]) * sc, hi16(lo[0]) * sc); o[1] = cvt2(lo16(lo[1]) * sc, hi16(lo[1]) * sc); o[2] = cvt2(lo16(hi[0]) * sc, hi16(hi[0]) * sc); o[3] = cvt2(lo16(hi[1]) * sc, hi16(hi[1]) * sc);
                                st16_wt(srs, boff + GS_QF + ((rt * 4 + kt) * 2 + ss) * 1024 + l3 * 16, o); }
                } else {
#pragma unroll
                    for (int rt = 0; rt < 2; ++rt)
#pragma unroll
                        for (int kt2 = 0; kt2 < 2; ++kt2)
#pragma unroll
                            for (int ss = 0; ss < 2; ++ss) { const int ii = 32 * rt + r;
                                const u32x2 lo = *(const LAS u32x2*)(L + P2_PS + ii * 144 + (32 * kt2 + 16 * ss + 4 * hh) * 2), hi = *(const LAS u32x2*)(L + P2_PS + ii * 144 + (32 * kt2 + 16 * ss + 8 + 4 * hh) * 2);
                                u32x4 o; o[0] = lo[0]; o[1] = lo[1]; o[2] = hi[0]; o[3] = hi[1];
                                st16_wt(srs, boff + GS_PF + ((rt * 2 + kt2) * 2 + ss) * 1024 + l3 * 16, o); }
                }
            }
        }
        LDS_BARRIER();
        if (grpB) {
            P2_PART(2, rwA);
        } else if (actA) {
            int l4 = lane; asm volatile("" : "+v"(l4));
            const int c16 = l4 & 15, g = l4 >> 4;
            const f32x4 z4 = {0.f, 0.f, 0.f, 0.f};
            f32x4 a10, a20, a21, a30, a31, a32, e0, e1, e2, e3;
            { const LAS unsigned char* ar = L + P2_AS + c16 * 272 + (4 * g) * 4;
              a10 = *(const LAS f32x4*)(ar + 16 * 272); a20 = *(const LAS f32x4*)(ar + 32 * 272); a21 = *(const LAS f32x4*)(ar + 32 * 272 + 64);
              a30 = *(const LAS f32x4*)(ar + 48 * 272); a31 = *(const LAS f32x4*)(ar + 48 * 272 + 64); a32 = *(const LAS f32x4*)(ar + 48 * 272 + 128);
              const LAS unsigned char* er = L + P2_ES + (c16 * 16 + 4 * g) * 4;
              e0 = *(const LAS f32x4*)er; e1 = *(const LAS f32x4*)(er + 1024); e2 = *(const LAS f32x4*)(er + 2048); e3 = *(const LAS f32x4*)(er + 3072); }
            const bf16x8 fA10 = g1_pack_b(z4 - a10, z4), fA2 = g1_pack_b(z4 - a20, z4 - a21), fA3a = g1_pack_b(z4 - a30, z4 - a31), fA3b = g1_pack_b(z4 - a32, z4);
            const bf16x8 fE0 = g1_pack_b(e0, z4), fE1 = g1_pack_b(e1, z4), fE2 = g1_pack_b(e2, z4), fE3 = g1_pack_b(e3, z4);
#pragma unroll
            for (int tl = 0; tl < 4; ++tl) {
                const int t16 = 4 * wave + tl; const bool isw = t16 < 8; const int d = 16 * (t16 & 7) + c16;
                f32x4 R[4];
#pragma unroll
                for (int ib = 0; ib < 4; ++ib)
#pragma unroll
                    for (int e = 0; e < 4; ++e) { const int row = 16 * ib + 4 * g + e; const float raw1 = bf2f(*(const LAS bf16_t*)(Sb + (isw ? P2_K : P2_V) + row * 272 + d * 2)); R[ib][e] = raw1 * beta_s[row] * (isw ? eg_s[row] : 1.0f); }
                const f32x4 X0 = MFMA16(fE0, g1_pack_b(R[0], z4), R[0]);
                const f32x4 Y1 = MFMA16(fA10, g1_pack_b(X0, z4), R[1]);
                const f32x4 X1 = MFMA16(fE1, g1_pack_b(Y1, z4), Y1);
                const f32x4 Y2 = MFMA16(fA2, g1_pack_b(X0, X1), R[2]);
                const f32x4 X2 = MFMA16(fE2, g1_pack_b(Y2, z4), Y2);
                f32x4 Y3 = MFMA16(fA3a, g1_pack_b(X0, X1), R[3]);
                Y3 = MFMA16(fA3b, g1_pack_b(X2, z4), Y3);
                const f32x4 X3 = MFMA16(fE3, g1_pack_b(Y3, z4), Y3);
                const f32x4 X[4] = {X0, X1, X2, X3};
                if (isw) {
#pragma unroll
                    for (int ib = 0; ib < 4; ++ib)
#pragma unroll
                        for (int e = 0; e < 4; ++e) *(LAS bf16_t*)(Sb + P2_Q + (16 * ib + 4 * g + e) * 272 + d * 2) = (bf16_t)(cvt2(-X[ib][e], 0.f) & 0xffffu);
                } else {
                    const int ws = d >> 5, cc = d & 31;
#pragma unroll
                    for (int ib = 0; ib < 4; ++ib) { const int rt = ib >> 1, q = 2 * (ib & 1) + (g >> 1), hh = g & 1;
                        u32x2 o; o[0] = cvt2(X[ib][0], X[ib][1]); o[1] = cvt2(X[ib][2], X[ib][3]);
                        st8_wt(blk + GS_UF + (size_t)(((ws * 2 + rt) * 64) + cc + 32 * hh) * 32 + q * 8, o); }
                }
            }
        }
        LDS_BARRIER();
        if (grpB) {
            { const int ntk = taskB + stride < 4224 ? taskB + stride : 4223; int s1, c1, h1; g1_decode(ntk, s1, c1, h1);
#pragma unroll
              for (int q = 0; q < 6; ++q) { const int ii = tb + 256 * q, jj = ii / 384, cc = ii % 384; pcw[q] = F.in[29][(size_t)jj * 3072 + (cc >> 7) * 1024 + h1 * 128 + (cc & 127)]; }
              const int ntp = ntk < 4095 ? ntk : 4095; int s2, c2, h2; g1_decode(ntp, s2, c2, h2);
              p2_load_part(F, rwA, s2, c2, h2, 0, tb);
#pragma unroll
              for (int q = 0; q < 6; ++q) cw_s[tb + 256 * q] = pcw[q]; }
        } else if (actA) {
            int l5 = lane; asm volatile("" : "+v"(l5));
            const int kt = wave, r = l5 & 31, hh = l5 >> 5;
#pragma unroll
            for (int rt = 0; rt < 2; ++rt)
#pragma unroll
                for (int ss = 0; ss < 2; ++ss) { const int ii = 32 * rt + r;
                    const u32x2 lo = *(const LAS u32x2*)(Sb + P2_Q + ii * 272 + (32 * kt + 16 * ss + 4 * hh) * 2), hi = *(const LAS u32x2*)(Sb + P2_Q + ii * 272 + (32 * kt + 16 * ss + 8 + 4 * hh) * 2);
                    u32x4 o; o[0] = lo[0]; o[1] = lo[1]; o[2] = hi[0]; o[3] = hi[1];
                    st16_wt(srs, boff + GS_WF + ((rt * 4 + kt) * 2 + ss) * 1024 + l5 * 16, o); }
            asm volatile("s_waitcnt vmcnt(0)" ::: "memory");
        }
        if (gact) {
            LAS float* gv = (LAS float*)(L + P2_VEC + (i & 1) * 1024);
            const bool ok = lane < (gs < BP ? 64 : TS); float x = ok ? gva : 0.f;
#pragma unroll
            for (int o = 1; o < 64; o <<= 1) { const float y = shfl_idx(x, lane >= o ? lane - o : lane); if (lane >= o) x += y; }
            const float gl = shfl_idx(x, 63);
            gv[lane] = ok ? gvb : 0.f; gv[64 + lane] = x; gv[128 + lane] = __expf(x); gv[192 + lane] = ok ? __expf(gl - x) : 0.f;
            const int gsidx = taskB < 4096 ? ((gs * 8 + gh) * 64 + gc) : taskB;
            if (lane == 0) __hip_atomic_store((unsigned*)DEC + gsidx, __float_as_uint(__expf(gl)), __ATOMIC_RELAXED, __HIP_MEMORY_SCOPE_AGENT);
        }
        LDS_BARRIER();
        if (tid == 0 && i >= 1) __hip_atomic_store(ready + 16 * sidx, 1u, __ATOMIC_RELAXED, __HIP_MEMORY_SCOPE_AGENT);
#undef P2_PART
    }
}

constexpr int G2_FB = GS_BYTES, G2_OSTRIDE = 528, G2_HN = 2 * G2_FB, G2_DEC = G2_HN + 512;
__device__ __forceinline__ bf16x8 pack8(const f32x16& x, const int s) {
    u32x4 p; p[0] = cvt2(x[8 * s], x[8 * s + 1]); p[1] = cvt2(x[8 * s + 2], x[8 * s + 3]); p[2] = cvt2(x[8 * s + 4], x[8 * s + 5]); p[3] = cvt2(x[8 * s + 6], x[8 * s + 7]);
    return __builtin_bit_cast(bf16x8, p);
}
template <bool WT>
__device__ __forceinline__ void g2_load_set(u32x4 (&pre)[18], float& dpre, const unsigned char* blk, int lt, brsrc_t srs, unsigned boff, const unsigned* flag, const float* decp) {
    if (WT) { unsigned sp = 0; while (__builtin_amdgcn_readfirstlane(__hip_atomic_load(flag, __ATOMIC_RELAXED, __HIP_MEMORY_SCOPE_AGENT)) == 0u && ++sp < (1u << 20)) __builtin_amdgcn_s_sleep(4);
        dpre = __uint_as_float(__hip_atomic_load((const unsigned*)decp, __ATOMIC_RELAXED, __HIP_MEMORY_SCOPE_AGENT));
#pragma unroll
        for (int i = 0; i < 18; ++i) pre[i] = ld16_wt(srs, boff + (unsigned)(i * 256 + lt) * 16u);
    } else { const u32x4* src = (const u32x4*)blk; dpre = *decp;
#pragma unroll
        for (int i = 0; i < 18; ++i) pre[i] = src[i * 256 + lt]; }
}
__device__ __forceinline__ void g2_store_set(const u32x4 (&pre)[18], LAS unsigned char* dst, int lt) {
#pragma unroll
    for (int i = 0; i < 18; ++i) *(LAS u32x4*)(dst + (size_t)(i * 256 + lt) * 16) = pre[i];
}
#define G2_FRAG(off) (*(const LAS bf16x8*)(B + (off)))
#define G2_SCHED() __builtin_amdgcn_sched_barrier(0)
__device__ __forceinline__ void g2_mfma_step(f32x16& S0, f32x16& S1, f32x16& S2, f32x16& S3, LAS unsigned char* Bimg, const float dec, int ws, int lane, int cc, int hh) {
    const LAS unsigned char* B = Bimg + lane * 16;
    f32x16 vn0, vn1, o0, o1;
    { const LAS u32x4* up = (const LAS u32x4*)(Bimg + GS_UF + (size_t)(ws * 2 * 64 + lane) * 32); const u32x4 u0 = up[0], u1 = up[1], u2 = up[128], u3 = up[129];
#pragma unroll
      for (int q = 0; q < 4; ++q) { vn0[2 * q] = lo16(u0[q]); vn0[2 * q + 1] = hi16(u0[q]); vn0[8 + 2 * q] = lo16(u1[q]); vn0[8 + 2 * q + 1] = hi16(u1[q]);
                                    vn1[2 * q] = lo16(u2[q]); vn1[2 * q + 1] = hi16(u2[q]); vn1[8 + 2 * q] = lo16(u3[q]); vn1[8 + 2 * q + 1] = hi16(u3[q]); } }
#pragma unroll
    for (int e = 0; e < 16; ++e) { o0[e] = 0.f; o1[e] = 0.f; }
#define G2_WQ(Sx, kt) do { _Pragma("unroll") for (int ss = 0; ss < 2; ++ss) { const bf16x8 sb = pack8(Sx, ss); \
        const bf16x8 fw0 = G2_FRAG(GS_WF + ((0 * 4 + kt) * 2 + ss) * 1024), fw1 = G2_FRAG(GS_WF + ((1 * 4 + kt) * 2 + ss) * 1024); \
        const bf16x8 fq0 = G2_FRAG(GS_QF + ((0 * 4 + kt) * 2 + ss) * 1024), fq1 = G2_FRAG(GS_QF + ((1 * 4 + kt) * 2 + ss) * 1024); \
        vn0 = MFMA32(fw0, sb, vn0); vn1 = MFMA32(fw1, sb, vn1); o0 = MFMA32(fq0, sb, o0); o1 = MFMA32(fq1, sb, o1); } } while (0)
    G2_WQ(S0, 0); G2_WQ(S1, 1); G2_WQ(S2, 2); G2_WQ(S3, 3);
#undef G2_WQ
    bf16x8 vb[2][2];
    vb[0][0] = pack8(vn0, 0); vb[0][1] = pack8(vn0, 1); vb[1][0] = pack8(vn1, 0); vb[1][1] = pack8(vn1, 1);
#pragma unroll
    for (int kt2 = 0; kt2 < 2; ++kt2)
#pragma unroll
        for (int ss = 0; ss < 2; ++ss) { o0 = MFMA32(G2_FRAG(GS_PF + ((0 * 2 + kt2) * 2 + ss) * 1024), vb[kt2][ss], o0); o1 = MFMA32(G2_FRAG(GS_PF + ((1 * 2 + kt2) * 2 + ss) * 1024), vb[kt2][ss], o1); }
    S0 = S0 * dec; S1 = S1 * dec; S2 = S2 * dec; S3 = S3 * dec;
#pragma unroll
    for (int kt2 = 0; kt2 < 2; ++kt2)
#pragma unroll
        for (int ss = 0; ss < 2; ++ss) {
            S0 = MFMA32(G2_FRAG(GS_KF + ((0 * 2 + kt2) * 2 + ss) * 1024), vb[kt2][ss], S0); S1 = MFMA32(G2_FRAG(GS_KF + ((1 * 2 + kt2) * 2 + ss) * 1024), vb[kt2][ss], S1);
            S2 = MFMA32(G2_FRAG(GS_KF + ((2 * 2 + kt2) * 2 + ss) * 1024), vb[kt2][ss], S2); S3 = MFMA32(G2_FRAG(GS_KF + ((3 * 2 + kt2) * 2 + ss) * 1024), vb[kt2][ss], S3); }
    LDS_BARRIER();
#pragma unroll
    for (int e = 0; e < 16; ++e) { const int rr = (e & 3) + 8 * (e >> 2) + 4 * hh;
        *(LAS float*)(Bimg + rr * G2_OSTRIDE + (32 * ws + cc) * 4) = o0[e]; *(LAS float*)(Bimg + (32 + rr) * G2_OSTRIDE + (32 * ws + cc) * 4) = o1[e]; }
    LDS_BARRIER();
}
__device__ __forceinline__ void g2_epi16(Frame& F, LAS unsigned char* L, const LAS unsigned char* Oimg, const u32x4 (&zz)[2], int row, int sub, size_t m, int h, bool rok, int lane) {
    f32x4 ov[4]; float ss = 0.f;
#pragma unroll
    for (int q = 0; q < 4; ++q) { ov[q] = *(const LAS f32x4*)(Oimg + row * G2_OSTRIDE + (sub * 16 + 4 * q) * 4); ss += (ov[q][0] * ov[q][0] + ov[q][1] * ov[q][1]) + (ov[q][2] * ov[q][2] + ov[q][3] * ov[q][3]); }
    ss += shfl_xor_l(ss, 1, lane); ss += shfl_xor_l(ss, 2, lane); ss += shfl_xor_l(ss, 4, lane);
    const float rn = __builtin_amdgcn_rsqf(ss * (1.f / 128.f) + EPS);
    if (rok) {
        const LAS float* hn_s = (const LAS float*)(L + G2_HN);
        u32x4* yp = (u32x4*)(F.Y1() + m * D + h * 128 + sub * 16);
#pragma unroll
        for (int q = 0; q < 2; ++q) {
            const f32x4 oa = ov[2 * q], ob = ov[2 * q + 1];
            const f32x4 ha = *(const LAS f32x4*)(hn_s + sub * 16 + 8 * q), hb = *(const LAS f32x4*)(hn_s + sub * 16 + 8 * q + 4);
            u32x4 yo;
            yo[0] = cvt2(oa[0] * rn * ha[0] * siluf_(lo16(zz[q][0])), oa[1] * rn * ha[1] * siluf_(hi16(zz[q][0])));
            yo[1] = cvt2(oa[2] * rn * ha[2] * siluf_(lo16(zz[q][1])), oa[3] * rn * ha[3] * siluf_(hi16(zz[q][1])));
            yo[2] = cvt2(ob[0] * rn * hb[0] * siluf_(lo16(zz[q][2])), ob[1] * rn * hb[1] * siluf_(hi16(zz[q][2])));
            yo[3] = cvt2(ob[2] * rn * hb[2] * siluf_(lo16(zz[q][3])), ob[3] * rn * hb[3] * siluf_(hi16(zz[q][3])));
            yp[q] = yo; }
    }
}
template <int NCH, bool WT>
__device__ __forceinline__ void g2_task(Frame& F, LAS unsigned char* L, const float* DEC, int s, int h, int ch0, int tid, int lane, int wave) {
    const size_t cstep = (size_t)GS_BYTES;
    const int base = seq_base(s), nvalid = s < BP ? 64 : TS;
    const unsigned char* blk0 = F.ws + WS_RB + (size_t)ch0 * GS_BYTES;
    constexpr int lastc = NCH - 1;
    if (wave < 4) {
        const int ws = wave, cc = lane & 31, hh = lane >> 5;
        f32x16 S0, S1, S2, S3;
        if (s < BP) {
#pragma unroll
            for (int e = 0; e < 16; ++e) { S0[e] = 0.f; S1[e] = 0.f; S2[e] = 0.f; S3[e] = 0.f; }
        } else {
            const float* sp = F.in[7] + ((size_t)(s - BP) * 8 + h) * 16384 + 32 * ws + cc;
#pragma unroll
            for (int e = 0; e < 16; ++e) { const int rr = (e & 3) + 8 * (e >> 2) + 4 * hh; S0[e] = sp[(size_t)rr * 128]; S1[e] = sp[(size_t)(32 + rr) * 128]; S2[e] = sp[(size_t)(64 + rr) * 128]; S3[e] = sp[(size_t)(96 + rr) * 128]; }
        }
        const LAS float* dec_s = (const LAS float*)(L + G2_DEC);
        const int erow = tid >> 3, esub = tid & 7; const bool erok = erow < nvalid;
        u32x4 zz[2];
#define G2_ZLOAD(cidx) do { const u32x4* zp = (const u32x4*)(F.Z1() + ((size_t)base + (cidx) * 64 + erow) * D + h * 128 + esub * 16); zz[0] = zp[0]; zz[1] = zp[1]; } while (0)
        LDS_BARRIER();
        if (NCH == 1) { if (erok) G2_ZLOAD(0); g2_mfma_step(S0, S1, S2, S3, L, dec_s[0], ws, lane, cc, hh); g2_epi16(F, L, L, zz, erow, esub, (size_t)base + erow, h, erok, lane); LDS_BARRIER(); }
        else for (int c = 0; c < NCH; c += 2) {
            G2_ZLOAD(c);
            g2_mfma_step(S0, S1, S2, S3, L, dec_s[c], ws, lane, cc, hh);
            g2_epi16(F, L, L, zz, erow, esub, (size_t)base + c * 64 + erow, h, erok, lane);
            LDS_BARRIER();
            G2_ZLOAD(c + 1);
            g2_mfma_step(S0, S1, S2, S3, L + G2_FB, dec_s[c + 1], ws, lane, cc, hh);
            g2_epi16(F, L, L + G2_FB, zz, erow, esub, (size_t)base + (c + 1) * 64 + erow, h, erok, lane);
            LDS_BARRIER();
        }
        int l9 = lane; asm volatile("" : "+v"(l9));
        const int cc9 = l9 & 31, hh9 = l9 >> 5;
        float* so = (s < BP ? F.out + O_GSP + ((size_t)s * 8 + h) * 16384 : F.out + O_GSS + ((size_t)(s - BP) * 8 + h) * 16384) + 32 * ws + cc9;
#pragma unroll
        for (int e = 0; e < 16; ++e) { const int rr = (e & 3) + 8 * (e >> 2) + 4 * hh9; so[(size_t)rr * 128] = S0[e]; so[(size_t)(32 + rr) * 128] = S1[e]; so[(size_t)(64 + rr) * 128] = S2[e]; so[(size_t)(96 + rr) * 128] = S3[e]; }
    } else {
        const int lt = tid - 256;
        if (lt < 128) ((LAS float*)(L + G2_HN))[lt] = F.in[32][lt];
        const brsrc_t srs = staging_rsrc(F.ws);
        const unsigned* ready = (const unsigned*)(F.ws + WS_READY);
        LAS float* dec_w = (LAS float*)(L + G2_DEC);
#define G2_LOAD(pre, dpre, k) do { const int _k = (k) < lastc ? (k) : lastc; g2_load_set<WT>(pre, dpre, blk0 + (size_t)_k * cstep, lt, srs, (unsigned)(ch0 + _k) * (unsigned)GS_BYTES, ready + 16 * (ch0 + _k), DEC + ch0 + _k); } while (0)
        u32x4 preA[18], preB[18]; float dA, dB;
        G2_LOAD(preA, dA, 0);
        G2_LOAD(preB, dB, 1);
        g2_store_set(preA, L, lt); if (lt == 0) dec_w[0] = dA;
        G2_LOAD(preA, dA, 2);
        const int erow = tid >> 3, esub = tid & 7; const bool erok = erow < nvalid;
        u32x4 zz[2];
#define G2_ZLOAD(cidx) do { const u32x4* zp = (const u32x4*)(F.Z1() + ((size_t)base + (cidx) * 64 + erow) * D + h * 128 + esub * 16); zz[0] = zp[0]; zz[1] = zp[1]; } while (0)
        LDS_BARRIER();
        if (NCH == 1) {
            if (erok) G2_ZLOAD(0);
            LDS_BARRIER();
            LDS_BARRIER();
            g2_epi16(F, L, L, zz, erow, esub, (size_t)base + erow, h, erok, lane);
            LDS_BARRIER();
        } else {
            for (int c = 0; c < NCH; c += 2) {
                {
                    g2_store_set(preB, L + G2_FB, lt); if (lt == 0) dec_w[(c + 1) & 63] = dB;
                    G2_ZLOAD(c);
                    G2_LOAD(preB, dB, c + 3);
                    LDS_BARRIER();
                    LDS_BARRIER();
                    g2_epi16(F, L, L, zz, erow, esub, (size_t)base + c * 64 + erow, h, erok, lane);
                    LDS_BARRIER();
                }
                {
                    g2_store_set(preA, L, lt); if (lt == 0) dec_w[(c + 2) & 63] = dA;
                    G2_ZLOAD(c + 1);
                    G2_LOAD(preA, dA, c + 4);
                    LDS_BARRIER();
                    LDS_BARRIER();
                    g2_epi16(F, L, L + G2_FB, zz, erow, esub, (size_t)base + (c + 1) * 64 + erow, h, erok, lane);
                    LDS_BARRIER();
                }
            }
        }
    }
}
#undef G2_ZLOAD
#undef G2_LOAD
constexpr int G12_CHAINS = 64;
__device__ __forceinline__ void phase_gdn_fused(Frame& F) {
    LAS unsigned char* L = F.lds;
    const float* DEC = (const float*)(F.ws + WS_DEC);
    if ((int)blockIdx.x < G12_CHAINS && F.G > G12_CHAINS) {
        const int tid = opaque_tid(F.wv);
        const int ci = blockIdx.x;
        g2_task<64, true>(F, L, DEC, ci >> 3, ci & 7, ci * 64, tid, tid & 63, F.wv);
    } else {
        const bool all = !(F.G > G12_CHAINS);
        const int p = all ? (int)blockIdx.x : (int)blockIdx.x - G12_CHAINS, np = all ? F.G : F.G - G12_CHAINS;
        gdn_g1_tasks(F, p, np);
        for (int t = p; t < 128; t += np) {
            const int tid = opaque_tid(F.wv);
            __syncthreads();
            g2_task<1, true>(F, L, DEC, BP + (t >> 3), t & 7, 4096 + t, tid, tid & 63, F.wv);
        }
    }
}

__device__ __forceinline__ float dpp_shr_f(float idv, float x, const int o) {
    int r;
    switch (o) {
        case 1: r = __builtin_amdgcn_update_dpp(__float_as_int(idv), __float_as_int(x), 0x111, 0xf, 0xf, false); break;
        case 2: r = __builtin_amdgcn_update_dpp(__float_as_int(idv), __float_as_int(x), 0x112, 0xf, 0xf, false); break;
        case 4: r = __builtin_amdgcn_update_dpp(__float_as_int(idv), __float_as_int(x), 0x114, 0xf, 0xf, false); break;
        default: r = __builtin_amdgcn_update_dpp(__float_as_int(idv), __float_as_int(x), 0x118, 0xf, 0xf, false); break;
    }
    return __int_as_float(r);
}
__device__ __forceinline__ float dpp_shr0_f(float x, const int o) {
    int r;
    switch (o) {
        case 1: r = __builtin_amdgcn_update_dpp(0, __float_as_int(x), 0x111, 0xf, 0xf, true); break;
        case 2: r = __builtin_amdgcn_update_dpp(0, __float_as_int(x), 0x112, 0xf, 0xf, true); break;
        case 4: r = __builtin_amdgcn_update_dpp(0, __float_as_int(x), 0x114, 0xf, 0xf, true); break;
        default: r = __builtin_amdgcn_update_dpp(0, __float_as_int(x), 0x118, 0xf, 0xf, true); break;
    }
    return __int_as_float(r);
}
__device__ __forceinline__ void phase_lru(Frame& F) {
    int tid = opaque_tid(F.wv);
    const int lane = tid & 63, wave = __builtin_amdgcn_readfirstlane(tid >> 6);
    const int gw = F.vcu * 8 + wave, NGW = F.G * 8, h = gw & 7, g = lane >> 4, l15 = lane & 15;
    LAS unsigned char* xs = F.lds + wave * 9216;
    LAS float* cst = (LAS float*)(F.lds + 73728 + wave * 768);
    const bf16_t* LGW = (const bf16_t*)(F.ws + WS_LGW);
    float* LAG = F.LAG();
    bf16x8 wfa[4][2], wfx[4][2];
#pragma unroll
    for (int nt = 0; nt < 4; ++nt)
#pragma unroll
        for (int ks = 0; ks < 2; ++ks) {
            wfa[nt][ks] = *(const bf16x8*)(LGW + ((size_t)(h * 2 + 0) * 64 + 16 * nt + l15) * 64 + 32 * ks + 8 * g);
            wfx[nt][ks] = *(const bf16x8*)(LGW + ((size_t)(h * 2 + 1) * 64 + 16 * nt + l15) * 64 + 32 * ks + 8 * g); }
    cst[lane] = -1.4426950408889634f * F.in[18][h * 64 + lane]; cst[64 + lane] = -1.4426950408889634f * F.in[20][h * 64 + lane]; cst[128 + lane] = -8.0f * 1.4426950408889634f * softplusf_(-F.in[21][h * 64 + lane]);
    for (int task = gw; task < 4224; task += NGW) {
        int s, c; if (task < 4096) { s = task >> 9; c = (task >> 3) & 63; } else { s = BP + ((task - 4096) >> 3); c = 0; }
        const int T = seq_len(s), base = seq_base(s), t0 = c * 64, ntile = s < BP ? 4 : 1;
        {
            int l1 = lane; asm volatile("" : "+v"(l1));
            const int cg = l1 & 7, tp = l1 >> 3;
#pragma unroll 1
            for (int hf2 = 0; hf2 < 2; ++hf2) {
                const int chb = h * 64 + cg * 8 + hf2 * 4;
                float xr[11][4];
                if (s < BP) {
                    u32x2 w[11];
#pragma unroll
                    for (int i = 0; i < 11; ++i) { int tt = t0 + tp * 8 - 3 + i; tt = tt < 0 ? 0 : tt; w[i] = *(const u32x2*)(F.U0() + (size_t)(base + tt) * EV_IN + C_XA + chb); }
                    if (t0 == 0 && tp == 0) { w[0] = (u32x2){0u, 0u}; w[1] = (u32x2){0u, 0u}; w[2] = (u32x2){0u, 0u}; }
#pragma unroll
                    for (int i = 0; i < 11; ++i) { xr[i][0] = lo16(w[i][0]); xr[i][1] = hi16(w[i][0]); xr[i][2] = lo16(w[i][1]); xr[i][3] = hi16(w[i][1]); }
                } else {
#pragma unroll
                    for (int i = 0; i < 11; ++i) {
                        const int tt = t0 + tp * 8 - 3 + i;
                        if (tt >= 0 && tt < T) { const u32x2 w = *(const u32x2*)(F.U0() + (size_t)(base + tt) * EV_IN + C_XA + chb);
                            xr[i][0] = lo16(w[0]); xr[i][1] = hi16(w[0]); xr[i][2] = lo16(w[1]); xr[i][3] = hi16(w[1]); }
                        else if (tt < 0) { const f32x4 a = *(const f32x4*)(F.in[2] + ((size_t)(s - BP) * 3 + (tt + 3)) * 512 + chb); xr[i][0] = a[0]; xr[i][1] = a[1]; xr[i][2] = a[2]; xr[i][3] = a[3]; }
                        else { xr[i][0] = 0.f; xr[i][1] = 0.f; xr[i][2] = 0.f; xr[i][3] = 0.f; }
                    }
                }
                const f32x4 c0 = *(const f32x4*)(F.in[15] + chb), c1 = *(const f32x4*)(F.in[15] + 512 + chb), c2 = *(const f32x4*)(F.in[15] + 1024 + chb), c3 = *(const f32x4*)(F.in[15] + 1536 + chb), cb = *(const f32x4*)(F.in[16] + chb);
#pragma unroll
                for (int i = 0; i < 8; ++i) { float o[4];
#pragma unroll
                    for (int e = 0; e < 4; ++e) o[e] = c0[e] * xr[i][e] + c1[e] * xr[i + 1][e] + c2[e] * xr[i + 2][e] + c3[e] * xr[i + 3][e] + cb[e];
                    u32x2 w; w[0] = cvt2(o[0], o[1]); w[1] = cvt2(o[2], o[3]);
                    *(LAS u32x2*)(xs + (tp * 8 + i) * 144 + cg * 16 + hf2 * 8) = w; }
                if (t0 + 64 >= T && tp == ((T - 1) >> 3) - (t0 >> 3)) {
                    float* o = (s < BP ? F.out + O_LCP + (size_t)s * 3 * 512 : F.out + O_LCS + (size_t)(s - BP) * 3 * 512) + chb;
#pragma unroll
                    for (int q = 0; q < 3; ++q) *(f32x4*)(o + q * 512) = (f32x4){xr[8 + q][0], xr[8 + q][1], xr[8 + q][2], xr[8 + q][3]};
                }
            }
        }
        float hin[4], arun[4];
#pragma unroll
        for (int nt = 0; nt < 4; ++nt) { hin[nt] = 0.f; arun[nt] = 1.f; }
        asm volatile("s_waitcnt lgkmcnt(0)" ::: "memory");
        float cba[4], cbx[4], csp[4];
#pragma unroll
        for (int nt = 0; nt < 4; ++nt) { cba[nt] = cst[16 * nt + l15]; cbx[nt] = cst[64 + 16 * nt + l15]; csp[nt] = cst[128 + 16 * nt + l15]; }
        for (int tt = 0; tt < ntile; ++tt) {
            const int tok = 16 * tt + l15;
            const bf16x8 b0 = *(const LAS bf16x8*)(xs + tok * 144 + (8 * g) * 2), b1 = *(const LAS bf16x8*)(xs + tok * 144 + (32 + 8 * g) * 2);
            const size_t m4 = (size_t)base + t0 + 16 * tt + 4 * g;
#pragma unroll
            for (int nt = 0; nt < 4; ++nt) {
                f32x4 za = {0.f, 0.f, 0.f, 0.f}, zx = {0.f, 0.f, 0.f, 0.f};
                za = MFMA16(b0, wfa[nt][0], za); za = MFMA16(b1, wfa[nt][1], za);
                zx = MFMA16(b0, wfx[nt][0], zx); zx = MFMA16(b1, wfx[nt][1], zx);
                const int n = 16 * nt + l15;
                float Ap[4], Bp[4];
#pragma unroll
                for (int e = 0; e < 4; ++e) {
                    const float xc = bf2f(*(const LAS bf16_t*)(xs + (16 * tt + 4 * g + e) * 144 + n * 2));
                    const float r = __builtin_amdgcn_rcpf(1.0f + __builtin_amdgcn_exp2f(za[e] + cba[nt])), ig = __builtin_amdgcn_rcpf(1.0f + __builtin_amdgcn_exp2f(zx[e] + cbx[nt]));
                    const float a = __builtin_amdgcn_exp2f(r * csp[nt]);
                    const float b = __builtin_amdgcn_sqrtf(fmaxf(1.0f - a * a, 0.f)) * (ig * xc);
                    if (e == 0) { Ap[0] = a; Bp[0] = b; } else { Bp[e] = a * Bp[e - 1] + b; Ap[e] = Ap[e - 1] * a; }
                }
                const float A0 = shfl_idx(Ap[3], l15), B0 = shfl_idx(Bp[3], l15), A1 = shfl_idx(Ap[3], l15 + 16), B1 = shfl_idx(Bp[3], l15 + 16), A2 = shfl_idx(Ap[3], l15 + 32), B2 = shfl_idx(Bp[3], l15 + 32);
                const float c1 = A0 * hin[nt] + B0, c2 = A1 * c1 + B1, c3 = A2 * c2 + B2, q2 = A0 * A1, q3 = q2 * A2;
                const float carry = g == 0 ? hin[nt] : g == 1 ? c1 : g == 2 ? c2 : c3;
                const float pref = arun[nt] * (g == 0 ? 1.0f : g == 1 ? A0 : g == 2 ? q2 : q3);
                float hv3 = 0.f, pv3 = 0.f;
#pragma unroll
                for (int e = 0; e < 4; ++e) {
                    const float hv = Bp[e] + Ap[e] * carry, pv = Ap[e] * pref;
                    *(unsigned*)(F.YO() + (m4 + e) * D + h * 128 + 2 * n) = cvt2(hv, pv);
                    if (e == 3) { hv3 = hv; pv3 = pv; }
                }
                hin[nt] = shfl_idx(hv3, l15 + 48); arun[nt] = shfl_idx(pv3, l15 + 48);
                if (nt & 1) __builtin_amdgcn_sched_barrier(0);
            }
        }
        if (s < BP && g == 0) {
            f32x2* lp = (f32x2*)LAG + (size_t)(s * 64 + c) * 512 + h * 64;
#pragma unroll
            for (int nt = 0; nt < 4; ++nt) lp[16 * nt + l15] = (f32x2){arun[nt], hin[nt]};
        }
        asm volatile("s_waitcnt lgkmcnt(0)" ::: "memory");
    }
}

#define LRA_LOAD(c_) do { _Pragma("unroll") for (int it = 0; it < 8; ++it) { const size_t m = (size_t)base + (c_) * 64 + 8 * (it < nit ? it : nit - 1) + tq; \
    hl[it] = *(const u32x4*)(F.YO() + m * D + h * 128 + 16 * cg); pp[it] = *(const u32x4*)(F.YO() + m * D + h * 128 + 16 * cg + 8); gg[it] = *(const u32x4*)(F.U0() + m * EV_IN + C_GA + h * 64 + 8 * cg); } } while (0)
__device__ __forceinline__ void lru_apply_chunk(Frame& F, const u32x4 (&hl)[8], const u32x4 (&pp)[8], const u32x4 (&gg)[8], const float hf, const int s, const int base, const int t0, const int T, const int nit, const int h, const int lane) {
    const int cg = lane & 7, tq = lane >> 3;
    float cr[8];
#pragma unroll
    for (int e = 0; e < 8; ++e) cr[e] = shfl_idx(hf, 8 * cg + e);
#pragma unroll
    for (int it = 0; it < 8; ++it) if (it < nit) {
        const int t = t0 + 8 * it + tq; const size_t m = (size_t)base + t;
        float hv[8]; u32x4 yo;
#pragma unroll
        for (int e = 0; e < 4; ++e) { const unsigned w0 = e < 2 ? hl[it][2 * e] : pp[it][2 * e - 4], w1 = e < 2 ? hl[it][2 * e + 1] : pp[it][2 * e - 3];
            hv[2 * e] = lo16(w0) + hi16(w0) * cr[2 * e]; hv[2 * e + 1] = lo16(w1) + hi16(w1) * cr[2 * e + 1];
            yo[e] = cvt2(hv[2 * e] * siluf_(lo16(gg[it][e])), hv[2 * e + 1] * siluf_(hi16(gg[it][e]))); }
        *(u32x4*)(F.Y0() + m * D + h * 64 + 8 * cg) = yo;
        if (t == T - 1) { float* o = (s < BP ? F.out + O_LHP + s * 512 : F.out + O_LHS + (s - BP) * 512) + h * 64 + 8 * cg;
            *(f32x4*)o = (f32x4){hv[0], hv[1], hv[2], hv[3]}; *(f32x4*)(o + 4) = (f32x4){hv[4], hv[5], hv[6], hv[7]}; }
    }
}
__device__ __forceinline__ void phase_lru_apply(Frame& F) {
    PHASE_IDS();
    const int gw = F.vcu * 8 + wave, NGW = F.G * 8, cg = lane & 7, tq = lane >> 3;
    for (int w = gw; w < 2048; w += NGW) {
        const int s = w >> 8, c0 = 2 * ((w >> 3) & 31), h = w & 7, base = s * TP, nit = 8;
        u32x4 hl[8], pp[8], gg[8];
        LRA_LOAD(c0);
        const f32x2* lp = (const f32x2*)F.LAG() + (size_t)(s * 64) * 512 + h * 64 + lane;
        const f32x2 own = lp[(size_t)c0 * 512];
        float hf = 0.f;
        for (int j0 = 0; j0 < c0; j0 += 32) { f32x2 v[32];
#pragma unroll
            for (int q = 0; q < 32; ++q) { const int jj = j0 + q < c0 ? j0 + q : c0 - 1; v[q] = lp[(size_t)jj * 512]; }
#pragma unroll
            for (int q = 0; q < 32; ++q) if (j0 + q < c0) hf = v[q][0] * hf + v[q][1]; }
        lru_apply_chunk(F, hl, pp, gg, hf, s, base, c0 * 64, TP, 8, h, lane);
        hf = own[0] * hf + own[1];
        LRA_LOAD(c0 + 1);
        lru_apply_chunk(F, hl, pp, gg, hf, s, base, (c0 + 1) * 64, TP, 8, h, lane);
    }
    for (int w = gw; w < 128; w += NGW) {
        const int s = BP + (w >> 3), h = w & 7, base = seq_base(s), nit = 2;
        u32x4 hl[8], pp[8], gg[8];
        LRA_LOAD(0);
        const float hf = F.in[3][(s - BP) * 512 + h * 64 + lane];
        lru_apply_chunk(F, hl, pp, gg, hf, s, base, 0, TS, 2, h, lane);
    }
}

constexpr size_t RB_VTP = RB_WEND, RB_VTS = RB_VTP + (size_t)BP * 2 * 64 * TP * 2, RB_VTEND = RB_VTS + (size_t)BS * 2 * 64 * 192 * 2;
static_assert(RB_VTEND <= RB_BYTES, "ws map");
__device__ __forceinline__ void vt_load(Frame& F, u32x4 (&w)[8], const int task, const int lane) {
    int s, kv, kb; if (task < 1024) { s = task >> 7; kv = (task >> 6) & 1; kb = task & 63; } else { const int r = task - 1024; s = BP + r / 6; kv = (r % 6) / 3; kb = r % 3; }
    const int row8 = lane >> 3, ch = lane & 7;
#pragma unroll
    for (int i = 0; i < 8; ++i) {
        const int key = 8 * i + row8, kg = kb * 64 + key; w[i] = (u32x4){0u, 0u, 0u, 0u};
        if (s < BP) w[i] = *(const u32x4*)(F.U0() + (size_t)(s * TP + kg) * EV_IN + C_V + kv * 64 + ch * 8);
        else if (kg < 128) { const f32x4* p = (const f32x4*)(F.in[5] + ((size_t)((s - BP) * 128 + kg) * 2 + kv) * 64 + ch * 8); const f32x4 a = p[0], b = p[1]; w[i][0] = cvt2(a[0], a[1]); w[i][1] = cvt2(a[2], a[3]); w[i][2] = cvt2(b[0], b[1]); w[i][3] = cvt2(b[2], b[3]); }
        else if (kg < 128 + TS) w[i] = *(const u32x4*)(F.U0() + (size_t)(MP + (s - BP) * TS + (kg - 128)) * EV_IN + C_V + kv * 64 + ch * 8);
    }
}
__device__ __forceinline__ void vt_finish(Frame& F, const u32x4 (&w)[8], const int task, const int lane, LAS unsigned char* xs) {
    int s, kv, kb; if (task < 1024) { s = task >> 7; kv = (task >> 6) & 1; kb = task & 63; } else { const int r = task - 1024; s = BP + r / 6; kv = (r % 6) / 3; kb = r % 3; }
    bf16_t* VTP = (bf16_t*)(F.ws + WS_RB + RB_VTP); bf16_t* VTS = (bf16_t*)(F.ws + WS_RB + RB_VTS);
    const int row8 = lane >> 3, ch = lane & 7;
#pragma unroll
    for (int i = 0; i < 8; ++i) *(LAS u32x4*)(xs + (8 * i + row8) * 144 + ch * 16) = w[i];
    asm volatile("s_waitcnt lgkmcnt(0)" ::: "memory");
    bf16_t* dst = s < BP ? VTP + ((size_t)(s * 2 + kv) * 64 + lane) * TP + kb * 64 : VTS + ((size_t)((s - BP) * 2 + kv) * 64 + lane) * 192 + kb * 64;
#pragma unroll
    for (int q = 0; q < 8; ++q) { u32x4 o;
#pragma unroll
        for (int e = 0; e < 4; ++e) { const unsigned lo = *(const LAS bf16_t*)(xs + (8 * q + 2 * e) * 144 + lane * 2), hi = *(const LAS bf16_t*)(xs + (8 * q + 2 * e + 1) * 144 + lane * 2); o[e] = lo | (hi << 16); }
        *(u32x4*)(dst + 8 * q) = o; }
    asm volatile("s_waitcnt lgkmcnt(0)" ::: "memory");
}
__device__ __forceinline__ void phase_rope_vt(Frame& F) {
    PHASE_IDS();
    const int gw = F.vcu * 8 + wave, NGW = F.G * 8, voff = NGW > 1120 ? NGW - 1120 : 0, t0 = gw - voff;
    LAS unsigned char* xs = F.lds + wave * 9216;
    u32x4 vw[8];
    const bool have = t0 >= 0 && t0 < 1120;
    if (have) vt_load(F, vw, t0, lane);
    rope_phase_body(F, tid);
    if (have) vt_finish(F, vw, t0, lane, xs);
    for (int task = t0 + NGW; task < 1120; task += NGW) if (task >= 0) { vt_load(F, vw, task, lane); vt_finish(F, vw, task, lane, xs); }
}
constexpr int AT_K = 0, AT_V = 27648;
__device__ __forceinline__ void attn_issue(Frame& F, const bf16_t* VTP, int task, int tid, int wave, int lane, u32x4 (&kreg)[3], u32x4 (&vreg)[3], u32x4 (&qreg)[4]) {
    const int s = task >> 7, c = (task >> 1) & 63, kv = task & 1, tok0 = c * 64 - 128;
#pragma unroll
    for (int i = 0; i < 3; ++i) { const int idx = tid + 512 * i, key = idx >> 3, ch = idx & 7; int tk = tok0 + key; tk = tk < 0 ? 0 : tk;
        kreg[i] = *(const u32x4*)(F.U0() + (size_t)(s * TP + tk) * EV_IN + C_K + kv * 64 + ch * 8); }
#pragma unroll
    for (int i = 0; i < 3; ++i) { const int idx = tid + 512 * i, d = idx / 24, ch = idx % 24; int tk = tok0 + ch * 8; tk = tk < 0 ? 0 : tk;
        vreg[i] = *(const u32x4*)(VTP + ((size_t)(s * 2 + kv) * 64 + d) * TP + tk); }
    const int g = wave >> 1, qh = wave & 1, hq = kv * 4 + g, r = lane & 31, hh = lane >> 5;
    const size_t m = (size_t)s * TP + c * 64 + qh * 32 + r;
#pragma unroll
    for (int ks = 0; ks < 4; ++ks) qreg[ks] = *(const u32x4*)(F.U0() + m * EV_IN + C_Q + hq * 64 + 16 * ks + 8 * hh);
}
__device__ __forceinline__ void phase_attn(Frame& F) {
    PHASE_IDS();
    LAS unsigned char* L = F.lds;
    const bf16_t* VTP = (const bf16_t*)(F.ws + WS_RB + RB_VTP); const bf16_t* VTS = (const bf16_t*)(F.ws + WS_RB + RB_VTS);
    u32x4 kreg[3], vreg[3], qreg[4];
    attn_issue(F, VTP, F.vcu < 1024 ? F.vcu : 0, tid, wave, lane, kreg, vreg, qreg);
    for (int ti = F.vcu; ti < 1024 + 64; ti += F.G) {
        if (ti >= 1024 && ti < 1056) continue;
        const int task = ti < 1024 ? ti : ti - 32;
        int s, c, kv; if (task < 1024) { s = task >> 7; c = (task >> 1) & 63; kv = task & 1; } else { s = BP + ((task - 1024) >> 1); c = 0; kv = task & 1; }
        const int base = seq_base(s), tok0 = c * 64 - 128;
        const int kmin = s < BP ? (tok0 < 0 ? -tok0 : 0) : 0, kmax = s < BP ? 192 : 128 + TS;
        const int tid = opaque_tid(F.wv), lane = tid & 63;
        const int g = wave >> 1, qh = wave & 1, hq = kv * 4 + g, r = lane & 31, hh = lane >> 5, qi = qh * 32 + r;
        const bool qok = s < BP ? true : qi < TS;
        const size_t m = (size_t)base + c * 64 + (qok ? qi : 0);
        bf16x8 qf[4]; u32x2 gbr[8];
        LDS_BARRIER();
        if (s < BP) {
#pragma unroll
            for (int i = 0; i < 3; ++i) { const int idx = tid + 512 * i, key = idx >> 3, ch = idx & 7; const u32x4 z = {0u, 0u, 0u, 0u}; *(LAS u32x4*)(L + AT_K + key * 144 + ch * 16) = key >= kmin ? kreg[i] : z; }
#pragma unroll
            for (int i = 0; i < 3; ++i) { const int idx = tid + 512 * i, d = idx / 24, ch = idx % 24; const u32x4 z = {0u, 0u, 0u, 0u}; *(LAS u32x4*)(L + AT_V + d * 400 + ch * 16) = ch * 8 >= kmin ? vreg[i] : z; }
#pragma unroll
            for (int ks = 0; ks < 4; ++ks) { u32x4 w;
#pragma unroll
                for (int e = 0; e < 4; ++e) w[e] = cvt2(lo16(qreg[ks][e]) * 0.125f, hi16(qreg[ks][e]) * 0.125f);
                qf[ks] = __builtin_bit_cast(bf16x8, w); }
        } else {
#pragma unroll
            for (int i = 0; i < 3; ++i) {
                const int idx = tid + 512 * i, key = idx >> 3, ch = idx & 7; u32x4 w = {0u, 0u, 0u, 0u};
                if (key < kmax) {
                    if (key < 128) { const f32x4* p = (const f32x4*)(F.in[4] + ((size_t)((s - BP) * 128 + key) * 2 + kv) * 64 + ch * 8); const f32x4 a = p[0], b2 = p[1]; w[0] = cvt2(a[0], a[1]); w[1] = cvt2(a[2], a[3]); w[2] = cvt2(b2[0], b2[1]); w[3] = cvt2(b2[2], b2[3]); }
                    else w = *(const u32x4*)(F.U0() + (size_t)(base + key - 128) * EV_IN + C_K + kv * 64 + ch * 8);
                }
                *(LAS u32x4*)(L + AT_K + key * 144 + ch * 16) = w;
            }
#pragma unroll
            for (int i = 0; i < 3; ++i) {
                const int idx = tid + 512 * i, d = idx / 24, ch = idx % 24, key = ch * 8;
                *(LAS u32x4*)(L + AT_V + d * 400 + ch * 16) = *(const u32x4*)(VTS + ((size_t)((s - BP) * 2 + kv) * 64 + d) * 192 + key);
            }
#pragma unroll
            for (int ks = 0; ks < 4; ++ks) { u32x4 w = {0u, 0u, 0u, 0u};
                if (qok) { const u32x4 x = *(const u32x4*)(F.U0() + m * EV_IN + C_Q + hq * 64 + 16 * ks + 8 * hh);
#pragma unroll
                    for (int e = 0; e < 4; ++e) w[e] = cvt2(lo16(x[e]) * 0.125f, hi16(x[e]) * 0.125f); }
                qf[ks] = __builtin_bit_cast(bf16x8, w); }
        }
#pragma unroll
        for (int qq = 0; qq < 4; ++qq) { gbr[2 * qq] = qok ? *(const u32x2*)(F.U0() + m * EV_IN + C_GB + hq * 64 + 8 * qq + 4 * hh) : (u32x2){0u, 0u}; gbr[2 * qq + 1] = qok ? *(const u32x2*)(F.U0() + m * EV_IN + C_GB + hq * 64 + 32 + 8 * qq + 4 * hh) : (u32x2){0u, 0u}; }
        { const int nt = ti + F.G < 1024 ? ti + F.G : (ti < 1024 ? ti : 0); int t9 = tid; asm volatile("" : "+v"(t9)); attn_issue(F, VTP, nt, t9, wave, t9 & 63, kreg, vreg, qreg); }
        const float sink = F.in[22][hq];
        LDS_BARRIER();
        float mrun = sink, lrun = 1.0f;
        f32x16 o0, o1;
#pragma unroll
        for (int e = 0; e < 16; ++e) { o0[e] = 0.f; o1[e] = 0.f; }
#pragma unroll 1
        for (int half = 0; half < 2; ++half) {
            f32x16 sc[3];
#pragma unroll
            for (int k3 = 0; k3 < 3; ++k3) {
                const int kt = 3 * half + k3;
#pragma unroll
                for (int e = 0; e < 16; ++e) sc[k3][e] = 0.f;
#pragma unroll
                for (int ks = 0; ks < 4; ++ks) { const bf16x8 kf = *(const LAS bf16x8*)(L + AT_K + (32 * kt + r) * 144 + (16 * ks + 8 * hh) * 2); sc[k3] = MFMA32(kf, qf[ks], sc[k3]); }
            }
            float mx = -1e30f;
#pragma unroll
            for (int k3 = 0; k3 < 3; ++k3)
#pragma unroll
                for (int e = 0; e < 16; ++e) { const int kidx = 32 * (3 * half + k3) + (e & 3) + 8 * (e >> 2) + 4 * hh; const bool ok = kidx >= kmin && kidx < kmax; sc[k3][e] = ok ? sc[k3][e] : -1e30f; mx = fmaxf(mx, sc[k3][e]); }
            mx = fmaxf(mx, shfl_xor_l(mx, 32, lane));
            const float mnew = fmaxf(mrun, mx), alpha = __expf(mrun - mnew);
            float psum = 0.f;
#pragma unroll
            for (int k3 = 0; k3 < 3; ++k3)
#pragma unroll
                for (int e = 0; e < 16; ++e) { const float p = __expf(sc[k3][e] - mnew); sc[k3][e] = p; psum += p; }
            psum += shfl_xor_l(psum, 32, lane);
            lrun = lrun * alpha + psum; mrun = mnew;
            o0 = o0 * alpha; o1 = o1 * alpha;
#pragma unroll
            for (int k3 = 0; k3 < 3; ++k3)
#pragma unroll
                for (int ss = 0; ss < 2; ++ss) {
                    const int kt = 3 * half + k3;
                    const bf16x8 pb = pack8(sc[k3], ss);
                    const LAS unsigned char* vp = L + AT_V + r * 400 + (32 * kt + 16 * ss + 4 * hh) * 2;
                    const u32x2 a0 = *(const LAS u32x2*)vp, a1 = *(const LAS u32x2*)(vp + 16), b0 = *(const LAS u32x2*)(vp + 32 * 400), b1 = *(const LAS u32x2*)(vp + 32 * 400 + 16);
                    const u32x4 va = {a0[0], a0[1], a1[0], a1[1]}, vb = {b0[0], b0[1], b1[0], b1[1]};
                    o0 = MFMA32(__builtin_bit_cast(bf16x8, va), pb, o0); o1 = MFMA32(__builtin_bit_cast(bf16x8, vb), pb, o1);
                }
        }
        const float il = __builtin_amdgcn_rcpf(lrun);
        if (qok) {
#pragma unroll
            for (int qq = 0; qq < 4; ++qq) {
                { const int d = 8 * qq + 4 * hh; const u32x2 gb = gbr[2 * qq];
                  u32x2 yo; yo[0] = cvt2(o0[4 * qq] * il * siluf_(lo16(gb[0])), o0[4 * qq + 1] * il * siluf_(hi16(gb[0]))); yo[1] = cvt2(o0[4 * qq + 2] * il * siluf_(lo16(gb[1])), o0[4 * qq + 3] * il * siluf_(hi16(gb[1])));
                  *(u32x2*)(F.Y0() + m * D + 512 + hq * 64 + d) = yo; }
                { const int d = 32 + 8 * qq + 4 * hh; const u32x2 gb = gbr[2 * qq + 1];
                  u32x2 yo; yo[0] = cvt2(o1[4 * qq] * il * siluf_(lo16(gb[0])), o1[4 * qq + 1] * il * siluf_(hi16(gb[0]))); yo[1] = cvt2(o1[4 * qq + 2] * il * siluf_(lo16(gb[1])), o1[4 * qq + 3] * il * siluf_(hi16(gb[1])));
                  *(u32x2*)(F.Y0() + m * D + 512 + hq * 64 + d) = yo; }
            }
        }
    }
    __syncthreads();
}

constexpr int SG_A = 0, SG_B = 36864, SG_BUF = 36864 + 9216;
struct SOut { bf16_t* O0; int ld0; int split; bf16_t* O1; int ld1; };
__device__ __forceinline__ void sgemm_strip(Frame& F, const bf16_t* A, const bf16_t* Bt, const int K, const int n0, const SOut o, const int tid, const int lane, const int wave) {
    LAS unsigned char* L = F.lds;
    const int nkt = K / 64;
    const bf16_t* ap = A + (size_t)(tid >> 3) * K + (tid & 7) * 8;
    const bf16_t* bp = Bt + (size_t)(n0 + (tid >> 3)) * K + (tid & 7) * 8;
    const int lofs = (tid >> 3) * 144 + (tid & 7) * 16;
    u32x4 ra[4], rb, sa[4], sb;
#define SG_LOAD(RA, RB, kt) do { _Pragma("unroll") for (int i = 0; i < 4; ++i) RA[i] = *(const u32x4*)(ap + (size_t)i * 64 * K + (kt) * 64); RB = *(const u32x4*)(bp + (kt) * 64); } while (0)
#define SG_STORE(RA, RB, buf) do { _Pragma("unroll") for (int i = 0; i < 4; ++i) *(LAS u32x4*)(L + (buf) * SG_BUF + SG_A + lofs + i * 64 * 144) = RA[i]; *(LAS u32x4*)(L + (buf) * SG_BUF + SG_B + lofs) = RB; } while (0)
    SG_LOAD(ra, rb, 0); SG_LOAD(sa, sb, 1);
    SG_STORE(ra, rb, 0);
    SG_LOAD(ra, rb, (2 < nkt ? 2 : nkt - 1));
    f32x16 acc0, acc1;
#pragma unroll
    for (int e = 0; e < 16; ++e) { acc0[e] = 0.f; acc1[e] = 0.f; }
    const int r = lane & 31, hh = lane >> 5;
    LDS_BARRIER();
    for (int kt = 0; kt < nkt; kt += 2) {
#define SG_STEP(buf, RA, RB, knext) do { \
        const LAS unsigned char* Ab = L + (buf) * SG_BUF + SG_A + (32 * wave + r) * 144 + hh * 16; const LAS unsigned char* Bb = L + (buf) * SG_BUF + SG_B + r * 144 + hh * 16; \
        _Pragma("unroll") for (int ks = 0; ks < 4; ++ks) { const bf16x8 af = *(const LAS bf16x8*)(Ab + ks * 32), b0 = *(const LAS bf16x8*)(Bb + ks * 32), b1 = *(const LAS bf16x8*)(Bb + 32 * 144 + ks * 32); \
            acc0 = MFMA32(b0, af, acc0); acc1 = MFMA32(b1, af, acc1); } \
        SG_STORE(RA, RB, (buf) ^ 1); { const int kn = (knext) < nkt ? (knext) : nkt - 1; SG_LOAD(RA, RB, kn); } \
        LDS_BARRIER(); } while (0)
        SG_STEP(0, sa, sb, kt + 3);
        SG_STEP(1, ra, rb, kt + 4);
    }
#undef SG_STEP
#undef SG_LOAD
#undef SG_STORE
    const int row = 32 * wave + r; int colt = n0; bf16_t* base = o.O0; int ld = o.ld0;
    if (colt >= o.split) { base = o.O1; ld = o.ld1; colt -= o.split; }
    bf16_t* rowp = base + (size_t)row * ld + colt;
#pragma unroll
    for (int q = 0; q < 4; ++q) {
        u32x2 w0, w1; w0[0] = cvt2(acc0[4 * q], acc0[4 * q + 1]); w0[1] = cvt2(acc0[4 * q + 2], acc0[4 * q + 3]); w1[0] = cvt2(acc1[4 * q], acc1[4 * q + 1]); w1[1] = cvt2(acc1[4 * q + 2], acc1[4 * q + 3]);
        *(u32x2*)(rowp + 8 * q + 4 * hh) = w0; *(u32x2*)(rowp + 32 + 8 * q + 4 * hh) = w1; }
    LDS_BARRIER();
}
__device__ __forceinline__ void sgemm_phase(Frame& F, const bf16_t* A, const bf16_t* Bt, const int N, const int K, const SOut o, const int from) {
    const int nstrip = N / 64;
    for (int st = ((int)blockIdx.x - from + F.G) % F.G; st < nstrip; st += F.G) {
        const int tid = opaque_tid(F.wv);
        sgemm_strip(F, A, Bt, K, st * 64, o, tid, tid & 63, F.wv);
    }
}

__device__ __forceinline__ void rows_final(Frame& F, const int m0, const int n, const int s, const int lane) {
    const float* MODP = (const float*)(F.ws + WS_MODP);
    f32x4 A1[4];
#pragma unroll
    for (int j = 0; j < 4; ++j) { const int c = 4 * lane + 256 * j; const f32x4 g = *(const f32x4*)(F.in[27] + c), gt = mod4(MODP, 1, s, 2048 + c);
#pragma unroll
        for (int e = 0; e < 4; ++e) A1[j][e] = gt[e] * g[e]; }
    u32x2 ycur[4], xcur[4];
#pragma unroll
    for (int j = 0; j < 4; ++j) { ycur[j] = *(const u32x2*)(F.YO() + (size_t)m0 * D + 4 * lane + 256 * j); xcur[j] = *(const u32x2*)((const bf16_t*)(F.out + O_Y + (size_t)m0 * D) + 4 * lane + 256 * j); }
    for (int i = 0; i < n; ++i) {
        const int m = m0 + i, mn = m0 + (i + 1 < n ? i + 1 : i); u32x2 ynxt[4], xnxt[4];
#pragma unroll
        for (int j = 0; j < 4; ++j) { ynxt[j] = *(const u32x2*)(F.YO() + (size_t)mn * D + 4 * lane + 256 * j); xnxt[j] = *(const u32x2*)((const bf16_t*)(F.out + O_Y + (size_t)mn * D) + 4 * lane + 256 * j); }
        f32x4 y[4]; float ss = 0.f;
#pragma unroll
        for (int j = 0; j < 4; ++j) { y[j] = (f32x4){lo16(ycur[j][0]), hi16(ycur[j][0]), lo16(ycur[j][1]), hi16(ycur[j][1])}; ss += (y[j][0] * y[j][0] + y[j][1] * y[j][1]) + (y[j][2] * y[j][2] + y[j][3] * y[j][3]); }
        const float r1 = rsqrtf(wave_sum(ss, lane) * (1.f / D) + EPS);
#pragma unroll
        for (int j = 0; j < 4; ++j) { f32x4 o;
#pragma unroll
            for (int e = 0; e < 4; ++e) o[e] = ((e & 1) ? hi16(xcur[j][e >> 1]) : lo16(xcur[j][e >> 1])) + A1[j][e] * (y[j][e] * r1);
            *(f32x4*)(F.out + O_Y + (size_t)m * D + 4 * lane + 256 * j) = o; }
#pragma unroll
        for (int j = 0; j < 4; ++j) { ycur[j] = ynxt[j]; xcur[j] = xnxt[j]; }
    }
}
__device__ __forceinline__ void phase_final_rowwise(Frame& F) {
    PHASE_IDS();
    const int gw = F.vcu * 8 + wave, NGW = F.G * 8;
    for (int w = gw; w < MP / 16; w += NGW) rows_final(F, w * 16, 16, w >> 8, lane);
    for (int w = gw; w < MS; w += NGW) rows_final(F, MP + w, 1, BP + (w >> 4), lane);
}

__global__ void __launch_bounds__(512, 2) fwd_megakernel(Params P) {
    extern __shared__ __attribute__((aligned(16))) unsigned char lds_raw[];
    Frame F;
    F.lds = (LAS unsigned char*)lds_raw;
    F.wv = __builtin_amdgcn_readfirstlane(threadIdx.x >> 6);
    F.G = gridDim.x; { const int bx = blockIdx.x; F.vcu = (F.G % 8 == 0) ? (bx % 8) * (F.G / 8) + bx / 8 : bx; }
    F.in = P.in; F.out = P.out; F.ws = P.ws;

    volatile LAS unsigned* misc = (volatile LAS unsigned*)(F.lds + LDS_BYTES - 64);
    if (threadIdx.x < 16) misc[threadIdx.x] = 0u;
    __syncthreads();
    XcdBarrier xbar = xcd_barrier_post((unsigned*)(P.ws + WS_CTL), misc);
#define GRID_BAR() xcd_barrier(xbar, F.wv)
    phase_mod0(F);
    GRID_BAR();
    phase_prologue(F);
    phase_mod1(F);
    phase_prenorm0(F);
    GRID_BAR();
    { pg8::Gemm g{F.XN(), F.W0I(), MP, EV_IN, D}; pg8::StaticOrder S; S.init(MP, EV_IN, F.G, (int)blockIdx.x);
      pg8::EpiBf16 E{F.U0(), EV_IN, 1 << 30, F.U0(), EV_IN}; pg8::gemm_phase(F.lds, g, S, E, F.wv);
      sgemm_phase(F, F.XN() + (size_t)MP * D, F.W0I(), EV_IN, D, SOut{F.U0() + (size_t)MP * EV_IN, EV_IN, 1 << 30, nullptr, 0}, 128); }
    GRID_BAR();
    phase_rope_vt(F);
    phase_lru(F);
    GRID_BAR();
    phase_lru_apply(F);
    phase_attn(F);
    GRID_BAR();
    { pg8::Gemm g{F.Y0(), F.W0O(), MP, D, D}; pg8::StaticOrder S; S.init(MP, D, F.G, (int)blockIdx.x);
      pg8::EpiBf16 E{F.YO(), D, 1 << 30, F.YO(), D}; pg8::gemm_phase(F.lds, g, S, E, F.wv);
      sgemm_phase(F, F.Y0() + (size_t)MP * D, F.W0O(), D, D, SOut{F.YO() + (size_t)MP * D, D, 1 << 30, nullptr, 0}, 0); }
    GRID_BAR();
    phase_mid_rowwise(F);
    GRID_BAR();
    { pg8::Gemm g{F.XN(), F.W1I(), MP, OD_MAIN, D}; pg8::StaticOrder S; S.init(MP, OD_MAIN, F.G, (int)blockIdx.x);
      pg8::EpiBf16 E{F.QKV1(), 3072, 3072, F.Z1(), D}; pg8::gemm_phase(F.lds, g, S, E, F.wv);
      sgemm_phase(F, F.XN() + (size_t)MP * D, F.W1I(), OD_MAIN, D, SOut{F.QKV1() + (size_t)MP * 3072, 3072, 3072, F.Z1() + (size_t)MP * D, D}, 0); }
    GRID_BAR();
    phase_gdn_fused(F);
    GRID_BAR();
    { pg8::Gemm g{F.Y1(), F.W1O(), MP, D, D}; pg8::StaticOrder S; S.init(MP, D, F.G, (int)blockIdx.x);
      pg8::EpiBf16 E{F.YO(), D, 1 << 30, F.YO(), D}; pg8::gemm_phase(F.lds, g, S, E, F.wv);
      sgemm_phase(F, F.Y1() + (size_t)MP * D, F.W1O(), D, D, SOut{F.YO() + (size_t)MP * D, D, 1 << 30, nullptr, 0}, 0); }
    GRID_BAR();
    phase_final_rowwise(F);
}

extern "C" void kernel_launch(void* const* d_in, const int* in_sizes, int n_in, void* d_out, int out_size, void* d_ws, size_t ws_size, hipStream_t stream) {
    static int grid = 0;
    if (grid == 0) {
        if (n_in != 34 || out_size != (int)O_END || ws_size < WS_END) { grid = -1; return; }
        int dev = 0, cus = 0, per_cu = 0;
        if (hipGetDevice(&dev) != hipSuccess || hipDeviceGetAttribute(&cus, hipDeviceAttributeMultiprocessorCount, dev) != hipSuccess) { grid = -1; return; }
        if (hipFuncSetAttribute((const void*)fwd_megakernel, hipFuncAttributeMaxDynamicSharedMemorySize, LDS_BYTES) != hipSuccess) { grid = -1; return; }
        if (hipOccupancyMaxActiveBlocksPerMultiprocessor(&per_cu, (const void*)fwd_megakernel, 512, LDS_BYTES) != hipSuccess || per_cu < 1) { grid = -1; return; }
        grid = cus;
    }
    if (grid < 0) return;
    if (hipMemsetAsync((char*)d_ws + WS_CTL, 0, 65536 + 4224 * 64, stream) != hipSuccess) return;
    Params p{};
    for (int i = 0; i < 34; ++i) p.in[i] = (const float*)d_in[i];
    p.out = (float*)d_out; p.ws = (unsigned char*)d_ws;
    void* args[] = {&p};
    (void)hipLaunchCooperativeKernel((const void*)fwd_megakernel, dim3(grid), dim3(512), args, LDS_BYTES, stream);
}
```
